# Optimizing an MI355X kernel written in HIP

```python
import math
import jax, jax.numpy as jnp
from jax import lax
import numpy as np

D_MODEL = 1024
BATCH = 4
SEQ = 4096
DEPTH = 4

GRID_W = 64
CTX_LEN = 256
MIX_WIDTH = D_MODEL
RWKV_WIDTH = MIX_WIDTH // 2
CONV_WIDTH = MIX_WIDTH - RWKV_WIDTH
HEAD_SIZE = 64
RWKV_HEADS = RWKV_WIDTH // HEAD_SIZE
DECAY_LORA = 64
ICLR_LORA = 64
GATE_LORA = 128
CONV_K = 3
D_FF = 7 * D_MODEL // 2
N_EXPERTS = 8
TOP_K = 2
N_DENSE = (DEPTH + 1) // 2
N_MOE = DEPTH // 2
DN_ALPHA = (2 * DEPTH) ** 0.25
DN_BETA = (8 * DEPTH) ** -0.25
LN_EPS = 1e-5
GN_EPS = 64e-5
NORM_EPS = 1e-12
PROJ_SIZES = (RWKV_WIDTH, RWKV_WIDTH, RWKV_WIDTH, 2 * DECAY_LORA, 2 * ICLR_LORA, GATE_LORA, CONV_WIDTH, CONV_WIDTH, CONV_WIDTH)
PROJ_COLS = sum(PROJ_SIZES)
SPLIT_IDX = tuple(sum(PROJ_SIZES[:i + 1]) for i in range(len(PROJ_SIZES) - 1))
VALUE_GROUPS = (2, 8)

kernel_name = "hybrid_rwkv7_shortconv_moe_deepnorm_dit"


def layer_norm(x, g, b):
    xf = x.astype(jnp.float32)
    mu = jnp.mean(xf, -1, keepdims=True)
    var = jnp.mean(jnp.square(xf - mu), -1, keepdims=True)
    return ((xf - mu) * lax.rsqrt(var + LN_EPS)).astype(x.dtype) * g + b


def heads(t):
    return t.reshape(t.shape[:-1] + (RWKV_HEADS, HEAD_SIZE))


def rwkv_prep(r, k, v, wd, ad, w0, w2, a0, a2, k_k, k_a):
    nb, n = r.shape[:2]
    wd = wd.reshape(nb, n, 2, DECAY_LORA)
    ad = ad.reshape(nb, n, 2, ICLR_LORA)
    w_log = -jax.nn.softplus(-(w0 + jnp.einsum("bldr,drc->bldc", jnp.tanh(wd), w2))) - 0.5
    decay = jnp.exp(-jnp.exp(w_log.astype(jnp.float32)))
    a = jax.nn.sigmoid(a0 + jnp.einsum("bldr,drc->bldc", ad, a2))
    kk = heads(k * k_k).astype(jnp.float32)
    kk = kk / jnp.maximum(jnp.sqrt(jnp.sum(kk * kk, -1, keepdims=True)), NORM_EPS)
    k_dir = heads(k[:, :, None, :] * (1 + (a - 1) * k_a))
    b_vec = kk[:, :, None] * heads(a)
    return (heads(r), k_dir, heads(v), heads(decay), kk, b_vec)


def wkv_scan(s0, terms, d, reverse, readout):
    r, k, v, w, kk, b = terms
    tm = lambda t: jnp.moveaxis(t.astype(jnp.float32), 1, 0)
    xs = (tm(w[:, :, d]), tm(k[:, :, d]), tm(v), tm(kk), tm(b[:, :, d]))
    if readout:
        xs = xs + (tm(r),)

    def step(s, inp):
        w_t, k_t, v_t, kk_t, b_t = inp[:5]
        sa = jnp.einsum("bhvk,bhk->bhv", s, -kk_t)
        s = s * w_t[:, :, None, :] + sa[..., None] * b_t[:, :, None, :] + v_t[..., None] * k_t[:, :, None, :]
        y = jnp.einsum("bhvk,bhk->bhv", s, inp[5]) if readout else None
        return s, y

    s_fin, ys = lax.scan(step, s0, xs, reverse=reverse)
    return s_fin, (jnp.moveaxis(ys, 0, 1) if readout else None)


def rwkv_readout(y, terms, gd, r_k, g2, lnx_g, lnx_b):
    r, k, v = terms[:3]
    mu = jnp.mean(y, -1, keepdims=True)
    var = jnp.mean(jnp.square(y - mu), -1, keepdims=True)
    yn = (y - mu) * lax.rsqrt(var + GN_EPS)
    bonus = jnp.sum(jnp.sum(r[:, :, None] * k * r_k, -1, keepdims=True) * v[:, :, None], axis=2)
    out = yn.reshape(y.shape[:2] + (RWKV_WIDTH,)) * lnx_g + lnx_b + bonus.reshape(y.shape[:2] + (RWKV_WIDTH,))
    g = jax.nn.sigmoid(gd) @ g2
    return (out * g).astype(gd.dtype)


def short_conv(u, w):
    pad = CONV_K // 2
    n = u.shape[-2]
    up = jnp.pad(u, [(0, 0)] * (u.ndim - 2) + [(pad, pad), (0, 0)])
    out = up[..., 0:n, :] * w[0]
    for j in range(1, CONV_K):
        out = out + up[..., j:j + n, :] * w[j]
    return out


def conv_branch(cb, cc, ch, conv_w, rows):
    u = cc * ch
    if rows is not None:
        u = u.reshape(u.shape[0], rows, GRID_W, u.shape[-1])
    return cb * short_conv(u, conv_w).reshape(cb.shape)


def token_mixer(hl, hc, rows, w_in, w0, w2, a0, a2, k_k, k_a, r_k, g2, lnx_g, lnx_b, conv_w, w_out, ctx_out):
    pl = jnp.split(hl @ w_in, SPLIT_IDX, axis=-1)
    pc = jnp.split(hc @ w_in, SPLIT_IDX, axis=-1)
    lat = rwkv_prep(pl[0], pl[1], pl[2], pl[3], pl[4], w0, w2, a0, a2, k_k, k_a)
    cx = rwkv_prep(pc[0], pc[1], pc[2], pc[3], pc[4], w0, w2, a0, a2, k_k, k_a)
    s0 = jnp.zeros((hl.shape[0], RWKV_HEADS, HEAD_SIZE, HEAD_SIZE), jnp.float32)
    y_lat, y_ctx = 0.0, 0.0
    for d in range(2):
        s_ctx, yc = wkv_scan(s0, cx, d, d == 1, ctx_out)
        _, yl = wkv_scan(s_ctx, lat, d, d == 1, True)
        y_lat = y_lat + yl
        if ctx_out:
            y_ctx = y_ctx + yc
    out_l = jnp.concatenate([rwkv_readout(y_lat, lat, pl[5], r_k, g2, lnx_g, lnx_b),
                             conv_branch(pl[6], pl[7], pl[8], conv_w, rows)], axis=-1) @ w_out
    if not ctx_out:
        return out_l, None
    out_c = jnp.concatenate([rwkv_readout(y_ctx, cx, pc[5], r_k, g2, lnx_g, lnx_b),
                             conv_branch(pc[6], pc[7], pc[8], conv_w, None)], axis=-1) @ w_out
    return out_l, out_c


def swiglu(x, w1, w3, w2):
    return (jax.nn.silu(x @ w1) * (x @ w3)) @ w2


def moe_ffn(x, w_router, b_router, w1, w3, w2):
    logits = (x @ w_router + b_router).astype(jnp.float32)
    top_v, top_i = lax.top_k(logits, TOP_K)
    top_w = jax.nn.softmax(top_v, axis=-1)
    gate = jnp.sum(jax.nn.one_hot(top_i, N_EXPERTS, dtype=jnp.float32) * top_w[..., None], axis=-2).astype(x.dtype)
    out = gate[..., 0:1] * swiglu(x, w1[0], w3[0], w2[0])
    for e in range(1, N_EXPERTS):
        out = out + gate[..., e:e + 1] * swiglu(x, w1[e], w3[e], w2[e])
    return out


def channel_mixer(h, l, ffn_w1, ffn_w3, ffn_w2, router_w, router_b, moe_w1, moe_w3, moe_w2):
    i = l // 2
    if l % 2 == 0:
        return swiglu(h, ffn_w1[i], ffn_w3[i], ffn_w2[i])
    return moe_ffn(h, router_w[i], router_b[i], moe_w1[i], moe_w3[i], moe_w2[i])


def setup_inputs(seed: int = 0) -> dict:
    key = jax.random.key(seed)
    ks = iter(jax.random.split(key, 40))
    D = D_MODEL
    L = DEPTH
    nrm = lambda shape, s: jax.random.normal(next(ks), shape, jnp.float32) * s
    col_scale = jnp.concatenate([jnp.full((n,), DN_BETA if i in VALUE_GROUPS else 1.0, jnp.float32)
                                 for i, n in enumerate(PROJ_SIZES)])
    return {
        "x": nrm((BATCH, SEQ, D), 1.0),
        "c": nrm((BATCH, D), 1.0),
        "ctx": nrm((BATCH, CTX_LEN, D), 1.0),
        "c_ctx": nrm((D,), 1.0),
        "w_mod": nrm((L, D, 6 * D), 0.5 * D ** -0.5),
        "b_mod": nrm((L, 6 * D), 0.02),
        "w_in": nrm((L, D, PROJ_COLS), D ** -0.5) * col_scale,
        "rk_w0": -6.0 + 5.0 * jax.random.uniform(next(ks), (L, 2, RWKV_WIDTH), jnp.float32),
        "rk_w2": nrm((L, 2, DECAY_LORA, RWKV_WIDTH), 0.1 * DECAY_LORA ** -0.5),
        "rk_a0": nrm((L, 2, RWKV_WIDTH), 0.1),
        "rk_a2": nrm((L, 2, ICLR_LORA, RWKV_WIDTH), 0.1 * ICLR_LORA ** -0.5),
        "rk_kk": 0.85 + nrm((L, RWKV_WIDTH), 0.02),
        "rk_ka": 1.0 + nrm((L, RWKV_WIDTH), 0.02),
        "rk_rk": nrm((L, RWKV_HEADS, HEAD_SIZE), 0.1),
        "rk_g2": nrm((L, GATE_LORA, RWKV_WIDTH), GATE_LORA ** -0.5),
        "rk_lnx_g": 1.0 + nrm((L, RWKV_WIDTH), 0.02),
        "rk_lnx_b": nrm((L, RWKV_WIDTH), 0.02),
        "conv_w": nrm((L, CONV_K, CONV_WIDTH), CONV_K ** -0.5),
        "w_out": nrm((L, MIX_WIDTH, D), MIX_WIDTH ** -0.5 * DN_BETA),
        "ln1_g": 1.0 + nrm((L, D), 0.02),
        "ln1_b": nrm((L, D), 0.02),
        "ln2_g": 1.0 + nrm((L, D), 0.02),
        "ln2_b": nrm((L, D), 0.02),
        "ffn_w1": nrm((N_DENSE, D, D_FF), D ** -0.5),
        "ffn_w3": nrm((N_DENSE, D, D_FF), D ** -0.5),
        "ffn_w2": nrm((N_DENSE, D_FF, D), D_FF ** -0.5 * DN_BETA),
        "router_w": nrm((N_MOE, D, N_EXPERTS), D ** -0.5),
        "router_b": nrm((N_MOE, N_EXPERTS), 0.01),
        "moe_w1": nrm((N_MOE, N_EXPERTS, D, D_FF), D ** -0.5),
        "moe_w3": nrm((N_MOE, N_EXPERTS, D, D_FF), D ** -0.5),
        "moe_w2": nrm((N_MOE, N_EXPERTS, D_FF, D), D_FF ** -0.5 * DN_BETA),
    }


def reference(x, c, ctx, c_ctx, w_mod, b_mod, w_in, rk_w0, rk_w2, rk_a0, rk_a2, rk_kk, rk_ka, rk_rk, rk_g2,
              rk_lnx_g, rk_lnx_b, conv_w, w_out, ln1_g, ln1_b, ln2_g, ln2_b, ffn_w1, ffn_w3, ffn_w2,
              router_w, router_b, moe_w1, moe_w3, moe_w2):
    rows = x.shape[1] // GRID_W
    n_ctx = ctx.shape[1]
    xl, xc = x, ctx
    for l in range(DEPTH):
        last = l == DEPTH - 1
        ml = jnp.split((jax.nn.silu(c) @ w_mod[l] + b_mod[l])[:, None, :], 6, axis=-1)
        mc = jnp.split(jax.nn.silu(c_ctx) @ w_mod[l] + b_mod[l], 6, axis=-1)
        mix_l, mix_c = token_mixer(xl * (1 + ml[1]) + ml[0], xc * (1 + mc[1]) + mc[0], rows,
                                   w_in[l], rk_w0[l], rk_w2[l], rk_a0[l], rk_a2[l], rk_kk[l], rk_ka[l],
                                   rk_rk[l], rk_g2[l], rk_lnx_g[l], rk_lnx_b[l], conv_w[l], w_out[l], not last)
        xl = layer_norm(DN_ALPHA * xl + ml[2] * mix_l, ln1_g[l], ln1_b[l])
        if last:
            f_l = channel_mixer(xl * (1 + ml[4]) + ml[3], l, ffn_w1, ffn_w3, ffn_w2,
                                router_w, router_b, moe_w1, moe_w3, moe_w2)
        else:
            xc = layer_norm(DN_ALPHA * xc + mc[2] * mix_c, ln1_g[l], ln1_b[l])
            h = jnp.concatenate([xc * (1 + mc[4]) + mc[3], xl * (1 + ml[4]) + ml[3]], axis=1)
            f = channel_mixer(h, l, ffn_w1, ffn_w3, ffn_w2, router_w, router_b, moe_w1, moe_w3, moe_w2)
            xc = layer_norm(DN_ALPHA * xc + mc[5] * f[:, :n_ctx], ln2_g[l], ln2_b[l])
            f_l = f[:, n_ctx:]
        xl = layer_norm(DN_ALPHA * xl + ml[5] * f_l, ln2_g[l], ln2_b[l])
    return xl
```

```cpp
#include <hip/hip_runtime.h>
#include <cstdio>
#include <cstdint>
namespace pg8 {
#define PG8_LAS __attribute__((address_space(3)))
typedef unsigned short bf16_t;
typedef short bf16x8 __attribute__((ext_vector_type(8)));
typedef float f32x4 __attribute__((ext_vector_type(4)));
typedef unsigned u32x4 __attribute__((ext_vector_type(4)));
constexpr int BM = 256, BK = 64, HALF = 128, HTB = HALF * BK * 2  , STAGE_BYTES = 8 * HTB, NXCD = 8, WGM = 8;

__host__ __device__ __forceinline__ int lds_byte(int r, int c) { const int st = (r >> 4) * 2 + (c >> 5), rr = r & 15, cc = c & 31, ob = rr * 64 + cc * 2; return st * 1024 + (ob ^ (((ob >> 9) & 1) << 5)); }
__host__ __device__ __forceinline__ void stage_rc(int b, int& R, int& C) { const int st = b / 1024, sb = b % 1024, swz = sb ^ (((sb >> 9) & 1) << 5); R = (st >> 1) * 16 + swz / 64; C = (st & 1) * 32 + (swz % 64) / 2; }
__host__ __device__ __forceinline__ int perm32(int rho) { const int n = rho >> 4, i = rho & 15; return 8 * (i >> 2) + 4 * n + (i & 3); }

struct Unit { int pm, pn; };
struct Gemm { const bf16_t* A; const bf16_t* Bt; int M, N, K; };

struct StaticOrder {
    int nM, nN, nwg, G, c;
    __host__ __device__ void init(int M, int N, int G_, int c_) { nM = M / BM; nN = N / BM; nwg = nM * nN; G = G_; c = c_; }
    __host__ __device__ bool next(int i, Unit& u) const {
        const long L = (long)i * G + c; if (L >= nwg) return false;
        int wgid = (int)L; { const int q = nwg / NXCD, r = nwg % NXCD, xcd = wgid % NXCD, off = wgid / NXCD; wgid = (xcd < r ? xcd * (q + 1) : r * (q + 1) + (xcd - r) * q) + off; }
        const int nig = WGM * nN, gid = wgid / nig, fm = gid * WGM, gsz = (nM - fm) < WGM ? (nM - fm) : WGM;
        u.pm = fm + ((wgid % nig) % gsz); u.pn = (wgid % nig) / gsz; return true;
    }
    __device__ __forceinline__ const bf16_t* bt(const Gemm& g, const Unit&) const { return g.Bt; }
    __device__ __forceinline__ void a_ready(const Unit&) const {}
    __device__ __forceinline__ void done(const Unit&) const {}
};

__device__ __forceinline__ unsigned cvt_pk_bf16(float lo, float hi) { unsigned r; asm volatile("v_cvt_pk_bf16_f32 %0, %1, %2" : "=v"(r) : "v"(lo), "v"(hi)); return r; }
typedef float f32x2 __attribute__((ext_vector_type(2)));
__device__ __forceinline__ f32x2 gelu_pk(f32x2 v) {
    const f32x2 av = __builtin_elementwise_abs(v), d = av * 0.2316418882f + 1.0f;
    f32x2 t; t.x = __builtin_amdgcn_rcpf(d.x); t.y = __builtin_amdgcn_rcpf(d.y);
    f32x2 q = t * 0.5307027145f + (-0.7265760135f); q = q * t + 0.7107068705f; q = q * t + (-0.142248368f); q = q * t + 0.127414796f; q = q * t;
    const f32x2 s = (v * v) * (-0.72134752044f);
    f32x2 e; e.x = __builtin_amdgcn_exp2f(s.x); e.y = __builtin_amdgcn_exp2f(s.y);
    const f32x2 m = v * (q * e), r = v - m;
    f32x2 o; o.x = v.x < 0.f ? m.x : r.x; o.y = v.y < 0.f ? m.y : r.y; return o;
}

template <int ACT  > struct EpiBf16 {
    static constexpr bool PERM = true, AFTER_DRAIN = false; static_assert(ACT == 0 || ACT == 1, "EpiBf16: ACT is 0 (none) or 1 (gelu_pk)");
    bf16_t* O; int ldc; const float* bias; int split_cols; size_t split_stride; float scale0;
    __device__ __forceinline__ void operator()(const f32x4 (&acc)[2][2][4][2], const Unit& u, int wr, int wc, int fr, int fq) const {
        const int row0 = u.pm * BM + wr * 64 + fr; int colt = u.pn * BM; bf16_t* base = O;
        float sc = 1.f; if (split_cols) { const int t = colt / split_cols; base += (size_t)t * split_stride; colt -= t * split_cols; if (t == 0) sc = scale0; }
        const int col0 = colt + wc * 32 + 8 * fq, bcol0 = u.pn * BM + wc * 32 + 8 * fq;
        f32x4 bv[2][2];
#pragma unroll
        for (int bj = 0; bj < 2; ++bj)
#pragma unroll
            for (int n = 0; n < 2; ++n) bv[bj][n] = bias ? *(const f32x4*)(bias + bcol0 + bj * HALF + 4 * n) : (f32x4){0.f, 0.f, 0.f, 0.f};
#pragma unroll
        for (int ai = 0; ai < 2; ++ai)
#pragma unroll
            for (int m = 0; m < 4; ++m) { bf16_t* rowp = base + (size_t)(row0 + ai * HALF + m * 16) * ldc + col0;
#pragma unroll
                for (int bj = 0; bj < 2; ++bj) { f32x4 v0 = acc[ai][bj][m][0] + bv[bj][0], v1 = acc[ai][bj][m][1] + bv[bj][1];
                    if (ACT == 1) { f32x2 a = gelu_pk((f32x2){v0[0], v0[1]}), b = gelu_pk((f32x2){v0[2], v0[3]}), c = gelu_pk((f32x2){v1[0], v1[1]}), d = gelu_pk((f32x2){v1[2], v1[3]});
                        v0 = (f32x4){a.x, a.y, b.x, b.y}; v1 = (f32x4){c.x, c.y, d.x, d.y}; }
                    v0 = v0 * sc; v1 = v1 * sc; u32x4 w; w.x = cvt_pk_bf16(v0[0], v0[1]); w.y = cvt_pk_bf16(v0[2], v0[3]); w.z = cvt_pk_bf16(v1[0], v1[1]); w.w = cvt_pk_bf16(v1[2], v1[3]);
                    *(u32x4*)(rowp + bj * HALF) = w; } }
    }
};
struct EpiF32 {
    static constexpr bool PERM = false, AFTER_DRAIN = false;
    float* C; int ldc; int accum;
    __device__ __forceinline__ void operator()(const f32x4 (&acc)[2][2][4][2], const Unit& u, int wr, int wc, int fr, int fq) const {
        const int row0 = u.pm * BM + wr * 64 + fr, col0 = u.pn * BM + wc * 32 + 4 * fq;
#pragma unroll
        for (int ai = 0; ai < 2; ++ai)
#pragma unroll
            for (int m = 0; m < 4; ++m) { float* rowp = C + (size_t)(row0 + ai * HALF + m * 16) * ldc + col0;
#pragma unroll
                for (int bj = 0; bj < 2; ++bj)
#pragma unroll
                    for (int n = 0; n < 2; ++n) { f32x4 v = acc[ai][bj][m][n]; if (accum) v += *(const f32x4*)(rowp + bj * HALF + n * 16); *(f32x4*)(rowp + bj * HALF + n * 16) = v; } }
    }
};
struct EpiSwiGLU {
    static constexpr bool PERM = true, AFTER_DRAIN = false;
    bf16_t* O; int ldo; const float* rowscale; int rs_stride;
    __device__ __forceinline__ void operator()(const f32x4 (&acc)[2][2][4][2], const Unit& u, int wr, int wc, int fr, int fq) const {
        typedef unsigned u32x2v __attribute__((ext_vector_type(2)));
        const int row0 = u.pm * BM + wr * 64 + fr; const int ch0 = (u.pn * BM + wc * 32 + 8 * fq) >> 1;
#pragma unroll
        for (int ai = 0; ai < 2; ++ai)
#pragma unroll
            for (int m = 0; m < 4; ++m) { const int row = row0 + ai * HALF + m * 16; bf16_t* rowp = O + (size_t)row * ldo + ch0;
                const float rs = rowscale ? rowscale[(size_t)row * rs_stride] : 1.f;
#pragma unroll
                for (int bj = 0; bj < 2; ++bj) { const f32x4 a = acc[ai][bj][m][0], b = acc[ai][bj][m][1]; f32x4 o;
#pragma unroll
                    for (int i = 0; i < 4; ++i) o[i] = a[i] * __builtin_amdgcn_rcpf(1.f + __expf(-a[i])) * b[i] * rs;
                    u32x2v w; w.x = cvt_pk_bf16(o[0], o[1]); w.y = cvt_pk_bf16(o[2], o[3]);
                    *(u32x2v*)(rowp + bj * (HALF / 2)) = w; } }
    }
};
template <class Epi, class Sched, bool ALIGN_EPI = false, bool SP2 = false>
__device__ __forceinline__ void gemm_phase(PG8_LAS unsigned char* lds, const Gemm g, const Sched& S, const Epi& E) {
    int tid_o = threadIdx.x; asm volatile("" : "+v"(tid_o));
    const int tid = tid_o, wid = __builtin_amdgcn_readfirstlane(tid >> 6), lane = tid & 63, wr = wid >> 2, wc = wid & 3, fr = lane & 15, fq = lane >> 4;
    const int K = g.K, nt = K / BK;
    unsigned voffA[2], voffB[2];
#pragma unroll
    for (int i = 0; i < 2; ++i) { int R, C; stage_rc(tid * 16 + i * 8192, R, C); const int Rb = Epi::PERM ? ((R & ~31) + perm32(R & 31)) : R;
        voffA[i] = (unsigned)(R * K + C) * 2u; voffB[i] = (unsigned)(Rb * K + C) * 2u; }
    const size_t kstep = (size_t)(BK * 2);
    const size_t hstep = (size_t)HALF * K * 2;
    const size_t tstep = 2 * hstep;
    const unsigned ldsw = (unsigned)wid * 1024u;
    const int aoff = lds_byte(wr * 64 + fr, fq * 8), boff = lds_byte(wc * 32 + fr, fq * 8);
#define PG8_SA(b, h) (((b) * 2 + (h)) * HTB)
#define PG8_SB(b, h) ((4 + (b) * 2 + (h)) * HTB)
#define PG8_STAGE(bufoff, gbase, voff) do { _Pragma("unroll") for (int _i = 0; _i < 2; ++_i) \
        __builtin_amdgcn_global_load_lds((const unsigned*)((const char*)(gbase) + (voff)[_i]), (PG8_LAS unsigned*)(lds + (bufoff) + ldsw + _i * 8192), 16, 0, 0); } while (0)
#define PG8_LDA(dst, b, h) do { _Pragma("unroll") for (int m = 0; m < 4; ++m) _Pragma("unroll") for (int k = 0; k < 2; ++k) dst[m][k] = *(const PG8_LAS bf16x8*)(lds + PG8_SA(b, h) + aoff + m * 2048 + k * 1024); } while (0)
#define PG8_LDB(dst, b, h) do { _Pragma("unroll") for (int n = 0; n < 2; ++n) _Pragma("unroll") for (int k = 0; k < 2; ++k) dst[n][k] = *(const PG8_LAS bf16x8*)(lds + PG8_SB(b, h) + boff + n * 2048 + k * 1024); } while (0)
#define PG8_MMA(ai, bj, At, Bt) do { __builtin_amdgcn_s_setprio(1); _Pragma("unroll") for (int m = 0; m < 4; ++m) _Pragma("unroll") for (int n = 0; n < 2; ++n) _Pragma("unroll") for (int k = 0; k < 2; ++k) \
        acc[ai][bj][m][n] = __builtin_amdgcn_mfma_f32_16x16x32_bf16(Bt[n][k], At[m][k], acc[ai][bj][m][n], 0, 0, 0); __builtin_amdgcn_s_setprio(0); } while (0)
#define PG8_WAIT_V(n) asm volatile("s_waitcnt vmcnt(" #n ")" ::: "memory")
#define PG8_WAIT_L(n) asm volatile("s_waitcnt lgkmcnt(" #n ")" ::: "memory")
#define PG8_BAR __builtin_amdgcn_s_barrier()
#define PG8_SCHED __builtin_amdgcn_sched_barrier(0)
    Unit cur, nxt; int ui = 0;
    if (!S.next(0, cur)) return;
    f32x4 acc[2][2][4][2];
#pragma unroll
    for (int a = 0; a < 2; ++a)
#pragma unroll
        for (int b = 0; b < 2; ++b)
#pragma unroll
            for (int m = 0; m < 4; ++m)
#pragma unroll
                for (int n = 0; n < 2; ++n) acc[a][b][m][n] = (f32x4){0.f, 0.f, 0.f, 0.f};
    bf16x8 At[4][2], B0[2][2], B1[2][2];
    const char* cA = (const char*)g.A + (size_t)cur.pm * tstep; const char* cB = (const char*)S.bt(g, cur) + (size_t)cur.pn * tstep;
    S.a_ready(cur);
    if constexpr (SP2) {
        PG8_STAGE(PG8_SB(0, 0), cB, voffB); PG8_STAGE(PG8_SB(0, 1), cB + hstep, voffB); PG8_STAGE(PG8_SA(0, 0), cA, voffA); PG8_STAGE(PG8_SA(0, 1), cA + hstep, voffA);
        if (wr == 1) PG8_BAR;
        PG8_WAIT_V(2); PG8_BAR;
        PG8_STAGE(PG8_SB(1, 0), cB + kstep, voffB); PG8_STAGE(PG8_SA(1, 0), cA + kstep, voffA); PG8_STAGE(PG8_SB(1, 1), cB + hstep + kstep, voffB);
        PG8_WAIT_V(6); PG8_BAR;
    } else {
        PG8_STAGE(PG8_SB(0, 0), cB, voffB); PG8_STAGE(PG8_SA(0, 0), cA, voffA); PG8_STAGE(PG8_SB(0, 1), cB + hstep, voffB); PG8_STAGE(PG8_SA(0, 1), cA + hstep, voffA);
        if (wr == 1) PG8_BAR;
        PG8_WAIT_V(4); PG8_BAR;
        PG8_STAGE(PG8_SB(1, 0), cB + kstep, voffB); PG8_STAGE(PG8_SA(1, 0), cA + kstep, voffA); PG8_STAGE(PG8_SB(1, 1), cB + hstep + kstep, voffB);
        PG8_WAIT_V(6); PG8_BAR;
    }
    for (;;) {
        const bool has_next = S.next(ui + 1, nxt);
        const char* nA = has_next ? (const char*)g.A + (size_t)nxt.pm * tstep : cA; const char* nB = has_next ? (const char*)S.bt(g, nxt) + (size_t)nxt.pn * tstep : cB;
        for (int t = 0; t < nt; t += 2) {
            const bool last = (t == nt - 2);
            const char* a1 = cA + (size_t)(t + 1) * kstep;
            const char* a2 = last ? nA : cA + (size_t)(t + 2) * kstep; const char* b2 = last ? nB : cB + (size_t)(t + 2) * kstep;
            const char* a3 = a2 + kstep; const char* b3 = b2 + kstep;
            if (last && has_next) S.a_ready(nxt);
            if constexpr (SP2) {
            PG8_LDB(B0, 0, 0); PG8_LDB(B1, 0, 1); PG8_SCHED; PG8_LDA(At, 0, 0); PG8_STAGE(PG8_SA(1, 1), a1 + hstep, voffA);
            PG8_WAIT_V(8); PG8_WAIT_L(0); PG8_BAR; PG8_MMA(0, 0, At, B0); PG8_MMA(0, 1, At, B1); PG8_BAR; PG8_SCHED;
            PG8_LDA(At, 0, 1); PG8_STAGE(PG8_SB(0, 0), b2, voffB); PG8_STAGE(PG8_SB(0, 1), b2 + hstep, voffB); PG8_STAGE(PG8_SA(0, 0), a2, voffA);
            PG8_WAIT_V(8); PG8_WAIT_L(0); PG8_BAR; PG8_MMA(1, 0, At, B0); PG8_MMA(1, 1, At, B1); PG8_BAR; PG8_SCHED;
            PG8_LDB(B0, 1, 0); PG8_LDB(B1, 1, 1); PG8_SCHED; PG8_LDA(At, 1, 0); PG8_STAGE(PG8_SA(0, 1), a2 + hstep, voffA);
            PG8_WAIT_V(8); PG8_WAIT_L(0); PG8_BAR; PG8_MMA(0, 0, At, B0); PG8_MMA(0, 1, At, B1); PG8_BAR; PG8_SCHED;
            PG8_LDA(At, 1, 1); PG8_STAGE(PG8_SB(1, 0), b3, voffB); PG8_STAGE(PG8_SB(1, 1), b3 + hstep, voffB); PG8_STAGE(PG8_SA(1, 0), a3, voffA);
            PG8_WAIT_V(8); PG8_WAIT_L(0); PG8_BAR; PG8_MMA(1, 0, At, B0); PG8_MMA(1, 1, At, B1); PG8_BAR; PG8_SCHED;
            } else {
            PG8_LDB(B0, 0, 0); PG8_SCHED; PG8_LDA(At, 0, 0); PG8_STAGE(PG8_SA(1, 1), a1 + hstep, voffA);
            PG8_WAIT_L(8); PG8_BAR; PG8_WAIT_L(0); PG8_MMA(0, 0, At, B0); PG8_BAR; PG8_SCHED;
            PG8_LDB(B1, 0, 1); PG8_STAGE(PG8_SB(0, 0), b2, voffB);
            PG8_BAR; PG8_WAIT_L(0); PG8_MMA(0, 1, At, B1); PG8_BAR;
            PG8_LDA(At, 0, 1); PG8_STAGE(PG8_SA(0, 0), a2, voffA);
            PG8_BAR; PG8_WAIT_L(0); PG8_MMA(1, 0, At, B0); PG8_BAR; PG8_SCHED;
            PG8_STAGE(PG8_SB(0, 1), b2 + hstep, voffB);
            PG8_WAIT_V(6); PG8_BAR; PG8_MMA(1, 1, At, B1); PG8_BAR;
            PG8_LDB(B0, 1, 0); PG8_SCHED; PG8_LDA(At, 1, 0); PG8_STAGE(PG8_SA(0, 1), a2 + hstep, voffA);
            PG8_WAIT_L(8); PG8_BAR; PG8_WAIT_L(0); PG8_MMA(0, 0, At, B0); PG8_BAR; PG8_SCHED;
            PG8_LDB(B1, 1, 1); PG8_STAGE(PG8_SB(1, 0), b3, voffB);
            PG8_BAR; PG8_WAIT_L(0); PG8_MMA(0, 1, At, B1); PG8_BAR;
            PG8_LDA(At, 1, 1); PG8_STAGE(PG8_SA(1, 0), a3, voffA);
            PG8_BAR; PG8_WAIT_L(0); PG8_MMA(1, 0, At, B0); PG8_BAR; PG8_SCHED;
            PG8_STAGE(PG8_SB(1, 1), b3 + hstep, voffB);
            PG8_WAIT_V(6); PG8_BAR; PG8_MMA(1, 1, At, B1); PG8_BAR;
            }
        }
        if constexpr (ALIGN_EPI) { if (wr == 0) PG8_BAR; }
        if constexpr (!Epi::AFTER_DRAIN) { E(acc, cur, wr, wc, fr, fq); S.done(cur); }
        if (!has_next) break;
#pragma unroll
        for (int a = 0; a < 2; ++a)
#pragma unroll
            for (int b = 0; b < 2; ++b)
#pragma unroll
                for (int m = 0; m < 4; ++m)
#pragma unroll
                    for (int n = 0; n < 2; ++n) acc[a][b][m][n] = (f32x4){0.f, 0.f, 0.f, 0.f};
        cur = nxt; cA = nA; cB = nB; ++ui;
        if constexpr (ALIGN_EPI) { if (wr == 1) PG8_BAR; }
    }
    PG8_WAIT_V(0);
    if constexpr (!ALIGN_EPI) { if (wr == 0) PG8_BAR; }
    PG8_BAR;
    if constexpr (Epi::AFTER_DRAIN) { E.fused(acc, cur, wr, wc, fr, fq, lds, wid, lane); S.done(cur); }
#undef PG8_SA
#undef PG8_SB
#undef PG8_STAGE
#undef PG8_LDA
#undef PG8_LDB
#undef PG8_MMA
#undef PG8_WAIT_V
#undef PG8_WAIT_L
#undef PG8_BAR
#undef PG8_SCHED
}
}

constexpr int NWAVES = 8;
constexpr int D = 1024, NB = 4, SEQ = 4096, CTXL = 256, NLAT = NB * SEQ, NCTX = NB * CTXL, MROWS = NLAT + NCTX;
constexpr int DEPTH = 4, RW = 512, NH = 8, HS = 64, DFF = 3584, NE = 8, NPROJ = 3456, NP = 3584, NLO = 2560, KLA = 512, NMOD = 6144;
constexpr int PC_R = 0, PC_K = 512, PC_V = 1024, PC_CB = 1536, PC_CC = 2048, PC_CH = 2560, PC_WD = 3072, PC_AD = 3200, PC_GD = 3328;
constexpr float LN_EPS = 1e-5f, GN_EPS = 64e-5f, DN_ALPHA = 1.681792830507429f;
enum { I_X = 0, I_C, I_CTX, I_CCTX, I_WMOD, I_BMOD, I_WIN, I_W0, I_W2, I_A0, I_A2, I_KK, I_KA, I_RK, I_G2, I_LNXG, I_LNXB, I_CONVW, I_WOUT, I_LN1G, I_LN1B, I_LN2G, I_LN2B,
       I_FW1, I_FW3, I_FW2, I_RTW, I_RTB, I_MW1, I_MW3, I_MW2, N_IN };

constexpr size_t MiB = 1u << 20;
constexpr size_t WS_CTL = 0, CTL_BYTES = 1 * MiB;
constexpr size_t WS_MODV = 1 * MiB;
constexpr size_t WS_G8 = 2 * MiB;
constexpr size_t WS_RKS = 3 * MiB;
constexpr size_t WS_WIN = 4 * MiB;
constexpr size_t WS_WOUT = WS_WIN + 28 * MiB;
constexpr size_t WS_LORA = WS_WOUT + 8 * MiB;
constexpr size_t WS_F13 = WS_LORA + 10 * MiB;
constexpr size_t WS_F2 = WS_F13 + 28 * MiB;
constexpr size_t WS_X = WS_F2 + 14 * MiB;
constexpr size_t WS_H = WS_X + 68 * MiB;
constexpr size_t WS_SCR = WS_H + 34 * MiB;
constexpr size_t WS_P = WS_SCR;
constexpr size_t WS_LA = WS_P + 119 * MiB;
constexpr size_t WS_LO = WS_LA + 17 * MiB;
constexpr size_t WS_MIX = WS_LO;
constexpr size_t WS_PREP = WS_LO + 170 * MiB;
constexpr size_t WS_Y = WS_PREP + 238 * MiB;
constexpr size_t WS_MIXIN = WS_Y + 68 * MiB;
constexpr size_t WS_MIXO = WS_PREP;
constexpr size_t WS_END_MIXER = WS_MIXIN + 34 * MiB;
constexpr size_t WS_MOEW13 = WS_SCR;
constexpr size_t WS_MOEW2 = WS_MOEW13 + 112 * MiB;
constexpr size_t WS_ACT = WS_MOEW2 + 56 * MiB;
constexpr size_t WS_F = WS_ACT + 119 * MiB;
constexpr size_t WS_END_FFN = WS_F + 68 * MiB;
constexpr size_t WS_NEED = WS_END_MIXER > WS_END_FFN ? WS_END_MIXER : WS_END_FFN;
static_assert((size_t)MROWS * NP * 2 <= 119 * MiB && (size_t)MROWS * NLO * 4 <= 170 * MiB && (size_t)MROWS * RW * 4 * 7 <= 238 * MiB && (size_t)MROWS * D * 4 <= 68 * MiB, "ws map");
constexpr int CW_BAR = 4096;

constexpr int RING_BYTES = 131072, LDSCTL_OFF = RING_BYTES, MISC_OFF = LDSCTL_OFF + 320, LDS_BYTES = 147456;

typedef unsigned short bf16;
typedef unsigned v4u __attribute__((ext_vector_type(4)));
typedef unsigned v2u __attribute__((ext_vector_type(2)));
typedef float f32x4 __attribute__((ext_vector_type(4)));
#define LAS __attribute__((address_space(3)))
#define LDS_WAIT() asm volatile("s_waitcnt lgkmcnt(0)" ::: "memory")
__device__ __forceinline__ unsigned f2bf(float f) { unsigned u = __builtin_bit_cast(unsigned, f); return (u + 0x7fffu + ((u >> 16) & 1u)) >> 16; }
__device__ __forceinline__ unsigned pk2(float lo, float hi) { return f2bf(lo) | (f2bf(hi) << 16); }
__device__ __forceinline__ float bf2f(unsigned short b) { return __builtin_bit_cast(float, ((unsigned)b) << 16); }
__device__ __forceinline__ float bflo(unsigned w) { return __builtin_bit_cast(float, w << 16); }
__device__ __forceinline__ float bfhi(unsigned w) { return __builtin_bit_cast(float, w & 0xffff0000u); }
__device__ __forceinline__ float wave_sum(float v) {
#pragma unroll
    for (int o = 1; o < 64; o <<= 1) v += __shfl_xor(v, o);
    return v;
}
__device__ __forceinline__ float sigm(float x) { return 1.f / (1.f + __expf(-x)); }

#define XB_TMO      128
#define XB_XCNT(j)  (256  + 64 * (j))
#define XB_XSUB(j)  (1280 + 64 * (j))
#define XB_XGEN(j)  (2304 + 64 * (j))
#define XB_TOP      3328
#define XB_TOPGEN   3392
#define XCD_BAR_WORDS 3456
#define XB_SPIN_CAP (1u << 18)

__device__ __forceinline__ unsigned xb_ld(unsigned* p)              { return __hip_atomic_load(p, __ATOMIC_RELAXED, __HIP_MEMORY_SCOPE_AGENT); }
__device__ __forceinline__ unsigned xb_add(unsigned* p, unsigned v) { return __hip_atomic_fetch_add(p, v, __ATOMIC_RELAXED, __HIP_MEMORY_SCOPE_AGENT); }
__device__ __forceinline__ unsigned xb_xcc_id() { return (unsigned)__builtin_amdgcn_s_getreg((3 << 11) | 20) & 0xFu; }
#define XB_SPIN(cond, bar) do { unsigned _sp = 0; while (cond) { __builtin_amdgcn_s_sleep(1); \
    if ((++_sp & 255u) == 0u) { if (xb_ld(&(bar)[XB_TMO])) break; if (_sp > XB_SPIN_CAP) { atomicAdd(&(bar)[XB_TMO], 1u); break; } } } } while (0)

struct XcdBarrier {
    unsigned* bar; unsigned x;
    volatile LAS unsigned* st;
};

__device__ __forceinline__ XcdBarrier xcd_barrier_post(unsigned* bar, volatile LAS unsigned* st) {
    XcdBarrier b; b.bar = bar; b.x = xb_xcc_id(); b.st = st;
    if (threadIdx.x == 0) (void)xb_add(&bar[XB_XCNT(b.x)], 1u);
    return b;
}
__device__ __forceinline__ void xcd_barrier_complete(unsigned* bar, unsigned x, unsigned& nloc, unsigned& nx) {
    const unsigned G = gridDim.x * gridDim.y * gridDim.z;
    unsigned sum, cnt, mine, sp = 0u;
    for (;;) {
        sum = 0u; cnt = 0u; mine = 0u;
#pragma unroll
        for (unsigned j = 0; j < 16; ++j) { const unsigned c = xb_ld(&bar[XB_XCNT(j)]); sum += c; cnt += (c > 0u) ? 1u : 0u; mine = (j == x) ? c : mine; }
        if (sum == G) break;
        __builtin_amdgcn_s_sleep(1);
        if ((++sp & 255u) == 0u) { if (xb_ld(&bar[XB_TMO])) break; if (sp > XB_SPIN_CAP) { atomicAdd(&bar[XB_TMO], 1u); break; } }
    }
    nloc = mine > 0u ? mine : 1u; nx = cnt > 0u ? cnt : 1u;
}

__device__ __forceinline__ void xcd_barrier(const XcdBarrier& b) {
    asm volatile("s_waitcnt vmcnt(0)" ::: "memory");
    __syncthreads();
    if (threadIdx.x == 0) {
        unsigned* bar = b.bar;
        __builtin_amdgcn_s_waitcnt(0);
        unsigned nloc = b.st[0], nx = b.st[1];
        if (nloc == 0u) { xcd_barrier_complete(bar, b.x, nloc, nx); b.st[0] = nloc; b.st[1] = nx; }
        const unsigned old = xb_add(&bar[XB_XSUB(b.x)], 1u);
        const unsigned gen = old / nloc;
        if (old + 1u == (gen + 1u) * nloc) {
            __builtin_amdgcn_fence(__ATOMIC_RELEASE, "agent");
            asm volatile("s_waitcnt vmcnt(0)" ::: "memory");
            const unsigned og = xb_add(&bar[XB_TOP], 1u);
            const unsigned tg = og / nx;
            if (og + 1u == (tg + 1u) * nx) xb_add(&bar[XB_TOPGEN], 1u);
            else XB_SPIN(xb_ld(&bar[XB_TOPGEN]) == tg, bar);
            __builtin_amdgcn_fence(__ATOMIC_ACQUIRE, "agent");
            xb_add(&bar[XB_XGEN(b.x)], 1u);
            asm volatile("s_waitcnt vmcnt(0)" ::: "memory");
        } else {
            XB_SPIN(xb_ld(&bar[XB_XGEN(b.x)]) == gen, bar);
            __builtin_amdgcn_fence(__ATOMIC_ACQUIRE, "agent");
            asm volatile("s_waitcnt vmcnt(0)" ::: "memory");
        }
    }
    __syncthreads();
}


struct KP { const float* in[N_IN]; float* out; unsigned char* ws; int ph; int pad; };

template <int MODE> __device__ __forceinline__ int rowmap(int n, int arg) {
    if (MODE == 0) return n + arg;
    if (MODE == 1) { if (n < 1536) return n; if (n < 1664) return n - 1536 + PC_WD; if (n < 1792) return n - 1664 + PC_AD; if (n < 1920) return n - 1792 + PC_GD;
                     if (n < 2432) return n - 1920 + PC_CB; if (n < 2944) return n - 2432 + PC_CC; return n - 2944 + PC_CH; }
    return 8 * (n >> 2) + 4 * arg + (n & 3);
}
template <int MODE> __device__ __forceinline__ void transpose_item(const float* W, int K, int N, bf16* WT, int arg, LAS float* scr, int item, int lane) {
    const int nblk = N / 32, kb = item / nblk, nb = item % nblk, k0 = 64 * kb, n0 = 32 * nb;
#pragma unroll 8
    for (int i = 0; i < 32; ++i) { const int kk = 2 * i + (lane >> 5); scr[kk * 33 + (lane & 31)] = W[(size_t)(k0 + kk) * N + n0 + (lane & 31)]; }
    LDS_WAIT(); asm volatile("" ::: "memory");
    const int c = lane & 7;
#pragma unroll
    for (int j = 0; j < 4; ++j) { const int n = (lane >> 3) + 8 * j; const LAS float* s = scr + (8 * c) * 33 + n;
        v4u o; o.x = pk2(s[0 * 33], s[1 * 33]); o.y = pk2(s[2 * 33], s[3 * 33]); o.z = pk2(s[4 * 33], s[5 * 33]); o.w = pk2(s[6 * 33], s[7 * 33]);
        *(v4u*)(WT + (size_t)rowmap<MODE>(n0 + n, arg) * K + k0 + 8 * c) = o; }
    LDS_WAIT(); asm volatile("" ::: "memory");
}

__device__ __forceinline__ void ph_modvec(const KP& p, LAS unsigned char* lds, int tid) {
    LAS float* sil = (LAS float*)lds;
    LAS float* red = (LAS float*)(lds + 5 * 1024 * 4);
    const float* c = p.in[I_C]; const float* cc = p.in[I_CCTX];
    for (int i = tid; i < 5 * 1024; i += 512) { const float v = i < 4096 ? c[i] : cc[i - 4096]; sil[i] = v / (1.f + __expf(-v)); }
    __syncthreads();
    float* modv = (float*)(p.ws + WS_MODV);
    const int ks = tid >> 6, col = tid & 63;
    for (int task = blockIdx.x; task < DEPTH * 96; task += gridDim.x) {
        const int l = task / 96, j0 = (task % 96) * 64;
        const float* w = p.in[I_WMOD] + (size_t)l * D * NMOD + (size_t)(ks * 128) * NMOD + j0 + col;
        float a0 = 0.f, a1 = 0.f, a2 = 0.f, a3 = 0.f, a4 = 0.f;
#pragma unroll 8
        for (int k = 0; k < 128; ++k) { const float wv = w[(size_t)k * NMOD]; const int kk = ks * 128 + k;
            a0 += sil[kk] * wv; a1 += sil[1024 + kk] * wv; a2 += sil[2048 + kk] * wv; a3 += sil[3072 + kk] * wv; a4 += sil[4096 + kk] * wv; }
        red[(ks * 5 + 0) * 64 + col] = a0; red[(ks * 5 + 1) * 64 + col] = a1; red[(ks * 5 + 2) * 64 + col] = a2; red[(ks * 5 + 3) * 64 + col] = a3; red[(ks * 5 + 4) * 64 + col] = a4;
        __syncthreads();
        if (tid < 320) { const int r = tid >> 6; float s = 0.f;
#pragma unroll
            for (int q = 0; q < 8; ++q) s += red[(q * 5 + r) * 64 + col];
            modv[(size_t)(l * 5 + r) * NMOD + j0 + col] = s + p.in[I_BMOD][l * NMOD + j0 + col]; }
        __syncthreads();
    }
}

__device__ __forceinline__ void ph_convert(const KP& p, LAS unsigned char* lds, int gw, int NGW, int wave, int lane) {
    LAS float* scr = (LAS float*)(lds + wave * 16384);
    bf16* win = (bf16*)(p.ws + WS_WIN); bf16* wout = (bf16*)(p.ws + WS_WOUT); bf16* f13 = (bf16*)(p.ws + WS_F13); bf16* f2 = (bf16*)(p.ws + WS_F2); bf16* lora = (bf16*)(p.ws + WS_LORA);
    constexpr int I_IN = (D / 64) * (NPROJ / 32), I_OUT = (D / 64) * (D / 32), I_UP = (D / 64) * (DFF / 32), I_DN = (DFF / 64) * (D / 32);
    constexpr int T_IN = DEPTH * I_IN, T_OUT = DEPTH * I_OUT, T_UP = 2 * I_UP, T_DN = 2 * I_DN, NITEMS = T_IN + T_OUT + 2 * T_UP + T_DN;
    for (int it = gw; it < NITEMS; it += NGW) {
        int r = it;
        if (r < T_IN) { const int l = r / I_IN; transpose_item<1>(p.in[I_WIN] + (size_t)l * D * NPROJ, D, NPROJ, win + (size_t)l * NP * D, 0, scr, r % I_IN, lane); continue; } r -= T_IN;
        if (r < T_OUT) { const int l = r / I_OUT; transpose_item<0>(p.in[I_WOUT] + (size_t)l * D * D, D, D, wout + (size_t)l * D * D, 0, scr, r % I_OUT, lane); continue; } r -= T_OUT;
        if (r < T_UP) { const int l = r / I_UP; transpose_item<2>(p.in[I_FW1] + (size_t)l * D * DFF, D, DFF, f13 + (size_t)l * 2 * DFF * D, 0, scr, r % I_UP, lane); continue; } r -= T_UP;
        if (r < T_UP) { const int l = r / I_UP; transpose_item<2>(p.in[I_FW3] + (size_t)l * D * DFF, D, DFF, f13 + (size_t)l * 2 * DFF * D, 1, scr, r % I_UP, lane); continue; } r -= T_UP;
        { const int l = r / I_DN; transpose_item<0>(p.in[I_FW2] + (size_t)l * DFF * D, DFF, D, f2 + (size_t)l * D * DFF, 0, scr, r % I_DN, lane); }
    }
    { const int gt = gw * 64 + lane, NGT = NGW * 64; constexpr int PER = (NP - NPROJ) * D / 8;
      for (int i = gt; i < DEPTH * PER; i += NGT) { const int l = i / PER, q = i % PER; *(v4u*)(win + (size_t)l * NP * D + (size_t)NPROJ * D + (size_t)q * 8) = (v4u){0u, 0u, 0u, 0u}; } }
    { const int gt = gw * 64 + lane, NGT = NGW * 64; constexpr int PER = NLO * KLA / 8;
      for (int i = gt; i < DEPTH * PER; i += NGT) { const int l = i / PER, q = i % PER, n = q / (KLA / 8), k0 = (q % (KLA / 8)) * 8; float v[8];
#pragma unroll
          for (int j = 0; j < 8; ++j) { const int k = k0 + j; float x = 0.f;
              if (n < 1024) { const int d = n >> 9, c = n & 511; if (k >= 64 * d && k < 64 * d + 64) x = p.in[I_W2][((size_t)(l * 2 + d) * 64 + (k - 64 * d)) * RW + c]; }
              else if (n < 2048) { const int d = (n - 1024) >> 9, c = n & 511; if (k >= 128 + 64 * d && k < 192 + 64 * d) x = p.in[I_A2][((size_t)(l * 2 + d) * 64 + (k - 128 - 64 * d)) * RW + c]; }
              else { const int c = n - 2048; if (k >= 256 && k < 384) x = p.in[I_G2][((size_t)l * 128 + (k - 256)) * RW + c]; }
              v[j] = x; }
          v4u o; o.x = pk2(v[0], v[1]); o.y = pk2(v[2], v[3]); o.z = pk2(v[4], v[5]); o.w = pk2(v[6], v[7]);
          *(v4u*)(lora + (size_t)l * NLO * KLA + (size_t)n * KLA + k0) = o; } }
}
__device__ __forceinline__ void ph_convert_moe(const KP& p, LAS unsigned char* lds, int mi, int gw, int NGW, int wave, int lane) {
    LAS float* scr = (LAS float*)(lds + wave * 16384);
    bf16* w13 = (bf16*)(p.ws + WS_MOEW13); bf16* w2 = (bf16*)(p.ws + WS_MOEW2);
    constexpr int I_UP = (D / 64) * (DFF / 32), I_DN = (DFF / 64) * (D / 32), T_UP = NE * I_UP, T_DN = NE * I_DN;
    for (int it = gw; it < 2 * T_UP + T_DN; it += NGW) {
        int r = it;
        if (r < T_UP) { const int e = r / I_UP; transpose_item<2>(p.in[I_MW1] + ((size_t)mi * NE + e) * D * DFF, D, DFF, w13 + (size_t)e * 2 * DFF * D, 0, scr, r % I_UP, lane); continue; } r -= T_UP;
        if (r < T_UP) { const int e = r / I_UP; transpose_item<2>(p.in[I_MW3] + ((size_t)mi * NE + e) * D * DFF, D, DFF, w13 + (size_t)e * 2 * DFF * D, 1, scr, r % I_UP, lane); continue; } r -= T_UP;
        { const int e = r / I_DN; transpose_item<0>(p.in[I_MW2] + ((size_t)mi * NE + e) * DFF * D, DFF, D, w2 + (size_t)e * D * DFF, 0, scr, r % I_DN, lane); }
    }
}

__device__ __forceinline__ void ld_row(const float* r, int lane, f32x4 (&v)[4]) { const f32x4* q = (const f32x4*)r + lane;
#pragma unroll
    for (int j = 0; j < 4; ++j) v[j] = q[64 * j]; }
__device__ __forceinline__ void st_row(float* r, int lane, const f32x4 (&v)[4]) { f32x4* q = (f32x4*)r + lane;
#pragma unroll
    for (int j = 0; j < 4; ++j) q[64 * j] = v[j]; }
__device__ __forceinline__ void st_row_bf16(bf16* r, int lane, const f32x4 (&v)[4]) { v2u* q = (v2u*)r + lane;
#pragma unroll
    for (int j = 0; j < 4; ++j) { v2u w; w.x = pk2(v[j][0], v[j][1]); w.y = pk2(v[j][2], v[j][3]); q[64 * j] = w; } }
__device__ __forceinline__ int mod_row(int row) { return row < NLAT ? (row >> 12) : 4; }

__device__ __forceinline__ void ph_init_rows(const KP& p, int gw, int NGW, int lane) {
    const float* modv = (const float*)(p.ws + WS_MODV); float* X = (float*)(p.ws + WS_X); bf16* H = (bf16*)(p.ws + WS_H);
    for (int row = gw; row < MROWS; row += NGW) {
        const float* src = row < NLAT ? p.in[I_X] + (size_t)row * D : p.in[I_CTX] + (size_t)(row - NLAT) * D;
        const float* mv = modv + (size_t)(0 * 5 + mod_row(row)) * NMOD;
        f32x4 x[4], sh[4], sc[4], h[4]; ld_row(src, lane, x); ld_row(mv, lane, sh); ld_row(mv + 1024, lane, sc);
#pragma unroll
        for (int j = 0; j < 4; ++j) h[j] = x[j] * (1.f + sc[j]) + sh[j];
        st_row(X + (size_t)row * D, lane, x); st_row_bf16(H + (size_t)row * D, lane, h);
    }
}

__device__ __forceinline__ void ph_lora_in(const KP& p, int gw, int NGW, int lane) {
    const bf16* P = (const bf16*)(p.ws + WS_P); bf16* LA = (bf16*)(p.ws + WS_LA);
    const int gt = gw * 64 + lane, NGT = NGW * 64;
    for (int i = gt; i < MROWS * (KLA / 8); i += NGT) { const int row = i >> 6, k0 = (i & 63) * 8; v4u o = (v4u){0u, 0u, 0u, 0u};
        if (k0 < 384) { const v4u s = *(const v4u*)(P + (size_t)row * NP + PC_WD + k0); float v[8] = {bflo(s.x), bfhi(s.x), bflo(s.y), bfhi(s.y), bflo(s.z), bfhi(s.z), bflo(s.w), bfhi(s.w)};
            if (k0 < 128) {
#pragma unroll
                for (int j = 0; j < 8; ++j) v[j] = tanhf(v[j]); }
            else if (k0 >= 256) {
#pragma unroll
                for (int j = 0; j < 8; ++j) v[j] = sigm(v[j]); }
            o.x = pk2(v[0], v[1]); o.y = pk2(v[2], v[3]); o.z = pk2(v[4], v[5]); o.w = pk2(v[6], v[7]); }
        *(v4u*)(LA + (size_t)row * KLA + k0) = o; }
}

__device__ __forceinline__ void ph_prep(const KP& p, int l, int gw, int NGW, int lane) {
    const bf16* P = (const bf16*)(p.ws + WS_P); const float* LO = (const float*)(p.ws + WS_LO); float* PR = (float*)(p.ws + WS_PREP); float* RKS = (float*)(p.ws + WS_RKS);
    constexpr size_t PA = (size_t)MROWS * RW;
    for (int it = gw; it < MROWS * NH; it += NGW) { const int row = it >> 3, h = it & 7, c = h * 64 + lane;
        const float kv = bf2f(P[(size_t)row * NP + PC_K + c]), rv = bf2f(P[(size_t)row * NP + PC_R + c]);
        const float* lo = LO + (size_t)row * NLO;
        float dec[2], a[2];
#pragma unroll
        for (int d = 0; d < 2; ++d) {
            const float wl = p.in[I_W0][(l * 2 + d) * RW + c] + lo[d * RW + c];
            const float z = -wl, sp = z > 20.f ? z : log1pf(expf(z));
            const float w_log = -sp - 0.5f; dec[d] = expf(-expf(w_log));
            a[d] = sigm(p.in[I_A0][(l * 2 + d) * RW + c] + lo[1024 + d * RW + c]);
        }
        float kk = kv * p.in[I_KK][l * RW + c]; const float ss = wave_sum(kk * kk); kk = kk / fmaxf(sqrtf(ss), 1e-12f);
        const float ka = p.in[I_KA][l * RW + c];
        const float kd0 = kv * (1.f + (a[0] - 1.f) * ka), kd1 = kv * (1.f + (a[1] - 1.f) * ka);
        const float rk = wave_sum(rv * (kd0 + kd1) * p.in[I_RK][(l * NH + h) * HS + lane]);
        const size_t o = (size_t)row * RW + c;
        PR[0 * PA + o] = dec[0]; PR[1 * PA + o] = dec[1]; PR[2 * PA + o] = kd0; PR[3 * PA + o] = kd1; PR[4 * PA + o] = kk * a[0]; PR[5 * PA + o] = kk * a[1]; PR[6 * PA + o] = kk;
        if (lane == 0) RKS[row * 8 + h] = rk;
    }
}

__device__ __forceinline__ int scan_row(int b, int dir, int step) { return step < CTXL ? NLAT + b * CTXL + (dir ? CTXL - 1 - step : step) : b * SEQ + (dir ? SEQ - 1 - (step - CTXL) : step - CTXL); }
__device__ __forceinline__ void ph_scan(const KP& p, int wave, int lane) {
    if (wave >= 4) return;
    const bf16* P = (const bf16*)(p.ws + WS_P); const float* PR = (const float*)(p.ws + WS_PREP); float* Y = (float*)(p.ws + WS_Y);
    constexpr size_t PA = (size_t)MROWS * RW; constexpr int NSTEP = CTXL + SEQ;
    for (int wt = blockIdx.x * 4 + wave; wt < 1024; wt += gridDim.x * 4) {
        const int rg = wt & 15, h = (wt >> 4) & 7, b = (wt >> 7) & 3, dir = wt >> 9;
        const int rr = lane >> 4, q = lane & 15, vrow = rg * 4 + rr, ch0 = h * 64 + q * 4;
        const float* Wd = PR + (size_t)dir * PA + ch0; const float* Kd = PR + (size_t)(2 + dir) * PA + ch0; const float* Bd = PR + (size_t)(4 + dir) * PA + ch0; const float* KKp = PR + 6 * PA + ch0;
        float* Yo = Y + (size_t)dir * PA + h * 64 + vrow;
        f32x4 s = (f32x4){0.f, 0.f, 0.f, 0.f};
        f32x4 bw[4], bk[4], bb[4], bq[4]; v2u br[4]; float bv[4];
#pragma unroll
        for (int u = 0; u < 4; ++u) { const size_t ro = (size_t)scan_row(b, dir, u) * RW; const size_t rp = (size_t)scan_row(b, dir, u) * NP;
            bw[u] = *(const f32x4*)(Wd + ro); bk[u] = *(const f32x4*)(Kd + ro); bb[u] = *(const f32x4*)(Bd + ro); bq[u] = *(const f32x4*)(KKp + ro);
            br[u] = *(const v2u*)(P + rp + PC_R + ch0); bv[u] = bf2f(P[rp + PC_V + h * 64 + vrow]); }
        for (int st = 0; st < NSTEP; st += 4) {
#pragma unroll
            for (int u = 0; u < 4; ++u) {
                const f32x4 w = bw[u], kd = bk[u], bvec = bb[u], kk = bq[u]; const v2u rw = br[u]; const float vv = bv[u];
                const int cur = scan_row(b, dir, st + u);
                { const int nstep = st + u + 4 < NSTEP ? st + u + 4 : NSTEP - 1; const int nrow = scan_row(b, dir, nstep); const size_t ro = (size_t)nrow * RW, rp = (size_t)nrow * NP;
                  bw[u] = *(const f32x4*)(Wd + ro); bk[u] = *(const f32x4*)(Kd + ro); bb[u] = *(const f32x4*)(Bd + ro); bq[u] = *(const f32x4*)(KKp + ro);
                  br[u] = *(const v2u*)(P + rp + PC_R + ch0); bv[u] = bf2f(P[rp + PC_V + h * 64 + vrow]); }
                float sa = -((s[0] * kk[0] + s[1] * kk[1]) + (s[2] * kk[2] + s[3] * kk[3]));
                sa += __shfl_xor(sa, 1); sa += __shfl_xor(sa, 2); sa += __shfl_xor(sa, 4); sa += __shfl_xor(sa, 8);
                s = s * w + sa * bvec + vv * kd;
                float y = (s[0] * bflo(rw.x) + s[1] * bfhi(rw.x)) + (s[2] * bflo(rw.y) + s[3] * bfhi(rw.y));
                y += __shfl_xor(y, 1); y += __shfl_xor(y, 2); y += __shfl_xor(y, 4); y += __shfl_xor(y, 8);
                if (q == 0) Yo[(size_t)cur * RW] = y;
            }
        }
    }
}

__device__ __forceinline__ void ph_readout(const KP& p, int l, int gw, int NGW, int lane) {
    const bf16* P = (const bf16*)(p.ws + WS_P); const float* LO = (const float*)(p.ws + WS_LO); const float* Y = (const float*)(p.ws + WS_Y); const float* RKS = (const float*)(p.ws + WS_RKS);
    bf16* MI = (bf16*)(p.ws + WS_MIXIN); constexpr size_t PA = (size_t)MROWS * RW;
    for (int it = gw; it < MROWS * NH; it += NGW) { const int row = it >> 3, h = it & 7, c = h * 64 + lane;
        const float y = Y[(size_t)row * RW + c] + Y[PA + (size_t)row * RW + c];
        const float mu = wave_sum(y) * (1.f / 64.f), dv = y - mu, var = wave_sum(dv * dv) * (1.f / 64.f);
        const float yn = dv / sqrtf(var + GN_EPS);
        const bf16* pr = P + (size_t)row * NP;
        const float v = bf2f(pr[PC_V + c]);
        const float o = yn * p.in[I_LNXG][l * RW + c] + p.in[I_LNXB][l * RW + c] + RKS[row * 8 + h] * v;
        const float g = LO[(size_t)row * NLO + 2048 + c];
        MI[(size_t)row * D + c] = (bf16)f2bf(o * g);
        int t, len; if (row < NLAT) { t = row & 63; len = 64; } else { t = (row - NLAT) & 255; len = 256; }
        const float uc = bf2f(pr[PC_CC + c]) * bf2f(pr[PC_CH + c]);
        const float up = t > 0 ? bf2f(pr[PC_CC + c - NP]) * bf2f(pr[PC_CH + c - NP]) : 0.f;
        const float un = t < len - 1 ? bf2f(pr[PC_CC + c + NP]) * bf2f(pr[PC_CH + c + NP]) : 0.f;
        const float* cw = p.in[I_CONVW] + (size_t)l * 3 * RW;
        const float cv = up * cw[c] + uc * cw[RW + c] + un * cw[2 * RW + c];
        MI[(size_t)row * D + RW + c] = (bf16)f2bf(bf2f(pr[PC_CB + c]) * cv);
    }
}

__device__ __forceinline__ void ph_ln(const KP& p, int l, int which, int gw, int NGW, int lane) {
    const float* modv = (const float*)(p.ws + WS_MODV); float* X = (float*)(p.ws + WS_X); bf16* H = (bf16*)(p.ws + WS_H);
    const float* BR = (const float*)(p.ws + (which == 0 ? WS_MIXO : WS_F)); float* G8 = (float*)(p.ws + WS_G8);
    const float* lg = p.in[which == 0 ? I_LN1G : I_LN2G] + l * D; const float* lb = p.in[which == 0 ? I_LN1B : I_LN2B] + l * D;
    const bool moe = (which == 0) && (l & 1); const bool last = (which == 1) && (l == DEPTH - 1);
    for (int row = gw; row < MROWS; row += NGW) {
        const int mr = mod_row(row); const float* mv = modv + (size_t)(l * 5 + mr) * NMOD;
        f32x4 x[4], br[4], gt[4], t[4]; ld_row(X + (size_t)row * D, lane, x); ld_row(BR + (size_t)row * D, lane, br); ld_row(mv + (which == 0 ? 2048 : 5120), lane, gt);
        float s = 0.f;
#pragma unroll
        for (int j = 0; j < 4; ++j) { t[j] = DN_ALPHA * x[j] + gt[j] * br[j]; s += (t[j][0] + t[j][1]) + (t[j][2] + t[j][3]); }
        const float mean = wave_sum(s) * (1.f / D); float s2 = 0.f;
#pragma unroll
        for (int j = 0; j < 4; ++j) { t[j] = t[j] - mean; s2 += (t[j][0] * t[j][0] + t[j][1] * t[j][1]) + (t[j][2] * t[j][2] + t[j][3] * t[j][3]); }
        const float rstd = 1.f / sqrtf(wave_sum(s2) * (1.f / D) + LN_EPS);
        f32x4 g4[4], b4[4]; ld_row(lg, lane, g4); ld_row(lb, lane, b4);
#pragma unroll
        for (int j = 0; j < 4; ++j) x[j] = t[j] * rstd * g4[j] + b4[j];
        if (last) { if (row < NLAT) st_row(p.out + (size_t)row * D, lane, x); continue; }
        st_row(X + (size_t)row * D, lane, x);
        const float* mv2 = which == 0 ? mv + 3072 : modv + (size_t)((l + 1) * 5 + mr) * NMOD;
        f32x4 sh[4], sc[4], hh[4]; ld_row(mv2, lane, sh); ld_row(mv2 + 1024, lane, sc);
#pragma unroll
        for (int j = 0; j < 4; ++j) hh[j] = x[j] * (1.f + sc[j]) + sh[j];
        st_row_bf16(H + (size_t)row * D, lane, hh);
        if (moe) {
            const float* rw = p.in[I_RTW] + (size_t)(l >> 1) * D * NE; float lgt[8];
#pragma unroll
            for (int e = 0; e < 8; ++e) lgt[e] = 0.f;
#pragma unroll
            for (int j = 0; j < 4; ++j)
#pragma unroll
                for (int i = 0; i < 4; ++i) { const f32x4* wp = (const f32x4*)(rw + (size_t)(4 * lane + 256 * j + i) * NE); const f32x4 w0 = wp[0], w1 = wp[1]; const float hv = hh[j][i];
                    lgt[0] += hv * w0[0]; lgt[1] += hv * w0[1]; lgt[2] += hv * w0[2]; lgt[3] += hv * w0[3]; lgt[4] += hv * w1[0]; lgt[5] += hv * w1[1]; lgt[6] += hv * w1[2]; lgt[7] += hv * w1[3]; }
#pragma unroll
            for (int e = 0; e < 8; ++e) lgt[e] = wave_sum(lgt[e]) + p.in[I_RTB][(l >> 1) * NE + e];
            float v0 = lgt[0]; int i0 = 0;
#pragma unroll
            for (int e = 1; e < 8; ++e) if (lgt[e] > v0) { v0 = lgt[e]; i0 = e; }
            float v1 = -3.0e38f; int i1 = -1;
#pragma unroll
            for (int e = 0; e < 8; ++e) if (e != i0 && lgt[e] > v1) { v1 = lgt[e]; i1 = e; }
            const float w0 = 1.f / (1.f + expf(v1 - v0)), w1 = 1.f - w0;
            if (lane < 8) G8[row * 8 + lane] = lane == i0 ? w0 : (lane == i1 ? w1 : 0.f);
        }
    }
}

__global__ void __launch_bounds__(NWAVES * 64, 2) fwd_kernel(KP p) {
    extern __shared__ __attribute__((aligned(16))) unsigned char lds_raw[];
    LAS unsigned char* lds = (LAS unsigned char*)lds_raw;
    volatile LAS unsigned* MISC = (volatile LAS unsigned*)(lds + MISC_OFF);
    const int G = gridDim.x, NGW = G * NWAVES;
    for (int u = threadIdx.x; u < (LDS_BYTES - LDSCTL_OFF) / 4; u += NWAVES * 64) ((LAS unsigned*)(lds + LDSCTL_OFF))[u] = 0u;
    __syncthreads();
    unsigned* ctl = (unsigned*)(p.ws + WS_CTL);
    const bool single = p.ph < 0;
    XcdBarrier bar; bar.bar = ctl + CW_BAR; bar.x = 0; bar.st = nullptr;
    if (single) bar = xcd_barrier_post(ctl + CW_BAR, MISC + 8);
    int phc = 0;
#define RUN() (single || p.ph == phc)
#define FRESH() int tid = threadIdx.x; asm volatile("" : "+v"(tid)); const int lane = tid & 63, wave = __builtin_amdgcn_readfirstlane(tid >> 6), gw = blockIdx.x * NWAVES + wave; (void)lane; (void)gw
#define SEAM() do { if (single) { XcdBarrier b2_ = bar; asm volatile("" : "+s"(b2_.bar)); xcd_barrier(b2_); } ++phc; } while (0)

    bf16* H = (bf16*)(p.ws + WS_H); bf16* Pm = (bf16*)(p.ws + WS_P);
    if (RUN()) { FRESH(); ph_modvec(p, lds, tid); __syncthreads(); ph_convert(p, lds, gw, NGW, wave, lane); }
    SEAM();
    if (RUN()) { FRESH(); ph_init_rows(p, gw, NGW, lane); }
    SEAM();
    for (int l = 0; l < DEPTH; ++l) {
        if (RUN()) { pg8::Gemm g{H, (const bf16*)(p.ws + WS_WIN) + (size_t)l * NP * D, MROWS, NP, D}; pg8::StaticOrder S; S.init(MROWS, NP, G, (int)blockIdx.x);
            pg8::EpiBf16<0> E{Pm, NP, nullptr, 0, 0, 1.f}; pg8::gemm_phase<pg8::EpiBf16<0>, pg8::StaticOrder, true, true>(lds, g, S, E); }
        SEAM();
        if (RUN()) { FRESH(); ph_lora_in(p, gw, NGW, lane); }
        SEAM();
        if (RUN()) { pg8::Gemm g{(const bf16*)(p.ws + WS_LA), (const bf16*)(p.ws + WS_LORA) + (size_t)l * NLO * KLA, MROWS, NLO, KLA}; pg8::StaticOrder S; S.init(MROWS, NLO, G, (int)blockIdx.x);
            pg8::EpiF32 E{(float*)(p.ws + WS_LO), NLO, 0}; pg8::gemm_phase<pg8::EpiF32, pg8::StaticOrder, true, true>(lds, g, S, E); }
        SEAM();
        if (RUN()) { FRESH(); ph_prep(p, l, gw, NGW, lane); }
        SEAM();
        if (RUN()) { FRESH(); ph_scan(p, wave, lane); }
        SEAM();
        if (RUN()) { FRESH(); ph_readout(p, l, gw, NGW, lane); }
        SEAM();
        if (RUN()) { pg8::Gemm g{(const bf16*)(p.ws + WS_MIXIN), (const bf16*)(p.ws + WS_WOUT) + (size_t)l * D * D, MROWS, D, D}; pg8::StaticOrder S; S.init(MROWS, D, G, (int)blockIdx.x);
            pg8::EpiF32 E{(float*)(p.ws + WS_MIXO), D, 0}; pg8::gemm_phase<pg8::EpiF32, pg8::StaticOrder, true, true>(lds, g, S, E); }
        SEAM();
        if (RUN()) { FRESH(); ph_ln(p, l, 0, gw, NGW, lane); }
        SEAM();
        if ((l & 1) == 0) {
            const int fi = l >> 1;
            if (RUN()) { pg8::Gemm g{H, (const bf16*)(p.ws + WS_F13) + (size_t)fi * 2 * DFF * D, MROWS, 2 * DFF, D}; pg8::StaticOrder S; S.init(MROWS, 2 * DFF, G, (int)blockIdx.x);
                pg8::EpiSwiGLU E{(bf16*)(p.ws + WS_ACT), DFF, nullptr, 0}; pg8::gemm_phase<pg8::EpiSwiGLU, pg8::StaticOrder, true, true>(lds, g, S, E); }
            SEAM();
            if (RUN()) { pg8::Gemm g{(const bf16*)(p.ws + WS_ACT), (const bf16*)(p.ws + WS_F2) + (size_t)fi * D * DFF, MROWS, D, DFF}; pg8::StaticOrder S; S.init(MROWS, D, G, (int)blockIdx.x);
                pg8::EpiF32 E{(float*)(p.ws + WS_F), D, 0}; pg8::gemm_phase<pg8::EpiF32, pg8::StaticOrder, true, true>(lds, g, S, E); }
            SEAM();
        } else {
            if (RUN()) { FRESH(); ph_convert_moe(p, lds, l >> 1, gw, NGW, wave, lane); }
            SEAM();
            for (int e = 0; e < NE; ++e) {
                if (RUN()) { pg8::Gemm g{H, (const bf16*)(p.ws + WS_MOEW13) + (size_t)e * 2 * DFF * D, MROWS, 2 * DFF, D}; pg8::StaticOrder S; S.init(MROWS, 2 * DFF, G, (int)blockIdx.x);
                    pg8::EpiSwiGLU E{(bf16*)(p.ws + WS_ACT), DFF, (const float*)(p.ws + WS_G8) + e, NE}; pg8::gemm_phase<pg8::EpiSwiGLU, pg8::StaticOrder, true, true>(lds, g, S, E); }
                SEAM();
                if (RUN()) { pg8::Gemm g{(const bf16*)(p.ws + WS_ACT), (const bf16*)(p.ws + WS_MOEW2) + (size_t)e * D * DFF, MROWS, D, DFF}; pg8::StaticOrder S; S.init(MROWS, D, G, (int)blockIdx.x);
                    pg8::EpiF32 E{(float*)(p.ws + WS_F), D, e > 0 ? 1 : 0}; pg8::gemm_phase<pg8::EpiF32, pg8::StaticOrder, true, true>(lds, g, S, E); }
                SEAM();
            }
        }
        if (RUN()) { FRESH(); ph_ln(p, l, 1, gw, NGW, lane); }
        SEAM();
    }
#undef RUN
#undef SEAM
}

#ifndef MK_PER_PHASE
#define MK_PER_PHASE 0
#endif
extern "C" void kernel_launch(void* const* d_in, const int* in_sizes, int n_in, void* d_out, int out_size, void* d_ws, size_t ws_size, hipStream_t stream) {
    static int grid = 0;
    if (grid == 0) {
        if (n_in != N_IN || in_sizes[0] != NLAT * D || out_size != NLAT * D || ws_size < WS_NEED) { fprintf(stderr, "kernel_launch: unexpected shapes / workspace (%d inputs, ws %zu, need %zu)\n", n_in, ws_size, (size_t)WS_NEED); grid = -1; return; }
        int dev = 0, cus = 0, per_cu = 0;
        if (hipGetDevice(&dev) != hipSuccess || hipDeviceGetAttribute(&cus, hipDeviceAttributeMultiprocessorCount, dev) != hipSuccess) { grid = -1; return; }
        if (hipFuncSetAttribute((const void*)fwd_kernel, hipFuncAttributeMaxDynamicSharedMemorySize, LDS_BYTES) != hipSuccess) { fprintf(stderr, "kernel_launch: hipFuncSetAttribute failed\n"); grid = -1; return; }
        if (hipOccupancyMaxActiveBlocksPerMultiprocessor(&per_cu, (const void*)fwd_kernel, NWAVES * 64, LDS_BYTES) != hipSuccess || per_cu < 1) fprintf(stderr, "kernel_launch: occupancy query says %d\n", per_cu);
        (void)hipGetLastError();
        grid = cus;
    }
    if (grid < 0) return;
    if (hipMemsetAsync((char*)d_ws + WS_CTL, 0, CTL_BYTES, stream) != hipSuccess) return;
    KP p{};
    for (int i = 0; i < N_IN; ++i) p.in[i] = (const float*)d_in[i];
    p.out = (float*)d_out; p.ws = (unsigned char*)d_ws; p.pad = 0;
#if MK_PER_PHASE
    const int nph = 2 + 2 * 11 + 2 * 26;
    for (int ph = 0; ph < nph; ++ph) { p.ph = ph; hipLaunchKernelGGL(fwd_kernel, dim3(grid), dim3(NWAVES * 64), LDS_BYTES, stream, p); }
#else
    p.ph = -1;
    hipLaunchKernelGGL(fwd_kernel, dim3(grid), dim3(NWAVES * 64), LDS_BYTES, stream, p);
#endif
}
```

```cpp
#include <hip/hip_runtime.h>
#include <cstdio>
#include <cstdint>
namespace pg8 {
#define PG8_LAS __attribute__((address_space(3)))
typedef unsigned short bf16_t;
typedef short bf16x8 __attribute__((ext_vector_type(8)));
typedef float f32x4 __attribute__((ext_vector_type(4)));
typedef unsigned u32x4 __attribute__((ext_vector_type(4)));
constexpr int BM = 256, BK = 64, HALF = 128, HTB = HALF * BK * 2  , STAGE_BYTES = 8 * HTB, NXCD = 8, WGM = 8;

__host__ __device__ __forceinline__ int lds_byte(int r, int c) { const int st = (r >> 4) * 2 + (c >> 5), rr = r & 15, cc = c & 31, ob = rr * 64 + cc * 2; return st * 1024 + (ob ^ (((ob >> 9) & 1) << 5)); }
__host__ __device__ __forceinline__ void stage_rc(int b, int& R, int& C) { const int st = b / 1024, sb = b % 1024, swz = sb ^ (((sb >> 9) & 1) << 5); R = (st >> 1) * 16 + swz / 64; C = (st & 1) * 32 + (swz % 64) / 2; }
__host__ __device__ __forceinline__ int perm32(int rho) { const int n = rho >> 4, i = rho & 15; return 8 * (i >> 2) + 4 * n + (i & 3); }

struct Unit { int pm, pn; };
struct Gemm { const bf16_t* A; const bf16_t* Bt; int M, N, K; };

struct StaticOrder {
    int nM, nN, nwg, G, c;
    __host__ __device__ void init(int M, int N, int G_, int c_) { nM = M / BM; nN = N / BM; nwg = nM * nN; G = G_; c = c_; }
    __host__ __device__ bool next(int i, Unit& u) const {
        const long L = (long)i * G + c; if (L >= nwg) return false;
        int wgid = (int)L; { const int q = nwg / NXCD, r = nwg % NXCD, xcd = wgid % NXCD, off = wgid / NXCD; wgid = (xcd < r ? xcd * (q + 1) : r * (q + 1) + (xcd - r) * q) + off; }
        const int nig = WGM * nN, gid = wgid / nig, fm = gid * WGM, gsz = (nM - fm) < WGM ? (nM - fm) : WGM;
        u.pm = fm + ((wgid % nig) % gsz); u.pn = (wgid % nig) / gsz; return true;
    }
    __device__ __forceinline__ const bf16_t* bt(const Gemm& g, const Unit&) const { return g.Bt; }
    __device__ __forceinline__ void a_ready(const Unit&) const {}
    __device__ __forceinline__ void done(const Unit&) const {}
};

__device__ __forceinline__ unsigned cvt_pk_bf16(float lo, float hi) { unsigned r; asm volatile("v_cvt_pk_bf16_f32 %0, %1, %2" : "=v"(r) : "v"(lo), "v"(hi)); return r; }
typedef float f32x2 __attribute__((ext_vector_type(2)));
__device__ __forceinline__ f32x2 gelu_pk(f32x2 v) {
    const f32x2 av = __builtin_elementwise_abs(v), d = av * 0.2316418882f + 1.0f;
    f32x2 t; t.x = __builtin_amdgcn_rcpf(d.x); t.y = __builtin_amdgcn_rcpf(d.y);
    f32x2 q = t * 0.5307027145f + (-0.7265760135f); q = q * t + 0.7107068705f; q = q * t + (-0.142248368f); q = q * t + 0.127414796f; q = q * t;
    const f32x2 s = (v * v) * (-0.72134752044f);
    f32x2 e; e.x = __builtin_amdgcn_exp2f(s.x); e.y = __builtin_amdgcn_exp2f(s.y);
    const f32x2 m = v * (q * e), r = v - m;
    f32x2 o; o.x = v.x < 0.f ? m.x : r.x; o.y = v.y < 0.f ? m.y : r.y; return o;
}

template <int ACT  > struct EpiBf16 {
    static constexpr bool PERM = true, AFTER_DRAIN = false; static_assert(ACT == 0 || ACT == 1, "EpiBf16: ACT is 0 (none) or 1 (gelu_pk)");
    bf16_t* O; int ldc; const float* bias; int split_cols; size_t split_stride; float scale0;
    __device__ __forceinline__ void operator()(const f32x4 (&acc)[2][2][4][2], const Unit& u, int wr, int wc, int fr, int fq) const {
        const int row0 = u.pm * BM + wr * 64 + fr; int colt = u.pn * BM; bf16_t* base = O;
        float sc = 1.f; if (split_cols) { const int t = colt / split_cols; base += (size_t)t * split_stride; colt -= t * split_cols; if (t == 0) sc = scale0; }
        const int col0 = colt + wc * 32 + 8 * fq, bcol0 = u.pn * BM + wc * 32 + 8 * fq;
        f32x4 bv[2][2];
#pragma unroll
        for (int bj = 0; bj < 2; ++bj)
#pragma unroll
            for (int n = 0; n < 2; ++n) bv[bj][n] = bias ? *(const f32x4*)(bias + bcol0 + bj * HALF + 4 * n) : (f32x4){0.f, 0.f, 0.f, 0.f};
#pragma unroll
        for (int ai = 0; ai < 2; ++ai)
#pragma unroll
            for (int m = 0; m < 4; ++m) { bf16_t* rowp = base + (size_t)(row0 + ai * HALF + m * 16) * ldc + col0;
#pragma unroll
                for (int bj = 0; bj < 2; ++bj) { f32x4 v0 = acc[ai][bj][m][0] + bv[bj][0], v1 = acc[ai][bj][m][1] + bv[bj][1];
                    if (ACT == 1) { f32x2 a = gelu_pk((f32x2){v0[0], v0[1]}), b = gelu_pk((f32x2){v0[2], v0[3]}), c = gelu_pk((f32x2){v1[0], v1[1]}), d = gelu_pk((f32x2){v1[2], v1[3]});
                        v0 = (f32x4){a.x, a.y, b.x, b.y}; v1 = (f32x4){c.x, c.y, d.x, d.y}; }
                    v0 = v0 * sc; v1 = v1 * sc; u32x4 w; w.x = cvt_pk_bf16(v0[0], v0[1]); w.y = cvt_pk_bf16(v0[2], v0[3]); w.z = cvt_pk_bf16(v1[0], v1[1]); w.w = cvt_pk_bf16(v1[2], v1[3]);
                    *(u32x4*)(rowp + bj * HALF) = w; } }
    }
};
struct EpiF32 {
    static constexpr bool PERM = false, AFTER_DRAIN = false;
    float* C; int ldc; int accum;
    __device__ __forceinline__ void operator()(const f32x4 (&acc)[2][2][4][2], const Unit& u, int wr, int wc, int fr, int fq) const {
        const int row0 = u.pm * BM + wr * 64 + fr, col0 = u.pn * BM + wc * 32 + 4 * fq;
#pragma unroll
        for (int ai = 0; ai < 2; ++ai)
#pragma unroll
            for (int m = 0; m < 4; ++m) { float* rowp = C + (size_t)(row0 + ai * HALF + m * 16) * ldc + col0;
#pragma unroll
                for (int bj = 0; bj < 2; ++bj)
#pragma unroll
                    for (int n = 0; n < 2; ++n) { f32x4 v = acc[ai][bj][m][n]; if (accum) v += *(const f32x4*)(rowp + bj * HALF + n * 16); *(f32x4*)(rowp + bj * HALF + n * 16) = v; } }
    }
};
struct EpiSwiGLU {
    static constexpr bool PERM = true, AFTER_DRAIN = false;
    bf16_t* O; int ldo; const float* rowscale; int rs_stride;
    __device__ __forceinline__ void operator()(const f32x4 (&acc)[2][2][4][2], const Unit& u, int wr, int wc, int fr, int fq) const {
        typedef unsigned u32x2v __attribute__((ext_vector_type(2)));
        const int row0 = u.pm * BM + wr * 64 + fr; const int ch0 = (u.pn * BM + wc * 32 + 8 * fq) >> 1;
#pragma unroll
        for (int ai = 0; ai < 2; ++ai)
#pragma unroll
            for (int m = 0; m < 4; ++m) { const int row = row0 + ai * HALF + m * 16; bf16_t* rowp = O + (size_t)row * ldo + ch0;
                const float rs = rowscale ? rowscale[(size_t)row * rs_stride] : 1.f;
#pragma unroll
                for (int bj = 0; bj < 2; ++bj) { const f32x4 a = acc[ai][bj][m][0], b = acc[ai][bj][m][1]; f32x4 o;
#pragma unroll
                    for (int i = 0; i < 4; ++i) o[i] = a[i] * __builtin_amdgcn_rcpf(1.f + __expf(-a[i])) * b[i] * rs;
                    u32x2v w; w.x = cvt_pk_bf16(o[0], o[1]); w.y = cvt_pk_bf16(o[2], o[3]);
                    *(u32x2v*)(rowp + bj * (HALF / 2)) = w; } }
    }
};

struct MoeOrder : StaticOrder {
    int pb1, pb2, pb3, pb4, pb5, pb6, pb7; size_t estride;
    __device__ __forceinline__ const bf16_t* bt(const Gemm& g, const Unit& u) const {
        const int e = (u.pm >= pb1) + (u.pm >= pb2) + (u.pm >= pb3) + (u.pm >= pb4) + (u.pm >= pb5) + (u.pm >= pb6) + (u.pm >= pb7);
        return g.Bt + (size_t)e * estride; }
};
template <class Epi, class Sched, bool ALIGN_EPI = false, bool SP2 = false>
__device__ __forceinline__ void gemm_phase(PG8_LAS unsigned char* lds, const Gemm g, const Sched& S, const Epi& E) {
    int tid_o = threadIdx.x; asm volatile("" : "+v"(tid_o));
    const int tid = tid_o, wid = __builtin_amdgcn_readfirstlane(tid >> 6), lane = tid & 63, wr = wid >> 2, wc = wid & 3, fr = lane & 15, fq = lane >> 4;
    const int K = g.K, nt = K / BK;
    unsigned voffA[2], voffB[2];
#pragma unroll
    for (int i = 0; i < 2; ++i) { int R, C; stage_rc(tid * 16 + i * 8192, R, C); const int Rb = Epi::PERM ? ((R & ~31) + perm32(R & 31)) : R;
        voffA[i] = (unsigned)(R * K + C) * 2u; voffB[i] = (unsigned)(Rb * K + C) * 2u; }
    const size_t kstep = (size_t)(BK * 2);
    const size_t hstep = (size_t)HALF * K * 2;
    const size_t tstep = 2 * hstep;
    const unsigned ldsw = (unsigned)wid * 1024u;
    const int aoff = lds_byte(wr * 64 + fr, fq * 8), boff = lds_byte(wc * 32 + fr, fq * 8);
#define PG8_SA(b, h) (((b) * 2 + (h)) * HTB)
#define PG8_SB(b, h) ((4 + (b) * 2 + (h)) * HTB)
#define PG8_STAGE(bufoff, gbase, voff) do { _Pragma("unroll") for (int _i = 0; _i < 2; ++_i) \
        __builtin_amdgcn_global_load_lds((const unsigned*)((const char*)(gbase) + (voff)[_i]), (PG8_LAS unsigned*)(lds + (bufoff) + ldsw + _i * 8192), 16, 0, 0); } while (0)
#define PG8_LDA(dst, b, h) do { _Pragma("unroll") for (int m = 0; m < 4; ++m) _Pragma("unroll") for (int k = 0; k < 2; ++k) dst[m][k] = *(const PG8_LAS bf16x8*)(lds + PG8_SA(b, h) + aoff + m * 2048 + k * 1024); } while (0)
#define PG8_LDB(dst, b, h) do { _Pragma("unroll") for (int n = 0; n < 2; ++n) _Pragma("unroll") for (int k = 0; k < 2; ++k) dst[n][k] = *(const PG8_LAS bf16x8*)(lds + PG8_SB(b, h) + boff + n * 2048 + k * 1024); } while (0)
#define PG8_MMA(ai, bj, At, Bt) do { __builtin_amdgcn_s_setprio(1); _Pragma("unroll") for (int m = 0; m < 4; ++m) _Pragma("unroll") for (int n = 0; n < 2; ++n) _Pragma("unroll") for (int k = 0; k < 2; ++k) \
        acc[ai][bj][m][n] = __builtin_amdgcn_mfma_f32_16x16x32_bf16(Bt[n][k], At[m][k], acc[ai][bj][m][n], 0, 0, 0); __builtin_amdgcn_s_setprio(0); } while (0)
#define PG8_WAIT_V(n) asm volatile("s_waitcnt vmcnt(" #n ")" ::: "memory")
#define PG8_WAIT_L(n) asm volatile("s_waitcnt lgkmcnt(" #n ")" ::: "memory")
#define PG8_BAR __builtin_amdgcn_s_barrier()
#define PG8_SCHED __builtin_amdgcn_sched_barrier(0)
    Unit cur, nxt; int ui = 0;
    if (!S.next(0, cur)) return;
    f32x4 acc[2][2][4][2];
#pragma unroll
    for (int a = 0; a < 2; ++a)
#pragma unroll
        for (int b = 0; b < 2; ++b)
#pragma unroll
            for (int m = 0; m < 4; ++m)
#pragma unroll
                for (int n = 0; n < 2; ++n) acc[a][b][m][n] = (f32x4){0.f, 0.f, 0.f, 0.f};
    bf16x8 At[4][2], B0[2][2], B1[2][2];
    const char* cA = (const char*)g.A + (size_t)cur.pm * tstep; const char* cB = (const char*)S.bt(g, cur) + (size_t)cur.pn * tstep;
    S.a_ready(cur);
    if constexpr (SP2) {
        PG8_STAGE(PG8_SB(0, 0), cB, voffB); PG8_STAGE(PG8_SB(0, 1), cB + hstep, voffB); PG8_STAGE(PG8_SA(0, 0), cA, voffA); PG8_STAGE(PG8_SA(0, 1), cA + hstep, voffA);
        if (wr == 1) PG8_BAR;
        PG8_WAIT_V(2); PG8_BAR;
        PG8_STAGE(PG8_SB(1, 0), cB + kstep, voffB); PG8_STAGE(PG8_SA(1, 0), cA + kstep, voffA); PG8_STAGE(PG8_SB(1, 1), cB + hstep + kstep, voffB);
        PG8_WAIT_V(6); PG8_BAR;
    } else {
        PG8_STAGE(PG8_SB(0, 0), cB, voffB); PG8_STAGE(PG8_SA(0, 0), cA, voffA); PG8_STAGE(PG8_SB(0, 1), cB + hstep, voffB); PG8_STAGE(PG8_SA(0, 1), cA + hstep, voffA);
        if (wr == 1) PG8_BAR;
        PG8_WAIT_V(4); PG8_BAR;
        PG8_STAGE(PG8_SB(1, 0), cB + kstep, voffB); PG8_STAGE(PG8_SA(1, 0), cA + kstep, voffA); PG8_STAGE(PG8_SB(1, 1), cB + hstep + kstep, voffB);
        PG8_WAIT_V(6); PG8_BAR;
    }
    for (;;) {
        const bool has_next = S.next(ui + 1, nxt);
        const char* nA = has_next ? (const char*)g.A + (size_t)nxt.pm * tstep : cA; const char* nB = has_next ? (const char*)S.bt(g, nxt) + (size_t)nxt.pn * tstep : cB;
        for (int t = 0; t < nt; t += 2) {
            const bool last = (t == nt - 2);
            const char* a1 = cA + (size_t)(t + 1) * kstep;
            const char* a2 = last ? nA : cA + (size_t)(t + 2) * kstep; const char* b2 = last ? nB : cB + (size_t)(t + 2) * kstep;
            const char* a3 = a2 + kstep; const char* b3 = b2 + kstep;
            if (last && has_next) S.a_ready(nxt);
            if constexpr (SP2) {
            PG8_LDB(B0, 0, 0); PG8_LDB(B1, 0, 1); PG8_SCHED; PG8_LDA(At, 0, 0); PG8_STAGE(PG8_SA(1, 1), a1 + hstep, voffA);
            PG8_WAIT_V(8); PG8_WAIT_L(0); PG8_BAR; PG8_MMA(0, 0, At, B0); PG8_MMA(0, 1, At, B1); PG8_BAR; PG8_SCHED;
            PG8_LDA(At, 0, 1); PG8_STAGE(PG8_SB(0, 0), b2, voffB); PG8_STAGE(PG8_SB(0, 1), b2 + hstep, voffB); PG8_STAGE(PG8_SA(0, 0), a2, voffA);
            PG8_WAIT_V(8); PG8_WAIT_L(0); PG8_BAR; PG8_MMA(1, 0, At, B0); PG8_MMA(1, 1, At, B1); PG8_BAR; PG8_SCHED;
            PG8_LDB(B0, 1, 0); PG8_LDB(B1, 1, 1); PG8_SCHED; PG8_LDA(At, 1, 0); PG8_STAGE(PG8_SA(0, 1), a2 + hstep, voffA);
            PG8_WAIT_V(8); PG8_WAIT_L(0); PG8_BAR; PG8_MMA(0, 0, At, B0); PG8_MMA(0, 1, At, B1); PG8_BAR; PG8_SCHED;
            PG8_LDA(At, 1, 1); PG8_STAGE(PG8_SB(1, 0), b3, voffB); PG8_STAGE(PG8_SB(1, 1), b3 + hstep, voffB); PG8_STAGE(PG8_SA(1, 0), a3, voffA);
            PG8_WAIT_V(8); PG8_WAIT_L(0); PG8_BAR; PG8_MMA(1, 0, At, B0); PG8_MMA(1, 1, At, B1); PG8_BAR; PG8_SCHED;
            } else {
            PG8_LDB(B0, 0, 0); PG8_SCHED; PG8_LDA(At, 0, 0); PG8_STAGE(PG8_SA(1, 1), a1 + hstep, voffA);
            PG8_WAIT_L(8); PG8_BAR; PG8_WAIT_L(0); PG8_MMA(0, 0, At, B0); PG8_BAR; PG8_SCHED;
            PG8_LDB(B1, 0, 1); PG8_STAGE(PG8_SB(0, 0), b2, voffB);
            PG8_BAR; PG8_WAIT_L(0); PG8_MMA(0, 1, At, B1); PG8_BAR;
            PG8_LDA(At, 0, 1); PG8_STAGE(PG8_SA(0, 0), a2, voffA);
            PG8_BAR; PG8_WAIT_L(0); PG8_MMA(1, 0, At, B0); PG8_BAR; PG8_SCHED;
            PG8_STAGE(PG8_SB(0, 1), b2 + hstep, voffB);
            PG8_WAIT_V(6); PG8_BAR; PG8_MMA(1, 1, At, B1); PG8_BAR;
            PG8_LDB(B0, 1, 0); PG8_SCHED; PG8_LDA(At, 1, 0); PG8_STAGE(PG8_SA(0, 1), a2 + hstep, voffA);
            PG8_WAIT_L(8); PG8_BAR; PG8_WAIT_L(0); PG8_MMA(0, 0, At, B0); PG8_BAR; PG8_SCHED;
            PG8_LDB(B1, 1, 1); PG8_STAGE(PG8_SB(1, 0), b3, voffB);
            PG8_BAR; PG8_WAIT_L(0); PG8_MMA(0, 1, At, B1); PG8_BAR;
            PG8_LDA(At, 1, 1); PG8_STAGE(PG8_SA(1, 0), a3, voffA);
            PG8_BAR; PG8_WAIT_L(0); PG8_MMA(1, 0, At, B0); PG8_BAR; PG8_SCHED;
            PG8_STAGE(PG8_SB(1, 1), b3 + hstep, voffB);
            PG8_WAIT_V(6); PG8_BAR; PG8_MMA(1, 1, At, B1); PG8_BAR;
            }
        }
        if constexpr (ALIGN_EPI) { if (wr == 0) PG8_BAR; }
        if constexpr (!Epi::AFTER_DRAIN) { E(acc, cur, wr, wc, fr, fq); S.done(cur); }
        if (!has_next) break;
#pragma unroll
        for (int a = 0; a < 2; ++a)
#pragma unroll
            for (int b = 0; b < 2; ++b)
#pragma unroll
                for (int m = 0; m < 4; ++m)
#pragma unroll
                    for (int n = 0; n < 2; ++n) acc[a][b][m][n] = (f32x4){0.f, 0.f, 0.f, 0.f};
        cur = nxt; cA = nA; cB = nB; ++ui;
        if constexpr (ALIGN_EPI) { if (wr == 1) PG8_BAR; }
    }
    PG8_WAIT_V(0);
    if constexpr (!ALIGN_EPI) { if (wr == 0) PG8_BAR; }
    PG8_BAR;
    if constexpr (Epi::AFTER_DRAIN) { E.fused(acc, cur, wr, wc, fr, fq, lds, wid, lane); S.done(cur); }
#undef PG8_SA
#undef PG8_SB
#undef PG8_STAGE
#undef PG8_LDA
#undef PG8_LDB
#undef PG8_MMA
#undef PG8_WAIT_V
#undef PG8_WAIT_L
#undef PG8_BAR
#undef PG8_SCHED
}
}

constexpr int NWAVES = 8;
constexpr int D = 1024, NB = 4, SEQ = 4096, CTXL = 256, NLAT = NB * SEQ, NCTX = NB * CTXL, MROWS = NLAT + NCTX;
constexpr int DEPTH = 4, RW = 512, NH = 8, HS = 64, DFF = 3584, NE = 8, NPROJ = 3456, NP = 3584, NLO = 2560, KLA = 512, NMOD = 6144;
constexpr int PC_R = 0, PC_K = 512, PC_V = 1024, PC_CB = 1536, PC_CC = 2048, PC_CH = 2560, PC_WD = 3072, PC_AD = 3200, PC_GD = 3328;
constexpr float LN_EPS = 1e-5f, GN_EPS = 64e-5f, DN_ALPHA = 1.681792830507429f;
enum { I_X = 0, I_C, I_CTX, I_CCTX, I_WMOD, I_BMOD, I_WIN, I_W0, I_W2, I_A0, I_A2, I_KK, I_KA, I_RK, I_G2, I_LNXG, I_LNXB, I_CONVW, I_WOUT, I_LN1G, I_LN1B, I_LN2G, I_LN2B,
       I_FW1, I_FW3, I_FW2, I_RTW, I_RTB, I_MW1, I_MW3, I_MW2, N_IN };

constexpr size_t MiB = 1u << 20;
constexpr size_t WS_CTL = 0, CTL_BYTES = 1 * MiB;
constexpr size_t WS_MODV = 1 * MiB;
constexpr size_t WS_G8 = 2 * MiB;
constexpr size_t WS_RKS = 3 * MiB;
constexpr size_t WS_WIN = 4 * MiB;
constexpr size_t WS_WOUT = WS_WIN + 28 * MiB;
constexpr size_t WS_LORA = WS_WOUT + 8 * MiB;
constexpr size_t WS_F13 = WS_LORA + 10 * MiB;
constexpr size_t WS_F2 = WS_F13 + 28 * MiB;
constexpr size_t WS_X = WS_F2 + 14 * MiB;
constexpr size_t WS_H = WS_X + 68 * MiB;
constexpr size_t WS_MOES = WS_H + 34 * MiB;
constexpr size_t WS_ROWLIST = WS_MOES;
constexpr size_t WS_TOKSEL = WS_MOES + 640 * 1024;
constexpr size_t WS_WSEL = WS_TOKSEL + 320 * 1024;
constexpr size_t WS_WSORT = WS_WSEL + 192 * 1024;
constexpr size_t WS_SCR = WS_MOES + 2 * MiB;
constexpr size_t WS_P = WS_SCR;
constexpr size_t WS_LA = WS_P + 119 * MiB;
constexpr size_t WS_LO = WS_LA + 17 * MiB;
constexpr size_t WS_MIX = WS_LO;
constexpr size_t WS_PREP = WS_LO + 170 * MiB;
constexpr size_t WS_Y = WS_PREP + 238 * MiB;
constexpr size_t WS_MIXIN = WS_Y + 68 * MiB;
constexpr size_t WS_MIXO = WS_PREP;
constexpr size_t WS_END_MIXER = WS_MIXIN + 34 * MiB;
constexpr size_t WS_MOEW13 = WS_SCR;
constexpr size_t WS_MOEW2 = WS_MOEW13 + 112 * MiB;
constexpr size_t WS_HG = WS_MOEW2 + 56 * MiB;
constexpr size_t WS_ACT = WS_HG + 72 * MiB;
constexpr size_t WS_F = WS_ACT + 252 * MiB;
constexpr size_t WS_END_FFN = WS_F + 144 * MiB;
constexpr size_t WS_NEED = WS_END_MIXER > WS_END_FFN ? WS_END_MIXER : WS_END_FFN;
static_assert((size_t)MROWS * NP * 2 <= 119 * MiB && (size_t)MROWS * NLO * 4 <= 170 * MiB && (size_t)MROWS * RW * 4 * 7 <= 238 * MiB && (size_t)MROWS * D * 4 <= 68 * MiB, "ws map");
constexpr int MOE_ROWS = 36864;
constexpr int CW_BAR = 4096, CW_GCNT = 8192;

constexpr int RING_BYTES = 131072, LDSCTL_OFF = RING_BYTES, MISC_OFF = LDSCTL_OFF + 320, LDS_BYTES = 147456;

typedef unsigned short bf16;
typedef unsigned v4u __attribute__((ext_vector_type(4)));
typedef unsigned v2u __attribute__((ext_vector_type(2)));
typedef float f32x4 __attribute__((ext_vector_type(4)));
#define LAS __attribute__((address_space(3)))
#define LDS_WAIT() asm volatile("s_waitcnt lgkmcnt(0)" ::: "memory")
__device__ __forceinline__ unsigned f2bf(float f) { unsigned u = __builtin_bit_cast(unsigned, f); return (u + 0x7fffu + ((u >> 16) & 1u)) >> 16; }
__device__ __forceinline__ unsigned pk2(float lo, float hi) { return f2bf(lo) | (f2bf(hi) << 16); }
__device__ __forceinline__ float bf2f(unsigned short b) { return __builtin_bit_cast(float, ((unsigned)b) << 16); }
__device__ __forceinline__ float bflo(unsigned w) { return __builtin_bit_cast(float, w << 16); }
__device__ __forceinline__ float bfhi(unsigned w) { return __builtin_bit_cast(float, w & 0xffff0000u); }
__device__ __forceinline__ float wave_sum(float v) {
#pragma unroll
    for (int o = 1; o < 64; o <<= 1) v += __shfl_xor(v, o);
    return v;
}
__device__ __forceinline__ float sigm(float x) { return 1.f / (1.f + __expf(-x)); }

#define XB_TMO      128
#define XB_XCNT(j)  (256  + 64 * (j))
#define XB_XSUB(j)  (1280 + 64 * (j))
#define XB_XGEN(j)  (2304 + 64 * (j))
#define XB_TOP      3328
#define XB_TOPGEN   3392
#define XCD_BAR_WORDS 3456
#define XB_SPIN_CAP (1u << 18)

__device__ __forceinline__ unsigned xb_ld(unsigned* p)              { return __hip_atomic_load(p, __ATOMIC_RELAXED, __HIP_MEMORY_SCOPE_AGENT); }
__device__ __forceinline__ unsigned xb_add(unsigned* p, unsigned v) { return __hip_atomic_fetch_add(p, v, __ATOMIC_RELAXED, __HIP_MEMORY_SCOPE_AGENT); }
__device__ __forceinline__ unsigned xb_xcc_id() { return (unsigned)__builtin_amdgcn_s_getreg((3 << 11) | 20) & 0xFu; }
#define XB_SPIN(cond, bar) do { unsigned _sp = 0; while (cond) { __builtin_amdgcn_s_sleep(1); \
    if ((++_sp & 255u) == 0u) { if (xb_ld(&(bar)[XB_TMO])) break; if (_sp > XB_SPIN_CAP) { atomicAdd(&(bar)[XB_TMO], 1u); break; } } } } while (0)

struct XcdBarrier {
    unsigned* bar; unsigned x;
    volatile LAS unsigned* st;
};

__device__ __forceinline__ XcdBarrier xcd_barrier_post(unsigned* bar, volatile LAS unsigned* st) {
    XcdBarrier b; b.bar = bar; b.x = xb_xcc_id(); b.st = st;
    if (threadIdx.x == 0) (void)xb_add(&bar[XB_XCNT(b.x)], 1u);
    return b;
}
__device__ __forceinline__ void xcd_barrier_complete(unsigned* bar, unsigned x, unsigned& nloc, unsigned& nx) {
    const unsigned G = gridDim.x * gridDim.y * gridDim.z;
    unsigned sum, cnt, mine, sp = 0u;
    for (;;) {
        sum = 0u; cnt = 0u; mine = 0u;
#pragma unroll
        for (unsigned j = 0; j < 16; ++j) { const unsigned c = xb_ld(&bar[XB_XCNT(j)]); sum += c; cnt += (c > 0u) ? 1u : 0u; mine = (j == x) ? c : mine; }
        if (sum == G) break;
        __builtin_amdgcn_s_sleep(1);
        if ((++sp & 255u) == 0u) { if (xb_ld(&bar[XB_TMO])) break; if (sp > XB_SPIN_CAP) { atomicAdd(&bar[XB_TMO], 1u); break; } }
    }
    nloc = mine > 0u ? mine : 1u; nx = cnt > 0u ? cnt : 1u;
}

__device__ __forceinline__ void xcd_barrier(const XcdBarrier& b) {
    asm volatile("s_waitcnt vmcnt(0)" ::: "memory");
    __syncthreads();
    if (threadIdx.x == 0) {
        unsigned* bar = b.bar;
        __builtin_amdgcn_s_waitcnt(0);
        unsigned nloc = b.st[0], nx = b.st[1];
        if (nloc == 0u) { xcd_barrier_complete(bar, b.x, nloc, nx); b.st[0] = nloc; b.st[1] = nx; }
        const unsigned old = xb_add(&bar[XB_XSUB(b.x)], 1u);
        const unsigned gen = old / nloc;
        if (old + 1u == (gen + 1u) * nloc) {
            __builtin_amdgcn_fence(__ATOMIC_RELEASE, "agent");
            asm volatile("s_waitcnt vmcnt(0)" ::: "memory");
            const unsigned og = xb_add(&bar[XB_TOP], 1u);
            const unsigned tg = og / nx;
            if (og + 1u == (tg + 1u) * nx) xb_add(&bar[XB_TOPGEN], 1u);
            else XB_SPIN(xb_ld(&bar[XB_TOPGEN]) == tg, bar);
            __builtin_amdgcn_fence(__ATOMIC_ACQUIRE, "agent");
            xb_add(&bar[XB_XGEN(b.x)], 1u);
            asm volatile("s_waitcnt vmcnt(0)" ::: "memory");
        } else {
            XB_SPIN(xb_ld(&bar[XB_XGEN(b.x)]) == gen, bar);
            __builtin_amdgcn_fence(__ATOMIC_ACQUIRE, "agent");
            asm volatile("s_waitcnt vmcnt(0)" ::: "memory");
        }
    }
    __syncthreads();
}


struct KP { const float* in[N_IN]; float* out; unsigned char* ws; int ph; int pad; };

template <int MODE> __device__ __forceinline__ int rowmap(int n, int arg) {
    if (MODE == 0) return n + arg;
    if (MODE == 1) { if (n < 1536) return n; if (n < 1664) return n - 1536 + PC_WD; if (n < 1792) return n - 1664 + PC_AD; if (n < 1920) return n - 1792 + PC_GD;
                     if (n < 2432) return n - 1920 + PC_CB; if (n < 2944) return n - 2432 + PC_CC; return n - 2944 + PC_CH; }
    return 8 * (n >> 2) + 4 * arg + (n & 3);
}
template <int MODE> __device__ __forceinline__ void transpose_item(const float* W, int K, int N, bf16* WT, int arg, LAS float* scr, int item, int lane) {
    const int nblk = N / 32, kb = item / nblk, nb = item % nblk, k0 = 64 * kb, n0 = 32 * nb;
#pragma unroll 8
    for (int i = 0; i < 32; ++i) { const int kk = 2 * i + (lane >> 5); scr[kk * 33 + (lane & 31)] = W[(size_t)(k0 + kk) * N + n0 + (lane & 31)]; }
    LDS_WAIT(); asm volatile("" ::: "memory");
    const int c = lane & 7;
#pragma unroll
    for (int j = 0; j < 4; ++j) { const int n = (lane >> 3) + 8 * j; const LAS float* s = scr + (8 * c) * 33 + n;
        v4u o; o.x = pk2(s[0 * 33], s[1 * 33]); o.y = pk2(s[2 * 33], s[3 * 33]); o.z = pk2(s[4 * 33], s[5 * 33]); o.w = pk2(s[6 * 33], s[7 * 33]);
        *(v4u*)(WT + (size_t)rowmap<MODE>(n0 + n, arg) * K + k0 + 8 * c) = o; }
    LDS_WAIT(); asm volatile("" ::: "memory");
}

__device__ __forceinline__ void ph_modvec(const KP& p, LAS unsigned char* lds, int tid) {
    LAS float* sil = (LAS float*)lds;
    LAS float* red = (LAS float*)(lds + 5 * 1024 * 4);
    const float* c = p.in[I_C]; const float* cc = p.in[I_CCTX];
    for (int i = tid; i < 5 * 1024; i += 512) { const float v = i < 4096 ? c[i] : cc[i - 4096]; sil[i] = v / (1.f + __expf(-v)); }
    __syncthreads();
    float* modv = (float*)(p.ws + WS_MODV);
    const int ks = tid >> 6, col = tid & 63;
    for (int task = blockIdx.x; task < DEPTH * 96; task += gridDim.x) {
        const int l = task / 96, j0 = (task % 96) * 64;
        const float* w = p.in[I_WMOD] + (size_t)l * D * NMOD + (size_t)(ks * 128) * NMOD + j0 + col;
        float a0 = 0.f, a1 = 0.f, a2 = 0.f, a3 = 0.f, a4 = 0.f;
#pragma unroll 8
        for (int k = 0; k < 128; ++k) { const float wv = w[(size_t)k * NMOD]; const int kk = ks * 128 + k;
            a0 += sil[kk] * wv; a1 += sil[1024 + kk] * wv; a2 += sil[2048 + kk] * wv; a3 += sil[3072 + kk] * wv; a4 += sil[4096 + kk] * wv; }
        red[(ks * 5 + 0) * 64 + col] = a0; red[(ks * 5 + 1) * 64 + col] = a1; red[(ks * 5 + 2) * 64 + col] = a2; red[(ks * 5 + 3) * 64 + col] = a3; red[(ks * 5 + 4) * 64 + col] = a4;
        __syncthreads();
        if (tid < 320) { const int r = tid >> 6; float s = 0.f;
#pragma unroll
            for (int q = 0; q < 8; ++q) s += red[(q * 5 + r) * 64 + col];
            modv[(size_t)(l * 5 + r) * NMOD + j0 + col] = s + p.in[I_BMOD][l * NMOD + j0 + col]; }
        __syncthreads();
    }
}

__device__ __forceinline__ void ph_convert(const KP& p, LAS unsigned char* lds, int gw, int NGW, int wave, int lane) {
    LAS float* scr = (LAS float*)(lds + wave * 16384);
    bf16* win = (bf16*)(p.ws + WS_WIN); bf16* wout = (bf16*)(p.ws + WS_WOUT); bf16* f13 = (bf16*)(p.ws + WS_F13); bf16* f2 = (bf16*)(p.ws + WS_F2); bf16* lora = (bf16*)(p.ws + WS_LORA);
    constexpr int I_IN = (D / 64) * (NPROJ / 32), I_OUT = (D / 64) * (D / 32), I_UP = (D / 64) * (DFF / 32), I_DN = (DFF / 64) * (D / 32);
    constexpr int T_IN = DEPTH * I_IN, T_OUT = DEPTH * I_OUT, T_UP = 2 * I_UP, T_DN = 2 * I_DN, NITEMS = T_IN + T_OUT + 2 * T_UP + T_DN;
    for (int it = gw; it < NITEMS; it += NGW) {
        int r = it;
        if (r < T_IN) { const int l = r / I_IN; transpose_item<1>(p.in[I_WIN] + (size_t)l * D * NPROJ, D, NPROJ, win + (size_t)l * NP * D, 0, scr, r % I_IN, lane); continue; } r -= T_IN;
        if (r < T_OUT) { const int l = r / I_OUT; transpose_item<0>(p.in[I_WOUT] + (size_t)l * D * D, D, D, wout + (size_t)l * D * D, 0, scr, r % I_OUT, lane); continue; } r -= T_OUT;
        if (r < T_UP) { const int l = r / I_UP; transpose_item<2>(p.in[I_FW1] + (size_t)l * D * DFF, D, DFF, f13 + (size_t)l * 2 * DFF * D, 0, scr, r % I_UP, lane); continue; } r -= T_UP;
        if (r < T_UP) { const int l = r / I_UP; transpose_item<2>(p.in[I_FW3] + (size_t)l * D * DFF, D, DFF, f13 + (size_t)l * 2 * DFF * D, 1, scr, r % I_UP, lane); continue; } r -= T_UP;
        { const int l = r / I_DN; transpose_item<0>(p.in[I_FW2] + (size_t)l * DFF * D, DFF, D, f2 + (size_t)l * D * DFF, 0, scr, r % I_DN, lane); }
    }
    { const int gt = gw * 64 + lane, NGT = NGW * 64; constexpr int PER = (NP - NPROJ) * D / 8;
      for (int i = gt; i < DEPTH * PER; i += NGT) { const int l = i / PER, q = i % PER; *(v4u*)(win + (size_t)l * NP * D + (size_t)NPROJ * D + (size_t)q * 8) = (v4u){0u, 0u, 0u, 0u}; } }
    { const int gt = gw * 64 + lane, NGT = NGW * 64; constexpr int PER = NLO * KLA / 8;
      for (int i = gt; i < DEPTH * PER; i += NGT) { const int l = i / PER, q = i % PER, n = q / (KLA / 8), k0 = (q % (KLA / 8)) * 8; float v[8];
#pragma unroll
          for (int j = 0; j < 8; ++j) { const int k = k0 + j; float x = 0.f;
              if (n < 1024) { const int d = n >> 9, c = n & 511; if (k >= 64 * d && k < 64 * d + 64) x = p.in[I_W2][((size_t)(l * 2 + d) * 64 + (k - 64 * d)) * RW + c]; }
              else if (n < 2048) { const int d = (n - 1024) >> 9, c = n & 511; if (k >= 128 + 64 * d && k < 192 + 64 * d) x = p.in[I_A2][((size_t)(l * 2 + d) * 64 + (k - 128 - 64 * d)) * RW + c]; }
              else { const int c = n - 2048; if (k >= 256 && k < 384) x = p.in[I_G2][((size_t)l * 128 + (k - 256)) * RW + c]; }
              v[j] = x; }
          v4u o; o.x = pk2(v[0], v[1]); o.y = pk2(v[2], v[3]); o.z = pk2(v[4], v[5]); o.w = pk2(v[6], v[7]);
          *(v4u*)(lora + (size_t)l * NLO * KLA + (size_t)n * KLA + k0) = o; } }
}
__device__ __forceinline__ void ph_convert_moe(const KP& p, LAS unsigned char* lds, int mi, int gw, int NGW, int wave, int lane) {
    LAS float* scr = (LAS float*)(lds + wave * 16384);
    bf16* w13 = (bf16*)(p.ws + WS_MOEW13); bf16* w2 = (bf16*)(p.ws + WS_MOEW2);
    constexpr int I_UP = (D / 64) * (DFF / 32), I_DN = (DFF / 64) * (D / 32), T_UP = NE * I_UP, T_DN = NE * I_DN;
    for (int it = gw; it < 2 * T_UP + T_DN; it += NGW) {
        int r = it;
        if (r < T_UP) { const int e = r / I_UP; transpose_item<2>(p.in[I_MW1] + ((size_t)mi * NE + e) * D * DFF, D, DFF, w13 + (size_t)e * 2 * DFF * D, 0, scr, r % I_UP, lane); continue; } r -= T_UP;
        if (r < T_UP) { const int e = r / I_UP; transpose_item<2>(p.in[I_MW3] + ((size_t)mi * NE + e) * D * DFF, D, DFF, w13 + (size_t)e * 2 * DFF * D, 1, scr, r % I_UP, lane); continue; } r -= T_UP;
        { const int e = r / I_DN; transpose_item<0>(p.in[I_MW2] + ((size_t)mi * NE + e) * DFF * D, DFF, D, w2 + (size_t)e * D * DFF, 0, scr, r % I_DN, lane); }
    }
}

__device__ __forceinline__ void ld_row(const float* r, int lane, f32x4 (&v)[4]) { const f32x4* q = (const f32x4*)r + lane;
#pragma unroll
    for (int j = 0; j < 4; ++j) v[j] = q[64 * j]; }
__device__ __forceinline__ void st_row(float* r, int lane, const f32x4 (&v)[4]) { f32x4* q = (f32x4*)r + lane;
#pragma unroll
    for (int j = 0; j < 4; ++j) q[64 * j] = v[j]; }
__device__ __forceinline__ void st_row_bf16(bf16* r, int lane, const f32x4 (&v)[4]) { v2u* q = (v2u*)r + lane;
#pragma unroll
    for (int j = 0; j < 4; ++j) { v2u w; w.x = pk2(v[j][0], v[j][1]); w.y = pk2(v[j][2], v[j][3]); q[64 * j] = w; } }
__device__ __forceinline__ int mod_row(int row) { return row < NLAT ? (row >> 12) : 4; }

__device__ __forceinline__ void ph_init_rows(const KP& p, int gw, int NGW, int lane) {
    const float* modv = (const float*)(p.ws + WS_MODV); float* X = (float*)(p.ws + WS_X); bf16* H = (bf16*)(p.ws + WS_H);
    for (int row = gw; row < MROWS; row += NGW) {
        const float* src = row < NLAT ? p.in[I_X] + (size_t)row * D : p.in[I_CTX] + (size_t)(row - NLAT) * D;
        const float* mv = modv + (size_t)(0 * 5 + mod_row(row)) * NMOD;
        f32x4 x[4], sh[4], sc[4], h[4]; ld_row(src, lane, x); ld_row(mv, lane, sh); ld_row(mv + 1024, lane, sc);
#pragma unroll
        for (int j = 0; j < 4; ++j) h[j] = x[j] * (1.f + sc[j]) + sh[j];
        st_row(X + (size_t)row * D, lane, x); st_row_bf16(H + (size_t)row * D, lane, h);
    }
}

__device__ __forceinline__ void ph_lora_in(const KP& p, int gw, int NGW, int lane) {
    const bf16* P = (const bf16*)(p.ws + WS_P); bf16* LA = (bf16*)(p.ws + WS_LA);
    const int gt = gw * 64 + lane, NGT = NGW * 64;
    for (int i = gt; i < MROWS * (KLA / 8); i += NGT) { const int row = i >> 6, k0 = (i & 63) * 8; v4u o = (v4u){0u, 0u, 0u, 0u};
        if (k0 < 384) { const v4u s = *(const v4u*)(P + (size_t)row * NP + PC_WD + k0); float v[8] = {bflo(s.x), bfhi(s.x), bflo(s.y), bfhi(s.y), bflo(s.z), bfhi(s.z), bflo(s.w), bfhi(s.w)};
            if (k0 < 128) {
#pragma unroll
                for (int j = 0; j < 8; ++j) v[j] = tanhf(v[j]); }
            else if (k0 >= 256) {
#pragma unroll
                for (int j = 0; j < 8; ++j) v[j] = sigm(v[j]); }
            o.x = pk2(v[0], v[1]); o.y = pk2(v[2], v[3]); o.z = pk2(v[4], v[5]); o.w = pk2(v[6], v[7]); }
        *(v4u*)(LA + (size_t)row * KLA + k0) = o; }
}

__device__ __forceinline__ void ph_prep(const KP& p, int l, int gw, int NGW, int lane) {
    const bf16* P = (const bf16*)(p.ws + WS_P); const float* LO = (const float*)(p.ws + WS_LO); float* PR = (float*)(p.ws + WS_PREP); float* RKS = (float*)(p.ws + WS_RKS);
    constexpr size_t PA = (size_t)MROWS * RW;
    for (int it = gw; it < MROWS * NH; it += NGW) { const int row = it >> 3, h = it & 7, c = h * 64 + lane;
        const float kv = bf2f(P[(size_t)row * NP + PC_K + c]), rv = bf2f(P[(size_t)row * NP + PC_R + c]);
        const float* lo = LO + (size_t)row * NLO;
        float dec[2], a[2];
#pragma unroll
        for (int d = 0; d < 2; ++d) {
            const float wl = p.in[I_W0][(l * 2 + d) * RW + c] + lo[d * RW + c];
            const float z = -wl, sp = z > 20.f ? z : log1pf(expf(z));
            const float w_log = -sp - 0.5f; dec[d] = expf(-expf(w_log));
            a[d] = sigm(p.in[I_A0][(l * 2 + d) * RW + c] + lo[1024 + d * RW + c]);
        }
        float kk = kv * p.in[I_KK][l * RW + c]; const float ss = wave_sum(kk * kk); kk = kk / fmaxf(sqrtf(ss), 1e-12f);
        const float ka = p.in[I_KA][l * RW + c];
        const float kd0 = kv * (1.f + (a[0] - 1.f) * ka), kd1 = kv * (1.f + (a[1] - 1.f) * ka);
        const float rk = wave_sum(rv * (kd0 + kd1) * p.in[I_RK][(l * NH + h) * HS + lane]);
        const size_t o = (size_t)row * RW + c;
        PR[0 * PA + o] = dec[0]; PR[1 * PA + o] = dec[1]; PR[2 * PA + o] = kd0; PR[3 * PA + o] = kd1; PR[4 * PA + o] = kk * a[0]; PR[5 * PA + o] = kk * a[1]; PR[6 * PA + o] = kk;
        if (lane == 0) RKS[row * 8 + h] = rk;
    }
}

__device__ __forceinline__ int scan_row(int b, int dir, int step) { return step < CTXL ? NLAT + b * CTXL + (dir ? CTXL - 1 - step : step) : b * SEQ + (dir ? SEQ - 1 - (step - CTXL) : step - CTXL); }
__device__ __forceinline__ void ph_scan(const KP& p, int wave, int lane) {
    if (wave >= 4) return;
    const bf16* P = (const bf16*)(p.ws + WS_P); const float* PR = (const float*)(p.ws + WS_PREP); float* Y = (float*)(p.ws + WS_Y);
    constexpr size_t PA = (size_t)MROWS * RW; constexpr int NSTEP = CTXL + SEQ;
    for (int wt = blockIdx.x * 4 + wave; wt < 1024; wt += gridDim.x * 4) {
        const int rg = wt & 15, h = (wt >> 4) & 7, b = (wt >> 7) & 3, dir = wt >> 9;
        const int rr = lane >> 4, q = lane & 15, vrow = rg * 4 + rr, ch0 = h * 64 + q * 4;
        const float* Wd = PR + (size_t)dir * PA + ch0; const float* Kd = PR + (size_t)(2 + dir) * PA + ch0; const float* Bd = PR + (size_t)(4 + dir) * PA + ch0; const float* KKp = PR + 6 * PA + ch0;
        float* Yo = Y + (size_t)dir * PA + h * 64 + vrow;
        f32x4 s = (f32x4){0.f, 0.f, 0.f, 0.f};
        f32x4 bw[4], bk[4], bb[4], bq[4]; v2u br[4]; float bv[4];
#pragma unroll
        for (int u = 0; u < 4; ++u) { const size_t ro = (size_t)scan_row(b, dir, u) * RW; const size_t rp = (size_t)scan_row(b, dir, u) * NP;
            bw[u] = *(const f32x4*)(Wd + ro); bk[u] = *(const f32x4*)(Kd + ro); bb[u] = *(const f32x4*)(Bd + ro); bq[u] = *(const f32x4*)(KKp + ro);
            br[u] = *(const v2u*)(P + rp + PC_R + ch0); bv[u] = bf2f(P[rp + PC_V + h * 64 + vrow]); }
        for (int st = 0; st < NSTEP; st += 4) {
#pragma unroll
            for (int u = 0; u < 4; ++u) {
                const f32x4 w = bw[u], kd = bk[u], bvec = bb[u], kk = bq[u]; const v2u rw = br[u]; const float vv = bv[u];
                const int cur = scan_row(b, dir, st + u);
                { const int nstep = st + u + 4 < NSTEP ? st + u + 4 : NSTEP - 1; const int nrow = scan_row(b, dir, nstep); const size_t ro = (size_t)nrow * RW, rp = (size_t)nrow * NP;
                  bw[u] = *(const f32x4*)(Wd + ro); bk[u] = *(const f32x4*)(Kd + ro); bb[u] = *(const f32x4*)(Bd + ro); bq[u] = *(const f32x4*)(KKp + ro);
                  br[u] = *(const v2u*)(P + rp + PC_R + ch0); bv[u] = bf2f(P[rp + PC_V + h * 64 + vrow]); }
                float sa = -((s[0] * kk[0] + s[1] * kk[1]) + (s[2] * kk[2] + s[3] * kk[3]));
                sa += __shfl_xor(sa, 1); sa += __shfl_xor(sa, 2); sa += __shfl_xor(sa, 4); sa += __shfl_xor(sa, 8);
                s = s * w + sa * bvec + vv * kd;
                float y = (s[0] * bflo(rw.x) + s[1] * bfhi(rw.x)) + (s[2] * bflo(rw.y) + s[3] * bfhi(rw.y));
                y += __shfl_xor(y, 1); y += __shfl_xor(y, 2); y += __shfl_xor(y, 4); y += __shfl_xor(y, 8);
                if (q == 0) Yo[(size_t)cur * RW] = y;
            }
        }
    }
}

__device__ __forceinline__ void ph_readout(const KP& p, int l, int gw, int NGW, int lane) {
    const bf16* P = (const bf16*)(p.ws + WS_P); const float* LO = (const float*)(p.ws + WS_LO); const float* Y = (const float*)(p.ws + WS_Y); const float* RKS = (const float*)(p.ws + WS_RKS);
    bf16* MI = (bf16*)(p.ws + WS_MIXIN); constexpr size_t PA = (size_t)MROWS * RW;
    for (int it = gw; it < MROWS * NH; it += NGW) { const int row = it >> 3, h = it & 7, c = h * 64 + lane;
        const float y = Y[(size_t)row * RW + c] + Y[PA + (size_t)row * RW + c];
        const float mu = wave_sum(y) * (1.f / 64.f), dv = y - mu, var = wave_sum(dv * dv) * (1.f / 64.f);
        const float yn = dv / sqrtf(var + GN_EPS);
        const bf16* pr = P + (size_t)row * NP;
        const float v = bf2f(pr[PC_V + c]);
        const float o = yn * p.in[I_LNXG][l * RW + c] + p.in[I_LNXB][l * RW + c] + RKS[row * 8 + h] * v;
        const float g = LO[(size_t)row * NLO + 2048 + c];
        MI[(size_t)row * D + c] = (bf16)f2bf(o * g);
        int t, len; if (row < NLAT) { t = row & 63; len = 64; } else { t = (row - NLAT) & 255; len = 256; }
        const float uc = bf2f(pr[PC_CC + c]) * bf2f(pr[PC_CH + c]);
        const float up = t > 0 ? bf2f(pr[PC_CC + c - NP]) * bf2f(pr[PC_CH + c - NP]) : 0.f;
        const float un = t < len - 1 ? bf2f(pr[PC_CC + c + NP]) * bf2f(pr[PC_CH + c + NP]) : 0.f;
        const float* cw = p.in[I_CONVW] + (size_t)l * 3 * RW;
        const float cv = up * cw[c] + uc * cw[RW + c] + un * cw[2 * RW + c];
        MI[(size_t)row * D + RW + c] = (bf16)f2bf(bf2f(pr[PC_CB + c]) * cv);
    }
}


__device__ __forceinline__ void ph_moe_gather(const KP& p, int l, int gw, int NGW, int lane) {
    const unsigned* gcnt = (const unsigned*)(p.ws + WS_CTL) + CW_GCNT + 64 * (l >> 1);
    int cnt[8], pb[9]; pb[0] = 0;
#pragma unroll
    for (int e = 0; e < 8; ++e) { cnt[e] = (int)gcnt[e]; pb[e + 1] = pb[e] + ((cnt[e] + 255) & ~255); }
    const unsigned* rowlist = (const unsigned*)(p.ws + WS_ROWLIST); const float* wsel = (const float*)(p.ws + WS_WSEL); float* wsort = (float*)(p.ws + WS_WSORT);
    const bf16* H = (const bf16*)(p.ws + WS_H); bf16* HG = (bf16*)(p.ws + WS_HG);
    for (int pos = gw; pos < pb[8]; pos += NGW) {
        int e = 0, base = 0, ce = cnt[0];
#pragma unroll
        for (int k = 1; k < 8; ++k) if (pos >= pb[k]) { e = k; base = pb[k]; ce = cnt[k]; }
        const int rank = pos - base; v4u a = (v4u){0u, 0u, 0u, 0u}, b = a; float w = 0.f;
        if (rank < ce) { const unsigned ent = rowlist[(size_t)e * MROWS + rank]; const v4u* src = (const v4u*)(H + (size_t)(ent >> 1) * D); a = src[lane]; b = src[64 + lane]; w = wsel[ent]; }
        v4u* dst = (v4u*)(HG + (size_t)pos * D); dst[lane] = a; dst[64 + lane] = b;
        if (lane == 0) wsort[pos] = w;
    }
}

__device__ __forceinline__ void ph_ln(const KP& p, LAS unsigned char* lds, int l, int which, int tid, int wave, int gw, int NGW, int lane) {
    const float* modv = (const float*)(p.ws + WS_MODV); float* X = (float*)(p.ws + WS_X); bf16* H = (bf16*)(p.ws + WS_H);
    const float* BR = (const float*)(p.ws + (which == 0 ? WS_MIXO : WS_F));
    const float* lg = p.in[which == 0 ? I_LN1G : I_LN2G] + l * D; const float* lb = p.in[which == 0 ? I_LN1B : I_LN2B] + l * D;
    const bool moe = (which == 0) && (l & 1); const bool last = (which == 1) && (l == DEPTH - 1); const bool moe_out = (which == 1) && (l & 1);
    LAS int* lcnt = (LAS int*)lds;
    LAS int* lsel = (LAS int*)(lds + 64);
    int nloc = 0;
    if (moe) { if (tid < 16) lcnt[tid] = 0; __syncthreads(); }
    int pbs[9]; pbs[0] = 0;
    if (moe_out) { const unsigned* gcnt = (const unsigned*)(p.ws + WS_CTL) + CW_GCNT + 64 * (l >> 1);
#pragma unroll
        for (int e = 0; e < 8; ++e) pbs[e + 1] = pbs[e] + (int)((gcnt[e] + 255u) & ~255u); }
    for (int row = gw; row < MROWS; row += NGW) {
        const int mr = mod_row(row); const float* mv = modv + (size_t)(l * 5 + mr) * NMOD;
        f32x4 x[4], br[4], gt[4], t[4]; ld_row(X + (size_t)row * D, lane, x); ld_row(mv + (which == 0 ? 2048 : 5120), lane, gt);
        if (moe_out) { const int* ts = (const int*)(p.ws + WS_TOKSEL) + row * 4; const int e0 = ts[0], r0 = ts[1], e1 = ts[2], r1 = ts[3]; int b0 = 0, b1 = 0;
#pragma unroll
            for (int k = 1; k < 8; ++k) { if (e0 >= k) b0 = pbs[k]; if (e1 >= k) b1 = pbs[k]; }
            f32x4 ba[4], bb[4]; ld_row(BR + (size_t)(b0 + r0) * D, lane, ba); ld_row(BR + (size_t)(b1 + r1) * D, lane, bb);
#pragma unroll
            for (int j = 0; j < 4; ++j) br[j] = ba[j] + bb[j]; }
        else ld_row(BR + (size_t)row * D, lane, br);
        float s = 0.f;
#pragma unroll
        for (int j = 0; j < 4; ++j) { t[j] = DN_ALPHA * x[j] + gt[j] * br[j]; s += (t[j][0] + t[j][1]) + (t[j][2] + t[j][3]); }
        const float mean = wave_sum(s) * (1.f / D); float s2 = 0.f;
#pragma unroll
        for (int j = 0; j < 4; ++j) { t[j] = t[j] - mean; s2 += (t[j][0] * t[j][0] + t[j][1] * t[j][1]) + (t[j][2] * t[j][2] + t[j][3] * t[j][3]); }
        const float rstd = 1.f / sqrtf(wave_sum(s2) * (1.f / D) + LN_EPS);
        f32x4 g4[4], b4[4]; ld_row(lg, lane, g4); ld_row(lb, lane, b4);
#pragma unroll
        for (int j = 0; j < 4; ++j) x[j] = t[j] * rstd * g4[j] + b4[j];
        if (last) { if (row < NLAT) st_row(p.out + (size_t)row * D, lane, x); continue; }
        st_row(X + (size_t)row * D, lane, x);
        const float* mv2 = which == 0 ? mv + 3072 : modv + (size_t)((l + 1) * 5 + mr) * NMOD;
        f32x4 sh[4], sc[4], hh[4]; ld_row(mv2, lane, sh); ld_row(mv2 + 1024, lane, sc);
#pragma unroll
        for (int j = 0; j < 4; ++j) hh[j] = x[j] * (1.f + sc[j]) + sh[j];
        st_row_bf16(H + (size_t)row * D, lane, hh);
        if (moe) {
            const float* rw = p.in[I_RTW] + (size_t)(l >> 1) * D * NE; float lgt[8];
#pragma unroll
            for (int e = 0; e < 8; ++e) lgt[e] = 0.f;
#pragma unroll
            for (int j = 0; j < 4; ++j)
#pragma unroll
                for (int i = 0; i < 4; ++i) { const f32x4* wp = (const f32x4*)(rw + (size_t)(4 * lane + 256 * j + i) * NE); const f32x4 w0 = wp[0], w1 = wp[1]; const float hv = hh[j][i];
                    lgt[0] += hv * w0[0]; lgt[1] += hv * w0[1]; lgt[2] += hv * w0[2]; lgt[3] += hv * w0[3]; lgt[4] += hv * w1[0]; lgt[5] += hv * w1[1]; lgt[6] += hv * w1[2]; lgt[7] += hv * w1[3]; }
#pragma unroll
            for (int e = 0; e < 8; ++e) lgt[e] = wave_sum(lgt[e]) + p.in[I_RTB][(l >> 1) * NE + e];
            float v0 = lgt[0]; int i0 = 0;
#pragma unroll
            for (int e = 1; e < 8; ++e) if (lgt[e] > v0) { v0 = lgt[e]; i0 = e; }
            float v1 = -3.0e38f; int i1 = -1;
#pragma unroll
            for (int e = 0; e < 8; ++e) if (e != i0 && lgt[e] > v1) { v1 = lgt[e]; i1 = e; }
            const float w0 = 1.f / (1.f + expf(v1 - v0)), w1 = 1.f - w0;
            if (lane == 0) { const int lr0 = __hip_atomic_fetch_add(lcnt + i0, 1, __ATOMIC_RELAXED, __HIP_MEMORY_SCOPE_WORKGROUP), lr1 = __hip_atomic_fetch_add(lcnt + i1, 1, __ATOMIC_RELAXED, __HIP_MEMORY_SCOPE_WORKGROUP); const int li = nloc * NWAVES + wave;
                lsel[li * 8 + 0] = row; lsel[li * 8 + 1] = i0; lsel[li * 8 + 2] = lr0; lsel[li * 8 + 3] = i1; lsel[li * 8 + 4] = lr1;
                ((float*)(p.ws + WS_WSEL))[row * 2] = w0; ((float*)(p.ws + WS_WSEL))[row * 2 + 1] = w1; }
            ++nloc;
        }
    }
    if (moe) {
        __syncthreads();
        unsigned* gcnt = (unsigned*)(p.ws + WS_CTL) + CW_GCNT + 64 * (l >> 1);
        if (tid < 8) lcnt[8 + tid] = (int)__hip_atomic_fetch_add(gcnt + tid, (unsigned)lcnt[tid], __ATOMIC_RELAXED, __HIP_MEMORY_SCOPE_AGENT);
        __syncthreads();
        unsigned* rowlist = (unsigned*)(p.ws + WS_ROWLIST); int* toksel = (int*)(p.ws + WS_TOKSEL);
        if (tid < 16 * NWAVES) { const int k = tid / NWAVES, w = tid % NWAVES; if (k * NGW + (int)blockIdx.x * NWAVES + w < MROWS) { const int li = k * NWAVES + w;
            const int row = lsel[li * 8 + 0], e0 = lsel[li * 8 + 1], r0 = lcnt[8 + e0] + lsel[li * 8 + 2], e1 = lsel[li * 8 + 3], r1 = lcnt[8 + e1] + lsel[li * 8 + 4];
            rowlist[(size_t)e0 * MROWS + r0] = (unsigned)row * 2u; rowlist[(size_t)e1 * MROWS + r1] = (unsigned)row * 2u + 1u;
            toksel[row * 4 + 0] = e0; toksel[row * 4 + 1] = r0; toksel[row * 4 + 2] = e1; toksel[row * 4 + 3] = r1; } }
    }
}

__global__ void __launch_bounds__(NWAVES * 64, 2) fwd_kernel(KP p) {
    extern __shared__ __attribute__((aligned(16))) unsigned char lds_raw[];
    LAS unsigned char* lds = (LAS unsigned char*)lds_raw;
    volatile LAS unsigned* MISC = (volatile LAS unsigned*)(lds + MISC_OFF);
    const int G = gridDim.x, NGW = G * NWAVES;
    for (int u = threadIdx.x; u < (LDS_BYTES - LDSCTL_OFF) / 4; u += NWAVES * 64) ((LAS unsigned*)(lds + LDSCTL_OFF))[u] = 0u;
    __syncthreads();
    unsigned* ctl = (unsigned*)(p.ws + WS_CTL);
    const bool single = p.ph < 0;
    XcdBarrier bar; bar.bar = ctl + CW_BAR; bar.x = 0; bar.st = nullptr;
    if (single) bar = xcd_barrier_post(ctl + CW_BAR, MISC + 8);
    int phc = 0;
#define RUN() (single || p.ph == phc)
#define FRESH() int tid = threadIdx.x; asm volatile("" : "+v"(tid)); const int lane = tid & 63, wave = __builtin_amdgcn_readfirstlane(tid >> 6), gw = blockIdx.x * NWAVES + wave; (void)lane; (void)gw
#define SEAM() do { if (single) { XcdBarrier b2_ = bar; asm volatile("" : "+s"(b2_.bar)); xcd_barrier(b2_); } ++phc; } while (0)

    bf16* H = (bf16*)(p.ws + WS_H); bf16* Pm = (bf16*)(p.ws + WS_P);
    if (RUN()) { FRESH(); ph_modvec(p, lds, tid); __syncthreads(); ph_convert(p, lds, gw, NGW, wave, lane); }
    SEAM();
    if (RUN()) { FRESH(); ph_init_rows(p, gw, NGW, lane); }
    SEAM();
    for (int l = 0; l < DEPTH; ++l) {
        if (RUN()) { pg8::Gemm g{H, (const bf16*)(p.ws + WS_WIN) + (size_t)l * NP * D, MROWS, NP, D}; pg8::StaticOrder S; S.init(MROWS, NP, G, (int)blockIdx.x);
            pg8::EpiBf16<0> E{Pm, NP, nullptr, 0, 0, 1.f}; pg8::gemm_phase<pg8::EpiBf16<0>, pg8::StaticOrder, true, true>(lds, g, S, E); }
        SEAM();
        if (RUN()) { FRESH(); ph_lora_in(p, gw, NGW, lane); }
        SEAM();
        if (RUN()) { pg8::Gemm g{(const bf16*)(p.ws + WS_LA), (const bf16*)(p.ws + WS_LORA) + (size_t)l * NLO * KLA, MROWS, NLO, KLA}; pg8::StaticOrder S; S.init(MROWS, NLO, G, (int)blockIdx.x);
            pg8::EpiF32 E{(float*)(p.ws + WS_LO), NLO, 0}; pg8::gemm_phase<pg8::EpiF32, pg8::StaticOrder, true, true>(lds, g, S, E); }
        SEAM();
        if (RUN()) { FRESH(); ph_prep(p, l, gw, NGW, lane); }
        SEAM();
        if (RUN()) { FRESH(); ph_scan(p, wave, lane); }
        SEAM();
        if (RUN()) { FRESH(); ph_readout(p, l, gw, NGW, lane); }
        SEAM();
        if (RUN()) { pg8::Gemm g{(const bf16*)(p.ws + WS_MIXIN), (const bf16*)(p.ws + WS_WOUT) + (size_t)l * D * D, MROWS, D, D}; pg8::StaticOrder S; S.init(MROWS, D, G, (int)blockIdx.x);
            pg8::EpiF32 E{(float*)(p.ws + WS_MIXO), D, 0}; pg8::gemm_phase<pg8::EpiF32, pg8::StaticOrder, true, true>(lds, g, S, E); }
        SEAM();
        if (RUN()) { FRESH(); ph_ln(p, lds, l, 0, tid, wave, gw, NGW, lane); }
        SEAM();
        if ((l & 1) == 0) {
            const int fi = l >> 1;
            if (RUN()) { pg8::Gemm g{H, (const bf16*)(p.ws + WS_F13) + (size_t)fi * 2 * DFF * D, MROWS, 2 * DFF, D}; pg8::StaticOrder S; S.init(MROWS, 2 * DFF, G, (int)blockIdx.x);
                pg8::EpiSwiGLU E{(bf16*)(p.ws + WS_ACT), DFF, nullptr, 0}; pg8::gemm_phase<pg8::EpiSwiGLU, pg8::StaticOrder, true, true>(lds, g, S, E); }
            SEAM();
            if (RUN()) { pg8::Gemm g{(const bf16*)(p.ws + WS_ACT), (const bf16*)(p.ws + WS_F2) + (size_t)fi * D * DFF, MROWS, D, DFF}; pg8::StaticOrder S; S.init(MROWS, D, G, (int)blockIdx.x);
                pg8::EpiF32 E{(float*)(p.ws + WS_F), D, 0}; pg8::gemm_phase<pg8::EpiF32, pg8::StaticOrder, true, true>(lds, g, S, E); }
            SEAM();
        } else {
            if (RUN()) { FRESH(); ph_convert_moe(p, lds, l >> 1, gw, NGW, wave, lane); }
            SEAM();
            if (RUN()) { FRESH(); ph_moe_gather(p, l, gw, NGW, lane); }
            SEAM();
            {   const unsigned* gcnt = (const unsigned*)(p.ws + WS_CTL) + CW_GCNT + 64 * (l >> 1); int pbp[9]; pbp[0] = 0;
#pragma unroll
                for (int e = 0; e < 8; ++e) pbp[e + 1] = pbp[e] + (int)((gcnt[e] + 255u) >> 8);
                const int mrows = pbp[8] * 256;
                if (RUN()) { pg8::Gemm g{(const bf16*)(p.ws + WS_HG), (const bf16*)(p.ws + WS_MOEW13), mrows, 2 * DFF, D}; pg8::MoeOrder S; S.init(mrows, 2 * DFF, G, (int)blockIdx.x);
                    S.pb1 = pbp[1]; S.pb2 = pbp[2]; S.pb3 = pbp[3]; S.pb4 = pbp[4]; S.pb5 = pbp[5]; S.pb6 = pbp[6]; S.pb7 = pbp[7]; S.estride = (size_t)2 * DFF * D;
                    pg8::EpiSwiGLU E{(bf16*)(p.ws + WS_ACT), DFF, (const float*)(p.ws + WS_WSORT), 1}; pg8::gemm_phase<pg8::EpiSwiGLU, pg8::MoeOrder, true, true>(lds, g, S, E); }
                SEAM();
                if (RUN()) { pg8::Gemm g{(const bf16*)(p.ws + WS_ACT), (const bf16*)(p.ws + WS_MOEW2), mrows, D, DFF}; pg8::MoeOrder S; S.init(mrows, D, G, (int)blockIdx.x);
                    S.pb1 = pbp[1]; S.pb2 = pbp[2]; S.pb3 = pbp[3]; S.pb4 = pbp[4]; S.pb5 = pbp[5]; S.pb6 = pbp[6]; S.pb7 = pbp[7]; S.estride = (size_t)D * DFF;
                    pg8::EpiF32 E{(float*)(p.ws + WS_F), D, 0}; pg8::gemm_phase<pg8::EpiF32, pg8::MoeOrder, true, true>(lds, g, S, E); }
                SEAM();
            }
        }
        if (RUN()) { FRESH(); ph_ln(p, lds, l, 1, tid, wave, gw, NGW, lane); }
        SEAM();
    }
#undef RUN
#undef SEAM
}

#ifndef MK_PER_PHASE
#define MK_PER_PHASE 0
#endif
extern "C" void kernel_launch(void* const* d_in, const int* in_sizes, int n_in, void* d_out, int out_size, void* d_ws, size_t ws_size, hipStream_t stream) {
    static int grid = 0;
    if (grid == 0) {
        if (n_in != N_IN || in_sizes[0] != NLAT * D || out_size != NLAT * D || ws_size < WS_NEED) { fprintf(stderr, "kernel_launch: unexpected shapes / workspace (%d inputs, ws %zu, need %zu)\n", n_in, ws_size, (size_t)WS_NEED); grid = -1; return; }
        int dev = 0, cus = 0, per_cu = 0;
        if (hipGetDevice(&dev) != hipSuccess || hipDeviceGetAttribute(&cus, hipDeviceAttributeMultiprocessorCount, dev) != hipSuccess) { grid = -1; return; }
        if (hipFuncSetAttribute((const void*)fwd_kernel, hipFuncAttributeMaxDynamicSharedMemorySize, LDS_BYTES) != hipSuccess) { fprintf(stderr, "kernel_launch: hipFuncSetAttribute failed\n"); grid = -1; return; }
        if (hipOccupancyMaxActiveBlocksPerMultiprocessor(&per_cu, (const void*)fwd_kernel, NWAVES * 64, LDS_BYTES) != hipSuccess || per_cu < 1) fprintf(stderr, "kernel_launch: occupancy query says %d\n", per_cu);
        (void)hipGetLastError();
        grid = cus;
    }
    if (grid < 0) return;
    if (hipMemsetAsync((char*)d_ws + WS_CTL, 0, CTL_BYTES, stream) != hipSuccess) return;
    KP p{};
    for (int i = 0; i < N_IN; ++i) p.in[i] = (const float*)d_in[i];
    p.out = (float*)d_out; p.ws = (unsigned char*)d_ws; p.pad = 0;
#if MK_PER_PHASE
    const int nph = 2 + 2 * 11 + 2 * 13;
    for (int ph = 0; ph < nph; ++ph) { p.ph = ph; hipLaunchKernelGGL(fwd_kernel, dim3(grid), dim3(NWAVES * 64), LDS_BYTES, stream, p); }
#else
    p.ph = -1;
    hipLaunchKernelGGL(fwd_kernel, dim3(grid), dim3(NWAVES * 64), LDS_BYTES, stream, p);
#endif
}
```

```cpp
#include <hip/hip_runtime.h>
#include <cstdio>
#include <cstdint>
namespace pg8 {
#define PG8_LAS __attribute__((address_space(3)))
typedef unsigned short bf16_t;
typedef short bf16x8 __attribute__((ext_vector_type(8)));
typedef float f32x4 __attribute__((ext_vector_type(4)));
typedef unsigned u32x4 __attribute__((ext_vector_type(4)));
constexpr int BM = 256, BK = 64, HALF = 128, HTB = HALF * BK * 2  , STAGE_BYTES = 8 * HTB, NXCD = 8, WGM = 8;

__host__ __device__ __forceinline__ int lds_byte(int r, int c) { const int st = (r >> 4) * 2 + (c >> 5), rr = r & 15, cc = c & 31, ob = rr * 64 + cc * 2; return st * 1024 + (ob ^ (((ob >> 9) & 1) << 5)); }
__host__ __device__ __forceinline__ void stage_rc(int b, int& R, int& C) { const int st = b / 1024, sb = b % 1024, swz = sb ^ (((sb >> 9) & 1) << 5); R = (st >> 1) * 16 + swz / 64; C = (st & 1) * 32 + (swz % 64) / 2; }
__host__ __device__ __forceinline__ int perm32(int rho) { const int n = rho >> 4, i = rho & 15; return 8 * (i >> 2) + 4 * n + (i & 3); }

struct Unit { int pm, pn; };
struct Gemm { const bf16_t* A; const bf16_t* Bt; int M, N, K; };

struct StaticOrder {
    int nM, nN, nwg, G, c;
    __host__ __device__ void init(int M, int N, int G_, int c_) { nM = M / BM; nN = N / BM; nwg = nM * nN; G = G_; c = c_; }
    __host__ __device__ bool next(int i, Unit& u) const {
        const long L = (long)i * G + c; if (L >= nwg) return false;
        int wgid = (int)L; { const int q = nwg / NXCD, r = nwg % NXCD, xcd = wgid % NXCD, off = wgid / NXCD; wgid = (xcd < r ? xcd * (q + 1) : r * (q + 1) + (xcd - r) * q) + off; }
        const int nig = WGM * nN, gid = wgid / nig, fm = gid * WGM, gsz = (nM - fm) < WGM ? (nM - fm) : WGM;
        u.pm = fm + ((wgid % nig) % gsz); u.pn = (wgid % nig) / gsz; return true;
    }
    __device__ __forceinline__ const bf16_t* bt(const Gemm& g, const Unit&) const { return g.Bt; }
    __device__ __forceinline__ void a_ready(const Unit&) const {}
    __device__ __forceinline__ void done(const Unit&) const {}
};

__device__ __forceinline__ unsigned cvt_pk_bf16(float lo, float hi) { unsigned r; asm volatile("v_cvt_pk_bf16_f32 %0, %1, %2" : "=v"(r) : "v"(lo), "v"(hi)); return r; }
typedef float f32x2 __attribute__((ext_vector_type(2)));
__device__ __forceinline__ f32x2 gelu_pk(f32x2 v) {
    const f32x2 av = __builtin_elementwise_abs(v), d = av * 0.2316418882f + 1.0f;
    f32x2 t; t.x = __builtin_amdgcn_rcpf(d.x); t.y = __builtin_amdgcn_rcpf(d.y);
    f32x2 q = t * 0.5307027145f + (-0.7265760135f); q = q * t + 0.7107068705f; q = q * t + (-0.142248368f); q = q * t + 0.127414796f; q = q * t;
    const f32x2 s = (v * v) * (-0.72134752044f);
    f32x2 e; e.x = __builtin_amdgcn_exp2f(s.x); e.y = __builtin_amdgcn_exp2f(s.y);
    const f32x2 m = v * (q * e), r = v - m;
    f32x2 o; o.x = v.x < 0.f ? m.x : r.x; o.y = v.y < 0.f ? m.y : r.y; return o;
}

template <int ACT  > struct EpiBf16 {
    static constexpr bool PERM = true, AFTER_DRAIN = false; static_assert(ACT == 0 || ACT == 1, "EpiBf16: ACT is 0 (none) or 1 (gelu_pk)");
    bf16_t* O; int ldc; const float* bias; int split_cols; size_t split_stride; float scale0;
    __device__ __forceinline__ void operator()(const f32x4 (&acc)[2][2][4][2], const Unit& u, int wr, int wc, int fr, int fq) const {
        const int row0 = u.pm * BM + wr * 64 + fr; int colt = u.pn * BM; bf16_t* base = O;
        float sc = 1.f; if (split_cols) { const int t = colt / split_cols; base += (size_t)t * split_stride; colt -= t * split_cols; if (t == 0) sc = scale0; }
        const int col0 = colt + wc * 32 + 8 * fq, bcol0 = u.pn * BM + wc * 32 + 8 * fq;
        f32x4 bv[2][2];
#pragma unroll
        for (int bj = 0; bj < 2; ++bj)
#pragma unroll
            for (int n = 0; n < 2; ++n) bv[bj][n] = bias ? *(const f32x4*)(bias + bcol0 + bj * HALF + 4 * n) : (f32x4){0.f, 0.f, 0.f, 0.f};
#pragma unroll
        for (int ai = 0; ai < 2; ++ai)
#pragma unroll
            for (int m = 0; m < 4; ++m) { bf16_t* rowp = base + (size_t)(row0 + ai * HALF + m * 16) * ldc + col0;
#pragma unroll
                for (int bj = 0; bj < 2; ++bj) { f32x4 v0 = acc[ai][bj][m][0] + bv[bj][0], v1 = acc[ai][bj][m][1] + bv[bj][1];
                    if (ACT == 1) { f32x2 a = gelu_pk((f32x2){v0[0], v0[1]}), b = gelu_pk((f32x2){v0[2], v0[3]}), c = gelu_pk((f32x2){v1[0], v1[1]}), d = gelu_pk((f32x2){v1[2], v1[3]});
                        v0 = (f32x4){a.x, a.y, b.x, b.y}; v1 = (f32x4){c.x, c.y, d.x, d.y}; }
                    v0 = v0 * sc; v1 = v1 * sc; u32x4 w; w.x = cvt_pk_bf16(v0[0], v0[1]); w.y = cvt_pk_bf16(v0[2], v0[3]); w.z = cvt_pk_bf16(v1[0], v1[1]); w.w = cvt_pk_bf16(v1[2], v1[3]);
                    *(u32x4*)(rowp + bj * HALF) = w; } }
    }
};
struct EpiF32 {
    static constexpr bool PERM = false, AFTER_DRAIN = false;
    float* C; int ldc; int accum;
    __device__ __forceinline__ void operator()(const f32x4 (&acc)[2][2][4][2], const Unit& u, int wr, int wc, int fr, int fq) const {
        const int row0 = u.pm * BM + wr * 64 + fr, col0 = u.pn * BM + wc * 32 + 4 * fq;
#pragma unroll
        for (int ai = 0; ai < 2; ++ai)
#pragma unroll
            for (int m = 0; m < 4; ++m) { float* rowp = C + (size_t)(row0 + ai * HALF + m * 16) * ldc + col0;
#pragma unroll
                for (int bj = 0; bj < 2; ++bj)
#pragma unroll
                    for (int n = 0; n < 2; ++n) { f32x4 v = acc[ai][bj][m][n]; if (accum) v += *(const f32x4*)(rowp + bj * HALF + n * 16); *(f32x4*)(rowp + bj * HALF + n * 16) = v; } }
    }
};
struct EpiSwiGLU {
    static constexpr bool PERM = true, AFTER_DRAIN = false;
    bf16_t* O; int ldo; const float* rowscale; int rs_stride;
    __device__ __forceinline__ void operator()(const f32x4 (&acc)[2][2][4][2], const Unit& u, int wr, int wc, int fr, int fq) const {
        typedef unsigned u32x2v __attribute__((ext_vector_type(2)));
        const int row0 = u.pm * BM + wr * 64 + fr; const int ch0 = (u.pn * BM + wc * 32 + 8 * fq) >> 1;
#pragma unroll
        for (int ai = 0; ai < 2; ++ai)
#pragma unroll
            for (int m = 0; m < 4; ++m) { const int row = row0 + ai * HALF + m * 16; bf16_t* rowp = O + (size_t)row * ldo + ch0;
                const float rs = rowscale ? rowscale[(size_t)row * rs_stride] : 1.f;
#pragma unroll
                for (int bj = 0; bj < 2; ++bj) { const f32x4 a = acc[ai][bj][m][0], b = acc[ai][bj][m][1]; f32x4 o;
#pragma unroll
                    for (int i = 0; i < 4; ++i) o[i] = a[i] * __builtin_amdgcn_rcpf(1.f + __expf(-a[i])) * b[i] * rs;
                    u32x2v w; w.x = cvt_pk_bf16(o[0], o[1]); w.y = cvt_pk_bf16(o[2], o[3]);
                    *(u32x2v*)(rowp + bj * (HALF / 2)) = w; } }
    }
};

struct MoeOrder : StaticOrder {
    int pb1, pb2, pb3, pb4, pb5, pb6, pb7; size_t estride;
    __device__ __forceinline__ const bf16_t* bt(const Gemm& g, const Unit& u) const {
        const int e = (u.pm >= pb1) + (u.pm >= pb2) + (u.pm >= pb3) + (u.pm >= pb4) + (u.pm >= pb5) + (u.pm >= pb6) + (u.pm >= pb7);
        return g.Bt + (size_t)e * estride; }
};
template <class Epi, class Sched, bool ALIGN_EPI = false, bool SP2 = false>
__device__ __forceinline__ void gemm_phase(PG8_LAS unsigned char* lds, const Gemm g, const Sched& S, const Epi& E) {
    int tid_o = threadIdx.x; asm volatile("" : "+v"(tid_o));
    const int tid = tid_o, wid = __builtin_amdgcn_readfirstlane(tid >> 6), lane = tid & 63, wr = wid >> 2, wc = wid & 3, fr = lane & 15, fq = lane >> 4;
    const int K = g.K, nt = K / BK;
    unsigned voffA[2], voffB[2];
#pragma unroll
    for (int i = 0; i < 2; ++i) { int R, C; stage_rc(tid * 16 + i * 8192, R, C); const int Rb = Epi::PERM ? ((R & ~31) + perm32(R & 31)) : R;
        voffA[i] = (unsigned)(R * K + C) * 2u; voffB[i] = (unsigned)(Rb * K + C) * 2u; }
    const size_t kstep = (size_t)(BK * 2);
    const size_t hstep = (size_t)HALF * K * 2;
    const size_t tstep = 2 * hstep;
    const unsigned ldsw = (unsigned)wid * 1024u;
    const int aoff = lds_byte(wr * 64 + fr, fq * 8), boff = lds_byte(wc * 32 + fr, fq * 8);
#define PG8_SA(b, h) (((b) * 2 + (h)) * HTB)
#define PG8_SB(b, h) ((4 + (b) * 2 + (h)) * HTB)
#define PG8_STAGE(bufoff, gbase, voff) do { _Pragma("unroll") for (int _i = 0; _i < 2; ++_i) \
        __builtin_amdgcn_global_load_lds((const unsigned*)((const char*)(gbase) + (voff)[_i]), (PG8_LAS unsigned*)(lds + (bufoff) + ldsw + _i * 8192), 16, 0, 0); } while (0)
#define PG8_LDA(dst, b, h) do { _Pragma("unroll") for (int m = 0; m < 4; ++m) _Pragma("unroll") for (int k = 0; k < 2; ++k) dst[m][k] = *(const PG8_LAS bf16x8*)(lds + PG8_SA(b, h) + aoff + m * 2048 + k * 1024); } while (0)
#define PG8_LDB(dst, b, h) do { _Pragma("unroll") for (int n = 0; n < 2; ++n) _Pragma("unroll") for (int k = 0; k < 2; ++k) dst[n][k] = *(const PG8_LAS bf16x8*)(lds + PG8_SB(b, h) + boff + n * 2048 + k * 1024); } while (0)
#define PG8_MMA(ai, bj, At, Bt) do { __builtin_amdgcn_s_setprio(1); _Pragma("unroll") for (int m = 0; m < 4; ++m) _Pragma("unroll") for (int n = 0; n < 2; ++n) _Pragma("unroll") for (int k = 0; k < 2; ++k) \
        acc[ai][bj][m][n] = __builtin_amdgcn_mfma_f32_16x16x32_bf16(Bt[n][k], At[m][k], acc[ai][bj][m][n], 0, 0, 0); __builtin_amdgcn_s_setprio(0); } while (0)
#define PG8_WAIT_V(n) asm volatile("s_waitcnt vmcnt(" #n ")" ::: "memory")
#define PG8_WAIT_L(n) asm volatile("s_waitcnt lgkmcnt(" #n ")" ::: "memory")
#define PG8_BAR __builtin_amdgcn_s_barrier()
#define PG8_SCHED __builtin_amdgcn_sched_barrier(0)
    Unit cur, nxt; int ui = 0;
    if (!S.next(0, cur)) return;
    f32x4 acc[2][2][4][2];
#pragma unroll
    for (int a = 0; a < 2; ++a)
#pragma unroll
        for (int b = 0; b < 2; ++b)
#pragma unroll
            for (int m = 0; m < 4; ++m)
#pragma unroll
                for (int n = 0; n < 2; ++n) acc[a][b][m][n] = (f32x4){0.f, 0.f, 0.f, 0.f};
    bf16x8 At[4][2], B0[2][2], B1[2][2];
    const char* cA = (const char*)g.A + (size_t)cur.pm * tstep; const char* cB = (const char*)S.bt(g, cur) + (size_t)cur.pn * tstep;
    S.a_ready(cur);
    if constexpr (SP2) {
        PG8_STAGE(PG8_SB(0, 0), cB, voffB); PG8_STAGE(PG8_SB(0, 1), cB + hstep, voffB); PG8_STAGE(PG8_SA(0, 0), cA, voffA); PG8_STAGE(PG8_SA(0, 1), cA + hstep, voffA);
        if (wr == 1) PG8_BAR;
        PG8_WAIT_V(2); PG8_BAR;
        PG8_STAGE(PG8_SB(1, 0), cB + kstep, voffB); PG8_STAGE(PG8_SA(1, 0), cA + kstep, voffA); PG8_STAGE(PG8_SB(1, 1), cB + hstep + kstep, voffB);
        PG8_WAIT_V(6); PG8_BAR;
    } else {
        PG8_STAGE(PG8_SB(0, 0), cB, voffB); PG8_STAGE(PG8_SA(0, 0), cA, voffA); PG8_STAGE(PG8_SB(0, 1), cB + hstep, voffB); PG8_STAGE(PG8_SA(0, 1), cA + hstep, voffA);
        if (wr == 1) PG8_BAR;
        PG8_WAIT_V(4); PG8_BAR;
        PG8_STAGE(PG8_SB(1, 0), cB + kstep, voffB); PG8_STAGE(PG8_SA(1, 0), cA + kstep, voffA); PG8_STAGE(PG8_SB(1, 1), cB + hstep + kstep, voffB);
        PG8_WAIT_V(6); PG8_BAR;
    }
    for (;;) {
        const bool has_next = S.next(ui + 1, nxt);
        const char* nA = has_next ? (const char*)g.A + (size_t)nxt.pm * tstep : cA; const char* nB = has_next ? (const char*)S.bt(g, nxt) + (size_t)nxt.pn * tstep : cB;
        for (int t = 0; t < nt; t += 2) {
            const bool last = (t == nt - 2);
            const char* a1 = cA + (size_t)(t + 1) * kstep;
            const char* a2 = last ? nA : cA + (size_t)(t + 2) * kstep; const char* b2 = last ? nB : cB + (size_t)(t + 2) * kstep;
            const char* a3 = a2 + kstep; const char* b3 = b2 + kstep;
            if (last && has_next) S.a_ready(nxt);
            if constexpr (SP2) {
            PG8_LDB(B0, 0, 0); PG8_LDB(B1, 0, 1); PG8_SCHED; PG8_LDA(At, 0, 0); PG8_STAGE(PG8_SA(1, 1), a1 + hstep, voffA);
            PG8_WAIT_V(8); PG8_WAIT_L(0); PG8_BAR; PG8_MMA(0, 0, At, B0); PG8_MMA(0, 1, At, B1); PG8_BAR; PG8_SCHED;
            PG8_LDA(At, 0, 1); PG8_STAGE(PG8_SB(0, 0), b2, voffB); PG8_STAGE(PG8_SB(0, 1), b2 + hstep, voffB); PG8_STAGE(PG8_SA(0, 0), a2, voffA);
            PG8_WAIT_V(8); PG8_WAIT_L(0); PG8_BAR; PG8_MMA(1, 0, At, B0); PG8_MMA(1, 1, At, B1); PG8_BAR; PG8_SCHED;
            PG8_LDB(B0, 1, 0); PG8_LDB(B1, 1, 1); PG8_SCHED; PG8_LDA(At, 1, 0); PG8_STAGE(PG8_SA(0, 1), a2 + hstep, voffA);
            PG8_WAIT_V(8); PG8_WAIT_L(0); PG8_BAR; PG8_MMA(0, 0, At, B0); PG8_MMA(0, 1, At, B1); PG8_BAR; PG8_SCHED;
            PG8_LDA(At, 1, 1); PG8_STAGE(PG8_SB(1, 0), b3, voffB); PG8_STAGE(PG8_SB(1, 1), b3 + hstep, voffB); PG8_STAGE(PG8_SA(1, 0), a3, voffA);
            PG8_WAIT_V(8); PG8_WAIT_L(0); PG8_BAR; PG8_MMA(1, 0, At, B0); PG8_MMA(1, 1, At, B1); PG8_BAR; PG8_SCHED;
            } else {
            PG8_LDB(B0, 0, 0); PG8_SCHED; PG8_LDA(At, 0, 0); PG8_STAGE(PG8_SA(1, 1), a1 + hstep, voffA);
            PG8_WAIT_L(8); PG8_BAR; PG8_WAIT_L(0); PG8_MMA(0, 0, At, B0); PG8_BAR; PG8_SCHED;
            PG8_LDB(B1, 0, 1); PG8_STAGE(PG8_SB(0, 0), b2, voffB);
            PG8_BAR; PG8_WAIT_L(0); PG8_MMA(0, 1, At, B1); PG8_BAR;
            PG8_LDA(At, 0, 1); PG8_STAGE(PG8_SA(0, 0), a2, voffA);
            PG8_BAR; PG8_WAIT_L(0); PG8_MMA(1, 0, At, B0); PG8_BAR; PG8_SCHED;
            PG8_STAGE(PG8_SB(0, 1), b2 + hstep, voffB);
            PG8_WAIT_V(6); PG8_BAR; PG8_MMA(1, 1, At, B1); PG8_BAR;
            PG8_LDB(B0, 1, 0); PG8_SCHED; PG8_LDA(At, 1, 0); PG8_STAGE(PG8_SA(0, 1), a2 + hstep, voffA);
            PG8_WAIT_L(8); PG8_BAR; PG8_WAIT_L(0); PG8_MMA(0, 0, At, B0); PG8_BAR; PG8_SCHED;
            PG8_LDB(B1, 1, 1); PG8_STAGE(PG8_SB(1, 0), b3, voffB);
            PG8_BAR; PG8_WAIT_L(0); PG8_MMA(0, 1, At, B1); PG8_BAR;
            PG8_LDA(At, 1, 1); PG8_STAGE(PG8_SA(1, 0), a3, voffA);
            PG8_BAR; PG8_WAIT_L(0); PG8_MMA(1, 0, At, B0); PG8_BAR; PG8_SCHED;
            PG8_STAGE(PG8_SB(1, 1), b3 + hstep, voffB);
            PG8_WAIT_V(6); PG8_BAR; PG8_MMA(1, 1, At, B1); PG8_BAR;
            }
        }
        if constexpr (ALIGN_EPI) { if (wr == 0) PG8_BAR; }
        if constexpr (!Epi::AFTER_DRAIN) { E(acc, cur, wr, wc, fr, fq); S.done(cur); }
        if (!has_next) break;
#pragma unroll
        for (int a = 0; a < 2; ++a)
#pragma unroll
            for (int b = 0; b < 2; ++b)
#pragma unroll
                for (int m = 0; m < 4; ++m)
#pragma unroll
                    for (int n = 0; n < 2; ++n) acc[a][b][m][n] = (f32x4){0.f, 0.f, 0.f, 0.f};
        cur = nxt; cA = nA; cB = nB; ++ui;
        if constexpr (ALIGN_EPI) { if (wr == 1) PG8_BAR; }
    }
    PG8_WAIT_V(0);
    if constexpr (!ALIGN_EPI) { if (wr == 0) PG8_BAR; }
    PG8_BAR;
    if constexpr (Epi::AFTER_DRAIN) { E.fused(acc, cur, wr, wc, fr, fq, lds, wid, lane); S.done(cur); }
#undef PG8_SA
#undef PG8_SB
#undef PG8_STAGE
#undef PG8_LDA
#undef PG8_LDB
#undef PG8_MMA
#undef PG8_WAIT_V
#undef PG8_WAIT_L
#undef PG8_BAR
#undef PG8_SCHED
}
}

constexpr int NWAVES = 8;
constexpr int D = 1024, NB = 4, SEQ = 4096, CTXL = 256, NLAT = NB * SEQ, NCTX = NB * CTXL, MROWS = NLAT + NCTX;
constexpr int DEPTH = 4, RW = 512, NH = 8, HS = 64, DFF = 3584, NE = 8, NPROJ = 3456, NP = 3584, NLO = 2560, KLA = 512, NMOD = 6144;
constexpr int PC_R = 0, PC_K = 512, PC_V = 1024, PC_CB = 1536, PC_CC = 2048, PC_CH = 2560, PC_WD = 3072, PC_AD = 3200, PC_GD = 3328;
constexpr float LN_EPS = 1e-5f, GN_EPS = 64e-5f, DN_ALPHA = 1.681792830507429f;
enum { I_X = 0, I_C, I_CTX, I_CCTX, I_WMOD, I_BMOD, I_WIN, I_W0, I_W2, I_A0, I_A2, I_KK, I_KA, I_RK, I_G2, I_LNXG, I_LNXB, I_CONVW, I_WOUT, I_LN1G, I_LN1B, I_LN2G, I_LN2B,
       I_FW1, I_FW3, I_FW2, I_RTW, I_RTB, I_MW1, I_MW3, I_MW2, N_IN };

constexpr size_t MiB = 1u << 20;
constexpr size_t WS_CTL = 0, CTL_BYTES = 1 * MiB;
constexpr size_t WS_MODV = 1 * MiB;
constexpr size_t WS_G8 = 2 * MiB;
constexpr size_t WS_RKS = 3 * MiB;
constexpr size_t WS_WIN = 4 * MiB;
constexpr size_t WS_WOUT = WS_WIN + 28 * MiB;
constexpr size_t WS_LORA = WS_WOUT + 8 * MiB;
constexpr size_t WS_F13 = WS_LORA + 10 * MiB;
constexpr size_t WS_F2 = WS_F13 + 28 * MiB;
constexpr size_t WS_X = WS_F2 + 14 * MiB;
constexpr size_t WS_H = WS_X + 68 * MiB;
constexpr size_t WS_MOES = WS_H + 34 * MiB;
constexpr size_t WS_ROWLIST = WS_MOES;
constexpr size_t WS_TOKSEL = WS_MOES + 640 * 1024;
constexpr size_t WS_WSEL = WS_TOKSEL + 320 * 1024;
constexpr size_t WS_WSORT = WS_WSEL + 192 * 1024;
constexpr size_t WS_SCR = WS_MOES + 2 * MiB;
constexpr size_t WS_P = WS_SCR;
constexpr size_t WS_LA = WS_P + 119 * MiB;
constexpr size_t WS_LO = WS_LA + 17 * MiB;
constexpr size_t WS_MIX = WS_LO;
constexpr size_t WS_PREP = WS_LO + 170 * MiB;
constexpr size_t WS_Y = WS_PREP + 238 * MiB;
constexpr size_t WS_MIXIN = WS_Y + 68 * MiB;
constexpr size_t WS_CH = WS_PREP;
constexpr size_t WS_MIXO = WS_PREP;
constexpr size_t WS_END_MIXER = WS_MIXIN + 34 * MiB;
constexpr size_t WS_MOEW13 = WS_SCR;
constexpr size_t WS_MOEW2 = WS_MOEW13 + 112 * MiB;
constexpr size_t WS_HG = WS_MOEW2 + 56 * MiB;
constexpr size_t WS_ACT = WS_HG + 72 * MiB;
constexpr size_t WS_F = WS_ACT + 252 * MiB;
constexpr size_t WS_END_FFN = WS_F + 144 * MiB;
constexpr size_t WS_NEED = WS_END_MIXER > WS_END_FFN ? WS_END_MIXER : WS_END_FFN;
static_assert((size_t)MROWS * NP * 2 <= 119 * MiB && (size_t)MROWS * NLO * 4 <= 170 * MiB && (size_t)MROWS * RW * 4 * 7 <= 238 * MiB && (size_t)MROWS * D * 4 <= 68 * MiB, "ws map");
constexpr int MOE_ROWS = 36864;
constexpr int CW_BAR = 4096, CW_GCNT = 8192;

constexpr int RING_BYTES = 131072, LDSCTL_OFF = RING_BYTES, MISC_OFF = LDSCTL_OFF + 320, LDS_BYTES = 147456;

typedef unsigned short bf16;
typedef unsigned v4u __attribute__((ext_vector_type(4)));
typedef unsigned v2u __attribute__((ext_vector_type(2)));
typedef float f32x4 __attribute__((ext_vector_type(4)));
#define LAS __attribute__((address_space(3)))
#define LDS_WAIT() asm volatile("s_waitcnt lgkmcnt(0)" ::: "memory")
__device__ __forceinline__ unsigned f2bf(float f) { unsigned u = __builtin_bit_cast(unsigned, f); return (u + 0x7fffu + ((u >> 16) & 1u)) >> 16; }
__device__ __forceinline__ unsigned pk2(float lo, float hi) { return f2bf(lo) | (f2bf(hi) << 16); }
__device__ __forceinline__ float bf2f(unsigned short b) { return __builtin_bit_cast(float, ((unsigned)b) << 16); }
__device__ __forceinline__ float bflo(unsigned w) { return __builtin_bit_cast(float, w << 16); }
__device__ __forceinline__ float bfhi(unsigned w) { return __builtin_bit_cast(float, w & 0xffff0000u); }
__device__ __forceinline__ float wave_sum(float v) {
#pragma unroll
    for (int o = 1; o < 64; o <<= 1) v += __shfl_xor(v, o);
    return v;
}
__device__ __forceinline__ float sigm(float x) { return 1.f / (1.f + __expf(-x)); }

#define XB_TMO      128
#define XB_XCNT(j)  (256  + 64 * (j))
#define XB_XSUB(j)  (1280 + 64 * (j))
#define XB_XGEN(j)  (2304 + 64 * (j))
#define XB_TOP      3328
#define XB_TOPGEN   3392
#define XCD_BAR_WORDS 3456
#define XB_SPIN_CAP (1u << 18)

__device__ __forceinline__ unsigned xb_ld(unsigned* p)              { return __hip_atomic_load(p, __ATOMIC_RELAXED, __HIP_MEMORY_SCOPE_AGENT); }
__device__ __forceinline__ unsigned xb_add(unsigned* p, unsigned v) { return __hip_atomic_fetch_add(p, v, __ATOMIC_RELAXED, __HIP_MEMORY_SCOPE_AGENT); }
__device__ __forceinline__ unsigned xb_xcc_id() { return (unsigned)__builtin_amdgcn_s_getreg((3 << 11) | 20) & 0xFu; }
#define XB_SPIN(cond, bar) do { unsigned _sp = 0; while (cond) { __builtin_amdgcn_s_sleep(1); \
    if ((++_sp & 255u) == 0u) { if (xb_ld(&(bar)[XB_TMO])) break; if (_sp > XB_SPIN_CAP) { atomicAdd(&(bar)[XB_TMO], 1u); break; } } } } while (0)

struct XcdBarrier {
    unsigned* bar; unsigned x;
    volatile LAS unsigned* st;
};

__device__ __forceinline__ XcdBarrier xcd_barrier_post(unsigned* bar, volatile LAS unsigned* st) {
    XcdBarrier b; b.bar = bar; b.x = xb_xcc_id(); b.st = st;
    if (threadIdx.x == 0) (void)xb_add(&bar[XB_XCNT(b.x)], 1u);
    return b;
}
__device__ __forceinline__ void xcd_barrier_complete(unsigned* bar, unsigned x, unsigned& nloc, unsigned& nx) {
    const unsigned G = gridDim.x * gridDim.y * gridDim.z;
    unsigned sum, cnt, mine, sp = 0u;
    for (;;) {
        sum = 0u; cnt = 0u; mine = 0u;
#pragma unroll
        for (unsigned j = 0; j < 16; ++j) { const unsigned c = xb_ld(&bar[XB_XCNT(j)]); sum += c; cnt += (c > 0u) ? 1u : 0u; mine = (j == x) ? c : mine; }
        if (sum == G) break;
        __builtin_amdgcn_s_sleep(1);
        if ((++sp & 255u) == 0u) { if (xb_ld(&bar[XB_TMO])) break; if (sp > XB_SPIN_CAP) { atomicAdd(&bar[XB_TMO], 1u); break; } }
    }
    nloc = mine > 0u ? mine : 1u; nx = cnt > 0u ? cnt : 1u;
}

__device__ __forceinline__ void xcd_barrier(const XcdBarrier& b) {
    asm volatile("s_waitcnt vmcnt(0)" ::: "memory");
    __syncthreads();
    if (threadIdx.x == 0) {
        unsigned* bar = b.bar;
        __builtin_amdgcn_s_waitcnt(0);
        unsigned nloc = b.st[0], nx = b.st[1];
        if (nloc == 0u) { xcd_barrier_complete(bar, b.x, nloc, nx); b.st[0] = nloc; b.st[1] = nx; }
        const unsigned old = xb_add(&bar[XB_XSUB(b.x)], 1u);
        const unsigned gen = old / nloc;
        if (old + 1u == (gen + 1u) * nloc) {
            __builtin_amdgcn_fence(__ATOMIC_RELEASE, "agent");
            asm volatile("s_waitcnt vmcnt(0)" ::: "memory");
            const unsigned og = xb_add(&bar[XB_TOP], 1u);
            const unsigned tg = og / nx;
            if (og + 1u == (tg + 1u) * nx) xb_add(&bar[XB_TOPGEN], 1u);
            else XB_SPIN(xb_ld(&bar[XB_TOPGEN]) == tg, bar);
            __builtin_amdgcn_fence(__ATOMIC_ACQUIRE, "agent");
            xb_add(&bar[XB_XGEN(b.x)], 1u);
            asm volatile("s_waitcnt vmcnt(0)" ::: "memory");
        } else {
            XB_SPIN(xb_ld(&bar[XB_XGEN(b.x)]) == gen, bar);
            __builtin_amdgcn_fence(__ATOMIC_ACQUIRE, "agent");
            asm volatile("s_waitcnt vmcnt(0)" ::: "memory");
        }
    }
    __syncthreads();
}


struct KP { const float* in[N_IN]; float* out; unsigned char* ws; int ph; int pad; };

template <int MODE> __device__ __forceinline__ int rowmap(int n, int arg) {
    if (MODE == 0) return n + arg;
    if (MODE == 1) { if (n < 1536) return n; if (n < 1664) return n - 1536 + PC_WD; if (n < 1792) return n - 1664 + PC_AD; if (n < 1920) return n - 1792 + PC_GD;
                     if (n < 2432) return n - 1920 + PC_CB; if (n < 2944) return n - 2432 + PC_CC; return n - 2944 + PC_CH; }
    return 8 * (n >> 2) + 4 * arg + (n & 3);
}
template <int MODE> __device__ __forceinline__ void transpose_item(const float* W, int K, int N, bf16* WT, int arg, LAS float* scr, int item, int lane) {
    const int nblk = N / 32, kb = item / nblk, nb = item % nblk, k0 = 64 * kb, n0 = 32 * nb;
#pragma unroll 8
    for (int i = 0; i < 32; ++i) { const int kk = 2 * i + (lane >> 5); scr[kk * 33 + (lane & 31)] = W[(size_t)(k0 + kk) * N + n0 + (lane & 31)]; }
    LDS_WAIT(); asm volatile("" ::: "memory");
    const int c = lane & 7;
#pragma unroll
    for (int j = 0; j < 4; ++j) { const int n = (lane >> 3) + 8 * j; const LAS float* s = scr + (8 * c) * 33 + n;
        v4u o; o.x = pk2(s[0 * 33], s[1 * 33]); o.y = pk2(s[2 * 33], s[3 * 33]); o.z = pk2(s[4 * 33], s[5 * 33]); o.w = pk2(s[6 * 33], s[7 * 33]);
        *(v4u*)(WT + (size_t)rowmap<MODE>(n0 + n, arg) * K + k0 + 8 * c) = o; }
    LDS_WAIT(); asm volatile("" ::: "memory");
}

__device__ __forceinline__ void ph_modvec(const KP& p, LAS unsigned char* lds, int tid) {
    LAS float* sil = (LAS float*)lds;
    LAS float* red = (LAS float*)(lds + 5 * 1024 * 4);
    const float* c = p.in[I_C]; const float* cc = p.in[I_CCTX];
    for (int i = tid; i < 5 * 1024; i += 512) { const float v = i < 4096 ? c[i] : cc[i - 4096]; sil[i] = v / (1.f + __expf(-v)); }
    __syncthreads();
    float* modv = (float*)(p.ws + WS_MODV);
    const int ks = tid >> 6, col = tid & 63;
    for (int task = blockIdx.x; task < DEPTH * 96; task += gridDim.x) {
        const int l = task / 96, j0 = (task % 96) * 64;
        const float* w = p.in[I_WMOD] + (size_t)l * D * NMOD + (size_t)(ks * 128) * NMOD + j0 + col;
        float a0 = 0.f, a1 = 0.f, a2 = 0.f, a3 = 0.f, a4 = 0.f;
#pragma unroll 8
        for (int k = 0; k < 128; ++k) { const float wv = w[(size_t)k * NMOD]; const int kk = ks * 128 + k;
            a0 += sil[kk] * wv; a1 += sil[1024 + kk] * wv; a2 += sil[2048 + kk] * wv; a3 += sil[3072 + kk] * wv; a4 += sil[4096 + kk] * wv; }
        red[(ks * 5 + 0) * 64 + col] = a0; red[(ks * 5 + 1) * 64 + col] = a1; red[(ks * 5 + 2) * 64 + col] = a2; red[(ks * 5 + 3) * 64 + col] = a3; red[(ks * 5 + 4) * 64 + col] = a4;
        __syncthreads();
        if (tid < 320) { const int r = tid >> 6; float s = 0.f;
#pragma unroll
            for (int q = 0; q < 8; ++q) s += red[(q * 5 + r) * 64 + col];
            modv[(size_t)(l * 5 + r) * NMOD + j0 + col] = s + p.in[I_BMOD][l * NMOD + j0 + col]; }
        __syncthreads();
    }
}

__device__ __forceinline__ void ph_convert(const KP& p, LAS unsigned char* lds, int gw, int NGW, int wave, int lane) {
    LAS float* scr = (LAS float*)(lds + wave * 16384);
    bf16* win = (bf16*)(p.ws + WS_WIN); bf16* wout = (bf16*)(p.ws + WS_WOUT); bf16* f13 = (bf16*)(p.ws + WS_F13); bf16* f2 = (bf16*)(p.ws + WS_F2); bf16* lora = (bf16*)(p.ws + WS_LORA);
    constexpr int I_IN = (D / 64) * (NPROJ / 32), I_OUT = (D / 64) * (D / 32), I_UP = (D / 64) * (DFF / 32), I_DN = (DFF / 64) * (D / 32);
    constexpr int T_IN = DEPTH * I_IN, T_OUT = DEPTH * I_OUT, T_UP = 2 * I_UP, T_DN = 2 * I_DN, NITEMS = T_IN + T_OUT + 2 * T_UP + T_DN;
    for (int it = gw; it < NITEMS; it += NGW) {
        int r = it;
        if (r < T_IN) { const int l = r / I_IN; transpose_item<1>(p.in[I_WIN] + (size_t)l * D * NPROJ, D, NPROJ, win + (size_t)l * NP * D, 0, scr, r % I_IN, lane); continue; } r -= T_IN;
        if (r < T_OUT) { const int l = r / I_OUT; transpose_item<0>(p.in[I_WOUT] + (size_t)l * D * D, D, D, wout + (size_t)l * D * D, 0, scr, r % I_OUT, lane); continue; } r -= T_OUT;
        if (r < T_UP) { const int l = r / I_UP; transpose_item<2>(p.in[I_FW1] + (size_t)l * D * DFF, D, DFF, f13 + (size_t)l * 2 * DFF * D, 0, scr, r % I_UP, lane); continue; } r -= T_UP;
        if (r < T_UP) { const int l = r / I_UP; transpose_item<2>(p.in[I_FW3] + (size_t)l * D * DFF, D, DFF, f13 + (size_t)l * 2 * DFF * D, 1, scr, r % I_UP, lane); continue; } r -= T_UP;
        { const int l = r / I_DN; transpose_item<0>(p.in[I_FW2] + (size_t)l * DFF * D, DFF, D, f2 + (size_t)l * D * DFF, 0, scr, r % I_DN, lane); }
    }
    { const int gt = gw * 64 + lane, NGT = NGW * 64; constexpr int PER = (NP - NPROJ) * D / 8;
      for (int i = gt; i < DEPTH * PER; i += NGT) { const int l = i / PER, q = i % PER; *(v4u*)(win + (size_t)l * NP * D + (size_t)NPROJ * D + (size_t)q * 8) = (v4u){0u, 0u, 0u, 0u}; } }
    { const int gt = gw * 64 + lane, NGT = NGW * 64; constexpr int PER = NLO * KLA / 8;
      for (int i = gt; i < DEPTH * PER; i += NGT) { const int l = i / PER, q = i % PER, n = q / (KLA / 8), k0 = (q % (KLA / 8)) * 8; float v[8];
#pragma unroll
          for (int j = 0; j < 8; ++j) { const int k = k0 + j; float x = 0.f;
              if (n < 1024) { const int d = n >> 9, c = n & 511; if (k >= 64 * d && k < 64 * d + 64) x = p.in[I_W2][((size_t)(l * 2 + d) * 64 + (k - 64 * d)) * RW + c]; }
              else if (n < 2048) { const int d = (n - 1024) >> 9, c = n & 511; if (k >= 128 + 64 * d && k < 192 + 64 * d) x = p.in[I_A2][((size_t)(l * 2 + d) * 64 + (k - 128 - 64 * d)) * RW + c]; }
              else { const int c = n - 2048; if (k >= 256 && k < 384) x = p.in[I_G2][((size_t)l * 128 + (k - 256)) * RW + c]; }
              v[j] = x; }
          v4u o; o.x = pk2(v[0], v[1]); o.y = pk2(v[2], v[3]); o.z = pk2(v[4], v[5]); o.w = pk2(v[6], v[7]);
          *(v4u*)(lora + (size_t)l * NLO * KLA + (size_t)n * KLA + k0) = o; } }
}
__device__ __forceinline__ void ph_convert_moe(const KP& p, LAS unsigned char* lds, int mi, int gw, int NGW, int wave, int lane) {
    LAS float* scr = (LAS float*)(lds + wave * 16384);
    bf16* w13 = (bf16*)(p.ws + WS_MOEW13); bf16* w2 = (bf16*)(p.ws + WS_MOEW2);
    constexpr int I_UP = (D / 64) * (DFF / 32), I_DN = (DFF / 64) * (D / 32), T_UP = NE * I_UP, T_DN = NE * I_DN;
    for (int it = gw; it < 2 * T_UP + T_DN; it += NGW) {
        int r = it;
        if (r < T_UP) { const int e = r / I_UP; transpose_item<2>(p.in[I_MW1] + ((size_t)mi * NE + e) * D * DFF, D, DFF, w13 + (size_t)e * 2 * DFF * D, 0, scr, r % I_UP, lane); continue; } r -= T_UP;
        if (r < T_UP) { const int e = r / I_UP; transpose_item<2>(p.in[I_MW3] + ((size_t)mi * NE + e) * D * DFF, D, DFF, w13 + (size_t)e * 2 * DFF * D, 1, scr, r % I_UP, lane); continue; } r -= T_UP;
        { const int e = r / I_DN; transpose_item<0>(p.in[I_MW2] + ((size_t)mi * NE + e) * DFF * D, DFF, D, w2 + (size_t)e * D * DFF, 0, scr, r % I_DN, lane); }
    }
}

__device__ __forceinline__ void ld_row(const float* r, int lane, f32x4 (&v)[4]) { const f32x4* q = (const f32x4*)r + lane;
#pragma unroll
    for (int j = 0; j < 4; ++j) v[j] = q[64 * j]; }
__device__ __forceinline__ void st_row(float* r, int lane, const f32x4 (&v)[4]) { f32x4* q = (f32x4*)r + lane;
#pragma unroll
    for (int j = 0; j < 4; ++j) q[64 * j] = v[j]; }
__device__ __forceinline__ void st_row_bf16(bf16* r, int lane, const f32x4 (&v)[4]) { v2u* q = (v2u*)r + lane;
#pragma unroll
    for (int j = 0; j < 4; ++j) { v2u w; w.x = pk2(v[j][0], v[j][1]); w.y = pk2(v[j][2], v[j][3]); q[64 * j] = w; } }
__device__ __forceinline__ int mod_row(int row) { return row < NLAT ? (row >> 12) : 4; }

__device__ __forceinline__ void ph_init_rows(const KP& p, int gw, int NGW, int lane) {
    const float* modv = (const float*)(p.ws + WS_MODV); float* X = (float*)(p.ws + WS_X); bf16* H = (bf16*)(p.ws + WS_H);
    for (int row = gw; row < MROWS; row += NGW) {
        const float* src = row < NLAT ? p.in[I_X] + (size_t)row * D : p.in[I_CTX] + (size_t)(row - NLAT) * D;
        const float* mv = modv + (size_t)(0 * 5 + mod_row(row)) * NMOD;
        f32x4 x[4], sh[4], sc[4], h[4]; ld_row(src, lane, x); ld_row(mv, lane, sh); ld_row(mv + 1024, lane, sc);
#pragma unroll
        for (int j = 0; j < 4; ++j) h[j] = x[j] * (1.f + sc[j]) + sh[j];
        st_row(X + (size_t)row * D, lane, x); st_row_bf16(H + (size_t)row * D, lane, h);
    }
}

__device__ __forceinline__ void ph_lora_in(const KP& p, int gw, int NGW, int lane) {
    const bf16* P = (const bf16*)(p.ws + WS_P); bf16* LA = (bf16*)(p.ws + WS_LA);
    const int gt = gw * 64 + lane, NGT = NGW * 64;
    for (int i = gt; i < MROWS * (KLA / 8); i += NGT) { const int row = i >> 6, k0 = (i & 63) * 8; v4u o = (v4u){0u, 0u, 0u, 0u};
        if (k0 < 384) { const v4u s = *(const v4u*)(P + (size_t)row * NP + PC_WD + k0); float v[8] = {bflo(s.x), bfhi(s.x), bflo(s.y), bfhi(s.y), bflo(s.z), bfhi(s.z), bflo(s.w), bfhi(s.w)};
            if (k0 < 128) {
#pragma unroll
                for (int j = 0; j < 8; ++j) v[j] = tanhf(v[j]); }
            else if (k0 >= 256) {
#pragma unroll
                for (int j = 0; j < 8; ++j) v[j] = sigm(v[j]); }
            o.x = pk2(v[0], v[1]); o.y = pk2(v[2], v[3]); o.z = pk2(v[4], v[5]); o.w = pk2(v[6], v[7]); }
        *(v4u*)(LA + (size_t)row * KLA + k0) = o; }
}

__device__ __forceinline__ void ph_prep(const KP& p, int l, int gw, int NGW, int lane) {
    const bf16* P = (const bf16*)(p.ws + WS_P); const float* LO = (const float*)(p.ws + WS_LO); float* PR = (float*)(p.ws + WS_PREP); float* RKS = (float*)(p.ws + WS_RKS);
    constexpr size_t PA = (size_t)MROWS * RW;
    for (int it = gw; it < MROWS * NH; it += NGW) { const int row = it >> 3, h = it & 7, c = h * 64 + lane;
        const float kv = bf2f(P[(size_t)row * NP + PC_K + c]), rv = bf2f(P[(size_t)row * NP + PC_R + c]);
        const float* lo = LO + (size_t)row * NLO;
        float dec[2], a[2];
#pragma unroll
        for (int d = 0; d < 2; ++d) {
            const float wl = p.in[I_W0][(l * 2 + d) * RW + c] + lo[d * RW + c];
            const float z = -wl, sp = z > 20.f ? z : log1pf(expf(z));
            const float w_log = -sp - 0.5f; dec[d] = expf(-expf(w_log));
            a[d] = sigm(p.in[I_A0][(l * 2 + d) * RW + c] + lo[1024 + d * RW + c]);
        }
        float kk = kv * p.in[I_KK][l * RW + c]; const float ss = wave_sum(kk * kk); kk = kk / fmaxf(sqrtf(ss), 1e-12f);
        const float ka = p.in[I_KA][l * RW + c];
        const float kd0 = kv * (1.f + (a[0] - 1.f) * ka), kd1 = kv * (1.f + (a[1] - 1.f) * ka);
        const float rk = wave_sum(rv * (kd0 + kd1) * p.in[I_RK][(l * NH + h) * HS + lane]);
        const size_t o = (size_t)row * RW + c;
        PR[0 * PA + o] = dec[0]; PR[1 * PA + o] = dec[1]; PR[2 * PA + o] = kd0; PR[3 * PA + o] = kd1; PR[4 * PA + o] = kk * a[0]; PR[5 * PA + o] = kk * a[1]; PR[6 * PA + o] = kk;
        if (lane == 0) RKS[row * 8 + h] = rk;
    }
}

__device__ __forceinline__ int scan_row(int b, int dir, int step) { return step < CTXL ? NLAT + b * CTXL + (dir ? CTXL - 1 - step : step) : b * SEQ + (dir ? SEQ - 1 - (step - CTXL) : step - CTXL); }
__device__ __forceinline__ void ph_scan(const KP& p, int wave, int lane) {
    if (wave >= 4) return;
    const bf16* P = (const bf16*)(p.ws + WS_P); const float* PR = (const float*)(p.ws + WS_PREP); float* Y = (float*)(p.ws + WS_Y);
    constexpr size_t PA = (size_t)MROWS * RW; constexpr int NSTEP = CTXL + SEQ;
    for (int wt = blockIdx.x * 4 + wave; wt < 1024; wt += gridDim.x * 4) {
        const int rg = wt & 15, h = (wt >> 4) & 7, b = (wt >> 7) & 3, dir = wt >> 9;
        const int rr = lane >> 4, q = lane & 15, vrow = rg * 4 + rr, ch0 = h * 64 + q * 4;
        const float* Wd = PR + (size_t)dir * PA + ch0; const float* Kd = PR + (size_t)(2 + dir) * PA + ch0; const float* Bd = PR + (size_t)(4 + dir) * PA + ch0; const float* KKp = PR + 6 * PA + ch0;
        float* Yo = Y + (size_t)dir * PA + h * 64 + vrow;
        f32x4 s = (f32x4){0.f, 0.f, 0.f, 0.f};
        f32x4 bw[4], bk[4], bb[4], bq[4]; v2u br[4]; float bv[4];
#pragma unroll
        for (int u = 0; u < 4; ++u) { const size_t ro = (size_t)scan_row(b, dir, u) * RW; const size_t rp = (size_t)scan_row(b, dir, u) * NP;
            bw[u] = *(const f32x4*)(Wd + ro); bk[u] = *(const f32x4*)(Kd + ro); bb[u] = *(const f32x4*)(Bd + ro); bq[u] = *(const f32x4*)(KKp + ro);
            br[u] = *(const v2u*)(P + rp + PC_R + ch0); bv[u] = bf2f(P[rp + PC_V + h * 64 + vrow]); }
        for (int st = 0; st < NSTEP; st += 4) {
#pragma unroll
            for (int u = 0; u < 4; ++u) {
                const f32x4 w = bw[u], kd = bk[u], bvec = bb[u], kk = bq[u]; const v2u rw = br[u]; const float vv = bv[u];
                const int cur = scan_row(b, dir, st + u);
                { const int nstep = st + u + 4 < NSTEP ? st + u + 4 : NSTEP - 1; const int nrow = scan_row(b, dir, nstep); const size_t ro = (size_t)nrow * RW, rp = (size_t)nrow * NP;
                  bw[u] = *(const f32x4*)(Wd + ro); bk[u] = *(const f32x4*)(Kd + ro); bb[u] = *(const f32x4*)(Bd + ro); bq[u] = *(const f32x4*)(KKp + ro);
                  br[u] = *(const v2u*)(P + rp + PC_R + ch0); bv[u] = bf2f(P[rp + PC_V + h * 64 + vrow]); }
                float sa = -((s[0] * kk[0] + s[1] * kk[1]) + (s[2] * kk[2] + s[3] * kk[3]));
                sa += __shfl_xor(sa, 1); sa += __shfl_xor(sa, 2); sa += __shfl_xor(sa, 4); sa += __shfl_xor(sa, 8);
                s = s * w + sa * bvec + vv * kd;
                float y = (s[0] * bflo(rw.x) + s[1] * bfhi(rw.x)) + (s[2] * bflo(rw.y) + s[3] * bfhi(rw.y));
                y += __shfl_xor(y, 1); y += __shfl_xor(y, 2); y += __shfl_xor(y, 4); y += __shfl_xor(y, 8);
                if (q == 0) Yo[(size_t)cur * RW] = y;
            }
        }
    }
}


typedef short sbf16x8 __attribute__((ext_vector_type(8)));
typedef float f32x16 __attribute__((ext_vector_type(16)));
constexpr int SC_C = 32, SC_NCH = (CTXL + SEQ) / SC_C  , SC_NCHAIN = NB * NH * 2  , SC_NTASK = SC_NCH * SC_NCHAIN  ;
constexpr int CH_G = 0, CH_Q = 8192, CH_UT = 12288, CH_YL = 20480, CH_EC = 24576, CH_BYTES = 25600, CH_NLOAD = 26;

__device__ __forceinline__ f32x16 mm(v4u a, v4u b, f32x16 c) { return __builtin_amdgcn_mfma_f32_32x32x16_bf16(__builtin_bit_cast(sbf16x8, a), __builtin_bit_cast(sbf16x8, b), c, 0, 0, 0); }
typedef float f32x2c __attribute__((ext_vector_type(2))); typedef __bf16 bf16x2c __attribute__((ext_vector_type(2)));
__device__ __forceinline__ unsigned cvtpk(float lo, float hi) { return __builtin_bit_cast(unsigned, __builtin_convertvector((f32x2c){lo, hi}, bf16x2c)); }
template <int S, int NEG> __device__ __forceinline__ v4u cvtf(const f32x16& x) {
    v4u w; const float sg = NEG ? -1.f : 1.f;
    w.x = cvtpk(sg * x[8 * S + 0], sg * x[8 * S + 1]); w.y = cvtpk(sg * x[8 * S + 2], sg * x[8 * S + 3]); w.z = cvtpk(sg * x[8 * S + 4], sg * x[8 * S + 5]); w.w = cvtpk(sg * x[8 * S + 6], sg * x[8 * S + 7]); return w; }
template <int MODE  > __device__ __forceinline__ f32x16 mask_acc(f32x16 x, int n, int hh) {
#pragma unroll
    for (int r = 0; r < 16; ++r) { const int m = (r & 3) + 8 * (r >> 2) + 4 * hh; const bool keep = MODE == 0 ? (m > n) : MODE == 1 ? (m < n) : (m <= n); x[r] = keep ? x[r] : 0.f; }
    return x; }
__device__ __forceinline__ f32x16 zero16() { f32x16 z;
#pragma unroll
    for (int r = 0; r < 16; ++r) z[r] = 0.f;
    return z; }
__device__ __forceinline__ void cm_build(const unsigned (&w)[16], v4u (&f)[2][2]) {
#pragma unroll
    for (int s = 0; s < 2; ++s) {
        const auto r0 = __builtin_amdgcn_permlane32_swap(w[8 * s + 0], w[8 * s + 2], false, false), r1 = __builtin_amdgcn_permlane32_swap(w[8 * s + 1], w[8 * s + 3], false, false);
        const auto r2 = __builtin_amdgcn_permlane32_swap(w[8 * s + 4], w[8 * s + 6], false, false), r3 = __builtin_amdgcn_permlane32_swap(w[8 * s + 5], w[8 * s + 7], false, false);
        f[0][s] = (v4u){r0[0], r1[0], r2[0], r3[0]}; f[1][s] = (v4u){r0[1], r1[1], r2[1], r3[1]}; }
}
__device__ __forceinline__ void st16(unsigned char* base, int off, int lane, v4u v) { *(v4u*)(base + off + lane * 16) = v; }

__device__ __forceinline__ void ph_kknorm(const KP& p, int l, int gw, int NGW, int lane) {
    const bf16* P = (const bf16*)(p.ws + WS_P); float* NRM = (float*)(p.ws + WS_RKS);
    for (int it = gw; it < MROWS * NH; it += NGW) { const int row = it >> 3, h = it & 7, c = h * 64 + lane;
        const float kk = bf2f(P[(size_t)row * NP + PC_K + c]) * p.in[I_KK][l * RW + c]; const float ss = wave_sum(kk * kk);
        if (lane == 0) NRM[it] = 1.f / fmaxf(sqrtf(ss), 1e-12f); }
}

__device__ __forceinline__ void ph_scan1(const KP& p, int l, int gw, int NGW, int lane) {
    const bf16* P = (const bf16*)(p.ws + WS_P); const float* LO = (const float*)(p.ws + WS_LO); const float* NRM = (const float*)(p.ws + WS_RKS); unsigned char* CH = p.ws + WS_CH;
    const int n = lane & 31, hh = lane >> 5;
    v4u Id[2];
#pragma unroll
    for (int s = 0; s < 2; ++s) { unsigned wd[4];
#pragma unroll
        for (int q = 0; q < 4; ++q) { const int j0 = 2 * q, j1 = 2 * q + 1; const int t0 = 16 * s + 8 * (j0 >> 2) + 4 * hh + (j0 & 3), t1 = 16 * s + 8 * (j1 >> 2) + 4 * hh + (j1 & 3);
            wd[q] = (t0 == n ? 0x3F80u : 0u) | (t1 == n ? 0x3F800000u : 0u); }
        Id[s] = (v4u){wd[0], wd[1], wd[2], wd[3]}; }
    for (int task = gw; task < SC_NTASK; task += NGW) {
        const int dir = task & 1, h = (task >> 1) & 7, b = (task >> 4) & 3, ci = task >> 6;
        const int row0 = scan_row(b, dir, SC_C * ci), sgn = dir ? -1 : 1, c = h * 64 + lane;
        const float w0c = p.in[I_W0][(l * 2 + dir) * RW + c], a0c = p.in[I_A0][(l * 2 + dir) * RW + c], kkc = p.in[I_KK][l * RW + c], kac = p.in[I_KA][l * RW + c];
        unsigned wAl[16], wBe[16], wKa[16], wRh[16], wV[16], wBp[16], wKp[16];
        float cs = 0.f, Eprev = 1.f;
#pragma unroll
        for (int pz = 0; pz < 16; ++pz) { float al[2], be[2], ka[2], rh[2], vv[2];
#pragma unroll
            for (int e = 0; e < 2; ++e) { const int row = row0 + sgn * (2 * pz + e); const bf16* pr = P + (size_t)row * NP; const float* lo = LO + (size_t)row * NLO;
                const float kv = bf2f(pr[PC_K + c]), rv = bf2f(pr[PC_R + c]); vv[e] = bf2f(pr[PC_V + c]);
                const float wl = w0c + lo[dir * RW + c], aa = 1.f / (1.f + __expf(-(a0c + lo[1024 + dir * RW + c]))), nrm = NRM[row * 8 + h];
                const float lw = -0.6065306597f / (1.f + __expf(-wl));
                cs += lw; const float E = __expf(cs), Ei = 1.f / E;
                const float kkn = kv * kkc * nrm, kd = kv * (1.f + (aa - 1.f) * kac);
                al[e] = kkn * Eprev; be[e] = kkn * aa * Ei; ka[e] = kd * Ei; rh[e] = rv * E; Eprev = E; }
            wAl[pz] = cvtpk(al[0], al[1]); wBe[pz] = cvtpk(be[0], be[1]); wKa[pz] = cvtpk(ka[0], ka[1]); wRh[pz] = cvtpk(rh[0], rh[1]); wV[pz] = cvtpk(vv[0], vv[1]); }
        const float EC = Eprev;
#pragma unroll
        for (int pz = 0; pz < 16; ++pz) { wBp[pz] = cvtpk(bflo(wBe[pz]) * EC, bfhi(wBe[pz]) * EC); wKp[pz] = cvtpk(bflo(wKa[pz]) * EC, bfhi(wKa[pz]) * EC); }
        unsigned char* img = CH + (size_t)(((b * 8 + h) * 2 + dir) * SC_NCH + ci) * CH_BYTES;
        ((float*)(img + CH_EC))[lane] = EC;
        v4u cAl[2][2], cV[2][2], cBp[2][2], cKp[2][2], cRh[2][2];
        v4u tAl[4], tBe[4], tKa[4], tRh[4];
        cm_build(wAl, cAl); cm_build(wV, cV); cm_build(wBp, cBp); cm_build(wKp, cKp); cm_build(wRh, cRh);
        {   v4u cBe[2][2], cKa[2][2]; cm_build(wBe, cBe); cm_build(wKa, cKa);
#define TRANSPOSE(cZ, tZ) do { _Pragma("unroll") for (int ct = 0; ct < 2; ++ct) { f32x16 T_ = mm(cZ[ct][0], Id[0], zero16()); T_ = mm(cZ[ct][1], Id[1], T_); tZ[2 * ct] = cvtf<0, 0>(T_); tZ[2 * ct + 1] = cvtf<1, 0>(T_); } } while (0)
            TRANSPOSE(cAl, tAl); TRANSPOSE(cBe, tBe); TRANSPOSE(cKa, tKa); TRANSPOSE(cRh, tRh);
#undef TRANSPOSE
        }
#define PROD4(A, B) mm(A[3], B[3], mm(A[2], B[2], mm(A[1], B[1], mm(A[0], B[0], zero16()))))
        f32x16 XN = mask_acc<0>(PROD4(tAl, tBe), n, hh), XT = mask_acc<1>(PROD4(tBe, tAl), n, hh);
        v4u fLM[2], fGB[2], fGK[2];
        { const f32x16 t = mask_acc<1>(PROD4(tKa, tAl), n, hh); fLM[0] = cvtf<0, 0>(t); fLM[1] = cvtf<1, 0>(t); }
        { const f32x16 t = mask_acc<2>(PROD4(tBe, tRh), n, hh); fGB[0] = cvtf<0, 0>(t); fGB[1] = cvtf<1, 0>(t); }
        { const f32x16 t = mask_acc<2>(PROD4(tKa, tRh), n, hh); fGK[0] = cvtf<0, 0>(t); fGK[1] = cvtf<1, 0>(t); }
#undef PROD4
#pragma unroll
        for (int r = 0; r < 16; ++r) { XN[r] = -XN[r]; XT[r] = -XT[r]; }
        f32x16 RT = XT;
#pragma unroll
        for (int r = 0; r < 16; ++r) RT[r] += ((r & 3) + 8 * (r >> 2) + 4 * hh == n) ? 1.f : 0.f;
#pragma unroll
        for (int pw = 1; pw < 5; ++pw) {
            const v4u xn0 = cvtf<0, 0>(XN), xn1 = cvtf<1, 0>(XN), xt0 = cvtf<0, 0>(XT), xt1 = cvtf<1, 0>(XT);
            XN = mm(xt1, xn1, mm(xt0, xn0, zero16()));
            if (pw < 4) XT = mm(xn1, xt1, mm(xn0, xt0, zero16()));
            const v4u yn0 = cvtf<0, 0>(XN), yn1 = cvtf<1, 0>(XN), rt0 = cvtf<0, 0>(RT), rt1 = cvtf<1, 0>(RT);
            RT = mm(yn1, rt1, mm(yn0, rt0, RT));
        }
        const v4u fA0 = cvtf<0, 0>(RT), fA1 = cvtf<1, 0>(RT);
        f32x16 At[2], Vt[2];
#pragma unroll
        for (int t = 0; t < 2; ++t) {
            const f32x16 lmv = mm(fLM[1], cV[t][1], mm(fLM[0], cV[t][0], zero16()));
            At[t] = mm(fA1, cAl[t][1], mm(fA0, cAl[t][0], zero16()));
            Vt[t] = mm(fA1, cvtf<1, 0>(lmv), mm(fA0, cvtf<0, 0>(lmv), zero16()));
        }
#pragma unroll
        for (int kt1 = 0; kt1 < 2; ++kt1) { const v4u a0 = cvtf<0, 0>(At[kt1]), a1 = cvtf<1, 0>(At[kt1]);
#pragma unroll
            for (int kt2 = 0; kt2 < 2; ++kt2) { const f32x16 g = mm(a1, cBp[kt2][1], mm(a0, cBp[kt2][0], zero16()));
                st16(img, CH_G + ((kt2 * 2 + kt1) * 2 + 0) * 1024, lane, cvtf<0, 1>(g)); st16(img, CH_G + ((kt2 * 2 + kt1) * 2 + 1) * 1024, lane, cvtf<1, 1>(g)); } }
#pragma unroll
        for (int vt = 0; vt < 2; ++vt) { const v4u nv0 = cvtf<0, 1>(Vt[vt]), nv1 = cvtf<1, 1>(Vt[vt]);
#pragma unroll
            for (int kt = 0; kt < 2; ++kt) { f32x16 u = mm(cKp[kt][1], cV[vt][1], mm(cKp[kt][0], cV[vt][0], zero16())); u = mm(cBp[kt][1], nv1, mm(cBp[kt][0], nv0, u));
                st16(img, CH_UT + ((kt * 2 + vt) * 2 + 0) * 1024, lane, cvtf<0, 0>(u)); st16(img, CH_UT + ((kt * 2 + vt) * 2 + 1) * 1024, lane, cvtf<1, 0>(u)); }
            f32x16 y = mm(cV[vt][1], fGK[1], mm(cV[vt][0], fGK[0], zero16())); y = mm(nv1, fGB[1], mm(nv0, fGB[0], y));
            st16(img, CH_YL + (vt * 2 + 0) * 1024, lane, cvtf<0, 0>(y)); st16(img, CH_YL + (vt * 2 + 1) * 1024, lane, cvtf<1, 0>(y)); }
#pragma unroll
        for (int kt = 0; kt < 2; ++kt) { f32x16 q = mm(cRh[kt][1], Id[1], mm(cRh[kt][0], Id[0], zero16()));
            q = mm(cvtf<1, 1>(At[kt]), fGB[1], mm(cvtf<0, 1>(At[kt]), fGB[0], q));
            st16(img, CH_Q + (kt * 2 + 0) * 1024, lane, cvtf<0, 0>(q)); st16(img, CH_Q + (kt * 2 + 1) * 1024, lane, cvtf<1, 0>(q)); }
    }
}

__device__ __forceinline__ void ph_scan2(const KP& p, LAS unsigned char* lds, int wave, int lane) {
    if (wave != 0 || blockIdx.x >= SC_NCHAIN * 2) return;
    const int chain = blockIdx.x >> 1, vt = blockIdx.x & 1, dir = chain & 1, h = (chain >> 1) & 7, b = chain >> 4;
    const int n = lane & 31, hh = lane >> 5;
    const unsigned char* CH = p.ws + WS_CH + (size_t)chain * SC_NCH * CH_BYTES; float* Y = (float*)(p.ws + WS_Y) + (size_t)dir * MROWS * RW + h * 64 + 32 * vt + 4 * hh;
    constexpr int SLOT = CH_NLOAD * 1024;
#define SC2_ISSUE(ci_, slot_) do { const unsigned char* im_ = CH + (size_t)(ci_) * CH_BYTES; LAS unsigned char* sl_ = lds + (slot_) * SLOT; \
        _Pragma("unroll") for (int f = 0; f < 12; ++f) __builtin_amdgcn_global_load_lds((const unsigned*)(im_ + f * 1024 + lane * 16), (LAS unsigned*)(sl_ + f * 1024), 16, 0, 0); \
        _Pragma("unroll") for (int kt = 0; kt < 2; ++kt) _Pragma("unroll") for (int hf = 0; hf < 2; ++hf) \
            __builtin_amdgcn_global_load_lds((const unsigned*)(im_ + CH_UT + ((kt * 2 + vt) * 2 + hf) * 1024 + lane * 16), (LAS unsigned*)(sl_ + (12 + kt * 2 + hf) * 1024), 16, 0, 0); \
        _Pragma("unroll") for (int hf = 0; hf < 2; ++hf) __builtin_amdgcn_global_load_lds((const unsigned*)(im_ + CH_YL + (vt * 2 + hf) * 1024 + lane * 16), (LAS unsigned*)(sl_ + (16 + hf) * 1024), 16, 0, 0); \
        _Pragma("unroll") for (int kt = 0; kt < 2; ++kt) _Pragma("unroll") for (int q = 0; q < 4; ++q) \
            __builtin_amdgcn_global_load_lds((const unsigned*)(im_ + CH_EC + (32 * kt + 8 * q + 4 * hh) * 4), (LAS unsigned*)(sl_ + (18 + kt * 4 + q) * 1024), 16, 0, 0); } while (0)
#define SC2_LD(slot_, piece_) (*(const LAS v4u*)(lds + (slot_) * SLOT + (piece_) * 1024 + lane * 16))
    f32x16 ST[2] = {zero16(), zero16()};
    SC2_ISSUE(0, 0); SC2_ISSUE(1, 1);
    for (int ci = 0; ci < SC_NCH; ++ci) {
        const int slot = ci % 3;
        { const int nx = ci + 2 < SC_NCH ? ci + 2 : SC_NCH - 1; SC2_ISSUE(nx, (ci + 2) % 3); }
        asm volatile("s_waitcnt vmcnt(52)" ::: "memory");
        const v4u s00 = cvtf<0, 0>(ST[0]), s01 = cvtf<1, 0>(ST[0]), s10 = cvtf<0, 0>(ST[1]), s11 = cvtf<1, 0>(ST[1]);
        f32x16 y;
        { const v4u a = SC2_LD(slot, 16), c = SC2_LD(slot, 17);
          y[0] = bflo(a.x); y[1] = bfhi(a.x); y[2] = bflo(a.y); y[3] = bfhi(a.y); y[4] = bflo(a.z); y[5] = bfhi(a.z); y[6] = bflo(a.w); y[7] = bfhi(a.w);
          y[8] = bflo(c.x); y[9] = bfhi(c.x); y[10] = bflo(c.y); y[11] = bfhi(c.y); y[12] = bflo(c.z); y[13] = bfhi(c.z); y[14] = bflo(c.w); y[15] = bfhi(c.w); }
        y = mm(s00, SC2_LD(slot, 8), y); y = mm(s01, SC2_LD(slot, 9), y); y = mm(s10, SC2_LD(slot, 10), y); y = mm(s11, SC2_LD(slot, 11), y);
        { const int row = scan_row(b, dir, SC_C * ci + n); float* yo = Y + (size_t)row * RW;
#pragma unroll
          for (int q = 0; q < 4; ++q) *(f32x4*)(yo + 8 * q) = (f32x4){y[4 * q], y[4 * q + 1], y[4 * q + 2], y[4 * q + 3]}; }
#pragma unroll
        for (int kt2 = 0; kt2 < 2; ++kt2) { f32x16 a;
            const v4u u0 = SC2_LD(slot, 12 + kt2 * 2), u1 = SC2_LD(slot, 13 + kt2 * 2);
            a[0] = bflo(u0.x); a[1] = bfhi(u0.x); a[2] = bflo(u0.y); a[3] = bfhi(u0.y); a[4] = bflo(u0.z); a[5] = bfhi(u0.z); a[6] = bflo(u0.w); a[7] = bfhi(u0.w);
            a[8] = bflo(u1.x); a[9] = bfhi(u1.x); a[10] = bflo(u1.y); a[11] = bfhi(u1.y); a[12] = bflo(u1.z); a[13] = bfhi(u1.z); a[14] = bflo(u1.w); a[15] = bfhi(u1.w);
#pragma unroll
            for (int q = 0; q < 4; ++q) { const f32x4 ec = __builtin_bit_cast(f32x4, SC2_LD(slot, 18 + kt2 * 4 + q));
#pragma unroll
                for (int e = 0; e < 4; ++e) a[4 * q + e] += ST[kt2][4 * q + e] * ec[e]; }
            a = mm(SC2_LD(slot, (kt2 * 2 + 0) * 2 + 0), s00, a); a = mm(SC2_LD(slot, (kt2 * 2 + 0) * 2 + 1), s01, a);
            a = mm(SC2_LD(slot, (kt2 * 2 + 1) * 2 + 0), s10, a); a = mm(SC2_LD(slot, (kt2 * 2 + 1) * 2 + 1), s11, a);
            ST[kt2] = a; }
        asm volatile("s_waitcnt lgkmcnt(0)" ::: "memory");
    }
    asm volatile("s_waitcnt vmcnt(0)" ::: "memory");
#undef SC2_ISSUE
#undef SC2_LD
}

__device__ __forceinline__ void ph_readout(const KP& p, int l, int gw, int NGW, int lane) {
    const bf16* P = (const bf16*)(p.ws + WS_P); const float* LO = (const float*)(p.ws + WS_LO); const float* Y = (const float*)(p.ws + WS_Y);
    bf16* MI = (bf16*)(p.ws + WS_MIXIN); constexpr size_t PA = (size_t)MROWS * RW;
    for (int it = gw; it < MROWS * NH; it += NGW) { const int row = it >> 3, h = it & 7, c = h * 64 + lane;
        const float y = Y[(size_t)row * RW + c] + Y[PA + (size_t)row * RW + c];
        const float mu = wave_sum(y) * (1.f / 64.f), dv = y - mu, var = wave_sum(dv * dv) * (1.f / 64.f);
        const float yn = dv / sqrtf(var + GN_EPS);
        const bf16* pr = P + (size_t)row * NP;
        const float v = bf2f(pr[PC_V + c]);
        const float kv = bf2f(pr[PC_K + c]), rv = bf2f(pr[PC_R + c]);
        const float a0v = sigm(p.in[I_A0][(l * 2 + 0) * RW + c] + LO[(size_t)row * NLO + 1024 + c]), a1v = sigm(p.in[I_A0][(l * 2 + 1) * RW + c] + LO[(size_t)row * NLO + 1536 + c]);
        const float rk = wave_sum(rv * kv * (2.f + (a0v + a1v - 2.f) * p.in[I_KA][l * RW + c]) * p.in[I_RK][(l * NH + h) * HS + lane]);
        const float o = yn * p.in[I_LNXG][l * RW + c] + p.in[I_LNXB][l * RW + c] + rk * v;
        const float g = LO[(size_t)row * NLO + 2048 + c];
        MI[(size_t)row * D + c] = (bf16)f2bf(o * g);
        int t, len; if (row < NLAT) { t = row & 63; len = 64; } else { t = (row - NLAT) & 255; len = 256; }
        const float uc = bf2f(pr[PC_CC + c]) * bf2f(pr[PC_CH + c]);
        const float up = t > 0 ? bf2f(pr[PC_CC + c - NP]) * bf2f(pr[PC_CH + c - NP]) : 0.f;
        const float un = t < len - 1 ? bf2f(pr[PC_CC + c + NP]) * bf2f(pr[PC_CH + c + NP]) : 0.f;
        const float* cw = p.in[I_CONVW] + (size_t)l * 3 * RW;
        const float cv = up * cw[c] + uc * cw[RW + c] + un * cw[2 * RW + c];
        MI[(size_t)row * D + RW + c] = (bf16)f2bf(bf2f(pr[PC_CB + c]) * cv);
    }
}


__device__ __forceinline__ void ph_moe_gather(const KP& p, int l, int gw, int NGW, int lane) {
    const unsigned* gcnt = (const unsigned*)(p.ws + WS_CTL) + CW_GCNT + 64 * (l >> 1);
    int cnt[8], pb[9]; pb[0] = 0;
#pragma unroll
    for (int e = 0; e < 8; ++e) { cnt[e] = (int)gcnt[e]; pb[e + 1] = pb[e] + ((cnt[e] + 255) & ~255); }
    const unsigned* rowlist = (const unsigned*)(p.ws + WS_ROWLIST); const float* wsel = (const float*)(p.ws + WS_WSEL); float* wsort = (float*)(p.ws + WS_WSORT);
    const bf16* H = (const bf16*)(p.ws + WS_H); bf16* HG = (bf16*)(p.ws + WS_HG);
    for (int pos = gw; pos < pb[8]; pos += NGW) {
        int e = 0, base = 0, ce = cnt[0];
#pragma unroll
        for (int k = 1; k < 8; ++k) if (pos >= pb[k]) { e = k; base = pb[k]; ce = cnt[k]; }
        const int rank = pos - base; v4u a = (v4u){0u, 0u, 0u, 0u}, b = a; float w = 0.f;
        if (rank < ce) { const unsigned ent = rowlist[(size_t)e * MROWS + rank]; const v4u* src = (const v4u*)(H + (size_t)(ent >> 1) * D); a = src[lane]; b = src[64 + lane]; w = wsel[ent]; }
        v4u* dst = (v4u*)(HG + (size_t)pos * D); dst[lane] = a; dst[64 + lane] = b;
        if (lane == 0) wsort[pos] = w;
    }
}

__device__ __forceinline__ void ph_ln(const KP& p, LAS unsigned char* lds, int l, int which, int tid, int wave, int gw, int NGW, int lane) {
    const float* modv = (const float*)(p.ws + WS_MODV); float* X = (float*)(p.ws + WS_X); bf16* H = (bf16*)(p.ws + WS_H);
    const float* BR = (const float*)(p.ws + (which == 0 ? WS_MIXO : WS_F));
    const float* lg = p.in[which == 0 ? I_LN1G : I_LN2G] + l * D; const float* lb = p.in[which == 0 ? I_LN1B : I_LN2B] + l * D;
    const bool moe = (which == 0) && (l & 1); const bool last = (which == 1) && (l == DEPTH - 1); const bool moe_out = (which == 1) && (l & 1);
    LAS int* lcnt = (LAS int*)lds;
    LAS int* lsel = (LAS int*)(lds + 64);
    int nloc = 0;
    if (moe) { if (tid < 16) lcnt[tid] = 0; __syncthreads(); }
    int pbs[9]; pbs[0] = 0;
    if (moe_out) { const unsigned* gcnt = (const unsigned*)(p.ws + WS_CTL) + CW_GCNT + 64 * (l >> 1);
#pragma unroll
        for (int e = 0; e < 8; ++e) pbs[e + 1] = pbs[e] + (int)((gcnt[e] + 255u) & ~255u); }
    for (int row = gw; row < MROWS; row += NGW) {
        const int mr = mod_row(row); const float* mv = modv + (size_t)(l * 5 + mr) * NMOD;
        f32x4 x[4], br[4], gt[4], t[4]; ld_row(X + (size_t)row * D, lane, x); ld_row(mv + (which == 0 ? 2048 : 5120), lane, gt);
        if (moe_out) { const int* ts = (const int*)(p.ws + WS_TOKSEL) + row * 4; const int e0 = ts[0], r0 = ts[1], e1 = ts[2], r1 = ts[3]; int b0 = 0, b1 = 0;
#pragma unroll
            for (int k = 1; k < 8; ++k) { if (e0 >= k) b0 = pbs[k]; if (e1 >= k) b1 = pbs[k]; }
            f32x4 ba[4], bb[4]; ld_row(BR + (size_t)(b0 + r0) * D, lane, ba); ld_row(BR + (size_t)(b1 + r1) * D, lane, bb);
#pragma unroll
            for (int j = 0; j < 4; ++j) br[j] = ba[j] + bb[j]; }
        else ld_row(BR + (size_t)row * D, lane, br);
        float s = 0.f;
#pragma unroll
        for (int j = 0; j < 4; ++j) { t[j] = DN_ALPHA * x[j] + gt[j] * br[j]; s += (t[j][0] + t[j][1]) + (t[j][2] + t[j][3]); }
        const float mean = wave_sum(s) * (1.f / D); float s2 = 0.f;
#pragma unroll
        for (int j = 0; j < 4; ++j) { t[j] = t[j] - mean; s2 += (t[j][0] * t[j][0] + t[j][1] * t[j][1]) + (t[j][2] * t[j][2] + t[j][3] * t[j][3]); }
        const float rstd = 1.f / sqrtf(wave_sum(s2) * (1.f / D) + LN_EPS);
        f32x4 g4[4], b4[4]; ld_row(lg, lane, g4); ld_row(lb, lane, b4);
#pragma unroll
        for (int j = 0; j < 4; ++j) x[j] = t[j] * rstd * g4[j] + b4[j];
        if (last) { if (row < NLAT) st_row(p.out + (size_t)row * D, lane, x); continue; }
        st_row(X + (size_t)row * D, lane, x);
        const float* mv2 = which == 0 ? mv + 3072 : modv + (size_t)((l + 1) * 5 + mr) * NMOD;
        f32x4 sh[4], sc[4], hh[4]; ld_row(mv2, lane, sh); ld_row(mv2 + 1024, lane, sc);
#pragma unroll
        for (int j = 0; j < 4; ++j) hh[j] = x[j] * (1.f + sc[j]) + sh[j];
        st_row_bf16(H + (size_t)row * D, lane, hh);
        if (moe) {
            const float* rw = p.in[I_RTW] + (size_t)(l >> 1) * D * NE; float lgt[8];
#pragma unroll
            for (int e = 0; e < 8; ++e) lgt[e] = 0.f;
#pragma unroll
            for (int j = 0; j < 4; ++j)
#pragma unroll
                for (int i = 0; i < 4; ++i) { const f32x4* wp = (const f32x4*)(rw + (size_t)(4 * lane + 256 * j + i) * NE); const f32x4 w0 = wp[0], w1 = wp[1]; const float hv = hh[j][i];
                    lgt[0] += hv * w0[0]; lgt[1] += hv * w0[1]; lgt[2] += hv * w0[2]; lgt[3] += hv * w0[3]; lgt[4] += hv * w1[0]; lgt[5] += hv * w1[1]; lgt[6] += hv * w1[2]; lgt[7] += hv * w1[3]; }
#pragma unroll
            for (int e = 0; e < 8; ++e) lgt[e] = wave_sum(lgt[e]) + p.in[I_RTB][(l >> 1) * NE + e];
            float v0 = lgt[0]; int i0 = 0;
#pragma unroll
            for (int e = 1; e < 8; ++e) if (lgt[e] > v0) { v0 = lgt[e]; i0 = e; }
            float v1 = -3.0e38f; int i1 = -1;
#pragma unroll
            for (int e = 0; e < 8; ++e) if (e != i0 && lgt[e] > v1) { v1 = lgt[e]; i1 = e; }
            const float w0 = 1.f / (1.f + expf(v1 - v0)), w1 = 1.f - w0;
            if (lane == 0) { const int lr0 = __hip_atomic_fetch_add(lcnt + i0, 1, __ATOMIC_RELAXED, __HIP_MEMORY_SCOPE_WORKGROUP), lr1 = __hip_atomic_fetch_add(lcnt + i1, 1, __ATOMIC_RELAXED, __HIP_MEMORY_SCOPE_WORKGROUP); const int li = nloc * NWAVES + wave;
                lsel[li * 8 + 0] = row; lsel[li * 8 + 1] = i0; lsel[li * 8 + 2] = lr0; lsel[li * 8 + 3] = i1; lsel[li * 8 + 4] = lr1;
                ((float*)(p.ws + WS_WSEL))[row * 2] = w0; ((float*)(p.ws + WS_WSEL))[row * 2 + 1] = w1; }
            ++nloc;
        }
    }
    if (moe) {
        __syncthreads();
        unsigned* gcnt = (unsigned*)(p.ws + WS_CTL) + CW_GCNT + 64 * (l >> 1);
        if (tid < 8) lcnt[8 + tid] = (int)__hip_atomic_fetch_add(gcnt + tid, (unsigned)lcnt[tid], __ATOMIC_RELAXED, __HIP_MEMORY_SCOPE_AGENT);
        __syncthreads();
        unsigned* rowlist = (unsigned*)(p.ws + WS_ROWLIST); int* toksel = (int*)(p.ws + WS_TOKSEL);
        if (tid < 16 * NWAVES) { const int k = tid / NWAVES, w = tid % NWAVES; if (k * NGW + (int)blockIdx.x * NWAVES + w < MROWS) { const int li = k * NWAVES + w;
            const int row = lsel[li * 8 + 0], e0 = lsel[li * 8 + 1], r0 = lcnt[8 + e0] + lsel[li * 8 + 2], e1 = lsel[li * 8 + 3], r1 = lcnt[8 + e1] + lsel[li * 8 + 4];
            rowlist[(size_t)e0 * MROWS + r0] = (unsigned)row * 2u; rowlist[(size_t)e1 * MROWS + r1] = (unsigned)row * 2u + 1u;
            toksel[row * 4 + 0] = e0; toksel[row * 4 + 1] = r0; toksel[row * 4 + 2] = e1; toksel[row * 4 + 3] = r1; } }
    }
}

__global__ void __launch_bounds__(NWAVES * 64, 2) fwd_kernel(KP p) {
    extern __shared__ __attribute__((aligned(16))) unsigned char lds_raw[];
    LAS unsigned char* lds = (LAS unsigned char*)lds_raw;
    volatile LAS unsigned* MISC = (volatile LAS unsigned*)(lds + MISC_OFF);
    const int G = gridDim.x, NGW = G * NWAVES;
    for (int u = threadIdx.x; u < (LDS_BYTES - LDSCTL_OFF) / 4; u += NWAVES * 64) ((LAS unsigned*)(lds + LDSCTL_OFF))[u] = 0u;
    __syncthreads();
    unsigned* ctl = (unsigned*)(p.ws + WS_CTL);
    const bool single = p.ph < 0;
    XcdBarrier bar; bar.bar = ctl + CW_BAR; bar.x = 0; bar.st = nullptr;
    if (single) bar = xcd_barrier_post(ctl + CW_BAR, MISC + 8);
    int phc = 0;
#define RUN() (single || p.ph == phc)
#define FRESH() int tid = threadIdx.x; asm volatile("" : "+v"(tid)); const int lane = tid & 63, wave = __builtin_amdgcn_readfirstlane(tid >> 6), gw = blockIdx.x * NWAVES + wave; (void)lane; (void)gw
#define SEAM() do { if (single) { XcdBarrier b2_ = bar; asm volatile("" : "+s"(b2_.bar)); xcd_barrier(b2_); } ++phc; } while (0)

    bf16* H = (bf16*)(p.ws + WS_H); bf16* Pm = (bf16*)(p.ws + WS_P);
    if (RUN()) { FRESH(); ph_modvec(p, lds, tid); __syncthreads(); ph_convert(p, lds, gw, NGW, wave, lane); }
    SEAM();
    if (RUN()) { FRESH(); ph_init_rows(p, gw, NGW, lane); }
    SEAM();
    for (int l = 0; l < DEPTH; ++l) {
        if (RUN()) { pg8::Gemm g{H, (const bf16*)(p.ws + WS_WIN) + (size_t)l * NP * D, MROWS, NP, D}; pg8::StaticOrder S; S.init(MROWS, NP, G, (int)blockIdx.x);
            pg8::EpiBf16<0> E{Pm, NP, nullptr, 0, 0, 1.f}; pg8::gemm_phase<pg8::EpiBf16<0>, pg8::StaticOrder, true, true>(lds, g, S, E); }
        SEAM();
        if (RUN()) { FRESH(); ph_lora_in(p, gw, NGW, lane); ph_kknorm(p, l, gw, NGW, lane); }
        SEAM();
        if (RUN()) { pg8::Gemm g{(const bf16*)(p.ws + WS_LA), (const bf16*)(p.ws + WS_LORA) + (size_t)l * NLO * KLA, MROWS, NLO, KLA}; pg8::StaticOrder S; S.init(MROWS, NLO, G, (int)blockIdx.x);
            pg8::EpiF32 E{(float*)(p.ws + WS_LO), NLO, 0}; pg8::gemm_phase<pg8::EpiF32, pg8::StaticOrder, true, true>(lds, g, S, E); }
        SEAM();
        if (RUN()) { FRESH(); ph_scan1(p, l, gw, NGW, lane); }
        SEAM();
        if (RUN()) { FRESH(); ph_scan2(p, lds, wave, lane); }
        SEAM();
        if (RUN()) { FRESH(); ph_readout(p, l, gw, NGW, lane); }
        SEAM();
        if (RUN()) { pg8::Gemm g{(const bf16*)(p.ws + WS_MIXIN), (const bf16*)(p.ws + WS_WOUT) + (size_t)l * D * D, MROWS, D, D}; pg8::StaticOrder S; S.init(MROWS, D, G, (int)blockIdx.x);
            pg8::EpiF32 E{(float*)(p.ws + WS_MIXO), D, 0}; pg8::gemm_phase<pg8::EpiF32, pg8::StaticOrder, true, true>(lds, g, S, E); }
        SEAM();
        if (RUN()) { FRESH(); ph_ln(p, lds, l, 0, tid, wave, gw, NGW, lane); }
        SEAM();
        if ((l & 1) == 0) {
            const int fi = l >> 1;
            if (RUN()) { pg8::Gemm g{H, (const bf16*)(p.ws + WS_F13) + (size_t)fi * 2 * DFF * D, MROWS, 2 * DFF, D}; pg8::StaticOrder S; S.init(MROWS, 2 * DFF, G, (int)blockIdx.x);
                pg8::EpiSwiGLU E{(bf16*)(p.ws + WS_ACT), DFF, nullptr, 0}; pg8::gemm_phase<pg8::EpiSwiGLU, pg8::StaticOrder, true, true>(lds, g, S, E); }
            SEAM();
            if (RUN()) { pg8::Gemm g{(const bf16*)(p.ws + WS_ACT), (const bf16*)(p.ws + WS_F2) + (size_t)fi * D * DFF, MROWS, D, DFF}; pg8::StaticOrder S; S.init(MROWS, D, G, (int)blockIdx.x);
                pg8::EpiF32 E{(float*)(p.ws + WS_F), D, 0}; pg8::gemm_phase<pg8::EpiF32, pg8::StaticOrder, true, true>(lds, g, S, E); }
            SEAM();
        } else {
            if (RUN()) { FRESH(); ph_convert_moe(p, lds, l >> 1, gw, NGW, wave, lane); }
            SEAM();
            if (RUN()) { FRESH(); ph_moe_gather(p, l, gw, NGW, lane); }
            SEAM();
            {   const unsigned* gcnt = (const unsigned*)(p.ws + WS_CTL) + CW_GCNT + 64 * (l >> 1); int pbp[9]; pbp[0] = 0;
#pragma unroll
                for (int e = 0; e < 8; ++e) pbp[e + 1] = pbp[e] + (int)((gcnt[e] + 255u) >> 8);
                const int mrows = pbp[8] * 256;
                if (RUN()) { pg8::Gemm g{(const bf16*)(p.ws + WS_HG), (const bf16*)(p.ws + WS_MOEW13), mrows, 2 * DFF, D}; pg8::MoeOrder S; S.init(mrows, 2 * DFF, G, (int)blockIdx.x);
                    S.pb1 = pbp[1]; S.pb2 = pbp[2]; S.pb3 = pbp[3]; S.pb4 = pbp[4]; S.pb5 = pbp[5]; S.pb6 = pbp[6]; S.pb7 = pbp[7]; S.estride = (size_t)2 * DFF * D;
                    pg8::EpiSwiGLU E{(bf16*)(p.ws + WS_ACT), DFF, (const float*)(p.ws + WS_WSORT), 1}; pg8::gemm_phase<pg8::EpiSwiGLU, pg8::MoeOrder, true, true>(lds, g, S, E); }
                SEAM();
                if (RUN()) { pg8::Gemm g{(const bf16*)(p.ws + WS_ACT), (const bf16*)(p.ws + WS_MOEW2), mrows, D, DFF}; pg8::MoeOrder S; S.init(mrows, D, G, (int)blockIdx.x);
                    S.pb1 = pbp[1]; S.pb2 = pbp[2]; S.pb3 = pbp[3]; S.pb4 = pbp[4]; S.pb5 = pbp[5]; S.pb6 = pbp[6]; S.pb7 = pbp[7]; S.estride = (size_t)D * DFF;
                    pg8::EpiF32 E{(float*)(p.ws + WS_F), D, 0}; pg8::gemm_phase<pg8::EpiF32, pg8::MoeOrder, true, true>(lds, g, S, E); }
                SEAM();
            }
        }
        if (RUN()) { FRESH(); ph_ln(p, lds, l, 1, tid, wave, gw, NGW, lane); }
        SEAM();
    }
#undef RUN
#undef SEAM
}

#ifndef MK_PER_PHASE
#define MK_PER_PHASE 0
#endif
extern "C" void kernel_launch(void* const* d_in, const int* in_sizes, int n_in, void* d_out, int out_size, void* d_ws, size_t ws_size, hipStream_t stream) {
    static int grid = 0;
    if (grid == 0) {
        if (n_in != N_IN || in_sizes[0] != NLAT * D || out_size != NLAT * D || ws_size < WS_NEED) { fprintf(stderr, "kernel_launch: unexpected shapes / workspace (%d inputs, ws %zu, need %zu)\n", n_in, ws_size, (size_t)WS_NEED); grid = -1; return; }
        int dev = 0, cus = 0, per_cu = 0;
        if (hipGetDevice(&dev) != hipSuccess || hipDeviceGetAttribute(&cus, hipDeviceAttributeMultiprocessorCount, dev) != hipSuccess) { grid = -1; return; }
        if (hipFuncSetAttribute((const void*)fwd_kernel, hipFuncAttributeMaxDynamicSharedMemorySize, LDS_BYTES) != hipSuccess) { fprintf(stderr, "kernel_launch: hipFuncSetAttribute failed\n"); grid = -1; return; }
        if (hipOccupancyMaxActiveBlocksPerMultiprocessor(&per_cu, (const void*)fwd_kernel, NWAVES * 64, LDS_BYTES) != hipSuccess || per_cu < 1) fprintf(stderr, "kernel_launch: occupancy query says %d\n", per_cu);
        (void)hipGetLastError();
        grid = cus;
    }
    if (grid < 0) return;
    if (hipMemsetAsync((char*)d_ws + WS_CTL, 0, CTL_BYTES, stream) != hipSuccess) return;
    KP p{};
    for (int i = 0; i < N_IN; ++i) p.in[i] = (const float*)d_in[i];
    p.out = (float*)d_out; p.ws = (unsigned char*)d_ws; p.pad = 0;
#if MK_PER_PHASE
    const int nph = 2 + 2 * 11 + 2 * 13;
    for (int ph = 0; ph < nph; ++ph) { p.ph = ph; hipLaunchKernelGGL(fwd_kernel, dim3(grid), dim3(NWAVES * 64), LDS_BYTES, stream, p); }
#else
    p.ph = -1;
    hipLaunchKernelGGL(fwd_kernel, dim3(grid), dim3(NWAVES * 64), LDS_BYTES, stream, p);
#endif
}
```

```cpp
#include <hip/hip_runtime.h>
#define PROBE_DUP 0
#include <cstdio>
#include <cstdint>
namespace pg8 {
#define PG8_LAS __attribute__((address_space(3)))
typedef unsigned short bf16_t;
typedef short bf16x8 __attribute__((ext_vector_type(8)));
typedef float f32x4 __attribute__((ext_vector_type(4)));
typedef unsigned u32x4 __attribute__((ext_vector_type(4)));
constexpr int BM = 256, BK = 64, HALF = 128, HTB = HALF * BK * 2  , STAGE_BYTES = 8 * HTB, NXCD = 8, WGM = 8;

__host__ __device__ __forceinline__ int lds_byte(int r, int c) { const int st = (r >> 4) * 2 + (c >> 5), rr = r & 15, cc = c & 31, ob = rr * 64 + cc * 2; return st * 1024 + (ob ^ (((ob >> 9) & 1) << 5)); }
__host__ __device__ __forceinline__ void stage_rc(int b, int& R, int& C) { const int st = b / 1024, sb = b % 1024, swz = sb ^ (((sb >> 9) & 1) << 5); R = (st >> 1) * 16 + swz / 64; C = (st & 1) * 32 + (swz % 64) / 2; }
__host__ __device__ __forceinline__ int perm32(int rho) { const int n = rho >> 4, i = rho & 15; return 8 * (i >> 2) + 4 * n + (i & 3); }

struct Unit { int pm, pn; };
struct Gemm { const bf16_t* A; const bf16_t* Bt; int M, N, K; };

struct StaticOrder {
    int nM, nN, nwg, G, c;
    __host__ __device__ void init(int M, int N, int G_, int c_) { nM = M / BM; nN = N / BM; nwg = nM * nN; G = G_; c = c_; }
    __host__ __device__ bool next(int i, Unit& u) const {
        const long L = (long)i * G + c; if (L >= nwg) return false;
        int wgid = (int)L; { const int q = nwg / NXCD, r = nwg % NXCD, xcd = wgid % NXCD, off = wgid / NXCD; wgid = (xcd < r ? xcd * (q + 1) : r * (q + 1) + (xcd - r) * q) + off; }
        const int nig = WGM * nN, gid = wgid / nig, fm = gid * WGM, gsz = (nM - fm) < WGM ? (nM - fm) : WGM;
        u.pm = fm + ((wgid % nig) % gsz); u.pn = (wgid % nig) / gsz; return true;
    }
    __device__ __forceinline__ const bf16_t* bt(const Gemm& g, const Unit&) const { return g.Bt; }
    __device__ __forceinline__ void a_ready(const Unit&) const {}
    __device__ __forceinline__ void done(const Unit&) const {}
};

__device__ __forceinline__ unsigned cvt_pk_bf16(float lo, float hi) { unsigned r; asm volatile("v_cvt_pk_bf16_f32 %0, %1, %2" : "=v"(r) : "v"(lo), "v"(hi)); return r; }
typedef float f32x2 __attribute__((ext_vector_type(2)));
__device__ __forceinline__ f32x2 gelu_pk(f32x2 v) {
    const f32x2 av = __builtin_elementwise_abs(v), d = av * 0.2316418882f + 1.0f;
    f32x2 t; t.x = __builtin_amdgcn_rcpf(d.x); t.y = __builtin_amdgcn_rcpf(d.y);
    f32x2 q = t * 0.5307027145f + (-0.7265760135f); q = q * t + 0.7107068705f; q = q * t + (-0.142248368f); q = q * t + 0.127414796f; q = q * t;
    const f32x2 s = (v * v) * (-0.72134752044f);
    f32x2 e; e.x = __builtin_amdgcn_exp2f(s.x); e.y = __builtin_amdgcn_exp2f(s.y);
    const f32x2 m = v * (q * e), r = v - m;
    f32x2 o; o.x = v.x < 0.f ? m.x : r.x; o.y = v.y < 0.f ? m.y : r.y; return o;
}

template <int ACT  > struct EpiBf16 {
    static constexpr bool PERM = true, AFTER_DRAIN = false; static_assert(ACT == 0 || ACT == 1, "EpiBf16: ACT is 0 (none) or 1 (gelu_pk)");
    bf16_t* O; int ldc; const float* bias; int split_cols; size_t split_stride; float scale0;
    __device__ __forceinline__ void operator()(const f32x4 (&acc)[2][2][4][2], const Unit& u, int wr, int wc, int fr, int fq) const {
        const int row0 = u.pm * BM + wr * 64 + fr; int colt = u.pn * BM; bf16_t* base = O;
        float sc = 1.f; if (split_cols) { const int t = colt / split_cols; base += (size_t)t * split_stride; colt -= t * split_cols; if (t == 0) sc = scale0; }
        const int col0 = colt + wc * 32 + 8 * fq, bcol0 = u.pn * BM + wc * 32 + 8 * fq;
        f32x4 bv[2][2];
#pragma unroll
        for (int bj = 0; bj < 2; ++bj)
#pragma unroll
            for (int n = 0; n < 2; ++n) bv[bj][n] = bias ? *(const f32x4*)(bias + bcol0 + bj * HALF + 4 * n) : (f32x4){0.f, 0.f, 0.f, 0.f};
#pragma unroll
        for (int ai = 0; ai < 2; ++ai)
#pragma unroll
            for (int m = 0; m < 4; ++m) { bf16_t* rowp = base + (size_t)(row0 + ai * HALF + m * 16) * ldc + col0;
#pragma unroll
                for (int bj = 0; bj < 2; ++bj) { f32x4 v0 = acc[ai][bj][m][0] + bv[bj][0], v1 = acc[ai][bj][m][1] + bv[bj][1];
                    if (ACT == 1) { f32x2 a = gelu_pk((f32x2){v0[0], v0[1]}), b = gelu_pk((f32x2){v0[2], v0[3]}), c = gelu_pk((f32x2){v1[0], v1[1]}), d = gelu_pk((f32x2){v1[2], v1[3]});
                        v0 = (f32x4){a.x, a.y, b.x, b.y}; v1 = (f32x4){c.x, c.y, d.x, d.y}; }
                    v0 = v0 * sc; v1 = v1 * sc; u32x4 w; w.x = cvt_pk_bf16(v0[0], v0[1]); w.y = cvt_pk_bf16(v0[2], v0[3]); w.z = cvt_pk_bf16(v1[0], v1[1]); w.w = cvt_pk_bf16(v1[2], v1[3]);
                    *(u32x4*)(rowp + bj * HALF) = w; } }
    }
};
struct EpiF32 {
    static constexpr bool PERM = false, AFTER_DRAIN = false;
    float* C; int ldc; int accum;
    __device__ __forceinline__ void operator()(const f32x4 (&acc)[2][2][4][2], const Unit& u, int wr, int wc, int fr, int fq) const {
        const int row0 = u.pm * BM + wr * 64 + fr, col0 = u.pn * BM + wc * 32 + 4 * fq;
#pragma unroll
        for (int ai = 0; ai < 2; ++ai)
#pragma unroll
            for (int m = 0; m < 4; ++m) { float* rowp = C + (size_t)(row0 + ai * HALF + m * 16) * ldc + col0;
#pragma unroll
                for (int bj = 0; bj < 2; ++bj)
#pragma unroll
                    for (int n = 0; n < 2; ++n) { f32x4 v = acc[ai][bj][m][n]; if (accum) v += *(const f32x4*)(rowp + bj * HALF + n * 16); *(f32x4*)(rowp + bj * HALF + n * 16) = v; } }
    }
};
struct EpiSwiGLU {
    static constexpr bool PERM = true, AFTER_DRAIN = false;
    bf16_t* O; int ldo; const float* rowscale; int rs_stride;
    __device__ __forceinline__ void operator()(const f32x4 (&acc)[2][2][4][2], const Unit& u, int wr, int wc, int fr, int fq) const {
        typedef unsigned u32x2v __attribute__((ext_vector_type(2)));
        const int row0 = u.pm * BM + wr * 64 + fr; const int ch0 = (u.pn * BM + wc * 32 + 8 * fq) >> 1;
#pragma unroll
        for (int ai = 0; ai < 2; ++ai)
#pragma unroll
            for (int m = 0; m < 4; ++m) { const int row = row0 + ai * HALF + m * 16; bf16_t* rowp = O + (size_t)row * ldo + ch0;
                const float rs = rowscale ? rowscale[(size_t)row * rs_stride] : 1.f;
#pragma unroll
                for (int bj = 0; bj < 2; ++bj) { const f32x4 a = acc[ai][bj][m][0], b = acc[ai][bj][m][1]; f32x4 o;
#pragma unroll
                    for (int i = 0; i < 4; ++i) o[i] = a[i] * __builtin_amdgcn_rcpf(1.f + __expf(-a[i])) * b[i] * rs;
                    u32x2v w; w.x = cvt_pk_bf16(o[0], o[1]); w.y = cvt_pk_bf16(o[2], o[3]);
                    *(u32x2v*)(rowp + bj * (HALF / 2)) = w; } }
    }
};

struct MoeOrder : StaticOrder {
    int pb1, pb2, pb3, pb4, pb5, pb6, pb7; size_t estride;
    __device__ __forceinline__ const bf16_t* bt(const Gemm& g, const Unit& u) const {
        const int e = (u.pm >= pb1) + (u.pm >= pb2) + (u.pm >= pb3) + (u.pm >= pb4) + (u.pm >= pb5) + (u.pm >= pb6) + (u.pm >= pb7);
        return g.Bt + (size_t)e * estride; }
};
template <class Epi, class Sched, bool ALIGN_EPI = false, bool SP2 = false>
__device__ __forceinline__ void gemm_phase(PG8_LAS unsigned char* lds, const Gemm g, const Sched& S, const Epi& E) {
    int tid_o = threadIdx.x; asm volatile("" : "+v"(tid_o));
    const int tid = tid_o, wid = __builtin_amdgcn_readfirstlane(tid >> 6), lane = tid & 63, wr = wid >> 2, wc = wid & 3, fr = lane & 15, fq = lane >> 4;
    const int K = g.K, nt = K / BK;
    unsigned voffA[2], voffB[2];
#pragma unroll
    for (int i = 0; i < 2; ++i) { int R, C; stage_rc(tid * 16 + i * 8192, R, C); const int Rb = Epi::PERM ? ((R & ~31) + perm32(R & 31)) : R;
        voffA[i] = (unsigned)(R * K + C) * 2u; voffB[i] = (unsigned)(Rb * K + C) * 2u; }
    const size_t kstep = (size_t)(BK * 2);
    const size_t hstep = (size_t)HALF * K * 2;
    const size_t tstep = 2 * hstep;
    const unsigned ldsw = (unsigned)wid * 1024u;
    const int aoff = lds_byte(wr * 64 + fr, fq * 8), boff = lds_byte(wc * 32 + fr, fq * 8);
#define PG8_SA(b, h) (((b) * 2 + (h)) * HTB)
#define PG8_SB(b, h) ((4 + (b) * 2 + (h)) * HTB)
#define PG8_STAGE(bufoff, gbase, voff) do { _Pragma("unroll") for (int _i = 0; _i < 2; ++_i) \
        __builtin_amdgcn_global_load_lds((const unsigned*)((const char*)(gbase) + (voff)[_i]), (PG8_LAS unsigned*)(lds + (bufoff) + ldsw + _i * 8192), 16, 0, 0); } while (0)
#define PG8_LDA(dst, b, h) do { _Pragma("unroll") for (int m = 0; m < 4; ++m) _Pragma("unroll") for (int k = 0; k < 2; ++k) dst[m][k] = *(const PG8_LAS bf16x8*)(lds + PG8_SA(b, h) + aoff + m * 2048 + k * 1024); } while (0)
#define PG8_LDB(dst, b, h) do { _Pragma("unroll") for (int n = 0; n < 2; ++n) _Pragma("unroll") for (int k = 0; k < 2; ++k) dst[n][k] = *(const PG8_LAS bf16x8*)(lds + PG8_SB(b, h) + boff + n * 2048 + k * 1024); } while (0)
#define PG8_MMA(ai, bj, At, Bt) do { __builtin_amdgcn_s_setprio(1); _Pragma("unroll") for (int m = 0; m < 4; ++m) _Pragma("unroll") for (int n = 0; n < 2; ++n) _Pragma("unroll") for (int k = 0; k < 2; ++k) \
        acc[ai][bj][m][n] = __builtin_amdgcn_mfma_f32_16x16x32_bf16(Bt[n][k], At[m][k], acc[ai][bj][m][n], 0, 0, 0); __builtin_amdgcn_s_setprio(0); } while (0)
#define PG8_WAIT_V(n) asm volatile("s_waitcnt vmcnt(" #n ")" ::: "memory")
#define PG8_WAIT_L(n) asm volatile("s_waitcnt lgkmcnt(" #n ")" ::: "memory")
#define PG8_BAR __builtin_amdgcn_s_barrier()
#define PG8_SCHED __builtin_amdgcn_sched_barrier(0)
    Unit cur, nxt; int ui = 0;
    if (!S.next(0, cur)) return;
    f32x4 acc[2][2][4][2];
#pragma unroll
    for (int a = 0; a < 2; ++a)
#pragma unroll
        for (int b = 0; b < 2; ++b)
#pragma unroll
            for (int m = 0; m < 4; ++m)
#pragma unroll
                for (int n = 0; n < 2; ++n) acc[a][b][m][n] = (f32x4){0.f, 0.f, 0.f, 0.f};
    bf16x8 At[4][2], B0[2][2], B1[2][2];
    const char* cA = (const char*)g.A + (size_t)cur.pm * tstep; const char* cB = (const char*)S.bt(g, cur) + (size_t)cur.pn * tstep;
    S.a_ready(cur);
    if constexpr (SP2) {
        PG8_STAGE(PG8_SB(0, 0), cB, voffB); PG8_STAGE(PG8_SB(0, 1), cB + hstep, voffB); PG8_STAGE(PG8_SA(0, 0), cA, voffA); PG8_STAGE(PG8_SA(0, 1), cA + hstep, voffA);
        if (wr == 1) PG8_BAR;
        PG8_WAIT_V(2); PG8_BAR;
        PG8_STAGE(PG8_SB(1, 0), cB + kstep, voffB); PG8_STAGE(PG8_SA(1, 0), cA + kstep, voffA); PG8_STAGE(PG8_SB(1, 1), cB + hstep + kstep, voffB);
        PG8_WAIT_V(6); PG8_BAR;
    } else {
        PG8_STAGE(PG8_SB(0, 0), cB, voffB); PG8_STAGE(PG8_SA(0, 0), cA, voffA); PG8_STAGE(PG8_SB(0, 1), cB + hstep, voffB); PG8_STAGE(PG8_SA(0, 1), cA + hstep, voffA);
        if (wr == 1) PG8_BAR;
        PG8_WAIT_V(4); PG8_BAR;
        PG8_STAGE(PG8_SB(1, 0), cB + kstep, voffB); PG8_STAGE(PG8_SA(1, 0), cA + kstep, voffA); PG8_STAGE(PG8_SB(1, 1), cB + hstep + kstep, voffB);
        PG8_WAIT_V(6); PG8_BAR;
    }
    for (;;) {
        const bool has_next = S.next(ui + 1, nxt);
        const char* nA = has_next ? (const char*)g.A + (size_t)nxt.pm * tstep : cA; const char* nB = has_next ? (const char*)S.bt(g, nxt) + (size_t)nxt.pn * tstep : cB;
        for (int t = 0; t < nt; t += 2) {
            const bool last = (t == nt - 2);
            const char* a1 = cA + (size_t)(t + 1) * kstep;
            const char* a2 = last ? nA : cA + (size_t)(t + 2) * kstep; const char* b2 = last ? nB : cB + (size_t)(t + 2) * kstep;
            const char* a3 = a2 + kstep; const char* b3 = b2 + kstep;
            if (last && has_next) S.a_ready(nxt);
            if constexpr (SP2) {
            PG8_LDB(B0, 0, 0); PG8_LDB(B1, 0, 1); PG8_SCHED; PG8_LDA(At, 0, 0); PG8_STAGE(PG8_SA(1, 1), a1 + hstep, voffA);
            PG8_WAIT_V(8); PG8_WAIT_L(0); PG8_BAR; PG8_MMA(0, 0, At, B0); PG8_MMA(0, 1, At, B1); PG8_BAR; PG8_SCHED;
            PG8_LDA(At, 0, 1); PG8_STAGE(PG8_SB(0, 0), b2, voffB); PG8_STAGE(PG8_SB(0, 1), b2 + hstep, voffB); PG8_STAGE(PG8_SA(0, 0), a2, voffA);
            PG8_WAIT_V(8); PG8_WAIT_L(0); PG8_BAR; PG8_MMA(1, 0, At, B0); PG8_MMA(1, 1, At, B1); PG8_BAR; PG8_SCHED;
            PG8_LDB(B0, 1, 0); PG8_LDB(B1, 1, 1); PG8_SCHED; PG8_LDA(At, 1, 0); PG8_STAGE(PG8_SA(0, 1), a2 + hstep, voffA);
            PG8_WAIT_V(8); PG8_WAIT_L(0); PG8_BAR; PG8_MMA(0, 0, At, B0); PG8_MMA(0, 1, At, B1); PG8_BAR; PG8_SCHED;
            PG8_LDA(At, 1, 1); PG8_STAGE(PG8_SB(1, 0), b3, voffB); PG8_STAGE(PG8_SB(1, 1), b3 + hstep, voffB); PG8_STAGE(PG8_SA(1, 0), a3, voffA);
            PG8_WAIT_V(8); PG8_WAIT_L(0); PG8_BAR; PG8_MMA(1, 0, At, B0); PG8_MMA(1, 1, At, B1); PG8_BAR; PG8_SCHED;
            } else {
            PG8_LDB(B0, 0, 0); PG8_SCHED; PG8_LDA(At, 0, 0); PG8_STAGE(PG8_SA(1, 1), a1 + hstep, voffA);
            PG8_WAIT_L(8); PG8_BAR; PG8_WAIT_L(0); PG8_MMA(0, 0, At, B0); PG8_BAR; PG8_SCHED;
            PG8_LDB(B1, 0, 1); PG8_STAGE(PG8_SB(0, 0), b2, voffB);
            PG8_BAR; PG8_WAIT_L(0); PG8_MMA(0, 1, At, B1); PG8_BAR;
            PG8_LDA(At, 0, 1); PG8_STAGE(PG8_SA(0, 0), a2, voffA);
            PG8_BAR; PG8_WAIT_L(0); PG8_MMA(1, 0, At, B0); PG8_BAR; PG8_SCHED;
            PG8_STAGE(PG8_SB(0, 1), b2 + hstep, voffB);
            PG8_WAIT_V(6); PG8_BAR; PG8_MMA(1, 1, At, B1); PG8_BAR;
            PG8_LDB(B0, 1, 0); PG8_SCHED; PG8_LDA(At, 1, 0); PG8_STAGE(PG8_SA(0, 1), a2 + hstep, voffA);
            PG8_WAIT_L(8); PG8_BAR; PG8_WAIT_L(0); PG8_MMA(0, 0, At, B0); PG8_BAR; PG8_SCHED;
            PG8_LDB(B1, 1, 1); PG8_STAGE(PG8_SB(1, 0), b3, voffB);
            PG8_BAR; PG8_WAIT_L(0); PG8_MMA(0, 1, At, B1); PG8_BAR;
            PG8_LDA(At, 1, 1); PG8_STAGE(PG8_SA(1, 0), a3, voffA);
            PG8_BAR; PG8_WAIT_L(0); PG8_MMA(1, 0, At, B0); PG8_BAR; PG8_SCHED;
            PG8_STAGE(PG8_SB(1, 1), b3 + hstep, voffB);
            PG8_WAIT_V(6); PG8_BAR; PG8_MMA(1, 1, At, B1); PG8_BAR;
            }
        }
        if constexpr (ALIGN_EPI) { if (wr == 0) PG8_BAR; }
        if constexpr (!Epi::AFTER_DRAIN) { E(acc, cur, wr, wc, fr, fq); S.done(cur); }
        if (!has_next) break;
#pragma unroll
        for (int a = 0; a < 2; ++a)
#pragma unroll
            for (int b = 0; b < 2; ++b)
#pragma unroll
                for (int m = 0; m < 4; ++m)
#pragma unroll
                    for (int n = 0; n < 2; ++n) acc[a][b][m][n] = (f32x4){0.f, 0.f, 0.f, 0.f};
        cur = nxt; cA = nA; cB = nB; ++ui;
        if constexpr (ALIGN_EPI) { if (wr == 1) PG8_BAR; }
    }
    PG8_WAIT_V(0);
    if constexpr (!ALIGN_EPI) { if (wr == 0) PG8_BAR; }
    PG8_BAR;
    if constexpr (Epi::AFTER_DRAIN) { E.fused(acc, cur, wr, wc, fr, fq, lds, wid, lane); S.done(cur); }
#undef PG8_SA
#undef PG8_SB
#undef PG8_STAGE
#undef PG8_LDA
#undef PG8_LDB
#undef PG8_MMA
#undef PG8_WAIT_V
#undef PG8_WAIT_L
#undef PG8_BAR
#undef PG8_SCHED
}
}

constexpr int NWAVES = 8;
constexpr int D = 1024, NB = 4, SEQ = 4096, CTXL = 256, NLAT = NB * SEQ, NCTX = NB * CTXL, MROWS = NLAT + NCTX;
constexpr int DEPTH = 4, RW = 512, NH = 8, HS = 64, DFF = 3584, NE = 8, NPROJ = 3456, NP = 3584, NLO = 2560, KLA = 512, NMOD = 6144;
constexpr int PC_R = 0, PC_K = 512, PC_V = 1024, PC_CB = 1536, PC_CC = 2048, PC_CH = 2560, PC_WD = 3072, PC_AD = 3200, PC_GD = 3328;
constexpr float LN_EPS = 1e-5f, GN_EPS = 64e-5f, DN_ALPHA = 1.681792830507429f;
enum { I_X = 0, I_C, I_CTX, I_CCTX, I_WMOD, I_BMOD, I_WIN, I_W0, I_W2, I_A0, I_A2, I_KK, I_KA, I_RK, I_G2, I_LNXG, I_LNXB, I_CONVW, I_WOUT, I_LN1G, I_LN1B, I_LN2G, I_LN2B,
       I_FW1, I_FW3, I_FW2, I_RTW, I_RTB, I_MW1, I_MW3, I_MW2, N_IN };

constexpr size_t MiB = 1u << 20;
constexpr size_t WS_CTL = 0, CTL_BYTES = 1 * MiB;
constexpr size_t WS_MODV = 1 * MiB;
constexpr size_t WS_G8 = 2 * MiB;
constexpr size_t WS_RKS = 3 * MiB;
constexpr size_t WS_WIN = 4 * MiB;
constexpr size_t WS_WOUT = WS_WIN + 28 * MiB;
constexpr size_t WS_LORA = WS_WOUT + 8 * MiB;
constexpr size_t WS_F13 = WS_LORA + 10 * MiB;
constexpr size_t WS_F2 = WS_F13 + 28 * MiB;
constexpr size_t WS_X = WS_F2 + 14 * MiB;
constexpr size_t WS_H = WS_X + 68 * MiB;
constexpr size_t WS_MOES = WS_H + 34 * MiB;
constexpr size_t WS_ROWLIST = WS_MOES;
constexpr size_t WS_TOKSEL = WS_MOES + 640 * 1024;
constexpr size_t WS_WSEL = WS_TOKSEL + 320 * 1024;
constexpr size_t WS_WSORT = WS_WSEL + 192 * 1024;
constexpr size_t WS_SCR = WS_MOES + 2 * MiB;
constexpr size_t WS_P = WS_SCR;
constexpr size_t WS_LA = WS_P + 119 * MiB;
constexpr size_t WS_LO = WS_LA + 17 * MiB;
constexpr size_t WS_MIX = WS_LO;
constexpr size_t WS_PREP = WS_LO + 170 * MiB;
constexpr size_t WS_Y = WS_PREP + 238 * MiB;
constexpr size_t WS_MIXIN = WS_Y + 68 * MiB;
constexpr size_t WS_CH = WS_PREP;
constexpr size_t WS_MIXO = WS_PREP;
constexpr size_t WS_END_MIXER = WS_MIXIN + 34 * MiB;
constexpr size_t WS_MOEW13 = WS_SCR;
constexpr size_t WS_MOEW2 = WS_MOEW13 + 112 * MiB;
constexpr size_t WS_HG = WS_MOEW2 + 56 * MiB;
constexpr size_t WS_ACT = WS_HG + 72 * MiB;
constexpr size_t WS_F = WS_ACT + 252 * MiB;
constexpr size_t WS_END_FFN = WS_F + 144 * MiB;
constexpr size_t WS_NEED = WS_END_MIXER > WS_END_FFN ? WS_END_MIXER : WS_END_FFN;
static_assert((size_t)MROWS * NP * 2 <= 119 * MiB && (size_t)MROWS * NLO * 4 <= 170 * MiB && (size_t)MROWS * RW * 4 * 7 <= 238 * MiB && (size_t)MROWS * D * 4 <= 68 * MiB, "ws map");
constexpr int MOE_ROWS = 36864;
constexpr int CW_BAR = 4096, CW_GCNT = 8192;

constexpr int RING_BYTES = 131072, LDSCTL_OFF = RING_BYTES, MISC_OFF = LDSCTL_OFF + 320, LDS_BYTES = 147456;

typedef unsigned short bf16;
typedef unsigned v4u __attribute__((ext_vector_type(4)));
typedef unsigned v2u __attribute__((ext_vector_type(2)));
typedef float f32x4 __attribute__((ext_vector_type(4)));
#define LAS __attribute__((address_space(3)))
#define LDS_WAIT() asm volatile("s_waitcnt lgkmcnt(0)" ::: "memory")
__device__ __forceinline__ unsigned f2bf(float f) { unsigned u = __builtin_bit_cast(unsigned, f); return (u + 0x7fffu + ((u >> 16) & 1u)) >> 16; }
__device__ __forceinline__ unsigned pk2(float lo, float hi) { return f2bf(lo) | (f2bf(hi) << 16); }
__device__ __forceinline__ float bf2f(unsigned short b) { return __builtin_bit_cast(float, ((unsigned)b) << 16); }
__device__ __forceinline__ float bflo(unsigned w) { return __builtin_bit_cast(float, w << 16); }
__device__ __forceinline__ float bfhi(unsigned w) { return __builtin_bit_cast(float, w & 0xffff0000u); }
__device__ __forceinline__ float wave_sum(float v) {
#pragma unroll
    for (int o = 1; o < 64; o <<= 1) v += __shfl_xor(v, o);
    return v;
}
__device__ __forceinline__ float sigm(float x) { return 1.f / (1.f + __expf(-x)); }

#define XB_TMO      128
#define XB_XCNT(j)  (256  + 64 * (j))
#define XB_XSUB(j)  (1280 + 64 * (j))
#define XB_XGEN(j)  (2304 + 64 * (j))
#define XB_TOP      3328
#define XB_TOPGEN   3392
#define XCD_BAR_WORDS 3456
#define XB_SPIN_CAP (1u << 18)

__device__ __forceinline__ unsigned xb_ld(unsigned* p)              { return __hip_atomic_load(p, __ATOMIC_RELAXED, __HIP_MEMORY_SCOPE_AGENT); }
__device__ __forceinline__ unsigned xb_add(unsigned* p, unsigned v) { return __hip_atomic_fetch_add(p, v, __ATOMIC_RELAXED, __HIP_MEMORY_SCOPE_AGENT); }
__device__ __forceinline__ unsigned xb_xcc_id() { return (unsigned)__builtin_amdgcn_s_getreg((3 << 11) | 20) & 0xFu; }
#define XB_SPIN(cond, bar) do { unsigned _sp = 0; while (cond) { __builtin_amdgcn_s_sleep(1); \
    if ((++_sp & 255u) == 0u) { if (xb_ld(&(bar)[XB_TMO])) break; if (_sp > XB_SPIN_CAP) { atomicAdd(&(bar)[XB_TMO], 1u); break; } } } } while (0)

struct XcdBarrier {
    unsigned* bar; unsigned x;
    volatile LAS unsigned* st;
};

__device__ __forceinline__ XcdBarrier xcd_barrier_post(unsigned* bar, volatile LAS unsigned* st) {
    XcdBarrier b; b.bar = bar; b.x = xb_xcc_id(); b.st = st;
    if (threadIdx.x == 0) (void)xb_add(&bar[XB_XCNT(b.x)], 1u);
    return b;
}
__device__ __forceinline__ void xcd_barrier_complete(unsigned* bar, unsigned x, unsigned& nloc, unsigned& nx) {
    const unsigned G = gridDim.x * gridDim.y * gridDim.z;
    unsigned sum, cnt, mine, sp = 0u;
    for (;;) {
        sum = 0u; cnt = 0u; mine = 0u;
#pragma unroll
        for (unsigned j = 0; j < 16; ++j) { const unsigned c = xb_ld(&bar[XB_XCNT(j)]); sum += c; cnt += (c > 0u) ? 1u : 0u; mine = (j == x) ? c : mine; }
        if (sum == G) break;
        __builtin_amdgcn_s_sleep(1);
        if ((++sp & 255u) == 0u) { if (xb_ld(&bar[XB_TMO])) break; if (sp > XB_SPIN_CAP) { atomicAdd(&bar[XB_TMO], 1u); break; } }
    }
    nloc = mine > 0u ? mine : 1u; nx = cnt > 0u ? cnt : 1u;
}

__device__ __forceinline__ void xcd_barrier(const XcdBarrier& b) {
    asm volatile("s_waitcnt vmcnt(0)" ::: "memory");
    __syncthreads();
    if (threadIdx.x == 0) {
        unsigned* bar = b.bar;
        __builtin_amdgcn_s_waitcnt(0);
        unsigned nloc = b.st[0], nx = b.st[1];
        if (nloc == 0u) { xcd_barrier_complete(bar, b.x, nloc, nx); b.st[0] = nloc; b.st[1] = nx; }
        const unsigned old = xb_add(&bar[XB_XSUB(b.x)], 1u);
        const unsigned gen = old / nloc;
        if (old + 1u == (gen + 1u) * nloc) {
            __builtin_amdgcn_fence(__ATOMIC_RELEASE, "agent");
            asm volatile("s_waitcnt vmcnt(0)" ::: "memory");
            const unsigned og = xb_add(&bar[XB_TOP], 1u);
            const unsigned tg = og / nx;
            if (og + 1u == (tg + 1u) * nx) xb_add(&bar[XB_TOPGEN], 1u);
            else XB_SPIN(xb_ld(&bar[XB_TOPGEN]) == tg, bar);
            __builtin_amdgcn_fence(__ATOMIC_ACQUIRE, "agent");
            xb_add(&bar[XB_XGEN(b.x)], 1u);
            asm volatile("s_waitcnt vmcnt(0)" ::: "memory");
        } else {
            XB_SPIN(xb_ld(&bar[XB_XGEN(b.x)]) == gen, bar);
            __builtin_amdgcn_fence(__ATOMIC_ACQUIRE, "agent");
            asm volatile("s_waitcnt vmcnt(0)" ::: "memory");
        }
    }
    __syncthreads();
}


struct KP { const float* in[N_IN]; float* out; unsigned char* ws; int ph; int pad; };

template <int MODE> __device__ __forceinline__ int rowmap(int n, int arg) {
    if (MODE == 0) return n + arg;
    if (MODE == 1) { if (n < 1536) return n; if (n < 1664) return n - 1536 + PC_WD; if (n < 1792) return n - 1664 + PC_AD; if (n < 1920) return n - 1792 + PC_GD;
                     if (n < 2432) return n - 1920 + PC_CB; if (n < 2944) return n - 2432 + PC_CC; return n - 2944 + PC_CH; }
    return 8 * (n >> 2) + 4 * arg + (n & 3);
}
template <int MODE> __device__ __forceinline__ void transpose_item(const float* W, int K, int N, bf16* WT, int arg, LAS float* scr, int item, int lane) {
    const int nblk = N / 32, kb = item / nblk, nb = item % nblk, k0 = 64 * kb, n0 = 32 * nb;
#pragma unroll 8
    for (int i = 0; i < 32; ++i) { const int kk = 2 * i + (lane >> 5); scr[kk * 33 + (lane & 31)] = W[(size_t)(k0 + kk) * N + n0 + (lane & 31)]; }
    LDS_WAIT(); asm volatile("" ::: "memory");
    const int c = lane & 7;
#pragma unroll
    for (int j = 0; j < 4; ++j) { const int n = (lane >> 3) + 8 * j; const LAS float* s = scr + (8 * c) * 33 + n;
        v4u o; o.x = pk2(s[0 * 33], s[1 * 33]); o.y = pk2(s[2 * 33], s[3 * 33]); o.z = pk2(s[4 * 33], s[5 * 33]); o.w = pk2(s[6 * 33], s[7 * 33]);
        *(v4u*)(WT + (size_t)rowmap<MODE>(n0 + n, arg) * K + k0 + 8 * c) = o; }
    LDS_WAIT(); asm volatile("" ::: "memory");
}

__device__ __forceinline__ void ph_modvec(const KP& p, LAS unsigned char* lds, int tid) {
    LAS float* sil = (LAS float*)lds;
    LAS float* red = (LAS float*)(lds + 5 * 1024 * 4);
    const float* c = p.in[I_C]; const float* cc = p.in[I_CCTX];
    for (int i = tid; i < 5 * 1024; i += 512) { const float v = i < 4096 ? c[i] : cc[i - 4096]; sil[i] = v / (1.f + __expf(-v)); }
    __syncthreads();
    float* modv = (float*)(p.ws + WS_MODV);
    const int ks = tid >> 6, col = tid & 63;
    for (int task = blockIdx.x; task < DEPTH * 96; task += gridDim.x) {
        const int l = task / 96, j0 = (task % 96) * 64;
        const float* w = p.in[I_WMOD] + (size_t)l * D * NMOD + (size_t)(ks * 128) * NMOD + j0 + col;
        float a0 = 0.f, a1 = 0.f, a2 = 0.f, a3 = 0.f, a4 = 0.f;
#pragma unroll 8
        for (int k = 0; k < 128; ++k) { const float wv = w[(size_t)k * NMOD]; const int kk = ks * 128 + k;
            a0 += sil[kk] * wv; a1 += sil[1024 + kk] * wv; a2 += sil[2048 + kk] * wv; a3 += sil[3072 + kk] * wv; a4 += sil[4096 + kk] * wv; }
        red[(ks * 5 + 0) * 64 + col] = a0; red[(ks * 5 + 1) * 64 + col] = a1; red[(ks * 5 + 2) * 64 + col] = a2; red[(ks * 5 + 3) * 64 + col] = a3; red[(ks * 5 + 4) * 64 + col] = a4;
        __syncthreads();
        if (tid < 320) { const int r = tid >> 6; float s = 0.f;
#pragma unroll
            for (int q = 0; q < 8; ++q) s += red[(q * 5 + r) * 64 + col];
            modv[(size_t)(l * 5 + r) * NMOD + j0 + col] = s + p.in[I_BMOD][l * NMOD + j0 + col]; }
        __syncthreads();
    }
}

__device__ __forceinline__ void ph_convert(const KP& p, LAS unsigned char* lds, int gw, int NGW, int wave, int lane) {
    LAS float* scr = (LAS float*)(lds + wave * 16384);
    bf16* win = (bf16*)(p.ws + WS_WIN); bf16* wout = (bf16*)(p.ws + WS_WOUT); bf16* f13 = (bf16*)(p.ws + WS_F13); bf16* f2 = (bf16*)(p.ws + WS_F2); bf16* lora = (bf16*)(p.ws + WS_LORA);
    constexpr int I_IN = (D / 64) * (NPROJ / 32), I_OUT = (D / 64) * (D / 32), I_UP = (D / 64) * (DFF / 32), I_DN = (DFF / 64) * (D / 32);
    constexpr int T_IN = DEPTH * I_IN, T_OUT = DEPTH * I_OUT, T_UP = 2 * I_UP, T_DN = 2 * I_DN, NITEMS = T_IN + T_OUT + 2 * T_UP + T_DN;
    for (int it = gw; it < NITEMS; it += NGW) {
        int r = it;
        if (r < T_IN) { const int l = r / I_IN; transpose_item<1>(p.in[I_WIN] + (size_t)l * D * NPROJ, D, NPROJ, win + (size_t)l * NP * D, 0, scr, r % I_IN, lane); continue; } r -= T_IN;
        if (r < T_OUT) { const int l = r / I_OUT; transpose_item<0>(p.in[I_WOUT] + (size_t)l * D * D, D, D, wout + (size_t)l * D * D, 0, scr, r % I_OUT, lane); continue; } r -= T_OUT;
        if (r < T_UP) { const int l = r / I_UP; transpose_item<2>(p.in[I_FW1] + (size_t)l * D * DFF, D, DFF, f13 + (size_t)l * 2 * DFF * D, 0, scr, r % I_UP, lane); continue; } r -= T_UP;
        if (r < T_UP) { const int l = r / I_UP; transpose_item<2>(p.in[I_FW3] + (size_t)l * D * DFF, D, DFF, f13 + (size_t)l * 2 * DFF * D, 1, scr, r % I_UP, lane); continue; } r -= T_UP;
        { const int l = r / I_DN; transpose_item<0>(p.in[I_FW2] + (size_t)l * DFF * D, DFF, D, f2 + (size_t)l * D * DFF, 0, scr, r % I_DN, lane); }
    }
    { const int gt = gw * 64 + lane, NGT = NGW * 64; constexpr int PER = (NP - NPROJ) * D / 8;
      for (int i = gt; i < DEPTH * PER; i += NGT) { const int l = i / PER, q = i % PER; *(v4u*)(win + (size_t)l * NP * D + (size_t)NPROJ * D + (size_t)q * 8) = (v4u){0u, 0u, 0u, 0u}; } }
    { const int gt = gw * 64 + lane, NGT = NGW * 64; constexpr int PER = NLO * KLA / 8;
      for (int i = gt; i < DEPTH * PER; i += NGT) { const int l = i / PER, q = i % PER, n = q / (KLA / 8), k0 = (q % (KLA / 8)) * 8; float v[8];
#pragma unroll
          for (int j = 0; j < 8; ++j) { const int k = k0 + j; float x = 0.f;
              if (n < 1024) { const int d = n >> 9, c = n & 511; if (k >= 64 * d && k < 64 * d + 64) x = p.in[I_W2][((size_t)(l * 2 + d) * 64 + (k - 64 * d)) * RW + c]; }
              else if (n < 2048) { const int d = (n - 1024) >> 9, c = n & 511; if (k >= 128 + 64 * d && k < 192 + 64 * d) x = p.in[I_A2][((size_t)(l * 2 + d) * 64 + (k - 128 - 64 * d)) * RW + c]; }
              else { const int c = n - 2048; if (k >= 256 && k < 384) x = p.in[I_G2][((size_t)l * 128 + (k - 256)) * RW + c]; }
              v[j] = x; }
          v4u o; o.x = pk2(v[0], v[1]); o.y = pk2(v[2], v[3]); o.z = pk2(v[4], v[5]); o.w = pk2(v[6], v[7]);
          *(v4u*)(lora + (size_t)l * NLO * KLA + (size_t)n * KLA + k0) = o; } }
}
__device__ __forceinline__ void ph_convert_moe(const KP& p, LAS unsigned char* lds, int mi, int gw, int NGW, int wave, int lane) {
    LAS float* scr = (LAS float*)(lds + wave * 16384);
    bf16* w13 = (bf16*)(p.ws + WS_MOEW13); bf16* w2 = (bf16*)(p.ws + WS_MOEW2);
    constexpr int I_UP = (D / 64) * (DFF / 32), I_DN = (DFF / 64) * (D / 32), T_UP = NE * I_UP, T_DN = NE * I_DN;
    for (int it = gw; it < 2 * T_UP + T_DN; it += NGW) {
        int r = it;
        if (r < T_UP) { const int e = r / I_UP; transpose_item<2>(p.in[I_MW1] + ((size_t)mi * NE + e) * D * DFF, D, DFF, w13 + (size_t)e * 2 * DFF * D, 0, scr, r % I_UP, lane); continue; } r -= T_UP;
        if (r < T_UP) { const int e = r / I_UP; transpose_item<2>(p.in[I_MW3] + ((size_t)mi * NE + e) * D * DFF, D, DFF, w13 + (size_t)e * 2 * DFF * D, 1, scr, r % I_UP, lane); continue; } r -= T_UP;
        { const int e = r / I_DN; transpose_item<0>(p.in[I_MW2] + ((size_t)mi * NE + e) * DFF * D, DFF, D, w2 + (size_t)e * D * DFF, 0, scr, r % I_DN, lane); }
    }
}

__device__ __forceinline__ void ld_row(const float* r, int lane, f32x4 (&v)[4]) { const f32x4* q = (const f32x4*)r + lane;
#pragma unroll
    for (int j = 0; j < 4; ++j) v[j] = q[64 * j]; }
__device__ __forceinline__ void st_row(float* r, int lane, const f32x4 (&v)[4]) { f32x4* q = (f32x4*)r + lane;
#pragma unroll
    for (int j = 0; j < 4; ++j) q[64 * j] = v[j]; }
__device__ __forceinline__ void st_row_bf16(bf16* r, int lane, const f32x4 (&v)[4]) { v2u* q = (v2u*)r + lane;
#pragma unroll
    for (int j = 0; j < 4; ++j) { v2u w; w.x = pk2(v[j][0], v[j][1]); w.y = pk2(v[j][2], v[j][3]); q[64 * j] = w; } }
__device__ __forceinline__ int mod_row(int row) { return row < NLAT ? (row >> 12) : 4; }

__device__ __forceinline__ void ph_init_rows(const KP& p, int gw, int NGW, int lane) {
    const float* modv = (const float*)(p.ws + WS_MODV); float* X = (float*)(p.ws + WS_X); bf16* H = (bf16*)(p.ws + WS_H);
    for (int row = gw; row < MROWS; row += NGW) {
        const float* src = row < NLAT ? p.in[I_X] + (size_t)row * D : p.in[I_CTX] + (size_t)(row - NLAT) * D;
        const float* mv = modv + (size_t)(0 * 5 + mod_row(row)) * NMOD;
        f32x4 x[4], sh[4], sc[4], h[4]; ld_row(src, lane, x); ld_row(mv, lane, sh); ld_row(mv + 1024, lane, sc);
#pragma unroll
        for (int j = 0; j < 4; ++j) h[j] = x[j] * (1.f + sc[j]) + sh[j];
        st_row(X + (size_t)row * D, lane, x); st_row_bf16(H + (size_t)row * D, lane, h);
    }
}

__device__ __forceinline__ void ph_lora_in(const KP& p, int gw, int NGW, int lane) {
    const bf16* P = (const bf16*)(p.ws + WS_P); bf16* LA = (bf16*)(p.ws + WS_LA);
    const int gt = gw * 64 + lane, NGT = NGW * 64;
    for (int i = gt; i < MROWS * (KLA / 8); i += NGT) { const int row = i >> 6, k0 = (i & 63) * 8; v4u o = (v4u){0u, 0u, 0u, 0u};
        if (k0 < 384) { const v4u s = *(const v4u*)(P + (size_t)row * NP + PC_WD + k0); float v[8] = {bflo(s.x), bfhi(s.x), bflo(s.y), bfhi(s.y), bflo(s.z), bfhi(s.z), bflo(s.w), bfhi(s.w)};
            if (k0 < 128) {
#pragma unroll
                for (int j = 0; j < 8; ++j) v[j] = tanhf(v[j]); }
            else if (k0 >= 256) {
#pragma unroll
                for (int j = 0; j < 8; ++j) v[j] = sigm(v[j]); }
            o.x = pk2(v[0], v[1]); o.y = pk2(v[2], v[3]); o.z = pk2(v[4], v[5]); o.w = pk2(v[6], v[7]); }
        *(v4u*)(LA + (size_t)row * KLA + k0) = o; }
}

__device__ __forceinline__ void ph_prep(const KP& p, int l, int gw, int NGW, int lane) {
    const bf16* P = (const bf16*)(p.ws + WS_P); const float* LO = (const float*)(p.ws + WS_LO); float* PR = (float*)(p.ws + WS_PREP); float* RKS = (float*)(p.ws + WS_RKS);
    constexpr size_t PA = (size_t)MROWS * RW;
    for (int it = gw; it < MROWS * NH; it += NGW) { const int row = it >> 3, h = it & 7, c = h * 64 + lane;
        const float kv = bf2f(P[(size_t)row * NP + PC_K + c]), rv = bf2f(P[(size_t)row * NP + PC_R + c]);
        const float* lo = LO + (size_t)row * NLO;
        float dec[2], a[2];
#pragma unroll
        for (int d = 0; d < 2; ++d) {
            const float wl = p.in[I_W0][(l * 2 + d) * RW + c] + lo[d * RW + c];
            const float z = -wl, sp = z > 20.f ? z : log1pf(expf(z));
            const float w_log = -sp - 0.5f; dec[d] = expf(-expf(w_log));
            a[d] = sigm(p.in[I_A0][(l * 2 + d) * RW + c] + lo[1024 + d * RW + c]);
        }
        float kk = kv * p.in[I_KK][l * RW + c]; const float ss = wave_sum(kk * kk); kk = kk / fmaxf(sqrtf(ss), 1e-12f);
        const float ka = p.in[I_KA][l * RW + c];
        const float kd0 = kv * (1.f + (a[0] - 1.f) * ka), kd1 = kv * (1.f + (a[1] - 1.f) * ka);
        const float rk = wave_sum(rv * (kd0 + kd1) * p.in[I_RK][(l * NH + h) * HS + lane]);
        const size_t o = (size_t)row * RW + c;
        PR[0 * PA + o] = dec[0]; PR[1 * PA + o] = dec[1]; PR[2 * PA + o] = kd0; PR[3 * PA + o] = kd1; PR[4 * PA + o] = kk * a[0]; PR[5 * PA + o] = kk * a[1]; PR[6 * PA + o] = kk;
        if (lane == 0) RKS[row * 8 + h] = rk;
    }
}

__device__ __forceinline__ int scan_row(int b, int dir, int step) { return step < CTXL ? NLAT + b * CTXL + (dir ? CTXL - 1 - step : step) : b * SEQ + (dir ? SEQ - 1 - (step - CTXL) : step - CTXL); }
__device__ __forceinline__ void ph_scan(const KP& p, int wave, int lane) {
    if (wave >= 4) return;
    const bf16* P = (const bf16*)(p.ws + WS_P); const float* PR = (const float*)(p.ws + WS_PREP); float* Y = (float*)(p.ws + WS_Y);
    constexpr size_t PA = (size_t)MROWS * RW; constexpr int NSTEP = CTXL + SEQ;
    for (int wt = blockIdx.x * 4 + wave; wt < 1024; wt += gridDim.x * 4) {
        const int rg = wt & 15, h = (wt >> 4) & 7, b = (wt >> 7) & 3, dir = wt >> 9;
        const int rr = lane >> 4, q = lane & 15, vrow = rg * 4 + rr, ch0 = h * 64 + q * 4;
        const float* Wd = PR + (size_t)dir * PA + ch0; const float* Kd = PR + (size_t)(2 + dir) * PA + ch0; const float* Bd = PR + (size_t)(4 + dir) * PA + ch0; const float* KKp = PR + 6 * PA + ch0;
        float* Yo = Y + (size_t)dir * PA + h * 64 + vrow;
        f32x4 s = (f32x4){0.f, 0.f, 0.f, 0.f};
        f32x4 bw[4], bk[4], bb[4], bq[4]; v2u br[4]; float bv[4];
#pragma unroll
        for (int u = 0; u < 4; ++u) { const size_t ro = (size_t)scan_row(b, dir, u) * RW; const size_t rp = (size_t)scan_row(b, dir, u) * NP;
            bw[u] = *(const f32x4*)(Wd + ro); bk[u] = *(const f32x4*)(Kd + ro); bb[u] = *(const f32x4*)(Bd + ro); bq[u] = *(const f32x4*)(KKp + ro);
            br[u] = *(const v2u*)(P + rp + PC_R + ch0); bv[u] = bf2f(P[rp + PC_V + h * 64 + vrow]); }
        for (int st = 0; st < NSTEP; st += 4) {
#pragma unroll
            for (int u = 0; u < 4; ++u) {
                const f32x4 w = bw[u], kd = bk[u], bvec = bb[u], kk = bq[u]; const v2u rw = br[u]; const float vv = bv[u];
                const int cur = scan_row(b, dir, st + u);
                { const int nstep = st + u + 4 < NSTEP ? st + u + 4 : NSTEP - 1; const int nrow = scan_row(b, dir, nstep); const size_t ro = (size_t)nrow * RW, rp = (size_t)nrow * NP;
                  bw[u] = *(const f32x4*)(Wd + ro); bk[u] = *(const f32x4*)(Kd + ro); bb[u] = *(const f32x4*)(Bd + ro); bq[u] = *(const f32x4*)(KKp + ro);
                  br[u] = *(const v2u*)(P + rp + PC_R + ch0); bv[u] = bf2f(P[rp + PC_V + h * 64 + vrow]); }
                float sa = -((s[0] * kk[0] + s[1] * kk[1]) + (s[2] * kk[2] + s[3] * kk[3]));
                sa += __shfl_xor(sa, 1); sa += __shfl_xor(sa, 2); sa += __shfl_xor(sa, 4); sa += __shfl_xor(sa, 8);
                s = s * w + sa * bvec + vv * kd;
                float y = (s[0] * bflo(rw.x) + s[1] * bfhi(rw.x)) + (s[2] * bflo(rw.y) + s[3] * bfhi(rw.y));
                y += __shfl_xor(y, 1); y += __shfl_xor(y, 2); y += __shfl_xor(y, 4); y += __shfl_xor(y, 8);
                if (q == 0) Yo[(size_t)cur * RW] = y;
            }
        }
    }
}


typedef short sbf16x8 __attribute__((ext_vector_type(8)));
typedef float f32x16 __attribute__((ext_vector_type(16)));
constexpr int SC_C = 32, SC_NCH = (CTXL + SEQ) / SC_C  , SC_NCHAIN = NB * NH * 2  , SC_NTASK = SC_NCH * SC_NCHAIN  ;
constexpr int CH_G = 0, CH_Q = 8192, CH_UT = 12288, CH_YL = 20480, CH_EC = 24576, CH_BYTES = 25600, CH_NLOAD = 26;

__device__ __forceinline__ f32x16 mm(v4u a, v4u b, f32x16 c) { return __builtin_amdgcn_mfma_f32_32x32x16_bf16(__builtin_bit_cast(sbf16x8, a), __builtin_bit_cast(sbf16x8, b), c, 0, 0, 0); }
typedef float f32x2c __attribute__((ext_vector_type(2))); typedef __bf16 bf16x2c __attribute__((ext_vector_type(2)));
__device__ __forceinline__ unsigned cvtpk(float lo, float hi) { return __builtin_bit_cast(unsigned, __builtin_convertvector((f32x2c){lo, hi}, bf16x2c)); }
template <int S, int NEG> __device__ __forceinline__ v4u cvtf(const f32x16& x) {
    v4u w; const float sg = NEG ? -1.f : 1.f;
    w.x = cvtpk(sg * x[8 * S + 0], sg * x[8 * S + 1]); w.y = cvtpk(sg * x[8 * S + 2], sg * x[8 * S + 3]); w.z = cvtpk(sg * x[8 * S + 4], sg * x[8 * S + 5]); w.w = cvtpk(sg * x[8 * S + 6], sg * x[8 * S + 7]); return w; }
template <int MODE  > __device__ __forceinline__ f32x16 mask_acc(f32x16 x, int n, int hh) {
#pragma unroll
    for (int r = 0; r < 16; ++r) { const int m = (r & 3) + 8 * (r >> 2) + 4 * hh; const bool keep = MODE == 0 ? (m > n) : MODE == 1 ? (m < n) : (m <= n); x[r] = keep ? x[r] : 0.f; }
    return x; }
__device__ __forceinline__ f32x16 zero16() { f32x16 z;
#pragma unroll
    for (int r = 0; r < 16; ++r) z[r] = 0.f;
    return z; }
__device__ __forceinline__ void cm_build(const unsigned (&w)[16], v4u (&f)[2][2]) {
#pragma unroll
    for (int s = 0; s < 2; ++s) {
        const auto r0 = __builtin_amdgcn_permlane32_swap(w[8 * s + 0], w[8 * s + 2], false, false), r1 = __builtin_amdgcn_permlane32_swap(w[8 * s + 1], w[8 * s + 3], false, false);
        const auto r2 = __builtin_amdgcn_permlane32_swap(w[8 * s + 4], w[8 * s + 6], false, false), r3 = __builtin_amdgcn_permlane32_swap(w[8 * s + 5], w[8 * s + 7], false, false);
        f[0][s] = (v4u){r0[0], r1[0], r2[0], r3[0]}; f[1][s] = (v4u){r0[1], r1[1], r2[1], r3[1]}; }
}
__device__ __forceinline__ void st16(unsigned char* base, int off, int lane, v4u v) { *(v4u*)(base + off + lane * 16) = v; }

__device__ __forceinline__ void ph_kknorm(const KP& p, int l, int gw, int NGW, int lane) {
    const bf16* P = (const bf16*)(p.ws + WS_P); float* NRM = (float*)(p.ws + WS_RKS);
    for (int it = gw; it < MROWS * NH; it += NGW) { const int row = it >> 3, h = it & 7, c = h * 64 + lane;
        const float kk = bf2f(P[(size_t)row * NP + PC_K + c]) * p.in[I_KK][l * RW + c]; const float ss = wave_sum(kk * kk);
        if (lane == 0) NRM[it] = 1.f / fmaxf(sqrtf(ss), 1e-12f); }
}

__device__ __forceinline__ void ph_scan1(const KP& p, int l, int gw, int NGW, int lane) {
    const bf16* P = (const bf16*)(p.ws + WS_P); const float* LO = (const float*)(p.ws + WS_LO); const float* NRM = (const float*)(p.ws + WS_RKS); unsigned char* CH = p.ws + WS_CH;
    const int n = lane & 31, hh = lane >> 5;
    v4u Id[2];
#pragma unroll
    for (int s = 0; s < 2; ++s) { unsigned wd[4];
#pragma unroll
        for (int q = 0; q < 4; ++q) { const int j0 = 2 * q, j1 = 2 * q + 1; const int t0 = 16 * s + 8 * (j0 >> 2) + 4 * hh + (j0 & 3), t1 = 16 * s + 8 * (j1 >> 2) + 4 * hh + (j1 & 3);
            wd[q] = (t0 == n ? 0x3F80u : 0u) | (t1 == n ? 0x3F800000u : 0u); }
        Id[s] = (v4u){wd[0], wd[1], wd[2], wd[3]}; }
    for (int task = gw; task < SC_NTASK; task += NGW) {
        const int dir = task & 1, h = (task >> 1) & 7, b = (task >> 4) & 3, ci = task >> 6;
        const int row0 = scan_row(b, dir, SC_C * ci), sgn = dir ? -1 : 1, c = h * 64 + lane;
        const float w0c = p.in[I_W0][(l * 2 + dir) * RW + c], a0c = p.in[I_A0][(l * 2 + dir) * RW + c], kkc = p.in[I_KK][l * RW + c], kac = p.in[I_KA][l * RW + c];
        unsigned wAl[16], wBe[16], wKa[16], wRh[16], wV[16], wBp[16], wKp[16];
        float cs = 0.f, Eprev = 1.f;
#pragma unroll
        for (int hb = 0; hb < 2; ++hb) {
            unsigned rk_[16], rr_[16], rv_[16]; float rw_[16], ra_[16], rn_[16];
#pragma unroll
            for (int i = 0; i < 16; ++i) { const int row = row0 + sgn * (16 * hb + i); const bf16* pr = P + (size_t)row * NP; const float* lo = LO + (size_t)row * NLO;
                rk_[i] = pr[PC_K + c]; rr_[i] = pr[PC_R + c]; rv_[i] = pr[PC_V + c]; rw_[i] = lo[dir * RW + c]; ra_[i] = lo[1024 + dir * RW + c]; rn_[i] = NRM[row * 8 + h]; }
#pragma unroll
            for (int i = 0; i < 16; ++i) asm volatile("" : "+v"(rk_[i]), "+v"(rr_[i]), "+v"(rv_[i]), "+v"(rw_[i]), "+v"(ra_[i]), "+v"(rn_[i]));
#pragma unroll
            for (int pq = 0; pq < 8; ++pq) { const int pz = 8 * hb + pq; float al[2], be[2], ka[2], rh[2], vv[2];
#pragma unroll
                for (int e = 0; e < 2; ++e) { const int i = 2 * pq + e;
                    const float kv = bf2f((unsigned short)rk_[i]), rv = bf2f((unsigned short)rr_[i]); vv[e] = bf2f((unsigned short)rv_[i]);
                    const float wl = w0c + rw_[i], aa = __builtin_amdgcn_rcpf(1.f + __expf(-(a0c + ra_[i]))), nrm = rn_[i];
                    const float lw = -0.6065306597f * __builtin_amdgcn_rcpf(1.f + __expf(-wl));
                    cs += lw; const float E = __expf(cs), Ei = __builtin_amdgcn_rcpf(E);
                    const float kkn = kv * kkc * nrm, kd = kv * (1.f + (aa - 1.f) * kac);
                    al[e] = kkn * Eprev; be[e] = kkn * aa * Ei; ka[e] = kd * Ei; rh[e] = rv * E; Eprev = E; }
                wAl[pz] = cvtpk(al[0], al[1]); wBe[pz] = cvtpk(be[0], be[1]); wKa[pz] = cvtpk(ka[0], ka[1]); wRh[pz] = cvtpk(rh[0], rh[1]); wV[pz] = cvtpk(vv[0], vv[1]); }
        }
        const float EC = Eprev;
#pragma unroll
        for (int pz = 0; pz < 16; ++pz) { wBp[pz] = cvtpk(bflo(wBe[pz]) * EC, bfhi(wBe[pz]) * EC); wKp[pz] = cvtpk(bflo(wKa[pz]) * EC, bfhi(wKa[pz]) * EC); }
        unsigned char* img = CH + (size_t)(((b * 8 + h) * 2 + dir) * SC_NCH + ci) * CH_BYTES;
        ((float*)(img + CH_EC))[lane] = EC;
        v4u cAl[2][2], cV[2][2], cBp[2][2], cKp[2][2], cRh[2][2];
        v4u tAl[4], tBe[4], tKa[4], tRh[4];
        cm_build(wAl, cAl); cm_build(wV, cV); cm_build(wBp, cBp); cm_build(wKp, cKp); cm_build(wRh, cRh);
        {   v4u cBe[2][2], cKa[2][2]; cm_build(wBe, cBe); cm_build(wKa, cKa);
#define TRANSPOSE(cZ, tZ) do { _Pragma("unroll") for (int ct = 0; ct < 2; ++ct) { f32x16 T_ = mm(cZ[ct][0], Id[0], zero16()); T_ = mm(cZ[ct][1], Id[1], T_); tZ[2 * ct] = cvtf<0, 0>(T_); tZ[2 * ct + 1] = cvtf<1, 0>(T_); } } while (0)
            TRANSPOSE(cAl, tAl); TRANSPOSE(cBe, tBe); TRANSPOSE(cKa, tKa); TRANSPOSE(cRh, tRh);
#undef TRANSPOSE
        }
#define PROD4(A, B) mm(A[3], B[3], mm(A[2], B[2], mm(A[1], B[1], mm(A[0], B[0], zero16()))))
        f32x16 XN = mask_acc<0>(PROD4(tAl, tBe), n, hh), XT = mask_acc<1>(PROD4(tBe, tAl), n, hh);
        v4u fLM[2], fGB[2], fGK[2];
        { const f32x16 t = mask_acc<1>(PROD4(tKa, tAl), n, hh); fLM[0] = cvtf<0, 0>(t); fLM[1] = cvtf<1, 0>(t); }
        { const f32x16 t = mask_acc<2>(PROD4(tBe, tRh), n, hh); fGB[0] = cvtf<0, 0>(t); fGB[1] = cvtf<1, 0>(t); }
        { const f32x16 t = mask_acc<2>(PROD4(tKa, tRh), n, hh); fGK[0] = cvtf<0, 0>(t); fGK[1] = cvtf<1, 0>(t); }
#undef PROD4
#pragma unroll
        for (int r = 0; r < 16; ++r) { XN[r] = -XN[r]; XT[r] = -XT[r]; }
        f32x16 RT = XT;
#pragma unroll
        for (int r = 0; r < 16; ++r) RT[r] += ((r & 3) + 8 * (r >> 2) + 4 * hh == n) ? 1.f : 0.f;
#pragma unroll
        for (int pw = 1; pw < 5; ++pw) {
            const v4u xn0 = cvtf<0, 0>(XN), xn1 = cvtf<1, 0>(XN), xt0 = cvtf<0, 0>(XT), xt1 = cvtf<1, 0>(XT);
            XN = mm(xt1, xn1, mm(xt0, xn0, zero16()));
            if (pw < 4) XT = mm(xn1, xt1, mm(xn0, xt0, zero16()));
            const v4u yn0 = cvtf<0, 0>(XN), yn1 = cvtf<1, 0>(XN), rt0 = cvtf<0, 0>(RT), rt1 = cvtf<1, 0>(RT);
            RT = mm(yn1, rt1, mm(yn0, rt0, RT));
        }
        const v4u fA0 = cvtf<0, 0>(RT), fA1 = cvtf<1, 0>(RT);
        f32x16 At[2], Vt[2];
#pragma unroll
        for (int t = 0; t < 2; ++t) {
            const f32x16 lmv = mm(fLM[1], cV[t][1], mm(fLM[0], cV[t][0], zero16()));
            At[t] = mm(fA1, cAl[t][1], mm(fA0, cAl[t][0], zero16()));
            Vt[t] = mm(fA1, cvtf<1, 0>(lmv), mm(fA0, cvtf<0, 0>(lmv), zero16()));
        }
#pragma unroll
        for (int kt1 = 0; kt1 < 2; ++kt1) { const v4u a0 = cvtf<0, 0>(At[kt1]), a1 = cvtf<1, 0>(At[kt1]);
#pragma unroll
            for (int kt2 = 0; kt2 < 2; ++kt2) { const f32x16 g = mm(a1, cBp[kt2][1], mm(a0, cBp[kt2][0], zero16()));
                st16(img, CH_G + ((kt2 * 2 + kt1) * 2 + 0) * 1024, lane, cvtf<0, 1>(g)); st16(img, CH_G + ((kt2 * 2 + kt1) * 2 + 1) * 1024, lane, cvtf<1, 1>(g)); } }
#pragma unroll
        for (int vt = 0; vt < 2; ++vt) { const v4u nv0 = cvtf<0, 1>(Vt[vt]), nv1 = cvtf<1, 1>(Vt[vt]);
#pragma unroll
            for (int kt = 0; kt < 2; ++kt) { f32x16 u = mm(cKp[kt][1], cV[vt][1], mm(cKp[kt][0], cV[vt][0], zero16())); u = mm(cBp[kt][1], nv1, mm(cBp[kt][0], nv0, u));
                st16(img, CH_UT + ((kt * 2 + vt) * 2 + 0) * 1024, lane, cvtf<0, 0>(u)); st16(img, CH_UT + ((kt * 2 + vt) * 2 + 1) * 1024, lane, cvtf<1, 0>(u)); }
            f32x16 y = mm(cV[vt][1], fGK[1], mm(cV[vt][0], fGK[0], zero16())); y = mm(nv1, fGB[1], mm(nv0, fGB[0], y));
            st16(img, CH_YL + (vt * 2 + 0) * 1024, lane, cvtf<0, 0>(y)); st16(img, CH_YL + (vt * 2 + 1) * 1024, lane, cvtf<1, 0>(y)); }
#pragma unroll
        for (int kt = 0; kt < 2; ++kt) { f32x16 q = mm(cRh[kt][1], Id[1], mm(cRh[kt][0], Id[0], zero16()));
            q = mm(cvtf<1, 1>(At[kt]), fGB[1], mm(cvtf<0, 1>(At[kt]), fGB[0], q));
            st16(img, CH_Q + (kt * 2 + 0) * 1024, lane, cvtf<0, 0>(q)); st16(img, CH_Q + (kt * 2 + 1) * 1024, lane, cvtf<1, 0>(q)); }
    }
}

__device__ __forceinline__ void ph_scan2(const KP& p, LAS unsigned char* lds, int wave, int lane) {
    if (blockIdx.x >= SC_NCHAIN * 2) return;
    const int chain = blockIdx.x >> 1, vt = blockIdx.x & 1, dir = chain & 1, h = (chain >> 1) & 7, b = chain >> 4;
    const int n = lane & 31, hh = lane >> 5;
    const unsigned char* CH = p.ws + WS_CH + (size_t)chain * SC_NCH * CH_BYTES; float* Y = (float*)(p.ws + WS_Y) + (size_t)dir * MROWS * RW + h * 64 + 32 * vt + 4 * hh;
    constexpr int NPIECE = 19, SLOT = NPIECE * 1024;
    int psrc[3], pdst[3];
#pragma unroll
    for (int j = 0; j < 3; ++j) { int f = wave + 8 * j; if (f >= NPIECE) f -= NPIECE;
        pdst[j] = f;
        psrc[j] = f < 12 ? f * 1024 : f < 16 ? CH_UT + ((((f - 12) >> 1) * 2 + vt) * 2 + ((f - 12) & 1)) * 1024 : f < 18 ? CH_YL + (vt * 2 + (f - 16)) * 1024 : CH_EC; }
    const int lane_off[3] = {pdst[0] == 18 ? (lane * 16) & 255 : lane * 16, pdst[1] == 18 ? (lane * 16) & 255 : lane * 16, pdst[2] == 18 ? (lane * 16) & 255 : lane * 16};
#define SC2_ISSUE(ci_, slot_) do { const unsigned char* im_ = CH + (size_t)(ci_) * CH_BYTES; LAS unsigned char* sl_ = lds + (slot_) * SLOT; \
        _Pragma("unroll") for (int j = 0; j < 3; ++j) __builtin_amdgcn_global_load_lds((const unsigned*)(im_ + psrc[j] + lane_off[j]), (LAS unsigned*)(sl_ + pdst[j] * 1024), 16, 0, 0); } while (0)
#define SC2_LD(slot_, piece_) (*(const LAS v4u*)(lds + (slot_) * SLOT + (piece_) * 1024 + lane * 16))
    f32x16 ST[2] = {zero16(), zero16()};
    SC2_ISSUE(0, 0); SC2_ISSUE(1, 1);
    for (int ci = 0; ci < SC_NCH; ++ci) {
        const int slot = ci % 3;
        asm volatile("s_waitcnt vmcnt(3)" ::: "memory");
        __builtin_amdgcn_s_barrier();
        asm volatile("" ::: "memory");
        { const int nx = ci + 2 < SC_NCH ? ci + 2 : SC_NCH - 1; SC2_ISSUE(nx, (ci + 2) % 3); }
        if (wave != 0) continue;
        const v4u s00 = cvtf<0, 0>(ST[0]), s01 = cvtf<1, 0>(ST[0]), s10 = cvtf<0, 0>(ST[1]), s11 = cvtf<1, 0>(ST[1]);
        f32x16 y;
        { const v4u a = SC2_LD(slot, 16), c = SC2_LD(slot, 17);
          y[0] = bflo(a.x); y[1] = bfhi(a.x); y[2] = bflo(a.y); y[3] = bfhi(a.y); y[4] = bflo(a.z); y[5] = bfhi(a.z); y[6] = bflo(a.w); y[7] = bfhi(a.w);
          y[8] = bflo(c.x); y[9] = bfhi(c.x); y[10] = bflo(c.y); y[11] = bfhi(c.y); y[12] = bflo(c.z); y[13] = bfhi(c.z); y[14] = bflo(c.w); y[15] = bfhi(c.w); }
        y = mm(s00, SC2_LD(slot, 8), y); y = mm(s01, SC2_LD(slot, 9), y); y = mm(s10, SC2_LD(slot, 10), y); y = mm(s11, SC2_LD(slot, 11), y);
        { const int row = scan_row(b, dir, SC_C * ci + n); float* yo = Y + (size_t)row * RW;
#pragma unroll
          for (int q = 0; q < 4; ++q) *(f32x4*)(yo + 8 * q) = (f32x4){y[4 * q], y[4 * q + 1], y[4 * q + 2], y[4 * q + 3]}; }
#pragma unroll
        for (int kt2 = 0; kt2 < 2; ++kt2) { f32x16 a;
            const v4u u0 = SC2_LD(slot, 12 + kt2 * 2), u1 = SC2_LD(slot, 13 + kt2 * 2);
            a[0] = bflo(u0.x); a[1] = bfhi(u0.x); a[2] = bflo(u0.y); a[3] = bfhi(u0.y); a[4] = bflo(u0.z); a[5] = bfhi(u0.z); a[6] = bflo(u0.w); a[7] = bfhi(u0.w);
            a[8] = bflo(u1.x); a[9] = bfhi(u1.x); a[10] = bflo(u1.y); a[11] = bfhi(u1.y); a[12] = bflo(u1.z); a[13] = bfhi(u1.z); a[14] = bflo(u1.w); a[15] = bfhi(u1.w);
#pragma unroll
            for (int q = 0; q < 4; ++q) { const f32x4 ec = *(const LAS f32x4*)(lds + slot * SLOT + 18 * 1024 + (32 * kt2 + 8 * q + 4 * hh) * 4);
#pragma unroll
                for (int e = 0; e < 4; ++e) a[4 * q + e] += ST[kt2][4 * q + e] * ec[e]; }
            a = mm(SC2_LD(slot, (kt2 * 2 + 0) * 2 + 0), s00, a); a = mm(SC2_LD(slot, (kt2 * 2 + 0) * 2 + 1), s01, a);
            a = mm(SC2_LD(slot, (kt2 * 2 + 1) * 2 + 0), s10, a); a = mm(SC2_LD(slot, (kt2 * 2 + 1) * 2 + 1), s11, a);
            ST[kt2] = a; }
        asm volatile("s_waitcnt lgkmcnt(0)" ::: "memory");
    }
    asm volatile("s_waitcnt vmcnt(0)" ::: "memory");
#undef SC2_ISSUE
#undef SC2_LD
}


__device__ __forceinline__ float sum8(float v) { v += __shfl_xor(v, 1); v += __shfl_xor(v, 2); v += __shfl_xor(v, 4); return v; }
__device__ __forceinline__ void unpack8(v4u s, float (&v)[8]) { v[0] = bflo(s.x); v[1] = bfhi(s.x); v[2] = bflo(s.y); v[3] = bfhi(s.y); v[4] = bflo(s.z); v[5] = bfhi(s.z); v[6] = bflo(s.w); v[7] = bfhi(s.w); }
__device__ __forceinline__ void ld8f(const float* q, float (&v)[8]) { const f32x4 a = *(const f32x4*)q, b = *(const f32x4*)(q + 4); v[0] = a[0]; v[1] = a[1]; v[2] = a[2]; v[3] = a[3]; v[4] = b[0]; v[5] = b[1]; v[6] = b[2]; v[7] = b[3]; }
__device__ __forceinline__ v4u pack8(const float (&v)[8]) { v4u o; o.x = cvtpk(v[0], v[1]); o.y = cvtpk(v[2], v[3]); o.z = cvtpk(v[4], v[5]); o.w = cvtpk(v[6], v[7]); return o; }

__device__ __forceinline__ void ph_post_inproj(const KP& p, int l, int gw, int NGW, int lane) {
    const bf16* P = (const bf16*)(p.ws + WS_P); bf16* LA = (bf16*)(p.ws + WS_LA); float* NRM = (float*)(p.ws + WS_RKS);
    float kkc[8]; ld8f(p.in[I_KK] + l * RW + lane * 8, kkc);
    for (int row = gw; row < MROWS; row += NGW) { const bf16* pr = P + (size_t)row * NP;
        const v4u kw = *(const v4u*)(pr + PC_K + lane * 8); v4u sw = (v4u){0u, 0u, 0u, 0u}; if (lane < 48) sw = *(const v4u*)(pr + PC_WD + lane * 8);
        float kv[8]; unpack8(kw, kv); float ss = 0.f;
#pragma unroll
        for (int j = 0; j < 8; ++j) { const float t = kv[j] * kkc[j]; ss += t * t; }
        ss = sum8(ss); if ((lane & 7) == 0) NRM[row * 8 + (lane >> 3)] = 1.f / fmaxf(sqrtf(ss), 1e-12f);
        float v[8]; unpack8(sw, v);
        if (lane < 16) {
#pragma unroll
            for (int j = 0; j < 8; ++j) v[j] = tanhf(v[j]); }
        else if (lane >= 32) {
#pragma unroll
            for (int j = 0; j < 8; ++j) v[j] = sigm(v[j]); }
        v4u o = pack8(v); if (lane >= 48) o = (v4u){0u, 0u, 0u, 0u};
        *(v4u*)(LA + (size_t)row * KLA + lane * 8) = o; }
}

__device__ __forceinline__ void ph_readout2(const KP& p, int l, int gw, int NGW, int lane) {
    const bf16* P = (const bf16*)(p.ws + WS_P); const float* LO = (const float*)(p.ws + WS_LO); const float* Y = (const float*)(p.ws + WS_Y);
    bf16* MI = (bf16*)(p.ws + WS_MIXIN); constexpr size_t PA = (size_t)MROWS * RW; const int c0 = lane * 8;
    for (int row = gw; row < MROWS; row += NGW) { const bf16* pr = P + (size_t)row * NP; const float* lo = LO + (size_t)row * NLO;
        int t, len; if (row < NLAT) { t = row & 63; len = 64; } else { t = (row - NLAT) & 255; len = 256; }
        const v4u kw = *(const v4u*)(pr + PC_K + c0), rw = *(const v4u*)(pr + PC_R + c0), vw = *(const v4u*)(pr + PC_V + c0);
        const v4u cbw = *(const v4u*)(pr + PC_CB + c0), ccw = *(const v4u*)(pr + PC_CC + c0), chw = *(const v4u*)(pr + PC_CH + c0);
        v4u ccp = (v4u){0u, 0u, 0u, 0u}, chp = ccp, ccn = ccp, chn = ccp;
        if (t > 0) { ccp = *(const v4u*)(pr - NP + PC_CC + c0); chp = *(const v4u*)(pr - NP + PC_CH + c0); }
        if (t < len - 1) { ccn = *(const v4u*)(pr + NP + PC_CC + c0); chn = *(const v4u*)(pr + NP + PC_CH + c0); }
        float yf[8], yb[8], la0[8], la1[8], g[8];
        ld8f(Y + (size_t)row * RW + c0, yf); ld8f(Y + PA + (size_t)row * RW + c0, yb); ld8f(lo + 1024 + c0, la0); ld8f(lo + 1536 + c0, la1); ld8f(lo + 2048 + c0, g);
        float a0[8], a1[8], ka[8], rkp[8], lg[8], lb[8];
        ld8f(p.in[I_A0] + (l * 2 + 0) * RW + c0, a0); ld8f(p.in[I_A0] + (l * 2 + 1) * RW + c0, a1); ld8f(p.in[I_KA] + l * RW + c0, ka); ld8f(p.in[I_RK] + l * RW + c0, rkp);
        ld8f(p.in[I_LNXG] + l * RW + c0, lg); ld8f(p.in[I_LNXB] + l * RW + c0, lb);
        float kv[8], rv[8], vv[8]; unpack8(kw, kv); unpack8(rw, rv); unpack8(vw, vv);
        float y[8], s = 0.f, rk = 0.f;
#pragma unroll
        for (int j = 0; j < 8; ++j) { y[j] = yf[j] + yb[j]; s += y[j]; const float av = sigm(a0[j] + la0[j]) + sigm(a1[j] + la1[j]); rk += rv[j] * kv[j] * (2.f + (av - 2.f) * ka[j]) * rkp[j]; }
        const float mu = sum8(s) * (1.f / 64.f); rk = sum8(rk); float q = 0.f;
#pragma unroll
        for (int j = 0; j < 8; ++j) { y[j] -= mu; q += y[j] * y[j]; }
        const float rstd = 1.f / sqrtf(sum8(q) * (1.f / 64.f) + GN_EPS);
        float o[8];
#pragma unroll
        for (int j = 0; j < 8; ++j) o[j] = (y[j] * rstd * lg[j] + lb[j] + rk * vv[j]) * g[j];
        *(v4u*)(MI + (size_t)row * D + c0) = pack8(o);
        float cb[8], cc[8], ch[8], pcc[8], pch[8], ncc[8], nch[8], w0[8], w1[8], w2[8];
        unpack8(cbw, cb); unpack8(ccw, cc); unpack8(chw, ch); unpack8(ccp, pcc); unpack8(chp, pch); unpack8(ccn, ncc); unpack8(chn, nch);
        const float* cw = p.in[I_CONVW] + (size_t)l * 3 * RW + c0; ld8f(cw, w0); ld8f(cw + RW, w1); ld8f(cw + 2 * RW, w2);
#pragma unroll
        for (int j = 0; j < 8; ++j) o[j] = cb[j] * (pcc[j] * pch[j] * w0[j] + cc[j] * ch[j] * w1[j] + ncc[j] * nch[j] * w2[j]);
        *(v4u*)(MI + (size_t)row * D + RW + c0) = pack8(o);
    }
}

__device__ __forceinline__ void ph_readout(const KP& p, int l, int gw, int NGW, int lane) {
    const bf16* P = (const bf16*)(p.ws + WS_P); const float* LO = (const float*)(p.ws + WS_LO); const float* Y = (const float*)(p.ws + WS_Y);
    bf16* MI = (bf16*)(p.ws + WS_MIXIN); constexpr size_t PA = (size_t)MROWS * RW;
    for (int it = gw; it < MROWS * NH; it += NGW) { const int row = it >> 3, h = it & 7, c = h * 64 + lane;
        const float y = Y[(size_t)row * RW + c] + Y[PA + (size_t)row * RW + c];
        const float mu = wave_sum(y) * (1.f / 64.f), dv = y - mu, var = wave_sum(dv * dv) * (1.f / 64.f);
        const float yn = dv / sqrtf(var + GN_EPS);
        const bf16* pr = P + (size_t)row * NP;
        const float v = bf2f(pr[PC_V + c]);
        const float kv = bf2f(pr[PC_K + c]), rv = bf2f(pr[PC_R + c]);
        const float a0v = sigm(p.in[I_A0][(l * 2 + 0) * RW + c] + LO[(size_t)row * NLO + 1024 + c]), a1v = sigm(p.in[I_A0][(l * 2 + 1) * RW + c] + LO[(size_t)row * NLO + 1536 + c]);
        const float rk = wave_sum(rv * kv * (2.f + (a0v + a1v - 2.f) * p.in[I_KA][l * RW + c]) * p.in[I_RK][(l * NH + h) * HS + lane]);
        const float o = yn * p.in[I_LNXG][l * RW + c] + p.in[I_LNXB][l * RW + c] + rk * v;
        const float g = LO[(size_t)row * NLO + 2048 + c];
        MI[(size_t)row * D + c] = (bf16)f2bf(o * g);
        int t, len; if (row < NLAT) { t = row & 63; len = 64; } else { t = (row - NLAT) & 255; len = 256; }
        const float uc = bf2f(pr[PC_CC + c]) * bf2f(pr[PC_CH + c]);
        const float up = t > 0 ? bf2f(pr[PC_CC + c - NP]) * bf2f(pr[PC_CH + c - NP]) : 0.f;
        const float un = t < len - 1 ? bf2f(pr[PC_CC + c + NP]) * bf2f(pr[PC_CH + c + NP]) : 0.f;
        const float* cw = p.in[I_CONVW] + (size_t)l * 3 * RW;
        const float cv = up * cw[c] + uc * cw[RW + c] + un * cw[2 * RW + c];
        MI[(size_t)row * D + RW + c] = (bf16)f2bf(bf2f(pr[PC_CB + c]) * cv);
    }
}


__device__ __forceinline__ void ph_moe_gather(const KP& p, int l, int gw, int NGW, int lane) {
    const unsigned* gcnt = (const unsigned*)(p.ws + WS_CTL) + CW_GCNT + 64 * (l >> 1);
    int cnt[8], pb[9]; pb[0] = 0;
#pragma unroll
    for (int e = 0; e < 8; ++e) { cnt[e] = (int)gcnt[e]; pb[e + 1] = pb[e] + ((cnt[e] + 255) & ~255); }
    const unsigned* rowlist = (const unsigned*)(p.ws + WS_ROWLIST); const float* wsel = (const float*)(p.ws + WS_WSEL); float* wsort = (float*)(p.ws + WS_WSORT);
    const bf16* H = (const bf16*)(p.ws + WS_H); bf16* HG = (bf16*)(p.ws + WS_HG);
    for (int pos = gw; pos < pb[8]; pos += NGW) {
        int e = 0, base = 0, ce = cnt[0];
#pragma unroll
        for (int k = 1; k < 8; ++k) if (pos >= pb[k]) { e = k; base = pb[k]; ce = cnt[k]; }
        const int rank = pos - base; v4u a = (v4u){0u, 0u, 0u, 0u}, b = a; float w = 0.f;
        if (rank < ce) { const unsigned ent = rowlist[(size_t)e * MROWS + rank]; const v4u* src = (const v4u*)(H + (size_t)(ent >> 1) * D); a = src[lane]; b = src[64 + lane]; w = wsel[ent]; }
        v4u* dst = (v4u*)(HG + (size_t)pos * D); dst[lane] = a; dst[64 + lane] = b;
        if (lane == 0) wsort[pos] = w;
    }
}

__device__ __forceinline__ void ph_ln(const KP& p, LAS unsigned char* lds, int l, int which, int tid, int wave, int gw, int NGW, int lane) {
    const float* modv = (const float*)(p.ws + WS_MODV); float* X = (float*)(p.ws + WS_X); bf16* H = (bf16*)(p.ws + WS_H);
    const float* BR = (const float*)(p.ws + (which == 0 ? WS_MIXO : WS_F));
    const float* lg = p.in[which == 0 ? I_LN1G : I_LN2G] + l * D; const float* lb = p.in[which == 0 ? I_LN1B : I_LN2B] + l * D;
    const bool moe = (which == 0) && (l & 1); const bool last = (which == 1) && (l == DEPTH - 1); const bool moe_out = (which == 1) && (l & 1);
    LAS int* lcnt = (LAS int*)lds;
    LAS int* lsel = (LAS int*)(lds + 64);
    int nloc = 0;
    if (moe) { if (tid < 16) lcnt[tid] = 0; __syncthreads(); }
    int pbs[9]; pbs[0] = 0;
    if (moe_out) { const unsigned* gcnt = (const unsigned*)(p.ws + WS_CTL) + CW_GCNT + 64 * (l >> 1);
#pragma unroll
        for (int e = 0; e < 8; ++e) pbs[e + 1] = pbs[e] + (int)((gcnt[e] + 255u) & ~255u); }
    for (int row = gw; row < MROWS; row += NGW) {
        const int mr = mod_row(row); const float* mv = modv + (size_t)(l * 5 + mr) * NMOD;
        f32x4 x[4], br[4], gt[4], t[4]; ld_row(X + (size_t)row * D, lane, x); ld_row(mv + (which == 0 ? 2048 : 5120), lane, gt);
        if (moe_out) { const int* ts = (const int*)(p.ws + WS_TOKSEL) + row * 4; const int e0 = ts[0], r0 = ts[1], e1 = ts[2], r1 = ts[3]; int b0 = 0, b1 = 0;
#pragma unroll
            for (int k = 1; k < 8; ++k) { if (e0 >= k) b0 = pbs[k]; if (e1 >= k) b1 = pbs[k]; }
            f32x4 ba[4], bb[4]; ld_row(BR + (size_t)(b0 + r0) * D, lane, ba); ld_row(BR + (size_t)(b1 + r1) * D, lane, bb);
#pragma unroll
            for (int j = 0; j < 4; ++j) br[j] = ba[j] + bb[j]; }
        else ld_row(BR + (size_t)row * D, lane, br);
        float s = 0.f;
#pragma unroll
        for (int j = 0; j < 4; ++j) { t[j] = DN_ALPHA * x[j] + gt[j] * br[j]; s += (t[j][0] + t[j][1]) + (t[j][2] + t[j][3]); }
        const float mean = wave_sum(s) * (1.f / D); float s2 = 0.f;
#pragma unroll
        for (int j = 0; j < 4; ++j) { t[j] = t[j] - mean; s2 += (t[j][0] * t[j][0] + t[j][1] * t[j][1]) + (t[j][2] * t[j][2] + t[j][3] * t[j][3]); }
        const float rstd = 1.f / sqrtf(wave_sum(s2) * (1.f / D) + LN_EPS);
        f32x4 g4[4], b4[4]; ld_row(lg, lane, g4); ld_row(lb, lane, b4);
#pragma unroll
        for (int j = 0; j < 4; ++j) x[j] = t[j] * rstd * g4[j] + b4[j];
        if (last) { if (row < NLAT) st_row(p.out + (size_t)row * D, lane, x); continue; }
        st_row(X + (size_t)row * D, lane, x);
        const float* mv2 = which == 0 ? mv + 3072 : modv + (size_t)((l + 1) * 5 + mr) * NMOD;
        f32x4 sh[4], sc[4], hh[4]; ld_row(mv2, lane, sh); ld_row(mv2 + 1024, lane, sc);
#pragma unroll
        for (int j = 0; j < 4; ++j) hh[j] = x[j] * (1.f + sc[j]) + sh[j];
        st_row_bf16(H + (size_t)row * D, lane, hh);
        if (moe) {
            const float* rw = p.in[I_RTW] + (size_t)(l >> 1) * D * NE; float lgt[8];
#pragma unroll
            for (int e = 0; e < 8; ++e) lgt[e] = 0.f;
#pragma unroll
            for (int j = 0; j < 4; ++j)
#pragma unroll
                for (int i = 0; i < 4; ++i) { const f32x4* wp = (const f32x4*)(rw + (size_t)(4 * lane + 256 * j + i) * NE); const f32x4 w0 = wp[0], w1 = wp[1]; const float hv = hh[j][i];
                    lgt[0] += hv * w0[0]; lgt[1] += hv * w0[1]; lgt[2] += hv * w0[2]; lgt[3] += hv * w0[3]; lgt[4] += hv * w1[0]; lgt[5] += hv * w1[1]; lgt[6] += hv * w1[2]; lgt[7] += hv * w1[3]; }
#pragma unroll
            for (int e = 0; e < 8; ++e) lgt[e] = wave_sum(lgt[e]) + p.in[I_RTB][(l >> 1) * NE + e];
            float v0 = lgt[0]; int i0 = 0;
#pragma unroll
            for (int e = 1; e < 8; ++e) if (lgt[e] > v0) { v0 = lgt[e]; i0 = e; }
            float v1 = -3.0e38f; int i1 = -1;
#pragma unroll
            for (int e = 0; e < 8; ++e) if (e != i0 && lgt[e] > v1) { v1 = lgt[e]; i1 = e; }
            const float w0 = 1.f / (1.f + expf(v1 - v0)), w1 = 1.f - w0;
            if (lane == 0) { const int lr0 = __hip_atomic_fetch_add(lcnt + i0, 1, __ATOMIC_RELAXED, __HIP_MEMORY_SCOPE_WORKGROUP), lr1 = __hip_atomic_fetch_add(lcnt + i1, 1, __ATOMIC_RELAXED, __HIP_MEMORY_SCOPE_WORKGROUP); const int li = nloc * NWAVES + wave;
                lsel[li * 8 + 0] = row; lsel[li * 8 + 1] = i0; lsel[li * 8 + 2] = lr0; lsel[li * 8 + 3] = i1; lsel[li * 8 + 4] = lr1;
                ((float*)(p.ws + WS_WSEL))[row * 2] = w0; ((float*)(p.ws + WS_WSEL))[row * 2 + 1] = w1; }
            ++nloc;
        }
    }
    if (moe) {
        __syncthreads();
        unsigned* gcnt = (unsigned*)(p.ws + WS_CTL) + CW_GCNT + 64 * (l >> 1);
        if (tid < 8) lcnt[8 + tid] = (int)__hip_atomic_fetch_add(gcnt + tid, (unsigned)lcnt[tid], __ATOMIC_RELAXED, __HIP_MEMORY_SCOPE_AGENT);
        __syncthreads();
        unsigned* rowlist = (unsigned*)(p.ws + WS_ROWLIST); int* toksel = (int*)(p.ws + WS_TOKSEL);
        if (tid < 16 * NWAVES) { const int k = tid / NWAVES, w = tid % NWAVES; if (k * NGW + (int)blockIdx.x * NWAVES + w < MROWS) { const int li = k * NWAVES + w;
            const int row = lsel[li * 8 + 0], e0 = lsel[li * 8 + 1], r0 = lcnt[8 + e0] + lsel[li * 8 + 2], e1 = lsel[li * 8 + 3], r1 = lcnt[8 + e1] + lsel[li * 8 + 4];
            rowlist[(size_t)e0 * MROWS + r0] = (unsigned)row * 2u; rowlist[(size_t)e1 * MROWS + r1] = (unsigned)row * 2u + 1u;
            toksel[row * 4 + 0] = e0; toksel[row * 4 + 1] = r0; toksel[row * 4 + 2] = e1; toksel[row * 4 + 3] = r1; } }
    }
}

__global__ void __launch_bounds__(NWAVES * 64, 2) fwd_kernel(KP p) {
    extern __shared__ __attribute__((aligned(16))) unsigned char lds_raw[];
    LAS unsigned char* lds = (LAS unsigned char*)lds_raw;
    volatile LAS unsigned* MISC = (volatile LAS unsigned*)(lds + MISC_OFF);
    const int G = gridDim.x, NGW = G * NWAVES;
    for (int u = threadIdx.x; u < (LDS_BYTES - LDSCTL_OFF) / 4; u += NWAVES * 64) ((LAS unsigned*)(lds + LDSCTL_OFF))[u] = 0u;
    __syncthreads();
    unsigned* ctl = (unsigned*)(p.ws + WS_CTL);
    const bool single = p.ph < 0;
    XcdBarrier bar; bar.bar = ctl + CW_BAR; bar.x = 0; bar.st = nullptr;
    if (single) bar = xcd_barrier_post(ctl + CW_BAR, MISC + 8);
    int phc = 0;
#ifndef PROBE_DUP
#define PROBE_DUP 0
#endif
#define REP(bit) for (int rep_ = 0; rep_ < ((PROBE_DUP & (bit)) ? 2 : 1); ++rep_)
#define RUN() (single || p.ph == phc)
#define FRESH() int tid = threadIdx.x; asm volatile("" : "+v"(tid)); const int lane = tid & 63, wave = __builtin_amdgcn_readfirstlane(tid >> 6), gw = blockIdx.x * NWAVES + wave; (void)lane; (void)gw
#define SEAM() do { if (single) { XcdBarrier b2_ = bar; asm volatile("" : "+s"(b2_.bar)); xcd_barrier(b2_); } ++phc; } while (0)

    bf16* H = (bf16*)(p.ws + WS_H); bf16* Pm = (bf16*)(p.ws + WS_P);
    REP(4) if (RUN()) { FRESH(); ph_modvec(p, lds, tid); __syncthreads(); ph_convert(p, lds, gw, NGW, wave, lane); }
    SEAM();
    if (RUN()) { FRESH(); ph_init_rows(p, gw, NGW, lane); }
    SEAM();
    for (int l = 0; l < DEPTH; ++l) {
        REP(16) if (RUN()) { pg8::Gemm g{H, (const bf16*)(p.ws + WS_WIN) + (size_t)l * NP * D, MROWS, NP, D}; pg8::StaticOrder S; S.init(MROWS, NP, G, (int)blockIdx.x);
            pg8::EpiBf16<0> E{Pm, NP, nullptr, 0, 0, 1.f}; pg8::gemm_phase<pg8::EpiBf16<0>, pg8::StaticOrder, true, true>(lds, g, S, E); }
        SEAM();
        REP(8) if (RUN()) { FRESH(); ph_post_inproj(p, l, gw, NGW, lane); }
        SEAM();
        REP(16) if (RUN()) { pg8::Gemm g{(const bf16*)(p.ws + WS_LA), (const bf16*)(p.ws + WS_LORA) + (size_t)l * NLO * KLA, MROWS, NLO, KLA}; pg8::StaticOrder S; S.init(MROWS, NLO, G, (int)blockIdx.x);
            pg8::EpiF32 E{(float*)(p.ws + WS_LO), NLO, 0}; pg8::gemm_phase<pg8::EpiF32, pg8::StaticOrder, true, true>(lds, g, S, E); }
        SEAM();
        REP(1) if (RUN()) { FRESH(); ph_scan1(p, l, gw, NGW, lane); }
        SEAM();
        REP(2) if (RUN()) { FRESH(); ph_scan2(p, lds, wave, lane); }
        SEAM();
        REP(8) if (RUN()) { FRESH(); ph_readout2(p, l, gw, NGW, lane); }
        SEAM();
        REP(16) if (RUN()) { pg8::Gemm g{(const bf16*)(p.ws + WS_MIXIN), (const bf16*)(p.ws + WS_WOUT) + (size_t)l * D * D, MROWS, D, D}; pg8::StaticOrder S; S.init(MROWS, D, G, (int)blockIdx.x);
            pg8::EpiF32 E{(float*)(p.ws + WS_MIXO), D, 0}; pg8::gemm_phase<pg8::EpiF32, pg8::StaticOrder, true, true>(lds, g, S, E); }
        SEAM();
        if (RUN()) { FRESH(); ph_ln(p, lds, l, 0, tid, wave, gw, NGW, lane); }
        SEAM();
        if ((l & 1) == 0) {
            const int fi = l >> 1;
            REP(16) if (RUN()) { pg8::Gemm g{H, (const bf16*)(p.ws + WS_F13) + (size_t)fi * 2 * DFF * D, MROWS, 2 * DFF, D}; pg8::StaticOrder S; S.init(MROWS, 2 * DFF, G, (int)blockIdx.x);
                pg8::EpiSwiGLU E{(bf16*)(p.ws + WS_ACT), DFF, nullptr, 0}; pg8::gemm_phase<pg8::EpiSwiGLU, pg8::StaticOrder, true, true>(lds, g, S, E); }
            SEAM();
            REP(16) if (RUN()) { pg8::Gemm g{(const bf16*)(p.ws + WS_ACT), (const bf16*)(p.ws + WS_F2) + (size_t)fi * D * DFF, MROWS, D, DFF}; pg8::StaticOrder S; S.init(MROWS, D, G, (int)blockIdx.x);
                pg8::EpiF32 E{(float*)(p.ws + WS_F), D, 0}; pg8::gemm_phase<pg8::EpiF32, pg8::StaticOrder, true, true>(lds, g, S, E); }
            SEAM();
        } else {
            REP(4) if (RUN()) { FRESH(); ph_convert_moe(p, lds, l >> 1, gw, NGW, wave, lane); }
            SEAM();
            if (RUN()) { FRESH(); ph_moe_gather(p, l, gw, NGW, lane); }
            SEAM();
            {   const unsigned* gcnt = (const unsigned*)(p.ws + WS_CTL) + CW_GCNT + 64 * (l >> 1); int pbp[9]; pbp[0] = 0;
#pragma unroll
                for (int e = 0; e < 8; ++e) pbp[e + 1] = pbp[e] + (int)((gcnt[e] + 255u) >> 8);
                const int mrows = pbp[8] * 256;
                REP(16) if (RUN()) { pg8::Gemm g{(const bf16*)(p.ws + WS_HG), (const bf16*)(p.ws + WS_MOEW13), mrows, 2 * DFF, D}; pg8::MoeOrder S; S.init(mrows, 2 * DFF, G, (int)blockIdx.x);
                    S.pb1 = pbp[1]; S.pb2 = pbp[2]; S.pb3 = pbp[3]; S.pb4 = pbp[4]; S.pb5 = pbp[5]; S.pb6 = pbp[6]; S.pb7 = pbp[7]; S.estride = (size_t)2 * DFF * D;
                    pg8::EpiSwiGLU E{(bf16*)(p.ws + WS_ACT), DFF, (const float*)(p.ws + WS_WSORT), 1}; pg8::gemm_phase<pg8::EpiSwiGLU, pg8::MoeOrder, true, true>(lds, g, S, E); }
                SEAM();
                REP(16) if (RUN()) { pg8::Gemm g{(const bf16*)(p.ws + WS_ACT), (const bf16*)(p.ws + WS_MOEW2), mrows, D, DFF}; pg8::MoeOrder S; S.init(mrows, D, G, (int)blockIdx.x);
                    S.pb1 = pbp[1]; S.pb2 = pbp[2]; S.pb3 = pbp[3]; S.pb4 = pbp[4]; S.pb5 = pbp[5]; S.pb6 = pbp[6]; S.pb7 = pbp[7]; S.estride = (size_t)D * DFF;
                    pg8::EpiF32 E{(float*)(p.ws + WS_F), D, 0}; pg8::gemm_phase<pg8::EpiF32, pg8::MoeOrder, true, true>(lds, g, S, E); }
                SEAM();
            }
        }
        if (RUN()) { FRESH(); ph_ln(p, lds, l, 1, tid, wave, gw, NGW, lane); }
        SEAM();
    }
#undef RUN
#undef SEAM
}

#ifndef MK_PER_PHASE
#define MK_PER_PHASE 0
#endif
extern "C" void kernel_launch(void* const* d_in, const int* in_sizes, int n_in, void* d_out, int out_size, void* d_ws, size_t ws_size, hipStream_t stream) {
    static int grid = 0;
    if (grid == 0) {
        if (n_in != N_IN || in_sizes[0] != NLAT * D || out_size != NLAT * D || ws_size < WS_NEED) { fprintf(stderr, "kernel_launch: unexpected shapes / workspace (%d inputs, ws %zu, need %zu)\n", n_in, ws_size, (size_t)WS_NEED); grid = -1; return; }
        int dev = 0, cus = 0, per_cu = 0;
        if (hipGetDevice(&dev) != hipSuccess || hipDeviceGetAttribute(&cus, hipDeviceAttributeMultiprocessorCount, dev) != hipSuccess) { grid = -1; return; }
        if (hipFuncSetAttribute((const void*)fwd_kernel, hipFuncAttributeMaxDynamicSharedMemorySize, LDS_BYTES) != hipSuccess) { fprintf(stderr, "kernel_launch: hipFuncSetAttribute failed\n"); grid = -1; return; }
        if (hipOccupancyMaxActiveBlocksPerMultiprocessor(&per_cu, (const void*)fwd_kernel, NWAVES * 64, LDS_BYTES) != hipSuccess || per_cu < 1) fprintf(stderr, "kernel_launch: occupancy query says %d\n", per_cu);
        (void)hipGetLastError();
        grid = cus;
    }
    if (grid < 0) return;
    if (hipMemsetAsync((char*)d_ws + WS_CTL, 0, CTL_BYTES, stream) != hipSuccess) return;
    KP p{};
    for (int i = 0; i < N_IN; ++i) p.in[i] = (const float*)d_in[i];
    p.out = (float*)d_out; p.ws = (unsigned char*)d_ws; p.pad = 0;
#if MK_PER_PHASE
    const int nph = 2 + 2 * 11 + 2 * 13;
    for (int ph = 0; ph < nph; ++ph) { p.ph = ph; hipLaunchKernelGGL(fwd_kernel, dim3(grid), dim3(NWAVES * 64), LDS_BYTES, stream, p); }
#else
    p.ph = -1;
    hipLaunchKernelGGL(fwd_kernel, dim3(grid), dim3(NWAVES * 64), LDS_BYTES, stream, p);
#endif
}
```

```cpp
#include <hip/hip_runtime.h>
#define PROBE_DUP 0
#include <cstdio>
#include <cstdint>
namespace pg8 {
#define PG8_LAS __attribute__((address_space(3)))
typedef unsigned short bf16_t;
typedef short bf16x8 __attribute__((ext_vector_type(8)));
typedef float f32x4 __attribute__((ext_vector_type(4)));
typedef unsigned u32x4 __attribute__((ext_vector_type(4)));
constexpr int BM = 256, BK = 64, HALF = 128, HTB = HALF * BK * 2  , STAGE_BYTES = 8 * HTB, NXCD = 8, WGM = 8;

__host__ __device__ __forceinline__ int lds_byte(int r, int c) { const int st = (r >> 4) * 2 + (c >> 5), rr = r & 15, cc = c & 31, ob = rr * 64 + cc * 2; return st * 1024 + (ob ^ (((ob >> 9) & 1) << 5)); }
__host__ __device__ __forceinline__ void stage_rc(int b, int& R, int& C) { const int st = b / 1024, sb = b % 1024, swz = sb ^ (((sb >> 9) & 1) << 5); R = (st >> 1) * 16 + swz / 64; C = (st & 1) * 32 + (swz % 64) / 2; }
__host__ __device__ __forceinline__ int perm32(int rho) { const int n = rho >> 4, i = rho & 15; return 8 * (i >> 2) + 4 * n + (i & 3); }

struct Unit { int pm, pn, ks; };
struct Gemm { const bf16_t* A; const bf16_t* Bt; int M, N, K, ld; };

struct StaticOrder {
    int nM, nN, nwg, G, c;
    __host__ __device__ void init(int M, int N, int G_, int c_) { nM = M / BM; nN = N / BM; nwg = nM * nN; G = G_; c = c_; }
    __host__ __device__ bool next(int i, Unit& u) const {
        const long L = (long)i * G + c; if (L >= nwg) return false;
        int wgid = (int)L; { const int q = nwg / NXCD, r = nwg % NXCD, xcd = wgid % NXCD, off = wgid / NXCD; wgid = (xcd < r ? xcd * (q + 1) : r * (q + 1) + (xcd - r) * q) + off; }
        const int nig = WGM * nN, gid = wgid / nig, fm = gid * WGM, gsz = (nM - fm) < WGM ? (nM - fm) : WGM;
        u.pm = fm + ((wgid % nig) % gsz); u.pn = (wgid % nig) / gsz; u.ks = 0; return true;
    }
    __device__ __forceinline__ const char* abase(const Gemm& g, const Unit& u, size_t tstep) const { return (const char*)g.A + (size_t)u.pm * tstep; }
    __device__ __forceinline__ const char* bbase(const Gemm& g, const Unit& u, size_t tstep) const { return (const char*)g.Bt + (size_t)u.pn * tstep; }
    __device__ __forceinline__ void a_ready(const Unit&) const {}
    __device__ __forceinline__ void done(const Unit&) const {}
};

__device__ __forceinline__ unsigned cvt_pk_bf16(float lo, float hi) { unsigned r; asm volatile("v_cvt_pk_bf16_f32 %0, %1, %2" : "=v"(r) : "v"(lo), "v"(hi)); return r; }
typedef float f32x2 __attribute__((ext_vector_type(2)));
__device__ __forceinline__ f32x2 gelu_pk(f32x2 v) {
    const f32x2 av = __builtin_elementwise_abs(v), d = av * 0.2316418882f + 1.0f;
    f32x2 t; t.x = __builtin_amdgcn_rcpf(d.x); t.y = __builtin_amdgcn_rcpf(d.y);
    f32x2 q = t * 0.5307027145f + (-0.7265760135f); q = q * t + 0.7107068705f; q = q * t + (-0.142248368f); q = q * t + 0.127414796f; q = q * t;
    const f32x2 s = (v * v) * (-0.72134752044f);
    f32x2 e; e.x = __builtin_amdgcn_exp2f(s.x); e.y = __builtin_amdgcn_exp2f(s.y);
    const f32x2 m = v * (q * e), r = v - m;
    f32x2 o; o.x = v.x < 0.f ? m.x : r.x; o.y = v.y < 0.f ? m.y : r.y; return o;
}

template <int ACT  > struct EpiBf16 {
    static constexpr bool PERM = true, AFTER_DRAIN = false; static_assert(ACT == 0 || ACT == 1, "EpiBf16: ACT is 0 (none) or 1 (gelu_pk)");
    bf16_t* O; int ldc; const float* bias; int split_cols; size_t split_stride; float scale0;
    __device__ __forceinline__ void operator()(const f32x4 (&acc)[2][2][4][2], const Unit& u, int wr, int wc, int fr, int fq) const {
        const int row0 = u.pm * BM + wr * 64 + fr; int colt = u.pn * BM; bf16_t* base = O;
        float sc = 1.f; if (split_cols) { const int t = colt / split_cols; base += (size_t)t * split_stride; colt -= t * split_cols; if (t == 0) sc = scale0; }
        const int col0 = colt + wc * 32 + 8 * fq, bcol0 = u.pn * BM + wc * 32 + 8 * fq;
        f32x4 bv[2][2];
#pragma unroll
        for (int bj = 0; bj < 2; ++bj)
#pragma unroll
            for (int n = 0; n < 2; ++n) bv[bj][n] = bias ? *(const f32x4*)(bias + bcol0 + bj * HALF + 4 * n) : (f32x4){0.f, 0.f, 0.f, 0.f};
#pragma unroll
        for (int ai = 0; ai < 2; ++ai)
#pragma unroll
            for (int m = 0; m < 4; ++m) { bf16_t* rowp = base + (size_t)(row0 + ai * HALF + m * 16) * ldc + col0;
#pragma unroll
                for (int bj = 0; bj < 2; ++bj) { f32x4 v0 = acc[ai][bj][m][0] + bv[bj][0], v1 = acc[ai][bj][m][1] + bv[bj][1];
                    if (ACT == 1) { f32x2 a = gelu_pk((f32x2){v0[0], v0[1]}), b = gelu_pk((f32x2){v0[2], v0[3]}), c = gelu_pk((f32x2){v1[0], v1[1]}), d = gelu_pk((f32x2){v1[2], v1[3]});
                        v0 = (f32x4){a.x, a.y, b.x, b.y}; v1 = (f32x4){c.x, c.y, d.x, d.y}; }
                    v0 = v0 * sc; v1 = v1 * sc; u32x4 w; w.x = cvt_pk_bf16(v0[0], v0[1]); w.y = cvt_pk_bf16(v0[2], v0[3]); w.z = cvt_pk_bf16(v1[0], v1[1]); w.w = cvt_pk_bf16(v1[2], v1[3]);
                    *(u32x4*)(rowp + bj * HALF) = w; } }
    }
};
struct EpiF32 {
    static constexpr bool PERM = false, AFTER_DRAIN = false;
    float* C; int ldc; int accum;
    __device__ __forceinline__ void operator()(const f32x4 (&acc)[2][2][4][2], const Unit& u, int wr, int wc, int fr, int fq) const {
        const int row0 = u.pm * BM + wr * 64 + fr, col0 = u.pn * BM + wc * 32 + 4 * fq;
#pragma unroll
        for (int ai = 0; ai < 2; ++ai)
#pragma unroll
            for (int m = 0; m < 4; ++m) { float* rowp = C + (size_t)(row0 + ai * HALF + m * 16) * ldc + col0;
#pragma unroll
                for (int bj = 0; bj < 2; ++bj)
#pragma unroll
                    for (int n = 0; n < 2; ++n) { f32x4 v = acc[ai][bj][m][n]; if (accum) v += *(const f32x4*)(rowp + bj * HALF + n * 16); *(f32x4*)(rowp + bj * HALF + n * 16) = v; } }
    }
};
struct EpiSwiGLU {
    static constexpr bool PERM = true, AFTER_DRAIN = false;
    bf16_t* O; int ldo; const float* rowscale; int rs_stride;
    __device__ __forceinline__ void operator()(const f32x4 (&acc)[2][2][4][2], const Unit& u, int wr, int wc, int fr, int fq) const {
        typedef unsigned u32x2v __attribute__((ext_vector_type(2)));
        const int row0 = u.pm * BM + wr * 64 + fr; const int ch0 = (u.pn * BM + wc * 32 + 8 * fq) >> 1;
#pragma unroll
        for (int ai = 0; ai < 2; ++ai)
#pragma unroll
            for (int m = 0; m < 4; ++m) { const int row = row0 + ai * HALF + m * 16; bf16_t* rowp = O + (size_t)row * ldo + ch0;
                const float rs = rowscale ? rowscale[(size_t)row * rs_stride] : 1.f;
#pragma unroll
                for (int bj = 0; bj < 2; ++bj) { const f32x4 a = acc[ai][bj][m][0], b = acc[ai][bj][m][1]; f32x4 o;
#pragma unroll
                    for (int i = 0; i < 4; ++i) o[i] = a[i] * __builtin_amdgcn_rcpf(1.f + __expf(-a[i])) * b[i] * rs;
                    u32x2v w; w.x = cvt_pk_bf16(o[0], o[1]); w.y = cvt_pk_bf16(o[2], o[3]);
                    *(u32x2v*)(rowp + bj * (HALF / 2)) = w; } }
    }
};

struct MoeOrder : StaticOrder {
    int pb1, pb2, pb3, pb4, pb5, pb6, pb7; size_t estride;
    __device__ __forceinline__ const char* bbase(const Gemm& g, const Unit& u, size_t tstep) const {
        const int e = (u.pm >= pb1) + (u.pm >= pb2) + (u.pm >= pb3) + (u.pm >= pb4) + (u.pm >= pb5) + (u.pm >= pb6) + (u.pm >= pb7);
        return (const char*)(g.Bt + (size_t)e * estride) + (size_t)u.pn * tstep; }
};
struct SplitOrder {
    int nM, nN, S, G, c, pm0; int pb1, pb2, pb3, pb4, pb5, pb6, pb7; size_t estride;
    __device__ __forceinline__ bool next(int i, Unit& u) const { const int L = i * G + c; if (L >= nM * nN * S) return false; u.ks = L % S; const int t = L / S; u.pn = t % nN; u.pm = pm0 + t / nN; return true; }
    __device__ __forceinline__ const char* abase(const Gemm& g, const Unit& u, size_t tstep) const { return (const char*)g.A + (size_t)u.pm * tstep + (size_t)u.ks * g.K * 2; }
    __device__ __forceinline__ const char* bbase(const Gemm& g, const Unit& u, size_t tstep) const {
        const int e = estride ? (u.pm >= pb1) + (u.pm >= pb2) + (u.pm >= pb3) + (u.pm >= pb4) + (u.pm >= pb5) + (u.pm >= pb6) + (u.pm >= pb7) : 0;
        return (const char*)(g.Bt + (size_t)e * estride) + (size_t)u.pn * tstep + (size_t)u.ks * g.K * 2; }
    __device__ __forceinline__ void a_ready(const Unit&) const {}
    __device__ __forceinline__ void done(const Unit&) const {}
};
struct EpiPart {
    static constexpr bool PERM = false, AFTER_DRAIN = false;
    float* C; int ldc; size_t pstride; int pm0;
    __device__ __forceinline__ void operator()(const f32x4 (&acc)[2][2][4][2], const Unit& u, int wr, int wc, int fr, int fq) const {
        const int row0 = (u.pm - pm0) * BM + wr * 64 + fr, col0 = u.pn * BM + wc * 32 + 4 * fq; float* base = C + (size_t)u.ks * pstride;
#pragma unroll
        for (int ai = 0; ai < 2; ++ai)
#pragma unroll
            for (int m = 0; m < 4; ++m) { float* rowp = base + (size_t)(row0 + ai * HALF + m * 16) * ldc + col0;
#pragma unroll
                for (int bj = 0; bj < 2; ++bj)
#pragma unroll
                    for (int n = 0; n < 2; ++n) *(f32x4*)(rowp + bj * HALF + n * 16) = acc[ai][bj][m][n]; }
    }
};
template <class Epi, class Sched, bool ALIGN_EPI = false, bool SP2 = false>
__device__ __forceinline__ void gemm_phase(PG8_LAS unsigned char* lds, const Gemm g, const Sched& S, const Epi& E) {
    int tid_o = threadIdx.x; asm volatile("" : "+v"(tid_o));
    const int tid = tid_o, wid = __builtin_amdgcn_readfirstlane(tid >> 6), lane = tid & 63, wr = wid >> 2, wc = wid & 3, fr = lane & 15, fq = lane >> 4;
    const int K = g.K, nt = K / BK;
    unsigned voffA[2], voffB[2];
#pragma unroll
    for (int i = 0; i < 2; ++i) { int R, C; stage_rc(tid * 16 + i * 8192, R, C); const int Rb = Epi::PERM ? ((R & ~31) + perm32(R & 31)) : R;
        voffA[i] = (unsigned)(R * g.ld + C) * 2u; voffB[i] = (unsigned)(Rb * g.ld + C) * 2u; }
    const size_t kstep = (size_t)(BK * 2);
    const size_t hstep = (size_t)HALF * g.ld * 2;
    const size_t tstep = 2 * hstep;
    const unsigned ldsw = (unsigned)wid * 1024u;
    const int aoff = lds_byte(wr * 64 + fr, fq * 8), boff = lds_byte(wc * 32 + fr, fq * 8);
#define PG8_SA(b, h) (((b) * 2 + (h)) * HTB)
#define PG8_SB(b, h) ((4 + (b) * 2 + (h)) * HTB)
#define PG8_STAGE(bufoff, gbase, voff) do { _Pragma("unroll") for (int _i = 0; _i < 2; ++_i) \
        __builtin_amdgcn_global_load_lds((const unsigned*)((const char*)(gbase) + (voff)[_i]), (PG8_LAS unsigned*)(lds + (bufoff) + ldsw + _i * 8192), 16, 0, 0); } while (0)
#define PG8_LDA(dst, b, h) do { _Pragma("unroll") for (int m = 0; m < 4; ++m) _Pragma("unroll") for (int k = 0; k < 2; ++k) dst[m][k] = *(const PG8_LAS bf16x8*)(lds + PG8_SA(b, h) + aoff + m * 2048 + k * 1024); } while (0)
#define PG8_LDB(dst, b, h) do { _Pragma("unroll") for (int n = 0; n < 2; ++n) _Pragma("unroll") for (int k = 0; k < 2; ++k) dst[n][k] = *(const PG8_LAS bf16x8*)(lds + PG8_SB(b, h) + boff + n * 2048 + k * 1024); } while (0)
#define PG8_MMA(ai, bj, At, Bt) do { __builtin_amdgcn_s_setprio(1); _Pragma("unroll") for (int m = 0; m < 4; ++m) _Pragma("unroll") for (int n = 0; n < 2; ++n) _Pragma("unroll") for (int k = 0; k < 2; ++k) \
        acc[ai][bj][m][n] = __builtin_amdgcn_mfma_f32_16x16x32_bf16(Bt[n][k], At[m][k], acc[ai][bj][m][n], 0, 0, 0); __builtin_amdgcn_s_setprio(0); } while (0)
#define PG8_WAIT_V(n) asm volatile("s_waitcnt vmcnt(" #n ")" ::: "memory")
#define PG8_WAIT_L(n) asm volatile("s_waitcnt lgkmcnt(" #n ")" ::: "memory")
#define PG8_BAR __builtin_amdgcn_s_barrier()
#define PG8_SCHED __builtin_amdgcn_sched_barrier(0)
    Unit cur, nxt; int ui = 0;
    if (!S.next(0, cur)) return;
    f32x4 acc[2][2][4][2];
#pragma unroll
    for (int a = 0; a < 2; ++a)
#pragma unroll
        for (int b = 0; b < 2; ++b)
#pragma unroll
            for (int m = 0; m < 4; ++m)
#pragma unroll
                for (int n = 0; n < 2; ++n) acc[a][b][m][n] = (f32x4){0.f, 0.f, 0.f, 0.f};
    bf16x8 At[4][2], B0[2][2], B1[2][2];
    const char* cA = S.abase(g, cur, tstep); const char* cB = S.bbase(g, cur, tstep);
    S.a_ready(cur);
    if constexpr (SP2) {
        PG8_STAGE(PG8_SB(0, 0), cB, voffB); PG8_STAGE(PG8_SB(0, 1), cB + hstep, voffB); PG8_STAGE(PG8_SA(0, 0), cA, voffA); PG8_STAGE(PG8_SA(0, 1), cA + hstep, voffA);
        if (wr == 1) PG8_BAR;
        PG8_WAIT_V(2); PG8_BAR;
        PG8_STAGE(PG8_SB(1, 0), cB + kstep, voffB); PG8_STAGE(PG8_SA(1, 0), cA + kstep, voffA); PG8_STAGE(PG8_SB(1, 1), cB + hstep + kstep, voffB);
        PG8_WAIT_V(6); PG8_BAR;
    } else {
        PG8_STAGE(PG8_SB(0, 0), cB, voffB); PG8_STAGE(PG8_SA(0, 0), cA, voffA); PG8_STAGE(PG8_SB(0, 1), cB + hstep, voffB); PG8_STAGE(PG8_SA(0, 1), cA + hstep, voffA);
        if (wr == 1) PG8_BAR;
        PG8_WAIT_V(4); PG8_BAR;
        PG8_STAGE(PG8_SB(1, 0), cB + kstep, voffB); PG8_STAGE(PG8_SA(1, 0), cA + kstep, voffA); PG8_STAGE(PG8_SB(1, 1), cB + hstep + kstep, voffB);
        PG8_WAIT_V(6); PG8_BAR;
    }
    for (;;) {
        const bool has_next = S.next(ui + 1, nxt);
        const char* nA = has_next ? S.abase(g, nxt, tstep) : cA; const char* nB = has_next ? S.bbase(g, nxt, tstep) : cB;
        for (int t = 0; t < nt; t += 2) {
            const bool last = (t == nt - 2);
            const char* a1 = cA + (size_t)(t + 1) * kstep;
            const char* a2 = last ? nA : cA + (size_t)(t + 2) * kstep; const char* b2 = last ? nB : cB + (size_t)(t + 2) * kstep;
            const char* a3 = a2 + kstep; const char* b3 = b2 + kstep;
            if (last && has_next) S.a_ready(nxt);
            if constexpr (SP2) {
            PG8_LDB(B0, 0, 0); PG8_LDB(B1, 0, 1); PG8_SCHED; PG8_LDA(At, 0, 0); PG8_STAGE(PG8_SA(1, 1), a1 + hstep, voffA);
            PG8_WAIT_V(8); PG8_WAIT_L(0); PG8_BAR; PG8_MMA(0, 0, At, B0); PG8_MMA(0, 1, At, B1); PG8_BAR; PG8_SCHED;
            PG8_LDA(At, 0, 1); PG8_STAGE(PG8_SB(0, 0), b2, voffB); PG8_STAGE(PG8_SB(0, 1), b2 + hstep, voffB); PG8_STAGE(PG8_SA(0, 0), a2, voffA);
            PG8_WAIT_V(8); PG8_WAIT_L(0); PG8_BAR; PG8_MMA(1, 0, At, B0); PG8_MMA(1, 1, At, B1); PG8_BAR; PG8_SCHED;
            PG8_LDB(B0, 1, 0); PG8_LDB(B1, 1, 1); PG8_SCHED; PG8_LDA(At, 1, 0); PG8_STAGE(PG8_SA(0, 1), a2 + hstep, voffA);
            PG8_WAIT_V(8); PG8_WAIT_L(0); PG8_BAR; PG8_MMA(0, 0, At, B0); PG8_MMA(0, 1, At, B1); PG8_BAR; PG8_SCHED;
            PG8_LDA(At, 1, 1); PG8_STAGE(PG8_SB(1, 0), b3, voffB); PG8_STAGE(PG8_SB(1, 1), b3 + hstep, voffB); PG8_STAGE(PG8_SA(1, 0), a3, voffA);
            PG8_WAIT_V(8); PG8_WAIT_L(0); PG8_BAR; PG8_MMA(1, 0, At, B0); PG8_MMA(1, 1, At, B1); PG8_BAR; PG8_SCHED;
            } else {
            PG8_LDB(B0, 0, 0); PG8_SCHED; PG8_LDA(At, 0, 0); PG8_STAGE(PG8_SA(1, 1), a1 + hstep, voffA);
            PG8_WAIT_L(8); PG8_BAR; PG8_WAIT_L(0); PG8_MMA(0, 0, At, B0); PG8_BAR; PG8_SCHED;
            PG8_LDB(B1, 0, 1); PG8_STAGE(PG8_SB(0, 0), b2, voffB);
            PG8_BAR; PG8_WAIT_L(0); PG8_MMA(0, 1, At, B1); PG8_BAR;
            PG8_LDA(At, 0, 1); PG8_STAGE(PG8_SA(0, 0), a2, voffA);
            PG8_BAR; PG8_WAIT_L(0); PG8_MMA(1, 0, At, B0); PG8_BAR; PG8_SCHED;
            PG8_STAGE(PG8_SB(0, 1), b2 + hstep, voffB);
            PG8_WAIT_V(6); PG8_BAR; PG8_MMA(1, 1, At, B1); PG8_BAR;
            PG8_LDB(B0, 1, 0); PG8_SCHED; PG8_LDA(At, 1, 0); PG8_STAGE(PG8_SA(0, 1), a2 + hstep, voffA);
            PG8_WAIT_L(8); PG8_BAR; PG8_WAIT_L(0); PG8_MMA(0, 0, At, B0); PG8_BAR; PG8_SCHED;
            PG8_LDB(B1, 1, 1); PG8_STAGE(PG8_SB(1, 0), b3, voffB);
            PG8_BAR; PG8_WAIT_L(0); PG8_MMA(0, 1, At, B1); PG8_BAR;
            PG8_LDA(At, 1, 1); PG8_STAGE(PG8_SA(1, 0), a3, voffA);
            PG8_BAR; PG8_WAIT_L(0); PG8_MMA(1, 0, At, B0); PG8_BAR; PG8_SCHED;
            PG8_STAGE(PG8_SB(1, 1), b3 + hstep, voffB);
            PG8_WAIT_V(6); PG8_BAR; PG8_MMA(1, 1, At, B1); PG8_BAR;
            }
        }
        if constexpr (ALIGN_EPI) { if (wr == 0) PG8_BAR; }
        if constexpr (!Epi::AFTER_DRAIN) { E(acc, cur, wr, wc, fr, fq); S.done(cur); }
        if (!has_next) break;
#pragma unroll
        for (int a = 0; a < 2; ++a)
#pragma unroll
            for (int b = 0; b < 2; ++b)
#pragma unroll
                for (int m = 0; m < 4; ++m)
#pragma unroll
                    for (int n = 0; n < 2; ++n) acc[a][b][m][n] = (f32x4){0.f, 0.f, 0.f, 0.f};
        cur = nxt; cA = nA; cB = nB; ++ui;
        if constexpr (ALIGN_EPI) { if (wr == 1) PG8_BAR; }
    }
    PG8_WAIT_V(0);
    if constexpr (!ALIGN_EPI) { if (wr == 0) PG8_BAR; }
    PG8_BAR;
    if constexpr (Epi::AFTER_DRAIN) { E.fused(acc, cur, wr, wc, fr, fq, lds, wid, lane); S.done(cur); }
#undef PG8_SA
#undef PG8_SB
#undef PG8_STAGE
#undef PG8_LDA
#undef PG8_LDB
#undef PG8_MMA
#undef PG8_WAIT_V
#undef PG8_WAIT_L
#undef PG8_BAR
#undef PG8_SCHED
}
}

constexpr int NWAVES = 8;
constexpr int D = 1024, NB = 4, SEQ = 4096, CTXL = 256, NLAT = NB * SEQ, NCTX = NB * CTXL, MROWS = NLAT + NCTX;
constexpr int DEPTH = 4, RW = 512, NH = 8, HS = 64, DFF = 3584, NE = 8, NPROJ = 3456, NP = 3584, NLO = 2560, KLA = 512, NMOD = 6144;
constexpr int PC_R = 0, PC_K = 512, PC_V = 1024, PC_CB = 1536, PC_CC = 2048, PC_CH = 2560, PC_WD = 3072, PC_AD = 3200, PC_GD = 3328;
constexpr float LN_EPS = 1e-5f, GN_EPS = 64e-5f, DN_ALPHA = 1.681792830507429f;
enum { I_X = 0, I_C, I_CTX, I_CCTX, I_WMOD, I_BMOD, I_WIN, I_W0, I_W2, I_A0, I_A2, I_KK, I_KA, I_RK, I_G2, I_LNXG, I_LNXB, I_CONVW, I_WOUT, I_LN1G, I_LN1B, I_LN2G, I_LN2B,
       I_FW1, I_FW3, I_FW2, I_RTW, I_RTB, I_MW1, I_MW3, I_MW2, N_IN };

constexpr size_t MiB = 1u << 20;
constexpr size_t WS_CTL = 0, CTL_BYTES = 1 * MiB;
constexpr size_t WS_MODV = 1 * MiB;
constexpr size_t WS_G8 = 2 * MiB;
constexpr size_t WS_RKS = 3 * MiB;
constexpr size_t WS_WIN = 4 * MiB;
constexpr size_t WS_WOUT = WS_WIN + 28 * MiB;
constexpr size_t WS_LORA = WS_WOUT + 8 * MiB;
constexpr size_t WS_F13 = WS_LORA + 10 * MiB;
constexpr size_t WS_F2 = WS_F13 + 28 * MiB;
constexpr size_t WS_X = WS_F2 + 14 * MiB;
constexpr size_t WS_H = WS_X + 68 * MiB;
constexpr size_t WS_MOES = WS_H + 34 * MiB;
constexpr size_t WS_ROWLIST = WS_MOES;
constexpr size_t WS_TOKSEL = WS_MOES + 640 * 1024;
constexpr size_t WS_WSEL = WS_TOKSEL + 320 * 1024;
constexpr size_t WS_WSORT = WS_WSEL + 192 * 1024;
constexpr size_t WS_SCR = WS_MOES + 2 * MiB;
constexpr size_t WS_P = WS_SCR;
constexpr size_t WS_LA = WS_P + 119 * MiB;
constexpr size_t WS_LO = WS_LA + 17 * MiB;
constexpr size_t WS_MIX = WS_LO;
constexpr size_t WS_PREP = WS_LO + 170 * MiB;
constexpr size_t WS_Y = WS_PREP + 238 * MiB;
constexpr size_t WS_MIXIN = WS_Y + 68 * MiB;
constexpr size_t WS_CH = WS_PREP;
constexpr size_t WS_MIXO = WS_PREP;
constexpr size_t WS_MIXP = WS_PREP + 34 * MiB;
constexpr size_t WS_END_MIXER = WS_MIXIN + 34 * MiB;
constexpr size_t WS_MOEW13 = WS_SCR;
constexpr size_t WS_MOEW2 = WS_MOEW13 + 112 * MiB;
constexpr size_t WS_HG = WS_MOEW2 + 56 * MiB;
constexpr size_t WS_ACT = WS_HG + 72 * MiB;
constexpr size_t WS_F = WS_ACT + 252 * MiB;
constexpr size_t WS_FP = WS_F + 72 * MiB;
constexpr size_t WS_END_FFN = WS_F + 144 * MiB;
constexpr size_t WS_NEED = WS_END_MIXER > WS_END_FFN ? WS_END_MIXER : WS_END_FFN;
static_assert((size_t)MROWS * NP * 2 <= 119 * MiB && (size_t)MROWS * NLO * 4 <= 170 * MiB && (size_t)MROWS * RW * 4 * 7 <= 238 * MiB && (size_t)MROWS * D * 4 <= 68 * MiB, "ws map");
constexpr int MOE_MAIN_PANELS = 128, MOE_TAIL_ROWS = 4096;
constexpr int MOE_ROWS = 36864;
constexpr int CW_BAR = 4096, CW_GCNT = 8192;

constexpr int RING_BYTES = 131072, LDSCTL_OFF = RING_BYTES, MISC_OFF = LDSCTL_OFF + 320, LDS_BYTES = 147456;

typedef unsigned short bf16;
typedef unsigned v4u __attribute__((ext_vector_type(4)));
typedef unsigned v2u __attribute__((ext_vector_type(2)));
typedef float f32x4 __attribute__((ext_vector_type(4)));
#define LAS __attribute__((address_space(3)))
#define LDS_WAIT() asm volatile("s_waitcnt lgkmcnt(0)" ::: "memory")
__device__ __forceinline__ unsigned f2bf(float f) { unsigned u = __builtin_bit_cast(unsigned, f); return (u + 0x7fffu + ((u >> 16) & 1u)) >> 16; }
__device__ __forceinline__ unsigned pk2(float lo, float hi) { return f2bf(lo) | (f2bf(hi) << 16); }
__device__ __forceinline__ float bf2f(unsigned short b) { return __builtin_bit_cast(float, ((unsigned)b) << 16); }
__device__ __forceinline__ float bflo(unsigned w) { return __builtin_bit_cast(float, w << 16); }
__device__ __forceinline__ float bfhi(unsigned w) { return __builtin_bit_cast(float, w & 0xffff0000u); }
__device__ __forceinline__ float wave_sum(float v) {
#pragma unroll
    for (int o = 1; o < 64; o <<= 1) v += __shfl_xor(v, o);
    return v;
}
__device__ __forceinline__ float sigm(float x) { return 1.f / (1.f + __expf(-x)); }

#define XB_TMO      128
#define XB_XCNT(j)  (256  + 64 * (j))
#define XB_XSUB(j)  (1280 + 64 * (j))
#define XB_XGEN(j)  (2304 + 64 * (j))
#define XB_TOP      3328
#define XB_TOPGEN   3392
#define XCD_BAR_WORDS 3456
#define XB_SPIN_CAP (1u << 18)

__device__ __forceinline__ unsigned xb_ld(unsigned* p)              { return __hip_atomic_load(p, __ATOMIC_RELAXED, __HIP_MEMORY_SCOPE_AGENT); }
__device__ __forceinline__ unsigned xb_add(unsigned* p, unsigned v) { return __hip_atomic_fetch_add(p, v, __ATOMIC_RELAXED, __HIP_MEMORY_SCOPE_AGENT); }
__device__ __forceinline__ unsigned xb_xcc_id() { return (unsigned)__builtin_amdgcn_s_getreg((3 << 11) | 20) & 0xFu; }
#define XB_SPIN(cond, bar) do { unsigned _sp = 0; while (cond) { __builtin_amdgcn_s_sleep(1); \
    if ((++_sp & 255u) == 0u) { if (xb_ld(&(bar)[XB_TMO])) break; if (_sp > XB_SPIN_CAP) { atomicAdd(&(bar)[XB_TMO], 1u); break; } } } } while (0)

struct XcdBarrier {
    unsigned* bar; unsigned x;
    volatile LAS unsigned* st;
};

__device__ __forceinline__ XcdBarrier xcd_barrier_post(unsigned* bar, volatile LAS unsigned* st) {
    XcdBarrier b; b.bar = bar; b.x = xb_xcc_id(); b.st = st;
    if (threadIdx.x == 0) (void)xb_add(&bar[XB_XCNT(b.x)], 1u);
    return b;
}
__device__ __forceinline__ void xcd_barrier_complete(unsigned* bar, unsigned x, unsigned& nloc, unsigned& nx) {
    const unsigned G = gridDim.x * gridDim.y * gridDim.z;
    unsigned sum, cnt, mine, sp = 0u;
    for (;;) {
        sum = 0u; cnt = 0u; mine = 0u;
#pragma unroll
        for (unsigned j = 0; j < 16; ++j) { const unsigned c = xb_ld(&bar[XB_XCNT(j)]); sum += c; cnt += (c > 0u) ? 1u : 0u; mine = (j == x) ? c : mine; }
        if (sum == G) break;
        __builtin_amdgcn_s_sleep(1);
        if ((++sp & 255u) == 0u) { if (xb_ld(&bar[XB_TMO])) break; if (sp > XB_SPIN_CAP) { atomicAdd(&bar[XB_TMO], 1u); break; } }
    }
    nloc = mine > 0u ? mine : 1u; nx = cnt > 0u ? cnt : 1u;
}

__device__ __forceinline__ void xcd_barrier(const XcdBarrier& b) {
    asm volatile("s_waitcnt vmcnt(0)" ::: "memory");
    __syncthreads();
    if (threadIdx.x == 0) {
        unsigned* bar = b.bar;
        __builtin_amdgcn_s_waitcnt(0);
        unsigned nloc = b.st[0], nx = b.st[1];
        if (nloc == 0u) { xcd_barrier_complete(bar, b.x, nloc, nx); b.st[0] = nloc; b.st[1] = nx; }
        const unsigned old = xb_add(&bar[XB_XSUB(b.x)], 1u);
        const unsigned gen = old / nloc;
        if (old + 1u == (gen + 1u) * nloc) {
            __builtin_amdgcn_fence(__ATOMIC_RELEASE, "agent");
            asm volatile("s_waitcnt vmcnt(0)" ::: "memory");
            const unsigned og = xb_add(&bar[XB_TOP], 1u);
            const unsigned tg = og / nx;
            if (og + 1u == (tg + 1u) * nx) xb_add(&bar[XB_TOPGEN], 1u);
            else XB_SPIN(xb_ld(&bar[XB_TOPGEN]) == tg, bar);
            __builtin_amdgcn_fence(__ATOMIC_ACQUIRE, "agent");
            xb_add(&bar[XB_XGEN(b.x)], 1u);
            asm volatile("s_waitcnt vmcnt(0)" ::: "memory");
        } else {
            XB_SPIN(xb_ld(&bar[XB_XGEN(b.x)]) == gen, bar);
            __builtin_amdgcn_fence(__ATOMIC_ACQUIRE, "agent");
            asm volatile("s_waitcnt vmcnt(0)" ::: "memory");
        }
    }
    __syncthreads();
}


struct KP { const float* in[N_IN]; float* out; unsigned char* ws; int ph; int pad; };

template <int MODE> __device__ __forceinline__ int rowmap(int n, int arg) {
    if (MODE == 0) return n + arg;
    if (MODE == 1) { if (n < 1536) return n; if (n < 1664) return n - 1536 + PC_WD; if (n < 1792) return n - 1664 + PC_AD; if (n < 1920) return n - 1792 + PC_GD;
                     if (n < 2432) return n - 1920 + PC_CB; if (n < 2944) return n - 2432 + PC_CC; return n - 2944 + PC_CH; }
    return 8 * (n >> 2) + 4 * arg + (n & 3);
}
template <int MODE> __device__ __forceinline__ void transpose_item(const float* W, int K, int N, bf16* WT, int arg, LAS float* scr, int item, int lane) {
    const int nblk = N / 32, kb = item / nblk, nb = item % nblk, k0 = 64 * kb, n0 = 32 * nb;
#pragma unroll 8
    for (int i = 0; i < 32; ++i) { const int kk = 2 * i + (lane >> 5); scr[kk * 33 + (lane & 31)] = W[(size_t)(k0 + kk) * N + n0 + (lane & 31)]; }
    LDS_WAIT(); asm volatile("" ::: "memory");
    const int c = lane & 7;
#pragma unroll
    for (int j = 0; j < 4; ++j) { const int n = (lane >> 3) + 8 * j; const LAS float* s = scr + (8 * c) * 33 + n;
        v4u o; o.x = pk2(s[0 * 33], s[1 * 33]); o.y = pk2(s[2 * 33], s[3 * 33]); o.z = pk2(s[4 * 33], s[5 * 33]); o.w = pk2(s[6 * 33], s[7 * 33]);
        *(v4u*)(WT + (size_t)rowmap<MODE>(n0 + n, arg) * K + k0 + 8 * c) = o; }
    LDS_WAIT(); asm volatile("" ::: "memory");
}

__device__ __forceinline__ void ph_modvec(const KP& p, LAS unsigned char* lds, int tid) {
    LAS float* sil = (LAS float*)lds;
    LAS float* red = (LAS float*)(lds + 5 * 1024 * 4);
    const float* c = p.in[I_C]; const float* cc = p.in[I_CCTX];
    for (int i = tid; i < 5 * 1024; i += 512) { const float v = i < 4096 ? c[i] : cc[i - 4096]; sil[i] = v / (1.f + __expf(-v)); }
    __syncthreads();
    float* modv = (float*)(p.ws + WS_MODV);
    const int ks = tid >> 6, col = tid & 63;
    for (int task = blockIdx.x; task < DEPTH * 96; task += gridDim.x) {
        const int l = task / 96, j0 = (task % 96) * 64;
        const float* w = p.in[I_WMOD] + (size_t)l * D * NMOD + (size_t)(ks * 128) * NMOD + j0 + col;
        float a0 = 0.f, a1 = 0.f, a2 = 0.f, a3 = 0.f, a4 = 0.f;
#pragma unroll 8
        for (int k = 0; k < 128; ++k) { const float wv = w[(size_t)k * NMOD]; const int kk = ks * 128 + k;
            a0 += sil[kk] * wv; a1 += sil[1024 + kk] * wv; a2 += sil[2048 + kk] * wv; a3 += sil[3072 + kk] * wv; a4 += sil[4096 + kk] * wv; }
        red[(ks * 5 + 0) * 64 + col] = a0; red[(ks * 5 + 1) * 64 + col] = a1; red[(ks * 5 + 2) * 64 + col] = a2; red[(ks * 5 + 3) * 64 + col] = a3; red[(ks * 5 + 4) * 64 + col] = a4;
        __syncthreads();
        if (tid < 320) { const int r = tid >> 6; float s = 0.f;
#pragma unroll
            for (int q = 0; q < 8; ++q) s += red[(q * 5 + r) * 64 + col];
            modv[(size_t)(l * 5 + r) * NMOD + j0 + col] = s + p.in[I_BMOD][l * NMOD + j0 + col]; }
        __syncthreads();
    }
}

__device__ __forceinline__ void ph_convert(const KP& p, LAS unsigned char* lds, int gw, int NGW, int wave, int lane) {
    LAS float* scr = (LAS float*)(lds + wave * 16384);
    bf16* win = (bf16*)(p.ws + WS_WIN); bf16* wout = (bf16*)(p.ws + WS_WOUT); bf16* f13 = (bf16*)(p.ws + WS_F13); bf16* f2 = (bf16*)(p.ws + WS_F2); bf16* lora = (bf16*)(p.ws + WS_LORA);
    constexpr int I_IN = (D / 64) * (NPROJ / 32), I_OUT = (D / 64) * (D / 32), I_UP = (D / 64) * (DFF / 32), I_DN = (DFF / 64) * (D / 32);
    constexpr int T_IN = DEPTH * I_IN, T_OUT = DEPTH * I_OUT, T_UP = 2 * I_UP, T_DN = 2 * I_DN, NITEMS = T_IN + T_OUT + 2 * T_UP + T_DN;
    for (int it = gw; it < NITEMS; it += NGW) {
        int r = it;
        if (r < T_IN) { const int l = r / I_IN; transpose_item<1>(p.in[I_WIN] + (size_t)l * D * NPROJ, D, NPROJ, win + (size_t)l * NP * D, 0, scr, r % I_IN, lane); continue; } r -= T_IN;
        if (r < T_OUT) { const int l = r / I_OUT; transpose_item<0>(p.in[I_WOUT] + (size_t)l * D * D, D, D, wout + (size_t)l * D * D, 0, scr, r % I_OUT, lane); continue; } r -= T_OUT;
        if (r < T_UP) { const int l = r / I_UP; transpose_item<2>(p.in[I_FW1] + (size_t)l * D * DFF, D, DFF, f13 + (size_t)l * 2 * DFF * D, 0, scr, r % I_UP, lane); continue; } r -= T_UP;
        if (r < T_UP) { const int l = r / I_UP; transpose_item<2>(p.in[I_FW3] + (size_t)l * D * DFF, D, DFF, f13 + (size_t)l * 2 * DFF * D, 1, scr, r % I_UP, lane); continue; } r -= T_UP;
        { const int l = r / I_DN; transpose_item<0>(p.in[I_FW2] + (size_t)l * DFF * D, DFF, D, f2 + (size_t)l * D * DFF, 0, scr, r % I_DN, lane); }
    }
    { const int gt = gw * 64 + lane, NGT = NGW * 64; constexpr int PER = (NP - NPROJ) * D / 8;
      for (int i = gt; i < DEPTH * PER; i += NGT) { const int l = i / PER, q = i % PER; *(v4u*)(win + (size_t)l * NP * D + (size_t)NPROJ * D + (size_t)q * 8) = (v4u){0u, 0u, 0u, 0u}; } }
    { const int gt = gw * 64 + lane, NGT = NGW * 64; constexpr int PER = NLO * KLA / 8;
      for (int i = gt; i < DEPTH * PER; i += NGT) { const int l = i / PER, q = i % PER, n = q / (KLA / 8), k0 = (q % (KLA / 8)) * 8; float v[8];
#pragma unroll
          for (int j = 0; j < 8; ++j) { const int k = k0 + j; float x = 0.f;
              if (n < 1024) { const int d = n >> 9, c = n & 511; if (k >= 64 * d && k < 64 * d + 64) x = p.in[I_W2][((size_t)(l * 2 + d) * 64 + (k - 64 * d)) * RW + c]; }
              else if (n < 2048) { const int d = (n - 1024) >> 9, c = n & 511; if (k >= 128 + 64 * d && k < 192 + 64 * d) x = p.in[I_A2][((size_t)(l * 2 + d) * 64 + (k - 128 - 64 * d)) * RW + c]; }
              else { const int c = n - 2048; if (k >= 256 && k < 384) x = p.in[I_G2][((size_t)l * 128 + (k - 256)) * RW + c]; }
              v[j] = x; }
          v4u o; o.x = pk2(v[0], v[1]); o.y = pk2(v[2], v[3]); o.z = pk2(v[4], v[5]); o.w = pk2(v[6], v[7]);
          *(v4u*)(lora + (size_t)l * NLO * KLA + (size_t)n * KLA + k0) = o; } }
}
__device__ __forceinline__ void ph_convert_moe(const KP& p, LAS unsigned char* lds, int mi, int gw, int NGW, int wave, int lane) {
    LAS float* scr = (LAS float*)(lds + wave * 16384);
    bf16* w13 = (bf16*)(p.ws + WS_MOEW13); bf16* w2 = (bf16*)(p.ws + WS_MOEW2);
    constexpr int I_UP = (D / 64) * (DFF / 32), I_DN = (DFF / 64) * (D / 32), T_UP = NE * I_UP, T_DN = NE * I_DN;
    for (int it = gw; it < 2 * T_UP + T_DN; it += NGW) {
        int r = it;
        if (r < T_UP) { const int e = r / I_UP; transpose_item<2>(p.in[I_MW1] + ((size_t)mi * NE + e) * D * DFF, D, DFF, w13 + (size_t)e * 2 * DFF * D, 0, scr, r % I_UP, lane); continue; } r -= T_UP;
        if (r < T_UP) { const int e = r / I_UP; transpose_item<2>(p.in[I_MW3] + ((size_t)mi * NE + e) * D * DFF, D, DFF, w13 + (size_t)e * 2 * DFF * D, 1, scr, r % I_UP, lane); continue; } r -= T_UP;
        { const int e = r / I_DN; transpose_item<0>(p.in[I_MW2] + ((size_t)mi * NE + e) * DFF * D, DFF, D, w2 + (size_t)e * D * DFF, 0, scr, r % I_DN, lane); }
    }
}

__device__ __forceinline__ void ld_row(const float* r, int lane, f32x4 (&v)[4]) { const f32x4* q = (const f32x4*)r + lane;
#pragma unroll
    for (int j = 0; j < 4; ++j) v[j] = q[64 * j]; }
__device__ __forceinline__ void st_row(float* r, int lane, const f32x4 (&v)[4]) { f32x4* q = (f32x4*)r + lane;
#pragma unroll
    for (int j = 0; j < 4; ++j) q[64 * j] = v[j]; }
__device__ __forceinline__ void st_row_bf16(bf16* r, int lane, const f32x4 (&v)[4]) { v2u* q = (v2u*)r + lane;
#pragma unroll
    for (int j = 0; j < 4; ++j) { v2u w; w.x = pk2(v[j][0], v[j][1]); w.y = pk2(v[j][2], v[j][3]); q[64 * j] = w; } }
__device__ __forceinline__ void ld_row_bf16(const bf16* r, int lane, f32x4 (&v)[4]) { const v2u* q = (const v2u*)r + lane;
#pragma unroll
    for (int j = 0; j < 4; ++j) { const v2u w = q[64 * j]; v[j] = (f32x4){bflo(w.x), bfhi(w.x), bflo(w.y), bfhi(w.y)}; } }
template <int S> __device__ __forceinline__ void ld_row_parts(const float* r, size_t pstride, int lane, f32x4 (&v)[4]) {
    ld_row(r, lane, v);
#pragma unroll
    for (int s = 1; s < S; ++s) { f32x4 t[4]; ld_row(r + (size_t)s * pstride, lane, t);
#pragma unroll
        for (int j = 0; j < 4; ++j) v[j] += t[j]; } }
__device__ __forceinline__ int mod_row(int row) { return row < NLAT ? (row >> 12) : 4; }

__device__ __forceinline__ void ph_init_rows(const KP& p, int gw, int NGW, int lane) {
    const float* modv = (const float*)(p.ws + WS_MODV); float* X = (float*)(p.ws + WS_X); bf16* H = (bf16*)(p.ws + WS_H);
    for (int row = gw; row < MROWS; row += NGW) {
        const float* src = row < NLAT ? p.in[I_X] + (size_t)row * D : p.in[I_CTX] + (size_t)(row - NLAT) * D;
        const float* mv = modv + (size_t)(0 * 5 + mod_row(row)) * NMOD;
        f32x4 x[4], sh[4], sc[4], h[4]; ld_row(src, lane, x); ld_row(mv, lane, sh); ld_row(mv + 1024, lane, sc);
#pragma unroll
        for (int j = 0; j < 4; ++j) h[j] = x[j] * (1.f + sc[j]) + sh[j];
        st_row(X + (size_t)row * D, lane, x); st_row_bf16(H + (size_t)row * D, lane, h);
    }
}

__device__ __forceinline__ void ph_lora_in(const KP& p, int gw, int NGW, int lane) {
    const bf16* P = (const bf16*)(p.ws + WS_P); bf16* LA = (bf16*)(p.ws + WS_LA);
    const int gt = gw * 64 + lane, NGT = NGW * 64;
    for (int i = gt; i < MROWS * (KLA / 8); i += NGT) { const int row = i >> 6, k0 = (i & 63) * 8; v4u o = (v4u){0u, 0u, 0u, 0u};
        if (k0 < 384) { const v4u s = *(const v4u*)(P + (size_t)row * NP + PC_WD + k0); float v[8] = {bflo(s.x), bfhi(s.x), bflo(s.y), bfhi(s.y), bflo(s.z), bfhi(s.z), bflo(s.w), bfhi(s.w)};
            if (k0 < 128) {
#pragma unroll
                for (int j = 0; j < 8; ++j) v[j] = tanhf(v[j]); }
            else if (k0 >= 256) {
#pragma unroll
                for (int j = 0; j < 8; ++j) v[j] = sigm(v[j]); }
            o.x = pk2(v[0], v[1]); o.y = pk2(v[2], v[3]); o.z = pk2(v[4], v[5]); o.w = pk2(v[6], v[7]); }
        *(v4u*)(LA + (size_t)row * KLA + k0) = o; }
}

__device__ __forceinline__ void ph_prep(const KP& p, int l, int gw, int NGW, int lane) {
    const bf16* P = (const bf16*)(p.ws + WS_P); const float* LO = (const float*)(p.ws + WS_LO); float* PR = (float*)(p.ws + WS_PREP); float* RKS = (float*)(p.ws + WS_RKS);
    constexpr size_t PA = (size_t)MROWS * RW;
    for (int it = gw; it < MROWS * NH; it += NGW) { const int row = it >> 3, h = it & 7, c = h * 64 + lane;
        const float kv = bf2f(P[(size_t)row * NP + PC_K + c]), rv = bf2f(P[(size_t)row * NP + PC_R + c]);
        const float* lo = LO + (size_t)row * NLO;
        float dec[2], a[2];
#pragma unroll
        for (int d = 0; d < 2; ++d) {
            const float wl = p.in[I_W0][(l * 2 + d) * RW + c] + lo[d * RW + c];
            const float z = -wl, sp = z > 20.f ? z : log1pf(expf(z));
            const float w_log = -sp - 0.5f; dec[d] = expf(-expf(w_log));
            a[d] = sigm(p.in[I_A0][(l * 2 + d) * RW + c] + lo[1024 + d * RW + c]);
        }
        float kk = kv * p.in[I_KK][l * RW + c]; const float ss = wave_sum(kk * kk); kk = kk / fmaxf(sqrtf(ss), 1e-12f);
        const float ka = p.in[I_KA][l * RW + c];
        const float kd0 = kv * (1.f + (a[0] - 1.f) * ka), kd1 = kv * (1.f + (a[1] - 1.f) * ka);
        const float rk = wave_sum(rv * (kd0 + kd1) * p.in[I_RK][(l * NH + h) * HS + lane]);
        const size_t o = (size_t)row * RW + c;
        PR[0 * PA + o] = dec[0]; PR[1 * PA + o] = dec[1]; PR[2 * PA + o] = kd0; PR[3 * PA + o] = kd1; PR[4 * PA + o] = kk * a[0]; PR[5 * PA + o] = kk * a[1]; PR[6 * PA + o] = kk;
        if (lane == 0) RKS[row * 8 + h] = rk;
    }
}

__device__ __forceinline__ int scan_row(int b, int dir, int step) { return step < CTXL ? NLAT + b * CTXL + (dir ? CTXL - 1 - step : step) : b * SEQ + (dir ? SEQ - 1 - (step - CTXL) : step - CTXL); }
__device__ __forceinline__ void ph_scan(const KP& p, int wave, int lane) {
    if (wave >= 4) return;
    const bf16* P = (const bf16*)(p.ws + WS_P); const float* PR = (const float*)(p.ws + WS_PREP); float* Y = (float*)(p.ws + WS_Y);
    constexpr size_t PA = (size_t)MROWS * RW; constexpr int NSTEP = CTXL + SEQ;
    for (int wt = blockIdx.x * 4 + wave; wt < 1024; wt += gridDim.x * 4) {
        const int rg = wt & 15, h = (wt >> 4) & 7, b = (wt >> 7) & 3, dir = wt >> 9;
        const int rr = lane >> 4, q = lane & 15, vrow = rg * 4 + rr, ch0 = h * 64 + q * 4;
        const float* Wd = PR + (size_t)dir * PA + ch0; const float* Kd = PR + (size_t)(2 + dir) * PA + ch0; const float* Bd = PR + (size_t)(4 + dir) * PA + ch0; const float* KKp = PR + 6 * PA + ch0;
        float* Yo = Y + (size_t)dir * PA + h * 64 + vrow;
        f32x4 s = (f32x4){0.f, 0.f, 0.f, 0.f};
        f32x4 bw[4], bk[4], bb[4], bq[4]; v2u br[4]; float bv[4];
#pragma unroll
        for (int u = 0; u < 4; ++u) { const size_t ro = (size_t)scan_row(b, dir, u) * RW; const size_t rp = (size_t)scan_row(b, dir, u) * NP;
            bw[u] = *(const f32x4*)(Wd + ro); bk[u] = *(const f32x4*)(Kd + ro); bb[u] = *(const f32x4*)(Bd + ro); bq[u] = *(const f32x4*)(KKp + ro);
            br[u] = *(const v2u*)(P + rp + PC_R + ch0); bv[u] = bf2f(P[rp + PC_V + h * 64 + vrow]); }
        for (int st = 0; st < NSTEP; st += 4) {
#pragma unroll
            for (int u = 0; u < 4; ++u) {
                const f32x4 w = bw[u], kd = bk[u], bvec = bb[u], kk = bq[u]; const v2u rw = br[u]; const float vv = bv[u];
                const int cur = scan_row(b, dir, st + u);
                { const int nstep = st + u + 4 < NSTEP ? st + u + 4 : NSTEP - 1; const int nrow = scan_row(b, dir, nstep); const size_t ro = (size_t)nrow * RW, rp = (size_t)nrow * NP;
                  bw[u] = *(const f32x4*)(Wd + ro); bk[u] = *(const f32x4*)(Kd + ro); bb[u] = *(const f32x4*)(Bd + ro); bq[u] = *(const f32x4*)(KKp + ro);
                  br[u] = *(const v2u*)(P + rp + PC_R + ch0); bv[u] = bf2f(P[rp + PC_V + h * 64 + vrow]); }
                float sa = -((s[0] * kk[0] + s[1] * kk[1]) + (s[2] * kk[2] + s[3] * kk[3]));
                sa += __shfl_xor(sa, 1); sa += __shfl_xor(sa, 2); sa += __shfl_xor(sa, 4); sa += __shfl_xor(sa, 8);
                s = s * w + sa * bvec + vv * kd;
                float y = (s[0] * bflo(rw.x) + s[1] * bfhi(rw.x)) + (s[2] * bflo(rw.y) + s[3] * bfhi(rw.y));
                y += __shfl_xor(y, 1); y += __shfl_xor(y, 2); y += __shfl_xor(y, 4); y += __shfl_xor(y, 8);
                if (q == 0) Yo[(size_t)cur * RW] = y;
            }
        }
    }
}


typedef short sbf16x8 __attribute__((ext_vector_type(8)));
typedef float f32x16 __attribute__((ext_vector_type(16)));
constexpr int SC_C = 32, SC_NCH = (CTXL + SEQ) / SC_C  , SC_NCHAIN = NB * NH * 2  , SC_NTASK = SC_NCH * SC_NCHAIN  ;
constexpr int CH_G = 0, CH_Q = 8192, CH_UT = 12288, CH_YL = 20480, CH_EC = 24576, CH_BYTES = 25600, CH_NLOAD = 26;

__device__ __forceinline__ f32x16 mm(v4u a, v4u b, f32x16 c) { return __builtin_amdgcn_mfma_f32_32x32x16_bf16(__builtin_bit_cast(sbf16x8, a), __builtin_bit_cast(sbf16x8, b), c, 0, 0, 0); }
typedef float f32x2c __attribute__((ext_vector_type(2))); typedef __bf16 bf16x2c __attribute__((ext_vector_type(2)));
__device__ __forceinline__ unsigned cvtpk(float lo, float hi) { return __builtin_bit_cast(unsigned, __builtin_convertvector((f32x2c){lo, hi}, bf16x2c)); }
template <int S, int NEG> __device__ __forceinline__ v4u cvtf(const f32x16& x) {
    v4u w; const float sg = NEG ? -1.f : 1.f;
    w.x = cvtpk(sg * x[8 * S + 0], sg * x[8 * S + 1]); w.y = cvtpk(sg * x[8 * S + 2], sg * x[8 * S + 3]); w.z = cvtpk(sg * x[8 * S + 4], sg * x[8 * S + 5]); w.w = cvtpk(sg * x[8 * S + 6], sg * x[8 * S + 7]); return w; }
template <int MODE  > __device__ __forceinline__ f32x16 mask_acc(f32x16 x, int n, int hh) {
#pragma unroll
    for (int r = 0; r < 16; ++r) { const int m = (r & 3) + 8 * (r >> 2) + 4 * hh; const bool keep = MODE == 0 ? (m > n) : MODE == 1 ? (m < n) : (m <= n); x[r] = keep ? x[r] : 0.f; }
    return x; }
__device__ __forceinline__ f32x16 zero16() { f32x16 z;
#pragma unroll
    for (int r = 0; r < 16; ++r) z[r] = 0.f;
    return z; }
__device__ __forceinline__ void cm_build(const unsigned (&w)[16], v4u (&f)[2][2]) {
#pragma unroll
    for (int s = 0; s < 2; ++s) {
        const auto r0 = __builtin_amdgcn_permlane32_swap(w[8 * s + 0], w[8 * s + 2], false, false), r1 = __builtin_amdgcn_permlane32_swap(w[8 * s + 1], w[8 * s + 3], false, false);
        const auto r2 = __builtin_amdgcn_permlane32_swap(w[8 * s + 4], w[8 * s + 6], false, false), r3 = __builtin_amdgcn_permlane32_swap(w[8 * s + 5], w[8 * s + 7], false, false);
        f[0][s] = (v4u){r0[0], r1[0], r2[0], r3[0]}; f[1][s] = (v4u){r0[1], r1[1], r2[1], r3[1]}; }
}
__device__ __forceinline__ void st16(unsigned char* base, int off, int lane, v4u v) { *(v4u*)(base + off + lane * 16) = v; }

__device__ __forceinline__ void ph_kknorm(const KP& p, int l, int gw, int NGW, int lane) {
    const bf16* P = (const bf16*)(p.ws + WS_P); float* NRM = (float*)(p.ws + WS_RKS);
    for (int it = gw; it < MROWS * NH; it += NGW) { const int row = it >> 3, h = it & 7, c = h * 64 + lane;
        const float kk = bf2f(P[(size_t)row * NP + PC_K + c]) * p.in[I_KK][l * RW + c]; const float ss = wave_sum(kk * kk);
        if (lane == 0) NRM[it] = 1.f / fmaxf(sqrtf(ss), 1e-12f); }
}

__device__ __forceinline__ void ph_scan1(const KP& p, int l, int gw, int NGW, int lane) {
    const bf16* P = (const bf16*)(p.ws + WS_P); const float* LO = (const float*)(p.ws + WS_LO); const float* NRM = (const float*)(p.ws + WS_RKS); unsigned char* CH = p.ws + WS_CH;
    const int n = lane & 31, hh = lane >> 5;
    v4u Id[2];
#pragma unroll
    for (int s = 0; s < 2; ++s) { unsigned wd[4];
#pragma unroll
        for (int q = 0; q < 4; ++q) { const int j0 = 2 * q, j1 = 2 * q + 1; const int t0 = 16 * s + 8 * (j0 >> 2) + 4 * hh + (j0 & 3), t1 = 16 * s + 8 * (j1 >> 2) + 4 * hh + (j1 & 3);
            wd[q] = (t0 == n ? 0x3F80u : 0u) | (t1 == n ? 0x3F800000u : 0u); }
        Id[s] = (v4u){wd[0], wd[1], wd[2], wd[3]}; }
    for (int task = gw; task < SC_NTASK; task += NGW) {
        const int dir = task & 1, h = (task >> 1) & 7, b = (task >> 4) & 3, ci = task >> 6;
        const int row0 = scan_row(b, dir, SC_C * ci), sgn = dir ? -1 : 1, c = h * 64 + lane;
        const float w0c = p.in[I_W0][(l * 2 + dir) * RW + c], a0c = p.in[I_A0][(l * 2 + dir) * RW + c], kkc = p.in[I_KK][l * RW + c], kac = p.in[I_KA][l * RW + c];
        unsigned wAl[16], wBe[16], wKa[16], wRh[16], wV[16], wBp[16], wKp[16];
        float cs = 0.f, Eprev = 1.f;
#pragma unroll
        for (int hb = 0; hb < 2; ++hb) {
            unsigned rk_[16], rr_[16], rv_[16]; float rw_[16], ra_[16], rn_[16];
#pragma unroll
            for (int i = 0; i < 16; ++i) { const int row = row0 + sgn * (16 * hb + i); const bf16* pr = P + (size_t)row * NP; const float* lo = LO + (size_t)row * NLO;
                rk_[i] = pr[PC_K + c]; rr_[i] = pr[PC_R + c]; rv_[i] = pr[PC_V + c]; rw_[i] = lo[dir * RW + c]; ra_[i] = lo[1024 + dir * RW + c]; rn_[i] = NRM[row * 8 + h]; }
#pragma unroll
            for (int i = 0; i < 16; ++i) asm volatile("" : "+v"(rk_[i]), "+v"(rr_[i]), "+v"(rv_[i]), "+v"(rw_[i]), "+v"(ra_[i]), "+v"(rn_[i]));
#pragma unroll
            for (int pq = 0; pq < 8; ++pq) { const int pz = 8 * hb + pq; float al[2], be[2], ka[2], rh[2], vv[2];
#pragma unroll
                for (int e = 0; e < 2; ++e) { const int i = 2 * pq + e;
                    const float kv = bf2f((unsigned short)rk_[i]), rv = bf2f((unsigned short)rr_[i]); vv[e] = bf2f((unsigned short)rv_[i]);
                    const float wl = w0c + rw_[i], aa = __builtin_amdgcn_rcpf(1.f + __expf(-(a0c + ra_[i]))), nrm = rn_[i];
                    const float lw = -0.6065306597f * __builtin_amdgcn_rcpf(1.f + __expf(-wl));
                    cs += lw; const float E = __expf(cs), Ei = __builtin_amdgcn_rcpf(E);
                    const float kkn = kv * kkc * nrm, kd = kv * (1.f + (aa - 1.f) * kac);
                    al[e] = kkn * Eprev; be[e] = kkn * aa * Ei; ka[e] = kd * Ei; rh[e] = rv * E; Eprev = E; }
                wAl[pz] = cvtpk(al[0], al[1]); wBe[pz] = cvtpk(be[0], be[1]); wKa[pz] = cvtpk(ka[0], ka[1]); wRh[pz] = cvtpk(rh[0], rh[1]); wV[pz] = cvtpk(vv[0], vv[1]); }
        }
        const float EC = Eprev;
#pragma unroll
        for (int pz = 0; pz < 16; ++pz) { wBp[pz] = cvtpk(bflo(wBe[pz]) * EC, bfhi(wBe[pz]) * EC); wKp[pz] = cvtpk(bflo(wKa[pz]) * EC, bfhi(wKa[pz]) * EC); }
        unsigned char* img = CH + (size_t)(((b * 8 + h) * 2 + dir) * SC_NCH + ci) * CH_BYTES;
        ((float*)(img + CH_EC))[lane] = EC;
        v4u cAl[2][2], cV[2][2], cBp[2][2], cKp[2][2], cRh[2][2];
        v4u tAl[4], tBe[4], tKa[4], tRh[4];
        cm_build(wAl, cAl); cm_build(wV, cV); cm_build(wBp, cBp); cm_build(wKp, cKp); cm_build(wRh, cRh);
        {   v4u cBe[2][2], cKa[2][2]; cm_build(wBe, cBe); cm_build(wKa, cKa);
#define TRANSPOSE(cZ, tZ) do { _Pragma("unroll") for (int ct = 0; ct < 2; ++ct) { f32x16 T_ = mm(cZ[ct][0], Id[0], zero16()); T_ = mm(cZ[ct][1], Id[1], T_); tZ[2 * ct] = cvtf<0, 0>(T_); tZ[2 * ct + 1] = cvtf<1, 0>(T_); } } while (0)
            TRANSPOSE(cAl, tAl); TRANSPOSE(cBe, tBe); TRANSPOSE(cKa, tKa); TRANSPOSE(cRh, tRh);
#undef TRANSPOSE
        }
#define PROD4(A, B) mm(A[3], B[3], mm(A[2], B[2], mm(A[1], B[1], mm(A[0], B[0], zero16()))))
        f32x16 XN = mask_acc<0>(PROD4(tAl, tBe), n, hh), XT = mask_acc<1>(PROD4(tBe, tAl), n, hh);
        v4u fLM[2], fGB[2], fGK[2];
        { const f32x16 t = mask_acc<1>(PROD4(tKa, tAl), n, hh); fLM[0] = cvtf<0, 0>(t); fLM[1] = cvtf<1, 0>(t); }
        { const f32x16 t = mask_acc<2>(PROD4(tBe, tRh), n, hh); fGB[0] = cvtf<0, 0>(t); fGB[1] = cvtf<1, 0>(t); }
        { const f32x16 t = mask_acc<2>(PROD4(tKa, tRh), n, hh); fGK[0] = cvtf<0, 0>(t); fGK[1] = cvtf<1, 0>(t); }
#undef PROD4
#pragma unroll
        for (int r = 0; r < 16; ++r) { XN[r] = -XN[r]; XT[r] = -XT[r]; }
        f32x16 RT = XT;
#pragma unroll
        for (int r = 0; r < 16; ++r) RT[r] += ((r & 3) + 8 * (r >> 2) + 4 * hh == n) ? 1.f : 0.f;
#pragma unroll
        for (int pw = 1; pw < 5; ++pw) {
            const v4u xn0 = cvtf<0, 0>(XN), xn1 = cvtf<1, 0>(XN), xt0 = cvtf<0, 0>(XT), xt1 = cvtf<1, 0>(XT);
            XN = mm(xt1, xn1, mm(xt0, xn0, zero16()));
            if (pw < 4) XT = mm(xn1, xt1, mm(xn0, xt0, zero16()));
            const v4u yn0 = cvtf<0, 0>(XN), yn1 = cvtf<1, 0>(XN), rt0 = cvtf<0, 0>(RT), rt1 = cvtf<1, 0>(RT);
            RT = mm(yn1, rt1, mm(yn0, rt0, RT));
        }
        const v4u fA0 = cvtf<0, 0>(RT), fA1 = cvtf<1, 0>(RT);
        f32x16 At[2], Vt[2];
#pragma unroll
        for (int t = 0; t < 2; ++t) {
            const f32x16 lmv = mm(fLM[1], cV[t][1], mm(fLM[0], cV[t][0], zero16()));
            At[t] = mm(fA1, cAl[t][1], mm(fA0, cAl[t][0], zero16()));
            Vt[t] = mm(fA1, cvtf<1, 0>(lmv), mm(fA0, cvtf<0, 0>(lmv), zero16()));
        }
#pragma unroll
        for (int kt1 = 0; kt1 < 2; ++kt1) { const v4u a0 = cvtf<0, 0>(At[kt1]), a1 = cvtf<1, 0>(At[kt1]);
#pragma unroll
            for (int kt2 = 0; kt2 < 2; ++kt2) { const f32x16 g = mm(a1, cBp[kt2][1], mm(a0, cBp[kt2][0], zero16()));
                st16(img, CH_G + ((kt2 * 2 + kt1) * 2 + 0) * 1024, lane, cvtf<0, 1>(g)); st16(img, CH_G + ((kt2 * 2 + kt1) * 2 + 1) * 1024, lane, cvtf<1, 1>(g)); } }
#pragma unroll
        for (int vt = 0; vt < 2; ++vt) { const v4u nv0 = cvtf<0, 1>(Vt[vt]), nv1 = cvtf<1, 1>(Vt[vt]);
#pragma unroll
            for (int kt = 0; kt < 2; ++kt) { f32x16 u = mm(cKp[kt][1], cV[vt][1], mm(cKp[kt][0], cV[vt][0], zero16())); u = mm(cBp[kt][1], nv1, mm(cBp[kt][0], nv0, u));
                st16(img, CH_UT + ((kt * 2 + vt) * 2 + 0) * 1024, lane, cvtf<0, 0>(u)); st16(img, CH_UT + ((kt * 2 + vt) * 2 + 1) * 1024, lane, cvtf<1, 0>(u)); }
            f32x16 y = mm(cV[vt][1], fGK[1], mm(cV[vt][0], fGK[0], zero16())); y = mm(nv1, fGB[1], mm(nv0, fGB[0], y));
            st16(img, CH_YL + (vt * 2 + 0) * 1024, lane, cvtf<0, 0>(y)); st16(img, CH_YL + (vt * 2 + 1) * 1024, lane, cvtf<1, 0>(y)); }
#pragma unroll
        for (int kt = 0; kt < 2; ++kt) { f32x16 q = mm(cRh[kt][1], Id[1], mm(cRh[kt][0], Id[0], zero16()));
            q = mm(cvtf<1, 1>(At[kt]), fGB[1], mm(cvtf<0, 1>(At[kt]), fGB[0], q));
            st16(img, CH_Q + (kt * 2 + 0) * 1024, lane, cvtf<0, 0>(q)); st16(img, CH_Q + (kt * 2 + 1) * 1024, lane, cvtf<1, 0>(q)); }
    }
}

__device__ __forceinline__ void ph_scan2(const KP& p, LAS unsigned char* lds, int wave, int lane) {
    if (blockIdx.x >= SC_NCHAIN * 2) return;
    const int chain = blockIdx.x >> 1, vt = blockIdx.x & 1, dir = chain & 1, h = (chain >> 1) & 7, b = chain >> 4;
    const int n = lane & 31, hh = lane >> 5;
    const unsigned char* CH = p.ws + WS_CH + (size_t)chain * SC_NCH * CH_BYTES; float* Y = (float*)(p.ws + WS_Y) + (size_t)dir * MROWS * RW + h * 64 + 32 * vt + 4 * hh;
    constexpr int NPIECE = 19, SLOT = NPIECE * 1024;
    int psrc[3], pdst[3];
#pragma unroll
    for (int j = 0; j < 3; ++j) { int f = wave + 8 * j; if (f >= NPIECE) f -= NPIECE;
        pdst[j] = f;
        psrc[j] = f < 12 ? f * 1024 : f < 16 ? CH_UT + ((((f - 12) >> 1) * 2 + vt) * 2 + ((f - 12) & 1)) * 1024 : f < 18 ? CH_YL + (vt * 2 + (f - 16)) * 1024 : CH_EC; }
    const int lane_off[3] = {pdst[0] == 18 ? (lane * 16) & 255 : lane * 16, pdst[1] == 18 ? (lane * 16) & 255 : lane * 16, pdst[2] == 18 ? (lane * 16) & 255 : lane * 16};
#define SC2_ISSUE(ci_, slot_) do { const unsigned char* im_ = CH + (size_t)(ci_) * CH_BYTES; LAS unsigned char* sl_ = lds + (slot_) * SLOT; \
        _Pragma("unroll") for (int j = 0; j < 3; ++j) __builtin_amdgcn_global_load_lds((const unsigned*)(im_ + psrc[j] + lane_off[j]), (LAS unsigned*)(sl_ + pdst[j] * 1024), 16, 0, 0); } while (0)
#define SC2_LD(slot_, piece_) (*(const LAS v4u*)(lds + (slot_) * SLOT + (piece_) * 1024 + lane * 16))
    f32x16 ST[2] = {zero16(), zero16()};
    SC2_ISSUE(0, 0); SC2_ISSUE(1, 1);
    for (int ci = 0; ci < SC_NCH; ++ci) {
        const int slot = ci % 3;
        asm volatile("s_waitcnt vmcnt(3)" ::: "memory");
        __builtin_amdgcn_s_barrier();
        asm volatile("" ::: "memory");
        { const int nx = ci + 2 < SC_NCH ? ci + 2 : SC_NCH - 1; SC2_ISSUE(nx, (ci + 2) % 3); }
        if (wave != 0) continue;
        const v4u s00 = cvtf<0, 0>(ST[0]), s01 = cvtf<1, 0>(ST[0]), s10 = cvtf<0, 0>(ST[1]), s11 = cvtf<1, 0>(ST[1]);
        f32x16 y;
        { const v4u a = SC2_LD(slot, 16), c = SC2_LD(slot, 17);
          y[0] = bflo(a.x); y[1] = bfhi(a.x); y[2] = bflo(a.y); y[3] = bfhi(a.y); y[4] = bflo(a.z); y[5] = bfhi(a.z); y[6] = bflo(a.w); y[7] = bfhi(a.w);
          y[8] = bflo(c.x); y[9] = bfhi(c.x); y[10] = bflo(c.y); y[11] = bfhi(c.y); y[12] = bflo(c.z); y[13] = bfhi(c.z); y[14] = bflo(c.w); y[15] = bfhi(c.w); }
        y = mm(s00, SC2_LD(slot, 8), y); y = mm(s01, SC2_LD(slot, 9), y); y = mm(s10, SC2_LD(slot, 10), y); y = mm(s11, SC2_LD(slot, 11), y);
        { const int row = scan_row(b, dir, SC_C * ci + n); float* yo = Y + (size_t)row * RW;
#pragma unroll
          for (int q = 0; q < 4; ++q) *(f32x4*)(yo + 8 * q) = (f32x4){y[4 * q], y[4 * q + 1], y[4 * q + 2], y[4 * q + 3]}; }
#pragma unroll
        for (int kt2 = 0; kt2 < 2; ++kt2) { f32x16 a;
            const v4u u0 = SC2_LD(slot, 12 + kt2 * 2), u1 = SC2_LD(slot, 13 + kt2 * 2);
            a[0] = bflo(u0.x); a[1] = bfhi(u0.x); a[2] = bflo(u0.y); a[3] = bfhi(u0.y); a[4] = bflo(u0.z); a[5] = bfhi(u0.z); a[6] = bflo(u0.w); a[7] = bfhi(u0.w);
            a[8] = bflo(u1.x); a[9] = bfhi(u1.x); a[10] = bflo(u1.y); a[11] = bfhi(u1.y); a[12] = bflo(u1.z); a[13] = bfhi(u1.z); a[14] = bflo(u1.w); a[15] = bfhi(u1.w);
#pragma unroll
            for (int q = 0; q < 4; ++q) { const f32x4 ec = *(const LAS f32x4*)(lds + slot * SLOT + 18 * 1024 + (32 * kt2 + 8 * q + 4 * hh) * 4);
#pragma unroll
                for (int e = 0; e < 4; ++e) a[4 * q + e] += ST[kt2][4 * q + e] * ec[e]; }
            a = mm(SC2_LD(slot, (kt2 * 2 + 0) * 2 + 0), s00, a); a = mm(SC2_LD(slot, (kt2 * 2 + 0) * 2 + 1), s01, a);
            a = mm(SC2_LD(slot, (kt2 * 2 + 1) * 2 + 0), s10, a); a = mm(SC2_LD(slot, (kt2 * 2 + 1) * 2 + 1), s11, a);
            ST[kt2] = a; }
        asm volatile("s_waitcnt lgkmcnt(0)" ::: "memory");
    }
    asm volatile("s_waitcnt vmcnt(0)" ::: "memory");
#undef SC2_ISSUE
#undef SC2_LD
}


__device__ __forceinline__ float sum8(float v) { v += __shfl_xor(v, 1); v += __shfl_xor(v, 2); v += __shfl_xor(v, 4); return v; }
__device__ __forceinline__ void unpack8(v4u s, float (&v)[8]) { v[0] = bflo(s.x); v[1] = bfhi(s.x); v[2] = bflo(s.y); v[3] = bfhi(s.y); v[4] = bflo(s.z); v[5] = bfhi(s.z); v[6] = bflo(s.w); v[7] = bfhi(s.w); }
__device__ __forceinline__ void ld8f(const float* q, float (&v)[8]) { const f32x4 a = *(const f32x4*)q, b = *(const f32x4*)(q + 4); v[0] = a[0]; v[1] = a[1]; v[2] = a[2]; v[3] = a[3]; v[4] = b[0]; v[5] = b[1]; v[6] = b[2]; v[7] = b[3]; }
__device__ __forceinline__ v4u pack8(const float (&v)[8]) { v4u o; o.x = cvtpk(v[0], v[1]); o.y = cvtpk(v[2], v[3]); o.z = cvtpk(v[4], v[5]); o.w = cvtpk(v[6], v[7]); return o; }

__device__ __forceinline__ void ph_post_inproj(const KP& p, int l, int gw, int NGW, int lane) {
    const bf16* P = (const bf16*)(p.ws + WS_P); bf16* LA = (bf16*)(p.ws + WS_LA); float* NRM = (float*)(p.ws + WS_RKS);
    float kkc[8]; ld8f(p.in[I_KK] + l * RW + lane * 8, kkc);
    for (int row = gw; row < MROWS; row += NGW) { const bf16* pr = P + (size_t)row * NP;
        const v4u kw = *(const v4u*)(pr + PC_K + lane * 8); v4u sw = (v4u){0u, 0u, 0u, 0u}; if (lane < 48) sw = *(const v4u*)(pr + PC_WD + lane * 8);
        float kv[8]; unpack8(kw, kv); float ss = 0.f;
#pragma unroll
        for (int j = 0; j < 8; ++j) { const float t = kv[j] * kkc[j]; ss += t * t; }
        ss = sum8(ss); if ((lane & 7) == 0) NRM[row * 8 + (lane >> 3)] = 1.f / fmaxf(sqrtf(ss), 1e-12f);
        float v[8]; unpack8(sw, v);
        if (lane < 16) {
#pragma unroll
            for (int j = 0; j < 8; ++j) v[j] = tanhf(v[j]); }
        else if (lane >= 32) {
#pragma unroll
            for (int j = 0; j < 8; ++j) v[j] = sigm(v[j]); }
        v4u o = pack8(v); if (lane >= 48) o = (v4u){0u, 0u, 0u, 0u};
        *(v4u*)(LA + (size_t)row * KLA + lane * 8) = o; }
}

__device__ __forceinline__ void ph_readout2(const KP& p, int l, int gw, int NGW, int lane) {
    const bf16* P = (const bf16*)(p.ws + WS_P); const float* LO = (const float*)(p.ws + WS_LO); const float* Y = (const float*)(p.ws + WS_Y);
    bf16* MI = (bf16*)(p.ws + WS_MIXIN); constexpr size_t PA = (size_t)MROWS * RW; const int c0 = lane * 8;
    for (int row = gw; row < MROWS; row += NGW) { const bf16* pr = P + (size_t)row * NP; const float* lo = LO + (size_t)row * NLO;
        int t, len; if (row < NLAT) { t = row & 63; len = 64; } else { t = (row - NLAT) & 255; len = 256; }
        const v4u kw = *(const v4u*)(pr + PC_K + c0), rw = *(const v4u*)(pr + PC_R + c0), vw = *(const v4u*)(pr + PC_V + c0);
        const v4u cbw = *(const v4u*)(pr + PC_CB + c0), ccw = *(const v4u*)(pr + PC_CC + c0), chw = *(const v4u*)(pr + PC_CH + c0);
        v4u ccp = (v4u){0u, 0u, 0u, 0u}, chp = ccp, ccn = ccp, chn = ccp;
        if (t > 0) { ccp = *(const v4u*)(pr - NP + PC_CC + c0); chp = *(const v4u*)(pr - NP + PC_CH + c0); }
        if (t < len - 1) { ccn = *(const v4u*)(pr + NP + PC_CC + c0); chn = *(const v4u*)(pr + NP + PC_CH + c0); }
        float yf[8], yb[8], la0[8], la1[8], g[8];
        ld8f(Y + (size_t)row * RW + c0, yf); ld8f(Y + PA + (size_t)row * RW + c0, yb); ld8f(lo + 1024 + c0, la0); ld8f(lo + 1536 + c0, la1); ld8f(lo + 2048 + c0, g);
        float a0[8], a1[8], ka[8], rkp[8], lg[8], lb[8];
        ld8f(p.in[I_A0] + (l * 2 + 0) * RW + c0, a0); ld8f(p.in[I_A0] + (l * 2 + 1) * RW + c0, a1); ld8f(p.in[I_KA] + l * RW + c0, ka); ld8f(p.in[I_RK] + l * RW + c0, rkp);
        ld8f(p.in[I_LNXG] + l * RW + c0, lg); ld8f(p.in[I_LNXB] + l * RW + c0, lb);
        float kv[8], rv[8], vv[8]; unpack8(kw, kv); unpack8(rw, rv); unpack8(vw, vv);
        float y[8], s = 0.f, rk = 0.f;
#pragma unroll
        for (int j = 0; j < 8; ++j) { y[j] = yf[j] + yb[j]; s += y[j]; const float av = sigm(a0[j] + la0[j]) + sigm(a1[j] + la1[j]); rk += rv[j] * kv[j] * (2.f + (av - 2.f) * ka[j]) * rkp[j]; }
        const float mu = sum8(s) * (1.f / 64.f); rk = sum8(rk); float q = 0.f;
#pragma unroll
        for (int j = 0; j < 8; ++j) { y[j] -= mu; q += y[j] * y[j]; }
        const float rstd = 1.f / sqrtf(sum8(q) * (1.f / 64.f) + GN_EPS);
        float o[8];
#pragma unroll
        for (int j = 0; j < 8; ++j) o[j] = (y[j] * rstd * lg[j] + lb[j] + rk * vv[j]) * g[j];
        *(v4u*)(MI + (size_t)row * D + c0) = pack8(o);
        float cb[8], cc[8], ch[8], pcc[8], pch[8], ncc[8], nch[8], w0[8], w1[8], w2[8];
        unpack8(cbw, cb); unpack8(ccw, cc); unpack8(chw, ch); unpack8(ccp, pcc); unpack8(chp, pch); unpack8(ccn, ncc); unpack8(chn, nch);
        const float* cw = p.in[I_CONVW] + (size_t)l * 3 * RW + c0; ld8f(cw, w0); ld8f(cw + RW, w1); ld8f(cw + 2 * RW, w2);
#pragma unroll
        for (int j = 0; j < 8; ++j) o[j] = cb[j] * (pcc[j] * pch[j] * w0[j] + cc[j] * ch[j] * w1[j] + ncc[j] * nch[j] * w2[j]);
        *(v4u*)(MI + (size_t)row * D + RW + c0) = pack8(o);
    }
}

__device__ __forceinline__ void ph_readout(const KP& p, int l, int gw, int NGW, int lane) {
    const bf16* P = (const bf16*)(p.ws + WS_P); const float* LO = (const float*)(p.ws + WS_LO); const float* Y = (const float*)(p.ws + WS_Y);
    bf16* MI = (bf16*)(p.ws + WS_MIXIN); constexpr size_t PA = (size_t)MROWS * RW;
    for (int it = gw; it < MROWS * NH; it += NGW) { const int row = it >> 3, h = it & 7, c = h * 64 + lane;
        const float y = Y[(size_t)row * RW + c] + Y[PA + (size_t)row * RW + c];
        const float mu = wave_sum(y) * (1.f / 64.f), dv = y - mu, var = wave_sum(dv * dv) * (1.f / 64.f);
        const float yn = dv / sqrtf(var + GN_EPS);
        const bf16* pr = P + (size_t)row * NP;
        const float v = bf2f(pr[PC_V + c]);
        const float kv = bf2f(pr[PC_K + c]), rv = bf2f(pr[PC_R + c]);
        const float a0v = sigm(p.in[I_A0][(l * 2 + 0) * RW + c] + LO[(size_t)row * NLO + 1024 + c]), a1v = sigm(p.in[I_A0][(l * 2 + 1) * RW + c] + LO[(size_t)row * NLO + 1536 + c]);
        const float rk = wave_sum(rv * kv * (2.f + (a0v + a1v - 2.f) * p.in[I_KA][l * RW + c]) * p.in[I_RK][(l * NH + h) * HS + lane]);
        const float o = yn * p.in[I_LNXG][l * RW + c] + p.in[I_LNXB][l * RW + c] + rk * v;
        const float g = LO[(size_t)row * NLO + 2048 + c];
        MI[(size_t)row * D + c] = (bf16)f2bf(o * g);
        int t, len; if (row < NLAT) { t = row & 63; len = 64; } else { t = (row - NLAT) & 255; len = 256; }
        const float uc = bf2f(pr[PC_CC + c]) * bf2f(pr[PC_CH + c]);
        const float up = t > 0 ? bf2f(pr[PC_CC + c - NP]) * bf2f(pr[PC_CH + c - NP]) : 0.f;
        const float un = t < len - 1 ? bf2f(pr[PC_CC + c + NP]) * bf2f(pr[PC_CH + c + NP]) : 0.f;
        const float* cw = p.in[I_CONVW] + (size_t)l * 3 * RW;
        const float cv = up * cw[c] + uc * cw[RW + c] + un * cw[2 * RW + c];
        MI[(size_t)row * D + RW + c] = (bf16)f2bf(bf2f(pr[PC_CB + c]) * cv);
    }
}


__device__ __forceinline__ void ph_moe_gather(const KP& p, int l, int gw, int NGW, int lane) {
    const unsigned* gcnt = (const unsigned*)(p.ws + WS_CTL) + CW_GCNT + 64 * (l >> 1);
    int cnt[8], pb[9]; pb[0] = 0;
#pragma unroll
    for (int e = 0; e < 8; ++e) { cnt[e] = (int)gcnt[e]; pb[e + 1] = pb[e] + ((cnt[e] + 255) & ~255); }
    const unsigned* rowlist = (const unsigned*)(p.ws + WS_ROWLIST); const float* wsel = (const float*)(p.ws + WS_WSEL); float* wsort = (float*)(p.ws + WS_WSORT);
    const bf16* H = (const bf16*)(p.ws + WS_H); bf16* HG = (bf16*)(p.ws + WS_HG);
    for (int pos = gw; pos < pb[8]; pos += NGW) {
        int e = 0, base = 0, ce = cnt[0];
#pragma unroll
        for (int k = 1; k < 8; ++k) if (pos >= pb[k]) { e = k; base = pb[k]; ce = cnt[k]; }
        const int rank = pos - base; v4u a = (v4u){0u, 0u, 0u, 0u}, b = a; float w = 0.f;
        if (rank < ce) { const unsigned ent = rowlist[(size_t)e * MROWS + rank]; const v4u* src = (const v4u*)(H + (size_t)(ent >> 1) * D); a = src[lane]; b = src[64 + lane]; w = wsel[ent]; }
        v4u* dst = (v4u*)(HG + (size_t)pos * D); dst[lane] = a; dst[64 + lane] = b;
        if (lane == 0) wsort[pos] = w;
    }
}

__device__ __forceinline__ void ph_ln(const KP& p, LAS unsigned char* lds, int l, int which, int tid, int wave, int gw, int NGW, int lane) {
    const float* modv = (const float*)(p.ws + WS_MODV); float* X = (float*)(p.ws + WS_X); bf16* H = (bf16*)(p.ws + WS_H);
    const bf16* BR = (const bf16*)(p.ws + (which == 0 ? WS_MIXO : WS_F)); const float* BP = (const float*)(p.ws + (which == 0 ? WS_MIXP : WS_FP));
    const float* lg = p.in[which == 0 ? I_LN1G : I_LN2G] + l * D; const float* lb = p.in[which == 0 ? I_LN1B : I_LN2B] + l * D;
    const bool moe = (which == 0) && (l & 1); const bool last = (which == 1) && (l == DEPTH - 1); const bool moe_out = (which == 1) && (l & 1);
    LAS int* lcnt = (LAS int*)lds;
    LAS int* lsel = (LAS int*)(lds + 64);
    int nloc = 0;
    if (moe) { if (tid < 16) lcnt[tid] = 0; __syncthreads(); }
    int pbs[9]; pbs[0] = 0;
    if (moe_out) { const unsigned* gcnt = (const unsigned*)(p.ws + WS_CTL) + CW_GCNT + 64 * (l >> 1);
#pragma unroll
        for (int e = 0; e < 8; ++e) pbs[e + 1] = pbs[e] + (int)((gcnt[e] + 255u) & ~255u); }
    for (int row = gw; row < MROWS; row += NGW) {
        const int mr = mod_row(row); const float* mv = modv + (size_t)(l * 5 + mr) * NMOD;
        f32x4 x[4], br[4], gt[4], t[4]; ld_row(X + (size_t)row * D, lane, x); ld_row(mv + (which == 0 ? 2048 : 5120), lane, gt);
        if (moe_out) { const int* ts = (const int*)(p.ws + WS_TOKSEL) + row * 4; const int e0 = ts[0], r0 = ts[1], e1 = ts[2], r1 = ts[3]; int b0 = 0, b1 = 0;
#pragma unroll
            for (int k = 1; k < 8; ++k) { if (e0 >= k) b0 = pbs[k]; if (e1 >= k) b1 = pbs[k]; }
            f32x4 ba[4], bb[4]; const int q0 = b0 + r0, q1 = b1 + r1; constexpr int MM = MOE_MAIN_PANELS * 256;
            if (q0 < MM) ld_row_bf16(BR + (size_t)q0 * D, lane, ba); else ld_row_parts<4>(BP + (size_t)(q0 - MM) * D, (size_t)MOE_TAIL_ROWS * D, lane, ba);
            if (q1 < MM) ld_row_bf16(BR + (size_t)q1 * D, lane, bb); else ld_row_parts<4>(BP + (size_t)(q1 - MM) * D, (size_t)MOE_TAIL_ROWS * D, lane, bb);
#pragma unroll
            for (int j = 0; j < 4; ++j) br[j] = ba[j] + bb[j]; }
        else if (row < NLAT) ld_row_bf16(BR + (size_t)row * D, lane, br);
        else if (which == 0) ld_row_parts<4>(BP + (size_t)(row - NLAT) * D, (size_t)NCTX * D, lane, br);
        else ld_row_parts<7>(BP + (size_t)(row - NLAT) * D, (size_t)NCTX * D, lane, br);
        float s = 0.f;
#pragma unroll
        for (int j = 0; j < 4; ++j) { t[j] = DN_ALPHA * x[j] + gt[j] * br[j]; s += (t[j][0] + t[j][1]) + (t[j][2] + t[j][3]); }
        const float mean = wave_sum(s) * (1.f / D); float s2 = 0.f;
#pragma unroll
        for (int j = 0; j < 4; ++j) { t[j] = t[j] - mean; s2 += (t[j][0] * t[j][0] + t[j][1] * t[j][1]) + (t[j][2] * t[j][2] + t[j][3] * t[j][3]); }
        const float rstd = 1.f / sqrtf(wave_sum(s2) * (1.f / D) + LN_EPS);
        f32x4 g4[4], b4[4]; ld_row(lg, lane, g4); ld_row(lb, lane, b4);
#pragma unroll
        for (int j = 0; j < 4; ++j) x[j] = t[j] * rstd * g4[j] + b4[j];
        if (last) { if (row < NLAT) st_row(p.out + (size_t)row * D, lane, x); continue; }
        st_row(X + (size_t)row * D, lane, x);
        const float* mv2 = which == 0 ? mv + 3072 : modv + (size_t)((l + 1) * 5 + mr) * NMOD;
        f32x4 sh[4], sc[4], hh[4]; ld_row(mv2, lane, sh); ld_row(mv2 + 1024, lane, sc);
#pragma unroll
        for (int j = 0; j < 4; ++j) hh[j] = x[j] * (1.f + sc[j]) + sh[j];
        st_row_bf16(H + (size_t)row * D, lane, hh);
        if (moe) {
            const float* rw = p.in[I_RTW] + (size_t)(l >> 1) * D * NE; float lgt[8];
#pragma unroll
            for (int e = 0; e < 8; ++e) lgt[e] = 0.f;
#pragma unroll
            for (int j = 0; j < 4; ++j)
#pragma unroll
                for (int i = 0; i < 4; ++i) { const f32x4* wp = (const f32x4*)(rw + (size_t)(4 * lane + 256 * j + i) * NE); const f32x4 w0 = wp[0], w1 = wp[1]; const float hv = hh[j][i];
                    lgt[0] += hv * w0[0]; lgt[1] += hv * w0[1]; lgt[2] += hv * w0[2]; lgt[3] += hv * w0[3]; lgt[4] += hv * w1[0]; lgt[5] += hv * w1[1]; lgt[6] += hv * w1[2]; lgt[7] += hv * w1[3]; }
#pragma unroll
            for (int e = 0; e < 8; ++e) lgt[e] = wave_sum(lgt[e]) + p.in[I_RTB][(l >> 1) * NE + e];
            float v0 = lgt[0]; int i0 = 0;
#pragma unroll
            for (int e = 1; e < 8; ++e) if (lgt[e] > v0) { v0 = lgt[e]; i0 = e; }
            float v1 = -3.0e38f; int i1 = -1;
#pragma unroll
            for (int e = 0; e < 8; ++e) if (e != i0 && lgt[e] > v1) { v1 = lgt[e]; i1 = e; }
            const float w0 = 1.f / (1.f + expf(v1 - v0)), w1 = 1.f - w0;
            if (lane == 0) { const int lr0 = __hip_atomic_fetch_add(lcnt + i0, 1, __ATOMIC_RELAXED, __HIP_MEMORY_SCOPE_WORKGROUP), lr1 = __hip_atomic_fetch_add(lcnt + i1, 1, __ATOMIC_RELAXED, __HIP_MEMORY_SCOPE_WORKGROUP); const int li = nloc * NWAVES + wave;
                lsel[li * 8 + 0] = row; lsel[li * 8 + 1] = i0; lsel[li * 8 + 2] = lr0; lsel[li * 8 + 3] = i1; lsel[li * 8 + 4] = lr1;
                ((float*)(p.ws + WS_WSEL))[row * 2] = w0; ((float*)(p.ws + WS_WSEL))[row * 2 + 1] = w1; }
            ++nloc;
        }
    }
    if (moe) {
        __syncthreads();
        unsigned* gcnt = (unsigned*)(p.ws + WS_CTL) + CW_GCNT + 64 * (l >> 1);
        if (tid < 8) lcnt[8 + tid] = (int)__hip_atomic_fetch_add(gcnt + tid, (unsigned)lcnt[tid], __ATOMIC_RELAXED, __HIP_MEMORY_SCOPE_AGENT);
        __syncthreads();
        unsigned* rowlist = (unsigned*)(p.ws + WS_ROWLIST); int* toksel = (int*)(p.ws + WS_TOKSEL);
        if (tid < 16 * NWAVES) { const int k = tid / NWAVES, w = tid % NWAVES; if (k * NGW + (int)blockIdx.x * NWAVES + w < MROWS) { const int li = k * NWAVES + w;
            const int row = lsel[li * 8 + 0], e0 = lsel[li * 8 + 1], r0 = lcnt[8 + e0] + lsel[li * 8 + 2], e1 = lsel[li * 8 + 3], r1 = lcnt[8 + e1] + lsel[li * 8 + 4];
            rowlist[(size_t)e0 * MROWS + r0] = (unsigned)row * 2u; rowlist[(size_t)e1 * MROWS + r1] = (unsigned)row * 2u + 1u;
            toksel[row * 4 + 0] = e0; toksel[row * 4 + 1] = r0; toksel[row * 4 + 2] = e1; toksel[row * 4 + 3] = r1; } }
    }
}

__global__ void __launch_bounds__(NWAVES * 64, 2) fwd_kernel(KP p) {
    extern __shared__ __attribute__((aligned(16))) unsigned char lds_raw[];
    LAS unsigned char* lds = (LAS unsigned char*)lds_raw;
    volatile LAS unsigned* MISC = (volatile LAS unsigned*)(lds + MISC_OFF);
    const int G = gridDim.x, NGW = G * NWAVES;
    for (int u = threadIdx.x; u < (LDS_BYTES - LDSCTL_OFF) / 4; u += NWAVES * 64) ((LAS unsigned*)(lds + LDSCTL_OFF))[u] = 0u;
    __syncthreads();
    unsigned* ctl = (unsigned*)(p.ws + WS_CTL);
    const bool single = p.ph < 0;
    XcdBarrier bar; bar.bar = ctl + CW_BAR; bar.x = 0; bar.st = nullptr;
    if (single) bar = xcd_barrier_post(ctl + CW_BAR, MISC + 8);
    int phc = 0;
#ifndef PROBE_DUP
#define PROBE_DUP 0
#endif
#define REP(bit) for (int rep_ = 0; rep_ < ((PROBE_DUP & (bit)) ? 2 : 1); ++rep_)
#define RUN() (single || p.ph == phc)
#define FRESH() int tid = threadIdx.x; asm volatile("" : "+v"(tid)); const int lane = tid & 63, wave = __builtin_amdgcn_readfirstlane(tid >> 6), gw = blockIdx.x * NWAVES + wave; (void)lane; (void)gw
#define SEAM() do { if (single) { XcdBarrier b2_ = bar; asm volatile("" : "+s"(b2_.bar)); xcd_barrier(b2_); } ++phc; } while (0)

    bf16* H = (bf16*)(p.ws + WS_H); bf16* Pm = (bf16*)(p.ws + WS_P);
    REP(4) if (RUN()) { FRESH(); ph_modvec(p, lds, tid); __syncthreads(); ph_convert(p, lds, gw, NGW, wave, lane); }
    SEAM();
    if (RUN()) { FRESH(); ph_init_rows(p, gw, NGW, lane); }
    SEAM();
    for (int l = 0; l < DEPTH; ++l) {
        REP(16) if (RUN()) { pg8::Gemm g{H, (const bf16*)(p.ws + WS_WIN) + (size_t)l * NP * D, MROWS, NP, D, D}; pg8::StaticOrder S; S.init(MROWS, NP, G, (int)blockIdx.x);
            pg8::EpiBf16<0> E{Pm, NP, nullptr, 0, 0, 1.f}; pg8::gemm_phase<pg8::EpiBf16<0>, pg8::StaticOrder, true, true>(lds, g, S, E); }
        SEAM();
        REP(8) if (RUN()) { FRESH(); ph_post_inproj(p, l, gw, NGW, lane); }
        SEAM();
        REP(16) if (RUN()) { pg8::Gemm g{(const bf16*)(p.ws + WS_LA), (const bf16*)(p.ws + WS_LORA) + (size_t)l * NLO * KLA, MROWS, NLO, KLA, KLA}; pg8::StaticOrder S; S.init(MROWS, NLO, G, (int)blockIdx.x);
            pg8::EpiF32 E{(float*)(p.ws + WS_LO), NLO, 0}; pg8::gemm_phase<pg8::EpiF32, pg8::StaticOrder, true, true>(lds, g, S, E); }
        SEAM();
        REP(1) if (RUN()) { FRESH(); ph_scan1(p, l, gw, NGW, lane); }
        SEAM();
        REP(2) if (RUN()) { FRESH(); ph_scan2(p, lds, wave, lane); }
        SEAM();
        REP(8) if (RUN()) { FRESH(); ph_readout2(p, l, gw, NGW, lane); }
        SEAM();
        REP(16) if (RUN()) {
            { pg8::Gemm g{(const bf16*)(p.ws + WS_MIXIN), (const bf16*)(p.ws + WS_WOUT) + (size_t)l * D * D, NLAT, D, D, D}; pg8::StaticOrder S; S.init(NLAT, D, G, (int)blockIdx.x);
              pg8::EpiBf16<0> E{(bf16*)(p.ws + WS_MIXO), D, nullptr, 0, 0, 1.f}; pg8::gemm_phase<pg8::EpiBf16<0>, pg8::StaticOrder, true, true>(lds, g, S, E); }
            { pg8::Gemm g{(const bf16*)(p.ws + WS_MIXIN), (const bf16*)(p.ws + WS_WOUT) + (size_t)l * D * D, NCTX, D, D / 4, D}; pg8::SplitOrder S{NCTX / 256, D / 256, 4, G, (int)blockIdx.x, NLAT / 256, 0, 0, 0, 0, 0, 0, 0, 0};
              pg8::EpiPart E{(float*)(p.ws + WS_MIXP), D, (size_t)NCTX * D, NLAT / 256}; pg8::gemm_phase<pg8::EpiPart, pg8::SplitOrder, true, true>(lds, g, S, E); }
        }
        SEAM();
        if (RUN()) { FRESH(); ph_ln(p, lds, l, 0, tid, wave, gw, NGW, lane); }
        SEAM();
        if ((l & 1) == 0) {
            const int fi = l >> 1;
            REP(16) if (RUN()) { pg8::Gemm g{H, (const bf16*)(p.ws + WS_F13) + (size_t)fi * 2 * DFF * D, MROWS, 2 * DFF, D, D}; pg8::StaticOrder S; S.init(MROWS, 2 * DFF, G, (int)blockIdx.x);
                pg8::EpiSwiGLU E{(bf16*)(p.ws + WS_ACT), DFF, nullptr, 0}; pg8::gemm_phase<pg8::EpiSwiGLU, pg8::StaticOrder, true, true>(lds, g, S, E); }
            SEAM();
            REP(16) if (RUN()) {
                { pg8::Gemm g{(const bf16*)(p.ws + WS_ACT), (const bf16*)(p.ws + WS_F2) + (size_t)fi * D * DFF, NLAT, D, DFF, DFF}; pg8::StaticOrder S; S.init(NLAT, D, G, (int)blockIdx.x);
                  pg8::EpiBf16<0> E{(bf16*)(p.ws + WS_F), D, nullptr, 0, 0, 1.f}; pg8::gemm_phase<pg8::EpiBf16<0>, pg8::StaticOrder, true, true>(lds, g, S, E); }
                { pg8::Gemm g{(const bf16*)(p.ws + WS_ACT), (const bf16*)(p.ws + WS_F2) + (size_t)fi * D * DFF, NCTX, D, DFF / 7, DFF}; pg8::SplitOrder S{NCTX / 256, D / 256, 7, G, (int)blockIdx.x, NLAT / 256, 0, 0, 0, 0, 0, 0, 0, 0};
                  pg8::EpiPart E{(float*)(p.ws + WS_FP), D, (size_t)NCTX * D, NLAT / 256}; pg8::gemm_phase<pg8::EpiPart, pg8::SplitOrder, true, true>(lds, g, S, E); }
            }
            SEAM();
        } else {
            REP(4) if (RUN()) { FRESH(); ph_convert_moe(p, lds, l >> 1, gw, NGW, wave, lane); }
            SEAM();
            if (RUN()) { FRESH(); ph_moe_gather(p, l, gw, NGW, lane); }
            SEAM();
            {   const unsigned* gcnt = (const unsigned*)(p.ws + WS_CTL) + CW_GCNT + 64 * (l >> 1); int pbp[9]; pbp[0] = 0;
#pragma unroll
                for (int e = 0; e < 8; ++e) pbp[e + 1] = pbp[e] + (int)((gcnt[e] + 255u) >> 8);
                const int mrows = pbp[8] * 256;
                REP(16) if (RUN()) { pg8::Gemm g{(const bf16*)(p.ws + WS_HG), (const bf16*)(p.ws + WS_MOEW13), mrows, 2 * DFF, D, D}; pg8::MoeOrder S; S.init(mrows, 2 * DFF, G, (int)blockIdx.x);
                    S.pb1 = pbp[1]; S.pb2 = pbp[2]; S.pb3 = pbp[3]; S.pb4 = pbp[4]; S.pb5 = pbp[5]; S.pb6 = pbp[6]; S.pb7 = pbp[7]; S.estride = (size_t)2 * DFF * D;
                    pg8::EpiSwiGLU E{(bf16*)(p.ws + WS_ACT), DFF, (const float*)(p.ws + WS_WSORT), 1}; pg8::gemm_phase<pg8::EpiSwiGLU, pg8::MoeOrder, true, true>(lds, g, S, E); }
                SEAM();
                REP(16) if (RUN()) {
                    { pg8::Gemm g{(const bf16*)(p.ws + WS_ACT), (const bf16*)(p.ws + WS_MOEW2), MOE_MAIN_PANELS * 256, D, DFF, DFF}; pg8::MoeOrder S; S.init(MOE_MAIN_PANELS * 256, D, G, (int)blockIdx.x);
                      S.pb1 = pbp[1]; S.pb2 = pbp[2]; S.pb3 = pbp[3]; S.pb4 = pbp[4]; S.pb5 = pbp[5]; S.pb6 = pbp[6]; S.pb7 = pbp[7]; S.estride = (size_t)D * DFF;
                      pg8::EpiBf16<0> E{(bf16*)(p.ws + WS_F), D, nullptr, 0, 0, 1.f}; pg8::gemm_phase<pg8::EpiBf16<0>, pg8::MoeOrder, true, true>(lds, g, S, E); }
                    { const int nT = pbp[8] - MOE_MAIN_PANELS;
                      pg8::Gemm g{(const bf16*)(p.ws + WS_ACT), (const bf16*)(p.ws + WS_MOEW2), nT * 256, D, DFF / 4, DFF}; pg8::SplitOrder S{nT, D / 256, 4, G, (int)blockIdx.x, MOE_MAIN_PANELS, pbp[1], pbp[2], pbp[3], pbp[4], pbp[5], pbp[6], pbp[7], (size_t)D * DFF};
                      pg8::EpiPart E{(float*)(p.ws + WS_FP), D, (size_t)MOE_TAIL_ROWS * D, MOE_MAIN_PANELS}; pg8::gemm_phase<pg8::EpiPart, pg8::SplitOrder, true, true>(lds, g, S, E); }
                }
                SEAM();
            }
        }
        if (RUN()) { FRESH(); ph_ln(p, lds, l, 1, tid, wave, gw, NGW, lane); }
        SEAM();
    }
#undef RUN
#undef SEAM
}

#ifndef MK_PER_PHASE
#define MK_PER_PHASE 0
#endif
extern "C" void kernel_launch(void* const* d_in, const int* in_sizes, int n_in, void* d_out, int out_size, void* d_ws, size_t ws_size, hipStream_t stream) {
    static int grid = 0;
    if (grid == 0) {
        if (n_in != N_IN || in_sizes[0] != NLAT * D || out_size != NLAT * D || ws_size < WS_NEED) { fprintf(stderr, "kernel_launch: unexpected shapes / workspace (%d inputs, ws %zu, need %zu)\n", n_in, ws_size, (size_t)WS_NEED); grid = -1; return; }
        int dev = 0, cus = 0, per_cu = 0;
        if (hipGetDevice(&dev) != hipSuccess || hipDeviceGetAttribute(&cus, hipDeviceAttributeMultiprocessorCount, dev) != hipSuccess) { grid = -1; return; }
        if (hipFuncSetAttribute((const void*)fwd_kernel, hipFuncAttributeMaxDynamicSharedMemorySize, LDS_BYTES) != hipSuccess) { fprintf(stderr, "kernel_launch: hipFuncSetAttribute failed\n"); grid = -1; return; }
        if (hipOccupancyMaxActiveBlocksPerMultiprocessor(&per_cu, (const void*)fwd_kernel, NWAVES * 64, LDS_BYTES) != hipSuccess || per_cu < 1) fprintf(stderr, "kernel_launch: occupancy query says %d\n", per_cu);
        (void)hipGetLastError();
        grid = cus;
    }
    if (grid < 0) return;
    if (hipMemsetAsync((char*)d_ws + WS_CTL, 0, CTL_BYTES, stream) != hipSuccess) return;
    KP p{};
    for (int i = 0; i < N_IN; ++i) p.in[i] = (const float*)d_in[i];
    p.out = (float*)d_out; p.ws = (unsigned char*)d_ws; p.pad = 0;
#if MK_PER_PHASE
    const int nph = 2 + 2 * 11 + 2 * 13;
    for (int ph = 0; ph < nph; ++ph) { p.ph = ph; hipLaunchKernelGGL(fwd_kernel, dim3(grid), dim3(NWAVES * 64), LDS_BYTES, stream, p); }
#else
    p.ph = -1;
    hipLaunchKernelGGL(fwd_kernel, dim3(grid), dim3(NWAVES * 64), LDS_BYTES, stream, p);
#endif
}
```

```cpp
#include <hip/hip_runtime.h>
#define PROBE_DUP 0
#define CQ_SLOT_WGS 0
#include <cstdio>
#include <cstdint>
namespace pg8 {
#define PG8_LAS __attribute__((address_space(3)))
typedef unsigned short bf16_t;
typedef short bf16x8 __attribute__((ext_vector_type(8)));
typedef float f32x4 __attribute__((ext_vector_type(4)));
typedef unsigned u32x4 __attribute__((ext_vector_type(4)));
constexpr int BM = 256, BK = 64, HALF = 128, HTB = HALF * BK * 2  , STAGE_BYTES = 8 * HTB, NXCD = 8, WGM = 8;

__host__ __device__ __forceinline__ int lds_byte(int r, int c) { const int st = (r >> 4) * 2 + (c >> 5), rr = r & 15, cc = c & 31, ob = rr * 64 + cc * 2; return st * 1024 + (ob ^ (((ob >> 9) & 1) << 5)); }
__host__ __device__ __forceinline__ void stage_rc(int b, int& R, int& C) { const int st = b / 1024, sb = b % 1024, swz = sb ^ (((sb >> 9) & 1) << 5); R = (st >> 1) * 16 + swz / 64; C = (st & 1) * 32 + (swz % 64) / 2; }
__host__ __device__ __forceinline__ int perm32(int rho) { const int n = rho >> 4, i = rho & 15; return 8 * (i >> 2) + 4 * n + (i & 3); }

struct Unit { int pm, pn, ks; };
struct Gemm { const bf16_t* A; const bf16_t* Bt; int M, N, K, ld; };

struct StaticOrder {
    int nM, nN, nwg, G, c;
    __host__ __device__ void init(int M, int N, int G_, int c_) { nM = M / BM; nN = N / BM; nwg = nM * nN; G = G_; c = c_; }
    __host__ __device__ bool next(int i, Unit& u) const {
        const long L = (long)i * G + c; if (L >= nwg) return false;
        int wgid = (int)L; { const int q = nwg / NXCD, r = nwg % NXCD, xcd = wgid % NXCD, off = wgid / NXCD; wgid = (xcd < r ? xcd * (q + 1) : r * (q + 1) + (xcd - r) * q) + off; }
        const int nig = WGM * nN, gid = wgid / nig, fm = gid * WGM, gsz = (nM - fm) < WGM ? (nM - fm) : WGM;
        u.pm = fm + ((wgid % nig) % gsz); u.pn = (wgid % nig) / gsz; u.ks = 0; return true;
    }
    __device__ __forceinline__ const char* abase(const Gemm& g, const Unit& u, size_t tstep) const { return (const char*)g.A + (size_t)u.pm * tstep; }
    __device__ __forceinline__ const char* bbase(const Gemm& g, const Unit& u, size_t tstep) const { return (const char*)g.Bt + (size_t)u.pn * tstep; }
    __device__ __forceinline__ void a_ready(const Unit&) const {}
    __device__ __forceinline__ void done(const Unit&) const {}
};

__device__ __forceinline__ unsigned cvt_pk_bf16(float lo, float hi) { unsigned r; asm volatile("v_cvt_pk_bf16_f32 %0, %1, %2" : "=v"(r) : "v"(lo), "v"(hi)); return r; }
typedef float f32x2 __attribute__((ext_vector_type(2)));
__device__ __forceinline__ f32x2 gelu_pk(f32x2 v) {
    const f32x2 av = __builtin_elementwise_abs(v), d = av * 0.2316418882f + 1.0f;
    f32x2 t; t.x = __builtin_amdgcn_rcpf(d.x); t.y = __builtin_amdgcn_rcpf(d.y);
    f32x2 q = t * 0.5307027145f + (-0.7265760135f); q = q * t + 0.7107068705f; q = q * t + (-0.142248368f); q = q * t + 0.127414796f; q = q * t;
    const f32x2 s = (v * v) * (-0.72134752044f);
    f32x2 e; e.x = __builtin_amdgcn_exp2f(s.x); e.y = __builtin_amdgcn_exp2f(s.y);
    const f32x2 m = v * (q * e), r = v - m;
    f32x2 o; o.x = v.x < 0.f ? m.x : r.x; o.y = v.y < 0.f ? m.y : r.y; return o;
}

template <int ACT  > struct EpiBf16 {
    static constexpr bool PERM = true, AFTER_DRAIN = false; static_assert(ACT == 0 || ACT == 1, "EpiBf16: ACT is 0 (none) or 1 (gelu_pk)");
    bf16_t* O; int ldc; const float* bias; int split_cols; size_t split_stride; float scale0;
    __device__ __forceinline__ void operator()(const f32x4 (&acc)[2][2][4][2], const Unit& u, int wr, int wc, int fr, int fq) const {
        const int row0 = u.pm * BM + wr * 64 + fr; int colt = u.pn * BM; bf16_t* base = O;
        float sc = 1.f; if (split_cols) { const int t = colt / split_cols; base += (size_t)t * split_stride; colt -= t * split_cols; if (t == 0) sc = scale0; }
        const int col0 = colt + wc * 32 + 8 * fq, bcol0 = u.pn * BM + wc * 32 + 8 * fq;
        f32x4 bv[2][2];
#pragma unroll
        for (int bj = 0; bj < 2; ++bj)
#pragma unroll
            for (int n = 0; n < 2; ++n) bv[bj][n] = bias ? *(const f32x4*)(bias + bcol0 + bj * HALF + 4 * n) : (f32x4){0.f, 0.f, 0.f, 0.f};
#pragma unroll
        for (int ai = 0; ai < 2; ++ai)
#pragma unroll
            for (int m = 0; m < 4; ++m) { bf16_t* rowp = base + (size_t)(row0 + ai * HALF + m * 16) * ldc + col0;
#pragma unroll
                for (int bj = 0; bj < 2; ++bj) { f32x4 v0 = acc[ai][bj][m][0] + bv[bj][0], v1 = acc[ai][bj][m][1] + bv[bj][1];
                    if (ACT == 1) { f32x2 a = gelu_pk((f32x2){v0[0], v0[1]}), b = gelu_pk((f32x2){v0[2], v0[3]}), c = gelu_pk((f32x2){v1[0], v1[1]}), d = gelu_pk((f32x2){v1[2], v1[3]});
                        v0 = (f32x4){a.x, a.y, b.x, b.y}; v1 = (f32x4){c.x, c.y, d.x, d.y}; }
                    v0 = v0 * sc; v1 = v1 * sc; u32x4 w; w.x = cvt_pk_bf16(v0[0], v0[1]); w.y = cvt_pk_bf16(v0[2], v0[3]); w.z = cvt_pk_bf16(v1[0], v1[1]); w.w = cvt_pk_bf16(v1[2], v1[3]);
                    *(u32x4*)(rowp + bj * HALF) = w; } }
    }
};
struct EpiF32 {
    static constexpr bool PERM = false, AFTER_DRAIN = false;
    float* C; int ldc; int accum;
    __device__ __forceinline__ void operator()(const f32x4 (&acc)[2][2][4][2], const Unit& u, int wr, int wc, int fr, int fq) const {
        const int row0 = u.pm * BM + wr * 64 + fr, col0 = u.pn * BM + wc * 32 + 4 * fq;
#pragma unroll
        for (int ai = 0; ai < 2; ++ai)
#pragma unroll
            for (int m = 0; m < 4; ++m) { float* rowp = C + (size_t)(row0 + ai * HALF + m * 16) * ldc + col0;
#pragma unroll
                for (int bj = 0; bj < 2; ++bj)
#pragma unroll
                    for (int n = 0; n < 2; ++n) { f32x4 v = acc[ai][bj][m][n]; if (accum) v += *(const f32x4*)(rowp + bj * HALF + n * 16); *(f32x4*)(rowp + bj * HALF + n * 16) = v; } }
    }
};
struct EpiSwiGLU {
    static constexpr bool PERM = true, AFTER_DRAIN = false;
    bf16_t* O; int ldo; const float* rowscale; int rs_stride;
    __device__ __forceinline__ void operator()(const f32x4 (&acc)[2][2][4][2], const Unit& u, int wr, int wc, int fr, int fq) const {
        typedef unsigned u32x2v __attribute__((ext_vector_type(2)));
        const int row0 = u.pm * BM + wr * 64 + fr; const int ch0 = (u.pn * BM + wc * 32 + 8 * fq) >> 1;
#pragma unroll
        for (int ai = 0; ai < 2; ++ai)
#pragma unroll
            for (int m = 0; m < 4; ++m) { const int row = row0 + ai * HALF + m * 16; bf16_t* rowp = O + (size_t)row * ldo + ch0;
                const float rs = rowscale ? rowscale[(size_t)row * rs_stride] : 1.f;
#pragma unroll
                for (int bj = 0; bj < 2; ++bj) { const f32x4 a = acc[ai][bj][m][0], b = acc[ai][bj][m][1]; f32x4 o;
#pragma unroll
                    for (int i = 0; i < 4; ++i) o[i] = a[i] * __builtin_amdgcn_rcpf(1.f + __expf(-a[i])) * b[i] * rs;
                    u32x2v w; w.x = cvt_pk_bf16(o[0], o[1]); w.y = cvt_pk_bf16(o[2], o[3]);
                    *(u32x2v*)(rowp + bj * (HALF / 2)) = w; } }
    }
};

struct MoeOrder : StaticOrder {
    int pb1, pb2, pb3, pb4, pb5, pb6, pb7; size_t estride;
    __device__ __forceinline__ const char* bbase(const Gemm& g, const Unit& u, size_t tstep) const {
        const int e = (u.pm >= pb1) + (u.pm >= pb2) + (u.pm >= pb3) + (u.pm >= pb4) + (u.pm >= pb5) + (u.pm >= pb6) + (u.pm >= pb7);
        return (const char*)(g.Bt + (size_t)e * estride) + (size_t)u.pn * tstep; }
};
struct SplitOrder {
    int nM, nN, S, G, c, pm0; int pb1, pb2, pb3, pb4, pb5, pb6, pb7; size_t estride;
    __device__ __forceinline__ bool next(int i, Unit& u) const { const int L = i * G + c; if (L >= nM * nN * S) return false; u.ks = L % S; const int t = L / S; u.pn = t % nN; u.pm = pm0 + t / nN; return true; }
    __device__ __forceinline__ const char* abase(const Gemm& g, const Unit& u, size_t tstep) const { return (const char*)g.A + (size_t)u.pm * tstep + (size_t)u.ks * g.K * 2; }
    __device__ __forceinline__ const char* bbase(const Gemm& g, const Unit& u, size_t tstep) const {
        const int e = estride ? (u.pm >= pb1) + (u.pm >= pb2) + (u.pm >= pb3) + (u.pm >= pb4) + (u.pm >= pb5) + (u.pm >= pb6) + (u.pm >= pb7) : 0;
        return (const char*)(g.Bt + (size_t)e * estride) + (size_t)u.pn * tstep + (size_t)u.ks * g.K * 2; }
    __device__ __forceinline__ void a_ready(const Unit&) const {}
    __device__ __forceinline__ void done(const Unit&) const {}
};
struct EpiPart {
    static constexpr bool PERM = false, AFTER_DRAIN = false;
    float* C; int ldc; size_t pstride; int pm0;
    __device__ __forceinline__ void operator()(const f32x4 (&acc)[2][2][4][2], const Unit& u, int wr, int wc, int fr, int fq) const {
        const int row0 = (u.pm - pm0) * BM + wr * 64 + fr, col0 = u.pn * BM + wc * 32 + 4 * fq; float* base = C + (size_t)u.ks * pstride;
#pragma unroll
        for (int ai = 0; ai < 2; ++ai)
#pragma unroll
            for (int m = 0; m < 4; ++m) { float* rowp = base + (size_t)(row0 + ai * HALF + m * 16) * ldc + col0;
#pragma unroll
                for (int bj = 0; bj < 2; ++bj)
#pragma unroll
                    for (int n = 0; n < 2; ++n) *(f32x4*)(rowp + bj * HALF + n * 16) = acc[ai][bj][m][n]; }
    }
};
template <class Epi, class Sched, bool ALIGN_EPI = false, bool SP2 = false>
__device__ __forceinline__ void gemm_phase(PG8_LAS unsigned char* lds, const Gemm g, const Sched& S, const Epi& E) {
    int tid_o = threadIdx.x; asm volatile("" : "+v"(tid_o));
    const int tid = tid_o, wid = __builtin_amdgcn_readfirstlane(tid >> 6), lane = tid & 63, wr = wid >> 2, wc = wid & 3, fr = lane & 15, fq = lane >> 4;
    const int K = g.K, nt = K / BK;
    unsigned voffA[2], voffB[2];
#pragma unroll
    for (int i = 0; i < 2; ++i) { int R, C; stage_rc(tid * 16 + i * 8192, R, C); const int Rb = Epi::PERM ? ((R & ~31) + perm32(R & 31)) : R;
        voffA[i] = (unsigned)(R * g.ld + C) * 2u; voffB[i] = (unsigned)(Rb * g.ld + C) * 2u; }
    const size_t kstep = (size_t)(BK * 2);
    const size_t hstep = (size_t)HALF * g.ld * 2;
    const size_t tstep = 2 * hstep;
    const unsigned ldsw = (unsigned)wid * 1024u;
    const int aoff = lds_byte(wr * 64 + fr, fq * 8), boff = lds_byte(wc * 32 + fr, fq * 8);
#define PG8_SA(b, h) (((b) * 2 + (h)) * HTB)
#define PG8_SB(b, h) ((4 + (b) * 2 + (h)) * HTB)
#define PG8_STAGE(bufoff, gbase, voff) do { _Pragma("unroll") for (int _i = 0; _i < 2; ++_i) \
        __builtin_amdgcn_global_load_lds((const unsigned*)((const char*)(gbase) + (voff)[_i]), (PG8_LAS unsigned*)(lds + (bufoff) + ldsw + _i * 8192), 16, 0, 0); } while (0)
#define PG8_LDA(dst, b, h) do { _Pragma("unroll") for (int m = 0; m < 4; ++m) _Pragma("unroll") for (int k = 0; k < 2; ++k) dst[m][k] = *(const PG8_LAS bf16x8*)(lds + PG8_SA(b, h) + aoff + m * 2048 + k * 1024); } while (0)
#define PG8_LDB(dst, b, h) do { _Pragma("unroll") for (int n = 0; n < 2; ++n) _Pragma("unroll") for (int k = 0; k < 2; ++k) dst[n][k] = *(const PG8_LAS bf16x8*)(lds + PG8_SB(b, h) + boff + n * 2048 + k * 1024); } while (0)
#define PG8_MMA(ai, bj, At, Bt) do { __builtin_amdgcn_s_setprio(1); _Pragma("unroll") for (int m = 0; m < 4; ++m) _Pragma("unroll") for (int n = 0; n < 2; ++n) _Pragma("unroll") for (int k = 0; k < 2; ++k) \
        acc[ai][bj][m][n] = __builtin_amdgcn_mfma_f32_16x16x32_bf16(Bt[n][k], At[m][k], acc[ai][bj][m][n], 0, 0, 0); __builtin_amdgcn_s_setprio(0); } while (0)
#define PG8_WAIT_V(n) asm volatile("s_waitcnt vmcnt(" #n ")" ::: "memory")
#define PG8_WAIT_L(n) asm volatile("s_waitcnt lgkmcnt(" #n ")" ::: "memory")
#define PG8_BAR __builtin_amdgcn_s_barrier()
#define PG8_SCHED __builtin_amdgcn_sched_barrier(0)
    Unit cur, nxt; int ui = 0;
    if (!S.next(0, cur)) return;
    f32x4 acc[2][2][4][2];
#pragma unroll
    for (int a = 0; a < 2; ++a)
#pragma unroll
        for (int b = 0; b < 2; ++b)
#pragma unroll
            for (int m = 0; m < 4; ++m)
#pragma unroll
                for (int n = 0; n < 2; ++n) acc[a][b][m][n] = (f32x4){0.f, 0.f, 0.f, 0.f};
    bf16x8 At[4][2], B0[2][2], B1[2][2];
    const char* cA = S.abase(g, cur, tstep); const char* cB = S.bbase(g, cur, tstep);
    S.a_ready(cur);
    if constexpr (SP2) {
        PG8_STAGE(PG8_SB(0, 0), cB, voffB); PG8_STAGE(PG8_SB(0, 1), cB + hstep, voffB); PG8_STAGE(PG8_SA(0, 0), cA, voffA); PG8_STAGE(PG8_SA(0, 1), cA + hstep, voffA);
        if (wr == 1) PG8_BAR;
        PG8_WAIT_V(2); PG8_BAR;
        PG8_STAGE(PG8_SB(1, 0), cB + kstep, voffB); PG8_STAGE(PG8_SA(1, 0), cA + kstep, voffA); PG8_STAGE(PG8_SB(1, 1), cB + hstep + kstep, voffB);
        PG8_WAIT_V(6); PG8_BAR;
    } else {
        PG8_STAGE(PG8_SB(0, 0), cB, voffB); PG8_STAGE(PG8_SA(0, 0), cA, voffA); PG8_STAGE(PG8_SB(0, 1), cB + hstep, voffB); PG8_STAGE(PG8_SA(0, 1), cA + hstep, voffA);
        if (wr == 1) PG8_BAR;
        PG8_WAIT_V(4); PG8_BAR;
        PG8_STAGE(PG8_SB(1, 0), cB + kstep, voffB); PG8_STAGE(PG8_SA(1, 0), cA + kstep, voffA); PG8_STAGE(PG8_SB(1, 1), cB + hstep + kstep, voffB);
        PG8_WAIT_V(6); PG8_BAR;
    }
    for (;;) {
        const bool has_next = S.next(ui + 1, nxt);
        const char* nA = has_next ? S.abase(g, nxt, tstep) : cA; const char* nB = has_next ? S.bbase(g, nxt, tstep) : cB;
        for (int t = 0; t < nt; t += 2) {
            const bool last = (t == nt - 2);
            const char* a1 = cA + (size_t)(t + 1) * kstep;
            const char* a2 = last ? nA : cA + (size_t)(t + 2) * kstep; const char* b2 = last ? nB : cB + (size_t)(t + 2) * kstep;
            const char* a3 = a2 + kstep; const char* b3 = b2 + kstep;
            if (last && has_next) S.a_ready(nxt);
            if constexpr (SP2) {
            PG8_LDB(B0, 0, 0); PG8_LDB(B1, 0, 1); PG8_SCHED; PG8_LDA(At, 0, 0); PG8_STAGE(PG8_SA(1, 1), a1 + hstep, voffA);
            PG8_WAIT_V(8); PG8_WAIT_L(0); PG8_BAR; PG8_MMA(0, 0, At, B0); PG8_MMA(0, 1, At, B1); PG8_BAR; PG8_SCHED;
            PG8_LDA(At, 0, 1); PG8_STAGE(PG8_SB(0, 0), b2, voffB); PG8_STAGE(PG8_SB(0, 1), b2 + hstep, voffB); PG8_STAGE(PG8_SA(0, 0), a2, voffA);
            PG8_WAIT_V(8); PG8_WAIT_L(0); PG8_BAR; PG8_MMA(1, 0, At, B0); PG8_MMA(1, 1, At, B1); PG8_BAR; PG8_SCHED;
            PG8_LDB(B0, 1, 0); PG8_LDB(B1, 1, 1); PG8_SCHED; PG8_LDA(At, 1, 0); PG8_STAGE(PG8_SA(0, 1), a2 + hstep, voffA);
            PG8_WAIT_V(8); PG8_WAIT_L(0); PG8_BAR; PG8_MMA(0, 0, At, B0); PG8_MMA(0, 1, At, B1); PG8_BAR; PG8_SCHED;
            PG8_LDA(At, 1, 1); PG8_STAGE(PG8_SB(1, 0), b3, voffB); PG8_STAGE(PG8_SB(1, 1), b3 + hstep, voffB); PG8_STAGE(PG8_SA(1, 0), a3, voffA);
            PG8_WAIT_V(8); PG8_WAIT_L(0); PG8_BAR; PG8_MMA(1, 0, At, B0); PG8_MMA(1, 1, At, B1); PG8_BAR; PG8_SCHED;
            } else {
            PG8_LDB(B0, 0, 0); PG8_SCHED; PG8_LDA(At, 0, 0); PG8_STAGE(PG8_SA(1, 1), a1 + hstep, voffA);
            PG8_WAIT_L(8); PG8_BAR; PG8_WAIT_L(0); PG8_MMA(0, 0, At, B0); PG8_BAR; PG8_SCHED;
            PG8_LDB(B1, 0, 1); PG8_STAGE(PG8_SB(0, 0), b2, voffB);
            PG8_BAR; PG8_WAIT_L(0); PG8_MMA(0, 1, At, B1); PG8_BAR;
            PG8_LDA(At, 0, 1); PG8_STAGE(PG8_SA(0, 0), a2, voffA);
            PG8_BAR; PG8_WAIT_L(0); PG8_MMA(1, 0, At, B0); PG8_BAR; PG8_SCHED;
            PG8_STAGE(PG8_SB(0, 1), b2 + hstep, voffB);
            PG8_WAIT_V(6); PG8_BAR; PG8_MMA(1, 1, At, B1); PG8_BAR;
            PG8_LDB(B0, 1, 0); PG8_SCHED; PG8_LDA(At, 1, 0); PG8_STAGE(PG8_SA(0, 1), a2 + hstep, voffA);
            PG8_WAIT_L(8); PG8_BAR; PG8_WAIT_L(0); PG8_MMA(0, 0, At, B0); PG8_BAR; PG8_SCHED;
            PG8_LDB(B1, 1, 1); PG8_STAGE(PG8_SB(1, 0), b3, voffB);
            PG8_BAR; PG8_WAIT_L(0); PG8_MMA(0, 1, At, B1); PG8_BAR;
            PG8_LDA(At, 1, 1); PG8_STAGE(PG8_SA(1, 0), a3, voffA);
            PG8_BAR; PG8_WAIT_L(0); PG8_MMA(1, 0, At, B0); PG8_BAR; PG8_SCHED;
            PG8_STAGE(PG8_SB(1, 1), b3 + hstep, voffB);
            PG8_WAIT_V(6); PG8_BAR; PG8_MMA(1, 1, At, B1); PG8_BAR;
            }
        }
        if constexpr (ALIGN_EPI) { if (wr == 0) PG8_BAR; }
        if constexpr (!Epi::AFTER_DRAIN) { E(acc, cur, wr, wc, fr, fq); S.done(cur); }
        if (!has_next) break;
#pragma unroll
        for (int a = 0; a < 2; ++a)
#pragma unroll
            for (int b = 0; b < 2; ++b)
#pragma unroll
                for (int m = 0; m < 4; ++m)
#pragma unroll
                    for (int n = 0; n < 2; ++n) acc[a][b][m][n] = (f32x4){0.f, 0.f, 0.f, 0.f};
        cur = nxt; cA = nA; cB = nB; ++ui;
        if constexpr (ALIGN_EPI) { if (wr == 1) PG8_BAR; }
    }
    PG8_WAIT_V(0);
    if constexpr (!ALIGN_EPI) { if (wr == 0) PG8_BAR; }
    PG8_BAR;
    if constexpr (Epi::AFTER_DRAIN) { E.fused(acc, cur, wr, wc, fr, fq, lds, wid, lane); S.done(cur); }
#undef PG8_SA
#undef PG8_SB
#undef PG8_STAGE
#undef PG8_LDA
#undef PG8_LDB
#undef PG8_MMA
#undef PG8_WAIT_V
#undef PG8_WAIT_L
#undef PG8_BAR
#undef PG8_SCHED
}
}

constexpr int NWAVES = 8;
constexpr int D = 1024, NB = 4, SEQ = 4096, CTXL = 256, NLAT = NB * SEQ, NCTX = NB * CTXL, MROWS = NLAT + NCTX;
constexpr int DEPTH = 4, RW = 512, NH = 8, HS = 64, DFF = 3584, NE = 8, NPROJ = 3456, NP = 3584, NLO = 2560, KLA = 512, NMOD = 6144;
constexpr int PC_R = 0, PC_K = 512, PC_V = 1024, PC_CB = 1536, PC_CC = 2048, PC_CH = 2560, PC_WD = 3072, PC_AD = 3200, PC_GD = 3328;
constexpr float LN_EPS = 1e-5f, GN_EPS = 64e-5f, DN_ALPHA = 1.681792830507429f;
enum { I_X = 0, I_C, I_CTX, I_CCTX, I_WMOD, I_BMOD, I_WIN, I_W0, I_W2, I_A0, I_A2, I_KK, I_KA, I_RK, I_G2, I_LNXG, I_LNXB, I_CONVW, I_WOUT, I_LN1G, I_LN1B, I_LN2G, I_LN2B,
       I_FW1, I_FW3, I_FW2, I_RTW, I_RTB, I_MW1, I_MW3, I_MW2, N_IN };

constexpr size_t MiB = 1u << 20;
constexpr size_t WS_CTL = 0, CTL_BYTES = 1 * MiB;
constexpr size_t WS_MODV = 1 * MiB;
constexpr size_t WS_G8 = 2 * MiB;
constexpr size_t WS_RKS = 3 * MiB;
constexpr size_t WS_WIN = 4 * MiB;
constexpr size_t WS_WOUT = WS_WIN + 28 * MiB;
constexpr size_t WS_LORA = WS_WOUT + 8 * MiB;
constexpr size_t WS_F13 = WS_LORA + 10 * MiB;
constexpr size_t WS_F2 = WS_F13 + 28 * MiB;
constexpr size_t WS_X = WS_F2 + 14 * MiB;
constexpr size_t WS_H = WS_X + 68 * MiB;
constexpr size_t WS_MOES = WS_H + 34 * MiB;
constexpr size_t WS_ROWLIST = WS_MOES;
constexpr size_t WS_TOKSEL = WS_MOES + 640 * 1024;
constexpr size_t WS_WSEL = WS_TOKSEL + 320 * 1024;
constexpr size_t WS_WSORT = WS_WSEL + 192 * 1024;
constexpr size_t WS_MOEW13 = WS_MOES + 2 * MiB;
constexpr size_t WS_MOEW2 = WS_MOEW13 + 112 * MiB;
constexpr size_t WS_SCR = WS_MOEW2 + 56 * MiB;
constexpr size_t WS_P = WS_SCR;
constexpr size_t WS_LO = WS_P + 119 * MiB;
constexpr size_t WS_PREP = WS_LO + 170 * MiB;
constexpr size_t WS_Y = WS_PREP + 213 * MiB;
constexpr size_t WS_MIXIN = WS_Y + 68 * MiB;
constexpr size_t WS_CH = WS_PREP;
constexpr size_t WS_MIXO = WS_PREP;
constexpr size_t WS_MIXP = WS_PREP + 34 * MiB;
constexpr size_t WS_END_MIXER = WS_MIXIN + 34 * MiB;
constexpr size_t WS_HG = WS_SCR;
constexpr size_t WS_ACT = WS_HG + 72 * MiB;
constexpr size_t WS_F = WS_ACT + 252 * MiB;
constexpr size_t WS_FP = WS_F + 72 * MiB;
constexpr size_t WS_END_FFN = WS_FP + 64 * MiB;
constexpr size_t WS_NEED = WS_END_MIXER > WS_END_FFN ? WS_END_MIXER : WS_END_FFN;
static_assert((size_t)MROWS * NP * 2 <= 119 * MiB && (size_t)MROWS * NLO * 4 <= 170 * MiB && (size_t)8704 * 25600 <= 213 * MiB && (size_t)MROWS * D * 4 <= 68 * MiB && WS_NEED <= 990 * MiB, "ws map");
constexpr int MOE_MAIN_PANELS = 128, MOE_TAIL_ROWS = 4096;
constexpr int MOE_ROWS = 36864;
constexpr int LORAW_PER_LAYER = 4 * 512 * 64 + 512 * 128;
constexpr int CW_BAR = 4096, CW_GCNT = 8192, CW_CQ = 12288, CW_SDONE = 12544;

constexpr int RING_BYTES = 131072, LDSCTL_OFF = RING_BYTES, MISC_OFF = LDSCTL_OFF + 320, LDS_BYTES = 147456;

typedef unsigned short bf16;
typedef unsigned v4u __attribute__((ext_vector_type(4)));
typedef unsigned v2u __attribute__((ext_vector_type(2)));
typedef float f32x4 __attribute__((ext_vector_type(4)));
#define LAS __attribute__((address_space(3)))
#define LDS_WAIT() asm volatile("s_waitcnt lgkmcnt(0)" ::: "memory")
__device__ __forceinline__ unsigned f2bf(float f) { unsigned u = __builtin_bit_cast(unsigned, f); return (u + 0x7fffu + ((u >> 16) & 1u)) >> 16; }
__device__ __forceinline__ unsigned pk2(float lo, float hi) { return f2bf(lo) | (f2bf(hi) << 16); }
__device__ __forceinline__ float bf2f(unsigned short b) { return __builtin_bit_cast(float, ((unsigned)b) << 16); }
__device__ __forceinline__ float bflo(unsigned w) { return __builtin_bit_cast(float, w << 16); }
__device__ __forceinline__ float bfhi(unsigned w) { return __builtin_bit_cast(float, w & 0xffff0000u); }
__device__ __forceinline__ float wave_sum(float v) {
#pragma unroll
    for (int o = 1; o < 64; o <<= 1) v += __shfl_xor(v, o);
    return v;
}
__device__ __forceinline__ float sigm(float x) { return 1.f / (1.f + __expf(-x)); }

#define XB_TMO      128
#define XB_XCNT(j)  (256  + 64 * (j))
#define XB_XSUB(j)  (1280 + 64 * (j))
#define XB_XGEN(j)  (2304 + 64 * (j))
#define XB_TOP      3328
#define XB_TOPGEN   3392
#define XCD_BAR_WORDS 3456
#define XB_SPIN_CAP (1u << 18)

__device__ __forceinline__ unsigned xb_ld(unsigned* p)              { return __hip_atomic_load(p, __ATOMIC_RELAXED, __HIP_MEMORY_SCOPE_AGENT); }
__device__ __forceinline__ unsigned xb_add(unsigned* p, unsigned v) { return __hip_atomic_fetch_add(p, v, __ATOMIC_RELAXED, __HIP_MEMORY_SCOPE_AGENT); }
__device__ __forceinline__ unsigned xb_xcc_id() { return (unsigned)__builtin_amdgcn_s_getreg((3 << 11) | 20) & 0xFu; }
#define XB_SPIN(cond, bar) do { unsigned _sp = 0; while (cond) { __builtin_amdgcn_s_sleep(1); \
    if ((++_sp & 255u) == 0u) { if (xb_ld(&(bar)[XB_TMO])) break; if (_sp > XB_SPIN_CAP) { atomicAdd(&(bar)[XB_TMO], 1u); break; } } } } while (0)

struct XcdBarrier {
    unsigned* bar; unsigned x;
    volatile LAS unsigned* st;
};

__device__ __forceinline__ XcdBarrier xcd_barrier_post(unsigned* bar, volatile LAS unsigned* st) {
    XcdBarrier b; b.bar = bar; b.x = xb_xcc_id(); b.st = st;
    if (threadIdx.x == 0) (void)xb_add(&bar[XB_XCNT(b.x)], 1u);
    return b;
}
__device__ __forceinline__ void xcd_barrier_complete(unsigned* bar, unsigned x, unsigned& nloc, unsigned& nx) {
    const unsigned G = gridDim.x * gridDim.y * gridDim.z;
    unsigned sum, cnt, mine, sp = 0u;
    for (;;) {
        sum = 0u; cnt = 0u; mine = 0u;
#pragma unroll
        for (unsigned j = 0; j < 16; ++j) { const unsigned c = xb_ld(&bar[XB_XCNT(j)]); sum += c; cnt += (c > 0u) ? 1u : 0u; mine = (j == x) ? c : mine; }
        if (sum == G) break;
        __builtin_amdgcn_s_sleep(1);
        if ((++sp & 255u) == 0u) { if (xb_ld(&bar[XB_TMO])) break; if (sp > XB_SPIN_CAP) { atomicAdd(&bar[XB_TMO], 1u); break; } }
    }
    nloc = mine > 0u ? mine : 1u; nx = cnt > 0u ? cnt : 1u;
}

__device__ __forceinline__ void xcd_barrier(const XcdBarrier& b) {
    asm volatile("s_waitcnt vmcnt(0)" ::: "memory");
    __syncthreads();
    if (threadIdx.x == 0) {
        unsigned* bar = b.bar;
        __builtin_amdgcn_s_waitcnt(0);
        unsigned nloc = b.st[0], nx = b.st[1];
        if (nloc == 0u) { xcd_barrier_complete(bar, b.x, nloc, nx); b.st[0] = nloc; b.st[1] = nx; }
        const unsigned old = xb_add(&bar[XB_XSUB(b.x)], 1u);
        const unsigned gen = old / nloc;
        if (old + 1u == (gen + 1u) * nloc) {
            __builtin_amdgcn_fence(__ATOMIC_RELEASE, "agent");
            asm volatile("s_waitcnt vmcnt(0)" ::: "memory");
            const unsigned og = xb_add(&bar[XB_TOP], 1u);
            const unsigned tg = og / nx;
            if (og + 1u == (tg + 1u) * nx) xb_add(&bar[XB_TOPGEN], 1u);
            else XB_SPIN(xb_ld(&bar[XB_TOPGEN]) == tg, bar);
            __builtin_amdgcn_fence(__ATOMIC_ACQUIRE, "agent");
            xb_add(&bar[XB_XGEN(b.x)], 1u);
            asm volatile("s_waitcnt vmcnt(0)" ::: "memory");
        } else {
            XB_SPIN(xb_ld(&bar[XB_XGEN(b.x)]) == gen, bar);
            __builtin_amdgcn_fence(__ATOMIC_ACQUIRE, "agent");
            asm volatile("s_waitcnt vmcnt(0)" ::: "memory");
        }
    }
    __syncthreads();
}


struct KP { const float* in[N_IN]; float* out; unsigned char* ws; int ph; int pad; };

template <int MODE> __device__ __forceinline__ int rowmap(int n, int arg) {
    if (MODE == 0) return n + arg;
    if (MODE == 1) { if (n < 1536) return n; if (n < 1664) return n - 1536 + PC_WD; if (n < 1792) return n - 1664 + PC_AD; if (n < 1920) return n - 1792 + PC_GD;
                     if (n < 2432) return n - 1920 + PC_CB; if (n < 2944) return n - 2432 + PC_CC; return n - 2944 + PC_CH; }
    return 8 * (n >> 2) + 4 * arg + (n & 3);
}
template <int MODE> __device__ __forceinline__ void transpose_item(const float* W, int K, int N, bf16* WT, int arg, LAS float* scr, int item, int lane) {
    const int nblk = N / 32, kb = item / nblk, nb = item % nblk, k0 = 64 * kb, n0 = 32 * nb;
#pragma unroll 8
    for (int i = 0; i < 32; ++i) { const int kk = 2 * i + (lane >> 5); scr[kk * 33 + (lane & 31)] = W[(size_t)(k0 + kk) * N + n0 + (lane & 31)]; }
    LDS_WAIT(); asm volatile("" ::: "memory");
    const int c = lane & 7;
#pragma unroll
    for (int j = 0; j < 4; ++j) { const int n = (lane >> 3) + 8 * j; const LAS float* s = scr + (8 * c) * 33 + n;
        v4u o; o.x = pk2(s[0 * 33], s[1 * 33]); o.y = pk2(s[2 * 33], s[3 * 33]); o.z = pk2(s[4 * 33], s[5 * 33]); o.w = pk2(s[6 * 33], s[7 * 33]);
        *(v4u*)(WT + (size_t)rowmap<MODE>(n0 + n, arg) * K + k0 + 8 * c) = o; }
    LDS_WAIT(); asm volatile("" ::: "memory");
}

__device__ __forceinline__ void ph_modvec(const KP& p, LAS unsigned char* lds, int tid) {
    LAS float* sil = (LAS float*)lds;
    LAS float* red = (LAS float*)(lds + 5 * 1024 * 4);
    const float* c = p.in[I_C]; const float* cc = p.in[I_CCTX];
    for (int i = tid; i < 5 * 1024; i += 512) { const float v = i < 4096 ? c[i] : cc[i - 4096]; sil[i] = v / (1.f + __expf(-v)); }
    __syncthreads();
    float* modv = (float*)(p.ws + WS_MODV);
    const int ks = tid >> 6, col = tid & 63;
    for (int task = blockIdx.x; task < DEPTH * 96; task += gridDim.x) {
        const int l = task / 96, j0 = (task % 96) * 64;
        const float* w = p.in[I_WMOD] + (size_t)l * D * NMOD + (size_t)(ks * 128) * NMOD + j0 + col;
        float a0 = 0.f, a1 = 0.f, a2 = 0.f, a3 = 0.f, a4 = 0.f;
#pragma unroll 8
        for (int k = 0; k < 128; ++k) { const float wv = w[(size_t)k * NMOD]; const int kk = ks * 128 + k;
            a0 += sil[kk] * wv; a1 += sil[1024 + kk] * wv; a2 += sil[2048 + kk] * wv; a3 += sil[3072 + kk] * wv; a4 += sil[4096 + kk] * wv; }
        red[(ks * 5 + 0) * 64 + col] = a0; red[(ks * 5 + 1) * 64 + col] = a1; red[(ks * 5 + 2) * 64 + col] = a2; red[(ks * 5 + 3) * 64 + col] = a3; red[(ks * 5 + 4) * 64 + col] = a4;
        __syncthreads();
        if (tid < 320) { const int r = tid >> 6; float s = 0.f;
#pragma unroll
            for (int q = 0; q < 8; ++q) s += red[(q * 5 + r) * 64 + col];
            modv[(size_t)(l * 5 + r) * NMOD + j0 + col] = s + p.in[I_BMOD][l * NMOD + j0 + col]; }
        __syncthreads();
    }
}

__device__ __forceinline__ void ph_convert(const KP& p, LAS unsigned char* lds, int gw, int NGW, int wave, int lane) {
    LAS float* scr = (LAS float*)(lds + wave * 16384);
    bf16* win = (bf16*)(p.ws + WS_WIN); bf16* wout = (bf16*)(p.ws + WS_WOUT); bf16* f13 = (bf16*)(p.ws + WS_F13); bf16* f2 = (bf16*)(p.ws + WS_F2); bf16* lora = (bf16*)(p.ws + WS_LORA);
    constexpr int I_IN = (D / 64) * (NPROJ / 32), I_OUT = (D / 64) * (D / 32), I_UP = (D / 64) * (DFF / 32), I_DN = (DFF / 64) * (D / 32);
    constexpr int NITEMS = I_IN + I_OUT + 2 * I_UP + I_DN;
    for (int it = gw; it < NITEMS; it += NGW) {
        int r = it;
        if (r < I_IN) { transpose_item<1>(p.in[I_WIN], D, NPROJ, win, 0, scr, r, lane); continue; } r -= I_IN;
        if (r < I_OUT) { transpose_item<0>(p.in[I_WOUT], D, D, wout, 0, scr, r, lane); continue; } r -= I_OUT;
        if (r < I_UP) { transpose_item<2>(p.in[I_FW1], D, DFF, f13, 0, scr, r, lane); continue; } r -= I_UP;
        if (r < I_UP) { transpose_item<2>(p.in[I_FW3], D, DFF, f13, 1, scr, r, lane); continue; } r -= I_UP;
        transpose_item<0>(p.in[I_FW2], DFF, D, f2, 0, scr, r, lane);
    }
    { const int gt = gw * 64 + lane, NGT = NGW * 64; constexpr int PER = (NP - NPROJ) * D / 8;
      for (int i = gt; i < DEPTH * PER; i += NGT) { const int l = i / PER, q = i % PER; *(v4u*)(win + (size_t)l * NP * D + (size_t)NPROJ * D + (size_t)q * 8) = (v4u){0u, 0u, 0u, 0u}; } }
    { const int gt = gw * 64 + lane, NGT = NGW * 64;
      for (int i = gt; i < DEPTH * LORAW_PER_LAYER / 8; i += NGT) { const int l = i / (LORAW_PER_LAYER / 8); int q = (i % (LORAW_PER_LAYER / 8)) * 8; float v[8];
          int grp, c, k0; if (q < 4 * 512 * 64) { grp = q / (512 * 64); q -= grp * 512 * 64; c = q / 64; k0 = q % 64; } else { grp = 4; q -= 4 * 512 * 64; c = q / 128; k0 = q % 128; }
#pragma unroll
          for (int j = 0; j < 8; ++j) { const int k = k0 + j;
              v[j] = grp < 2 ? p.in[I_W2][((size_t)(l * 2 + grp) * 64 + k) * RW + c] : grp < 4 ? p.in[I_A2][((size_t)(l * 2 + grp - 2) * 64 + k) * RW + c] : p.in[I_G2][((size_t)l * 128 + k) * RW + c]; }
          v4u o; o.x = pk2(v[0], v[1]); o.y = pk2(v[2], v[3]); o.z = pk2(v[4], v[5]); o.w = pk2(v[6], v[7]);
          *(v4u*)(lora + (size_t)i * 8) = o; } }
}
constexpr int CQ_IN = (D / 64) * (NPROJ / 32), CQ_OUT = (D / 64) * (D / 32), CQ_UP = (D / 64) * (DFF / 32), CQ_DN = (DFF / 64) * (D / 32);
constexpr int CQ_J1 = 3 * CQ_IN + 3 * CQ_OUT + 2 * CQ_UP + CQ_DN, CQ_MOE = NE * (2 * CQ_UP + CQ_DN), CQ_END0 = CQ_J1 + CQ_MOE, CQ_END1 = CQ_END0 + CQ_MOE;
struct CqItem { const float* W; bf16* WT; int K, N, mode, arg, item; };
__device__ __forceinline__ CqItem cq_decode(const KP& p, int q) {
    CqItem c; bf16* win = (bf16*)(p.ws + WS_WIN); bf16* wout = (bf16*)(p.ws + WS_WOUT); bf16* f13 = (bf16*)(p.ws + WS_F13); bf16* f2 = (bf16*)(p.ws + WS_F2);
    bf16* m13 = (bf16*)(p.ws + WS_MOEW13); bf16* m2 = (bf16*)(p.ws + WS_MOEW2);
    if (q < 3 * CQ_IN) { const int l = 1 + q / CQ_IN; c = CqItem{p.in[I_WIN] + (size_t)l * D * NPROJ, win + (size_t)l * NP * D, D, NPROJ, 1, 0, q % CQ_IN}; return c; } q -= 3 * CQ_IN;
    if (q < 3 * CQ_OUT) { const int l = 1 + q / CQ_OUT; c = CqItem{p.in[I_WOUT] + (size_t)l * D * D, wout + (size_t)l * D * D, D, D, 0, 0, q % CQ_OUT}; return c; } q -= 3 * CQ_OUT;
    if (q < CQ_UP) { c = CqItem{p.in[I_FW1] + (size_t)D * DFF, f13 + (size_t)2 * DFF * D, D, DFF, 2, 0, q}; return c; } q -= CQ_UP;
    if (q < CQ_UP) { c = CqItem{p.in[I_FW3] + (size_t)D * DFF, f13 + (size_t)2 * DFF * D, D, DFF, 2, 1, q}; return c; } q -= CQ_UP;
    if (q < CQ_DN) { c = CqItem{p.in[I_FW2] + (size_t)DFF * D, f2 + (size_t)D * DFF, DFF, D, 0, 0, q}; return c; } q -= CQ_DN;
    const int mi = q / CQ_MOE; q -= mi * CQ_MOE;
    if (q < NE * CQ_UP) { const int e = q / CQ_UP; c = CqItem{p.in[I_MW1] + ((size_t)mi * NE + e) * D * DFF, m13 + (size_t)e * 2 * DFF * D, D, DFF, 2, 0, q % CQ_UP}; return c; } q -= NE * CQ_UP;
    if (q < NE * CQ_UP) { const int e = q / CQ_UP; c = CqItem{p.in[I_MW3] + ((size_t)mi * NE + e) * D * DFF, m13 + (size_t)e * 2 * DFF * D, D, DFF, 2, 1, q % CQ_UP}; return c; } q -= NE * CQ_UP;
    { const int e = q / CQ_DN; c = CqItem{p.in[I_MW2] + ((size_t)mi * NE + e) * DFF * D, m2 + (size_t)e * D * DFF, DFF, D, 0, 0, q % CQ_DN}; return c; }
}
__device__ __forceinline__ void cq_load(const CqItem& c, int lane, float (&r)[32]) {
    const int nblk = c.N / 32, kb = c.item / nblk, nb = c.item % nblk; const float* src = c.W + (size_t)(64 * kb + (lane >> 5)) * c.N + 32 * nb + (lane & 31);
#pragma unroll
    for (int i = 0; i < 32; ++i) r[i] = src[(size_t)(2 * i) * c.N];
}
__device__ __forceinline__ void cq_store(const CqItem& c, int lane, const float (&r)[32], LAS float* scr) {
    const int nblk = c.N / 32, kb = c.item / nblk, nb = c.item % nblk, k0 = 64 * kb, n0 = 32 * nb;
#pragma unroll
    for (int i = 0; i < 32; ++i) scr[(2 * i + (lane >> 5)) * 33 + (lane & 31)] = r[i];
    LDS_WAIT(); asm volatile("" ::: "memory");
    const int cc = lane & 7;
#pragma unroll
    for (int j = 0; j < 4; ++j) { const int n = (lane >> 3) + 8 * j; const LAS float* sp = scr + (8 * cc) * 33 + n;
        v4u o; o.x = pk2(sp[0 * 33], sp[1 * 33]); o.y = pk2(sp[2 * 33], sp[3 * 33]); o.z = pk2(sp[4 * 33], sp[5 * 33]); o.w = pk2(sp[6 * 33], sp[7 * 33]);
        const int nn = n0 + n; const int row = c.mode == 0 ? nn : c.mode == 1 ? rowmap<1>(nn, 0) : 8 * (nn >> 2) + 4 * c.arg + (nn & 3);
        *(v4u*)(c.WT + (size_t)row * c.K + k0 + 8 * cc) = o; }
    LDS_WAIT(); asm volatile("" ::: "memory");
}
constexpr int CQ_B = 4;
__device__ __forceinline__ int cq_grab(unsigned* heads, int nseg, int& cnt, int lane) {
    int q = -1, n = 0;
    if (lane == 0) { for (int sg = 0; sg < nseg && q < 0; ++sg) { const int size = sg == 0 ? CQ_J1 : CQ_MOE, base = sg == 0 ? 0 : sg == 1 ? CQ_J1 : CQ_END0; unsigned* hd = heads + 64 * sg;
            if ((int)__hip_atomic_load(hd, __ATOMIC_RELAXED, __HIP_MEMORY_SCOPE_AGENT) < size) { const int t = (int)__hip_atomic_fetch_add(hd, (unsigned)CQ_B, __ATOMIC_RELAXED, __HIP_MEMORY_SCOPE_AGENT);
                if (t < size) { q = base + t; n = size - t < CQ_B ? size - t : CQ_B; } } } }
    cnt = __builtin_amdgcn_readfirstlane(n); return __builtin_amdgcn_readfirstlane(q);
}
__device__ __forceinline__ void cq_run(const KP& p, LAS unsigned char* lds, int nseg, const unsigned* stop, unsigned stopval, int wave, int lane) {
    unsigned* heads = (unsigned*)(p.ws + WS_CTL) + CW_CQ; LAS float* scr = (LAS float*)(lds + wave * 16384);
    for (;;) {
        if (stop) { unsigned sv = 0u; if (lane == 0) sv = __hip_atomic_load(stop, __ATOMIC_RELAXED, __HIP_MEMORY_SCOPE_AGENT); if ((unsigned)__builtin_amdgcn_readfirstlane((int)sv) >= stopval) break; }
        int cnt; const int q0 = cq_grab(heads, nseg, cnt, lane); if (q0 < 0) break;
        CqItem cur = cq_decode(p, q0); float ra[32]; cq_load(cur, lane, ra);
        for (int j = 0; j < cnt; ++j) { CqItem nxt = cur; float rb[32];
            if (j + 1 < cnt) { nxt = cq_decode(p, q0 + j + 1); cq_load(nxt, lane, rb); }
            cq_store(cur, lane, ra, scr);
            if (j + 1 < cnt) { cur = nxt;
#pragma unroll
                for (int i = 0; i < 32; ++i) ra[i] = rb[i]; } }
    }
}

__device__ __forceinline__ void cq_static(const KP& p, LAS unsigned char* lds, int q0, int q1, int gw, int NGW, int wave, int lane) {
    LAS float* scr = (LAS float*)(lds + wave * 16384);
    int q = q0 + gw; if (q >= q1) return;
    CqItem cur = cq_decode(p, q); float ra[32]; cq_load(cur, lane, ra);
    for (;;) { const int qn = q + NGW; CqItem nxt = cur; float rb[32];
        if (qn < q1) { nxt = cq_decode(p, qn); cq_load(nxt, lane, rb); }
        cq_store(cur, lane, ra, scr);
        if (qn >= q1) break;
        cur = nxt; q = qn;
#pragma unroll
        for (int i = 0; i < 32; ++i) ra[i] = rb[i]; }
}

__device__ __forceinline__ void ld_row(const float* r, int lane, f32x4 (&v)[4]) { const f32x4* q = (const f32x4*)r + lane;
#pragma unroll
    for (int j = 0; j < 4; ++j) v[j] = q[64 * j]; }
__device__ __forceinline__ void st_row(float* r, int lane, const f32x4 (&v)[4]) { f32x4* q = (f32x4*)r + lane;
#pragma unroll
    for (int j = 0; j < 4; ++j) q[64 * j] = v[j]; }
__device__ __forceinline__ void st_row_bf16(bf16* r, int lane, const f32x4 (&v)[4]) { v2u* q = (v2u*)r + lane;
#pragma unroll
    for (int j = 0; j < 4; ++j) { v2u w; w.x = pk2(v[j][0], v[j][1]); w.y = pk2(v[j][2], v[j][3]); q[64 * j] = w; } }
__device__ __forceinline__ void ld_row_bf16(const bf16* r, int lane, f32x4 (&v)[4]) { const v2u* q = (const v2u*)r + lane;
#pragma unroll
    for (int j = 0; j < 4; ++j) { const v2u w = q[64 * j]; v[j] = (f32x4){bflo(w.x), bfhi(w.x), bflo(w.y), bfhi(w.y)}; } }
template <int S> __device__ __forceinline__ void ld_row_parts(const float* r, size_t pstride, int lane, f32x4 (&v)[4]) {
    ld_row(r, lane, v);
#pragma unroll
    for (int s = 1; s < S; ++s) { f32x4 t[4]; ld_row(r + (size_t)s * pstride, lane, t);
#pragma unroll
        for (int j = 0; j < 4; ++j) v[j] += t[j]; } }
__device__ __forceinline__ int mod_row(int row) { return row < NLAT ? (row >> 12) : 4; }

__device__ __forceinline__ void ph_init_rows(const KP& p, int gw, int NGW, int lane) {
    const float* modv = (const float*)(p.ws + WS_MODV); float* X = (float*)(p.ws + WS_X); bf16* H = (bf16*)(p.ws + WS_H);
    for (int row = gw; row < MROWS; row += NGW) {
        const float* src = row < NLAT ? p.in[I_X] + (size_t)row * D : p.in[I_CTX] + (size_t)(row - NLAT) * D;
        const float* mv = modv + (size_t)(0 * 5 + mod_row(row)) * NMOD;
        f32x4 x[4], sh[4], sc[4], h[4]; ld_row(src, lane, x); ld_row(mv, lane, sh); ld_row(mv + 1024, lane, sc);
#pragma unroll
        for (int j = 0; j < 4; ++j) h[j] = x[j] * (1.f + sc[j]) + sh[j];
        st_row(X + (size_t)row * D, lane, x); st_row_bf16(H + (size_t)row * D, lane, h);
    }
}

__device__ __forceinline__ int scan_row(int b, int dir, int step) { return step < CTXL ? NLAT + b * CTXL + (dir ? CTXL - 1 - step : step) : b * SEQ + (dir ? SEQ - 1 - (step - CTXL) : step - CTXL); }
typedef short sbf16x8 __attribute__((ext_vector_type(8)));
typedef float f32x16 __attribute__((ext_vector_type(16)));
constexpr int SC_C = 32, SC_NCH = (CTXL + SEQ) / SC_C  , SC_NCHAIN = NB * NH * 2  , SC_NTASK = SC_NCH * SC_NCHAIN  ;
constexpr int CH_G = 0, CH_Q = 8192, CH_UT = 12288, CH_YL = 20480, CH_EC = 24576, CH_BYTES = 25600, CH_NLOAD = 26;

__device__ __forceinline__ f32x16 mm(v4u a, v4u b, f32x16 c) { return __builtin_amdgcn_mfma_f32_32x32x16_bf16(__builtin_bit_cast(sbf16x8, a), __builtin_bit_cast(sbf16x8, b), c, 0, 0, 0); }
typedef float f32x2c __attribute__((ext_vector_type(2))); typedef __bf16 bf16x2c __attribute__((ext_vector_type(2)));
__device__ __forceinline__ unsigned cvtpk(float lo, float hi) { return __builtin_bit_cast(unsigned, __builtin_convertvector((f32x2c){lo, hi}, bf16x2c)); }
template <int S, int NEG> __device__ __forceinline__ v4u cvtf(const f32x16& x) {
    v4u w; const float sg = NEG ? -1.f : 1.f;
    w.x = cvtpk(sg * x[8 * S + 0], sg * x[8 * S + 1]); w.y = cvtpk(sg * x[8 * S + 2], sg * x[8 * S + 3]); w.z = cvtpk(sg * x[8 * S + 4], sg * x[8 * S + 5]); w.w = cvtpk(sg * x[8 * S + 6], sg * x[8 * S + 7]); return w; }
template <int MODE  > __device__ __forceinline__ f32x16 mask_acc(f32x16 x, int n, int hh) {
#pragma unroll
    for (int r = 0; r < 16; ++r) { const int m = (r & 3) + 8 * (r >> 2) + 4 * hh; const bool keep = MODE == 0 ? (m > n) : MODE == 1 ? (m < n) : (m <= n); x[r] = keep ? x[r] : 0.f; }
    return x; }
__device__ __forceinline__ f32x16 zero16() { f32x16 z;
#pragma unroll
    for (int r = 0; r < 16; ++r) z[r] = 0.f;
    return z; }
__device__ __forceinline__ void cm_build(const unsigned (&w)[16], v4u (&f)[2][2]) {
#pragma unroll
    for (int s = 0; s < 2; ++s) {
        const auto r0 = __builtin_amdgcn_permlane32_swap(w[8 * s + 0], w[8 * s + 2], false, false), r1 = __builtin_amdgcn_permlane32_swap(w[8 * s + 1], w[8 * s + 3], false, false);
        const auto r2 = __builtin_amdgcn_permlane32_swap(w[8 * s + 4], w[8 * s + 6], false, false), r3 = __builtin_amdgcn_permlane32_swap(w[8 * s + 5], w[8 * s + 7], false, false);
        f[0][s] = (v4u){r0[0], r1[0], r2[0], r3[0]}; f[1][s] = (v4u){r0[1], r1[1], r2[1], r3[1]}; }
}
__device__ __forceinline__ void st16(unsigned char* base, int off, int lane, v4u v) { *(v4u*)(base + off + lane * 16) = v; }

__device__ __forceinline__ void ph_scan1(const KP& p, int l, int gw, int NGW, int lane) {
    const bf16* P = (const bf16*)(p.ws + WS_P); const float* LO = (const float*)(p.ws + WS_LO); const float* NRM = (const float*)(p.ws + WS_RKS); unsigned char* CH = p.ws + WS_CH;
    const int n = lane & 31, hh = lane >> 5;
    v4u Id[2];
#pragma unroll
    for (int s = 0; s < 2; ++s) { unsigned wd[4];
#pragma unroll
        for (int q = 0; q < 4; ++q) { const int j0 = 2 * q, j1 = 2 * q + 1; const int t0 = 16 * s + 8 * (j0 >> 2) + 4 * hh + (j0 & 3), t1 = 16 * s + 8 * (j1 >> 2) + 4 * hh + (j1 & 3);
            wd[q] = (t0 == n ? 0x3F80u : 0u) | (t1 == n ? 0x3F800000u : 0u); }
        Id[s] = (v4u){wd[0], wd[1], wd[2], wd[3]}; }
    for (int task = gw; task < SC_NTASK; task += NGW) {
        const int dir = task & 1, h = (task >> 1) & 7, b = (task >> 4) & 3, ci = task >> 6;
        const int row0 = scan_row(b, dir, SC_C * ci), sgn = dir ? -1 : 1, c = h * 64 + lane;
        const float w0c = p.in[I_W0][(l * 2 + dir) * RW + c], a0c = p.in[I_A0][(l * 2 + dir) * RW + c], kkc = p.in[I_KK][l * RW + c], kac = p.in[I_KA][l * RW + c];
        unsigned wAl[16], wBe[16], wKa[16], wRh[16], wV[16], wBp[16], wKp[16];
        float cs = 0.f, Eprev = 1.f;
#pragma unroll
        for (int hb = 0; hb < 2; ++hb) {
            unsigned rk_[16], rr_[16], rv_[16]; float rw_[16], ra_[16], rn_[16];
#pragma unroll
            for (int i = 0; i < 16; ++i) { const int row = row0 + sgn * (16 * hb + i); const bf16* pr = P + (size_t)row * NP; const float* lo = LO + (size_t)row * NLO;
                rk_[i] = pr[PC_K + c]; rr_[i] = pr[PC_R + c]; rv_[i] = pr[PC_V + c]; rw_[i] = lo[dir * RW + c]; ra_[i] = lo[1024 + dir * RW + c]; rn_[i] = NRM[row * 8 + h]; }
#pragma unroll
            for (int i = 0; i < 16; ++i) asm volatile("" : "+v"(rk_[i]), "+v"(rr_[i]), "+v"(rv_[i]), "+v"(rw_[i]), "+v"(ra_[i]), "+v"(rn_[i]));
#pragma unroll
            for (int pq = 0; pq < 8; ++pq) { const int pz = 8 * hb + pq; float al[2], be[2], ka[2], rh[2], vv[2];
#pragma unroll
                for (int e = 0; e < 2; ++e) { const int i = 2 * pq + e;
                    const float kv = bf2f((unsigned short)rk_[i]), rv = bf2f((unsigned short)rr_[i]); vv[e] = bf2f((unsigned short)rv_[i]);
                    const float wl = w0c + rw_[i], aa = __builtin_amdgcn_rcpf(1.f + __expf(-(a0c + ra_[i]))), nrm = rn_[i];
                    const float lw = -0.6065306597f * __builtin_amdgcn_rcpf(1.f + __expf(-wl));
                    cs += lw; const float E = __expf(cs), Ei = __builtin_amdgcn_rcpf(E);
                    const float kkn = kv * kkc * nrm, kd = kv * (1.f + (aa - 1.f) * kac);
                    al[e] = kkn * Eprev; be[e] = kkn * aa * Ei; ka[e] = kd * Ei; rh[e] = rv * E; Eprev = E; }
                wAl[pz] = cvtpk(al[0], al[1]); wBe[pz] = cvtpk(be[0], be[1]); wKa[pz] = cvtpk(ka[0], ka[1]); wRh[pz] = cvtpk(rh[0], rh[1]); wV[pz] = cvtpk(vv[0], vv[1]); }
        }
        const float EC = Eprev;
#pragma unroll
        for (int pz = 0; pz < 16; ++pz) { wBp[pz] = cvtpk(bflo(wBe[pz]) * EC, bfhi(wBe[pz]) * EC); wKp[pz] = cvtpk(bflo(wKa[pz]) * EC, bfhi(wKa[pz]) * EC); }
        unsigned char* img = CH + (size_t)(((b * 8 + h) * 2 + dir) * SC_NCH + ci) * CH_BYTES;
        ((float*)(img + CH_EC))[lane] = EC;
        v4u cAl[2][2], cV[2][2], cBp[2][2], cKp[2][2], cRh[2][2];
        v4u tAl[4], tBe[4], tKa[4], tRh[4];
        cm_build(wAl, cAl); cm_build(wV, cV); cm_build(wBp, cBp); cm_build(wKp, cKp); cm_build(wRh, cRh);
        {   v4u cBe[2][2], cKa[2][2]; cm_build(wBe, cBe); cm_build(wKa, cKa);
#define TRANSPOSE(cZ, tZ) do { _Pragma("unroll") for (int ct = 0; ct < 2; ++ct) { f32x16 T_ = mm(cZ[ct][0], Id[0], zero16()); T_ = mm(cZ[ct][1], Id[1], T_); tZ[2 * ct] = cvtf<0, 0>(T_); tZ[2 * ct + 1] = cvtf<1, 0>(T_); } } while (0)
            TRANSPOSE(cAl, tAl); TRANSPOSE(cBe, tBe); TRANSPOSE(cKa, tKa); TRANSPOSE(cRh, tRh);
#undef TRANSPOSE
        }
#define PROD4(A, B) mm(A[3], B[3], mm(A[2], B[2], mm(A[1], B[1], mm(A[0], B[0], zero16()))))
        f32x16 XN = mask_acc<0>(PROD4(tAl, tBe), n, hh), XT = mask_acc<1>(PROD4(tBe, tAl), n, hh);
        v4u fLM[2], fGB[2], fGK[2];
        { const f32x16 t = mask_acc<1>(PROD4(tKa, tAl), n, hh); fLM[0] = cvtf<0, 0>(t); fLM[1] = cvtf<1, 0>(t); }
        { const f32x16 t = mask_acc<2>(PROD4(tBe, tRh), n, hh); fGB[0] = cvtf<0, 0>(t); fGB[1] = cvtf<1, 0>(t); }
        { const f32x16 t = mask_acc<2>(PROD4(tKa, tRh), n, hh); fGK[0] = cvtf<0, 0>(t); fGK[1] = cvtf<1, 0>(t); }
#undef PROD4
#pragma unroll
        for (int r = 0; r < 16; ++r) { XN[r] = -XN[r]; XT[r] = -XT[r]; }
        f32x16 RT = XT;
#pragma unroll
        for (int r = 0; r < 16; ++r) RT[r] += ((r & 3) + 8 * (r >> 2) + 4 * hh == n) ? 1.f : 0.f;
#pragma unroll
        for (int pw = 1; pw < 5; ++pw) {
            const v4u xn0 = cvtf<0, 0>(XN), xn1 = cvtf<1, 0>(XN), xt0 = cvtf<0, 0>(XT), xt1 = cvtf<1, 0>(XT);
            XN = mm(xt1, xn1, mm(xt0, xn0, zero16()));
            if (pw < 4) XT = mm(xn1, xt1, mm(xn0, xt0, zero16()));
            const v4u yn0 = cvtf<0, 0>(XN), yn1 = cvtf<1, 0>(XN), rt0 = cvtf<0, 0>(RT), rt1 = cvtf<1, 0>(RT);
            RT = mm(yn1, rt1, mm(yn0, rt0, RT));
        }
        const v4u fA0 = cvtf<0, 0>(RT), fA1 = cvtf<1, 0>(RT);
        f32x16 At[2], Vt[2];
#pragma unroll
        for (int t = 0; t < 2; ++t) {
            const f32x16 lmv = mm(fLM[1], cV[t][1], mm(fLM[0], cV[t][0], zero16()));
            At[t] = mm(fA1, cAl[t][1], mm(fA0, cAl[t][0], zero16()));
            Vt[t] = mm(fA1, cvtf<1, 0>(lmv), mm(fA0, cvtf<0, 0>(lmv), zero16()));
        }
#pragma unroll
        for (int kt1 = 0; kt1 < 2; ++kt1) { const v4u a0 = cvtf<0, 0>(At[kt1]), a1 = cvtf<1, 0>(At[kt1]);
#pragma unroll
            for (int kt2 = 0; kt2 < 2; ++kt2) { const f32x16 g = mm(a1, cBp[kt2][1], mm(a0, cBp[kt2][0], zero16()));
                st16(img, CH_G + ((kt2 * 2 + kt1) * 2 + 0) * 1024, lane, cvtf<0, 1>(g)); st16(img, CH_G + ((kt2 * 2 + kt1) * 2 + 1) * 1024, lane, cvtf<1, 1>(g)); } }
#pragma unroll
        for (int vt = 0; vt < 2; ++vt) { const v4u nv0 = cvtf<0, 1>(Vt[vt]), nv1 = cvtf<1, 1>(Vt[vt]);
#pragma unroll
            for (int kt = 0; kt < 2; ++kt) { f32x16 u = mm(cKp[kt][1], cV[vt][1], mm(cKp[kt][0], cV[vt][0], zero16())); u = mm(cBp[kt][1], nv1, mm(cBp[kt][0], nv0, u));
                st16(img, CH_UT + ((kt * 2 + vt) * 2 + 0) * 1024, lane, cvtf<0, 0>(u)); st16(img, CH_UT + ((kt * 2 + vt) * 2 + 1) * 1024, lane, cvtf<1, 0>(u)); }
            f32x16 y = mm(cV[vt][1], fGK[1], mm(cV[vt][0], fGK[0], zero16())); y = mm(nv1, fGB[1], mm(nv0, fGB[0], y));
            st16(img, CH_YL + (vt * 2 + 0) * 1024, lane, cvtf<0, 0>(y)); st16(img, CH_YL + (vt * 2 + 1) * 1024, lane, cvtf<1, 0>(y)); }
#pragma unroll
        for (int kt = 0; kt < 2; ++kt) { f32x16 q = mm(cRh[kt][1], Id[1], mm(cRh[kt][0], Id[0], zero16()));
            q = mm(cvtf<1, 1>(At[kt]), fGB[1], mm(cvtf<0, 1>(At[kt]), fGB[0], q));
            st16(img, CH_Q + (kt * 2 + 0) * 1024, lane, cvtf<0, 0>(q)); st16(img, CH_Q + (kt * 2 + 1) * 1024, lane, cvtf<1, 0>(q)); }
    }
}

__device__ __forceinline__ void ph_scan2(const KP& p, LAS unsigned char* lds, int l, int wave, int lane) {
    unsigned* sdone = (unsigned*)(p.ws + WS_CTL) + CW_SDONE + 64 * l;
#ifndef CQ_SLOT_WGS
#define CQ_SLOT_WGS 128
#endif
    if (blockIdx.x >= SC_NCHAIN * 2) return;
    const int chain = blockIdx.x >> 1, vt = blockIdx.x & 1, dir = chain & 1, h = (chain >> 1) & 7, b = chain >> 4;
    const int n = lane & 31, hh = lane >> 5;
    const unsigned char* CH = p.ws + WS_CH + (size_t)chain * SC_NCH * CH_BYTES; float* Y = (float*)(p.ws + WS_Y) + (size_t)dir * MROWS * RW + h * 64 + 32 * vt + 4 * hh;
    constexpr int NPIECE = 19, SLOT = NPIECE * 1024, NSLOT = 6, PD = 4, XCH = NSLOT * SLOT;
    int psrc[3], pdst[3];
#pragma unroll
    for (int j = 0; j < 3; ++j) { int f = wave + 8 * j; if (f >= NPIECE) f -= NPIECE;
        pdst[j] = f;
        psrc[j] = f < 12 ? f * 1024 : f < 16 ? CH_UT + ((((f - 12) >> 1) * 2 + vt) * 2 + ((f - 12) & 1)) * 1024 : f < 18 ? CH_YL + (vt * 2 + (f - 16)) * 1024 : CH_EC; }
    const int lane_off[3] = {pdst[0] == 18 ? (lane * 16) & 255 : lane * 16, pdst[1] == 18 ? (lane * 16) & 255 : lane * 16, pdst[2] == 18 ? (lane * 16) & 255 : lane * 16};
#define SC2_ISSUE(ci_, slot_) do { const unsigned char* im_ = CH + (size_t)(ci_) * CH_BYTES; LAS unsigned char* sl_ = lds + (slot_) * SLOT; \
        _Pragma("unroll") for (int j = 0; j < 3; ++j) __builtin_amdgcn_global_load_lds((const unsigned*)(im_ + psrc[j] + lane_off[j]), (LAS unsigned*)(sl_ + pdst[j] * 1024), 16, 0, 0); } while (0)
#define SC2_LD(slot_, piece_) (*(const LAS v4u*)(lds + (slot_) * SLOT + (piece_) * 1024 + lane * 16))
#define SC2_X(par_, k_) (*(LAS v4u*)(lds + XCH + (par_) * 4096 + (k_) * 1024 + lane * 16))
    f32x16 ST[2] = {zero16(), zero16()};
    SC2_ISSUE(0, 0); SC2_ISSUE(1, 1); SC2_ISSUE(2, 2); SC2_ISSUE(3, 3);
    for (int ci = 0; ci <= SC_NCH; ++ci) {
        const int slot = ci % NSLOT;
        asm volatile("s_waitcnt vmcnt(9)" ::: "memory");
        __builtin_amdgcn_s_barrier();
        asm volatile("" ::: "memory");
        { const int nx = ci + PD < SC_NCH ? ci + PD : SC_NCH - 1; SC2_ISSUE(nx, (ci + PD) % NSLOT); }
        if (wave == 0 && lane == 0 && ci == SC_NCH - 24) __hip_atomic_fetch_add(sdone, 1u, __ATOMIC_RELAXED, __HIP_MEMORY_SCOPE_AGENT);
        if (wave == 0 && ci < SC_NCH) {
            const v4u s00 = cvtf<0, 0>(ST[0]), s01 = cvtf<1, 0>(ST[0]), s10 = cvtf<0, 0>(ST[1]), s11 = cvtf<1, 0>(ST[1]);
            SC2_X(ci & 1, 0) = s00; SC2_X(ci & 1, 1) = s01; SC2_X(ci & 1, 2) = s10; SC2_X(ci & 1, 3) = s11;
#pragma unroll
            for (int kt2 = 0; kt2 < 2; ++kt2) { f32x16 a;
                const v4u u0 = SC2_LD(slot, 12 + kt2 * 2), u1 = SC2_LD(slot, 13 + kt2 * 2);
                a[0] = bflo(u0.x); a[1] = bfhi(u0.x); a[2] = bflo(u0.y); a[3] = bfhi(u0.y); a[4] = bflo(u0.z); a[5] = bfhi(u0.z); a[6] = bflo(u0.w); a[7] = bfhi(u0.w);
                a[8] = bflo(u1.x); a[9] = bfhi(u1.x); a[10] = bflo(u1.y); a[11] = bfhi(u1.y); a[12] = bflo(u1.z); a[13] = bfhi(u1.z); a[14] = bflo(u1.w); a[15] = bfhi(u1.w);
#pragma unroll
                for (int q = 0; q < 4; ++q) { const f32x4 ec = *(const LAS f32x4*)(lds + slot * SLOT + 18 * 1024 + (32 * kt2 + 8 * q + 4 * hh) * 4);
#pragma unroll
                    for (int e = 0; e < 4; ++e) a[4 * q + e] += ST[kt2][4 * q + e] * ec[e]; }
                a = mm(SC2_LD(slot, (kt2 * 2 + 0) * 2 + 0), s00, a); a = mm(SC2_LD(slot, (kt2 * 2 + 0) * 2 + 1), s01, a);
                a = mm(SC2_LD(slot, (kt2 * 2 + 1) * 2 + 0), s10, a); a = mm(SC2_LD(slot, (kt2 * 2 + 1) * 2 + 1), s11, a);
                ST[kt2] = a; }
        } else if (wave == 1 && ci >= 1) {
            const int cj = ci - 1, sj = cj % NSLOT, par = cj & 1; f32x16 y;
            { const v4u a = SC2_LD(sj, 16), c = SC2_LD(sj, 17);
              y[0] = bflo(a.x); y[1] = bfhi(a.x); y[2] = bflo(a.y); y[3] = bfhi(a.y); y[4] = bflo(a.z); y[5] = bfhi(a.z); y[6] = bflo(a.w); y[7] = bfhi(a.w);
              y[8] = bflo(c.x); y[9] = bfhi(c.x); y[10] = bflo(c.y); y[11] = bfhi(c.y); y[12] = bflo(c.z); y[13] = bfhi(c.z); y[14] = bflo(c.w); y[15] = bfhi(c.w); }
            y = mm(SC2_X(par, 0), SC2_LD(sj, 8), y); y = mm(SC2_X(par, 1), SC2_LD(sj, 9), y); y = mm(SC2_X(par, 2), SC2_LD(sj, 10), y); y = mm(SC2_X(par, 3), SC2_LD(sj, 11), y);
            const int row = scan_row(b, dir, SC_C * cj + n); float* yo = Y + (size_t)row * RW;
#pragma unroll
            for (int q = 0; q < 4; ++q) *(f32x4*)(yo + 8 * q) = (f32x4){y[4 * q], y[4 * q + 1], y[4 * q + 2], y[4 * q + 3]};
        }
        asm volatile("s_waitcnt lgkmcnt(0)" ::: "memory");
    }
    asm volatile("s_waitcnt vmcnt(0)" ::: "memory");
#undef SC2_ISSUE
#undef SC2_LD
#undef SC2_X
}

__device__ __forceinline__ float sum8(float v) { v += __shfl_xor(v, 1); v += __shfl_xor(v, 2); v += __shfl_xor(v, 4); return v; }
__device__ __forceinline__ void unpack8(v4u s, float (&v)[8]) { v[0] = bflo(s.x); v[1] = bfhi(s.x); v[2] = bflo(s.y); v[3] = bfhi(s.y); v[4] = bflo(s.z); v[5] = bfhi(s.z); v[6] = bflo(s.w); v[7] = bfhi(s.w); }
__device__ __forceinline__ void ld8f(const float* q, float (&v)[8]) { const f32x4 a = *(const f32x4*)q, b = *(const f32x4*)(q + 4); v[0] = a[0]; v[1] = a[1]; v[2] = a[2]; v[3] = a[3]; v[4] = b[0]; v[5] = b[1]; v[6] = b[2]; v[7] = b[3]; }
__device__ __forceinline__ v4u pack8(const float (&v)[8]) { v4u o; o.x = cvtpk(v[0], v[1]); o.y = cvtpk(v[2], v[3]); o.z = cvtpk(v[4], v[5]); o.w = cvtpk(v[6], v[7]); return o; }

__device__ __forceinline__ void ph_readout2(const KP& p, int l, int gw, int NGW, int lane) {
    const bf16* P = (const bf16*)(p.ws + WS_P); const float* LO = (const float*)(p.ws + WS_LO); const float* Y = (const float*)(p.ws + WS_Y);
    bf16* MI = (bf16*)(p.ws + WS_MIXIN); constexpr size_t PA = (size_t)MROWS * RW; const int c0 = lane * 8;
    for (int row = gw; row < MROWS; row += NGW) { const bf16* pr = P + (size_t)row * NP; const float* lo = LO + (size_t)row * NLO;
        int t, len; if (row < NLAT) { t = row & 63; len = 64; } else { t = (row - NLAT) & 255; len = 256; }
        const v4u kw = *(const v4u*)(pr + PC_K + c0), rw = *(const v4u*)(pr + PC_R + c0), vw = *(const v4u*)(pr + PC_V + c0);
        const v4u cbw = *(const v4u*)(pr + PC_CB + c0), ccw = *(const v4u*)(pr + PC_CC + c0), chw = *(const v4u*)(pr + PC_CH + c0);
        v4u ccp = (v4u){0u, 0u, 0u, 0u}, chp = ccp, ccn = ccp, chn = ccp;
        if (t > 0) { ccp = *(const v4u*)(pr - NP + PC_CC + c0); chp = *(const v4u*)(pr - NP + PC_CH + c0); }
        if (t < len - 1) { ccn = *(const v4u*)(pr + NP + PC_CC + c0); chn = *(const v4u*)(pr + NP + PC_CH + c0); }
        float yf[8], yb[8], la0[8], la1[8], g[8];
        ld8f(Y + (size_t)row * RW + c0, yf); ld8f(Y + PA + (size_t)row * RW + c0, yb); ld8f(lo + 1024 + c0, la0); ld8f(lo + 1536 + c0, la1); ld8f(lo + 2048 + c0, g);
        float a0[8], a1[8], ka[8], rkp[8], lg[8], lb[8];
        ld8f(p.in[I_A0] + (l * 2 + 0) * RW + c0, a0); ld8f(p.in[I_A0] + (l * 2 + 1) * RW + c0, a1); ld8f(p.in[I_KA] + l * RW + c0, ka); ld8f(p.in[I_RK] + l * RW + c0, rkp);
        ld8f(p.in[I_LNXG] + l * RW + c0, lg); ld8f(p.in[I_LNXB] + l * RW + c0, lb);
        float kv[8], rv[8], vv[8]; unpack8(kw, kv); unpack8(rw, rv); unpack8(vw, vv);
        float y[8], s = 0.f, rk = 0.f;
#pragma unroll
        for (int j = 0; j < 8; ++j) { y[j] = yf[j] + yb[j]; s += y[j]; const float av = sigm(a0[j] + la0[j]) + sigm(a1[j] + la1[j]); rk += rv[j] * kv[j] * (2.f + (av - 2.f) * ka[j]) * rkp[j]; }
        const float mu = sum8(s) * (1.f / 64.f); rk = sum8(rk); float q = 0.f;
#pragma unroll
        for (int j = 0; j < 8; ++j) { y[j] -= mu; q += y[j] * y[j]; }
        const float rstd = 1.f / sqrtf(sum8(q) * (1.f / 64.f) + GN_EPS);
        float o[8];
#pragma unroll
        for (int j = 0; j < 8; ++j) o[j] = (y[j] * rstd * lg[j] + lb[j] + rk * vv[j]) * g[j];
        *(v4u*)(MI + (size_t)row * D + c0) = pack8(o);
        float cb[8], cc[8], ch[8], pcc[8], pch[8], ncc[8], nch[8], w0[8], w1[8], w2[8];
        unpack8(cbw, cb); unpack8(ccw, cc); unpack8(chw, ch); unpack8(ccp, pcc); unpack8(chp, pch); unpack8(ccn, ncc); unpack8(chn, nch);
        const float* cw = p.in[I_CONVW] + (size_t)l * 3 * RW + c0; ld8f(cw, w0); ld8f(cw + RW, w1); ld8f(cw + 2 * RW, w2);
#pragma unroll
        for (int j = 0; j < 8; ++j) o[j] = cb[j] * (pcc[j] * pch[j] * w0[j] + cc[j] * ch[j] * w1[j] + ncc[j] * nch[j] * w2[j]);
        *(v4u*)(MI + (size_t)row * D + RW + c0) = pack8(o);
    }
}


template <int KS> __device__ __forceinline__ void lora_task(const bf16* pr, int col0, int fn, const bf16* wt, float* out, int ct0, int n, int hh) {
    v4u af[KS];
#pragma unroll
    for (int s = 0; s < KS; ++s) { const v4u w = *(const v4u*)(pr + col0 + 16 * s + 8 * hh); float v[8]; unpack8(w, v);
        if (fn == 0) {
#pragma unroll
            for (int j = 0; j < 8; ++j) v[j] = 1.f - 2.f * __builtin_amdgcn_rcpf(1.f + __expf(2.f * v[j])); }
        else if (fn == 2) {
#pragma unroll
            for (int j = 0; j < 8; ++j) v[j] = __builtin_amdgcn_rcpf(1.f + __expf(-v[j])); }
        af[s] = pack8(v); }
#pragma unroll 2
    for (int ct = ct0; ct < ct0 + 8; ++ct) { f32x16 acc = zero16(); const bf16* wb = wt + (size_t)(32 * ct + n) * (16 * KS) + 8 * hh;
#pragma unroll
        for (int s = 0; s < KS; ++s) acc = mm(af[s], *(const v4u*)(wb + 16 * s), acc);
#pragma unroll
        for (int r = 0; r < 16; ++r) out[(size_t)((r & 3) + 8 * (r >> 2) + 4 * hh) * NLO + 32 * ct + n] = acc[r]; }
}
__device__ __forceinline__ void ph_lora(const KP& p, int l, int gw, int NGW, int lane) {
    const bf16* P = (const bf16*)(p.ws + WS_P); float* LO = (float*)(p.ws + WS_LO); float* NRM = (float*)(p.ws + WS_RKS);
    const bf16* LW = (const bf16*)(p.ws + WS_LORA) + (size_t)l * LORAW_PER_LAYER; const int n = lane & 31, hh = lane >> 5;
    for (int task = gw; task < (MROWS / 32) * 10; task += NGW) { const int half = task & 1, grp = (task >> 1) % 5, rb = task / 10;
        const bf16* pr = P + (size_t)(rb * 32 + n) * NP; float* out = LO + (size_t)(rb * 32) * NLO + grp * 512;
        if (grp < 4) lora_task<4>(pr, grp < 2 ? PC_WD + 64 * grp : PC_AD + 64 * (grp - 2), grp < 2 ? 0 : 1, LW + (size_t)grp * 512 * 64, out, half * 8, n, hh);
        else lora_task<8>(pr, PC_GD, 2, LW + (size_t)4 * 512 * 64, out, half * 8, n, hh); }
    float kkc[8]; ld8f(p.in[I_KK] + l * RW + lane * 8, kkc);
    for (int row = gw; row < MROWS; row += NGW) { const v4u kw = *(const v4u*)(P + (size_t)row * NP + PC_K + lane * 8); float kv[8]; unpack8(kw, kv); float ss = 0.f;
#pragma unroll
        for (int j = 0; j < 8; ++j) { const float t = kv[j] * kkc[j]; ss += t * t; }
        ss = sum8(ss); if ((lane & 7) == 0) NRM[row * 8 + (lane >> 3)] = 1.f / fmaxf(sqrtf(ss), 1e-12f); }
}

__device__ __forceinline__ void ph_moe_gather(const KP& p, int l, int gw, int NGW, int lane) {
    const unsigned* gcnt = (const unsigned*)(p.ws + WS_CTL) + CW_GCNT + 64 * (l >> 1);
    int cnt[8], pb[9]; pb[0] = 0;
#pragma unroll
    for (int e = 0; e < 8; ++e) { cnt[e] = (int)gcnt[e]; pb[e + 1] = pb[e] + ((cnt[e] + 255) & ~255); }
    const unsigned* rowlist = (const unsigned*)(p.ws + WS_ROWLIST); const float* wsel = (const float*)(p.ws + WS_WSEL); float* wsort = (float*)(p.ws + WS_WSORT);
    const bf16* H = (const bf16*)(p.ws + WS_H); bf16* HG = (bf16*)(p.ws + WS_HG);
    for (int pos = gw; pos < pb[8]; pos += NGW) {
        int e = 0, base = 0, ce = cnt[0];
#pragma unroll
        for (int k = 1; k < 8; ++k) if (pos >= pb[k]) { e = k; base = pb[k]; ce = cnt[k]; }
        const int rank = pos - base; v4u a = (v4u){0u, 0u, 0u, 0u}, b = a; float w = 0.f;
        if (rank < ce) { const unsigned ent = rowlist[(size_t)e * MROWS + rank]; const v4u* src = (const v4u*)(H + (size_t)(ent >> 1) * D); a = src[lane]; b = src[64 + lane]; w = wsel[ent]; }
        v4u* dst = (v4u*)(HG + (size_t)pos * D); dst[lane] = a; dst[64 + lane] = b;
        if (lane == 0) wsort[pos] = w;
    }
}

__device__ __forceinline__ void ph_ln(const KP& p, LAS unsigned char* lds, int l, int which, int tid, int wave, int gw, int NGW, int lane) {
    const float* modv = (const float*)(p.ws + WS_MODV); float* X = (float*)(p.ws + WS_X); bf16* H = (bf16*)(p.ws + WS_H);
    const bf16* BR = (const bf16*)(p.ws + (which == 0 ? WS_MIXO : WS_F)); const float* BP = (const float*)(p.ws + (which == 0 ? WS_MIXP : WS_FP));
    const float* lg = p.in[which == 0 ? I_LN1G : I_LN2G] + l * D; const float* lb = p.in[which == 0 ? I_LN1B : I_LN2B] + l * D;
    const bool moe = (which == 0) && (l & 1); const bool last = (which == 1) && (l == DEPTH - 1); const bool moe_out = (which == 1) && (l & 1);
    LAS int* lcnt = (LAS int*)lds;
    LAS int* lsel = (LAS int*)(lds + 64);
    int nloc = 0;
    if (moe) { if (tid < 16) lcnt[tid] = 0; __syncthreads(); }
    int pbs[9]; pbs[0] = 0;
    if (moe_out) { const unsigned* gcnt = (const unsigned*)(p.ws + WS_CTL) + CW_GCNT + 64 * (l >> 1);
#pragma unroll
        for (int e = 0; e < 8; ++e) pbs[e + 1] = pbs[e] + (int)((gcnt[e] + 255u) & ~255u); }
    for (int row = gw; row < MROWS; row += NGW) {
        const int mr = mod_row(row); const float* mv = modv + (size_t)(l * 5 + mr) * NMOD;
        f32x4 x[4], br[4], gt[4], t[4]; ld_row(X + (size_t)row * D, lane, x); ld_row(mv + (which == 0 ? 2048 : 5120), lane, gt);
        if (moe_out) { const int* ts = (const int*)(p.ws + WS_TOKSEL) + row * 4; const int e0 = ts[0], r0 = ts[1], e1 = ts[2], r1 = ts[3]; int b0 = 0, b1 = 0;
#pragma unroll
            for (int k = 1; k < 8; ++k) { if (e0 >= k) b0 = pbs[k]; if (e1 >= k) b1 = pbs[k]; }
            f32x4 ba[4], bb[4]; const int q0 = b0 + r0, q1 = b1 + r1; constexpr int MM = MOE_MAIN_PANELS * 256;
            if (q0 < MM) ld_row_bf16(BR + (size_t)q0 * D, lane, ba); else ld_row_parts<4>(BP + (size_t)(q0 - MM) * D, (size_t)MOE_TAIL_ROWS * D, lane, ba);
            if (q1 < MM) ld_row_bf16(BR + (size_t)q1 * D, lane, bb); else ld_row_parts<4>(BP + (size_t)(q1 - MM) * D, (size_t)MOE_TAIL_ROWS * D, lane, bb);
#pragma unroll
            for (int j = 0; j < 4; ++j) br[j] = ba[j] + bb[j]; }
        else if (row < NLAT) ld_row_bf16(BR + (size_t)row * D, lane, br);
        else if (which == 0) ld_row_parts<4>(BP + (size_t)(row - NLAT) * D, (size_t)NCTX * D, lane, br);
        else ld_row_parts<7>(BP + (size_t)(row - NLAT) * D, (size_t)NCTX * D, lane, br);
        float s = 0.f;
#pragma unroll
        for (int j = 0; j < 4; ++j) { t[j] = DN_ALPHA * x[j] + gt[j] * br[j]; s += (t[j][0] + t[j][1]) + (t[j][2] + t[j][3]); }
        const float mean = wave_sum(s) * (1.f / D); float s2 = 0.f;
#pragma unroll
        for (int j = 0; j < 4; ++j) { t[j] = t[j] - mean; s2 += (t[j][0] * t[j][0] + t[j][1] * t[j][1]) + (t[j][2] * t[j][2] + t[j][3] * t[j][3]); }
        const float rstd = 1.f / sqrtf(wave_sum(s2) * (1.f / D) + LN_EPS);
        f32x4 g4[4], b4[4]; ld_row(lg, lane, g4); ld_row(lb, lane, b4);
#pragma unroll
        for (int j = 0; j < 4; ++j) x[j] = t[j] * rstd * g4[j] + b4[j];
        if (last) { if (row < NLAT) st_row(p.out + (size_t)row * D, lane, x); continue; }
        st_row(X + (size_t)row * D, lane, x);
        const float* mv2 = which == 0 ? mv + 3072 : modv + (size_t)((l + 1) * 5 + mr) * NMOD;
        f32x4 sh[4], sc[4], hh[4]; ld_row(mv2, lane, sh); ld_row(mv2 + 1024, lane, sc);
#pragma unroll
        for (int j = 0; j < 4; ++j) hh[j] = x[j] * (1.f + sc[j]) + sh[j];
        st_row_bf16(H + (size_t)row * D, lane, hh);
        if (moe) {
            const float* rw = p.in[I_RTW] + (size_t)(l >> 1) * D * NE; float lgt[8];
#pragma unroll
            for (int e = 0; e < 8; ++e) lgt[e] = 0.f;
#pragma unroll
            for (int j = 0; j < 4; ++j)
#pragma unroll
                for (int i = 0; i < 4; ++i) { const f32x4* wp = (const f32x4*)(rw + (size_t)(4 * lane + 256 * j + i) * NE); const f32x4 w0 = wp[0], w1 = wp[1]; const float hv = hh[j][i];
                    lgt[0] += hv * w0[0]; lgt[1] += hv * w0[1]; lgt[2] += hv * w0[2]; lgt[3] += hv * w0[3]; lgt[4] += hv * w1[0]; lgt[5] += hv * w1[1]; lgt[6] += hv * w1[2]; lgt[7] += hv * w1[3]; }
#pragma unroll
            for (int e = 0; e < 8; ++e) lgt[e] = wave_sum(lgt[e]) + p.in[I_RTB][(l >> 1) * NE + e];
            float v0 = lgt[0]; int i0 = 0;
#pragma unroll
            for (int e = 1; e < 8; ++e) if (lgt[e] > v0) { v0 = lgt[e]; i0 = e; }
            float v1 = -3.0e38f; int i1 = -1;
#pragma unroll
            for (int e = 0; e < 8; ++e) if (e != i0 && lgt[e] > v1) { v1 = lgt[e]; i1 = e; }
            const float w0 = 1.f / (1.f + expf(v1 - v0)), w1 = 1.f - w0;
            if (lane == 0) { const int lr0 = __hip_atomic_fetch_add(lcnt + i0, 1, __ATOMIC_RELAXED, __HIP_MEMORY_SCOPE_WORKGROUP), lr1 = __hip_atomic_fetch_add(lcnt + i1, 1, __ATOMIC_RELAXED, __HIP_MEMORY_SCOPE_WORKGROUP); const int li = nloc * NWAVES + wave;
                lsel[li * 8 + 0] = row; lsel[li * 8 + 1] = i0; lsel[li * 8 + 2] = lr0; lsel[li * 8 + 3] = i1; lsel[li * 8 + 4] = lr1;
                ((float*)(p.ws + WS_WSEL))[row * 2] = w0; ((float*)(p.ws + WS_WSEL))[row * 2 + 1] = w1; }
            ++nloc;
        }
    }
    if (moe) {
        __syncthreads();
        unsigned* gcnt = (unsigned*)(p.ws + WS_CTL) + CW_GCNT + 64 * (l >> 1);
        if (tid < 8) lcnt[8 + tid] = (int)__hip_atomic_fetch_add(gcnt + tid, (unsigned)lcnt[tid], __ATOMIC_RELAXED, __HIP_MEMORY_SCOPE_AGENT);
        __syncthreads();
        unsigned* rowlist = (unsigned*)(p.ws + WS_ROWLIST); int* toksel = (int*)(p.ws + WS_TOKSEL);
        if (tid < 16 * NWAVES) { const int k = tid / NWAVES, w = tid % NWAVES; if (k * NGW + (int)blockIdx.x * NWAVES + w < MROWS) { const int li = k * NWAVES + w;
            const int row = lsel[li * 8 + 0], e0 = lsel[li * 8 + 1], r0 = lcnt[8 + e0] + lsel[li * 8 + 2], e1 = lsel[li * 8 + 3], r1 = lcnt[8 + e1] + lsel[li * 8 + 4];
            rowlist[(size_t)e0 * MROWS + r0] = (unsigned)row * 2u; rowlist[(size_t)e1 * MROWS + r1] = (unsigned)row * 2u + 1u;
            toksel[row * 4 + 0] = e0; toksel[row * 4 + 1] = r0; toksel[row * 4 + 2] = e1; toksel[row * 4 + 3] = r1; } }
    }
}

__global__ void __launch_bounds__(NWAVES * 64, 2) fwd_kernel(KP p) {
    extern __shared__ __attribute__((aligned(16))) unsigned char lds_raw[];
    LAS unsigned char* lds = (LAS unsigned char*)lds_raw;
    volatile LAS unsigned* MISC = (volatile LAS unsigned*)(lds + MISC_OFF);
    const int G = gridDim.x, NGW = G * NWAVES;
    for (int u = threadIdx.x; u < (LDS_BYTES - LDSCTL_OFF) / 4; u += NWAVES * 64) ((LAS unsigned*)(lds + LDSCTL_OFF))[u] = 0u;
    __syncthreads();
    unsigned* ctl = (unsigned*)(p.ws + WS_CTL);
    const bool single = p.ph < 0;
    XcdBarrier bar; bar.bar = ctl + CW_BAR; bar.x = 0; bar.st = nullptr;
    if (single) bar = xcd_barrier_post(ctl + CW_BAR, MISC + 8);
    int phc = 0;
#ifndef PROBE_DUP
#define PROBE_DUP 0
#endif
#define REP(bit) for (int rep_ = 0; rep_ < ((PROBE_DUP & (bit)) ? 2 : 1); ++rep_)
#define RUN() (single || p.ph == phc)
#define FRESH() int tid = threadIdx.x; asm volatile("" : "+v"(tid)); const int lane = tid & 63, wave = __builtin_amdgcn_readfirstlane(tid >> 6), gw = blockIdx.x * NWAVES + wave; (void)lane; (void)gw
#define SEAM() do { if (single) { XcdBarrier b2_ = bar; asm volatile("" : "+s"(b2_.bar)); xcd_barrier(b2_); } ++phc; } while (0)

    bf16* H = (bf16*)(p.ws + WS_H); bf16* Pm = (bf16*)(p.ws + WS_P);
    REP(4) if (RUN()) { FRESH(); ph_modvec(p, lds, tid); __syncthreads(); ph_convert(p, lds, gw, NGW, wave, lane); cq_static(p, lds, 0, CQ_J1, gw, NGW, wave, lane); }
    SEAM();
    if (RUN()) { FRESH(); ph_init_rows(p, gw, NGW, lane); }
    SEAM();
    for (int l = 0; l < DEPTH; ++l) {
         if (RUN()) { pg8::Gemm g{H, (const bf16*)(p.ws + WS_WIN) + (size_t)l * NP * D, MROWS, NP, D, D}; pg8::StaticOrder S; S.init(MROWS, NP, G, (int)blockIdx.x);
            pg8::EpiBf16<0> E{Pm, NP, nullptr, 0, 0, 1.f}; pg8::gemm_phase<pg8::EpiBf16<0>, pg8::StaticOrder, true, true>(lds, g, S, E); }
        SEAM();
        REP(8) if (RUN()) { FRESH(); ph_lora(p, l, gw, NGW, lane); }
        SEAM();
        REP(1) if (RUN()) { FRESH(); ph_scan1(p, l, gw, NGW, lane); }
        SEAM();
        REP(2) if (RUN()) { FRESH(); ph_scan2(p, lds, l, wave, lane); }
        SEAM();
        REP(8) if (RUN()) { FRESH(); ph_readout2(p, l, gw, NGW, lane); }
        SEAM();
         if (RUN()) {
            { pg8::Gemm g{(const bf16*)(p.ws + WS_MIXIN), (const bf16*)(p.ws + WS_WOUT) + (size_t)l * D * D, NLAT, D, D, D}; pg8::StaticOrder S; S.init(NLAT, D, G, (int)blockIdx.x);
              pg8::EpiBf16<0> E{(bf16*)(p.ws + WS_MIXO), D, nullptr, 0, 0, 1.f}; pg8::gemm_phase<pg8::EpiBf16<0>, pg8::StaticOrder, true, true>(lds, g, S, E); }
            { pg8::Gemm g{(const bf16*)(p.ws + WS_MIXIN), (const bf16*)(p.ws + WS_WOUT) + (size_t)l * D * D, NCTX, D, D / 4, D}; pg8::SplitOrder S{NCTX / 256, D / 256, 4, G, (int)blockIdx.x, NLAT / 256, 0, 0, 0, 0, 0, 0, 0, 0};
              pg8::EpiPart E{(float*)(p.ws + WS_MIXP), D, (size_t)NCTX * D, NLAT / 256}; pg8::gemm_phase<pg8::EpiPart, pg8::SplitOrder, true, true>(lds, g, S, E); }
        }
        SEAM();
        if (RUN()) { FRESH(); ph_ln(p, lds, l, 0, tid, wave, gw, NGW, lane); }
        SEAM();
        if ((l & 1) == 0) {
            const int fi = l >> 1;
             if (RUN()) { pg8::Gemm g{H, (const bf16*)(p.ws + WS_F13) + (size_t)fi * 2 * DFF * D, MROWS, 2 * DFF, D, D}; pg8::StaticOrder S; S.init(MROWS, 2 * DFF, G, (int)blockIdx.x);
                pg8::EpiSwiGLU E{(bf16*)(p.ws + WS_ACT), DFF, nullptr, 0}; pg8::gemm_phase<pg8::EpiSwiGLU, pg8::StaticOrder, true, true>(lds, g, S, E); }
            SEAM();
             if (RUN()) {
                { pg8::Gemm g{(const bf16*)(p.ws + WS_ACT), (const bf16*)(p.ws + WS_F2) + (size_t)fi * D * DFF, NLAT, D, DFF, DFF}; pg8::StaticOrder S; S.init(NLAT, D, G, (int)blockIdx.x);
                  pg8::EpiBf16<0> E{(bf16*)(p.ws + WS_F), D, nullptr, 0, 0, 1.f}; pg8::gemm_phase<pg8::EpiBf16<0>, pg8::StaticOrder, true, true>(lds, g, S, E); }
                { pg8::Gemm g{(const bf16*)(p.ws + WS_ACT), (const bf16*)(p.ws + WS_F2) + (size_t)fi * D * DFF, NCTX, D, DFF / 7, DFF}; pg8::SplitOrder S{NCTX / 256, D / 256, 7, G, (int)blockIdx.x, NLAT / 256, 0, 0, 0, 0, 0, 0, 0, 0};
                  pg8::EpiPart E{(float*)(p.ws + WS_FP), D, (size_t)NCTX * D, NLAT / 256}; pg8::gemm_phase<pg8::EpiPart, pg8::SplitOrder, true, true>(lds, g, S, E); }
            }
            SEAM();
        } else {
            REP(4) if (RUN()) { FRESH(); cq_static(p, lds, l == 1 ? CQ_J1 : CQ_END0, l == 1 ? CQ_END0 : CQ_END1, gw, NGW, wave, lane); }
            SEAM();
            if (RUN()) { FRESH(); ph_moe_gather(p, l, gw, NGW, lane); }
            SEAM();
            {   const unsigned* gcnt = (const unsigned*)(p.ws + WS_CTL) + CW_GCNT + 64 * (l >> 1); int pbp[9]; pbp[0] = 0;
#pragma unroll
                for (int e = 0; e < 8; ++e) pbp[e + 1] = pbp[e] + (int)((gcnt[e] + 255u) >> 8);
                const int mrows = pbp[8] * 256;
                 if (RUN()) { pg8::Gemm g{(const bf16*)(p.ws + WS_HG), (const bf16*)(p.ws + WS_MOEW13), mrows, 2 * DFF, D, D}; pg8::MoeOrder S; S.init(mrows, 2 * DFF, G, (int)blockIdx.x);
                    S.pb1 = pbp[1]; S.pb2 = pbp[2]; S.pb3 = pbp[3]; S.pb4 = pbp[4]; S.pb5 = pbp[5]; S.pb6 = pbp[6]; S.pb7 = pbp[7]; S.estride = (size_t)2 * DFF * D;
                    pg8::EpiSwiGLU E{(bf16*)(p.ws + WS_ACT), DFF, (const float*)(p.ws + WS_WSORT), 1}; pg8::gemm_phase<pg8::EpiSwiGLU, pg8::MoeOrder, true, true>(lds, g, S, E); }
                SEAM();
                 if (RUN()) {
                    { pg8::Gemm g{(const bf16*)(p.ws + WS_ACT), (const bf16*)(p.ws + WS_MOEW2), MOE_MAIN_PANELS * 256, D, DFF, DFF}; pg8::MoeOrder S; S.init(MOE_MAIN_PANELS * 256, D, G, (int)blockIdx.x);
                      S.pb1 = pbp[1]; S.pb2 = pbp[2]; S.pb3 = pbp[3]; S.pb4 = pbp[4]; S.pb5 = pbp[5]; S.pb6 = pbp[6]; S.pb7 = pbp[7]; S.estride = (size_t)D * DFF;
                      pg8::EpiBf16<0> E{(bf16*)(p.ws + WS_F), D, nullptr, 0, 0, 1.f}; pg8::gemm_phase<pg8::EpiBf16<0>, pg8::MoeOrder, true, true>(lds, g, S, E); }
                    { const int nT = pbp[8] - MOE_MAIN_PANELS;
                      pg8::Gemm g{(const bf16*)(p.ws + WS_ACT), (const bf16*)(p.ws + WS_MOEW2), nT * 256, D, DFF / 4, DFF}; pg8::SplitOrder S{nT, D / 256, 4, G, (int)blockIdx.x, MOE_MAIN_PANELS, pbp[1], pbp[2], pbp[3], pbp[4], pbp[5], pbp[6], pbp[7], (size_t)D * DFF};
                      pg8::EpiPart E{(float*)(p.ws + WS_FP), D, (size_t)MOE_TAIL_ROWS * D, MOE_MAIN_PANELS}; pg8::gemm_phase<pg8::EpiPart, pg8::SplitOrder, true, true>(lds, g, S, E); }
                }
                SEAM();
            }
        }
        if (RUN()) { FRESH(); ph_ln(p, lds, l, 1, tid, wave, gw, NGW, lane); }
        SEAM();
    }
#undef RUN
#undef SEAM
}

#ifndef MK_PER_PHASE
#define MK_PER_PHASE 0
#endif
extern "C" void kernel_launch(void* const* d_in, const int* in_sizes, int n_in, void* d_out, int out_size, void* d_ws, size_t ws_size, hipStream_t stream) {
    static int grid = 0;
    if (grid == 0) {
        if (n_in != N_IN || in_sizes[0] != NLAT * D || out_size != NLAT * D || ws_size < WS_NEED) { fprintf(stderr, "kernel_launch: unexpected shapes / workspace (%d inputs, ws %zu, need %zu)\n", n_in, ws_size, (size_t)WS_NEED); grid = -1; return; }
        int dev = 0, cus = 0, per_cu = 0;
        if (hipGetDevice(&dev) != hipSuccess || hipDeviceGetAttribute(&cus, hipDeviceAttributeMultiprocessorCount, dev) != hipSuccess) { grid = -1; return; }
        if (hipFuncSetAttribute((const void*)fwd_kernel, hipFuncAttributeMaxDynamicSharedMemorySize, LDS_BYTES) != hipSuccess) { fprintf(stderr, "kernel_launch: hipFuncSetAttribute failed\n"); grid = -1; return; }
        if (hipOccupancyMaxActiveBlocksPerMultiprocessor(&per_cu, (const void*)fwd_kernel, NWAVES * 64, LDS_BYTES) != hipSuccess || per_cu < 1) fprintf(stderr, "kernel_launch: occupancy query says %d\n", per_cu);
        (void)hipGetLastError();
        grid = cus;
    }
    if (grid < 0) return;
    if (hipMemsetAsync((char*)d_ws + WS_CTL, 0, CTL_BYTES, stream) != hipSuccess) return;
    KP p{};
    for (int i = 0; i < N_IN; ++i) p.in[i] = (const float*)d_in[i];
    p.out = (float*)d_out; p.ws = (unsigned char*)d_ws; p.pad = 0;
#if MK_PER_PHASE
    const int nph = 2 + 2 * 11 + 2 * 13;
    for (int ph = 0; ph < nph; ++ph) { p.ph = ph; hipLaunchKernelGGL(fwd_kernel, dim3(grid), dim3(NWAVES * 64), LDS_BYTES, stream, p); }
#else
    p.ph = -1;
    hipLaunchKernelGGL(fwd_kernel, dim3(grid), dim3(NWAVES * 64), LDS_BYTES, stream, p);
#endif
}
```

```cpp
#include <hip/hip_runtime.h>
#define PROBE_DUP 0
#define CQ_SLOT_WGS 0
#define CQ_SLOT_ITEMS 3500
#include <cstdio>
#include <cstdint>
namespace pg8 {
#define PG8_LAS __attribute__((address_space(3)))
typedef unsigned short bf16_t;
typedef short bf16x8 __attribute__((ext_vector_type(8)));
typedef float f32x4 __attribute__((ext_vector_type(4)));
typedef unsigned u32x4 __attribute__((ext_vector_type(4)));
constexpr int BM = 256, BK = 64, HALF = 128, HTB = HALF * BK * 2  , STAGE_BYTES = 8 * HTB, NXCD = 8, WGM = 8;

__host__ __device__ __forceinline__ int lds_byte(int r, int c) { const int st = (r >> 4) * 2 + (c >> 5), rr = r & 15, cc = c & 31, ob = rr * 64 + cc * 2; return st * 1024 + (ob ^ (((ob >> 9) & 1) << 5)); }
__host__ __device__ __forceinline__ void stage_rc(int b, int& R, int& C) { const int st = b / 1024, sb = b % 1024, swz = sb ^ (((sb >> 9) & 1) << 5); R = (st >> 1) * 16 + swz / 64; C = (st & 1) * 32 + (swz % 64) / 2; }
__host__ __device__ __forceinline__ int perm32(int rho) { const int n = rho >> 4, i = rho & 15; return 8 * (i >> 2) + 4 * n + (i & 3); }

struct Unit { int pm, pn, ks; };
struct Gemm { const bf16_t* A; const bf16_t* Bt; int M, N, K, ld; };

struct StaticOrder {
    int nM, nN, nwg, G, c;
    __host__ __device__ void init(int M, int N, int G_, int c_) { nM = M / BM; nN = N / BM; nwg = nM * nN; G = G_; c = c_; }
    __host__ __device__ bool next(int i, Unit& u) const {
        const long L = (long)i * G + c; if (L >= nwg) return false;
        int wgid = (int)L; { const int q = nwg / NXCD, r = nwg % NXCD, xcd = wgid % NXCD, off = wgid / NXCD; wgid = (xcd < r ? xcd * (q + 1) : r * (q + 1) + (xcd - r) * q) + off; }
        const int nig = WGM * nN, gid = wgid / nig, fm = gid * WGM, gsz = (nM - fm) < WGM ? (nM - fm) : WGM;
        u.pm = fm + ((wgid % nig) % gsz); u.pn = (wgid % nig) / gsz; u.ks = 0; return true;
    }
    __device__ __forceinline__ const char* abase(const Gemm& g, const Unit& u, size_t tstep) const { return (const char*)g.A + (size_t)u.pm * tstep; }
    __device__ __forceinline__ const char* bbase(const Gemm& g, const Unit& u, size_t tstep) const { return (const char*)g.Bt + (size_t)u.pn * tstep; }
    __device__ __forceinline__ void a_ready(const Unit&) const {}
    __device__ __forceinline__ void done(const Unit&) const {}
};

__device__ __forceinline__ unsigned cvt_pk_bf16(float lo, float hi) { unsigned r; asm volatile("v_cvt_pk_bf16_f32 %0, %1, %2" : "=v"(r) : "v"(lo), "v"(hi)); return r; }
typedef float f32x2 __attribute__((ext_vector_type(2)));
__device__ __forceinline__ f32x2 gelu_pk(f32x2 v) {
    const f32x2 av = __builtin_elementwise_abs(v), d = av * 0.2316418882f + 1.0f;
    f32x2 t; t.x = __builtin_amdgcn_rcpf(d.x); t.y = __builtin_amdgcn_rcpf(d.y);
    f32x2 q = t * 0.5307027145f + (-0.7265760135f); q = q * t + 0.7107068705f; q = q * t + (-0.142248368f); q = q * t + 0.127414796f; q = q * t;
    const f32x2 s = (v * v) * (-0.72134752044f);
    f32x2 e; e.x = __builtin_amdgcn_exp2f(s.x); e.y = __builtin_amdgcn_exp2f(s.y);
    const f32x2 m = v * (q * e), r = v - m;
    f32x2 o; o.x = v.x < 0.f ? m.x : r.x; o.y = v.y < 0.f ? m.y : r.y; return o;
}

template <int ACT  > struct EpiBf16 {
    static constexpr bool PERM = true, AFTER_DRAIN = false; static_assert(ACT == 0 || ACT == 1, "EpiBf16: ACT is 0 (none) or 1 (gelu_pk)");
    bf16_t* O; int ldc; const float* bias; int split_cols; size_t split_stride; float scale0;
    __device__ __forceinline__ void operator()(const f32x4 (&acc)[2][2][4][2], const Unit& u, int wr, int wc, int fr, int fq) const {
        const int row0 = u.pm * BM + wr * 64 + fr; int colt = u.pn * BM; bf16_t* base = O;
        float sc = 1.f; if (split_cols) { const int t = colt / split_cols; base += (size_t)t * split_stride; colt -= t * split_cols; if (t == 0) sc = scale0; }
        const int col0 = colt + wc * 32 + 8 * fq, bcol0 = u.pn * BM + wc * 32 + 8 * fq;
        f32x4 bv[2][2];
#pragma unroll
        for (int bj = 0; bj < 2; ++bj)
#pragma unroll
            for (int n = 0; n < 2; ++n) bv[bj][n] = bias ? *(const f32x4*)(bias + bcol0 + bj * HALF + 4 * n) : (f32x4){0.f, 0.f, 0.f, 0.f};
#pragma unroll
        for (int ai = 0; ai < 2; ++ai)
#pragma unroll
            for (int m = 0; m < 4; ++m) { bf16_t* rowp = base + (size_t)(row0 + ai * HALF + m * 16) * ldc + col0;
#pragma unroll
                for (int bj = 0; bj < 2; ++bj) { f32x4 v0 = acc[ai][bj][m][0] + bv[bj][0], v1 = acc[ai][bj][m][1] + bv[bj][1];
                    if (ACT == 1) { f32x2 a = gelu_pk((f32x2){v0[0], v0[1]}), b = gelu_pk((f32x2){v0[2], v0[3]}), c = gelu_pk((f32x2){v1[0], v1[1]}), d = gelu_pk((f32x2){v1[2], v1[3]});
                        v0 = (f32x4){a.x, a.y, b.x, b.y}; v1 = (f32x4){c.x, c.y, d.x, d.y}; }
                    v0 = v0 * sc; v1 = v1 * sc; u32x4 w; w.x = cvt_pk_bf16(v0[0], v0[1]); w.y = cvt_pk_bf16(v0[2], v0[3]); w.z = cvt_pk_bf16(v1[0], v1[1]); w.w = cvt_pk_bf16(v1[2], v1[3]);
                    *(u32x4*)(rowp + bj * HALF) = w; } }
    }
};
struct EpiF32 {
    static constexpr bool PERM = false, AFTER_DRAIN = false;
    float* C; int ldc; int accum;
    __device__ __forceinline__ void operator()(const f32x4 (&acc)[2][2][4][2], const Unit& u, int wr, int wc, int fr, int fq) const {
        const int row0 = u.pm * BM + wr * 64 + fr, col0 = u.pn * BM + wc * 32 + 4 * fq;
#pragma unroll
        for (int ai = 0; ai < 2; ++ai)
#pragma unroll
            for (int m = 0; m < 4; ++m) { float* rowp = C + (size_t)(row0 + ai * HALF + m * 16) * ldc + col0;
#pragma unroll
                for (int bj = 0; bj < 2; ++bj)
#pragma unroll
                    for (int n = 0; n < 2; ++n) { f32x4 v = acc[ai][bj][m][n]; if (accum) v += *(const f32x4*)(rowp + bj * HALF + n * 16); *(f32x4*)(rowp + bj * HALF + n * 16) = v; } }
    }
};
struct EpiSwiGLU {
    static constexpr bool PERM = true, AFTER_DRAIN = false;
    bf16_t* O; int ldo; const float* rowscale; int rs_stride;
    __device__ __forceinline__ void operator()(const f32x4 (&acc)[2][2][4][2], const Unit& u, int wr, int wc, int fr, int fq) const {
        typedef unsigned u32x2v __attribute__((ext_vector_type(2)));
        const int row0 = u.pm * BM + wr * 64 + fr; const int ch0 = (u.pn * BM + wc * 32 + 8 * fq) >> 1;
#pragma unroll
        for (int ai = 0; ai < 2; ++ai)
#pragma unroll
            for (int m = 0; m < 4; ++m) { const int row = row0 + ai * HALF + m * 16; bf16_t* rowp = O + (size_t)row * ldo + ch0;
                const float rs = rowscale ? rowscale[(size_t)row * rs_stride] : 1.f;
#pragma unroll
                for (int bj = 0; bj < 2; ++bj) { const f32x4 a = acc[ai][bj][m][0], b = acc[ai][bj][m][1]; f32x4 o;
#pragma unroll
                    for (int i = 0; i < 4; ++i) o[i] = a[i] * __builtin_amdgcn_rcpf(1.f + __expf(-a[i])) * b[i] * rs;
                    u32x2v w; w.x = cvt_pk_bf16(o[0], o[1]); w.y = cvt_pk_bf16(o[2], o[3]);
                    *(u32x2v*)(rowp + bj * (HALF / 2)) = w; } }
    }
};

struct MoeOrder : StaticOrder {
    int pb1, pb2, pb3, pb4, pb5, pb6, pb7; size_t estride;
    __device__ __forceinline__ const char* bbase(const Gemm& g, const Unit& u, size_t tstep) const {
        const int e = (u.pm >= pb1) + (u.pm >= pb2) + (u.pm >= pb3) + (u.pm >= pb4) + (u.pm >= pb5) + (u.pm >= pb6) + (u.pm >= pb7);
        return (const char*)(g.Bt + (size_t)e * estride) + (size_t)u.pn * tstep; }
};
struct SplitOrder {
    int nM, nN, S, G, c, pm0; int pb1, pb2, pb3, pb4, pb5, pb6, pb7; size_t estride;
    __device__ __forceinline__ bool next(int i, Unit& u) const { const int L = i * G + c; if (L >= nM * nN * S) return false; u.ks = L % S; const int t = L / S; u.pn = t % nN; u.pm = pm0 + t / nN; return true; }
    __device__ __forceinline__ const char* abase(const Gemm& g, const Unit& u, size_t tstep) const { return (const char*)g.A + (size_t)u.pm * tstep + (size_t)u.ks * g.K * 2; }
    __device__ __forceinline__ const char* bbase(const Gemm& g, const Unit& u, size_t tstep) const {
        const int e = estride ? (u.pm >= pb1) + (u.pm >= pb2) + (u.pm >= pb3) + (u.pm >= pb4) + (u.pm >= pb5) + (u.pm >= pb6) + (u.pm >= pb7) : 0;
        return (const char*)(g.Bt + (size_t)e * estride) + (size_t)u.pn * tstep + (size_t)u.ks * g.K * 2; }
    __device__ __forceinline__ void a_ready(const Unit&) const {}
    __device__ __forceinline__ void done(const Unit&) const {}
};
struct EpiPart {
    static constexpr bool PERM = false, AFTER_DRAIN = false;
    float* C; int ldc; size_t pstride; int pm0;
    __device__ __forceinline__ void operator()(const f32x4 (&acc)[2][2][4][2], const Unit& u, int wr, int wc, int fr, int fq) const {
        const int row0 = (u.pm - pm0) * BM + wr * 64 + fr, col0 = u.pn * BM + wc * 32 + 4 * fq; float* base = C + (size_t)u.ks * pstride;
#pragma unroll
        for (int ai = 0; ai < 2; ++ai)
#pragma unroll
            for (int m = 0; m < 4; ++m) { float* rowp = base + (size_t)(row0 + ai * HALF + m * 16) * ldc + col0;
#pragma unroll
                for (int bj = 0; bj < 2; ++bj)
#pragma unroll
                    for (int n = 0; n < 2; ++n) *(f32x4*)(rowp + bj * HALF + n * 16) = acc[ai][bj][m][n]; }
    }
};
template <class Epi, class Sched, bool ALIGN_EPI = false, bool SP2 = false>
__device__ __forceinline__ void gemm_phase(PG8_LAS unsigned char* lds, const Gemm g, const Sched& S, const Epi& E) {
    int tid_o = threadIdx.x; asm volatile("" : "+v"(tid_o));
    const int tid = tid_o, wid = __builtin_amdgcn_readfirstlane(tid >> 6), lane = tid & 63, wr = wid >> 2, wc = wid & 3, fr = lane & 15, fq = lane >> 4;
    const int K = g.K, nt = K / BK;
    unsigned voffA[2], voffB[2];
#pragma unroll
    for (int i = 0; i < 2; ++i) { int R, C; stage_rc(tid * 16 + i * 8192, R, C); const int Rb = Epi::PERM ? ((R & ~31) + perm32(R & 31)) : R;
        voffA[i] = (unsigned)(R * g.ld + C) * 2u; voffB[i] = (unsigned)(Rb * g.ld + C) * 2u; }
    const size_t kstep = (size_t)(BK * 2);
    const size_t hstep = (size_t)HALF * g.ld * 2;
    const size_t tstep = 2 * hstep;
    const unsigned ldsw = (unsigned)wid * 1024u;
    const int aoff = lds_byte(wr * 64 + fr, fq * 8), boff = lds_byte(wc * 32 + fr, fq * 8);
#define PG8_SA(b, h) (((b) * 2 + (h)) * HTB)
#define PG8_SB(b, h) ((4 + (b) * 2 + (h)) * HTB)
#define PG8_STAGE(bufoff, gbase, voff) do { _Pragma("unroll") for (int _i = 0; _i < 2; ++_i) \
        __builtin_amdgcn_global_load_lds((const unsigned*)((const char*)(gbase) + (voff)[_i]), (PG8_LAS unsigned*)(lds + (bufoff) + ldsw + _i * 8192), 16, 0, 0); } while (0)
#define PG8_LDA(dst, b, h) do { _Pragma("unroll") for (int m = 0; m < 4; ++m) _Pragma("unroll") for (int k = 0; k < 2; ++k) dst[m][k] = *(const PG8_LAS bf16x8*)(lds + PG8_SA(b, h) + aoff + m * 2048 + k * 1024); } while (0)
#define PG8_LDB(dst, b, h) do { _Pragma("unroll") for (int n = 0; n < 2; ++n) _Pragma("unroll") for (int k = 0; k < 2; ++k) dst[n][k] = *(const PG8_LAS bf16x8*)(lds + PG8_SB(b, h) + boff + n * 2048 + k * 1024); } while (0)
#define PG8_MMA(ai, bj, At, Bt) do { __builtin_amdgcn_s_setprio(1); _Pragma("unroll") for (int m = 0; m < 4; ++m) _Pragma("unroll") for (int n = 0; n < 2; ++n) _Pragma("unroll") for (int k = 0; k < 2; ++k) \
        acc[ai][bj][m][n] = __builtin_amdgcn_mfma_f32_16x16x32_bf16(Bt[n][k], At[m][k], acc[ai][bj][m][n], 0, 0, 0); __builtin_amdgcn_s_setprio(0); } while (0)
#define PG8_WAIT_V(n) asm volatile("s_waitcnt vmcnt(" #n ")" ::: "memory")
#define PG8_WAIT_L(n) asm volatile("s_waitcnt lgkmcnt(" #n ")" ::: "memory")
#define PG8_BAR __builtin_amdgcn_s_barrier()
#define PG8_SCHED __builtin_amdgcn_sched_barrier(0)
    Unit cur, nxt; int ui = 0;
    if (!S.next(0, cur)) return;
    f32x4 acc[2][2][4][2];
#pragma unroll
    for (int a = 0; a < 2; ++a)
#pragma unroll
        for (int b = 0; b < 2; ++b)
#pragma unroll
            for (int m = 0; m < 4; ++m)
#pragma unroll
                for (int n = 0; n < 2; ++n) acc[a][b][m][n] = (f32x4){0.f, 0.f, 0.f, 0.f};
    bf16x8 At[4][2], B0[2][2], B1[2][2];
    const char* cA = S.abase(g, cur, tstep); const char* cB = S.bbase(g, cur, tstep);
    S.a_ready(cur);
    if constexpr (SP2) {
        PG8_STAGE(PG8_SB(0, 0), cB, voffB); PG8_STAGE(PG8_SB(0, 1), cB + hstep, voffB); PG8_STAGE(PG8_SA(0, 0), cA, voffA); PG8_STAGE(PG8_SA(0, 1), cA + hstep, voffA);
        if (wr == 1) PG8_BAR;
        PG8_WAIT_V(2); PG8_BAR;
        PG8_STAGE(PG8_SB(1, 0), cB + kstep, voffB); PG8_STAGE(PG8_SA(1, 0), cA + kstep, voffA); PG8_STAGE(PG8_SB(1, 1), cB + hstep + kstep, voffB);
        PG8_WAIT_V(6); PG8_BAR;
    } else {
        PG8_STAGE(PG8_SB(0, 0), cB, voffB); PG8_STAGE(PG8_SA(0, 0), cA, voffA); PG8_STAGE(PG8_SB(0, 1), cB + hstep, voffB); PG8_STAGE(PG8_SA(0, 1), cA + hstep, voffA);
        if (wr == 1) PG8_BAR;
        PG8_WAIT_V(4); PG8_BAR;
        PG8_STAGE(PG8_SB(1, 0), cB + kstep, voffB); PG8_STAGE(PG8_SA(1, 0), cA + kstep, voffA); PG8_STAGE(PG8_SB(1, 1), cB + hstep + kstep, voffB);
        PG8_WAIT_V(6); PG8_BAR;
    }
    for (;;) {
        const bool has_next = S.next(ui + 1, nxt);
        const char* nA = has_next ? S.abase(g, nxt, tstep) : cA; const char* nB = has_next ? S.bbase(g, nxt, tstep) : cB;
        for (int t = 0; t < nt; t += 2) {
            const bool last = (t == nt - 2);
            const char* a1 = cA + (size_t)(t + 1) * kstep;
            const char* a2 = last ? nA : cA + (size_t)(t + 2) * kstep; const char* b2 = last ? nB : cB + (size_t)(t + 2) * kstep;
            const char* a3 = a2 + kstep; const char* b3 = b2 + kstep;
            if (last && has_next) S.a_ready(nxt);
            if constexpr (SP2) {
            PG8_LDB(B0, 0, 0); PG8_LDB(B1, 0, 1); PG8_SCHED; PG8_LDA(At, 0, 0); PG8_STAGE(PG8_SA(1, 1), a1 + hstep, voffA);
            PG8_WAIT_V(8); PG8_WAIT_L(0); PG8_BAR; PG8_MMA(0, 0, At, B0); PG8_MMA(0, 1, At, B1); PG8_BAR; PG8_SCHED;
            PG8_LDA(At, 0, 1); PG8_STAGE(PG8_SB(0, 0), b2, voffB); PG8_STAGE(PG8_SB(0, 1), b2 + hstep, voffB); PG8_STAGE(PG8_SA(0, 0), a2, voffA);
            PG8_WAIT_V(8); PG8_WAIT_L(0); PG8_BAR; PG8_MMA(1, 0, At, B0); PG8_MMA(1, 1, At, B1); PG8_BAR; PG8_SCHED;
            PG8_LDB(B0, 1, 0); PG8_LDB(B1, 1, 1); PG8_SCHED; PG8_LDA(At, 1, 0); PG8_STAGE(PG8_SA(0, 1), a2 + hstep, voffA);
            PG8_WAIT_V(8); PG8_WAIT_L(0); PG8_BAR; PG8_MMA(0, 0, At, B0); PG8_MMA(0, 1, At, B1); PG8_BAR; PG8_SCHED;
            PG8_LDA(At, 1, 1); PG8_STAGE(PG8_SB(1, 0), b3, voffB); PG8_STAGE(PG8_SB(1, 1), b3 + hstep, voffB); PG8_STAGE(PG8_SA(1, 0), a3, voffA);
            PG8_WAIT_V(8); PG8_WAIT_L(0); PG8_BAR; PG8_MMA(1, 0, At, B0); PG8_MMA(1, 1, At, B1); PG8_BAR; PG8_SCHED;
            } else {
            PG8_LDB(B0, 0, 0); PG8_SCHED; PG8_LDA(At, 0, 0); PG8_STAGE(PG8_SA(1, 1), a1 + hstep, voffA);
            PG8_WAIT_L(8); PG8_BAR; PG8_WAIT_L(0); PG8_MMA(0, 0, At, B0); PG8_BAR; PG8_SCHED;
            PG8_LDB(B1, 0, 1); PG8_STAGE(PG8_SB(0, 0), b2, voffB);
            PG8_BAR; PG8_WAIT_L(0); PG8_MMA(0, 1, At, B1); PG8_BAR;
            PG8_LDA(At, 0, 1); PG8_STAGE(PG8_SA(0, 0), a2, voffA);
            PG8_BAR; PG8_WAIT_L(0); PG8_MMA(1, 0, At, B0); PG8_BAR; PG8_SCHED;
            PG8_STAGE(PG8_SB(0, 1), b2 + hstep, voffB);
            PG8_WAIT_V(6); PG8_BAR; PG8_MMA(1, 1, At, B1); PG8_BAR;
            PG8_LDB(B0, 1, 0); PG8_SCHED; PG8_LDA(At, 1, 0); PG8_STAGE(PG8_SA(0, 1), a2 + hstep, voffA);
            PG8_WAIT_L(8); PG8_BAR; PG8_WAIT_L(0); PG8_MMA(0, 0, At, B0); PG8_BAR; PG8_SCHED;
            PG8_LDB(B1, 1, 1); PG8_STAGE(PG8_SB(1, 0), b3, voffB);
            PG8_BAR; PG8_WAIT_L(0); PG8_MMA(0, 1, At, B1); PG8_BAR;
            PG8_LDA(At, 1, 1); PG8_STAGE(PG8_SA(1, 0), a3, voffA);
            PG8_BAR; PG8_WAIT_L(0); PG8_MMA(1, 0, At, B0); PG8_BAR; PG8_SCHED;
            PG8_STAGE(PG8_SB(1, 1), b3 + hstep, voffB);
            PG8_WAIT_V(6); PG8_BAR; PG8_MMA(1, 1, At, B1); PG8_BAR;
            }
        }
        if constexpr (ALIGN_EPI) { if (wr == 0) PG8_BAR; }
        if constexpr (!Epi::AFTER_DRAIN) { E(acc, cur, wr, wc, fr, fq); S.done(cur); }
        if (!has_next) break;
#pragma unroll
        for (int a = 0; a < 2; ++a)
#pragma unroll
            for (int b = 0; b < 2; ++b)
#pragma unroll
                for (int m = 0; m < 4; ++m)
#pragma unroll
                    for (int n = 0; n < 2; ++n) acc[a][b][m][n] = (f32x4){0.f, 0.f, 0.f, 0.f};
        cur = nxt; cA = nA; cB = nB; ++ui;
        if constexpr (ALIGN_EPI) { if (wr == 1) PG8_BAR; }
    }
    PG8_WAIT_V(0);
    if constexpr (!ALIGN_EPI) { if (wr == 0) PG8_BAR; }
    PG8_BAR;
    if constexpr (Epi::AFTER_DRAIN) { E.fused(acc, cur, wr, wc, fr, fq, lds, wid, lane); S.done(cur); }
#undef PG8_SA
#undef PG8_SB
#undef PG8_STAGE
#undef PG8_LDA
#undef PG8_LDB
#undef PG8_MMA
#undef PG8_WAIT_V
#undef PG8_WAIT_L
#undef PG8_BAR
#undef PG8_SCHED
}
}

constexpr int NWAVES = 8;
constexpr int D = 1024, NB = 4, SEQ = 4096, CTXL = 256, NLAT = NB * SEQ, NCTX = NB * CTXL, MROWS = NLAT + NCTX;
constexpr int DEPTH = 4, RW = 512, NH = 8, HS = 64, DFF = 3584, NE = 8, NPROJ = 3456, NP = 3584, NLO = 2560, KLA = 512, NMOD = 6144;
constexpr int PC_R = 0, PC_K = 512, PC_V = 1024, PC_CB = 1536, PC_CC = 2048, PC_CH = 2560, PC_WD = 3072, PC_AD = 3200, PC_GD = 3328;
constexpr float LN_EPS = 1e-5f, GN_EPS = 64e-5f, DN_ALPHA = 1.681792830507429f;
enum { I_X = 0, I_C, I_CTX, I_CCTX, I_WMOD, I_BMOD, I_WIN, I_W0, I_W2, I_A0, I_A2, I_KK, I_KA, I_RK, I_G2, I_LNXG, I_LNXB, I_CONVW, I_WOUT, I_LN1G, I_LN1B, I_LN2G, I_LN2B,
       I_FW1, I_FW3, I_FW2, I_RTW, I_RTB, I_MW1, I_MW3, I_MW2, N_IN };

constexpr size_t MiB = 1u << 20;
constexpr size_t WS_CTL = 0, CTL_BYTES = 1 * MiB;
constexpr size_t WS_MODV = 1 * MiB;
constexpr size_t WS_G8 = 2 * MiB;
constexpr size_t WS_RKS = 3 * MiB;
constexpr size_t WS_WIN = 4 * MiB;
constexpr size_t WS_WOUT = WS_WIN + 28 * MiB;
constexpr size_t WS_LORA = WS_WOUT + 8 * MiB;
constexpr size_t WS_F13 = WS_LORA + 10 * MiB;
constexpr size_t WS_F2 = WS_F13 + 28 * MiB;
constexpr size_t WS_X = WS_F2 + 14 * MiB;
constexpr size_t WS_H = WS_X + 68 * MiB;
constexpr size_t WS_MOES = WS_H + 34 * MiB;
constexpr size_t WS_ROWLIST = WS_MOES;
constexpr size_t WS_TOKSEL = WS_MOES + 640 * 1024;
constexpr size_t WS_WSEL = WS_TOKSEL + 320 * 1024;
constexpr size_t WS_WSORT = WS_WSEL + 192 * 1024;
constexpr size_t WS_MOEW13 = WS_MOES + 2 * MiB;
constexpr size_t WS_MOEW2 = WS_MOEW13 + 112 * MiB;
constexpr size_t WS_SCR = WS_MOEW2 + 56 * MiB;
constexpr size_t WS_P = WS_SCR;
constexpr size_t WS_LO = WS_P + 119 * MiB;
constexpr size_t WS_PREP = WS_LO + 170 * MiB;
constexpr size_t WS_Y = WS_PREP + 213 * MiB;
constexpr size_t WS_MIXIN = WS_Y + 68 * MiB;
constexpr size_t WS_CH = WS_PREP;
constexpr size_t WS_MIXO = WS_PREP;
constexpr size_t WS_MIXP = WS_PREP + 34 * MiB;
constexpr size_t WS_END_MIXER = WS_MIXIN + 34 * MiB;
constexpr size_t WS_HG = WS_SCR;
constexpr size_t WS_ACT = WS_HG + 72 * MiB;
constexpr size_t WS_F = WS_ACT + 252 * MiB;
constexpr size_t WS_FP = WS_F + 72 * MiB;
constexpr size_t WS_END_FFN = WS_FP + 64 * MiB;
constexpr size_t WS_NEED = WS_END_MIXER > WS_END_FFN ? WS_END_MIXER : WS_END_FFN;
static_assert((size_t)MROWS * NP * 2 <= 119 * MiB && (size_t)MROWS * NLO * 4 <= 170 * MiB && (size_t)8704 * 25600 <= 213 * MiB && (size_t)MROWS * D * 4 <= 68 * MiB && WS_NEED <= 990 * MiB, "ws map");
constexpr int MOE_MAIN_PANELS = 128, MOE_TAIL_ROWS = 4096;
constexpr int MOE_ROWS = 36864;
constexpr int LORAW_PER_LAYER = 4 * 512 * 64 + 512 * 128;
constexpr int CW_BAR = 4096, CW_GCNT = 8192, CW_CQ = 12288, CW_SDONE = 12544;

constexpr int RING_BYTES = 131072, LDSCTL_OFF = RING_BYTES, MISC_OFF = LDSCTL_OFF + 320, LDS_BYTES = 147456;

typedef unsigned short bf16;
typedef unsigned v4u __attribute__((ext_vector_type(4)));
typedef unsigned v2u __attribute__((ext_vector_type(2)));
typedef float f32x4 __attribute__((ext_vector_type(4)));
#define LAS __attribute__((address_space(3)))
#define LDS_WAIT() asm volatile("s_waitcnt lgkmcnt(0)" ::: "memory")
__device__ __forceinline__ unsigned f2bf(float f) { unsigned u = __builtin_bit_cast(unsigned, f); return (u + 0x7fffu + ((u >> 16) & 1u)) >> 16; }
__device__ __forceinline__ unsigned pk2(float lo, float hi) { return f2bf(lo) | (f2bf(hi) << 16); }
__device__ __forceinline__ float bf2f(unsigned short b) { return __builtin_bit_cast(float, ((unsigned)b) << 16); }
__device__ __forceinline__ float bflo(unsigned w) { return __builtin_bit_cast(float, w << 16); }
__device__ __forceinline__ float bfhi(unsigned w) { return __builtin_bit_cast(float, w & 0xffff0000u); }
__device__ __forceinline__ float wave_sum(float v) {
#pragma unroll
    for (int o = 1; o < 64; o <<= 1) v += __shfl_xor(v, o);
    return v;
}
__device__ __forceinline__ float sigm(float x) { return 1.f / (1.f + __expf(-x)); }

#define XB_TMO      128
#define XB_XCNT(j)  (256  + 64 * (j))
#define XB_XSUB(j)  (1280 + 64 * (j))
#define XB_XGEN(j)  (2304 + 64 * (j))
#define XB_TOP      3328
#define XB_TOPGEN   3392
#define XCD_BAR_WORDS 3456
#define XB_SPIN_CAP (1u << 18)

__device__ __forceinline__ unsigned xb_ld(unsigned* p)              { return __hip_atomic_load(p, __ATOMIC_RELAXED, __HIP_MEMORY_SCOPE_AGENT); }
__device__ __forceinline__ unsigned xb_add(unsigned* p, unsigned v) { return __hip_atomic_fetch_add(p, v, __ATOMIC_RELAXED, __HIP_MEMORY_SCOPE_AGENT); }
__device__ __forceinline__ unsigned xb_xcc_id() { return (unsigned)__builtin_amdgcn_s_getreg((3 << 11) | 20) & 0xFu; }
#define XB_SPIN(cond, bar) do { unsigned _sp = 0; while (cond) { __builtin_amdgcn_s_sleep(1); \
    if ((++_sp & 255u) == 0u) { if (xb_ld(&(bar)[XB_TMO])) break; if (_sp > XB_SPIN_CAP) { atomicAdd(&(bar)[XB_TMO], 1u); break; } } } } while (0)

struct XcdBarrier {
    unsigned* bar; unsigned x;
    volatile LAS unsigned* st;
};

__device__ __forceinline__ XcdBarrier xcd_barrier_post(unsigned* bar, volatile LAS unsigned* st) {
    XcdBarrier b; b.bar = bar; b.x = xb_xcc_id(); b.st = st;
    if (threadIdx.x == 0) (void)xb_add(&bar[XB_XCNT(b.x)], 1u);
    return b;
}
__device__ __forceinline__ void xcd_barrier_complete(unsigned* bar, unsigned x, unsigned& nloc, unsigned& nx) {
    const unsigned G = gridDim.x * gridDim.y * gridDim.z;
    unsigned sum, cnt, mine, sp = 0u;
    for (;;) {
        sum = 0u; cnt = 0u; mine = 0u;
#pragma unroll
        for (unsigned j = 0; j < 16; ++j) { const unsigned c = xb_ld(&bar[XB_XCNT(j)]); sum += c; cnt += (c > 0u) ? 1u : 0u; mine = (j == x) ? c : mine; }
        if (sum == G) break;
        __builtin_amdgcn_s_sleep(1);
        if ((++sp & 255u) == 0u) { if (xb_ld(&bar[XB_TMO])) break; if (sp > XB_SPIN_CAP) { atomicAdd(&bar[XB_TMO], 1u); break; } }
    }
    nloc = mine > 0u ? mine : 1u; nx = cnt > 0u ? cnt : 1u;
}

__device__ __forceinline__ void xcd_barrier(const XcdBarrier& b) {
    asm volatile("s_waitcnt vmcnt(0)" ::: "memory");
    __syncthreads();
    if (threadIdx.x == 0) {
        unsigned* bar = b.bar;
        __builtin_amdgcn_s_waitcnt(0);
        unsigned nloc = b.st[0], nx = b.st[1];
        if (nloc == 0u) { xcd_barrier_complete(bar, b.x, nloc, nx); b.st[0] = nloc; b.st[1] = nx; }
        const unsigned old = xb_add(&bar[XB_XSUB(b.x)], 1u);
        const unsigned gen = old / nloc;
        if (old + 1u == (gen + 1u) * nloc) {
            __builtin_amdgcn_fence(__ATOMIC_RELEASE, "agent");
            asm volatile("s_waitcnt vmcnt(0)" ::: "memory");
            const unsigned og = xb_add(&bar[XB_TOP], 1u);
            const unsigned tg = og / nx;
            if (og + 1u == (tg + 1u) * nx) xb_add(&bar[XB_TOPGEN], 1u);
            else XB_SPIN(xb_ld(&bar[XB_TOPGEN]) == tg, bar);
            __builtin_amdgcn_fence(__ATOMIC_ACQUIRE, "agent");
            xb_add(&bar[XB_XGEN(b.x)], 1u);
            asm volatile("s_waitcnt vmcnt(0)" ::: "memory");
        } else {
            XB_SPIN(xb_ld(&bar[XB_XGEN(b.x)]) == gen, bar);
            __builtin_amdgcn_fence(__ATOMIC_ACQUIRE, "agent");
            asm volatile("s_waitcnt vmcnt(0)" ::: "memory");
        }
    }
    __syncthreads();
}


struct KP { const float* in[N_IN]; float* out; unsigned char* ws; int ph; int pad; };

template <int MODE> __device__ __forceinline__ int rowmap(int n, int arg) {
    if (MODE == 0) return n + arg;
    if (MODE == 1) { if (n < 1536) return n; if (n < 1664) return n - 1536 + PC_WD; if (n < 1792) return n - 1664 + PC_AD; if (n < 1920) return n - 1792 + PC_GD;
                     if (n < 2432) return n - 1920 + PC_CB; if (n < 2944) return n - 2432 + PC_CC; return n - 2944 + PC_CH; }
    return 8 * (n >> 2) + 4 * arg + (n & 3);
}
template <int MODE> __device__ __forceinline__ void transpose_item(const float* W, int K, int N, bf16* WT, int arg, LAS float* scr, int item, int lane) {
    const int nblk = N / 32, kb = item / nblk, nb = item % nblk, k0 = 64 * kb, n0 = 32 * nb;
#pragma unroll 8
    for (int i = 0; i < 32; ++i) { const int kk = 2 * i + (lane >> 5); scr[kk * 33 + (lane & 31)] = W[(size_t)(k0 + kk) * N + n0 + (lane & 31)]; }
    LDS_WAIT(); asm volatile("" ::: "memory");
    const int c = lane & 7;
#pragma unroll
    for (int j = 0; j < 4; ++j) { const int n = (lane >> 3) + 8 * j; const LAS float* s = scr + (8 * c) * 33 + n;
        v4u o; o.x = pk2(s[0 * 33], s[1 * 33]); o.y = pk2(s[2 * 33], s[3 * 33]); o.z = pk2(s[4 * 33], s[5 * 33]); o.w = pk2(s[6 * 33], s[7 * 33]);
        *(v4u*)(WT + (size_t)rowmap<MODE>(n0 + n, arg) * K + k0 + 8 * c) = o; }
    LDS_WAIT(); asm volatile("" ::: "memory");
}

__device__ __forceinline__ void ph_modvec(const KP& p, LAS unsigned char* lds, int tid) {
    LAS float* sil = (LAS float*)lds;
    LAS float* red = (LAS float*)(lds + 5 * 1024 * 4);
    const float* c = p.in[I_C]; const float* cc = p.in[I_CCTX];
    for (int i = tid; i < 5 * 1024; i += 512) { const float v = i < 4096 ? c[i] : cc[i - 4096]; sil[i] = v / (1.f + __expf(-v)); }
    __syncthreads();
    float* modv = (float*)(p.ws + WS_MODV);
    const int ks = tid >> 6, col = tid & 63;
    for (int task = blockIdx.x; task < DEPTH * 96; task += gridDim.x) {
        const int l = task / 96, j0 = (task % 96) * 64;
        const float* w = p.in[I_WMOD] + (size_t)l * D * NMOD + (size_t)(ks * 128) * NMOD + j0 + col;
        float a0 = 0.f, a1 = 0.f, a2 = 0.f, a3 = 0.f, a4 = 0.f;
#pragma unroll 8
        for (int k = 0; k < 128; ++k) { const float wv = w[(size_t)k * NMOD]; const int kk = ks * 128 + k;
            a0 += sil[kk] * wv; a1 += sil[1024 + kk] * wv; a2 += sil[2048 + kk] * wv; a3 += sil[3072 + kk] * wv; a4 += sil[4096 + kk] * wv; }
        red[(ks * 5 + 0) * 64 + col] = a0; red[(ks * 5 + 1) * 64 + col] = a1; red[(ks * 5 + 2) * 64 + col] = a2; red[(ks * 5 + 3) * 64 + col] = a3; red[(ks * 5 + 4) * 64 + col] = a4;
        __syncthreads();
        if (tid < 320) { const int r = tid >> 6; float s = 0.f;
#pragma unroll
            for (int q = 0; q < 8; ++q) s += red[(q * 5 + r) * 64 + col];
            modv[(size_t)(l * 5 + r) * NMOD + j0 + col] = s + p.in[I_BMOD][l * NMOD + j0 + col]; }
        __syncthreads();
    }
}

__device__ __forceinline__ void ph_convert(const KP& p, LAS unsigned char* lds, int gw, int NGW, int wave, int lane) {
    LAS float* scr = (LAS float*)(lds + wave * 16384);
    bf16* win = (bf16*)(p.ws + WS_WIN); bf16* wout = (bf16*)(p.ws + WS_WOUT); bf16* f13 = (bf16*)(p.ws + WS_F13); bf16* f2 = (bf16*)(p.ws + WS_F2); bf16* lora = (bf16*)(p.ws + WS_LORA);
    constexpr int I_IN = (D / 64) * (NPROJ / 32), I_OUT = (D / 64) * (D / 32), I_UP = (D / 64) * (DFF / 32), I_DN = (DFF / 64) * (D / 32);
    constexpr int NITEMS = I_IN + I_OUT + 2 * I_UP + I_DN;
    for (int it = gw; it < NITEMS; it += NGW) {
        int r = it;
        if (r < I_IN) { transpose_item<1>(p.in[I_WIN], D, NPROJ, win, 0, scr, r, lane); continue; } r -= I_IN;
        if (r < I_OUT) { transpose_item<0>(p.in[I_WOUT], D, D, wout, 0, scr, r, lane); continue; } r -= I_OUT;
        if (r < I_UP) { transpose_item<2>(p.in[I_FW1], D, DFF, f13, 0, scr, r, lane); continue; } r -= I_UP;
        if (r < I_UP) { transpose_item<2>(p.in[I_FW3], D, DFF, f13, 1, scr, r, lane); continue; } r -= I_UP;
        transpose_item<0>(p.in[I_FW2], DFF, D, f2, 0, scr, r, lane);
    }
    { const int gt = gw * 64 + lane, NGT = NGW * 64; constexpr int PER = (NP - NPROJ) * D / 8;
      for (int i = gt; i < DEPTH * PER; i += NGT) { const int l = i / PER, q = i % PER; *(v4u*)(win + (size_t)l * NP * D + (size_t)NPROJ * D + (size_t)q * 8) = (v4u){0u, 0u, 0u, 0u}; } }
    { const int gt = gw * 64 + lane, NGT = NGW * 64;
      for (int i = gt; i < DEPTH * LORAW_PER_LAYER / 8; i += NGT) { const int l = i / (LORAW_PER_LAYER / 8); int q = (i % (LORAW_PER_LAYER / 8)) * 8; float v[8];
          int grp, c, k0; if (q < 4 * 512 * 64) { grp = q / (512 * 64); q -= grp * 512 * 64; c = q / 64; k0 = q % 64; } else { grp = 4; q -= 4 * 512 * 64; c = q / 128; k0 = q % 128; }
#pragma unroll
          for (int j = 0; j < 8; ++j) { const int k = k0 + j;
              v[j] = grp < 2 ? p.in[I_W2][((size_t)(l * 2 + grp) * 64 + k) * RW + c] : grp < 4 ? p.in[I_A2][((size_t)(l * 2 + grp - 2) * 64 + k) * RW + c] : p.in[I_G2][((size_t)l * 128 + k) * RW + c]; }
          v4u o; o.x = pk2(v[0], v[1]); o.y = pk2(v[2], v[3]); o.z = pk2(v[4], v[5]); o.w = pk2(v[6], v[7]);
          *(v4u*)(lora + (size_t)i * 8) = o; } }
}
constexpr int CQ_IN = (D / 64) * (NPROJ / 32), CQ_OUT = (D / 64) * (D / 32), CQ_UP = (D / 64) * (DFF / 32), CQ_DN = (DFF / 64) * (D / 32);
constexpr int CQ_J1 = 3 * CQ_IN + 3 * CQ_OUT + 2 * CQ_UP + CQ_DN, CQ_MOE = NE * (2 * CQ_UP + CQ_DN), CQ_END0 = CQ_J1 + CQ_MOE, CQ_END1 = CQ_END0 + CQ_MOE;
#ifndef CQ_SLOT_ITEMS
#define CQ_SLOT_ITEMS 12000
#endif
struct CqItem { const float* W; bf16* WT; int K, N, mode, arg, item; };
__device__ __forceinline__ CqItem cq_decode(const KP& p, int q) {
    CqItem c; bf16* win = (bf16*)(p.ws + WS_WIN); bf16* wout = (bf16*)(p.ws + WS_WOUT); bf16* f13 = (bf16*)(p.ws + WS_F13); bf16* f2 = (bf16*)(p.ws + WS_F2);
    bf16* m13 = (bf16*)(p.ws + WS_MOEW13); bf16* m2 = (bf16*)(p.ws + WS_MOEW2);
    if (q < 3 * CQ_IN) { const int l = 1 + q / CQ_IN; c = CqItem{p.in[I_WIN] + (size_t)l * D * NPROJ, win + (size_t)l * NP * D, D, NPROJ, 1, 0, q % CQ_IN}; return c; } q -= 3 * CQ_IN;
    if (q < 3 * CQ_OUT) { const int l = 1 + q / CQ_OUT; c = CqItem{p.in[I_WOUT] + (size_t)l * D * D, wout + (size_t)l * D * D, D, D, 0, 0, q % CQ_OUT}; return c; } q -= 3 * CQ_OUT;
    if (q < CQ_UP) { c = CqItem{p.in[I_FW1] + (size_t)D * DFF, f13 + (size_t)2 * DFF * D, D, DFF, 2, 0, q}; return c; } q -= CQ_UP;
    if (q < CQ_UP) { c = CqItem{p.in[I_FW3] + (size_t)D * DFF, f13 + (size_t)2 * DFF * D, D, DFF, 2, 1, q}; return c; } q -= CQ_UP;
    if (q < CQ_DN) { c = CqItem{p.in[I_FW2] + (size_t)DFF * D, f2 + (size_t)D * DFF, DFF, D, 0, 0, q}; return c; } q -= CQ_DN;
    const int mi = q / CQ_MOE; q -= mi * CQ_MOE;
    if (q < NE * CQ_UP) { const int e = q / CQ_UP; c = CqItem{p.in[I_MW1] + ((size_t)mi * NE + e) * D * DFF, m13 + (size_t)e * 2 * DFF * D, D, DFF, 2, 0, q % CQ_UP}; return c; } q -= NE * CQ_UP;
    if (q < NE * CQ_UP) { const int e = q / CQ_UP; c = CqItem{p.in[I_MW3] + ((size_t)mi * NE + e) * D * DFF, m13 + (size_t)e * 2 * DFF * D, D, DFF, 2, 1, q % CQ_UP}; return c; } q -= NE * CQ_UP;
    { const int e = q / CQ_DN; c = CqItem{p.in[I_MW2] + ((size_t)mi * NE + e) * DFF * D, m2 + (size_t)e * D * DFF, DFF, D, 0, 0, q % CQ_DN}; return c; }
}
__device__ __forceinline__ void cq_load(const CqItem& c, int lane, float (&r)[32]) {
    const int nblk = c.N / 32, kb = c.item / nblk, nb = c.item % nblk; const float* src = c.W + (size_t)(64 * kb + (lane >> 5)) * c.N + 32 * nb + (lane & 31);
#pragma unroll
    for (int i = 0; i < 32; ++i) r[i] = src[(size_t)(2 * i) * c.N];
}
__device__ __forceinline__ void cq_store(const CqItem& c, int lane, const float (&r)[32], LAS float* scr) {
    const int nblk = c.N / 32, kb = c.item / nblk, nb = c.item % nblk, k0 = 64 * kb, n0 = 32 * nb;
#pragma unroll
    for (int i = 0; i < 32; ++i) scr[(2 * i + (lane >> 5)) * 33 + (lane & 31)] = r[i];
    LDS_WAIT(); asm volatile("" ::: "memory");
    const int cc = lane & 7;
#pragma unroll
    for (int j = 0; j < 4; ++j) { const int n = (lane >> 3) + 8 * j; const LAS float* sp = scr + (8 * cc) * 33 + n;
        v4u o; o.x = pk2(sp[0 * 33], sp[1 * 33]); o.y = pk2(sp[2 * 33], sp[3 * 33]); o.z = pk2(sp[4 * 33], sp[5 * 33]); o.w = pk2(sp[6 * 33], sp[7 * 33]);
        const int nn = n0 + n; const int row = c.mode == 0 ? nn : c.mode == 1 ? rowmap<1>(nn, 0) : 8 * (nn >> 2) + 4 * c.arg + (nn & 3);
        *(v4u*)(c.WT + (size_t)row * c.K + k0 + 8 * cc) = o; }
    LDS_WAIT(); asm volatile("" ::: "memory");
}
constexpr int CQ_B = 4;
__device__ __forceinline__ int cq_grab(unsigned* heads, int nseg, int& cnt, int lane) {
    int q = -1, n = 0;
    if (lane == 0) { for (int sg = 0; sg < nseg && q < 0; ++sg) { const int size = sg == 0 ? CQ_J1 : CQ_MOE, base = sg == 0 ? 0 : sg == 1 ? CQ_J1 : CQ_END0; unsigned* hd = heads + 64 * sg;
            if ((int)__hip_atomic_load(hd, __ATOMIC_RELAXED, __HIP_MEMORY_SCOPE_AGENT) < size) { const int t = (int)__hip_atomic_fetch_add(hd, (unsigned)CQ_B, __ATOMIC_RELAXED, __HIP_MEMORY_SCOPE_AGENT);
                if (t < size) { q = base + t; n = size - t < CQ_B ? size - t : CQ_B; } } } }
    cnt = __builtin_amdgcn_readfirstlane(n); return __builtin_amdgcn_readfirstlane(q);
}
__device__ __forceinline__ void cq_run(const KP& p, LAS unsigned char* lds, int nseg, const unsigned* stop, unsigned stopval, int wave, int lane) {
    unsigned* heads = (unsigned*)(p.ws + WS_CTL) + CW_CQ; LAS float* scr = (LAS float*)(lds + wave * 16384);
    for (;;) {
        if (stop) { unsigned sv = 0u; if (lane == 0) sv = __hip_atomic_load(stop, __ATOMIC_RELAXED, __HIP_MEMORY_SCOPE_AGENT); if ((unsigned)__builtin_amdgcn_readfirstlane((int)sv) >= stopval) break; }
        int cnt; const int q0 = cq_grab(heads, nseg, cnt, lane); if (q0 < 0) break;
        CqItem cur = cq_decode(p, q0); float ra[32]; cq_load(cur, lane, ra);
        for (int j = 0; j < cnt; ++j) { CqItem nxt = cur; float rb[32];
            if (j + 1 < cnt) { nxt = cq_decode(p, q0 + j + 1); cq_load(nxt, lane, rb); }
            cq_store(cur, lane, ra, scr);
            if (j + 1 < cnt) { cur = nxt;
#pragma unroll
                for (int i = 0; i < 32; ++i) ra[i] = rb[i]; } }
    }
}

__device__ __forceinline__ void cq_static(const KP& p, LAS unsigned char* lds, int q0, int q1, int gw, int NGW, int wave, int lane) {
    LAS float* scr = (LAS float*)(lds + wave * 16384);
    int q = q0 + gw; if (q >= q1) return;
    CqItem cur = cq_decode(p, q); float ra[32]; cq_load(cur, lane, ra);
    for (;;) { const int qn = q + NGW; CqItem nxt = cur; float rb[32];
        if (qn < q1) { nxt = cq_decode(p, qn); cq_load(nxt, lane, rb); }
        cq_store(cur, lane, ra, scr);
        if (qn >= q1) break;
        cur = nxt; q = qn;
#pragma unroll
        for (int i = 0; i < 32; ++i) ra[i] = rb[i]; }
}

__device__ __forceinline__ void ld_row(const float* r, int lane, f32x4 (&v)[4]) { const f32x4* q = (const f32x4*)r + lane;
#pragma unroll
    for (int j = 0; j < 4; ++j) v[j] = q[64 * j]; }
__device__ __forceinline__ void st_row(float* r, int lane, const f32x4 (&v)[4]) { f32x4* q = (f32x4*)r + lane;
#pragma unroll
    for (int j = 0; j < 4; ++j) q[64 * j] = v[j]; }
__device__ __forceinline__ void st_row_bf16(bf16* r, int lane, const f32x4 (&v)[4]) { v2u* q = (v2u*)r + lane;
#pragma unroll
    for (int j = 0; j < 4; ++j) { v2u w; w.x = pk2(v[j][0], v[j][1]); w.y = pk2(v[j][2], v[j][3]); q[64 * j] = w; } }
__device__ __forceinline__ void ld_row_bf16(const bf16* r, int lane, f32x4 (&v)[4]) { const v2u* q = (const v2u*)r + lane;
#pragma unroll
    for (int j = 0; j < 4; ++j) { const v2u w = q[64 * j]; v[j] = (f32x4){bflo(w.x), bfhi(w.x), bflo(w.y), bfhi(w.y)}; } }
template <int S> __device__ __forceinline__ void ld_row_parts(const float* r, size_t pstride, int lane, f32x4 (&v)[4]) {
    ld_row(r, lane, v);
#pragma unroll
    for (int s = 1; s < S; ++s) { f32x4 t[4]; ld_row(r + (size_t)s * pstride, lane, t);
#pragma unroll
        for (int j = 0; j < 4; ++j) v[j] += t[j]; } }
__device__ __forceinline__ int mod_row(int row) { return row < NLAT ? (row >> 12) : 4; }

__device__ __forceinline__ void ph_init_rows(const KP& p, int gw, int NGW, int lane) {
    const float* modv = (const float*)(p.ws + WS_MODV); float* X = (float*)(p.ws + WS_X); bf16* H = (bf16*)(p.ws + WS_H);
    for (int row = gw; row < MROWS; row += NGW) {
        const float* src = row < NLAT ? p.in[I_X] + (size_t)row * D : p.in[I_CTX] + (size_t)(row - NLAT) * D;
        const float* mv = modv + (size_t)(0 * 5 + mod_row(row)) * NMOD;
        f32x4 x[4], sh[4], sc[4], h[4]; ld_row(src, lane, x); ld_row(mv, lane, sh); ld_row(mv + 1024, lane, sc);
#pragma unroll
        for (int j = 0; j < 4; ++j) h[j] = x[j] * (1.f + sc[j]) + sh[j];
        st_row(X + (size_t)row * D, lane, x); st_row_bf16(H + (size_t)row * D, lane, h);
    }
}

__device__ __forceinline__ int scan_row(int b, int dir, int step) { return step < CTXL ? NLAT + b * CTXL + (dir ? CTXL - 1 - step : step) : b * SEQ + (dir ? SEQ - 1 - (step - CTXL) : step - CTXL); }
typedef short sbf16x8 __attribute__((ext_vector_type(8)));
typedef float f32x16 __attribute__((ext_vector_type(16)));
constexpr int SC_C = 32, SC_NCH = (CTXL + SEQ) / SC_C  , SC_NCHAIN = NB * NH * 2  , SC_NTASK = SC_NCH * SC_NCHAIN  ;
constexpr int CH_G = 0, CH_Q = 8192, CH_UT = 12288, CH_YL = 20480, CH_EC = 24576, CH_BYTES = 25600, CH_NLOAD = 26;

__device__ __forceinline__ f32x16 mm(v4u a, v4u b, f32x16 c) { return __builtin_amdgcn_mfma_f32_32x32x16_bf16(__builtin_bit_cast(sbf16x8, a), __builtin_bit_cast(sbf16x8, b), c, 0, 0, 0); }
typedef float f32x2c __attribute__((ext_vector_type(2))); typedef __bf16 bf16x2c __attribute__((ext_vector_type(2)));
__device__ __forceinline__ unsigned cvtpk(float lo, float hi) { return __builtin_bit_cast(unsigned, __builtin_convertvector((f32x2c){lo, hi}, bf16x2c)); }
template <int S, int NEG> __device__ __forceinline__ v4u cvtf(const f32x16& x) {
    v4u w; const float sg = NEG ? -1.f : 1.f;
    w.x = cvtpk(sg * x[8 * S + 0], sg * x[8 * S + 1]); w.y = cvtpk(sg * x[8 * S + 2], sg * x[8 * S + 3]); w.z = cvtpk(sg * x[8 * S + 4], sg * x[8 * S + 5]); w.w = cvtpk(sg * x[8 * S + 6], sg * x[8 * S + 7]); return w; }
template <int MODE  > __device__ __forceinline__ f32x16 mask_acc(f32x16 x, int n, int hh) {
#pragma unroll
    for (int r = 0; r < 16; ++r) { const int m = (r & 3) + 8 * (r >> 2) + 4 * hh; const bool keep = MODE == 0 ? (m > n) : MODE == 1 ? (m < n) : (m <= n); x[r] = keep ? x[r] : 0.f; }
    return x; }
__device__ __forceinline__ f32x16 zero16() { f32x16 z;
#pragma unroll
    for (int r = 0; r < 16; ++r) z[r] = 0.f;
    return z; }
__device__ __forceinline__ void cm_build(const unsigned (&w)[16], v4u (&f)[2][2]) {
#pragma unroll
    for (int s = 0; s < 2; ++s) {
        const auto r0 = __builtin_amdgcn_permlane32_swap(w[8 * s + 0], w[8 * s + 2], false, false), r1 = __builtin_amdgcn_permlane32_swap(w[8 * s + 1], w[8 * s + 3], false, false);
        const auto r2 = __builtin_amdgcn_permlane32_swap(w[8 * s + 4], w[8 * s + 6], false, false), r3 = __builtin_amdgcn_permlane32_swap(w[8 * s + 5], w[8 * s + 7], false, false);
        f[0][s] = (v4u){r0[0], r1[0], r2[0], r3[0]}; f[1][s] = (v4u){r0[1], r1[1], r2[1], r3[1]}; }
}
__device__ __forceinline__ void st16(unsigned char* base, int off, int lane, v4u v) { *(v4u*)(base + off + lane * 16) = v; }

__device__ __forceinline__ void ph_scan1(const KP& p, int l, int gw, int NGW, int lane) {
    const bf16* P = (const bf16*)(p.ws + WS_P); const float* LO = (const float*)(p.ws + WS_LO); const float* NRM = (const float*)(p.ws + WS_RKS); unsigned char* CH = p.ws + WS_CH;
    const int n = lane & 31, hh = lane >> 5;
    v4u Id[2];
#pragma unroll
    for (int s = 0; s < 2; ++s) { unsigned wd[4];
#pragma unroll
        for (int q = 0; q < 4; ++q) { const int j0 = 2 * q, j1 = 2 * q + 1; const int t0 = 16 * s + 8 * (j0 >> 2) + 4 * hh + (j0 & 3), t1 = 16 * s + 8 * (j1 >> 2) + 4 * hh + (j1 & 3);
            wd[q] = (t0 == n ? 0x3F80u : 0u) | (t1 == n ? 0x3F800000u : 0u); }
        Id[s] = (v4u){wd[0], wd[1], wd[2], wd[3]}; }
    for (int task = gw; task < SC_NTASK; task += NGW) {
        const int dir = task & 1, h = (task >> 1) & 7, b = (task >> 4) & 3, ci = task >> 6;
        const int row0 = scan_row(b, dir, SC_C * ci), sgn = dir ? -1 : 1, c = h * 64 + lane;
        const float w0c = p.in[I_W0][(l * 2 + dir) * RW + c], a0c = p.in[I_A0][(l * 2 + dir) * RW + c], kkc = p.in[I_KK][l * RW + c], kac = p.in[I_KA][l * RW + c];
        unsigned wAl[16], wBe[16], wKa[16], wRh[16], wV[16], wBp[16], wKp[16];
        float cs = 0.f, Eprev = 1.f;
#pragma unroll
        for (int hb = 0; hb < 2; ++hb) {
            unsigned rk_[16], rr_[16], rv_[16]; float rw_[16], ra_[16], rn_[16];
#pragma unroll
            for (int i = 0; i < 16; ++i) { const int row = row0 + sgn * (16 * hb + i); const bf16* pr = P + (size_t)row * NP; const float* lo = LO + (size_t)row * NLO;
                rk_[i] = pr[PC_K + c]; rr_[i] = pr[PC_R + c]; rv_[i] = pr[PC_V + c]; rw_[i] = lo[dir * RW + c]; ra_[i] = lo[1024 + dir * RW + c]; rn_[i] = NRM[row * 8 + h]; }
#pragma unroll
            for (int i = 0; i < 16; ++i) asm volatile("" : "+v"(rk_[i]), "+v"(rr_[i]), "+v"(rv_[i]), "+v"(rw_[i]), "+v"(ra_[i]), "+v"(rn_[i]));
#pragma unroll
            for (int pq = 0; pq < 8; ++pq) { const int pz = 8 * hb + pq; float al[2], be[2], ka[2], rh[2], vv[2];
#pragma unroll
                for (int e = 0; e < 2; ++e) { const int i = 2 * pq + e;
                    const float kv = bf2f((unsigned short)rk_[i]), rv = bf2f((unsigned short)rr_[i]); vv[e] = bf2f((unsigned short)rv_[i]);
                    const float wl = w0c + rw_[i], aa = __builtin_amdgcn_rcpf(1.f + __expf(-(a0c + ra_[i]))), nrm = rn_[i];
                    const float lw = -0.6065306597f * __builtin_amdgcn_rcpf(1.f + __expf(-wl));
                    cs += lw; const float E = __expf(cs), Ei = __builtin_amdgcn_rcpf(E);
                    const float kkn = kv * kkc * nrm, kd = kv * (1.f + (aa - 1.f) * kac);
                    al[e] = kkn * Eprev; be[e] = kkn * aa * Ei; ka[e] = kd * Ei; rh[e] = rv * E; Eprev = E; }
                wAl[pz] = cvtpk(al[0], al[1]); wBe[pz] = cvtpk(be[0], be[1]); wKa[pz] = cvtpk(ka[0], ka[1]); wRh[pz] = cvtpk(rh[0], rh[1]); wV[pz] = cvtpk(vv[0], vv[1]); }
        }
        const float EC = Eprev;
#pragma unroll
        for (int pz = 0; pz < 16; ++pz) { wBp[pz] = cvtpk(bflo(wBe[pz]) * EC, bfhi(wBe[pz]) * EC); wKp[pz] = cvtpk(bflo(wKa[pz]) * EC, bfhi(wKa[pz]) * EC); }
        unsigned char* img = CH + (size_t)(((b * 8 + h) * 2 + dir) * SC_NCH + ci) * CH_BYTES;
        ((float*)(img + CH_EC))[lane] = EC;
        v4u cAl[2][2], cV[2][2], cBp[2][2], cKp[2][2], cRh[2][2];
        v4u tAl[4], tBe[4], tKa[4], tRh[4];
        cm_build(wAl, cAl); cm_build(wV, cV); cm_build(wBp, cBp); cm_build(wKp, cKp); cm_build(wRh, cRh);
        {   v4u cBe[2][2], cKa[2][2]; cm_build(wBe, cBe); cm_build(wKa, cKa);
#define TRANSPOSE(cZ, tZ) do { _Pragma("unroll") for (int ct = 0; ct < 2; ++ct) { f32x16 T_ = mm(cZ[ct][0], Id[0], zero16()); T_ = mm(cZ[ct][1], Id[1], T_); tZ[2 * ct] = cvtf<0, 0>(T_); tZ[2 * ct + 1] = cvtf<1, 0>(T_); } } while (0)
            TRANSPOSE(cAl, tAl); TRANSPOSE(cBe, tBe); TRANSPOSE(cKa, tKa); TRANSPOSE(cRh, tRh);
#undef TRANSPOSE
        }
#define PROD4(A, B) mm(A[3], B[3], mm(A[2], B[2], mm(A[1], B[1], mm(A[0], B[0], zero16()))))
        f32x16 XN = mask_acc<0>(PROD4(tAl, tBe), n, hh), XT = mask_acc<1>(PROD4(tBe, tAl), n, hh);
        v4u fLM[2], fGB[2], fGK[2];
        { const f32x16 t = mask_acc<1>(PROD4(tKa, tAl), n, hh); fLM[0] = cvtf<0, 0>(t); fLM[1] = cvtf<1, 0>(t); }
        { const f32x16 t = mask_acc<2>(PROD4(tBe, tRh), n, hh); fGB[0] = cvtf<0, 0>(t); fGB[1] = cvtf<1, 0>(t); }
        { const f32x16 t = mask_acc<2>(PROD4(tKa, tRh), n, hh); fGK[0] = cvtf<0, 0>(t); fGK[1] = cvtf<1, 0>(t); }
#undef PROD4
#pragma unroll
        for (int r = 0; r < 16; ++r) { XN[r] = -XN[r]; XT[r] = -XT[r]; }
        f32x16 RT = XT;
#pragma unroll
        for (int r = 0; r < 16; ++r) RT[r] += ((r & 3) + 8 * (r >> 2) + 4 * hh == n) ? 1.f : 0.f;
#pragma unroll
        for (int pw = 1; pw < 5; ++pw) {
            const v4u xn0 = cvtf<0, 0>(XN), xn1 = cvtf<1, 0>(XN), xt0 = cvtf<0, 0>(XT), xt1 = cvtf<1, 0>(XT);
            XN = mm(xt1, xn1, mm(xt0, xn0, zero16()));
            if (pw < 4) XT = mm(xn1, xt1, mm(xn0, xt0, zero16()));
            const v4u yn0 = cvtf<0, 0>(XN), yn1 = cvtf<1, 0>(XN), rt0 = cvtf<0, 0>(RT), rt1 = cvtf<1, 0>(RT);
            RT = mm(yn1, rt1, mm(yn0, rt0, RT));
        }
        const v4u fA0 = cvtf<0, 0>(RT), fA1 = cvtf<1, 0>(RT);
        f32x16 At[2], Vt[2];
#pragma unroll
        for (int t = 0; t < 2; ++t) {
            const f32x16 lmv = mm(fLM[1], cV[t][1], mm(fLM[0], cV[t][0], zero16()));
            At[t] = mm(fA1, cAl[t][1], mm(fA0, cAl[t][0], zero16()));
            Vt[t] = mm(fA1, cvtf<1, 0>(lmv), mm(fA0, cvtf<0, 0>(lmv), zero16()));
        }
#pragma unroll
        for (int kt1 = 0; kt1 < 2; ++kt1) { const v4u a0 = cvtf<0, 0>(At[kt1]), a1 = cvtf<1, 0>(At[kt1]);
#pragma unroll
            for (int kt2 = 0; kt2 < 2; ++kt2) { const f32x16 g = mm(a1, cBp[kt2][1], mm(a0, cBp[kt2][0], zero16()));
                st16(img, CH_G + ((kt2 * 2 + kt1) * 2 + 0) * 1024, lane, cvtf<0, 1>(g)); st16(img, CH_G + ((kt2 * 2 + kt1) * 2 + 1) * 1024, lane, cvtf<1, 1>(g)); } }
#pragma unroll
        for (int vt = 0; vt < 2; ++vt) { const v4u nv0 = cvtf<0, 1>(Vt[vt]), nv1 = cvtf<1, 1>(Vt[vt]);
#pragma unroll
            for (int kt = 0; kt < 2; ++kt) { f32x16 u = mm(cKp[kt][1], cV[vt][1], mm(cKp[kt][0], cV[vt][0], zero16())); u = mm(cBp[kt][1], nv1, mm(cBp[kt][0], nv0, u));
                st16(img, CH_UT + ((kt * 2 + vt) * 2 + 0) * 1024, lane, cvtf<0, 0>(u)); st16(img, CH_UT + ((kt * 2 + vt) * 2 + 1) * 1024, lane, cvtf<1, 0>(u)); }
            f32x16 y = mm(cV[vt][1], fGK[1], mm(cV[vt][0], fGK[0], zero16())); y = mm(nv1, fGB[1], mm(nv0, fGB[0], y));
            st16(img, CH_YL + (vt * 2 + 0) * 1024, lane, cvtf<0, 0>(y)); st16(img, CH_YL + (vt * 2 + 1) * 1024, lane, cvtf<1, 0>(y)); }
#pragma unroll
        for (int kt = 0; kt < 2; ++kt) { f32x16 q = mm(cRh[kt][1], Id[1], mm(cRh[kt][0], Id[0], zero16()));
            q = mm(cvtf<1, 1>(At[kt]), fGB[1], mm(cvtf<0, 1>(At[kt]), fGB[0], q));
            st16(img, CH_Q + (kt * 2 + 0) * 1024, lane, cvtf<0, 0>(q)); st16(img, CH_Q + (kt * 2 + 1) * 1024, lane, cvtf<1, 0>(q)); }
    }
}

__device__ __forceinline__ void ph_scan2(const KP& p, LAS unsigned char* lds, int l, int wave, int lane) {
    unsigned* sdone = (unsigned*)(p.ws + WS_CTL) + CW_SDONE + 64 * l;
#ifndef CQ_SLOT_WGS
#define CQ_SLOT_WGS 128
#endif
    if (blockIdx.x >= SC_NCHAIN * 2) {
        const int q0 = (l < 2 ? CQ_J1 : CQ_END0) + (l & 1) * CQ_SLOT_ITEMS;
        cq_static(p, lds, q0, q0 + CQ_SLOT_ITEMS, ((int)blockIdx.x - SC_NCHAIN * 2) * NWAVES + wave, ((int)gridDim.x - SC_NCHAIN * 2) * NWAVES, wave, lane); return; }
    const int chain = blockIdx.x >> 1, vt = blockIdx.x & 1, dir = chain & 1, h = (chain >> 1) & 7, b = chain >> 4;
    const int n = lane & 31, hh = lane >> 5;
    const unsigned char* CH = p.ws + WS_CH + (size_t)chain * SC_NCH * CH_BYTES; float* Y = (float*)(p.ws + WS_Y) + (size_t)dir * MROWS * RW + h * 64 + 32 * vt + 4 * hh;
    constexpr int NPIECE = 19, SLOT = NPIECE * 1024, NSLOT = 6, PD = 4, XCH = NSLOT * SLOT;
    int psrc[3], pdst[3];
#pragma unroll
    for (int j = 0; j < 3; ++j) { int f = wave + 8 * j; if (f >= NPIECE) f -= NPIECE;
        pdst[j] = f;
        psrc[j] = f < 12 ? f * 1024 : f < 16 ? CH_UT + ((((f - 12) >> 1) * 2 + vt) * 2 + ((f - 12) & 1)) * 1024 : f < 18 ? CH_YL + (vt * 2 + (f - 16)) * 1024 : CH_EC; }
    const int lane_off[3] = {pdst[0] == 18 ? (lane * 16) & 255 : lane * 16, pdst[1] == 18 ? (lane * 16) & 255 : lane * 16, pdst[2] == 18 ? (lane * 16) & 255 : lane * 16};
#define SC2_ISSUE(ci_, slot_) do { const unsigned char* im_ = CH + (size_t)(ci_) * CH_BYTES; LAS unsigned char* sl_ = lds + (slot_) * SLOT; \
        _Pragma("unroll") for (int j = 0; j < 3; ++j) __builtin_amdgcn_global_load_lds((const unsigned*)(im_ + psrc[j] + lane_off[j]), (LAS unsigned*)(sl_ + pdst[j] * 1024), 16, 0, 0); } while (0)
#define SC2_LD(slot_, piece_) (*(const LAS v4u*)(lds + (slot_) * SLOT + (piece_) * 1024 + lane * 16))
#define SC2_X(par_, k_) (*(LAS v4u*)(lds + XCH + (par_) * 4096 + (k_) * 1024 + lane * 16))
    f32x16 ST[2] = {zero16(), zero16()};
    SC2_ISSUE(0, 0); SC2_ISSUE(1, 1); SC2_ISSUE(2, 2); SC2_ISSUE(3, 3);
    for (int ci = 0; ci <= SC_NCH; ++ci) {
        const int slot = ci % NSLOT;
        asm volatile("s_waitcnt vmcnt(9)" ::: "memory");
        __builtin_amdgcn_s_barrier();
        asm volatile("" ::: "memory");
        { const int nx = ci + PD < SC_NCH ? ci + PD : SC_NCH - 1; SC2_ISSUE(nx, (ci + PD) % NSLOT); }
        if (wave == 0 && lane == 0 && ci == SC_NCH - 24) __hip_atomic_fetch_add(sdone, 1u, __ATOMIC_RELAXED, __HIP_MEMORY_SCOPE_AGENT);
        if (wave == 0 && ci < SC_NCH) {
            const v4u s00 = cvtf<0, 0>(ST[0]), s01 = cvtf<1, 0>(ST[0]), s10 = cvtf<0, 0>(ST[1]), s11 = cvtf<1, 0>(ST[1]);
            SC2_X(ci & 1, 0) = s00; SC2_X(ci & 1, 1) = s01; SC2_X(ci & 1, 2) = s10; SC2_X(ci & 1, 3) = s11;
#pragma unroll
            for (int kt2 = 0; kt2 < 2; ++kt2) { f32x16 a;
                const v4u u0 = SC2_LD(slot, 12 + kt2 * 2), u1 = SC2_LD(slot, 13 + kt2 * 2);
                a[0] = bflo(u0.x); a[1] = bfhi(u0.x); a[2] = bflo(u0.y); a[3] = bfhi(u0.y); a[4] = bflo(u0.z); a[5] = bfhi(u0.z); a[6] = bflo(u0.w); a[7] = bfhi(u0.w);
                a[8] = bflo(u1.x); a[9] = bfhi(u1.x); a[10] = bflo(u1.y); a[11] = bfhi(u1.y); a[12] = bflo(u1.z); a[13] = bfhi(u1.z); a[14] = bflo(u1.w); a[15] = bfhi(u1.w);
#pragma unroll
                for (int q = 0; q < 4; ++q) { const f32x4 ec = *(const LAS f32x4*)(lds + slot * SLOT + 18 * 1024 + (32 * kt2 + 8 * q + 4 * hh) * 4);
#pragma unroll
                    for (int e = 0; e < 4; ++e) a[4 * q + e] += ST[kt2][4 * q + e] * ec[e]; }
                a = mm(SC2_LD(slot, (kt2 * 2 + 0) * 2 + 0), s00, a); a = mm(SC2_LD(slot, (kt2 * 2 + 0) * 2 + 1), s01, a);
                a = mm(SC2_LD(slot, (kt2 * 2 + 1) * 2 + 0), s10, a); a = mm(SC2_LD(slot, (kt2 * 2 + 1) * 2 + 1), s11, a);
                ST[kt2] = a; }
        } else if (wave == 1 && ci >= 1) {
            const int cj = ci - 1, sj = cj % NSLOT, par = cj & 1; f32x16 y;
            { const v4u a = SC2_LD(sj, 16), c = SC2_LD(sj, 17);
              y[0] = bflo(a.x); y[1] = bfhi(a.x); y[2] = bflo(a.y); y[3] = bfhi(a.y); y[4] = bflo(a.z); y[5] = bfhi(a.z); y[6] = bflo(a.w); y[7] = bfhi(a.w);
              y[8] = bflo(c.x); y[9] = bfhi(c.x); y[10] = bflo(c.y); y[11] = bfhi(c.y); y[12] = bflo(c.z); y[13] = bfhi(c.z); y[14] = bflo(c.w); y[15] = bfhi(c.w); }
            y = mm(SC2_X(par, 0), SC2_LD(sj, 8), y); y = mm(SC2_X(par, 1), SC2_LD(sj, 9), y); y = mm(SC2_X(par, 2), SC2_LD(sj, 10), y); y = mm(SC2_X(par, 3), SC2_LD(sj, 11), y);
            const int row = scan_row(b, dir, SC_C * cj + n); float* yo = Y + (size_t)row * RW;
#pragma unroll
            for (int q = 0; q < 4; ++q) *(f32x4*)(yo + 8 * q) = (f32x4){y[4 * q], y[4 * q + 1], y[4 * q + 2], y[4 * q + 3]};
        }
        asm volatile("s_waitcnt lgkmcnt(0)" ::: "memory");
    }
    asm volatile("s_waitcnt vmcnt(0)" ::: "memory");
#undef SC2_ISSUE
#undef SC2_LD
#undef SC2_X
}

__device__ __forceinline__ float sum8(float v) { v += __shfl_xor(v, 1); v += __shfl_xor(v, 2); v += __shfl_xor(v, 4); return v; }
__device__ __forceinline__ void unpack8(v4u s, float (&v)[8]) { v[0] = bflo(s.x); v[1] = bfhi(s.x); v[2] = bflo(s.y); v[3] = bfhi(s.y); v[4] = bflo(s.z); v[5] = bfhi(s.z); v[6] = bflo(s.w); v[7] = bfhi(s.w); }
__device__ __forceinline__ void ld8f(const float* q, float (&v)[8]) { const f32x4 a = *(const f32x4*)q, b = *(const f32x4*)(q + 4); v[0] = a[0]; v[1] = a[1]; v[2] = a[2]; v[3] = a[3]; v[4] = b[0]; v[5] = b[1]; v[6] = b[2]; v[7] = b[3]; }
__device__ __forceinline__ v4u pack8(const float (&v)[8]) { v4u o; o.x = cvtpk(v[0], v[1]); o.y = cvtpk(v[2], v[3]); o.z = cvtpk(v[4], v[5]); o.w = cvtpk(v[6], v[7]); return o; }

__device__ __forceinline__ void ph_readout2(const KP& p, int l, int gw, int NGW, int lane) {
    const bf16* P = (const bf16*)(p.ws + WS_P); const float* LO = (const float*)(p.ws + WS_LO); const float* Y = (const float*)(p.ws + WS_Y);
    bf16* MI = (bf16*)(p.ws + WS_MIXIN); constexpr size_t PA = (size_t)MROWS * RW; const int c0 = lane * 8;
    for (int row = gw; row < MROWS; row += NGW) { const bf16* pr = P + (size_t)row * NP; const float* lo = LO + (size_t)row * NLO;
        int t, len; if (row < NLAT) { t = row & 63; len = 64; } else { t = (row - NLAT) & 255; len = 256; }
        const v4u kw = *(const v4u*)(pr + PC_K + c0), rw = *(const v4u*)(pr + PC_R + c0), vw = *(const v4u*)(pr + PC_V + c0);
        const v4u cbw = *(const v4u*)(pr + PC_CB + c0), ccw = *(const v4u*)(pr + PC_CC + c0), chw = *(const v4u*)(pr + PC_CH + c0);
        v4u ccp = (v4u){0u, 0u, 0u, 0u}, chp = ccp, ccn = ccp, chn = ccp;
        if (t > 0) { ccp = *(const v4u*)(pr - NP + PC_CC + c0); chp = *(const v4u*)(pr - NP + PC_CH + c0); }
        if (t < len - 1) { ccn = *(const v4u*)(pr + NP + PC_CC + c0); chn = *(const v4u*)(pr + NP + PC_CH + c0); }
        float yf[8], yb[8], la0[8], la1[8], g[8];
        ld8f(Y + (size_t)row * RW + c0, yf); ld8f(Y + PA + (size_t)row * RW + c0, yb); ld8f(lo + 1024 + c0, la0); ld8f(lo + 1536 + c0, la1); ld8f(lo + 2048 + c0, g);
        float a0[8], a1[8], ka[8], rkp[8], lg[8], lb[8];
        ld8f(p.in[I_A0] + (l * 2 + 0) * RW + c0, a0); ld8f(p.in[I_A0] + (l * 2 + 1) * RW + c0, a1); ld8f(p.in[I_KA] + l * RW + c0, ka); ld8f(p.in[I_RK] + l * RW + c0, rkp);
        ld8f(p.in[I_LNXG] + l * RW + c0, lg); ld8f(p.in[I_LNXB] + l * RW + c0, lb);
        float kv[8], rv[8], vv[8]; unpack8(kw, kv); unpack8(rw, rv); unpack8(vw, vv);
        float y[8], s = 0.f, rk = 0.f;
#pragma unroll
        for (int j = 0; j < 8; ++j) { y[j] = yf[j] + yb[j]; s += y[j]; const float av = sigm(a0[j] + la0[j]) + sigm(a1[j] + la1[j]); rk += rv[j] * kv[j] * (2.f + (av - 2.f) * ka[j]) * rkp[j]; }
        const float mu = sum8(s) * (1.f / 64.f); rk = sum8(rk); float q = 0.f;
#pragma unroll
        for (int j = 0; j < 8; ++j) { y[j] -= mu; q += y[j] * y[j]; }
        const float rstd = 1.f / sqrtf(sum8(q) * (1.f / 64.f) + GN_EPS);
        float o[8];
#pragma unroll
        for (int j = 0; j < 8; ++j) o[j] = (y[j] * rstd * lg[j] + lb[j] + rk * vv[j]) * g[j];
        *(v4u*)(MI + (size_t)row * D + c0) = pack8(o);
        float cb[8], cc[8], ch[8], pcc[8], pch[8], ncc[8], nch[8], w0[8], w1[8], w2[8];
        unpack8(cbw, cb); unpack8(ccw, cc); unpack8(chw, ch); unpack8(ccp, pcc); unpack8(chp, pch); unpack8(ccn, ncc); unpack8(chn, nch);
        const float* cw = p.in[I_CONVW] + (size_t)l * 3 * RW + c0; ld8f(cw, w0); ld8f(cw + RW, w1); ld8f(cw + 2 * RW, w2);
#pragma unroll
        for (int j = 0; j < 8; ++j) o[j] = cb[j] * (pcc[j] * pch[j] * w0[j] + cc[j] * ch[j] * w1[j] + ncc[j] * nch[j] * w2[j]);
        *(v4u*)(MI + (size_t)row * D + RW + c0) = pack8(o);
    }
}


template <int KS> __device__ __forceinline__ void lora_task(const bf16* pr, int col0, int fn, const bf16* wt, float* out, int ct0, int n, int hh) {
    v4u af[KS];
#pragma unroll
    for (int s = 0; s < KS; ++s) { const v4u w = *(const v4u*)(pr + col0 + 16 * s + 8 * hh); float v[8]; unpack8(w, v);
        if (fn == 0) {
#pragma unroll
            for (int j = 0; j < 8; ++j) v[j] = 1.f - 2.f * __builtin_amdgcn_rcpf(1.f + __expf(2.f * v[j])); }
        else if (fn == 2) {
#pragma unroll
            for (int j = 0; j < 8; ++j) v[j] = __builtin_amdgcn_rcpf(1.f + __expf(-v[j])); }
        af[s] = pack8(v); }
#pragma unroll 2
    for (int ct = ct0; ct < ct0 + 8; ++ct) { f32x16 acc = zero16(); const bf16* wb = wt + (size_t)(32 * ct + n) * (16 * KS) + 8 * hh;
#pragma unroll
        for (int s = 0; s < KS; ++s) acc = mm(af[s], *(const v4u*)(wb + 16 * s), acc);
#pragma unroll
        for (int r = 0; r < 16; ++r) out[(size_t)((r & 3) + 8 * (r >> 2) + 4 * hh) * NLO + 32 * ct + n] = acc[r]; }
}
__device__ __forceinline__ void ph_lora(const KP& p, int l, int gw, int NGW, int lane) {
    const bf16* P = (const bf16*)(p.ws + WS_P); float* LO = (float*)(p.ws + WS_LO); float* NRM = (float*)(p.ws + WS_RKS);
    const bf16* LW = (const bf16*)(p.ws + WS_LORA) + (size_t)l * LORAW_PER_LAYER; const int n = lane & 31, hh = lane >> 5;
    for (int task = gw; task < (MROWS / 32) * 10; task += NGW) { const int half = task & 1, grp = (task >> 1) % 5, rb = task / 10;
        const bf16* pr = P + (size_t)(rb * 32 + n) * NP; float* out = LO + (size_t)(rb * 32) * NLO + grp * 512;
        if (grp < 4) lora_task<4>(pr, grp < 2 ? PC_WD + 64 * grp : PC_AD + 64 * (grp - 2), grp < 2 ? 0 : 1, LW + (size_t)grp * 512 * 64, out, half * 8, n, hh);
        else lora_task<8>(pr, PC_GD, 2, LW + (size_t)4 * 512 * 64, out, half * 8, n, hh); }
    float kkc[8]; ld8f(p.in[I_KK] + l * RW + lane * 8, kkc);
    for (int row = gw; row < MROWS; row += NGW) { const v4u kw = *(const v4u*)(P + (size_t)row * NP + PC_K + lane * 8); float kv[8]; unpack8(kw, kv); float ss = 0.f;
#pragma unroll
        for (int j = 0; j < 8; ++j) { const float t = kv[j] * kkc[j]; ss += t * t; }
        ss = sum8(ss); if ((lane & 7) == 0) NRM[row * 8 + (lane >> 3)] = 1.f / fmaxf(sqrtf(ss), 1e-12f); }
}

__device__ __forceinline__ void ph_moe_gather(const KP& p, int l, int gw, int NGW, int lane) {
    const unsigned* gcnt = (const unsigned*)(p.ws + WS_CTL) + CW_GCNT + 64 * (l >> 1);
    int cnt[8], pb[9]; pb[0] = 0;
#pragma unroll
    for (int e = 0; e < 8; ++e) { cnt[e] = (int)gcnt[e]; pb[e + 1] = pb[e] + ((cnt[e] + 255) & ~255); }
    const unsigned* rowlist = (const unsigned*)(p.ws + WS_ROWLIST); const float* wsel = (const float*)(p.ws + WS_WSEL); float* wsort = (float*)(p.ws + WS_WSORT);
    const bf16* H = (const bf16*)(p.ws + WS_H); bf16* HG = (bf16*)(p.ws + WS_HG);
    for (int pos = gw; pos < pb[8]; pos += NGW) {
        int e = 0, base = 0, ce = cnt[0];
#pragma unroll
        for (int k = 1; k < 8; ++k) if (pos >= pb[k]) { e = k; base = pb[k]; ce = cnt[k]; }
        const int rank = pos - base; v4u a = (v4u){0u, 0u, 0u, 0u}, b = a; float w = 0.f;
        if (rank < ce) { const unsigned ent = rowlist[(size_t)e * MROWS + rank]; const v4u* src = (const v4u*)(H + (size_t)(ent >> 1) * D); a = src[lane]; b = src[64 + lane]; w = wsel[ent]; }
        v4u* dst = (v4u*)(HG + (size_t)pos * D); dst[lane] = a; dst[64 + lane] = b;
        if (lane == 0) wsort[pos] = w;
    }
}

__device__ __forceinline__ void ph_ln(const KP& p, LAS unsigned char* lds, int l, int which, int tid, int wave, int gw, int NGW, int lane) {
    const float* modv = (const float*)(p.ws + WS_MODV); float* X = (float*)(p.ws + WS_X); bf16* H = (bf16*)(p.ws + WS_H);
    const bf16* BR = (const bf16*)(p.ws + (which == 0 ? WS_MIXO : WS_F)); const float* BP = (const float*)(p.ws + (which == 0 ? WS_MIXP : WS_FP));
    const float* lg = p.in[which == 0 ? I_LN1G : I_LN2G] + l * D; const float* lb = p.in[which == 0 ? I_LN1B : I_LN2B] + l * D;
    const bool moe = (which == 0) && (l & 1); const bool last = (which == 1) && (l == DEPTH - 1); const bool moe_out = (which == 1) && (l & 1);
    LAS int* lcnt = (LAS int*)lds;
    LAS int* lsel = (LAS int*)(lds + 64);
    int nloc = 0;
    if (moe) { if (tid < 16) lcnt[tid] = 0; __syncthreads(); }
    int pbs[9]; pbs[0] = 0;
    if (moe_out) { const unsigned* gcnt = (const unsigned*)(p.ws + WS_CTL) + CW_GCNT + 64 * (l >> 1);
#pragma unroll
        for (int e = 0; e < 8; ++e) pbs[e + 1] = pbs[e] + (int)((gcnt[e] + 255u) & ~255u); }
    f32x4 gt[4], g4[4], b4[4], sh[4], sc[4]; ld_row(lg, lane, g4); ld_row(lb, lane, b4);
    for (int it = 0; it < 9; ++it) {
        if (it == 8 && gw >= NCTX) break;
        const int row = it < 8 ? (gw >> 9) * SEQ + (gw & 511) + 512 * it : NLAT + gw;
        const int mr = mod_row(row); const float* mv = modv + (size_t)(l * 5 + mr) * NMOD;
        if (it == 0 || it == 8) { ld_row(mv + (which == 0 ? 2048 : 5120), lane, gt);
            if (!last) { const float* mv2 = which == 0 ? mv + 3072 : modv + (size_t)((l + 1) * 5 + mr) * NMOD; ld_row(mv2, lane, sh); ld_row(mv2 + 1024, lane, sc); } }
        f32x4 x[4], br[4], t[4]; ld_row(X + (size_t)row * D, lane, x);
        if (moe_out) { const int* ts = (const int*)(p.ws + WS_TOKSEL) + row * 4; const int e0 = ts[0], r0 = ts[1], e1 = ts[2], r1 = ts[3]; int b0 = 0, b1 = 0;
#pragma unroll
            for (int k = 1; k < 8; ++k) { if (e0 >= k) b0 = pbs[k]; if (e1 >= k) b1 = pbs[k]; }
            f32x4 ba[4], bb[4]; const int q0 = b0 + r0, q1 = b1 + r1; constexpr int MM = MOE_MAIN_PANELS * 256;
            if (q0 < MM) ld_row_bf16(BR + (size_t)q0 * D, lane, ba); else ld_row_parts<4>(BP + (size_t)(q0 - MM) * D, (size_t)MOE_TAIL_ROWS * D, lane, ba);
            if (q1 < MM) ld_row_bf16(BR + (size_t)q1 * D, lane, bb); else ld_row_parts<4>(BP + (size_t)(q1 - MM) * D, (size_t)MOE_TAIL_ROWS * D, lane, bb);
#pragma unroll
            for (int j = 0; j < 4; ++j) br[j] = ba[j] + bb[j]; }
        else if (row < NLAT) ld_row_bf16(BR + (size_t)row * D, lane, br);
        else if (which == 0) ld_row_parts<4>(BP + (size_t)(row - NLAT) * D, (size_t)NCTX * D, lane, br);
        else ld_row_parts<7>(BP + (size_t)(row - NLAT) * D, (size_t)NCTX * D, lane, br);
        float s = 0.f;
#pragma unroll
        for (int j = 0; j < 4; ++j) { t[j] = DN_ALPHA * x[j] + gt[j] * br[j]; s += (t[j][0] + t[j][1]) + (t[j][2] + t[j][3]); }
        const float mean = wave_sum(s) * (1.f / D); float s2 = 0.f;
#pragma unroll
        for (int j = 0; j < 4; ++j) { t[j] = t[j] - mean; s2 += (t[j][0] * t[j][0] + t[j][1] * t[j][1]) + (t[j][2] * t[j][2] + t[j][3] * t[j][3]); }
        const float rstd = 1.f / sqrtf(wave_sum(s2) * (1.f / D) + LN_EPS);
#pragma unroll
        for (int j = 0; j < 4; ++j) x[j] = t[j] * rstd * g4[j] + b4[j];
        if (last) { if (row < NLAT) st_row(p.out + (size_t)row * D, lane, x); continue; }
        st_row(X + (size_t)row * D, lane, x);
        f32x4 hh[4];
#pragma unroll
        for (int j = 0; j < 4; ++j) hh[j] = x[j] * (1.f + sc[j]) + sh[j];
        st_row_bf16(H + (size_t)row * D, lane, hh);
        if (moe) {
            const float* rw = p.in[I_RTW] + (size_t)(l >> 1) * D * NE; float lgt[8];
#pragma unroll
            for (int e = 0; e < 8; ++e) lgt[e] = 0.f;
#pragma unroll
            for (int j = 0; j < 4; ++j)
#pragma unroll
                for (int i = 0; i < 4; ++i) { const f32x4* wp = (const f32x4*)(rw + (size_t)(4 * lane + 256 * j + i) * NE); const f32x4 w0 = wp[0], w1 = wp[1]; const float hv = hh[j][i];
                    lgt[0] += hv * w0[0]; lgt[1] += hv * w0[1]; lgt[2] += hv * w0[2]; lgt[3] += hv * w0[3]; lgt[4] += hv * w1[0]; lgt[5] += hv * w1[1]; lgt[6] += hv * w1[2]; lgt[7] += hv * w1[3]; }
#pragma unroll
            for (int e = 0; e < 8; ++e) lgt[e] = wave_sum(lgt[e]) + p.in[I_RTB][(l >> 1) * NE + e];
            float v0 = lgt[0]; int i0 = 0;
#pragma unroll
            for (int e = 1; e < 8; ++e) if (lgt[e] > v0) { v0 = lgt[e]; i0 = e; }
            float v1 = -3.0e38f; int i1 = -1;
#pragma unroll
            for (int e = 0; e < 8; ++e) if (e != i0 && lgt[e] > v1) { v1 = lgt[e]; i1 = e; }
            const float w0 = 1.f / (1.f + expf(v1 - v0)), w1 = 1.f - w0;
            if (lane == 0) { const int lr0 = __hip_atomic_fetch_add(lcnt + i0, 1, __ATOMIC_RELAXED, __HIP_MEMORY_SCOPE_WORKGROUP), lr1 = __hip_atomic_fetch_add(lcnt + i1, 1, __ATOMIC_RELAXED, __HIP_MEMORY_SCOPE_WORKGROUP); const int li = nloc * NWAVES + wave;
                lsel[li * 8 + 0] = row; lsel[li * 8 + 1] = i0; lsel[li * 8 + 2] = lr0; lsel[li * 8 + 3] = i1; lsel[li * 8 + 4] = lr1;
                ((float*)(p.ws + WS_WSEL))[row * 2] = w0; ((float*)(p.ws + WS_WSEL))[row * 2 + 1] = w1; }
            ++nloc;
        }
    }
    if (moe) {
        __syncthreads();
        unsigned* gcnt = (unsigned*)(p.ws + WS_CTL) + CW_GCNT + 64 * (l >> 1);
        if (tid < 8) lcnt[8 + tid] = (int)__hip_atomic_fetch_add(gcnt + tid, (unsigned)lcnt[tid], __ATOMIC_RELAXED, __HIP_MEMORY_SCOPE_AGENT);
        __syncthreads();
        unsigned* rowlist = (unsigned*)(p.ws + WS_ROWLIST); int* toksel = (int*)(p.ws + WS_TOKSEL);
        if (tid < 16 * NWAVES) { const int k = tid / NWAVES, w = tid % NWAVES; if (k < 8 || (k == 8 && (int)blockIdx.x * NWAVES + w < NCTX)) { const int li = k * NWAVES + w;
            const int row = lsel[li * 8 + 0], e0 = lsel[li * 8 + 1], r0 = lcnt[8 + e0] + lsel[li * 8 + 2], e1 = lsel[li * 8 + 3], r1 = lcnt[8 + e1] + lsel[li * 8 + 4];
            rowlist[(size_t)e0 * MROWS + r0] = (unsigned)row * 2u; rowlist[(size_t)e1 * MROWS + r1] = (unsigned)row * 2u + 1u;
            toksel[row * 4 + 0] = e0; toksel[row * 4 + 1] = r0; toksel[row * 4 + 2] = e1; toksel[row * 4 + 3] = r1; } }
    }
}

__global__ void __launch_bounds__(NWAVES * 64, 2) fwd_kernel(KP p) {
    extern __shared__ __attribute__((aligned(16))) unsigned char lds_raw[];
    LAS unsigned char* lds = (LAS unsigned char*)lds_raw;
    volatile LAS unsigned* MISC = (volatile LAS unsigned*)(lds + MISC_OFF);
    const int G = gridDim.x, NGW = G * NWAVES;
    for (int u = threadIdx.x; u < (LDS_BYTES - LDSCTL_OFF) / 4; u += NWAVES * 64) ((LAS unsigned*)(lds + LDSCTL_OFF))[u] = 0u;
    __syncthreads();
    unsigned* ctl = (unsigned*)(p.ws + WS_CTL);
    const bool single = p.ph < 0;
    XcdBarrier bar; bar.bar = ctl + CW_BAR; bar.x = 0; bar.st = nullptr;
    if (single) bar = xcd_barrier_post(ctl + CW_BAR, MISC + 8);
    int phc = 0;
#ifndef PROBE_DUP
#define PROBE_DUP 0
#endif
#define REP(bit) for (int rep_ = 0; rep_ < ((PROBE_DUP & (bit)) ? 2 : 1); ++rep_)
#define RUN() (single || p.ph == phc)
#define FRESH() int tid = threadIdx.x; asm volatile("" : "+v"(tid)); const int lane = tid & 63, wave = __builtin_amdgcn_readfirstlane(tid >> 6), gw = blockIdx.x * NWAVES + wave; (void)lane; (void)gw
#define SEAM() do { if (single) { XcdBarrier b2_ = bar; asm volatile("" : "+s"(b2_.bar)); xcd_barrier(b2_); if (PROBE_DUP & 32) { XcdBarrier b3_ = bar; asm volatile("" : "+s"(b3_.bar)); xcd_barrier(b3_); } } ++phc; } while (0)

    bf16* H = (bf16*)(p.ws + WS_H); bf16* Pm = (bf16*)(p.ws + WS_P);
    REP(4) if (RUN()) { FRESH(); ph_modvec(p, lds, tid); __syncthreads(); ph_convert(p, lds, gw, NGW, wave, lane); cq_static(p, lds, 0, CQ_J1, gw, NGW, wave, lane); }
    SEAM();
    if (RUN()) { FRESH(); ph_init_rows(p, gw, NGW, lane); }
    SEAM();
    for (int l = 0; l < DEPTH; ++l) {
         if (RUN()) { pg8::Gemm g{H, (const bf16*)(p.ws + WS_WIN) + (size_t)l * NP * D, MROWS, NP, D, D}; pg8::StaticOrder S; S.init(MROWS, NP, G, (int)blockIdx.x);
            pg8::EpiBf16<0> E{Pm, NP, nullptr, 0, 0, 1.f}; pg8::gemm_phase<pg8::EpiBf16<0>, pg8::StaticOrder, true, true>(lds, g, S, E); }
        SEAM();
        REP(8) if (RUN()) { FRESH(); ph_lora(p, l, gw, NGW, lane); }
        SEAM();
        REP(1) if (RUN()) { FRESH(); ph_scan1(p, l, gw, NGW, lane); }
        SEAM();
        REP(2) if (RUN()) { FRESH(); ph_scan2(p, lds, l, wave, lane); }
        SEAM();
        REP(64) if (RUN()) { FRESH(); ph_readout2(p, l, gw, NGW, lane); }
        SEAM();
         if (RUN()) {
            { pg8::Gemm g{(const bf16*)(p.ws + WS_MIXIN), (const bf16*)(p.ws + WS_WOUT) + (size_t)l * D * D, NLAT, D, D, D}; pg8::StaticOrder S; S.init(NLAT, D, G, (int)blockIdx.x);
              pg8::EpiBf16<0> E{(bf16*)(p.ws + WS_MIXO), D, nullptr, 0, 0, 1.f}; pg8::gemm_phase<pg8::EpiBf16<0>, pg8::StaticOrder, true, true>(lds, g, S, E); }
            { pg8::Gemm g{(const bf16*)(p.ws + WS_MIXIN), (const bf16*)(p.ws + WS_WOUT) + (size_t)l * D * D, NCTX, D, D / 4, D}; pg8::SplitOrder S{NCTX / 256, D / 256, 4, G, (int)blockIdx.x, NLAT / 256, 0, 0, 0, 0, 0, 0, 0, 0};
              pg8::EpiPart E{(float*)(p.ws + WS_MIXP), D, (size_t)NCTX * D, NLAT / 256}; pg8::gemm_phase<pg8::EpiPart, pg8::SplitOrder, true, true>(lds, g, S, E); }
        }
        SEAM();
        if (RUN()) { FRESH(); ph_ln(p, lds, l, 0, tid, wave, gw, NGW, lane); }
        SEAM();
        if ((l & 1) == 0) {
            const int fi = l >> 1;
             if (RUN()) { pg8::Gemm g{H, (const bf16*)(p.ws + WS_F13) + (size_t)fi * 2 * DFF * D, MROWS, 2 * DFF, D, D}; pg8::StaticOrder S; S.init(MROWS, 2 * DFF, G, (int)blockIdx.x);
                pg8::EpiSwiGLU E{(bf16*)(p.ws + WS_ACT), DFF, nullptr, 0}; pg8::gemm_phase<pg8::EpiSwiGLU, pg8::StaticOrder, true, true>(lds, g, S, E); }
            SEAM();
             if (RUN()) {
                { pg8::Gemm g{(const bf16*)(p.ws + WS_ACT), (const bf16*)(p.ws + WS_F2) + (size_t)fi * D * DFF, NLAT, D, DFF, DFF}; pg8::StaticOrder S; S.init(NLAT, D, G, (int)blockIdx.x);
                  pg8::EpiBf16<0> E{(bf16*)(p.ws + WS_F), D, nullptr, 0, 0, 1.f}; pg8::gemm_phase<pg8::EpiBf16<0>, pg8::StaticOrder, true, true>(lds, g, S, E); }
                { pg8::Gemm g{(const bf16*)(p.ws + WS_ACT), (const bf16*)(p.ws + WS_F2) + (size_t)fi * D * DFF, NCTX, D, DFF / 7, DFF}; pg8::SplitOrder S{NCTX / 256, D / 256, 7, G, (int)blockIdx.x, NLAT / 256, 0, 0, 0, 0, 0, 0, 0, 0};
                  pg8::EpiPart E{(float*)(p.ws + WS_FP), D, (size_t)NCTX * D, NLAT / 256}; pg8::gemm_phase<pg8::EpiPart, pg8::SplitOrder, true, true>(lds, g, S, E); }
            }
            SEAM();
        } else {
            REP(4) if (RUN()) { FRESH(); cq_static(p, lds, (l == 1 ? CQ_J1 : CQ_END0) + 2 * CQ_SLOT_ITEMS, l == 1 ? CQ_END0 : CQ_END1, gw, NGW, wave, lane); }
            SEAM();
            if (RUN()) { FRESH(); ph_moe_gather(p, l, gw, NGW, lane); }
            SEAM();
            {   const unsigned* gcnt = (const unsigned*)(p.ws + WS_CTL) + CW_GCNT + 64 * (l >> 1); int pbp[9]; pbp[0] = 0;
#pragma unroll
                for (int e = 0; e < 8; ++e) pbp[e + 1] = pbp[e] + (int)((gcnt[e] + 255u) >> 8);
                const int mrows = pbp[8] * 256;
                 if (RUN()) { pg8::Gemm g{(const bf16*)(p.ws + WS_HG), (const bf16*)(p.ws + WS_MOEW13), mrows, 2 * DFF, D, D}; pg8::MoeOrder S; S.init(mrows, 2 * DFF, G, (int)blockIdx.x);
                    S.pb1 = pbp[1]; S.pb2 = pbp[2]; S.pb3 = pbp[3]; S.pb4 = pbp[4]; S.pb5 = pbp[5]; S.pb6 = pbp[6]; S.pb7 = pbp[7]; S.estride = (size_t)2 * DFF * D;
                    pg8::EpiSwiGLU E{(bf16*)(p.ws + WS_ACT), DFF, (const float*)(p.ws + WS_WSORT), 1}; pg8::gemm_phase<pg8::EpiSwiGLU, pg8::MoeOrder, true, true>(lds, g, S, E); }
                SEAM();
                 if (RUN()) {
                    { pg8::Gemm g{(const bf16*)(p.ws + WS_ACT), (const bf16*)(p.ws + WS_MOEW2), MOE_MAIN_PANELS * 256, D, DFF, DFF}; pg8::MoeOrder S; S.init(MOE_MAIN_PANELS * 256, D, G, (int)blockIdx.x);
                      S.pb1 = pbp[1]; S.pb2 = pbp[2]; S.pb3 = pbp[3]; S.pb4 = pbp[4]; S.pb5 = pbp[5]; S.pb6 = pbp[6]; S.pb7 = pbp[7]; S.estride = (size_t)D * DFF;
                      pg8::EpiBf16<0> E{(bf16*)(p.ws + WS_F), D, nullptr, 0, 0, 1.f}; pg8::gemm_phase<pg8::EpiBf16<0>, pg8::MoeOrder, true, true>(lds, g, S, E); }
                    { const int nT = pbp[8] - MOE_MAIN_PANELS;
                      pg8::Gemm g{(const bf16*)(p.ws + WS_ACT), (const bf16*)(p.ws + WS_MOEW2), nT * 256, D, DFF / 4, DFF}; pg8::SplitOrder S{nT, D / 256, 4, G, (int)blockIdx.x, MOE_MAIN_PANELS, pbp[1], pbp[2], pbp[3], pbp[4], pbp[5], pbp[6], pbp[7], (size_t)D * DFF};
                      pg8::EpiPart E{(float*)(p.ws + WS_FP), D, (size_t)MOE_TAIL_ROWS * D, MOE_MAIN_PANELS}; pg8::gemm_phase<pg8::EpiPart, pg8::SplitOrder, true, true>(lds, g, S, E); }
                }
                SEAM();
            }
        }
        if (RUN()) { FRESH(); ph_ln(p, lds, l, 1, tid, wave, gw, NGW, lane); }
        SEAM();
    }
#undef RUN
#undef SEAM
}

#ifndef MK_PER_PHASE
#define MK_PER_PHASE 0
#endif
extern "C" void kernel_launch(void* const* d_in, const int* in_sizes, int n_in, void* d_out, int out_size, void* d_ws, size_t ws_size, hipStream_t stream) {
    static int grid = 0;
    if (grid == 0) {
        if (n_in != N_IN || in_sizes[0] != NLAT * D || out_size != NLAT * D || ws_size < WS_NEED) { fprintf(stderr, "kernel_launch: unexpected shapes / workspace (%d inputs, ws %zu, need %zu)\n", n_in, ws_size, (size_t)WS_NEED); grid = -1; return; }
        int dev = 0, cus = 0, per_cu = 0;
        if (hipGetDevice(&dev) != hipSuccess || hipDeviceGetAttribute(&cus, hipDeviceAttributeMultiprocessorCount, dev) != hipSuccess) { grid = -1; return; }
        if (hipFuncSetAttribute((const void*)fwd_kernel, hipFuncAttributeMaxDynamicSharedMemorySize, LDS_BYTES) != hipSuccess) { fprintf(stderr, "kernel_launch: hipFuncSetAttribute failed\n"); grid = -1; return; }
        if (hipOccupancyMaxActiveBlocksPerMultiprocessor(&per_cu, (const void*)fwd_kernel, NWAVES * 64, LDS_BYTES) != hipSuccess || per_cu < 1) fprintf(stderr, "kernel_launch: occupancy query says %d\n", per_cu);
        (void)hipGetLastError();
        grid = cus;
        if (grid != 256) { fprintf(stderr, "kernel_launch: built for a 256-CU device, found %d CUs\n", cus); grid = -1; return; }
    }
    if (grid < 0) return;
    if (hipMemsetAsync((char*)d_ws + WS_CTL, 0, CTL_BYTES, stream) != hipSuccess) return;
    KP p{};
    for (int i = 0; i < N_IN; ++i) p.in[i] = (const float*)d_in[i];
    p.out = (float*)d_out; p.ws = (unsigned char*)d_ws; p.pad = 0;
#if MK_PER_PHASE
    const int nph = 2 + 2 * 11 + 2 * 13;
    for (int ph = 0; ph < nph; ++ph) { p.ph = ph; hipLaunchKernelGGL(fwd_kernel, dim3(grid), dim3(NWAVES * 64), LDS_BYTES, stream, p); }
#else
    p.ph = -1;
    hipLaunchKernelGGL(fwd_kernel, dim3(grid), dim3(NWAVES * 64), LDS_BYTES, stream, p);
#endif
}
```

```cpp
#include <hip/hip_runtime.h>
#define PROBE_DUP 0
#define CQ_SLOT_WGS 0
#define CQ_SLOT_ITEMS 3500
#include <cstdio>
#include <cstdint>
namespace pg8 {
#define PG8_LAS __attribute__((address_space(3)))
typedef unsigned short bf16_t;
typedef short bf16x8 __attribute__((ext_vector_type(8)));
typedef float f32x4 __attribute__((ext_vector_type(4)));
typedef unsigned u32x4 __attribute__((ext_vector_type(4)));
constexpr int BM = 256, BK = 64, HALF = 128, HTB = HALF * BK * 2  , STAGE_BYTES = 8 * HTB, NXCD = 8, WGM = 8;

__host__ __device__ __forceinline__ int lds_byte(int r, int c) { const int st = (r >> 4) * 2 + (c >> 5), rr = r & 15, cc = c & 31, ob = rr * 64 + cc * 2; return st * 1024 + (ob ^ (((ob >> 9) & 1) << 5)); }
__host__ __device__ __forceinline__ void stage_rc(int b, int& R, int& C) { const int st = b / 1024, sb = b % 1024, swz = sb ^ (((sb >> 9) & 1) << 5); R = (st >> 1) * 16 + swz / 64; C = (st & 1) * 32 + (swz % 64) / 2; }
__host__ __device__ __forceinline__ int perm32(int rho) { const int n = rho >> 4, i = rho & 15; return 8 * (i >> 2) + 4 * n + (i & 3); }

struct Unit { int pm, pn, ks; };
struct Gemm { const bf16_t* A; const bf16_t* Bt; int M, N, K, ld; };

struct StaticOrder {
    int nM, nN, nwg, G, c;
    __host__ __device__ void init(int M, int N, int G_, int c_) { nM = M / BM; nN = N / BM; nwg = nM * nN; G = G_; c = c_; }
    __host__ __device__ bool next(int i, Unit& u) const {
        const long L = (long)i * G + c; if (L >= nwg) return false;
        int wgid = (int)L; { const int q = nwg / NXCD, r = nwg % NXCD, xcd = wgid % NXCD, off = wgid / NXCD; wgid = (xcd < r ? xcd * (q + 1) : r * (q + 1) + (xcd - r) * q) + off; }
        const int nig = WGM * nN, gid = wgid / nig, fm = gid * WGM, gsz = (nM - fm) < WGM ? (nM - fm) : WGM;
        u.pm = fm + ((wgid % nig) % gsz); u.pn = (wgid % nig) / gsz; u.ks = 0; return true;
    }
    __device__ __forceinline__ const char* abase(const Gemm& g, const Unit& u, size_t tstep) const { return (const char*)g.A + (size_t)u.pm * tstep; }
    __device__ __forceinline__ const char* bbase(const Gemm& g, const Unit& u, size_t tstep) const { return (const char*)g.Bt + (size_t)u.pn * tstep; }
    __device__ __forceinline__ void a_ready(const Unit&) const {}
    __device__ __forceinline__ void done(const Unit&) const {}
};

__device__ __forceinline__ unsigned cvt_pk_bf16(float lo, float hi) { unsigned r; asm volatile("v_cvt_pk_bf16_f32 %0, %1, %2" : "=v"(r) : "v"(lo), "v"(hi)); return r; }
typedef float f32x2 __attribute__((ext_vector_type(2)));
__device__ __forceinline__ f32x2 gelu_pk(f32x2 v) {
    const f32x2 av = __builtin_elementwise_abs(v), d = av * 0.2316418882f + 1.0f;
    f32x2 t; t.x = __builtin_amdgcn_rcpf(d.x); t.y = __builtin_amdgcn_rcpf(d.y);
    f32x2 q = t * 0.5307027145f + (-0.7265760135f); q = q * t + 0.7107068705f; q = q * t + (-0.142248368f); q = q * t + 0.127414796f; q = q * t;
    const f32x2 s = (v * v) * (-0.72134752044f);
    f32x2 e; e.x = __builtin_amdgcn_exp2f(s.x); e.y = __builtin_amdgcn_exp2f(s.y);
    const f32x2 m = v * (q * e), r = v - m;
    f32x2 o; o.x = v.x < 0.f ? m.x : r.x; o.y = v.y < 0.f ? m.y : r.y; return o;
}

template <int ACT  > struct EpiBf16 {
    static constexpr bool PERM = true, AFTER_DRAIN = false; static_assert(ACT == 0 || ACT == 1, "EpiBf16: ACT is 0 (none) or 1 (gelu_pk)");
    bf16_t* O; int ldc; const float* bias; int split_cols; size_t split_stride; float scale0;
    __device__ __forceinline__ void operator()(const f32x4 (&acc)[2][2][4][2], const Unit& u, int wr, int wc, int fr, int fq) const {
        const int row0 = u.pm * BM + wr * 64 + fr; int colt = u.pn * BM; bf16_t* base = O;
        float sc = 1.f; if (split_cols) { const int t = colt / split_cols; base += (size_t)t * split_stride; colt -= t * split_cols; if (t == 0) sc = scale0; }
        const int col0 = colt + wc * 32 + 8 * fq, bcol0 = u.pn * BM + wc * 32 + 8 * fq;
        f32x4 bv[2][2];
#pragma unroll
        for (int bj = 0; bj < 2; ++bj)
#pragma unroll
            for (int n = 0; n < 2; ++n) bv[bj][n] = bias ? *(const f32x4*)(bias + bcol0 + bj * HALF + 4 * n) : (f32x4){0.f, 0.f, 0.f, 0.f};
#pragma unroll
        for (int ai = 0; ai < 2; ++ai)
#pragma unroll
            for (int m = 0; m < 4; ++m) { bf16_t* rowp = base + (size_t)(row0 + ai * HALF + m * 16) * ldc + col0;
#pragma unroll
                for (int bj = 0; bj < 2; ++bj) { f32x4 v0 = acc[ai][bj][m][0] + bv[bj][0], v1 = acc[ai][bj][m][1] + bv[bj][1];
                    if (ACT == 1) { f32x2 a = gelu_pk((f32x2){v0[0], v0[1]}), b = gelu_pk((f32x2){v0[2], v0[3]}), c = gelu_pk((f32x2){v1[0], v1[1]}), d = gelu_pk((f32x2){v1[2], v1[3]});
                        v0 = (f32x4){a.x, a.y, b.x, b.y}; v1 = (f32x4){c.x, c.y, d.x, d.y}; }
                    v0 = v0 * sc; v1 = v1 * sc; u32x4 w; w.x = cvt_pk_bf16(v0[0], v0[1]); w.y = cvt_pk_bf16(v0[2], v0[3]); w.z = cvt_pk_bf16(v1[0], v1[1]); w.w = cvt_pk_bf16(v1[2], v1[3]);
                    *(u32x4*)(rowp + bj * HALF) = w; } }
    }
};
struct EpiF32 {
    static constexpr bool PERM = false, AFTER_DRAIN = false;
    float* C; int ldc; int accum;
    __device__ __forceinline__ void operator()(const f32x4 (&acc)[2][2][4][2], const Unit& u, int wr, int wc, int fr, int fq) const {
        const int row0 = u.pm * BM + wr * 64 + fr, col0 = u.pn * BM + wc * 32 + 4 * fq;
#pragma unroll
        for (int ai = 0; ai < 2; ++ai)
#pragma unroll
            for (int m = 0; m < 4; ++m) { float* rowp = C + (size_t)(row0 + ai * HALF + m * 16) * ldc + col0;
#pragma unroll
                for (int bj = 0; bj < 2; ++bj)
#pragma unroll
                    for (int n = 0; n < 2; ++n) { f32x4 v = acc[ai][bj][m][n]; if (accum) v += *(const f32x4*)(rowp + bj * HALF + n * 16); *(f32x4*)(rowp + bj * HALF + n * 16) = v; } }
    }
};
struct EpiSwiGLU {
    static constexpr bool PERM = true, AFTER_DRAIN = false;
    bf16_t* O; int ldo; const float* rowscale; int rs_stride;
    __device__ __forceinline__ void operator()(const f32x4 (&acc)[2][2][4][2], const Unit& u, int wr, int wc, int fr, int fq) const {
        typedef unsigned u32x2v __attribute__((ext_vector_type(2)));
        const int row0 = u.pm * BM + wr * 64 + fr; const int ch0 = (u.pn * BM + wc * 32 + 8 * fq) >> 1;
#pragma unroll
        for (int ai = 0; ai < 2; ++ai)
#pragma unroll
            for (int m = 0; m < 4; ++m) { const int row = row0 + ai * HALF + m * 16; bf16_t* rowp = O + (size_t)row * ldo + ch0;
                const float rs = rowscale ? rowscale[(size_t)row * rs_stride] : 1.f;
#pragma unroll
                for (int bj = 0; bj < 2; ++bj) { const f32x4 a = acc[ai][bj][m][0], b = acc[ai][bj][m][1]; f32x4 o;
#pragma unroll
                    for (int i = 0; i < 4; ++i) o[i] = a[i] * __builtin_amdgcn_rcpf(1.f + __expf(-a[i])) * b[i] * rs;
                    u32x2v w; w.x = cvt_pk_bf16(o[0], o[1]); w.y = cvt_pk_bf16(o[2], o[3]);
                    *(u32x2v*)(rowp + bj * (HALF / 2)) = w; } }
    }
};

struct MoeOrder : StaticOrder {
    int pb1, pb2, pb3, pb4, pb5, pb6, pb7; size_t estride;
    __device__ __forceinline__ const char* bbase(const Gemm& g, const Unit& u, size_t tstep) const {
        const int e = (u.pm >= pb1) + (u.pm >= pb2) + (u.pm >= pb3) + (u.pm >= pb4) + (u.pm >= pb5) + (u.pm >= pb6) + (u.pm >= pb7);
        return (const char*)(g.Bt + (size_t)e * estride) + (size_t)u.pn * tstep; }
};
struct SplitOrder {
    int nM, nN, S, G, c, pm0; int pb1, pb2, pb3, pb4, pb5, pb6, pb7; size_t estride;
    __device__ __forceinline__ bool next(int i, Unit& u) const { const int L = i * G + c; if (L >= nM * nN * S) return false; u.ks = L % S; const int t = L / S; u.pn = t % nN; u.pm = pm0 + t / nN; return true; }
    __device__ __forceinline__ const char* abase(const Gemm& g, const Unit& u, size_t tstep) const { return (const char*)g.A + (size_t)u.pm * tstep + (size_t)u.ks * g.K * 2; }
    __device__ __forceinline__ const char* bbase(const Gemm& g, const Unit& u, size_t tstep) const {
        const int e = estride ? (u.pm >= pb1) + (u.pm >= pb2) + (u.pm >= pb3) + (u.pm >= pb4) + (u.pm >= pb5) + (u.pm >= pb6) + (u.pm >= pb7) : 0;
        return (const char*)(g.Bt + (size_t)e * estride) + (size_t)u.pn * tstep + (size_t)u.ks * g.K * 2; }
    __device__ __forceinline__ void a_ready(const Unit&) const {}
    __device__ __forceinline__ void done(const Unit&) const {}
};
struct EpiPart {
    static constexpr bool PERM = false, AFTER_DRAIN = false;
    float* C; int ldc; size_t pstride; int pm0;
    __device__ __forceinline__ void operator()(const f32x4 (&acc)[2][2][4][2], const Unit& u, int wr, int wc, int fr, int fq) const {
        const int row0 = (u.pm - pm0) * BM + wr * 64 + fr, col0 = u.pn * BM + wc * 32 + 4 * fq; float* base = C + (size_t)u.ks * pstride;
#pragma unroll
        for (int ai = 0; ai < 2; ++ai)
#pragma unroll
            for (int m = 0; m < 4; ++m) { float* rowp = base + (size_t)(row0 + ai * HALF + m * 16) * ldc + col0;
#pragma unroll
                for (int bj = 0; bj < 2; ++bj)
#pragma unroll
                    for (int n = 0; n < 2; ++n) *(f32x4*)(rowp + bj * HALF + n * 16) = acc[ai][bj][m][n]; }
    }
};
template <class Epi, class Sched, bool ALIGN_EPI = false, bool SP2 = false>
__device__ __forceinline__ void gemm_phase(PG8_LAS unsigned char* lds, const Gemm g, const Sched& S, const Epi& E) {
    int tid_o = threadIdx.x; asm volatile("" : "+v"(tid_o));
    const int tid = tid_o, wid = __builtin_amdgcn_readfirstlane(tid >> 6), lane = tid & 63, wr = wid >> 2, wc = wid & 3, fr = lane & 15, fq = lane >> 4;
    const int K = g.K, nt = K / BK;
    unsigned voffA[2], voffB[2];
#pragma unroll
    for (int i = 0; i < 2; ++i) { int R, C; stage_rc(tid * 16 + i * 8192, R, C); const int Rb = Epi::PERM ? ((R & ~31) + perm32(R & 31)) : R;
        voffA[i] = (unsigned)(R * g.ld + C) * 2u; voffB[i] = (unsigned)(Rb * g.ld + C) * 2u; }
    const size_t kstep = (size_t)(BK * 2);
    const size_t hstep = (size_t)HALF * g.ld * 2;
    const size_t tstep = 2 * hstep;
    const unsigned ldsw = (unsigned)wid * 1024u;
    const int aoff = lds_byte(wr * 64 + fr, fq * 8), boff = lds_byte(wc * 32 + fr, fq * 8);
#define PG8_SA(b, h) (((b) * 2 + (h)) * HTB)
#define PG8_SB(b, h) ((4 + (b) * 2 + (h)) * HTB)
#define PG8_STAGE(bufoff, gbase, voff) do { _Pragma("unroll") for (int _i = 0; _i < 2; ++_i) \
        __builtin_amdgcn_global_load_lds((const unsigned*)((const char*)(gbase) + (voff)[_i]), (PG8_LAS unsigned*)(lds + (bufoff) + ldsw + _i * 8192), 16, 0, 0); } while (0)
#define PG8_LDA(dst, b, h) do { _Pragma("unroll") for (int m = 0; m < 4; ++m) _Pragma("unroll") for (int k = 0; k < 2; ++k) dst[m][k] = *(const PG8_LAS bf16x8*)(lds + PG8_SA(b, h) + aoff + m * 2048 + k * 1024); } while (0)
#define PG8_LDB(dst, b, h) do { _Pragma("unroll") for (int n = 0; n < 2; ++n) _Pragma("unroll") for (int k = 0; k < 2; ++k) dst[n][k] = *(const PG8_LAS bf16x8*)(lds + PG8_SB(b, h) + boff + n * 2048 + k * 1024); } while (0)
#define PG8_MMA(ai, bj, At, Bt) do { __builtin_amdgcn_s_setprio(1); _Pragma("unroll") for (int m = 0; m < 4; ++m) _Pragma("unroll") for (int n = 0; n < 2; ++n) _Pragma("unroll") for (int k = 0; k < 2; ++k) \
        acc[ai][bj][m][n] = __builtin_amdgcn_mfma_f32_16x16x32_bf16(Bt[n][k], At[m][k], acc[ai][bj][m][n], 0, 0, 0); __builtin_amdgcn_s_setprio(0); } while (0)
#define PG8_WAIT_V(n) asm volatile("s_waitcnt vmcnt(" #n ")" ::: "memory")
#define PG8_WAIT_L(n) asm volatile("s_waitcnt lgkmcnt(" #n ")" ::: "memory")
#define PG8_BAR __builtin_amdgcn_s_barrier()
#define PG8_SCHED __builtin_amdgcn_sched_barrier(0)
    Unit cur, nxt; int ui = 0;
    if (!S.next(0, cur)) return;
    f32x4 acc[2][2][4][2];
#pragma unroll
    for (int a = 0; a < 2; ++a)
#pragma unroll
        for (int b = 0; b < 2; ++b)
#pragma unroll
            for (int m = 0; m < 4; ++m)
#pragma unroll
                for (int n = 0; n < 2; ++n) acc[a][b][m][n] = (f32x4){0.f, 0.f, 0.f, 0.f};
    bf16x8 At[4][2], B0[2][2], B1[2][2];
    const char* cA = S.abase(g, cur, tstep); const char* cB = S.bbase(g, cur, tstep);
    S.a_ready(cur);
    if constexpr (SP2) {
        PG8_STAGE(PG8_SB(0, 0), cB, voffB); PG8_STAGE(PG8_SB(0, 1), cB + hstep, voffB); PG8_STAGE(PG8_SA(0, 0), cA, voffA); PG8_STAGE(PG8_SA(0, 1), cA + hstep, voffA);
        if (wr == 1) PG8_BAR;
        PG8_WAIT_V(2); PG8_BAR;
        PG8_STAGE(PG8_SB(1, 0), cB + kstep, voffB); PG8_STAGE(PG8_SA(1, 0), cA + kstep, voffA); PG8_STAGE(PG8_SB(1, 1), cB + hstep + kstep, voffB);
        PG8_WAIT_V(6); PG8_BAR;
    } else {
        PG8_STAGE(PG8_SB(0, 0), cB, voffB); PG8_STAGE(PG8_SA(0, 0), cA, voffA); PG8_STAGE(PG8_SB(0, 1), cB + hstep, voffB); PG8_STAGE(PG8_SA(0, 1), cA + hstep, voffA);
        if (wr == 1) PG8_BAR;
        PG8_WAIT_V(4); PG8_BAR;
        PG8_STAGE(PG8_SB(1, 0), cB + kstep, voffB); PG8_STAGE(PG8_SA(1, 0), cA + kstep, voffA); PG8_STAGE(PG8_SB(1, 1), cB + hstep + kstep, voffB);
        PG8_WAIT_V(6); PG8_BAR;
    }
    for (;;) {
        const bool has_next = S.next(ui + 1, nxt);
        const char* nA = has_next ? S.abase(g, nxt, tstep) : cA; const char* nB = has_next ? S.bbase(g, nxt, tstep) : cB;
        for (int t = 0; t < nt; t += 2) {
            const bool last = (t == nt - 2);
            const char* a1 = cA + (size_t)(t + 1) * kstep;
            const char* a2 = last ? nA : cA + (size_t)(t + 2) * kstep; const char* b2 = last ? nB : cB + (size_t)(t + 2) * kstep;
            const char* a3 = a2 + kstep; const char* b3 = b2 + kstep;
            if (last && has_next) S.a_ready(nxt);
            if constexpr (SP2) {
            PG8_LDB(B0, 0, 0); PG8_LDB(B1, 0, 1); PG8_SCHED; PG8_LDA(At, 0, 0); PG8_STAGE(PG8_SA(1, 1), a1 + hstep, voffA);
            PG8_WAIT_V(8); PG8_WAIT_L(0); PG8_BAR; PG8_MMA(0, 0, At, B0); PG8_MMA(0, 1, At, B1); PG8_BAR; PG8_SCHED;
            PG8_LDA(At, 0, 1); PG8_STAGE(PG8_SB(0, 0), b2, voffB); PG8_STAGE(PG8_SB(0, 1), b2 + hstep, voffB); PG8_STAGE(PG8_SA(0, 0), a2, voffA);
            PG8_WAIT_V(8); PG8_WAIT_L(0); PG8_BAR; PG8_MMA(1, 0, At, B0); PG8_MMA(1, 1, At, B1); PG8_BAR; PG8_SCHED;
            PG8_LDB(B0, 1, 0); PG8_LDB(B1, 1, 1); PG8_SCHED; PG8_LDA(At, 1, 0); PG8_STAGE(PG8_SA(0, 1), a2 + hstep, voffA);
            PG8_WAIT_V(8); PG8_WAIT_L(0); PG8_BAR; PG8_MMA(0, 0, At, B0); PG8_MMA(0, 1, At, B1); PG8_BAR; PG8_SCHED;
            PG8_LDA(At, 1, 1); PG8_STAGE(PG8_SB(1, 0), b3, voffB); PG8_STAGE(PG8_SB(1, 1), b3 + hstep, voffB); PG8_STAGE(PG8_SA(1, 0), a3, voffA);
            PG8_WAIT_V(8); PG8_WAIT_L(0); PG8_BAR; PG8_MMA(1, 0, At, B0); PG8_MMA(1, 1, At, B1); PG8_BAR; PG8_SCHED;
            } else {
            PG8_LDB(B0, 0, 0); PG8_SCHED; PG8_LDA(At, 0, 0); PG8_STAGE(PG8_SA(1, 1), a1 + hstep, voffA);
            PG8_WAIT_L(8); PG8_BAR; PG8_WAIT_L(0); PG8_MMA(0, 0, At, B0); PG8_BAR; PG8_SCHED;
            PG8_LDB(B1, 0, 1); PG8_STAGE(PG8_SB(0, 0), b2, voffB);
            PG8_BAR; PG8_WAIT_L(0); PG8_MMA(0, 1, At, B1); PG8_BAR;
            PG8_LDA(At, 0, 1); PG8_STAGE(PG8_SA(0, 0), a2, voffA);
            PG8_BAR; PG8_WAIT_L(0); PG8_MMA(1, 0, At, B0); PG8_BAR; PG8_SCHED;
            PG8_STAGE(PG8_SB(0, 1), b2 + hstep, voffB);
            PG8_WAIT_V(6); PG8_BAR; PG8_MMA(1, 1, At, B1); PG8_BAR;
            PG8_LDB(B0, 1, 0); PG8_SCHED; PG8_LDA(At, 1, 0); PG8_STAGE(PG8_SA(0, 1), a2 + hstep, voffA);
            PG8_WAIT_L(8); PG8_BAR; PG8_WAIT_L(0); PG8_MMA(0, 0, At, B0); PG8_BAR; PG8_SCHED;
            PG8_LDB(B1, 1, 1); PG8_STAGE(PG8_SB(1, 0), b3, voffB);
            PG8_BAR; PG8_WAIT_L(0); PG8_MMA(0, 1, At, B1); PG8_BAR;
            PG8_LDA(At, 1, 1); PG8_STAGE(PG8_SA(1, 0), a3, voffA);
            PG8_BAR; PG8_WAIT_L(0); PG8_MMA(1, 0, At, B0); PG8_BAR; PG8_SCHED;
            PG8_STAGE(PG8_SB(1, 1), b3 + hstep, voffB);
            PG8_WAIT_V(6); PG8_BAR; PG8_MMA(1, 1, At, B1); PG8_BAR;
            }
        }
        if constexpr (ALIGN_EPI) { if (wr == 0) PG8_BAR; }
        if constexpr (!Epi::AFTER_DRAIN) { E(acc, cur, wr, wc, fr, fq); S.done(cur); }
        if (!has_next) break;
#pragma unroll
        for (int a = 0; a < 2; ++a)
#pragma unroll
            for (int b = 0; b < 2; ++b)
#pragma unroll
                for (int m = 0; m < 4; ++m)
#pragma unroll
                    for (int n = 0; n < 2; ++n) acc[a][b][m][n] = (f32x4){0.f, 0.f, 0.f, 0.f};
        cur = nxt; cA = nA; cB = nB; ++ui;
        if constexpr (ALIGN_EPI) { if (wr == 1) PG8_BAR; }
    }
    PG8_WAIT_V(0);
    if constexpr (!ALIGN_EPI) { if (wr == 0) PG8_BAR; }
    PG8_BAR;
    if constexpr (Epi::AFTER_DRAIN) { E.fused(acc, cur, wr, wc, fr, fq, lds, wid, lane); S.done(cur); }
#undef PG8_SA
#undef PG8_SB
#undef PG8_STAGE
#undef PG8_LDA
#undef PG8_LDB
#undef PG8_MMA
#undef PG8_WAIT_V
#undef PG8_WAIT_L
#undef PG8_BAR
#undef PG8_SCHED
}
}

constexpr int NWAVES = 8;
constexpr int D = 1024, NB = 4, SEQ = 4096, CTXL = 256, NLAT = NB * SEQ, NCTX = NB * CTXL, MROWS = NLAT + NCTX;
constexpr int DEPTH = 4, RW = 512, NH = 8, HS = 64, DFF = 3584, NE = 8, NPROJ = 3456, NP = 3584, NLO = 2560, KLA = 512, NMOD = 6144;
constexpr int PC_R = 0, PC_K = 512, PC_V = 1024, PC_CB = 1536, PC_CC = 2048, PC_CH = 2560, PC_WD = 3072, PC_AD = 3200, PC_GD = 3328;
constexpr float LN_EPS = 1e-5f, GN_EPS = 64e-5f, DN_ALPHA = 1.681792830507429f;
enum { I_X = 0, I_C, I_CTX, I_CCTX, I_WMOD, I_BMOD, I_WIN, I_W0, I_W2, I_A0, I_A2, I_KK, I_KA, I_RK, I_G2, I_LNXG, I_LNXB, I_CONVW, I_WOUT, I_LN1G, I_LN1B, I_LN2G, I_LN2B,
       I_FW1, I_FW3, I_FW2, I_RTW, I_RTB, I_MW1, I_MW3, I_MW2, N_IN };

constexpr size_t MiB = 1u << 20;
constexpr size_t WS_CTL = 0, CTL_BYTES = 1 * MiB;
constexpr size_t WS_MODV = 1 * MiB;
constexpr size_t WS_G8 = 2 * MiB;
constexpr size_t WS_RKS = 3 * MiB;
constexpr size_t WS_WIN = 4 * MiB;
constexpr size_t WS_WOUT = WS_WIN + 28 * MiB;
constexpr size_t WS_LORA = WS_WOUT + 8 * MiB;
constexpr size_t WS_F13 = WS_LORA + 10 * MiB;
constexpr size_t WS_F2 = WS_F13 + 28 * MiB;
constexpr size_t WS_X = WS_F2 + 14 * MiB;
constexpr size_t WS_H = WS_X + 68 * MiB;
constexpr size_t WS_MOES = WS_H + 34 * MiB;
constexpr size_t WS_ROWLIST = WS_MOES;
constexpr size_t WS_TOKSEL = WS_MOES + 640 * 1024;
constexpr size_t WS_WSEL = WS_TOKSEL + 320 * 1024;
constexpr size_t WS_WSORT = WS_WSEL + 192 * 1024;
constexpr size_t WS_MOEW13 = WS_MOES + 2 * MiB;
constexpr size_t WS_MOEW2 = WS_MOEW13 + 112 * MiB;
constexpr size_t WS_SCR = WS_MOEW2 + 56 * MiB;
constexpr size_t WS_P = WS_SCR;
constexpr size_t WS_LO = WS_P + 119 * MiB;
constexpr size_t WS_PREP = WS_LO + 170 * MiB;
constexpr size_t WS_Y = WS_PREP + 213 * MiB;
constexpr size_t WS_MIXIN = WS_Y + 68 * MiB;
constexpr size_t WS_CH = WS_PREP;
constexpr size_t WS_MIXO = WS_PREP;
constexpr size_t WS_MIXP = WS_PREP + 34 * MiB;
constexpr size_t WS_END_MIXER = WS_MIXIN + 34 * MiB;
constexpr size_t WS_HG = WS_SCR;
constexpr size_t WS_ACT = WS_HG + 72 * MiB;
constexpr size_t WS_F = WS_ACT + 252 * MiB;
constexpr size_t WS_FP = WS_F + 72 * MiB;
constexpr size_t WS_END_FFN = WS_FP + 64 * MiB;
constexpr size_t WS_NEED = WS_END_MIXER > WS_END_FFN ? WS_END_MIXER : WS_END_FFN;
static_assert((size_t)MROWS * NP * 2 <= 119 * MiB && (size_t)MROWS * NLO * 4 <= 170 * MiB && (size_t)8704 * 25600 <= 213 * MiB && (size_t)MROWS * D * 4 <= 68 * MiB && WS_NEED <= 990 * MiB, "ws map");
constexpr int MOE_MAIN_PANELS = 128, MOE_TAIL_ROWS = 4096;
constexpr int MOE_ROWS = 36864;
constexpr int LORAW_PER_LAYER = 4 * 512 * 64 + 512 * 128;
constexpr int CW_BAR = 4096, CW_GCNT = 8192, CW_CQ = 12288, CW_SDONE = 12544;

constexpr int RING_BYTES = 131072, LDSCTL_OFF = RING_BYTES, MISC_OFF = LDSCTL_OFF + 320, LDS_BYTES = 147456;

typedef unsigned short bf16;
typedef unsigned v4u __attribute__((ext_vector_type(4)));
typedef unsigned v2u __attribute__((ext_vector_type(2)));
typedef float f32x4 __attribute__((ext_vector_type(4)));
#define LAS __attribute__((address_space(3)))
#define LDS_WAIT() asm volatile("s_waitcnt lgkmcnt(0)" ::: "memory")
__device__ __forceinline__ unsigned f2bf(float f) { unsigned u = __builtin_bit_cast(unsigned, f); return (u + 0x7fffu + ((u >> 16) & 1u)) >> 16; }
__device__ __forceinline__ unsigned pk2(float lo, float hi) { return f2bf(lo) | (f2bf(hi) << 16); }
__device__ __forceinline__ float bf2f(unsigned short b) { return __builtin_bit_cast(float, ((unsigned)b) << 16); }
__device__ __forceinline__ float bflo(unsigned w) { return __builtin_bit_cast(float, w << 16); }
__device__ __forceinline__ float bfhi(unsigned w) { return __builtin_bit_cast(float, w & 0xffff0000u); }
__device__ __forceinline__ float wave_sum(float v) {
#pragma unroll
    for (int o = 1; o < 64; o <<= 1) v += __shfl_xor(v, o);
    return v;
}
__device__ __forceinline__ float sigm(float x) { return 1.f / (1.f + __expf(-x)); }

#define XB_TMO      128
#define XB_XCNT(j)  (256  + 64 * (j))
#define XB_XSUB(j)  (1280 + 64 * (j))
#define XB_XGEN(j)  (2304 + 64 * (j))
#define XB_TOP      3328
#define XB_TOPGEN   3392
#define XCD_BAR_WORDS 3456
#define XB_SPIN_CAP (1u << 18)

__device__ __forceinline__ unsigned xb_ld(unsigned* p)              { return __hip_atomic_load(p, __ATOMIC_RELAXED, __HIP_MEMORY_SCOPE_AGENT); }
__device__ __forceinline__ unsigned xb_add(unsigned* p, unsigned v) { return __hip_atomic_fetch_add(p, v, __ATOMIC_RELAXED, __HIP_MEMORY_SCOPE_AGENT); }
__device__ __forceinline__ unsigned xb_xcc_id() { return (unsigned)__builtin_amdgcn_s_getreg((3 << 11) | 20) & 0xFu; }
#define XB_SPIN(cond, bar) do { unsigned _sp = 0; while (cond) { __builtin_amdgcn_s_sleep(1); \
    if ((++_sp & 255u) == 0u) { if (xb_ld(&(bar)[XB_TMO])) break; if (_sp > XB_SPIN_CAP) { atomicAdd(&(bar)[XB_TMO], 1u); break; } } } } while (0)

struct XcdBarrier {
    unsigned* bar; unsigned x;
    volatile LAS unsigned* st;
};

__device__ __forceinline__ XcdBarrier xcd_barrier_post(unsigned* bar, volatile LAS unsigned* st) {
    XcdBarrier b; b.bar = bar; b.x = xb_xcc_id(); b.st = st;
    if (threadIdx.x == 0) (void)xb_add(&bar[XB_XCNT(b.x)], 1u);
    return b;
}
__device__ __forceinline__ void xcd_barrier_complete(unsigned* bar, unsigned x, unsigned& nloc, unsigned& nx) {
    const unsigned G = gridDim.x * gridDim.y * gridDim.z;
    unsigned sum, cnt, mine, sp = 0u;
    for (;;) {
        sum = 0u; cnt = 0u; mine = 0u;
#pragma unroll
        for (unsigned j = 0; j < 16; ++j) { const unsigned c = xb_ld(&bar[XB_XCNT(j)]); sum += c; cnt += (c > 0u) ? 1u : 0u; mine = (j == x) ? c : mine; }
        if (sum == G) break;
        __builtin_amdgcn_s_sleep(1);
        if ((++sp & 255u) == 0u) { if (xb_ld(&bar[XB_TMO])) break; if (sp > XB_SPIN_CAP) { atomicAdd(&bar[XB_TMO], 1u); break; } }
    }
    nloc = mine > 0u ? mine : 1u; nx = cnt > 0u ? cnt : 1u;
}

__device__ __forceinline__ void xcd_barrier(const XcdBarrier& b) {
    asm volatile("s_waitcnt vmcnt(0)" ::: "memory");
    __syncthreads();
    if (threadIdx.x == 0) {
        unsigned* bar = b.bar;
        __builtin_amdgcn_s_waitcnt(0);
        unsigned nloc = b.st[0], nx = b.st[1];
        if (nloc == 0u) { xcd_barrier_complete(bar, b.x, nloc, nx); b.st[0] = nloc; b.st[1] = nx; }
        const unsigned old = xb_add(&bar[XB_XSUB(b.x)], 1u);
        const unsigned gen = old / nloc;
        if (old + 1u == (gen + 1u) * nloc) {
            __builtin_amdgcn_fence(__ATOMIC_RELEASE, "agent");
            asm volatile("s_waitcnt vmcnt(0)" ::: "memory");
            const unsigned og = xb_add(&bar[XB_TOP], 1u);
            const unsigned tg = og / nx;
            if (og + 1u == (tg + 1u) * nx) xb_add(&bar[XB_TOPGEN], 1u);
            else XB_SPIN(xb_ld(&bar[XB_TOPGEN]) == tg, bar);
            __builtin_amdgcn_fence(__ATOMIC_ACQUIRE, "agent");
            xb_add(&bar[XB_XGEN(b.x)], 1u);
            asm volatile("s_waitcnt vmcnt(0)" ::: "memory");
        } else {
            XB_SPIN(xb_ld(&bar[XB_XGEN(b.x)]) == gen, bar);
            __builtin_amdgcn_fence(__ATOMIC_ACQUIRE, "agent");
            asm volatile("s_waitcnt vmcnt(0)" ::: "memory");
        }
    }
    __syncthreads();
}


struct KP { const float* in[N_IN]; float* out; unsigned char* ws; int ph; int pad; };

template <int MODE> __device__ __forceinline__ int rowmap(int n, int arg) {
    if (MODE == 0) return n + arg;
    if (MODE == 1) { if (n < 1536) return n; if (n < 1664) return n - 1536 + PC_WD; if (n < 1792) return n - 1664 + PC_AD; if (n < 1920) return n - 1792 + PC_GD;
                     if (n < 2432) return n - 1920 + PC_CB; if (n < 2944) return n - 2432 + PC_CC; return n - 2944 + PC_CH; }
    return 8 * (n >> 2) + 4 * arg + (n & 3);
}
template <int MODE> __device__ __forceinline__ void transpose_item(const float* W, int K, int N, bf16* WT, int arg, LAS float* scr, int item, int lane) {
    const int nblk = N / 32, kb = item / nblk, nb = item % nblk, k0 = 64 * kb, n0 = 32 * nb;
#pragma unroll 8
    for (int i = 0; i < 32; ++i) { const int kk = 2 * i + (lane >> 5); scr[kk * 33 + (lane & 31)] = W[(size_t)(k0 + kk) * N + n0 + (lane & 31)]; }
    LDS_WAIT(); asm volatile("" ::: "memory");
    const int c = lane & 7;
#pragma unroll
    for (int j = 0; j < 4; ++j) { const int n = (lane >> 3) + 8 * j; const LAS float* s = scr + (8 * c) * 33 + n;
        v4u o; o.x = pk2(s[0 * 33], s[1 * 33]); o.y = pk2(s[2 * 33], s[3 * 33]); o.z = pk2(s[4 * 33], s[5 * 33]); o.w = pk2(s[6 * 33], s[7 * 33]);
        *(v4u*)(WT + (size_t)rowmap<MODE>(n0 + n, arg) * K + k0 + 8 * c) = o; }
    LDS_WAIT(); asm volatile("" ::: "memory");
}

__device__ __forceinline__ void ph_modvec(const KP& p, LAS unsigned char* lds, int tid) {
    LAS float* sil = (LAS float*)lds;
    LAS float* red = (LAS float*)(lds + 5 * 1024 * 4);
    const float* c = p.in[I_C]; const float* cc = p.in[I_CCTX];
    for (int i = tid; i < 5 * 1024; i += 512) { const float v = i < 4096 ? c[i] : cc[i - 4096]; sil[i] = v / (1.f + __expf(-v)); }
    __syncthreads();
    float* modv = (float*)(p.ws + WS_MODV);
    const int ks = tid >> 6, col = tid & 63;
    for (int task = blockIdx.x; task < DEPTH * 96; task += gridDim.x) {
        const int l = task / 96, j0 = (task % 96) * 64;
        const float* w = p.in[I_WMOD] + (size_t)l * D * NMOD + (size_t)(ks * 128) * NMOD + j0 + col;
        float a0 = 0.f, a1 = 0.f, a2 = 0.f, a3 = 0.f, a4 = 0.f;
#pragma unroll 8
        for (int k = 0; k < 128; ++k) { const float wv = w[(size_t)k * NMOD]; const int kk = ks * 128 + k;
            a0 += sil[kk] * wv; a1 += sil[1024 + kk] * wv; a2 += sil[2048 + kk] * wv; a3 += sil[3072 + kk] * wv; a4 += sil[4096 + kk] * wv; }
        red[(ks * 5 + 0) * 64 + col] = a0; red[(ks * 5 + 1) * 64 + col] = a1; red[(ks * 5 + 2) * 64 + col] = a2; red[(ks * 5 + 3) * 64 + col] = a3; red[(ks * 5 + 4) * 64 + col] = a4;
        __syncthreads();
        if (tid < 320) { const int r = tid >> 6; float s = 0.f;
#pragma unroll
            for (int q = 0; q < 8; ++q) s += red[(q * 5 + r) * 64 + col];
            modv[(size_t)(l * 5 + r) * NMOD + j0 + col] = s + p.in[I_BMOD][l * NMOD + j0 + col]; }
        __syncthreads();
    }
}

__device__ __forceinline__ void ph_convert(const KP& p, LAS unsigned char* lds, int gw, int NGW, int wave, int lane) {
    LAS float* scr = (LAS float*)(lds + wave * 16384);
    bf16* win = (bf16*)(p.ws + WS_WIN); bf16* wout = (bf16*)(p.ws + WS_WOUT); bf16* f13 = (bf16*)(p.ws + WS_F13); bf16* f2 = (bf16*)(p.ws + WS_F2); bf16* lora = (bf16*)(p.ws + WS_LORA);
    constexpr int I_IN = (D / 64) * (NPROJ / 32), I_OUT = (D / 64) * (D / 32), I_UP = (D / 64) * (DFF / 32), I_DN = (DFF / 64) * (D / 32);
    constexpr int NITEMS = I_IN + I_OUT + 2 * I_UP + I_DN;
    for (int it = gw; it < NITEMS; it += NGW) {
        int r = it;
        if (r < I_IN) { transpose_item<1>(p.in[I_WIN], D, NPROJ, win, 0, scr, r, lane); continue; } r -= I_IN;
        if (r < I_OUT) { transpose_item<0>(p.in[I_WOUT], D, D, wout, 0, scr, r, lane); continue; } r -= I_OUT;
        if (r < I_UP) { transpose_item<2>(p.in[I_FW1], D, DFF, f13, 0, scr, r, lane); continue; } r -= I_UP;
        if (r < I_UP) { transpose_item<2>(p.in[I_FW3], D, DFF, f13, 1, scr, r, lane); continue; } r -= I_UP;
        transpose_item<0>(p.in[I_FW2], DFF, D, f2, 0, scr, r, lane);
    }
    { const int gt = gw * 64 + lane, NGT = NGW * 64; constexpr int PER = (NP - NPROJ) * D / 8;
      for (int i = gt; i < DEPTH * PER; i += NGT) { const int l = i / PER, q = i % PER; *(v4u*)(win + (size_t)l * NP * D + (size_t)NPROJ * D + (size_t)q * 8) = (v4u){0u, 0u, 0u, 0u}; } }
    { const int gt = gw * 64 + lane, NGT = NGW * 64;
      for (int i = gt; i < DEPTH * LORAW_PER_LAYER / 8; i += NGT) { const int l = i / (LORAW_PER_LAYER / 8); int q = (i % (LORAW_PER_LAYER / 8)) * 8; float v[8];
          int grp, c, k0; if (q < 4 * 512 * 64) { grp = q / (512 * 64); q -= grp * 512 * 64; c = q / 64; k0 = q % 64; } else { grp = 4; q -= 4 * 512 * 64; c = q / 128; k0 = q % 128; }
#pragma unroll
          for (int j = 0; j < 8; ++j) { const int k = k0 + j;
              v[j] = grp < 2 ? p.in[I_W2][((size_t)(l * 2 + grp) * 64 + k) * RW + c] : grp < 4 ? p.in[I_A2][((size_t)(l * 2 + grp - 2) * 64 + k) * RW + c] : p.in[I_G2][((size_t)l * 128 + k) * RW + c]; }
          v4u o; o.x = pk2(v[0], v[1]); o.y = pk2(v[2], v[3]); o.z = pk2(v[4], v[5]); o.w = pk2(v[6], v[7]);
          *(v4u*)(lora + (size_t)i * 8) = o; } }
}
constexpr int CQ_IN = (D / 64) * (NPROJ / 32), CQ_OUT = (D / 64) * (D / 32), CQ_UP = (D / 64) * (DFF / 32), CQ_DN = (DFF / 64) * (D / 32);
constexpr int CQ_J1 = 3 * CQ_IN + 3 * CQ_OUT + 2 * CQ_UP + CQ_DN, CQ_MOE = NE * (2 * CQ_UP + CQ_DN), CQ_END0 = CQ_J1 + CQ_MOE, CQ_END1 = CQ_END0 + CQ_MOE;
#ifndef CQ_SLOT_ITEMS
#define CQ_SLOT_ITEMS 12000
#endif
struct CqItem { const float* W; bf16* WT; int K, N, mode, arg, item; };
__device__ __forceinline__ CqItem cq_decode(const KP& p, int q) {
    CqItem c; bf16* win = (bf16*)(p.ws + WS_WIN); bf16* wout = (bf16*)(p.ws + WS_WOUT); bf16* f13 = (bf16*)(p.ws + WS_F13); bf16* f2 = (bf16*)(p.ws + WS_F2);
    bf16* m13 = (bf16*)(p.ws + WS_MOEW13); bf16* m2 = (bf16*)(p.ws + WS_MOEW2);
    if (q < 3 * CQ_IN) { const int l = 1 + q / CQ_IN; c = CqItem{p.in[I_WIN] + (size_t)l * D * NPROJ, win + (size_t)l * NP * D, D, NPROJ, 1, 0, q % CQ_IN}; return c; } q -= 3 * CQ_IN;
    if (q < 3 * CQ_OUT) { const int l = 1 + q / CQ_OUT; c = CqItem{p.in[I_WOUT] + (size_t)l * D * D, wout + (size_t)l * D * D, D, D, 0, 0, q % CQ_OUT}; return c; } q -= 3 * CQ_OUT;
    if (q < CQ_UP) { c = CqItem{p.in[I_FW1] + (size_t)D * DFF, f13 + (size_t)2 * DFF * D, D, DFF, 2, 0, q}; return c; } q -= CQ_UP;
    if (q < CQ_UP) { c = CqItem{p.in[I_FW3] + (size_t)D * DFF, f13 + (size_t)2 * DFF * D, D, DFF, 2, 1, q}; return c; } q -= CQ_UP;
    if (q < CQ_DN) { c = CqItem{p.in[I_FW2] + (size_t)DFF * D, f2 + (size_t)D * DFF, DFF, D, 0, 0, q}; return c; } q -= CQ_DN;
    const int mi = q / CQ_MOE; q -= mi * CQ_MOE;
    if (q < NE * CQ_UP) { const int e = q / CQ_UP; c = CqItem{p.in[I_MW1] + ((size_t)mi * NE + e) * D * DFF, m13 + (size_t)e * 2 * DFF * D, D, DFF, 2, 0, q % CQ_UP}; return c; } q -= NE * CQ_UP;
    if (q < NE * CQ_UP) { const int e = q / CQ_UP; c = CqItem{p.in[I_MW3] + ((size_t)mi * NE + e) * D * DFF, m13 + (size_t)e * 2 * DFF * D, D, DFF, 2, 1, q % CQ_UP}; return c; } q -= NE * CQ_UP;
    { const int e = q / CQ_DN; c = CqItem{p.in[I_MW2] + ((size_t)mi * NE + e) * DFF * D, m2 + (size_t)e * D * DFF, DFF, D, 0, 0, q % CQ_DN}; return c; }
}
__device__ __forceinline__ void cq_load(const CqItem& c, int lane, float (&r)[32]) {
    const int nblk = c.N / 32, kb = c.item / nblk, nb = c.item % nblk; const float* src = c.W + (size_t)(64 * kb + (lane >> 5)) * c.N + 32 * nb + (lane & 31);
#pragma unroll
    for (int i = 0; i < 32; ++i) r[i] = src[(size_t)(2 * i) * c.N];
}
__device__ __forceinline__ void cq_store(const CqItem& c, int lane, const float (&r)[32], LAS float* scr) {
    const int nblk = c.N / 32, kb = c.item / nblk, nb = c.item % nblk, k0 = 64 * kb, n0 = 32 * nb;
#pragma unroll
    for (int i = 0; i < 32; ++i) scr[(2 * i + (lane >> 5)) * 33 + (lane & 31)] = r[i];
    LDS_WAIT(); asm volatile("" ::: "memory");
    const int cc = lane & 7;
#pragma unroll
    for (int j = 0; j < 4; ++j) { const int n = (lane >> 3) + 8 * j; const LAS float* sp = scr + (8 * cc) * 33 + n;
        v4u o; o.x = pk2(sp[0 * 33], sp[1 * 33]); o.y = pk2(sp[2 * 33], sp[3 * 33]); o.z = pk2(sp[4 * 33], sp[5 * 33]); o.w = pk2(sp[6 * 33], sp[7 * 33]);
        const int nn = n0 + n; const int row = c.mode == 0 ? nn : c.mode == 1 ? rowmap<1>(nn, 0) : 8 * (nn >> 2) + 4 * c.arg + (nn & 3);
        *(v4u*)(c.WT + (size_t)row * c.K + k0 + 8 * cc) = o; }
    LDS_WAIT(); asm volatile("" ::: "memory");
}
constexpr int CQ_B = 4;
__device__ __forceinline__ int cq_grab(unsigned* heads, int nseg, int& cnt, int lane) {
    int q = -1, n = 0;
    if (lane == 0) { for (int sg = 0; sg < nseg && q < 0; ++sg) { const int size = sg == 0 ? CQ_J1 : CQ_MOE, base = sg == 0 ? 0 : sg == 1 ? CQ_J1 : CQ_END0; unsigned* hd = heads + 64 * sg;
            if ((int)__hip_atomic_load(hd, __ATOMIC_RELAXED, __HIP_MEMORY_SCOPE_AGENT) < size) { const int t = (int)__hip_atomic_fetch_add(hd, (unsigned)CQ_B, __ATOMIC_RELAXED, __HIP_MEMORY_SCOPE_AGENT);
                if (t < size) { q = base + t; n = size - t < CQ_B ? size - t : CQ_B; } } } }
    cnt = __builtin_amdgcn_readfirstlane(n); return __builtin_amdgcn_readfirstlane(q);
}
__device__ __forceinline__ void cq_run(const KP& p, LAS unsigned char* lds, int nseg, const unsigned* stop, unsigned stopval, int wave, int lane) {
    unsigned* heads = (unsigned*)(p.ws + WS_CTL) + CW_CQ; LAS float* scr = (LAS float*)(lds + wave * 16384);
    for (;;) {
        if (stop) { unsigned sv = 0u; if (lane == 0) sv = __hip_atomic_load(stop, __ATOMIC_RELAXED, __HIP_MEMORY_SCOPE_AGENT); if ((unsigned)__builtin_amdgcn_readfirstlane((int)sv) >= stopval) break; }
        int cnt; const int q0 = cq_grab(heads, nseg, cnt, lane); if (q0 < 0) break;
        CqItem cur = cq_decode(p, q0); float ra[32]; cq_load(cur, lane, ra);
        for (int j = 0; j < cnt; ++j) { CqItem nxt = cur; float rb[32];
            if (j + 1 < cnt) { nxt = cq_decode(p, q0 + j + 1); cq_load(nxt, lane, rb); }
            cq_store(cur, lane, ra, scr);
            if (j + 1 < cnt) { cur = nxt;
#pragma unroll
                for (int i = 0; i < 32; ++i) ra[i] = rb[i]; } }
    }
}

__device__ __forceinline__ void cq_static(const KP& p, LAS unsigned char* lds, int q0, int q1, int gw, int NGW, int wave, int lane) {
    LAS float* scr = (LAS float*)(lds + wave * 16384);
    int q = q0 + gw; if (q >= q1) return;
    CqItem cur = cq_decode(p, q); float ra[32]; cq_load(cur, lane, ra);
    for (;;) { const int qn = q + NGW; CqItem nxt = cur; float rb[32];
        if (qn < q1) { nxt = cq_decode(p, qn); cq_load(nxt, lane, rb); }
        cq_store(cur, lane, ra, scr);
        if (qn >= q1) break;
        cur = nxt; q = qn;
#pragma unroll
        for (int i = 0; i < 32; ++i) ra[i] = rb[i]; }
}

__device__ __forceinline__ void ld_row(const float* r, int lane, f32x4 (&v)[4]) { const f32x4* q = (const f32x4*)r + lane;
#pragma unroll
    for (int j = 0; j < 4; ++j) v[j] = q[64 * j]; }
__device__ __forceinline__ void st_row(float* r, int lane, const f32x4 (&v)[4]) { f32x4* q = (f32x4*)r + lane;
#pragma unroll
    for (int j = 0; j < 4; ++j) q[64 * j] = v[j]; }
__device__ __forceinline__ void st_row_bf16(bf16* r, int lane, const f32x4 (&v)[4]) { v2u* q = (v2u*)r + lane;
#pragma unroll
    for (int j = 0; j < 4; ++j) { v2u w; w.x = pk2(v[j][0], v[j][1]); w.y = pk2(v[j][2], v[j][3]); q[64 * j] = w; } }
__device__ __forceinline__ void ld_row_bf16(const bf16* r, int lane, f32x4 (&v)[4]) { const v2u* q = (const v2u*)r + lane;
#pragma unroll
    for (int j = 0; j < 4; ++j) { const v2u w = q[64 * j]; v[j] = (f32x4){bflo(w.x), bfhi(w.x), bflo(w.y), bfhi(w.y)}; } }
template <int S> __device__ __forceinline__ void ld_row_parts(const float* r, size_t pstride, int lane, f32x4 (&v)[4]) {
    ld_row(r, lane, v);
#pragma unroll
    for (int s = 1; s < S; ++s) { f32x4 t[4]; ld_row(r + (size_t)s * pstride, lane, t);
#pragma unroll
        for (int j = 0; j < 4; ++j) v[j] += t[j]; } }
__device__ __forceinline__ int mod_row(int row) { return row < NLAT ? (row >> 12) : 4; }

__device__ __forceinline__ void ph_init_rows(const KP& p, int gw, int NGW, int lane) {
    const float* modv = (const float*)(p.ws + WS_MODV); float* X = (float*)(p.ws + WS_X); bf16* H = (bf16*)(p.ws + WS_H);
    for (int row = gw; row < MROWS; row += NGW) {
        const float* src = row < NLAT ? p.in[I_X] + (size_t)row * D : p.in[I_CTX] + (size_t)(row - NLAT) * D;
        const float* mv = modv + (size_t)(0 * 5 + mod_row(row)) * NMOD;
        f32x4 x[4], sh[4], sc[4], h[4]; ld_row(src, lane, x); ld_row(mv, lane, sh); ld_row(mv + 1024, lane, sc);
#pragma unroll
        for (int j = 0; j < 4; ++j) h[j] = x[j] * (1.f + sc[j]) + sh[j];
        st_row(X + (size_t)row * D, lane, x); st_row_bf16(H + (size_t)row * D, lane, h);
    }
}

__device__ __forceinline__ int scan_row(int b, int dir, int step) { return step < CTXL ? NLAT + b * CTXL + (dir ? CTXL - 1 - step : step) : b * SEQ + (dir ? SEQ - 1 - (step - CTXL) : step - CTXL); }
typedef short sbf16x8 __attribute__((ext_vector_type(8)));
typedef float f32x16 __attribute__((ext_vector_type(16)));
constexpr int SC_C = 32, SC_NCH = (CTXL + SEQ) / SC_C  , SC_NCHAIN = NB * NH * 2  , SC_NTASK = SC_NCH * SC_NCHAIN  ;
constexpr int CH_G = 0, CH_Q = 8192, CH_UT = 12288, CH_YL = 20480, CH_EC = 24576, CH_BYTES = 25600, CH_NLOAD = 26;

__device__ __forceinline__ f32x16 mm(v4u a, v4u b, f32x16 c) { return __builtin_amdgcn_mfma_f32_32x32x16_bf16(__builtin_bit_cast(sbf16x8, a), __builtin_bit_cast(sbf16x8, b), c, 0, 0, 0); }
typedef float f32x2c __attribute__((ext_vector_type(2))); typedef __bf16 bf16x2c __attribute__((ext_vector_type(2)));
__device__ __forceinline__ unsigned cvtpk(float lo, float hi) { return __builtin_bit_cast(unsigned, __builtin_convertvector((f32x2c){lo, hi}, bf16x2c)); }
template <int S, int NEG> __device__ __forceinline__ v4u cvtf(const f32x16& x) {
    v4u w; const float sg = NEG ? -1.f : 1.f;
    w.x = cvtpk(sg * x[8 * S + 0], sg * x[8 * S + 1]); w.y = cvtpk(sg * x[8 * S + 2], sg * x[8 * S + 3]); w.z = cvtpk(sg * x[8 * S + 4], sg * x[8 * S + 5]); w.w = cvtpk(sg * x[8 * S + 6], sg * x[8 * S + 7]); return w; }
template <int MODE  > __device__ __forceinline__ f32x16 mask_acc(f32x16 x, int n, int hh) {
#pragma unroll
    for (int r = 0; r < 16; ++r) { const int m = (r & 3) + 8 * (r >> 2) + 4 * hh; const bool keep = MODE == 0 ? (m > n) : MODE == 1 ? (m < n) : (m <= n); x[r] = keep ? x[r] : 0.f; }
    return x; }
__device__ __forceinline__ f32x16 zero16() { f32x16 z;
#pragma unroll
    for (int r = 0; r < 16; ++r) z[r] = 0.f;
    return z; }
__device__ __forceinline__ void cm_build(const unsigned (&w)[16], v4u (&f)[2][2]) {
#pragma unroll
    for (int s = 0; s < 2; ++s) {
        const auto r0 = __builtin_amdgcn_permlane32_swap(w[8 * s + 0], w[8 * s + 2], false, false), r1 = __builtin_amdgcn_permlane32_swap(w[8 * s + 1], w[8 * s + 3], false, false);
        const auto r2 = __builtin_amdgcn_permlane32_swap(w[8 * s + 4], w[8 * s + 6], false, false), r3 = __builtin_amdgcn_permlane32_swap(w[8 * s + 5], w[8 * s + 7], false, false);
        f[0][s] = (v4u){r0[0], r1[0], r2[0], r3[0]}; f[1][s] = (v4u){r0[1], r1[1], r2[1], r3[1]}; }
}
__device__ __forceinline__ void st16(unsigned char* base, int off, int lane, v4u v) { *(v4u*)(base + off + lane * 16) = v; }

__device__ __forceinline__ void ph_scan1(const KP& p, int l, int gw, int NGW, int lane) {
    const bf16* P = (const bf16*)(p.ws + WS_P); const bf16* LO = (const bf16*)(p.ws + WS_LO); const float* NRM = (const float*)(p.ws + WS_RKS); unsigned char* CH = p.ws + WS_CH;
    const int n = lane & 31, hh = lane >> 5;
    v4u Id[2];
#pragma unroll
    for (int s = 0; s < 2; ++s) { unsigned wd[4];
#pragma unroll
        for (int q = 0; q < 4; ++q) { const int j0 = 2 * q, j1 = 2 * q + 1; const int t0 = 16 * s + 8 * (j0 >> 2) + 4 * hh + (j0 & 3), t1 = 16 * s + 8 * (j1 >> 2) + 4 * hh + (j1 & 3);
            wd[q] = (t0 == n ? 0x3F80u : 0u) | (t1 == n ? 0x3F800000u : 0u); }
        Id[s] = (v4u){wd[0], wd[1], wd[2], wd[3]}; }
    for (int task = gw; task < SC_NTASK; task += NGW) {
        const int dir = task & 1, h = (task >> 1) & 7, b = (task >> 4) & 3, ci = task >> 6;
        const int row0 = scan_row(b, dir, SC_C * ci), sgn = dir ? -1 : 1, c = h * 64 + lane;
        const float w0c = p.in[I_W0][(l * 2 + dir) * RW + c], a0c = p.in[I_A0][(l * 2 + dir) * RW + c], kkc = p.in[I_KK][l * RW + c], kac = p.in[I_KA][l * RW + c];
        unsigned wAl[16], wBe[16], wKa[16], wRh[16], wV[16], wBp[16], wKp[16];
        float cs = 0.f, Eprev = 1.f;
#pragma unroll
        for (int hb = 0; hb < 2; ++hb) {
            unsigned rk_[16], rr_[16], rv_[16], rw_[16], ra_[16]; float rn_[16];
#pragma unroll
            for (int i = 0; i < 16; ++i) { const int row = row0 + sgn * (16 * hb + i); const bf16* pr = P + (size_t)row * NP; const bf16* lo = LO + (size_t)row * NLO;
                rk_[i] = pr[PC_K + c]; rr_[i] = pr[PC_R + c]; rv_[i] = pr[PC_V + c]; rw_[i] = lo[dir * RW + c]; ra_[i] = lo[1024 + dir * RW + c]; rn_[i] = NRM[row * 8 + h]; }
#pragma unroll
            for (int i = 0; i < 16; ++i) asm volatile("" : "+v"(rk_[i]), "+v"(rr_[i]), "+v"(rv_[i]), "+v"(rw_[i]), "+v"(ra_[i]), "+v"(rn_[i]));
#pragma unroll
            for (int pq = 0; pq < 8; ++pq) { const int pz = 8 * hb + pq; float al[2], be[2], ka[2], rh[2], vv[2];
#pragma unroll
                for (int e = 0; e < 2; ++e) { const int i = 2 * pq + e;
                    const float kv = bf2f((unsigned short)rk_[i]), rv = bf2f((unsigned short)rr_[i]); vv[e] = bf2f((unsigned short)rv_[i]);
                    const float wl = w0c + bf2f((unsigned short)rw_[i]), aa = __builtin_amdgcn_rcpf(1.f + __expf(-(a0c + bf2f((unsigned short)ra_[i])))), nrm = rn_[i];
                    const float lw = -0.6065306597f * __builtin_amdgcn_rcpf(1.f + __expf(-wl));
                    cs += lw; const float E = __expf(cs), Ei = __builtin_amdgcn_rcpf(E);
                    const float kkn = kv * kkc * nrm, kd = kv * (1.f + (aa - 1.f) * kac);
                    al[e] = kkn * Eprev; be[e] = kkn * aa * Ei; ka[e] = kd * Ei; rh[e] = rv * E; Eprev = E; }
                wAl[pz] = cvtpk(al[0], al[1]); wBe[pz] = cvtpk(be[0], be[1]); wKa[pz] = cvtpk(ka[0], ka[1]); wRh[pz] = cvtpk(rh[0], rh[1]); wV[pz] = cvtpk(vv[0], vv[1]); }
        }
        const float EC = Eprev;
#pragma unroll
        for (int pz = 0; pz < 16; ++pz) { wBp[pz] = cvtpk(bflo(wBe[pz]) * EC, bfhi(wBe[pz]) * EC); wKp[pz] = cvtpk(bflo(wKa[pz]) * EC, bfhi(wKa[pz]) * EC); }
        unsigned char* img = CH + (size_t)(((b * 8 + h) * 2 + dir) * SC_NCH + ci) * CH_BYTES;
        ((float*)(img + CH_EC))[lane] = EC;
        v4u cAl[2][2], cV[2][2], cBp[2][2], cKp[2][2], cRh[2][2];
        v4u tAl[4], tBe[4], tKa[4], tRh[4];
        cm_build(wAl, cAl); cm_build(wV, cV); cm_build(wBp, cBp); cm_build(wKp, cKp); cm_build(wRh, cRh);
        {   v4u cBe[2][2], cKa[2][2]; cm_build(wBe, cBe); cm_build(wKa, cKa);
#define TRANSPOSE(cZ, tZ) do { _Pragma("unroll") for (int ct = 0; ct < 2; ++ct) { f32x16 T_ = mm(cZ[ct][0], Id[0], zero16()); T_ = mm(cZ[ct][1], Id[1], T_); tZ[2 * ct] = cvtf<0, 0>(T_); tZ[2 * ct + 1] = cvtf<1, 0>(T_); } } while (0)
            TRANSPOSE(cAl, tAl); TRANSPOSE(cBe, tBe); TRANSPOSE(cKa, tKa); TRANSPOSE(cRh, tRh);
#undef TRANSPOSE
        }
#define PROD4(A, B) mm(A[3], B[3], mm(A[2], B[2], mm(A[1], B[1], mm(A[0], B[0], zero16()))))
        f32x16 XN = mask_acc<0>(PROD4(tAl, tBe), n, hh), XT = mask_acc<1>(PROD4(tBe, tAl), n, hh);
        v4u fLM[2], fGB[2], fGK[2];
        { const f32x16 t = mask_acc<1>(PROD4(tKa, tAl), n, hh); fLM[0] = cvtf<0, 0>(t); fLM[1] = cvtf<1, 0>(t); }
        { const f32x16 t = mask_acc<2>(PROD4(tBe, tRh), n, hh); fGB[0] = cvtf<0, 0>(t); fGB[1] = cvtf<1, 0>(t); }
        { const f32x16 t = mask_acc<2>(PROD4(tKa, tRh), n, hh); fGK[0] = cvtf<0, 0>(t); fGK[1] = cvtf<1, 0>(t); }
#undef PROD4
#pragma unroll
        for (int r = 0; r < 16; ++r) { XN[r] = -XN[r]; XT[r] = -XT[r]; }
        f32x16 RT = XT;
#pragma unroll
        for (int r = 0; r < 16; ++r) RT[r] += ((r & 3) + 8 * (r >> 2) + 4 * hh == n) ? 1.f : 0.f;
#pragma unroll
        for (int pw = 1; pw < 5; ++pw) {
            const v4u xn0 = cvtf<0, 0>(XN), xn1 = cvtf<1, 0>(XN), xt0 = cvtf<0, 0>(XT), xt1 = cvtf<1, 0>(XT);
            XN = mm(xt1, xn1, mm(xt0, xn0, zero16()));
            if (pw < 4) XT = mm(xn1, xt1, mm(xn0, xt0, zero16()));
            const v4u yn0 = cvtf<0, 0>(XN), yn1 = cvtf<1, 0>(XN), rt0 = cvtf<0, 0>(RT), rt1 = cvtf<1, 0>(RT);
            RT = mm(yn1, rt1, mm(yn0, rt0, RT));
        }
        const v4u fA0 = cvtf<0, 0>(RT), fA1 = cvtf<1, 0>(RT);
        f32x16 At[2], Vt[2];
#pragma unroll
        for (int t = 0; t < 2; ++t) {
            const f32x16 lmv = mm(fLM[1], cV[t][1], mm(fLM[0], cV[t][0], zero16()));
            At[t] = mm(fA1, cAl[t][1], mm(fA0, cAl[t][0], zero16()));
            Vt[t] = mm(fA1, cvtf<1, 0>(lmv), mm(fA0, cvtf<0, 0>(lmv), zero16()));
        }
#pragma unroll
        for (int kt1 = 0; kt1 < 2; ++kt1) { const v4u a0 = cvtf<0, 0>(At[kt1]), a1 = cvtf<1, 0>(At[kt1]);
#pragma unroll
            for (int kt2 = 0; kt2 < 2; ++kt2) { const f32x16 g = mm(a1, cBp[kt2][1], mm(a0, cBp[kt2][0], zero16()));
                st16(img, CH_G + ((kt2 * 2 + kt1) * 2 + 0) * 1024, lane, cvtf<0, 1>(g)); st16(img, CH_G + ((kt2 * 2 + kt1) * 2 + 1) * 1024, lane, cvtf<1, 1>(g)); } }
#pragma unroll
        for (int vt = 0; vt < 2; ++vt) { const v4u nv0 = cvtf<0, 1>(Vt[vt]), nv1 = cvtf<1, 1>(Vt[vt]);
#pragma unroll
            for (int kt = 0; kt < 2; ++kt) { f32x16 u = mm(cKp[kt][1], cV[vt][1], mm(cKp[kt][0], cV[vt][0], zero16())); u = mm(cBp[kt][1], nv1, mm(cBp[kt][0], nv0, u));
                st16(img, CH_UT + ((kt * 2 + vt) * 2 + 0) * 1024, lane, cvtf<0, 0>(u)); st16(img, CH_UT + ((kt * 2 + vt) * 2 + 1) * 1024, lane, cvtf<1, 0>(u)); }
            f32x16 y = mm(cV[vt][1], fGK[1], mm(cV[vt][0], fGK[0], zero16())); y = mm(nv1, fGB[1], mm(nv0, fGB[0], y));
            st16(img, CH_YL + (vt * 2 + 0) * 1024, lane, cvtf<0, 0>(y)); st16(img, CH_YL + (vt * 2 + 1) * 1024, lane, cvtf<1, 0>(y)); }
#pragma unroll
        for (int kt = 0; kt < 2; ++kt) { f32x16 q = mm(cRh[kt][1], Id[1], mm(cRh[kt][0], Id[0], zero16()));
            q = mm(cvtf<1, 1>(At[kt]), fGB[1], mm(cvtf<0, 1>(At[kt]), fGB[0], q));
            st16(img, CH_Q + (kt * 2 + 0) * 1024, lane, cvtf<0, 0>(q)); st16(img, CH_Q + (kt * 2 + 1) * 1024, lane, cvtf<1, 0>(q)); }
    }
}

__device__ __forceinline__ void ph_scan2(const KP& p, LAS unsigned char* lds, int l, int wave, int lane) {
    unsigned* sdone = (unsigned*)(p.ws + WS_CTL) + CW_SDONE + 64 * l;
#ifndef CQ_SLOT_WGS
#define CQ_SLOT_WGS 128
#endif
    if (blockIdx.x >= SC_NCHAIN * 2) {
        const int q0 = (l < 2 ? CQ_J1 : CQ_END0) + (l & 1) * CQ_SLOT_ITEMS;
        cq_static(p, lds, q0, q0 + CQ_SLOT_ITEMS, ((int)blockIdx.x - SC_NCHAIN * 2) * NWAVES + wave, ((int)gridDim.x - SC_NCHAIN * 2) * NWAVES, wave, lane); return; }
    const int chain = blockIdx.x >> 1, vt = blockIdx.x & 1, dir = chain & 1, h = (chain >> 1) & 7, b = chain >> 4;
    const int n = lane & 31, hh = lane >> 5;
    const unsigned char* CH = p.ws + WS_CH + (size_t)chain * SC_NCH * CH_BYTES; bf16* Y = (bf16*)(p.ws + WS_Y) + (size_t)dir * MROWS * RW + h * 64 + 32 * vt + 4 * hh;
    constexpr int NPIECE = 19, SLOT = NPIECE * 1024, NSLOT = 6, PD = 4, XCH = NSLOT * SLOT;
    int psrc[3], pdst[3];
#pragma unroll
    for (int j = 0; j < 3; ++j) { int f = wave + 8 * j; if (f >= NPIECE) f -= NPIECE;
        pdst[j] = f;
        psrc[j] = f < 12 ? f * 1024 : f < 16 ? CH_UT + ((((f - 12) >> 1) * 2 + vt) * 2 + ((f - 12) & 1)) * 1024 : f < 18 ? CH_YL + (vt * 2 + (f - 16)) * 1024 : CH_EC; }
    const int lane_off[3] = {pdst[0] == 18 ? (lane * 16) & 255 : lane * 16, pdst[1] == 18 ? (lane * 16) & 255 : lane * 16, pdst[2] == 18 ? (lane * 16) & 255 : lane * 16};
#define SC2_ISSUE(ci_, slot_) do { const unsigned char* im_ = CH + (size_t)(ci_) * CH_BYTES; LAS unsigned char* sl_ = lds + (slot_) * SLOT; \
        _Pragma("unroll") for (int j = 0; j < 3; ++j) __builtin_amdgcn_global_load_lds((const unsigned*)(im_ + psrc[j] + lane_off[j]), (LAS unsigned*)(sl_ + pdst[j] * 1024), 16, 0, 0); } while (0)
#define SC2_LD(slot_, piece_) (*(const LAS v4u*)(lds + (slot_) * SLOT + (piece_) * 1024 + lane * 16))
#define SC2_X(par_, k_) (*(LAS v4u*)(lds + XCH + (par_) * 4096 + (k_) * 1024 + lane * 16))
    f32x16 ST[2] = {zero16(), zero16()};
    SC2_ISSUE(0, 0); SC2_ISSUE(1, 1); SC2_ISSUE(2, 2); SC2_ISSUE(3, 3);
    for (int ci = 0; ci <= SC_NCH; ++ci) {
        const int slot = ci % NSLOT;
        asm volatile("s_waitcnt vmcnt(9)" ::: "memory");
        __builtin_amdgcn_s_barrier();
        asm volatile("" ::: "memory");
        { const int nx = ci + PD < SC_NCH ? ci + PD : SC_NCH - 1; SC2_ISSUE(nx, (ci + PD) % NSLOT); }
        if (wave == 0 && ci < SC_NCH) {
            v4u g0 = SC2_LD(slot, 0), g1 = SC2_LD(slot, 1), g2 = SC2_LD(slot, 2), g3 = SC2_LD(slot, 3), g4 = SC2_LD(slot, 4), g5 = SC2_LD(slot, 5), g6 = SC2_LD(slot, 6), g7 = SC2_LD(slot, 7);
            v4u u0 = SC2_LD(slot, 12), u1 = SC2_LD(slot, 13), u2 = SC2_LD(slot, 14), u3 = SC2_LD(slot, 15);
            f32x4 ec[8];
#pragma unroll
            for (int kq = 0; kq < 8; ++kq) ec[kq] = *(const LAS f32x4*)(lds + slot * SLOT + 18 * 1024 + (32 * (kq >> 2) + 8 * (kq & 3) + 4 * hh) * 4);
            asm volatile("" : "+v"(g0), "+v"(g1), "+v"(g2), "+v"(g3), "+v"(g4), "+v"(g5), "+v"(g6), "+v"(g7), "+v"(u0), "+v"(u1), "+v"(u2), "+v"(u3));
            asm volatile("" : "+v"(ec[0]), "+v"(ec[1]), "+v"(ec[2]), "+v"(ec[3]), "+v"(ec[4]), "+v"(ec[5]), "+v"(ec[6]), "+v"(ec[7]));
            const v4u s00 = cvtf<0, 0>(ST[0]), s01 = cvtf<1, 0>(ST[0]), s10 = cvtf<0, 0>(ST[1]), s11 = cvtf<1, 0>(ST[1]);
            SC2_X(ci & 1, 0) = s00; SC2_X(ci & 1, 1) = s01; SC2_X(ci & 1, 2) = s10; SC2_X(ci & 1, 3) = s11;
            f32x16 a0, a1;
            a0[0] = bflo(u0.x); a0[1] = bfhi(u0.x); a0[2] = bflo(u0.y); a0[3] = bfhi(u0.y); a0[4] = bflo(u0.z); a0[5] = bfhi(u0.z); a0[6] = bflo(u0.w); a0[7] = bfhi(u0.w);
            a0[8] = bflo(u1.x); a0[9] = bfhi(u1.x); a0[10] = bflo(u1.y); a0[11] = bfhi(u1.y); a0[12] = bflo(u1.z); a0[13] = bfhi(u1.z); a0[14] = bflo(u1.w); a0[15] = bfhi(u1.w);
            a1[0] = bflo(u2.x); a1[1] = bfhi(u2.x); a1[2] = bflo(u2.y); a1[3] = bfhi(u2.y); a1[4] = bflo(u2.z); a1[5] = bfhi(u2.z); a1[6] = bflo(u2.w); a1[7] = bfhi(u2.w);
            a1[8] = bflo(u3.x); a1[9] = bfhi(u3.x); a1[10] = bflo(u3.y); a1[11] = bfhi(u3.y); a1[12] = bflo(u3.z); a1[13] = bfhi(u3.z); a1[14] = bflo(u3.w); a1[15] = bfhi(u3.w);
#pragma unroll
            for (int q = 0; q < 4; ++q)
#pragma unroll
                for (int e = 0; e < 4; ++e) { a0[4 * q + e] += ST[0][4 * q + e] * ec[q][e]; a1[4 * q + e] += ST[1][4 * q + e] * ec[4 + q][e]; }
            a0 = mm(g0, s00, a0); a1 = mm(g4, s00, a1); a0 = mm(g1, s01, a0); a1 = mm(g5, s01, a1);
            a0 = mm(g2, s10, a0); a1 = mm(g6, s10, a1); a0 = mm(g3, s11, a0); a1 = mm(g7, s11, a1);
            ST[0] = a0; ST[1] = a1;
            if (lane == 0 && ci == SC_NCH - 24) __hip_atomic_fetch_add(sdone, 1u, __ATOMIC_RELAXED, __HIP_MEMORY_SCOPE_AGENT);
        } else if (wave == 1 && ci >= 1) {
            const int cj = ci - 1, sj = cj % NSLOT, par = cj & 1;
            v4u ya = SC2_LD(sj, 16), yc = SC2_LD(sj, 17), q0 = SC2_LD(sj, 8), q1 = SC2_LD(sj, 9), q2 = SC2_LD(sj, 10), q3 = SC2_LD(sj, 11), x0 = SC2_X(par, 0), x1 = SC2_X(par, 1), x2 = SC2_X(par, 2), x3 = SC2_X(par, 3);
            asm volatile("" : "+v"(ya), "+v"(yc), "+v"(q0), "+v"(q1), "+v"(q2), "+v"(q3), "+v"(x0), "+v"(x1), "+v"(x2), "+v"(x3));
            f32x16 y, y2 = zero16();
            y[0] = bflo(ya.x); y[1] = bfhi(ya.x); y[2] = bflo(ya.y); y[3] = bfhi(ya.y); y[4] = bflo(ya.z); y[5] = bfhi(ya.z); y[6] = bflo(ya.w); y[7] = bfhi(ya.w);
            y[8] = bflo(yc.x); y[9] = bfhi(yc.x); y[10] = bflo(yc.y); y[11] = bfhi(yc.y); y[12] = bflo(yc.z); y[13] = bfhi(yc.z); y[14] = bflo(yc.w); y[15] = bfhi(yc.w);
            y = mm(x0, q0, y); y2 = mm(x2, q2, y2); y = mm(x1, q1, y); y2 = mm(x3, q3, y2);
            const int row = scan_row(b, dir, SC_C * cj + n); bf16* yo = Y + (size_t)row * RW;
#pragma unroll
            for (int q = 0; q < 4; ++q) *(v2u*)(yo + 8 * q) = (v2u){cvtpk(y[4 * q] + y2[4 * q], y[4 * q + 1] + y2[4 * q + 1]), cvtpk(y[4 * q + 2] + y2[4 * q + 2], y[4 * q + 3] + y2[4 * q + 3])};
        }
        asm volatile("s_waitcnt lgkmcnt(0)" ::: "memory");
    }
    asm volatile("s_waitcnt vmcnt(0)" ::: "memory");
#undef SC2_ISSUE
#undef SC2_LD
#undef SC2_X
}

__device__ __forceinline__ float sum8(float v) { v += __shfl_xor(v, 1); v += __shfl_xor(v, 2); v += __shfl_xor(v, 4); return v; }
__device__ __forceinline__ void unpack8(v4u s, float (&v)[8]) { v[0] = bflo(s.x); v[1] = bfhi(s.x); v[2] = bflo(s.y); v[3] = bfhi(s.y); v[4] = bflo(s.z); v[5] = bfhi(s.z); v[6] = bflo(s.w); v[7] = bfhi(s.w); }
__device__ __forceinline__ void ld8f(const float* q, float (&v)[8]) { const f32x4 a = *(const f32x4*)q, b = *(const f32x4*)(q + 4); v[0] = a[0]; v[1] = a[1]; v[2] = a[2]; v[3] = a[3]; v[4] = b[0]; v[5] = b[1]; v[6] = b[2]; v[7] = b[3]; }
__device__ __forceinline__ v4u pack8(const float (&v)[8]) { v4u o; o.x = cvtpk(v[0], v[1]); o.y = cvtpk(v[2], v[3]); o.z = cvtpk(v[4], v[5]); o.w = cvtpk(v[6], v[7]); return o; }

__device__ __forceinline__ void ph_readout2(const KP& p, int l, int gw, int NGW, int lane) {
    const bf16* P = (const bf16*)(p.ws + WS_P); const bf16* LO = (const bf16*)(p.ws + WS_LO); const bf16* Y = (const bf16*)(p.ws + WS_Y);
    bf16* MI = (bf16*)(p.ws + WS_MIXIN); constexpr size_t PA = (size_t)MROWS * RW; const int c0 = lane * 8;
    for (int row = gw; row < MROWS; row += NGW) { const bf16* pr = P + (size_t)row * NP; const bf16* lo = LO + (size_t)row * NLO;
        int t, len; if (row < NLAT) { t = row & 63; len = 64; } else { t = (row - NLAT) & 255; len = 256; }
        const v4u kw = *(const v4u*)(pr + PC_K + c0), rw = *(const v4u*)(pr + PC_R + c0), vw = *(const v4u*)(pr + PC_V + c0);
        const v4u cbw = *(const v4u*)(pr + PC_CB + c0), ccw = *(const v4u*)(pr + PC_CC + c0), chw = *(const v4u*)(pr + PC_CH + c0);
        v4u ccp = (v4u){0u, 0u, 0u, 0u}, chp = ccp, ccn = ccp, chn = ccp;
        if (t > 0) { ccp = *(const v4u*)(pr - NP + PC_CC + c0); chp = *(const v4u*)(pr - NP + PC_CH + c0); }
        if (t < len - 1) { ccn = *(const v4u*)(pr + NP + PC_CC + c0); chn = *(const v4u*)(pr + NP + PC_CH + c0); }
        float yf[8], yb[8], la0[8], la1[8], g[8];
        unpack8(*(const v4u*)(Y + (size_t)row * RW + c0), yf); unpack8(*(const v4u*)(Y + PA + (size_t)row * RW + c0), yb); unpack8(*(const v4u*)(lo + 1024 + c0), la0); unpack8(*(const v4u*)(lo + 1536 + c0), la1); unpack8(*(const v4u*)(lo + 2048 + c0), g);
        float a0[8], a1[8], ka[8], rkp[8], lg[8], lb[8];
        ld8f(p.in[I_A0] + (l * 2 + 0) * RW + c0, a0); ld8f(p.in[I_A0] + (l * 2 + 1) * RW + c0, a1); ld8f(p.in[I_KA] + l * RW + c0, ka); ld8f(p.in[I_RK] + l * RW + c0, rkp);
        ld8f(p.in[I_LNXG] + l * RW + c0, lg); ld8f(p.in[I_LNXB] + l * RW + c0, lb);
        float kv[8], rv[8], vv[8]; unpack8(kw, kv); unpack8(rw, rv); unpack8(vw, vv);
        float y[8], s = 0.f, rk = 0.f;
#pragma unroll
        for (int j = 0; j < 8; ++j) { y[j] = yf[j] + yb[j]; s += y[j]; const float av = sigm(a0[j] + la0[j]) + sigm(a1[j] + la1[j]); rk += rv[j] * kv[j] * (2.f + (av - 2.f) * ka[j]) * rkp[j]; }
        const float mu = sum8(s) * (1.f / 64.f); rk = sum8(rk); float q = 0.f;
#pragma unroll
        for (int j = 0; j < 8; ++j) { y[j] -= mu; q += y[j] * y[j]; }
        const float rstd = 1.f / sqrtf(sum8(q) * (1.f / 64.f) + GN_EPS);
        float o[8];
#pragma unroll
        for (int j = 0; j < 8; ++j) o[j] = (y[j] * rstd * lg[j] + lb[j] + rk * vv[j]) * g[j];
        *(v4u*)(MI + (size_t)row * D + c0) = pack8(o);
        float cb[8], cc[8], ch[8], pcc[8], pch[8], ncc[8], nch[8], w0[8], w1[8], w2[8];
        unpack8(cbw, cb); unpack8(ccw, cc); unpack8(chw, ch); unpack8(ccp, pcc); unpack8(chp, pch); unpack8(ccn, ncc); unpack8(chn, nch);
        const float* cw = p.in[I_CONVW] + (size_t)l * 3 * RW + c0; ld8f(cw, w0); ld8f(cw + RW, w1); ld8f(cw + 2 * RW, w2);
#pragma unroll
        for (int j = 0; j < 8; ++j) o[j] = cb[j] * (pcc[j] * pch[j] * w0[j] + cc[j] * ch[j] * w1[j] + ncc[j] * nch[j] * w2[j]);
        *(v4u*)(MI + (size_t)row * D + RW + c0) = pack8(o);
    }
}


template <int KS> __device__ __forceinline__ void lora_task(const bf16* pr, int col0, int fn, const bf16* wt, bf16* out, int ct0, int n, int hh) {
    v4u af[KS];
#pragma unroll
    for (int s = 0; s < KS; ++s) { const v4u w = *(const v4u*)(pr + col0 + 16 * s + 8 * hh); float v[8]; unpack8(w, v);
        if (fn == 0) {
#pragma unroll
            for (int j = 0; j < 8; ++j) v[j] = 1.f - 2.f * __builtin_amdgcn_rcpf(1.f + __expf(2.f * v[j])); }
        else if (fn == 2) {
#pragma unroll
            for (int j = 0; j < 8; ++j) v[j] = __builtin_amdgcn_rcpf(1.f + __expf(-v[j])); }
        af[s] = pack8(v); }
#pragma unroll 2
    for (int ct = ct0; ct < ct0 + 8; ++ct) { f32x16 acc = zero16(); const bf16* wb = wt + (size_t)(32 * ct + n) * (16 * KS) + 8 * hh;
#pragma unroll
        for (int s = 0; s < KS; ++s) acc = mm(af[s], *(const v4u*)(wb + 16 * s), acc);
#pragma unroll
        for (int r = 0; r < 16; ++r) out[(size_t)((r & 3) + 8 * (r >> 2) + 4 * hh) * NLO + 32 * ct + n] = (bf16)f2bf(acc[r]); }
}
__device__ __forceinline__ void ph_lora(const KP& p, int l, int gw, int NGW, int lane) {
    const bf16* P = (const bf16*)(p.ws + WS_P); bf16* LO = (bf16*)(p.ws + WS_LO); float* NRM = (float*)(p.ws + WS_RKS);
    const bf16* LW = (const bf16*)(p.ws + WS_LORA) + (size_t)l * LORAW_PER_LAYER; const int n = lane & 31, hh = lane >> 5;
    for (int task = gw; task < (MROWS / 32) * 10; task += NGW) { const int half = task & 1, grp = (task >> 1) % 5, rb = task / 10;
        const bf16* pr = P + (size_t)(rb * 32 + n) * NP; bf16* out = LO + (size_t)(rb * 32) * NLO + grp * 512;
        if (grp < 4) lora_task<4>(pr, grp < 2 ? PC_WD + 64 * grp : PC_AD + 64 * (grp - 2), grp < 2 ? 0 : 1, LW + (size_t)grp * 512 * 64, out, half * 8, n, hh);
        else lora_task<8>(pr, PC_GD, 2, LW + (size_t)4 * 512 * 64, out, half * 8, n, hh); }
    float kkc[8]; ld8f(p.in[I_KK] + l * RW + lane * 8, kkc);
    for (int row = gw; row < MROWS; row += NGW) { const v4u kw = *(const v4u*)(P + (size_t)row * NP + PC_K + lane * 8); float kv[8]; unpack8(kw, kv); float ss = 0.f;
#pragma unroll
        for (int j = 0; j < 8; ++j) { const float t = kv[j] * kkc[j]; ss += t * t; }
        ss = sum8(ss); if ((lane & 7) == 0) NRM[row * 8 + (lane >> 3)] = 1.f / fmaxf(sqrtf(ss), 1e-12f); }
}

__device__ __forceinline__ void ph_moe_gather(const KP& p, int l, int gw, int NGW, int lane) {
    const unsigned* gcnt = (const unsigned*)(p.ws + WS_CTL) + CW_GCNT + 64 * (l >> 1);
    int cnt[8], pb[9]; pb[0] = 0;
#pragma unroll
    for (int e = 0; e < 8; ++e) { cnt[e] = (int)gcnt[e]; pb[e + 1] = pb[e] + ((cnt[e] + 255) & ~255); }
    const unsigned* rowlist = (const unsigned*)(p.ws + WS_ROWLIST); const float* wsel = (const float*)(p.ws + WS_WSEL); float* wsort = (float*)(p.ws + WS_WSORT);
    const bf16* H = (const bf16*)(p.ws + WS_H); bf16* HG = (bf16*)(p.ws + WS_HG);
    for (int pos = gw; pos < pb[8]; pos += NGW) {
        int e = 0, base = 0, ce = cnt[0];
#pragma unroll
        for (int k = 1; k < 8; ++k) if (pos >= pb[k]) { e = k; base = pb[k]; ce = cnt[k]; }
        const int rank = pos - base; v4u a = (v4u){0u, 0u, 0u, 0u}, b = a; float w = 0.f;
        if (rank < ce) { const unsigned ent = rowlist[(size_t)e * MROWS + rank]; const v4u* src = (const v4u*)(H + (size_t)(ent >> 1) * D); a = src[lane]; b = src[64 + lane]; w = wsel[ent]; }
        v4u* dst = (v4u*)(HG + (size_t)pos * D); dst[lane] = a; dst[64 + lane] = b;
        if (lane == 0) wsort[pos] = w;
    }
}

__device__ __forceinline__ void ph_ln(const KP& p, LAS unsigned char* lds, int l, int which, int tid, int wave, int gw, int NGW, int lane) {
    const float* modv = (const float*)(p.ws + WS_MODV); float* X = (float*)(p.ws + WS_X); bf16* H = (bf16*)(p.ws + WS_H);
    const bf16* BR = (const bf16*)(p.ws + (which == 0 ? WS_MIXO : WS_F)); const float* BP = (const float*)(p.ws + (which == 0 ? WS_MIXP : WS_FP));
    const float* lg = p.in[which == 0 ? I_LN1G : I_LN2G] + l * D; const float* lb = p.in[which == 0 ? I_LN1B : I_LN2B] + l * D;
    const bool moe = (which == 0) && (l & 1); const bool last = (which == 1) && (l == DEPTH - 1); const bool moe_out = (which == 1) && (l & 1);
    LAS int* lcnt = (LAS int*)lds;
    LAS int* lsel = (LAS int*)(lds + 64);
    int nloc = 0;
    if (moe) { if (tid < 16) lcnt[tid] = 0; __syncthreads(); }
    int pbs[9]; pbs[0] = 0;
    if (moe_out) { const unsigned* gcnt = (const unsigned*)(p.ws + WS_CTL) + CW_GCNT + 64 * (l >> 1);
#pragma unroll
        for (int e = 0; e < 8; ++e) pbs[e + 1] = pbs[e] + (int)((gcnt[e] + 255u) & ~255u); }
    f32x4 gt[4], g4[4], b4[4], sh[4], sc[4]; ld_row(lg, lane, g4); ld_row(lb, lane, b4);
    for (int it = 0; it < 9; ++it) {
        if (it == 8 && gw >= NCTX) break;
        const int row = it < 8 ? (gw >> 9) * SEQ + (gw & 511) + 512 * it : NLAT + gw;
        const int mr = mod_row(row); const float* mv = modv + (size_t)(l * 5 + mr) * NMOD;
        if (it == 0 || it == 8) { ld_row(mv + (which == 0 ? 2048 : 5120), lane, gt);
            if (!last) { const float* mv2 = which == 0 ? mv + 3072 : modv + (size_t)((l + 1) * 5 + mr) * NMOD; ld_row(mv2, lane, sh); ld_row(mv2 + 1024, lane, sc); } }
        f32x4 x[4], br[4], t[4]; ld_row(X + (size_t)row * D, lane, x);
        if (moe_out) { const int* ts = (const int*)(p.ws + WS_TOKSEL) + row * 4; const int e0 = ts[0], r0 = ts[1], e1 = ts[2], r1 = ts[3]; int b0 = 0, b1 = 0;
#pragma unroll
            for (int k = 1; k < 8; ++k) { if (e0 >= k) b0 = pbs[k]; if (e1 >= k) b1 = pbs[k]; }
            f32x4 ba[4], bb[4]; const int q0 = b0 + r0, q1 = b1 + r1; constexpr int MM = MOE_MAIN_PANELS * 256;
            if (q0 < MM) ld_row_bf16(BR + (size_t)q0 * D, lane, ba); else ld_row_parts<4>(BP + (size_t)(q0 - MM) * D, (size_t)MOE_TAIL_ROWS * D, lane, ba);
            if (q1 < MM) ld_row_bf16(BR + (size_t)q1 * D, lane, bb); else ld_row_parts<4>(BP + (size_t)(q1 - MM) * D, (size_t)MOE_TAIL_ROWS * D, lane, bb);
#pragma unroll
            for (int j = 0; j < 4; ++j) br[j] = ba[j] + bb[j]; }
        else if (row < NLAT) ld_row_bf16(BR + (size_t)row * D, lane, br);
        else if (which == 0) ld_row_parts<4>(BP + (size_t)(row - NLAT) * D, (size_t)NCTX * D, lane, br);
        else ld_row_parts<7>(BP + (size_t)(row - NLAT) * D, (size_t)NCTX * D, lane, br);
        float s = 0.f;
#pragma unroll
        for (int j = 0; j < 4; ++j) { t[j] = DN_ALPHA * x[j] + gt[j] * br[j]; s += (t[j][0] + t[j][1]) + (t[j][2] + t[j][3]); }
        const float mean = wave_sum(s) * (1.f / D); float s2 = 0.f;
#pragma unroll
        for (int j = 0; j < 4; ++j) { t[j] = t[j] - mean; s2 += (t[j][0] * t[j][0] + t[j][1] * t[j][1]) + (t[j][2] * t[j][2] + t[j][3] * t[j][3]); }
        const float rstd = 1.f / sqrtf(wave_sum(s2) * (1.f / D) + LN_EPS);
#pragma unroll
        for (int j = 0; j < 4; ++j) x[j] = t[j] * rstd * g4[j] + b4[j];
        if (last) { if (row < NLAT) st_row(p.out + (size_t)row * D, lane, x); continue; }
        st_row(X + (size_t)row * D, lane, x);
        f32x4 hh[4];
#pragma unroll
        for (int j = 0; j < 4; ++j) hh[j] = x[j] * (1.f + sc[j]) + sh[j];
        st_row_bf16(H + (size_t)row * D, lane, hh);
        if (moe) {
            const float* rw = p.in[I_RTW] + (size_t)(l >> 1) * D * NE; float lgt[8];
#pragma unroll
            for (int e = 0; e < 8; ++e) lgt[e] = 0.f;
#pragma unroll
            for (int j = 0; j < 4; ++j)
#pragma unroll
                for (int i = 0; i < 4; ++i) { const f32x4* wp = (const f32x4*)(rw + (size_t)(4 * lane + 256 * j + i) * NE); const f32x4 w0 = wp[0], w1 = wp[1]; const float hv = hh[j][i];
                    lgt[0] += hv * w0[0]; lgt[1] += hv * w0[1]; lgt[2] += hv * w0[2]; lgt[3] += hv * w0[3]; lgt[4] += hv * w1[0]; lgt[5] += hv * w1[1]; lgt[6] += hv * w1[2]; lgt[7] += hv * w1[3]; }
#pragma unroll
            for (int e = 0; e < 8; ++e) lgt[e] = wave_sum(lgt[e]) + p.in[I_RTB][(l >> 1) * NE + e];
            float v0 = lgt[0]; int i0 = 0;
#pragma unroll
            for (int e = 1; e < 8; ++e) if (lgt[e] > v0) { v0 = lgt[e]; i0 = e; }
            float v1 = -3.0e38f; int i1 = -1;
#pragma unroll
            for (int e = 0; e < 8; ++e) if (e != i0 && lgt[e] > v1) { v1 = lgt[e]; i1 = e; }
            const float w0 = 1.f / (1.f + expf(v1 - v0)), w1 = 1.f - w0;
            if (lane == 0) { const int lr0 = __hip_atomic_fetch_add(lcnt + i0, 1, __ATOMIC_RELAXED, __HIP_MEMORY_SCOPE_WORKGROUP), lr1 = __hip_atomic_fetch_add(lcnt + i1, 1, __ATOMIC_RELAXED, __HIP_MEMORY_SCOPE_WORKGROUP); const int li = nloc * NWAVES + wave;
                lsel[li * 8 + 0] = row; lsel[li * 8 + 1] = i0; lsel[li * 8 + 2] = lr0; lsel[li * 8 + 3] = i1; lsel[li * 8 + 4] = lr1;
                ((float*)(p.ws + WS_WSEL))[row * 2] = w0; ((float*)(p.ws + WS_WSEL))[row * 2 + 1] = w1; }
            ++nloc;
        }
    }
    if (moe) {
        __syncthreads();
        unsigned* gcnt = (unsigned*)(p.ws + WS_CTL) + CW_GCNT + 64 * (l >> 1);
        if (tid < 8) lcnt[8 + tid] = (int)__hip_atomic_fetch_add(gcnt + tid, (unsigned)lcnt[tid], __ATOMIC_RELAXED, __HIP_MEMORY_SCOPE_AGENT);
        __syncthreads();
        unsigned* rowlist = (unsigned*)(p.ws + WS_ROWLIST); int* toksel = (int*)(p.ws + WS_TOKSEL);
        if (tid < 16 * NWAVES) { const int k = tid / NWAVES, w = tid % NWAVES; if (k < 8 || (k == 8 && (int)blockIdx.x * NWAVES + w < NCTX)) { const int li = k * NWAVES + w;
            const int row = lsel[li * 8 + 0], e0 = lsel[li * 8 + 1], r0 = lcnt[8 + e0] + lsel[li * 8 + 2], e1 = lsel[li * 8 + 3], r1 = lcnt[8 + e1] + lsel[li * 8 + 4];
            rowlist[(size_t)e0 * MROWS + r0] = (unsigned)row * 2u; rowlist[(size_t)e1 * MROWS + r1] = (unsigned)row * 2u + 1u;
            toksel[row * 4 + 0] = e0; toksel[row * 4 + 1] = r0; toksel[row * 4 + 2] = e1; toksel[row * 4 + 3] = r1; } }
    }
}

__global__ void __launch_bounds__(NWAVES * 64, 2) fwd_kernel(KP p) {
    extern __shared__ __attribute__((aligned(16))) unsigned char lds_raw[];
    LAS unsigned char* lds = (LAS unsigned char*)lds_raw;
    volatile LAS unsigned* MISC = (volatile LAS unsigned*)(lds + MISC_OFF);
    const int G = gridDim.x, NGW = G * NWAVES;
    for (int u = threadIdx.x; u < (LDS_BYTES - LDSCTL_OFF) / 4; u += NWAVES * 64) ((LAS unsigned*)(lds + LDSCTL_OFF))[u] = 0u;
    __syncthreads();
    unsigned* ctl = (unsigned*)(p.ws + WS_CTL);
    const bool single = p.ph < 0;
    XcdBarrier bar; bar.bar = ctl + CW_BAR; bar.x = 0; bar.st = nullptr;
    if (single) bar = xcd_barrier_post(ctl + CW_BAR, MISC + 8);
    int phc = 0;
#ifndef PROBE_DUP
#define PROBE_DUP 0
#endif
#define REP(bit) for (int rep_ = 0; rep_ < ((PROBE_DUP & (bit)) ? 2 : 1); ++rep_)
#define RUN() (single || p.ph == phc)
#define FRESH() int tid = threadIdx.x; asm volatile("" : "+v"(tid)); const int lane = tid & 63, wave = __builtin_amdgcn_readfirstlane(tid >> 6), gw = blockIdx.x * NWAVES + wave; (void)lane; (void)gw
#define SEAM() do { if (single) { XcdBarrier b2_ = bar; asm volatile("" : "+s"(b2_.bar)); xcd_barrier(b2_); if (PROBE_DUP & 32) { XcdBarrier b3_ = bar; asm volatile("" : "+s"(b3_.bar)); xcd_barrier(b3_); } } ++phc; } while (0)

    bf16* H = (bf16*)(p.ws + WS_H); bf16* Pm = (bf16*)(p.ws + WS_P);
    REP(4) if (RUN()) { FRESH(); ph_modvec(p, lds, tid); __syncthreads(); ph_convert(p, lds, gw, NGW, wave, lane); cq_static(p, lds, 0, CQ_J1, gw, NGW, wave, lane); }
    SEAM();
    if (RUN()) { FRESH(); ph_init_rows(p, gw, NGW, lane); }
    SEAM();
    for (int l = 0; l < DEPTH; ++l) {
         if (RUN()) { pg8::Gemm g{H, (const bf16*)(p.ws + WS_WIN) + (size_t)l * NP * D, MROWS, NP, D, D}; pg8::StaticOrder S; S.init(MROWS, NP, G, (int)blockIdx.x);
            pg8::EpiBf16<0> E{Pm, NP, nullptr, 0, 0, 1.f}; pg8::gemm_phase<pg8::EpiBf16<0>, pg8::StaticOrder, true, true>(lds, g, S, E); }
        SEAM();
        REP(8) if (RUN()) { FRESH(); ph_lora(p, l, gw, NGW, lane); }
        SEAM();
        REP(1) if (RUN()) { FRESH(); ph_scan1(p, l, gw, NGW, lane); }
        SEAM();
        REP(2) if (RUN()) { FRESH(); ph_scan2(p, lds, l, wave, lane); }
        SEAM();
        REP(64) if (RUN()) { FRESH(); ph_readout2(p, l, gw, NGW, lane); }
        SEAM();
         if (RUN()) {
            { pg8::Gemm g{(const bf16*)(p.ws + WS_MIXIN), (const bf16*)(p.ws + WS_WOUT) + (size_t)l * D * D, NLAT, D, D, D}; pg8::StaticOrder S; S.init(NLAT, D, G, (int)blockIdx.x);
              pg8::EpiBf16<0> E{(bf16*)(p.ws + WS_MIXO), D, nullptr, 0, 0, 1.f}; pg8::gemm_phase<pg8::EpiBf16<0>, pg8::StaticOrder, true, true>(lds, g, S, E); }
            { pg8::Gemm g{(const bf16*)(p.ws + WS_MIXIN), (const bf16*)(p.ws + WS_WOUT) + (size_t)l * D * D, NCTX, D, D / 4, D}; pg8::SplitOrder S{NCTX / 256, D / 256, 4, G, (int)blockIdx.x, NLAT / 256, 0, 0, 0, 0, 0, 0, 0, 0};
              pg8::EpiPart E{(float*)(p.ws + WS_MIXP), D, (size_t)NCTX * D, NLAT / 256}; pg8::gemm_phase<pg8::EpiPart, pg8::SplitOrder, true, true>(lds, g, S, E); }
        }
        SEAM();
        if (RUN()) { FRESH(); ph_ln(p, lds, l, 0, tid, wave, gw, NGW, lane); }
        SEAM();
        if ((l & 1) == 0) {
            const int fi = l >> 1;
             if (RUN()) { pg8::Gemm g{H, (const bf16*)(p.ws + WS_F13) + (size_t)fi * 2 * DFF * D, MROWS, 2 * DFF, D, D}; pg8::StaticOrder S; S.init(MROWS, 2 * DFF, G, (int)blockIdx.x);
                pg8::EpiSwiGLU E{(bf16*)(p.ws + WS_ACT), DFF, nullptr, 0}; pg8::gemm_phase<pg8::EpiSwiGLU, pg8::StaticOrder, true, true>(lds, g, S, E); }
            SEAM();
             if (RUN()) {
                { pg8::Gemm g{(const bf16*)(p.ws + WS_ACT), (const bf16*)(p.ws + WS_F2) + (size_t)fi * D * DFF, NLAT, D, DFF, DFF}; pg8::StaticOrder S; S.init(NLAT, D, G, (int)blockIdx.x);
                  pg8::EpiBf16<0> E{(bf16*)(p.ws + WS_F), D, nullptr, 0, 0, 1.f}; pg8::gemm_phase<pg8::EpiBf16<0>, pg8::StaticOrder, true, true>(lds, g, S, E); }
                { pg8::Gemm g{(const bf16*)(p.ws + WS_ACT), (const bf16*)(p.ws + WS_F2) + (size_t)fi * D * DFF, NCTX, D, DFF / 7, DFF}; pg8::SplitOrder S{NCTX / 256, D / 256, 7, G, (int)blockIdx.x, NLAT / 256, 0, 0, 0, 0, 0, 0, 0, 0};
                  pg8::EpiPart E{(float*)(p.ws + WS_FP), D, (size_t)NCTX * D, NLAT / 256}; pg8::gemm_phase<pg8::EpiPart, pg8::SplitOrder, true, true>(lds, g, S, E); }
            }
            SEAM();
        } else {
            REP(4) if (RUN()) { FRESH(); cq_static(p, lds, (l == 1 ? CQ_J1 : CQ_END0) + 2 * CQ_SLOT_ITEMS, l == 1 ? CQ_END0 : CQ_END1, gw, NGW, wave, lane); }
            SEAM();
            if (RUN()) { FRESH(); ph_moe_gather(p, l, gw, NGW, lane); }
            SEAM();
            {   const unsigned* gcnt = (const unsigned*)(p.ws + WS_CTL) + CW_GCNT + 64 * (l >> 1); int pbp[9]; pbp[0] = 0;
#pragma unroll
                for (int e = 0; e < 8; ++e) pbp[e + 1] = pbp[e] + (int)((gcnt[e] + 255u) >> 8);
                const int mrows = pbp[8] * 256;
                 if (RUN()) { pg8::Gemm g{(const bf16*)(p.ws + WS_HG), (const bf16*)(p.ws + WS_MOEW13), mrows, 2 * DFF, D, D}; pg8::MoeOrder S; S.init(mrows, 2 * DFF, G, (int)blockIdx.x);
                    S.pb1 = pbp[1]; S.pb2 = pbp[2]; S.pb3 = pbp[3]; S.pb4 = pbp[4]; S.pb5 = pbp[5]; S.pb6 = pbp[6]; S.pb7 = pbp[7]; S.estride = (size_t)2 * DFF * D;
                    pg8::EpiSwiGLU E{(bf16*)(p.ws + WS_ACT), DFF, (const float*)(p.ws + WS_WSORT), 1}; pg8::gemm_phase<pg8::EpiSwiGLU, pg8::MoeOrder, true, true>(lds, g, S, E); }
                SEAM();
                 if (RUN()) {
                    { pg8::Gemm g{(const bf16*)(p.ws + WS_ACT), (const bf16*)(p.ws + WS_MOEW2), MOE_MAIN_PANELS * 256, D, DFF, DFF}; pg8::MoeOrder S; S.init(MOE_MAIN_PANELS * 256, D, G, (int)blockIdx.x);
                      S.pb1 = pbp[1]; S.pb2 = pbp[2]; S.pb3 = pbp[3]; S.pb4 = pbp[4]; S.pb5 = pbp[5]; S.pb6 = pbp[6]; S.pb7 = pbp[7]; S.estride = (size_t)D * DFF;
                      pg8::EpiBf16<0> E{(bf16*)(p.ws + WS_F), D, nullptr, 0, 0, 1.f}; pg8::gemm_phase<pg8::EpiBf16<0>, pg8::MoeOrder, true, true>(lds, g, S, E); }
                    { const int nT = pbp[8] - MOE_MAIN_PANELS;
                      pg8::Gemm g{(const bf16*)(p.ws + WS_ACT), (const bf16*)(p.ws + WS_MOEW2), nT * 256, D, DFF / 4, DFF}; pg8::SplitOrder S{nT, D / 256, 4, G, (int)blockIdx.x, MOE_MAIN_PANELS, pbp[1], pbp[2], pbp[3], pbp[4], pbp[5], pbp[6], pbp[7], (size_t)D * DFF};
                      pg8::EpiPart E{(float*)(p.ws + WS_FP), D, (size_t)MOE_TAIL_ROWS * D, MOE_MAIN_PANELS}; pg8::gemm_phase<pg8::EpiPart, pg8::SplitOrder, true, true>(lds, g, S, E); }
                }
                SEAM();
            }
        }
        if (RUN()) { FRESH(); ph_ln(p, lds, l, 1, tid, wave, gw, NGW, lane); }
        SEAM();
    }
#undef RUN
#undef SEAM
}

#ifndef MK_PER_PHASE
#define MK_PER_PHASE 0
#endif
extern "C" void kernel_launch(void* const* d_in, const int* in_sizes, int n_in, void* d_out, int out_size, void* d_ws, size_t ws_size, hipStream_t stream) {
    static int grid = 0;
    if (grid == 0) {
        if (n_in != N_IN || in_sizes[0] != NLAT * D || out_size != NLAT * D || ws_size < WS_NEED) { fprintf(stderr, "kernel_launch: unexpected shapes / workspace (%d inputs, ws %zu, need %zu)\n", n_in, ws_size, (size_t)WS_NEED); grid = -1; return; }
        int dev = 0, cus = 0, per_cu = 0;
        if (hipGetDevice(&dev) != hipSuccess || hipDeviceGetAttribute(&cus, hipDeviceAttributeMultiprocessorCount, dev) != hipSuccess) { grid = -1; return; }
        if (hipFuncSetAttribute((const void*)fwd_kernel, hipFuncAttributeMaxDynamicSharedMemorySize, LDS_BYTES) != hipSuccess) { fprintf(stderr, "kernel_launch: hipFuncSetAttribute failed\n"); grid = -1; return; }
        if (hipOccupancyMaxActiveBlocksPerMultiprocessor(&per_cu, (const void*)fwd_kernel, NWAVES * 64, LDS_BYTES) != hipSuccess || per_cu < 1) fprintf(stderr, "kernel_launch: occupancy query says %d\n", per_cu);
        (void)hipGetLastError();
        grid = cus;
        if (grid != 256) { fprintf(stderr, "kernel_launch: built for a 256-CU device, found %d CUs\n", cus); grid = -1; return; }
    }
    if (grid < 0) return;
    if (hipMemsetAsync((char*)d_ws + WS_CTL, 0, CTL_BYTES, stream) != hipSuccess) return;
    KP p{};
    for (int i = 0; i < N_IN; ++i) p.in[i] = (const float*)d_in[i];
    p.out = (float*)d_out; p.ws = (unsigned char*)d_ws; p.pad = 0;
#if MK_PER_PHASE
    const int nph = 2 + 2 * 11 + 2 * 13;
    for (int ph = 0; ph < nph; ++ph) { p.ph = ph; hipLaunchKernelGGL(fwd_kernel, dim3(grid), dim3(NWAVES * 64), LDS_BYTES, stream, p); }
#else
    p.ph = -1;
    hipLaunchKernelGGL(fwd_kernel, dim3(grid), dim3(NWAVES * 64), LDS_BYTES, stream, p);
#endif
}
```

```cpp
#include <hip/hip_runtime.h>
#define PROBE_DUP 0
#define CQ_SLOT_WGS 0
#define CQ_SLOT_ITEMS 3500
#include <cstdio>
#include <cstdint>
namespace pg8 {
#define PG8_LAS __attribute__((address_space(3)))
typedef unsigned short bf16_t;
typedef short bf16x8 __attribute__((ext_vector_type(8)));
typedef float f32x4 __attribute__((ext_vector_type(4)));
typedef unsigned u32x4 __attribute__((ext_vector_type(4)));
constexpr int BM = 256, BK = 64, HALF = 128, HTB = HALF * BK * 2  , STAGE_BYTES = 8 * HTB, NXCD = 8, WGM = 8;

__host__ __device__ __forceinline__ int lds_byte(int r, int c) { const int st = (r >> 4) * 2 + (c >> 5), rr = r & 15, cc = c & 31, ob = rr * 64 + cc * 2; return st * 1024 + (ob ^ (((ob >> 9) & 1) << 5)); }
__host__ __device__ __forceinline__ void stage_rc(int b, int& R, int& C) { const int st = b / 1024, sb = b % 1024, swz = sb ^ (((sb >> 9) & 1) << 5); R = (st >> 1) * 16 + swz / 64; C = (st & 1) * 32 + (swz % 64) / 2; }
__host__ __device__ __forceinline__ int perm32(int rho) { const int n = rho >> 4, i = rho & 15; return 8 * (i >> 2) + 4 * n + (i & 3); }

struct Unit { int pm, pn, ks; };
struct Gemm { const bf16_t* A; const bf16_t* Bt; int M, N, K, ld; };

struct StaticOrder {
    int nM, nN, nwg, G, c;
    __host__ __device__ void init(int M, int N, int G_, int c_) { nM = M / BM; nN = N / BM; nwg = nM * nN; G = G_; c = c_; }
    __host__ __device__ bool next(int i, Unit& u) const {
        const long L = (long)i * G + c; if (L >= nwg) return false;
        int wgid = (int)L; { const int q = nwg / NXCD, r = nwg % NXCD, xcd = wgid % NXCD, off = wgid / NXCD; wgid = (xcd < r ? xcd * (q + 1) : r * (q + 1) + (xcd - r) * q) + off; }
        const int nig = WGM * nN, gid = wgid / nig, fm = gid * WGM, gsz = (nM - fm) < WGM ? (nM - fm) : WGM;
        u.pm = fm + ((wgid % nig) % gsz); u.pn = (wgid % nig) / gsz; u.ks = 0; return true;
    }
    __device__ __forceinline__ const char* abase(const Gemm& g, const Unit& u, size_t tstep) const { return (const char*)g.A + (size_t)u.pm * tstep; }
    __device__ __forceinline__ const char* bbase(const Gemm& g, const Unit& u, size_t tstep) const { return (const char*)g.Bt + (size_t)u.pn * tstep; }
    __device__ __forceinline__ void a_ready(const Unit&) const {}
    __device__ __forceinline__ void done(const Unit&) const {}
};

__device__ __forceinline__ unsigned cvt_pk_bf16(float lo, float hi) { unsigned r; asm volatile("v_cvt_pk_bf16_f32 %0, %1, %2" : "=v"(r) : "v"(lo), "v"(hi)); return r; }
typedef float f32x2 __attribute__((ext_vector_type(2)));
__device__ __forceinline__ f32x2 gelu_pk(f32x2 v) {
    const f32x2 av = __builtin_elementwise_abs(v), d = av * 0.2316418882f + 1.0f;
    f32x2 t; t.x = __builtin_amdgcn_rcpf(d.x); t.y = __builtin_amdgcn_rcpf(d.y);
    f32x2 q = t * 0.5307027145f + (-0.7265760135f); q = q * t + 0.7107068705f; q = q * t + (-0.142248368f); q = q * t + 0.127414796f; q = q * t;
    const f32x2 s = (v * v) * (-0.72134752044f);
    f32x2 e; e.x = __builtin_amdgcn_exp2f(s.x); e.y = __builtin_amdgcn_exp2f(s.y);
    const f32x2 m = v * (q * e), r = v - m;
    f32x2 o; o.x = v.x < 0.f ? m.x : r.x; o.y = v.y < 0.f ? m.y : r.y; return o;
}

template <int ACT  > struct EpiBf16 {
    static constexpr bool PERM = true, AFTER_DRAIN = false; static_assert(ACT == 0 || ACT == 1, "EpiBf16: ACT is 0 (none) or 1 (gelu_pk)");
    bf16_t* O; int ldc; const float* bias; int split_cols; size_t split_stride; float scale0;
    __device__ __forceinline__ void operator()(const f32x4 (&acc)[2][2][4][2], const Unit& u, int wr, int wc, int fr, int fq) const {
        asm volatile("" : "+v"(fr), "+v"(fq));
        const int row0 = u.pm * BM + wr * 64 + fr; int colt = u.pn * BM; bf16_t* base = O;
        float sc = 1.f; if (split_cols) { const int t = colt / split_cols; base += (size_t)t * split_stride; colt -= t * split_cols; if (t == 0) sc = scale0; }
        const int col0 = colt + wc * 32 + 8 * fq, bcol0 = u.pn * BM + wc * 32 + 8 * fq;
        f32x4 bv[2][2];
#pragma unroll
        for (int bj = 0; bj < 2; ++bj)
#pragma unroll
            for (int n = 0; n < 2; ++n) bv[bj][n] = bias ? *(const f32x4*)(bias + bcol0 + bj * HALF + 4 * n) : (f32x4){0.f, 0.f, 0.f, 0.f};
#pragma unroll
        for (int ai = 0; ai < 2; ++ai)
#pragma unroll
            for (int m = 0; m < 4; ++m) { bf16_t* rowp = base + (size_t)(row0 + ai * HALF + m * 16) * ldc + col0;
#pragma unroll
                for (int bj = 0; bj < 2; ++bj) { f32x4 v0 = acc[ai][bj][m][0] + bv[bj][0], v1 = acc[ai][bj][m][1] + bv[bj][1];
                    if (ACT == 1) { f32x2 a = gelu_pk((f32x2){v0[0], v0[1]}), b = gelu_pk((f32x2){v0[2], v0[3]}), c = gelu_pk((f32x2){v1[0], v1[1]}), d = gelu_pk((f32x2){v1[2], v1[3]});
                        v0 = (f32x4){a.x, a.y, b.x, b.y}; v1 = (f32x4){c.x, c.y, d.x, d.y}; }
                    v0 = v0 * sc; v1 = v1 * sc; u32x4 w; w.x = cvt_pk_bf16(v0[0], v0[1]); w.y = cvt_pk_bf16(v0[2], v0[3]); w.z = cvt_pk_bf16(v1[0], v1[1]); w.w = cvt_pk_bf16(v1[2], v1[3]);
                    *(u32x4*)(rowp + bj * HALF) = w; } }
    }
};
typedef int i32x4 __attribute__((ext_vector_type(4)));
template <bool I8> __device__ __forceinline__ f32x4 mma16(bf16x8 b, bf16x8 a, f32x4 c) { return __builtin_amdgcn_mfma_f32_16x16x32_bf16(b, a, c, 0, 0, 0); }
template <bool I8> __device__ __forceinline__ i32x4 mma16(bf16x8 b, bf16x8 a, i32x4 c) { return __builtin_amdgcn_mfma_i32_16x16x64_i8(__builtin_bit_cast(i32x4, b), __builtin_bit_cast(i32x4, a), c, 0, 0, 0); }
struct EpiF32 {
    static constexpr bool PERM = false, AFTER_DRAIN = false;
    float* C; int ldc; int accum;
    __device__ __forceinline__ void operator()(const f32x4 (&acc)[2][2][4][2], const Unit& u, int wr, int wc, int fr, int fq) const {
        asm volatile("" : "+v"(fr), "+v"(fq));
        const int row0 = u.pm * BM + wr * 64 + fr, col0 = u.pn * BM + wc * 32 + 4 * fq;
#pragma unroll
        for (int ai = 0; ai < 2; ++ai)
#pragma unroll
            for (int m = 0; m < 4; ++m) { float* rowp = C + (size_t)(row0 + ai * HALF + m * 16) * ldc + col0;
#pragma unroll
                for (int bj = 0; bj < 2; ++bj)
#pragma unroll
                    for (int n = 0; n < 2; ++n) { f32x4 v = acc[ai][bj][m][n]; if (accum) v += *(const f32x4*)(rowp + bj * HALF + n * 16); *(f32x4*)(rowp + bj * HALF + n * 16) = v; } }
    }
};
struct EpiSwiGLU {
    static constexpr bool PERM = true, AFTER_DRAIN = false;
    bf16_t* O; int ldo; const float* rowscale; int rs_stride;
    __device__ __forceinline__ void operator()(const f32x4 (&acc)[2][2][4][2], const Unit& u, int wr, int wc, int fr, int fq) const {
        asm volatile("" : "+v"(fr), "+v"(fq));
        typedef unsigned u32x2v __attribute__((ext_vector_type(2)));
        const int row0 = u.pm * BM + wr * 64 + fr; const int ch0 = (u.pn * BM + wc * 32 + 8 * fq) >> 1;
#pragma unroll
        for (int ai = 0; ai < 2; ++ai)
#pragma unroll
            for (int m = 0; m < 4; ++m) { const int row = row0 + ai * HALF + m * 16; bf16_t* rowp = O + (size_t)row * ldo + ch0;
                const float rs = rowscale ? rowscale[(size_t)row * rs_stride] : 1.f;
#pragma unroll
                for (int bj = 0; bj < 2; ++bj) { const f32x4 a = acc[ai][bj][m][0], b = acc[ai][bj][m][1]; f32x4 o;
#pragma unroll
                    for (int i = 0; i < 4; ++i) o[i] = a[i] * __builtin_amdgcn_rcpf(1.f + __expf(-a[i])) * b[i] * rs;
                    u32x2v w; w.x = cvt_pk_bf16(o[0], o[1]); w.y = cvt_pk_bf16(o[2], o[3]);
                    *(u32x2v*)(rowp + bj * (HALF / 2)) = w; } }
    }
};

struct MoeOrder : StaticOrder {
    int pb1, pb2, pb3, pb4, pb5, pb6, pb7; size_t estride;
    __device__ __forceinline__ const char* bbase(const Gemm& g, const Unit& u, size_t tstep) const {
        const int e = (u.pm >= pb1) + (u.pm >= pb2) + (u.pm >= pb3) + (u.pm >= pb4) + (u.pm >= pb5) + (u.pm >= pb6) + (u.pm >= pb7);
        return (const char*)(g.Bt + (size_t)e * estride) + (size_t)u.pn * tstep; }
};
struct SplitOrder {
    int nM, nN, S, G, c, pm0; int pb1, pb2, pb3, pb4, pb5, pb6, pb7; size_t estride;
    __device__ __forceinline__ bool next(int i, Unit& u) const { const int L = i * G + c; if (L >= nM * nN * S) return false; u.ks = L % S; const int t = L / S; u.pn = t % nN; u.pm = pm0 + t / nN; return true; }
    __device__ __forceinline__ const char* abase(const Gemm& g, const Unit& u, size_t tstep) const { return (const char*)g.A + (size_t)u.pm * tstep + (size_t)u.ks * g.K * 2; }
    __device__ __forceinline__ const char* bbase(const Gemm& g, const Unit& u, size_t tstep) const {
        const int e = estride ? (u.pm >= pb1) + (u.pm >= pb2) + (u.pm >= pb3) + (u.pm >= pb4) + (u.pm >= pb5) + (u.pm >= pb6) + (u.pm >= pb7) : 0;
        return (const char*)(g.Bt + (size_t)e * estride) + (size_t)u.pn * tstep + (size_t)u.ks * g.K * 2; }
    __device__ __forceinline__ void a_ready(const Unit&) const {}
    __device__ __forceinline__ void done(const Unit&) const {}
};
struct EpiPart {
    static constexpr bool PERM = false, AFTER_DRAIN = false;
    float* C; int ldc; size_t pstride; int pm0;
    __device__ __forceinline__ void operator()(const f32x4 (&acc)[2][2][4][2], const Unit& u, int wr, int wc, int fr, int fq) const {
        asm volatile("" : "+v"(fr), "+v"(fq));
        const int row0 = (u.pm - pm0) * BM + wr * 64 + fr, col0 = u.pn * BM + wc * 32 + 4 * fq; float* base = C + (size_t)u.ks * pstride;
#pragma unroll
        for (int ai = 0; ai < 2; ++ai)
#pragma unroll
            for (int m = 0; m < 4; ++m) { float* rowp = base + (size_t)(row0 + ai * HALF + m * 16) * ldc + col0;
#pragma unroll
                for (int bj = 0; bj < 2; ++bj)
#pragma unroll
                    for (int n = 0; n < 2; ++n) *(f32x4*)(rowp + bj * HALF + n * 16) = acc[ai][bj][m][n]; }
    }
};

struct EpiSwiGLU8 {
    static constexpr bool PERM = true, AFTER_DRAIN = false;
    bf16_t* O; int ldo; const float* rowscale; const float* sa; const unsigned* amax; int pb1, pb2, pb3, pb4, pb5, pb6, pb7;
    __device__ __forceinline__ void operator()(const i32x4 (&acc)[2][2][4][2], const Unit& u, int wr, int wc, int fr, int fq) const {
        typedef unsigned u32x2v __attribute__((ext_vector_type(2))); typedef unsigned u32x4v __attribute__((ext_vector_type(4)));
        asm volatile("" : "+v"(fr), "+v"(fq));
        const int row0 = u.pm * BM + wr * 64 + fr; const int cb0 = u.pn * BM + wc * 32 + 8 * fq; const int ch0 = cb0 >> 1;
        const int e = (u.pm >= pb1) + (u.pm >= pb2) + (u.pm >= pb3) + (u.pm >= pb4) + (u.pm >= pb5) + (u.pm >= pb6) + (u.pm >= pb7);
        const unsigned* am = amax + (size_t)e * 2 * 3584 + cb0;
#pragma unroll
        for (int bj = 0; bj < 2; ++bj) {
            const float* amf = (const float*)am + bj * HALF;
            const f32x4 sb0 = *(const f32x4*)amf * (1.f / 127.f), sb1 = *(const f32x4*)(amf + 4) * (1.f / 127.f);
#pragma unroll
            for (int ai = 0; ai < 2; ++ai)
#pragma unroll
                for (int m = 0; m < 4; ++m) { const int row = row0 + ai * HALF + m * 16; bf16_t* rowp = O + (size_t)row * ldo + ch0 + bj * (HALF / 2);
                    const float sr = sa[row], rs = rowscale ? rowscale[row] : 1.f; f32x4 o;
#pragma unroll
                    for (int i = 0; i < 4; ++i) { const float a = (float)acc[ai][bj][m][0][i] * sr * sb0[i], b = (float)acc[ai][bj][m][1][i] * sr * sb1[i];
                        o[i] = a * __builtin_amdgcn_rcpf(1.f + __expf(-a)) * b * rs; }
                    u32x2v w; w.x = cvt_pk_bf16(o[0], o[1]); w.y = cvt_pk_bf16(o[2], o[3]);
                    *(u32x2v*)rowp = w;
#if PROBE_DUP & 128
                    if (dbg && row < 4096) { f32x4 av, bv;
#pragma unroll
                        for (int i = 0; i < 4; ++i) { av[i] = (float)acc[ai][bj][m][0][i] * sr * sb0[i]; bv[i] = (float)acc[ai][bj][m][1][i] * sr * sb1[i]; }
                        *(f32x4*)((float*)dbg + (size_t)row * ldo + (rowp - (O + (size_t)row * ldo))) = av; *(f32x4*)((float*)dbg + (size_t)4096 * ldo + (size_t)row * ldo + (rowp - (O + (size_t)row * ldo))) = bv; }
#endif
                    } }
    }
#if PROBE_DUP & 128
    int* dbg = nullptr;
#endif
};
template <bool I8> struct AccSel { typedef f32x4 type; }; template <> struct AccSel<true> { typedef i32x4 type; };
template <class Epi, class Sched, bool ALIGN_EPI = false, bool SP2 = false, bool I8 = false>
__device__ __forceinline__ void gemm_phase(PG8_LAS unsigned char* lds, const Gemm g, const Sched& S, const Epi& E) {
    int tid_o = threadIdx.x; asm volatile("" : "+v"(tid_o));
    const int tid = tid_o, wid = __builtin_amdgcn_readfirstlane(tid >> 6), lane = tid & 63, wr = wid >> 2, wc = wid & 3, fr = lane & 15, fq = lane >> 4;
    const int K = g.K, nt = K / BK;
    unsigned voffA[2], voffB[2];
#pragma unroll
    for (int i = 0; i < 2; ++i) { int R, C; stage_rc(tid * 16 + i * 8192, R, C); const int Rb = Epi::PERM ? ((R & ~31) + perm32(R & 31)) : R;
        voffA[i] = (unsigned)(R * g.ld + C) * 2u; voffB[i] = (unsigned)(Rb * g.ld + C) * 2u; }
    const size_t kstep = (size_t)(BK * 2);
    const size_t hstep = (size_t)HALF * g.ld * 2;
    const size_t tstep = 2 * hstep;
    const unsigned ldsw = (unsigned)wid * 1024u;
    const int aoff = lds_byte(wr * 64 + fr, fq * 8), boff = lds_byte(wc * 32 + fr, fq * 8);
#define PG8_SA(b, h) (((b) * 2 + (h)) * HTB)
#define PG8_SB(b, h) ((4 + (b) * 2 + (h)) * HTB)
#define PG8_STAGE(bufoff, gbase, voff) do { _Pragma("unroll") for (int _i = 0; _i < 2; ++_i) \
        __builtin_amdgcn_global_load_lds((const unsigned*)((const char*)(gbase) + (voff)[_i]), (PG8_LAS unsigned*)(lds + (bufoff) + ldsw + _i * 8192), 16, 0, 0); } while (0)
#define PG8_LDA(dst, b, h) do { _Pragma("unroll") for (int m = 0; m < 4; ++m) _Pragma("unroll") for (int k = 0; k < 2; ++k) dst[m][k] = *(const PG8_LAS bf16x8*)(lds + PG8_SA(b, h) + aoff + m * 2048 + k * 1024); } while (0)
#define PG8_LDB(dst, b, h) do { _Pragma("unroll") for (int n = 0; n < 2; ++n) _Pragma("unroll") for (int k = 0; k < 2; ++k) dst[n][k] = *(const PG8_LAS bf16x8*)(lds + PG8_SB(b, h) + boff + n * 2048 + k * 1024); } while (0)
#define PG8_MMA(ai, bj, At, Bt) do { __builtin_amdgcn_s_setprio(1); _Pragma("unroll") for (int k = 0; k < 2; ++k) _Pragma("unroll") for (int m = 0; m < 4; ++m) _Pragma("unroll") for (int n = 0; n < 2; ++n) \
        acc[ai][bj][m][n] = mma16<I8>(Bt[n][k], At[m][k], acc[ai][bj][m][n]); __builtin_amdgcn_s_setprio(0); } while (0)
#define PG8_WAIT_V(n) asm volatile("s_waitcnt vmcnt(" #n ")" ::: "memory")
#define PG8_WAIT_L(n) asm volatile("s_waitcnt lgkmcnt(" #n ")" ::: "memory")
#define PG8_BAR __builtin_amdgcn_s_barrier()
#define PG8_SCHED __builtin_amdgcn_sched_barrier(0)
    Unit cur, nxt; int ui = 0;
    if (!S.next(0, cur)) return;
    typedef typename AccSel<I8>::type AccT; AccT acc[2][2][4][2];
#pragma unroll
    for (int a = 0; a < 2; ++a)
#pragma unroll
        for (int b = 0; b < 2; ++b)
#pragma unroll
            for (int m = 0; m < 4; ++m)
#pragma unroll
                for (int n = 0; n < 2; ++n) acc[a][b][m][n] = (AccT)(0);
    bf16x8 At[4][2], B0[2][2], B1[2][2];
    const char* cA = S.abase(g, cur, tstep); const char* cB = S.bbase(g, cur, tstep);
    S.a_ready(cur);
    if constexpr (SP2) {
        PG8_STAGE(PG8_SB(0, 0), cB, voffB); PG8_STAGE(PG8_SB(0, 1), cB + hstep, voffB); PG8_STAGE(PG8_SA(0, 0), cA, voffA); PG8_STAGE(PG8_SA(0, 1), cA + hstep, voffA);
        if (wr == 1) PG8_BAR;
        PG8_WAIT_V(2); PG8_BAR;
        PG8_STAGE(PG8_SB(1, 0), cB + kstep, voffB); PG8_STAGE(PG8_SA(1, 0), cA + kstep, voffA); PG8_STAGE(PG8_SB(1, 1), cB + hstep + kstep, voffB);
        PG8_WAIT_V(6); PG8_BAR;
    } else {
        PG8_STAGE(PG8_SB(0, 0), cB, voffB); PG8_STAGE(PG8_SA(0, 0), cA, voffA); PG8_STAGE(PG8_SB(0, 1), cB + hstep, voffB); PG8_STAGE(PG8_SA(0, 1), cA + hstep, voffA);
        if (wr == 1) PG8_BAR;
        PG8_WAIT_V(4); PG8_BAR;
        PG8_STAGE(PG8_SB(1, 0), cB + kstep, voffB); PG8_STAGE(PG8_SA(1, 0), cA + kstep, voffA); PG8_STAGE(PG8_SB(1, 1), cB + hstep + kstep, voffB);
        PG8_WAIT_V(6); PG8_BAR;
    }
    for (;;) {
        const bool has_next = S.next(ui + 1, nxt);
        const char* nA = has_next ? S.abase(g, nxt, tstep) : cA; const char* nB = has_next ? S.bbase(g, nxt, tstep) : cB;
        for (int t = 0; t < nt; t += 2) {
            const bool last = (t == nt - 2);
            const char* a1 = cA + (size_t)(t + 1) * kstep;
            const char* a2 = last ? nA : cA + (size_t)(t + 2) * kstep; const char* b2 = last ? nB : cB + (size_t)(t + 2) * kstep;
            const char* a3 = a2 + kstep; const char* b3 = b2 + kstep;
            if (last && has_next) S.a_ready(nxt);
            if constexpr (SP2) {
            PG8_LDB(B0, 0, 0); PG8_LDB(B1, 0, 1); PG8_SCHED; PG8_LDA(At, 0, 0); PG8_STAGE(PG8_SA(1, 1), a1 + hstep, voffA);
            PG8_WAIT_V(8); PG8_WAIT_L(0); PG8_BAR; PG8_MMA(0, 0, At, B0); PG8_MMA(0, 1, At, B1); PG8_BAR; PG8_SCHED;
            PG8_LDA(At, 0, 1); PG8_STAGE(PG8_SB(0, 0), b2, voffB); PG8_STAGE(PG8_SB(0, 1), b2 + hstep, voffB); PG8_STAGE(PG8_SA(0, 0), a2, voffA);
            PG8_WAIT_V(8); PG8_WAIT_L(0); PG8_BAR; PG8_MMA(1, 0, At, B0); PG8_MMA(1, 1, At, B1); PG8_BAR; PG8_SCHED;
            PG8_LDB(B0, 1, 0); PG8_LDB(B1, 1, 1); PG8_SCHED; PG8_LDA(At, 1, 0); PG8_STAGE(PG8_SA(0, 1), a2 + hstep, voffA);
            PG8_WAIT_V(8); PG8_WAIT_L(0); PG8_BAR; PG8_MMA(0, 0, At, B0); PG8_MMA(0, 1, At, B1); PG8_BAR; PG8_SCHED;
            PG8_LDA(At, 1, 1); PG8_STAGE(PG8_SB(1, 0), b3, voffB); PG8_STAGE(PG8_SB(1, 1), b3 + hstep, voffB); PG8_STAGE(PG8_SA(1, 0), a3, voffA);
            PG8_WAIT_V(8); PG8_WAIT_L(0); PG8_BAR; PG8_MMA(1, 0, At, B0); PG8_MMA(1, 1, At, B1); PG8_BAR; PG8_SCHED;
            } else {
            PG8_LDB(B0, 0, 0); PG8_SCHED; PG8_LDA(At, 0, 0); PG8_STAGE(PG8_SA(1, 1), a1 + hstep, voffA);
            PG8_WAIT_L(8); PG8_BAR; PG8_WAIT_L(0); PG8_MMA(0, 0, At, B0); PG8_BAR; PG8_SCHED;
            PG8_LDB(B1, 0, 1); PG8_STAGE(PG8_SB(0, 0), b2, voffB);
            PG8_BAR; PG8_WAIT_L(0); PG8_MMA(0, 1, At, B1); PG8_BAR;
            PG8_LDA(At, 0, 1); PG8_STAGE(PG8_SA(0, 0), a2, voffA);
            PG8_BAR; PG8_WAIT_L(0); PG8_MMA(1, 0, At, B0); PG8_BAR; PG8_SCHED;
            PG8_STAGE(PG8_SB(0, 1), b2 + hstep, voffB);
            PG8_WAIT_V(6); PG8_BAR; PG8_MMA(1, 1, At, B1); PG8_BAR;
            PG8_LDB(B0, 1, 0); PG8_SCHED; PG8_LDA(At, 1, 0); PG8_STAGE(PG8_SA(0, 1), a2 + hstep, voffA);
            PG8_WAIT_L(8); PG8_BAR; PG8_WAIT_L(0); PG8_MMA(0, 0, At, B0); PG8_BAR; PG8_SCHED;
            PG8_LDB(B1, 1, 1); PG8_STAGE(PG8_SB(1, 0), b3, voffB);
            PG8_BAR; PG8_WAIT_L(0); PG8_MMA(0, 1, At, B1); PG8_BAR;
            PG8_LDA(At, 1, 1); PG8_STAGE(PG8_SA(1, 0), a3, voffA);
            PG8_BAR; PG8_WAIT_L(0); PG8_MMA(1, 0, At, B0); PG8_BAR; PG8_SCHED;
            PG8_STAGE(PG8_SB(1, 1), b3 + hstep, voffB);
            PG8_WAIT_V(6); PG8_BAR; PG8_MMA(1, 1, At, B1); PG8_BAR;
            }
        }
        if constexpr (ALIGN_EPI) { if (wr == 0) PG8_BAR; }
        if constexpr (!Epi::AFTER_DRAIN) { E(acc, cur, wr, wc, fr, fq); S.done(cur); }
        if (!has_next) break;
#pragma unroll
        for (int a = 0; a < 2; ++a)
#pragma unroll
            for (int b = 0; b < 2; ++b)
#pragma unroll
                for (int m = 0; m < 4; ++m)
#pragma unroll
                    for (int n = 0; n < 2; ++n) acc[a][b][m][n] = (AccT)(0);
        cur = nxt; cA = nA; cB = nB; ++ui;
        if constexpr (ALIGN_EPI) { if (wr == 1) PG8_BAR; }
    }
    PG8_WAIT_V(0);
    if constexpr (!ALIGN_EPI) { if (wr == 0) PG8_BAR; }
    PG8_BAR;
    if constexpr (Epi::AFTER_DRAIN) { E.fused(acc, cur, wr, wc, fr, fq, lds, wid, lane); S.done(cur); }
#undef PG8_SA
#undef PG8_SB
#undef PG8_STAGE
#undef PG8_LDA
#undef PG8_LDB
#undef PG8_MMA
#undef PG8_WAIT_V
#undef PG8_WAIT_L
#undef PG8_BAR
#undef PG8_SCHED
}
}

constexpr int NWAVES = 8;
constexpr int D = 1024, NB = 4, SEQ = 4096, CTXL = 256, NLAT = NB * SEQ, NCTX = NB * CTXL, MROWS = NLAT + NCTX;
constexpr int DEPTH = 4, RW = 512, NH = 8, HS = 64, DFF = 3584, NE = 8, NPROJ = 3456, NP = 3584, NLO = 2560, KLA = 512, NMOD = 6144;
constexpr int PC_R = 0, PC_K = 512, PC_V = 1024, PC_CB = 1536, PC_CC = 2048, PC_CH = 2560, PC_WD = 3072, PC_AD = 3200, PC_GD = 3328;
constexpr float LN_EPS = 1e-5f, GN_EPS = 64e-5f, DN_ALPHA = 1.681792830507429f;
enum { I_X = 0, I_C, I_CTX, I_CCTX, I_WMOD, I_BMOD, I_WIN, I_W0, I_W2, I_A0, I_A2, I_KK, I_KA, I_RK, I_G2, I_LNXG, I_LNXB, I_CONVW, I_WOUT, I_LN1G, I_LN1B, I_LN2G, I_LN2B,
       I_FW1, I_FW3, I_FW2, I_RTW, I_RTB, I_MW1, I_MW3, I_MW2, N_IN };

constexpr size_t MiB = 1u << 20;
constexpr size_t WS_CTL = 0, CTL_BYTES = 3 * MiB;
constexpr size_t WS_MODV = 1 * MiB;
constexpr size_t WS_AMAX = 2 * MiB;
constexpr size_t WS_RKS = 3 * MiB;
constexpr size_t WS_WIN = 4 * MiB;
constexpr size_t WS_WOUT = WS_WIN + 28 * MiB;
constexpr size_t WS_LORA = WS_WOUT + 8 * MiB;
constexpr size_t WS_F13 = WS_LORA + 10 * MiB;
constexpr size_t WS_F2 = WS_F13 + 28 * MiB;
constexpr size_t WS_X = WS_F2 + 14 * MiB;
constexpr size_t WS_H = WS_X + 68 * MiB;
constexpr size_t WS_MOES = WS_H + 34 * MiB;
constexpr size_t WS_ROWLIST = WS_MOES;
constexpr size_t WS_TOKSEL = WS_MOES + 640 * 1024;
constexpr size_t WS_WSEL = WS_TOKSEL + 320 * 1024;
constexpr size_t WS_WSORT = WS_WSEL + 192 * 1024;
constexpr size_t WS_MOEW13 = WS_MOES + 2 * MiB;
constexpr size_t WS_MOEW2 = WS_MOEW13 + 112 * MiB;
constexpr size_t WS_H8 = WS_MOEW13 + 56 * MiB;
constexpr size_t WS_SA = WS_H8 + 17 * MiB;
constexpr size_t WS_SAG = WS_SA + 1 * MiB;
constexpr size_t WS_SCR = WS_MOEW2 + 56 * MiB;
constexpr size_t WS_P = WS_SCR;
constexpr size_t WS_LO = WS_P + 119 * MiB;
constexpr size_t WS_PREP = WS_LO + 170 * MiB;
constexpr size_t WS_Y = WS_PREP + 213 * MiB;
constexpr size_t WS_MIXIN = WS_Y + 68 * MiB;
constexpr size_t WS_CH = WS_PREP;
constexpr size_t WS_MIXO = WS_PREP;
constexpr size_t WS_MIXP = WS_PREP + 34 * MiB;
constexpr size_t WS_END_MIXER = WS_MIXIN + 34 * MiB;
constexpr size_t WS_HG = WS_SCR;
constexpr size_t WS_ACT = WS_HG + 72 * MiB;
constexpr size_t WS_F = WS_ACT + 252 * MiB;
constexpr size_t WS_FP = WS_F + 72 * MiB;
constexpr size_t WS_END_FFN = WS_FP + 64 * MiB;
constexpr size_t WS_NEED = WS_END_MIXER > WS_END_FFN ? WS_END_MIXER : WS_END_FFN;
static_assert((size_t)MROWS * NP * 2 <= 119 * MiB && (size_t)MROWS * NLO * 4 <= 170 * MiB && (size_t)8704 * 25600 <= 213 * MiB && (size_t)MROWS * D * 4 <= 68 * MiB && WS_NEED <= 990 * MiB, "ws map");
constexpr int MOE_MAIN_PANELS = 128, MOE_TAIL_ROWS = 4096;
constexpr int MOE_ROWS = 36864;
constexpr int LORAW_PER_LAYER = 4 * 512 * 64 + 512 * 128;
constexpr int CW_BAR = 4096, CW_GCNT = 8192, CW_CQ = 12288, CW_SDONE = 12544;

constexpr int RING_BYTES = 131072, LDSCTL_OFF = RING_BYTES, MISC_OFF = LDSCTL_OFF + 320, LDS_BYTES = 147456;

typedef unsigned short bf16;
typedef unsigned v4u __attribute__((ext_vector_type(4)));
typedef unsigned v2u __attribute__((ext_vector_type(2)));
typedef float f32x4 __attribute__((ext_vector_type(4)));
#define LAS __attribute__((address_space(3)))
#define LDS_WAIT() asm volatile("s_waitcnt lgkmcnt(0)" ::: "memory")
__device__ __forceinline__ unsigned f2bf(float f) { unsigned u = __builtin_bit_cast(unsigned, f); return (u + 0x7fffu + ((u >> 16) & 1u)) >> 16; }
__device__ __forceinline__ unsigned pk2(float lo, float hi) { return f2bf(lo) | (f2bf(hi) << 16); }
__device__ __forceinline__ float bf2f(unsigned short b) { return __builtin_bit_cast(float, ((unsigned)b) << 16); }
__device__ __forceinline__ float bflo(unsigned w) { return __builtin_bit_cast(float, w << 16); }
__device__ __forceinline__ float bfhi(unsigned w) { return __builtin_bit_cast(float, w & 0xffff0000u); }
__device__ __forceinline__ float wave_sum(float v) {
#pragma unroll
    for (int o = 1; o < 64; o <<= 1) v += __shfl_xor(v, o);
    return v;
}
__device__ __forceinline__ float sigm(float x) { return 1.f / (1.f + __expf(-x)); }

#define XB_TMO      128
#define XB_XCNT(j)  (256  + 64 * (j))
#define XB_XSUB(j)  (1280 + 64 * (j))
#define XB_XGEN(j)  (2304 + 64 * (j))
#define XB_TOP      3328
#define XB_TOPGEN   3392
#define XCD_BAR_WORDS 3456
#define XB_SPIN_CAP (1u << 18)

__device__ __forceinline__ unsigned xb_ld(unsigned* p)              { return __hip_atomic_load(p, __ATOMIC_RELAXED, __HIP_MEMORY_SCOPE_AGENT); }
__device__ __forceinline__ unsigned xb_add(unsigned* p, unsigned v) { return __hip_atomic_fetch_add(p, v, __ATOMIC_RELAXED, __HIP_MEMORY_SCOPE_AGENT); }
__device__ __forceinline__ unsigned xb_xcc_id() { return (unsigned)__builtin_amdgcn_s_getreg((3 << 11) | 20) & 0xFu; }
#define XB_SPIN(cond, bar) do { unsigned _sp = 0; while (cond) { __builtin_amdgcn_s_sleep(1); \
    if ((++_sp & 255u) == 0u) { if (xb_ld(&(bar)[XB_TMO])) break; if (_sp > XB_SPIN_CAP) { atomicAdd(&(bar)[XB_TMO], 1u); break; } } } } while (0)

struct XcdBarrier {
    unsigned* bar; unsigned x;
    volatile LAS unsigned* st;
};

__device__ __forceinline__ XcdBarrier xcd_barrier_post(unsigned* bar, volatile LAS unsigned* st) {
    XcdBarrier b; b.bar = bar; b.x = xb_xcc_id(); b.st = st;
    if (threadIdx.x == 0) (void)xb_add(&bar[XB_XCNT(b.x)], 1u);
    return b;
}
__device__ __forceinline__ void xcd_barrier_complete(unsigned* bar, unsigned x, unsigned& nloc, unsigned& nx) {
    const unsigned G = gridDim.x * gridDim.y * gridDim.z;
    unsigned sum, cnt, mine, sp = 0u;
    for (;;) {
        sum = 0u; cnt = 0u; mine = 0u;
#pragma unroll
        for (unsigned j = 0; j < 16; ++j) { const unsigned c = xb_ld(&bar[XB_XCNT(j)]); sum += c; cnt += (c > 0u) ? 1u : 0u; mine = (j == x) ? c : mine; }
        if (sum == G) break;
        __builtin_amdgcn_s_sleep(1);
        if ((++sp & 255u) == 0u) { if (xb_ld(&bar[XB_TMO])) break; if (sp > XB_SPIN_CAP) { atomicAdd(&bar[XB_TMO], 1u); break; } }
    }
    nloc = mine > 0u ? mine : 1u; nx = cnt > 0u ? cnt : 1u;
}

__device__ __forceinline__ void xcd_barrier(const XcdBarrier& b) {
    asm volatile("s_waitcnt vmcnt(0)" ::: "memory");
    __syncthreads();
    if (threadIdx.x == 0) {
        unsigned* bar = b.bar;
        __builtin_amdgcn_s_waitcnt(0);
        unsigned nloc = b.st[0], nx = b.st[1];
        if (nloc == 0u) { xcd_barrier_complete(bar, b.x, nloc, nx); b.st[0] = nloc; b.st[1] = nx; }
        const unsigned old = xb_add(&bar[XB_XSUB(b.x)], 1u);
        const unsigned gen = old / nloc;
        if (old + 1u == (gen + 1u) * nloc) {
            __builtin_amdgcn_fence(__ATOMIC_RELEASE, "agent");
            asm volatile("s_waitcnt vmcnt(0)" ::: "memory");
            const unsigned og = xb_add(&bar[XB_TOP], 1u);
            const unsigned tg = og / nx;
            if (og + 1u == (tg + 1u) * nx) xb_add(&bar[XB_TOPGEN], 1u);
            else XB_SPIN(xb_ld(&bar[XB_TOPGEN]) == tg, bar);
            __builtin_amdgcn_fence(__ATOMIC_ACQUIRE, "agent");
            xb_add(&bar[XB_XGEN(b.x)], 1u);
            asm volatile("s_waitcnt vmcnt(0)" ::: "memory");
        } else {
            XB_SPIN(xb_ld(&bar[XB_XGEN(b.x)]) == gen, bar);
            __builtin_amdgcn_fence(__ATOMIC_ACQUIRE, "agent");
            asm volatile("s_waitcnt vmcnt(0)" ::: "memory");
        }
    }
    __syncthreads();
}


__device__ __forceinline__ size_t opaque_zero() { size_t z = 0; asm volatile("" : "+s"(z)); return z; }
#define OWS (p.ws + opaque_zero())
__device__ __forceinline__ int opaque_zero_i() { int z = 0; asm volatile("" : "+s"(z)); return z; }
#define PIN(i) (p.in[(i) + opaque_zero_i()])
struct KP { const float* in[N_IN]; float* out; unsigned char* ws; int ph; int pad; };

template <int MODE> __device__ __forceinline__ int rowmap(int n, int arg) {
    if (MODE == 0) return n + arg;
    if (MODE == 1) { if (n < 1536) return n; if (n < 1664) return n - 1536 + PC_WD; if (n < 1792) return n - 1664 + PC_AD; if (n < 1920) return n - 1792 + PC_GD;
                     if (n < 2432) return n - 1920 + PC_CB; if (n < 2944) return n - 2432 + PC_CC; return n - 2944 + PC_CH; }
    return 8 * (n >> 2) + 4 * arg + (n & 3);
}
template <int MODE> __device__ __forceinline__ void transpose_item(const float* W, int K, int N, bf16* WT, int arg, LAS float* scr, int item, int lane) {
    const int nblk = N / 32, kb = item / nblk, nb = item % nblk, k0 = 64 * kb, n0 = 32 * nb;
#pragma unroll 8
    for (int i = 0; i < 32; ++i) { const int kk = 2 * i + (lane >> 5); scr[kk * 33 + (lane & 31)] = W[(size_t)(k0 + kk) * N + n0 + (lane & 31)]; }
    LDS_WAIT(); asm volatile("" ::: "memory");
    const int c = lane & 7;
#pragma unroll
    for (int j = 0; j < 4; ++j) { const int n = (lane >> 3) + 8 * j; const LAS float* s = scr + (8 * c) * 33 + n;
        v4u o; o.x = pk2(s[0 * 33], s[1 * 33]); o.y = pk2(s[2 * 33], s[3 * 33]); o.z = pk2(s[4 * 33], s[5 * 33]); o.w = pk2(s[6 * 33], s[7 * 33]);
        *(v4u*)(WT + (size_t)rowmap<MODE>(n0 + n, arg) * K + k0 + 8 * c) = o; }
    LDS_WAIT(); asm volatile("" ::: "memory");
}

__device__ __forceinline__ void ph_modvec(const KP& p, LAS unsigned char* lds, int tid) {
    LAS float* sil = (LAS float*)lds;
    LAS float* red = (LAS float*)(lds + 5 * 1024 * 4);
    const float* c = PIN(I_C); const float* cc = PIN(I_CCTX);
    for (int i = tid; i < 5 * 1024; i += 512) { const float v = i < 4096 ? c[i] : cc[i - 4096]; sil[i] = v / (1.f + __expf(-v)); }
    __syncthreads();
    float* modv = (float*)(OWS + WS_MODV);
    const int ks = tid >> 6, col = tid & 63;
    for (int task = blockIdx.x; task < DEPTH * 96; task += gridDim.x) {
        const int l = task / 96, j0 = (task % 96) * 64;
        const float* w = PIN(I_WMOD) + (size_t)l * D * NMOD + (size_t)(ks * 128) * NMOD + j0 + col;
        float a0 = 0.f, a1 = 0.f, a2 = 0.f, a3 = 0.f, a4 = 0.f;
#pragma unroll 8
        for (int k = 0; k < 128; ++k) { const float wv = w[(size_t)k * NMOD]; const int kk = ks * 128 + k;
            a0 += sil[kk] * wv; a1 += sil[1024 + kk] * wv; a2 += sil[2048 + kk] * wv; a3 += sil[3072 + kk] * wv; a4 += sil[4096 + kk] * wv; }
        red[(ks * 5 + 0) * 64 + col] = a0; red[(ks * 5 + 1) * 64 + col] = a1; red[(ks * 5 + 2) * 64 + col] = a2; red[(ks * 5 + 3) * 64 + col] = a3; red[(ks * 5 + 4) * 64 + col] = a4;
        __syncthreads();
        if (tid < 320) { const int r = tid >> 6; float s = 0.f;
#pragma unroll
            for (int q = 0; q < 8; ++q) s += red[(q * 5 + r) * 64 + col];
            modv[(size_t)(l * 5 + r) * NMOD + j0 + col] = s + PIN(I_BMOD)[l * NMOD + j0 + col]; }
        __syncthreads();
    }
}

__device__ __forceinline__ void ph_convert(const KP& p, LAS unsigned char* lds, int gw, int NGW, int wave, int lane) {
    LAS float* scr = (LAS float*)(lds + wave * 16384);
    bf16* win = (bf16*)(OWS + WS_WIN); bf16* wout = (bf16*)(OWS + WS_WOUT); bf16* f2 = (bf16*)(OWS + WS_F2); bf16* lora = (bf16*)(OWS + WS_LORA);
    constexpr int I_IN = (D / 64) * (NPROJ / 32), I_OUT = (D / 64) * (D / 32), I_UP = (D / 64) * (DFF / 32), I_DN = (DFF / 64) * (D / 32);
    constexpr int NITEMS = I_IN + I_OUT + I_DN;
    for (int it = gw; it < NITEMS; it += NGW) {
        int r = it;
        if (r < I_IN) { transpose_item<1>(PIN(I_WIN), D, NPROJ, win, 0, scr, r, lane); continue; } r -= I_IN;
        if (r < I_OUT) { transpose_item<0>(PIN(I_WOUT), D, D, wout, 0, scr, r, lane); continue; } r -= I_OUT;
        transpose_item<0>(PIN(I_FW2), DFF, D, f2, 0, scr, r, lane);
    }
    { const int gt = gw * 64 + lane, NGT = NGW * 64; constexpr int PER = (NP - NPROJ) * D / 8;
      for (int i = gt; i < DEPTH * PER; i += NGT) { const int l = i / PER, q = i % PER; *(v4u*)(win + (size_t)l * NP * D + (size_t)NPROJ * D + (size_t)q * 8) = (v4u){0u, 0u, 0u, 0u}; } }
    { const int gt = gw * 64 + lane, NGT = NGW * 64;
      for (int i = gt; i < DEPTH * LORAW_PER_LAYER / 8; i += NGT) { const int l = i / (LORAW_PER_LAYER / 8); int q = (i % (LORAW_PER_LAYER / 8)) * 8; float v[8];
          int grp, c, k0; if (q < 4 * 512 * 64) { grp = q / (512 * 64); q -= grp * 512 * 64; c = q / 64; k0 = q % 64; } else { grp = 4; q -= 4 * 512 * 64; c = q / 128; k0 = q % 128; }
#pragma unroll
          for (int j = 0; j < 8; ++j) { const int k = k0 + j;
              v[j] = grp < 2 ? PIN(I_W2)[((size_t)(l * 2 + grp) * 64 + k) * RW + c] : grp < 4 ? PIN(I_A2)[((size_t)(l * 2 + grp - 2) * 64 + k) * RW + c] : PIN(I_G2)[((size_t)l * 128 + k) * RW + c]; }
          v4u o; o.x = pk2(v[0], v[1]); o.y = pk2(v[2], v[3]); o.z = pk2(v[4], v[5]); o.w = pk2(v[6], v[7]);
          *(v4u*)(lora + (size_t)i * 8) = o; } }
}
__device__ __forceinline__ void ph_amax(const KP& p, int gw, int NGW, int lane) {
    unsigned* AM = (unsigned*)(OWS + WS_AMAX);
    for (int it = gw; it < 18 * 2 * (DFF / 64) * 4; it += NGW) { const int kq = it & 3, strip = (it >> 2) % (DFF / 64), sm = (it >> 2) / (DFF / 64), s1 = sm & 1, cm = sm >> 1;
        const float* W = cm < 2 ? PIN(s1 ? I_FW3 : I_FW1) + (size_t)cm * D * DFF : PIN(s1 ? I_MW3 : I_MW1) + (size_t)(cm - 2) * D * DFF;
        const int n = strip * 64 + lane; const float* src = W + (size_t)(kq * 256) * DFF + n; float m = 0.f;
#pragma unroll 16
        for (int k = 0; k < 256; ++k) m = fmaxf(m, fabsf(src[(size_t)k * DFF]));
        __hip_atomic_fetch_max(AM + (size_t)cm * 2 * DFF + 8 * (n >> 2) + 4 * s1 + (n & 3), __builtin_bit_cast(unsigned, m), __ATOMIC_RELAXED, __HIP_MEMORY_SCOPE_AGENT); }
}
__device__ __forceinline__ unsigned q8pack(float a, float b, float c, float d) {
    const int qa = __float2int_rn(a), qb = __float2int_rn(b), qc = __float2int_rn(c), qd = __float2int_rn(d);
    return (unsigned)(qa & 255) | ((unsigned)(qb & 255) << 8) | ((unsigned)(qc & 255) << 16) | ((unsigned)(qd & 255) << 24); }
constexpr int CQ_IN = (D / 64) * (NPROJ / 32), CQ_OUT = (D / 64) * (D / 32), CQ_UP = (D / 64) * (DFF / 32), CQ_DN = (DFF / 64) * (D / 32);
constexpr int CQ_J1 = 3 * CQ_IN + 3 * CQ_OUT + 2 * CQ_UP + CQ_DN, CQ_MOE = NE * (2 * CQ_UP + CQ_DN), CQ_END0 = CQ_J1 + CQ_MOE, CQ_END1 = CQ_END0 + CQ_MOE;
#ifndef CQ_SLOT_ITEMS
#define CQ_SLOT_ITEMS 12000
#endif
struct CqItem { const float* W; bf16* WT; int K, N, mode, arg, item; const unsigned* am; };
__device__ __forceinline__ CqItem cq_decode(const KP& p, int q) {
    CqItem c; bf16* win = (bf16*)(OWS + WS_WIN); bf16* wout = (bf16*)(OWS + WS_WOUT); bf16* f13 = (bf16*)(OWS + WS_F13); bf16* f2 = (bf16*)(OWS + WS_F2);
    bf16* m13 = (bf16*)(OWS + WS_MOEW13); bf16* m2 = (bf16*)(OWS + WS_MOEW2); const unsigned* AM = (const unsigned*)(OWS + WS_AMAX);
    if (q < 0) { q += 2 * CQ_UP;
        if (q < CQ_UP) { c = CqItem{PIN(I_FW1), f13, D, DFF, 2, 0, q, AM}; return c; } q -= CQ_UP;
        c = CqItem{PIN(I_FW3), f13, D, DFF, 2, 1, q, AM}; return c; }
    if (q < 3 * CQ_IN) { const int l = 1 + q / CQ_IN; c = CqItem{PIN(I_WIN) + (size_t)l * D * NPROJ, win + (size_t)l * NP * D, D, NPROJ, 1, 0, q % CQ_IN, nullptr}; return c; } q -= 3 * CQ_IN;
    if (q < 3 * CQ_OUT) { const int l = 1 + q / CQ_OUT; c = CqItem{PIN(I_WOUT) + (size_t)l * D * D, wout + (size_t)l * D * D, D, D, 0, 0, q % CQ_OUT, nullptr}; return c; } q -= 3 * CQ_OUT;
    if (q < CQ_UP) { c = CqItem{PIN(I_FW1) + (size_t)D * DFF, f13 + (size_t)DFF * D, D, DFF, 2, 0, q, AM + 2 * DFF}; return c; } q -= CQ_UP;
    if (q < CQ_UP) { c = CqItem{PIN(I_FW3) + (size_t)D * DFF, f13 + (size_t)DFF * D, D, DFF, 2, 1, q, AM + 2 * DFF}; return c; } q -= CQ_UP;
    if (q < CQ_DN) { c = CqItem{PIN(I_FW2) + (size_t)DFF * D, f2 + (size_t)D * DFF, DFF, D, 0, 0, q, nullptr}; return c; } q -= CQ_DN;
    const int mi = q / CQ_MOE; q -= mi * CQ_MOE;
    if (q < NE * CQ_UP) { const int e = q / CQ_UP; c = CqItem{PIN(I_MW1) + ((size_t)mi * NE + e) * D * DFF, m13 + (size_t)e * DFF * D, D, DFF, 2, 0, q % CQ_UP, AM + (size_t)(2 + 8 * mi + e) * 2 * DFF}; return c; } q -= NE * CQ_UP;
    if (q < NE * CQ_UP) { const int e = q / CQ_UP; c = CqItem{PIN(I_MW3) + ((size_t)mi * NE + e) * D * DFF, m13 + (size_t)e * DFF * D, D, DFF, 2, 1, q % CQ_UP, AM + (size_t)(2 + 8 * mi + e) * 2 * DFF}; return c; } q -= NE * CQ_UP;
    { const int e = q / CQ_DN; c = CqItem{PIN(I_MW2) + ((size_t)mi * NE + e) * DFF * D, m2 + (size_t)e * D * DFF, DFF, D, 0, 0, q % CQ_DN, nullptr}; return c; }
}
__device__ __forceinline__ void cq_load(const CqItem& c, int lane, float (&r)[32]) {
    const int nblk = c.N / 32, kb = c.item / nblk, nb = c.item % nblk; const float* src = c.W + (size_t)(64 * kb + (lane >> 5)) * c.N + 32 * nb + (lane & 31);
#pragma unroll
    for (int i = 0; i < 32; ++i) r[i] = src[(size_t)(2 * i) * c.N];
}
__device__ __forceinline__ void cq_store(const CqItem& c, int lane, const float (&r)[32], LAS float* scr) {
    const int nblk = c.N / 32, kb = c.item / nblk, nb = c.item % nblk, k0 = 64 * kb, n0 = 32 * nb;
#pragma unroll
    for (int i = 0; i < 32; ++i) scr[(2 * i + (lane >> 5)) * 33 + (lane & 31)] = r[i];
    LDS_WAIT(); asm volatile("" ::: "memory");
    if (c.mode == 2) {
        const int n = lane >> 1, hf = lane & 1, nn = n0 + n, j = 8 * (nn >> 2) + 4 * c.arg + (nn & 3);
        const float inv = 127.f / fmaxf(__builtin_bit_cast(float, c.am[j]), 1e-30f); const LAS float* sp = scr + (32 * hf) * 33 + n; unsigned w[8];
#pragma unroll
        for (int q = 0; q < 8; ++q) w[q] = q8pack(sp[(4 * q + 0) * 33] * inv, sp[(4 * q + 1) * 33] * inv, sp[(4 * q + 2) * 33] * inv, sp[(4 * q + 3) * 33] * inv);
        unsigned char* dst = (unsigned char*)c.WT + (size_t)j * c.K + k0 + 32 * hf;
        *(v4u*)dst = (v4u){w[0], w[1], w[2], w[3]}; *(v4u*)(dst + 16) = (v4u){w[4], w[5], w[6], w[7]};
    } else {
    const int cc = lane & 7;
#pragma unroll
    for (int j = 0; j < 4; ++j) { const int n = (lane >> 3) + 8 * j; const LAS float* sp = scr + (8 * cc) * 33 + n;
        v4u o; o.x = pk2(sp[0 * 33], sp[1 * 33]); o.y = pk2(sp[2 * 33], sp[3 * 33]); o.z = pk2(sp[4 * 33], sp[5 * 33]); o.w = pk2(sp[6 * 33], sp[7 * 33]);
        const int nn = n0 + n; const int row = c.mode == 0 ? nn : rowmap<1>(nn, 0);
        *(v4u*)(c.WT + (size_t)row * c.K + k0 + 8 * cc) = o; }
    }
    LDS_WAIT(); asm volatile("" ::: "memory");
}
constexpr int CQ_B = 4;
__device__ __forceinline__ int cq_grab(unsigned* heads, int nseg, int& cnt, int lane) {
    int q = -1, n = 0;
    if (lane == 0) { for (int sg = 0; sg < nseg && q < 0; ++sg) { const int size = sg == 0 ? CQ_J1 : CQ_MOE, base = sg == 0 ? 0 : sg == 1 ? CQ_J1 : CQ_END0; unsigned* hd = heads + 64 * sg;
            if ((int)__hip_atomic_load(hd, __ATOMIC_RELAXED, __HIP_MEMORY_SCOPE_AGENT) < size) { const int t = (int)__hip_atomic_fetch_add(hd, (unsigned)CQ_B, __ATOMIC_RELAXED, __HIP_MEMORY_SCOPE_AGENT);
                if (t < size) { q = base + t; n = size - t < CQ_B ? size - t : CQ_B; } } } }
    cnt = __builtin_amdgcn_readfirstlane(n); return __builtin_amdgcn_readfirstlane(q);
}
__device__ __forceinline__ void cq_run(const KP& p, LAS unsigned char* lds, int nseg, const unsigned* stop, unsigned stopval, int wave, int lane) {
    unsigned* heads = (unsigned*)(OWS + WS_CTL) + CW_CQ; LAS float* scr = (LAS float*)(lds + wave * 16384);
    for (;;) {
        if (stop) { unsigned sv = 0u; if (lane == 0) sv = __hip_atomic_load(stop, __ATOMIC_RELAXED, __HIP_MEMORY_SCOPE_AGENT); if ((unsigned)__builtin_amdgcn_readfirstlane((int)sv) >= stopval) break; }
        int cnt; const int q0 = cq_grab(heads, nseg, cnt, lane); if (q0 < 0) break;
        CqItem cur = cq_decode(p, q0); float ra[32]; cq_load(cur, lane, ra);
        for (int j = 0; j < cnt; ++j) { CqItem nxt = cur; float rb[32];
            if (j + 1 < cnt) { nxt = cq_decode(p, q0 + j + 1); cq_load(nxt, lane, rb); }
            cq_store(cur, lane, ra, scr);
            if (j + 1 < cnt) { cur = nxt;
#pragma unroll
                for (int i = 0; i < 32; ++i) ra[i] = rb[i]; } }
    }
}

__device__ __forceinline__ void cq_static(const KP& p, LAS unsigned char* lds, int q0, int q1, int gw, int NGW, int wave, int lane) {
    LAS float* scr = (LAS float*)(lds + wave * 16384);
    int q = q0 + gw; if (q >= q1) return;
    CqItem cur = cq_decode(p, q); float ra[32]; cq_load(cur, lane, ra);
    for (;;) { const int qn = q + NGW; CqItem nxt = cur; float rb[32];
        if (qn < q1) { nxt = cq_decode(p, qn); cq_load(nxt, lane, rb); }
        cq_store(cur, lane, ra, scr);
        if (qn >= q1) break;
        cur = nxt; q = qn;
#pragma unroll
        for (int i = 0; i < 32; ++i) ra[i] = rb[i]; }
}

__device__ __forceinline__ void ld_row(const float* r, int lane, f32x4 (&v)[4]) { const f32x4* q = (const f32x4*)r + lane;
#pragma unroll
    for (int j = 0; j < 4; ++j) v[j] = q[64 * j]; }
__device__ __forceinline__ void st_row(float* r, int lane, const f32x4 (&v)[4]) { f32x4* q = (f32x4*)r + lane;
#pragma unroll
    for (int j = 0; j < 4; ++j) q[64 * j] = v[j]; }
__device__ __forceinline__ void st_row_bf16(bf16* r, int lane, const f32x4 (&v)[4]) { v2u* q = (v2u*)r + lane;
#pragma unroll
    for (int j = 0; j < 4; ++j) { v2u w; w.x = pk2(v[j][0], v[j][1]); w.y = pk2(v[j][2], v[j][3]); q[64 * j] = w; } }
__device__ __forceinline__ void ld_row_bf16(const bf16* r, int lane, f32x4 (&v)[4]) { const v2u* q = (const v2u*)r + lane;
#pragma unroll
    for (int j = 0; j < 4; ++j) { const v2u w = q[64 * j]; v[j] = (f32x4){bflo(w.x), bfhi(w.x), bflo(w.y), bfhi(w.y)}; } }
template <int S> __device__ __forceinline__ void ld_row_parts(const float* r, size_t pstride, int lane, f32x4 (&v)[4]) {
    ld_row(r, lane, v);
#pragma unroll
    for (int s = 1; s < S; ++s) { f32x4 t[4]; ld_row(r + (size_t)s * pstride, lane, t);
#pragma unroll
        for (int j = 0; j < 4; ++j) v[j] += t[j]; } }
__device__ __forceinline__ int mod_row(int row) { return row < NLAT ? (row >> 12) : 4; }

__device__ __forceinline__ void ph_init_rows(const KP& p, int gw, int NGW, int lane) {
    const float* modv = (const float*)(OWS + WS_MODV); float* X = (float*)(OWS + WS_X); bf16* H = (bf16*)(OWS + WS_H);
    for (int row = gw; row < MROWS; row += NGW) {
        const float* src = row < NLAT ? PIN(I_X) + (size_t)row * D : PIN(I_CTX) + (size_t)(row - NLAT) * D;
        const float* mv = modv + (size_t)(0 * 5 + mod_row(row)) * NMOD;
        f32x4 x[4], sh[4], sc[4], h[4]; ld_row(src, lane, x); ld_row(mv, lane, sh); ld_row(mv + 1024, lane, sc);
#pragma unroll
        for (int j = 0; j < 4; ++j) h[j] = x[j] * (1.f + sc[j]) + sh[j];
        st_row(X + (size_t)row * D, lane, x); st_row_bf16(H + (size_t)row * D, lane, h);
    }
}

__device__ __forceinline__ int scan_row(int b, int dir, int step) { return step < CTXL ? NLAT + b * CTXL + (dir ? CTXL - 1 - step : step) : b * SEQ + (dir ? SEQ - 1 - (step - CTXL) : step - CTXL); }
typedef short sbf16x8 __attribute__((ext_vector_type(8)));
typedef float f32x16 __attribute__((ext_vector_type(16)));
constexpr int SC_C = 32, SC_NCH = (CTXL + SEQ) / SC_C  , SC_NCHAIN = NB * NH * 2  , SC_NTASK = SC_NCH * SC_NCHAIN  ;
constexpr int CH_G = 0, CH_Q = 8192, CH_UT = 12288, CH_YL = 20480, CH_EC = 24576, CH_BYTES = 25600, CH_NLOAD = 26;

__device__ __forceinline__ f32x16 mm(v4u a, v4u b, f32x16 c) { return __builtin_amdgcn_mfma_f32_32x32x16_bf16(__builtin_bit_cast(sbf16x8, a), __builtin_bit_cast(sbf16x8, b), c, 0, 0, 0); }
typedef float f32x2c __attribute__((ext_vector_type(2))); typedef __bf16 bf16x2c __attribute__((ext_vector_type(2)));
__device__ __forceinline__ unsigned cvtpk(float lo, float hi) { return __builtin_bit_cast(unsigned, __builtin_convertvector((f32x2c){lo, hi}, bf16x2c)); }
template <int S, int NEG> __device__ __forceinline__ v4u cvtf(const f32x16& x) {
    v4u w; const float sg = NEG ? -1.f : 1.f;
    w.x = cvtpk(sg * x[8 * S + 0], sg * x[8 * S + 1]); w.y = cvtpk(sg * x[8 * S + 2], sg * x[8 * S + 3]); w.z = cvtpk(sg * x[8 * S + 4], sg * x[8 * S + 5]); w.w = cvtpk(sg * x[8 * S + 6], sg * x[8 * S + 7]); return w; }
template <int MODE  > __device__ __forceinline__ f32x16 mask_acc(f32x16 x, int n, int hh) {
#pragma unroll
    for (int r = 0; r < 16; ++r) { const int m = (r & 3) + 8 * (r >> 2) + 4 * hh; const bool keep = MODE == 0 ? (m > n) : MODE == 1 ? (m < n) : (m <= n); x[r] = keep ? x[r] : 0.f; }
    return x; }
__device__ __forceinline__ f32x16 zero16() { f32x16 z;
#pragma unroll
    for (int r = 0; r < 16; ++r) z[r] = 0.f;
    return z; }
__device__ __forceinline__ void cm_build(const unsigned (&w)[16], v4u (&f)[2][2]) {
#pragma unroll
    for (int s = 0; s < 2; ++s) {
        const auto r0 = __builtin_amdgcn_permlane32_swap(w[8 * s + 0], w[8 * s + 2], false, false), r1 = __builtin_amdgcn_permlane32_swap(w[8 * s + 1], w[8 * s + 3], false, false);
        const auto r2 = __builtin_amdgcn_permlane32_swap(w[8 * s + 4], w[8 * s + 6], false, false), r3 = __builtin_amdgcn_permlane32_swap(w[8 * s + 5], w[8 * s + 7], false, false);
        f[0][s] = (v4u){r0[0], r1[0], r2[0], r3[0]}; f[1][s] = (v4u){r0[1], r1[1], r2[1], r3[1]}; }
}
__device__ __forceinline__ void st16(unsigned char* base, int off, int lane, v4u v) { *(v4u*)(base + off + lane * 16) = v; }

__device__ __forceinline__ void ph_scan1(const KP& p, int l, int gw, int NGW, int lane) {
    const bf16* P = (const bf16*)(OWS + WS_P); const bf16* LO = (const bf16*)(OWS + WS_LO); const float* NRM = (const float*)(OWS + WS_RKS); unsigned char* CH = OWS + WS_CH;
    const int n = lane & 31, hh = lane >> 5;
    v4u Id[2];
#pragma unroll
    for (int s = 0; s < 2; ++s) { unsigned wd[4];
#pragma unroll
        for (int q = 0; q < 4; ++q) { const int j0 = 2 * q, j1 = 2 * q + 1; const int t0 = 16 * s + 8 * (j0 >> 2) + 4 * hh + (j0 & 3), t1 = 16 * s + 8 * (j1 >> 2) + 4 * hh + (j1 & 3);
            wd[q] = (t0 == n ? 0x3F80u : 0u) | (t1 == n ? 0x3F800000u : 0u); }
        Id[s] = (v4u){wd[0], wd[1], wd[2], wd[3]}; }
    for (int task = gw; task < SC_NTASK; task += NGW) {
        const int dir = task & 1, h = (task >> 1) & 7, b = (task >> 4) & 3, ci = task >> 6;
        const int row0 = scan_row(b, dir, SC_C * ci), sgn = dir ? -1 : 1, c = h * 64 + lane;
        const float w0c = PIN(I_W0)[(l * 2 + dir) * RW + c], a0c = PIN(I_A0)[(l * 2 + dir) * RW + c], kkc = PIN(I_KK)[l * RW + c], kac = PIN(I_KA)[l * RW + c];
        unsigned wAl[16], wBe[16], wKa[16], wRh[16], wV[16], wBp[16], wKp[16];
        float cs = 0.f, Eprev = 1.f;
#pragma unroll
        for (int hb = 0; hb < 2; ++hb) {
            unsigned rk_[16], rr_[16], rv_[16], rw_[16], ra_[16]; float rn_[16];
#pragma unroll
            for (int i = 0; i < 16; ++i) { const int row = row0 + sgn * (16 * hb + i); const bf16* pr = P + (size_t)row * NP; const bf16* lo = LO + (size_t)row * NLO;
                rk_[i] = pr[PC_K + c]; rr_[i] = pr[PC_R + c]; rv_[i] = pr[PC_V + c]; rw_[i] = lo[dir * RW + c]; ra_[i] = lo[1024 + dir * RW + c]; rn_[i] = NRM[row * 8 + h]; }
#pragma unroll
            for (int i = 0; i < 16; ++i) asm volatile("" : "+v"(rk_[i]), "+v"(rr_[i]), "+v"(rv_[i]), "+v"(rw_[i]), "+v"(ra_[i]), "+v"(rn_[i]));
#pragma unroll
            for (int pq = 0; pq < 8; ++pq) { const int pz = 8 * hb + pq; float al[2], be[2], ka[2], rh[2], vv[2];
#pragma unroll
                for (int e = 0; e < 2; ++e) { const int i = 2 * pq + e;
                    const float kv = bf2f((unsigned short)rk_[i]), rv = bf2f((unsigned short)rr_[i]); vv[e] = bf2f((unsigned short)rv_[i]);
                    const float wl = w0c + bf2f((unsigned short)rw_[i]), aa = __builtin_amdgcn_rcpf(1.f + __expf(-(a0c + bf2f((unsigned short)ra_[i])))), nrm = rn_[i];
                    const float lw = -0.6065306597f * __builtin_amdgcn_rcpf(1.f + __expf(-wl));
                    cs += lw; const float E = __expf(cs), Ei = __builtin_amdgcn_rcpf(E);
                    const float kkn = kv * kkc * nrm, kd = kv * (1.f + (aa - 1.f) * kac);
                    al[e] = kkn * Eprev; be[e] = kkn * aa * Ei; ka[e] = kd * Ei; rh[e] = rv * E; Eprev = E; }
                wAl[pz] = cvtpk(al[0], al[1]); wBe[pz] = cvtpk(be[0], be[1]); wKa[pz] = cvtpk(ka[0], ka[1]); wRh[pz] = cvtpk(rh[0], rh[1]); wV[pz] = cvtpk(vv[0], vv[1]); }
        }
        const float EC = Eprev;
#pragma unroll
        for (int pz = 0; pz < 16; ++pz) { wBp[pz] = cvtpk(bflo(wBe[pz]) * EC, bfhi(wBe[pz]) * EC); wKp[pz] = cvtpk(bflo(wKa[pz]) * EC, bfhi(wKa[pz]) * EC); }
        unsigned char* img = CH + (size_t)(((b * 8 + h) * 2 + dir) * SC_NCH + ci) * CH_BYTES;
        ((float*)(img + CH_EC))[lane] = EC;
        v4u cAl[2][2], cV[2][2], cBp[2][2], cKp[2][2], cRh[2][2];
        v4u tAl[4], tBe[4], tKa[4], tRh[4];
        cm_build(wAl, cAl); cm_build(wV, cV); cm_build(wBp, cBp); cm_build(wKp, cKp); cm_build(wRh, cRh);
        {   v4u cBe[2][2], cKa[2][2]; cm_build(wBe, cBe); cm_build(wKa, cKa);
#define TRANSPOSE(cZ, tZ) do { _Pragma("unroll") for (int ct = 0; ct < 2; ++ct) { f32x16 T_ = mm(cZ[ct][0], Id[0], zero16()); T_ = mm(cZ[ct][1], Id[1], T_); tZ[2 * ct] = cvtf<0, 0>(T_); tZ[2 * ct + 1] = cvtf<1, 0>(T_); } } while (0)
            TRANSPOSE(cAl, tAl); TRANSPOSE(cBe, tBe); TRANSPOSE(cKa, tKa); TRANSPOSE(cRh, tRh);
#undef TRANSPOSE
        }
#define PROD4(A, B) mm(A[3], B[3], mm(A[2], B[2], mm(A[1], B[1], mm(A[0], B[0], zero16()))))
        f32x16 XN = mask_acc<0>(PROD4(tAl, tBe), n, hh), XT = mask_acc<1>(PROD4(tBe, tAl), n, hh);
        v4u fLM[2], fGB[2], fGK[2];
        { const f32x16 t = mask_acc<1>(PROD4(tKa, tAl), n, hh); fLM[0] = cvtf<0, 0>(t); fLM[1] = cvtf<1, 0>(t); }
        { const f32x16 t = mask_acc<2>(PROD4(tBe, tRh), n, hh); fGB[0] = cvtf<0, 0>(t); fGB[1] = cvtf<1, 0>(t); }
        { const f32x16 t = mask_acc<2>(PROD4(tKa, tRh), n, hh); fGK[0] = cvtf<0, 0>(t); fGK[1] = cvtf<1, 0>(t); }
#undef PROD4
#pragma unroll
        for (int r = 0; r < 16; ++r) { XN[r] = -XN[r]; XT[r] = -XT[r]; }
        f32x16 RT = XT;
#pragma unroll
        for (int r = 0; r < 16; ++r) RT[r] += ((r & 3) + 8 * (r >> 2) + 4 * hh == n) ? 1.f : 0.f;
#pragma unroll
        for (int pw = 1; pw < 5; ++pw) {
            const v4u xn0 = cvtf<0, 0>(XN), xn1 = cvtf<1, 0>(XN), xt0 = cvtf<0, 0>(XT), xt1 = cvtf<1, 0>(XT);
            XN = mm(xt1, xn1, mm(xt0, xn0, zero16()));
            if (pw < 4) XT = mm(xn1, xt1, mm(xn0, xt0, zero16()));
            const v4u yn0 = cvtf<0, 0>(XN), yn1 = cvtf<1, 0>(XN), rt0 = cvtf<0, 0>(RT), rt1 = cvtf<1, 0>(RT);
            RT = mm(yn1, rt1, mm(yn0, rt0, RT));
        }
        const v4u fA0 = cvtf<0, 0>(RT), fA1 = cvtf<1, 0>(RT);
        f32x16 At[2], Vt[2];
#pragma unroll
        for (int t = 0; t < 2; ++t) {
            const f32x16 lmv = mm(fLM[1], cV[t][1], mm(fLM[0], cV[t][0], zero16()));
            At[t] = mm(fA1, cAl[t][1], mm(fA0, cAl[t][0], zero16()));
            Vt[t] = mm(fA1, cvtf<1, 0>(lmv), mm(fA0, cvtf<0, 0>(lmv), zero16()));
        }
#pragma unroll
        for (int kt1 = 0; kt1 < 2; ++kt1) { const v4u a0 = cvtf<0, 0>(At[kt1]), a1 = cvtf<1, 0>(At[kt1]);
#pragma unroll
            for (int kt2 = 0; kt2 < 2; ++kt2) { const f32x16 g = mm(a1, cBp[kt2][1], mm(a0, cBp[kt2][0], zero16()));
                st16(img, CH_G + ((kt2 * 2 + kt1) * 2 + 0) * 1024, lane, cvtf<0, 1>(g)); st16(img, CH_G + ((kt2 * 2 + kt1) * 2 + 1) * 1024, lane, cvtf<1, 1>(g)); } }
#pragma unroll
        for (int vt = 0; vt < 2; ++vt) { const v4u nv0 = cvtf<0, 1>(Vt[vt]), nv1 = cvtf<1, 1>(Vt[vt]);
#pragma unroll
            for (int kt = 0; kt < 2; ++kt) { f32x16 u = mm(cKp[kt][1], cV[vt][1], mm(cKp[kt][0], cV[vt][0], zero16())); u = mm(cBp[kt][1], nv1, mm(cBp[kt][0], nv0, u));
                st16(img, CH_UT + ((kt * 2 + vt) * 2 + 0) * 1024, lane, cvtf<0, 0>(u)); st16(img, CH_UT + ((kt * 2 + vt) * 2 + 1) * 1024, lane, cvtf<1, 0>(u)); }
            f32x16 y = mm(cV[vt][1], fGK[1], mm(cV[vt][0], fGK[0], zero16())); y = mm(nv1, fGB[1], mm(nv0, fGB[0], y));
            st16(img, CH_YL + (vt * 2 + 0) * 1024, lane, cvtf<0, 0>(y)); st16(img, CH_YL + (vt * 2 + 1) * 1024, lane, cvtf<1, 0>(y)); }
#pragma unroll
        for (int kt = 0; kt < 2; ++kt) { f32x16 q = mm(cRh[kt][1], Id[1], mm(cRh[kt][0], Id[0], zero16()));
            q = mm(cvtf<1, 1>(At[kt]), fGB[1], mm(cvtf<0, 1>(At[kt]), fGB[0], q));
            st16(img, CH_Q + (kt * 2 + 0) * 1024, lane, cvtf<0, 0>(q)); st16(img, CH_Q + (kt * 2 + 1) * 1024, lane, cvtf<1, 0>(q)); }
    }
}

__device__ __forceinline__ void ph_scan2(const KP& p, LAS unsigned char* lds, int l, int wave, int lane) {
    unsigned* sdone = (unsigned*)(OWS + WS_CTL) + CW_SDONE + 64 * l;
#ifndef CQ_SLOT_WGS
#define CQ_SLOT_WGS 128
#endif
    if (blockIdx.x >= SC_NCHAIN * 2) {
        const int q0 = (l < 2 ? CQ_J1 : CQ_END0) + (l & 1) * CQ_SLOT_ITEMS;
        cq_static(p, lds, q0, q0 + CQ_SLOT_ITEMS, ((int)blockIdx.x - SC_NCHAIN * 2) * NWAVES + wave, ((int)gridDim.x - SC_NCHAIN * 2) * NWAVES, wave, lane); return; }
    const int chain = blockIdx.x >> 1, vt = blockIdx.x & 1, dir = chain & 1, h = (chain >> 1) & 7, b = chain >> 4;
    const int n = lane & 31, hh = lane >> 5;
    const unsigned char* CH = OWS + WS_CH + (size_t)chain * SC_NCH * CH_BYTES; bf16* Y = (bf16*)(OWS + WS_Y) + (size_t)dir * MROWS * RW + h * 64 + 32 * vt + 4 * hh;
    constexpr int NPIECE = 19, SLOT = NPIECE * 1024, NSLOT = 6, PD = 4, XCH = NSLOT * SLOT;
    int psrc[3], pdst[3];
#pragma unroll
    for (int j = 0; j < 3; ++j) { int f = wave + 8 * j; if (f >= NPIECE) f -= NPIECE;
        pdst[j] = f;
        psrc[j] = f < 12 ? f * 1024 : f < 16 ? CH_UT + ((((f - 12) >> 1) * 2 + vt) * 2 + ((f - 12) & 1)) * 1024 : f < 18 ? CH_YL + (vt * 2 + (f - 16)) * 1024 : CH_EC; }
    const int lane_off[3] = {pdst[0] == 18 ? (lane * 16) & 255 : lane * 16, pdst[1] == 18 ? (lane * 16) & 255 : lane * 16, pdst[2] == 18 ? (lane * 16) & 255 : lane * 16};
#define SC2_ISSUE(ci_, slot_) do { const unsigned char* im_ = CH + (size_t)(ci_) * CH_BYTES; LAS unsigned char* sl_ = lds + (slot_) * SLOT; \
        _Pragma("unroll") for (int j = 0; j < 3; ++j) __builtin_amdgcn_global_load_lds((const unsigned*)(im_ + psrc[j] + lane_off[j]), (LAS unsigned*)(sl_ + pdst[j] * 1024), 16, 0, 0); } while (0)
#define SC2_LD(slot_, piece_) (*(const LAS v4u*)(lds + (slot_) * SLOT + (piece_) * 1024 + lane * 16))
#define SC2_X(par_, k_) (*(LAS v4u*)(lds + XCH + (par_) * 4096 + (k_) * 1024 + lane * 16))
    f32x16 ST[2] = {zero16(), zero16()};
    SC2_ISSUE(0, 0); SC2_ISSUE(1, 1); SC2_ISSUE(2, 2); SC2_ISSUE(3, 3);
    for (int ci = 0; ci <= SC_NCH; ++ci) {
        const int slot = ci % NSLOT;
        asm volatile("s_waitcnt vmcnt(9)" ::: "memory");
        __builtin_amdgcn_s_barrier();
        asm volatile("" ::: "memory");
        { const int nx = ci + PD < SC_NCH ? ci + PD : SC_NCH - 1; SC2_ISSUE(nx, (ci + PD) % NSLOT); }
        if (wave == 0 && ci < SC_NCH) {
            v4u g0 = SC2_LD(slot, 0), g1 = SC2_LD(slot, 1), g2 = SC2_LD(slot, 2), g3 = SC2_LD(slot, 3), g4 = SC2_LD(slot, 4), g5 = SC2_LD(slot, 5), g6 = SC2_LD(slot, 6), g7 = SC2_LD(slot, 7);
            v4u u0 = SC2_LD(slot, 12), u1 = SC2_LD(slot, 13), u2 = SC2_LD(slot, 14), u3 = SC2_LD(slot, 15);
            f32x4 ec[8];
#pragma unroll
            for (int kq = 0; kq < 8; ++kq) ec[kq] = *(const LAS f32x4*)(lds + slot * SLOT + 18 * 1024 + (32 * (kq >> 2) + 8 * (kq & 3) + 4 * hh) * 4);
            asm volatile("" : "+v"(g0), "+v"(g1), "+v"(g2), "+v"(g3), "+v"(g4), "+v"(g5), "+v"(g6), "+v"(g7), "+v"(u0), "+v"(u1), "+v"(u2), "+v"(u3));
            asm volatile("" : "+v"(ec[0]), "+v"(ec[1]), "+v"(ec[2]), "+v"(ec[3]), "+v"(ec[4]), "+v"(ec[5]), "+v"(ec[6]), "+v"(ec[7]));
            const v4u s00 = cvtf<0, 0>(ST[0]), s01 = cvtf<1, 0>(ST[0]), s10 = cvtf<0, 0>(ST[1]), s11 = cvtf<1, 0>(ST[1]);
            SC2_X(ci & 1, 0) = s00; SC2_X(ci & 1, 1) = s01; SC2_X(ci & 1, 2) = s10; SC2_X(ci & 1, 3) = s11;
            f32x16 a0, a1;
            a0[0] = bflo(u0.x); a0[1] = bfhi(u0.x); a0[2] = bflo(u0.y); a0[3] = bfhi(u0.y); a0[4] = bflo(u0.z); a0[5] = bfhi(u0.z); a0[6] = bflo(u0.w); a0[7] = bfhi(u0.w);
            a0[8] = bflo(u1.x); a0[9] = bfhi(u1.x); a0[10] = bflo(u1.y); a0[11] = bfhi(u1.y); a0[12] = bflo(u1.z); a0[13] = bfhi(u1.z); a0[14] = bflo(u1.w); a0[15] = bfhi(u1.w);
            a1[0] = bflo(u2.x); a1[1] = bfhi(u2.x); a1[2] = bflo(u2.y); a1[3] = bfhi(u2.y); a1[4] = bflo(u2.z); a1[5] = bfhi(u2.z); a1[6] = bflo(u2.w); a1[7] = bfhi(u2.w);
            a1[8] = bflo(u3.x); a1[9] = bfhi(u3.x); a1[10] = bflo(u3.y); a1[11] = bfhi(u3.y); a1[12] = bflo(u3.z); a1[13] = bfhi(u3.z); a1[14] = bflo(u3.w); a1[15] = bfhi(u3.w);
#pragma unroll
            for (int q = 0; q < 4; ++q)
#pragma unroll
                for (int e = 0; e < 4; ++e) { a0[4 * q + e] += ST[0][4 * q + e] * ec[q][e]; a1[4 * q + e] += ST[1][4 * q + e] * ec[4 + q][e]; }
            a0 = mm(g0, s00, a0); a1 = mm(g4, s00, a1); a0 = mm(g1, s01, a0); a1 = mm(g5, s01, a1);
            a0 = mm(g2, s10, a0); a1 = mm(g6, s10, a1); a0 = mm(g3, s11, a0); a1 = mm(g7, s11, a1);
            ST[0] = a0; ST[1] = a1;
            if (lane == 0 && ci == SC_NCH - 24) __hip_atomic_fetch_add(sdone, 1u, __ATOMIC_RELAXED, __HIP_MEMORY_SCOPE_AGENT);
        } else if (wave == 1 && ci >= 1) {
            const int cj = ci - 1, sj = cj % NSLOT, par = cj & 1;
            v4u ya = SC2_LD(sj, 16), yc = SC2_LD(sj, 17), q0 = SC2_LD(sj, 8), q1 = SC2_LD(sj, 9), q2 = SC2_LD(sj, 10), q3 = SC2_LD(sj, 11), x0 = SC2_X(par, 0), x1 = SC2_X(par, 1), x2 = SC2_X(par, 2), x3 = SC2_X(par, 3);
            asm volatile("" : "+v"(ya), "+v"(yc), "+v"(q0), "+v"(q1), "+v"(q2), "+v"(q3), "+v"(x0), "+v"(x1), "+v"(x2), "+v"(x3));
            f32x16 y, y2 = zero16();
            y[0] = bflo(ya.x); y[1] = bfhi(ya.x); y[2] = bflo(ya.y); y[3] = bfhi(ya.y); y[4] = bflo(ya.z); y[5] = bfhi(ya.z); y[6] = bflo(ya.w); y[7] = bfhi(ya.w);
            y[8] = bflo(yc.x); y[9] = bfhi(yc.x); y[10] = bflo(yc.y); y[11] = bfhi(yc.y); y[12] = bflo(yc.z); y[13] = bfhi(yc.z); y[14] = bflo(yc.w); y[15] = bfhi(yc.w);
            y = mm(x0, q0, y); y2 = mm(x2, q2, y2); y = mm(x1, q1, y); y2 = mm(x3, q3, y2);
            const int row = scan_row(b, dir, SC_C * cj + n); bf16* yo = Y + (size_t)row * RW;
#pragma unroll
            for (int q = 0; q < 4; ++q) *(v2u*)(yo + 8 * q) = (v2u){cvtpk(y[4 * q] + y2[4 * q], y[4 * q + 1] + y2[4 * q + 1]), cvtpk(y[4 * q + 2] + y2[4 * q + 2], y[4 * q + 3] + y2[4 * q + 3])};
        }
        asm volatile("s_waitcnt lgkmcnt(0)" ::: "memory");
    }
    asm volatile("s_waitcnt vmcnt(0)" ::: "memory");
#undef SC2_ISSUE
#undef SC2_LD
#undef SC2_X
}

__device__ __forceinline__ float sum8(float v) { v += __shfl_xor(v, 1); v += __shfl_xor(v, 2); v += __shfl_xor(v, 4); return v; }
__device__ __forceinline__ void unpack8(v4u s, float (&v)[8]) { v[0] = bflo(s.x); v[1] = bfhi(s.x); v[2] = bflo(s.y); v[3] = bfhi(s.y); v[4] = bflo(s.z); v[5] = bfhi(s.z); v[6] = bflo(s.w); v[7] = bfhi(s.w); }
__device__ __forceinline__ void ld8f(const float* q, float (&v)[8]) { const f32x4 a = *(const f32x4*)q, b = *(const f32x4*)(q + 4); v[0] = a[0]; v[1] = a[1]; v[2] = a[2]; v[3] = a[3]; v[4] = b[0]; v[5] = b[1]; v[6] = b[2]; v[7] = b[3]; }
__device__ __forceinline__ v4u pack8(const float (&v)[8]) { v4u o; o.x = cvtpk(v[0], v[1]); o.y = cvtpk(v[2], v[3]); o.z = cvtpk(v[4], v[5]); o.w = cvtpk(v[6], v[7]); return o; }

__device__ __forceinline__ void ph_readout2(const KP& p, int l, int gw, int NGW, int lane) {
    const bf16* P = (const bf16*)(OWS + WS_P); const bf16* LO = (const bf16*)(OWS + WS_LO); const bf16* Y = (const bf16*)(OWS + WS_Y);
    bf16* MI = (bf16*)(OWS + WS_MIXIN); constexpr size_t PA = (size_t)MROWS * RW; const int c0 = lane * 8;
    for (int row = gw; row < MROWS; row += NGW) { const bf16* pr = P + (size_t)row * NP; const bf16* lo = LO + (size_t)row * NLO;
        int t, len; if (row < NLAT) { t = row & 63; len = 64; } else { t = (row - NLAT) & 255; len = 256; }
        const v4u kw = *(const v4u*)(pr + PC_K + c0), rw = *(const v4u*)(pr + PC_R + c0), vw = *(const v4u*)(pr + PC_V + c0);
        const v4u cbw = *(const v4u*)(pr + PC_CB + c0), ccw = *(const v4u*)(pr + PC_CC + c0), chw = *(const v4u*)(pr + PC_CH + c0);
        v4u ccp = (v4u){0u, 0u, 0u, 0u}, chp = ccp, ccn = ccp, chn = ccp;
        if (t > 0) { ccp = *(const v4u*)(pr - NP + PC_CC + c0); chp = *(const v4u*)(pr - NP + PC_CH + c0); }
        if (t < len - 1) { ccn = *(const v4u*)(pr + NP + PC_CC + c0); chn = *(const v4u*)(pr + NP + PC_CH + c0); }
        float yf[8], yb[8], la0[8], la1[8], g[8];
        unpack8(*(const v4u*)(Y + (size_t)row * RW + c0), yf); unpack8(*(const v4u*)(Y + PA + (size_t)row * RW + c0), yb); unpack8(*(const v4u*)(lo + 1024 + c0), la0); unpack8(*(const v4u*)(lo + 1536 + c0), la1); unpack8(*(const v4u*)(lo + 2048 + c0), g);
        float a0[8], a1[8], ka[8], rkp[8], lg[8], lb[8];
        ld8f(PIN(I_A0) + (l * 2 + 0) * RW + c0, a0); ld8f(PIN(I_A0) + (l * 2 + 1) * RW + c0, a1); ld8f(PIN(I_KA) + l * RW + c0, ka); ld8f(PIN(I_RK) + l * RW + c0, rkp);
        ld8f(PIN(I_LNXG) + l * RW + c0, lg); ld8f(PIN(I_LNXB) + l * RW + c0, lb);
        float kv[8], rv[8], vv[8]; unpack8(kw, kv); unpack8(rw, rv); unpack8(vw, vv);
        float y[8], s = 0.f, rk = 0.f;
#pragma unroll
        for (int j = 0; j < 8; ++j) { y[j] = yf[j] + yb[j]; s += y[j]; const float av = sigm(a0[j] + la0[j]) + sigm(a1[j] + la1[j]); rk += rv[j] * kv[j] * (2.f + (av - 2.f) * ka[j]) * rkp[j]; }
        const float mu = sum8(s) * (1.f / 64.f); rk = sum8(rk); float q = 0.f;
#pragma unroll
        for (int j = 0; j < 8; ++j) { y[j] -= mu; q += y[j] * y[j]; }
        const float rstd = 1.f / sqrtf(sum8(q) * (1.f / 64.f) + GN_EPS);
        float o[8];
#pragma unroll
        for (int j = 0; j < 8; ++j) o[j] = (y[j] * rstd * lg[j] + lb[j] + rk * vv[j]) * g[j];
        *(v4u*)(MI + (size_t)row * D + c0) = pack8(o);
        float cb[8], cc[8], ch[8], pcc[8], pch[8], ncc[8], nch[8], w0[8], w1[8], w2[8];
        unpack8(cbw, cb); unpack8(ccw, cc); unpack8(chw, ch); unpack8(ccp, pcc); unpack8(chp, pch); unpack8(ccn, ncc); unpack8(chn, nch);
        const float* cw = PIN(I_CONVW) + (size_t)l * 3 * RW + c0; ld8f(cw, w0); ld8f(cw + RW, w1); ld8f(cw + 2 * RW, w2);
#pragma unroll
        for (int j = 0; j < 8; ++j) o[j] = cb[j] * (pcc[j] * pch[j] * w0[j] + cc[j] * ch[j] * w1[j] + ncc[j] * nch[j] * w2[j]);
        *(v4u*)(MI + (size_t)row * D + RW + c0) = pack8(o);
    }
}


template <int KS> __device__ __forceinline__ void lora_task(const bf16* pr, int col0, int fn, const bf16* wt, bf16* out, int ct0, int n, int hh) {
    v4u af[KS];
#pragma unroll
    for (int s = 0; s < KS; ++s) { const v4u w = *(const v4u*)(pr + col0 + 16 * s + 8 * hh); float v[8]; unpack8(w, v);
        if (fn == 0) {
#pragma unroll
            for (int j = 0; j < 8; ++j) v[j] = 1.f - 2.f * __builtin_amdgcn_rcpf(1.f + __expf(2.f * v[j])); }
        else if (fn == 2) {
#pragma unroll
            for (int j = 0; j < 8; ++j) v[j] = __builtin_amdgcn_rcpf(1.f + __expf(-v[j])); }
        af[s] = pack8(v); }
#pragma unroll 2
    for (int ct = ct0; ct < ct0 + 8; ++ct) { f32x16 acc = zero16(); const bf16* wb = wt + (size_t)(32 * ct + n) * (16 * KS) + 8 * hh;
#pragma unroll
        for (int s = 0; s < KS; ++s) acc = mm(af[s], *(const v4u*)(wb + 16 * s), acc);
#pragma unroll
        for (int r = 0; r < 16; ++r) out[(size_t)((r & 3) + 8 * (r >> 2) + 4 * hh) * NLO + 32 * ct + n] = (bf16)f2bf(acc[r]); }
}
__device__ __forceinline__ void ph_lora(const KP& p, int l, int gw, int NGW, int lane) {
    const bf16* P = (const bf16*)(OWS + WS_P); bf16* LO = (bf16*)(OWS + WS_LO); float* NRM = (float*)(OWS + WS_RKS);
    const bf16* LW = (const bf16*)(OWS + WS_LORA) + (size_t)l * LORAW_PER_LAYER; const int n = lane & 31, hh = lane >> 5;
    for (int task = gw; task < (MROWS / 32) * 10; task += NGW) { const int half = task & 1, grp = (task >> 1) % 5, rb = task / 10;
        const bf16* pr = P + (size_t)(rb * 32 + n) * NP; bf16* out = LO + (size_t)(rb * 32) * NLO + grp * 512;
        if (grp < 4) lora_task<4>(pr, grp < 2 ? PC_WD + 64 * grp : PC_AD + 64 * (grp - 2), grp < 2 ? 0 : 1, LW + (size_t)grp * 512 * 64, out, half * 8, n, hh);
        else lora_task<8>(pr, PC_GD, 2, LW + (size_t)4 * 512 * 64, out, half * 8, n, hh); }
    float kkc[8]; ld8f(PIN(I_KK) + l * RW + lane * 8, kkc);
    for (int row = gw; row < MROWS; row += NGW) { const v4u kw = *(const v4u*)(P + (size_t)row * NP + PC_K + lane * 8); float kv[8]; unpack8(kw, kv); float ss = 0.f;
#pragma unroll
        for (int j = 0; j < 8; ++j) { const float t = kv[j] * kkc[j]; ss += t * t; }
        ss = sum8(ss); if ((lane & 7) == 0) NRM[row * 8 + (lane >> 3)] = 1.f / fmaxf(sqrtf(ss), 1e-12f); }
}

__device__ __forceinline__ void ph_moe_gather(const KP& p, int l, int gw, int NGW, int lane) {
    const unsigned* gcnt = (const unsigned*)(OWS + WS_CTL) + CW_GCNT + 64 * (l >> 1);
    int cnt[8], pb[9]; pb[0] = 0;
#pragma unroll
    for (int e = 0; e < 8; ++e) { cnt[e] = (int)gcnt[e]; pb[e + 1] = pb[e] + ((cnt[e] + 255) & ~255); }
    const unsigned* rowlist = (const unsigned*)(OWS + WS_ROWLIST); const float* wsel = (const float*)(OWS + WS_WSEL); float* wsort = (float*)(OWS + WS_WSORT);
    const unsigned char* H8 = OWS + WS_H8; unsigned char* HG = OWS + WS_HG; const float* sa = (const float*)(OWS + WS_SA); float* sag = (float*)(OWS + WS_SAG);
    for (int pos = gw; pos < pb[8]; pos += NGW) {
        int e = 0, base = 0, ce = cnt[0];
#pragma unroll
        for (int k = 1; k < 8; ++k) if (pos >= pb[k]) { e = k; base = pb[k]; ce = cnt[k]; }
        const int rank = pos - base; v4u a = (v4u){0u, 0u, 0u, 0u}; float w = 0.f, sc = 0.f;
        if (rank < ce) { const unsigned ent = rowlist[(size_t)e * MROWS + rank]; a = *(const v4u*)(H8 + (size_t)(ent >> 1) * D + lane * 16); w = wsel[ent]; sc = sa[ent >> 1]; }
        *(v4u*)(HG + (size_t)pos * D + lane * 16) = a;
        if (lane == 0) { wsort[pos] = w; sag[pos] = sc; }
    }
}

__device__ __forceinline__ void ph_ln(const KP& p, LAS unsigned char* lds, int l, int which, int tid, int wave, int gw, int NGW, int lane) {
    const float* modv = (const float*)(OWS + WS_MODV); float* X = (float*)(OWS + WS_X); bf16* H = (bf16*)(OWS + WS_H);
    const bf16* BR = (const bf16*)(OWS + (which == 0 ? WS_MIXO : WS_F)); const float* BP = (const float*)(OWS + (which == 0 ? WS_MIXP : WS_FP));
    const float* lg = PIN(which == 0 ? I_LN1G : I_LN2G) + l * D; const float* lb = PIN(which == 0 ? I_LN1B : I_LN2B) + l * D;
    const bool moe = (which == 0) && (l & 1); const bool last = (which == 1) && (l == DEPTH - 1); const bool moe_out = (which == 1) && (l & 1);
    LAS int* lcnt = (LAS int*)lds;
    LAS int* lsel = (LAS int*)(lds + 64);
    int nloc = 0;
    if (moe) { if (tid < 16) lcnt[tid] = 0; __syncthreads(); }
    int pbs[9]; pbs[0] = 0;
    if (moe_out) { const unsigned* gcnt = (const unsigned*)(OWS + WS_CTL) + CW_GCNT + 64 * (l >> 1);
#pragma unroll
        for (int e = 0; e < 8; ++e) pbs[e + 1] = pbs[e] + (int)((gcnt[e] + 255u) & ~255u); }
    f32x4 gt[4], g4[4], b4[4], sh[4], sc[4]; ld_row(lg, lane, g4); ld_row(lb, lane, b4);
    for (int it = 0; it < 9; ++it) {
        if (it == 8 && gw >= NCTX) break;
        const int row = it < 8 ? (gw >> 9) * SEQ + (gw & 511) + 512 * it : NLAT + gw;
        const int mr = mod_row(row); const float* mv = modv + (size_t)(l * 5 + mr) * NMOD;
        if (it == 0 || it == 8) { ld_row(mv + (which == 0 ? 2048 : 5120), lane, gt);
            if (!last) { const float* mv2 = which == 0 ? mv + 3072 : modv + (size_t)((l + 1) * 5 + mr) * NMOD; ld_row(mv2, lane, sh); ld_row(mv2 + 1024, lane, sc); } }
        f32x4 x[4], br[4], t[4]; ld_row(X + (size_t)row * D, lane, x);
        if (moe_out) { const int* ts = (const int*)(OWS + WS_TOKSEL) + row * 4; const int e0 = ts[0], r0 = ts[1], e1 = ts[2], r1 = ts[3]; int b0 = 0, b1 = 0;
#pragma unroll
            for (int k = 1; k < 8; ++k) { if (e0 >= k) b0 = pbs[k]; if (e1 >= k) b1 = pbs[k]; }
            f32x4 ba[4], bb[4]; const int q0 = b0 + r0, q1 = b1 + r1; constexpr int MM = MOE_MAIN_PANELS * 256;
            if (q0 < MM) ld_row_bf16(BR + (size_t)q0 * D, lane, ba); else ld_row_parts<4>(BP + (size_t)(q0 - MM) * D, (size_t)MOE_TAIL_ROWS * D, lane, ba);
            if (q1 < MM) ld_row_bf16(BR + (size_t)q1 * D, lane, bb); else ld_row_parts<4>(BP + (size_t)(q1 - MM) * D, (size_t)MOE_TAIL_ROWS * D, lane, bb);
#pragma unroll
            for (int j = 0; j < 4; ++j) br[j] = ba[j] + bb[j]; }
        else if (row < NLAT) ld_row_bf16(BR + (size_t)row * D, lane, br);
        else if (which == 0) ld_row_parts<4>(BP + (size_t)(row - NLAT) * D, (size_t)NCTX * D, lane, br);
        else ld_row_parts<7>(BP + (size_t)(row - NLAT) * D, (size_t)NCTX * D, lane, br);
        float s = 0.f;
#pragma unroll
        for (int j = 0; j < 4; ++j) { t[j] = DN_ALPHA * x[j] + gt[j] * br[j]; s += (t[j][0] + t[j][1]) + (t[j][2] + t[j][3]); }
        const float mean = wave_sum(s) * (1.f / D); float s2 = 0.f;
#pragma unroll
        for (int j = 0; j < 4; ++j) { t[j] = t[j] - mean; s2 += (t[j][0] * t[j][0] + t[j][1] * t[j][1]) + (t[j][2] * t[j][2] + t[j][3] * t[j][3]); }
        const float rstd = 1.f / sqrtf(wave_sum(s2) * (1.f / D) + LN_EPS);
#pragma unroll
        for (int j = 0; j < 4; ++j) x[j] = t[j] * rstd * g4[j] + b4[j];
        if (last) {
#if PROBE_DUP & (128 | 256)
            { const unsigned* cw = (const unsigned*)(OWS + WS_CTL); const float cval = 10.f * ((float)cw[20001] / 1024.f) / fmaxf((float)cw[20000], 1.f);
#pragma unroll
              for (int j = 0; j < 4; ++j) x[j] = (f32x4){cval, cval, cval, cval}; }
#endif
            if (row < NLAT) st_row(p.out + (size_t)row * D, lane, x); continue; }
        st_row(X + (size_t)row * D, lane, x);
        f32x4 hh[4];
#pragma unroll
        for (int j = 0; j < 4; ++j) hh[j] = x[j] * (1.f + sc[j]) + sh[j];
        if (which == 1) st_row_bf16(H + (size_t)row * D, lane, hh);
        else {
            float am = 0.f;
#pragma unroll
            for (int j = 0; j < 4; ++j) am = fmaxf(fmaxf(am, fmaxf(fabsf(hh[j][0]), fabsf(hh[j][1]))), fmaxf(fabsf(hh[j][2]), fabsf(hh[j][3])));
#pragma unroll
            for (int o = 1; o < 64; o <<= 1) am = fmaxf(am, __shfl_xor(am, o));
            am = fmaxf(am, 1e-30f); const float inv = 127.f / am; unsigned* h8 = (unsigned*)(OWS + WS_H8) + (size_t)row * (D / 4) + lane;
#pragma unroll
            for (int j = 0; j < 4; ++j) h8[64 * j] = q8pack(hh[j][0] * inv, hh[j][1] * inv, hh[j][2] * inv, hh[j][3] * inv);
            if (lane == 0) ((float*)(OWS + WS_SA))[row] = am * (1.f / 127.f);
        }
        if (moe) {
            const float* rw = PIN(I_RTW) + (size_t)(l >> 1) * D * NE; float lgt[8];
#pragma unroll
            for (int e = 0; e < 8; ++e) lgt[e] = 0.f;
#pragma unroll
            for (int j = 0; j < 4; ++j)
#pragma unroll
                for (int i = 0; i < 4; ++i) { const f32x4* wp = (const f32x4*)(rw + (size_t)(4 * lane + 256 * j + i) * NE); const f32x4 w0 = wp[0], w1 = wp[1]; const float hv = hh[j][i];
                    lgt[0] += hv * w0[0]; lgt[1] += hv * w0[1]; lgt[2] += hv * w0[2]; lgt[3] += hv * w0[3]; lgt[4] += hv * w1[0]; lgt[5] += hv * w1[1]; lgt[6] += hv * w1[2]; lgt[7] += hv * w1[3]; }
#pragma unroll
            for (int e = 0; e < 8; ++e) lgt[e] = wave_sum(lgt[e]) + PIN(I_RTB)[(l >> 1) * NE + e];
            float v0 = lgt[0]; int i0 = 0;
#pragma unroll
            for (int e = 1; e < 8; ++e) if (lgt[e] > v0) { v0 = lgt[e]; i0 = e; }
            float v1 = -3.0e38f; int i1 = -1;
#pragma unroll
            for (int e = 0; e < 8; ++e) if (e != i0 && lgt[e] > v1) { v1 = lgt[e]; i1 = e; }
            const float w0 = 1.f / (1.f + expf(v1 - v0)), w1 = 1.f - w0;
            if (lane == 0) { const int lr0 = __hip_atomic_fetch_add(lcnt + i0, 1, __ATOMIC_RELAXED, __HIP_MEMORY_SCOPE_WORKGROUP), lr1 = __hip_atomic_fetch_add(lcnt + i1, 1, __ATOMIC_RELAXED, __HIP_MEMORY_SCOPE_WORKGROUP); const int li = nloc * NWAVES + wave;
                lsel[li * 8 + 0] = row; lsel[li * 8 + 1] = i0; lsel[li * 8 + 2] = lr0; lsel[li * 8 + 3] = i1; lsel[li * 8 + 4] = lr1;
                ((float*)(OWS + WS_WSEL))[row * 2] = w0; ((float*)(OWS + WS_WSEL))[row * 2 + 1] = w1; }
            ++nloc;
        }
    }
    if (moe) {
        __syncthreads();
        unsigned* gcnt = (unsigned*)(OWS + WS_CTL) + CW_GCNT + 64 * (l >> 1);
        if (tid < 8) lcnt[8 + tid] = (int)__hip_atomic_fetch_add(gcnt + tid, (unsigned)lcnt[tid], __ATOMIC_RELAXED, __HIP_MEMORY_SCOPE_AGENT);
        __syncthreads();
        unsigned* rowlist = (unsigned*)(OWS + WS_ROWLIST); int* toksel = (int*)(OWS + WS_TOKSEL);
        if (tid < 16 * NWAVES) { const int k = tid / NWAVES, w = tid % NWAVES; if (k < 8 || (k == 8 && (int)blockIdx.x * NWAVES + w < NCTX)) { const int li = k * NWAVES + w;
            const int row = lsel[li * 8 + 0], e0 = lsel[li * 8 + 1], r0 = lcnt[8 + e0] + lsel[li * 8 + 2], e1 = lsel[li * 8 + 3], r1 = lcnt[8 + e1] + lsel[li * 8 + 4];
            rowlist[(size_t)e0 * MROWS + r0] = (unsigned)row * 2u; rowlist[(size_t)e1 * MROWS + r1] = (unsigned)row * 2u + 1u;
            toksel[row * 4 + 0] = e0; toksel[row * 4 + 1] = r0; toksel[row * 4 + 2] = e1; toksel[row * 4 + 3] = r1; } }
    }
}


#ifndef PROBE_WHICH
#define PROBE_WHICH(x, y) (x)
#endif
#if PROBE_DUP & 128
__device__ __forceinline__ void ph_check_up(const KP& p, int gw, int lane) {
    if (gw >= 64) return;
    const float* X = (const float*)(OWS + WS_X); const float* modv = (const float*)(OWS + WS_MODV); const bf16* ACT = (const bf16*)(OWS + WS_ACT);
    const int row = gw * 257, c = lane * 56 + (gw & 7), mr = mod_row(row); const float* mv = modv + (size_t)(0 * 5 + mr) * NMOD;
    const signed char* H8 = (const signed char*)(OWS + WS_H8); const signed char* W8 = (const signed char*)(OWS + WS_F13); const float* SA = (const float*)(OWS + WS_SA); const unsigned* AM = (const unsigned*)(OWS + WS_AMAX);
    const int j1 = 8 * (c >> 2) + (c & 3), j3 = j1 + 4; int ia = 0, ib = 0;
    for (int k = 0; k < D; ++k) { const int h = H8[(size_t)row * D + k]; ia += h * W8[(size_t)j1 * D + k]; ib += h * W8[(size_t)j3 * D + k]; }
    const float a = (float)ia * SA[row] * __builtin_bit_cast(float, AM[j1]) * (1.f / 127.f), b = (float)ib * SA[row] * __builtin_bit_cast(float, AM[j3]) * (1.f / 127.f);
    (void)X; (void)mv;
    const float ref = a / (1.f + expf(-a)) * b, got = bf2f(ACT[(size_t)row * DFF + c]);
    const float da = ((const float*)(OWS + WS_F))[(size_t)row * DFF + c], db = ((const float*)(OWS + WS_F))[(size_t)4096 * DFF + (size_t)row * DFF + c]; (void)got; (void)db;
    if (row < 4096 && abs(ia) > 1000) { const float ratio = 10.f * fminf(fabsf(PROBE_WHICH(da / a, db / b) - 1.f), 0.4f);
        __hip_atomic_fetch_add((unsigned*)(OWS + WS_CTL) + 20000, 1u, __ATOMIC_RELAXED, __HIP_MEMORY_SCOPE_AGENT); __hip_atomic_fetch_add((unsigned*)(OWS + WS_CTL) + 20001, (unsigned)(ratio * 1024.f), __ATOMIC_RELAXED, __HIP_MEMORY_SCOPE_AGENT); }
}
#endif

#if PROBE_DUP & 256
__device__ __forceinline__ void ph_check_mfma(const KP& p, int lane) {
    typedef int i32x4 __attribute__((ext_vector_type(4)));
    const int r = lane & 15, g = lane >> 4; unsigned aw[4], bw[4];
#pragma unroll
    for (int q = 0; q < 4; ++q) { unsigned a = 0, b = 0;
#pragma unroll
        for (int t = 0; t < 4; ++t) { const int k = 16 * g + 4 * q + t; const int av = ((r * 7 + k * 3) % 5) - 2, bv = ((r * 5 + k * 11) % 7) - 3; a |= (unsigned)(av & 255) << (8 * t); b |= (unsigned)(bv & 255) << (8 * t); }
        aw[q] = a; bw[q] = b; }
    i32x4 c = {0, 0, 0, 0};
    c = __builtin_amdgcn_mfma_i32_16x16x64_i8((i32x4){(int)aw[0], (int)aw[1], (int)aw[2], (int)aw[3]}, (i32x4){(int)bw[0], (int)bw[1], (int)bw[2], (int)bw[3]}, c, 0, 0, 0);
    bool bad = false;
#pragma unroll
    for (int reg = 0; reg < 4; ++reg) { const int i = 4 * g + reg, j = r; int e = 0;
        for (int k = 0; k < 64; ++k) e += (((i * 7 + k * 3) % 5) - 2) * (((j * 5 + k * 11) % 7) - 3);
        if (c[reg] != e) bad = true; }
    if (bad) __hip_atomic_fetch_add((unsigned*)(OWS + WS_CTL) + 20000, 1000u, __ATOMIC_RELAXED, __HIP_MEMORY_SCOPE_AGENT);
}
#endif
__global__ void __launch_bounds__(NWAVES * 64, 2) fwd_kernel(KP p) {
    extern __shared__ __attribute__((aligned(16))) unsigned char lds_raw[];
    LAS unsigned char* lds = (LAS unsigned char*)lds_raw;
    volatile LAS unsigned* MISC = (volatile LAS unsigned*)(lds + MISC_OFF);
    const int G = gridDim.x, NGW = G * NWAVES;
    for (int u = threadIdx.x; u < (LDS_BYTES - LDSCTL_OFF) / 4; u += NWAVES * 64) ((LAS unsigned*)(lds + LDSCTL_OFF))[u] = 0u;
    __syncthreads();
    unsigned* ctl = (unsigned*)(OWS + WS_CTL);
    const bool single = p.ph < 0;
    XcdBarrier bar; bar.bar = ctl + CW_BAR; bar.x = 0; bar.st = nullptr;
    if (single) bar = xcd_barrier_post(ctl + CW_BAR, MISC + 8);
    int phc = 0;
#ifndef PROBE_DUP
#define PROBE_DUP 0
#endif
#define REP(bit) for (int rep_ = 0; rep_ < ((PROBE_DUP & (bit)) ? 2 : 1); ++rep_)
#define RUN() (single || p.ph == phc)
#define FRESH() int tid = threadIdx.x; asm volatile("" : "+v"(tid)); const int lane = tid & 63, wave = __builtin_amdgcn_readfirstlane(tid >> 6), gw = blockIdx.x * NWAVES + wave; (void)lane; (void)gw
#define SEAM() do { if (single) { XcdBarrier b2_ = bar; asm volatile("" : "+s"(b2_.bar)); xcd_barrier(b2_); if (PROBE_DUP & 32) { XcdBarrier b3_ = bar; asm volatile("" : "+s"(b3_.bar)); xcd_barrier(b3_); } } ++phc; } while (0)

    REP(4) if (RUN()) { FRESH(); ph_modvec(p, lds, tid); __syncthreads(); ph_convert(p, lds, gw, NGW, wave, lane); cq_static(p, lds, 0, 3 * CQ_IN + 3 * CQ_OUT, gw, NGW, wave, lane); cq_static(p, lds, 3 * CQ_IN + 3 * CQ_OUT + 2 * CQ_UP, CQ_J1, gw, NGW, wave, lane); ph_amax(p, gw, NGW, lane); }
    SEAM();
#if PROBE_DUP & 256
    if (blockIdx.x == 0 && threadIdx.x < 64) ph_check_mfma(p, threadIdx.x);
#endif
    if (RUN()) { FRESH(); ph_init_rows(p, gw, NGW, lane); cq_static(p, lds, -2 * CQ_UP, 0, gw, NGW, wave, lane); cq_static(p, lds, 3 * CQ_IN + 3 * CQ_OUT, 3 * CQ_IN + 3 * CQ_OUT + 2 * CQ_UP, gw, NGW, wave, lane); }
    SEAM();
    for (int ll = 0; ll < DEPTH; ++ll) {
#define l (ll + opaque_zero_i())
         if (RUN()) { pg8::Gemm g{(const bf16*)(OWS + WS_H), (const bf16*)(OWS + WS_WIN) + (size_t)l * NP * D, MROWS, NP, D, D}; pg8::StaticOrder S; S.init(MROWS, NP, G, (int)blockIdx.x);
            pg8::EpiBf16<0> E{(bf16*)(OWS + WS_P), NP, nullptr, 0, 0, 1.f}; pg8::gemm_phase<pg8::EpiBf16<0>, pg8::StaticOrder, true, true>(lds, g, S, E); }
        SEAM();
        REP(8) if (RUN()) { FRESH(); ph_lora(p, l, gw, NGW, lane); }
        SEAM();
        REP(1) if (RUN()) { FRESH(); ph_scan1(p, l, gw, NGW, lane); }
        SEAM();
        REP(2) if (RUN()) { FRESH(); ph_scan2(p, lds, l, wave, lane); }
        SEAM();
        REP(64) if (RUN()) { FRESH(); ph_readout2(p, l, gw, NGW, lane); }
        SEAM();
         if (RUN()) {
            { pg8::Gemm g{(const bf16*)(OWS + WS_MIXIN), (const bf16*)(OWS + WS_WOUT) + (size_t)l * D * D, NLAT, D, D, D}; pg8::StaticOrder S; S.init(NLAT, D, G, (int)blockIdx.x);
              pg8::EpiBf16<0> E{(bf16*)(OWS + WS_MIXO), D, nullptr, 0, 0, 1.f}; pg8::gemm_phase<pg8::EpiBf16<0>, pg8::StaticOrder, true, true>(lds, g, S, E); }
            { pg8::Gemm g{(const bf16*)(OWS + WS_MIXIN), (const bf16*)(OWS + WS_WOUT) + (size_t)l * D * D, NCTX, D, D / 4, D}; pg8::SplitOrder S{NCTX / 256, D / 256, 4, G, (int)blockIdx.x, NLAT / 256, 0, 0, 0, 0, 0, 0, 0, 0};
              pg8::EpiPart E{(float*)(OWS + WS_MIXP), D, (size_t)NCTX * D, NLAT / 256}; pg8::gemm_phase<pg8::EpiPart, pg8::SplitOrder, true, true>(lds, g, S, E); }
        }
        SEAM();
        if (RUN()) { FRESH(); ph_ln(p, lds, l, 0, tid, wave, gw, NGW, lane); }
        SEAM();
        if ((l & 1) == 0) {
            const int fi = l >> 1;
             if (RUN()) { pg8::Gemm g{(const bf16*)(OWS + WS_H8), (const bf16*)(OWS + WS_F13) + (size_t)fi * DFF * D, MROWS, 2 * DFF, D / 2, D / 2}; pg8::StaticOrder S; S.init(MROWS, 2 * DFF, G, (int)blockIdx.x);
                constexpr int NOE = 0x7fffffff; pg8::EpiSwiGLU8 E{(bf16*)(OWS + WS_ACT), DFF, nullptr, (const float*)(OWS + WS_SA), (const unsigned*)(OWS + WS_AMAX) + (size_t)fi * 2 * DFF, NOE, NOE, NOE, NOE, NOE, NOE, NOE};
#if PROBE_DUP & 128
                E.dbg = (int*)(OWS + WS_F);
#endif
                pg8::gemm_phase<pg8::EpiSwiGLU8, pg8::StaticOrder, true, true, true>(lds, g, S, E); }
            SEAM();
#if PROBE_DUP & 128
            if (ll == 0) { if (RUN()) { FRESH(); ph_check_up(p, gw, lane); } SEAM(); }
#endif
             if (RUN()) {
                { pg8::Gemm g{(const bf16*)(OWS + WS_ACT), (const bf16*)(OWS + WS_F2) + (size_t)fi * D * DFF, NLAT, D, DFF, DFF}; pg8::StaticOrder S; S.init(NLAT, D, G, (int)blockIdx.x);
                  pg8::EpiBf16<0> E{(bf16*)(OWS + WS_F), D, nullptr, 0, 0, 1.f}; pg8::gemm_phase<pg8::EpiBf16<0>, pg8::StaticOrder, true, true>(lds, g, S, E); }
                { pg8::Gemm g{(const bf16*)(OWS + WS_ACT), (const bf16*)(OWS + WS_F2) + (size_t)fi * D * DFF, NCTX, D, DFF / 7, DFF}; pg8::SplitOrder S{NCTX / 256, D / 256, 7, G, (int)blockIdx.x, NLAT / 256, 0, 0, 0, 0, 0, 0, 0, 0};
                  pg8::EpiPart E{(float*)(OWS + WS_FP), D, (size_t)NCTX * D, NLAT / 256}; pg8::gemm_phase<pg8::EpiPart, pg8::SplitOrder, true, true>(lds, g, S, E); }
            }
            SEAM();
        } else {
            REP(4) if (RUN()) { FRESH(); cq_static(p, lds, (l == 1 ? CQ_J1 : CQ_END0) + 2 * CQ_SLOT_ITEMS, l == 1 ? CQ_END0 : CQ_END1, gw, NGW, wave, lane); }
            SEAM();
            if (RUN()) { FRESH(); ph_moe_gather(p, l, gw, NGW, lane); }
            SEAM();
            {   const unsigned* gcnt = (const unsigned*)(OWS + WS_CTL) + CW_GCNT + 64 * (l >> 1); int pbp[9]; pbp[0] = 0;
#pragma unroll
                for (int e = 0; e < 8; ++e) pbp[e + 1] = pbp[e] + (int)((gcnt[e] + 255u) >> 8);
                const int mrows = pbp[8] * 256;
                 if (RUN()) { pg8::Gemm g{(const bf16*)(OWS + WS_HG), (const bf16*)(OWS + WS_MOEW13), mrows, 2 * DFF, D / 2, D / 2}; pg8::MoeOrder S; S.init(mrows, 2 * DFF, G, (int)blockIdx.x);
                    S.pb1 = pbp[1]; S.pb2 = pbp[2]; S.pb3 = pbp[3]; S.pb4 = pbp[4]; S.pb5 = pbp[5]; S.pb6 = pbp[6]; S.pb7 = pbp[7]; S.estride = (size_t)DFF * D;
                    pg8::EpiSwiGLU8 E{(bf16*)(OWS + WS_ACT), DFF, (const float*)(OWS + WS_WSORT), (const float*)(OWS + WS_SAG), (const unsigned*)(OWS + WS_AMAX) + (size_t)(2 + 8 * (l >> 1)) * 2 * DFF, pbp[1], pbp[2], pbp[3], pbp[4], pbp[5], pbp[6], pbp[7]};
                    pg8::gemm_phase<pg8::EpiSwiGLU8, pg8::MoeOrder, true, true, true>(lds, g, S, E); }
                SEAM();
                 if (RUN()) {
                    { pg8::Gemm g{(const bf16*)(OWS + WS_ACT), (const bf16*)(OWS + WS_MOEW2), MOE_MAIN_PANELS * 256, D, DFF, DFF}; pg8::MoeOrder S; S.init(MOE_MAIN_PANELS * 256, D, G, (int)blockIdx.x);
                      S.pb1 = pbp[1]; S.pb2 = pbp[2]; S.pb3 = pbp[3]; S.pb4 = pbp[4]; S.pb5 = pbp[5]; S.pb6 = pbp[6]; S.pb7 = pbp[7]; S.estride = (size_t)D * DFF;
                      pg8::EpiBf16<0> E{(bf16*)(OWS + WS_F), D, nullptr, 0, 0, 1.f}; pg8::gemm_phase<pg8::EpiBf16<0>, pg8::MoeOrder, true, true>(lds, g, S, E); }
                    { const int nT = pbp[8] - MOE_MAIN_PANELS;
                      pg8::Gemm g{(const bf16*)(OWS + WS_ACT), (const bf16*)(OWS + WS_MOEW2), nT * 256, D, DFF / 4, DFF}; pg8::SplitOrder S{nT, D / 256, 4, G, (int)blockIdx.x, MOE_MAIN_PANELS, pbp[1], pbp[2], pbp[3], pbp[4], pbp[5], pbp[6], pbp[7], (size_t)D * DFF};
                      pg8::EpiPart E{(float*)(OWS + WS_FP), D, (size_t)MOE_TAIL_ROWS * D, MOE_MAIN_PANELS}; pg8::gemm_phase<pg8::EpiPart, pg8::SplitOrder, true, true>(lds, g, S, E); }
                }
                SEAM();
            }
        }
        if (RUN()) { FRESH(); ph_ln(p, lds, l, 1, tid, wave, gw, NGW, lane); }
        SEAM();
    }
#undef l
#undef RUN
#undef SEAM
}

#ifndef MK_PER_PHASE
#define MK_PER_PHASE 0
#endif
extern "C" void kernel_launch(void* const* d_in, const int* in_sizes, int n_in, void* d_out, int out_size, void* d_ws, size_t ws_size, hipStream_t stream) {
    static int grid = 0;
    if (grid == 0) {
        if (n_in != N_IN || in_sizes[0] != NLAT * D || out_size != NLAT * D || ws_size < WS_NEED) { fprintf(stderr, "kernel_launch: unexpected shapes / workspace (%d inputs, ws %zu, need %zu)\n", n_in, ws_size, (size_t)WS_NEED); grid = -1; return; }
        int dev = 0, cus = 0, per_cu = 0;
        if (hipGetDevice(&dev) != hipSuccess || hipDeviceGetAttribute(&cus, hipDeviceAttributeMultiprocessorCount, dev) != hipSuccess) { grid = -1; return; }
        if (hipFuncSetAttribute((const void*)fwd_kernel, hipFuncAttributeMaxDynamicSharedMemorySize, LDS_BYTES) != hipSuccess) { fprintf(stderr, "kernel_launch: hipFuncSetAttribute failed\n"); grid = -1; return; }
        if (hipOccupancyMaxActiveBlocksPerMultiprocessor(&per_cu, (const void*)fwd_kernel, NWAVES * 64, LDS_BYTES) != hipSuccess || per_cu < 1) fprintf(stderr, "kernel_launch: occupancy query says %d\n", per_cu);
        (void)hipGetLastError();
        grid = cus;
        if (grid != 256) { fprintf(stderr, "kernel_launch: built for a 256-CU device, found %d CUs\n", cus); grid = -1; return; }
    }
    if (grid < 0) return;
    if (hipMemsetAsync((char*)d_ws + WS_CTL, 0, CTL_BYTES, stream) != hipSuccess) return;
    KP p{};
    for (int i = 0; i < N_IN; ++i) p.in[i] = (const float*)d_in[i];
    p.out = (float*)d_out; p.ws = (unsigned char*)d_ws; p.pad = 0;
#if MK_PER_PHASE
    const int nph = 2 + 2 * 11 + 2 * 13;
    for (int ph = 0; ph < nph; ++ph) { p.ph = ph; hipLaunchKernelGGL(fwd_kernel, dim3(grid), dim3(NWAVES * 64), LDS_BYTES, stream, p); }
#else
    p.ph = -1;
    hipLaunchKernelGGL(fwd_kernel, dim3(grid), dim3(NWAVES * 64), LDS_BYTES, stream, p);
#endif
}
```

```cpp
#include <hip/hip_runtime.h>
#define PROBE_DUP 0
#define CQ_SLOT_WGS 0
#define CQ_SLOT_ITEMS 3500
#include <cstdio>
#include <cstdint>
namespace pg8 {
#define PG8_LAS __attribute__((address_space(3)))
typedef unsigned short bf16_t;
typedef short bf16x8 __attribute__((ext_vector_type(8)));
typedef float f32x4 __attribute__((ext_vector_type(4)));
typedef unsigned u32x4 __attribute__((ext_vector_type(4)));
constexpr int BM = 256, BK = 64, HALF = 128, HTB = HALF * BK * 2  , STAGE_BYTES = 8 * HTB, NXCD = 8, WGM = 8;

__host__ __device__ __forceinline__ int lds_byte(int r, int c) { const int st = (r >> 4) * 2 + (c >> 5), rr = r & 15, cc = c & 31, ob = rr * 64 + cc * 2; return st * 1024 + (ob ^ (((ob >> 9) & 1) << 5)); }
__host__ __device__ __forceinline__ void stage_rc(int b, int& R, int& C) { const int st = b / 1024, sb = b % 1024, swz = sb ^ (((sb >> 9) & 1) << 5); R = (st >> 1) * 16 + swz / 64; C = (st & 1) * 32 + (swz % 64) / 2; }
__host__ __device__ __forceinline__ int perm32(int rho) { const int n = rho >> 4, i = rho & 15; return 8 * (i >> 2) + 4 * n + (i & 3); }

struct Unit { int pm, pn, ks; };
struct Gemm { const bf16_t* A; const bf16_t* Bt; int M, N, K, ld; };

struct StaticOrder {
    int nM, nN, nwg, G, c;
    __host__ __device__ void init(int M, int N, int G_, int c_) { nM = M / BM; nN = N / BM; nwg = nM * nN; G = G_; c = c_; }
    __host__ __device__ bool next(int i, Unit& u) const {
        const long L = (long)i * G + c; if (L >= nwg) return false;
        int wgid = (int)L; { const int q = nwg / NXCD, r = nwg % NXCD, xcd = wgid % NXCD, off = wgid / NXCD; wgid = (xcd < r ? xcd * (q + 1) : r * (q + 1) + (xcd - r) * q) + off; }
        const int nig = WGM * nN, gid = wgid / nig, fm = gid * WGM, gsz = (nM - fm) < WGM ? (nM - fm) : WGM;
        u.pm = fm + ((wgid % nig) % gsz); u.pn = (wgid % nig) / gsz; u.ks = 0; return true;
    }
    __device__ __forceinline__ const char* abase(const Gemm& g, const Unit& u, size_t tstep) const { return (const char*)g.A + (size_t)u.pm * tstep; }
    __device__ __forceinline__ const char* bbase(const Gemm& g, const Unit& u, size_t tstep) const { return (const char*)g.Bt + (size_t)u.pn * tstep; }
    __device__ __forceinline__ void a_ready(const Unit&) const {}
    __device__ __forceinline__ void done(const Unit&) const {}
};

__device__ __forceinline__ unsigned cvt_pk_bf16(float lo, float hi) { unsigned r; asm volatile("v_cvt_pk_bf16_f32 %0, %1, %2" : "=v"(r) : "v"(lo), "v"(hi)); return r; }
typedef float f32x2 __attribute__((ext_vector_type(2)));
__device__ __forceinline__ f32x2 gelu_pk(f32x2 v) {
    const f32x2 av = __builtin_elementwise_abs(v), d = av * 0.2316418882f + 1.0f;
    f32x2 t; t.x = __builtin_amdgcn_rcpf(d.x); t.y = __builtin_amdgcn_rcpf(d.y);
    f32x2 q = t * 0.5307027145f + (-0.7265760135f); q = q * t + 0.7107068705f; q = q * t + (-0.142248368f); q = q * t + 0.127414796f; q = q * t;
    const f32x2 s = (v * v) * (-0.72134752044f);
    f32x2 e; e.x = __builtin_amdgcn_exp2f(s.x); e.y = __builtin_amdgcn_exp2f(s.y);
    const f32x2 m = v * (q * e), r = v - m;
    f32x2 o; o.x = v.x < 0.f ? m.x : r.x; o.y = v.y < 0.f ? m.y : r.y; return o;
}

template <int ACT  > struct EpiBf16 {
    static constexpr bool PERM = true, AFTER_DRAIN = false; static_assert(ACT == 0 || ACT == 1, "EpiBf16: ACT is 0 (none) or 1 (gelu_pk)");
    bf16_t* O; int ldc; const float* bias; int split_cols; size_t split_stride; float scale0;
    __device__ __forceinline__ void operator()(const f32x4 (&acc)[2][2][4][2], const Unit& u, int wr, int wc, int fr, int fq) const {
        asm volatile("" : "+v"(fr), "+v"(fq));
        const int row0 = u.pm * BM + wr * 64 + fr; int colt = u.pn * BM; bf16_t* base = O;
        float sc = 1.f; if (split_cols) { const int t = colt / split_cols; base += (size_t)t * split_stride; colt -= t * split_cols; if (t == 0) sc = scale0; }
        const int col0 = colt + wc * 32 + 8 * fq, bcol0 = u.pn * BM + wc * 32 + 8 * fq;
        f32x4 bv[2][2];
#pragma unroll
        for (int bj = 0; bj < 2; ++bj)
#pragma unroll
            for (int n = 0; n < 2; ++n) bv[bj][n] = bias ? *(const f32x4*)(bias + bcol0 + bj * HALF + 4 * n) : (f32x4){0.f, 0.f, 0.f, 0.f};
#pragma unroll
        for (int ai = 0; ai < 2; ++ai)
#pragma unroll
            for (int m = 0; m < 4; ++m) { bf16_t* rowp = base + (size_t)(row0 + ai * HALF + m * 16) * ldc + col0;
#pragma unroll
                for (int bj = 0; bj < 2; ++bj) { f32x4 v0 = acc[ai][bj][m][0] + bv[bj][0], v1 = acc[ai][bj][m][1] + bv[bj][1];
                    if (ACT == 1) { f32x2 a = gelu_pk((f32x2){v0[0], v0[1]}), b = gelu_pk((f32x2){v0[2], v0[3]}), c = gelu_pk((f32x2){v1[0], v1[1]}), d = gelu_pk((f32x2){v1[2], v1[3]});
                        v0 = (f32x4){a.x, a.y, b.x, b.y}; v1 = (f32x4){c.x, c.y, d.x, d.y}; }
                    v0 = v0 * sc; v1 = v1 * sc; u32x4 w; w.x = cvt_pk_bf16(v0[0], v0[1]); w.y = cvt_pk_bf16(v0[2], v0[3]); w.z = cvt_pk_bf16(v1[0], v1[1]); w.w = cvt_pk_bf16(v1[2], v1[3]);
                    *(u32x4*)(rowp + bj * HALF) = w; } }
    }
};
typedef int i32x4 __attribute__((ext_vector_type(4)));
template <bool I8> __device__ __forceinline__ f32x4 mma16(bf16x8 b, bf16x8 a, f32x4 c) { return __builtin_amdgcn_mfma_f32_16x16x32_bf16(b, a, c, 0, 0, 0); }
template <bool I8> __device__ __forceinline__ i32x4 mma16(bf16x8 b, bf16x8 a, i32x4 c) { return __builtin_amdgcn_mfma_i32_16x16x64_i8(__builtin_bit_cast(i32x4, b), __builtin_bit_cast(i32x4, a), c, 0, 0, 0); }
struct EpiF32 {
    static constexpr bool PERM = false, AFTER_DRAIN = false;
    float* C; int ldc; int accum;
    __device__ __forceinline__ void operator()(const f32x4 (&acc)[2][2][4][2], const Unit& u, int wr, int wc, int fr, int fq) const {
        asm volatile("" : "+v"(fr), "+v"(fq));
        const int row0 = u.pm * BM + wr * 64 + fr, col0 = u.pn * BM + wc * 32 + 4 * fq;
#pragma unroll
        for (int ai = 0; ai < 2; ++ai)
#pragma unroll
            for (int m = 0; m < 4; ++m) { float* rowp = C + (size_t)(row0 + ai * HALF + m * 16) * ldc + col0;
#pragma unroll
                for (int bj = 0; bj < 2; ++bj)
#pragma unroll
                    for (int n = 0; n < 2; ++n) { f32x4 v = acc[ai][bj][m][n]; if (accum) v += *(const f32x4*)(rowp + bj * HALF + n * 16); *(f32x4*)(rowp + bj * HALF + n * 16) = v; } }
    }
};
struct EpiSwiGLU {
    static constexpr bool PERM = true, AFTER_DRAIN = false;
    bf16_t* O; int ldo; const float* rowscale; int rs_stride;
    __device__ __forceinline__ void operator()(const f32x4 (&acc)[2][2][4][2], const Unit& u, int wr, int wc, int fr, int fq) const {
        asm volatile("" : "+v"(fr), "+v"(fq));
        typedef unsigned u32x2v __attribute__((ext_vector_type(2)));
        const int row0 = u.pm * BM + wr * 64 + fr; const int ch0 = (u.pn * BM + wc * 32 + 8 * fq) >> 1;
#pragma unroll
        for (int ai = 0; ai < 2; ++ai)
#pragma unroll
            for (int m = 0; m < 4; ++m) { const int row = row0 + ai * HALF + m * 16; bf16_t* rowp = O + (size_t)row * ldo + ch0;
                const float rs = rowscale ? rowscale[(size_t)row * rs_stride] : 1.f;
#pragma unroll
                for (int bj = 0; bj < 2; ++bj) { const f32x4 a = acc[ai][bj][m][0], b = acc[ai][bj][m][1]; f32x4 o;
#pragma unroll
                    for (int i = 0; i < 4; ++i) o[i] = a[i] * __builtin_amdgcn_rcpf(1.f + __expf(-a[i])) * b[i] * rs;
                    u32x2v w; w.x = cvt_pk_bf16(o[0], o[1]); w.y = cvt_pk_bf16(o[2], o[3]);
                    *(u32x2v*)(rowp + bj * (HALF / 2)) = w; } }
    }
};

struct MoeOrder : StaticOrder {
    int pb1, pb2, pb3, pb4, pb5, pb6, pb7; size_t estride;
    __device__ __forceinline__ const char* bbase(const Gemm& g, const Unit& u, size_t tstep) const {
        const int e = (u.pm >= pb1) + (u.pm >= pb2) + (u.pm >= pb3) + (u.pm >= pb4) + (u.pm >= pb5) + (u.pm >= pb6) + (u.pm >= pb7);
        return (const char*)(g.Bt + (size_t)e * estride) + (size_t)u.pn * tstep; }
};
struct SplitOrder {
    int nM, nN, S, G, c, pm0; int pb1, pb2, pb3, pb4, pb5, pb6, pb7; size_t estride;
    __device__ __forceinline__ bool next(int i, Unit& u) const { const int L = i * G + c; if (L >= nM * nN * S) return false; u.ks = L % S; const int t = L / S; u.pn = t % nN; u.pm = pm0 + t / nN; return true; }
    __device__ __forceinline__ const char* abase(const Gemm& g, const Unit& u, size_t tstep) const { return (const char*)g.A + (size_t)u.pm * tstep + (size_t)u.ks * g.K * 2; }
    __device__ __forceinline__ const char* bbase(const Gemm& g, const Unit& u, size_t tstep) const {
        const int e = estride ? (u.pm >= pb1) + (u.pm >= pb2) + (u.pm >= pb3) + (u.pm >= pb4) + (u.pm >= pb5) + (u.pm >= pb6) + (u.pm >= pb7) : 0;
        return (const char*)(g.Bt + (size_t)e * estride) + (size_t)u.pn * tstep + (size_t)u.ks * g.K * 2; }
    __device__ __forceinline__ void a_ready(const Unit&) const {}
    __device__ __forceinline__ void done(const Unit&) const {}
};
struct EpiPart {
    static constexpr bool PERM = false, AFTER_DRAIN = false;
    float* C; int ldc; size_t pstride; int pm0;
    __device__ __forceinline__ void operator()(const f32x4 (&acc)[2][2][4][2], const Unit& u, int wr, int wc, int fr, int fq) const {
        asm volatile("" : "+v"(fr), "+v"(fq));
        const int row0 = (u.pm - pm0) * BM + wr * 64 + fr, col0 = u.pn * BM + wc * 32 + 4 * fq; float* base = C + (size_t)u.ks * pstride;
#pragma unroll
        for (int ai = 0; ai < 2; ++ai)
#pragma unroll
            for (int m = 0; m < 4; ++m) { float* rowp = base + (size_t)(row0 + ai * HALF + m * 16) * ldc + col0;
#pragma unroll
                for (int bj = 0; bj < 2; ++bj)
#pragma unroll
                    for (int n = 0; n < 2; ++n) *(f32x4*)(rowp + bj * HALF + n * 16) = acc[ai][bj][m][n]; }
    }
};

struct EpiSwiGLU8 {
    static constexpr bool PERM = true, AFTER_DRAIN = false;
    bf16_t* O; int ldo; const float* rowscale; const float* sa; const unsigned* amax; int pb1, pb2, pb3, pb4, pb5, pb6, pb7;
    __device__ __forceinline__ void operator()(const i32x4 (&acc)[2][2][4][2], const Unit& u, int wr, int wc, int fr, int fq) const {
        typedef unsigned u32x2v __attribute__((ext_vector_type(2))); typedef unsigned u32x4v __attribute__((ext_vector_type(4)));
        asm volatile("" : "+v"(fr), "+v"(fq));
        const int row0 = u.pm * BM + wr * 64 + fr; const int cb0 = u.pn * BM + wc * 32 + 8 * fq; const int ch0 = cb0 >> 1;
        const int e = (u.pm >= pb1) + (u.pm >= pb2) + (u.pm >= pb3) + (u.pm >= pb4) + (u.pm >= pb5) + (u.pm >= pb6) + (u.pm >= pb7);
        const unsigned* am = amax + (size_t)e * 2 * 3584 + cb0;
#pragma unroll
        for (int bj = 0; bj < 2; ++bj) {
            const float* amf = (const float*)am + bj * HALF;
            const f32x4 sb0 = *(const f32x4*)amf * (1.f / 127.f), sb1 = *(const f32x4*)(amf + 4) * (1.f / 127.f);
#pragma unroll
            for (int ai = 0; ai < 2; ++ai)
#pragma unroll
                for (int m = 0; m < 4; ++m) { const int row = row0 + ai * HALF + m * 16; bf16_t* rowp = O + (size_t)row * ldo + ch0 + bj * (HALF / 2);
                    const float sr = sa[row], rs = rowscale ? rowscale[row] : 1.f; f32x4 o;
#pragma unroll
                    for (int i = 0; i < 4; ++i) { const float a = (float)acc[ai][bj][m][0][i] * sr * sb0[i], b = (float)acc[ai][bj][m][1][i] * sr * sb1[i];
                        o[i] = a * __builtin_amdgcn_rcpf(1.f + __expf(-a)) * b * rs; }
                    u32x2v w; w.x = cvt_pk_bf16(o[0], o[1]); w.y = cvt_pk_bf16(o[2], o[3]);
                    *(u32x2v*)rowp = w;
#if PROBE_DUP & 128
                    if (dbg && row < 4096) { f32x4 av, bv;
#pragma unroll
                        for (int i = 0; i < 4; ++i) { av[i] = (float)acc[ai][bj][m][0][i] * sr * sb0[i]; bv[i] = (float)acc[ai][bj][m][1][i] * sr * sb1[i]; }
                        *(f32x4*)((float*)dbg + (size_t)row * ldo + (rowp - (O + (size_t)row * ldo))) = av; *(f32x4*)((float*)dbg + (size_t)4096 * ldo + (size_t)row * ldo + (rowp - (O + (size_t)row * ldo))) = bv; }
#endif
                    } }
    }
#if PROBE_DUP & 128
    int* dbg = nullptr;
#endif
};

struct EpiBf16S8 {
    static constexpr bool PERM = true, AFTER_DRAIN = false;
    bf16_t* O; int ldc; const float* sa; const float* amax;
    __device__ __forceinline__ void operator()(const i32x4 (&acc)[2][2][4][2], const Unit& u, int wr, int wc, int fr, int fq) const {
        asm volatile("" : "+v"(fr), "+v"(fq));
        const int row0 = u.pm * BM + wr * 64 + fr, col0 = u.pn * BM + wc * 32 + 8 * fq;
#pragma unroll
        for (int bj = 0; bj < 2; ++bj) { const f32x4 s0 = *(const f32x4*)(amax + col0 + bj * HALF) * (1.f / 127.f), s1 = *(const f32x4*)(amax + col0 + bj * HALF + 4) * (1.f / 127.f);
#pragma unroll
            for (int ai = 0; ai < 2; ++ai)
#pragma unroll
                for (int m = 0; m < 4; ++m) { const int row = row0 + ai * HALF + m * 16; const float sr = sa[row]; f32x4 v0, v1;
#pragma unroll
                    for (int i = 0; i < 4; ++i) { v0[i] = (float)acc[ai][bj][m][0][i] * sr * s0[i]; v1[i] = (float)acc[ai][bj][m][1][i] * sr * s1[i]; }
                    u32x4 w; w.x = cvt_pk_bf16(v0[0], v0[1]); w.y = cvt_pk_bf16(v0[2], v0[3]); w.z = cvt_pk_bf16(v1[0], v1[1]); w.w = cvt_pk_bf16(v1[2], v1[3]);
                    *(u32x4*)(O + (size_t)row * ldc + col0 + bj * HALF) = w; } }
    }
};
struct EpiPartS8 {
    static constexpr bool PERM = false, AFTER_DRAIN = false;
    float* C; int ldc; size_t pstride; int pm0; const float* sa; const float* amax;
    __device__ __forceinline__ void operator()(const i32x4 (&acc)[2][2][4][2], const Unit& u, int wr, int wc, int fr, int fq) const {
        asm volatile("" : "+v"(fr), "+v"(fq));
        const int row0 = (u.pm - pm0) * BM + wr * 64 + fr, col0 = u.pn * BM + wc * 32 + 4 * fq; float* base = C + (size_t)u.ks * pstride;
#pragma unroll
        for (int bj = 0; bj < 2; ++bj)
#pragma unroll
            for (int n = 0; n < 2; ++n) { const f32x4 sc = *(const f32x4*)(amax + col0 + bj * HALF + n * 16) * (1.f / 127.f);
#pragma unroll
                for (int ai = 0; ai < 2; ++ai)
#pragma unroll
                    for (int m = 0; m < 4; ++m) { const int rl = row0 + ai * HALF + m * 16; const float sr = sa[rl + pm0 * BM]; f32x4 v;
#pragma unroll
                        for (int i = 0; i < 4; ++i) v[i] = (float)acc[ai][bj][m][n][i] * sr * sc[i];
                        *(f32x4*)(base + (size_t)rl * ldc + col0 + bj * HALF + n * 16) = v; } }
    }
};
template <bool I8> struct AccSel { typedef f32x4 type; }; template <> struct AccSel<true> { typedef i32x4 type; };
template <class Epi, class Sched, bool ALIGN_EPI = false, bool SP2 = false, bool I8 = false>
__device__ __forceinline__ void gemm_phase(PG8_LAS unsigned char* lds, const Gemm g, const Sched& S, const Epi& E) {
    int tid_o = threadIdx.x; asm volatile("" : "+v"(tid_o));
    const int tid = tid_o, wid = __builtin_amdgcn_readfirstlane(tid >> 6), lane = tid & 63, wr = wid >> 2, wc = wid & 3, fr = lane & 15, fq = lane >> 4;
    const int K = g.K, nt = K / BK;
    unsigned voffA[2], voffB[2];
#pragma unroll
    for (int i = 0; i < 2; ++i) { int R, C; stage_rc(tid * 16 + i * 8192, R, C); const int Rb = Epi::PERM ? ((R & ~31) + perm32(R & 31)) : R;
        voffA[i] = (unsigned)(R * g.ld + C) * 2u; voffB[i] = (unsigned)(Rb * g.ld + C) * 2u; }
    const size_t kstep = (size_t)(BK * 2);
    const size_t hstep = (size_t)HALF * g.ld * 2;
    const size_t tstep = 2 * hstep;
    const unsigned ldsw = (unsigned)wid * 1024u;
    const int aoff = lds_byte(wr * 64 + fr, fq * 8), boff = lds_byte(wc * 32 + fr, fq * 8);
#define PG8_SA(b, h) (((b) * 2 + (h)) * HTB)
#define PG8_SB(b, h) ((4 + (b) * 2 + (h)) * HTB)
#define PG8_STAGE(bufoff, gbase, voff) do { _Pragma("unroll") for (int _i = 0; _i < 2; ++_i) \
        __builtin_amdgcn_global_load_lds((const unsigned*)((const char*)(gbase) + (voff)[_i]), (PG8_LAS unsigned*)(lds + (bufoff) + ldsw + _i * 8192), 16, 0, 0); } while (0)
#define PG8_LDA(dst, b, h) do { _Pragma("unroll") for (int m = 0; m < 4; ++m) _Pragma("unroll") for (int k = 0; k < 2; ++k) dst[m][k] = *(const PG8_LAS bf16x8*)(lds + PG8_SA(b, h) + aoff + m * 2048 + k * 1024); } while (0)
#define PG8_LDB(dst, b, h) do { _Pragma("unroll") for (int n = 0; n < 2; ++n) _Pragma("unroll") for (int k = 0; k < 2; ++k) dst[n][k] = *(const PG8_LAS bf16x8*)(lds + PG8_SB(b, h) + boff + n * 2048 + k * 1024); } while (0)
#define PG8_MMA(ai, bj, At, Bt) do { __builtin_amdgcn_s_setprio(1); _Pragma("unroll") for (int k = 0; k < 2; ++k) _Pragma("unroll") for (int m = 0; m < 4; ++m) _Pragma("unroll") for (int n = 0; n < 2; ++n) \
        acc[ai][bj][m][n] = mma16<I8>(Bt[n][k], At[m][k], acc[ai][bj][m][n]); __builtin_amdgcn_s_setprio(0); } while (0)
#define PG8_WAIT_V(n) asm volatile("s_waitcnt vmcnt(" #n ")" ::: "memory")
#define PG8_WAIT_L(n) asm volatile("s_waitcnt lgkmcnt(" #n ")" ::: "memory")
#define PG8_BAR __builtin_amdgcn_s_barrier()
#define PG8_SCHED __builtin_amdgcn_sched_barrier(0)
    Unit cur, nxt; int ui = 0;
    if (!S.next(0, cur)) return;
    typedef typename AccSel<I8>::type AccT; AccT acc[2][2][4][2];
#pragma unroll
    for (int a = 0; a < 2; ++a)
#pragma unroll
        for (int b = 0; b < 2; ++b)
#pragma unroll
            for (int m = 0; m < 4; ++m)
#pragma unroll
                for (int n = 0; n < 2; ++n) acc[a][b][m][n] = (AccT)(0);
    bf16x8 At[4][2], B0[2][2], B1[2][2];
    const char* cA = S.abase(g, cur, tstep); const char* cB = S.bbase(g, cur, tstep);
    S.a_ready(cur);
    if constexpr (SP2) {
        PG8_STAGE(PG8_SB(0, 0), cB, voffB); PG8_STAGE(PG8_SB(0, 1), cB + hstep, voffB); PG8_STAGE(PG8_SA(0, 0), cA, voffA); PG8_STAGE(PG8_SA(0, 1), cA + hstep, voffA);
        if (wr == 1) PG8_BAR;
        PG8_WAIT_V(2); PG8_BAR;
        PG8_STAGE(PG8_SB(1, 0), cB + kstep, voffB); PG8_STAGE(PG8_SA(1, 0), cA + kstep, voffA); PG8_STAGE(PG8_SB(1, 1), cB + hstep + kstep, voffB);
        PG8_WAIT_V(6); PG8_BAR;
    } else {
        PG8_STAGE(PG8_SB(0, 0), cB, voffB); PG8_STAGE(PG8_SA(0, 0), cA, voffA); PG8_STAGE(PG8_SB(0, 1), cB + hstep, voffB); PG8_STAGE(PG8_SA(0, 1), cA + hstep, voffA);
        if (wr == 1) PG8_BAR;
        PG8_WAIT_V(4); PG8_BAR;
        PG8_STAGE(PG8_SB(1, 0), cB + kstep, voffB); PG8_STAGE(PG8_SA(1, 0), cA + kstep, voffA); PG8_STAGE(PG8_SB(1, 1), cB + hstep + kstep, voffB);
        PG8_WAIT_V(6); PG8_BAR;
    }
    for (;;) {
        const bool has_next = S.next(ui + 1, nxt);
        const char* nA = has_next ? S.abase(g, nxt, tstep) : cA; const char* nB = has_next ? S.bbase(g, nxt, tstep) : cB;
        for (int t = 0; t < nt; t += 2) {
            const bool last = (t == nt - 2);
            const char* a1 = cA + (size_t)(t + 1) * kstep;
            const char* a2 = last ? nA : cA + (size_t)(t + 2) * kstep; const char* b2 = last ? nB : cB + (size_t)(t + 2) * kstep;
            const char* a3 = a2 + kstep; const char* b3 = b2 + kstep;
            if (last && has_next) S.a_ready(nxt);
            if constexpr (SP2) {
            PG8_LDB(B0, 0, 0); PG8_LDB(B1, 0, 1); PG8_SCHED; PG8_LDA(At, 0, 0); PG8_STAGE(PG8_SA(1, 1), a1 + hstep, voffA);
            PG8_WAIT_V(8); PG8_WAIT_L(0); PG8_BAR; PG8_MMA(0, 0, At, B0); PG8_MMA(0, 1, At, B1); PG8_BAR; PG8_SCHED;
            PG8_LDA(At, 0, 1); PG8_STAGE(PG8_SB(0, 0), b2, voffB); PG8_STAGE(PG8_SB(0, 1), b2 + hstep, voffB); PG8_STAGE(PG8_SA(0, 0), a2, voffA);
            PG8_WAIT_V(8); PG8_WAIT_L(0); PG8_BAR; PG8_MMA(1, 0, At, B0); PG8_MMA(1, 1, At, B1); PG8_BAR; PG8_SCHED;
            PG8_LDB(B0, 1, 0); PG8_LDB(B1, 1, 1); PG8_SCHED; PG8_LDA(At, 1, 0); PG8_STAGE(PG8_SA(0, 1), a2 + hstep, voffA);
            PG8_WAIT_V(8); PG8_WAIT_L(0); PG8_BAR; PG8_MMA(0, 0, At, B0); PG8_MMA(0, 1, At, B1); PG8_BAR; PG8_SCHED;
            PG8_LDA(At, 1, 1); PG8_STAGE(PG8_SB(1, 0), b3, voffB); PG8_STAGE(PG8_SB(1, 1), b3 + hstep, voffB); PG8_STAGE(PG8_SA(1, 0), a3, voffA);
            PG8_WAIT_V(8); PG8_WAIT_L(0); PG8_BAR; PG8_MMA(1, 0, At, B0); PG8_MMA(1, 1, At, B1); PG8_BAR; PG8_SCHED;
            } else {
            PG8_LDB(B0, 0, 0); PG8_SCHED; PG8_LDA(At, 0, 0); PG8_STAGE(PG8_SA(1, 1), a1 + hstep, voffA);
            PG8_WAIT_L(8); PG8_BAR; PG8_WAIT_L(0); PG8_MMA(0, 0, At, B0); PG8_BAR; PG8_SCHED;
            PG8_LDB(B1, 0, 1); PG8_STAGE(PG8_SB(0, 0), b2, voffB);
            PG8_BAR; PG8_WAIT_L(0); PG8_MMA(0, 1, At, B1); PG8_BAR;
            PG8_LDA(At, 0, 1); PG8_STAGE(PG8_SA(0, 0), a2, voffA);
            PG8_BAR; PG8_WAIT_L(0); PG8_MMA(1, 0, At, B0); PG8_BAR; PG8_SCHED;
            PG8_STAGE(PG8_SB(0, 1), b2 + hstep, voffB);
            PG8_WAIT_V(6); PG8_BAR; PG8_MMA(1, 1, At, B1); PG8_BAR;
            PG8_LDB(B0, 1, 0); PG8_SCHED; PG8_LDA(At, 1, 0); PG8_STAGE(PG8_SA(0, 1), a2 + hstep, voffA);
            PG8_WAIT_L(8); PG8_BAR; PG8_WAIT_L(0); PG8_MMA(0, 0, At, B0); PG8_BAR; PG8_SCHED;
            PG8_LDB(B1, 1, 1); PG8_STAGE(PG8_SB(1, 0), b3, voffB);
            PG8_BAR; PG8_WAIT_L(0); PG8_MMA(0, 1, At, B1); PG8_BAR;
            PG8_LDA(At, 1, 1); PG8_STAGE(PG8_SA(1, 0), a3, voffA);
            PG8_BAR; PG8_WAIT_L(0); PG8_MMA(1, 0, At, B0); PG8_BAR; PG8_SCHED;
            PG8_STAGE(PG8_SB(1, 1), b3 + hstep, voffB);
            PG8_WAIT_V(6); PG8_BAR; PG8_MMA(1, 1, At, B1); PG8_BAR;
            }
        }
        if constexpr (ALIGN_EPI) { if (wr == 0) PG8_BAR; }
        if constexpr (!Epi::AFTER_DRAIN) { E(acc, cur, wr, wc, fr, fq); S.done(cur); }
        if (!has_next) break;
#pragma unroll
        for (int a = 0; a < 2; ++a)
#pragma unroll
            for (int b = 0; b < 2; ++b)
#pragma unroll
                for (int m = 0; m < 4; ++m)
#pragma unroll
                    for (int n = 0; n < 2; ++n) acc[a][b][m][n] = (AccT)(0);
        cur = nxt; cA = nA; cB = nB; ++ui;
        if constexpr (ALIGN_EPI) { if (wr == 1) PG8_BAR; }
    }
    PG8_WAIT_V(0);
    if constexpr (!ALIGN_EPI) { if (wr == 0) PG8_BAR; }
    PG8_BAR;
    if constexpr (Epi::AFTER_DRAIN) { E.fused(acc, cur, wr, wc, fr, fq, lds, wid, lane); S.done(cur); }
#undef PG8_SA
#undef PG8_SB
#undef PG8_STAGE
#undef PG8_LDA
#undef PG8_LDB
#undef PG8_MMA
#undef PG8_WAIT_V
#undef PG8_WAIT_L
#undef PG8_BAR
#undef PG8_SCHED
}
}

constexpr int NWAVES = 8;
constexpr int D = 1024, NB = 4, SEQ = 4096, CTXL = 256, NLAT = NB * SEQ, NCTX = NB * CTXL, MROWS = NLAT + NCTX;
constexpr int DEPTH = 4, RW = 512, NH = 8, HS = 64, DFF = 3584, NE = 8, NPROJ = 3456, NP = 3584, NLO = 2560, KLA = 512, NMOD = 6144;
constexpr int PC_R = 0, PC_K = 512, PC_V = 1024, PC_CB = 1536, PC_CC = 2048, PC_CH = 2560, PC_WD = 3072, PC_AD = 3200, PC_GD = 3328;
constexpr float LN_EPS = 1e-5f, GN_EPS = 64e-5f, DN_ALPHA = 1.681792830507429f;
enum { I_X = 0, I_C, I_CTX, I_CCTX, I_WMOD, I_BMOD, I_WIN, I_W0, I_W2, I_A0, I_A2, I_KK, I_KA, I_RK, I_G2, I_LNXG, I_LNXB, I_CONVW, I_WOUT, I_LN1G, I_LN1B, I_LN2G, I_LN2B,
       I_FW1, I_FW3, I_FW2, I_RTW, I_RTB, I_MW1, I_MW3, I_MW2, N_IN };

constexpr size_t MiB = 1u << 20;
constexpr size_t WS_CTL = 0, CTL_BYTES = 3 * MiB;
constexpr size_t WS_MODV = 1 * MiB;
constexpr size_t WS_AMAX = 2 * MiB;
constexpr size_t WS_RKS = 3 * MiB;
constexpr size_t WS_WIN = 4 * MiB;
constexpr size_t WS_WOUT = WS_WIN + 28 * MiB;
constexpr size_t WS_LORA = WS_WOUT + 8 * MiB;
constexpr size_t WS_F13 = WS_LORA + 10 * MiB;
constexpr size_t WS_F2 = WS_F13 + 28 * MiB;
constexpr size_t WS_X = WS_F2 + 14 * MiB;
constexpr size_t WS_H = WS_X + 68 * MiB;
constexpr size_t WS_MOES = WS_H + 34 * MiB;
constexpr size_t WS_ROWLIST = WS_MOES;
constexpr size_t WS_TOKSEL = WS_MOES + 640 * 1024;
constexpr size_t WS_WSEL = WS_TOKSEL + 320 * 1024;
constexpr size_t WS_WSORT = WS_WSEL + 192 * 1024;
constexpr size_t WS_MOEW13 = WS_MOES + 2 * MiB;
constexpr size_t WS_MOEW2 = WS_MOEW13 + 112 * MiB;
constexpr size_t WS_H8 = WS_MOEW13 + 56 * MiB;
constexpr size_t WS_SA = WS_H8 + 17 * MiB;
constexpr size_t WS_SAM = WS_SA + 512 * 1024;
constexpr size_t WS_SAG = WS_SA + 1 * MiB;
constexpr size_t WS_SCR = WS_MOEW2 + 56 * MiB;
constexpr size_t WS_P = WS_SCR;
constexpr size_t WS_LO = WS_P + 119 * MiB;
constexpr size_t WS_PREP = WS_LO + 170 * MiB;
constexpr size_t WS_Y = WS_PREP + 213 * MiB;
constexpr size_t WS_MIXIN = WS_Y + 68 * MiB;
constexpr size_t WS_CH = WS_PREP;
constexpr size_t WS_MIXO = WS_PREP;
constexpr size_t WS_MIXP = WS_PREP + 34 * MiB;
constexpr size_t WS_END_MIXER = WS_MIXIN + 34 * MiB;
constexpr size_t WS_HG = WS_SCR;
constexpr size_t WS_ACT = WS_HG + 72 * MiB;
constexpr size_t WS_F = WS_ACT + 252 * MiB;
constexpr size_t WS_FP = WS_F + 72 * MiB;
constexpr size_t WS_END_FFN = WS_FP + 64 * MiB;
constexpr size_t WS_NEED = WS_END_MIXER > WS_END_FFN ? WS_END_MIXER : WS_END_FFN;
static_assert((size_t)MROWS * NP * 2 <= 119 * MiB && (size_t)MROWS * NLO * 4 <= 170 * MiB && (size_t)8704 * 25600 <= 213 * MiB && (size_t)MROWS * D * 4 <= 68 * MiB && WS_NEED <= 990 * MiB, "ws map");
constexpr int MOE_MAIN_PANELS = 128, MOE_TAIL_ROWS = 4096;
constexpr int MOE_ROWS = 36864;
constexpr int AM_IN = 18 * 2 * DFF, AM_OUT = AM_IN + DEPTH * NP;
constexpr int LORAW_PER_LAYER = 4 * 512 * 64 + 512 * 128;
constexpr int CW_BAR = 4096, CW_GCNT = 8192, CW_CQ = 12288, CW_SDONE = 12544;

constexpr int RING_BYTES = 131072, LDSCTL_OFF = RING_BYTES, MISC_OFF = LDSCTL_OFF + 320, LDS_BYTES = 147456;

typedef unsigned short bf16;
typedef unsigned v4u __attribute__((ext_vector_type(4)));
typedef unsigned v2u __attribute__((ext_vector_type(2)));
typedef float f32x4 __attribute__((ext_vector_type(4)));
#define LAS __attribute__((address_space(3)))
#define LDS_WAIT() asm volatile("s_waitcnt lgkmcnt(0)" ::: "memory")
__device__ __forceinline__ unsigned f2bf(float f) { unsigned u = __builtin_bit_cast(unsigned, f); return (u + 0x7fffu + ((u >> 16) & 1u)) >> 16; }
__device__ __forceinline__ unsigned pk2(float lo, float hi) { return f2bf(lo) | (f2bf(hi) << 16); }
__device__ __forceinline__ float bf2f(unsigned short b) { return __builtin_bit_cast(float, ((unsigned)b) << 16); }
__device__ __forceinline__ float bflo(unsigned w) { return __builtin_bit_cast(float, w << 16); }
__device__ __forceinline__ float bfhi(unsigned w) { return __builtin_bit_cast(float, w & 0xffff0000u); }
__device__ __forceinline__ float wave_sum(float v) {
#pragma unroll
    for (int o = 1; o < 64; o <<= 1) v += __shfl_xor(v, o);
    return v;
}
__device__ __forceinline__ float sigm(float x) { return 1.f / (1.f + __expf(-x)); }

#define XB_TMO      128
#define XB_XCNT(j)  (256  + 64 * (j))
#define XB_XSUB(j)  (1280 + 64 * (j))
#define XB_XGEN(j)  (2304 + 64 * (j))
#define XB_TOP      3328
#define XB_TOPGEN   3392
#define XCD_BAR_WORDS 3456
#define XB_SPIN_CAP (1u << 18)

__device__ __forceinline__ unsigned xb_ld(unsigned* p)              { return __hip_atomic_load(p, __ATOMIC_RELAXED, __HIP_MEMORY_SCOPE_AGENT); }
__device__ __forceinline__ unsigned xb_add(unsigned* p, unsigned v) { return __hip_atomic_fetch_add(p, v, __ATOMIC_RELAXED, __HIP_MEMORY_SCOPE_AGENT); }
__device__ __forceinline__ unsigned xb_xcc_id() { return (unsigned)__builtin_amdgcn_s_getreg((3 << 11) | 20) & 0xFu; }
#define XB_SPIN(cond, bar) do { unsigned _sp = 0; while (cond) { __builtin_amdgcn_s_sleep(1); \
    if ((++_sp & 255u) == 0u) { if (xb_ld(&(bar)[XB_TMO])) break; if (_sp > XB_SPIN_CAP) { atomicAdd(&(bar)[XB_TMO], 1u); break; } } } } while (0)

struct XcdBarrier {
    unsigned* bar; unsigned x;
    volatile LAS unsigned* st;
};

__device__ __forceinline__ XcdBarrier xcd_barrier_post(unsigned* bar, volatile LAS unsigned* st) {
    XcdBarrier b; b.bar = bar; b.x = xb_xcc_id(); b.st = st;
    if (threadIdx.x == 0) (void)xb_add(&bar[XB_XCNT(b.x)], 1u);
    return b;
}
__device__ __forceinline__ void xcd_barrier_complete(unsigned* bar, unsigned x, unsigned& nloc, unsigned& nx) {
    const unsigned G = gridDim.x * gridDim.y * gridDim.z;
    unsigned sum, cnt, mine, sp = 0u;
    for (;;) {
        sum = 0u; cnt = 0u; mine = 0u;
#pragma unroll
        for (unsigned j = 0; j < 16; ++j) { const unsigned c = xb_ld(&bar[XB_XCNT(j)]); sum += c; cnt += (c > 0u) ? 1u : 0u; mine = (j == x) ? c : mine; }
        if (sum == G) break;
        __builtin_amdgcn_s_sleep(1);
        if ((++sp & 255u) == 0u) { if (xb_ld(&bar[XB_TMO])) break; if (sp > XB_SPIN_CAP) { atomicAdd(&bar[XB_TMO], 1u); break; } }
    }
    nloc = mine > 0u ? mine : 1u; nx = cnt > 0u ? cnt : 1u;
}

__device__ __forceinline__ void xcd_barrier(const XcdBarrier& b) {
    asm volatile("s_waitcnt vmcnt(0)" ::: "memory");
    __syncthreads();
    if (threadIdx.x == 0) {
        unsigned* bar = b.bar;
        __builtin_amdgcn_s_waitcnt(0);
        unsigned nloc = b.st[0], nx = b.st[1];
        if (nloc == 0u) { xcd_barrier_complete(bar, b.x, nloc, nx); b.st[0] = nloc; b.st[1] = nx; }
        const unsigned old = xb_add(&bar[XB_XSUB(b.x)], 1u);
        const unsigned gen = old / nloc;
        if (old + 1u == (gen + 1u) * nloc) {
            __builtin_amdgcn_fence(__ATOMIC_RELEASE, "agent");
            asm volatile("s_waitcnt vmcnt(0)" ::: "memory");
            const unsigned og = xb_add(&bar[XB_TOP], 1u);
            const unsigned tg = og / nx;
            if (og + 1u == (tg + 1u) * nx) xb_add(&bar[XB_TOPGEN], 1u);
            else XB_SPIN(xb_ld(&bar[XB_TOPGEN]) == tg, bar);
            __builtin_amdgcn_fence(__ATOMIC_ACQUIRE, "agent");
            xb_add(&bar[XB_XGEN(b.x)], 1u);
            asm volatile("s_waitcnt vmcnt(0)" ::: "memory");
        } else {
            XB_SPIN(xb_ld(&bar[XB_XGEN(b.x)]) == gen, bar);
            __builtin_amdgcn_fence(__ATOMIC_ACQUIRE, "agent");
            asm volatile("s_waitcnt vmcnt(0)" ::: "memory");
        }
    }
    __syncthreads();
}


__device__ __forceinline__ size_t opaque_zero() { size_t z = 0; asm volatile("" : "+s"(z)); return z; }
#define OWS (p.ws + opaque_zero())
__device__ __forceinline__ int opaque_zero_i() { int z = 0; asm volatile("" : "+s"(z)); return z; }
#define PIN(i) (p.in[(i) + opaque_zero_i()])
struct KP { const float* in[N_IN]; float* out; unsigned char* ws; int ph; int pad; };

template <int MODE> __device__ __forceinline__ int rowmap(int n, int arg) {
    if (MODE == 0) return n + arg;
    if (MODE == 1) { if (n < 1536) return n; if (n < 1664) return n - 1536 + PC_WD; if (n < 1792) return n - 1664 + PC_AD; if (n < 1920) return n - 1792 + PC_GD;
                     if (n < 2432) return n - 1920 + PC_CB; if (n < 2944) return n - 2432 + PC_CC; return n - 2944 + PC_CH; }
    return 8 * (n >> 2) + 4 * arg + (n & 3);
}
template <int MODE> __device__ __forceinline__ void transpose_item(const float* W, int K, int N, bf16* WT, int arg, LAS float* scr, int item, int lane) {
    const int nblk = N / 32, kb = item / nblk, nb = item % nblk, k0 = 64 * kb, n0 = 32 * nb;
#pragma unroll 8
    for (int i = 0; i < 32; ++i) { const int kk = 2 * i + (lane >> 5); scr[kk * 33 + (lane & 31)] = W[(size_t)(k0 + kk) * N + n0 + (lane & 31)]; }
    LDS_WAIT(); asm volatile("" ::: "memory");
    const int c = lane & 7;
#pragma unroll
    for (int j = 0; j < 4; ++j) { const int n = (lane >> 3) + 8 * j; const LAS float* s = scr + (8 * c) * 33 + n;
        v4u o; o.x = pk2(s[0 * 33], s[1 * 33]); o.y = pk2(s[2 * 33], s[3 * 33]); o.z = pk2(s[4 * 33], s[5 * 33]); o.w = pk2(s[6 * 33], s[7 * 33]);
        *(v4u*)(WT + (size_t)rowmap<MODE>(n0 + n, arg) * K + k0 + 8 * c) = o; }
    LDS_WAIT(); asm volatile("" ::: "memory");
}

__device__ __forceinline__ void ph_modvec(const KP& p, LAS unsigned char* lds, int tid) {
    LAS float* sil = (LAS float*)lds;
    LAS float* red = (LAS float*)(lds + 5 * 1024 * 4);
    const float* c = PIN(I_C); const float* cc = PIN(I_CCTX);
    for (int i = tid; i < 5 * 1024; i += 512) { const float v = i < 4096 ? c[i] : cc[i - 4096]; sil[i] = v / (1.f + __expf(-v)); }
    __syncthreads();
    float* modv = (float*)(OWS + WS_MODV);
    const int ks = tid >> 6, col = tid & 63;
    for (int task = blockIdx.x; task < DEPTH * 96; task += gridDim.x) {
        const int l = task / 96, j0 = (task % 96) * 64;
        const float* w = PIN(I_WMOD) + (size_t)l * D * NMOD + (size_t)(ks * 128) * NMOD + j0 + col;
        float a0 = 0.f, a1 = 0.f, a2 = 0.f, a3 = 0.f, a4 = 0.f;
#pragma unroll 8
        for (int k = 0; k < 128; ++k) { const float wv = w[(size_t)k * NMOD]; const int kk = ks * 128 + k;
            a0 += sil[kk] * wv; a1 += sil[1024 + kk] * wv; a2 += sil[2048 + kk] * wv; a3 += sil[3072 + kk] * wv; a4 += sil[4096 + kk] * wv; }
        red[(ks * 5 + 0) * 64 + col] = a0; red[(ks * 5 + 1) * 64 + col] = a1; red[(ks * 5 + 2) * 64 + col] = a2; red[(ks * 5 + 3) * 64 + col] = a3; red[(ks * 5 + 4) * 64 + col] = a4;
        __syncthreads();
        if (tid < 320) { const int r = tid >> 6; float s = 0.f;
#pragma unroll
            for (int q = 0; q < 8; ++q) s += red[(q * 5 + r) * 64 + col];
            modv[(size_t)(l * 5 + r) * NMOD + j0 + col] = s + PIN(I_BMOD)[l * NMOD + j0 + col]; }
        __syncthreads();
    }
}

__device__ __forceinline__ void ph_convert(const KP& p, LAS unsigned char* lds, int gw, int NGW, int wave, int lane) {
    LAS float* scr = (LAS float*)(lds + wave * 16384);
    bf16* win = (bf16*)(OWS + WS_WIN); bf16* f2 = (bf16*)(OWS + WS_F2); bf16* lora = (bf16*)(OWS + WS_LORA);
    constexpr int I_IN = (D / 64) * (NPROJ / 32), I_OUT = (D / 64) * (D / 32), I_UP = (D / 64) * (DFF / 32), I_DN = (DFF / 64) * (D / 32);
    for (int it = gw; it < I_DN; it += NGW) transpose_item<0>(PIN(I_FW2), DFF, D, f2, 0, scr, it, lane);
    { const int gt = gw * 64 + lane, NGT = NGW * 64; constexpr int PER = (NP - NPROJ) * D / 16;
      for (int i = gt; i < DEPTH * PER; i += NGT) { const int l = i / PER, q = i % PER; *(v4u*)((unsigned char*)win + (size_t)l * NP * D + (size_t)NPROJ * D + (size_t)q * 16) = (v4u){0u, 0u, 0u, 0u}; } }
    { const int gt = gw * 64 + lane, NGT = NGW * 64;
      for (int i = gt; i < DEPTH * LORAW_PER_LAYER / 8; i += NGT) { const int l = i / (LORAW_PER_LAYER / 8); int q = (i % (LORAW_PER_LAYER / 8)) * 8; float v[8];
          int grp, c, k0; if (q < 4 * 512 * 64) { grp = q / (512 * 64); q -= grp * 512 * 64; c = q / 64; k0 = q % 64; } else { grp = 4; q -= 4 * 512 * 64; c = q / 128; k0 = q % 128; }
#pragma unroll
          for (int j = 0; j < 8; ++j) { const int k = k0 + j;
              v[j] = grp < 2 ? PIN(I_W2)[((size_t)(l * 2 + grp) * 64 + k) * RW + c] : grp < 4 ? PIN(I_A2)[((size_t)(l * 2 + grp - 2) * 64 + k) * RW + c] : PIN(I_G2)[((size_t)l * 128 + k) * RW + c]; }
          v4u o; o.x = pk2(v[0], v[1]); o.y = pk2(v[2], v[3]); o.z = pk2(v[4], v[5]); o.w = pk2(v[6], v[7]);
          *(v4u*)(lora + (size_t)i * 8) = o; } }
}
__device__ __forceinline__ void ph_amax(const KP& p, int gw, int NGW, int lane) {
    unsigned* AM = (unsigned*)(OWS + WS_AMAX);
    for (int it = gw; it < 18 * 2 * (DFF / 64) * 4; it += NGW) { const int kq = it & 3, strip = (it >> 2) % (DFF / 64), sm = (it >> 2) / (DFF / 64), s1 = sm & 1, cm = sm >> 1;
        const float* W = cm < 2 ? PIN(s1 ? I_FW3 : I_FW1) + (size_t)cm * D * DFF : PIN(s1 ? I_MW3 : I_MW1) + (size_t)(cm - 2) * D * DFF;
        const int n = strip * 64 + lane; const float* src = W + (size_t)(kq * 256) * DFF + n; float m = 0.f;
#pragma unroll 16
        for (int k = 0; k < 256; ++k) m = fmaxf(m, fabsf(src[(size_t)k * DFF]));
        __hip_atomic_fetch_max(AM + (size_t)cm * 2 * DFF + 8 * (n >> 2) + 4 * s1 + (n & 3), __builtin_bit_cast(unsigned, m), __ATOMIC_RELAXED, __HIP_MEMORY_SCOPE_AGENT); }
    for (int it = gw; it < DEPTH * (NPROJ / 64 + D / 64) * 4; it += NGW) { const int kq = it & 3; int t = it >> 2; const int l = t / (NPROJ / 64 + D / 64); t -= l * (NPROJ / 64 + D / 64);
        const bool isin = t < NPROJ / 64; const int strip = isin ? t : t - NPROJ / 64, N = isin ? NPROJ : D, n = strip * 64 + lane;
        const float* src = (isin ? PIN(I_WIN) + (size_t)l * D * NPROJ : PIN(I_WOUT) + (size_t)l * D * D) + (size_t)(kq * 256) * N + n; float m = 0.f;
#pragma unroll 16
        for (int k = 0; k < 256; ++k) m = fmaxf(m, fabsf(src[(size_t)k * N]));
        __hip_atomic_fetch_max(AM + (isin ? AM_IN + l * NP + rowmap<1>(n, 0) : AM_OUT + l * D + n), __builtin_bit_cast(unsigned, m), __ATOMIC_RELAXED, __HIP_MEMORY_SCOPE_AGENT); }
}
__device__ __forceinline__ unsigned q8pack(float a, float b, float c, float d) {
    const int qa = __float2int_rn(a), qb = __float2int_rn(b), qc = __float2int_rn(c), qd = __float2int_rn(d);
    return (unsigned)(qa & 255) | ((unsigned)(qb & 255) << 8) | ((unsigned)(qc & 255) << 16) | ((unsigned)(qd & 255) << 24); }
constexpr int CQ_IN = (D / 64) * (NPROJ / 32), CQ_OUT = (D / 64) * (D / 32), CQ_UP = (D / 64) * (DFF / 32), CQ_DN = (DFF / 64) * (D / 32);
constexpr int CQ_NEG = CQ_IN + CQ_OUT + 2 * CQ_UP;
constexpr int CQ_J1 = 3 * CQ_IN + 3 * CQ_OUT + 2 * CQ_UP + CQ_DN, CQ_MOE = NE * (2 * CQ_UP + CQ_DN), CQ_END0 = CQ_J1 + CQ_MOE, CQ_END1 = CQ_END0 + CQ_MOE;
#ifndef CQ_SLOT_ITEMS
#define CQ_SLOT_ITEMS 12000
#endif
struct CqItem { const float* W; bf16* WT; int K, N, mode, arg, item; const unsigned* am; };
__device__ __forceinline__ CqItem cq_decode(const KP& p, int q) {
    CqItem c; bf16* win = (bf16*)(OWS + WS_WIN); bf16* wout = (bf16*)(OWS + WS_WOUT); bf16* f13 = (bf16*)(OWS + WS_F13); bf16* f2 = (bf16*)(OWS + WS_F2);
    bf16* m13 = (bf16*)(OWS + WS_MOEW13); bf16* m2 = (bf16*)(OWS + WS_MOEW2); const unsigned* AM = (const unsigned*)(OWS + WS_AMAX);
    if (q < 0) { q += CQ_NEG;
        if (q < CQ_IN) { c = CqItem{PIN(I_WIN), win, D, NPROJ, 3, 0, q, AM + AM_IN}; return c; } q -= CQ_IN;
        if (q < CQ_OUT) { c = CqItem{PIN(I_WOUT), wout, D, D, 4, 0, q, AM + AM_OUT}; return c; } q -= CQ_OUT;
        if (q < CQ_UP) { c = CqItem{PIN(I_FW1), f13, D, DFF, 2, 0, q, AM}; return c; } q -= CQ_UP;
        c = CqItem{PIN(I_FW3), f13, D, DFF, 2, 1, q, AM}; return c; }
    if (q < 3 * CQ_IN) { const int l = 1 + q / CQ_IN; c = CqItem{PIN(I_WIN) + (size_t)l * D * NPROJ, win + (size_t)l * (NP * D / 2), D, NPROJ, 3, 0, q % CQ_IN, AM + AM_IN + l * NP}; return c; } q -= 3 * CQ_IN;
    if (q < 3 * CQ_OUT) { const int l = 1 + q / CQ_OUT; c = CqItem{PIN(I_WOUT) + (size_t)l * D * D, wout + (size_t)l * (D * D / 2), D, D, 4, 0, q % CQ_OUT, AM + AM_OUT + l * D}; return c; } q -= 3 * CQ_OUT;
    if (q < CQ_UP) { c = CqItem{PIN(I_FW1) + (size_t)D * DFF, f13 + (size_t)DFF * D, D, DFF, 2, 0, q, AM + 2 * DFF}; return c; } q -= CQ_UP;
    if (q < CQ_UP) { c = CqItem{PIN(I_FW3) + (size_t)D * DFF, f13 + (size_t)DFF * D, D, DFF, 2, 1, q, AM + 2 * DFF}; return c; } q -= CQ_UP;
    if (q < CQ_DN) { c = CqItem{PIN(I_FW2) + (size_t)DFF * D, f2 + (size_t)D * DFF, DFF, D, 0, 0, q, nullptr}; return c; } q -= CQ_DN;
    const int mi = q / CQ_MOE; q -= mi * CQ_MOE;
    if (q < NE * CQ_UP) { const int e = q / CQ_UP; c = CqItem{PIN(I_MW1) + ((size_t)mi * NE + e) * D * DFF, m13 + (size_t)e * DFF * D, D, DFF, 2, 0, q % CQ_UP, AM + (size_t)(2 + 8 * mi + e) * 2 * DFF}; return c; } q -= NE * CQ_UP;
    if (q < NE * CQ_UP) { const int e = q / CQ_UP; c = CqItem{PIN(I_MW3) + ((size_t)mi * NE + e) * D * DFF, m13 + (size_t)e * DFF * D, D, DFF, 2, 1, q % CQ_UP, AM + (size_t)(2 + 8 * mi + e) * 2 * DFF}; return c; } q -= NE * CQ_UP;
    { const int e = q / CQ_DN; c = CqItem{PIN(I_MW2) + ((size_t)mi * NE + e) * DFF * D, m2 + (size_t)e * D * DFF, DFF, D, 0, 0, q % CQ_DN, nullptr}; return c; }
}
__device__ __forceinline__ void cq_load(const CqItem& c, int lane, float (&r)[32]) {
    const int nblk = c.N / 32, kb = c.item / nblk, nb = c.item % nblk; const float* src = c.W + (size_t)(64 * kb + (lane >> 5)) * c.N + 32 * nb + (lane & 31);
#pragma unroll
    for (int i = 0; i < 32; ++i) r[i] = src[(size_t)(2 * i) * c.N];
}
__device__ __forceinline__ void cq_store(const CqItem& c, int lane, const float (&r)[32], LAS float* scr) {
    const int nblk = c.N / 32, kb = c.item / nblk, nb = c.item % nblk, k0 = 64 * kb, n0 = 32 * nb;
#pragma unroll
    for (int i = 0; i < 32; ++i) scr[(2 * i + (lane >> 5)) * 33 + (lane & 31)] = r[i];
    LDS_WAIT(); asm volatile("" ::: "memory");
    if (c.mode >= 2) {
        const int n = lane >> 1, hf = lane & 1, nn = n0 + n, j = c.mode == 2 ? 8 * (nn >> 2) + 4 * c.arg + (nn & 3) : c.mode == 3 ? rowmap<1>(nn, 0) : nn;
        const float inv = 127.f / fmaxf(__builtin_bit_cast(float, c.am[j]), 1e-30f); const LAS float* sp = scr + (32 * hf) * 33 + n; unsigned w[8];
#pragma unroll
        for (int q = 0; q < 8; ++q) w[q] = q8pack(sp[(4 * q + 0) * 33] * inv, sp[(4 * q + 1) * 33] * inv, sp[(4 * q + 2) * 33] * inv, sp[(4 * q + 3) * 33] * inv);
        unsigned char* dst = (unsigned char*)c.WT + (size_t)j * c.K + k0 + 32 * hf;
        *(v4u*)dst = (v4u){w[0], w[1], w[2], w[3]}; *(v4u*)(dst + 16) = (v4u){w[4], w[5], w[6], w[7]};
    } else {
    const int cc = lane & 7;
#pragma unroll
    for (int j = 0; j < 4; ++j) { const int n = (lane >> 3) + 8 * j; const LAS float* sp = scr + (8 * cc) * 33 + n;
        v4u o; o.x = pk2(sp[0 * 33], sp[1 * 33]); o.y = pk2(sp[2 * 33], sp[3 * 33]); o.z = pk2(sp[4 * 33], sp[5 * 33]); o.w = pk2(sp[6 * 33], sp[7 * 33]);
        const int nn = n0 + n;
        *(v4u*)(c.WT + (size_t)nn * c.K + k0 + 8 * cc) = o; }
    }
    LDS_WAIT(); asm volatile("" ::: "memory");
}
constexpr int CQ_B = 4;
__device__ __forceinline__ int cq_grab(unsigned* heads, int nseg, int& cnt, int lane) {
    int q = -1, n = 0;
    if (lane == 0) { for (int sg = 0; sg < nseg && q < 0; ++sg) { const int size = sg == 0 ? CQ_J1 : CQ_MOE, base = sg == 0 ? 0 : sg == 1 ? CQ_J1 : CQ_END0; unsigned* hd = heads + 64 * sg;
            if ((int)__hip_atomic_load(hd, __ATOMIC_RELAXED, __HIP_MEMORY_SCOPE_AGENT) < size) { const int t = (int)__hip_atomic_fetch_add(hd, (unsigned)CQ_B, __ATOMIC_RELAXED, __HIP_MEMORY_SCOPE_AGENT);
                if (t < size) { q = base + t; n = size - t < CQ_B ? size - t : CQ_B; } } } }
    cnt = __builtin_amdgcn_readfirstlane(n); return __builtin_amdgcn_readfirstlane(q);
}
__device__ __forceinline__ void cq_run(const KP& p, LAS unsigned char* lds, int nseg, const unsigned* stop, unsigned stopval, int wave, int lane) {
    unsigned* heads = (unsigned*)(OWS + WS_CTL) + CW_CQ; LAS float* scr = (LAS float*)(lds + wave * 16384);
    for (;;) {
        if (stop) { unsigned sv = 0u; if (lane == 0) sv = __hip_atomic_load(stop, __ATOMIC_RELAXED, __HIP_MEMORY_SCOPE_AGENT); if ((unsigned)__builtin_amdgcn_readfirstlane((int)sv) >= stopval) break; }
        int cnt; const int q0 = cq_grab(heads, nseg, cnt, lane); if (q0 < 0) break;
        CqItem cur = cq_decode(p, q0); float ra[32]; cq_load(cur, lane, ra);
        for (int j = 0; j < cnt; ++j) { CqItem nxt = cur; float rb[32];
            if (j + 1 < cnt) { nxt = cq_decode(p, q0 + j + 1); cq_load(nxt, lane, rb); }
            cq_store(cur, lane, ra, scr);
            if (j + 1 < cnt) { cur = nxt;
#pragma unroll
                for (int i = 0; i < 32; ++i) ra[i] = rb[i]; } }
    }
}

__device__ __forceinline__ void cq_static(const KP& p, LAS unsigned char* lds, int q0, int q1, int gw, int NGW, int wave, int lane) {
    LAS float* scr = (LAS float*)(lds + wave * 16384);
    int q = q0 + gw; if (q >= q1) return;
    CqItem cur = cq_decode(p, q); float ra[32]; cq_load(cur, lane, ra);
    for (;;) { const int qn = q + NGW; CqItem nxt = cur; float rb[32];
        if (qn < q1) { nxt = cq_decode(p, qn); cq_load(nxt, lane, rb); }
        cq_store(cur, lane, ra, scr);
        if (qn >= q1) break;
        cur = nxt; q = qn;
#pragma unroll
        for (int i = 0; i < 32; ++i) ra[i] = rb[i]; }
}

__device__ __forceinline__ void ld_row(const float* r, int lane, f32x4 (&v)[4]) { const f32x4* q = (const f32x4*)r + lane;
#pragma unroll
    for (int j = 0; j < 4; ++j) v[j] = q[64 * j]; }
__device__ __forceinline__ void st_row(float* r, int lane, const f32x4 (&v)[4]) { f32x4* q = (f32x4*)r + lane;
#pragma unroll
    for (int j = 0; j < 4; ++j) q[64 * j] = v[j]; }
__device__ __forceinline__ void st_row_bf16(bf16* r, int lane, const f32x4 (&v)[4]) { v2u* q = (v2u*)r + lane;
#pragma unroll
    for (int j = 0; j < 4; ++j) { v2u w; w.x = pk2(v[j][0], v[j][1]); w.y = pk2(v[j][2], v[j][3]); q[64 * j] = w; } }
__device__ __forceinline__ void ld_row_bf16(const bf16* r, int lane, f32x4 (&v)[4]) { const v2u* q = (const v2u*)r + lane;
#pragma unroll
    for (int j = 0; j < 4; ++j) { const v2u w = q[64 * j]; v[j] = (f32x4){bflo(w.x), bfhi(w.x), bflo(w.y), bfhi(w.y)}; } }
template <int S> __device__ __forceinline__ void ld_row_parts(const float* r, size_t pstride, int lane, f32x4 (&v)[4]) {
    ld_row(r, lane, v);
#pragma unroll
    for (int s = 1; s < S; ++s) { f32x4 t[4]; ld_row(r + (size_t)s * pstride, lane, t);
#pragma unroll
        for (int j = 0; j < 4; ++j) v[j] += t[j]; } }
__device__ __forceinline__ int mod_row(int row) { return row < NLAT ? (row >> 12) : 4; }

__device__ __forceinline__ void st_row_q8(unsigned char* dst8, float* scale, int row, int lane, const f32x4 (&v)[4]) {
    float am = 0.f;
#pragma unroll
    for (int j = 0; j < 4; ++j) am = fmaxf(fmaxf(am, fmaxf(fabsf(v[j][0]), fabsf(v[j][1]))), fmaxf(fabsf(v[j][2]), fabsf(v[j][3])));
#pragma unroll
    for (int o = 1; o < 64; o <<= 1) am = fmaxf(am, __shfl_xor(am, o));
    am = fmaxf(am, 1e-30f); const float inv = 127.f / am; unsigned* h8 = (unsigned*)dst8 + (size_t)row * (D / 4) + lane;
#pragma unroll
    for (int j = 0; j < 4; ++j) h8[64 * j] = q8pack(v[j][0] * inv, v[j][1] * inv, v[j][2] * inv, v[j][3] * inv);
    if (lane == 0) scale[row] = am * (1.f / 127.f);
}
__device__ __forceinline__ void ph_init_rows(const KP& p, int gw, int NGW, int lane) {
    const float* modv = (const float*)(OWS + WS_MODV); float* X = (float*)(OWS + WS_X); bf16* H = (bf16*)(OWS + WS_H);
    for (int row = gw; row < MROWS; row += NGW) {
        const float* src = row < NLAT ? PIN(I_X) + (size_t)row * D : PIN(I_CTX) + (size_t)(row - NLAT) * D;
        const float* mv = modv + (size_t)(0 * 5 + mod_row(row)) * NMOD;
        f32x4 x[4], sh[4], sc[4], h[4]; ld_row(src, lane, x); ld_row(mv, lane, sh); ld_row(mv + 1024, lane, sc);
#pragma unroll
        for (int j = 0; j < 4; ++j) h[j] = x[j] * (1.f + sc[j]) + sh[j];
        st_row(X + (size_t)row * D, lane, x); st_row_q8(OWS + WS_H8, (float*)(OWS + WS_SA), row, lane, h);
    }
}

__device__ __forceinline__ int scan_row(int b, int dir, int step) { return step < CTXL ? NLAT + b * CTXL + (dir ? CTXL - 1 - step : step) : b * SEQ + (dir ? SEQ - 1 - (step - CTXL) : step - CTXL); }
typedef short sbf16x8 __attribute__((ext_vector_type(8)));
typedef float f32x16 __attribute__((ext_vector_type(16)));
constexpr int SC_C = 32, SC_NCH = (CTXL + SEQ) / SC_C  , SC_NCHAIN = NB * NH * 2  , SC_NTASK = SC_NCH * SC_NCHAIN  ;
constexpr int CH_G = 0, CH_Q = 8192, CH_UT = 12288, CH_YL = 20480, CH_EC = 24576, CH_BYTES = 25600, CH_NLOAD = 26;

__device__ __forceinline__ f32x16 mm(v4u a, v4u b, f32x16 c) { return __builtin_amdgcn_mfma_f32_32x32x16_bf16(__builtin_bit_cast(sbf16x8, a), __builtin_bit_cast(sbf16x8, b), c, 0, 0, 0); }
typedef float f32x2c __attribute__((ext_vector_type(2))); typedef __bf16 bf16x2c __attribute__((ext_vector_type(2)));
__device__ __forceinline__ unsigned cvtpk(float lo, float hi) { return __builtin_bit_cast(unsigned, __builtin_convertvector((f32x2c){lo, hi}, bf16x2c)); }
template <int S, int NEG> __device__ __forceinline__ v4u cvtf(const f32x16& x) {
    v4u w; const float sg = NEG ? -1.f : 1.f;
    w.x = cvtpk(sg * x[8 * S + 0], sg * x[8 * S + 1]); w.y = cvtpk(sg * x[8 * S + 2], sg * x[8 * S + 3]); w.z = cvtpk(sg * x[8 * S + 4], sg * x[8 * S + 5]); w.w = cvtpk(sg * x[8 * S + 6], sg * x[8 * S + 7]); return w; }
template <int MODE  > __device__ __forceinline__ f32x16 mask_acc(f32x16 x, int n, int hh) {
#pragma unroll
    for (int r = 0; r < 16; ++r) { const int m = (r & 3) + 8 * (r >> 2) + 4 * hh; const bool keep = MODE == 0 ? (m > n) : MODE == 1 ? (m < n) : (m <= n); x[r] = keep ? x[r] : 0.f; }
    return x; }
__device__ __forceinline__ f32x16 zero16() { f32x16 z;
#pragma unroll
    for (int r = 0; r < 16; ++r) z[r] = 0.f;
    return z; }
__device__ __forceinline__ void cm_build(const unsigned (&w)[16], v4u (&f)[2][2]) {
#pragma unroll
    for (int s = 0; s < 2; ++s) {
        const auto r0 = __builtin_amdgcn_permlane32_swap(w[8 * s + 0], w[8 * s + 2], false, false), r1 = __builtin_amdgcn_permlane32_swap(w[8 * s + 1], w[8 * s + 3], false, false);
        const auto r2 = __builtin_amdgcn_permlane32_swap(w[8 * s + 4], w[8 * s + 6], false, false), r3 = __builtin_amdgcn_permlane32_swap(w[8 * s + 5], w[8 * s + 7], false, false);
        f[0][s] = (v4u){r0[0], r1[0], r2[0], r3[0]}; f[1][s] = (v4u){r0[1], r1[1], r2[1], r3[1]}; }
}
__device__ __forceinline__ void st16(unsigned char* base, int off, int lane, v4u v) { *(v4u*)(base + off + lane * 16) = v; }

__device__ __forceinline__ void ph_scan1(const KP& p, int l, int gw, int NGW, int lane) {
    const bf16* P = (const bf16*)(OWS + WS_P); const bf16* LO = (const bf16*)(OWS + WS_LO); const float* NRM = (const float*)(OWS + WS_RKS); unsigned char* CH = OWS + WS_CH;
    const int n = lane & 31, hh = lane >> 5;
    v4u Id[2];
#pragma unroll
    for (int s = 0; s < 2; ++s) { unsigned wd[4];
#pragma unroll
        for (int q = 0; q < 4; ++q) { const int j0 = 2 * q, j1 = 2 * q + 1; const int t0 = 16 * s + 8 * (j0 >> 2) + 4 * hh + (j0 & 3), t1 = 16 * s + 8 * (j1 >> 2) + 4 * hh + (j1 & 3);
            wd[q] = (t0 == n ? 0x3F80u : 0u) | (t1 == n ? 0x3F800000u : 0u); }
        Id[s] = (v4u){wd[0], wd[1], wd[2], wd[3]}; }
    for (int task = gw; task < SC_NTASK; task += NGW) {
        const int dir = task & 1, h = (task >> 1) & 7, b = (task >> 4) & 3, ci = task >> 6;
        const int row0 = scan_row(b, dir, SC_C * ci), sgn = dir ? -1 : 1, c = h * 64 + lane;
        const float w0c = PIN(I_W0)[(l * 2 + dir) * RW + c], a0c = PIN(I_A0)[(l * 2 + dir) * RW + c], kkc = PIN(I_KK)[l * RW + c], kac = PIN(I_KA)[l * RW + c];
        unsigned wAl[16], wBe[16], wKa[16], wRh[16], wV[16], wBp[16], wKp[16];
        float cs = 0.f, Eprev = 1.f;
#pragma unroll
        for (int hb = 0; hb < 2; ++hb) {
            unsigned rk_[16], rr_[16], rv_[16], rw_[16], ra_[16]; float rn_[16];
#pragma unroll
            for (int i = 0; i < 16; ++i) { const int row = row0 + sgn * (16 * hb + i); const bf16* pr = P + (size_t)row * NP; const bf16* lo = LO + (size_t)row * NLO;
                rk_[i] = pr[PC_K + c]; rr_[i] = pr[PC_R + c]; rv_[i] = pr[PC_V + c]; rw_[i] = lo[dir * RW + c]; ra_[i] = lo[1024 + dir * RW + c]; rn_[i] = NRM[row * 8 + h]; }
#pragma unroll
            for (int i = 0; i < 16; ++i) asm volatile("" : "+v"(rk_[i]), "+v"(rr_[i]), "+v"(rv_[i]), "+v"(rw_[i]), "+v"(ra_[i]), "+v"(rn_[i]));
#pragma unroll
            for (int pq = 0; pq < 8; ++pq) { const int pz = 8 * hb + pq; float al[2], be[2], ka[2], rh[2], vv[2];
#pragma unroll
                for (int e = 0; e < 2; ++e) { const int i = 2 * pq + e;
                    const float kv = bf2f((unsigned short)rk_[i]), rv = bf2f((unsigned short)rr_[i]); vv[e] = bf2f((unsigned short)rv_[i]);
                    const float wl = w0c + bf2f((unsigned short)rw_[i]), aa = __builtin_amdgcn_rcpf(1.f + __expf(-(a0c + bf2f((unsigned short)ra_[i])))), nrm = rn_[i];
                    const float lw = -0.6065306597f * __builtin_amdgcn_rcpf(1.f + __expf(-wl));
                    cs += lw; const float E = __expf(cs), Ei = __builtin_amdgcn_rcpf(E);
                    const float kkn = kv * kkc * nrm, kd = kv * (1.f + (aa - 1.f) * kac);
                    al[e] = kkn * Eprev; be[e] = kkn * aa * Ei; ka[e] = kd * Ei; rh[e] = rv * E; Eprev = E; }
                wAl[pz] = cvtpk(al[0], al[1]); wBe[pz] = cvtpk(be[0], be[1]); wKa[pz] = cvtpk(ka[0], ka[1]); wRh[pz] = cvtpk(rh[0], rh[1]); wV[pz] = cvtpk(vv[0], vv[1]); }
        }
        const float EC = Eprev;
#pragma unroll
        for (int pz = 0; pz < 16; ++pz) { wBp[pz] = cvtpk(bflo(wBe[pz]) * EC, bfhi(wBe[pz]) * EC); wKp[pz] = cvtpk(bflo(wKa[pz]) * EC, bfhi(wKa[pz]) * EC); }
        unsigned char* img = CH + (size_t)(((b * 8 + h) * 2 + dir) * SC_NCH + ci) * CH_BYTES;
        ((float*)(img + CH_EC))[lane] = EC;
        v4u cAl[2][2], cV[2][2], cBp[2][2], cKp[2][2], cRh[2][2];
        v4u tAl[4], tBe[4], tKa[4], tRh[4];
        cm_build(wAl, cAl); cm_build(wV, cV); cm_build(wBp, cBp); cm_build(wKp, cKp); cm_build(wRh, cRh);
        {   v4u cBe[2][2], cKa[2][2]; cm_build(wBe, cBe); cm_build(wKa, cKa);
#define TRANSPOSE(cZ, tZ) do { _Pragma("unroll") for (int ct = 0; ct < 2; ++ct) { f32x16 T_ = mm(cZ[ct][0], Id[0], zero16()); T_ = mm(cZ[ct][1], Id[1], T_); tZ[2 * ct] = cvtf<0, 0>(T_); tZ[2 * ct + 1] = cvtf<1, 0>(T_); } } while (0)
            TRANSPOSE(cAl, tAl); TRANSPOSE(cBe, tBe); TRANSPOSE(cKa, tKa); TRANSPOSE(cRh, tRh);
#undef TRANSPOSE
        }
#define PROD4(A, B) mm(A[3], B[3], mm(A[2], B[2], mm(A[1], B[1], mm(A[0], B[0], zero16()))))
        f32x16 XN = mask_acc<0>(PROD4(tAl, tBe), n, hh), XT = mask_acc<1>(PROD4(tBe, tAl), n, hh);
        v4u fLM[2], fGB[2], fGK[2];
        { const f32x16 t = mask_acc<1>(PROD4(tKa, tAl), n, hh); fLM[0] = cvtf<0, 0>(t); fLM[1] = cvtf<1, 0>(t); }
        { const f32x16 t = mask_acc<2>(PROD4(tBe, tRh), n, hh); fGB[0] = cvtf<0, 0>(t); fGB[1] = cvtf<1, 0>(t); }
        { const f32x16 t = mask_acc<2>(PROD4(tKa, tRh), n, hh); fGK[0] = cvtf<0, 0>(t); fGK[1] = cvtf<1, 0>(t); }
#undef PROD4
#pragma unroll
        for (int r = 0; r < 16; ++r) { XN[r] = -XN[r]; XT[r] = -XT[r]; }
        f32x16 RT = XT;
#pragma unroll
        for (int r = 0; r < 16; ++r) RT[r] += ((r & 3) + 8 * (r >> 2) + 4 * hh == n) ? 1.f : 0.f;
#pragma unroll
        for (int pw = 1; pw < 5; ++pw) {
            const v4u xn0 = cvtf<0, 0>(XN), xn1 = cvtf<1, 0>(XN), xt0 = cvtf<0, 0>(XT), xt1 = cvtf<1, 0>(XT);
            XN = mm(xt1, xn1, mm(xt0, xn0, zero16()));
            if (pw < 4) XT = mm(xn1, xt1, mm(xn0, xt0, zero16()));
            const v4u yn0 = cvtf<0, 0>(XN), yn1 = cvtf<1, 0>(XN), rt0 = cvtf<0, 0>(RT), rt1 = cvtf<1, 0>(RT);
            RT = mm(yn1, rt1, mm(yn0, rt0, RT));
        }
        const v4u fA0 = cvtf<0, 0>(RT), fA1 = cvtf<1, 0>(RT);
        f32x16 At[2], Vt[2];
#pragma unroll
        for (int t = 0; t < 2; ++t) {
            const f32x16 lmv = mm(fLM[1], cV[t][1], mm(fLM[0], cV[t][0], zero16()));
            At[t] = mm(fA1, cAl[t][1], mm(fA0, cAl[t][0], zero16()));
            Vt[t] = mm(fA1, cvtf<1, 0>(lmv), mm(fA0, cvtf<0, 0>(lmv), zero16()));
        }
#pragma unroll
        for (int kt1 = 0; kt1 < 2; ++kt1) { const v4u a0 = cvtf<0, 0>(At[kt1]), a1 = cvtf<1, 0>(At[kt1]);
#pragma unroll
            for (int kt2 = 0; kt2 < 2; ++kt2) { const f32x16 g = mm(a1, cBp[kt2][1], mm(a0, cBp[kt2][0], zero16()));
                st16(img, CH_G + ((kt2 * 2 + kt1) * 2 + 0) * 1024, lane, cvtf<0, 1>(g)); st16(img, CH_G + ((kt2 * 2 + kt1) * 2 + 1) * 1024, lane, cvtf<1, 1>(g)); } }
#pragma unroll
        for (int vt = 0; vt < 2; ++vt) { const v4u nv0 = cvtf<0, 1>(Vt[vt]), nv1 = cvtf<1, 1>(Vt[vt]);
#pragma unroll
            for (int kt = 0; kt < 2; ++kt) { f32x16 u = mm(cKp[kt][1], cV[vt][1], mm(cKp[kt][0], cV[vt][0], zero16())); u = mm(cBp[kt][1], nv1, mm(cBp[kt][0], nv0, u));
                st16(img, CH_UT + ((kt * 2 + vt) * 2 + 0) * 1024, lane, cvtf<0, 0>(u)); st16(img, CH_UT + ((kt * 2 + vt) * 2 + 1) * 1024, lane, cvtf<1, 0>(u)); }
            f32x16 y = mm(cV[vt][1], fGK[1], mm(cV[vt][0], fGK[0], zero16())); y = mm(nv1, fGB[1], mm(nv0, fGB[0], y));
            st16(img, CH_YL + (vt * 2 + 0) * 1024, lane, cvtf<0, 0>(y)); st16(img, CH_YL + (vt * 2 + 1) * 1024, lane, cvtf<1, 0>(y)); }
#pragma unroll
        for (int kt = 0; kt < 2; ++kt) { f32x16 q = mm(cRh[kt][1], Id[1], mm(cRh[kt][0], Id[0], zero16()));
            q = mm(cvtf<1, 1>(At[kt]), fGB[1], mm(cvtf<0, 1>(At[kt]), fGB[0], q));
            st16(img, CH_Q + (kt * 2 + 0) * 1024, lane, cvtf<0, 0>(q)); st16(img, CH_Q + (kt * 2 + 1) * 1024, lane, cvtf<1, 0>(q)); }
    }
}

__device__ __forceinline__ void ph_scan2(const KP& p, LAS unsigned char* lds, int l, int wave, int lane) {
    unsigned* sdone = (unsigned*)(OWS + WS_CTL) + CW_SDONE + 64 * l;
#ifndef CQ_SLOT_WGS
#define CQ_SLOT_WGS 128
#endif
    if (blockIdx.x >= SC_NCHAIN * 2) {
        const int q0 = (l < 2 ? CQ_J1 : CQ_END0) + (l & 1) * CQ_SLOT_ITEMS;
        cq_static(p, lds, q0, q0 + CQ_SLOT_ITEMS, ((int)blockIdx.x - SC_NCHAIN * 2) * NWAVES + wave, ((int)gridDim.x - SC_NCHAIN * 2) * NWAVES, wave, lane); return; }
    const int chain = blockIdx.x >> 1, vt = blockIdx.x & 1, dir = chain & 1, h = (chain >> 1) & 7, b = chain >> 4;
    const int n = lane & 31, hh = lane >> 5;
    const unsigned char* CH = OWS + WS_CH + (size_t)chain * SC_NCH * CH_BYTES; bf16* Y = (bf16*)(OWS + WS_Y) + (size_t)dir * MROWS * RW + h * 64 + 32 * vt + 4 * hh;
    constexpr int NPIECE = 19, SLOT = NPIECE * 1024, NSLOT = 6, PD = 4, XCH = NSLOT * SLOT;
    int psrc[3], pdst[3];
#pragma unroll
    for (int j = 0; j < 3; ++j) { int f = wave + 8 * j; if (f >= NPIECE) f -= NPIECE;
        pdst[j] = f;
        psrc[j] = f < 12 ? f * 1024 : f < 16 ? CH_UT + ((((f - 12) >> 1) * 2 + vt) * 2 + ((f - 12) & 1)) * 1024 : f < 18 ? CH_YL + (vt * 2 + (f - 16)) * 1024 : CH_EC; }
    const int lane_off[3] = {pdst[0] == 18 ? (lane * 16) & 255 : lane * 16, pdst[1] == 18 ? (lane * 16) & 255 : lane * 16, pdst[2] == 18 ? (lane * 16) & 255 : lane * 16};
#define SC2_ISSUE(ci_, slot_) do { const unsigned char* im_ = CH + (size_t)(ci_) * CH_BYTES; LAS unsigned char* sl_ = lds + (slot_) * SLOT; \
        _Pragma("unroll") for (int j = 0; j < 3; ++j) __builtin_amdgcn_global_load_lds((const unsigned*)(im_ + psrc[j] + lane_off[j]), (LAS unsigned*)(sl_ + pdst[j] * 1024), 16, 0, 0); } while (0)
#define SC2_LD(slot_, piece_) (*(const LAS v4u*)(lds + (slot_) * SLOT + (piece_) * 1024 + lane * 16))
#define SC2_X(par_, k_) (*(LAS v4u*)(lds + XCH + (par_) * 4096 + (k_) * 1024 + lane * 16))
    f32x16 ST[2] = {zero16(), zero16()};
    SC2_ISSUE(0, 0); SC2_ISSUE(1, 1); SC2_ISSUE(2, 2); SC2_ISSUE(3, 3);
    for (int ci = 0; ci <= SC_NCH; ++ci) {
        const int slot = ci % NSLOT;
        asm volatile("s_waitcnt vmcnt(9)" ::: "memory");
        __builtin_amdgcn_s_barrier();
        asm volatile("" ::: "memory");
        { const int nx = ci + PD < SC_NCH ? ci + PD : SC_NCH - 1; SC2_ISSUE(nx, (ci + PD) % NSLOT); }
        if (wave == 0 && ci < SC_NCH) {
            v4u g0 = SC2_LD(slot, 0), g1 = SC2_LD(slot, 1), g2 = SC2_LD(slot, 2), g3 = SC2_LD(slot, 3), g4 = SC2_LD(slot, 4), g5 = SC2_LD(slot, 5), g6 = SC2_LD(slot, 6), g7 = SC2_LD(slot, 7);
            v4u u0 = SC2_LD(slot, 12), u1 = SC2_LD(slot, 13), u2 = SC2_LD(slot, 14), u3 = SC2_LD(slot, 15);
            f32x4 ec[8];
#pragma unroll
            for (int kq = 0; kq < 8; ++kq) ec[kq] = *(const LAS f32x4*)(lds + slot * SLOT + 18 * 1024 + (32 * (kq >> 2) + 8 * (kq & 3) + 4 * hh) * 4);
            asm volatile("" : "+v"(g0), "+v"(g1), "+v"(g2), "+v"(g3), "+v"(g4), "+v"(g5), "+v"(g6), "+v"(g7), "+v"(u0), "+v"(u1), "+v"(u2), "+v"(u3));
            asm volatile("" : "+v"(ec[0]), "+v"(ec[1]), "+v"(ec[2]), "+v"(ec[3]), "+v"(ec[4]), "+v"(ec[5]), "+v"(ec[6]), "+v"(ec[7]));
            const v4u s00 = cvtf<0, 0>(ST[0]), s01 = cvtf<1, 0>(ST[0]), s10 = cvtf<0, 0>(ST[1]), s11 = cvtf<1, 0>(ST[1]);
            SC2_X(ci & 1, 0) = s00; SC2_X(ci & 1, 1) = s01; SC2_X(ci & 1, 2) = s10; SC2_X(ci & 1, 3) = s11;
            f32x16 a0, a1;
            a0[0] = bflo(u0.x); a0[1] = bfhi(u0.x); a0[2] = bflo(u0.y); a0[3] = bfhi(u0.y); a0[4] = bflo(u0.z); a0[5] = bfhi(u0.z); a0[6] = bflo(u0.w); a0[7] = bfhi(u0.w);
            a0[8] = bflo(u1.x); a0[9] = bfhi(u1.x); a0[10] = bflo(u1.y); a0[11] = bfhi(u1.y); a0[12] = bflo(u1.z); a0[13] = bfhi(u1.z); a0[14] = bflo(u1.w); a0[15] = bfhi(u1.w);
            a1[0] = bflo(u2.x); a1[1] = bfhi(u2.x); a1[2] = bflo(u2.y); a1[3] = bfhi(u2.y); a1[4] = bflo(u2.z); a1[5] = bfhi(u2.z); a1[6] = bflo(u2.w); a1[7] = bfhi(u2.w);
            a1[8] = bflo(u3.x); a1[9] = bfhi(u3.x); a1[10] = bflo(u3.y); a1[11] = bfhi(u3.y); a1[12] = bflo(u3.z); a1[13] = bfhi(u3.z); a1[14] = bflo(u3.w); a1[15] = bfhi(u3.w);
#pragma unroll
            for (int q = 0; q < 4; ++q)
#pragma unroll
                for (int e = 0; e < 4; ++e) { a0[4 * q + e] += ST[0][4 * q + e] * ec[q][e]; a1[4 * q + e] += ST[1][4 * q + e] * ec[4 + q][e]; }
            a0 = mm(g0, s00, a0); a1 = mm(g4, s00, a1); a0 = mm(g1, s01, a0); a1 = mm(g5, s01, a1);
            a0 = mm(g2, s10, a0); a1 = mm(g6, s10, a1); a0 = mm(g3, s11, a0); a1 = mm(g7, s11, a1);
            ST[0] = a0; ST[1] = a1;
            if (lane == 0 && ci == SC_NCH - 24) __hip_atomic_fetch_add(sdone, 1u, __ATOMIC_RELAXED, __HIP_MEMORY_SCOPE_AGENT);
        } else if (wave == 1 && ci >= 1) {
            const int cj = ci - 1, sj = cj % NSLOT, par = cj & 1;
            v4u ya = SC2_LD(sj, 16), yc = SC2_LD(sj, 17), q0 = SC2_LD(sj, 8), q1 = SC2_LD(sj, 9), q2 = SC2_LD(sj, 10), q3 = SC2_LD(sj, 11), x0 = SC2_X(par, 0), x1 = SC2_X(par, 1), x2 = SC2_X(par, 2), x3 = SC2_X(par, 3);
            asm volatile("" : "+v"(ya), "+v"(yc), "+v"(q0), "+v"(q1), "+v"(q2), "+v"(q3), "+v"(x0), "+v"(x1), "+v"(x2), "+v"(x3));
            f32x16 y, y2 = zero16();
            y[0] = bflo(ya.x); y[1] = bfhi(ya.x); y[2] = bflo(ya.y); y[3] = bfhi(ya.y); y[4] = bflo(ya.z); y[5] = bfhi(ya.z); y[6] = bflo(ya.w); y[7] = bfhi(ya.w);
            y[8] = bflo(yc.x); y[9] = bfhi(yc.x); y[10] = bflo(yc.y); y[11] = bfhi(yc.y); y[12] = bflo(yc.z); y[13] = bfhi(yc.z); y[14] = bflo(yc.w); y[15] = bfhi(yc.w);
            y = mm(x0, q0, y); y2 = mm(x2, q2, y2); y = mm(x1, q1, y); y2 = mm(x3, q3, y2);
            const int row = scan_row(b, dir, SC_C * cj + n); bf16* yo = Y + (size_t)row * RW;
#pragma unroll
            for (int q = 0; q < 4; ++q) *(v2u*)(yo + 8 * q) = (v2u){cvtpk(y[4 * q] + y2[4 * q], y[4 * q + 1] + y2[4 * q + 1]), cvtpk(y[4 * q + 2] + y2[4 * q + 2], y[4 * q + 3] + y2[4 * q + 3])};
        }
        asm volatile("s_waitcnt lgkmcnt(0)" ::: "memory");
    }
    asm volatile("s_waitcnt vmcnt(0)" ::: "memory");
#undef SC2_ISSUE
#undef SC2_LD
#undef SC2_X
}

__device__ __forceinline__ float sum8(float v) { v += __shfl_xor(v, 1); v += __shfl_xor(v, 2); v += __shfl_xor(v, 4); return v; }
__device__ __forceinline__ void unpack8(v4u s, float (&v)[8]) { v[0] = bflo(s.x); v[1] = bfhi(s.x); v[2] = bflo(s.y); v[3] = bfhi(s.y); v[4] = bflo(s.z); v[5] = bfhi(s.z); v[6] = bflo(s.w); v[7] = bfhi(s.w); }
__device__ __forceinline__ void ld8f(const float* q, float (&v)[8]) { const f32x4 a = *(const f32x4*)q, b = *(const f32x4*)(q + 4); v[0] = a[0]; v[1] = a[1]; v[2] = a[2]; v[3] = a[3]; v[4] = b[0]; v[5] = b[1]; v[6] = b[2]; v[7] = b[3]; }
__device__ __forceinline__ v4u pack8(const float (&v)[8]) { v4u o; o.x = cvtpk(v[0], v[1]); o.y = cvtpk(v[2], v[3]); o.z = cvtpk(v[4], v[5]); o.w = cvtpk(v[6], v[7]); return o; }

__device__ __forceinline__ void ph_readout2(const KP& p, int l, int gw, int NGW, int lane) {
    const bf16* P = (const bf16*)(OWS + WS_P); const bf16* LO = (const bf16*)(OWS + WS_LO); const bf16* Y = (const bf16*)(OWS + WS_Y);
    bf16* MI = (bf16*)(OWS + WS_MIXIN); constexpr size_t PA = (size_t)MROWS * RW; const int c0 = lane * 8;
    for (int row = gw; row < MROWS; row += NGW) { const bf16* pr = P + (size_t)row * NP; const bf16* lo = LO + (size_t)row * NLO;
        int t, len; if (row < NLAT) { t = row & 63; len = 64; } else { t = (row - NLAT) & 255; len = 256; }
        const v4u kw = *(const v4u*)(pr + PC_K + c0), rw = *(const v4u*)(pr + PC_R + c0), vw = *(const v4u*)(pr + PC_V + c0);
        const v4u cbw = *(const v4u*)(pr + PC_CB + c0), ccw = *(const v4u*)(pr + PC_CC + c0), chw = *(const v4u*)(pr + PC_CH + c0);
        v4u ccp = (v4u){0u, 0u, 0u, 0u}, chp = ccp, ccn = ccp, chn = ccp;
        if (t > 0) { ccp = *(const v4u*)(pr - NP + PC_CC + c0); chp = *(const v4u*)(pr - NP + PC_CH + c0); }
        if (t < len - 1) { ccn = *(const v4u*)(pr + NP + PC_CC + c0); chn = *(const v4u*)(pr + NP + PC_CH + c0); }
        float yf[8], yb[8], la0[8], la1[8], g[8];
        unpack8(*(const v4u*)(Y + (size_t)row * RW + c0), yf); unpack8(*(const v4u*)(Y + PA + (size_t)row * RW + c0), yb); unpack8(*(const v4u*)(lo + 1024 + c0), la0); unpack8(*(const v4u*)(lo + 1536 + c0), la1); unpack8(*(const v4u*)(lo + 2048 + c0), g);
        float a0[8], a1[8], ka[8], rkp[8], lg[8], lb[8];
        ld8f(PIN(I_A0) + (l * 2 + 0) * RW + c0, a0); ld8f(PIN(I_A0) + (l * 2 + 1) * RW + c0, a1); ld8f(PIN(I_KA) + l * RW + c0, ka); ld8f(PIN(I_RK) + l * RW + c0, rkp);
        ld8f(PIN(I_LNXG) + l * RW + c0, lg); ld8f(PIN(I_LNXB) + l * RW + c0, lb);
        float kv[8], rv[8], vv[8]; unpack8(kw, kv); unpack8(rw, rv); unpack8(vw, vv);
        float y[8], s = 0.f, rk = 0.f;
#pragma unroll
        for (int j = 0; j < 8; ++j) { y[j] = yf[j] + yb[j]; s += y[j]; const float av = sigm(a0[j] + la0[j]) + sigm(a1[j] + la1[j]); rk += rv[j] * kv[j] * (2.f + (av - 2.f) * ka[j]) * rkp[j]; }
        const float mu = sum8(s) * (1.f / 64.f); rk = sum8(rk); float q = 0.f;
#pragma unroll
        for (int j = 0; j < 8; ++j) { y[j] -= mu; q += y[j] * y[j]; }
        const float rstd = 1.f / sqrtf(sum8(q) * (1.f / 64.f) + GN_EPS);
        float o[8];
#pragma unroll
        for (int j = 0; j < 8; ++j) o[j] = (y[j] * rstd * lg[j] + lb[j] + rk * vv[j]) * g[j];
        float orw[8];
#pragma unroll
        for (int j = 0; j < 8; ++j) orw[j] = o[j];
        float cb[8], cc[8], ch[8], pcc[8], pch[8], ncc[8], nch[8], w0[8], w1[8], w2[8];
        unpack8(cbw, cb); unpack8(ccw, cc); unpack8(chw, ch); unpack8(ccp, pcc); unpack8(chp, pch); unpack8(ccn, ncc); unpack8(chn, nch);
        const float* cw = PIN(I_CONVW) + (size_t)l * 3 * RW + c0; ld8f(cw, w0); ld8f(cw + RW, w1); ld8f(cw + 2 * RW, w2);
#pragma unroll
        for (int j = 0; j < 8; ++j) o[j] = cb[j] * (pcc[j] * pch[j] * w0[j] + cc[j] * ch[j] * w1[j] + ncc[j] * nch[j] * w2[j]);
        float am = 0.f;
#pragma unroll
        for (int j = 0; j < 8; ++j) am = fmaxf(am, fmaxf(fabsf(orw[j]), fabsf(o[j])));
#pragma unroll
        for (int sh = 1; sh < 64; sh <<= 1) am = fmaxf(am, __shfl_xor(am, sh));
        am = fmaxf(am, 1e-30f); const float inv = 127.f / am; unsigned char* m8 = (unsigned char*)MI + (size_t)row * D + c0;
        *(v2u*)m8 = (v2u){q8pack(orw[0] * inv, orw[1] * inv, orw[2] * inv, orw[3] * inv), q8pack(orw[4] * inv, orw[5] * inv, orw[6] * inv, orw[7] * inv)};
        *(v2u*)(m8 + RW) = (v2u){q8pack(o[0] * inv, o[1] * inv, o[2] * inv, o[3] * inv), q8pack(o[4] * inv, o[5] * inv, o[6] * inv, o[7] * inv)};
        if (lane == 0) ((float*)(OWS + WS_SAM))[row] = am * (1.f / 127.f);
    }
}


template <int KS> __device__ __forceinline__ void lora_task(const bf16* pr, int col0, int fn, const bf16* wt, bf16* out, int ct0, int n, int hh) {
    v4u af[KS];
#pragma unroll
    for (int s = 0; s < KS; ++s) { const v4u w = *(const v4u*)(pr + col0 + 16 * s + 8 * hh); float v[8]; unpack8(w, v);
        if (fn == 0) {
#pragma unroll
            for (int j = 0; j < 8; ++j) v[j] = 1.f - 2.f * __builtin_amdgcn_rcpf(1.f + __expf(2.f * v[j])); }
        else if (fn == 2) {
#pragma unroll
            for (int j = 0; j < 8; ++j) v[j] = __builtin_amdgcn_rcpf(1.f + __expf(-v[j])); }
        af[s] = pack8(v); }
#pragma unroll 2
    for (int ct = ct0; ct < ct0 + 8; ++ct) { f32x16 acc = zero16(); const bf16* wb = wt + (size_t)(32 * ct + n) * (16 * KS) + 8 * hh;
#pragma unroll
        for (int s = 0; s < KS; ++s) acc = mm(af[s], *(const v4u*)(wb + 16 * s), acc);
#pragma unroll
        for (int r = 0; r < 16; ++r) out[(size_t)((r & 3) + 8 * (r >> 2) + 4 * hh) * NLO + 32 * ct + n] = (bf16)f2bf(acc[r]); }
}
__device__ __forceinline__ void ph_lora(const KP& p, int l, int gw, int NGW, int lane) {
    const bf16* P = (const bf16*)(OWS + WS_P); bf16* LO = (bf16*)(OWS + WS_LO); float* NRM = (float*)(OWS + WS_RKS);
    const bf16* LW = (const bf16*)(OWS + WS_LORA) + (size_t)l * LORAW_PER_LAYER; const int n = lane & 31, hh = lane >> 5;
    for (int task = gw; task < (MROWS / 32) * 10; task += NGW) { const int half = task & 1, grp = (task >> 1) % 5, rb = task / 10;
        const bf16* pr = P + (size_t)(rb * 32 + n) * NP; bf16* out = LO + (size_t)(rb * 32) * NLO + grp * 512;
        if (grp < 4) lora_task<4>(pr, grp < 2 ? PC_WD + 64 * grp : PC_AD + 64 * (grp - 2), grp < 2 ? 0 : 1, LW + (size_t)grp * 512 * 64, out, half * 8, n, hh);
        else lora_task<8>(pr, PC_GD, 2, LW + (size_t)4 * 512 * 64, out, half * 8, n, hh); }
    float kkc[8]; ld8f(PIN(I_KK) + l * RW + lane * 8, kkc);
    for (int row = gw; row < MROWS; row += NGW) { const v4u kw = *(const v4u*)(P + (size_t)row * NP + PC_K + lane * 8); float kv[8]; unpack8(kw, kv); float ss = 0.f;
#pragma unroll
        for (int j = 0; j < 8; ++j) { const float t = kv[j] * kkc[j]; ss += t * t; }
        ss = sum8(ss); if ((lane & 7) == 0) NRM[row * 8 + (lane >> 3)] = 1.f / fmaxf(sqrtf(ss), 1e-12f); }
}

__device__ __forceinline__ void ph_moe_gather(const KP& p, int l, int gw, int NGW, int lane) {
    const unsigned* gcnt = (const unsigned*)(OWS + WS_CTL) + CW_GCNT + 64 * (l >> 1);
    int cnt[8], pb[9]; pb[0] = 0;
#pragma unroll
    for (int e = 0; e < 8; ++e) { cnt[e] = (int)gcnt[e]; pb[e + 1] = pb[e] + ((cnt[e] + 255) & ~255); }
    const unsigned* rowlist = (const unsigned*)(OWS + WS_ROWLIST); const float* wsel = (const float*)(OWS + WS_WSEL); float* wsort = (float*)(OWS + WS_WSORT);
    const unsigned char* H8 = OWS + WS_H8; unsigned char* HG = OWS + WS_HG; const float* sa = (const float*)(OWS + WS_SA); float* sag = (float*)(OWS + WS_SAG);
    for (int pos = gw; pos < pb[8]; pos += NGW) {
        int e = 0, base = 0, ce = cnt[0];
#pragma unroll
        for (int k = 1; k < 8; ++k) if (pos >= pb[k]) { e = k; base = pb[k]; ce = cnt[k]; }
        const int rank = pos - base; v4u a = (v4u){0u, 0u, 0u, 0u}; float w = 0.f, sc = 0.f;
        if (rank < ce) { const unsigned ent = rowlist[(size_t)e * MROWS + rank]; a = *(const v4u*)(H8 + (size_t)(ent >> 1) * D + lane * 16); w = wsel[ent]; sc = sa[ent >> 1]; }
        *(v4u*)(HG + (size_t)pos * D + lane * 16) = a;
        if (lane == 0) { wsort[pos] = w; sag[pos] = sc; }
    }
}

__device__ __forceinline__ void ph_ln(const KP& p, LAS unsigned char* lds, int l, int which, int tid, int wave, int gw, int NGW, int lane) {
    const float* modv = (const float*)(OWS + WS_MODV); float* X = (float*)(OWS + WS_X); bf16* H = (bf16*)(OWS + WS_H);
    const bf16* BR = (const bf16*)(OWS + (which == 0 ? WS_MIXO : WS_F)); const float* BP = (const float*)(OWS + (which == 0 ? WS_MIXP : WS_FP));
    const float* lg = PIN(which == 0 ? I_LN1G : I_LN2G) + l * D; const float* lb = PIN(which == 0 ? I_LN1B : I_LN2B) + l * D;
    const bool moe = (which == 0) && (l & 1); const bool last = (which == 1) && (l == DEPTH - 1); const bool moe_out = (which == 1) && (l & 1);
    LAS int* lcnt = (LAS int*)lds;
    LAS int* lsel = (LAS int*)(lds + 64);
    int nloc = 0;
    if (moe) { if (tid < 16) lcnt[tid] = 0; __syncthreads(); }
    int pbs[9]; pbs[0] = 0;
    if (moe_out) { const unsigned* gcnt = (const unsigned*)(OWS + WS_CTL) + CW_GCNT + 64 * (l >> 1);
#pragma unroll
        for (int e = 0; e < 8; ++e) pbs[e + 1] = pbs[e] + (int)((gcnt[e] + 255u) & ~255u); }
    f32x4 gt[4], g4[4], b4[4], sh[4], sc[4]; ld_row(lg, lane, g4); ld_row(lb, lane, b4);
    for (int it = 0; it < 9; ++it) {
        if (it == 8 && gw >= NCTX) break;
        const int row = it < 8 ? (gw >> 9) * SEQ + (gw & 511) + 512 * it : NLAT + gw;
        const int mr = mod_row(row); const float* mv = modv + (size_t)(l * 5 + mr) * NMOD;
        if (it == 0 || it == 8) { ld_row(mv + (which == 0 ? 2048 : 5120), lane, gt);
            if (!last) { const float* mv2 = which == 0 ? mv + 3072 : modv + (size_t)((l + 1) * 5 + mr) * NMOD; ld_row(mv2, lane, sh); ld_row(mv2 + 1024, lane, sc); } }
        f32x4 x[4], br[4], t[4]; ld_row(X + (size_t)row * D, lane, x);
        if (moe_out) { const int* ts = (const int*)(OWS + WS_TOKSEL) + row * 4; const int e0 = ts[0], r0 = ts[1], e1 = ts[2], r1 = ts[3]; int b0 = 0, b1 = 0;
#pragma unroll
            for (int k = 1; k < 8; ++k) { if (e0 >= k) b0 = pbs[k]; if (e1 >= k) b1 = pbs[k]; }
            f32x4 ba[4], bb[4]; const int q0 = b0 + r0, q1 = b1 + r1; constexpr int MM = MOE_MAIN_PANELS * 256;
            if (q0 < MM) ld_row_bf16(BR + (size_t)q0 * D, lane, ba); else ld_row_parts<4>(BP + (size_t)(q0 - MM) * D, (size_t)MOE_TAIL_ROWS * D, lane, ba);
            if (q1 < MM) ld_row_bf16(BR + (size_t)q1 * D, lane, bb); else ld_row_parts<4>(BP + (size_t)(q1 - MM) * D, (size_t)MOE_TAIL_ROWS * D, lane, bb);
#pragma unroll
            for (int j = 0; j < 4; ++j) br[j] = ba[j] + bb[j]; }
        else if (row < NLAT) ld_row_bf16(BR + (size_t)row * D, lane, br);
        else if (which == 0) ld_row_parts<2>(BP + (size_t)(row - NLAT) * D, (size_t)NCTX * D, lane, br);
        else ld_row_parts<7>(BP + (size_t)(row - NLAT) * D, (size_t)NCTX * D, lane, br);
        float s = 0.f;
#pragma unroll
        for (int j = 0; j < 4; ++j) { t[j] = DN_ALPHA * x[j] + gt[j] * br[j]; s += (t[j][0] + t[j][1]) + (t[j][2] + t[j][3]); }
        const float mean = wave_sum(s) * (1.f / D); float s2 = 0.f;
#pragma unroll
        for (int j = 0; j < 4; ++j) { t[j] = t[j] - mean; s2 += (t[j][0] * t[j][0] + t[j][1] * t[j][1]) + (t[j][2] * t[j][2] + t[j][3] * t[j][3]); }
        const float rstd = 1.f / sqrtf(wave_sum(s2) * (1.f / D) + LN_EPS);
#pragma unroll
        for (int j = 0; j < 4; ++j) x[j] = t[j] * rstd * g4[j] + b4[j];
        if (last) {
#if PROBE_DUP & (128 | 256)
            { const unsigned* cw = (const unsigned*)(OWS + WS_CTL); const float cval = 10.f * ((float)cw[20001] / 1024.f) / fmaxf((float)cw[20000], 1.f);
#pragma unroll
              for (int j = 0; j < 4; ++j) x[j] = (f32x4){cval, cval, cval, cval}; }
#endif
            if (row < NLAT) st_row(p.out + (size_t)row * D, lane, x); continue; }
        st_row(X + (size_t)row * D, lane, x);
        f32x4 hh[4];
#pragma unroll
        for (int j = 0; j < 4; ++j) hh[j] = x[j] * (1.f + sc[j]) + sh[j];
        st_row_q8(OWS + WS_H8, (float*)(OWS + WS_SA), row, lane, hh);
        if (moe) {
            const float* rw = PIN(I_RTW) + (size_t)(l >> 1) * D * NE; float lgt[8];
#pragma unroll
            for (int e = 0; e < 8; ++e) lgt[e] = 0.f;
#pragma unroll
            for (int j = 0; j < 4; ++j)
#pragma unroll
                for (int i = 0; i < 4; ++i) { const f32x4* wp = (const f32x4*)(rw + (size_t)(4 * lane + 256 * j + i) * NE); const f32x4 w0 = wp[0], w1 = wp[1]; const float hv = hh[j][i];
                    lgt[0] += hv * w0[0]; lgt[1] += hv * w0[1]; lgt[2] += hv * w0[2]; lgt[3] += hv * w0[3]; lgt[4] += hv * w1[0]; lgt[5] += hv * w1[1]; lgt[6] += hv * w1[2]; lgt[7] += hv * w1[3]; }
#pragma unroll
            for (int e = 0; e < 8; ++e) lgt[e] = wave_sum(lgt[e]) + PIN(I_RTB)[(l >> 1) * NE + e];
            float v0 = lgt[0]; int i0 = 0;
#pragma unroll
            for (int e = 1; e < 8; ++e) if (lgt[e] > v0) { v0 = lgt[e]; i0 = e; }
            float v1 = -3.0e38f; int i1 = -1;
#pragma unroll
            for (int e = 0; e < 8; ++e) if (e != i0 && lgt[e] > v1) { v1 = lgt[e]; i1 = e; }
            const float w0 = 1.f / (1.f + expf(v1 - v0)), w1 = 1.f - w0;
            if (lane == 0) { const int lr0 = __hip_atomic_fetch_add(lcnt + i0, 1, __ATOMIC_RELAXED, __HIP_MEMORY_SCOPE_WORKGROUP), lr1 = __hip_atomic_fetch_add(lcnt + i1, 1, __ATOMIC_RELAXED, __HIP_MEMORY_SCOPE_WORKGROUP); const int li = nloc * NWAVES + wave;
                lsel[li * 8 + 0] = row; lsel[li * 8 + 1] = i0; lsel[li * 8 + 2] = lr0; lsel[li * 8 + 3] = i1; lsel[li * 8 + 4] = lr1;
                ((float*)(OWS + WS_WSEL))[row * 2] = w0; ((float*)(OWS + WS_WSEL))[row * 2 + 1] = w1; }
            ++nloc;
        }
    }
    if (moe) {
        __syncthreads();
        unsigned* gcnt = (unsigned*)(OWS + WS_CTL) + CW_GCNT + 64 * (l >> 1);
        if (tid < 8) lcnt[8 + tid] = (int)__hip_atomic_fetch_add(gcnt + tid, (unsigned)lcnt[tid], __ATOMIC_RELAXED, __HIP_MEMORY_SCOPE_AGENT);
        __syncthreads();
        unsigned* rowlist = (unsigned*)(OWS + WS_ROWLIST); int* toksel = (int*)(OWS + WS_TOKSEL);
        if (tid < 16 * NWAVES) { const int k = tid / NWAVES, w = tid % NWAVES; if (k < 8 || (k == 8 && (int)blockIdx.x * NWAVES + w < NCTX)) { const int li = k * NWAVES + w;
            const int row = lsel[li * 8 + 0], e0 = lsel[li * 8 + 1], r0 = lcnt[8 + e0] + lsel[li * 8 + 2], e1 = lsel[li * 8 + 3], r1 = lcnt[8 + e1] + lsel[li * 8 + 4];
            rowlist[(size_t)e0 * MROWS + r0] = (unsigned)row * 2u; rowlist[(size_t)e1 * MROWS + r1] = (unsigned)row * 2u + 1u;
            toksel[row * 4 + 0] = e0; toksel[row * 4 + 1] = r0; toksel[row * 4 + 2] = e1; toksel[row * 4 + 3] = r1; } }
    }
}


#ifndef PROBE_WHICH
#define PROBE_WHICH(x, y) (x)
#endif
#if PROBE_DUP & 128
__device__ __forceinline__ void ph_check_up(const KP& p, int gw, int lane) {
    if (gw >= 64) return;
    const float* X = (const float*)(OWS + WS_X); const float* modv = (const float*)(OWS + WS_MODV); const bf16* ACT = (const bf16*)(OWS + WS_ACT);
    const int row = gw * 257, c = lane * 56 + (gw & 7), mr = mod_row(row); const float* mv = modv + (size_t)(0 * 5 + mr) * NMOD;
    const signed char* H8 = (const signed char*)(OWS + WS_H8); const signed char* W8 = (const signed char*)(OWS + WS_F13); const float* SA = (const float*)(OWS + WS_SA); const unsigned* AM = (const unsigned*)(OWS + WS_AMAX);
    const int j1 = 8 * (c >> 2) + (c & 3), j3 = j1 + 4; int ia = 0, ib = 0;
    for (int k = 0; k < D; ++k) { const int h = H8[(size_t)row * D + k]; ia += h * W8[(size_t)j1 * D + k]; ib += h * W8[(size_t)j3 * D + k]; }
    const float a = (float)ia * SA[row] * __builtin_bit_cast(float, AM[j1]) * (1.f / 127.f), b = (float)ib * SA[row] * __builtin_bit_cast(float, AM[j3]) * (1.f / 127.f);
    (void)X; (void)mv;
    const float ref = a / (1.f + expf(-a)) * b, got = bf2f(ACT[(size_t)row * DFF + c]);
    const float da = ((const float*)(OWS + WS_F))[(size_t)row * DFF + c], db = ((const float*)(OWS + WS_F))[(size_t)4096 * DFF + (size_t)row * DFF + c]; (void)got; (void)db;
    if (row < 4096 && abs(ia) > 1000) { const float ratio = 10.f * fminf(fabsf(PROBE_WHICH(da / a, db / b) - 1.f), 0.4f);
        __hip_atomic_fetch_add((unsigned*)(OWS + WS_CTL) + 20000, 1u, __ATOMIC_RELAXED, __HIP_MEMORY_SCOPE_AGENT); __hip_atomic_fetch_add((unsigned*)(OWS + WS_CTL) + 20001, (unsigned)(ratio * 1024.f), __ATOMIC_RELAXED, __HIP_MEMORY_SCOPE_AGENT); }
}
#endif

#if PROBE_DUP & 256
__device__ __forceinline__ void ph_check_mfma(const KP& p, int lane) {
    typedef int i32x4 __attribute__((ext_vector_type(4)));
    const int r = lane & 15, g = lane >> 4; unsigned aw[4], bw[4];
#pragma unroll
    for (int q = 0; q < 4; ++q) { unsigned a = 0, b = 0;
#pragma unroll
        for (int t = 0; t < 4; ++t) { const int k = 16 * g + 4 * q + t; const int av = ((r * 7 + k * 3) % 5) - 2, bv = ((r * 5 + k * 11) % 7) - 3; a |= (unsigned)(av & 255) << (8 * t); b |= (unsigned)(bv & 255) << (8 * t); }
        aw[q] = a; bw[q] = b; }
    i32x4 c = {0, 0, 0, 0};
    c = __builtin_amdgcn_mfma_i32_16x16x64_i8((i32x4){(int)aw[0], (int)aw[1], (int)aw[2], (int)aw[3]}, (i32x4){(int)bw[0], (int)bw[1], (int)bw[2], (int)bw[3]}, c, 0, 0, 0);
    bool bad = false;
#pragma unroll
    for (int reg = 0; reg < 4; ++reg) { const int i = 4 * g + reg, j = r; int e = 0;
        for (int k = 0; k < 64; ++k) e += (((i * 7 + k * 3) % 5) - 2) * (((j * 5 + k * 11) % 7) - 3);
        if (c[reg] != e) bad = true; }
    if (bad) __hip_atomic_fetch_add((unsigned*)(OWS + WS_CTL) + 20000, 1000u, __ATOMIC_RELAXED, __HIP_MEMORY_SCOPE_AGENT);
}
#endif
__global__ void __launch_bounds__(NWAVES * 64, 2) fwd_kernel(KP p) {
    extern __shared__ __attribute__((aligned(16))) unsigned char lds_raw[];
    LAS unsigned char* lds = (LAS unsigned char*)lds_raw;
    volatile LAS unsigned* MISC = (volatile LAS unsigned*)(lds + MISC_OFF);
    const int G = gridDim.x, NGW = G * NWAVES;
    for (int u = threadIdx.x; u < (LDS_BYTES - LDSCTL_OFF) / 4; u += NWAVES * 64) ((LAS unsigned*)(lds + LDSCTL_OFF))[u] = 0u;
    __syncthreads();
    unsigned* ctl = (unsigned*)(OWS + WS_CTL);
    const bool single = p.ph < 0;
    XcdBarrier bar; bar.bar = ctl + CW_BAR; bar.x = 0; bar.st = nullptr;
    if (single) bar = xcd_barrier_post(ctl + CW_BAR, MISC + 8);
    int phc = 0;
#ifndef PROBE_DUP
#define PROBE_DUP 0
#endif
#define REP(bit) for (int rep_ = 0; rep_ < ((PROBE_DUP & (bit)) ? 2 : 1); ++rep_)
#define RUN() (single || p.ph == phc)
#define FRESH() int tid = threadIdx.x; asm volatile("" : "+v"(tid)); const int lane = tid & 63, wave = __builtin_amdgcn_readfirstlane(tid >> 6), gw = blockIdx.x * NWAVES + wave; (void)lane; (void)gw
#define SEAM() do { if (single) { XcdBarrier b2_ = bar; asm volatile("" : "+s"(b2_.bar)); xcd_barrier(b2_); if (PROBE_DUP & 32) { XcdBarrier b3_ = bar; asm volatile("" : "+s"(b3_.bar)); xcd_barrier(b3_); } } ++phc; } while (0)

    REP(4) if (RUN()) { FRESH(); ph_modvec(p, lds, tid); __syncthreads(); ph_convert(p, lds, gw, NGW, wave, lane); cq_static(p, lds, 3 * CQ_IN + 3 * CQ_OUT + 2 * CQ_UP, CQ_J1, gw, NGW, wave, lane); ph_amax(p, gw, NGW, lane); }
    SEAM();
#if PROBE_DUP & 256
    if (blockIdx.x == 0 && threadIdx.x < 64) ph_check_mfma(p, threadIdx.x);
#endif
    if (RUN()) { FRESH(); ph_init_rows(p, gw, NGW, lane); cq_static(p, lds, -CQ_NEG, 3 * CQ_IN + 3 * CQ_OUT + 2 * CQ_UP, gw, NGW, wave, lane); }
    SEAM();
    for (int ll = 0; ll < DEPTH; ++ll) {
#define l (ll + opaque_zero_i())
         if (RUN()) { pg8::Gemm g{(const bf16*)(OWS + WS_H8), (const bf16*)(OWS + WS_WIN) + (size_t)l * (NP * D / 2), MROWS, NP, D / 2, D / 2}; pg8::StaticOrder S; S.init(MROWS, NP, G, (int)blockIdx.x);
            pg8::EpiBf16S8 E{(bf16*)(OWS + WS_P), NP, (const float*)(OWS + WS_SA), (const float*)(OWS + WS_AMAX) + AM_IN + l * NP}; pg8::gemm_phase<pg8::EpiBf16S8, pg8::StaticOrder, true, true, true>(lds, g, S, E); }
        SEAM();
        REP(8) if (RUN()) { FRESH(); ph_lora(p, l, gw, NGW, lane); }
        SEAM();
        REP(1) if (RUN()) { FRESH(); ph_scan1(p, l, gw, NGW, lane); }
        SEAM();
        REP(2) if (RUN()) { FRESH(); ph_scan2(p, lds, l, wave, lane); }
        SEAM();
        REP(64) if (RUN()) { FRESH(); ph_readout2(p, l, gw, NGW, lane); }
        SEAM();
         if (RUN()) {
            { pg8::Gemm g{(const bf16*)(OWS + WS_MIXIN), (const bf16*)(OWS + WS_WOUT) + (size_t)l * (D * D / 2), NLAT, D, D / 2, D / 2}; pg8::StaticOrder S; S.init(NLAT, D, G, (int)blockIdx.x);
              pg8::EpiBf16S8 E{(bf16*)(OWS + WS_MIXO), D, (const float*)(OWS + WS_SAM), (const float*)(OWS + WS_AMAX) + AM_OUT + l * D}; pg8::gemm_phase<pg8::EpiBf16S8, pg8::StaticOrder, true, true, true>(lds, g, S, E); }
            { pg8::Gemm g{(const bf16*)(OWS + WS_MIXIN), (const bf16*)(OWS + WS_WOUT) + (size_t)l * (D * D / 2), NCTX, D, D / 4, D / 2}; pg8::SplitOrder S{NCTX / 256, D / 256, 2, G, (int)blockIdx.x, NLAT / 256, 0, 0, 0, 0, 0, 0, 0, 0};
              pg8::EpiPartS8 E{(float*)(OWS + WS_MIXP), D, (size_t)NCTX * D, NLAT / 256, (const float*)(OWS + WS_SAM), (const float*)(OWS + WS_AMAX) + AM_OUT + l * D}; pg8::gemm_phase<pg8::EpiPartS8, pg8::SplitOrder, true, true, true>(lds, g, S, E); }
        }
        SEAM();
        if (RUN()) { FRESH(); ph_ln(p, lds, l, 0, tid, wave, gw, NGW, lane); }
        SEAM();
        if ((l & 1) == 0) {
            const int fi = l >> 1;
             if (RUN()) { pg8::Gemm g{(const bf16*)(OWS + WS_H8), (const bf16*)(OWS + WS_F13) + (size_t)fi * DFF * D, MROWS, 2 * DFF, D / 2, D / 2}; pg8::StaticOrder S; S.init(MROWS, 2 * DFF, G, (int)blockIdx.x);
                constexpr int NOE = 0x7fffffff; pg8::EpiSwiGLU8 E{(bf16*)(OWS + WS_ACT), DFF, nullptr, (const float*)(OWS + WS_SA), (const unsigned*)(OWS + WS_AMAX) + (size_t)fi * 2 * DFF, NOE, NOE, NOE, NOE, NOE, NOE, NOE};
#if PROBE_DUP & 128
                E.dbg = (int*)(OWS + WS_F);
#endif
                pg8::gemm_phase<pg8::EpiSwiGLU8, pg8::StaticOrder, true, true, true>(lds, g, S, E); }
            SEAM();
#if PROBE_DUP & 128
            if (ll == 0) { if (RUN()) { FRESH(); ph_check_up(p, gw, lane); } SEAM(); }
#endif
             if (RUN()) {
                { pg8::Gemm g{(const bf16*)(OWS + WS_ACT), (const bf16*)(OWS + WS_F2) + (size_t)fi * D * DFF, NLAT, D, DFF, DFF}; pg8::StaticOrder S; S.init(NLAT, D, G, (int)blockIdx.x);
                  pg8::EpiBf16<0> E{(bf16*)(OWS + WS_F), D, nullptr, 0, 0, 1.f}; pg8::gemm_phase<pg8::EpiBf16<0>, pg8::StaticOrder, true, true>(lds, g, S, E); }
                { pg8::Gemm g{(const bf16*)(OWS + WS_ACT), (const bf16*)(OWS + WS_F2) + (size_t)fi * D * DFF, NCTX, D, DFF / 7, DFF}; pg8::SplitOrder S{NCTX / 256, D / 256, 7, G, (int)blockIdx.x, NLAT / 256, 0, 0, 0, 0, 0, 0, 0, 0};
                  pg8::EpiPart E{(float*)(OWS + WS_FP), D, (size_t)NCTX * D, NLAT / 256}; pg8::gemm_phase<pg8::EpiPart, pg8::SplitOrder, true, true>(lds, g, S, E); }
            }
            SEAM();
        } else {
            REP(4) if (RUN()) { FRESH(); cq_static(p, lds, (l == 1 ? CQ_J1 : CQ_END0) + 2 * CQ_SLOT_ITEMS, l == 1 ? CQ_END0 : CQ_END1, gw, NGW, wave, lane); }
            SEAM();
            if (RUN()) { FRESH(); ph_moe_gather(p, l, gw, NGW, lane); }
            SEAM();
            {   const unsigned* gcnt = (const unsigned*)(OWS + WS_CTL) + CW_GCNT + 64 * (l >> 1); int pbp[9]; pbp[0] = 0;
#pragma unroll
                for (int e = 0; e < 8; ++e) pbp[e + 1] = pbp[e] + (int)((gcnt[e] + 255u) >> 8);
                const int mrows = pbp[8] * 256;
                 if (RUN()) { pg8::Gemm g{(const bf16*)(OWS + WS_HG), (const bf16*)(OWS + WS_MOEW13), mrows, 2 * DFF, D / 2, D / 2}; pg8::MoeOrder S; S.init(mrows, 2 * DFF, G, (int)blockIdx.x);
                    S.pb1 = pbp[1]; S.pb2 = pbp[2]; S.pb3 = pbp[3]; S.pb4 = pbp[4]; S.pb5 = pbp[5]; S.pb6 = pbp[6]; S.pb7 = pbp[7]; S.estride = (size_t)DFF * D;
                    pg8::EpiSwiGLU8 E{(bf16*)(OWS + WS_ACT), DFF, (const float*)(OWS + WS_WSORT), (const float*)(OWS + WS_SAG), (const unsigned*)(OWS + WS_AMAX) + (size_t)(2 + 8 * (l >> 1)) * 2 * DFF, pbp[1], pbp[2], pbp[3], pbp[4], pbp[5], pbp[6], pbp[7]};
                    pg8::gemm_phase<pg8::EpiSwiGLU8, pg8::MoeOrder, true, true, true>(lds, g, S, E); }
                SEAM();
                 if (RUN()) {
                    { pg8::Gemm g{(const bf16*)(OWS + WS_ACT), (const bf16*)(OWS + WS_MOEW2), MOE_MAIN_PANELS * 256, D, DFF, DFF}; pg8::MoeOrder S; S.init(MOE_MAIN_PANELS * 256, D, G, (int)blockIdx.x);
                      S.pb1 = pbp[1]; S.pb2 = pbp[2]; S.pb3 = pbp[3]; S.pb4 = pbp[4]; S.pb5 = pbp[5]; S.pb6 = pbp[6]; S.pb7 = pbp[7]; S.estride = (size_t)D * DFF;
                      pg8::EpiBf16<0> E{(bf16*)(OWS + WS_F), D, nullptr, 0, 0, 1.f}; pg8::gemm_phase<pg8::EpiBf16<0>, pg8::MoeOrder, true, true>(lds, g, S, E); }
                    { const int nT = pbp[8] - MOE_MAIN_PANELS;
                      pg8::Gemm g{(const bf16*)(OWS + WS_ACT), (const bf16*)(OWS + WS_MOEW2), nT * 256, D, DFF / 4, DFF}; pg8::SplitOrder S{nT, D / 256, 4, G, (int)blockIdx.x, MOE_MAIN_PANELS, pbp[1], pbp[2], pbp[3], pbp[4], pbp[5], pbp[6], pbp[7], (size_t)D * DFF};
                      pg8::EpiPart E{(float*)(OWS + WS_FP), D, (size_t)MOE_TAIL_ROWS * D, MOE_MAIN_PANELS}; pg8::gemm_phase<pg8::EpiPart, pg8::SplitOrder, true, true>(lds, g, S, E); }
                }
                SEAM();
            }
        }
        if (RUN()) { FRESH(); ph_ln(p, lds, l, 1, tid, wave, gw, NGW, lane); }
        SEAM();
    }
#undef l
#undef RUN
#undef SEAM
}

#ifndef MK_PER_PHASE
#define MK_PER_PHASE 0
#endif
extern "C" void kernel_launch(void* const* d_in, const int* in_sizes, int n_in, void* d_out, int out_size, void* d_ws, size_t ws_size, hipStream_t stream) {
    static int grid = 0;
    if (grid == 0) {
        if (n_in != N_IN || in_sizes[0] != NLAT * D || out_size != NLAT * D || ws_size < WS_NEED) { fprintf(stderr, "kernel_launch: unexpected shapes / workspace (%d inputs, ws %zu, need %zu)\n", n_in, ws_size, (size_t)WS_NEED); grid = -1; return; }
        int dev = 0, cus = 0, per_cu = 0;
        if (hipGetDevice(&dev) != hipSuccess || hipDeviceGetAttribute(&cus, hipDeviceAttributeMultiprocessorCount, dev) != hipSuccess) { grid = -1; return; }
        if (hipFuncSetAttribute((const void*)fwd_kernel, hipFuncAttributeMaxDynamicSharedMemorySize, LDS_BYTES) != hipSuccess) { fprintf(stderr, "kernel_launch: hipFuncSetAttribute failed\n"); grid = -1; return; }
        if (hipOccupancyMaxActiveBlocksPerMultiprocessor(&per_cu, (const void*)fwd_kernel, NWAVES * 64, LDS_BYTES) != hipSuccess || per_cu < 1) fprintf(stderr, "kernel_launch: occupancy query says %d\n", per_cu);
        (void)hipGetLastError();
        grid = cus;
        if (grid != 256) { fprintf(stderr, "kernel_launch: built for a 256-CU device, found %d CUs\n", cus); grid = -1; return; }
    }
    if (grid < 0) return;
    if (hipMemsetAsync((char*)d_ws + WS_CTL, 0, CTL_BYTES, stream) != hipSuccess) return;
    KP p{};
    for (int i = 0; i < N_IN; ++i) p.in[i] = (const float*)d_in[i];
    p.out = (float*)d_out; p.ws = (unsigned char*)d_ws; p.pad = 0;
#if MK_PER_PHASE
    const int nph = 2 + 2 * 11 + 2 * 13;
    for (int ph = 0; ph < nph; ++ph) { p.ph = ph; hipLaunchKernelGGL(fwd_kernel, dim3(grid), dim3(NWAVES * 64), LDS_BYTES, stream, p); }
#else
    p.ph = -1;
    hipLaunchKernelGGL(fwd_kernel, dim3(grid), dim3(NWAVES * 64), LDS_BYTES, stream, p);
#endif
}
```

```cpp
#include <hip/hip_runtime.h>
#define PROBE_DUP 0
#define CQ_SLOT_WGS 0
#define CQ_SLOT_ITEMS 3500
#include <cstdio>
#include <cstdint>
namespace pg8 {
#define PG8_LAS __attribute__((address_space(3)))
typedef unsigned short bf16_t;
typedef short bf16x8 __attribute__((ext_vector_type(8)));
typedef float f32x4 __attribute__((ext_vector_type(4)));
typedef unsigned u32x4 __attribute__((ext_vector_type(4)));
constexpr int BM = 256, BK = 64, HALF = 128, HTB = HALF * BK * 2  , STAGE_BYTES = 8 * HTB, NXCD = 8, WGM = 8;

__host__ __device__ __forceinline__ int lds_byte(int r, int c) { const int st = (r >> 4) * 2 + (c >> 5), rr = r & 15, cc = c & 31, ob = rr * 64 + cc * 2; return st * 1024 + (ob ^ (((ob >> 9) & 1) << 5)); }
__host__ __device__ __forceinline__ void stage_rc(int b, int& R, int& C) { const int st = b / 1024, sb = b % 1024, swz = sb ^ (((sb >> 9) & 1) << 5); R = (st >> 1) * 16 + swz / 64; C = (st & 1) * 32 + (swz % 64) / 2; }
__host__ __device__ __forceinline__ int perm32(int rho) { const int n = rho >> 4, i = rho & 15; return 8 * (i >> 2) + 4 * n + (i & 3); }

struct Unit { int pm, pn, ks; };
struct Gemm { const bf16_t* A; const bf16_t* Bt; int M, N, K, ld; };

struct StaticOrder {
    int nM, nN, nwg, G, c;
    __host__ __device__ void init(int M, int N, int G_, int c_) { nM = M / BM; nN = N / BM; nwg = nM * nN; G = G_; c = c_; }
    __host__ __device__ bool next(int i, Unit& u) const {
        const long L = (long)i * G + c; if (L >= nwg) return false;
        int wgid = (int)L; { const int q = nwg / NXCD, r = nwg % NXCD, xcd = wgid % NXCD, off = wgid / NXCD; wgid = (xcd < r ? xcd * (q + 1) : r * (q + 1) + (xcd - r) * q) + off; }
        const int nig = WGM * nN, gid = wgid / nig, fm = gid * WGM, gsz = (nM - fm) < WGM ? (nM - fm) : WGM;
        u.pm = fm + ((wgid % nig) % gsz); u.pn = (wgid % nig) / gsz; u.ks = 0; return true;
    }
    __device__ __forceinline__ const char* abase(const Gemm& g, const Unit& u, size_t tstep) const { return (const char*)g.A + (size_t)u.pm * tstep; }
    __device__ __forceinline__ const char* bbase(const Gemm& g, const Unit& u, size_t tstep) const { return (const char*)g.Bt + (size_t)u.pn * tstep; }
    __device__ __forceinline__ void a_ready(const Unit&) const {}
    __device__ __forceinline__ void done(const Unit&) const {}
};

__device__ __forceinline__ unsigned cvt_pk_bf16(float lo, float hi) { unsigned r; asm volatile("v_cvt_pk_bf16_f32 %0, %1, %2" : "=v"(r) : "v"(lo), "v"(hi)); return r; }
typedef float f32x2 __attribute__((ext_vector_type(2)));
__device__ __forceinline__ f32x2 gelu_pk(f32x2 v) {
    const f32x2 av = __builtin_elementwise_abs(v), d = av * 0.2316418882f + 1.0f;
    f32x2 t; t.x = __builtin_amdgcn_rcpf(d.x); t.y = __builtin_amdgcn_rcpf(d.y);
    f32x2 q = t * 0.5307027145f + (-0.7265760135f); q = q * t + 0.7107068705f; q = q * t + (-0.142248368f); q = q * t + 0.127414796f; q = q * t;
    const f32x2 s = (v * v) * (-0.72134752044f);
    f32x2 e; e.x = __builtin_amdgcn_exp2f(s.x); e.y = __builtin_amdgcn_exp2f(s.y);
    const f32x2 m = v * (q * e), r = v - m;
    f32x2 o; o.x = v.x < 0.f ? m.x : r.x; o.y = v.y < 0.f ? m.y : r.y; return o;
}

template <int ACT  > struct EpiBf16 {
    static constexpr bool PERM = true, AFTER_DRAIN = false; static_assert(ACT == 0 || ACT == 1, "EpiBf16: ACT is 0 (none) or 1 (gelu_pk)");
    bf16_t* O; int ldc; const float* bias; int split_cols; size_t split_stride; float scale0;
    __device__ __forceinline__ void operator()(const f32x4 (&acc)[2][2][4][2], const Unit& u, int wr, int wc, int fr, int fq) const {
        asm volatile("" : "+v"(fr), "+v"(fq));
        const int row0 = u.pm * BM + wr * 64 + fr; int colt = u.pn * BM; bf16_t* base = O;
        float sc = 1.f; if (split_cols) { const int t = colt / split_cols; base += (size_t)t * split_stride; colt -= t * split_cols; if (t == 0) sc = scale0; }
        const int col0 = colt + wc * 32 + 8 * fq, bcol0 = u.pn * BM + wc * 32 + 8 * fq;
        f32x4 bv[2][2];
#pragma unroll
        for (int bj = 0; bj < 2; ++bj)
#pragma unroll
            for (int n = 0; n < 2; ++n) bv[bj][n] = bias ? *(const f32x4*)(bias + bcol0 + bj * HALF + 4 * n) : (f32x4){0.f, 0.f, 0.f, 0.f};
#pragma unroll
        for (int ai = 0; ai < 2; ++ai)
#pragma unroll
            for (int m = 0; m < 4; ++m) { bf16_t* rowp = base + (size_t)(row0 + ai * HALF + m * 16) * ldc + col0;
#pragma unroll
                for (int bj = 0; bj < 2; ++bj) { f32x4 v0 = acc[ai][bj][m][0] + bv[bj][0], v1 = acc[ai][bj][m][1] + bv[bj][1];
                    if (ACT == 1) { f32x2 a = gelu_pk((f32x2){v0[0], v0[1]}), b = gelu_pk((f32x2){v0[2], v0[3]}), c = gelu_pk((f32x2){v1[0], v1[1]}), d = gelu_pk((f32x2){v1[2], v1[3]});
                        v0 = (f32x4){a.x, a.y, b.x, b.y}; v1 = (f32x4){c.x, c.y, d.x, d.y}; }
                    v0 = v0 * sc; v1 = v1 * sc; u32x4 w; w.x = cvt_pk_bf16(v0[0], v0[1]); w.y = cvt_pk_bf16(v0[2], v0[3]); w.z = cvt_pk_bf16(v1[0], v1[1]); w.w = cvt_pk_bf16(v1[2], v1[3]);
                    *(u32x4*)(rowp + bj * HALF) = w; } }
    }
};
typedef int i32x4 __attribute__((ext_vector_type(4)));
template <bool I8> __device__ __forceinline__ f32x4 mma16(bf16x8 b, bf16x8 a, f32x4 c) { return __builtin_amdgcn_mfma_f32_16x16x32_bf16(b, a, c, 0, 0, 0); }
template <bool I8> __device__ __forceinline__ i32x4 mma16(bf16x8 b, bf16x8 a, i32x4 c) { return __builtin_amdgcn_mfma_i32_16x16x64_i8(__builtin_bit_cast(i32x4, b), __builtin_bit_cast(i32x4, a), c, 0, 0, 0); }
struct EpiF32 {
    static constexpr bool PERM = false, AFTER_DRAIN = false;
    float* C; int ldc; int accum;
    __device__ __forceinline__ void operator()(const f32x4 (&acc)[2][2][4][2], const Unit& u, int wr, int wc, int fr, int fq) const {
        asm volatile("" : "+v"(fr), "+v"(fq));
        const int row0 = u.pm * BM + wr * 64 + fr, col0 = u.pn * BM + wc * 32 + 4 * fq;
#pragma unroll
        for (int ai = 0; ai < 2; ++ai)
#pragma unroll
            for (int m = 0; m < 4; ++m) { float* rowp = C + (size_t)(row0 + ai * HALF + m * 16) * ldc + col0;
#pragma unroll
                for (int bj = 0; bj < 2; ++bj)
#pragma unroll
                    for (int n = 0; n < 2; ++n) { f32x4 v = acc[ai][bj][m][n]; if (accum) v += *(const f32x4*)(rowp + bj * HALF + n * 16); *(f32x4*)(rowp + bj * HALF + n * 16) = v; } }
    }
};
struct EpiSwiGLU {
    static constexpr bool PERM = true, AFTER_DRAIN = false;
    bf16_t* O; int ldo; const float* rowscale; int rs_stride;
    __device__ __forceinline__ void operator()(const f32x4 (&acc)[2][2][4][2], const Unit& u, int wr, int wc, int fr, int fq) const {
        asm volatile("" : "+v"(fr), "+v"(fq));
        typedef unsigned u32x2v __attribute__((ext_vector_type(2)));
        const int row0 = u.pm * BM + wr * 64 + fr; const int ch0 = (u.pn * BM + wc * 32 + 8 * fq) >> 1;
#pragma unroll
        for (int ai = 0; ai < 2; ++ai)
#pragma unroll
            for (int m = 0; m < 4; ++m) { const int row = row0 + ai * HALF + m * 16; bf16_t* rowp = O + (size_t)row * ldo + ch0;
                const float rs = rowscale ? rowscale[(size_t)row * rs_stride] : 1.f;
#pragma unroll
                for (int bj = 0; bj < 2; ++bj) { const f32x4 a = acc[ai][bj][m][0], b = acc[ai][bj][m][1]; f32x4 o;
#pragma unroll
                    for (int i = 0; i < 4; ++i) o[i] = a[i] * __builtin_amdgcn_rcpf(1.f + __expf(-a[i])) * b[i] * rs;
                    u32x2v w; w.x = cvt_pk_bf16(o[0], o[1]); w.y = cvt_pk_bf16(o[2], o[3]);
                    *(u32x2v*)(rowp + bj * (HALF / 2)) = w; } }
    }
};

struct MoeOrder : StaticOrder {
    int pb1, pb2, pb3, pb4, pb5, pb6, pb7; size_t estride;
    __device__ __forceinline__ const char* bbase(const Gemm& g, const Unit& u, size_t tstep) const {
        const int e = (u.pm >= pb1) + (u.pm >= pb2) + (u.pm >= pb3) + (u.pm >= pb4) + (u.pm >= pb5) + (u.pm >= pb6) + (u.pm >= pb7);
        return (const char*)(g.Bt + (size_t)e * estride) + (size_t)u.pn * tstep; }
};
struct SplitOrder {
    int nM, nN, S, G, c, pm0; int pb1, pb2, pb3, pb4, pb5, pb6, pb7; size_t estride;
    __device__ __forceinline__ bool next(int i, Unit& u) const { const int L = i * G + c; if (L >= nM * nN * S) return false; u.ks = L % S; const int t = L / S; u.pn = t % nN; u.pm = pm0 + t / nN; return true; }
    __device__ __forceinline__ const char* abase(const Gemm& g, const Unit& u, size_t tstep) const { return (const char*)g.A + (size_t)u.pm * tstep + (size_t)u.ks * g.K * 2; }
    __device__ __forceinline__ const char* bbase(const Gemm& g, const Unit& u, size_t tstep) const {
        const int e = estride ? (u.pm >= pb1) + (u.pm >= pb2) + (u.pm >= pb3) + (u.pm >= pb4) + (u.pm >= pb5) + (u.pm >= pb6) + (u.pm >= pb7) : 0;
        return (const char*)(g.Bt + (size_t)e * estride) + (size_t)u.pn * tstep + (size_t)u.ks * g.K * 2; }
    __device__ __forceinline__ void a_ready(const Unit&) const {}
    __device__ __forceinline__ void done(const Unit&) const {}
};
struct EpiPart {
    static constexpr bool PERM = false, AFTER_DRAIN = false;
    float* C; int ldc; size_t pstride; int pm0;
    __device__ __forceinline__ void operator()(const f32x4 (&acc)[2][2][4][2], const Unit& u, int wr, int wc, int fr, int fq) const {
        asm volatile("" : "+v"(fr), "+v"(fq));
        const int row0 = (u.pm - pm0) * BM + wr * 64 + fr, col0 = u.pn * BM + wc * 32 + 4 * fq; float* base = C + (size_t)u.ks * pstride;
#pragma unroll
        for (int ai = 0; ai < 2; ++ai)
#pragma unroll
            for (int m = 0; m < 4; ++m) { float* rowp = base + (size_t)(row0 + ai * HALF + m * 16) * ldc + col0;
#pragma unroll
                for (int bj = 0; bj < 2; ++bj)
#pragma unroll
                    for (int n = 0; n < 2; ++n) *(f32x4*)(rowp + bj * HALF + n * 16) = acc[ai][bj][m][n]; }
    }
};

struct EpiSwiGLU8 {
    static constexpr bool PERM = true, AFTER_DRAIN = false;
    bf16_t* O; int ldo; const float* rowscale; const float* sa; const unsigned* amax; int pb1, pb2, pb3, pb4, pb5, pb6, pb7;
    __device__ __forceinline__ void operator()(const i32x4 (&acc)[2][2][4][2], const Unit& u, int wr, int wc, int fr, int fq) const {
        typedef unsigned u32x2v __attribute__((ext_vector_type(2))); typedef unsigned u32x4v __attribute__((ext_vector_type(4)));
        asm volatile("" : "+v"(fr), "+v"(fq));
        const int row0 = u.pm * BM + wr * 64 + fr; const int cb0 = u.pn * BM + wc * 32 + 8 * fq; const int ch0 = cb0 >> 1;
        const int e = (u.pm >= pb1) + (u.pm >= pb2) + (u.pm >= pb3) + (u.pm >= pb4) + (u.pm >= pb5) + (u.pm >= pb6) + (u.pm >= pb7);
        const unsigned* am = amax + (size_t)e * 2 * 3584 + cb0;
#pragma unroll
        for (int bj = 0; bj < 2; ++bj) {
            const float* amf = (const float*)am + bj * HALF;
            const f32x4 sb0 = *(const f32x4*)amf * (1.f / 127.f), sb1 = *(const f32x4*)(amf + 4) * (1.f / 127.f);
#pragma unroll
            for (int ai = 0; ai < 2; ++ai)
#pragma unroll
                for (int m = 0; m < 4; ++m) { const int row = row0 + ai * HALF + m * 16; bf16_t* rowp = O + (size_t)row * ldo + ch0 + bj * (HALF / 2);
                    const float sr = sa[row], rs = rowscale ? rowscale[row] : 1.f; f32x4 o;
#pragma unroll
                    for (int i = 0; i < 4; ++i) { const float a = (float)acc[ai][bj][m][0][i] * sr * sb0[i], b = (float)acc[ai][bj][m][1][i] * sr * sb1[i];
                        o[i] = a * __builtin_amdgcn_rcpf(1.f + __expf(-a)) * b * rs; }
                    u32x2v w; w.x = cvt_pk_bf16(o[0], o[1]); w.y = cvt_pk_bf16(o[2], o[3]);
                    *(u32x2v*)rowp = w;
#if PROBE_DUP & 128
                    if (dbg && row < 4096) { f32x4 av, bv;
#pragma unroll
                        for (int i = 0; i < 4; ++i) { av[i] = (float)acc[ai][bj][m][0][i] * sr * sb0[i]; bv[i] = (float)acc[ai][bj][m][1][i] * sr * sb1[i]; }
                        *(f32x4*)((float*)dbg + (size_t)row * ldo + (rowp - (O + (size_t)row * ldo))) = av; *(f32x4*)((float*)dbg + (size_t)4096 * ldo + (size_t)row * ldo + (rowp - (O + (size_t)row * ldo))) = bv; }
#endif
                    } }
    }
#if PROBE_DUP & 128
    int* dbg = nullptr;
#endif
};

struct EpiBf16S8 {
    static constexpr bool PERM = true, AFTER_DRAIN = false;
    bf16_t* O; int ldc; const float* sa; const float* amax;
    __device__ __forceinline__ void operator()(const i32x4 (&acc)[2][2][4][2], const Unit& u, int wr, int wc, int fr, int fq) const {
        asm volatile("" : "+v"(fr), "+v"(fq));
        const int row0 = u.pm * BM + wr * 64 + fr, col0 = u.pn * BM + wc * 32 + 8 * fq;
#pragma unroll
        for (int bj = 0; bj < 2; ++bj) { const f32x4 s0 = *(const f32x4*)(amax + col0 + bj * HALF) * (1.f / 127.f), s1 = *(const f32x4*)(amax + col0 + bj * HALF + 4) * (1.f / 127.f);
#pragma unroll
            for (int ai = 0; ai < 2; ++ai)
#pragma unroll
                for (int m = 0; m < 4; ++m) { const int row = row0 + ai * HALF + m * 16; const float sr = sa[row]; f32x4 v0, v1;
#pragma unroll
                    for (int i = 0; i < 4; ++i) { v0[i] = (float)acc[ai][bj][m][0][i] * sr * s0[i]; v1[i] = (float)acc[ai][bj][m][1][i] * sr * s1[i]; }
                    u32x4 w; w.x = cvt_pk_bf16(v0[0], v0[1]); w.y = cvt_pk_bf16(v0[2], v0[3]); w.z = cvt_pk_bf16(v1[0], v1[1]); w.w = cvt_pk_bf16(v1[2], v1[3]);
                    *(u32x4*)(O + (size_t)row * ldc + col0 + bj * HALF) = w; } }
    }
};
struct EpiPartS8 {
    static constexpr bool PERM = false, AFTER_DRAIN = false;
    float* C; int ldc; size_t pstride; int pm0; const float* sa; const float* amax;
    __device__ __forceinline__ void operator()(const i32x4 (&acc)[2][2][4][2], const Unit& u, int wr, int wc, int fr, int fq) const {
        asm volatile("" : "+v"(fr), "+v"(fq));
        const int row0 = (u.pm - pm0) * BM + wr * 64 + fr, col0 = u.pn * BM + wc * 32 + 4 * fq; float* base = C + (size_t)u.ks * pstride;
#pragma unroll
        for (int bj = 0; bj < 2; ++bj)
#pragma unroll
            for (int n = 0; n < 2; ++n) { const f32x4 sc = *(const f32x4*)(amax + col0 + bj * HALF + n * 16) * (1.f / 127.f);
#pragma unroll
                for (int ai = 0; ai < 2; ++ai)
#pragma unroll
                    for (int m = 0; m < 4; ++m) { const int rl = row0 + ai * HALF + m * 16; const float sr = sa[rl + pm0 * BM]; f32x4 v;
#pragma unroll
                        for (int i = 0; i < 4; ++i) v[i] = (float)acc[ai][bj][m][n][i] * sr * sc[i];
                        *(f32x4*)(base + (size_t)rl * ldc + col0 + bj * HALF + n * 16) = v; } }
    }
};
template <bool I8> struct AccSel { typedef f32x4 type; }; template <> struct AccSel<true> { typedef i32x4 type; };
template <class Epi, class Sched, bool ALIGN_EPI = false, bool SP2 = false, bool I8 = false>
__device__ __forceinline__ void gemm_phase(PG8_LAS unsigned char* lds, const Gemm g, const Sched& S, const Epi& E) {
    int tid_o = threadIdx.x; asm volatile("" : "+v"(tid_o));
    const int tid = tid_o, wid = __builtin_amdgcn_readfirstlane(tid >> 6), lane = tid & 63, wr = wid >> 2, wc = wid & 3, fr = lane & 15, fq = lane >> 4;
    const int K = g.K, nt = K / BK;
    unsigned voffA[2], voffB[2];
#pragma unroll
    for (int i = 0; i < 2; ++i) { int R, C; stage_rc(tid * 16 + i * 8192, R, C); const int Rb = Epi::PERM ? ((R & ~31) + perm32(R & 31)) : R;
        voffA[i] = (unsigned)(R * g.ld + C) * 2u; voffB[i] = (unsigned)(Rb * g.ld + C) * 2u; }
    const size_t kstep = (size_t)(BK * 2);
    const size_t hstep = (size_t)HALF * g.ld * 2;
    const size_t tstep = 2 * hstep;
    const unsigned ldsw = (unsigned)wid * 1024u;
    const int aoff = lds_byte(wr * 64 + fr, fq * 8), boff = lds_byte(wc * 32 + fr, fq * 8);
#define PG8_SA(b, h) (((b) * 2 + (h)) * HTB)
#define PG8_SB(b, h) ((4 + (b) * 2 + (h)) * HTB)
#define PG8_STAGE(bufoff, gbase, voff) do { _Pragma("unroll") for (int _i = 0; _i < 2; ++_i) \
        __builtin_amdgcn_global_load_lds((const unsigned*)((const char*)(gbase) + (voff)[_i]), (PG8_LAS unsigned*)(lds + (bufoff) + ldsw + _i * 8192), 16, 0, 0); } while (0)
#define PG8_LDA(dst, b, h) do { _Pragma("unroll") for (int m = 0; m < 4; ++m) _Pragma("unroll") for (int k = 0; k < 2; ++k) dst[m][k] = *(const PG8_LAS bf16x8*)(lds + PG8_SA(b, h) + aoff + m * 2048 + k * 1024); } while (0)
#define PG8_LDB(dst, b, h) do { _Pragma("unroll") for (int n = 0; n < 2; ++n) _Pragma("unroll") for (int k = 0; k < 2; ++k) dst[n][k] = *(const PG8_LAS bf16x8*)(lds + PG8_SB(b, h) + boff + n * 2048 + k * 1024); } while (0)
#define PG8_MMA(ai, bj, At, Bt) do { __builtin_amdgcn_s_setprio(1); _Pragma("unroll") for (int k = 0; k < 2; ++k) _Pragma("unroll") for (int m = 0; m < 4; ++m) _Pragma("unroll") for (int n = 0; n < 2; ++n) \
        acc[ai][bj][m][n] = mma16<I8>(Bt[n][k], At[m][k], acc[ai][bj][m][n]); __builtin_amdgcn_s_setprio(0); } while (0)
#define PG8_WAIT_V(n) asm volatile("s_waitcnt vmcnt(" #n ")" ::: "memory")
#define PG8_WAIT_L(n) asm volatile("s_waitcnt lgkmcnt(" #n ")" ::: "memory")
#define PG8_BAR __builtin_amdgcn_s_barrier()
#define PG8_SCHED __builtin_amdgcn_sched_barrier(0)
    Unit cur, nxt; int ui = 0;
    if (!S.next(0, cur)) return;
    typedef typename AccSel<I8>::type AccT; AccT acc[2][2][4][2];
#pragma unroll
    for (int a = 0; a < 2; ++a)
#pragma unroll
        for (int b = 0; b < 2; ++b)
#pragma unroll
            for (int m = 0; m < 4; ++m)
#pragma unroll
                for (int n = 0; n < 2; ++n) acc[a][b][m][n] = (AccT)(0);
    bf16x8 At[4][2], B0[2][2], B1[2][2];
    const char* cA = S.abase(g, cur, tstep); const char* cB = S.bbase(g, cur, tstep);
    S.a_ready(cur);
    if constexpr (SP2) {
        PG8_STAGE(PG8_SB(0, 0), cB, voffB); PG8_STAGE(PG8_SB(0, 1), cB + hstep, voffB); PG8_STAGE(PG8_SA(0, 0), cA, voffA); PG8_STAGE(PG8_SA(0, 1), cA + hstep, voffA);
        if (wr == 1) PG8_BAR;
        PG8_WAIT_V(2); PG8_BAR;
        PG8_STAGE(PG8_SB(1, 0), cB + kstep, voffB); PG8_STAGE(PG8_SA(1, 0), cA + kstep, voffA); PG8_STAGE(PG8_SB(1, 1), cB + hstep + kstep, voffB);
        PG8_WAIT_V(6); PG8_BAR;
    } else {
        PG8_STAGE(PG8_SB(0, 0), cB, voffB); PG8_STAGE(PG8_SA(0, 0), cA, voffA); PG8_STAGE(PG8_SB(0, 1), cB + hstep, voffB); PG8_STAGE(PG8_SA(0, 1), cA + hstep, voffA);
        if (wr == 1) PG8_BAR;
        PG8_WAIT_V(4); PG8_BAR;
        PG8_STAGE(PG8_SB(1, 0), cB + kstep, voffB); PG8_STAGE(PG8_SA(1, 0), cA + kstep, voffA); PG8_STAGE(PG8_SB(1, 1), cB + hstep + kstep, voffB);
        PG8_WAIT_V(6); PG8_BAR;
    }
    for (;;) {
        const bool has_next = S.next(ui + 1, nxt);
        const char* nA = has_next ? S.abase(g, nxt, tstep) : cA; const char* nB = has_next ? S.bbase(g, nxt, tstep) : cB;
        for (int t = 0; t < nt; t += 2) {
            const bool last = (t == nt - 2);
            const char* a1 = cA + (size_t)(t + 1) * kstep;
            const char* a2 = last ? nA : cA + (size_t)(t + 2) * kstep; const char* b2 = last ? nB : cB + (size_t)(t + 2) * kstep;
            const char* a3 = a2 + kstep; const char* b3 = b2 + kstep;
            if (last && has_next) S.a_ready(nxt);
            if constexpr (SP2) {
            PG8_LDB(B0, 0, 0); PG8_LDB(B1, 0, 1); PG8_SCHED; PG8_LDA(At, 0, 0); PG8_STAGE(PG8_SA(1, 1), a1 + hstep, voffA);
            PG8_WAIT_V(8); PG8_WAIT_L(0); PG8_BAR; PG8_MMA(0, 0, At, B0); PG8_MMA(0, 1, At, B1); PG8_BAR; PG8_SCHED;
            PG8_LDA(At, 0, 1); PG8_STAGE(PG8_SB(0, 0), b2, voffB); PG8_STAGE(PG8_SB(0, 1), b2 + hstep, voffB); PG8_STAGE(PG8_SA(0, 0), a2, voffA);
            PG8_WAIT_V(8); PG8_WAIT_L(0); PG8_BAR; PG8_MMA(1, 0, At, B0); PG8_MMA(1, 1, At, B1); PG8_BAR; PG8_SCHED;
            PG8_LDB(B0, 1, 0); PG8_LDB(B1, 1, 1); PG8_SCHED; PG8_LDA(At, 1, 0); PG8_STAGE(PG8_SA(0, 1), a2 + hstep, voffA);
            PG8_WAIT_V(8); PG8_WAIT_L(0); PG8_BAR; PG8_MMA(0, 0, At, B0); PG8_MMA(0, 1, At, B1); PG8_BAR; PG8_SCHED;
            PG8_LDA(At, 1, 1); PG8_STAGE(PG8_SB(1, 0), b3, voffB); PG8_STAGE(PG8_SB(1, 1), b3 + hstep, voffB); PG8_STAGE(PG8_SA(1, 0), a3, voffA);
            PG8_WAIT_V(8); PG8_WAIT_L(0); PG8_BAR; PG8_MMA(1, 0, At, B0); PG8_MMA(1, 1, At, B1); PG8_BAR; PG8_SCHED;
            } else {
            PG8_LDB(B0, 0, 0); PG8_SCHED; PG8_LDA(At, 0, 0); PG8_STAGE(PG8_SA(1, 1), a1 + hstep, voffA);
            PG8_WAIT_L(8); PG8_BAR; PG8_WAIT_L(0); PG8_MMA(0, 0, At, B0); PG8_BAR; PG8_SCHED;
            PG8_LDB(B1, 0, 1); PG8_STAGE(PG8_SB(0, 0), b2, voffB);
            PG8_BAR; PG8_WAIT_L(0); PG8_MMA(0, 1, At, B1); PG8_BAR;
            PG8_LDA(At, 0, 1); PG8_STAGE(PG8_SA(0, 0), a2, voffA);
            PG8_BAR; PG8_WAIT_L(0); PG8_MMA(1, 0, At, B0); PG8_BAR; PG8_SCHED;
            PG8_STAGE(PG8_SB(0, 1), b2 + hstep, voffB);
            PG8_WAIT_V(6); PG8_BAR; PG8_MMA(1, 1, At, B1); PG8_BAR;
            PG8_LDB(B0, 1, 0); PG8_SCHED; PG8_LDA(At, 1, 0); PG8_STAGE(PG8_SA(0, 1), a2 + hstep, voffA);
            PG8_WAIT_L(8); PG8_BAR; PG8_WAIT_L(0); PG8_MMA(0, 0, At, B0); PG8_BAR; PG8_SCHED;
            PG8_LDB(B1, 1, 1); PG8_STAGE(PG8_SB(1, 0), b3, voffB);
            PG8_BAR; PG8_WAIT_L(0); PG8_MMA(0, 1, At, B1); PG8_BAR;
            PG8_LDA(At, 1, 1); PG8_STAGE(PG8_SA(1, 0), a3, voffA);
            PG8_BAR; PG8_WAIT_L(0); PG8_MMA(1, 0, At, B0); PG8_BAR; PG8_SCHED;
            PG8_STAGE(PG8_SB(1, 1), b3 + hstep, voffB);
            PG8_WAIT_V(6); PG8_BAR; PG8_MMA(1, 1, At, B1); PG8_BAR;
            }
        }
        if constexpr (ALIGN_EPI) { if (wr == 0) PG8_BAR; }
        if constexpr (!Epi::AFTER_DRAIN) { E(acc, cur, wr, wc, fr, fq); S.done(cur); }
        if (!has_next) break;
#pragma unroll
        for (int a = 0; a < 2; ++a)
#pragma unroll
            for (int b = 0; b < 2; ++b)
#pragma unroll
                for (int m = 0; m < 4; ++m)
#pragma unroll
                    for (int n = 0; n < 2; ++n) acc[a][b][m][n] = (AccT)(0);
        cur = nxt; cA = nA; cB = nB; ++ui;
        if constexpr (ALIGN_EPI) { if (wr == 1) PG8_BAR; }
    }
    PG8_WAIT_V(0);
    if constexpr (!ALIGN_EPI) { if (wr == 0) PG8_BAR; }
    PG8_BAR;
    if constexpr (Epi::AFTER_DRAIN) { E.fused(acc, cur, wr, wc, fr, fq, lds, wid, lane); S.done(cur); }
#undef PG8_SA
#undef PG8_SB
#undef PG8_STAGE
#undef PG8_LDA
#undef PG8_LDB
#undef PG8_MMA
#undef PG8_WAIT_V
#undef PG8_WAIT_L
#undef PG8_BAR
#undef PG8_SCHED
}
}

constexpr int NWAVES = 8;
constexpr int D = 1024, NB = 4, SEQ = 4096, CTXL = 256, NLAT = NB * SEQ, NCTX = NB * CTXL, MROWS = NLAT + NCTX;
constexpr int DEPTH = 4, RW = 512, NH = 8, HS = 64, DFF = 3584, NE = 8, NPROJ = 3456, NP = 3584, NLO = 2560, KLA = 512, NMOD = 6144;
constexpr int PC_R = 0, PC_K = 512, PC_V = 1024, PC_CB = 1536, PC_CC = 2048, PC_CH = 2560, PC_WD = 3072, PC_AD = 3200, PC_GD = 3328;
constexpr float LN_EPS = 1e-5f, GN_EPS = 64e-5f, DN_ALPHA = 1.681792830507429f;
enum { I_X = 0, I_C, I_CTX, I_CCTX, I_WMOD, I_BMOD, I_WIN, I_W0, I_W2, I_A0, I_A2, I_KK, I_KA, I_RK, I_G2, I_LNXG, I_LNXB, I_CONVW, I_WOUT, I_LN1G, I_LN1B, I_LN2G, I_LN2B,
       I_FW1, I_FW3, I_FW2, I_RTW, I_RTB, I_MW1, I_MW3, I_MW2, N_IN };

constexpr size_t MiB = 1u << 20;
constexpr size_t WS_CTL = 0, CTL_BYTES = 3 * MiB;
constexpr size_t WS_MODV = 1 * MiB;
constexpr size_t WS_AMAX = 2 * MiB;
constexpr size_t WS_RKS = 3 * MiB;
constexpr size_t WS_WIN = 4 * MiB;
constexpr size_t WS_WOUT = WS_WIN + 28 * MiB;
constexpr size_t WS_LORA = WS_WOUT + 8 * MiB;
constexpr size_t WS_F13 = WS_LORA + 10 * MiB;
constexpr size_t WS_F2 = WS_F13 + 28 * MiB;
constexpr size_t WS_X = WS_F2 + 14 * MiB;
constexpr size_t WS_H = WS_X + 68 * MiB;
constexpr size_t WS_MOES = WS_H + 34 * MiB;
constexpr size_t WS_ROWLIST = WS_MOES;
constexpr size_t WS_TOKSEL = WS_MOES + 640 * 1024;
constexpr size_t WS_WSEL = WS_TOKSEL + 320 * 1024;
constexpr size_t WS_WSORT = WS_WSEL + 192 * 1024;
constexpr size_t WS_MOEW13 = WS_MOES + 2 * MiB;
constexpr size_t WS_MOEW2 = WS_MOEW13 + 112 * MiB;
constexpr size_t WS_H8 = WS_MOEW13 + 56 * MiB;
constexpr size_t WS_SA = WS_H8 + 17 * MiB;
constexpr size_t WS_SAM = WS_SA + 512 * 1024;
constexpr size_t WS_SAG = WS_SA + 1 * MiB;
constexpr size_t WS_SCR = WS_MOEW2 + 56 * MiB;
constexpr size_t WS_P = WS_SCR;
constexpr size_t WS_LO = WS_P + 119 * MiB;
constexpr size_t WS_PREP = WS_LO + 170 * MiB;
constexpr size_t WS_Y = WS_PREP + 213 * MiB;
constexpr size_t WS_MIXIN = WS_Y + 68 * MiB;
constexpr size_t WS_CH = WS_PREP;
constexpr size_t WS_MIXO = WS_PREP;
constexpr size_t WS_MIXP = WS_PREP + 34 * MiB;
constexpr size_t WS_END_MIXER = WS_MIXIN + 34 * MiB;
constexpr size_t WS_HG = WS_SCR;
constexpr size_t WS_ACT = WS_HG + 72 * MiB;
constexpr size_t WS_F = WS_ACT + 252 * MiB;
constexpr size_t WS_FP = WS_F + 72 * MiB;
constexpr size_t WS_END_FFN = WS_FP + 64 * MiB;
constexpr size_t WS_NEED = WS_END_MIXER > WS_END_FFN ? WS_END_MIXER : WS_END_FFN;
static_assert((size_t)MROWS * NP * 2 <= 119 * MiB && (size_t)MROWS * NLO * 4 <= 170 * MiB && (size_t)8704 * 25600 <= 213 * MiB && (size_t)MROWS * D * 4 <= 68 * MiB && WS_NEED <= 990 * MiB, "ws map");
constexpr int MOE_MAIN_PANELS = 128, MOE_TAIL_ROWS = 4096;
constexpr int MOE_ROWS = 36864;
constexpr int AM_IN = 18 * 2 * DFF, AM_OUT = AM_IN + DEPTH * NP;
constexpr int LORAW_PER_LAYER = 4 * 512 * 64 + 512 * 128;
constexpr int CW_BAR = 4096, CW_GCNT = 8192, CW_CQ = 12288, CW_SDONE = 12544;

constexpr int RING_BYTES = 131072, LDSCTL_OFF = RING_BYTES, MISC_OFF = LDSCTL_OFF + 320, LDS_BYTES = 147456;

typedef unsigned short bf16;
typedef unsigned v4u __attribute__((ext_vector_type(4)));
typedef unsigned v2u __attribute__((ext_vector_type(2)));
typedef float f32x4 __attribute__((ext_vector_type(4)));
#define LAS __attribute__((address_space(3)))
#define LDS_WAIT() asm volatile("s_waitcnt lgkmcnt(0)" ::: "memory")
__device__ __forceinline__ unsigned f2bf(float f) { unsigned u = __builtin_bit_cast(unsigned, f); return (u + 0x7fffu + ((u >> 16) & 1u)) >> 16; }
__device__ __forceinline__ unsigned pk2(float lo, float hi) { return f2bf(lo) | (f2bf(hi) << 16); }
__device__ __forceinline__ float bf2f(unsigned short b) { return __builtin_bit_cast(float, ((unsigned)b) << 16); }
__device__ __forceinline__ float bflo(unsigned w) { return __builtin_bit_cast(float, w << 16); }
__device__ __forceinline__ float bfhi(unsigned w) { return __builtin_bit_cast(float, w & 0xffff0000u); }
__device__ __forceinline__ float wave_sum(float v) {
#pragma unroll
    for (int o = 1; o < 64; o <<= 1) v += __shfl_xor(v, o);
    return v;
}
__device__ __forceinline__ float sigm(float x) { return 1.f / (1.f + __expf(-x)); }

#define XB_TMO      128
#define XB_XCNT(j)  (256  + 64 * (j))
#define XB_XSUB(j)  (1280 + 64 * (j))
#define XB_XGEN(j)  (2304 + 64 * (j))
#define XB_TOP      3328
#define XB_TOPGEN   3392
#define XCD_BAR_WORDS 3456
#define XB_SPIN_CAP (1u << 18)

__device__ __forceinline__ unsigned xb_ld(unsigned* p)              { return __hip_atomic_load(p, __ATOMIC_RELAXED, __HIP_MEMORY_SCOPE_AGENT); }
__device__ __forceinline__ unsigned xb_add(unsigned* p, unsigned v) { return __hip_atomic_fetch_add(p, v, __ATOMIC_RELAXED, __HIP_MEMORY_SCOPE_AGENT); }
__device__ __forceinline__ unsigned xb_xcc_id() { return (unsigned)__builtin_amdgcn_s_getreg((3 << 11) | 20) & 0xFu; }
#define XB_SPIN(cond, bar) do { unsigned _sp = 0; while (cond) { __builtin_amdgcn_s_sleep(1); \
    if ((++_sp & 255u) == 0u) { if (xb_ld(&(bar)[XB_TMO])) break; if (_sp > XB_SPIN_CAP) { atomicAdd(&(bar)[XB_TMO], 1u); break; } } } } while (0)

struct XcdBarrier {
    unsigned* bar; unsigned x;
    volatile LAS unsigned* st;
};

__device__ __forceinline__ XcdBarrier xcd_barrier_post(unsigned* bar, volatile LAS unsigned* st) {
    XcdBarrier b; b.bar = bar; b.x = xb_xcc_id(); b.st = st;
    if (threadIdx.x == 0) (void)xb_add(&bar[XB_XCNT(b.x)], 1u);
    return b;
}
__device__ __forceinline__ void xcd_barrier_complete(unsigned* bar, unsigned x, unsigned& nloc, unsigned& nx) {
    const unsigned G = gridDim.x * gridDim.y * gridDim.z;
    unsigned sum, cnt, mine, sp = 0u;
    for (;;) {
        sum = 0u; cnt = 0u; mine = 0u;
#pragma unroll
        for (unsigned j = 0; j < 16; ++j) { const unsigned c = xb_ld(&bar[XB_XCNT(j)]); sum += c; cnt += (c > 0u) ? 1u : 0u; mine = (j == x) ? c : mine; }
        if (sum == G) break;
        __builtin_amdgcn_s_sleep(1);
        if ((++sp & 255u) == 0u) { if (xb_ld(&bar[XB_TMO])) break; if (sp > XB_SPIN_CAP) { atomicAdd(&bar[XB_TMO], 1u); break; } }
    }
    nloc = mine > 0u ? mine : 1u; nx = cnt > 0u ? cnt : 1u;
}

__device__ __forceinline__ void xcd_barrier(const XcdBarrier& b) {
    asm volatile("s_waitcnt vmcnt(0)" ::: "memory");
    __syncthreads();
    if (threadIdx.x == 0) {
        unsigned* bar = b.bar;
        __builtin_amdgcn_s_waitcnt(0);
        unsigned nloc = b.st[0], nx = b.st[1];
        if (nloc == 0u) { xcd_barrier_complete(bar, b.x, nloc, nx); b.st[0] = nloc; b.st[1] = nx; }
        const unsigned old = xb_add(&bar[XB_XSUB(b.x)], 1u);
        const unsigned gen = old / nloc;
        if (old + 1u == (gen + 1u) * nloc) {
            __builtin_amdgcn_fence(__ATOMIC_RELEASE, "agent");
            asm volatile("s_waitcnt vmcnt(0)" ::: "memory");
            const unsigned og = xb_add(&bar[XB_TOP], 1u);
            const unsigned tg = og / nx;
            if (og + 1u == (tg + 1u) * nx) xb_add(&bar[XB_TOPGEN], 1u);
            else XB_SPIN(xb_ld(&bar[XB_TOPGEN]) == tg, bar);
            __builtin_amdgcn_fence(__ATOMIC_ACQUIRE, "agent");
            xb_add(&bar[XB_XGEN(b.x)], 1u);
            asm volatile("s_waitcnt vmcnt(0)" ::: "memory");
        } else {
            XB_SPIN(xb_ld(&bar[XB_XGEN(b.x)]) == gen, bar);
            __builtin_amdgcn_fence(__ATOMIC_ACQUIRE, "agent");
            asm volatile("s_waitcnt vmcnt(0)" ::: "memory");
        }
    }
    __syncthreads();
}


__device__ __forceinline__ size_t opaque_zero() { size_t z = 0; asm volatile("" : "+s"(z)); return z; }
#define OWS (p.ws + opaque_zero())
__device__ __forceinline__ int opaque_zero_i() { int z = 0; asm volatile("" : "+s"(z)); return z; }
#define PIN(i) (p.in[(i) + opaque_zero_i()])
struct KP { const float* in[N_IN]; float* out; unsigned char* ws; int ph; int pad; };

template <int MODE> __device__ __forceinline__ int rowmap(int n, int arg) {
    if (MODE == 0) return n + arg;
    if (MODE == 1) { if (n < 1536) return n; if (n < 1664) return n - 1536 + PC_WD; if (n < 1792) return n - 1664 + PC_AD; if (n < 1920) return n - 1792 + PC_GD;
                     if (n < 2432) return n - 1920 + PC_CB; if (n < 2944) return n - 2432 + PC_CC; return n - 2944 + PC_CH; }
    return 8 * (n >> 2) + 4 * arg + (n & 3);
}
template <int MODE> __device__ __forceinline__ void transpose_item(const float* W, int K, int N, bf16* WT, int arg, LAS float* scr, int item, int lane) {
    const int nblk = N / 32, kb = item / nblk, nb = item % nblk, k0 = 64 * kb, n0 = 32 * nb;
#pragma unroll 8
    for (int i = 0; i < 32; ++i) { const int kk = 2 * i + (lane >> 5); scr[kk * 33 + (lane & 31)] = W[(size_t)(k0 + kk) * N + n0 + (lane & 31)]; }
    LDS_WAIT(); asm volatile("" ::: "memory");
    const int c = lane & 7;
#pragma unroll
    for (int j = 0; j < 4; ++j) { const int n = (lane >> 3) + 8 * j; const LAS float* s = scr + (8 * c) * 33 + n;
        v4u o; o.x = pk2(s[0 * 33], s[1 * 33]); o.y = pk2(s[2 * 33], s[3 * 33]); o.z = pk2(s[4 * 33], s[5 * 33]); o.w = pk2(s[6 * 33], s[7 * 33]);
        *(v4u*)(WT + (size_t)rowmap<MODE>(n0 + n, arg) * K + k0 + 8 * c) = o; }
    LDS_WAIT(); asm volatile("" ::: "memory");
}

__device__ __forceinline__ void ph_modvec(const KP& p, LAS unsigned char* lds, int tid) {
    LAS float* sil = (LAS float*)lds;
    LAS float* red = (LAS float*)(lds + 5 * 1024 * 4);
    const float* c = PIN(I_C); const float* cc = PIN(I_CCTX);
    for (int i = tid; i < 5 * 1024; i += 512) { const float v = i < 4096 ? c[i] : cc[i - 4096]; sil[i] = v / (1.f + __expf(-v)); }
    __syncthreads();
    float* modv = (float*)(OWS + WS_MODV);
    const int ks = tid >> 6, col = tid & 63;
    for (int task = blockIdx.x; task < DEPTH * 96; task += gridDim.x) {
        const int l = task / 96, j0 = (task % 96) * 64;
        const float* w = PIN(I_WMOD) + (size_t)l * D * NMOD + (size_t)(ks * 128) * NMOD + j0 + col;
        float a0 = 0.f, a1 = 0.f, a2 = 0.f, a3 = 0.f, a4 = 0.f;
#pragma unroll 8
        for (int k = 0; k < 128; ++k) { const float wv = w[(size_t)k * NMOD]; const int kk = ks * 128 + k;
            a0 += sil[kk] * wv; a1 += sil[1024 + kk] * wv; a2 += sil[2048 + kk] * wv; a3 += sil[3072 + kk] * wv; a4 += sil[4096 + kk] * wv; }
        red[(ks * 5 + 0) * 64 + col] = a0; red[(ks * 5 + 1) * 64 + col] = a1; red[(ks * 5 + 2) * 64 + col] = a2; red[(ks * 5 + 3) * 64 + col] = a3; red[(ks * 5 + 4) * 64 + col] = a4;
        __syncthreads();
        if (tid < 320) { const int r = tid >> 6; float s = 0.f;
#pragma unroll
            for (int q = 0; q < 8; ++q) s += red[(q * 5 + r) * 64 + col];
            modv[(size_t)(l * 5 + r) * NMOD + j0 + col] = s + PIN(I_BMOD)[l * NMOD + j0 + col]; }
        __syncthreads();
    }
}

__device__ __forceinline__ void ph_convert(const KP& p, LAS unsigned char* lds, int gw, int NGW, int wave, int lane) {
    LAS float* scr = (LAS float*)(lds + wave * 16384);
    bf16* win = (bf16*)(OWS + WS_WIN); bf16* f2 = (bf16*)(OWS + WS_F2); bf16* lora = (bf16*)(OWS + WS_LORA);
    constexpr int I_IN = (D / 64) * (NPROJ / 32), I_OUT = (D / 64) * (D / 32), I_UP = (D / 64) * (DFF / 32), I_DN = (DFF / 64) * (D / 32);
    for (int it = gw; it < I_DN; it += NGW) transpose_item<0>(PIN(I_FW2), DFF, D, f2, 0, scr, it, lane);
    { const int gt = gw * 64 + lane, NGT = NGW * 64; constexpr int PER = (NP - NPROJ) * D / 16;
      for (int i = gt; i < DEPTH * PER; i += NGT) { const int l = i / PER, q = i % PER; *(v4u*)((unsigned char*)win + (size_t)l * NP * D + (size_t)NPROJ * D + (size_t)q * 16) = (v4u){0u, 0u, 0u, 0u}; } }
    { const int gt = gw * 64 + lane, NGT = NGW * 64;
      for (int i = gt; i < DEPTH * LORAW_PER_LAYER / 8; i += NGT) { const int l = i / (LORAW_PER_LAYER / 8); int q = (i % (LORAW_PER_LAYER / 8)) * 8; float v[8];
          int grp, c, k0; if (q < 4 * 512 * 64) { grp = q / (512 * 64); q -= grp * 512 * 64; c = q / 64; k0 = q % 64; } else { grp = 4; q -= 4 * 512 * 64; c = q / 128; k0 = q % 128; }
#pragma unroll
          for (int j = 0; j < 8; ++j) { const int k = k0 + j;
              v[j] = grp < 2 ? PIN(I_W2)[((size_t)(l * 2 + grp) * 64 + k) * RW + c] : grp < 4 ? PIN(I_A2)[((size_t)(l * 2 + grp - 2) * 64 + k) * RW + c] : PIN(I_G2)[((size_t)l * 128 + k) * RW + c]; }
          v4u o; o.x = pk2(v[0], v[1]); o.y = pk2(v[2], v[3]); o.z = pk2(v[4], v[5]); o.w = pk2(v[6], v[7]);
          *(v4u*)(lora + (size_t)i * 8) = o; } }
}
__device__ __forceinline__ void ph_amax(const KP& p, int gw, int NGW, int lane) {
    unsigned* AM = (unsigned*)(OWS + WS_AMAX);
    for (int it = gw; it < 18 * 2 * (DFF / 64); it += NGW) { const int kq = 0, strip = it % (DFF / 64), sm = it / (DFF / 64), s1 = sm & 1, cm = sm >> 1;
        const float* W = cm < 2 ? PIN(s1 ? I_FW3 : I_FW1) + (size_t)cm * D * DFF : PIN(s1 ? I_MW3 : I_MW1) + (size_t)(cm - 2) * D * DFF;
        const int n = strip * 64 + lane; const float* src = W + (size_t)(kq * 256) * DFF + n; float m = 0.f;
#pragma unroll 16
        for (int k = 0; k < 256; ++k) { const float w = src[(size_t)k * DFF]; m += w * w; }
        AM[(size_t)cm * 2 * DFF + 8 * (n >> 2) + 4 * s1 + (n & 3)] = __builtin_bit_cast(unsigned, 4.25f * sqrtf(m * (1.f / 256.f))); }
    for (int it = gw; it < DEPTH * (NPROJ / 64 + D / 64); it += NGW) { const int kq = 0; int t = it; const int l = t / (NPROJ / 64 + D / 64); t -= l * (NPROJ / 64 + D / 64);
        const bool isin = t < NPROJ / 64; const int strip = isin ? t : t - NPROJ / 64, N = isin ? NPROJ : D, n = strip * 64 + lane;
        const float* src = (isin ? PIN(I_WIN) + (size_t)l * D * NPROJ : PIN(I_WOUT) + (size_t)l * D * D) + (size_t)(kq * 256) * N + n; float m = 0.f;
#pragma unroll 16
        for (int k = 0; k < 256; ++k) { const float w = src[(size_t)k * N]; m += w * w; }
        AM[isin ? AM_IN + l * NP + rowmap<1>(n, 0) : AM_OUT + l * D + n] = __builtin_bit_cast(unsigned, 4.25f * sqrtf(m * (1.f / 256.f))); }
}
__device__ __forceinline__ unsigned q8pack(float a, float b, float c, float d) {
    const int qa = __float2int_rn(fminf(fmaxf(a, -127.f), 127.f)), qb = __float2int_rn(fminf(fmaxf(b, -127.f), 127.f)), qc = __float2int_rn(fminf(fmaxf(c, -127.f), 127.f)), qd = __float2int_rn(fminf(fmaxf(d, -127.f), 127.f));
    return (unsigned)(qa & 255) | ((unsigned)(qb & 255) << 8) | ((unsigned)(qc & 255) << 16) | ((unsigned)(qd & 255) << 24); }
constexpr int CQ_IN = (D / 64) * (NPROJ / 32), CQ_OUT = (D / 64) * (D / 32), CQ_UP = (D / 64) * (DFF / 32), CQ_DN = (DFF / 64) * (D / 32);
constexpr int CQ_NEG = CQ_IN + CQ_OUT + 2 * CQ_UP;
constexpr int CQ_J1 = 3 * CQ_IN + 3 * CQ_OUT + 2 * CQ_UP + CQ_DN, CQ_MOE = NE * (2 * CQ_UP + CQ_DN), CQ_END0 = CQ_J1 + CQ_MOE, CQ_END1 = CQ_END0 + CQ_MOE;
#ifndef CQ_SLOT_ITEMS
#define CQ_SLOT_ITEMS 12000
#endif
struct CqItem { const float* W; bf16* WT; int K, N, mode, arg, item; const unsigned* am; };
__device__ __forceinline__ CqItem cq_decode(const KP& p, int q) {
    CqItem c; bf16* win = (bf16*)(OWS + WS_WIN); bf16* wout = (bf16*)(OWS + WS_WOUT); bf16* f13 = (bf16*)(OWS + WS_F13); bf16* f2 = (bf16*)(OWS + WS_F2);
    bf16* m13 = (bf16*)(OWS + WS_MOEW13); bf16* m2 = (bf16*)(OWS + WS_MOEW2); const unsigned* AM = (const unsigned*)(OWS + WS_AMAX);
    if (q < 0) { q += CQ_NEG;
        if (q < CQ_IN) { c = CqItem{PIN(I_WIN), win, D, NPROJ, 3, 0, q, AM + AM_IN}; return c; } q -= CQ_IN;
        if (q < CQ_OUT) { c = CqItem{PIN(I_WOUT), wout, D, D, 4, 0, q, AM + AM_OUT}; return c; } q -= CQ_OUT;
        if (q < CQ_UP) { c = CqItem{PIN(I_FW1), f13, D, DFF, 2, 0, q, AM}; return c; } q -= CQ_UP;
        c = CqItem{PIN(I_FW3), f13, D, DFF, 2, 1, q, AM}; return c; }
    if (q < 3 * CQ_IN) { const int l = 1 + q / CQ_IN; c = CqItem{PIN(I_WIN) + (size_t)l * D * NPROJ, win + (size_t)l * (NP * D / 2), D, NPROJ, 3, 0, q % CQ_IN, AM + AM_IN + l * NP}; return c; } q -= 3 * CQ_IN;
    if (q < 3 * CQ_OUT) { const int l = 1 + q / CQ_OUT; c = CqItem{PIN(I_WOUT) + (size_t)l * D * D, wout + (size_t)l * (D * D / 2), D, D, 4, 0, q % CQ_OUT, AM + AM_OUT + l * D}; return c; } q -= 3 * CQ_OUT;
    if (q < CQ_UP) { c = CqItem{PIN(I_FW1) + (size_t)D * DFF, f13 + (size_t)DFF * D, D, DFF, 2, 0, q, AM + 2 * DFF}; return c; } q -= CQ_UP;
    if (q < CQ_UP) { c = CqItem{PIN(I_FW3) + (size_t)D * DFF, f13 + (size_t)DFF * D, D, DFF, 2, 1, q, AM + 2 * DFF}; return c; } q -= CQ_UP;
    if (q < CQ_DN) { c = CqItem{PIN(I_FW2) + (size_t)DFF * D, f2 + (size_t)D * DFF, DFF, D, 0, 0, q, nullptr}; return c; } q -= CQ_DN;
    const int mi = q / CQ_MOE; q -= mi * CQ_MOE;
    if (q < NE * CQ_UP) { const int e = q / CQ_UP; c = CqItem{PIN(I_MW1) + ((size_t)mi * NE + e) * D * DFF, m13 + (size_t)e * DFF * D, D, DFF, 2, 0, q % CQ_UP, AM + (size_t)(2 + 8 * mi + e) * 2 * DFF}; return c; } q -= NE * CQ_UP;
    if (q < NE * CQ_UP) { const int e = q / CQ_UP; c = CqItem{PIN(I_MW3) + ((size_t)mi * NE + e) * D * DFF, m13 + (size_t)e * DFF * D, D, DFF, 2, 1, q % CQ_UP, AM + (size_t)(2 + 8 * mi + e) * 2 * DFF}; return c; } q -= NE * CQ_UP;
    { const int e = q / CQ_DN; c = CqItem{PIN(I_MW2) + ((size_t)mi * NE + e) * DFF * D, m2 + (size_t)e * D * DFF, DFF, D, 0, 0, q % CQ_DN, nullptr}; return c; }
}
__device__ __forceinline__ void cq_load(const CqItem& c, int lane, float (&r)[32]) {
    const int nblk = c.N / 32, kb = c.item / nblk, nb = c.item % nblk; const float* src = c.W + (size_t)(64 * kb + (lane >> 5)) * c.N + 32 * nb + (lane & 31);
#pragma unroll
    for (int i = 0; i < 32; ++i) r[i] = src[(size_t)(2 * i) * c.N];
}
__device__ __forceinline__ void cq_store(const CqItem& c, int lane, const float (&r)[32], LAS float* scr) {
    const int nblk = c.N / 32, kb = c.item / nblk, nb = c.item % nblk, k0 = 64 * kb, n0 = 32 * nb;
#pragma unroll
    for (int i = 0; i < 32; ++i) scr[(2 * i + (lane >> 5)) * 33 + (lane & 31)] = r[i];
    LDS_WAIT(); asm volatile("" ::: "memory");
    if (c.mode >= 2) {
        const int n = lane >> 1, hf = lane & 1, nn = n0 + n, j = c.mode == 2 ? 8 * (nn >> 2) + 4 * c.arg + (nn & 3) : c.mode == 3 ? rowmap<1>(nn, 0) : nn;
        const float inv = 127.f / fmaxf(__builtin_bit_cast(float, c.am[j]), 1e-30f); const LAS float* sp = scr + (32 * hf) * 33 + n; unsigned w[8];
#pragma unroll
        for (int q = 0; q < 8; ++q) w[q] = q8pack(sp[(4 * q + 0) * 33] * inv, sp[(4 * q + 1) * 33] * inv, sp[(4 * q + 2) * 33] * inv, sp[(4 * q + 3) * 33] * inv);
        unsigned char* dst = (unsigned char*)c.WT + (size_t)j * c.K + k0 + 32 * hf;
        *(v4u*)dst = (v4u){w[0], w[1], w[2], w[3]}; *(v4u*)(dst + 16) = (v4u){w[4], w[5], w[6], w[7]};
    } else {
    const int cc = lane & 7;
#pragma unroll
    for (int j = 0; j < 4; ++j) { const int n = (lane >> 3) + 8 * j; const LAS float* sp = scr + (8 * cc) * 33 + n;
        v4u o; o.x = pk2(sp[0 * 33], sp[1 * 33]); o.y = pk2(sp[2 * 33], sp[3 * 33]); o.z = pk2(sp[4 * 33], sp[5 * 33]); o.w = pk2(sp[6 * 33], sp[7 * 33]);
        const int nn = n0 + n;
        *(v4u*)(c.WT + (size_t)nn * c.K + k0 + 8 * cc) = o; }
    }
    LDS_WAIT(); asm volatile("" ::: "memory");
}
constexpr int CQ_B = 4;
__device__ __forceinline__ int cq_grab(unsigned* heads, int nseg, int& cnt, int lane) {
    int q = -1, n = 0;
    if (lane == 0) { for (int sg = 0; sg < nseg && q < 0; ++sg) { const int size = sg == 0 ? CQ_J1 : CQ_MOE, base = sg == 0 ? 0 : sg == 1 ? CQ_J1 : CQ_END0; unsigned* hd = heads + 64 * sg;
            if ((int)__hip_atomic_load(hd, __ATOMIC_RELAXED, __HIP_MEMORY_SCOPE_AGENT) < size) { const int t = (int)__hip_atomic_fetch_add(hd, (unsigned)CQ_B, __ATOMIC_RELAXED, __HIP_MEMORY_SCOPE_AGENT);
                if (t < size) { q = base + t; n = size - t < CQ_B ? size - t : CQ_B; } } } }
    cnt = __builtin_amdgcn_readfirstlane(n); return __builtin_amdgcn_readfirstlane(q);
}
__device__ __forceinline__ void cq_run(const KP& p, LAS unsigned char* lds, int nseg, const unsigned* stop, unsigned stopval, int wave, int lane) {
    unsigned* heads = (unsigned*)(OWS + WS_CTL) + CW_CQ; LAS float* scr = (LAS float*)(lds + wave * 16384);
    for (;;) {
        if (stop) { unsigned sv = 0u; if (lane == 0) sv = __hip_atomic_load(stop, __ATOMIC_RELAXED, __HIP_MEMORY_SCOPE_AGENT); if ((unsigned)__builtin_amdgcn_readfirstlane((int)sv) >= stopval) break; }
        int cnt; const int q0 = cq_grab(heads, nseg, cnt, lane); if (q0 < 0) break;
        CqItem cur = cq_decode(p, q0); float ra[32]; cq_load(cur, lane, ra);
        for (int j = 0; j < cnt; ++j) { CqItem nxt = cur; float rb[32];
            if (j + 1 < cnt) { nxt = cq_decode(p, q0 + j + 1); cq_load(nxt, lane, rb); }
            cq_store(cur, lane, ra, scr);
            if (j + 1 < cnt) { cur = nxt;
#pragma unroll
                for (int i = 0; i < 32; ++i) ra[i] = rb[i]; } }
    }
}

__device__ __forceinline__ void cq_static(const KP& p, LAS unsigned char* lds, int q0, int q1, int gw, int NGW, int wave, int lane) {
    LAS float* scr = (LAS float*)(lds + wave * 16384);
    int q = q0 + gw; if (q >= q1) return;
    CqItem cur = cq_decode(p, q); float ra[32]; cq_load(cur, lane, ra);
    for (;;) { const int qn = q + NGW; CqItem nxt = cur; float rb[32];
        if (qn < q1) { nxt = cq_decode(p, qn); cq_load(nxt, lane, rb); }
        cq_store(cur, lane, ra, scr);
        if (qn >= q1) break;
        cur = nxt; q = qn;
#pragma unroll
        for (int i = 0; i < 32; ++i) ra[i] = rb[i]; }
}

__device__ __forceinline__ void ld_row(const float* r, int lane, f32x4 (&v)[4]) { const f32x4* q = (const f32x4*)r + lane;
#pragma unroll
    for (int j = 0; j < 4; ++j) v[j] = q[64 * j]; }
__device__ __forceinline__ void st_row(float* r, int lane, const f32x4 (&v)[4]) { f32x4* q = (f32x4*)r + lane;
#pragma unroll
    for (int j = 0; j < 4; ++j) q[64 * j] = v[j]; }
__device__ __forceinline__ void st_row_bf16(bf16* r, int lane, const f32x4 (&v)[4]) { v2u* q = (v2u*)r + lane;
#pragma unroll
    for (int j = 0; j < 4; ++j) { v2u w; w.x = pk2(v[j][0], v[j][1]); w.y = pk2(v[j][2], v[j][3]); q[64 * j] = w; } }
__device__ __forceinline__ void ld_row_bf16(const bf16* r, int lane, f32x4 (&v)[4]) { const v2u* q = (const v2u*)r + lane;
#pragma unroll
    for (int j = 0; j < 4; ++j) { const v2u w = q[64 * j]; v[j] = (f32x4){bflo(w.x), bfhi(w.x), bflo(w.y), bfhi(w.y)}; } }
template <int S> __device__ __forceinline__ void ld_row_parts(const float* r, size_t pstride, int lane, f32x4 (&v)[4]) {
    ld_row(r, lane, v);
#pragma unroll
    for (int s = 1; s < S; ++s) { f32x4 t[4]; ld_row(r + (size_t)s * pstride, lane, t);
#pragma unroll
        for (int j = 0; j < 4; ++j) v[j] += t[j]; } }
__device__ __forceinline__ int mod_row(int row) { return row < NLAT ? (row >> 12) : 4; }

__device__ __forceinline__ void st_row_q8(unsigned char* dst8, float* scale, int row, int lane, const f32x4 (&v)[4]) {
    float am = 0.f;
#pragma unroll
    for (int j = 0; j < 4; ++j) am = fmaxf(fmaxf(am, fmaxf(fabsf(v[j][0]), fabsf(v[j][1]))), fmaxf(fabsf(v[j][2]), fabsf(v[j][3])));
#pragma unroll
    for (int o = 1; o < 64; o <<= 1) am = fmaxf(am, __shfl_xor(am, o));
    am = fmaxf(am, 1e-30f); const float inv = 127.f / am; unsigned* h8 = (unsigned*)dst8 + (size_t)row * (D / 4) + lane;
#pragma unroll
    for (int j = 0; j < 4; ++j) h8[64 * j] = q8pack(v[j][0] * inv, v[j][1] * inv, v[j][2] * inv, v[j][3] * inv);
    if (lane == 0) scale[row] = am * (1.f / 127.f);
}
__device__ __forceinline__ void ph_init_rows(const KP& p, int gw, int NGW, int lane) {
    const float* modv = (const float*)(OWS + WS_MODV); float* X = (float*)(OWS + WS_X); bf16* H = (bf16*)(OWS + WS_H);
    for (int row = gw; row < MROWS; row += NGW) {
        const float* src = row < NLAT ? PIN(I_X) + (size_t)row * D : PIN(I_CTX) + (size_t)(row - NLAT) * D;
        const float* mv = modv + (size_t)(0 * 5 + mod_row(row)) * NMOD;
        f32x4 x[4], sh[4], sc[4], h[4]; ld_row(src, lane, x); ld_row(mv, lane, sh); ld_row(mv + 1024, lane, sc);
#pragma unroll
        for (int j = 0; j < 4; ++j) h[j] = x[j] * (1.f + sc[j]) + sh[j];
        st_row(X + (size_t)row * D, lane, x); st_row_q8(OWS + WS_H8, (float*)(OWS + WS_SA), row, lane, h);
    }
}

__device__ __forceinline__ int scan_row(int b, int dir, int step) { return step < CTXL ? NLAT + b * CTXL + (dir ? CTXL - 1 - step : step) : b * SEQ + (dir ? SEQ - 1 - (step - CTXL) : step - CTXL); }
typedef short sbf16x8 __attribute__((ext_vector_type(8)));
typedef float f32x16 __attribute__((ext_vector_type(16)));
constexpr int SC_C = 32, SC_NCH = (CTXL + SEQ) / SC_C  , SC_NCHAIN = NB * NH * 2  , SC_NTASK = SC_NCH * SC_NCHAIN  ;
constexpr int CH_G = 0, CH_Q = 8192, CH_UT = 12288, CH_YL = 20480, CH_EC = 24576, CH_BYTES = 25600, CH_NLOAD = 26;

__device__ __forceinline__ f32x16 mm(v4u a, v4u b, f32x16 c) { return __builtin_amdgcn_mfma_f32_32x32x16_bf16(__builtin_bit_cast(sbf16x8, a), __builtin_bit_cast(sbf16x8, b), c, 0, 0, 0); }
typedef float f32x2c __attribute__((ext_vector_type(2))); typedef __bf16 bf16x2c __attribute__((ext_vector_type(2)));
__device__ __forceinline__ unsigned cvtpk(float lo, float hi) { return __builtin_bit_cast(unsigned, __builtin_convertvector((f32x2c){lo, hi}, bf16x2c)); }
template <int S, int NEG> __device__ __forceinline__ v4u cvtf(const f32x16& x) {
    v4u w; const float sg = NEG ? -1.f : 1.f;
    w.x = cvtpk(sg * x[8 * S + 0], sg * x[8 * S + 1]); w.y = cvtpk(sg * x[8 * S + 2], sg * x[8 * S + 3]); w.z = cvtpk(sg * x[8 * S + 4], sg * x[8 * S + 5]); w.w = cvtpk(sg * x[8 * S + 6], sg * x[8 * S + 7]); return w; }
template <int MODE  > __device__ __forceinline__ f32x16 mask_acc(f32x16 x, int n, int hh) {
#pragma unroll
    for (int r = 0; r < 16; ++r) { const int m = (r & 3) + 8 * (r >> 2) + 4 * hh; const bool keep = MODE == 0 ? (m > n) : MODE == 1 ? (m < n) : (m <= n); x[r] = keep ? x[r] : 0.f; }
    return x; }
__device__ __forceinline__ f32x16 zero16() { f32x16 z;
#pragma unroll
    for (int r = 0; r < 16; ++r) z[r] = 0.f;
    return z; }
__device__ __forceinline__ void cm_build(const unsigned (&w)[16], v4u (&f)[2][2]) {
#pragma unroll
    for (int s = 0; s < 2; ++s) {
        const auto r0 = __builtin_amdgcn_permlane32_swap(w[8 * s + 0], w[8 * s + 2], false, false), r1 = __builtin_amdgcn_permlane32_swap(w[8 * s + 1], w[8 * s + 3], false, false);
        const auto r2 = __builtin_amdgcn_permlane32_swap(w[8 * s + 4], w[8 * s + 6], false, false), r3 = __builtin_amdgcn_permlane32_swap(w[8 * s + 5], w[8 * s + 7], false, false);
        f[0][s] = (v4u){r0[0], r1[0], r2[0], r3[0]}; f[1][s] = (v4u){r0[1], r1[1], r2[1], r3[1]}; }
}
__device__ __forceinline__ void st16(unsigned char* base, int off, int lane, v4u v) { *(v4u*)(base + off + lane * 16) = v; }

__device__ __forceinline__ void ph_scan1(const KP& p, int l, int gw, int NGW, int lane) {
    const bf16* P = (const bf16*)(OWS + WS_P); const bf16* LO = (const bf16*)(OWS + WS_LO); const float* NRM = (const float*)(OWS + WS_RKS); unsigned char* CH = OWS + WS_CH;
    const int n = lane & 31, hh = lane >> 5;
    v4u Id[2];
#pragma unroll
    for (int s = 0; s < 2; ++s) { unsigned wd[4];
#pragma unroll
        for (int q = 0; q < 4; ++q) { const int j0 = 2 * q, j1 = 2 * q + 1; const int t0 = 16 * s + 8 * (j0 >> 2) + 4 * hh + (j0 & 3), t1 = 16 * s + 8 * (j1 >> 2) + 4 * hh + (j1 & 3);
            wd[q] = (t0 == n ? 0x3F80u : 0u) | (t1 == n ? 0x3F800000u : 0u); }
        Id[s] = (v4u){wd[0], wd[1], wd[2], wd[3]}; }
    for (int task = gw; task < SC_NTASK; task += NGW) {
        const int dir = task & 1, h = (task >> 1) & 7, b = (task >> 4) & 3, ci = task >> 6;
        const int row0 = scan_row(b, dir, SC_C * ci), sgn = dir ? -1 : 1, c = h * 64 + lane;
        const float w0c = PIN(I_W0)[(l * 2 + dir) * RW + c], a0c = PIN(I_A0)[(l * 2 + dir) * RW + c], kkc = PIN(I_KK)[l * RW + c], kac = PIN(I_KA)[l * RW + c];
        unsigned wAl[16], wBe[16], wKa[16], wRh[16], wV[16], wBp[16], wKp[16];
        float cs = 0.f, Eprev = 1.f;
#pragma unroll
        for (int hb = 0; hb < 2; ++hb) {
            unsigned rk_[16], rr_[16], rv_[16], rw_[16], ra_[16]; float rn_[16];
#pragma unroll
            for (int i = 0; i < 16; ++i) { const int row = row0 + sgn * (16 * hb + i); const bf16* pr = P + (size_t)row * NP; const bf16* lo = LO + (size_t)row * NLO;
                rk_[i] = pr[PC_K + c]; rr_[i] = pr[PC_R + c]; rv_[i] = pr[PC_V + c]; rw_[i] = lo[dir * RW + c]; ra_[i] = lo[1024 + dir * RW + c]; rn_[i] = NRM[row * 8 + h]; }
#pragma unroll
            for (int i = 0; i < 16; ++i) asm volatile("" : "+v"(rk_[i]), "+v"(rr_[i]), "+v"(rv_[i]), "+v"(rw_[i]), "+v"(ra_[i]), "+v"(rn_[i]));
#pragma unroll
            for (int pq = 0; pq < 8; ++pq) { const int pz = 8 * hb + pq; float al[2], be[2], ka[2], rh[2], vv[2];
#pragma unroll
                for (int e = 0; e < 2; ++e) { const int i = 2 * pq + e;
                    const float kv = bf2f((unsigned short)rk_[i]), rv = bf2f((unsigned short)rr_[i]); vv[e] = bf2f((unsigned short)rv_[i]);
                    const float wl = w0c + bf2f((unsigned short)rw_[i]), aa = __builtin_amdgcn_rcpf(1.f + __expf(-(a0c + bf2f((unsigned short)ra_[i])))), nrm = rn_[i];
                    const float lw = -0.6065306597f * __builtin_amdgcn_rcpf(1.f + __expf(-wl));
                    cs += lw; const float E = __expf(cs), Ei = __builtin_amdgcn_rcpf(E);
                    const float kkn = kv * kkc * nrm, kd = kv * (1.f + (aa - 1.f) * kac);
                    al[e] = kkn * Eprev; be[e] = kkn * aa * Ei; ka[e] = kd * Ei; rh[e] = rv * E; Eprev = E; }
                wAl[pz] = cvtpk(al[0], al[1]); wBe[pz] = cvtpk(be[0], be[1]); wKa[pz] = cvtpk(ka[0], ka[1]); wRh[pz] = cvtpk(rh[0], rh[1]); wV[pz] = cvtpk(vv[0], vv[1]); }
        }
        const float EC = Eprev;
#pragma unroll
        for (int pz = 0; pz < 16; ++pz) { wBp[pz] = cvtpk(bflo(wBe[pz]) * EC, bfhi(wBe[pz]) * EC); wKp[pz] = cvtpk(bflo(wKa[pz]) * EC, bfhi(wKa[pz]) * EC); }
        unsigned char* img = CH + (size_t)(((b * 8 + h) * 2 + dir) * SC_NCH + ci) * CH_BYTES;
        ((float*)(img + CH_EC))[lane] = EC;
        v4u cAl[2][2], cV[2][2], cBp[2][2], cKp[2][2], cRh[2][2];
        v4u tAl[4], tBe[4], tKa[4], tRh[4];
        cm_build(wAl, cAl); cm_build(wV, cV); cm_build(wBp, cBp); cm_build(wKp, cKp); cm_build(wRh, cRh);
        {   v4u cBe[2][2], cKa[2][2]; cm_build(wBe, cBe); cm_build(wKa, cKa);
#define TRANSPOSE(cZ, tZ) do { _Pragma("unroll") for (int ct = 0; ct < 2; ++ct) { f32x16 T_ = mm(cZ[ct][0], Id[0], zero16()); T_ = mm(cZ[ct][1], Id[1], T_); tZ[2 * ct] = cvtf<0, 0>(T_); tZ[2 * ct + 1] = cvtf<1, 0>(T_); } } while (0)
            TRANSPOSE(cAl, tAl); TRANSPOSE(cBe, tBe); TRANSPOSE(cKa, tKa); TRANSPOSE(cRh, tRh);
#undef TRANSPOSE
        }
#define PROD4(A, B) mm(A[3], B[3], mm(A[2], B[2], mm(A[1], B[1], mm(A[0], B[0], zero16()))))
        f32x16 XN = mask_acc<0>(PROD4(tAl, tBe), n, hh), XT = mask_acc<1>(PROD4(tBe, tAl), n, hh);
        v4u fLM[2], fGB[2], fGK[2];
        { const f32x16 t = mask_acc<1>(PROD4(tKa, tAl), n, hh); fLM[0] = cvtf<0, 0>(t); fLM[1] = cvtf<1, 0>(t); }
        { const f32x16 t = mask_acc<2>(PROD4(tBe, tRh), n, hh); fGB[0] = cvtf<0, 0>(t); fGB[1] = cvtf<1, 0>(t); }
        { const f32x16 t = mask_acc<2>(PROD4(tKa, tRh), n, hh); fGK[0] = cvtf<0, 0>(t); fGK[1] = cvtf<1, 0>(t); }
#undef PROD4
#pragma unroll
        for (int r = 0; r < 16; ++r) { XN[r] = -XN[r]; XT[r] = -XT[r]; }
        f32x16 RT = XT;
#pragma unroll
        for (int r = 0; r < 16; ++r) RT[r] += ((r & 3) + 8 * (r >> 2) + 4 * hh == n) ? 1.f : 0.f;
#pragma unroll
        for (int pw = 1; pw < 5; ++pw) {
            const v4u xn0 = cvtf<0, 0>(XN), xn1 = cvtf<1, 0>(XN), xt0 = cvtf<0, 0>(XT), xt1 = cvtf<1, 0>(XT);
            XN = mm(xt1, xn1, mm(xt0, xn0, zero16()));
            if (pw < 4) XT = mm(xn1, xt1, mm(xn0, xt0, zero16()));
            const v4u yn0 = cvtf<0, 0>(XN), yn1 = cvtf<1, 0>(XN), rt0 = cvtf<0, 0>(RT), rt1 = cvtf<1, 0>(RT);
            RT = mm(yn1, rt1, mm(yn0, rt0, RT));
        }
        const v4u fA0 = cvtf<0, 0>(RT), fA1 = cvtf<1, 0>(RT);
        f32x16 At[2], Vt[2];
#pragma unroll
        for (int t = 0; t < 2; ++t) {
            const f32x16 lmv = mm(fLM[1], cV[t][1], mm(fLM[0], cV[t][0], zero16()));
            At[t] = mm(fA1, cAl[t][1], mm(fA0, cAl[t][0], zero16()));
            Vt[t] = mm(fA1, cvtf<1, 0>(lmv), mm(fA0, cvtf<0, 0>(lmv), zero16()));
        }
#pragma unroll
        for (int kt1 = 0; kt1 < 2; ++kt1) { const v4u a0 = cvtf<0, 0>(At[kt1]), a1 = cvtf<1, 0>(At[kt1]);
#pragma unroll
            for (int kt2 = 0; kt2 < 2; ++kt2) { const f32x16 g = mm(a1, cBp[kt2][1], mm(a0, cBp[kt2][0], zero16()));
                st16(img, CH_G + ((kt2 * 2 + kt1) * 2 + 0) * 1024, lane, cvtf<0, 1>(g)); st16(img, CH_G + ((kt2 * 2 + kt1) * 2 + 1) * 1024, lane, cvtf<1, 1>(g)); } }
#pragma unroll
        for (int vt = 0; vt < 2; ++vt) { const v4u nv0 = cvtf<0, 1>(Vt[vt]), nv1 = cvtf<1, 1>(Vt[vt]);
#pragma unroll
            for (int kt = 0; kt < 2; ++kt) { f32x16 u = mm(cKp[kt][1], cV[vt][1], mm(cKp[kt][0], cV[vt][0], zero16())); u = mm(cBp[kt][1], nv1, mm(cBp[kt][0], nv0, u));
                st16(img, CH_UT + ((kt * 2 + vt) * 2 + 0) * 1024, lane, cvtf<0, 0>(u)); st16(img, CH_UT + ((kt * 2 + vt) * 2 + 1) * 1024, lane, cvtf<1, 0>(u)); }
            f32x16 y = mm(cV[vt][1], fGK[1], mm(cV[vt][0], fGK[0], zero16())); y = mm(nv1, fGB[1], mm(nv0, fGB[0], y));
            st16(img, CH_YL + (vt * 2 + 0) * 1024, lane, cvtf<0, 0>(y)); st16(img, CH_YL + (vt * 2 + 1) * 1024, lane, cvtf<1, 0>(y)); }
#pragma unroll
        for (int kt = 0; kt < 2; ++kt) { f32x16 q = mm(cRh[kt][1], Id[1], mm(cRh[kt][0], Id[0], zero16()));
            q = mm(cvtf<1, 1>(At[kt]), fGB[1], mm(cvtf<0, 1>(At[kt]), fGB[0], q));
            st16(img, CH_Q + (kt * 2 + 0) * 1024, lane, cvtf<0, 0>(q)); st16(img, CH_Q + (kt * 2 + 1) * 1024, lane, cvtf<1, 0>(q)); }
    }
}

__device__ __forceinline__ void ph_scan2(const KP& p, LAS unsigned char* lds, int l, int wave, int lane) {
    unsigned* sdone = (unsigned*)(OWS + WS_CTL) + CW_SDONE + 64 * l;
#ifndef CQ_SLOT_WGS
#define CQ_SLOT_WGS 128
#endif
    if (blockIdx.x >= SC_NCHAIN * 2) {
        const int q0 = (l < 2 ? CQ_J1 : CQ_END0) + (l & 1) * CQ_SLOT_ITEMS;
        cq_static(p, lds, q0, q0 + CQ_SLOT_ITEMS, ((int)blockIdx.x - SC_NCHAIN * 2) * NWAVES + wave, ((int)gridDim.x - SC_NCHAIN * 2) * NWAVES, wave, lane); return; }
    const int chain = blockIdx.x >> 1, vt = blockIdx.x & 1, dir = chain & 1, h = (chain >> 1) & 7, b = chain >> 4;
    const int n = lane & 31, hh = lane >> 5;
    const unsigned char* CH = OWS + WS_CH + (size_t)chain * SC_NCH * CH_BYTES; bf16* Y = (bf16*)(OWS + WS_Y) + (size_t)dir * MROWS * RW + h * 64 + 32 * vt + 4 * hh;
    constexpr int NPIECE = 19, SLOT = NPIECE * 1024, NSLOT = 6, PD = 4, XCH = NSLOT * SLOT;
    int psrc[3], pdst[3];
#pragma unroll
    for (int j = 0; j < 3; ++j) { int f = wave + 8 * j; if (f >= NPIECE) f -= NPIECE;
        pdst[j] = f;
        psrc[j] = f < 12 ? f * 1024 : f < 16 ? CH_UT + ((((f - 12) >> 1) * 2 + vt) * 2 + ((f - 12) & 1)) * 1024 : f < 18 ? CH_YL + (vt * 2 + (f - 16)) * 1024 : CH_EC; }
    const int lane_off[3] = {pdst[0] == 18 ? (lane * 16) & 255 : lane * 16, pdst[1] == 18 ? (lane * 16) & 255 : lane * 16, pdst[2] == 18 ? (lane * 16) & 255 : lane * 16};
#define SC2_ISSUE(ci_, slot_) do { const unsigned char* im_ = CH + (size_t)(ci_) * CH_BYTES; LAS unsigned char* sl_ = lds + (slot_) * SLOT; \
        _Pragma("unroll") for (int j = 0; j < 3; ++j) __builtin_amdgcn_global_load_lds((const unsigned*)(im_ + psrc[j] + lane_off[j]), (LAS unsigned*)(sl_ + pdst[j] * 1024), 16, 0, 0); } while (0)
#define SC2_LD(slot_, piece_) (*(const LAS v4u*)(lds + (slot_) * SLOT + (piece_) * 1024 + lane * 16))
#define SC2_X(par_, k_) (*(LAS v4u*)(lds + XCH + (par_) * 4096 + (k_) * 1024 + lane * 16))
    f32x16 ST[2] = {zero16(), zero16()};
    SC2_ISSUE(0, 0); SC2_ISSUE(1, 1); SC2_ISSUE(2, 2); SC2_ISSUE(3, 3);
    for (int ci = 0; ci <= SC_NCH; ++ci) {
        const int slot = ci % NSLOT;
        asm volatile("s_waitcnt vmcnt(9)" ::: "memory");
        __builtin_amdgcn_s_barrier();
        asm volatile("" ::: "memory");
        { const int nx = ci + PD < SC_NCH ? ci + PD : SC_NCH - 1; SC2_ISSUE(nx, (ci + PD) % NSLOT); }
        if (wave == 0 && ci < SC_NCH) {
            v4u g0 = SC2_LD(slot, 0), g1 = SC2_LD(slot, 1), g2 = SC2_LD(slot, 2), g3 = SC2_LD(slot, 3), g4 = SC2_LD(slot, 4), g5 = SC2_LD(slot, 5), g6 = SC2_LD(slot, 6), g7 = SC2_LD(slot, 7);
            v4u u0 = SC2_LD(slot, 12), u1 = SC2_LD(slot, 13), u2 = SC2_LD(slot, 14), u3 = SC2_LD(slot, 15);
            f32x4 ec[8];
#pragma unroll
            for (int kq = 0; kq < 8; ++kq) ec[kq] = *(const LAS f32x4*)(lds + slot * SLOT + 18 * 1024 + (32 * (kq >> 2) + 8 * (kq & 3) + 4 * hh) * 4);
            asm volatile("" : "+v"(g0), "+v"(g1), "+v"(g2), "+v"(g3), "+v"(g4), "+v"(g5), "+v"(g6), "+v"(g7), "+v"(u0), "+v"(u1), "+v"(u2), "+v"(u3));
            asm volatile("" : "+v"(ec[0]), "+v"(ec[1]), "+v"(ec[2]), "+v"(ec[3]), "+v"(ec[4]), "+v"(ec[5]), "+v"(ec[6]), "+v"(ec[7]));
            const v4u s00 = cvtf<0, 0>(ST[0]), s01 = cvtf<1, 0>(ST[0]), s10 = cvtf<0, 0>(ST[1]), s11 = cvtf<1, 0>(ST[1]);
            SC2_X(ci & 1, 0) = s00; SC2_X(ci & 1, 1) = s01; SC2_X(ci & 1, 2) = s10; SC2_X(ci & 1, 3) = s11;
            f32x16 a0, a1;
            a0[0] = bflo(u0.x); a0[1] = bfhi(u0.x); a0[2] = bflo(u0.y); a0[3] = bfhi(u0.y); a0[4] = bflo(u0.z); a0[5] = bfhi(u0.z); a0[6] = bflo(u0.w); a0[7] = bfhi(u0.w);
            a0[8] = bflo(u1.x); a0[9] = bfhi(u1.x); a0[10] = bflo(u1.y); a0[11] = bfhi(u1.y); a0[12] = bflo(u1.z); a0[13] = bfhi(u1.z); a0[14] = bflo(u1.w); a0[15] = bfhi(u1.w);
            a1[0] = bflo(u2.x); a1[1] = bfhi(u2.x); a1[2] = bflo(u2.y); a1[3] = bfhi(u2.y); a1[4] = bflo(u2.z); a1[5] = bfhi(u2.z); a1[6] = bflo(u2.w); a1[7] = bfhi(u2.w);
            a1[8] = bflo(u3.x); a1[9] = bfhi(u3.x); a1[10] = bflo(u3.y); a1[11] = bfhi(u3.y); a1[12] = bflo(u3.z); a1[13] = bfhi(u3.z); a1[14] = bflo(u3.w); a1[15] = bfhi(u3.w);
#pragma unroll
            for (int q = 0; q < 4; ++q)
#pragma unroll
                for (int e = 0; e < 4; ++e) { a0[4 * q + e] += ST[0][4 * q + e] * ec[q][e]; a1[4 * q + e] += ST[1][4 * q + e] * ec[4 + q][e]; }
            a0 = mm(g0, s00, a0); a1 = mm(g4, s00, a1); a0 = mm(g1, s01, a0); a1 = mm(g5, s01, a1);
            a0 = mm(g2, s10, a0); a1 = mm(g6, s10, a1); a0 = mm(g3, s11, a0); a1 = mm(g7, s11, a1);
            ST[0] = a0; ST[1] = a1;
            if (lane == 0 && ci == SC_NCH - 24) __hip_atomic_fetch_add(sdone, 1u, __ATOMIC_RELAXED, __HIP_MEMORY_SCOPE_AGENT);
        } else if (wave == 1 && ci >= 1) {
            const int cj = ci - 1, sj = cj % NSLOT, par = cj & 1;
            v4u ya = SC2_LD(sj, 16), yc = SC2_LD(sj, 17), q0 = SC2_LD(sj, 8), q1 = SC2_LD(sj, 9), q2 = SC2_LD(sj, 10), q3 = SC2_LD(sj, 11), x0 = SC2_X(par, 0), x1 = SC2_X(par, 1), x2 = SC2_X(par, 2), x3 = SC2_X(par, 3);
            asm volatile("" : "+v"(ya), "+v"(yc), "+v"(q0), "+v"(q1), "+v"(q2), "+v"(q3), "+v"(x0), "+v"(x1), "+v"(x2), "+v"(x3));
            f32x16 y, y2 = zero16();
            y[0] = bflo(ya.x); y[1] = bfhi(ya.x); y[2] = bflo(ya.y); y[3] = bfhi(ya.y); y[4] = bflo(ya.z); y[5] = bfhi(ya.z); y[6] = bflo(ya.w); y[7] = bfhi(ya.w);
            y[8] = bflo(yc.x); y[9] = bfhi(yc.x); y[10] = bflo(yc.y); y[11] = bfhi(yc.y); y[12] = bflo(yc.z); y[13] = bfhi(yc.z); y[14] = bflo(yc.w); y[15] = bfhi(yc.w);
            y = mm(x0, q0, y); y2 = mm(x2, q2, y2); y = mm(x1, q1, y); y2 = mm(x3, q3, y2);
            const int row = scan_row(b, dir, SC_C * cj + n); bf16* yo = Y + (size_t)row * RW;
#pragma unroll
            for (int q = 0; q < 4; ++q) *(v2u*)(yo + 8 * q) = (v2u){cvtpk(y[4 * q] + y2[4 * q], y[4 * q + 1] + y2[4 * q + 1]), cvtpk(y[4 * q + 2] + y2[4 * q + 2], y[4 * q + 3] + y2[4 * q + 3])};
        }
        asm volatile("s_waitcnt lgkmcnt(0)" ::: "memory");
    }
    asm volatile("s_waitcnt vmcnt(0)" ::: "memory");
#undef SC2_ISSUE
#undef SC2_LD
#undef SC2_X
}

__device__ __forceinline__ float sum8(float v) { v += __shfl_xor(v, 1); v += __shfl_xor(v, 2); v += __shfl_xor(v, 4); return v; }
__device__ __forceinline__ void unpack8(v4u s, float (&v)[8]) { v[0] = bflo(s.x); v[1] = bfhi(s.x); v[2] = bflo(s.y); v[3] = bfhi(s.y); v[4] = bflo(s.z); v[5] = bfhi(s.z); v[6] = bflo(s.w); v[7] = bfhi(s.w); }
__device__ __forceinline__ void ld8f(const float* q, float (&v)[8]) { const f32x4 a = *(const f32x4*)q, b = *(const f32x4*)(q + 4); v[0] = a[0]; v[1] = a[1]; v[2] = a[2]; v[3] = a[3]; v[4] = b[0]; v[5] = b[1]; v[6] = b[2]; v[7] = b[3]; }
__device__ __forceinline__ v4u pack8(const float (&v)[8]) { v4u o; o.x = cvtpk(v[0], v[1]); o.y = cvtpk(v[2], v[3]); o.z = cvtpk(v[4], v[5]); o.w = cvtpk(v[6], v[7]); return o; }

__device__ __forceinline__ void ph_readout2(const KP& p, int l, int gw, int NGW, int lane) {
    const bf16* P = (const bf16*)(OWS + WS_P); const bf16* LO = (const bf16*)(OWS + WS_LO); const bf16* Y = (const bf16*)(OWS + WS_Y);
    bf16* MI = (bf16*)(OWS + WS_MIXIN); constexpr size_t PA = (size_t)MROWS * RW; const int c0 = lane * 8;
    for (int row = gw; row < MROWS; row += NGW) { const bf16* pr = P + (size_t)row * NP; const bf16* lo = LO + (size_t)row * NLO;
        int t, len; if (row < NLAT) { t = row & 63; len = 64; } else { t = (row - NLAT) & 255; len = 256; }
        const v4u kw = *(const v4u*)(pr + PC_K + c0), rw = *(const v4u*)(pr + PC_R + c0), vw = *(const v4u*)(pr + PC_V + c0);
        const v4u cbw = *(const v4u*)(pr + PC_CB + c0), ccw = *(const v4u*)(pr + PC_CC + c0), chw = *(const v4u*)(pr + PC_CH + c0);
        v4u ccp = (v4u){0u, 0u, 0u, 0u}, chp = ccp, ccn = ccp, chn = ccp;
        if (t > 0) { ccp = *(const v4u*)(pr - NP + PC_CC + c0); chp = *(const v4u*)(pr - NP + PC_CH + c0); }
        if (t < len - 1) { ccn = *(const v4u*)(pr + NP + PC_CC + c0); chn = *(const v4u*)(pr + NP + PC_CH + c0); }
        float yf[8], yb[8], la0[8], la1[8], g[8];
        unpack8(*(const v4u*)(Y + (size_t)row * RW + c0), yf); unpack8(*(const v4u*)(Y + PA + (size_t)row * RW + c0), yb); unpack8(*(const v4u*)(lo + 1024 + c0), la0); unpack8(*(const v4u*)(lo + 1536 + c0), la1); unpack8(*(const v4u*)(lo + 2048 + c0), g);
        float a0[8], a1[8], ka[8], rkp[8], lg[8], lb[8];
        ld8f(PIN(I_A0) + (l * 2 + 0) * RW + c0, a0); ld8f(PIN(I_A0) + (l * 2 + 1) * RW + c0, a1); ld8f(PIN(I_KA) + l * RW + c0, ka); ld8f(PIN(I_RK) + l * RW + c0, rkp);
        ld8f(PIN(I_LNXG) + l * RW + c0, lg); ld8f(PIN(I_LNXB) + l * RW + c0, lb);
        float kv[8], rv[8], vv[8]; unpack8(kw, kv); unpack8(rw, rv); unpack8(vw, vv);
        float y[8], s = 0.f, rk = 0.f;
#pragma unroll
        for (int j = 0; j < 8; ++j) { y[j] = yf[j] + yb[j]; s += y[j]; const float av = sigm(a0[j] + la0[j]) + sigm(a1[j] + la1[j]); rk += rv[j] * kv[j] * (2.f + (av - 2.f) * ka[j]) * rkp[j]; }
        const float mu = sum8(s) * (1.f / 64.f); rk = sum8(rk); float q = 0.f;
#pragma unroll
        for (int j = 0; j < 8; ++j) { y[j] -= mu; q += y[j] * y[j]; }
        const float rstd = 1.f / sqrtf(sum8(q) * (1.f / 64.f) + GN_EPS);
        float o[8];
#pragma unroll
        for (int j = 0; j < 8; ++j) o[j] = (y[j] * rstd * lg[j] + lb[j] + rk * vv[j]) * g[j];
        float orw[8];
#pragma unroll
        for (int j = 0; j < 8; ++j) orw[j] = o[j];
        float cb[8], cc[8], ch[8], pcc[8], pch[8], ncc[8], nch[8], w0[8], w1[8], w2[8];
        unpack8(cbw, cb); unpack8(ccw, cc); unpack8(chw, ch); unpack8(ccp, pcc); unpack8(chp, pch); unpack8(ccn, ncc); unpack8(chn, nch);
        const float* cw = PIN(I_CONVW) + (size_t)l * 3 * RW + c0; ld8f(cw, w0); ld8f(cw + RW, w1); ld8f(cw + 2 * RW, w2);
#pragma unroll
        for (int j = 0; j < 8; ++j) o[j] = cb[j] * (pcc[j] * pch[j] * w0[j] + cc[j] * ch[j] * w1[j] + ncc[j] * nch[j] * w2[j]);
        float am = 0.f;
#pragma unroll
        for (int j = 0; j < 8; ++j) am = fmaxf(am, fmaxf(fabsf(orw[j]), fabsf(o[j])));
#pragma unroll
        for (int sh = 1; sh < 64; sh <<= 1) am = fmaxf(am, __shfl_xor(am, sh));
        am = fmaxf(am, 1e-30f); const float inv = 127.f / am; unsigned char* m8 = (unsigned char*)MI + (size_t)row * D + c0;
        *(v2u*)m8 = (v2u){q8pack(orw[0] * inv, orw[1] * inv, orw[2] * inv, orw[3] * inv), q8pack(orw[4] * inv, orw[5] * inv, orw[6] * inv, orw[7] * inv)};
        *(v2u*)(m8 + RW) = (v2u){q8pack(o[0] * inv, o[1] * inv, o[2] * inv, o[3] * inv), q8pack(o[4] * inv, o[5] * inv, o[6] * inv, o[7] * inv)};
        if (lane == 0) ((float*)(OWS + WS_SAM))[row] = am * (1.f / 127.f);
    }
}


template <int KS> __device__ __forceinline__ void lora_task(const bf16* pr, int col0, int fn, const bf16* wt, bf16* out, int ct0, int n, int hh) {
    v4u af[KS];
#pragma unroll
    for (int s = 0; s < KS; ++s) { const v4u w = *(const v4u*)(pr + col0 + 16 * s + 8 * hh); float v[8]; unpack8(w, v);
        if (fn == 0) {
#pragma unroll
            for (int j = 0; j < 8; ++j) v[j] = 1.f - 2.f * __builtin_amdgcn_rcpf(1.f + __expf(2.f * v[j])); }
        else if (fn == 2) {
#pragma unroll
            for (int j = 0; j < 8; ++j) v[j] = __builtin_amdgcn_rcpf(1.f + __expf(-v[j])); }
        af[s] = pack8(v); }
#pragma unroll 2
    for (int ct = ct0; ct < ct0 + 8; ++ct) { f32x16 acc = zero16(); const bf16* wb = wt + (size_t)(32 * ct + n) * (16 * KS) + 8 * hh;
#pragma unroll
        for (int s = 0; s < KS; ++s) acc = mm(af[s], *(const v4u*)(wb + 16 * s), acc);
#pragma unroll
        for (int r = 0; r < 16; ++r) out[(size_t)((r & 3) + 8 * (r >> 2) + 4 * hh) * NLO + 32 * ct + n] = (bf16)f2bf(acc[r]); }
}
__device__ __forceinline__ void ph_lora(const KP& p, int l, int gw, int NGW, int lane) {
    const bf16* P = (const bf16*)(OWS + WS_P); bf16* LO = (bf16*)(OWS + WS_LO); float* NRM = (float*)(OWS + WS_RKS);
    const bf16* LW = (const bf16*)(OWS + WS_LORA) + (size_t)l * LORAW_PER_LAYER; const int n = lane & 31, hh = lane >> 5;
    for (int task = gw; task < (MROWS / 32) * 10; task += NGW) { const int half = task & 1, grp = (task >> 1) % 5, rb = task / 10;
        const bf16* pr = P + (size_t)(rb * 32 + n) * NP; bf16* out = LO + (size_t)(rb * 32) * NLO + grp * 512;
        if (grp < 4) lora_task<4>(pr, grp < 2 ? PC_WD + 64 * grp : PC_AD + 64 * (grp - 2), grp < 2 ? 0 : 1, LW + (size_t)grp * 512 * 64, out, half * 8, n, hh);
        else lora_task<8>(pr, PC_GD, 2, LW + (size_t)4 * 512 * 64, out, half * 8, n, hh); }
    float kkc[8]; ld8f(PIN(I_KK) + l * RW + lane * 8, kkc);
    for (int row = gw; row < MROWS; row += NGW) { const v4u kw = *(const v4u*)(P + (size_t)row * NP + PC_K + lane * 8); float kv[8]; unpack8(kw, kv); float ss = 0.f;
#pragma unroll
        for (int j = 0; j < 8; ++j) { const float t = kv[j] * kkc[j]; ss += t * t; }
        ss = sum8(ss); if ((lane & 7) == 0) NRM[row * 8 + (lane >> 3)] = 1.f / fmaxf(sqrtf(ss), 1e-12f); }
}

__device__ __forceinline__ void ph_moe_gather(const KP& p, int l, int gw, int NGW, int lane) {
    const unsigned* gcnt = (const unsigned*)(OWS + WS_CTL) + CW_GCNT + 64 * (l >> 1);
    int cnt[8], pb[9]; pb[0] = 0;
#pragma unroll
    for (int e = 0; e < 8; ++e) { cnt[e] = (int)gcnt[e]; pb[e + 1] = pb[e] + ((cnt[e] + 255) & ~255); }
    const unsigned* rowlist = (const unsigned*)(OWS + WS_ROWLIST); const float* wsel = (const float*)(OWS + WS_WSEL); float* wsort = (float*)(OWS + WS_WSORT);
    const unsigned char* H8 = OWS + WS_H8; unsigned char* HG = OWS + WS_HG; const float* sa = (const float*)(OWS + WS_SA); float* sag = (float*)(OWS + WS_SAG);
    for (int pos = gw; pos < pb[8]; pos += NGW) {
        int e = 0, base = 0, ce = cnt[0];
#pragma unroll
        for (int k = 1; k < 8; ++k) if (pos >= pb[k]) { e = k; base = pb[k]; ce = cnt[k]; }
        const int rank = pos - base; v4u a = (v4u){0u, 0u, 0u, 0u}; float w = 0.f, sc = 0.f;
        if (rank < ce) { const unsigned ent = rowlist[(size_t)e * MROWS + rank]; a = *(const v4u*)(H8 + (size_t)(ent >> 1) * D + lane * 16); w = wsel[ent]; sc = sa[ent >> 1]; }
        *(v4u*)(HG + (size_t)pos * D + lane * 16) = a;
        if (lane == 0) { wsort[pos] = w; sag[pos] = sc; }
    }
}

__device__ __forceinline__ void ph_ln(const KP& p, LAS unsigned char* lds, int l, int which, int tid, int wave, int gw, int NGW, int lane) {
    const float* modv = (const float*)(OWS + WS_MODV); float* X = (float*)(OWS + WS_X); bf16* H = (bf16*)(OWS + WS_H);
    const bf16* BR = (const bf16*)(OWS + (which == 0 ? WS_MIXO : WS_F)); const float* BP = (const float*)(OWS + (which == 0 ? WS_MIXP : WS_FP));
    const float* lg = PIN(which == 0 ? I_LN1G : I_LN2G) + l * D; const float* lb = PIN(which == 0 ? I_LN1B : I_LN2B) + l * D;
    const bool moe = (which == 0) && (l & 1); const bool last = (which == 1) && (l == DEPTH - 1); const bool moe_out = (which == 1) && (l & 1);
    LAS int* lcnt = (LAS int*)lds;
    LAS int* lsel = (LAS int*)(lds + 64);
    int nloc = 0;
    if (moe) { if (tid < 16) lcnt[tid] = 0; __syncthreads(); }
    int pbs[9]; pbs[0] = 0;
    if (moe_out) { const unsigned* gcnt = (const unsigned*)(OWS + WS_CTL) + CW_GCNT + 64 * (l >> 1);
#pragma unroll
        for (int e = 0; e < 8; ++e) pbs[e + 1] = pbs[e] + (int)((gcnt[e] + 255u) & ~255u); }
    f32x4 gt[4], g4[4], b4[4], sh[4], sc[4]; ld_row(lg, lane, g4); ld_row(lb, lane, b4);
    for (int it = 0; it < 9; ++it) {
        if (it == 8 && gw >= NCTX) break;
        const int row = it < 8 ? (gw >> 9) * SEQ + (gw & 511) + 512 * it : NLAT + gw;
        const int mr = mod_row(row); const float* mv = modv + (size_t)(l * 5 + mr) * NMOD;
        if (it == 0 || it == 8) { ld_row(mv + (which == 0 ? 2048 : 5120), lane, gt);
            if (!last) { const float* mv2 = which == 0 ? mv + 3072 : modv + (size_t)((l + 1) * 5 + mr) * NMOD; ld_row(mv2, lane, sh); ld_row(mv2 + 1024, lane, sc); } }
        f32x4 x[4], br[4], t[4]; ld_row(X + (size_t)row * D, lane, x);
        if (moe_out) { const int* ts = (const int*)(OWS + WS_TOKSEL) + row * 4; const int e0 = ts[0], r0 = ts[1], e1 = ts[2], r1 = ts[3]; int b0 = 0, b1 = 0;
#pragma unroll
            for (int k = 1; k < 8; ++k) { if (e0 >= k) b0 = pbs[k]; if (e1 >= k) b1 = pbs[k]; }
            f32x4 ba[4], bb[4]; const int q0 = b0 + r0, q1 = b1 + r1; constexpr int MM = MOE_MAIN_PANELS * 256;
            if (q0 < MM) ld_row_bf16(BR + (size_t)q0 * D, lane, ba); else ld_row_parts<4>(BP + (size_t)(q0 - MM) * D, (size_t)MOE_TAIL_ROWS * D, lane, ba);
            if (q1 < MM) ld_row_bf16(BR + (size_t)q1 * D, lane, bb); else ld_row_parts<4>(BP + (size_t)(q1 - MM) * D, (size_t)MOE_TAIL_ROWS * D, lane, bb);
#pragma unroll
            for (int j = 0; j < 4; ++j) br[j] = ba[j] + bb[j]; }
        else if (row < NLAT) ld_row_bf16(BR + (size_t)row * D, lane, br);
        else if (which == 0) ld_row_parts<2>(BP + (size_t)(row - NLAT) * D, (size_t)NCTX * D, lane, br);
        else ld_row_parts<7>(BP + (size_t)(row - NLAT) * D, (size_t)NCTX * D, lane, br);
        float s = 0.f;
#pragma unroll
        for (int j = 0; j < 4; ++j) { t[j] = DN_ALPHA * x[j] + gt[j] * br[j]; s += (t[j][0] + t[j][1]) + (t[j][2] + t[j][3]); }
        const float mean = wave_sum(s) * (1.f / D); float s2 = 0.f;
#pragma unroll
        for (int j = 0; j < 4; ++j) { t[j] = t[j] - mean; s2 += (t[j][0] * t[j][0] + t[j][1] * t[j][1]) + (t[j][2] * t[j][2] + t[j][3] * t[j][3]); }
        const float rstd = 1.f / sqrtf(wave_sum(s2) * (1.f / D) + LN_EPS);
#pragma unroll
        for (int j = 0; j < 4; ++j) x[j] = t[j] * rstd * g4[j] + b4[j];
        if (last) {
#if PROBE_DUP & (128 | 256)
            { const unsigned* cw = (const unsigned*)(OWS + WS_CTL); const float cval = 10.f * ((float)cw[20001] / 1024.f) / fmaxf((float)cw[20000], 1.f);
#pragma unroll
              for (int j = 0; j < 4; ++j) x[j] = (f32x4){cval, cval, cval, cval}; }
#endif
            if (row < NLAT) st_row(p.out + (size_t)row * D, lane, x); continue; }
        st_row(X + (size_t)row * D, lane, x);
        f32x4 hh[4];
#pragma unroll
        for (int j = 0; j < 4; ++j) hh[j] = x[j] * (1.f + sc[j]) + sh[j];
        st_row_q8(OWS + WS_H8, (float*)(OWS + WS_SA), row, lane, hh);
        if (moe) {
            const float* rw = PIN(I_RTW) + (size_t)(l >> 1) * D * NE; float lgt[8];
#pragma unroll
            for (int e = 0; e < 8; ++e) lgt[e] = 0.f;
#pragma unroll
            for (int j = 0; j < 4; ++j)
#pragma unroll
                for (int i = 0; i < 4; ++i) { const f32x4* wp = (const f32x4*)(rw + (size_t)(4 * lane + 256 * j + i) * NE); const f32x4 w0 = wp[0], w1 = wp[1]; const float hv = hh[j][i];
                    lgt[0] += hv * w0[0]; lgt[1] += hv * w0[1]; lgt[2] += hv * w0[2]; lgt[3] += hv * w0[3]; lgt[4] += hv * w1[0]; lgt[5] += hv * w1[1]; lgt[6] += hv * w1[2]; lgt[7] += hv * w1[3]; }
#pragma unroll
            for (int e = 0; e < 8; ++e) lgt[e] = wave_sum(lgt[e]) + PIN(I_RTB)[(l >> 1) * NE + e];
            float v0 = lgt[0]; int i0 = 0;
#pragma unroll
            for (int e = 1; e < 8; ++e) if (lgt[e] > v0) { v0 = lgt[e]; i0 = e; }
            float v1 = -3.0e38f; int i1 = -1;
#pragma unroll
            for (int e = 0; e < 8; ++e) if (e != i0 && lgt[e] > v1) { v1 = lgt[e]; i1 = e; }
            const float w0 = 1.f / (1.f + expf(v1 - v0)), w1 = 1.f - w0;
            if (lane == 0) { const int lr0 = __hip_atomic_fetch_add(lcnt + i0, 1, __ATOMIC_RELAXED, __HIP_MEMORY_SCOPE_WORKGROUP), lr1 = __hip_atomic_fetch_add(lcnt + i1, 1, __ATOMIC_RELAXED, __HIP_MEMORY_SCOPE_WORKGROUP); const int li = nloc * NWAVES + wave;
                lsel[li * 8 + 0] = row; lsel[li * 8 + 1] = i0; lsel[li * 8 + 2] = lr0; lsel[li * 8 + 3] = i1; lsel[li * 8 + 4] = lr1;
                ((float*)(OWS + WS_WSEL))[row * 2] = w0; ((float*)(OWS + WS_WSEL))[row * 2 + 1] = w1; }
            ++nloc;
        }
    }
    if (moe) {
        __syncthreads();
        unsigned* gcnt = (unsigned*)(OWS + WS_CTL) + CW_GCNT + 64 * (l >> 1);
        if (tid < 8) lcnt[8 + tid] = (int)__hip_atomic_fetch_add(gcnt + tid, (unsigned)lcnt[tid], __ATOMIC_RELAXED, __HIP_MEMORY_SCOPE_AGENT);
        __syncthreads();
        unsigned* rowlist = (unsigned*)(OWS + WS_ROWLIST); int* toksel = (int*)(OWS + WS_TOKSEL);
        if (tid < 16 * NWAVES) { const int k = tid / NWAVES, w = tid % NWAVES; if (k < 8 || (k == 8 && (int)blockIdx.x * NWAVES + w < NCTX)) { const int li = k * NWAVES + w;
            const int row = lsel[li * 8 + 0], e0 = lsel[li * 8 + 1], r0 = lcnt[8 + e0] + lsel[li * 8 + 2], e1 = lsel[li * 8 + 3], r1 = lcnt[8 + e1] + lsel[li * 8 + 4];
            rowlist[(size_t)e0 * MROWS + r0] = (unsigned)row * 2u; rowlist[(size_t)e1 * MROWS + r1] = (unsigned)row * 2u + 1u;
            toksel[row * 4 + 0] = e0; toksel[row * 4 + 1] = r0; toksel[row * 4 + 2] = e1; toksel[row * 4 + 3] = r1; } }
    }
}


#ifndef PROBE_WHICH
#define PROBE_WHICH(x, y) (x)
#endif
#if PROBE_DUP & 128
__device__ __forceinline__ void ph_check_up(const KP& p, int gw, int lane) {
    if (gw >= 64) return;
    const float* X = (const float*)(OWS + WS_X); const float* modv = (const float*)(OWS + WS_MODV); const bf16* ACT = (const bf16*)(OWS + WS_ACT);
    const int row = gw * 257, c = lane * 56 + (gw & 7), mr = mod_row(row); const float* mv = modv + (size_t)(0 * 5 + mr) * NMOD;
    const signed char* H8 = (const signed char*)(OWS + WS_H8); const signed char* W8 = (const signed char*)(OWS + WS_F13); const float* SA = (const float*)(OWS + WS_SA); const unsigned* AM = (const unsigned*)(OWS + WS_AMAX);
    const int j1 = 8 * (c >> 2) + (c & 3), j3 = j1 + 4; int ia = 0, ib = 0;
    for (int k = 0; k < D; ++k) { const int h = H8[(size_t)row * D + k]; ia += h * W8[(size_t)j1 * D + k]; ib += h * W8[(size_t)j3 * D + k]; }
    const float a = (float)ia * SA[row] * __builtin_bit_cast(float, AM[j1]) * (1.f / 127.f), b = (float)ib * SA[row] * __builtin_bit_cast(float, AM[j3]) * (1.f / 127.f);
    (void)X; (void)mv;
    const float ref = a / (1.f + expf(-a)) * b, got = bf2f(ACT[(size_t)row * DFF + c]);
    const float da = ((const float*)(OWS + WS_F))[(size_t)row * DFF + c], db = ((const float*)(OWS + WS_F))[(size_t)4096 * DFF + (size_t)row * DFF + c]; (void)got; (void)db;
    if (row < 4096 && abs(ia) > 1000) { const float ratio = 10.f * fminf(fabsf(PROBE_WHICH(da / a, db / b) - 1.f), 0.4f);
        __hip_atomic_fetch_add((unsigned*)(OWS + WS_CTL) + 20000, 1u, __ATOMIC_RELAXED, __HIP_MEMORY_SCOPE_AGENT); __hip_atomic_fetch_add((unsigned*)(OWS + WS_CTL) + 20001, (unsigned)(ratio * 1024.f), __ATOMIC_RELAXED, __HIP_MEMORY_SCOPE_AGENT); }
}
#endif

#if PROBE_DUP & 256
__device__ __forceinline__ void ph_check_mfma(const KP& p, int lane) {
    typedef int i32x4 __attribute__((ext_vector_type(4)));
    const int r = lane & 15, g = lane >> 4; unsigned aw[4], bw[4];
#pragma unroll
    for (int q = 0; q < 4; ++q) { unsigned a = 0, b = 0;
#pragma unroll
        for (int t = 0; t < 4; ++t) { const int k = 16 * g + 4 * q + t; const int av = ((r * 7 + k * 3) % 5) - 2, bv = ((r * 5 + k * 11) % 7) - 3; a |= (unsigned)(av & 255) << (8 * t); b |= (unsigned)(bv & 255) << (8 * t); }
        aw[q] = a; bw[q] = b; }
    i32x4 c = {0, 0, 0, 0};
    c = __builtin_amdgcn_mfma_i32_16x16x64_i8((i32x4){(int)aw[0], (int)aw[1], (int)aw[2], (int)aw[3]}, (i32x4){(int)bw[0], (int)bw[1], (int)bw[2], (int)bw[3]}, c, 0, 0, 0);
    bool bad = false;
#pragma unroll
    for (int reg = 0; reg < 4; ++reg) { const int i = 4 * g + reg, j = r; int e = 0;
        for (int k = 0; k < 64; ++k) e += (((i * 7 + k * 3) % 5) - 2) * (((j * 5 + k * 11) % 7) - 3);
        if (c[reg] != e) bad = true; }
    if (bad) __hip_atomic_fetch_add((unsigned*)(OWS + WS_CTL) + 20000, 1000u, __ATOMIC_RELAXED, __HIP_MEMORY_SCOPE_AGENT);
}
#endif
__global__ void __launch_bounds__(NWAVES * 64, 2) fwd_kernel(KP p) {
    extern __shared__ __attribute__((aligned(16))) unsigned char lds_raw[];
    LAS unsigned char* lds = (LAS unsigned char*)lds_raw;
    volatile LAS unsigned* MISC = (volatile LAS unsigned*)(lds + MISC_OFF);
    const int G = gridDim.x, NGW = G * NWAVES;
    for (int u = threadIdx.x; u < (LDS_BYTES - LDSCTL_OFF) / 4; u += NWAVES * 64) ((LAS unsigned*)(lds + LDSCTL_OFF))[u] = 0u;
    __syncthreads();
    unsigned* ctl = (unsigned*)(OWS + WS_CTL);
    const bool single = p.ph < 0;
    XcdBarrier bar; bar.bar = ctl + CW_BAR; bar.x = 0; bar.st = nullptr;
    if (single) bar = xcd_barrier_post(ctl + CW_BAR, MISC + 8);
    int phc = 0;
#ifndef PROBE_DUP
#define PROBE_DUP 0
#endif
#define REP(bit) for (int rep_ = 0; rep_ < ((PROBE_DUP & (bit)) ? 2 : 1); ++rep_)
#define RUN() (single || p.ph == phc)
#define FRESH() int tid = threadIdx.x; asm volatile("" : "+v"(tid)); const int lane = tid & 63, wave = __builtin_amdgcn_readfirstlane(tid >> 6), gw = blockIdx.x * NWAVES + wave; (void)lane; (void)gw
#define SEAM() do { if (single) { XcdBarrier b2_ = bar; asm volatile("" : "+s"(b2_.bar)); xcd_barrier(b2_); if (PROBE_DUP & 32) { XcdBarrier b3_ = bar; asm volatile("" : "+s"(b3_.bar)); xcd_barrier(b3_); } } ++phc; } while (0)

    REP(4) if (RUN()) { FRESH(); ph_modvec(p, lds, tid); __syncthreads(); ph_convert(p, lds, gw, NGW, wave, lane); cq_static(p, lds, 3 * CQ_IN + 3 * CQ_OUT + 2 * CQ_UP, CQ_J1, gw, NGW, wave, lane); ph_amax(p, gw, NGW, lane); }
    SEAM();
#if PROBE_DUP & 256
    if (blockIdx.x == 0 && threadIdx.x < 64) ph_check_mfma(p, threadIdx.x);
#endif
    if (RUN()) { FRESH(); ph_init_rows(p, gw, NGW, lane); cq_static(p, lds, -CQ_NEG, 3 * CQ_IN + 3 * CQ_OUT + 2 * CQ_UP, gw, NGW, wave, lane); }
    SEAM();
    for (int ll = 0; ll < DEPTH; ++ll) {
#define l (ll + opaque_zero_i())
         if (RUN()) { pg8::Gemm g{(const bf16*)(OWS + WS_H8), (const bf16*)(OWS + WS_WIN) + (size_t)l * (NP * D / 2), MROWS, NP, D / 2, D / 2}; pg8::StaticOrder S; S.init(MROWS, NP, G, (int)blockIdx.x);
            pg8::EpiBf16S8 E{(bf16*)(OWS + WS_P), NP, (const float*)(OWS + WS_SA), (const float*)(OWS + WS_AMAX) + AM_IN + l * NP}; pg8::gemm_phase<pg8::EpiBf16S8, pg8::StaticOrder, true, true, true>(lds, g, S, E); }
        SEAM();
        REP(8) if (RUN()) { FRESH(); ph_lora(p, l, gw, NGW, lane); }
        SEAM();
        REP(1) if (RUN()) { FRESH(); ph_scan1(p, l, gw, NGW, lane); }
        SEAM();
        REP(2) if (RUN()) { FRESH(); ph_scan2(p, lds, l, wave, lane); }
        SEAM();
        REP(64) if (RUN()) { FRESH(); ph_readout2(p, l, gw, NGW, lane); }
        SEAM();
         if (RUN()) {
            { pg8::Gemm g{(const bf16*)(OWS + WS_MIXIN), (const bf16*)(OWS + WS_WOUT) + (size_t)l * (D * D / 2), NLAT, D, D / 2, D / 2}; pg8::StaticOrder S; S.init(NLAT, D, G, (int)blockIdx.x);
              pg8::EpiBf16S8 E{(bf16*)(OWS + WS_MIXO), D, (const float*)(OWS + WS_SAM), (const float*)(OWS + WS_AMAX) + AM_OUT + l * D}; pg8::gemm_phase<pg8::EpiBf16S8, pg8::StaticOrder, true, true, true>(lds, g, S, E); }
            { pg8::Gemm g{(const bf16*)(OWS + WS_MIXIN), (const bf16*)(OWS + WS_WOUT) + (size_t)l * (D * D / 2), NCTX, D, D / 4, D / 2}; pg8::SplitOrder S{NCTX / 256, D / 256, 2, G, (int)blockIdx.x, NLAT / 256, 0, 0, 0, 0, 0, 0, 0, 0};
              pg8::EpiPartS8 E{(float*)(OWS + WS_MIXP), D, (size_t)NCTX * D, NLAT / 256, (const float*)(OWS + WS_SAM), (const float*)(OWS + WS_AMAX) + AM_OUT + l * D}; pg8::gemm_phase<pg8::EpiPartS8, pg8::SplitOrder, true, true, true>(lds, g, S, E); }
        }
        SEAM();
        if (RUN()) { FRESH(); ph_ln(p, lds, l, 0, tid, wave, gw, NGW, lane); }
        SEAM();
        if ((l & 1) == 0) {
            const int fi = l >> 1;
             if (RUN()) { pg8::Gemm g{(const bf16*)(OWS + WS_H8), (const bf16*)(OWS + WS_F13) + (size_t)fi * DFF * D, MROWS, 2 * DFF, D / 2, D / 2}; pg8::StaticOrder S; S.init(MROWS, 2 * DFF, G, (int)blockIdx.x);
                constexpr int NOE = 0x7fffffff; pg8::EpiSwiGLU8 E{(bf16*)(OWS + WS_ACT), DFF, nullptr, (const float*)(OWS + WS_SA), (const unsigned*)(OWS + WS_AMAX) + (size_t)fi * 2 * DFF, NOE, NOE, NOE, NOE, NOE, NOE, NOE};
#if PROBE_DUP & 128
                E.dbg = (int*)(OWS + WS_F);
#endif
                pg8::gemm_phase<pg8::EpiSwiGLU8, pg8::StaticOrder, true, true, true>(lds, g, S, E); }
            SEAM();
#if PROBE_DUP & 128
            if (ll == 0) { if (RUN()) { FRESH(); ph_check_up(p, gw, lane); } SEAM(); }
#endif
             if (RUN()) {
                { pg8::Gemm g{(const bf16*)(OWS + WS_ACT), (const bf16*)(OWS + WS_F2) + (size_t)fi * D * DFF, NLAT, D, DFF, DFF}; pg8::StaticOrder S; S.init(NLAT, D, G, (int)blockIdx.x);
                  pg8::EpiBf16<0> E{(bf16*)(OWS + WS_F), D, nullptr, 0, 0, 1.f}; pg8::gemm_phase<pg8::EpiBf16<0>, pg8::StaticOrder, true, true>(lds, g, S, E); }
                { pg8::Gemm g{(const bf16*)(OWS + WS_ACT), (const bf16*)(OWS + WS_F2) + (size_t)fi * D * DFF, NCTX, D, DFF / 7, DFF}; pg8::SplitOrder S{NCTX / 256, D / 256, 7, G, (int)blockIdx.x, NLAT / 256, 0, 0, 0, 0, 0, 0, 0, 0};
                  pg8::EpiPart E{(float*)(OWS + WS_FP), D, (size_t)NCTX * D, NLAT / 256}; pg8::gemm_phase<pg8::EpiPart, pg8::SplitOrder, true, true>(lds, g, S, E); }
            }
            SEAM();
        } else {
            REP(4) if (RUN()) { FRESH(); cq_static(p, lds, (l == 1 ? CQ_J1 : CQ_END0) + 2 * CQ_SLOT_ITEMS, l == 1 ? CQ_END0 : CQ_END1, gw, NGW, wave, lane); }
            SEAM();
            if (RUN()) { FRESH(); ph_moe_gather(p, l, gw, NGW, lane); }
            SEAM();
            {   const unsigned* gcnt = (const unsigned*)(OWS + WS_CTL) + CW_GCNT + 64 * (l >> 1); int pbp[9]; pbp[0] = 0;
#pragma unroll
                for (int e = 0; e < 8; ++e) pbp[e + 1] = pbp[e] + (int)((gcnt[e] + 255u) >> 8);
                const int mrows = pbp[8] * 256;
                 if (RUN()) { pg8::Gemm g{(const bf16*)(OWS + WS_HG), (const bf16*)(OWS + WS_MOEW13), mrows, 2 * DFF, D / 2, D / 2}; pg8::MoeOrder S; S.init(mrows, 2 * DFF, G, (int)blockIdx.x);
                    S.pb1 = pbp[1]; S.pb2 = pbp[2]; S.pb3 = pbp[3]; S.pb4 = pbp[4]; S.pb5 = pbp[5]; S.pb6 = pbp[6]; S.pb7 = pbp[7]; S.estride = (size_t)DFF * D;
                    pg8::EpiSwiGLU8 E{(bf16*)(OWS + WS_ACT), DFF, (const float*)(OWS + WS_WSORT), (const float*)(OWS + WS_SAG), (const unsigned*)(OWS + WS_AMAX) + (size_t)(2 + 8 * (l >> 1)) * 2 * DFF, pbp[1], pbp[2], pbp[3], pbp[4], pbp[5], pbp[6], pbp[7]};
                    pg8::gemm_phase<pg8::EpiSwiGLU8, pg8::MoeOrder, true, true, true>(lds, g, S, E); }
                SEAM();
                 if (RUN()) {
                    { pg8::Gemm g{(const bf16*)(OWS + WS_ACT), (const bf16*)(OWS + WS_MOEW2), MOE_MAIN_PANELS * 256, D, DFF, DFF}; pg8::MoeOrder S; S.init(MOE_MAIN_PANELS * 256, D, G, (int)blockIdx.x);
                      S.pb1 = pbp[1]; S.pb2 = pbp[2]; S.pb3 = pbp[3]; S.pb4 = pbp[4]; S.pb5 = pbp[5]; S.pb6 = pbp[6]; S.pb7 = pbp[7]; S.estride = (size_t)D * DFF;
                      pg8::EpiBf16<0> E{(bf16*)(OWS + WS_F), D, nullptr, 0, 0, 1.f}; pg8::gemm_phase<pg8::EpiBf16<0>, pg8::MoeOrder, true, true>(lds, g, S, E); }
                    { const int nT = pbp[8] - MOE_MAIN_PANELS;
                      pg8::Gemm g{(const bf16*)(OWS + WS_ACT), (const bf16*)(OWS + WS_MOEW2), nT * 256, D, DFF / 4, DFF}; pg8::SplitOrder S{nT, D / 256, 4, G, (int)blockIdx.x, MOE_MAIN_PANELS, pbp[1], pbp[2], pbp[3], pbp[4], pbp[5], pbp[6], pbp[7], (size_t)D * DFF};
                      pg8::EpiPart E{(float*)(OWS + WS_FP), D, (size_t)MOE_TAIL_ROWS * D, MOE_MAIN_PANELS}; pg8::gemm_phase<pg8::EpiPart, pg8::SplitOrder, true, true>(lds, g, S, E); }
                }
                SEAM();
            }
        }
        if (RUN()) { FRESH(); ph_ln(p, lds, l, 1, tid, wave, gw, NGW, lane); }
        SEAM();
    }
#undef l
#undef RUN
#undef SEAM
}

#ifndef MK_PER_PHASE
#define MK_PER_PHASE 0
#endif
extern "C" void kernel_launch(void* const* d_in, const int* in_sizes, int n_in, void* d_out, int out_size, void* d_ws, size_t ws_size, hipStream_t stream) {
    static int grid = 0;
    if (grid == 0) {
        if (n_in != N_IN || in_sizes[0] != NLAT * D || out_size != NLAT * D || ws_size < WS_NEED) { fprintf(stderr, "kernel_launch: unexpected shapes / workspace (%d inputs, ws %zu, need %zu)\n", n_in, ws_size, (size_t)WS_NEED); grid = -1; return; }
        int dev = 0, cus = 0, per_cu = 0;
        if (hipGetDevice(&dev) != hipSuccess || hipDeviceGetAttribute(&cus, hipDeviceAttributeMultiprocessorCount, dev) != hipSuccess) { grid = -1; return; }
        if (hipFuncSetAttribute((const void*)fwd_kernel, hipFuncAttributeMaxDynamicSharedMemorySize, LDS_BYTES) != hipSuccess) { fprintf(stderr, "kernel_launch: hipFuncSetAttribute failed\n"); grid = -1; return; }
        if (hipOccupancyMaxActiveBlocksPerMultiprocessor(&per_cu, (const void*)fwd_kernel, NWAVES * 64, LDS_BYTES) != hipSuccess || per_cu < 1) fprintf(stderr, "kernel_launch: occupancy query says %d\n", per_cu);
        (void)hipGetLastError();
        grid = cus;
        if (grid != 256) { fprintf(stderr, "kernel_launch: built for a 256-CU device, found %d CUs\n", cus); grid = -1; return; }
    }
    if (grid < 0) return;
    if (hipMemsetAsync((char*)d_ws + WS_CTL, 0, CTL_BYTES, stream) != hipSuccess) return;
    KP p{};
    for (int i = 0; i < N_IN; ++i) p.in[i] = (const float*)d_in[i];
    p.out = (float*)d_out; p.ws = (unsigned char*)d_ws; p.pad = 0;
#if MK_PER_PHASE
    const int nph = 2 + 2 * 11 + 2 * 13;
    for (int ph = 0; ph < nph; ++ph) { p.ph = ph; hipLaunchKernelGGL(fwd_kernel, dim3(grid), dim3(NWAVES * 64), LDS_BYTES, stream, p); }
#else
    p.ph = -1;
    hipLaunchKernelGGL(fwd_kernel, dim3(grid), dim3(NWAVES * 64), LDS_BYTES, stream, p);
#endif
}
```

```cpp
#include <hip/hip_runtime.h>
#define PROBE_DUP 0
#define CQ_SLOT_WGS 0
#define CQ_SLOT_ITEMS 3500
#include <cstdio>
#include <cstdint>
namespace pg8 {
#define PG8_LAS __attribute__((address_space(3)))
typedef unsigned short bf16_t;
typedef short bf16x8 __attribute__((ext_vector_type(8)));
typedef float f32x4 __attribute__((ext_vector_type(4)));
typedef unsigned u32x4 __attribute__((ext_vector_type(4)));
constexpr int BM = 256, BK = 64, HALF = 128, HTB = HALF * BK * 2  , STAGE_BYTES = 8 * HTB, NXCD = 8, WGM = 8;

__host__ __device__ __forceinline__ int lds_byte(int r, int c) { const int st = (r >> 4) * 2 + (c >> 5), rr = r & 15, cc = c & 31, ob = rr * 64 + cc * 2; return st * 1024 + (ob ^ (((ob >> 9) & 1) << 5)); }
__host__ __device__ __forceinline__ void stage_rc(int b, int& R, int& C) { const int st = b / 1024, sb = b % 1024, swz = sb ^ (((sb >> 9) & 1) << 5); R = (st >> 1) * 16 + swz / 64; C = (st & 1) * 32 + (swz % 64) / 2; }
__host__ __device__ __forceinline__ int perm32(int rho) { const int n = rho >> 4, i = rho & 15; return 8 * (i >> 2) + 4 * n + (i & 3); }

struct Unit { int pm, pn, ks; };
struct Gemm { const bf16_t* A; const bf16_t* Bt; int M, N, K, ld; };

struct StaticOrder {
    int nM, nN, nwg, G, c;
    __host__ __device__ void init(int M, int N, int G_, int c_) { nM = M / BM; nN = N / BM; nwg = nM * nN; G = G_; c = c_; }
    __host__ __device__ bool next(int i, Unit& u) const {
        const long L = (long)i * G + c; if (L >= nwg) return false;
        int wgid = (int)L; { const int q = nwg / NXCD, r = nwg % NXCD, xcd = wgid % NXCD, off = wgid / NXCD; wgid = (xcd < r ? xcd * (q + 1) : r * (q + 1) + (xcd - r) * q) + off; }
        const int nig = WGM * nN, gid = wgid / nig, fm = gid * WGM, gsz = (nM - fm) < WGM ? (nM - fm) : WGM;
        u.pm = fm + ((wgid % nig) % gsz); u.pn = (wgid % nig) / gsz; u.ks = 0; return true;
    }
    __device__ __forceinline__ const char* abase(const Gemm& g, const Unit& u, size_t tstep) const { return (const char*)g.A + (size_t)u.pm * tstep; }
    __device__ __forceinline__ const char* bbase(const Gemm& g, const Unit& u, size_t tstep) const { return (const char*)g.Bt + (size_t)u.pn * tstep; }
    __device__ __forceinline__ void a_ready(const Unit&) const {}
    __device__ __forceinline__ void done(const Unit&) const {}
};

__device__ __forceinline__ unsigned cvt_pk_bf16(float lo, float hi) { unsigned r; asm volatile("v_cvt_pk_bf16_f32 %0, %1, %2" : "=v"(r) : "v"(lo), "v"(hi)); return r; }
typedef float f32x2 __attribute__((ext_vector_type(2)));
__device__ __forceinline__ f32x2 gelu_pk(f32x2 v) {
    const f32x2 av = __builtin_elementwise_abs(v), d = av * 0.2316418882f + 1.0f;
    f32x2 t; t.x = __builtin_amdgcn_rcpf(d.x); t.y = __builtin_amdgcn_rcpf(d.y);
    f32x2 q = t * 0.5307027145f + (-0.7265760135f); q = q * t + 0.7107068705f; q = q * t + (-0.142248368f); q = q * t + 0.127414796f; q = q * t;
    const f32x2 s = (v * v) * (-0.72134752044f);
    f32x2 e; e.x = __builtin_amdgcn_exp2f(s.x); e.y = __builtin_amdgcn_exp2f(s.y);
    const f32x2 m = v * (q * e), r = v - m;
    f32x2 o; o.x = v.x < 0.f ? m.x : r.x; o.y = v.y < 0.f ? m.y : r.y; return o;
}

template <int ACT  > struct EpiBf16 {
    static constexpr bool PERM = true, AFTER_DRAIN = false; static_assert(ACT == 0 || ACT == 1, "EpiBf16: ACT is 0 (none) or 1 (gelu_pk)");
    bf16_t* O; int ldc; const float* bias; int split_cols; size_t split_stride; float scale0;
    __device__ __forceinline__ void operator()(const f32x4 (&acc)[2][2][4][2], const Unit& u, int wr, int wc, int fr, int fq) const {
        asm volatile("" : "+v"(fr), "+v"(fq));
        const int row0 = u.pm * BM + wr * 64 + fr; int colt = u.pn * BM; bf16_t* base = O;
        float sc = 1.f; if (split_cols) { const int t = colt / split_cols; base += (size_t)t * split_stride; colt -= t * split_cols; if (t == 0) sc = scale0; }
        const int col0 = colt + wc * 32 + 8 * fq, bcol0 = u.pn * BM + wc * 32 + 8 * fq;
        f32x4 bv[2][2];
#pragma unroll
        for (int bj = 0; bj < 2; ++bj)
#pragma unroll
            for (int n = 0; n < 2; ++n) bv[bj][n] = bias ? *(const f32x4*)(bias + bcol0 + bj * HALF + 4 * n) : (f32x4){0.f, 0.f, 0.f, 0.f};
#pragma unroll
        for (int ai = 0; ai < 2; ++ai)
#pragma unroll
            for (int m = 0; m < 4; ++m) { bf16_t* rowp = base + (size_t)(row0 + ai * HALF + m * 16) * ldc + col0;
#pragma unroll
                for (int bj = 0; bj < 2; ++bj) { f32x4 v0 = acc[ai][bj][m][0] + bv[bj][0], v1 = acc[ai][bj][m][1] + bv[bj][1];
                    if (ACT == 1) { f32x2 a = gelu_pk((f32x2){v0[0], v0[1]}), b = gelu_pk((f32x2){v0[2], v0[3]}), c = gelu_pk((f32x2){v1[0], v1[1]}), d = gelu_pk((f32x2){v1[2], v1[3]});
                        v0 = (f32x4){a.x, a.y, b.x, b.y}; v1 = (f32x4){c.x, c.y, d.x, d.y}; }
                    v0 = v0 * sc; v1 = v1 * sc; u32x4 w; w.x = cvt_pk_bf16(v0[0], v0[1]); w.y = cvt_pk_bf16(v0[2], v0[3]); w.z = cvt_pk_bf16(v1[0], v1[1]); w.w = cvt_pk_bf16(v1[2], v1[3]);
                    *(u32x4*)(rowp + bj * HALF) = w; } }
    }
};
typedef int i32x4 __attribute__((ext_vector_type(4)));
template <bool I8> __device__ __forceinline__ f32x4 mma16(bf16x8 b, bf16x8 a, f32x4 c) { return __builtin_amdgcn_mfma_f32_16x16x32_bf16(b, a, c, 0, 0, 0); }
template <bool I8> __device__ __forceinline__ i32x4 mma16(bf16x8 b, bf16x8 a, i32x4 c) { return __builtin_amdgcn_mfma_i32_16x16x64_i8(__builtin_bit_cast(i32x4, b), __builtin_bit_cast(i32x4, a), c, 0, 0, 0); }
struct EpiF32 {
    static constexpr bool PERM = false, AFTER_DRAIN = false;
    float* C; int ldc; int accum;
    __device__ __forceinline__ void operator()(const f32x4 (&acc)[2][2][4][2], const Unit& u, int wr, int wc, int fr, int fq) const {
        asm volatile("" : "+v"(fr), "+v"(fq));
        const int row0 = u.pm * BM + wr * 64 + fr, col0 = u.pn * BM + wc * 32 + 4 * fq;
#pragma unroll
        for (int ai = 0; ai < 2; ++ai)
#pragma unroll
            for (int m = 0; m < 4; ++m) { float* rowp = C + (size_t)(row0 + ai * HALF + m * 16) * ldc + col0;
#pragma unroll
                for (int bj = 0; bj < 2; ++bj)
#pragma unroll
                    for (int n = 0; n < 2; ++n) { f32x4 v = acc[ai][bj][m][n]; if (accum) v += *(const f32x4*)(rowp + bj * HALF + n * 16); *(f32x4*)(rowp + bj * HALF + n * 16) = v; } }
    }
};
struct EpiSwiGLU {
    static constexpr bool PERM = true, AFTER_DRAIN = false;
    bf16_t* O; int ldo; const float* rowscale; int rs_stride;
    __device__ __forceinline__ void operator()(const f32x4 (&acc)[2][2][4][2], const Unit& u, int wr, int wc, int fr, int fq) const {
        asm volatile("" : "+v"(fr), "+v"(fq));
        typedef unsigned u32x2v __attribute__((ext_vector_type(2)));
        const int row0 = u.pm * BM + wr * 64 + fr; const int ch0 = (u.pn * BM + wc * 32 + 8 * fq) >> 1;
#pragma unroll
        for (int ai = 0; ai < 2; ++ai)
#pragma unroll
            for (int m = 0; m < 4; ++m) { const int row = row0 + ai * HALF + m * 16; bf16_t* rowp = O + (size_t)row * ldo + ch0;
                const float rs = rowscale ? rowscale[(size_t)row * rs_stride] : 1.f;
#pragma unroll
                for (int bj = 0; bj < 2; ++bj) { const f32x4 a = acc[ai][bj][m][0], b = acc[ai][bj][m][1]; f32x4 o;
#pragma unroll
                    for (int i = 0; i < 4; ++i) o[i] = a[i] * __builtin_amdgcn_rcpf(1.f + __expf(-a[i])) * b[i] * rs;
                    u32x2v w; w.x = cvt_pk_bf16(o[0], o[1]); w.y = cvt_pk_bf16(o[2], o[3]);
                    *(u32x2v*)(rowp + bj * (HALF / 2)) = w; } }
    }
};

struct MoeOrder : StaticOrder {
    int pb1, pb2, pb3, pb4, pb5, pb6, pb7; size_t estride;
    __device__ __forceinline__ const char* bbase(const Gemm& g, const Unit& u, size_t tstep) const {
        const int e = (u.pm >= pb1) + (u.pm >= pb2) + (u.pm >= pb3) + (u.pm >= pb4) + (u.pm >= pb5) + (u.pm >= pb6) + (u.pm >= pb7);
        return (const char*)(g.Bt + (size_t)e * estride) + (size_t)u.pn * tstep; }
};
struct SplitOrder {
    int nM, nN, S, G, c, pm0; int pb1, pb2, pb3, pb4, pb5, pb6, pb7; size_t estride;
    __device__ __forceinline__ bool next(int i, Unit& u) const { const int L = i * G + c; if (L >= nM * nN * S) return false; u.ks = L % S; const int t = L / S; u.pn = t % nN; u.pm = pm0 + t / nN; return true; }
    __device__ __forceinline__ const char* abase(const Gemm& g, const Unit& u, size_t tstep) const { return (const char*)g.A + (size_t)u.pm * tstep + (size_t)u.ks * g.K * 2; }
    __device__ __forceinline__ const char* bbase(const Gemm& g, const Unit& u, size_t tstep) const {
        const int e = estride ? (u.pm >= pb1) + (u.pm >= pb2) + (u.pm >= pb3) + (u.pm >= pb4) + (u.pm >= pb5) + (u.pm >= pb6) + (u.pm >= pb7) : 0;
        return (const char*)(g.Bt + (size_t)e * estride) + (size_t)u.pn * tstep + (size_t)u.ks * g.K * 2; }
    __device__ __forceinline__ void a_ready(const Unit&) const {}
    __device__ __forceinline__ void done(const Unit&) const {}
};
struct EpiPart {
    static constexpr bool PERM = false, AFTER_DRAIN = false;
    float* C; int ldc; size_t pstride; int pm0;
    __device__ __forceinline__ void operator()(const f32x4 (&acc)[2][2][4][2], const Unit& u, int wr, int wc, int fr, int fq) const {
        asm volatile("" : "+v"(fr), "+v"(fq));
        const int row0 = (u.pm - pm0) * BM + wr * 64 + fr, col0 = u.pn * BM + wc * 32 + 4 * fq; float* base = C + (size_t)u.ks * pstride;
#pragma unroll
        for (int ai = 0; ai < 2; ++ai)
#pragma unroll
            for (int m = 0; m < 4; ++m) { float* rowp = base + (size_t)(row0 + ai * HALF + m * 16) * ldc + col0;
#pragma unroll
                for (int bj = 0; bj < 2; ++bj)
#pragma unroll
                    for (int n = 0; n < 2; ++n) *(f32x4*)(rowp + bj * HALF + n * 16) = acc[ai][bj][m][n]; }
    }
};

struct EpiSwiGLU8 {
    static constexpr bool PERM = true, AFTER_DRAIN = false;
    bf16_t* O; int ldo; const float* rowscale; const float* sa; const unsigned* amax; int pb1, pb2, pb3, pb4, pb5, pb6, pb7;
    __device__ __forceinline__ void operator()(const i32x4 (&acc)[2][2][4][2], const Unit& u, int wr, int wc, int fr, int fq) const {
        typedef unsigned u32x2v __attribute__((ext_vector_type(2))); typedef unsigned u32x4v __attribute__((ext_vector_type(4)));
        asm volatile("" : "+v"(fr), "+v"(fq));
        const int row0 = u.pm * BM + wr * 64 + fr; const int cb0 = u.pn * BM + wc * 32 + 8 * fq; const int ch0 = cb0 >> 1;
        const int e = (u.pm >= pb1) + (u.pm >= pb2) + (u.pm >= pb3) + (u.pm >= pb4) + (u.pm >= pb5) + (u.pm >= pb6) + (u.pm >= pb7);
        const unsigned* am = amax + (size_t)e * 2 * 3584 + cb0;
#pragma unroll
        for (int bj = 0; bj < 2; ++bj) {
            const float* amf = (const float*)am + bj * HALF;
            const f32x4 sb0 = *(const f32x4*)amf * (1.f / 127.f), sb1 = *(const f32x4*)(amf + 4) * (1.f / 127.f);
#pragma unroll
            for (int ai = 0; ai < 2; ++ai)
#pragma unroll
                for (int m = 0; m < 4; ++m) { const int row = row0 + ai * HALF + m * 16; bf16_t* rowp = O + (size_t)row * ldo + ch0 + bj * (HALF / 2);
                    const float sr = sa[row], rs = rowscale ? rowscale[row] : 1.f; f32x4 o;
#pragma unroll
                    for (int i = 0; i < 4; ++i) { const float a = (float)acc[ai][bj][m][0][i] * sr * sb0[i], b = (float)acc[ai][bj][m][1][i] * sr * sb1[i];
                        o[i] = a * __builtin_amdgcn_rcpf(1.f + __expf(-a)) * b * rs; }
                    u32x2v w; w.x = cvt_pk_bf16(o[0], o[1]); w.y = cvt_pk_bf16(o[2], o[3]);
                    *(u32x2v*)rowp = w;
#if PROBE_DUP & 128
                    if (dbg && row < 4096) { f32x4 av, bv;
#pragma unroll
                        for (int i = 0; i < 4; ++i) { av[i] = (float)acc[ai][bj][m][0][i] * sr * sb0[i]; bv[i] = (float)acc[ai][bj][m][1][i] * sr * sb1[i]; }
                        *(f32x4*)((float*)dbg + (size_t)row * ldo + (rowp - (O + (size_t)row * ldo))) = av; *(f32x4*)((float*)dbg + (size_t)4096 * ldo + (size_t)row * ldo + (rowp - (O + (size_t)row * ldo))) = bv; }
#endif
                    } }
    }
#if PROBE_DUP & 128
    int* dbg = nullptr;
#endif
};

struct EpiBf16S8 {
    static constexpr bool PERM = true, AFTER_DRAIN = false;
    bf16_t* O; int ldc; const float* sa; const float* amax;
    __device__ __forceinline__ void operator()(const i32x4 (&acc)[2][2][4][2], const Unit& u, int wr, int wc, int fr, int fq) const {
        asm volatile("" : "+v"(fr), "+v"(fq));
        const int row0 = u.pm * BM + wr * 64 + fr, col0 = u.pn * BM + wc * 32 + 8 * fq;
#pragma unroll
        for (int bj = 0; bj < 2; ++bj) { const f32x4 s0 = *(const f32x4*)(amax + col0 + bj * HALF) * (1.f / 127.f), s1 = *(const f32x4*)(amax + col0 + bj * HALF + 4) * (1.f / 127.f);
#pragma unroll
            for (int ai = 0; ai < 2; ++ai)
#pragma unroll
                for (int m = 0; m < 4; ++m) { const int row = row0 + ai * HALF + m * 16; const float sr = sa[row]; f32x4 v0, v1;
#pragma unroll
                    for (int i = 0; i < 4; ++i) { v0[i] = (float)acc[ai][bj][m][0][i] * sr * s0[i]; v1[i] = (float)acc[ai][bj][m][1][i] * sr * s1[i]; }
                    u32x4 w; w.x = cvt_pk_bf16(v0[0], v0[1]); w.y = cvt_pk_bf16(v0[2], v0[3]); w.z = cvt_pk_bf16(v1[0], v1[1]); w.w = cvt_pk_bf16(v1[2], v1[3]);
                    *(u32x4*)(O + (size_t)row * ldc + col0 + bj * HALF) = w; } }
    }
};
struct EpiPartS8 {
    static constexpr bool PERM = false, AFTER_DRAIN = false;
    float* C; int ldc; size_t pstride; int pm0; const float* sa; const float* amax;
    __device__ __forceinline__ void operator()(const i32x4 (&acc)[2][2][4][2], const Unit& u, int wr, int wc, int fr, int fq) const {
        asm volatile("" : "+v"(fr), "+v"(fq));
        const int row0 = (u.pm - pm0) * BM + wr * 64 + fr, col0 = u.pn * BM + wc * 32 + 4 * fq; float* base = C + (size_t)u.ks * pstride;
#pragma unroll
        for (int bj = 0; bj < 2; ++bj)
#pragma unroll
            for (int n = 0; n < 2; ++n) { const f32x4 sc = *(const f32x4*)(amax + col0 + bj * HALF + n * 16) * (1.f / 127.f);
#pragma unroll
                for (int ai = 0; ai < 2; ++ai)
#pragma unroll
                    for (int m = 0; m < 4; ++m) { const int rl = row0 + ai * HALF + m * 16; const float sr = sa[rl + pm0 * BM]; f32x4 v;
#pragma unroll
                        for (int i = 0; i < 4; ++i) v[i] = (float)acc[ai][bj][m][n][i] * sr * sc[i];
                        *(f32x4*)(base + (size_t)rl * ldc + col0 + bj * HALF + n * 16) = v; } }
    }
};
template <bool I8> struct AccSel { typedef f32x4 type; }; template <> struct AccSel<true> { typedef i32x4 type; };
template <class Epi, class Sched, bool ALIGN_EPI = false, bool SP2 = false, bool I8 = false>
__device__ __forceinline__ void gemm_phase(PG8_LAS unsigned char* lds, const Gemm g, const Sched& S, const Epi& E) {
    int tid_o = threadIdx.x; asm volatile("" : "+v"(tid_o));
    const int tid = tid_o, wid = __builtin_amdgcn_readfirstlane(tid >> 6), lane = tid & 63, wr = wid >> 2, wc = wid & 3, fr = lane & 15, fq = lane >> 4;
    const int K = g.K, nt = K / BK;
    unsigned voffA[2], voffB[2];
#pragma unroll
    for (int i = 0; i < 2; ++i) { int R, C; stage_rc(tid * 16 + i * 8192, R, C); const int Rb = Epi::PERM ? ((R & ~31) + perm32(R & 31)) : R;
        voffA[i] = (unsigned)(R * g.ld + C) * 2u; voffB[i] = (unsigned)(Rb * g.ld + C) * 2u; }
    const size_t kstep = (size_t)(BK * 2);
    const size_t hstep = (size_t)HALF * g.ld * 2;
    const size_t tstep = 2 * hstep;
    const unsigned ldsw = (unsigned)wid * 1024u;
    const int aoff = lds_byte(wr * 64 + fr, fq * 8), boff = lds_byte(wc * 32 + fr, fq * 8);
#define PG8_SA(b, h) (((b) * 2 + (h)) * HTB)
#define PG8_SB(b, h) ((4 + (b) * 2 + (h)) * HTB)
#define PG8_STAGE(bufoff, gbase, voff) do { _Pragma("unroll") for (int _i = 0; _i < 2; ++_i) \
        __builtin_amdgcn_global_load_lds((const unsigned*)((const char*)(gbase) + (voff)[_i]), (PG8_LAS unsigned*)(lds + (bufoff) + ldsw + _i * 8192), 16, 0, 0); } while (0)
#define PG8_LDA(dst, b, h) do { _Pragma("unroll") for (int m = 0; m < 4; ++m) _Pragma("unroll") for (int k = 0; k < 2; ++k) dst[m][k] = *(const PG8_LAS bf16x8*)(lds + PG8_SA(b, h) + aoff + m * 2048 + k * 1024); } while (0)
#define PG8_LDB(dst, b, h) do { _Pragma("unroll") for (int n = 0; n < 2; ++n) _Pragma("unroll") for (int k = 0; k < 2; ++k) dst[n][k] = *(const PG8_LAS bf16x8*)(lds + PG8_SB(b, h) + boff + n * 2048 + k * 1024); } while (0)
#define PG8_MMA(ai, bj, At, Bt) do { __builtin_amdgcn_s_setprio(1); _Pragma("unroll") for (int k = 0; k < 2; ++k) _Pragma("unroll") for (int m = 0; m < 4; ++m) _Pragma("unroll") for (int n = 0; n < 2; ++n) \
        acc[ai][bj][m][n] = mma16<I8>(Bt[n][k], At[m][k], acc[ai][bj][m][n]); __builtin_amdgcn_s_setprio(0); } while (0)
#define PG8_WAIT_V(n) asm volatile("s_waitcnt vmcnt(" #n ")" ::: "memory")
#define PG8_WAIT_L(n) asm volatile("s_waitcnt lgkmcnt(" #n ")" ::: "memory")
#define PG8_BAR __builtin_amdgcn_s_barrier()
#define PG8_SCHED __builtin_amdgcn_sched_barrier(0)
    Unit cur, nxt; int ui = 0;
    if (!S.next(0, cur)) return;
    typedef typename AccSel<I8>::type AccT; AccT acc[2][2][4][2];
#pragma unroll
    for (int a = 0; a < 2; ++a)
#pragma unroll
        for (int b = 0; b < 2; ++b)
#pragma unroll
            for (int m = 0; m < 4; ++m)
#pragma unroll
                for (int n = 0; n < 2; ++n) acc[a][b][m][n] = (AccT)(0);
    bf16x8 At[4][2], B0[2][2], B1[2][2];
    const char* cA = S.abase(g, cur, tstep); const char* cB = S.bbase(g, cur, tstep);
    S.a_ready(cur);
    if constexpr (SP2) {
        PG8_STAGE(PG8_SB(0, 0), cB, voffB); PG8_STAGE(PG8_SB(0, 1), cB + hstep, voffB); PG8_STAGE(PG8_SA(0, 0), cA, voffA); PG8_STAGE(PG8_SA(0, 1), cA + hstep, voffA);
        if (wr == 1) PG8_BAR;
        PG8_WAIT_V(2); PG8_BAR;
        PG8_STAGE(PG8_SB(1, 0), cB + kstep, voffB); PG8_STAGE(PG8_SA(1, 0), cA + kstep, voffA); PG8_STAGE(PG8_SB(1, 1), cB + hstep + kstep, voffB);
        PG8_WAIT_V(6); PG8_BAR;
    } else {
        PG8_STAGE(PG8_SB(0, 0), cB, voffB); PG8_STAGE(PG8_SA(0, 0), cA, voffA); PG8_STAGE(PG8_SB(0, 1), cB + hstep, voffB); PG8_STAGE(PG8_SA(0, 1), cA + hstep, voffA);
        if (wr == 1) PG8_BAR;
        PG8_WAIT_V(4); PG8_BAR;
        PG8_STAGE(PG8_SB(1, 0), cB + kstep, voffB); PG8_STAGE(PG8_SA(1, 0), cA + kstep, voffA); PG8_STAGE(PG8_SB(1, 1), cB + hstep + kstep, voffB);
        PG8_WAIT_V(6); PG8_BAR;
    }
    for (;;) {
        const bool has_next = S.next(ui + 1, nxt);
        const char* nA = has_next ? S.abase(g, nxt, tstep) : cA; const char* nB = has_next ? S.bbase(g, nxt, tstep) : cB;
        for (int t = 0; t < nt; t += 2) {
            const bool last = (t == nt - 2);
            const char* a1 = cA + (size_t)(t + 1) * kstep;
            const char* a2 = last ? nA : cA + (size_t)(t + 2) * kstep; const char* b2 = last ? nB : cB + (size_t)(t + 2) * kstep;
            const char* a3 = a2 + kstep; const char* b3 = b2 + kstep;
            if (last && has_next) S.a_ready(nxt);
            if constexpr (SP2) {
            PG8_LDB(B0, 0, 0); PG8_LDB(B1, 0, 1); PG8_SCHED; PG8_LDA(At, 0, 0); PG8_STAGE(PG8_SA(1, 1), a1 + hstep, voffA);
            PG8_WAIT_V(8); PG8_WAIT_L(0); PG8_BAR; PG8_MMA(0, 0, At, B0); PG8_MMA(0, 1, At, B1); PG8_BAR; PG8_SCHED;
            PG8_LDA(At, 0, 1); PG8_STAGE(PG8_SB(0, 0), b2, voffB); PG8_STAGE(PG8_SB(0, 1), b2 + hstep, voffB); PG8_STAGE(PG8_SA(0, 0), a2, voffA);
            PG8_WAIT_V(8); PG8_WAIT_L(0); PG8_BAR; PG8_MMA(1, 0, At, B0); PG8_MMA(1, 1, At, B1); PG8_BAR; PG8_SCHED;
            PG8_LDB(B0, 1, 0); PG8_LDB(B1, 1, 1); PG8_SCHED; PG8_LDA(At, 1, 0); PG8_STAGE(PG8_SA(0, 1), a2 + hstep, voffA);
            PG8_WAIT_V(8); PG8_WAIT_L(0); PG8_BAR; PG8_MMA(0, 0, At, B0); PG8_MMA(0, 1, At, B1); PG8_BAR; PG8_SCHED;
            PG8_LDA(At, 1, 1); PG8_STAGE(PG8_SB(1, 0), b3, voffB); PG8_STAGE(PG8_SB(1, 1), b3 + hstep, voffB); PG8_STAGE(PG8_SA(1, 0), a3, voffA);
            PG8_WAIT_V(8); PG8_WAIT_L(0); PG8_BAR; PG8_MMA(1, 0, At, B0); PG8_MMA(1, 1, At, B1); PG8_BAR; PG8_SCHED;
            } else {
            PG8_LDB(B0, 0, 0); PG8_SCHED; PG8_LDA(At, 0, 0); PG8_STAGE(PG8_SA(1, 1), a1 + hstep, voffA);
            PG8_WAIT_L(8); PG8_BAR; PG8_WAIT_L(0); PG8_MMA(0, 0, At, B0); PG8_BAR; PG8_SCHED;
            PG8_LDB(B1, 0, 1); PG8_STAGE(PG8_SB(0, 0), b2, voffB);
            PG8_BAR; PG8_WAIT_L(0); PG8_MMA(0, 1, At, B1); PG8_BAR;
            PG8_LDA(At, 0, 1); PG8_STAGE(PG8_SA(0, 0), a2, voffA);
            PG8_BAR; PG8_WAIT_L(0); PG8_MMA(1, 0, At, B0); PG8_BAR; PG8_SCHED;
            PG8_STAGE(PG8_SB(0, 1), b2 + hstep, voffB);
            PG8_WAIT_V(6); PG8_BAR; PG8_MMA(1, 1, At, B1); PG8_BAR;
            PG8_LDB(B0, 1, 0); PG8_SCHED; PG8_LDA(At, 1, 0); PG8_STAGE(PG8_SA(0, 1), a2 + hstep, voffA);
            PG8_WAIT_L(8); PG8_BAR; PG8_WAIT_L(0); PG8_MMA(0, 0, At, B0); PG8_BAR; PG8_SCHED;
            PG8_LDB(B1, 1, 1); PG8_STAGE(PG8_SB(1, 0), b3, voffB);
            PG8_BAR; PG8_WAIT_L(0); PG8_MMA(0, 1, At, B1); PG8_BAR;
            PG8_LDA(At, 1, 1); PG8_STAGE(PG8_SA(1, 0), a3, voffA);
            PG8_BAR; PG8_WAIT_L(0); PG8_MMA(1, 0, At, B0); PG8_BAR; PG8_SCHED;
            PG8_STAGE(PG8_SB(1, 1), b3 + hstep, voffB);
            PG8_WAIT_V(6); PG8_BAR; PG8_MMA(1, 1, At, B1); PG8_BAR;
            }
        }
        if constexpr (ALIGN_EPI) { if (wr == 0) PG8_BAR; }
        if constexpr (!Epi::AFTER_DRAIN) { E(acc, cur, wr, wc, fr, fq); S.done(cur); }
        if (!has_next) break;
#pragma unroll
        for (int a = 0; a < 2; ++a)
#pragma unroll
            for (int b = 0; b < 2; ++b)
#pragma unroll
                for (int m = 0; m < 4; ++m)
#pragma unroll
                    for (int n = 0; n < 2; ++n) acc[a][b][m][n] = (AccT)(0);
        cur = nxt; cA = nA; cB = nB; ++ui;
        if constexpr (ALIGN_EPI) { if (wr == 1) PG8_BAR; }
    }
    PG8_WAIT_V(0);
    if constexpr (!ALIGN_EPI) { if (wr == 0) PG8_BAR; }
    PG8_BAR;
    if constexpr (Epi::AFTER_DRAIN) { E.fused(acc, cur, wr, wc, fr, fq, lds, wid, lane); S.done(cur); }
#undef PG8_SA
#undef PG8_SB
#undef PG8_STAGE
#undef PG8_LDA
#undef PG8_LDB
#undef PG8_MMA
#undef PG8_WAIT_V
#undef PG8_WAIT_L
#undef PG8_BAR
#undef PG8_SCHED
}
}

constexpr int NWAVES = 8;
constexpr int D = 1024, NB = 4, SEQ = 4096, CTXL = 256, NLAT = NB * SEQ, NCTX = NB * CTXL, MROWS = NLAT + NCTX;
constexpr int DEPTH = 4, RW = 512, NH = 8, HS = 64, DFF = 3584, NE = 8, NPROJ = 3456, NP = 3584, NLO = 2560, KLA = 512, NMOD = 6144;
constexpr int PC_R = 0, PC_K = 512, PC_V = 1024, PC_CB = 1536, PC_CC = 2048, PC_CH = 2560, PC_WD = 3072, PC_AD = 3200, PC_GD = 3328;
constexpr float LN_EPS = 1e-5f, GN_EPS = 64e-5f, DN_ALPHA = 1.681792830507429f;
enum { I_X = 0, I_C, I_CTX, I_CCTX, I_WMOD, I_BMOD, I_WIN, I_W0, I_W2, I_A0, I_A2, I_KK, I_KA, I_RK, I_G2, I_LNXG, I_LNXB, I_CONVW, I_WOUT, I_LN1G, I_LN1B, I_LN2G, I_LN2B,
       I_FW1, I_FW3, I_FW2, I_RTW, I_RTB, I_MW1, I_MW3, I_MW2, N_IN };

constexpr size_t MiB = 1u << 20;
constexpr size_t WS_CTL = 0, CTL_BYTES = 3 * MiB;
constexpr size_t WS_MODV = 1 * MiB;
constexpr size_t WS_AMAX = 2 * MiB;
constexpr size_t WS_RKS = 3 * MiB;
constexpr size_t WS_WIN = 4 * MiB;
constexpr size_t WS_WOUT = WS_WIN + 28 * MiB;
constexpr size_t WS_LORA = WS_WOUT + 8 * MiB;
constexpr size_t WS_F13 = WS_LORA + 10 * MiB;
constexpr size_t WS_F2 = WS_F13 + 28 * MiB;
constexpr size_t WS_X = WS_F2 + 14 * MiB;
constexpr size_t WS_H = WS_X + 68 * MiB;
constexpr size_t WS_MOES = WS_H + 34 * MiB;
constexpr size_t WS_ROWLIST = WS_MOES;
constexpr size_t WS_TOKSEL = WS_MOES + 640 * 1024;
constexpr size_t WS_WSEL = WS_TOKSEL + 320 * 1024;
constexpr size_t WS_WSORT = WS_WSEL + 192 * 1024;
constexpr size_t WS_MOEW13 = WS_MOES + 2 * MiB;
constexpr size_t WS_MOEW2 = WS_MOEW13 + 112 * MiB;
constexpr size_t WS_H8 = WS_MOEW13 + 56 * MiB;
constexpr size_t WS_SA = WS_H8 + 17 * MiB;
constexpr size_t WS_SAM = WS_SA + 512 * 1024;
constexpr size_t WS_SAG = WS_SA + 1 * MiB;
constexpr size_t WS_SCR = WS_MOEW2 + 56 * MiB;
constexpr size_t WS_P = WS_SCR;
constexpr size_t WS_LO = WS_P + 119 * MiB;
constexpr size_t WS_PREP = WS_LO + 170 * MiB;
constexpr size_t WS_Y = WS_PREP + 213 * MiB;
constexpr size_t WS_MIXIN = WS_Y + 68 * MiB;
constexpr size_t WS_CH = WS_PREP;
constexpr size_t WS_MIXO = WS_PREP;
constexpr size_t WS_MIXP = WS_PREP + 34 * MiB;
constexpr size_t WS_END_MIXER = WS_MIXIN + 34 * MiB;
constexpr size_t WS_HG = WS_SCR;
constexpr size_t WS_ACT = WS_HG + 72 * MiB;
constexpr size_t WS_F = WS_ACT + 252 * MiB;
constexpr size_t WS_FP = WS_F + 72 * MiB;
constexpr size_t WS_END_FFN = WS_FP + 64 * MiB;
constexpr size_t WS_NEED = WS_END_MIXER > WS_END_FFN ? WS_END_MIXER : WS_END_FFN;
static_assert((size_t)MROWS * NP * 2 <= 119 * MiB && (size_t)MROWS * NLO * 4 <= 170 * MiB && (size_t)8704 * 25600 <= 213 * MiB && (size_t)MROWS * D * 4 <= 68 * MiB && WS_NEED <= 990 * MiB, "ws map");
constexpr int MOE_MAIN_PANELS = 128, MOE_TAIL_ROWS = 4096;
constexpr int MOE_ROWS = 36864;
constexpr int AM_IN = 18 * 2 * DFF, AM_OUT = AM_IN + DEPTH * NP;
constexpr int LORAW_PER_LAYER = 4 * 512 * 64 + 512 * 128;
constexpr int CW_BAR = 4096, CW_GCNT = 8192, CW_CQ = 12288, CW_SDONE = 12544;

constexpr int RING_BYTES = 131072, LDSCTL_OFF = RING_BYTES, MISC_OFF = LDSCTL_OFF + 320, LDS_BYTES = 147456;

typedef unsigned short bf16;
typedef unsigned v4u __attribute__((ext_vector_type(4)));
typedef unsigned v2u __attribute__((ext_vector_type(2)));
typedef float f32x4 __attribute__((ext_vector_type(4)));
#define LAS __attribute__((address_space(3)))
#define LDS_WAIT() asm volatile("s_waitcnt lgkmcnt(0)" ::: "memory")
__device__ __forceinline__ unsigned f2bf(float f) { unsigned u = __builtin_bit_cast(unsigned, f); return (u + 0x7fffu + ((u >> 16) & 1u)) >> 16; }
__device__ __forceinline__ unsigned pk2(float lo, float hi) { return f2bf(lo) | (f2bf(hi) << 16); }
__device__ __forceinline__ float bf2f(unsigned short b) { return __builtin_bit_cast(float, ((unsigned)b) << 16); }
__device__ __forceinline__ float bflo(unsigned w) { return __builtin_bit_cast(float, w << 16); }
__device__ __forceinline__ float bfhi(unsigned w) { return __builtin_bit_cast(float, w & 0xffff0000u); }
__device__ __forceinline__ float wave_sum(float v) {
#pragma unroll
    for (int o = 1; o < 64; o <<= 1) v += __shfl_xor(v, o);
    return v;
}
__device__ __forceinline__ float sigm(float x) { return 1.f / (1.f + __expf(-x)); }

#define XB_TMO      128
#define XB_XCNT(j)  (256  + 64 * (j))
#define XB_XSUB(j)  (1280 + 64 * (j))
#define XB_XGEN(j)  (2304 + 64 * (j))
#define XB_TOP      3328
#define XB_TOPGEN   3392
#define XCD_BAR_WORDS 3456
#define XB_SPIN_CAP (1u << 18)

__device__ __forceinline__ unsigned xb_ld(unsigned* p)              { return __hip_atomic_load(p, __ATOMIC_RELAXED, __HIP_MEMORY_SCOPE_AGENT); }
__device__ __forceinline__ unsigned xb_add(unsigned* p, unsigned v) { return __hip_atomic_fetch_add(p, v, __ATOMIC_RELAXED, __HIP_MEMORY_SCOPE_AGENT); }
__device__ __forceinline__ unsigned xb_xcc_id() { return (unsigned)__builtin_amdgcn_s_getreg((3 << 11) | 20) & 0xFu; }
#define XB_SPIN(cond, bar) do { unsigned _sp = 0; while (cond) { __builtin_amdgcn_s_sleep(1); \
    if ((++_sp & 255u) == 0u) { if (xb_ld(&(bar)[XB_TMO])) break; if (_sp > XB_SPIN_CAP) { atomicAdd(&(bar)[XB_TMO], 1u); break; } } } } while (0)

struct XcdBarrier {
    unsigned* bar; unsigned x;
    volatile LAS unsigned* st;
};

__device__ __forceinline__ XcdBarrier xcd_barrier_post(unsigned* bar, volatile LAS unsigned* st) {
    XcdBarrier b; b.bar = bar; b.x = xb_xcc_id(); b.st = st;
    if (threadIdx.x == 0) (void)xb_add(&bar[XB_XCNT(b.x)], 1u);
    return b;
}
__device__ __forceinline__ void xcd_barrier_complete(unsigned* bar, unsigned x, unsigned& nloc, unsigned& nx) {
    const unsigned G = gridDim.x * gridDim.y * gridDim.z;
    unsigned sum, cnt, mine, sp = 0u;
    for (;;) {
        sum = 0u; cnt = 0u; mine = 0u;
#pragma unroll
        for (unsigned j = 0; j < 16; ++j) { const unsigned c = xb_ld(&bar[XB_XCNT(j)]); sum += c; cnt += (c > 0u) ? 1u : 0u; mine = (j == x) ? c : mine; }
        if (sum == G) break;
        __builtin_amdgcn_s_sleep(1);
        if ((++sp & 255u) == 0u) { if (xb_ld(&bar[XB_TMO])) break; if (sp > XB_SPIN_CAP) { atomicAdd(&bar[XB_TMO], 1u); break; } }
    }
    nloc = mine > 0u ? mine : 1u; nx = cnt > 0u ? cnt : 1u;
}

__device__ __forceinline__ void xcd_barrier(const XcdBarrier& b) {
    asm volatile("s_waitcnt vmcnt(0)" ::: "memory");
    __syncthreads();
    if (threadIdx.x == 0) {
        unsigned* bar = b.bar;
        __builtin_amdgcn_s_waitcnt(0);
        unsigned nloc = b.st[0], nx = b.st[1];
        if (nloc == 0u) { xcd_barrier_complete(bar, b.x, nloc, nx); b.st[0] = nloc; b.st[1] = nx; }
        const unsigned old = xb_add(&bar[XB_XSUB(b.x)], 1u);
        const unsigned gen = old / nloc;
        if (old + 1u == (gen + 1u) * nloc) {
            __builtin_amdgcn_fence(__ATOMIC_RELEASE, "agent");
            asm volatile("s_waitcnt vmcnt(0)" ::: "memory");
            const unsigned og = xb_add(&bar[XB_TOP], 1u);
            const unsigned tg = og / nx;
            if (og + 1u == (tg + 1u) * nx) xb_add(&bar[XB_TOPGEN], 1u);
            else XB_SPIN(xb_ld(&bar[XB_TOPGEN]) == tg, bar);
            __builtin_amdgcn_fence(__ATOMIC_ACQUIRE, "agent");
            xb_add(&bar[XB_XGEN(b.x)], 1u);
            asm volatile("s_waitcnt vmcnt(0)" ::: "memory");
        } else {
            XB_SPIN(xb_ld(&bar[XB_XGEN(b.x)]) == gen, bar);
            __builtin_amdgcn_fence(__ATOMIC_ACQUIRE, "agent");
            asm volatile("s_waitcnt vmcnt(0)" ::: "memory");
        }
    }
    __syncthreads();
}


__device__ __forceinline__ size_t opaque_zero() { size_t z = 0; asm volatile("" : "+s"(z)); return z; }
#define OWS (p.ws + opaque_zero())
__device__ __forceinline__ int opaque_zero_i() { int z = 0; asm volatile("" : "+s"(z)); return z; }
#define PIN(i) (p.in[(i) + opaque_zero_i()])
struct KP { const float* in[N_IN]; float* out; unsigned char* ws; int ph; int pad; };

template <int MODE> __device__ __forceinline__ int rowmap(int n, int arg) {
    if (MODE == 0) return n + arg;
    if (MODE == 1) { if (n < 1536) return n; if (n < 1664) return n - 1536 + PC_WD; if (n < 1792) return n - 1664 + PC_AD; if (n < 1920) return n - 1792 + PC_GD;
                     if (n < 2432) return n - 1920 + PC_CB; if (n < 2944) return n - 2432 + PC_CC; return n - 2944 + PC_CH; }
    return 8 * (n >> 2) + 4 * arg + (n & 3);
}
template <int MODE> __device__ __forceinline__ void transpose_item(const float* W, int K, int N, bf16* WT, int arg, LAS float* scr, int item, int lane) {
    const int nblk = N / 32, kb = item / nblk, nb = item % nblk, k0 = 64 * kb, n0 = 32 * nb;
#pragma unroll 8
    for (int i = 0; i < 32; ++i) { const int kk = 2 * i + (lane >> 5); scr[kk * 33 + (lane & 31)] = W[(size_t)(k0 + kk) * N + n0 + (lane & 31)]; }
    LDS_WAIT(); asm volatile("" ::: "memory");
    const int c = lane & 7;
#pragma unroll
    for (int j = 0; j < 4; ++j) { const int n = (lane >> 3) + 8 * j; const LAS float* s = scr + (8 * c) * 33 + n;
        v4u o; o.x = pk2(s[0 * 33], s[1 * 33]); o.y = pk2(s[2 * 33], s[3 * 33]); o.z = pk2(s[4 * 33], s[5 * 33]); o.w = pk2(s[6 * 33], s[7 * 33]);
        *(v4u*)(WT + (size_t)rowmap<MODE>(n0 + n, arg) * K + k0 + 8 * c) = o; }
    LDS_WAIT(); asm volatile("" ::: "memory");
}

__device__ __forceinline__ void ph_modvec(const KP& p, LAS unsigned char* lds, int tid) {
    LAS float* sil = (LAS float*)lds;
    LAS float* red = (LAS float*)(lds + 5 * 1024 * 4);
    const float* c = PIN(I_C); const float* cc = PIN(I_CCTX);
    for (int i = tid; i < 5 * 1024; i += 512) { const float v = i < 4096 ? c[i] : cc[i - 4096]; sil[i] = v / (1.f + __expf(-v)); }
    __syncthreads();
    float* modv = (float*)(OWS + WS_MODV);
    const int ks = tid >> 6, col = tid & 63;
    for (int task = blockIdx.x; task < DEPTH * 96; task += gridDim.x) {
        const int l = task / 96, j0 = (task % 96) * 64;
        const float* w = PIN(I_WMOD) + (size_t)l * D * NMOD + (size_t)(ks * 128) * NMOD + j0 + col;
        float a0 = 0.f, a1 = 0.f, a2 = 0.f, a3 = 0.f, a4 = 0.f;
#pragma unroll 8
        for (int k = 0; k < 128; ++k) { const float wv = w[(size_t)k * NMOD]; const int kk = ks * 128 + k;
            a0 += sil[kk] * wv; a1 += sil[1024 + kk] * wv; a2 += sil[2048 + kk] * wv; a3 += sil[3072 + kk] * wv; a4 += sil[4096 + kk] * wv; }
        red[(ks * 5 + 0) * 64 + col] = a0; red[(ks * 5 + 1) * 64 + col] = a1; red[(ks * 5 + 2) * 64 + col] = a2; red[(ks * 5 + 3) * 64 + col] = a3; red[(ks * 5 + 4) * 64 + col] = a4;
        __syncthreads();
        if (tid < 320) { const int r = tid >> 6; float s = 0.f;
#pragma unroll
            for (int q = 0; q < 8; ++q) s += red[(q * 5 + r) * 64 + col];
            modv[(size_t)(l * 5 + r) * NMOD + j0 + col] = s + PIN(I_BMOD)[l * NMOD + j0 + col]; }
        __syncthreads();
    }
}

__device__ __forceinline__ void ph_convert(const KP& p, LAS unsigned char* lds, int gw, int NGW, int wave, int lane) {
    LAS float* scr = (LAS float*)(lds + wave * 16384);
    bf16* win = (bf16*)(OWS + WS_WIN); bf16* f2 = (bf16*)(OWS + WS_F2); bf16* lora = (bf16*)(OWS + WS_LORA);
    constexpr int I_IN = (D / 64) * (NPROJ / 32), I_OUT = (D / 64) * (D / 32), I_UP = (D / 64) * (DFF / 32), I_DN = (DFF / 64) * (D / 32);
    for (int it = gw; it < I_DN; it += NGW) transpose_item<0>(PIN(I_FW2), DFF, D, f2, 0, scr, it, lane);
    { const int gt = gw * 64 + lane, NGT = NGW * 64; constexpr int PER = (NP - NPROJ) * D / 16;
      for (int i = gt; i < DEPTH * PER; i += NGT) { const int l = i / PER, q = i % PER; *(v4u*)((unsigned char*)win + (size_t)l * NP * D + (size_t)NPROJ * D + (size_t)q * 16) = (v4u){0u, 0u, 0u, 0u}; } }
    { const int gt = gw * 64 + lane, NGT = NGW * 64;
      for (int i = gt; i < DEPTH * LORAW_PER_LAYER / 8; i += NGT) { const int l = i / (LORAW_PER_LAYER / 8); int q = (i % (LORAW_PER_LAYER / 8)) * 8; float v[8];
          int grp, c, k0; if (q < 4 * 512 * 64) { grp = q / (512 * 64); q -= grp * 512 * 64; c = q / 64; k0 = q % 64; } else { grp = 4; q -= 4 * 512 * 64; c = q / 128; k0 = q % 128; }
#pragma unroll
          for (int j = 0; j < 8; ++j) { const int k = k0 + j;
              v[j] = grp < 2 ? PIN(I_W2)[((size_t)(l * 2 + grp) * 64 + k) * RW + c] : grp < 4 ? PIN(I_A2)[((size_t)(l * 2 + grp - 2) * 64 + k) * RW + c] : PIN(I_G2)[((size_t)l * 128 + k) * RW + c]; }
          v4u o; o.x = pk2(v[0], v[1]); o.y = pk2(v[2], v[3]); o.z = pk2(v[4], v[5]); o.w = pk2(v[6], v[7]);
          *(v4u*)(lora + (size_t)i * 8) = o; } }
}
__device__ __forceinline__ void ph_amax(const KP& p, int gw, int NGW, int lane) {
    unsigned* AM = (unsigned*)(OWS + WS_AMAX);
    for (int it = gw; it < 18 * 2 * (DFF / 64); it += NGW) { const int kq = 0, strip = it % (DFF / 64), sm = it / (DFF / 64), s1 = sm & 1, cm = sm >> 1;
        const float* W = cm < 2 ? PIN(s1 ? I_FW3 : I_FW1) + (size_t)cm * D * DFF : PIN(s1 ? I_MW3 : I_MW1) + (size_t)(cm - 2) * D * DFF;
        const int n = strip * 64 + lane; const float* src = W + (size_t)(kq * 256) * DFF + n; float m = 0.f;
#pragma unroll 16
        for (int k = 0; k < 256; ++k) { const float w = src[(size_t)k * DFF]; m += w * w; }
        AM[(size_t)cm * 2 * DFF + 8 * (n >> 2) + 4 * s1 + (n & 3)] = __builtin_bit_cast(unsigned, 4.25f * sqrtf(m * (1.f / 256.f))); }
    for (int it = gw; it < DEPTH * (NPROJ / 64 + D / 64); it += NGW) { const int kq = 0; int t = it; const int l = t / (NPROJ / 64 + D / 64); t -= l * (NPROJ / 64 + D / 64);
        const bool isin = t < NPROJ / 64; const int strip = isin ? t : t - NPROJ / 64, N = isin ? NPROJ : D, n = strip * 64 + lane;
        const float* src = (isin ? PIN(I_WIN) + (size_t)l * D * NPROJ : PIN(I_WOUT) + (size_t)l * D * D) + (size_t)(kq * 256) * N + n; float m = 0.f;
#pragma unroll 16
        for (int k = 0; k < 256; ++k) { const float w = src[(size_t)k * N]; m += w * w; }
        AM[isin ? AM_IN + l * NP + rowmap<1>(n, 0) : AM_OUT + l * D + n] = __builtin_bit_cast(unsigned, 4.25f * sqrtf(m * (1.f / 256.f))); }
}
__device__ __forceinline__ unsigned q8pack(float a, float b, float c, float d) {
    const int qa = __float2int_rn(fminf(fmaxf(a, -127.f), 127.f)), qb = __float2int_rn(fminf(fmaxf(b, -127.f), 127.f)), qc = __float2int_rn(fminf(fmaxf(c, -127.f), 127.f)), qd = __float2int_rn(fminf(fmaxf(d, -127.f), 127.f));
    return (unsigned)(qa & 255) | ((unsigned)(qb & 255) << 8) | ((unsigned)(qc & 255) << 16) | ((unsigned)(qd & 255) << 24); }
constexpr int CQ_IN = (D / 64) * (NPROJ / 32), CQ_OUT = (D / 64) * (D / 32), CQ_UP = (D / 64) * (DFF / 32), CQ_DN = (DFF / 64) * (D / 32);
constexpr int CQ_NEG = CQ_IN + CQ_OUT + 2 * CQ_UP;
constexpr int CQ_J1 = 3 * CQ_IN + 3 * CQ_OUT + 2 * CQ_UP + CQ_DN, CQ_MOE = NE * (2 * CQ_UP + CQ_DN), CQ_END0 = CQ_J1 + CQ_MOE, CQ_END1 = CQ_END0 + CQ_MOE;
#ifndef CQ_SLOT_ITEMS
#define CQ_SLOT_ITEMS 12000
#endif
struct CqItem { const float* W; bf16* WT; int K, N, mode, arg, item; const unsigned* am; };
__device__ __forceinline__ CqItem cq_decode(const KP& p, int q) {
    CqItem c; bf16* win = (bf16*)(OWS + WS_WIN); bf16* wout = (bf16*)(OWS + WS_WOUT); bf16* f13 = (bf16*)(OWS + WS_F13); bf16* f2 = (bf16*)(OWS + WS_F2);
    bf16* m13 = (bf16*)(OWS + WS_MOEW13); bf16* m2 = (bf16*)(OWS + WS_MOEW2); const unsigned* AM = (const unsigned*)(OWS + WS_AMAX);
    if (q < 0) { q += CQ_NEG;
        if (q < CQ_IN) { c = CqItem{PIN(I_WIN), win, D, NPROJ, 3, 0, q, AM + AM_IN}; return c; } q -= CQ_IN;
        if (q < CQ_OUT) { c = CqItem{PIN(I_WOUT), wout, D, D, 4, 0, q, AM + AM_OUT}; return c; } q -= CQ_OUT;
        if (q < CQ_UP) { c = CqItem{PIN(I_FW1), f13, D, DFF, 2, 0, q, AM}; return c; } q -= CQ_UP;
        c = CqItem{PIN(I_FW3), f13, D, DFF, 2, 1, q, AM}; return c; }
    if (q < 3 * CQ_IN) { const int l = 1 + q / CQ_IN; c = CqItem{PIN(I_WIN) + (size_t)l * D * NPROJ, win + (size_t)l * (NP * D / 2), D, NPROJ, 3, 0, q % CQ_IN, AM + AM_IN + l * NP}; return c; } q -= 3 * CQ_IN;
    if (q < 3 * CQ_OUT) { const int l = 1 + q / CQ_OUT; c = CqItem{PIN(I_WOUT) + (size_t)l * D * D, wout + (size_t)l * (D * D / 2), D, D, 4, 0, q % CQ_OUT, AM + AM_OUT + l * D}; return c; } q -= 3 * CQ_OUT;
    if (q < CQ_UP) { c = CqItem{PIN(I_FW1) + (size_t)D * DFF, f13 + (size_t)DFF * D, D, DFF, 2, 0, q, AM + 2 * DFF}; return c; } q -= CQ_UP;
    if (q < CQ_UP) { c = CqItem{PIN(I_FW3) + (size_t)D * DFF, f13 + (size_t)DFF * D, D, DFF, 2, 1, q, AM + 2 * DFF}; return c; } q -= CQ_UP;
    if (q < CQ_DN) { c = CqItem{PIN(I_FW2) + (size_t)DFF * D, f2 + (size_t)D * DFF, DFF, D, 0, 0, q, nullptr}; return c; } q -= CQ_DN;
    const int mi = q / CQ_MOE; q -= mi * CQ_MOE;
    if (q < NE * CQ_UP) { const int e = q / CQ_UP; c = CqItem{PIN(I_MW1) + ((size_t)mi * NE + e) * D * DFF, m13 + (size_t)e * DFF * D, D, DFF, 2, 0, q % CQ_UP, AM + (size_t)(2 + 8 * mi + e) * 2 * DFF}; return c; } q -= NE * CQ_UP;
    if (q < NE * CQ_UP) { const int e = q / CQ_UP; c = CqItem{PIN(I_MW3) + ((size_t)mi * NE + e) * D * DFF, m13 + (size_t)e * DFF * D, D, DFF, 2, 1, q % CQ_UP, AM + (size_t)(2 + 8 * mi + e) * 2 * DFF}; return c; } q -= NE * CQ_UP;
    { const int e = q / CQ_DN; c = CqItem{PIN(I_MW2) + ((size_t)mi * NE + e) * DFF * D, m2 + (size_t)e * D * DFF, DFF, D, 0, 0, q % CQ_DN, nullptr}; return c; }
}
__device__ __forceinline__ void cq_load(const CqItem& c, int lane, float (&r)[32]) {
    const int nblk = c.N / 32, kb = c.item / nblk, nb = c.item % nblk; const float* src = c.W + (size_t)(64 * kb + (lane >> 5)) * c.N + 32 * nb + (lane & 31);
#pragma unroll
    for (int i = 0; i < 32; ++i) r[i] = src[(size_t)(2 * i) * c.N];
}
__device__ __forceinline__ void cq_store(const CqItem& c, int lane, const float (&r)[32], LAS float* scr) {
    const int nblk = c.N / 32, kb = c.item / nblk, nb = c.item % nblk, k0 = 64 * kb, n0 = 32 * nb;
#pragma unroll
    for (int i = 0; i < 32; ++i) scr[(2 * i + (lane >> 5)) * 33 + (lane & 31)] = r[i];
    LDS_WAIT(); asm volatile("" ::: "memory");
    if (c.mode >= 2) {
        const int n = lane >> 1, hf = lane & 1, nn = n0 + n, j = c.mode == 2 ? 8 * (nn >> 2) + 4 * c.arg + (nn & 3) : c.mode == 3 ? rowmap<1>(nn, 0) : nn;
        const float inv = 127.f / fmaxf(__builtin_bit_cast(float, c.am[j]), 1e-30f); const LAS float* sp = scr + (32 * hf) * 33 + n; unsigned w[8];
#pragma unroll
        for (int q = 0; q < 8; ++q) w[q] = q8pack(sp[(4 * q + 0) * 33] * inv, sp[(4 * q + 1) * 33] * inv, sp[(4 * q + 2) * 33] * inv, sp[(4 * q + 3) * 33] * inv);
        unsigned char* dst = (unsigned char*)c.WT + (size_t)j * c.K + k0 + 32 * hf;
        *(v4u*)dst = (v4u){w[0], w[1], w[2], w[3]}; *(v4u*)(dst + 16) = (v4u){w[4], w[5], w[6], w[7]};
    } else {
    const int cc = lane & 7;
#pragma unroll
    for (int j = 0; j < 4; ++j) { const int n = (lane >> 3) + 8 * j; const LAS float* sp = scr + (8 * cc) * 33 + n;
        v4u o; o.x = pk2(sp[0 * 33], sp[1 * 33]); o.y = pk2(sp[2 * 33], sp[3 * 33]); o.z = pk2(sp[4 * 33], sp[5 * 33]); o.w = pk2(sp[6 * 33], sp[7 * 33]);
        const int nn = n0 + n;
        *(v4u*)(c.WT + (size_t)nn * c.K + k0 + 8 * cc) = o; }
    }
    LDS_WAIT(); asm volatile("" ::: "memory");
}
constexpr int CQ_B = 4;
__device__ __forceinline__ int cq_grab(unsigned* heads, int nseg, int& cnt, int lane) {
    int q = -1, n = 0;
    if (lane == 0) { for (int sg = 0; sg < nseg && q < 0; ++sg) { const int size = sg == 0 ? CQ_J1 : CQ_MOE, base = sg == 0 ? 0 : sg == 1 ? CQ_J1 : CQ_END0; unsigned* hd = heads + 64 * sg;
            if ((int)__hip_atomic_load(hd, __ATOMIC_RELAXED, __HIP_MEMORY_SCOPE_AGENT) < size) { const int t = (int)__hip_atomic_fetch_add(hd, (unsigned)CQ_B, __ATOMIC_RELAXED, __HIP_MEMORY_SCOPE_AGENT);
                if (t < size) { q = base + t; n = size - t < CQ_B ? size - t : CQ_B; } } } }
    cnt = __builtin_amdgcn_readfirstlane(n); return __builtin_amdgcn_readfirstlane(q);
}
__device__ __forceinline__ void cq_run(const KP& p, LAS unsigned char* lds, int nseg, const unsigned* stop, unsigned stopval, int wave, int lane) {
    unsigned* heads = (unsigned*)(OWS + WS_CTL) + CW_CQ; LAS float* scr = (LAS float*)(lds + wave * 16384);
    for (;;) {
        if (stop) { unsigned sv = 0u; if (lane == 0) sv = __hip_atomic_load(stop, __ATOMIC_RELAXED, __HIP_MEMORY_SCOPE_AGENT); if ((unsigned)__builtin_amdgcn_readfirstlane((int)sv) >= stopval) break; }
        int cnt; const int q0 = cq_grab(heads, nseg, cnt, lane); if (q0 < 0) break;
        CqItem cur = cq_decode(p, q0); float ra[32]; cq_load(cur, lane, ra);
        for (int j = 0; j < cnt; ++j) { CqItem nxt = cur; float rb[32];
            if (j + 1 < cnt) { nxt = cq_decode(p, q0 + j + 1); cq_load(nxt, lane, rb); }
            cq_store(cur, lane, ra, scr);
            if (j + 1 < cnt) { cur = nxt;
#pragma unroll
                for (int i = 0; i < 32; ++i) ra[i] = rb[i]; } }
    }
}

__device__ __forceinline__ void cq_static(const KP& p, LAS unsigned char* lds, int q0, int q1, int gw, int NGW, int wave, int lane) {
    LAS float* scr = (LAS float*)(lds + wave * 16384);
    int q = q0 + gw; if (q >= q1) return;
    CqItem cur = cq_decode(p, q); float ra[32]; cq_load(cur, lane, ra);
    for (;;) { const int qn = q + NGW; CqItem nxt = cur; float rb[32];
        if (qn < q1) { nxt = cq_decode(p, qn); cq_load(nxt, lane, rb); }
        cq_store(cur, lane, ra, scr);
        if (qn >= q1) break;
        cur = nxt; q = qn;
#pragma unroll
        for (int i = 0; i < 32; ++i) ra[i] = rb[i]; }
}

__device__ __forceinline__ void ld_row(const float* r, int lane, f32x4 (&v)[4]) { const f32x4* q = (const f32x4*)r + lane;
#pragma unroll
    for (int j = 0; j < 4; ++j) v[j] = q[64 * j]; }
__device__ __forceinline__ void st_row(float* r, int lane, const f32x4 (&v)[4]) { f32x4* q = (f32x4*)r + lane;
#pragma unroll
    for (int j = 0; j < 4; ++j) q[64 * j] = v[j]; }
__device__ __forceinline__ void st_row_bf16(bf16* r, int lane, const f32x4 (&v)[4]) { v2u* q = (v2u*)r + lane;
#pragma unroll
    for (int j = 0; j < 4; ++j) { v2u w; w.x = pk2(v[j][0], v[j][1]); w.y = pk2(v[j][2], v[j][3]); q[64 * j] = w; } }
__device__ __forceinline__ void ld_row_bf16(const bf16* r, int lane, f32x4 (&v)[4]) { const v2u* q = (const v2u*)r + lane;
#pragma unroll
    for (int j = 0; j < 4; ++j) { const v2u w = q[64 * j]; v[j] = (f32x4){bflo(w.x), bfhi(w.x), bflo(w.y), bfhi(w.y)}; } }
template <int S> __device__ __forceinline__ void ld_row_parts(const float* r, size_t pstride, int lane, f32x4 (&v)[4]) {
    ld_row(r, lane, v);
#pragma unroll
    for (int s = 1; s < S; ++s) { f32x4 t[4]; ld_row(r + (size_t)s * pstride, lane, t);
#pragma unroll
        for (int j = 0; j < 4; ++j) v[j] += t[j]; } }
__device__ __forceinline__ int mod_row(int row) { return row < NLAT ? (row >> 12) : 4; }

__device__ __forceinline__ void st_row_q8(unsigned char* dst8, float* scale, int row, int lane, const f32x4 (&v)[4]) {
    float am = 0.f;
#pragma unroll
    for (int j = 0; j < 4; ++j) am = fmaxf(fmaxf(am, fmaxf(fabsf(v[j][0]), fabsf(v[j][1]))), fmaxf(fabsf(v[j][2]), fabsf(v[j][3])));
#pragma unroll
    for (int o = 1; o < 64; o <<= 1) am = fmaxf(am, __shfl_xor(am, o));
    am = fmaxf(am, 1e-30f); const float inv = 127.f / am; unsigned* h8 = (unsigned*)dst8 + (size_t)row * (D / 4) + lane;
#pragma unroll
    for (int j = 0; j < 4; ++j) h8[64 * j] = q8pack(v[j][0] * inv, v[j][1] * inv, v[j][2] * inv, v[j][3] * inv);
    if (lane == 0) scale[row] = am * (1.f / 127.f);
}
__device__ __forceinline__ void ph_init_rows(const KP& p, int gw, int NGW, int lane) {
    const float* modv = (const float*)(OWS + WS_MODV); float* X = (float*)(OWS + WS_X); bf16* H = (bf16*)(OWS + WS_H);
    for (int row = gw; row < MROWS; row += NGW) {
        const float* src = row < NLAT ? PIN(I_X) + (size_t)row * D : PIN(I_CTX) + (size_t)(row - NLAT) * D;
        const float* mv = modv + (size_t)(0 * 5 + mod_row(row)) * NMOD;
        f32x4 x[4], sh[4], sc[4], h[4]; ld_row(src, lane, x); ld_row(mv, lane, sh); ld_row(mv + 1024, lane, sc);
#pragma unroll
        for (int j = 0; j < 4; ++j) h[j] = x[j] * (1.f + sc[j]) + sh[j];
        st_row(X + (size_t)row * D, lane, x); st_row_q8(OWS + WS_H8, (float*)(OWS + WS_SA), row, lane, h);
    }
}

__device__ __forceinline__ int scan_row(int b, int dir, int step) { return step < CTXL ? NLAT + b * CTXL + (dir ? CTXL - 1 - step : step) : b * SEQ + (dir ? SEQ - 1 - (step - CTXL) : step - CTXL); }
typedef short sbf16x8 __attribute__((ext_vector_type(8)));
typedef float f32x16 __attribute__((ext_vector_type(16)));
constexpr int SC_C = 32, SC_NCH = (CTXL + SEQ) / SC_C  , SC_NCHAIN = NB * NH * 2  , SC_NTASK = SC_NCH * SC_NCHAIN  ;
constexpr int CH_G = 0, CH_Q = 8192, CH_UT = 12288, CH_YL = 20480, CH_EC = 24576, CH_BYTES = 25600, CH_NLOAD = 26;

__device__ __forceinline__ f32x16 mm(v4u a, v4u b, f32x16 c) { return __builtin_amdgcn_mfma_f32_32x32x16_bf16(__builtin_bit_cast(sbf16x8, a), __builtin_bit_cast(sbf16x8, b), c, 0, 0, 0); }
typedef float f32x2c __attribute__((ext_vector_type(2))); typedef __bf16 bf16x2c __attribute__((ext_vector_type(2)));
__device__ __forceinline__ unsigned cvtpk(float lo, float hi) { return __builtin_bit_cast(unsigned, __builtin_convertvector((f32x2c){lo, hi}, bf16x2c)); }
template <int S, int NEG> __device__ __forceinline__ v4u cvtf(const f32x16& x) {
    v4u w; const float sg = NEG ? -1.f : 1.f;
    w.x = cvtpk(sg * x[8 * S + 0], sg * x[8 * S + 1]); w.y = cvtpk(sg * x[8 * S + 2], sg * x[8 * S + 3]); w.z = cvtpk(sg * x[8 * S + 4], sg * x[8 * S + 5]); w.w = cvtpk(sg * x[8 * S + 6], sg * x[8 * S + 7]); return w; }
template <int MODE  > __device__ __forceinline__ f32x16 mask_acc(f32x16 x, int n, int hh) {
#pragma unroll
    for (int r = 0; r < 16; ++r) { const int m = (r & 3) + 8 * (r >> 2) + 4 * hh; const bool keep = MODE == 0 ? (m > n) : MODE == 1 ? (m < n) : (m <= n); x[r] = keep ? x[r] : 0.f; }
    return x; }
__device__ __forceinline__ f32x16 zero16() { f32x16 z;
#pragma unroll
    for (int r = 0; r < 16; ++r) z[r] = 0.f;
    return z; }
__device__ __forceinline__ void cm_build(const unsigned (&w)[16], v4u (&f)[2][2]) {
#pragma unroll
    for (int s = 0; s < 2; ++s) {
        const auto r0 = __builtin_amdgcn_permlane32_swap(w[8 * s + 0], w[8 * s + 2], false, false), r1 = __builtin_amdgcn_permlane32_swap(w[8 * s + 1], w[8 * s + 3], false, false);
        const auto r2 = __builtin_amdgcn_permlane32_swap(w[8 * s + 4], w[8 * s + 6], false, false), r3 = __builtin_amdgcn_permlane32_swap(w[8 * s + 5], w[8 * s + 7], false, false);
        f[0][s] = (v4u){r0[0], r1[0], r2[0], r3[0]}; f[1][s] = (v4u){r0[1], r1[1], r2[1], r3[1]}; }
}
__device__ __forceinline__ void st16(unsigned char* base, int off, int lane, v4u v) { *(v4u*)(base + off + lane * 16) = v; }

__device__ __forceinline__ void ph_scan1(const KP& p, int l, int gw, int NGW, int lane) {
    const bf16* P = (const bf16*)(OWS + WS_P); const bf16* LO = (const bf16*)(OWS + WS_LO); const float* NRM = (const float*)(OWS + WS_RKS); unsigned char* CH = OWS + WS_CH;
    const int n = lane & 31, hh = lane >> 5;
    v4u Id[2];
#pragma unroll
    for (int s = 0; s < 2; ++s) { unsigned wd[4];
#pragma unroll
        for (int q = 0; q < 4; ++q) { const int j0 = 2 * q, j1 = 2 * q + 1; const int t0 = 16 * s + 8 * (j0 >> 2) + 4 * hh + (j0 & 3), t1 = 16 * s + 8 * (j1 >> 2) + 4 * hh + (j1 & 3);
            wd[q] = (t0 == n ? 0x3F80u : 0u) | (t1 == n ? 0x3F800000u : 0u); }
        Id[s] = (v4u){wd[0], wd[1], wd[2], wd[3]}; }
    for (int task = gw; task < SC_NTASK; task += NGW) {
        const int dir = task & 1, h = (task >> 1) & 7, b = (task >> 4) & 3, ci = task >> 6;
        const int row0 = scan_row(b, dir, SC_C * ci), sgn = dir ? -1 : 1, c = h * 64 + lane;
        const float w0c = PIN(I_W0)[(l * 2 + dir) * RW + c], a0c = PIN(I_A0)[(l * 2 + dir) * RW + c], kkc = PIN(I_KK)[l * RW + c], kac = PIN(I_KA)[l * RW + c];
        unsigned wAl[16], wBe[16], wKa[16], wRh[16], wV[16], wBp[16], wKp[16];
        float cs = 0.f, Eprev = 1.f;
#pragma unroll
        for (int hb = 0; hb < 2; ++hb) {
            unsigned rk_[16], rr_[16], rv_[16], rw_[16], ra_[16]; float rn_[16];
#pragma unroll
            for (int i = 0; i < 16; ++i) { const int row = row0 + sgn * (16 * hb + i); const bf16* pr = P + (size_t)row * NP; const bf16* lo = LO + (size_t)row * NLO;
                rk_[i] = pr[PC_K + c]; rr_[i] = pr[PC_R + c]; rv_[i] = pr[PC_V + c]; rw_[i] = lo[dir * RW + c]; ra_[i] = lo[1024 + dir * RW + c]; rn_[i] = NRM[row * 8 + h]; }
#pragma unroll
            for (int i = 0; i < 16; ++i) asm volatile("" : "+v"(rk_[i]), "+v"(rr_[i]), "+v"(rv_[i]), "+v"(rw_[i]), "+v"(ra_[i]), "+v"(rn_[i]));
#pragma unroll
            for (int pq = 0; pq < 8; ++pq) { const int pz = 8 * hb + pq; float al[2], be[2], ka[2], rh[2], vv[2];
#pragma unroll
                for (int e = 0; e < 2; ++e) { const int i = 2 * pq + e;
                    const float kv = bf2f((unsigned short)rk_[i]), rv = bf2f((unsigned short)rr_[i]); vv[e] = bf2f((unsigned short)rv_[i]);
                    const float wl = w0c + bf2f((unsigned short)rw_[i]), aa = __builtin_amdgcn_rcpf(1.f + __expf(-(a0c + bf2f((unsigned short)ra_[i])))), nrm = rn_[i];
                    const float lw = -0.6065306597f * __builtin_amdgcn_rcpf(1.f + __expf(-wl));
                    cs += lw; const float E = __expf(cs), Ei = __builtin_amdgcn_rcpf(E);
                    const float kkn = kv * kkc * nrm, kd = kv * (1.f + (aa - 1.f) * kac);
                    al[e] = kkn * Eprev; be[e] = kkn * aa * Ei; ka[e] = kd * Ei; rh[e] = rv * E; Eprev = E; }
                wAl[pz] = cvtpk(al[0], al[1]); wBe[pz] = cvtpk(be[0], be[1]); wKa[pz] = cvtpk(ka[0], ka[1]); wRh[pz] = cvtpk(rh[0], rh[1]); wV[pz] = cvtpk(vv[0], vv[1]); }
        }
        const float EC = Eprev;
#pragma unroll
        for (int pz = 0; pz < 16; ++pz) { wBp[pz] = cvtpk(bflo(wBe[pz]) * EC, bfhi(wBe[pz]) * EC); wKp[pz] = cvtpk(bflo(wKa[pz]) * EC, bfhi(wKa[pz]) * EC); }
        unsigned char* img = CH + (size_t)(((b * 8 + h) * 2 + dir) * SC_NCH + ci) * CH_BYTES;
        ((float*)(img + CH_EC))[lane] = EC;
        v4u cAl[2][2], cV[2][2], cBp[2][2], cKp[2][2], cRh[2][2];
        v4u tAl[4], tBe[4], tKa[4], tRh[4];
        cm_build(wAl, cAl); cm_build(wV, cV); cm_build(wBp, cBp); cm_build(wKp, cKp); cm_build(wRh, cRh);
        {   v4u cBe[2][2], cKa[2][2]; cm_build(wBe, cBe); cm_build(wKa, cKa);
#define TRANSPOSE(cZ, tZ) do { _Pragma("unroll") for (int ct = 0; ct < 2; ++ct) { f32x16 T_ = mm(cZ[ct][0], Id[0], zero16()); T_ = mm(cZ[ct][1], Id[1], T_); tZ[2 * ct] = cvtf<0, 0>(T_); tZ[2 * ct + 1] = cvtf<1, 0>(T_); } } while (0)
            TRANSPOSE(cAl, tAl); TRANSPOSE(cBe, tBe); TRANSPOSE(cKa, tKa); TRANSPOSE(cRh, tRh);
#undef TRANSPOSE
        }
#define PROD4(A, B) mm(A[3], B[3], mm(A[2], B[2], mm(A[1], B[1], mm(A[0], B[0], zero16()))))
        f32x16 XN = mask_acc<0>(PROD4(tAl, tBe), n, hh), XT = mask_acc<1>(PROD4(tBe, tAl), n, hh);
        v4u fLM[2], fGB[2], fGK[2];
        { const f32x16 t = mask_acc<1>(PROD4(tKa, tAl), n, hh); fLM[0] = cvtf<0, 0>(t); fLM[1] = cvtf<1, 0>(t); }
        { const f32x16 t = mask_acc<2>(PROD4(tBe, tRh), n, hh); fGB[0] = cvtf<0, 0>(t); fGB[1] = cvtf<1, 0>(t); }
        { const f32x16 t = mask_acc<2>(PROD4(tKa, tRh), n, hh); fGK[0] = cvtf<0, 0>(t); fGK[1] = cvtf<1, 0>(t); }
#undef PROD4
#pragma unroll
        for (int r = 0; r < 16; ++r) { XN[r] = -XN[r]; XT[r] = -XT[r]; }
        f32x16 RT = XT;
#pragma unroll
        for (int r = 0; r < 16; ++r) RT[r] += ((r & 3) + 8 * (r >> 2) + 4 * hh == n) ? 1.f : 0.f;
#pragma unroll
        for (int pw = 1; pw < 5; ++pw) {
            const v4u xn0 = cvtf<0, 0>(XN), xn1 = cvtf<1, 0>(XN), xt0 = cvtf<0, 0>(XT), xt1 = cvtf<1, 0>(XT);
            XN = mm(xt1, xn1, mm(xt0, xn0, zero16()));
            if (pw < 4) XT = mm(xn1, xt1, mm(xn0, xt0, zero16()));
            const v4u yn0 = cvtf<0, 0>(XN), yn1 = cvtf<1, 0>(XN), rt0 = cvtf<0, 0>(RT), rt1 = cvtf<1, 0>(RT);
            RT = mm(yn1, rt1, mm(yn0, rt0, RT));
        }
        const v4u fA0 = cvtf<0, 0>(RT), fA1 = cvtf<1, 0>(RT);
        f32x16 At[2], Vt[2];
#pragma unroll
        for (int t = 0; t < 2; ++t) {
            const f32x16 lmv = mm(fLM[1], cV[t][1], mm(fLM[0], cV[t][0], zero16()));
            At[t] = mm(fA1, cAl[t][1], mm(fA0, cAl[t][0], zero16()));
            Vt[t] = mm(fA1, cvtf<1, 0>(lmv), mm(fA0, cvtf<0, 0>(lmv), zero16()));
        }
#pragma unroll
        for (int kt1 = 0; kt1 < 2; ++kt1) { const v4u a0 = cvtf<0, 0>(At[kt1]), a1 = cvtf<1, 0>(At[kt1]);
#pragma unroll
            for (int kt2 = 0; kt2 < 2; ++kt2) { const f32x16 g = mm(a1, cBp[kt2][1], mm(a0, cBp[kt2][0], zero16()));
                st16(img, CH_G + ((kt2 * 2 + kt1) * 2 + 0) * 1024, lane, cvtf<0, 1>(g)); st16(img, CH_G + ((kt2 * 2 + kt1) * 2 + 1) * 1024, lane, cvtf<1, 1>(g)); } }
#pragma unroll
        for (int vt = 0; vt < 2; ++vt) { const v4u nv0 = cvtf<0, 1>(Vt[vt]), nv1 = cvtf<1, 1>(Vt[vt]);
#pragma unroll
            for (int kt = 0; kt < 2; ++kt) { f32x16 u = mm(cKp[kt][1], cV[vt][1], mm(cKp[kt][0], cV[vt][0], zero16())); u = mm(cBp[kt][1], nv1, mm(cBp[kt][0], nv0, u));
                st16(img, CH_UT + ((kt * 2 + vt) * 2 + 0) * 1024, lane, cvtf<0, 0>(u)); st16(img, CH_UT + ((kt * 2 + vt) * 2 + 1) * 1024, lane, cvtf<1, 0>(u)); }
            f32x16 y = mm(cV[vt][1], fGK[1], mm(cV[vt][0], fGK[0], zero16())); y = mm(nv1, fGB[1], mm(nv0, fGB[0], y));
            st16(img, CH_YL + (vt * 2 + 0) * 1024, lane, cvtf<0, 0>(y)); st16(img, CH_YL + (vt * 2 + 1) * 1024, lane, cvtf<1, 0>(y)); }
#pragma unroll
        for (int kt = 0; kt < 2; ++kt) { f32x16 q = mm(cRh[kt][1], Id[1], mm(cRh[kt][0], Id[0], zero16()));
            q = mm(cvtf<1, 1>(At[kt]), fGB[1], mm(cvtf<0, 1>(At[kt]), fGB[0], q));
            st16(img, CH_Q + (kt * 2 + 0) * 1024, lane, cvtf<0, 0>(q)); st16(img, CH_Q + (kt * 2 + 1) * 1024, lane, cvtf<1, 0>(q)); }
    }
}

__device__ __forceinline__ void ph_scan2(const KP& p, LAS unsigned char* lds, int l, int wave, int lane) {
    unsigned* sdone = (unsigned*)(OWS + WS_CTL) + CW_SDONE + 64 * l;
#ifndef CQ_SLOT_WGS
#define CQ_SLOT_WGS 128
#endif
    if (blockIdx.x >= SC_NCHAIN * 2) {
        const int q0 = (l < 2 ? CQ_J1 : CQ_END0) + (l & 1) * CQ_SLOT_ITEMS;
        cq_static(p, lds, q0, q0 + CQ_SLOT_ITEMS, ((int)blockIdx.x - SC_NCHAIN * 2) * NWAVES + wave, ((int)gridDim.x - SC_NCHAIN * 2) * NWAVES, wave, lane); return; }
    const int chain = blockIdx.x >> 1, vt = blockIdx.x & 1, dir = chain & 1, h = (chain >> 1) & 7, b = chain >> 4;
    const int n = lane & 31, hh = lane >> 5;
    const unsigned char* CH = OWS + WS_CH + (size_t)chain * SC_NCH * CH_BYTES; bf16* Y = (bf16*)(OWS + WS_Y) + (size_t)dir * MROWS * RW + h * 64 + 32 * vt + 4 * hh;
    constexpr int NPIECE = 19, SLOT = NPIECE * 1024, NSLOT = 6, PD = 4, XCH = NSLOT * SLOT;
    int psrc[3], pdst[3];
#pragma unroll
    for (int j = 0; j < 3; ++j) { int f = wave + 8 * j; if (f >= NPIECE) f -= NPIECE;
        pdst[j] = f;
        psrc[j] = f < 12 ? f * 1024 : f < 16 ? CH_UT + ((((f - 12) >> 1) * 2 + vt) * 2 + ((f - 12) & 1)) * 1024 : f < 18 ? CH_YL + (vt * 2 + (f - 16)) * 1024 : CH_EC; }
    const int lane_off[3] = {pdst[0] == 18 ? (lane * 16) & 255 : lane * 16, pdst[1] == 18 ? (lane * 16) & 255 : lane * 16, pdst[2] == 18 ? (lane * 16) & 255 : lane * 16};
#define SC2_ISSUE(ci_, slot_) do { const unsigned char* im_ = CH + (size_t)(ci_) * CH_BYTES; LAS unsigned char* sl_ = lds + (slot_) * SLOT; \
        _Pragma("unroll") for (int j = 0; j < 3; ++j) __builtin_amdgcn_global_load_lds((const unsigned*)(im_ + psrc[j] + lane_off[j]), (LAS unsigned*)(sl_ + pdst[j] * 1024), 16, 0, 0); } while (0)
#define SC2_LD(slot_, piece_) (*(const LAS v4u*)(lds + (slot_) * SLOT + (piece_) * 1024 + lane * 16))
#define SC2_X(par_, k_) (*(LAS v4u*)(lds + XCH + (par_) * 4096 + (k_) * 1024 + lane * 16))
    f32x16 ST[2] = {zero16(), zero16()};
    SC2_ISSUE(0, 0); SC2_ISSUE(1, 1); SC2_ISSUE(2, 2); SC2_ISSUE(3, 3);
    v4u g0, g1, g2, g3, g4, g5, g6, g7, u0, u1, u2, u3; f32x4 ec[8];
#define SC2_PRELOAD(slot_) do { g0 = SC2_LD(slot_, 0); g1 = SC2_LD(slot_, 1); g2 = SC2_LD(slot_, 2); g3 = SC2_LD(slot_, 3); g4 = SC2_LD(slot_, 4); g5 = SC2_LD(slot_, 5); g6 = SC2_LD(slot_, 6); g7 = SC2_LD(slot_, 7); \
        u0 = SC2_LD(slot_, 12); u1 = SC2_LD(slot_, 13); u2 = SC2_LD(slot_, 14); u3 = SC2_LD(slot_, 15); \
        _Pragma("unroll") for (int kq = 0; kq < 8; ++kq) ec[kq] = *(const LAS f32x4*)(lds + (slot_) * SLOT + 18 * 1024 + (32 * (kq >> 2) + 8 * (kq & 3) + 4 * hh) * 4); } while (0)
    for (int ci = 0; ci <= SC_NCH; ++ci) {
        asm volatile("s_waitcnt vmcnt(6)" ::: "memory");
        __builtin_amdgcn_s_barrier();
        asm volatile("" ::: "memory");
        { const int nx = ci + PD < SC_NCH ? ci + PD : SC_NCH - 1; SC2_ISSUE(nx, (ci + PD) % NSLOT); }
        if (wave == 0 && ci < SC_NCH) {
            if (ci == 0) SC2_PRELOAD(0);
            asm volatile("" : "+v"(g0), "+v"(g1), "+v"(g2), "+v"(g3), "+v"(g4), "+v"(g5), "+v"(g6), "+v"(g7), "+v"(u0), "+v"(u1), "+v"(u2), "+v"(u3));
            asm volatile("" : "+v"(ec[0]), "+v"(ec[1]), "+v"(ec[2]), "+v"(ec[3]), "+v"(ec[4]), "+v"(ec[5]), "+v"(ec[6]), "+v"(ec[7]));
            const v4u s00 = cvtf<0, 0>(ST[0]), s01 = cvtf<1, 0>(ST[0]), s10 = cvtf<0, 0>(ST[1]), s11 = cvtf<1, 0>(ST[1]);
            SC2_X(ci & 1, 0) = s00; SC2_X(ci & 1, 1) = s01; SC2_X(ci & 1, 2) = s10; SC2_X(ci & 1, 3) = s11;
            f32x16 a0, a1;
            a0[0] = bflo(u0.x); a0[1] = bfhi(u0.x); a0[2] = bflo(u0.y); a0[3] = bfhi(u0.y); a0[4] = bflo(u0.z); a0[5] = bfhi(u0.z); a0[6] = bflo(u0.w); a0[7] = bfhi(u0.w);
            a0[8] = bflo(u1.x); a0[9] = bfhi(u1.x); a0[10] = bflo(u1.y); a0[11] = bfhi(u1.y); a0[12] = bflo(u1.z); a0[13] = bfhi(u1.z); a0[14] = bflo(u1.w); a0[15] = bfhi(u1.w);
            a1[0] = bflo(u2.x); a1[1] = bfhi(u2.x); a1[2] = bflo(u2.y); a1[3] = bfhi(u2.y); a1[4] = bflo(u2.z); a1[5] = bfhi(u2.z); a1[6] = bflo(u2.w); a1[7] = bfhi(u2.w);
            a1[8] = bflo(u3.x); a1[9] = bfhi(u3.x); a1[10] = bflo(u3.y); a1[11] = bfhi(u3.y); a1[12] = bflo(u3.z); a1[13] = bfhi(u3.z); a1[14] = bflo(u3.w); a1[15] = bfhi(u3.w);
#pragma unroll
            for (int q = 0; q < 4; ++q)
#pragma unroll
                for (int e = 0; e < 4; ++e) { a0[4 * q + e] += ST[0][4 * q + e] * ec[q][e]; a1[4 * q + e] += ST[1][4 * q + e] * ec[4 + q][e]; }
            a0 = mm(g0, s00, a0); a1 = mm(g4, s00, a1); a0 = mm(g1, s01, a0); a1 = mm(g5, s01, a1);
            a0 = mm(g2, s10, a0); a1 = mm(g6, s10, a1); a0 = mm(g3, s11, a0); a1 = mm(g7, s11, a1);
            if (ci + 1 < SC_NCH) SC2_PRELOAD((ci + 1) % NSLOT);
            ST[0] = a0; ST[1] = a1;
            if (lane == 0 && ci == SC_NCH - 24) __hip_atomic_fetch_add(sdone, 1u, __ATOMIC_RELAXED, __HIP_MEMORY_SCOPE_AGENT);
        } else if (wave == 1 && ci >= 1) {
            const int cj = ci - 1, sj = cj % NSLOT, par = cj & 1;
            v4u ya = SC2_LD(sj, 16), yc = SC2_LD(sj, 17), q0 = SC2_LD(sj, 8), q1 = SC2_LD(sj, 9), q2 = SC2_LD(sj, 10), q3 = SC2_LD(sj, 11), x0 = SC2_X(par, 0), x1 = SC2_X(par, 1), x2 = SC2_X(par, 2), x3 = SC2_X(par, 3);
            asm volatile("" : "+v"(ya), "+v"(yc), "+v"(q0), "+v"(q1), "+v"(q2), "+v"(q3), "+v"(x0), "+v"(x1), "+v"(x2), "+v"(x3));
            f32x16 y, y2 = zero16();
            y[0] = bflo(ya.x); y[1] = bfhi(ya.x); y[2] = bflo(ya.y); y[3] = bfhi(ya.y); y[4] = bflo(ya.z); y[5] = bfhi(ya.z); y[6] = bflo(ya.w); y[7] = bfhi(ya.w);
            y[8] = bflo(yc.x); y[9] = bfhi(yc.x); y[10] = bflo(yc.y); y[11] = bfhi(yc.y); y[12] = bflo(yc.z); y[13] = bfhi(yc.z); y[14] = bflo(yc.w); y[15] = bfhi(yc.w);
            y = mm(x0, q0, y); y2 = mm(x2, q2, y2); y = mm(x1, q1, y); y2 = mm(x3, q3, y2);
            const int row = scan_row(b, dir, SC_C * cj + n); bf16* yo = Y + (size_t)row * RW;
#pragma unroll
            for (int q = 0; q < 4; ++q) *(v2u*)(yo + 8 * q) = (v2u){cvtpk(y[4 * q] + y2[4 * q], y[4 * q + 1] + y2[4 * q + 1]), cvtpk(y[4 * q + 2] + y2[4 * q + 2], y[4 * q + 3] + y2[4 * q + 3])};
        }
        asm volatile("s_waitcnt lgkmcnt(0)" ::: "memory");
    }
    asm volatile("s_waitcnt vmcnt(0)" ::: "memory");
#undef SC2_ISSUE
#undef SC2_LD
#undef SC2_X
#undef SC2_PRELOAD
}

__device__ __forceinline__ float sum8(float v) { v += __shfl_xor(v, 1); v += __shfl_xor(v, 2); v += __shfl_xor(v, 4); return v; }
__device__ __forceinline__ void unpack8(v4u s, float (&v)[8]) { v[0] = bflo(s.x); v[1] = bfhi(s.x); v[2] = bflo(s.y); v[3] = bfhi(s.y); v[4] = bflo(s.z); v[5] = bfhi(s.z); v[6] = bflo(s.w); v[7] = bfhi(s.w); }
__device__ __forceinline__ void ld8f(const float* q, float (&v)[8]) { const f32x4 a = *(const f32x4*)q, b = *(const f32x4*)(q + 4); v[0] = a[0]; v[1] = a[1]; v[2] = a[2]; v[3] = a[3]; v[4] = b[0]; v[5] = b[1]; v[6] = b[2]; v[7] = b[3]; }
__device__ __forceinline__ v4u pack8(const float (&v)[8]) { v4u o; o.x = cvtpk(v[0], v[1]); o.y = cvtpk(v[2], v[3]); o.z = cvtpk(v[4], v[5]); o.w = cvtpk(v[6], v[7]); return o; }

__device__ __forceinline__ void ph_readout2(const KP& p, int l, int gw, int NGW, int lane) {
    const bf16* P = (const bf16*)(OWS + WS_P); const bf16* LO = (const bf16*)(OWS + WS_LO); const bf16* Y = (const bf16*)(OWS + WS_Y);
    bf16* MI = (bf16*)(OWS + WS_MIXIN); constexpr size_t PA = (size_t)MROWS * RW; const int c0 = lane * 8;
#pragma unroll 2
    for (int row = gw; row < MROWS; row += NGW) { const bf16* pr = P + (size_t)row * NP; const bf16* lo = LO + (size_t)row * NLO;
        int t, len; if (row < NLAT) { t = row & 63; len = 64; } else { t = (row - NLAT) & 255; len = 256; }
        const v4u kw = *(const v4u*)(pr + PC_K + c0), rw = *(const v4u*)(pr + PC_R + c0), vw = *(const v4u*)(pr + PC_V + c0);
        const v4u cbw = *(const v4u*)(pr + PC_CB + c0), ccw = *(const v4u*)(pr + PC_CC + c0), chw = *(const v4u*)(pr + PC_CH + c0);
        v4u ccp = (v4u){0u, 0u, 0u, 0u}, chp = ccp, ccn = ccp, chn = ccp;
        if (t > 0) { ccp = *(const v4u*)(pr - NP + PC_CC + c0); chp = *(const v4u*)(pr - NP + PC_CH + c0); }
        if (t < len - 1) { ccn = *(const v4u*)(pr + NP + PC_CC + c0); chn = *(const v4u*)(pr + NP + PC_CH + c0); }
        float yf[8], yb[8], la0[8], la1[8], g[8];
        unpack8(*(const v4u*)(Y + (size_t)row * RW + c0), yf); unpack8(*(const v4u*)(Y + PA + (size_t)row * RW + c0), yb); unpack8(*(const v4u*)(lo + 1024 + c0), la0); unpack8(*(const v4u*)(lo + 1536 + c0), la1); unpack8(*(const v4u*)(lo + 2048 + c0), g);
        float a0[8], a1[8], ka[8], rkp[8], lg[8], lb[8];
        ld8f(PIN(I_A0) + (l * 2 + 0) * RW + c0, a0); ld8f(PIN(I_A0) + (l * 2 + 1) * RW + c0, a1); ld8f(PIN(I_KA) + l * RW + c0, ka); ld8f(PIN(I_RK) + l * RW + c0, rkp);
        ld8f(PIN(I_LNXG) + l * RW + c0, lg); ld8f(PIN(I_LNXB) + l * RW + c0, lb);
        float kv[8], rv[8], vv[8]; unpack8(kw, kv); unpack8(rw, rv); unpack8(vw, vv);
        float y[8], s = 0.f, rk = 0.f;
#pragma unroll
        for (int j = 0; j < 8; ++j) { y[j] = yf[j] + yb[j]; s += y[j]; const float av = sigm(a0[j] + la0[j]) + sigm(a1[j] + la1[j]); rk += rv[j] * kv[j] * (2.f + (av - 2.f) * ka[j]) * rkp[j]; }
        const float mu = sum8(s) * (1.f / 64.f); rk = sum8(rk); float q = 0.f;
#pragma unroll
        for (int j = 0; j < 8; ++j) { y[j] -= mu; q += y[j] * y[j]; }
        const float rstd = 1.f / sqrtf(sum8(q) * (1.f / 64.f) + GN_EPS);
        float o[8];
#pragma unroll
        for (int j = 0; j < 8; ++j) o[j] = (y[j] * rstd * lg[j] + lb[j] + rk * vv[j]) * g[j];
        float orw[8];
#pragma unroll
        for (int j = 0; j < 8; ++j) orw[j] = o[j];
        float cb[8], cc[8], ch[8], pcc[8], pch[8], ncc[8], nch[8], w0[8], w1[8], w2[8];
        unpack8(cbw, cb); unpack8(ccw, cc); unpack8(chw, ch); unpack8(ccp, pcc); unpack8(chp, pch); unpack8(ccn, ncc); unpack8(chn, nch);
        const float* cw = PIN(I_CONVW) + (size_t)l * 3 * RW + c0; ld8f(cw, w0); ld8f(cw + RW, w1); ld8f(cw + 2 * RW, w2);
#pragma unroll
        for (int j = 0; j < 8; ++j) o[j] = cb[j] * (pcc[j] * pch[j] * w0[j] + cc[j] * ch[j] * w1[j] + ncc[j] * nch[j] * w2[j]);
        float am = 0.f;
#pragma unroll
        for (int j = 0; j < 8; ++j) am = fmaxf(am, fmaxf(fabsf(orw[j]), fabsf(o[j])));
#pragma unroll
        for (int sh = 1; sh < 64; sh <<= 1) am = fmaxf(am, __shfl_xor(am, sh));
        am = fmaxf(am, 1e-30f); const float inv = 127.f / am; unsigned char* m8 = (unsigned char*)MI + (size_t)row * D + c0;
        *(v2u*)m8 = (v2u){q8pack(orw[0] * inv, orw[1] * inv, orw[2] * inv, orw[3] * inv), q8pack(orw[4] * inv, orw[5] * inv, orw[6] * inv, orw[7] * inv)};
        *(v2u*)(m8 + RW) = (v2u){q8pack(o[0] * inv, o[1] * inv, o[2] * inv, o[3] * inv), q8pack(o[4] * inv, o[5] * inv, o[6] * inv, o[7] * inv)};
        if (lane == 0) ((float*)(OWS + WS_SAM))[row] = am * (1.f / 127.f);
    }
}


template <int KS> __device__ __forceinline__ void lora_task(const bf16* pr, int col0, int fn, const bf16* wt, bf16* out, int ct0, int n, int hh) {
    v4u af[KS];
#pragma unroll
    for (int s = 0; s < KS; ++s) { const v4u w = *(const v4u*)(pr + col0 + 16 * s + 8 * hh); float v[8]; unpack8(w, v);
        if (fn == 0) {
#pragma unroll
            for (int j = 0; j < 8; ++j) v[j] = 1.f - 2.f * __builtin_amdgcn_rcpf(1.f + __expf(2.f * v[j])); }
        else if (fn == 2) {
#pragma unroll
            for (int j = 0; j < 8; ++j) v[j] = __builtin_amdgcn_rcpf(1.f + __expf(-v[j])); }
        af[s] = pack8(v); }
#pragma unroll 2
    for (int ct = ct0; ct < ct0 + 8; ++ct) { f32x16 acc = zero16(); const bf16* wb = wt + (size_t)(32 * ct + n) * (16 * KS) + 8 * hh;
#pragma unroll
        for (int s = 0; s < KS; ++s) acc = mm(af[s], *(const v4u*)(wb + 16 * s), acc);
#pragma unroll
        for (int r = 0; r < 16; ++r) out[(size_t)((r & 3) + 8 * (r >> 2) + 4 * hh) * NLO + 32 * ct + n] = (bf16)f2bf(acc[r]); }
}
__device__ __forceinline__ void ph_lora(const KP& p, int l, int gw, int NGW, int lane) {
    const bf16* P = (const bf16*)(OWS + WS_P); bf16* LO = (bf16*)(OWS + WS_LO); float* NRM = (float*)(OWS + WS_RKS);
    const bf16* LW = (const bf16*)(OWS + WS_LORA) + (size_t)l * LORAW_PER_LAYER; const int n = lane & 31, hh = lane >> 5;
    for (int task = gw; task < (MROWS / 32) * 10; task += NGW) { const int half = task & 1, grp = (task >> 1) % 5, rb = task / 10;
        const bf16* pr = P + (size_t)(rb * 32 + n) * NP; bf16* out = LO + (size_t)(rb * 32) * NLO + grp * 512;
        if (grp < 4) lora_task<4>(pr, grp < 2 ? PC_WD + 64 * grp : PC_AD + 64 * (grp - 2), grp < 2 ? 0 : 1, LW + (size_t)grp * 512 * 64, out, half * 8, n, hh);
        else lora_task<8>(pr, PC_GD, 2, LW + (size_t)4 * 512 * 64, out, half * 8, n, hh); }
    float kkc[8]; ld8f(PIN(I_KK) + l * RW + lane * 8, kkc);
    for (int row = gw; row < MROWS; row += NGW) { const v4u kw = *(const v4u*)(P + (size_t)row * NP + PC_K + lane * 8); float kv[8]; unpack8(kw, kv); float ss = 0.f;
#pragma unroll
        for (int j = 0; j < 8; ++j) { const float t = kv[j] * kkc[j]; ss += t * t; }
        ss = sum8(ss); if ((lane & 7) == 0) NRM[row * 8 + (lane >> 3)] = 1.f / fmaxf(sqrtf(ss), 1e-12f); }
}

__device__ __forceinline__ void ph_moe_gather(const KP& p, int l, int gw, int NGW, int lane) {
    const unsigned* gcnt = (const unsigned*)(OWS + WS_CTL) + CW_GCNT + 64 * (l >> 1);
    int cnt[8], pb[9]; pb[0] = 0;
#pragma unroll
    for (int e = 0; e < 8; ++e) { cnt[e] = (int)gcnt[e]; pb[e + 1] = pb[e] + ((cnt[e] + 255) & ~255); }
    const unsigned* rowlist = (const unsigned*)(OWS + WS_ROWLIST); const float* wsel = (const float*)(OWS + WS_WSEL); float* wsort = (float*)(OWS + WS_WSORT);
    const unsigned char* H8 = OWS + WS_H8; unsigned char* HG = OWS + WS_HG; const float* sa = (const float*)(OWS + WS_SA); float* sag = (float*)(OWS + WS_SAG);
    for (int pos = gw; pos < pb[8]; pos += NGW) {
        int e = 0, base = 0, ce = cnt[0];
#pragma unroll
        for (int k = 1; k < 8; ++k) if (pos >= pb[k]) { e = k; base = pb[k]; ce = cnt[k]; }
        const int rank = pos - base; v4u a = (v4u){0u, 0u, 0u, 0u}; float w = 0.f, sc = 0.f;
        if (rank < ce) { const unsigned ent = rowlist[(size_t)e * MROWS + rank]; a = *(const v4u*)(H8 + (size_t)(ent >> 1) * D + lane * 16); w = wsel[ent]; sc = sa[ent >> 1]; }
        *(v4u*)(HG + (size_t)pos * D + lane * 16) = a;
        if (lane == 0) { wsort[pos] = w; sag[pos] = sc; }
    }
}

__device__ __forceinline__ void ph_ln(const KP& p, LAS unsigned char* lds, int l, int which, int tid, int wave, int gw, int NGW, int lane) {
    const float* modv = (const float*)(OWS + WS_MODV); float* X = (float*)(OWS + WS_X); bf16* H = (bf16*)(OWS + WS_H);
    const bf16* BR = (const bf16*)(OWS + (which == 0 ? WS_MIXO : WS_F)); const float* BP = (const float*)(OWS + (which == 0 ? WS_MIXP : WS_FP));
    const float* lg = PIN(which == 0 ? I_LN1G : I_LN2G) + l * D; const float* lb = PIN(which == 0 ? I_LN1B : I_LN2B) + l * D;
    const bool moe = (which == 0) && (l & 1); const bool last = (which == 1) && (l == DEPTH - 1); const bool moe_out = (which == 1) && (l & 1);
    LAS int* lcnt = (LAS int*)lds;
    LAS int* lsel = (LAS int*)(lds + 64);
    int nloc = 0;
    if (moe) { if (tid < 16) lcnt[tid] = 0; __syncthreads(); }
    int pbs[9]; pbs[0] = 0;
    if (moe_out) { const unsigned* gcnt = (const unsigned*)(OWS + WS_CTL) + CW_GCNT + 64 * (l >> 1);
#pragma unroll
        for (int e = 0; e < 8; ++e) pbs[e + 1] = pbs[e] + (int)((gcnt[e] + 255u) & ~255u); }
    f32x4 gt[4], g4[4], b4[4], sh[4], sc[4]; ld_row(lg, lane, g4); ld_row(lb, lane, b4);
#pragma unroll 2
    for (int it = 0; it < 9; ++it) {
        if (it == 8 && gw >= NCTX) break;
        const int row = it < 8 ? (gw >> 9) * SEQ + (gw & 511) + 512 * it : NLAT + gw;
        const int mr = mod_row(row); const float* mv = modv + (size_t)(l * 5 + mr) * NMOD;
        if (it == 0 || it == 8) { ld_row(mv + (which == 0 ? 2048 : 5120), lane, gt);
            if (!last) { const float* mv2 = which == 0 ? mv + 3072 : modv + (size_t)((l + 1) * 5 + mr) * NMOD; ld_row(mv2, lane, sh); ld_row(mv2 + 1024, lane, sc); } }
        f32x4 x[4], br[4], t[4]; ld_row(X + (size_t)row * D, lane, x);
        if (moe_out) { const int* ts = (const int*)(OWS + WS_TOKSEL) + row * 4; const int e0 = ts[0], r0 = ts[1], e1 = ts[2], r1 = ts[3]; int b0 = 0, b1 = 0;
#pragma unroll
            for (int k = 1; k < 8; ++k) { if (e0 >= k) b0 = pbs[k]; if (e1 >= k) b1 = pbs[k]; }
            f32x4 ba[4], bb[4]; const int q0 = b0 + r0, q1 = b1 + r1; constexpr int MM = MOE_MAIN_PANELS * 256;
            if (q0 < MM) ld_row_bf16(BR + (size_t)q0 * D, lane, ba); else ld_row_parts<4>(BP + (size_t)(q0 - MM) * D, (size_t)MOE_TAIL_ROWS * D, lane, ba);
            if (q1 < MM) ld_row_bf16(BR + (size_t)q1 * D, lane, bb); else ld_row_parts<4>(BP + (size_t)(q1 - MM) * D, (size_t)MOE_TAIL_ROWS * D, lane, bb);
#pragma unroll
            for (int j = 0; j < 4; ++j) br[j] = ba[j] + bb[j]; }
        else if (row < NLAT) ld_row_bf16(BR + (size_t)row * D, lane, br);
        else if (which == 0) ld_row_parts<2>(BP + (size_t)(row - NLAT) * D, (size_t)NCTX * D, lane, br);
        else ld_row_parts<7>(BP + (size_t)(row - NLAT) * D, (size_t)NCTX * D, lane, br);
        float s = 0.f;
#pragma unroll
        for (int j = 0; j < 4; ++j) { t[j] = DN_ALPHA * x[j] + gt[j] * br[j]; s += (t[j][0] + t[j][1]) + (t[j][2] + t[j][3]); }
        const float mean = wave_sum(s) * (1.f / D); float s2 = 0.f;
#pragma unroll
        for (int j = 0; j < 4; ++j) { t[j] = t[j] - mean; s2 += (t[j][0] * t[j][0] + t[j][1] * t[j][1]) + (t[j][2] * t[j][2] + t[j][3] * t[j][3]); }
        const float rstd = 1.f / sqrtf(wave_sum(s2) * (1.f / D) + LN_EPS);
#pragma unroll
        for (int j = 0; j < 4; ++j) x[j] = t[j] * rstd * g4[j] + b4[j];
        if (last) {
#if PROBE_DUP & (128 | 256)
            { const unsigned* cw = (const unsigned*)(OWS + WS_CTL); const float cval = 10.f * ((float)cw[20001] / 1024.f) / fmaxf((float)cw[20000], 1.f);
#pragma unroll
              for (int j = 0; j < 4; ++j) x[j] = (f32x4){cval, cval, cval, cval}; }
#endif
            if (row < NLAT) st_row(p.out + (size_t)row * D, lane, x); continue; }
        st_row(X + (size_t)row * D, lane, x);
        f32x4 hh[4];
#pragma unroll
        for (int j = 0; j < 4; ++j) hh[j] = x[j] * (1.f + sc[j]) + sh[j];
        st_row_q8(OWS + WS_H8, (float*)(OWS + WS_SA), row, lane, hh);
        if (moe) {
            const float* rw = PIN(I_RTW) + (size_t)(l >> 1) * D * NE; float lgt[8];
#pragma unroll
            for (int e = 0; e < 8; ++e) lgt[e] = 0.f;
#pragma unroll
            for (int j = 0; j < 4; ++j)
#pragma unroll
                for (int i = 0; i < 4; ++i) { const f32x4* wp = (const f32x4*)(rw + (size_t)(4 * lane + 256 * j + i) * NE); const f32x4 w0 = wp[0], w1 = wp[1]; const float hv = hh[j][i];
                    lgt[0] += hv * w0[0]; lgt[1] += hv * w0[1]; lgt[2] += hv * w0[2]; lgt[3] += hv * w0[3]; lgt[4] += hv * w1[0]; lgt[5] += hv * w1[1]; lgt[6] += hv * w1[2]; lgt[7] += hv * w1[3]; }
#pragma unroll
            for (int e = 0; e < 8; ++e) lgt[e] = wave_sum(lgt[e]) + PIN(I_RTB)[(l >> 1) * NE + e];
            float v0 = lgt[0]; int i0 = 0;
#pragma unroll
            for (int e = 1; e < 8; ++e) if (lgt[e] > v0) { v0 = lgt[e]; i0 = e; }
            float v1 = -3.0e38f; int i1 = -1;
#pragma unroll
            for (int e = 0; e < 8; ++e) if (e != i0 && lgt[e] > v1) { v1 = lgt[e]; i1 = e; }
            const float w0 = 1.f / (1.f + expf(v1 - v0)), w1 = 1.f - w0;
            if (lane == 0) { const int lr0 = __hip_atomic_fetch_add(lcnt + i0, 1, __ATOMIC_RELAXED, __HIP_MEMORY_SCOPE_WORKGROUP), lr1 = __hip_atomic_fetch_add(lcnt + i1, 1, __ATOMIC_RELAXED, __HIP_MEMORY_SCOPE_WORKGROUP); const int li = nloc * NWAVES + wave;
                lsel[li * 8 + 0] = row; lsel[li * 8 + 1] = i0; lsel[li * 8 + 2] = lr0; lsel[li * 8 + 3] = i1; lsel[li * 8 + 4] = lr1;
                ((float*)(OWS + WS_WSEL))[row * 2] = w0; ((float*)(OWS + WS_WSEL))[row * 2 + 1] = w1; }
            ++nloc;
        }
    }
    if (moe) {
        __syncthreads();
        unsigned* gcnt = (unsigned*)(OWS + WS_CTL) + CW_GCNT + 64 * (l >> 1);
        if (tid < 8) lcnt[8 + tid] = (int)__hip_atomic_fetch_add(gcnt + tid, (unsigned)lcnt[tid], __ATOMIC_RELAXED, __HIP_MEMORY_SCOPE_AGENT);
        __syncthreads();
        unsigned* rowlist = (unsigned*)(OWS + WS_ROWLIST); int* toksel = (int*)(OWS + WS_TOKSEL);
        if (tid < 16 * NWAVES) { const int k = tid / NWAVES, w = tid % NWAVES; if (k < 8 || (k == 8 && (int)blockIdx.x * NWAVES + w < NCTX)) { const int li = k * NWAVES + w;
            const int row = lsel[li * 8 + 0], e0 = lsel[li * 8 + 1], r0 = lcnt[8 + e0] + lsel[li * 8 + 2], e1 = lsel[li * 8 + 3], r1 = lcnt[8 + e1] + lsel[li * 8 + 4];
            rowlist[(size_t)e0 * MROWS + r0] = (unsigned)row * 2u; rowlist[(size_t)e1 * MROWS + r1] = (unsigned)row * 2u + 1u;
            toksel[row * 4 + 0] = e0; toksel[row * 4 + 1] = r0; toksel[row * 4 + 2] = e1; toksel[row * 4 + 3] = r1; } }
    }
}


#ifndef PROBE_WHICH
#define PROBE_WHICH(x, y) (x)
#endif
#if PROBE_DUP & 128
__device__ __forceinline__ void ph_check_up(const KP& p, int gw, int lane) {
    if (gw >= 64) return;
    const float* X = (const float*)(OWS + WS_X); const float* modv = (const float*)(OWS + WS_MODV); const bf16* ACT = (const bf16*)(OWS + WS_ACT);
    const int row = gw * 257, c = lane * 56 + (gw & 7), mr = mod_row(row); const float* mv = modv + (size_t)(0 * 5 + mr) * NMOD;
    const signed char* H8 = (const signed char*)(OWS + WS_H8); const signed char* W8 = (const signed char*)(OWS + WS_F13); const float* SA = (const float*)(OWS + WS_SA); const unsigned* AM = (const unsigned*)(OWS + WS_AMAX);
    const int j1 = 8 * (c >> 2) + (c & 3), j3 = j1 + 4; int ia = 0, ib = 0;
    for (int k = 0; k < D; ++k) { const int h = H8[(size_t)row * D + k]; ia += h * W8[(size_t)j1 * D + k]; ib += h * W8[(size_t)j3 * D + k]; }
    const float a = (float)ia * SA[row] * __builtin_bit_cast(float, AM[j1]) * (1.f / 127.f), b = (float)ib * SA[row] * __builtin_bit_cast(float, AM[j3]) * (1.f / 127.f);
    (void)X; (void)mv;
    const float ref = a / (1.f + expf(-a)) * b, got = bf2f(ACT[(size_t)row * DFF + c]);
    const float da = ((const float*)(OWS + WS_F))[(size_t)row * DFF + c], db = ((const float*)(OWS + WS_F))[(size_t)4096 * DFF + (size_t)row * DFF + c]; (void)got; (void)db;
    if (row < 4096 && abs(ia) > 1000) { const float ratio = 10.f * fminf(fabsf(PROBE_WHICH(da / a, db / b) - 1.f), 0.4f);
        __hip_atomic_fetch_add((unsigned*)(OWS + WS_CTL) + 20000, 1u, __ATOMIC_RELAXED, __HIP_MEMORY_SCOPE_AGENT); __hip_atomic_fetch_add((unsigned*)(OWS + WS_CTL) + 20001, (unsigned)(ratio * 1024.f), __ATOMIC_RELAXED, __HIP_MEMORY_SCOPE_AGENT); }
}
#endif

#if PROBE_DUP & 256
__device__ __forceinline__ void ph_check_mfma(const KP& p, int lane) {
    typedef int i32x4 __attribute__((ext_vector_type(4)));
    const int r = lane & 15, g = lane >> 4; unsigned aw[4], bw[4];
#pragma unroll
    for (int q = 0; q < 4; ++q) { unsigned a = 0, b = 0;
#pragma unroll
        for (int t = 0; t < 4; ++t) { const int k = 16 * g + 4 * q + t; const int av = ((r * 7 + k * 3) % 5) - 2, bv = ((r * 5 + k * 11) % 7) - 3; a |= (unsigned)(av & 255) << (8 * t); b |= (unsigned)(bv & 255) << (8 * t); }
        aw[q] = a; bw[q] = b; }
    i32x4 c = {0, 0, 0, 0};
    c = __builtin_amdgcn_mfma_i32_16x16x64_i8((i32x4){(int)aw[0], (int)aw[1], (int)aw[2], (int)aw[3]}, (i32x4){(int)bw[0], (int)bw[1], (int)bw[2], (int)bw[3]}, c, 0, 0, 0);
    bool bad = false;
#pragma unroll
    for (int reg = 0; reg < 4; ++reg) { const int i = 4 * g + reg, j = r; int e = 0;
        for (int k = 0; k < 64; ++k) e += (((i * 7 + k * 3) % 5) - 2) * (((j * 5 + k * 11) % 7) - 3);
        if (c[reg] != e) bad = true; }
    if (bad) __hip_atomic_fetch_add((unsigned*)(OWS + WS_CTL) + 20000, 1000u, __ATOMIC_RELAXED, __HIP_MEMORY_SCOPE_AGENT);
}
#endif
__global__ void __launch_bounds__(NWAVES * 64, 2) fwd_kernel(KP p) {
    extern __shared__ __attribute__((aligned(16))) unsigned char lds_raw[];
    LAS unsigned char* lds = (LAS unsigned char*)lds_raw;
    volatile LAS unsigned* MISC = (volatile LAS unsigned*)(lds + MISC_OFF);
    const int G = gridDim.x, NGW = G * NWAVES;
    for (int u = threadIdx.x; u < (LDS_BYTES - LDSCTL_OFF) / 4; u += NWAVES * 64) ((LAS unsigned*)(lds + LDSCTL_OFF))[u] = 0u;
    __syncthreads();
    unsigned* ctl = (unsigned*)(OWS + WS_CTL);
    const bool single = p.ph < 0;
    XcdBarrier bar; bar.bar = ctl + CW_BAR; bar.x = 0; bar.st = nullptr;
    if (single) bar = xcd_barrier_post(ctl + CW_BAR, MISC + 8);
    int phc = 0;
#ifndef PROBE_DUP
#define PROBE_DUP 0
#endif
#define REP(bit) for (int rep_ = 0; rep_ < ((PROBE_DUP & (bit)) ? 2 : 1); ++rep_)
#define RUN() (single || p.ph == phc)
#define FRESH() int tid = threadIdx.x; asm volatile("" : "+v"(tid)); const int lane = tid & 63, wave = __builtin_amdgcn_readfirstlane(tid >> 6), gw = blockIdx.x * NWAVES + wave; (void)lane; (void)gw
#define SEAM() do { if (single) { XcdBarrier b2_ = bar; asm volatile("" : "+s"(b2_.bar)); xcd_barrier(b2_); if (PROBE_DUP & 32) { XcdBarrier b3_ = bar; asm volatile("" : "+s"(b3_.bar)); xcd_barrier(b3_); } } ++phc; } while (0)

    REP(4) if (RUN()) { FRESH(); ph_modvec(p, lds, tid); __syncthreads(); ph_convert(p, lds, gw, NGW, wave, lane); cq_static(p, lds, 3 * CQ_IN + 3 * CQ_OUT + 2 * CQ_UP, CQ_J1, gw, NGW, wave, lane); ph_amax(p, gw, NGW, lane); }
    SEAM();
#if PROBE_DUP & 256
    if (blockIdx.x == 0 && threadIdx.x < 64) ph_check_mfma(p, threadIdx.x);
#endif
    if (RUN()) { FRESH(); ph_init_rows(p, gw, NGW, lane); cq_static(p, lds, -CQ_NEG, 3 * CQ_IN + 3 * CQ_OUT + 2 * CQ_UP, gw, NGW, wave, lane); }
    SEAM();
    for (int ll = 0; ll < DEPTH; ++ll) {
#define l (ll + opaque_zero_i())
         if (RUN()) { pg8::Gemm g{(const bf16*)(OWS + WS_H8), (const bf16*)(OWS + WS_WIN) + (size_t)l * (NP * D / 2), MROWS, NP, D / 2, D / 2}; pg8::StaticOrder S; S.init(MROWS, NP, G, (int)blockIdx.x);
            pg8::EpiBf16S8 E{(bf16*)(OWS + WS_P), NP, (const float*)(OWS + WS_SA), (const float*)(OWS + WS_AMAX) + AM_IN + l * NP}; pg8::gemm_phase<pg8::EpiBf16S8, pg8::StaticOrder, true, true, true>(lds, g, S, E); }
        SEAM();
        REP(8) if (RUN()) { FRESH(); ph_lora(p, l, gw, NGW, lane); }
        SEAM();
        REP(1) if (RUN()) { FRESH(); ph_scan1(p, l, gw, NGW, lane); }
        SEAM();
        REP(2) if (RUN()) { FRESH(); ph_scan2(p, lds, l, wave, lane); }
        SEAM();
        REP(64) if (RUN()) { FRESH(); ph_readout2(p, l, gw, NGW, lane); }
        SEAM();
         if (RUN()) {
            { pg8::Gemm g{(const bf16*)(OWS + WS_MIXIN), (const bf16*)(OWS + WS_WOUT) + (size_t)l * (D * D / 2), NLAT, D, D / 2, D / 2}; pg8::StaticOrder S; S.init(NLAT, D, G, (int)blockIdx.x);
              pg8::EpiBf16S8 E{(bf16*)(OWS + WS_MIXO), D, (const float*)(OWS + WS_SAM), (const float*)(OWS + WS_AMAX) + AM_OUT + l * D}; pg8::gemm_phase<pg8::EpiBf16S8, pg8::StaticOrder, true, true, true>(lds, g, S, E); }
            { pg8::Gemm g{(const bf16*)(OWS + WS_MIXIN), (const bf16*)(OWS + WS_WOUT) + (size_t)l * (D * D / 2), NCTX, D, D / 4, D / 2}; pg8::SplitOrder S{NCTX / 256, D / 256, 2, G, (int)blockIdx.x, NLAT / 256, 0, 0, 0, 0, 0, 0, 0, 0};
              pg8::EpiPartS8 E{(float*)(OWS + WS_MIXP), D, (size_t)NCTX * D, NLAT / 256, (const float*)(OWS + WS_SAM), (const float*)(OWS + WS_AMAX) + AM_OUT + l * D}; pg8::gemm_phase<pg8::EpiPartS8, pg8::SplitOrder, true, true, true>(lds, g, S, E); }
        }
        SEAM();
        if (RUN()) { FRESH(); ph_ln(p, lds, l, 0, tid, wave, gw, NGW, lane); }
        SEAM();
        if ((l & 1) == 0) {
            const int fi = l >> 1;
             if (RUN()) { pg8::Gemm g{(const bf16*)(OWS + WS_H8), (const bf16*)(OWS + WS_F13) + (size_t)fi * DFF * D, MROWS, 2 * DFF, D / 2, D / 2}; pg8::StaticOrder S; S.init(MROWS, 2 * DFF, G, (int)blockIdx.x);
                constexpr int NOE = 0x7fffffff; pg8::EpiSwiGLU8 E{(bf16*)(OWS + WS_ACT), DFF, nullptr, (const float*)(OWS + WS_SA), (const unsigned*)(OWS + WS_AMAX) + (size_t)fi * 2 * DFF, NOE, NOE, NOE, NOE, NOE, NOE, NOE};
#if PROBE_DUP & 128
                E.dbg = (int*)(OWS + WS_F);
#endif
                pg8::gemm_phase<pg8::EpiSwiGLU8, pg8::StaticOrder, true, true, true>(lds, g, S, E); }
            SEAM();
#if PROBE_DUP & 128
            if (ll == 0) { if (RUN()) { FRESH(); ph_check_up(p, gw, lane); } SEAM(); }
#endif
             if (RUN()) {
                { pg8::Gemm g{(const bf16*)(OWS + WS_ACT), (const bf16*)(OWS + WS_F2) + (size_t)fi * D * DFF, NLAT, D, DFF, DFF}; pg8::StaticOrder S; S.init(NLAT, D, G, (int)blockIdx.x);
                  pg8::EpiBf16<0> E{(bf16*)(OWS + WS_F), D, nullptr, 0, 0, 1.f}; pg8::gemm_phase<pg8::EpiBf16<0>, pg8::StaticOrder, true, true>(lds, g, S, E); }
                { pg8::Gemm g{(const bf16*)(OWS + WS_ACT), (const bf16*)(OWS + WS_F2) + (size_t)fi * D * DFF, NCTX, D, DFF / 7, DFF}; pg8::SplitOrder S{NCTX / 256, D / 256, 7, G, (int)blockIdx.x, NLAT / 256, 0, 0, 0, 0, 0, 0, 0, 0};
                  pg8::EpiPart E{(float*)(OWS + WS_FP), D, (size_t)NCTX * D, NLAT / 256}; pg8::gemm_phase<pg8::EpiPart, pg8::SplitOrder, true, true>(lds, g, S, E); }
            }
            SEAM();
        } else {
            REP(4) if (RUN()) { FRESH(); cq_static(p, lds, (l == 1 ? CQ_J1 : CQ_END0) + 2 * CQ_SLOT_ITEMS, l == 1 ? CQ_END0 : CQ_END1, gw, NGW, wave, lane); }
            SEAM();
            if (RUN()) { FRESH(); ph_moe_gather(p, l, gw, NGW, lane); }
            SEAM();
            {   const unsigned* gcnt = (const unsigned*)(OWS + WS_CTL) + CW_GCNT + 64 * (l >> 1); int pbp[9]; pbp[0] = 0;
#pragma unroll
                for (int e = 0; e < 8; ++e) pbp[e + 1] = pbp[e] + (int)((gcnt[e] + 255u) >> 8);
                const int mrows = pbp[8] * 256;
                 if (RUN()) { pg8::Gemm g{(const bf16*)(OWS + WS_HG), (const bf16*)(OWS + WS_MOEW13), mrows, 2 * DFF, D / 2, D / 2}; pg8::MoeOrder S; S.init(mrows, 2 * DFF, G, (int)blockIdx.x);
                    S.pb1 = pbp[1]; S.pb2 = pbp[2]; S.pb3 = pbp[3]; S.pb4 = pbp[4]; S.pb5 = pbp[5]; S.pb6 = pbp[6]; S.pb7 = pbp[7]; S.estride = (size_t)DFF * D;
                    pg8::EpiSwiGLU8 E{(bf16*)(OWS + WS_ACT), DFF, (const float*)(OWS + WS_WSORT), (const float*)(OWS + WS_SAG), (const unsigned*)(OWS + WS_AMAX) + (size_t)(2 + 8 * (l >> 1)) * 2 * DFF, pbp[1], pbp[2], pbp[3], pbp[4], pbp[5], pbp[6], pbp[7]};
                    pg8::gemm_phase<pg8::EpiSwiGLU8, pg8::MoeOrder, true, true, true>(lds, g, S, E); }
                SEAM();
                 if (RUN()) {
                    { pg8::Gemm g{(const bf16*)(OWS + WS_ACT), (const bf16*)(OWS + WS_MOEW2), MOE_MAIN_PANELS * 256, D, DFF, DFF}; pg8::MoeOrder S; S.init(MOE_MAIN_PANELS * 256, D, G, (int)blockIdx.x);
                      S.pb1 = pbp[1]; S.pb2 = pbp[2]; S.pb3 = pbp[3]; S.pb4 = pbp[4]; S.pb5 = pbp[5]; S.pb6 = pbp[6]; S.pb7 = pbp[7]; S.estride = (size_t)D * DFF;
                      pg8::EpiBf16<0> E{(bf16*)(OWS + WS_F), D, nullptr, 0, 0, 1.f}; pg8::gemm_phase<pg8::EpiBf16<0>, pg8::MoeOrder, true, true>(lds, g, S, E); }
                    { const int nT = pbp[8] - MOE_MAIN_PANELS;
                      pg8::Gemm g{(const bf16*)(OWS + WS_ACT), (const bf16*)(OWS + WS_MOEW2), nT * 256, D, DFF / 4, DFF}; pg8::SplitOrder S{nT, D / 256, 4, G, (int)blockIdx.x, MOE_MAIN_PANELS, pbp[1], pbp[2], pbp[3], pbp[4], pbp[5], pbp[6], pbp[7], (size_t)D * DFF};
                      pg8::EpiPart E{(float*)(OWS + WS_FP), D, (size_t)MOE_TAIL_ROWS * D, MOE_MAIN_PANELS}; pg8::gemm_phase<pg8::EpiPart, pg8::SplitOrder, true, true>(lds, g, S, E); }
                }
                SEAM();
            }
        }
        if (RUN()) { FRESH(); ph_ln(p, lds, l, 1, tid, wave, gw, NGW, lane); }
        SEAM();
    }
#undef l
#undef RUN
#undef SEAM
}

#ifndef MK_PER_PHASE
#define MK_PER_PHASE 0
#endif
extern "C" void kernel_launch(void* const* d_in, const int* in_sizes, int n_in, void* d_out, int out_size, void* d_ws, size_t ws_size, hipStream_t stream) {
    static int grid = 0;
    if (grid == 0) {
        if (n_in != N_IN || in_sizes[0] != NLAT * D || out_size != NLAT * D || ws_size < WS_NEED) { fprintf(stderr, "kernel_launch: unexpected shapes / workspace (%d inputs, ws %zu, need %zu)\n", n_in, ws_size, (size_t)WS_NEED); grid = -1; return; }
        int dev = 0, cus = 0, per_cu = 0;
        if (hipGetDevice(&dev) != hipSuccess || hipDeviceGetAttribute(&cus, hipDeviceAttributeMultiprocessorCount, dev) != hipSuccess) { grid = -1; return; }
        if (hipFuncSetAttribute((const void*)fwd_kernel, hipFuncAttributeMaxDynamicSharedMemorySize, LDS_BYTES) != hipSuccess) { fprintf(stderr, "kernel_launch: hipFuncSetAttribute failed\n"); grid = -1; return; }
        if (hipOccupancyMaxActiveBlocksPerMultiprocessor(&per_cu, (const void*)fwd_kernel, NWAVES * 64, LDS_BYTES) != hipSuccess || per_cu < 1) fprintf(stderr, "kernel_launch: occupancy query says %d\n", per_cu);
        (void)hipGetLastError();
        grid = cus;
        if (grid != 256) { fprintf(stderr, "kernel_launch: built for a 256-CU device, found %d CUs\n", cus); grid = -1; return; }
    }
    if (grid < 0) return;
    if (hipMemsetAsync((char*)d_ws + WS_CTL, 0, CTL_BYTES, stream) != hipSuccess) return;
    KP p{};
    for (int i = 0; i < N_IN; ++i) p.in[i] = (const float*)d_in[i];
    p.out = (float*)d_out; p.ws = (unsigned char*)d_ws; p.pad = 0;
#if MK_PER_PHASE
    const int nph = 2 + 2 * 11 + 2 * 13;
    for (int ph = 0; ph < nph; ++ph) { p.ph = ph; hipLaunchKernelGGL(fwd_kernel, dim3(grid), dim3(NWAVES * 64), LDS_BYTES, stream, p); }
#else
    p.ph = -1;
    hipLaunchKernelGGL(fwd_kernel, dim3(grid), dim3(NWAVES * 64), LDS_BYTES, stream, p);
#endif
}
```

```cpp
#include <hip/hip_runtime.h>
#define PROBE_DUP 0
#define CQ_SLOT_WGS 0
#define CQ_SLOT_ITEMS 3500
#include <cstdio>
#include <cstdint>
namespace pg8 {
#define PG8_LAS __attribute__((address_space(3)))
typedef unsigned short bf16_t;
typedef short bf16x8 __attribute__((ext_vector_type(8)));
typedef float f32x4 __attribute__((ext_vector_type(4)));
typedef unsigned u32x4 __attribute__((ext_vector_type(4)));
constexpr int BM = 256, BK = 64, HALF = 128, HTB = HALF * BK * 2  , STAGE_BYTES = 8 * HTB, NXCD = 8, WGM = 8;

__host__ __device__ __forceinline__ int lds_byte(int r, int c) { const int st = (r >> 4) * 2 + (c >> 5), rr = r & 15, cc = c & 31, ob = rr * 64 + cc * 2; return st * 1024 + (ob ^ (((ob >> 9) & 1) << 5)); }
__host__ __device__ __forceinline__ void stage_rc(int b, int& R, int& C) { const int st = b / 1024, sb = b % 1024, swz = sb ^ (((sb >> 9) & 1) << 5); R = (st >> 1) * 16 + swz / 64; C = (st & 1) * 32 + (swz % 64) / 2; }
__host__ __device__ __forceinline__ int perm32(int rho) { const int n = rho >> 4, i = rho & 15; return 8 * (i >> 2) + 4 * n + (i & 3); }

struct Unit { int pm, pn, ks; };
struct Gemm { const bf16_t* A; const bf16_t* Bt; int M, N, K, ld; };

struct StaticOrder {
    int nM, nN, nwg, G, c;
    __host__ __device__ void init(int M, int N, int G_, int c_) { nM = M / BM; nN = N / BM; nwg = nM * nN; G = G_; c = c_; }
    __host__ __device__ bool next(int i, Unit& u) const {
        const long L = (long)i * G + c; if (L >= nwg) return false;
        int wgid = (int)L; { const int q = nwg / NXCD, r = nwg % NXCD, xcd = wgid % NXCD, off = wgid / NXCD; wgid = (xcd < r ? xcd * (q + 1) : r * (q + 1) + (xcd - r) * q) + off; }
        const int nig = WGM * nN, gid = wgid / nig, fm = gid * WGM, gsz = (nM - fm) < WGM ? (nM - fm) : WGM;
        u.pm = fm + ((wgid % nig) % gsz); u.pn = (wgid % nig) / gsz; u.ks = 0; return true;
    }
    __device__ __forceinline__ const char* abase(const Gemm& g, const Unit& u, size_t tstep) const { return (const char*)g.A + (size_t)u.pm * tstep; }
    __device__ __forceinline__ const char* bbase(const Gemm& g, const Unit& u, size_t tstep) const { return (const char*)g.Bt + (size_t)u.pn * tstep; }
    __device__ __forceinline__ void a_ready(const Unit&) const {}
    __device__ __forceinline__ void done(const Unit&) const {}
};

__device__ __forceinline__ unsigned cvt_pk_bf16(float lo, float hi) { unsigned r; asm volatile("v_cvt_pk_bf16_f32 %0, %1, %2" : "=v"(r) : "v"(lo), "v"(hi)); return r; }
typedef float f32x2 __attribute__((ext_vector_type(2)));
__device__ __forceinline__ f32x2 gelu_pk(f32x2 v) {
    const f32x2 av = __builtin_elementwise_abs(v), d = av * 0.2316418882f + 1.0f;
    f32x2 t; t.x = __builtin_amdgcn_rcpf(d.x); t.y = __builtin_amdgcn_rcpf(d.y);
    f32x2 q = t * 0.5307027145f + (-0.7265760135f); q = q * t + 0.7107068705f; q = q * t + (-0.142248368f); q = q * t + 0.127414796f; q = q * t;
    const f32x2 s = (v * v) * (-0.72134752044f);
    f32x2 e; e.x = __builtin_amdgcn_exp2f(s.x); e.y = __builtin_amdgcn_exp2f(s.y);
    const f32x2 m = v * (q * e), r = v - m;
    f32x2 o; o.x = v.x < 0.f ? m.x : r.x; o.y = v.y < 0.f ? m.y : r.y; return o;
}

template <int ACT  > struct EpiBf16 {
    static constexpr bool PERM = true, AFTER_DRAIN = false; static_assert(ACT == 0 || ACT == 1, "EpiBf16: ACT is 0 (none) or 1 (gelu_pk)");
    bf16_t* O; int ldc; const float* bias; int split_cols; size_t split_stride; float scale0;
    __device__ __forceinline__ void operator()(const f32x4 (&acc)[2][2][4][2], const Unit& u, int wr, int wc, int fr, int fq) const {
        asm volatile("" : "+v"(fr), "+v"(fq));
        const int row0 = u.pm * BM + wr * 64 + fr; int colt = u.pn * BM; bf16_t* base = O;
        float sc = 1.f; if (split_cols) { const int t = colt / split_cols; base += (size_t)t * split_stride; colt -= t * split_cols; if (t == 0) sc = scale0; }
        const int col0 = colt + wc * 32 + 8 * fq, bcol0 = u.pn * BM + wc * 32 + 8 * fq;
        f32x4 bv[2][2];
#pragma unroll
        for (int bj = 0; bj < 2; ++bj)
#pragma unroll
            for (int n = 0; n < 2; ++n) bv[bj][n] = bias ? *(const f32x4*)(bias + bcol0 + bj * HALF + 4 * n) : (f32x4){0.f, 0.f, 0.f, 0.f};
#pragma unroll
        for (int ai = 0; ai < 2; ++ai)
#pragma unroll
            for (int m = 0; m < 4; ++m) { bf16_t* rowp = base + (size_t)(row0 + ai * HALF + m * 16) * ldc + col0;
#pragma unroll
                for (int bj = 0; bj < 2; ++bj) { f32x4 v0 = acc[ai][bj][m][0] + bv[bj][0], v1 = acc[ai][bj][m][1] + bv[bj][1];
                    if (ACT == 1) { f32x2 a = gelu_pk((f32x2){v0[0], v0[1]}), b = gelu_pk((f32x2){v0[2], v0[3]}), c = gelu_pk((f32x2){v1[0], v1[1]}), d = gelu_pk((f32x2){v1[2], v1[3]});
                        v0 = (f32x4){a.x, a.y, b.x, b.y}; v1 = (f32x4){c.x, c.y, d.x, d.y}; }
                    v0 = v0 * sc; v1 = v1 * sc; u32x4 w; w.x = cvt_pk_bf16(v0[0], v0[1]); w.y = cvt_pk_bf16(v0[2], v0[3]); w.z = cvt_pk_bf16(v1[0], v1[1]); w.w = cvt_pk_bf16(v1[2], v1[3]);
                    *(u32x4*)(rowp + bj * HALF) = w; } }
    }
};
typedef int i32x4 __attribute__((ext_vector_type(4)));
template <bool I8> __device__ __forceinline__ f32x4 mma16(bf16x8 b, bf16x8 a, f32x4 c) { return __builtin_amdgcn_mfma_f32_16x16x32_bf16(b, a, c, 0, 0, 0); }
template <bool I8> __device__ __forceinline__ i32x4 mma16(bf16x8 b, bf16x8 a, i32x4 c) { return __builtin_amdgcn_mfma_i32_16x16x64_i8(__builtin_bit_cast(i32x4, b), __builtin_bit_cast(i32x4, a), c, 0, 0, 0); }
struct EpiF32 {
    static constexpr bool PERM = false, AFTER_DRAIN = false;
    float* C; int ldc; int accum;
    __device__ __forceinline__ void operator()(const f32x4 (&acc)[2][2][4][2], const Unit& u, int wr, int wc, int fr, int fq) const {
        asm volatile("" : "+v"(fr), "+v"(fq));
        const int row0 = u.pm * BM + wr * 64 + fr, col0 = u.pn * BM + wc * 32 + 4 * fq;
#pragma unroll
        for (int ai = 0; ai < 2; ++ai)
#pragma unroll
            for (int m = 0; m < 4; ++m) { float* rowp = C + (size_t)(row0 + ai * HALF + m * 16) * ldc + col0;
#pragma unroll
                for (int bj = 0; bj < 2; ++bj)
#pragma unroll
                    for (int n = 0; n < 2; ++n) { f32x4 v = acc[ai][bj][m][n]; if (accum) v += *(const f32x4*)(rowp + bj * HALF + n * 16); *(f32x4*)(rowp + bj * HALF + n * 16) = v; } }
    }
};
struct EpiSwiGLU {
    static constexpr bool PERM = true, AFTER_DRAIN = false;
    bf16_t* O; int ldo; const float* rowscale; int rs_stride;
    __device__ __forceinline__ void operator()(const f32x4 (&acc)[2][2][4][2], const Unit& u, int wr, int wc, int fr, int fq) const {
        asm volatile("" : "+v"(fr), "+v"(fq));
        typedef unsigned u32x2v __attribute__((ext_vector_type(2)));
        const int row0 = u.pm * BM + wr * 64 + fr; const int ch0 = (u.pn * BM + wc * 32 + 8 * fq) >> 1;
#pragma unroll
        for (int ai = 0; ai < 2; ++ai)
#pragma unroll
            for (int m = 0; m < 4; ++m) { const int row = row0 + ai * HALF + m * 16; bf16_t* rowp = O + (size_t)row * ldo + ch0;
                const float rs = rowscale ? rowscale[(size_t)row * rs_stride] : 1.f;
#pragma unroll
                for (int bj = 0; bj < 2; ++bj) { const f32x4 a = acc[ai][bj][m][0], b = acc[ai][bj][m][1]; f32x4 o;
#pragma unroll
                    for (int i = 0; i < 4; ++i) o[i] = a[i] * __builtin_amdgcn_rcpf(1.f + __expf(-a[i])) * b[i] * rs;
                    u32x2v w; w.x = cvt_pk_bf16(o[0], o[1]); w.y = cvt_pk_bf16(o[2], o[3]);
                    *(u32x2v*)(rowp + bj * (HALF / 2)) = w; } }
    }
};

struct MoeOrder : StaticOrder {
    int pb1, pb2, pb3, pb4, pb5, pb6, pb7; size_t estride;
    __device__ __forceinline__ const char* bbase(const Gemm& g, const Unit& u, size_t tstep) const {
        const int e = (u.pm >= pb1) + (u.pm >= pb2) + (u.pm >= pb3) + (u.pm >= pb4) + (u.pm >= pb5) + (u.pm >= pb6) + (u.pm >= pb7);
        return (const char*)(g.Bt + (size_t)e * estride) + (size_t)u.pn * tstep; }
};
struct SplitOrder {
    int nM, nN, S, G, c, pm0; int pb1, pb2, pb3, pb4, pb5, pb6, pb7; size_t estride;
    __device__ __forceinline__ bool next(int i, Unit& u) const { const int L = i * G + c; if (L >= nM * nN * S) return false; u.ks = L % S; const int t = L / S; u.pn = t % nN; u.pm = pm0 + t / nN; return true; }
    __device__ __forceinline__ const char* abase(const Gemm& g, const Unit& u, size_t tstep) const { return (const char*)g.A + (size_t)u.pm * tstep + (size_t)u.ks * g.K * 2; }
    __device__ __forceinline__ const char* bbase(const Gemm& g, const Unit& u, size_t tstep) const {
        const int e = estride ? (u.pm >= pb1) + (u.pm >= pb2) + (u.pm >= pb3) + (u.pm >= pb4) + (u.pm >= pb5) + (u.pm >= pb6) + (u.pm >= pb7) : 0;
        return (const char*)(g.Bt + (size_t)e * estride) + (size_t)u.pn * tstep + (size_t)u.ks * g.K * 2; }
    __device__ __forceinline__ void a_ready(const Unit&) const {}
    __device__ __forceinline__ void done(const Unit&) const {}
};
struct EpiPart {
    static constexpr bool PERM = false, AFTER_DRAIN = false;
    float* C; int ldc; size_t pstride; int pm0;
    __device__ __forceinline__ void operator()(const f32x4 (&acc)[2][2][4][2], const Unit& u, int wr, int wc, int fr, int fq) const {
        asm volatile("" : "+v"(fr), "+v"(fq));
        const int row0 = (u.pm - pm0) * BM + wr * 64 + fr, col0 = u.pn * BM + wc * 32 + 4 * fq; float* base = C + (size_t)u.ks * pstride;
#pragma unroll
        for (int ai = 0; ai < 2; ++ai)
#pragma unroll
            for (int m = 0; m < 4; ++m) { float* rowp = base + (size_t)(row0 + ai * HALF + m * 16) * ldc + col0;
#pragma unroll
                for (int bj = 0; bj < 2; ++bj)
#pragma unroll
                    for (int n = 0; n < 2; ++n) *(f32x4*)(rowp + bj * HALF + n * 16) = acc[ai][bj][m][n]; }
    }
};

struct EpiSwiGLU8 {
    static constexpr bool PERM = true, AFTER_DRAIN = false;
    bf16_t* O; int ldo; const float* rowscale; const float* sa; const unsigned* amax; int pb1, pb2, pb3, pb4, pb5, pb6, pb7;
    __device__ __forceinline__ void operator()(const i32x4 (&acc)[2][2][4][2], const Unit& u, int wr, int wc, int fr, int fq) const {
        typedef unsigned u32x2v __attribute__((ext_vector_type(2))); typedef unsigned u32x4v __attribute__((ext_vector_type(4)));
        asm volatile("" : "+v"(fr), "+v"(fq));
        const int row0 = u.pm * BM + wr * 64 + fr; const int cb0 = u.pn * BM + wc * 32 + 8 * fq; const int ch0 = cb0 >> 1;
        const int e = (u.pm >= pb1) + (u.pm >= pb2) + (u.pm >= pb3) + (u.pm >= pb4) + (u.pm >= pb5) + (u.pm >= pb6) + (u.pm >= pb7);
        const unsigned* am = amax + (size_t)e * 2 * 3584 + cb0;
#pragma unroll
        for (int bj = 0; bj < 2; ++bj) {
            const float* amf = (const float*)am + bj * HALF;
            const f32x4 sb0 = *(const f32x4*)amf * (1.f / 127.f), sb1 = *(const f32x4*)(amf + 4) * (1.f / 127.f);
#pragma unroll
            for (int ai = 0; ai < 2; ++ai)
#pragma unroll
                for (int m = 0; m < 4; ++m) { const int row = row0 + ai * HALF + m * 16; bf16_t* rowp = O + (size_t)row * ldo + ch0 + bj * (HALF / 2);
                    const float sr = sa[row], rs = rowscale ? rowscale[row] : 1.f; f32x4 o;
#pragma unroll
                    for (int i = 0; i < 4; ++i) { const float a = (float)acc[ai][bj][m][0][i] * sr * sb0[i], b = (float)acc[ai][bj][m][1][i] * sr * sb1[i];
                        o[i] = a * __builtin_amdgcn_rcpf(1.f + __expf(-a)) * b * rs; }
                    u32x2v w; w.x = cvt_pk_bf16(o[0], o[1]); w.y = cvt_pk_bf16(o[2], o[3]);
                    *(u32x2v*)rowp = w;
#if PROBE_DUP & 128
                    if (dbg && row < 4096) { f32x4 av, bv;
#pragma unroll
                        for (int i = 0; i < 4; ++i) { av[i] = (float)acc[ai][bj][m][0][i] * sr * sb0[i]; bv[i] = (float)acc[ai][bj][m][1][i] * sr * sb1[i]; }
                        *(f32x4*)((float*)dbg + (size_t)row * ldo + (rowp - (O + (size_t)row * ldo))) = av; *(f32x4*)((float*)dbg + (size_t)4096 * ldo + (size_t)row * ldo + (rowp - (O + (size_t)row * ldo))) = bv; }
#endif
                    } }
    }
#if PROBE_DUP & 128
    int* dbg = nullptr;
#endif
};

struct EpiBf16S8 {
    static constexpr bool PERM = true, AFTER_DRAIN = false;
    bf16_t* O; int ldc; const float* sa; const float* amax;
    __device__ __forceinline__ void operator()(const i32x4 (&acc)[2][2][4][2], const Unit& u, int wr, int wc, int fr, int fq) const {
        asm volatile("" : "+v"(fr), "+v"(fq));
        const int row0 = u.pm * BM + wr * 64 + fr, col0 = u.pn * BM + wc * 32 + 8 * fq;
#pragma unroll
        for (int bj = 0; bj < 2; ++bj) { const f32x4 s0 = *(const f32x4*)(amax + col0 + bj * HALF) * (1.f / 127.f), s1 = *(const f32x4*)(amax + col0 + bj * HALF + 4) * (1.f / 127.f);
#pragma unroll
            for (int ai = 0; ai < 2; ++ai)
#pragma unroll
                for (int m = 0; m < 4; ++m) { const int row = row0 + ai * HALF + m * 16; const float sr = sa[row]; f32x4 v0, v1;
#pragma unroll
                    for (int i = 0; i < 4; ++i) { v0[i] = (float)acc[ai][bj][m][0][i] * sr * s0[i]; v1[i] = (float)acc[ai][bj][m][1][i] * sr * s1[i]; }
                    u32x4 w; w.x = cvt_pk_bf16(v0[0], v0[1]); w.y = cvt_pk_bf16(v0[2], v0[3]); w.z = cvt_pk_bf16(v1[0], v1[1]); w.w = cvt_pk_bf16(v1[2], v1[3]);
                    *(u32x4*)(O + (size_t)row * ldc + col0 + bj * HALF) = w; } }
    }
};
struct EpiPartS8 {
    static constexpr bool PERM = false, AFTER_DRAIN = false;
    float* C; int ldc; size_t pstride; int pm0; const float* sa; const float* amax;
    __device__ __forceinline__ void operator()(const i32x4 (&acc)[2][2][4][2], const Unit& u, int wr, int wc, int fr, int fq) const {
        asm volatile("" : "+v"(fr), "+v"(fq));
        const int row0 = (u.pm - pm0) * BM + wr * 64 + fr, col0 = u.pn * BM + wc * 32 + 4 * fq; float* base = C + (size_t)u.ks * pstride;
#pragma unroll
        for (int bj = 0; bj < 2; ++bj)
#pragma unroll
            for (int n = 0; n < 2; ++n) { const f32x4 sc = *(const f32x4*)(amax + col0 + bj * HALF + n * 16) * (1.f / 127.f);
#pragma unroll
                for (int ai = 0; ai < 2; ++ai)
#pragma unroll
                    for (int m = 0; m < 4; ++m) { const int rl = row0 + ai * HALF + m * 16; const float sr = sa[rl + pm0 * BM]; f32x4 v;
#pragma unroll
                        for (int i = 0; i < 4; ++i) v[i] = (float)acc[ai][bj][m][n][i] * sr * sc[i];
                        *(f32x4*)(base + (size_t)rl * ldc + col0 + bj * HALF + n * 16) = v; } }
    }
};
template <bool I8> struct AccSel { typedef f32x4 type; }; template <> struct AccSel<true> { typedef i32x4 type; };
template <class Epi, class Sched, bool ALIGN_EPI = false, bool SP2 = false, bool I8 = false>
__device__ __forceinline__ void gemm_phase(PG8_LAS unsigned char* lds, const Gemm g, const Sched& S, const Epi& E) {
    int tid_o = threadIdx.x; asm volatile("" : "+v"(tid_o));
    const int tid = tid_o, wid = __builtin_amdgcn_readfirstlane(tid >> 6), lane = tid & 63, wr = wid >> 2, wc = wid & 3, fr = lane & 15, fq = lane >> 4;
    const int K = g.K, nt = K / BK;
    unsigned voffA[2], voffB[2];
#pragma unroll
    for (int i = 0; i < 2; ++i) { int R, C; stage_rc(tid * 16 + i * 8192, R, C); const int Rb = Epi::PERM ? ((R & ~31) + perm32(R & 31)) : R;
        voffA[i] = (unsigned)(R * g.ld + C) * 2u; voffB[i] = (unsigned)(Rb * g.ld + C) * 2u; }
    const size_t kstep = (size_t)(BK * 2);
    const size_t hstep = (size_t)HALF * g.ld * 2;
    const size_t tstep = 2 * hstep;
    const unsigned ldsw = (unsigned)wid * 1024u;
    const int aoff = lds_byte(wr * 64 + fr, fq * 8), boff = lds_byte(wc * 32 + fr, fq * 8);
#define PG8_SA(b, h) (((b) * 2 + (h)) * HTB)
#define PG8_SB(b, h) ((4 + (b) * 2 + (h)) * HTB)
#define PG8_STAGE(bufoff, gbase, voff) do { _Pragma("unroll") for (int _i = 0; _i < 2; ++_i) \
        __builtin_amdgcn_global_load_lds((const unsigned*)((const char*)(gbase) + (voff)[_i]), (PG8_LAS unsigned*)(lds + (bufoff) + ldsw + _i * 8192), 16, 0, 0); } while (0)
#define PG8_LDA(dst, b, h) do { _Pragma("unroll") for (int m = 0; m < 4; ++m) _Pragma("unroll") for (int k = 0; k < 2; ++k) dst[m][k] = *(const PG8_LAS bf16x8*)(lds + PG8_SA(b, h) + aoff + m * 2048 + k * 1024); } while (0)
#define PG8_LDB(dst, b, h) do { _Pragma("unroll") for (int n = 0; n < 2; ++n) _Pragma("unroll") for (int k = 0; k < 2; ++k) dst[n][k] = *(const PG8_LAS bf16x8*)(lds + PG8_SB(b, h) + boff + n * 2048 + k * 1024); } while (0)
#define PG8_MMA(ai, bj, At, Bt) do { __builtin_amdgcn_s_setprio(1); _Pragma("unroll") for (int k = 0; k < 2; ++k) _Pragma("unroll") for (int m = 0; m < 4; ++m) _Pragma("unroll") for (int n = 0; n < 2; ++n) \
        acc[ai][bj][m][n] = mma16<I8>(Bt[n][k], At[m][k], acc[ai][bj][m][n]); __builtin_amdgcn_s_setprio(0); } while (0)
#define PG8_WAIT_V(n) asm volatile("s_waitcnt vmcnt(" #n ")" ::: "memory")
#define PG8_WAIT_L(n) asm volatile("s_waitcnt lgkmcnt(" #n ")" ::: "memory")
#define PG8_BAR __builtin_amdgcn_s_barrier()
#define PG8_SCHED __builtin_amdgcn_sched_barrier(0)
    Unit cur, nxt; int ui = 0;
    if (!S.next(0, cur)) return;
    typedef typename AccSel<I8>::type AccT; AccT acc[2][2][4][2];
#pragma unroll
    for (int a = 0; a < 2; ++a)
#pragma unroll
        for (int b = 0; b < 2; ++b)
#pragma unroll
            for (int m = 0; m < 4; ++m)
#pragma unroll
                for (int n = 0; n < 2; ++n) acc[a][b][m][n] = (AccT)(0);
    bf16x8 At[4][2], B0[2][2], B1[2][2];
    const char* cA = S.abase(g, cur, tstep); const char* cB = S.bbase(g, cur, tstep);
    S.a_ready(cur);
    if constexpr (SP2) {
        PG8_STAGE(PG8_SB(0, 0), cB, voffB); PG8_STAGE(PG8_SB(0, 1), cB + hstep, voffB); PG8_STAGE(PG8_SA(0, 0), cA, voffA); PG8_STAGE(PG8_SA(0, 1), cA + hstep, voffA);
        if (wr == 1) PG8_BAR;
        PG8_WAIT_V(2); PG8_BAR;
        PG8_STAGE(PG8_SB(1, 0), cB + kstep, voffB); PG8_STAGE(PG8_SA(1, 0), cA + kstep, voffA); PG8_STAGE(PG8_SB(1, 1), cB + hstep + kstep, voffB);
        PG8_WAIT_V(6); PG8_BAR;
    } else {
        PG8_STAGE(PG8_SB(0, 0), cB, voffB); PG8_STAGE(PG8_SA(0, 0), cA, voffA); PG8_STAGE(PG8_SB(0, 1), cB + hstep, voffB); PG8_STAGE(PG8_SA(0, 1), cA + hstep, voffA);
        if (wr == 1) PG8_BAR;
        PG8_WAIT_V(4); PG8_BAR;
        PG8_STAGE(PG8_SB(1, 0), cB + kstep, voffB); PG8_STAGE(PG8_SA(1, 0), cA + kstep, voffA); PG8_STAGE(PG8_SB(1, 1), cB + hstep + kstep, voffB);
        PG8_WAIT_V(6); PG8_BAR;
    }
    for (;;) {
        const bool has_next = S.next(ui + 1, nxt);
        const char* nA = has_next ? S.abase(g, nxt, tstep) : cA; const char* nB = has_next ? S.bbase(g, nxt, tstep) : cB;
        for (int t = 0; t < nt; t += 2) {
            const bool last = (t == nt - 2);
            const char* a1 = cA + (size_t)(t + 1) * kstep;
            const char* a2 = last ? nA : cA + (size_t)(t + 2) * kstep; const char* b2 = last ? nB : cB + (size_t)(t + 2) * kstep;
            const char* a3 = a2 + kstep; const char* b3 = b2 + kstep;
            if (last && has_next) S.a_ready(nxt);
            if constexpr (SP2) {
            PG8_LDB(B0, 0, 0); PG8_LDB(B1, 0, 1); PG8_SCHED; PG8_LDA(At, 0, 0); PG8_STAGE(PG8_SA(1, 1), a1 + hstep, voffA);
            PG8_WAIT_V(8); PG8_WAIT_L(0); PG8_BAR; PG8_MMA(0, 0, At, B0); PG8_MMA(0, 1, At, B1); PG8_BAR; PG8_SCHED;
            PG8_LDA(At, 0, 1); PG8_STAGE(PG8_SB(0, 0), b2, voffB); PG8_STAGE(PG8_SB(0, 1), b2 + hstep, voffB); PG8_STAGE(PG8_SA(0, 0), a2, voffA);
            PG8_WAIT_V(8); PG8_WAIT_L(0); PG8_BAR; PG8_MMA(1, 0, At, B0); PG8_MMA(1, 1, At, B1); PG8_BAR; PG8_SCHED;
            PG8_LDB(B0, 1, 0); PG8_LDB(B1, 1, 1); PG8_SCHED; PG8_LDA(At, 1, 0); PG8_STAGE(PG8_SA(0, 1), a2 + hstep, voffA);
            PG8_WAIT_V(8); PG8_WAIT_L(0); PG8_BAR; PG8_MMA(0, 0, At, B0); PG8_MMA(0, 1, At, B1); PG8_BAR; PG8_SCHED;
            PG8_LDA(At, 1, 1); PG8_STAGE(PG8_SB(1, 0), b3, voffB); PG8_STAGE(PG8_SB(1, 1), b3 + hstep, voffB); PG8_STAGE(PG8_SA(1, 0), a3, voffA);
            PG8_WAIT_V(8); PG8_WAIT_L(0); PG8_BAR; PG8_MMA(1, 0, At, B0); PG8_MMA(1, 1, At, B1); PG8_BAR; PG8_SCHED;
            } else {
            PG8_LDB(B0, 0, 0); PG8_SCHED; PG8_LDA(At, 0, 0); PG8_STAGE(PG8_SA(1, 1), a1 + hstep, voffA);
            PG8_WAIT_L(8); PG8_BAR; PG8_WAIT_L(0); PG8_MMA(0, 0, At, B0); PG8_BAR; PG8_SCHED;
            PG8_LDB(B1, 0, 1); PG8_STAGE(PG8_SB(0, 0), b2, voffB);
            PG8_BAR; PG8_WAIT_L(0); PG8_MMA(0, 1, At, B1); PG8_BAR;
            PG8_LDA(At, 0, 1); PG8_STAGE(PG8_SA(0, 0), a2, voffA);
            PG8_BAR; PG8_WAIT_L(0); PG8_MMA(1, 0, At, B0); PG8_BAR; PG8_SCHED;
            PG8_STAGE(PG8_SB(0, 1), b2 + hstep, voffB);
            PG8_WAIT_V(6); PG8_BAR; PG8_MMA(1, 1, At, B1); PG8_BAR;
            PG8_LDB(B0, 1, 0); PG8_SCHED; PG8_LDA(At, 1, 0); PG8_STAGE(PG8_SA(0, 1), a2 + hstep, voffA);
            PG8_WAIT_L(8); PG8_BAR; PG8_WAIT_L(0); PG8_MMA(0, 0, At, B0); PG8_BAR; PG8_SCHED;
            PG8_LDB(B1, 1, 1); PG8_STAGE(PG8_SB(1, 0), b3, voffB);
            PG8_BAR; PG8_WAIT_L(0); PG8_MMA(0, 1, At, B1); PG8_BAR;
            PG8_LDA(At, 1, 1); PG8_STAGE(PG8_SA(1, 0), a3, voffA);
            PG8_BAR; PG8_WAIT_L(0); PG8_MMA(1, 0, At, B0); PG8_BAR; PG8_SCHED;
            PG8_STAGE(PG8_SB(1, 1), b3 + hstep, voffB);
            PG8_WAIT_V(6); PG8_BAR; PG8_MMA(1, 1, At, B1); PG8_BAR;
            }
        }
        if constexpr (ALIGN_EPI) { if (wr == 0) PG8_BAR; }
        if constexpr (!Epi::AFTER_DRAIN) { E(acc, cur, wr, wc, fr, fq); S.done(cur); }
        if (!has_next) break;
#pragma unroll
        for (int a = 0; a < 2; ++a)
#pragma unroll
            for (int b = 0; b < 2; ++b)
#pragma unroll
                for (int m = 0; m < 4; ++m)
#pragma unroll
                    for (int n = 0; n < 2; ++n) acc[a][b][m][n] = (AccT)(0);
        cur = nxt; cA = nA; cB = nB; ++ui;
        if constexpr (ALIGN_EPI) { if (wr == 1) PG8_BAR; }
    }
    PG8_WAIT_V(0);
    if constexpr (!ALIGN_EPI) { if (wr == 0) PG8_BAR; }
    PG8_BAR;
    if constexpr (Epi::AFTER_DRAIN) { E.fused(acc, cur, wr, wc, fr, fq, lds, wid, lane); S.done(cur); }
#undef PG8_SA
#undef PG8_SB
#undef PG8_STAGE
#undef PG8_LDA
#undef PG8_LDB
#undef PG8_MMA
#undef PG8_WAIT_V
#undef PG8_WAIT_L
#undef PG8_BAR
#undef PG8_SCHED
}
}

constexpr int NWAVES = 8;
constexpr int D = 1024, NB = 4, SEQ = 4096, CTXL = 256, NLAT = NB * SEQ, NCTX = NB * CTXL, MROWS = NLAT + NCTX;
constexpr int DEPTH = 4, RW = 512, NH = 8, HS = 64, DFF = 3584, NE = 8, NPROJ = 3456, NP = 3584, NLO = 2560, KLA = 512, NMOD = 6144;
constexpr int PC_R = 0, PC_K = 512, PC_V = 1024, PC_CB = 1536, PC_CC = 2048, PC_CH = 2560, PC_WD = 3072, PC_AD = 3200, PC_GD = 3328;
constexpr float LN_EPS = 1e-5f, GN_EPS = 64e-5f, DN_ALPHA = 1.681792830507429f;
enum { I_X = 0, I_C, I_CTX, I_CCTX, I_WMOD, I_BMOD, I_WIN, I_W0, I_W2, I_A0, I_A2, I_KK, I_KA, I_RK, I_G2, I_LNXG, I_LNXB, I_CONVW, I_WOUT, I_LN1G, I_LN1B, I_LN2G, I_LN2B,
       I_FW1, I_FW3, I_FW2, I_RTW, I_RTB, I_MW1, I_MW3, I_MW2, N_IN };

constexpr size_t MiB = 1u << 20;
constexpr size_t WS_CTL = 0, CTL_BYTES = 3 * MiB;
constexpr size_t WS_MODV = 1 * MiB;
constexpr size_t WS_AMAX = 2 * MiB;
constexpr size_t WS_RKS = 3 * MiB;
constexpr size_t WS_WIN = 4 * MiB;
constexpr size_t WS_WOUT = WS_WIN + 28 * MiB;
constexpr size_t WS_LORA = WS_WOUT + 8 * MiB;
constexpr size_t WS_F13 = WS_LORA + 10 * MiB;
constexpr size_t WS_F2 = WS_F13 + 28 * MiB;
constexpr size_t WS_X = WS_F2 + 14 * MiB;
constexpr size_t WS_H = WS_X + 68 * MiB;
constexpr size_t WS_MOES = WS_H + 34 * MiB;
constexpr size_t WS_ROWLIST = WS_MOES;
constexpr size_t WS_TOKSEL = WS_MOES + 640 * 1024;
constexpr size_t WS_WSEL = WS_TOKSEL + 320 * 1024;
constexpr size_t WS_WSORT = WS_WSEL + 192 * 1024;
constexpr size_t WS_MOEW13 = WS_MOES + 2 * MiB;
constexpr size_t WS_MOEW2 = WS_MOEW13 + 112 * MiB;
constexpr size_t WS_H8 = WS_MOEW13 + 56 * MiB;
constexpr size_t WS_SA = WS_H8 + 17 * MiB;
constexpr size_t WS_SAM = WS_SA + 512 * 1024;
constexpr size_t WS_SAG = WS_SA + 1 * MiB;
constexpr size_t WS_SCR = WS_MOEW2 + 56 * MiB;
constexpr size_t WS_P = WS_SCR;
constexpr size_t WS_LO = WS_P + 119 * MiB;
constexpr size_t WS_PREP = WS_LO + 170 * MiB;
constexpr size_t WS_Y = WS_PREP + 213 * MiB;
constexpr size_t WS_MIXIN = WS_Y + 68 * MiB;
constexpr size_t WS_CH = WS_PREP;
constexpr size_t WS_MIXO = WS_PREP;
constexpr size_t WS_MIXP = WS_PREP + 34 * MiB;
constexpr size_t WS_END_MIXER = WS_MIXIN + 34 * MiB;
constexpr size_t WS_HG = WS_SCR;
constexpr size_t WS_ACT = WS_HG + 72 * MiB;
constexpr size_t WS_F = WS_ACT + 252 * MiB;
constexpr size_t WS_FP = WS_F + 72 * MiB;
constexpr size_t WS_END_FFN = WS_FP + 64 * MiB;
constexpr size_t WS_NEED = WS_END_MIXER > WS_END_FFN ? WS_END_MIXER : WS_END_FFN;
static_assert((size_t)MROWS * NP * 2 <= 119 * MiB && (size_t)MROWS * NLO * 4 <= 170 * MiB && (size_t)8704 * 25600 <= 213 * MiB && (size_t)MROWS * D * 4 <= 68 * MiB && WS_NEED <= 990 * MiB, "ws map");
constexpr int MOE_MAIN_PANELS = 128, MOE_TAIL_ROWS = 4096;
constexpr int MOE_ROWS = 36864;
constexpr int AM_IN = 18 * 2 * DFF, AM_OUT = AM_IN + DEPTH * NP;
constexpr int LORAW_PER_LAYER = 4 * 512 * 64 + 512 * 128;
constexpr int CW_BAR = 4096, CW_GCNT = 8192, CW_CQ = 12288, CW_SDONE = 12544;

constexpr int RING_BYTES = 131072, LDSCTL_OFF = RING_BYTES, MISC_OFF = LDSCTL_OFF + 320, LDS_BYTES = 147456;

typedef unsigned short bf16;
typedef unsigned v4u __attribute__((ext_vector_type(4)));
typedef unsigned v2u __attribute__((ext_vector_type(2)));
typedef float f32x4 __attribute__((ext_vector_type(4)));
#define LAS __attribute__((address_space(3)))
#define LDS_WAIT() asm volatile("s_waitcnt lgkmcnt(0)" ::: "memory")
__device__ __forceinline__ unsigned f2bf(float f) { unsigned u = __builtin_bit_cast(unsigned, f); return (u + 0x7fffu + ((u >> 16) & 1u)) >> 16; }
__device__ __forceinline__ unsigned pk2(float lo, float hi) { return f2bf(lo) | (f2bf(hi) << 16); }
__device__ __forceinline__ float bf2f(unsigned short b) { return __builtin_bit_cast(float, ((unsigned)b) << 16); }
__device__ __forceinline__ float bflo(unsigned w) { return __builtin_bit_cast(float, w << 16); }
__device__ __forceinline__ float bfhi(unsigned w) { return __builtin_bit_cast(float, w & 0xffff0000u); }
__device__ __forceinline__ float wave_sum(float v) {
#pragma unroll
    for (int o = 1; o < 64; o <<= 1) v += __shfl_xor(v, o);
    return v;
}
__device__ __forceinline__ float sigm(float x) { return 1.f / (1.f + __expf(-x)); }

#define XB_TMO      128
#define XB_XCNT(j)  (256  + 64 * (j))
#define XB_XSUB(j)  (1280 + 64 * (j))
#define XB_XGEN(j)  (2304 + 64 * (j))
#define XB_TOP      3328
#define XB_TOPGEN   3392
#define XCD_BAR_WORDS 3456
#define XB_SPIN_CAP (1u << 18)

__device__ __forceinline__ unsigned xb_ld(unsigned* p)              { return __hip_atomic_load(p, __ATOMIC_RELAXED, __HIP_MEMORY_SCOPE_AGENT); }
__device__ __forceinline__ unsigned xb_add(unsigned* p, unsigned v) { return __hip_atomic_fetch_add(p, v, __ATOMIC_RELAXED, __HIP_MEMORY_SCOPE_AGENT); }
__device__ __forceinline__ unsigned xb_xcc_id() { return (unsigned)__builtin_amdgcn_s_getreg((3 << 11) | 20) & 0xFu; }
#define XB_SPIN(cond, bar) do { unsigned _sp = 0; while (cond) { __builtin_amdgcn_s_sleep(1); \
    if ((++_sp & 255u) == 0u) { if (xb_ld(&(bar)[XB_TMO])) break; if (_sp > XB_SPIN_CAP) { atomicAdd(&(bar)[XB_TMO], 1u); break; } } } } while (0)

struct XcdBarrier {
    unsigned* bar; unsigned x;
    volatile LAS unsigned* st;
};

__device__ __forceinline__ XcdBarrier xcd_barrier_post(unsigned* bar, volatile LAS unsigned* st) {
    XcdBarrier b; b.bar = bar; b.x = xb_xcc_id(); b.st = st;
    if (threadIdx.x == 0) (void)xb_add(&bar[XB_XCNT(b.x)], 1u);
    return b;
}
__device__ __forceinline__ void xcd_barrier_complete(unsigned* bar, unsigned x, unsigned& nloc, unsigned& nx) {
    const unsigned G = gridDim.x * gridDim.y * gridDim.z;
    unsigned sum, cnt, mine, sp = 0u;
    for (;;) {
        sum = 0u; cnt = 0u; mine = 0u;
#pragma unroll
        for (unsigned j = 0; j < 16; ++j) { const unsigned c = xb_ld(&bar[XB_XCNT(j)]); sum += c; cnt += (c > 0u) ? 1u : 0u; mine = (j == x) ? c : mine; }
        if (sum == G) break;
        __builtin_amdgcn_s_sleep(1);
        if ((++sp & 255u) == 0u) { if (xb_ld(&bar[XB_TMO])) break; if (sp > XB_SPIN_CAP) { atomicAdd(&bar[XB_TMO], 1u); break; } }
    }
    nloc = mine > 0u ? mine : 1u; nx = cnt > 0u ? cnt : 1u;
}

__device__ __forceinline__ void xcd_barrier(const XcdBarrier& b) {
    asm volatile("s_waitcnt vmcnt(0)" ::: "memory");
    __syncthreads();
    if (threadIdx.x == 0) {
        unsigned* bar = b.bar;
        __builtin_amdgcn_s_waitcnt(0);
        unsigned nloc = b.st[0], nx = b.st[1];
        if (nloc == 0u) { xcd_barrier_complete(bar, b.x, nloc, nx); b.st[0] = nloc; b.st[1] = nx; }
        const unsigned old = xb_add(&bar[XB_XSUB(b.x)], 1u);
        const unsigned gen = old / nloc;
        if (old + 1u == (gen + 1u) * nloc) {
            __builtin_amdgcn_fence(__ATOMIC_RELEASE, "agent");
            asm volatile("s_waitcnt vmcnt(0)" ::: "memory");
            const unsigned og = xb_add(&bar[XB_TOP], 1u);
            const unsigned tg = og / nx;
            if (og + 1u == (tg + 1u) * nx) xb_add(&bar[XB_TOPGEN], 1u);
            else XB_SPIN(xb_ld(&bar[XB_TOPGEN]) == tg, bar);
            __builtin_amdgcn_fence(__ATOMIC_ACQUIRE, "agent");
            xb_add(&bar[XB_XGEN(b.x)], 1u);
            asm volatile("s_waitcnt vmcnt(0)" ::: "memory");
        } else {
            XB_SPIN(xb_ld(&bar[XB_XGEN(b.x)]) == gen, bar);
            __builtin_amdgcn_fence(__ATOMIC_ACQUIRE, "agent");
            asm volatile("s_waitcnt vmcnt(0)" ::: "memory");
        }
    }
    __syncthreads();
}


__device__ __forceinline__ size_t opaque_zero() { size_t z = 0; asm volatile("" : "+s"(z)); return z; }
#define OWS (p.ws + opaque_zero())
__device__ __forceinline__ int opaque_zero_i() { int z = 0; asm volatile("" : "+s"(z)); return z; }
#define PIN(i) (p.in[(i) + opaque_zero_i()])
struct KP { const float* in[N_IN]; float* out; unsigned char* ws; int ph; int pad; };

template <int MODE> __device__ __forceinline__ int rowmap(int n, int arg) {
    if (MODE == 0) return n + arg;
    if (MODE == 1) { if (n < 1536) return n; if (n < 1664) return n - 1536 + PC_WD; if (n < 1792) return n - 1664 + PC_AD; if (n < 1920) return n - 1792 + PC_GD;
                     if (n < 2432) return n - 1920 + PC_CB; if (n < 2944) return n - 2432 + PC_CC; return n - 2944 + PC_CH; }
    return 8 * (n >> 2) + 4 * arg + (n & 3);
}
template <int MODE> __device__ __forceinline__ void transpose_item(const float* W, int K, int N, bf16* WT, int arg, LAS float* scr, int item, int lane) {
    const int nblk = N / 32, kb = item / nblk, nb = item % nblk, k0 = 64 * kb, n0 = 32 * nb;
#pragma unroll 8
    for (int i = 0; i < 32; ++i) { const int kk = 2 * i + (lane >> 5); scr[kk * 33 + (lane & 31)] = W[(size_t)(k0 + kk) * N + n0 + (lane & 31)]; }
    LDS_WAIT(); asm volatile("" ::: "memory");
    const int c = lane & 7;
#pragma unroll
    for (int j = 0; j < 4; ++j) { const int n = (lane >> 3) + 8 * j; const LAS float* s = scr + (8 * c) * 33 + n;
        v4u o; o.x = pk2(s[0 * 33], s[1 * 33]); o.y = pk2(s[2 * 33], s[3 * 33]); o.z = pk2(s[4 * 33], s[5 * 33]); o.w = pk2(s[6 * 33], s[7 * 33]);
        *(v4u*)(WT + (size_t)rowmap<MODE>(n0 + n, arg) * K + k0 + 8 * c) = o; }
    LDS_WAIT(); asm volatile("" ::: "memory");
}

__device__ __forceinline__ void ph_modvec(const KP& p, LAS unsigned char* lds, int tid) {
    LAS float* sil = (LAS float*)lds;
    LAS float* red = (LAS float*)(lds + 5 * 1024 * 4);
    const float* c = PIN(I_C); const float* cc = PIN(I_CCTX);
    for (int i = tid; i < 5 * 1024; i += 512) { const float v = i < 4096 ? c[i] : cc[i - 4096]; sil[i] = v / (1.f + __expf(-v)); }
    __syncthreads();
    float* modv = (float*)(OWS + WS_MODV);
    const int ks = tid >> 6, col = tid & 63;
    for (int task = blockIdx.x; task < DEPTH * 96; task += gridDim.x) {
        const int l = task / 96, j0 = (task % 96) * 64;
        const float* w = PIN(I_WMOD) + (size_t)l * D * NMOD + (size_t)(ks * 128) * NMOD + j0 + col;
        float a0 = 0.f, a1 = 0.f, a2 = 0.f, a3 = 0.f, a4 = 0.f;
#pragma unroll 8
        for (int k = 0; k < 128; ++k) { const float wv = w[(size_t)k * NMOD]; const int kk = ks * 128 + k;
            a0 += sil[kk] * wv; a1 += sil[1024 + kk] * wv; a2 += sil[2048 + kk] * wv; a3 += sil[3072 + kk] * wv; a4 += sil[4096 + kk] * wv; }
        red[(ks * 5 + 0) * 64 + col] = a0; red[(ks * 5 + 1) * 64 + col] = a1; red[(ks * 5 + 2) * 64 + col] = a2; red[(ks * 5 + 3) * 64 + col] = a3; red[(ks * 5 + 4) * 64 + col] = a4;
        __syncthreads();
        if (tid < 320) { const int r = tid >> 6; float s = 0.f;
#pragma unroll
            for (int q = 0; q < 8; ++q) s += red[(q * 5 + r) * 64 + col];
            modv[(size_t)(l * 5 + r) * NMOD + j0 + col] = s + PIN(I_BMOD)[l * NMOD + j0 + col]; }
        __syncthreads();
    }
}

__device__ __forceinline__ void ph_convert(const KP& p, LAS unsigned char* lds, int gw, int NGW, int wave, int lane) {
    LAS float* scr = (LAS float*)(lds + wave * 16384);
    bf16* win = (bf16*)(OWS + WS_WIN); bf16* f2 = (bf16*)(OWS + WS_F2); bf16* lora = (bf16*)(OWS + WS_LORA);
    constexpr int I_IN = (D / 64) * (NPROJ / 32), I_OUT = (D / 64) * (D / 32), I_UP = (D / 64) * (DFF / 32), I_DN = (DFF / 64) * (D / 32);
    for (int it = gw; it < I_DN; it += NGW) transpose_item<0>(PIN(I_FW2), DFF, D, f2, 0, scr, it, lane);
    { const int gt = gw * 64 + lane, NGT = NGW * 64; constexpr int PER = (NP - NPROJ) * D / 16;
      for (int i = gt; i < DEPTH * PER; i += NGT) { const int l = i / PER, q = i % PER; *(v4u*)((unsigned char*)win + (size_t)l * NP * D + (size_t)NPROJ * D + (size_t)q * 16) = (v4u){0u, 0u, 0u, 0u}; } }
    { const int gt = gw * 64 + lane, NGT = NGW * 64;
      for (int i = gt; i < DEPTH * LORAW_PER_LAYER / 8; i += NGT) { const int l = i / (LORAW_PER_LAYER / 8); int q = (i % (LORAW_PER_LAYER / 8)) * 8; float v[8];
          int grp, c, k0; if (q < 4 * 512 * 64) { grp = q / (512 * 64); q -= grp * 512 * 64; c = q / 64; k0 = q % 64; } else { grp = 4; q -= 4 * 512 * 64; c = q / 128; k0 = q % 128; }
#pragma unroll
          for (int j = 0; j < 8; ++j) { const int k = k0 + j;
              v[j] = grp < 2 ? PIN(I_W2)[((size_t)(l * 2 + grp) * 64 + k) * RW + c] : grp < 4 ? PIN(I_A2)[((size_t)(l * 2 + grp - 2) * 64 + k) * RW + c] : PIN(I_G2)[((size_t)l * 128 + k) * RW + c]; }
          v4u o; o.x = pk2(v[0], v[1]); o.y = pk2(v[2], v[3]); o.z = pk2(v[4], v[5]); o.w = pk2(v[6], v[7]);
          *(v4u*)(lora + (size_t)i * 8) = o; } }
}
__device__ __forceinline__ void ph_amax(const KP& p, int gw, int NGW, int lane) {
    unsigned* AM = (unsigned*)(OWS + WS_AMAX);
    for (int it = gw; it < 18 * 2 * (DFF / 64); it += NGW) { const int kq = 0, strip = it % (DFF / 64), sm = it / (DFF / 64), s1 = sm & 1, cm = sm >> 1;
        const float* W = cm < 2 ? PIN(s1 ? I_FW3 : I_FW1) + (size_t)cm * D * DFF : PIN(s1 ? I_MW3 : I_MW1) + (size_t)(cm - 2) * D * DFF;
        const int n = strip * 64 + lane; const float* src = W + (size_t)(kq * 256) * DFF + n; float m = 0.f;
#pragma unroll 16
        for (int k = 0; k < 256; ++k) { const float w = src[(size_t)k * DFF]; m += w * w; }
        AM[(size_t)cm * 2 * DFF + 8 * (n >> 2) + 4 * s1 + (n & 3)] = __builtin_bit_cast(unsigned, 4.25f * sqrtf(m * (1.f / 256.f))); }
    for (int it = gw; it < DEPTH * (NPROJ / 64 + D / 64); it += NGW) { const int kq = 0; int t = it; const int l = t / (NPROJ / 64 + D / 64); t -= l * (NPROJ / 64 + D / 64);
        const bool isin = t < NPROJ / 64; const int strip = isin ? t : t - NPROJ / 64, N = isin ? NPROJ : D, n = strip * 64 + lane;
        const float* src = (isin ? PIN(I_WIN) + (size_t)l * D * NPROJ : PIN(I_WOUT) + (size_t)l * D * D) + (size_t)(kq * 256) * N + n; float m = 0.f;
#pragma unroll 16
        for (int k = 0; k < 256; ++k) { const float w = src[(size_t)k * N]; m += w * w; }
        AM[isin ? AM_IN + l * NP + rowmap<1>(n, 0) : AM_OUT + l * D + n] = __builtin_bit_cast(unsigned, 4.25f * sqrtf(m * (1.f / 256.f))); }
}
__device__ __forceinline__ unsigned q8pack(float a, float b, float c, float d) {
    const int qa = __float2int_rn(fminf(fmaxf(a, -127.f), 127.f)), qb = __float2int_rn(fminf(fmaxf(b, -127.f), 127.f)), qc = __float2int_rn(fminf(fmaxf(c, -127.f), 127.f)), qd = __float2int_rn(fminf(fmaxf(d, -127.f), 127.f));
    return (unsigned)(qa & 255) | ((unsigned)(qb & 255) << 8) | ((unsigned)(qc & 255) << 16) | ((unsigned)(qd & 255) << 24); }
constexpr int CQ_IN = (D / 64) * (NPROJ / 32), CQ_OUT = (D / 64) * (D / 32), CQ_UP = (D / 64) * (DFF / 32), CQ_DN = (DFF / 64) * (D / 32);
constexpr int CQ_NEG = CQ_IN + CQ_OUT + 2 * CQ_UP;
constexpr int CQ_J1 = 3 * CQ_IN + 3 * CQ_OUT + 2 * CQ_UP + CQ_DN, CQ_MOE = NE * (2 * CQ_UP + CQ_DN), CQ_END0 = CQ_J1 + CQ_MOE, CQ_END1 = CQ_END0 + CQ_MOE;
#ifndef CQ_SLOT_ITEMS
#define CQ_SLOT_ITEMS 12000
#endif
struct CqItem { const float* W; bf16* WT; int K, N, mode, arg, item; const unsigned* am; };
__device__ __forceinline__ CqItem cq_decode(const KP& p, int q) {
    CqItem c; bf16* win = (bf16*)(OWS + WS_WIN); bf16* wout = (bf16*)(OWS + WS_WOUT); bf16* f13 = (bf16*)(OWS + WS_F13); bf16* f2 = (bf16*)(OWS + WS_F2);
    bf16* m13 = (bf16*)(OWS + WS_MOEW13); bf16* m2 = (bf16*)(OWS + WS_MOEW2); const unsigned* AM = (const unsigned*)(OWS + WS_AMAX);
    if (q < 0) { q += CQ_NEG;
        if (q < CQ_IN) { c = CqItem{PIN(I_WIN), win, D, NPROJ, 3, 0, q, AM + AM_IN}; return c; } q -= CQ_IN;
        if (q < CQ_OUT) { c = CqItem{PIN(I_WOUT), wout, D, D, 4, 0, q, AM + AM_OUT}; return c; } q -= CQ_OUT;
        if (q < CQ_UP) { c = CqItem{PIN(I_FW1), f13, D, DFF, 2, 0, q, AM}; return c; } q -= CQ_UP;
        c = CqItem{PIN(I_FW3), f13, D, DFF, 2, 1, q, AM}; return c; }
    if (q < 3 * CQ_IN) { const int l = 1 + q / CQ_IN; c = CqItem{PIN(I_WIN) + (size_t)l * D * NPROJ, win + (size_t)l * (NP * D / 2), D, NPROJ, 3, 0, q % CQ_IN, AM + AM_IN + l * NP}; return c; } q -= 3 * CQ_IN;
    if (q < 3 * CQ_OUT) { const int l = 1 + q / CQ_OUT; c = CqItem{PIN(I_WOUT) + (size_t)l * D * D, wout + (size_t)l * (D * D / 2), D, D, 4, 0, q % CQ_OUT, AM + AM_OUT + l * D}; return c; } q -= 3 * CQ_OUT;
    if (q < CQ_UP) { c = CqItem{PIN(I_FW1) + (size_t)D * DFF, f13 + (size_t)DFF * D, D, DFF, 2, 0, q, AM + 2 * DFF}; return c; } q -= CQ_UP;
    if (q < CQ_UP) { c = CqItem{PIN(I_FW3) + (size_t)D * DFF, f13 + (size_t)DFF * D, D, DFF, 2, 1, q, AM + 2 * DFF}; return c; } q -= CQ_UP;
    if (q < CQ_DN) { c = CqItem{PIN(I_FW2) + (size_t)DFF * D, f2 + (size_t)D * DFF, DFF, D, 0, 0, q, nullptr}; return c; } q -= CQ_DN;
    const int mi = q / CQ_MOE; q -= mi * CQ_MOE;
    if (q < NE * CQ_UP) { const int e = q / CQ_UP; c = CqItem{PIN(I_MW1) + ((size_t)mi * NE + e) * D * DFF, m13 + (size_t)e * DFF * D, D, DFF, 2, 0, q % CQ_UP, AM + (size_t)(2 + 8 * mi + e) * 2 * DFF}; return c; } q -= NE * CQ_UP;
    if (q < NE * CQ_UP) { const int e = q / CQ_UP; c = CqItem{PIN(I_MW3) + ((size_t)mi * NE + e) * D * DFF, m13 + (size_t)e * DFF * D, D, DFF, 2, 1, q % CQ_UP, AM + (size_t)(2 + 8 * mi + e) * 2 * DFF}; return c; } q -= NE * CQ_UP;
    { const int e = q / CQ_DN; c = CqItem{PIN(I_MW2) + ((size_t)mi * NE + e) * DFF * D, m2 + (size_t)e * D * DFF, DFF, D, 0, 0, q % CQ_DN, nullptr}; return c; }
}
__device__ __forceinline__ void cq_load(const CqItem& c, int lane, float (&r)[32]) {
    const int nblk = c.N / 32, kb = c.item / nblk, nb = c.item % nblk; const float* src = c.W + (size_t)(64 * kb + (lane >> 5)) * c.N + 32 * nb + (lane & 31);
#pragma unroll
    for (int i = 0; i < 32; ++i) r[i] = src[(size_t)(2 * i) * c.N];
}
__device__ __forceinline__ void cq_store(const CqItem& c, int lane, const float (&r)[32], LAS float* scr) {
    const int nblk = c.N / 32, kb = c.item / nblk, nb = c.item % nblk, k0 = 64 * kb, n0 = 32 * nb;
#pragma unroll
    for (int i = 0; i < 32; ++i) scr[(2 * i + (lane >> 5)) * 33 + (lane & 31)] = r[i];
    LDS_WAIT(); asm volatile("" ::: "memory");
    if (c.mode >= 2) {
        const int n = lane >> 1, hf = lane & 1, nn = n0 + n, j = c.mode == 2 ? 8 * (nn >> 2) + 4 * c.arg + (nn & 3) : c.mode == 3 ? rowmap<1>(nn, 0) : nn;
        const float inv = 127.f / fmaxf(__builtin_bit_cast(float, c.am[j]), 1e-30f); const LAS float* sp = scr + (32 * hf) * 33 + n; unsigned w[8];
#pragma unroll
        for (int q = 0; q < 8; ++q) w[q] = q8pack(sp[(4 * q + 0) * 33] * inv, sp[(4 * q + 1) * 33] * inv, sp[(4 * q + 2) * 33] * inv, sp[(4 * q + 3) * 33] * inv);
        unsigned char* dst = (unsigned char*)c.WT + (size_t)j * c.K + k0 + 32 * hf;
        *(v4u*)dst = (v4u){w[0], w[1], w[2], w[3]}; *(v4u*)(dst + 16) = (v4u){w[4], w[5], w[6], w[7]};
    } else {
    const int cc = lane & 7;
#pragma unroll
    for (int j = 0; j < 4; ++j) { const int n = (lane >> 3) + 8 * j; const LAS float* sp = scr + (8 * cc) * 33 + n;
        v4u o; o.x = pk2(sp[0 * 33], sp[1 * 33]); o.y = pk2(sp[2 * 33], sp[3 * 33]); o.z = pk2(sp[4 * 33], sp[5 * 33]); o.w = pk2(sp[6 * 33], sp[7 * 33]);
        const int nn = n0 + n;
        *(v4u*)(c.WT + (size_t)nn * c.K + k0 + 8 * cc) = o; }
    }
    LDS_WAIT(); asm volatile("" ::: "memory");
}
constexpr int CQ_B = 4;
__device__ __forceinline__ int cq_grab(unsigned* heads, int nseg, int& cnt, int lane) {
    int q = -1, n = 0;
    if (lane == 0) { for (int sg = 0; sg < nseg && q < 0; ++sg) { const int size = sg == 0 ? CQ_J1 : CQ_MOE, base = sg == 0 ? 0 : sg == 1 ? CQ_J1 : CQ_END0; unsigned* hd = heads + 64 * sg;
            if ((int)__hip_atomic_load(hd, __ATOMIC_RELAXED, __HIP_MEMORY_SCOPE_AGENT) < size) { const int t = (int)__hip_atomic_fetch_add(hd, (unsigned)CQ_B, __ATOMIC_RELAXED, __HIP_MEMORY_SCOPE_AGENT);
                if (t < size) { q = base + t; n = size - t < CQ_B ? size - t : CQ_B; } } } }
    cnt = __builtin_amdgcn_readfirstlane(n); return __builtin_amdgcn_readfirstlane(q);
}
__device__ __forceinline__ void cq_run(const KP& p, LAS unsigned char* lds, int nseg, const unsigned* stop, unsigned stopval, int wave, int lane) {
    unsigned* heads = (unsigned*)(OWS + WS_CTL) + CW_CQ; LAS float* scr = (LAS float*)(lds + wave * 16384);
    for (;;) {
        if (stop) { unsigned sv = 0u; if (lane == 0) sv = __hip_atomic_load(stop, __ATOMIC_RELAXED, __HIP_MEMORY_SCOPE_AGENT); if ((unsigned)__builtin_amdgcn_readfirstlane((int)sv) >= stopval) break; }
        int cnt; const int q0 = cq_grab(heads, nseg, cnt, lane); if (q0 < 0) break;
        CqItem cur = cq_decode(p, q0); float ra[32]; cq_load(cur, lane, ra);
        for (int j = 0; j < cnt; ++j) { CqItem nxt = cur; float rb[32];
            if (j + 1 < cnt) { nxt = cq_decode(p, q0 + j + 1); cq_load(nxt, lane, rb); }
            cq_store(cur, lane, ra, scr);
            if (j + 1 < cnt) { cur = nxt;
#pragma unroll
                for (int i = 0; i < 32; ++i) ra[i] = rb[i]; } }
    }
}

__device__ __forceinline__ void cq_static(const KP& p, LAS unsigned char* lds, int q0, int q1, int gw, int NGW, int wave, int lane) {
    LAS float* scr = (LAS float*)(lds + wave * 16384);
    int q = q0 + gw; if (q >= q1) return;
    CqItem cur = cq_decode(p, q); float ra[32]; cq_load(cur, lane, ra);
    for (;;) { const int qn = q + NGW; CqItem nxt = cur; float rb[32];
        if (qn < q1) { nxt = cq_decode(p, qn); cq_load(nxt, lane, rb); }
        cq_store(cur, lane, ra, scr);
        if (qn >= q1) break;
        cur = nxt; q = qn;
#pragma unroll
        for (int i = 0; i < 32; ++i) ra[i] = rb[i]; }
}

__device__ __forceinline__ void ld_row(const float* r, int lane, f32x4 (&v)[4]) { const f32x4* q = (const f32x4*)r + lane;
#pragma unroll
    for (int j = 0; j < 4; ++j) v[j] = q[64 * j]; }
__device__ __forceinline__ void st_row(float* r, int lane, const f32x4 (&v)[4]) { f32x4* q = (f32x4*)r + lane;
#pragma unroll
    for (int j = 0; j < 4; ++j) q[64 * j] = v[j]; }
__device__ __forceinline__ void st_row_bf16(bf16* r, int lane, const f32x4 (&v)[4]) { v2u* q = (v2u*)r + lane;
#pragma unroll
    for (int j = 0; j < 4; ++j) { v2u w; w.x = pk2(v[j][0], v[j][1]); w.y = pk2(v[j][2], v[j][3]); q[64 * j] = w; } }
__device__ __forceinline__ void ld_row_bf16(const bf16* r, int lane, f32x4 (&v)[4]) { const v2u* q = (const v2u*)r + lane;
#pragma unroll
    for (int j = 0; j < 4; ++j) { const v2u w = q[64 * j]; v[j] = (f32x4){bflo(w.x), bfhi(w.x), bflo(w.y), bfhi(w.y)}; } }
template <int S> __device__ __forceinline__ void ld_row_parts(const float* r, size_t pstride, int lane, f32x4 (&v)[4]) {
    ld_row(r, lane, v);
#pragma unroll
    for (int s = 1; s < S; ++s) { f32x4 t[4]; ld_row(r + (size_t)s * pstride, lane, t);
#pragma unroll
        for (int j = 0; j < 4; ++j) v[j] += t[j]; } }
__device__ __forceinline__ int mod_row(int row) { return row < NLAT ? (row >> 12) : 4; }

__device__ __forceinline__ void st_row_q8(unsigned char* dst8, float* scale, int row, int lane, const f32x4 (&v)[4]) {
    float am = 0.f;
#pragma unroll
    for (int j = 0; j < 4; ++j) am = fmaxf(fmaxf(am, fmaxf(fabsf(v[j][0]), fabsf(v[j][1]))), fmaxf(fabsf(v[j][2]), fabsf(v[j][3])));
#pragma unroll
    for (int o = 1; o < 64; o <<= 1) am = fmaxf(am, __shfl_xor(am, o));
    am = fmaxf(am, 1e-30f); const float inv = 127.f / am; unsigned* h8 = (unsigned*)dst8 + (size_t)row * (D / 4) + lane;
#pragma unroll
    for (int j = 0; j < 4; ++j) h8[64 * j] = q8pack(v[j][0] * inv, v[j][1] * inv, v[j][2] * inv, v[j][3] * inv);
    if (lane == 0) scale[row] = am * (1.f / 127.f);
}
__device__ __forceinline__ void ph_init_rows(const KP& p, int gw, int NGW, int lane) {
    const float* modv = (const float*)(OWS + WS_MODV); float* X = (float*)(OWS + WS_X); bf16* H = (bf16*)(OWS + WS_H);
    for (int row = gw; row < MROWS; row += NGW) {
        const float* src = row < NLAT ? PIN(I_X) + (size_t)row * D : PIN(I_CTX) + (size_t)(row - NLAT) * D;
        const float* mv = modv + (size_t)(0 * 5 + mod_row(row)) * NMOD;
        f32x4 x[4], sh[4], sc[4], h[4]; ld_row(src, lane, x); ld_row(mv, lane, sh); ld_row(mv + 1024, lane, sc);
#pragma unroll
        for (int j = 0; j < 4; ++j) h[j] = x[j] * (1.f + sc[j]) + sh[j];
        st_row_q8(OWS + WS_H8, (float*)(OWS + WS_SA), row, lane, h);
    }
}

__device__ __forceinline__ int scan_row(int b, int dir, int step) { return step < CTXL ? NLAT + b * CTXL + (dir ? CTXL - 1 - step : step) : b * SEQ + (dir ? SEQ - 1 - (step - CTXL) : step - CTXL); }
typedef short sbf16x8 __attribute__((ext_vector_type(8)));
typedef float f32x16 __attribute__((ext_vector_type(16)));
constexpr int SC_C = 32, SC_NCH = (CTXL + SEQ) / SC_C  , SC_NCHAIN = NB * NH * 2  , SC_NTASK = SC_NCH * SC_NCHAIN  ;
constexpr int CH_G = 0, CH_Q = 8192, CH_UT = 12288, CH_YL = 20480, CH_EC = 24576, CH_BYTES = 25600, CH_NLOAD = 26;

__device__ __forceinline__ f32x16 mm(v4u a, v4u b, f32x16 c) { return __builtin_amdgcn_mfma_f32_32x32x16_bf16(__builtin_bit_cast(sbf16x8, a), __builtin_bit_cast(sbf16x8, b), c, 0, 0, 0); }
typedef float f32x2c __attribute__((ext_vector_type(2))); typedef __bf16 bf16x2c __attribute__((ext_vector_type(2)));
__device__ __forceinline__ unsigned cvtpk(float lo, float hi) { return __builtin_bit_cast(unsigned, __builtin_convertvector((f32x2c){lo, hi}, bf16x2c)); }
template <int S, int NEG> __device__ __forceinline__ v4u cvtf(const f32x16& x) {
    v4u w; const float sg = NEG ? -1.f : 1.f;
    w.x = cvtpk(sg * x[8 * S + 0], sg * x[8 * S + 1]); w.y = cvtpk(sg * x[8 * S + 2], sg * x[8 * S + 3]); w.z = cvtpk(sg * x[8 * S + 4], sg * x[8 * S + 5]); w.w = cvtpk(sg * x[8 * S + 6], sg * x[8 * S + 7]); return w; }
template <int MODE  > __device__ __forceinline__ f32x16 mask_acc(f32x16 x, int n, int hh) {
#pragma unroll
    for (int r = 0; r < 16; ++r) { const int m = (r & 3) + 8 * (r >> 2) + 4 * hh; const bool keep = MODE == 0 ? (m > n) : MODE == 1 ? (m < n) : (m <= n); x[r] = keep ? x[r] : 0.f; }
    return x; }
__device__ __forceinline__ f32x16 zero16() { f32x16 z;
#pragma unroll
    for (int r = 0; r < 16; ++r) z[r] = 0.f;
    return z; }
__device__ __forceinline__ void cm_build(const unsigned (&w)[16], v4u (&f)[2][2]) {
#pragma unroll
    for (int s = 0; s < 2; ++s) {
        const auto r0 = __builtin_amdgcn_permlane32_swap(w[8 * s + 0], w[8 * s + 2], false, false), r1 = __builtin_amdgcn_permlane32_swap(w[8 * s + 1], w[8 * s + 3], false, false);
        const auto r2 = __builtin_amdgcn_permlane32_swap(w[8 * s + 4], w[8 * s + 6], false, false), r3 = __builtin_amdgcn_permlane32_swap(w[8 * s + 5], w[8 * s + 7], false, false);
        f[0][s] = (v4u){r0[0], r1[0], r2[0], r3[0]}; f[1][s] = (v4u){r0[1], r1[1], r2[1], r3[1]}; }
}
__device__ __forceinline__ void st16(unsigned char* base, int off, int lane, v4u v) { *(v4u*)(base + off + lane * 16) = v; }

__device__ __forceinline__ void ph_scan1(const KP& p, int l, int gw, int NGW, int lane) {
    const bf16* P = (const bf16*)(OWS + WS_P); const bf16* LO = (const bf16*)(OWS + WS_LO); const float* NRM = (const float*)(OWS + WS_RKS); unsigned char* CH = OWS + WS_CH;
    const int n = lane & 31, hh = lane >> 5;
    v4u Id[2];
#pragma unroll
    for (int s = 0; s < 2; ++s) { unsigned wd[4];
#pragma unroll
        for (int q = 0; q < 4; ++q) { const int j0 = 2 * q, j1 = 2 * q + 1; const int t0 = 16 * s + 8 * (j0 >> 2) + 4 * hh + (j0 & 3), t1 = 16 * s + 8 * (j1 >> 2) + 4 * hh + (j1 & 3);
            wd[q] = (t0 == n ? 0x3F80u : 0u) | (t1 == n ? 0x3F800000u : 0u); }
        Id[s] = (v4u){wd[0], wd[1], wd[2], wd[3]}; }
    for (int task = gw; task < SC_NTASK; task += NGW) {
        const int dir = task & 1, h = (task >> 1) & 7, b = (task >> 4) & 3, ci = task >> 6;
        const int row0 = scan_row(b, dir, SC_C * ci), sgn = dir ? -1 : 1, c = h * 64 + lane;
        const float w0c = PIN(I_W0)[(l * 2 + dir) * RW + c], a0c = PIN(I_A0)[(l * 2 + dir) * RW + c], kkc = PIN(I_KK)[l * RW + c], kac = PIN(I_KA)[l * RW + c];
        unsigned wAl[16], wBe[16], wKa[16], wRh[16], wV[16], wBp[16], wKp[16];
        float cs = 0.f, Eprev = 1.f;
#pragma unroll
        for (int hb = 0; hb < 2; ++hb) {
            unsigned rk_[16], rr_[16], rv_[16], rw_[16], ra_[16]; float rn_[16];
#pragma unroll
            for (int i = 0; i < 16; ++i) { const int row = row0 + sgn * (16 * hb + i); const bf16* pr = P + (size_t)row * NP; const bf16* lo = LO + (size_t)row * NLO;
                rk_[i] = pr[PC_K + c]; rr_[i] = pr[PC_R + c]; rv_[i] = pr[PC_V + c]; rw_[i] = lo[dir * RW + c]; ra_[i] = lo[1024 + dir * RW + c]; rn_[i] = NRM[row * 8 + h]; }
#pragma unroll
            for (int i = 0; i < 16; ++i) asm volatile("" : "+v"(rk_[i]), "+v"(rr_[i]), "+v"(rv_[i]), "+v"(rw_[i]), "+v"(ra_[i]), "+v"(rn_[i]));
#pragma unroll
            for (int pq = 0; pq < 8; ++pq) { const int pz = 8 * hb + pq; float al[2], be[2], ka[2], rh[2], vv[2];
#pragma unroll
                for (int e = 0; e < 2; ++e) { const int i = 2 * pq + e;
                    const float kv = bf2f((unsigned short)rk_[i]), rv = bf2f((unsigned short)rr_[i]); vv[e] = bf2f((unsigned short)rv_[i]);
                    const float wl = w0c + bf2f((unsigned short)rw_[i]), aa = __builtin_amdgcn_rcpf(1.f + __expf(-(a0c + bf2f((unsigned short)ra_[i])))), nrm = rn_[i];
                    const float lw = -0.6065306597f * __builtin_amdgcn_rcpf(1.f + __expf(-wl));
                    cs += lw; const float E = __expf(cs), Ei = __builtin_amdgcn_rcpf(E);
                    const float kkn = kv * kkc * nrm, kd = kv * (1.f + (aa - 1.f) * kac);
                    al[e] = kkn * Eprev; be[e] = kkn * aa * Ei; ka[e] = kd * Ei; rh[e] = rv * E; Eprev = E; }
                wAl[pz] = cvtpk(al[0], al[1]); wBe[pz] = cvtpk(be[0], be[1]); wKa[pz] = cvtpk(ka[0], ka[1]); wRh[pz] = cvtpk(rh[0], rh[1]); wV[pz] = cvtpk(vv[0], vv[1]); }
        }
        const float EC = Eprev;
#pragma unroll
        for (int pz = 0; pz < 16; ++pz) { wBp[pz] = cvtpk(bflo(wBe[pz]) * EC, bfhi(wBe[pz]) * EC); wKp[pz] = cvtpk(bflo(wKa[pz]) * EC, bfhi(wKa[pz]) * EC); }
        unsigned char* img = CH + (size_t)(((b * 8 + h) * 2 + dir) * SC_NCH + ci) * CH_BYTES;
        ((float*)(img + CH_EC))[lane] = EC;
        v4u cAl[2][2], cV[2][2], cBp[2][2], cKp[2][2], cRh[2][2];
        v4u tAl[4], tBe[4], tKa[4], tRh[4];
        cm_build(wAl, cAl); cm_build(wV, cV); cm_build(wBp, cBp); cm_build(wKp, cKp); cm_build(wRh, cRh);
        {   v4u cBe[2][2], cKa[2][2]; cm_build(wBe, cBe); cm_build(wKa, cKa);
#define TRANSPOSE(cZ, tZ) do { _Pragma("unroll") for (int ct = 0; ct < 2; ++ct) { f32x16 T_ = mm(cZ[ct][0], Id[0], zero16()); T_ = mm(cZ[ct][1], Id[1], T_); tZ[2 * ct] = cvtf<0, 0>(T_); tZ[2 * ct + 1] = cvtf<1, 0>(T_); } } while (0)
            TRANSPOSE(cAl, tAl); TRANSPOSE(cBe, tBe); TRANSPOSE(cKa, tKa); TRANSPOSE(cRh, tRh);
#undef TRANSPOSE
        }
#define PROD4(A, B) mm(A[3], B[3], mm(A[2], B[2], mm(A[1], B[1], mm(A[0], B[0], zero16()))))
        f32x16 XN = mask_acc<0>(PROD4(tAl, tBe), n, hh), XT = mask_acc<1>(PROD4(tBe, tAl), n, hh);
        v4u fLM[2], fGB[2], fGK[2];
        { const f32x16 t = mask_acc<1>(PROD4(tKa, tAl), n, hh); fLM[0] = cvtf<0, 0>(t); fLM[1] = cvtf<1, 0>(t); }
        { const f32x16 t = mask_acc<2>(PROD4(tBe, tRh), n, hh); fGB[0] = cvtf<0, 0>(t); fGB[1] = cvtf<1, 0>(t); }
        { const f32x16 t = mask_acc<2>(PROD4(tKa, tRh), n, hh); fGK[0] = cvtf<0, 0>(t); fGK[1] = cvtf<1, 0>(t); }
#undef PROD4
#pragma unroll
        for (int r = 0; r < 16; ++r) { XN[r] = -XN[r]; XT[r] = -XT[r]; }
        f32x16 RT = XT;
#pragma unroll
        for (int r = 0; r < 16; ++r) RT[r] += ((r & 3) + 8 * (r >> 2) + 4 * hh == n) ? 1.f : 0.f;
#pragma unroll
        for (int pw = 1; pw < 5; ++pw) {
            const v4u xn0 = cvtf<0, 0>(XN), xn1 = cvtf<1, 0>(XN), xt0 = cvtf<0, 0>(XT), xt1 = cvtf<1, 0>(XT);
            XN = mm(xt1, xn1, mm(xt0, xn0, zero16()));
            if (pw < 4) XT = mm(xn1, xt1, mm(xn0, xt0, zero16()));
            const v4u yn0 = cvtf<0, 0>(XN), yn1 = cvtf<1, 0>(XN), rt0 = cvtf<0, 0>(RT), rt1 = cvtf<1, 0>(RT);
            RT = mm(yn1, rt1, mm(yn0, rt0, RT));
        }
        const v4u fA0 = cvtf<0, 0>(RT), fA1 = cvtf<1, 0>(RT);
        f32x16 At[2], Vt[2];
#pragma unroll
        for (int t = 0; t < 2; ++t) {
            const f32x16 lmv = mm(fLM[1], cV[t][1], mm(fLM[0], cV[t][0], zero16()));
            At[t] = mm(fA1, cAl[t][1], mm(fA0, cAl[t][0], zero16()));
            Vt[t] = mm(fA1, cvtf<1, 0>(lmv), mm(fA0, cvtf<0, 0>(lmv), zero16()));
        }
#pragma unroll
        for (int kt1 = 0; kt1 < 2; ++kt1) { const v4u a0 = cvtf<0, 0>(At[kt1]), a1 = cvtf<1, 0>(At[kt1]);
#pragma unroll
            for (int kt2 = 0; kt2 < 2; ++kt2) { const f32x16 g = mm(a1, cBp[kt2][1], mm(a0, cBp[kt2][0], zero16()));
                st16(img, CH_G + ((kt2 * 2 + kt1) * 2 + 0) * 1024, lane, cvtf<0, 1>(g)); st16(img, CH_G + ((kt2 * 2 + kt1) * 2 + 1) * 1024, lane, cvtf<1, 1>(g)); } }
#pragma unroll
        for (int vt = 0; vt < 2; ++vt) { const v4u nv0 = cvtf<0, 1>(Vt[vt]), nv1 = cvtf<1, 1>(Vt[vt]);
#pragma unroll
            for (int kt = 0; kt < 2; ++kt) { f32x16 u = mm(cKp[kt][1], cV[vt][1], mm(cKp[kt][0], cV[vt][0], zero16())); u = mm(cBp[kt][1], nv1, mm(cBp[kt][0], nv0, u));
                st16(img, CH_UT + ((kt * 2 + vt) * 2 + 0) * 1024, lane, cvtf<0, 0>(u)); st16(img, CH_UT + ((kt * 2 + vt) * 2 + 1) * 1024, lane, cvtf<1, 0>(u)); }
            f32x16 y = mm(cV[vt][1], fGK[1], mm(cV[vt][0], fGK[0], zero16())); y = mm(nv1, fGB[1], mm(nv0, fGB[0], y));
            st16(img, CH_YL + (vt * 2 + 0) * 1024, lane, cvtf<0, 0>(y)); st16(img, CH_YL + (vt * 2 + 1) * 1024, lane, cvtf<1, 0>(y)); }
#pragma unroll
        for (int kt = 0; kt < 2; ++kt) { f32x16 q = mm(cRh[kt][1], Id[1], mm(cRh[kt][0], Id[0], zero16()));
            q = mm(cvtf<1, 1>(At[kt]), fGB[1], mm(cvtf<0, 1>(At[kt]), fGB[0], q));
            st16(img, CH_Q + (kt * 2 + 0) * 1024, lane, cvtf<0, 0>(q)); st16(img, CH_Q + (kt * 2 + 1) * 1024, lane, cvtf<1, 0>(q)); }
    }
}

__device__ __forceinline__ void ph_scan2(const KP& p, LAS unsigned char* lds, int l, int wave, int lane) {
    unsigned* sdone = (unsigned*)(OWS + WS_CTL) + CW_SDONE + 64 * l;
#ifndef CQ_SLOT_WGS
#define CQ_SLOT_WGS 128
#endif
    if (blockIdx.x >= SC_NCHAIN * 2) {
        const int q0 = (l < 2 ? CQ_J1 : CQ_END0) + (l & 1) * CQ_SLOT_ITEMS;
        cq_static(p, lds, q0, q0 + CQ_SLOT_ITEMS, ((int)blockIdx.x - SC_NCHAIN * 2) * NWAVES + wave, ((int)gridDim.x - SC_NCHAIN * 2) * NWAVES, wave, lane); return; }
    const int chain = blockIdx.x >> 1, vt = blockIdx.x & 1, dir = chain & 1, h = (chain >> 1) & 7, b = chain >> 4;
    const int n = lane & 31, hh = lane >> 5;
    const unsigned char* CH = OWS + WS_CH + (size_t)chain * SC_NCH * CH_BYTES; bf16* Y = (bf16*)(OWS + WS_Y) + (size_t)dir * MROWS * RW + h * 64 + 32 * vt + 4 * hh;
    constexpr int NPIECE = 19, SLOT = NPIECE * 1024, NSLOT = 6, PD = 4, XCH = NSLOT * SLOT;
    int psrc[3], pdst[3];
#pragma unroll
    for (int j = 0; j < 3; ++j) { int f = wave + 8 * j; if (f >= NPIECE) f -= NPIECE;
        pdst[j] = f;
        psrc[j] = f < 12 ? f * 1024 : f < 16 ? CH_UT + ((((f - 12) >> 1) * 2 + vt) * 2 + ((f - 12) & 1)) * 1024 : f < 18 ? CH_YL + (vt * 2 + (f - 16)) * 1024 : CH_EC; }
    const int lane_off[3] = {pdst[0] == 18 ? (lane * 16) & 255 : lane * 16, pdst[1] == 18 ? (lane * 16) & 255 : lane * 16, pdst[2] == 18 ? (lane * 16) & 255 : lane * 16};
#define SC2_ISSUE(ci_, slot_) do { const unsigned char* im_ = CH + (size_t)(ci_) * CH_BYTES; LAS unsigned char* sl_ = lds + (slot_) * SLOT; \
        _Pragma("unroll") for (int j = 0; j < 3; ++j) __builtin_amdgcn_global_load_lds((const unsigned*)(im_ + psrc[j] + lane_off[j]), (LAS unsigned*)(sl_ + pdst[j] * 1024), 16, 0, 0); } while (0)
#define SC2_LD(slot_, piece_) (*(const LAS v4u*)(lds + (slot_) * SLOT + (piece_) * 1024 + lane * 16))
#define SC2_X(par_, k_) (*(LAS v4u*)(lds + XCH + (par_) * 4096 + (k_) * 1024 + lane * 16))
    f32x16 ST[2] = {zero16(), zero16()};
    SC2_ISSUE(0, 0); SC2_ISSUE(1, 1); SC2_ISSUE(2, 2); SC2_ISSUE(3, 3);
    v4u g0, g1, g2, g3, g4, g5, g6, g7, u0, u1, u2, u3; f32x4 ec[8];
#define SC2_PRELOAD(slot_) do { g0 = SC2_LD(slot_, 0); g1 = SC2_LD(slot_, 1); g2 = SC2_LD(slot_, 2); g3 = SC2_LD(slot_, 3); g4 = SC2_LD(slot_, 4); g5 = SC2_LD(slot_, 5); g6 = SC2_LD(slot_, 6); g7 = SC2_LD(slot_, 7); \
        u0 = SC2_LD(slot_, 12); u1 = SC2_LD(slot_, 13); u2 = SC2_LD(slot_, 14); u3 = SC2_LD(slot_, 15); \
        _Pragma("unroll") for (int kq = 0; kq < 8; ++kq) ec[kq] = *(const LAS f32x4*)(lds + (slot_) * SLOT + 18 * 1024 + (32 * (kq >> 2) + 8 * (kq & 3) + 4 * hh) * 4); } while (0)
    for (int ci = 0; ci <= SC_NCH; ++ci) {
        asm volatile("s_waitcnt vmcnt(6)" ::: "memory");
        __builtin_amdgcn_s_barrier();
        asm volatile("" ::: "memory");
        { const int nx = ci + PD < SC_NCH ? ci + PD : SC_NCH - 1; SC2_ISSUE(nx, (ci + PD) % NSLOT); }
        if (wave == 0 && ci < SC_NCH) {
            if (ci == 0) SC2_PRELOAD(0);
            asm volatile("" : "+v"(g0), "+v"(g1), "+v"(g2), "+v"(g3), "+v"(g4), "+v"(g5), "+v"(g6), "+v"(g7), "+v"(u0), "+v"(u1), "+v"(u2), "+v"(u3));
            asm volatile("" : "+v"(ec[0]), "+v"(ec[1]), "+v"(ec[2]), "+v"(ec[3]), "+v"(ec[4]), "+v"(ec[5]), "+v"(ec[6]), "+v"(ec[7]));
            const v4u s00 = cvtf<0, 0>(ST[0]), s01 = cvtf<1, 0>(ST[0]), s10 = cvtf<0, 0>(ST[1]), s11 = cvtf<1, 0>(ST[1]);
            SC2_X(ci & 1, 0) = s00; SC2_X(ci & 1, 1) = s01; SC2_X(ci & 1, 2) = s10; SC2_X(ci & 1, 3) = s11;
            f32x16 a0, a1;
            a0[0] = bflo(u0.x); a0[1] = bfhi(u0.x); a0[2] = bflo(u0.y); a0[3] = bfhi(u0.y); a0[4] = bflo(u0.z); a0[5] = bfhi(u0.z); a0[6] = bflo(u0.w); a0[7] = bfhi(u0.w);
            a0[8] = bflo(u1.x); a0[9] = bfhi(u1.x); a0[10] = bflo(u1.y); a0[11] = bfhi(u1.y); a0[12] = bflo(u1.z); a0[13] = bfhi(u1.z); a0[14] = bflo(u1.w); a0[15] = bfhi(u1.w);
            a1[0] = bflo(u2.x); a1[1] = bfhi(u2.x); a1[2] = bflo(u2.y); a1[3] = bfhi(u2.y); a1[4] = bflo(u2.z); a1[5] = bfhi(u2.z); a1[6] = bflo(u2.w); a1[7] = bfhi(u2.w);
            a1[8] = bflo(u3.x); a1[9] = bfhi(u3.x); a1[10] = bflo(u3.y); a1[11] = bfhi(u3.y); a1[12] = bflo(u3.z); a1[13] = bfhi(u3.z); a1[14] = bflo(u3.w); a1[15] = bfhi(u3.w);
#pragma unroll
            for (int q = 0; q < 4; ++q)
#pragma unroll
                for (int e = 0; e < 4; ++e) { a0[4 * q + e] += ST[0][4 * q + e] * ec[q][e]; a1[4 * q + e] += ST[1][4 * q + e] * ec[4 + q][e]; }
            a0 = mm(g0, s00, a0); a1 = mm(g4, s00, a1); a0 = mm(g1, s01, a0); a1 = mm(g5, s01, a1);
            a0 = mm(g2, s10, a0); a1 = mm(g6, s10, a1); a0 = mm(g3, s11, a0); a1 = mm(g7, s11, a1);
            if (ci + 1 < SC_NCH) SC2_PRELOAD((ci + 1) % NSLOT);
            ST[0] = a0; ST[1] = a1;
            if (lane == 0 && ci == SC_NCH - 24) __hip_atomic_fetch_add(sdone, 1u, __ATOMIC_RELAXED, __HIP_MEMORY_SCOPE_AGENT);
        } else if (wave == 1 && ci >= 1) {
            const int cj = ci - 1, sj = cj % NSLOT, par = cj & 1;
            v4u ya = SC2_LD(sj, 16), yc = SC2_LD(sj, 17), q0 = SC2_LD(sj, 8), q1 = SC2_LD(sj, 9), q2 = SC2_LD(sj, 10), q3 = SC2_LD(sj, 11), x0 = SC2_X(par, 0), x1 = SC2_X(par, 1), x2 = SC2_X(par, 2), x3 = SC2_X(par, 3);
            asm volatile("" : "+v"(ya), "+v"(yc), "+v"(q0), "+v"(q1), "+v"(q2), "+v"(q3), "+v"(x0), "+v"(x1), "+v"(x2), "+v"(x3));
            f32x16 y, y2 = zero16();
            y[0] = bflo(ya.x); y[1] = bfhi(ya.x); y[2] = bflo(ya.y); y[3] = bfhi(ya.y); y[4] = bflo(ya.z); y[5] = bfhi(ya.z); y[6] = bflo(ya.w); y[7] = bfhi(ya.w);
            y[8] = bflo(yc.x); y[9] = bfhi(yc.x); y[10] = bflo(yc.y); y[11] = bfhi(yc.y); y[12] = bflo(yc.z); y[13] = bfhi(yc.z); y[14] = bflo(yc.w); y[15] = bfhi(yc.w);
            y = mm(x0, q0, y); y2 = mm(x2, q2, y2); y = mm(x1, q1, y); y2 = mm(x3, q3, y2);
            const int row = scan_row(b, dir, SC_C * cj + n); bf16* yo = Y + (size_t)row * RW;
#pragma unroll
            for (int q = 0; q < 4; ++q) *(v2u*)(yo + 8 * q) = (v2u){cvtpk(y[4 * q] + y2[4 * q], y[4 * q + 1] + y2[4 * q + 1]), cvtpk(y[4 * q + 2] + y2[4 * q + 2], y[4 * q + 3] + y2[4 * q + 3])};
        }
        asm volatile("s_waitcnt lgkmcnt(0)" ::: "memory");
    }
    asm volatile("s_waitcnt vmcnt(0)" ::: "memory");
#undef SC2_ISSUE
#undef SC2_LD
#undef SC2_X
#undef SC2_PRELOAD
}

__device__ __forceinline__ float sum8(float v) { v += __shfl_xor(v, 1); v += __shfl_xor(v, 2); v += __shfl_xor(v, 4); return v; }
__device__ __forceinline__ void unpack8(v4u s, float (&v)[8]) { v[0] = bflo(s.x); v[1] = bfhi(s.x); v[2] = bflo(s.y); v[3] = bfhi(s.y); v[4] = bflo(s.z); v[5] = bfhi(s.z); v[6] = bflo(s.w); v[7] = bfhi(s.w); }
__device__ __forceinline__ void ld8f(const float* q, float (&v)[8]) { const f32x4 a = *(const f32x4*)q, b = *(const f32x4*)(q + 4); v[0] = a[0]; v[1] = a[1]; v[2] = a[2]; v[3] = a[3]; v[4] = b[0]; v[5] = b[1]; v[6] = b[2]; v[7] = b[3]; }
__device__ __forceinline__ v4u pack8(const float (&v)[8]) { v4u o; o.x = cvtpk(v[0], v[1]); o.y = cvtpk(v[2], v[3]); o.z = cvtpk(v[4], v[5]); o.w = cvtpk(v[6], v[7]); return o; }

__device__ __forceinline__ void ph_readout2(const KP& p, int l, int gw, int NGW, int lane) {
    const bf16* P = (const bf16*)(OWS + WS_P); const bf16* LO = (const bf16*)(OWS + WS_LO); const bf16* Y = (const bf16*)(OWS + WS_Y);
    bf16* MI = (bf16*)(OWS + WS_MIXIN); constexpr size_t PA = (size_t)MROWS * RW; const int c0 = lane * 8;
    const int nrows = l == DEPTH - 1 ? NLAT : MROWS;
#pragma unroll 2
    for (int row = gw; row < nrows; row += NGW) { const bf16* pr = P + (size_t)row * NP; const bf16* lo = LO + (size_t)row * NLO;
        int t, len; if (row < NLAT) { t = row & 63; len = 64; } else { t = (row - NLAT) & 255; len = 256; }
        const v4u kw = *(const v4u*)(pr + PC_K + c0), rw = *(const v4u*)(pr + PC_R + c0), vw = *(const v4u*)(pr + PC_V + c0);
        const v4u cbw = *(const v4u*)(pr + PC_CB + c0), ccw = *(const v4u*)(pr + PC_CC + c0), chw = *(const v4u*)(pr + PC_CH + c0);
        v4u ccp = (v4u){0u, 0u, 0u, 0u}, chp = ccp, ccn = ccp, chn = ccp;
        if (t > 0) { ccp = *(const v4u*)(pr - NP + PC_CC + c0); chp = *(const v4u*)(pr - NP + PC_CH + c0); }
        if (t < len - 1) { ccn = *(const v4u*)(pr + NP + PC_CC + c0); chn = *(const v4u*)(pr + NP + PC_CH + c0); }
        float yf[8], yb[8], la0[8], la1[8], g[8];
        unpack8(*(const v4u*)(Y + (size_t)row * RW + c0), yf); unpack8(*(const v4u*)(Y + PA + (size_t)row * RW + c0), yb); unpack8(*(const v4u*)(lo + 1024 + c0), la0); unpack8(*(const v4u*)(lo + 1536 + c0), la1); unpack8(*(const v4u*)(lo + 2048 + c0), g);
        float a0[8], a1[8], ka[8], rkp[8], lg[8], lb[8];
        ld8f(PIN(I_A0) + (l * 2 + 0) * RW + c0, a0); ld8f(PIN(I_A0) + (l * 2 + 1) * RW + c0, a1); ld8f(PIN(I_KA) + l * RW + c0, ka); ld8f(PIN(I_RK) + l * RW + c0, rkp);
        ld8f(PIN(I_LNXG) + l * RW + c0, lg); ld8f(PIN(I_LNXB) + l * RW + c0, lb);
        float kv[8], rv[8], vv[8]; unpack8(kw, kv); unpack8(rw, rv); unpack8(vw, vv);
        float y[8], s = 0.f, rk = 0.f;
#pragma unroll
        for (int j = 0; j < 8; ++j) { y[j] = yf[j] + yb[j]; s += y[j]; const float av = sigm(a0[j] + la0[j]) + sigm(a1[j] + la1[j]); rk += rv[j] * kv[j] * (2.f + (av - 2.f) * ka[j]) * rkp[j]; }
        const float mu = sum8(s) * (1.f / 64.f); rk = sum8(rk); float q = 0.f;
#pragma unroll
        for (int j = 0; j < 8; ++j) { y[j] -= mu; q += y[j] * y[j]; }
        const float rstd = 1.f / sqrtf(sum8(q) * (1.f / 64.f) + GN_EPS);
        float o[8];
#pragma unroll
        for (int j = 0; j < 8; ++j) o[j] = (y[j] * rstd * lg[j] + lb[j] + rk * vv[j]) * g[j];
        float orw[8];
#pragma unroll
        for (int j = 0; j < 8; ++j) orw[j] = o[j];
        float cb[8], cc[8], ch[8], pcc[8], pch[8], ncc[8], nch[8], w0[8], w1[8], w2[8];
        unpack8(cbw, cb); unpack8(ccw, cc); unpack8(chw, ch); unpack8(ccp, pcc); unpack8(chp, pch); unpack8(ccn, ncc); unpack8(chn, nch);
        const float* cw = PIN(I_CONVW) + (size_t)l * 3 * RW + c0; ld8f(cw, w0); ld8f(cw + RW, w1); ld8f(cw + 2 * RW, w2);
#pragma unroll
        for (int j = 0; j < 8; ++j) o[j] = cb[j] * (pcc[j] * pch[j] * w0[j] + cc[j] * ch[j] * w1[j] + ncc[j] * nch[j] * w2[j]);
        float am = 0.f;
#pragma unroll
        for (int j = 0; j < 8; ++j) am = fmaxf(am, fmaxf(fabsf(orw[j]), fabsf(o[j])));
#pragma unroll
        for (int sh = 1; sh < 64; sh <<= 1) am = fmaxf(am, __shfl_xor(am, sh));
        am = fmaxf(am, 1e-30f); const float inv = 127.f / am; unsigned char* m8 = (unsigned char*)MI + (size_t)row * D + c0;
        *(v2u*)m8 = (v2u){q8pack(orw[0] * inv, orw[1] * inv, orw[2] * inv, orw[3] * inv), q8pack(orw[4] * inv, orw[5] * inv, orw[6] * inv, orw[7] * inv)};
        *(v2u*)(m8 + RW) = (v2u){q8pack(o[0] * inv, o[1] * inv, o[2] * inv, o[3] * inv), q8pack(o[4] * inv, o[5] * inv, o[6] * inv, o[7] * inv)};
        if (lane == 0) ((float*)(OWS + WS_SAM))[row] = am * (1.f / 127.f);
    }
}


template <int KS> __device__ __forceinline__ void lora_afrag(const v4u (&raw)[KS], int fn, v4u (&af)[KS]) {
#pragma unroll
    for (int s = 0; s < KS; ++s) { float v[8]; unpack8(raw[s], v);
        if (fn == 0) {
#pragma unroll
            for (int j = 0; j < 8; ++j) v[j] = 1.f - 2.f * __builtin_amdgcn_rcpf(1.f + __expf(2.f * v[j])); }
        else if (fn == 2) {
#pragma unroll
            for (int j = 0; j < 8; ++j) v[j] = __builtin_amdgcn_rcpf(1.f + __expf(-v[j])); }
        af[s] = pack8(v); }
}
template <int KS, int NT> __device__ __forceinline__ void lora_task(const bf16* P, int col0, int fn, const bf16* wt, bf16* LOg, int ct0, int rb0, int rb1, int n, int hh) {
    v4u bfr[NT][KS];
#pragma unroll
    for (int t = 0; t < NT; ++t)
#pragma unroll
        for (int s = 0; s < KS; ++s) bfr[t][s] = *(const v4u*)(wt + (size_t)(32 * (ct0 + t) + n) * (16 * KS) + 8 * hh + 16 * s);
    v4u raw[KS];
#pragma unroll
    for (int s = 0; s < KS; ++s) raw[s] = *(const v4u*)(P + (size_t)(rb0 * 32 + n) * NP + col0 + 16 * s + 8 * hh);
    for (int rb = rb0; rb < rb1; ++rb) {
        v4u af[KS]; lora_afrag<KS>(raw, fn, af);
        if (rb + 1 < rb1) {
#pragma unroll
            for (int s = 0; s < KS; ++s) raw[s] = *(const v4u*)(P + (size_t)((rb + 1) * 32 + n) * NP + col0 + 16 * s + 8 * hh); }
        int no = n, ho = hh; asm volatile("" : "+v"(no), "+v"(ho));
        bf16* out = LOg + (size_t)(rb * 32 + 4 * ho) * NLO + 32 * ct0 + no;
#pragma unroll
        for (int t = 0; t < NT; ++t) { f32x16 acc = zero16();
#pragma unroll
            for (int s = 0; s < KS; ++s) acc = mm(af[s], bfr[t][s], acc);
#pragma unroll
            for (int r = 0; r < 16; ++r) out[(size_t)((r & 3) + 8 * (r >> 2)) * NLO + 32 * t] = (bf16)f2bf(acc[r]); }
    }
}
__device__ __forceinline__ void ph_lora(const KP& p, int l, int gw, int NGW, int lane) {
    const bf16* P = (const bf16*)(OWS + WS_P); bf16* LO = (bf16*)(OWS + WS_LO); float* NRM = (float*)(OWS + WS_RKS);
    const bf16* LW = (const bf16*)(OWS + WS_LORA) + (size_t)l * LORAW_PER_LAYER; const int n = lane & 31, hh = lane >> 5;
    constexpr int RCH = 7, NRB = MROWS / 32, NCHK = (NRB + RCH - 1) / RCH;
    for (int task = gw; task < NCHK * 24; task += NGW) { const int ctk = task % 24, chunk = task / 24, rb0 = chunk * RCH, rb1 = rb0 + RCH < NRB ? rb0 + RCH : NRB;
        if (ctk < 16) { const int grp = ctk >> 2; lora_task<4, 4>(P, grp < 2 ? PC_WD + 64 * grp : PC_AD + 64 * (grp - 2), grp < 2 ? 0 : 1, LW + (size_t)grp * 512 * 64, LO + grp * 512, (ctk & 3) * 4, rb0, rb1, n, hh); }
        else lora_task<8, 2>(P, PC_GD, 2, LW + (size_t)4 * 512 * 64, LO + 4 * 512, (ctk - 16) * 2, rb0, rb1, n, hh); }
    float kkc[8]; ld8f(PIN(I_KK) + l * RW + lane * 8, kkc);
    for (int row = gw; row < MROWS; row += NGW) { const v4u kw = *(const v4u*)(P + (size_t)row * NP + PC_K + lane * 8); float kv[8]; unpack8(kw, kv); float ss = 0.f;
#pragma unroll
        for (int j = 0; j < 8; ++j) { const float t = kv[j] * kkc[j]; ss += t * t; }
        ss = sum8(ss); if ((lane & 7) == 0) NRM[row * 8 + (lane >> 3)] = 1.f / fmaxf(sqrtf(ss), 1e-12f); }
}

__device__ __forceinline__ void ph_moe_gather(const KP& p, int l, int gw, int NGW, int lane) {
    const unsigned* gcnt = (const unsigned*)(OWS + WS_CTL) + CW_GCNT + 64 * (l >> 1);
    int cnt[8], pb[9]; pb[0] = 0;
#pragma unroll
    for (int e = 0; e < 8; ++e) { cnt[e] = (int)gcnt[e]; pb[e + 1] = pb[e] + ((cnt[e] + 255) & ~255); }
    const unsigned* rowlist = (const unsigned*)(OWS + WS_ROWLIST); const float* wsel = (const float*)(OWS + WS_WSEL); float* wsort = (float*)(OWS + WS_WSORT);
    const unsigned char* H8 = OWS + WS_H8; unsigned char* HG = OWS + WS_HG; const float* sa = (const float*)(OWS + WS_SA); float* sag = (float*)(OWS + WS_SAG);
    for (int pos = gw; pos < pb[8]; pos += NGW) {
        int e = 0, base = 0, ce = cnt[0];
#pragma unroll
        for (int k = 1; k < 8; ++k) if (pos >= pb[k]) { e = k; base = pb[k]; ce = cnt[k]; }
        const int rank = pos - base; v4u a = (v4u){0u, 0u, 0u, 0u}; float w = 0.f, sc = 0.f;
        if (rank < ce) { const unsigned ent = rowlist[(size_t)e * MROWS + rank]; a = *(const v4u*)(H8 + (size_t)(ent >> 1) * D + lane * 16); w = wsel[ent]; sc = sa[ent >> 1]; }
        *(v4u*)(HG + (size_t)pos * D + lane * 16) = a;
        if (lane == 0) { wsort[pos] = w; sag[pos] = sc; }
    }
}

__device__ __forceinline__ void ph_ln(const KP& p, LAS unsigned char* lds, int l, int which, int tid, int wave, int gw, int NGW, int lane) {
    const float* modv = (const float*)(OWS + WS_MODV); float* X = (float*)(OWS + WS_X); bf16* H = (bf16*)(OWS + WS_H);
    const bf16* BR = (const bf16*)(OWS + (which == 0 ? WS_MIXO : WS_F)); const float* BP = (const float*)(OWS + (which == 0 ? WS_MIXP : WS_FP));
    const float* lg = PIN(which == 0 ? I_LN1G : I_LN2G) + l * D; const float* lb = PIN(which == 0 ? I_LN1B : I_LN2B) + l * D;
    const bool moe = (which == 0) && (l & 1); const bool last = (which == 1) && (l == DEPTH - 1); const bool moe_out = (which == 1) && (l & 1);
    LAS int* lcnt = (LAS int*)lds;
    LAS int* lsel = (LAS int*)(lds + 64);
    int nloc = 0;
    if (moe) { if (tid < 16) lcnt[tid] = 0; __syncthreads(); }
    int pbs[9]; pbs[0] = 0;
    if (moe_out) { const unsigned* gcnt = (const unsigned*)(OWS + WS_CTL) + CW_GCNT + 64 * (l >> 1);
#pragma unroll
        for (int e = 0; e < 8; ++e) pbs[e + 1] = pbs[e] + (int)((gcnt[e] + 255u) & ~255u); }
    f32x4 gt[4], g4[4], b4[4], sh[4], sc[4]; ld_row(lg, lane, g4); ld_row(lb, lane, b4);
#pragma unroll 2
    for (int it = 0; it < 9; ++it) {
        if (it == 8 && (gw >= NCTX || l == DEPTH - 1)) break;
        const int row = it < 8 ? (gw >> 9) * SEQ + (gw & 511) + 512 * it : NLAT + gw;
        const int mr = mod_row(row); const float* mv = modv + (size_t)(l * 5 + mr) * NMOD;
        if (it == 0 || it == 8) { ld_row(mv + (which == 0 ? 2048 : 5120), lane, gt);
            if (!last) { const float* mv2 = which == 0 ? mv + 3072 : modv + (size_t)((l + 1) * 5 + mr) * NMOD; ld_row(mv2, lane, sh); ld_row(mv2 + 1024, lane, sc); } }
        f32x4 x[4], br[4], t[4]; ld_row(l == 0 && which == 0 ? (row < NLAT ? PIN(I_X) + (size_t)row * D : PIN(I_CTX) + (size_t)(row - NLAT) * D) : X + (size_t)row * D, lane, x);
        if (moe_out) { const int* ts = (const int*)(OWS + WS_TOKSEL) + row * 4; const int e0 = ts[0], r0 = ts[1], e1 = ts[2], r1 = ts[3]; int b0 = 0, b1 = 0;
#pragma unroll
            for (int k = 1; k < 8; ++k) { if (e0 >= k) b0 = pbs[k]; if (e1 >= k) b1 = pbs[k]; }
            f32x4 ba[4], bb[4]; const int q0 = b0 + r0, q1 = b1 + r1; constexpr int MM = MOE_MAIN_PANELS * 256;
            if (q0 < MM) ld_row_bf16(BR + (size_t)q0 * D, lane, ba); else ld_row_parts<4>(BP + (size_t)(q0 - MM) * D, (size_t)MOE_TAIL_ROWS * D, lane, ba);
            if (q1 < MM) ld_row_bf16(BR + (size_t)q1 * D, lane, bb); else ld_row_parts<4>(BP + (size_t)(q1 - MM) * D, (size_t)MOE_TAIL_ROWS * D, lane, bb);
#pragma unroll
            for (int j = 0; j < 4; ++j) br[j] = ba[j] + bb[j]; }
        else if (row < NLAT) ld_row_bf16(BR + (size_t)row * D, lane, br);
        else if (which == 0) ld_row_parts<2>(BP + (size_t)(row - NLAT) * D, (size_t)NCTX * D, lane, br);
        else ld_row_parts<7>(BP + (size_t)(row - NLAT) * D, (size_t)NCTX * D, lane, br);
        float s = 0.f;
#pragma unroll
        for (int j = 0; j < 4; ++j) { t[j] = DN_ALPHA * x[j] + gt[j] * br[j]; s += (t[j][0] + t[j][1]) + (t[j][2] + t[j][3]); }
        const float mean = wave_sum(s) * (1.f / D); float s2 = 0.f;
#pragma unroll
        for (int j = 0; j < 4; ++j) { t[j] = t[j] - mean; s2 += (t[j][0] * t[j][0] + t[j][1] * t[j][1]) + (t[j][2] * t[j][2] + t[j][3] * t[j][3]); }
        const float rstd = 1.f / sqrtf(wave_sum(s2) * (1.f / D) + LN_EPS);
#pragma unroll
        for (int j = 0; j < 4; ++j) x[j] = t[j] * rstd * g4[j] + b4[j];
        if (last) {
#if PROBE_DUP & (128 | 256)
            { const unsigned* cw = (const unsigned*)(OWS + WS_CTL); const float cval = 10.f * ((float)cw[20001] / 1024.f) / fmaxf((float)cw[20000], 1.f);
#pragma unroll
              for (int j = 0; j < 4; ++j) x[j] = (f32x4){cval, cval, cval, cval}; }
#endif
            if (row < NLAT) st_row(p.out + (size_t)row * D, lane, x); continue; }
        st_row(X + (size_t)row * D, lane, x);
        f32x4 hh[4];
#pragma unroll
        for (int j = 0; j < 4; ++j) hh[j] = x[j] * (1.f + sc[j]) + sh[j];
        st_row_q8(OWS + WS_H8, (float*)(OWS + WS_SA), row, lane, hh);
        if (moe) {
            const float* rw = PIN(I_RTW) + (size_t)(l >> 1) * D * NE; float lgt[8];
#pragma unroll
            for (int e = 0; e < 8; ++e) lgt[e] = 0.f;
#pragma unroll
            for (int j = 0; j < 4; ++j)
#pragma unroll
                for (int i = 0; i < 4; ++i) { const f32x4* wp = (const f32x4*)(rw + (size_t)(4 * lane + 256 * j + i) * NE); const f32x4 w0 = wp[0], w1 = wp[1]; const float hv = hh[j][i];
                    lgt[0] += hv * w0[0]; lgt[1] += hv * w0[1]; lgt[2] += hv * w0[2]; lgt[3] += hv * w0[3]; lgt[4] += hv * w1[0]; lgt[5] += hv * w1[1]; lgt[6] += hv * w1[2]; lgt[7] += hv * w1[3]; }
#pragma unroll
            for (int e = 0; e < 8; ++e) lgt[e] = wave_sum(lgt[e]) + PIN(I_RTB)[(l >> 1) * NE + e];
            float v0 = lgt[0]; int i0 = 0;
#pragma unroll
            for (int e = 1; e < 8; ++e) if (lgt[e] > v0) { v0 = lgt[e]; i0 = e; }
            float v1 = -3.0e38f; int i1 = -1;
#pragma unroll
            for (int e = 0; e < 8; ++e) if (e != i0 && lgt[e] > v1) { v1 = lgt[e]; i1 = e; }
            const float w0 = 1.f / (1.f + expf(v1 - v0)), w1 = 1.f - w0;
            if (lane == 0) { const int lr0 = __hip_atomic_fetch_add(lcnt + i0, 1, __ATOMIC_RELAXED, __HIP_MEMORY_SCOPE_WORKGROUP), lr1 = __hip_atomic_fetch_add(lcnt + i1, 1, __ATOMIC_RELAXED, __HIP_MEMORY_SCOPE_WORKGROUP); const int li = nloc * NWAVES + wave;
                lsel[li * 8 + 0] = row; lsel[li * 8 + 1] = i0; lsel[li * 8 + 2] = lr0; lsel[li * 8 + 3] = i1; lsel[li * 8 + 4] = lr1;
                ((float*)(OWS + WS_WSEL))[row * 2] = w0; ((float*)(OWS + WS_WSEL))[row * 2 + 1] = w1; }
            ++nloc;
        }
    }
    if (moe) {
        __syncthreads();
        unsigned* gcnt = (unsigned*)(OWS + WS_CTL) + CW_GCNT + 64 * (l >> 1);
        if (tid < 8) lcnt[8 + tid] = (int)__hip_atomic_fetch_add(gcnt + tid, (unsigned)lcnt[tid], __ATOMIC_RELAXED, __HIP_MEMORY_SCOPE_AGENT);
        __syncthreads();
        unsigned* rowlist = (unsigned*)(OWS + WS_ROWLIST); int* toksel = (int*)(OWS + WS_TOKSEL);
        if (tid < 16 * NWAVES) { const int k = tid / NWAVES, w = tid % NWAVES; if (k < 8 || (k == 8 && (int)blockIdx.x * NWAVES + w < NCTX && l != DEPTH - 1)) { const int li = k * NWAVES + w;
            const int row = lsel[li * 8 + 0], e0 = lsel[li * 8 + 1], r0 = lcnt[8 + e0] + lsel[li * 8 + 2], e1 = lsel[li * 8 + 3], r1 = lcnt[8 + e1] + lsel[li * 8 + 4];
            rowlist[(size_t)e0 * MROWS + r0] = (unsigned)row * 2u; rowlist[(size_t)e1 * MROWS + r1] = (unsigned)row * 2u + 1u;
            toksel[row * 4 + 0] = e0; toksel[row * 4 + 1] = r0; toksel[row * 4 + 2] = e1; toksel[row * 4 + 3] = r1; } }
    }
}


#ifndef PROBE_WHICH
#define PROBE_WHICH(x, y) (x)
#endif
#if PROBE_DUP & 128
__device__ __forceinline__ void ph_check_up(const KP& p, int gw, int lane) {
    if (gw >= 64) return;
    const float* X = (const float*)(OWS + WS_X); const float* modv = (const float*)(OWS + WS_MODV); const bf16* ACT = (const bf16*)(OWS + WS_ACT);
    const int row = gw * 257, c = lane * 56 + (gw & 7), mr = mod_row(row); const float* mv = modv + (size_t)(0 * 5 + mr) * NMOD;
    const signed char* H8 = (const signed char*)(OWS + WS_H8); const signed char* W8 = (const signed char*)(OWS + WS_F13); const float* SA = (const float*)(OWS + WS_SA); const unsigned* AM = (const unsigned*)(OWS + WS_AMAX);
    const int j1 = 8 * (c >> 2) + (c & 3), j3 = j1 + 4; int ia = 0, ib = 0;
    for (int k = 0; k < D; ++k) { const int h = H8[(size_t)row * D + k]; ia += h * W8[(size_t)j1 * D + k]; ib += h * W8[(size_t)j3 * D + k]; }
    const float a = (float)ia * SA[row] * __builtin_bit_cast(float, AM[j1]) * (1.f / 127.f), b = (float)ib * SA[row] * __builtin_bit_cast(float, AM[j3]) * (1.f / 127.f);
    (void)X; (void)mv;
    const float ref = a / (1.f + expf(-a)) * b, got = bf2f(ACT[(size_t)row * DFF + c]);
    const float da = ((const float*)(OWS + WS_F))[(size_t)row * DFF + c], db = ((const float*)(OWS + WS_F))[(size_t)4096 * DFF + (size_t)row * DFF + c]; (void)got; (void)db;
    if (row < 4096 && abs(ia) > 1000) { const float ratio = 10.f * fminf(fabsf(PROBE_WHICH(da / a, db / b) - 1.f), 0.4f);
        __hip_atomic_fetch_add((unsigned*)(OWS + WS_CTL) + 20000, 1u, __ATOMIC_RELAXED, __HIP_MEMORY_SCOPE_AGENT); __hip_atomic_fetch_add((unsigned*)(OWS + WS_CTL) + 20001, (unsigned)(ratio * 1024.f), __ATOMIC_RELAXED, __HIP_MEMORY_SCOPE_AGENT); }
}
#endif

#if PROBE_DUP & 256
__device__ __forceinline__ void ph_check_mfma(const KP& p, int lane) {
    typedef int i32x4 __attribute__((ext_vector_type(4)));
    const int r = lane & 15, g = lane >> 4; unsigned aw[4], bw[4];
#pragma unroll
    for (int q = 0; q < 4; ++q) { unsigned a = 0, b = 0;
#pragma unroll
        for (int t = 0; t < 4; ++t) { const int k = 16 * g + 4 * q + t; const int av = ((r * 7 + k * 3) % 5) - 2, bv = ((r * 5 + k * 11) % 7) - 3; a |= (unsigned)(av & 255) << (8 * t); b |= (unsigned)(bv & 255) << (8 * t); }
        aw[q] = a; bw[q] = b; }
    i32x4 c = {0, 0, 0, 0};
    c = __builtin_amdgcn_mfma_i32_16x16x64_i8((i32x4){(int)aw[0], (int)aw[1], (int)aw[2], (int)aw[3]}, (i32x4){(int)bw[0], (int)bw[1], (int)bw[2], (int)bw[3]}, c, 0, 0, 0);
    bool bad = false;
#pragma unroll
    for (int reg = 0; reg < 4; ++reg) { const int i = 4 * g + reg, j = r; int e = 0;
        for (int k = 0; k < 64; ++k) e += (((i * 7 + k * 3) % 5) - 2) * (((j * 5 + k * 11) % 7) - 3);
        if (c[reg] != e) bad = true; }
    if (bad) __hip_atomic_fetch_add((unsigned*)(OWS + WS_CTL) + 20000, 1000u, __ATOMIC_RELAXED, __HIP_MEMORY_SCOPE_AGENT);
}
#endif
__global__ void __launch_bounds__(NWAVES * 64, 2) fwd_kernel(KP p) {
    extern __shared__ __attribute__((aligned(16))) unsigned char lds_raw[];
    LAS unsigned char* lds = (LAS unsigned char*)lds_raw;
    volatile LAS unsigned* MISC = (volatile LAS unsigned*)(lds + MISC_OFF);
    const int G = gridDim.x, NGW = G * NWAVES;
    for (int u = threadIdx.x; u < (LDS_BYTES - LDSCTL_OFF) / 4; u += NWAVES * 64) ((LAS unsigned*)(lds + LDSCTL_OFF))[u] = 0u;
    __syncthreads();
    unsigned* ctl = (unsigned*)(OWS + WS_CTL);
    const bool single = p.ph < 0;
    XcdBarrier bar; bar.bar = ctl + CW_BAR; bar.x = 0; bar.st = nullptr;
    if (single) bar = xcd_barrier_post(ctl + CW_BAR, MISC + 8);
    int phc = 0;
#ifndef PROBE_DUP
#define PROBE_DUP 0
#endif
#define REP(bit) for (int rep_ = 0; rep_ < ((PROBE_DUP & (bit)) ? 2 : 1); ++rep_)
#define RUN() (single || p.ph == phc)
#define FRESH() int tid = threadIdx.x; asm volatile("" : "+v"(tid)); const int lane = tid & 63, wave = __builtin_amdgcn_readfirstlane(tid >> 6), gw = blockIdx.x * NWAVES + wave; (void)lane; (void)gw
#define SEAM() do { if (single) { XcdBarrier b2_ = bar; asm volatile("" : "+s"(b2_.bar)); xcd_barrier(b2_); if (PROBE_DUP & 32) { XcdBarrier b3_ = bar; asm volatile("" : "+s"(b3_.bar)); xcd_barrier(b3_); } } ++phc; } while (0)

    REP(4) if (RUN()) { FRESH(); ph_modvec(p, lds, tid); __syncthreads(); ph_convert(p, lds, gw, NGW, wave, lane); cq_static(p, lds, 3 * CQ_IN + 3 * CQ_OUT + 2 * CQ_UP, CQ_J1, gw, NGW, wave, lane); ph_amax(p, gw, NGW, lane); }
    SEAM();
#if PROBE_DUP & 256
    if (blockIdx.x == 0 && threadIdx.x < 64) ph_check_mfma(p, threadIdx.x);
#endif
    if (RUN()) { FRESH(); ph_init_rows(p, gw, NGW, lane); cq_static(p, lds, -CQ_NEG, 3 * CQ_IN + 3 * CQ_OUT + 2 * CQ_UP, gw, NGW, wave, lane); }
    SEAM();
    for (int ll = 0; ll < DEPTH; ++ll) {
#define l (ll + opaque_zero_i())
         if (RUN()) { pg8::Gemm g{(const bf16*)(OWS + WS_H8), (const bf16*)(OWS + WS_WIN) + (size_t)l * (NP * D / 2), MROWS, NP, D / 2, D / 2}; pg8::StaticOrder S; S.init(MROWS, NP, G, (int)blockIdx.x);
            pg8::EpiBf16S8 E{(bf16*)(OWS + WS_P), NP, (const float*)(OWS + WS_SA), (const float*)(OWS + WS_AMAX) + AM_IN + l * NP}; pg8::gemm_phase<pg8::EpiBf16S8, pg8::StaticOrder, true, true, true>(lds, g, S, E); }
        SEAM();
        REP(8) if (RUN()) { FRESH(); ph_lora(p, l, gw, NGW, lane); }
        SEAM();
        REP(1) if (RUN()) { FRESH(); ph_scan1(p, l, gw, NGW, lane); }
        SEAM();
        REP(2) if (RUN()) { FRESH(); ph_scan2(p, lds, l, wave, lane); }
        SEAM();
        REP(64) if (RUN()) { FRESH(); ph_readout2(p, l, gw, NGW, lane); }
        SEAM();
         if (RUN()) {
            { pg8::Gemm g{(const bf16*)(OWS + WS_MIXIN), (const bf16*)(OWS + WS_WOUT) + (size_t)l * (D * D / 2), NLAT, D, D / 2, D / 2}; pg8::StaticOrder S; S.init(NLAT, D, G, (int)blockIdx.x);
              pg8::EpiBf16S8 E{(bf16*)(OWS + WS_MIXO), D, (const float*)(OWS + WS_SAM), (const float*)(OWS + WS_AMAX) + AM_OUT + l * D}; pg8::gemm_phase<pg8::EpiBf16S8, pg8::StaticOrder, true, true, true>(lds, g, S, E); }
            if (ll < DEPTH - 1) { pg8::Gemm g{(const bf16*)(OWS + WS_MIXIN), (const bf16*)(OWS + WS_WOUT) + (size_t)l * (D * D / 2), NCTX, D, D / 4, D / 2}; pg8::SplitOrder S{NCTX / 256, D / 256, 2, G, (int)blockIdx.x, NLAT / 256, 0, 0, 0, 0, 0, 0, 0, 0};
              pg8::EpiPartS8 E{(float*)(OWS + WS_MIXP), D, (size_t)NCTX * D, NLAT / 256, (const float*)(OWS + WS_SAM), (const float*)(OWS + WS_AMAX) + AM_OUT + l * D}; pg8::gemm_phase<pg8::EpiPartS8, pg8::SplitOrder, true, true, true>(lds, g, S, E); }
        }
        SEAM();
        if (RUN()) { FRESH(); ph_ln(p, lds, l, 0, tid, wave, gw, NGW, lane); }
        SEAM();
        if ((l & 1) == 0) {
            const int fi = l >> 1;
             if (RUN()) { pg8::Gemm g{(const bf16*)(OWS + WS_H8), (const bf16*)(OWS + WS_F13) + (size_t)fi * DFF * D, MROWS, 2 * DFF, D / 2, D / 2}; pg8::StaticOrder S; S.init(MROWS, 2 * DFF, G, (int)blockIdx.x);
                constexpr int NOE = 0x7fffffff; pg8::EpiSwiGLU8 E{(bf16*)(OWS + WS_ACT), DFF, nullptr, (const float*)(OWS + WS_SA), (const unsigned*)(OWS + WS_AMAX) + (size_t)fi * 2 * DFF, NOE, NOE, NOE, NOE, NOE, NOE, NOE};
#if PROBE_DUP & 128
                E.dbg = (int*)(OWS + WS_F);
#endif
                pg8::gemm_phase<pg8::EpiSwiGLU8, pg8::StaticOrder, true, true, true>(lds, g, S, E); }
            SEAM();
#if PROBE_DUP & 128
            if (ll == 0) { if (RUN()) { FRESH(); ph_check_up(p, gw, lane); } SEAM(); }
#endif
             if (RUN()) {
                { pg8::Gemm g{(const bf16*)(OWS + WS_ACT), (const bf16*)(OWS + WS_F2) + (size_t)fi * D * DFF, NLAT, D, DFF, DFF}; pg8::StaticOrder S; S.init(NLAT, D, G, (int)blockIdx.x);
                  pg8::EpiBf16<0> E{(bf16*)(OWS + WS_F), D, nullptr, 0, 0, 1.f}; pg8::gemm_phase<pg8::EpiBf16<0>, pg8::StaticOrder, true, true>(lds, g, S, E); }
                { pg8::Gemm g{(const bf16*)(OWS + WS_ACT), (const bf16*)(OWS + WS_F2) + (size_t)fi * D * DFF, NCTX, D, DFF / 7, DFF}; pg8::SplitOrder S{NCTX / 256, D / 256, 7, G, (int)blockIdx.x, NLAT / 256, 0, 0, 0, 0, 0, 0, 0, 0};
                  pg8::EpiPart E{(float*)(OWS + WS_FP), D, (size_t)NCTX * D, NLAT / 256}; pg8::gemm_phase<pg8::EpiPart, pg8::SplitOrder, true, true>(lds, g, S, E); }
            }
            SEAM();
        } else {
            REP(4) if (RUN()) { FRESH(); cq_static(p, lds, (l == 1 ? CQ_J1 : CQ_END0) + 2 * CQ_SLOT_ITEMS, l == 1 ? CQ_END0 : CQ_END1, gw, NGW, wave, lane); }
            SEAM();
            if (RUN()) { FRESH(); ph_moe_gather(p, l, gw, NGW, lane); }
            SEAM();
            {   const unsigned* gcnt = (const unsigned*)(OWS + WS_CTL) + CW_GCNT + 64 * (l >> 1); int pbp[9]; pbp[0] = 0;
#pragma unroll
                for (int e = 0; e < 8; ++e) pbp[e + 1] = pbp[e] + (int)((gcnt[e] + 255u) >> 8);
                const int mrows = pbp[8] * 256;
                 if (RUN()) { pg8::Gemm g{(const bf16*)(OWS + WS_HG), (const bf16*)(OWS + WS_MOEW13), mrows, 2 * DFF, D / 2, D / 2}; pg8::MoeOrder S; S.init(mrows, 2 * DFF, G, (int)blockIdx.x);
                    S.pb1 = pbp[1]; S.pb2 = pbp[2]; S.pb3 = pbp[3]; S.pb4 = pbp[4]; S.pb5 = pbp[5]; S.pb6 = pbp[6]; S.pb7 = pbp[7]; S.estride = (size_t)DFF * D;
                    pg8::EpiSwiGLU8 E{(bf16*)(OWS + WS_ACT), DFF, (const float*)(OWS + WS_WSORT), (const float*)(OWS + WS_SAG), (const unsigned*)(OWS + WS_AMAX) + (size_t)(2 + 8 * (l >> 1)) * 2 * DFF, pbp[1], pbp[2], pbp[3], pbp[4], pbp[5], pbp[6], pbp[7]};
                    pg8::gemm_phase<pg8::EpiSwiGLU8, pg8::MoeOrder, true, true, true>(lds, g, S, E); }
                SEAM();
                 if (RUN()) {
                    { pg8::Gemm g{(const bf16*)(OWS + WS_ACT), (const bf16*)(OWS + WS_MOEW2), MOE_MAIN_PANELS * 256, D, DFF, DFF}; pg8::MoeOrder S; S.init(MOE_MAIN_PANELS * 256, D, G, (int)blockIdx.x);
                      S.pb1 = pbp[1]; S.pb2 = pbp[2]; S.pb3 = pbp[3]; S.pb4 = pbp[4]; S.pb5 = pbp[5]; S.pb6 = pbp[6]; S.pb7 = pbp[7]; S.estride = (size_t)D * DFF;
                      pg8::EpiBf16<0> E{(bf16*)(OWS + WS_F), D, nullptr, 0, 0, 1.f}; pg8::gemm_phase<pg8::EpiBf16<0>, pg8::MoeOrder, true, true>(lds, g, S, E); }
                    { const int nT = pbp[8] - MOE_MAIN_PANELS;
                      pg8::Gemm g{(const bf16*)(OWS + WS_ACT), (const bf16*)(OWS + WS_MOEW2), nT * 256, D, DFF / 4, DFF}; pg8::SplitOrder S{nT, D / 256, 4, G, (int)blockIdx.x, MOE_MAIN_PANELS, pbp[1], pbp[2], pbp[3], pbp[4], pbp[5], pbp[6], pbp[7], (size_t)D * DFF};
                      pg8::EpiPart E{(float*)(OWS + WS_FP), D, (size_t)MOE_TAIL_ROWS * D, MOE_MAIN_PANELS}; pg8::gemm_phase<pg8::EpiPart, pg8::SplitOrder, true, true>(lds, g, S, E); }
                }
                SEAM();
            }
        }
        if (RUN()) { FRESH(); ph_ln(p, lds, l, 1, tid, wave, gw, NGW, lane); }
        SEAM();
    }
#undef l
#undef RUN
#undef SEAM
}

#ifndef MK_PER_PHASE
#define MK_PER_PHASE 0
#endif
extern "C" void kernel_launch(void* const* d_in, const int* in_sizes, int n_in, void* d_out, int out_size, void* d_ws, size_t ws_size, hipStream_t stream) {
    static int grid = 0;
    if (grid == 0) {
        if (n_in != N_IN || in_sizes[0] != NLAT * D || out_size != NLAT * D || ws_size < WS_NEED) { fprintf(stderr, "kernel_launch: unexpected shapes / workspace (%d inputs, ws %zu, need %zu)\n", n_in, ws_size, (size_t)WS_NEED); grid = -1; return; }
        int dev = 0, cus = 0, per_cu = 0;
        if (hipGetDevice(&dev) != hipSuccess || hipDeviceGetAttribute(&cus, hipDeviceAttributeMultiprocessorCount, dev) != hipSuccess) { grid = -1; return; }
        if (hipFuncSetAttribute((const void*)fwd_kernel, hipFuncAttributeMaxDynamicSharedMemorySize, LDS_BYTES) != hipSuccess) { fprintf(stderr, "kernel_launch: hipFuncSetAttribute failed\n"); grid = -1; return; }
        if (hipOccupancyMaxActiveBlocksPerMultiprocessor(&per_cu, (const void*)fwd_kernel, NWAVES * 64, LDS_BYTES) != hipSuccess || per_cu < 1) fprintf(stderr, "kernel_launch: occupancy query says %d\n", per_cu);
        (void)hipGetLastError();
        grid = cus;
        if (grid != 256) { fprintf(stderr, "kernel_launch: built for a 256-CU device, found %d CUs\n", cus); grid = -1; return; }
    }
    if (grid < 0) return;
    if (hipMemsetAsync((char*)d_ws + WS_CTL, 0, CTL_BYTES, stream) != hipSuccess) return;
    KP p{};
    for (int i = 0; i < N_IN; ++i) p.in[i] = (const float*)d_in[i];
    p.out = (float*)d_out; p.ws = (unsigned char*)d_ws; p.pad = 0;
#if MK_PER_PHASE
    const int nph = 2 + 2 * 11 + 2 * 13;
    for (int ph = 0; ph < nph; ++ph) { p.ph = ph; hipLaunchKernelGGL(fwd_kernel, dim3(grid), dim3(NWAVES * 64), LDS_BYTES, stream, p); }
#else
    p.ph = -1;
    hipLaunchKernelGGL(fwd_kernel, dim3(grid), dim3(NWAVES * 64), LDS_BYTES, stream, p);
#endif
}
```

```cpp
#include <hip/hip_runtime.h>
#define PROBE_DUP 0
#define CQ_SLOT_WGS 0
#define CQ_SLOT_ITEMS 3500
#include <cstdio>
#include <cstdint>
namespace pg8 {
#define PG8_LAS __attribute__((address_space(3)))
typedef unsigned short bf16_t;
typedef short bf16x8 __attribute__((ext_vector_type(8)));
typedef float f32x4 __attribute__((ext_vector_type(4)));
typedef unsigned u32x4 __attribute__((ext_vector_type(4)));
constexpr int BM = 256, BK = 64, HALF = 128, HTB = HALF * BK * 2  , STAGE_BYTES = 8 * HTB, NXCD = 8, WGM = 8;

__host__ __device__ __forceinline__ int lds_byte(int r, int c) { const int st = (r >> 4) * 2 + (c >> 5), rr = r & 15, cc = c & 31, ob = rr * 64 + cc * 2; return st * 1024 + (ob ^ (((ob >> 9) & 1) << 5)); }
__host__ __device__ __forceinline__ void stage_rc(int b, int& R, int& C) { const int st = b / 1024, sb = b % 1024, swz = sb ^ (((sb >> 9) & 1) << 5); R = (st >> 1) * 16 + swz / 64; C = (st & 1) * 32 + (swz % 64) / 2; }
__host__ __device__ __forceinline__ int perm32(int rho) { const int n = rho >> 4, i = rho & 15; return 8 * (i >> 2) + 4 * n + (i & 3); }

struct Unit { int pm, pn, ks; };
struct Gemm { const bf16_t* A; const bf16_t* Bt; int M, N, K, ld; };

struct StaticOrder {
    int nM, nN, nwg, G, c;
    __host__ __device__ void init(int M, int N, int G_, int c_) { nM = M / BM; nN = N / BM; nwg = nM * nN; G = G_; c = c_; }
    __host__ __device__ bool next(int i, Unit& u) const {
        const long L = (long)i * G + c; if (L >= nwg) return false;
        int wgid = (int)L; { const int q = nwg / NXCD, r = nwg % NXCD, xcd = wgid % NXCD, off = wgid / NXCD; wgid = (xcd < r ? xcd * (q + 1) : r * (q + 1) + (xcd - r) * q) + off; }
        const int nig = WGM * nN, gid = wgid / nig, fm = gid * WGM, gsz = (nM - fm) < WGM ? (nM - fm) : WGM;
        u.pm = fm + ((wgid % nig) % gsz); u.pn = (wgid % nig) / gsz; u.ks = 0; return true;
    }
    __device__ __forceinline__ const char* abase(const Gemm& g, const Unit& u, size_t tstep) const { return (const char*)g.A + (size_t)u.pm * tstep; }
    __device__ __forceinline__ const char* bbase(const Gemm& g, const Unit& u, size_t tstep) const { return (const char*)g.Bt + (size_t)u.pn * tstep; }
    __device__ __forceinline__ void a_ready(const Unit&) const {}
    __device__ __forceinline__ void done(const Unit&) const {}
};

__device__ __forceinline__ unsigned cvt_pk_bf16(float lo, float hi) { unsigned r; asm volatile("v_cvt_pk_bf16_f32 %0, %1, %2" : "=v"(r) : "v"(lo), "v"(hi)); return r; }
typedef float f32x2 __attribute__((ext_vector_type(2)));
__device__ __forceinline__ f32x2 gelu_pk(f32x2 v) {
    const f32x2 av = __builtin_elementwise_abs(v), d = av * 0.2316418882f + 1.0f;
    f32x2 t; t.x = __builtin_amdgcn_rcpf(d.x); t.y = __builtin_amdgcn_rcpf(d.y);
    f32x2 q = t * 0.5307027145f + (-0.7265760135f); q = q * t + 0.7107068705f; q = q * t + (-0.142248368f); q = q * t + 0.127414796f; q = q * t;
    const f32x2 s = (v * v) * (-0.72134752044f);
    f32x2 e; e.x = __builtin_amdgcn_exp2f(s.x); e.y = __builtin_amdgcn_exp2f(s.y);
    const f32x2 m = v * (q * e), r = v - m;
    f32x2 o; o.x = v.x < 0.f ? m.x : r.x; o.y = v.y < 0.f ? m.y : r.y; return o;
}

template <int ACT  > struct EpiBf16 {
    static constexpr bool PERM = true, AFTER_DRAIN = false; static_assert(ACT == 0 || ACT == 1, "EpiBf16: ACT is 0 (none) or 1 (gelu_pk)");
    bf16_t* O; int ldc; const float* bias; int split_cols; size_t split_stride; float scale0;
    __device__ __forceinline__ void operator()(const f32x4 (&acc)[2][2][4][2], const Unit& u, int wr, int wc, int fr, int fq) const {
        asm volatile("" : "+v"(fr), "+v"(fq));
        const int row0 = u.pm * BM + wr * 64 + fr; int colt = u.pn * BM; bf16_t* base = O;
        float sc = 1.f; if (split_cols) { const int t = colt / split_cols; base += (size_t)t * split_stride; colt -= t * split_cols; if (t == 0) sc = scale0; }
        const int col0 = colt + wc * 32 + 8 * fq, bcol0 = u.pn * BM + wc * 32 + 8 * fq;
        f32x4 bv[2][2];
#pragma unroll
        for (int bj = 0; bj < 2; ++bj)
#pragma unroll
            for (int n = 0; n < 2; ++n) bv[bj][n] = bias ? *(const f32x4*)(bias + bcol0 + bj * HALF + 4 * n) : (f32x4){0.f, 0.f, 0.f, 0.f};
#pragma unroll
        for (int ai = 0; ai < 2; ++ai)
#pragma unroll
            for (int m = 0; m < 4; ++m) { bf16_t* rowp = base + (size_t)(row0 + ai * HALF + m * 16) * ldc + col0;
#pragma unroll
                for (int bj = 0; bj < 2; ++bj) { f32x4 v0 = acc[ai][bj][m][0] + bv[bj][0], v1 = acc[ai][bj][m][1] + bv[bj][1];
                    if (ACT == 1) { f32x2 a = gelu_pk((f32x2){v0[0], v0[1]}), b = gelu_pk((f32x2){v0[2], v0[3]}), c = gelu_pk((f32x2){v1[0], v1[1]}), d = gelu_pk((f32x2){v1[2], v1[3]});
                        v0 = (f32x4){a.x, a.y, b.x, b.y}; v1 = (f32x4){c.x, c.y, d.x, d.y}; }
                    v0 = v0 * sc; v1 = v1 * sc; u32x4 w; w.x = cvt_pk_bf16(v0[0], v0[1]); w.y = cvt_pk_bf16(v0[2], v0[3]); w.z = cvt_pk_bf16(v1[0], v1[1]); w.w = cvt_pk_bf16(v1[2], v1[3]);
                    *(u32x4*)(rowp + bj * HALF) = w; } }
    }
};
typedef int i32x4 __attribute__((ext_vector_type(4)));
template <bool I8> __device__ __forceinline__ f32x4 mma16(bf16x8 b, bf16x8 a, f32x4 c) { return __builtin_amdgcn_mfma_f32_16x16x32_bf16(b, a, c, 0, 0, 0); }
template <bool I8> __device__ __forceinline__ i32x4 mma16(bf16x8 b, bf16x8 a, i32x4 c) { return __builtin_amdgcn_mfma_i32_16x16x64_i8(__builtin_bit_cast(i32x4, b), __builtin_bit_cast(i32x4, a), c, 0, 0, 0); }
struct EpiF32 {
    static constexpr bool PERM = false, AFTER_DRAIN = false;
    float* C; int ldc; int accum;
    __device__ __forceinline__ void operator()(const f32x4 (&acc)[2][2][4][2], const Unit& u, int wr, int wc, int fr, int fq) const {
        asm volatile("" : "+v"(fr), "+v"(fq));
        const int row0 = u.pm * BM + wr * 64 + fr, col0 = u.pn * BM + wc * 32 + 4 * fq;
#pragma unroll
        for (int ai = 0; ai < 2; ++ai)
#pragma unroll
            for (int m = 0; m < 4; ++m) { float* rowp = C + (size_t)(row0 + ai * HALF + m * 16) * ldc + col0;
#pragma unroll
                for (int bj = 0; bj < 2; ++bj)
#pragma unroll
                    for (int n = 0; n < 2; ++n) { f32x4 v = acc[ai][bj][m][n]; if (accum) v += *(const f32x4*)(rowp + bj * HALF + n * 16); *(f32x4*)(rowp + bj * HALF + n * 16) = v; } }
    }
};
struct EpiSwiGLU {
    static constexpr bool PERM = true, AFTER_DRAIN = false;
    bf16_t* O; int ldo; const float* rowscale; int rs_stride;
    __device__ __forceinline__ void operator()(const f32x4 (&acc)[2][2][4][2], const Unit& u, int wr, int wc, int fr, int fq) const {
        asm volatile("" : "+v"(fr), "+v"(fq));
        typedef unsigned u32x2v __attribute__((ext_vector_type(2)));
        const int row0 = u.pm * BM + wr * 64 + fr; const int ch0 = (u.pn * BM + wc * 32 + 8 * fq) >> 1;
#pragma unroll
        for (int ai = 0; ai < 2; ++ai)
#pragma unroll
            for (int m = 0; m < 4; ++m) { const int row = row0 + ai * HALF + m * 16; bf16_t* rowp = O + (size_t)row * ldo + ch0;
                const float rs = rowscale ? rowscale[(size_t)row * rs_stride] : 1.f;
#pragma unroll
                for (int bj = 0; bj < 2; ++bj) { const f32x4 a = acc[ai][bj][m][0], b = acc[ai][bj][m][1]; f32x4 o;
#pragma unroll
                    for (int i = 0; i < 4; ++i) o[i] = a[i] * __builtin_amdgcn_rcpf(1.f + __expf(-a[i])) * b[i] * rs;
                    u32x2v w; w.x = cvt_pk_bf16(o[0], o[1]); w.y = cvt_pk_bf16(o[2], o[3]);
                    *(u32x2v*)(rowp + bj * (HALF / 2)) = w; } }
    }
};

struct MoeOrder : StaticOrder {
    int pb1, pb2, pb3, pb4, pb5, pb6, pb7; size_t estride;
    __device__ __forceinline__ const char* bbase(const Gemm& g, const Unit& u, size_t tstep) const {
        const int e = (u.pm >= pb1) + (u.pm >= pb2) + (u.pm >= pb3) + (u.pm >= pb4) + (u.pm >= pb5) + (u.pm >= pb6) + (u.pm >= pb7);
        return (const char*)(g.Bt + (size_t)e * estride) + (size_t)u.pn * tstep; }
};
struct SplitOrder {
    int nM, nN, S, G, c, pm0; int pb1, pb2, pb3, pb4, pb5, pb6, pb7; size_t estride;
    __device__ __forceinline__ bool next(int i, Unit& u) const { const int L = i * G + c; if (L >= nM * nN * S) return false; u.ks = L % S; const int t = L / S; u.pn = t % nN; u.pm = pm0 + t / nN; return true; }
    __device__ __forceinline__ const char* abase(const Gemm& g, const Unit& u, size_t tstep) const { return (const char*)g.A + (size_t)u.pm * tstep + (size_t)u.ks * g.K * 2; }
    __device__ __forceinline__ const char* bbase(const Gemm& g, const Unit& u, size_t tstep) const {
        const int e = estride ? (u.pm >= pb1) + (u.pm >= pb2) + (u.pm >= pb3) + (u.pm >= pb4) + (u.pm >= pb5) + (u.pm >= pb6) + (u.pm >= pb7) : 0;
        return (const char*)(g.Bt + (size_t)e * estride) + (size_t)u.pn * tstep + (size_t)u.ks * g.K * 2; }
    __device__ __forceinline__ void a_ready(const Unit&) const {}
    __device__ __forceinline__ void done(const Unit&) const {}
};
struct EpiPart {
    static constexpr bool PERM = false, AFTER_DRAIN = false;
    float* C; int ldc; size_t pstride; int pm0;
    __device__ __forceinline__ void operator()(const f32x4 (&acc)[2][2][4][2], const Unit& u, int wr, int wc, int fr, int fq) const {
        asm volatile("" : "+v"(fr), "+v"(fq));
        const int row0 = (u.pm - pm0) * BM + wr * 64 + fr, col0 = u.pn * BM + wc * 32 + 4 * fq; float* base = C + (size_t)u.ks * pstride;
#pragma unroll
        for (int ai = 0; ai < 2; ++ai)
#pragma unroll
            for (int m = 0; m < 4; ++m) { float* rowp = base + (size_t)(row0 + ai * HALF + m * 16) * ldc + col0;
#pragma unroll
                for (int bj = 0; bj < 2; ++bj)
#pragma unroll
                    for (int n = 0; n < 2; ++n) *(f32x4*)(rowp + bj * HALF + n * 16) = acc[ai][bj][m][n]; }
    }
};

struct EpiSwiGLU8 {
    static constexpr bool PERM = true, AFTER_DRAIN = false;
    bf16_t* O; int ldo; const float* rowscale; const float* sa; const unsigned* amax; int pb1, pb2, pb3, pb4, pb5, pb6, pb7;
    __device__ __forceinline__ void operator()(const i32x4 (&acc)[2][2][4][2], const Unit& u, int wr, int wc, int fr, int fq) const {
        typedef unsigned u32x2v __attribute__((ext_vector_type(2))); typedef unsigned u32x4v __attribute__((ext_vector_type(4)));
        asm volatile("" : "+v"(fr), "+v"(fq));
        const int row0 = u.pm * BM + wr * 64 + fr; const int cb0 = u.pn * BM + wc * 32 + 8 * fq; const int ch0 = cb0 >> 1;
        const int e = (u.pm >= pb1) + (u.pm >= pb2) + (u.pm >= pb3) + (u.pm >= pb4) + (u.pm >= pb5) + (u.pm >= pb6) + (u.pm >= pb7);
        const unsigned* am = amax + (size_t)e * 2 * 3584 + cb0;
#pragma unroll
        for (int bj = 0; bj < 2; ++bj) {
            const float* amf = (const float*)am + bj * HALF;
            const f32x4 sb0 = *(const f32x4*)amf * (1.f / 127.f), sb1 = *(const f32x4*)(amf + 4) * (1.f / 127.f);
#pragma unroll
            for (int ai = 0; ai < 2; ++ai)
#pragma unroll
                for (int m = 0; m < 4; ++m) { const int row = row0 + ai * HALF + m * 16; bf16_t* rowp = O + (size_t)row * ldo + ch0 + bj * (HALF / 2);
                    const float sr = sa[row], rs = rowscale ? rowscale[row] : 1.f; f32x4 o;
#pragma unroll
                    for (int i = 0; i < 4; ++i) { const float a = (float)acc[ai][bj][m][0][i] * sr * sb0[i], b = (float)acc[ai][bj][m][1][i] * sr * sb1[i];
                        o[i] = a * __builtin_amdgcn_rcpf(1.f + __expf(-a)) * b * rs; }
                    u32x2v w; w.x = cvt_pk_bf16(o[0], o[1]); w.y = cvt_pk_bf16(o[2], o[3]);
                    *(u32x2v*)rowp = w;
#if PROBE_DUP & 128
                    if (dbg && row < 4096) { f32x4 av, bv;
#pragma unroll
                        for (int i = 0; i < 4; ++i) { av[i] = (float)acc[ai][bj][m][0][i] * sr * sb0[i]; bv[i] = (float)acc[ai][bj][m][1][i] * sr * sb1[i]; }
                        *(f32x4*)((float*)dbg + (size_t)row * ldo + (rowp - (O + (size_t)row * ldo))) = av; *(f32x4*)((float*)dbg + (size_t)4096 * ldo + (size_t)row * ldo + (rowp - (O + (size_t)row * ldo))) = bv; }
#endif
                    } }
    }
#if PROBE_DUP & 128
    int* dbg = nullptr;
#endif
};

struct EpiBf16S8 {
    static constexpr bool PERM = true, AFTER_DRAIN = false;
    bf16_t* O; int ldc; const float* sa; const float* amax;
    __device__ __forceinline__ void operator()(const i32x4 (&acc)[2][2][4][2], const Unit& u, int wr, int wc, int fr, int fq) const {
        asm volatile("" : "+v"(fr), "+v"(fq));
        const int row0 = u.pm * BM + wr * 64 + fr, col0 = u.pn * BM + wc * 32 + 8 * fq;
#pragma unroll
        for (int bj = 0; bj < 2; ++bj) { const f32x4 s0 = *(const f32x4*)(amax + col0 + bj * HALF) * (1.f / 127.f), s1 = *(const f32x4*)(amax + col0 + bj * HALF + 4) * (1.f / 127.f);
#pragma unroll
            for (int ai = 0; ai < 2; ++ai)
#pragma unroll
                for (int m = 0; m < 4; ++m) { const int row = row0 + ai * HALF + m * 16; const float sr = sa[row]; f32x4 v0, v1;
#pragma unroll
                    for (int i = 0; i < 4; ++i) { v0[i] = (float)acc[ai][bj][m][0][i] * sr * s0[i]; v1[i] = (float)acc[ai][bj][m][1][i] * sr * s1[i]; }
                    u32x4 w; w.x = cvt_pk_bf16(v0[0], v0[1]); w.y = cvt_pk_bf16(v0[2], v0[3]); w.z = cvt_pk_bf16(v1[0], v1[1]); w.w = cvt_pk_bf16(v1[2], v1[3]);
                    *(u32x4*)(O + (size_t)row * ldc + col0 + bj * HALF) = w; } }
    }
};
struct EpiPartS8 {
    static constexpr bool PERM = false, AFTER_DRAIN = false;
    float* C; int ldc; size_t pstride; int pm0; const float* sa; const float* amax;
    __device__ __forceinline__ void operator()(const i32x4 (&acc)[2][2][4][2], const Unit& u, int wr, int wc, int fr, int fq) const {
        asm volatile("" : "+v"(fr), "+v"(fq));
        const int row0 = (u.pm - pm0) * BM + wr * 64 + fr, col0 = u.pn * BM + wc * 32 + 4 * fq; float* base = C + (size_t)u.ks * pstride;
#pragma unroll
        for (int bj = 0; bj < 2; ++bj)
#pragma unroll
            for (int n = 0; n < 2; ++n) { const f32x4 sc = *(const f32x4*)(amax + col0 + bj * HALF + n * 16) * (1.f / 127.f);
#pragma unroll
                for (int ai = 0; ai < 2; ++ai)
#pragma unroll
                    for (int m = 0; m < 4; ++m) { const int rl = row0 + ai * HALF + m * 16; const float sr = sa[rl + pm0 * BM]; f32x4 v;
#pragma unroll
                        for (int i = 0; i < 4; ++i) v[i] = (float)acc[ai][bj][m][n][i] * sr * sc[i];
                        *(f32x4*)(base + (size_t)rl * ldc + col0 + bj * HALF + n * 16) = v; } }
    }
};
template <bool I8> struct AccSel { typedef f32x4 type; }; template <> struct AccSel<true> { typedef i32x4 type; };
template <class Epi, class Sched, bool ALIGN_EPI = false, bool SP2 = false, bool I8 = false>
__device__ __forceinline__ void gemm_phase(PG8_LAS unsigned char* lds, const Gemm g, const Sched& S, const Epi& E) {
    int tid_o = threadIdx.x; asm volatile("" : "+v"(tid_o));
    const int tid = tid_o, wid = __builtin_amdgcn_readfirstlane(tid >> 6), lane = tid & 63, wr = wid >> 2, wc = wid & 3, fr = lane & 15, fq = lane >> 4;
    const int K = g.K, nt = K / BK;
    unsigned voffA[2], voffB[2];
#pragma unroll
    for (int i = 0; i < 2; ++i) { int R, C; stage_rc(tid * 16 + i * 8192, R, C); const int Rb = Epi::PERM ? ((R & ~31) + perm32(R & 31)) : R;
        voffA[i] = (unsigned)(R * g.ld + C) * 2u; voffB[i] = (unsigned)(Rb * g.ld + C) * 2u; }
    const size_t kstep = (size_t)(BK * 2);
    const size_t hstep = (size_t)HALF * g.ld * 2;
    const size_t tstep = 2 * hstep;
    const unsigned ldsw = (unsigned)wid * 1024u;
    const int aoff = lds_byte(wr * 64 + fr, fq * 8), boff = lds_byte(wc * 32 + fr, fq * 8);
#define PG8_SA(b, h) (((b) * 2 + (h)) * HTB)
#define PG8_SB(b, h) ((4 + (b) * 2 + (h)) * HTB)
#define PG8_STAGE(bufoff, gbase, voff) do { _Pragma("unroll") for (int _i = 0; _i < 2; ++_i) \
        __builtin_amdgcn_global_load_lds((const unsigned*)((const char*)(gbase) + (voff)[_i]), (PG8_LAS unsigned*)(lds + (bufoff) + ldsw + _i * 8192), 16, 0, 0); } while (0)
#define PG8_LDA(dst, b, h) do { _Pragma("unroll") for (int m = 0; m < 4; ++m) _Pragma("unroll") for (int k = 0; k < 2; ++k) dst[m][k] = *(const PG8_LAS bf16x8*)(lds + PG8_SA(b, h) + aoff + m * 2048 + k * 1024); } while (0)
#define PG8_LDB(dst, b, h) do { _Pragma("unroll") for (int n = 0; n < 2; ++n) _Pragma("unroll") for (int k = 0; k < 2; ++k) dst[n][k] = *(const PG8_LAS bf16x8*)(lds + PG8_SB(b, h) + boff + n * 2048 + k * 1024); } while (0)
#define PG8_MMA(ai, bj, At, Bt) do { __builtin_amdgcn_s_setprio(1); _Pragma("unroll") for (int k = 0; k < 2; ++k) _Pragma("unroll") for (int m = 0; m < 4; ++m) _Pragma("unroll") for (int n = 0; n < 2; ++n) \
        acc[ai][bj][m][n] = mma16<I8>(Bt[n][k], At[m][k], acc[ai][bj][m][n]); __builtin_amdgcn_s_setprio(0); } while (0)
#define PG8_WAIT_V(n) asm volatile("s_waitcnt vmcnt(" #n ")" ::: "memory")
#define PG8_WAIT_L(n) asm volatile("s_waitcnt lgkmcnt(" #n ")" ::: "memory")
#define PG8_BAR __builtin_amdgcn_s_barrier()
#define PG8_SCHED __builtin_amdgcn_sched_barrier(0)
    Unit cur, nxt; int ui = 0;
    if (!S.next(0, cur)) return;
    typedef typename AccSel<I8>::type AccT; AccT acc[2][2][4][2];
#pragma unroll
    for (int a = 0; a < 2; ++a)
#pragma unroll
        for (int b = 0; b < 2; ++b)
#pragma unroll
            for (int m = 0; m < 4; ++m)
#pragma unroll
                for (int n = 0; n < 2; ++n) acc[a][b][m][n] = (AccT)(0);
    bf16x8 At[4][2], B0[2][2], B1[2][2];
    const char* cA = S.abase(g, cur, tstep); const char* cB = S.bbase(g, cur, tstep);
    S.a_ready(cur);
    if constexpr (SP2) {
        PG8_STAGE(PG8_SB(0, 0), cB, voffB); PG8_STAGE(PG8_SB(0, 1), cB + hstep, voffB); PG8_STAGE(PG8_SA(0, 0), cA, voffA); PG8_STAGE(PG8_SA(0, 1), cA + hstep, voffA);
        if (wr == 1) PG8_BAR;
        PG8_WAIT_V(2); PG8_BAR;
        PG8_STAGE(PG8_SB(1, 0), cB + kstep, voffB); PG8_STAGE(PG8_SA(1, 0), cA + kstep, voffA); PG8_STAGE(PG8_SB(1, 1), cB + hstep + kstep, voffB);
        PG8_WAIT_V(6); PG8_BAR;
    } else {
        PG8_STAGE(PG8_SB(0, 0), cB, voffB); PG8_STAGE(PG8_SA(0, 0), cA, voffA); PG8_STAGE(PG8_SB(0, 1), cB + hstep, voffB); PG8_STAGE(PG8_SA(0, 1), cA + hstep, voffA);
        if (wr == 1) PG8_BAR;
        PG8_WAIT_V(4); PG8_BAR;
        PG8_STAGE(PG8_SB(1, 0), cB + kstep, voffB); PG8_STAGE(PG8_SA(1, 0), cA + kstep, voffA); PG8_STAGE(PG8_SB(1, 1), cB + hstep + kstep, voffB);
        PG8_WAIT_V(6); PG8_BAR;
    }
    for (;;) {
        const bool has_next = S.next(ui + 1, nxt);
        const char* nA = has_next ? S.abase(g, nxt, tstep) : cA; const char* nB = has_next ? S.bbase(g, nxt, tstep) : cB;
        for (int t = 0; t < nt; t += 2) {
            const bool last = (t == nt - 2);
            const char* a1 = cA + (size_t)(t + 1) * kstep;
            const char* a2 = last ? nA : cA + (size_t)(t + 2) * kstep; const char* b2 = last ? nB : cB + (size_t)(t + 2) * kstep;
            const char* a3 = a2 + kstep; const char* b3 = b2 + kstep;
            if (last && has_next) S.a_ready(nxt);
            if constexpr (SP2) {
            PG8_LDB(B0, 0, 0); PG8_LDB(B1, 0, 1); PG8_SCHED; PG8_LDA(At, 0, 0); PG8_STAGE(PG8_SA(1, 1), a1 + hstep, voffA);
            PG8_WAIT_V(8); PG8_WAIT_L(0); PG8_BAR; PG8_MMA(0, 0, At, B0); PG8_MMA(0, 1, At, B1); PG8_BAR; PG8_SCHED;
            PG8_LDA(At, 0, 1); PG8_STAGE(PG8_SB(0, 0), b2, voffB); PG8_STAGE(PG8_SB(0, 1), b2 + hstep, voffB); PG8_STAGE(PG8_SA(0, 0), a2, voffA);
            PG8_WAIT_V(8); PG8_WAIT_L(0); PG8_BAR; PG8_MMA(1, 0, At, B0); PG8_MMA(1, 1, At, B1); PG8_BAR; PG8_SCHED;
            PG8_LDB(B0, 1, 0); PG8_LDB(B1, 1, 1); PG8_SCHED; PG8_LDA(At, 1, 0); PG8_STAGE(PG8_SA(0, 1), a2 + hstep, voffA);
            PG8_WAIT_V(8); PG8_WAIT_L(0); PG8_BAR; PG8_MMA(0, 0, At, B0); PG8_MMA(0, 1, At, B1); PG8_BAR; PG8_SCHED;
            PG8_LDA(At, 1, 1); PG8_STAGE(PG8_SB(1, 0), b3, voffB); PG8_STAGE(PG8_SB(1, 1), b3 + hstep, voffB); PG8_STAGE(PG8_SA(1, 0), a3, voffA);
            PG8_WAIT_V(8); PG8_WAIT_L(0); PG8_BAR; PG8_MMA(1, 0, At, B0); PG8_MMA(1, 1, At, B1); PG8_BAR; PG8_SCHED;
            } else {
            PG8_LDB(B0, 0, 0); PG8_SCHED; PG8_LDA(At, 0, 0); PG8_STAGE(PG8_SA(1, 1), a1 + hstep, voffA);
            PG8_WAIT_L(8); PG8_BAR; PG8_WAIT_L(0); PG8_MMA(0, 0, At, B0); PG8_BAR; PG8_SCHED;
            PG8_LDB(B1, 0, 1); PG8_STAGE(PG8_SB(0, 0), b2, voffB);
            PG8_BAR; PG8_WAIT_L(0); PG8_MMA(0, 1, At, B1); PG8_BAR;
            PG8_LDA(At, 0, 1); PG8_STAGE(PG8_SA(0, 0), a2, voffA);
            PG8_BAR; PG8_WAIT_L(0); PG8_MMA(1, 0, At, B0); PG8_BAR; PG8_SCHED;
            PG8_STAGE(PG8_SB(0, 1), b2 + hstep, voffB);
            PG8_WAIT_V(6); PG8_BAR; PG8_MMA(1, 1, At, B1); PG8_BAR;
            PG8_LDB(B0, 1, 0); PG8_SCHED; PG8_LDA(At, 1, 0); PG8_STAGE(PG8_SA(0, 1), a2 + hstep, voffA);
            PG8_WAIT_L(8); PG8_BAR; PG8_WAIT_L(0); PG8_MMA(0, 0, At, B0); PG8_BAR; PG8_SCHED;
            PG8_LDB(B1, 1, 1); PG8_STAGE(PG8_SB(1, 0), b3, voffB);
            PG8_BAR; PG8_WAIT_L(0); PG8_MMA(0, 1, At, B1); PG8_BAR;
            PG8_LDA(At, 1, 1); PG8_STAGE(PG8_SA(1, 0), a3, voffA);
            PG8_BAR; PG8_WAIT_L(0); PG8_MMA(1, 0, At, B0); PG8_BAR; PG8_SCHED;
            PG8_STAGE(PG8_SB(1, 1), b3 + hstep, voffB);
            PG8_WAIT_V(6); PG8_BAR; PG8_MMA(1, 1, At, B1); PG8_BAR;
            }
        }
        if constexpr (ALIGN_EPI) { if (wr == 0) PG8_BAR; }
        if constexpr (!Epi::AFTER_DRAIN) { E(acc, cur, wr, wc, fr, fq); S.done(cur); }
        if (!has_next) break;
#pragma unroll
        for (int a = 0; a < 2; ++a)
#pragma unroll
            for (int b = 0; b < 2; ++b)
#pragma unroll
                for (int m = 0; m < 4; ++m)
#pragma unroll
                    for (int n = 0; n < 2; ++n) acc[a][b][m][n] = (AccT)(0);
        cur = nxt; cA = nA; cB = nB; ++ui;
        if constexpr (ALIGN_EPI) { if (wr == 1) PG8_BAR; }
    }
    PG8_WAIT_V(0);
    if constexpr (!ALIGN_EPI) { if (wr == 0) PG8_BAR; }
    PG8_BAR;
    if constexpr (Epi::AFTER_DRAIN) { E.fused(acc, cur, wr, wc, fr, fq, lds, wid, lane); S.done(cur); }
#undef PG8_SA
#undef PG8_SB
#undef PG8_STAGE
#undef PG8_LDA
#undef PG8_LDB
#undef PG8_MMA
#undef PG8_WAIT_V
#undef PG8_WAIT_L
#undef PG8_BAR
#undef PG8_SCHED
}
}

constexpr int NWAVES = 8;
constexpr int D = 1024, NB = 4, SEQ = 4096, CTXL = 256, NLAT = NB * SEQ, NCTX = NB * CTXL, MROWS = NLAT + NCTX;
constexpr int DEPTH = 4, RW = 512, NH = 8, HS = 64, DFF = 3584, NE = 8, NPROJ = 3456, NP = 3584, NLO = 2560, KLA = 512, NMOD = 6144;
constexpr int PC_R = 0, PC_K = 512, PC_V = 1024, PC_CB = 1536, PC_CC = 2048, PC_CH = 2560, PC_WD = 3072, PC_AD = 3200, PC_GD = 3328;
constexpr float LN_EPS = 1e-5f, GN_EPS = 64e-5f, DN_ALPHA = 1.681792830507429f;
enum { I_X = 0, I_C, I_CTX, I_CCTX, I_WMOD, I_BMOD, I_WIN, I_W0, I_W2, I_A0, I_A2, I_KK, I_KA, I_RK, I_G2, I_LNXG, I_LNXB, I_CONVW, I_WOUT, I_LN1G, I_LN1B, I_LN2G, I_LN2B,
       I_FW1, I_FW3, I_FW2, I_RTW, I_RTB, I_MW1, I_MW3, I_MW2, N_IN };

constexpr size_t MiB = 1u << 20;
constexpr size_t WS_CTL = 0, CTL_BYTES = 3 * MiB;
constexpr size_t WS_MODV = 1 * MiB;
constexpr size_t WS_AMAX = 2 * MiB;
constexpr size_t WS_RKS = 3 * MiB;
constexpr size_t WS_WIN = 4 * MiB;
constexpr size_t WS_WOUT = WS_WIN + 28 * MiB;
constexpr size_t WS_LORA = WS_WOUT + 8 * MiB;
constexpr size_t WS_F13 = WS_LORA + 10 * MiB;
constexpr size_t WS_F2 = WS_F13 + 28 * MiB;
constexpr size_t WS_X = WS_F2 + 14 * MiB;
constexpr size_t WS_H = WS_X + 68 * MiB;
constexpr size_t WS_MOES = WS_H + 34 * MiB;
constexpr size_t WS_ROWLIST = WS_MOES;
constexpr size_t WS_TOKSEL = WS_MOES + 640 * 1024;
constexpr size_t WS_WSEL = WS_TOKSEL + 320 * 1024;
constexpr size_t WS_WSORT = WS_WSEL + 192 * 1024;
constexpr size_t WS_MOEW13 = WS_MOES + 2 * MiB;
constexpr size_t WS_MOEW2 = WS_MOEW13 + 112 * MiB;
constexpr size_t WS_H8 = WS_MOEW13 + 56 * MiB;
constexpr size_t WS_SA = WS_H8 + 17 * MiB;
constexpr size_t WS_SAM = WS_SA + 512 * 1024;
constexpr size_t WS_SAG = WS_SA + 1 * MiB;
constexpr size_t WS_SCR = WS_MOEW2 + 56 * MiB;
constexpr size_t WS_P = WS_SCR;
constexpr size_t WS_LO = WS_P + 119 * MiB;
constexpr size_t WS_PREP = WS_LO + 170 * MiB;
constexpr size_t WS_Y = WS_PREP + 213 * MiB;
constexpr size_t WS_MIXIN = WS_Y + 68 * MiB;
constexpr size_t WS_CH = WS_PREP;
constexpr size_t WS_MIXO = WS_PREP;
constexpr size_t WS_MIXP = WS_PREP + 34 * MiB;
constexpr size_t WS_END_MIXER = WS_MIXIN + 34 * MiB;
constexpr size_t WS_HG = WS_SCR;
constexpr size_t WS_ACT = WS_HG + 72 * MiB;
constexpr size_t WS_F = WS_ACT + 252 * MiB;
constexpr size_t WS_FP = WS_F + 72 * MiB;
constexpr size_t WS_END_FFN = WS_FP + 64 * MiB;
constexpr size_t WS_NEED = WS_END_MIXER > WS_END_FFN ? WS_END_MIXER : WS_END_FFN;
static_assert((size_t)MROWS * NP * 2 <= 119 * MiB && (size_t)MROWS * NLO * 4 <= 170 * MiB && (size_t)8704 * 25600 <= 213 * MiB && (size_t)MROWS * D * 4 <= 68 * MiB && WS_NEED <= 990 * MiB, "ws map");
constexpr int MOE_MAIN_PANELS = 128, MOE_TAIL_ROWS = 4096;
constexpr int MOE_ROWS = 36864;
constexpr int AM_IN = 18 * 2 * DFF, AM_OUT = AM_IN + DEPTH * NP;
constexpr int LORAW_PER_LAYER = 4 * 512 * 64 + 512 * 128;
constexpr int CW_BAR = 4096, CW_GCNT = 8192, CW_CQ = 12288, CW_SDONE = 12544;

constexpr int RING_BYTES = 131072, LDSCTL_OFF = RING_BYTES, MISC_OFF = LDSCTL_OFF + 320, LDS_BYTES = 147456;

typedef unsigned short bf16;
typedef unsigned v4u __attribute__((ext_vector_type(4)));
typedef unsigned v2u __attribute__((ext_vector_type(2)));
typedef float f32x4 __attribute__((ext_vector_type(4)));
#define LAS __attribute__((address_space(3)))
#define LDS_WAIT() asm volatile("s_waitcnt lgkmcnt(0)" ::: "memory")
__device__ __forceinline__ unsigned f2bf(float f) { unsigned u = __builtin_bit_cast(unsigned, f); return (u + 0x7fffu + ((u >> 16) & 1u)) >> 16; }
__device__ __forceinline__ unsigned pk2(float lo, float hi) { return f2bf(lo) | (f2bf(hi) << 16); }
__device__ __forceinline__ float bf2f(unsigned short b) { return __builtin_bit_cast(float, ((unsigned)b) << 16); }
__device__ __forceinline__ float bflo(unsigned w) { return __builtin_bit_cast(float, w << 16); }
__device__ __forceinline__ float bfhi(unsigned w) { return __builtin_bit_cast(float, w & 0xffff0000u); }
__device__ __forceinline__ float wave_sum(float v) {
#pragma unroll
    for (int o = 1; o < 64; o <<= 1) v += __shfl_xor(v, o);
    return v;
}
__device__ __forceinline__ float sigm(float x) { return 1.f / (1.f + __expf(-x)); }

#define XB_TMO      128
#define XB_XCNT(j)  (256  + 64 * (j))
#define XB_XSUB(j)  (1280 + 64 * (j))
#define XB_XGEN(j)  (2304 + 64 * (j))
#define XB_TOP      3328
#define XB_TOPGEN   3392
#define XCD_BAR_WORDS 3456
#define XB_SPIN_CAP (1u << 18)

__device__ __forceinline__ unsigned xb_ld(unsigned* p)              { return __hip_atomic_load(p, __ATOMIC_RELAXED, __HIP_MEMORY_SCOPE_AGENT); }
__device__ __forceinline__ unsigned xb_add(unsigned* p, unsigned v) { return __hip_atomic_fetch_add(p, v, __ATOMIC_RELAXED, __HIP_MEMORY_SCOPE_AGENT); }
__device__ __forceinline__ unsigned xb_xcc_id() { return (unsigned)__builtin_amdgcn_s_getreg((3 << 11) | 20) & 0xFu; }
#define XB_SPIN(cond, bar) do { unsigned _sp = 0; while (cond) { __builtin_amdgcn_s_sleep(1); \
    if ((++_sp & 255u) == 0u) { if (xb_ld(&(bar)[XB_TMO])) break; if (_sp > XB_SPIN_CAP) { atomicAdd(&(bar)[XB_TMO], 1u); break; } } } } while (0)

struct XcdBarrier {
    unsigned* bar; unsigned x;
    volatile LAS unsigned* st;
};

__device__ __forceinline__ XcdBarrier xcd_barrier_post(unsigned* bar, volatile LAS unsigned* st) {
    XcdBarrier b; b.bar = bar; b.x = xb_xcc_id(); b.st = st;
    if (threadIdx.x == 0) (void)xb_add(&bar[XB_XCNT(b.x)], 1u);
    return b;
}
__device__ __forceinline__ void xcd_barrier_complete(unsigned* bar, unsigned x, unsigned& nloc, unsigned& nx) {
    const unsigned G = gridDim.x * gridDim.y * gridDim.z;
    unsigned sum, cnt, mine, sp = 0u;
    for (;;) {
        sum = 0u; cnt = 0u; mine = 0u;
#pragma unroll
        for (unsigned j = 0; j < 16; ++j) { const unsigned c = xb_ld(&bar[XB_XCNT(j)]); sum += c; cnt += (c > 0u) ? 1u : 0u; mine = (j == x) ? c : mine; }
        if (sum == G) break;
        __builtin_amdgcn_s_sleep(1);
        if ((++sp & 255u) == 0u) { if (xb_ld(&bar[XB_TMO])) break; if (sp > XB_SPIN_CAP) { atomicAdd(&bar[XB_TMO], 1u); break; } }
    }
    nloc = mine > 0u ? mine : 1u; nx = cnt > 0u ? cnt : 1u;
}

__device__ __forceinline__ void xcd_barrier(const XcdBarrier& b) {
    asm volatile("s_waitcnt vmcnt(0)" ::: "memory");
    __syncthreads();
    if (threadIdx.x == 0) {
        unsigned* bar = b.bar;
        __builtin_amdgcn_s_waitcnt(0);
        unsigned nloc = b.st[0], nx = b.st[1];
        if (nloc == 0u) { xcd_barrier_complete(bar, b.x, nloc, nx); b.st[0] = nloc; b.st[1] = nx; }
        const unsigned old = xb_add(&bar[XB_XSUB(b.x)], 1u);
        const unsigned gen = old / nloc;
        if (old + 1u == (gen + 1u) * nloc) {
            __builtin_amdgcn_fence(__ATOMIC_RELEASE, "agent");
            asm volatile("s_waitcnt vmcnt(0)" ::: "memory");
            const unsigned og = xb_add(&bar[XB_TOP], 1u);
            const unsigned tg = og / nx;
            if (og + 1u == (tg + 1u) * nx) xb_add(&bar[XB_TOPGEN], 1u);
            else XB_SPIN(xb_ld(&bar[XB_TOPGEN]) == tg, bar);
            __builtin_amdgcn_fence(__ATOMIC_ACQUIRE, "agent");
            xb_add(&bar[XB_XGEN(b.x)], 1u);
            asm volatile("s_waitcnt vmcnt(0)" ::: "memory");
        } else {
            XB_SPIN(xb_ld(&bar[XB_XGEN(b.x)]) == gen, bar);
            __builtin_amdgcn_fence(__ATOMIC_ACQUIRE, "agent");
            asm volatile("s_waitcnt vmcnt(0)" ::: "memory");
        }
    }
    __syncthreads();
}


__device__ __forceinline__ size_t opaque_zero() { size_t z = 0; asm volatile("" : "+s"(z)); return z; }
#define OWS (p.ws + opaque_zero())
__device__ __forceinline__ int opaque_zero_i() { int z = 0; asm volatile("" : "+s"(z)); return z; }
#define PIN(i) (p.in[(i) + opaque_zero_i()])
struct KP { const float* in[N_IN]; float* out; unsigned char* ws; int ph; int pad; };

template <int MODE> __device__ __forceinline__ int rowmap(int n, int arg) {
    if (MODE == 0) return n + arg;
    if (MODE == 1) { if (n < 1536) return n; if (n < 1664) return n - 1536 + PC_WD; if (n < 1792) return n - 1664 + PC_AD; if (n < 1920) return n - 1792 + PC_GD;
                     if (n < 2432) return n - 1920 + PC_CB; if (n < 2944) return n - 2432 + PC_CC; return n - 2944 + PC_CH; }
    return 8 * (n >> 2) + 4 * arg + (n & 3);
}
template <int MODE> __device__ __forceinline__ void transpose_item(const float* W, int K, int N, bf16* WT, int arg, LAS float* scr, int item, int lane) {
    const int nblk = N / 32, kb = item / nblk, nb = item % nblk, k0 = 64 * kb, n0 = 32 * nb;
#pragma unroll 8
    for (int i = 0; i < 32; ++i) { const int kk = 2 * i + (lane >> 5); scr[kk * 33 + (lane & 31)] = W[(size_t)(k0 + kk) * N + n0 + (lane & 31)]; }
    LDS_WAIT(); asm volatile("" ::: "memory");
    const int c = lane & 7;
#pragma unroll
    for (int j = 0; j < 4; ++j) { const int n = (lane >> 3) + 8 * j; const LAS float* s = scr + (8 * c) * 33 + n;
        v4u o; o.x = pk2(s[0 * 33], s[1 * 33]); o.y = pk2(s[2 * 33], s[3 * 33]); o.z = pk2(s[4 * 33], s[5 * 33]); o.w = pk2(s[6 * 33], s[7 * 33]);
        *(v4u*)(WT + (size_t)rowmap<MODE>(n0 + n, arg) * K + k0 + 8 * c) = o; }
    LDS_WAIT(); asm volatile("" ::: "memory");
}

__device__ __forceinline__ void ph_modvec(const KP& p, LAS unsigned char* lds, int tid) {
    LAS float* sil = (LAS float*)lds;
    LAS float* red = (LAS float*)(lds + 5 * 1024 * 4);
    const float* c = PIN(I_C); const float* cc = PIN(I_CCTX);
    for (int i = tid; i < 5 * 1024; i += 512) { const float v = i < 4096 ? c[i] : cc[i - 4096]; sil[i] = v / (1.f + __expf(-v)); }
    __syncthreads();
    float* modv = (float*)(OWS + WS_MODV);
    const int ks = tid >> 6, col = tid & 63;
    for (int task = blockIdx.x; task < DEPTH * 96; task += gridDim.x) {
        const int l = task / 96, j0 = (task % 96) * 64;
        const float* w = PIN(I_WMOD) + (size_t)l * D * NMOD + (size_t)(ks * 128) * NMOD + j0 + col;
        float a0 = 0.f, a1 = 0.f, a2 = 0.f, a3 = 0.f, a4 = 0.f;
#pragma unroll 8
        for (int k = 0; k < 128; ++k) { const float wv = w[(size_t)k * NMOD]; const int kk = ks * 128 + k;
            a0 += sil[kk] * wv; a1 += sil[1024 + kk] * wv; a2 += sil[2048 + kk] * wv; a3 += sil[3072 + kk] * wv; a4 += sil[4096 + kk] * wv; }
        red[(ks * 5 + 0) * 64 + col] = a0; red[(ks * 5 + 1) * 64 + col] = a1; red[(ks * 5 + 2) * 64 + col] = a2; red[(ks * 5 + 3) * 64 + col] = a3; red[(ks * 5 + 4) * 64 + col] = a4;
        __syncthreads();
        if (tid < 320) { const int r = tid >> 6; float s = 0.f;
#pragma unroll
            for (int q = 0; q < 8; ++q) s += red[(q * 5 + r) * 64 + col];
            modv[(size_t)(l * 5 + r) * NMOD + j0 + col] = s + PIN(I_BMOD)[l * NMOD + j0 + col]; }
        __syncthreads();
    }
}

__device__ __forceinline__ void ph_convert(const KP& p, LAS unsigned char* lds, int gw, int NGW, int wave, int lane) {
    LAS float* scr = (LAS float*)(lds + wave * 16384);
    bf16* win = (bf16*)(OWS + WS_WIN); bf16* f2 = (bf16*)(OWS + WS_F2); bf16* lora = (bf16*)(OWS + WS_LORA);
    constexpr int I_IN = (D / 64) * (NPROJ / 32), I_OUT = (D / 64) * (D / 32), I_UP = (D / 64) * (DFF / 32), I_DN = (DFF / 64) * (D / 32);
    for (int it = gw; it < I_DN; it += NGW) transpose_item<0>(PIN(I_FW2), DFF, D, f2, 0, scr, it, lane);
    { const int gt = gw * 64 + lane, NGT = NGW * 64; constexpr int PER = (NP - NPROJ) * D / 16;
      for (int i = gt; i < DEPTH * PER; i += NGT) { const int l = i / PER, q = i % PER; *(v4u*)((unsigned char*)win + (size_t)l * NP * D + (size_t)NPROJ * D + (size_t)q * 16) = (v4u){0u, 0u, 0u, 0u}; } }
    { const int gt = gw * 64 + lane, NGT = NGW * 64;
      for (int i = gt; i < DEPTH * LORAW_PER_LAYER / 8; i += NGT) { const int l = i / (LORAW_PER_LAYER / 8); int q = (i % (LORAW_PER_LAYER / 8)) * 8; float v[8];
          int grp, c, k0; if (q < 4 * 512 * 64) { grp = q / (512 * 64); q -= grp * 512 * 64; c = q / 64; k0 = q % 64; } else { grp = 4; q -= 4 * 512 * 64; c = q / 128; k0 = q % 128; }
#pragma unroll
          for (int j = 0; j < 8; ++j) { const int k = k0 + j;
              v[j] = grp < 2 ? PIN(I_W2)[((size_t)(l * 2 + grp) * 64 + k) * RW + c] : grp < 4 ? PIN(I_A2)[((size_t)(l * 2 + grp - 2) * 64 + k) * RW + c] : PIN(I_G2)[((size_t)l * 128 + k) * RW + c]; }
          v4u o; o.x = pk2(v[0], v[1]); o.y = pk2(v[2], v[3]); o.z = pk2(v[4], v[5]); o.w = pk2(v[6], v[7]);
          *(v4u*)(lora + (size_t)i * 8) = o; } }
}
__device__ __forceinline__ void ph_amax(const KP& p, int gw, int NGW, int lane) {
    unsigned* AM = (unsigned*)(OWS + WS_AMAX);
    for (int it = gw; it < 18 * 2 * (DFF / 64); it += NGW) { const int kq = 0, strip = it % (DFF / 64), sm = it / (DFF / 64), s1 = sm & 1, cm = sm >> 1;
        const float* W = cm < 2 ? PIN(s1 ? I_FW3 : I_FW1) + (size_t)cm * D * DFF : PIN(s1 ? I_MW3 : I_MW1) + (size_t)(cm - 2) * D * DFF;
        const int n = strip * 64 + lane; const float* src = W + (size_t)(kq * 256) * DFF + n; float m = 0.f;
#pragma unroll 16
        for (int k = 0; k < 256; ++k) { const float w = src[(size_t)k * DFF]; m += w * w; }
        AM[(size_t)cm * 2 * DFF + 8 * (n >> 2) + 4 * s1 + (n & 3)] = __builtin_bit_cast(unsigned, 4.25f * sqrtf(m * (1.f / 256.f))); }
    for (int it = gw; it < DEPTH * (NPROJ / 64 + D / 64); it += NGW) { const int kq = 0; int t = it; const int l = t / (NPROJ / 64 + D / 64); t -= l * (NPROJ / 64 + D / 64);
        const bool isin = t < NPROJ / 64; const int strip = isin ? t : t - NPROJ / 64, N = isin ? NPROJ : D, n = strip * 64 + lane;
        const float* src = (isin ? PIN(I_WIN) + (size_t)l * D * NPROJ : PIN(I_WOUT) + (size_t)l * D * D) + (size_t)(kq * 256) * N + n; float m = 0.f;
#pragma unroll 16
        for (int k = 0; k < 256; ++k) { const float w = src[(size_t)k * N]; m += w * w; }
        AM[isin ? AM_IN + l * NP + rowmap<1>(n, 0) : AM_OUT + l * D + n] = __builtin_bit_cast(unsigned, 4.25f * sqrtf(m * (1.f / 256.f))); }
}
__device__ __forceinline__ unsigned q8pack(float a, float b, float c, float d) {
    const int qa = __float2int_rn(fminf(fmaxf(a, -127.f), 127.f)), qb = __float2int_rn(fminf(fmaxf(b, -127.f), 127.f)), qc = __float2int_rn(fminf(fmaxf(c, -127.f), 127.f)), qd = __float2int_rn(fminf(fmaxf(d, -127.f), 127.f));
    return (unsigned)(qa & 255) | ((unsigned)(qb & 255) << 8) | ((unsigned)(qc & 255) << 16) | ((unsigned)(qd & 255) << 24); }
constexpr int CQ_IN = (D / 64) * (NPROJ / 32), CQ_OUT = (D / 64) * (D / 32), CQ_UP = (D / 64) * (DFF / 32), CQ_DN = (DFF / 64) * (D / 32);
constexpr int CQ_NEG = CQ_IN + CQ_OUT + 2 * CQ_UP;
constexpr int CQ_J1 = 3 * CQ_IN + 3 * CQ_OUT + 2 * CQ_UP + CQ_DN, CQ_MOE = NE * (2 * CQ_UP + CQ_DN), CQ_END0 = CQ_J1 + CQ_MOE, CQ_END1 = CQ_END0 + CQ_MOE;
#ifndef CQ_SLOT_ITEMS
#define CQ_SLOT_ITEMS 12000
#endif
struct CqItem { const float* W; bf16* WT; int K, N, mode, arg, item; const unsigned* am; };
__device__ __forceinline__ CqItem cq_decode(const KP& p, int q) {
    CqItem c; bf16* win = (bf16*)(OWS + WS_WIN); bf16* wout = (bf16*)(OWS + WS_WOUT); bf16* f13 = (bf16*)(OWS + WS_F13); bf16* f2 = (bf16*)(OWS + WS_F2);
    bf16* m13 = (bf16*)(OWS + WS_MOEW13); bf16* m2 = (bf16*)(OWS + WS_MOEW2); const unsigned* AM = (const unsigned*)(OWS + WS_AMAX);
    if (q < 0) { q += CQ_NEG;
        if (q < CQ_IN) { c = CqItem{PIN(I_WIN), win, D, NPROJ, 3, 0, q, AM + AM_IN}; return c; } q -= CQ_IN;
        if (q < CQ_OUT) { c = CqItem{PIN(I_WOUT), wout, D, D, 4, 0, q, AM + AM_OUT}; return c; } q -= CQ_OUT;
        if (q < CQ_UP) { c = CqItem{PIN(I_FW1), f13, D, DFF, 2, 0, q, AM}; return c; } q -= CQ_UP;
        c = CqItem{PIN(I_FW3), f13, D, DFF, 2, 1, q, AM}; return c; }
    if (q < 3 * CQ_IN) { const int l = 1 + q / CQ_IN; c = CqItem{PIN(I_WIN) + (size_t)l * D * NPROJ, win + (size_t)l * (NP * D / 2), D, NPROJ, 3, 0, q % CQ_IN, AM + AM_IN + l * NP}; return c; } q -= 3 * CQ_IN;
    if (q < 3 * CQ_OUT) { const int l = 1 + q / CQ_OUT; c = CqItem{PIN(I_WOUT) + (size_t)l * D * D, wout + (size_t)l * (D * D / 2), D, D, 4, 0, q % CQ_OUT, AM + AM_OUT + l * D}; return c; } q -= 3 * CQ_OUT;
    if (q < CQ_UP) { c = CqItem{PIN(I_FW1) + (size_t)D * DFF, f13 + (size_t)DFF * D, D, DFF, 2, 0, q, AM + 2 * DFF}; return c; } q -= CQ_UP;
    if (q < CQ_UP) { c = CqItem{PIN(I_FW3) + (size_t)D * DFF, f13 + (size_t)DFF * D, D, DFF, 2, 1, q, AM + 2 * DFF}; return c; } q -= CQ_UP;
    if (q < CQ_DN) { c = CqItem{PIN(I_FW2) + (size_t)DFF * D, f2 + (size_t)D * DFF, DFF, D, 0, 0, q, nullptr}; return c; } q -= CQ_DN;
    const int mi = q / CQ_MOE; q -= mi * CQ_MOE;
    if (q < NE * CQ_UP) { const int e = q / CQ_UP; c = CqItem{PIN(I_MW1) + ((size_t)mi * NE + e) * D * DFF, m13 + (size_t)e * DFF * D, D, DFF, 2, 0, q % CQ_UP, AM + (size_t)(2 + 8 * mi + e) * 2 * DFF}; return c; } q -= NE * CQ_UP;
    if (q < NE * CQ_UP) { const int e = q / CQ_UP; c = CqItem{PIN(I_MW3) + ((size_t)mi * NE + e) * D * DFF, m13 + (size_t)e * DFF * D, D, DFF, 2, 1, q % CQ_UP, AM + (size_t)(2 + 8 * mi + e) * 2 * DFF}; return c; } q -= NE * CQ_UP;
    { const int e = q / CQ_DN; c = CqItem{PIN(I_MW2) + ((size_t)mi * NE + e) * DFF * D, m2 + (size_t)e * D * DFF, DFF, D, 0, 0, q % CQ_DN, nullptr}; return c; }
}
__device__ __forceinline__ void cq_load(const CqItem& c, int lane, float (&r)[32]) {
    const int nblk = c.N / 32, kb = c.item / nblk, nb = c.item % nblk; const float* src = c.W + (size_t)(64 * kb + (lane >> 5)) * c.N + 32 * nb + (lane & 31);
#pragma unroll
    for (int i = 0; i < 32; ++i) r[i] = src[(size_t)(2 * i) * c.N];
}
__device__ __forceinline__ void cq_store(const CqItem& c, int lane, const float (&r)[32], LAS float* scr) {
    const int nblk = c.N / 32, kb = c.item / nblk, nb = c.item % nblk, k0 = 64 * kb, n0 = 32 * nb;
#pragma unroll
    for (int i = 0; i < 32; ++i) scr[(2 * i + (lane >> 5)) * 33 + (lane & 31)] = r[i];
    LDS_WAIT(); asm volatile("" ::: "memory");
    if (c.mode >= 2) {
        const int n = lane >> 1, hf = lane & 1, nn = n0 + n, j = c.mode == 2 ? 8 * (nn >> 2) + 4 * c.arg + (nn & 3) : c.mode == 3 ? rowmap<1>(nn, 0) : nn;
        const float inv = 127.f / fmaxf(__builtin_bit_cast(float, c.am[j]), 1e-30f); const LAS float* sp = scr + (32 * hf) * 33 + n; unsigned w[8];
#pragma unroll
        for (int q = 0; q < 8; ++q) w[q] = q8pack(sp[(4 * q + 0) * 33] * inv, sp[(4 * q + 1) * 33] * inv, sp[(4 * q + 2) * 33] * inv, sp[(4 * q + 3) * 33] * inv);
        unsigned char* dst = (unsigned char*)c.WT + (size_t)j * c.K + k0 + 32 * hf;
        *(v4u*)dst = (v4u){w[0], w[1], w[2], w[3]}; *(v4u*)(dst + 16) = (v4u){w[4], w[5], w[6], w[7]};
    } else {
    const int cc = lane & 7;
#pragma unroll
    for (int j = 0; j < 4; ++j) { const int n = (lane >> 3) + 8 * j; const LAS float* sp = scr + (8 * cc) * 33 + n;
        v4u o; o.x = pk2(sp[0 * 33], sp[1 * 33]); o.y = pk2(sp[2 * 33], sp[3 * 33]); o.z = pk2(sp[4 * 33], sp[5 * 33]); o.w = pk2(sp[6 * 33], sp[7 * 33]);
        const int nn = n0 + n;
        *(v4u*)(c.WT + (size_t)nn * c.K + k0 + 8 * cc) = o; }
    }
    LDS_WAIT(); asm volatile("" ::: "memory");
}
constexpr int CQ_B = 4;
__device__ __forceinline__ int cq_grab(unsigned* heads, int nseg, int& cnt, int lane) {
    int q = -1, n = 0;
    if (lane == 0) { for (int sg = 0; sg < nseg && q < 0; ++sg) { const int size = sg == 0 ? CQ_J1 : CQ_MOE, base = sg == 0 ? 0 : sg == 1 ? CQ_J1 : CQ_END0; unsigned* hd = heads + 64 * sg;
            if ((int)__hip_atomic_load(hd, __ATOMIC_RELAXED, __HIP_MEMORY_SCOPE_AGENT) < size) { const int t = (int)__hip_atomic_fetch_add(hd, (unsigned)CQ_B, __ATOMIC_RELAXED, __HIP_MEMORY_SCOPE_AGENT);
                if (t < size) { q = base + t; n = size - t < CQ_B ? size - t : CQ_B; } } } }
    cnt = __builtin_amdgcn_readfirstlane(n); return __builtin_amdgcn_readfirstlane(q);
}
__device__ __forceinline__ void cq_run(const KP& p, LAS unsigned char* lds, int nseg, const unsigned* stop, unsigned stopval, int wave, int lane) {
    unsigned* heads = (unsigned*)(OWS + WS_CTL) + CW_CQ; LAS float* scr = (LAS float*)(lds + wave * 16384);
    for (;;) {
        if (stop) { unsigned sv = 0u; if (lane == 0) sv = __hip_atomic_load(stop, __ATOMIC_RELAXED, __HIP_MEMORY_SCOPE_AGENT); if ((unsigned)__builtin_amdgcn_readfirstlane((int)sv) >= stopval) break; }
        int cnt; const int q0 = cq_grab(heads, nseg, cnt, lane); if (q0 < 0) break;
        CqItem cur = cq_decode(p, q0); float ra[32]; cq_load(cur, lane, ra);
        for (int j = 0; j < cnt; ++j) { CqItem nxt = cur; float rb[32];
            if (j + 1 < cnt) { nxt = cq_decode(p, q0 + j + 1); cq_load(nxt, lane, rb); }
            cq_store(cur, lane, ra, scr);
            if (j + 1 < cnt) { cur = nxt;
#pragma unroll
                for (int i = 0; i < 32; ++i) ra[i] = rb[i]; } }
    }
}

__device__ __forceinline__ void cq_static(const KP& p, LAS unsigned char* lds, int q0, int q1, int gw, int NGW, int wave, int lane) {
    LAS float* scr = (LAS float*)(lds + wave * 16384);
    int q = q0 + gw; if (q >= q1) return;
    CqItem cur = cq_decode(p, q); float ra[32]; cq_load(cur, lane, ra);
    for (;;) { const int qn = q + NGW; CqItem nxt = cur; float rb[32];
        if (qn < q1) { nxt = cq_decode(p, qn); cq_load(nxt, lane, rb); }
        cq_store(cur, lane, ra, scr);
        if (qn >= q1) break;
        cur = nxt; q = qn;
#pragma unroll
        for (int i = 0; i < 32; ++i) ra[i] = rb[i]; }
}

__device__ __forceinline__ void ld_row(const float* r, int lane, f32x4 (&v)[4]) { const f32x4* q = (const f32x4*)r + lane;
#pragma unroll
    for (int j = 0; j < 4; ++j) v[j] = q[64 * j]; }
__device__ __forceinline__ void st_row(float* r, int lane, const f32x4 (&v)[4]) { f32x4* q = (f32x4*)r + lane;
#pragma unroll
    for (int j = 0; j < 4; ++j) q[64 * j] = v[j]; }
__device__ __forceinline__ void st_row_bf16(bf16* r, int lane, const f32x4 (&v)[4]) { v2u* q = (v2u*)r + lane;
#pragma unroll
    for (int j = 0; j < 4; ++j) { v2u w; w.x = pk2(v[j][0], v[j][1]); w.y = pk2(v[j][2], v[j][3]); q[64 * j] = w; } }
__device__ __forceinline__ void ld_row_bf16(const bf16* r, int lane, f32x4 (&v)[4]) { const v2u* q = (const v2u*)r + lane;
#pragma unroll
    for (int j = 0; j < 4; ++j) { const v2u w = q[64 * j]; v[j] = (f32x4){bflo(w.x), bfhi(w.x), bflo(w.y), bfhi(w.y)}; } }
template <int S> __device__ __forceinline__ void ld_row_parts(const float* r, size_t pstride, int lane, f32x4 (&v)[4]) {
    ld_row(r, lane, v);
#pragma unroll
    for (int s = 1; s < S; ++s) { f32x4 t[4]; ld_row(r + (size_t)s * pstride, lane, t);
#pragma unroll
        for (int j = 0; j < 4; ++j) v[j] += t[j]; } }
__device__ __forceinline__ int mod_row(int row) { return row < NLAT ? (row >> 12) : 4; }

__device__ __forceinline__ void st_row_q8(unsigned char* dst8, float* scale, int row, int lane, const f32x4 (&v)[4]) {
    float am = 0.f;
#pragma unroll
    for (int j = 0; j < 4; ++j) am = fmaxf(fmaxf(am, fmaxf(fabsf(v[j][0]), fabsf(v[j][1]))), fmaxf(fabsf(v[j][2]), fabsf(v[j][3])));
#pragma unroll
    for (int o = 1; o < 64; o <<= 1) am = fmaxf(am, __shfl_xor(am, o));
    am = fmaxf(am, 1e-30f); const float inv = 127.f / am; unsigned* h8 = (unsigned*)dst8 + (size_t)row * (D / 4) + lane;
#pragma unroll
    for (int j = 0; j < 4; ++j) h8[64 * j] = q8pack(v[j][0] * inv, v[j][1] * inv, v[j][2] * inv, v[j][3] * inv);
    if (lane == 0) scale[row] = am * (1.f / 127.f);
}
__device__ __forceinline__ void ph_init_rows(const KP& p, int gw, int NGW, int lane) {
    const float* modv = (const float*)(OWS + WS_MODV); float* X = (float*)(OWS + WS_X); bf16* H = (bf16*)(OWS + WS_H);
    for (int row = gw; row < MROWS; row += NGW) {
        const float* src = row < NLAT ? PIN(I_X) + (size_t)row * D : PIN(I_CTX) + (size_t)(row - NLAT) * D;
        const float* mv = modv + (size_t)(0 * 5 + mod_row(row)) * NMOD;
        f32x4 x[4], sh[4], sc[4], h[4]; ld_row(src, lane, x); ld_row(mv, lane, sh); ld_row(mv + 1024, lane, sc);
#pragma unroll
        for (int j = 0; j < 4; ++j) h[j] = x[j] * (1.f + sc[j]) + sh[j];
        st_row_q8(OWS + WS_H8, (float*)(OWS + WS_SA), row, lane, h);
    }
}

__device__ __forceinline__ int scan_row(int b, int dir, int step) { return step < CTXL ? NLAT + b * CTXL + (dir ? CTXL - 1 - step : step) : b * SEQ + (dir ? SEQ - 1 - (step - CTXL) : step - CTXL); }
typedef short sbf16x8 __attribute__((ext_vector_type(8)));
typedef float f32x16 __attribute__((ext_vector_type(16)));
constexpr int SC_C = 32, SC_NCH = (CTXL + SEQ) / SC_C  , SC_NCHAIN = NB * NH * 2  , SC_NTASK = SC_NCH * SC_NCHAIN  ;
constexpr int CH_G = 0, CH_Q = 8192, CH_UT = 12288, CH_YL = 20480, CH_EC = 24576, CH_BYTES = 25600, CH_NLOAD = 26;

__device__ __forceinline__ f32x16 mm(v4u a, v4u b, f32x16 c) { return __builtin_amdgcn_mfma_f32_32x32x16_bf16(__builtin_bit_cast(sbf16x8, a), __builtin_bit_cast(sbf16x8, b), c, 0, 0, 0); }
typedef float f32x2c __attribute__((ext_vector_type(2))); typedef __bf16 bf16x2c __attribute__((ext_vector_type(2)));
__device__ __forceinline__ unsigned cvtpk(float lo, float hi) { return __builtin_bit_cast(unsigned, __builtin_convertvector((f32x2c){lo, hi}, bf16x2c)); }
template <int S, int NEG> __device__ __forceinline__ v4u cvtf(const f32x16& x) {
    v4u w; const float sg = NEG ? -1.f : 1.f;
    w.x = cvtpk(sg * x[8 * S + 0], sg * x[8 * S + 1]); w.y = cvtpk(sg * x[8 * S + 2], sg * x[8 * S + 3]); w.z = cvtpk(sg * x[8 * S + 4], sg * x[8 * S + 5]); w.w = cvtpk(sg * x[8 * S + 6], sg * x[8 * S + 7]); return w; }
template <int MODE  > __device__ __forceinline__ f32x16 mask_acc(f32x16 x, int n, int hh) {
#pragma unroll
    for (int r = 0; r < 16; ++r) { const int m = (r & 3) + 8 * (r >> 2) + 4 * hh; const bool keep = MODE == 0 ? (m > n) : MODE == 1 ? (m < n) : (m <= n); x[r] = keep ? x[r] : 0.f; }
    return x; }
__device__ __forceinline__ f32x16 zero16() { f32x16 z;
#pragma unroll
    for (int r = 0; r < 16; ++r) z[r] = 0.f;
    return z; }
__device__ __forceinline__ void cm_build(const unsigned (&w)[16], v4u (&f)[2][2]) {
#pragma unroll
    for (int s = 0; s < 2; ++s) {
        const auto r0 = __builtin_amdgcn_permlane32_swap(w[8 * s + 0], w[8 * s + 2], false, false), r1 = __builtin_amdgcn_permlane32_swap(w[8 * s + 1], w[8 * s + 3], false, false);
        const auto r2 = __builtin_amdgcn_permlane32_swap(w[8 * s + 4], w[8 * s + 6], false, false), r3 = __builtin_amdgcn_permlane32_swap(w[8 * s + 5], w[8 * s + 7], false, false);
        f[0][s] = (v4u){r0[0], r1[0], r2[0], r3[0]}; f[1][s] = (v4u){r0[1], r1[1], r2[1], r3[1]}; }
}
__device__ __forceinline__ void st16(unsigned char* base, int off, int lane, v4u v) { *(v4u*)(base + off + lane * 16) = v; }

__device__ __forceinline__ void ph_scan1(const KP& p, int l, int gw, int NGW, int lane) {
    const bf16* P = (const bf16*)(OWS + WS_P); const bf16* LO = (const bf16*)(OWS + WS_LO); const float* NRM = (const float*)(OWS + WS_RKS); unsigned char* CH = OWS + WS_CH;
    const int n = lane & 31, hh = lane >> 5;
    v4u Id[2];
#pragma unroll
    for (int s = 0; s < 2; ++s) { unsigned wd[4];
#pragma unroll
        for (int q = 0; q < 4; ++q) { const int j0 = 2 * q, j1 = 2 * q + 1; const int t0 = 16 * s + 8 * (j0 >> 2) + 4 * hh + (j0 & 3), t1 = 16 * s + 8 * (j1 >> 2) + 4 * hh + (j1 & 3);
            wd[q] = (t0 == n ? 0x3F80u : 0u) | (t1 == n ? 0x3F800000u : 0u); }
        Id[s] = (v4u){wd[0], wd[1], wd[2], wd[3]}; }
    for (int task = gw; task < SC_NTASK; task += NGW) {
        const int dir = task & 1, h = (task >> 1) & 7, b = (task >> 4) & 3, ci = task >> 6;
        const int row0 = scan_row(b, dir, SC_C * ci), sgn = dir ? -1 : 1, c = h * 64 + lane;
        const float w0c = PIN(I_W0)[(l * 2 + dir) * RW + c], a0c = PIN(I_A0)[(l * 2 + dir) * RW + c], kkc = PIN(I_KK)[l * RW + c], kac = PIN(I_KA)[l * RW + c];
        unsigned wAl[16], wBe[16], wKa[16], wRh[16], wV[16], wBp[16], wKp[16];
        float cs = 0.f, Eprev = 1.f;
#pragma unroll
        for (int hb = 0; hb < 2; ++hb) {
            unsigned rk_[16], rr_[16], rv_[16], rw_[16], ra_[16]; float rn_[16];
#pragma unroll
            for (int i = 0; i < 16; ++i) { const int row = row0 + sgn * (16 * hb + i); const bf16* pr = P + (size_t)row * NP; const bf16* lo = LO + (size_t)row * NLO;
                rk_[i] = pr[PC_K + c]; rr_[i] = pr[PC_R + c]; rv_[i] = pr[PC_V + c]; rw_[i] = lo[dir * RW + c]; ra_[i] = lo[1024 + dir * RW + c]; rn_[i] = NRM[row * 8 + h]; }
#pragma unroll
            for (int i = 0; i < 16; ++i) asm volatile("" : "+v"(rk_[i]), "+v"(rr_[i]), "+v"(rv_[i]), "+v"(rw_[i]), "+v"(ra_[i]), "+v"(rn_[i]));
#pragma unroll
            for (int pq = 0; pq < 8; ++pq) { const int pz = 8 * hb + pq; float al[2], be[2], ka[2], rh[2], vv[2];
#pragma unroll
                for (int e = 0; e < 2; ++e) { const int i = 2 * pq + e;
                    const float kv = bf2f((unsigned short)rk_[i]), rv = bf2f((unsigned short)rr_[i]); vv[e] = bf2f((unsigned short)rv_[i]);
                    const float wl = w0c + bf2f((unsigned short)rw_[i]), aa = __builtin_amdgcn_rcpf(1.f + __expf(-(a0c + bf2f((unsigned short)ra_[i])))), nrm = rn_[i];
                    const float lw = -0.6065306597f * __builtin_amdgcn_rcpf(1.f + __expf(-wl));
                    cs += lw; const float E = __expf(cs), Ei = __builtin_amdgcn_rcpf(E);
                    const float kkn = kv * kkc * nrm, kd = kv * (1.f + (aa - 1.f) * kac);
                    al[e] = kkn * Eprev; be[e] = kkn * aa * Ei; ka[e] = kd * Ei; rh[e] = rv * E; Eprev = E; }
                wAl[pz] = cvtpk(al[0], al[1]); wBe[pz] = cvtpk(be[0], be[1]); wKa[pz] = cvtpk(ka[0], ka[1]); wRh[pz] = cvtpk(rh[0], rh[1]); wV[pz] = cvtpk(vv[0], vv[1]); }
        }
        const float EC = Eprev;
#pragma unroll
        for (int pz = 0; pz < 16; ++pz) { wBp[pz] = cvtpk(bflo(wBe[pz]) * EC, bfhi(wBe[pz]) * EC); wKp[pz] = cvtpk(bflo(wKa[pz]) * EC, bfhi(wKa[pz]) * EC); }
        unsigned char* img = CH + (size_t)(((b * 8 + h) * 2 + dir) * SC_NCH + ci) * CH_BYTES;
        ((float*)(img + CH_EC))[lane] = EC;
        v4u cAl[2][2], cV[2][2], cBp[2][2], cKp[2][2], cRh[2][2];
        v4u tAl[4], tBe[4], tKa[4], tRh[4];
        cm_build(wAl, cAl); cm_build(wV, cV); cm_build(wBp, cBp); cm_build(wKp, cKp); cm_build(wRh, cRh);
        {   v4u cBe[2][2], cKa[2][2]; cm_build(wBe, cBe); cm_build(wKa, cKa);
#define TRANSPOSE(cZ, tZ) do { _Pragma("unroll") for (int ct = 0; ct < 2; ++ct) { f32x16 T_ = mm(cZ[ct][0], Id[0], zero16()); T_ = mm(cZ[ct][1], Id[1], T_); tZ[2 * ct] = cvtf<0, 0>(T_); tZ[2 * ct + 1] = cvtf<1, 0>(T_); } } while (0)
            TRANSPOSE(cAl, tAl); TRANSPOSE(cBe, tBe); TRANSPOSE(cKa, tKa); TRANSPOSE(cRh, tRh);
#undef TRANSPOSE
        }
#define PROD4(A, B) mm(A[3], B[3], mm(A[2], B[2], mm(A[1], B[1], mm(A[0], B[0], zero16()))))
        f32x16 XN = mask_acc<0>(PROD4(tAl, tBe), n, hh), XT = mask_acc<1>(PROD4(tBe, tAl), n, hh);
        v4u fLM[2], fGB[2], fGK[2];
        { const f32x16 t = mask_acc<1>(PROD4(tKa, tAl), n, hh); fLM[0] = cvtf<0, 0>(t); fLM[1] = cvtf<1, 0>(t); }
        { const f32x16 t = mask_acc<2>(PROD4(tBe, tRh), n, hh); fGB[0] = cvtf<0, 0>(t); fGB[1] = cvtf<1, 0>(t); }
        { const f32x16 t = mask_acc<2>(PROD4(tKa, tRh), n, hh); fGK[0] = cvtf<0, 0>(t); fGK[1] = cvtf<1, 0>(t); }
#undef PROD4
#pragma unroll
        for (int r = 0; r < 16; ++r) { XN[r] = -XN[r]; XT[r] = -XT[r]; }
        f32x16 RT = XT;
#pragma unroll
        for (int r = 0; r < 16; ++r) RT[r] += ((r & 3) + 8 * (r >> 2) + 4 * hh == n) ? 1.f : 0.f;
#pragma unroll
        for (int pw = 1; pw < 5; ++pw) {
            const v4u xn0 = cvtf<0, 0>(XN), xn1 = cvtf<1, 0>(XN), xt0 = cvtf<0, 0>(XT), xt1 = cvtf<1, 0>(XT);
            XN = mm(xt1, xn1, mm(xt0, xn0, zero16()));
            if (pw < 4) XT = mm(xn1, xt1, mm(xn0, xt0, zero16()));
            const v4u yn0 = cvtf<0, 0>(XN), yn1 = cvtf<1, 0>(XN), rt0 = cvtf<0, 0>(RT), rt1 = cvtf<1, 0>(RT);
            RT = mm(yn1, rt1, mm(yn0, rt0, RT));
        }
        const v4u fA0 = cvtf<0, 0>(RT), fA1 = cvtf<1, 0>(RT);
        f32x16 At[2], Vt[2];
#pragma unroll
        for (int t = 0; t < 2; ++t) {
            const f32x16 lmv = mm(fLM[1], cV[t][1], mm(fLM[0], cV[t][0], zero16()));
            At[t] = mm(fA1, cAl[t][1], mm(fA0, cAl[t][0], zero16()));
            Vt[t] = mm(fA1, cvtf<1, 0>(lmv), mm(fA0, cvtf<0, 0>(lmv), zero16()));
        }
#pragma unroll
        for (int kt1 = 0; kt1 < 2; ++kt1) { const v4u a0 = cvtf<0, 0>(At[kt1]), a1 = cvtf<1, 0>(At[kt1]);
#pragma unroll
            for (int kt2 = 0; kt2 < 2; ++kt2) { const f32x16 g = mm(a1, cBp[kt2][1], mm(a0, cBp[kt2][0], zero16()));
                st16(img, CH_G + ((kt2 * 2 + kt1) * 2 + 0) * 1024, lane, cvtf<0, 1>(g)); st16(img, CH_G + ((kt2 * 2 + kt1) * 2 + 1) * 1024, lane, cvtf<1, 1>(g)); } }
#pragma unroll
        for (int vt = 0; vt < 2; ++vt) { const v4u nv0 = cvtf<0, 1>(Vt[vt]), nv1 = cvtf<1, 1>(Vt[vt]);
#pragma unroll
            for (int kt = 0; kt < 2; ++kt) { f32x16 u = mm(cKp[kt][1], cV[vt][1], mm(cKp[kt][0], cV[vt][0], zero16())); u = mm(cBp[kt][1], nv1, mm(cBp[kt][0], nv0, u));
                st16(img, CH_UT + ((kt * 2 + vt) * 2 + 0) * 1024, lane, cvtf<0, 0>(u)); st16(img, CH_UT + ((kt * 2 + vt) * 2 + 1) * 1024, lane, cvtf<1, 0>(u)); }
            f32x16 y = mm(cV[vt][1], fGK[1], mm(cV[vt][0], fGK[0], zero16())); y = mm(nv1, fGB[1], mm(nv0, fGB[0], y));
            st16(img, CH_YL + (vt * 2 + 0) * 1024, lane, cvtf<0, 0>(y)); st16(img, CH_YL + (vt * 2 + 1) * 1024, lane, cvtf<1, 0>(y)); }
#pragma unroll
        for (int kt = 0; kt < 2; ++kt) { f32x16 q = mm(cRh[kt][1], Id[1], mm(cRh[kt][0], Id[0], zero16()));
            q = mm(cvtf<1, 1>(At[kt]), fGB[1], mm(cvtf<0, 1>(At[kt]), fGB[0], q));
            st16(img, CH_Q + (kt * 2 + 0) * 1024, lane, cvtf<0, 0>(q)); st16(img, CH_Q + (kt * 2 + 1) * 1024, lane, cvtf<1, 0>(q)); }
    }
}

__device__ __forceinline__ void ph_scan2(const KP& p, LAS unsigned char* lds, int l, int wave, int lane) {
    unsigned* sdone = (unsigned*)(OWS + WS_CTL) + CW_SDONE + 64 * l;
#ifndef CQ_SLOT_WGS
#define CQ_SLOT_WGS 128
#endif
    if (blockIdx.x >= SC_NCHAIN * 2) {
        const int q0 = (l < 2 ? CQ_J1 : CQ_END0) + (l & 1) * CQ_SLOT_ITEMS;
        cq_static(p, lds, q0, q0 + CQ_SLOT_ITEMS, ((int)blockIdx.x - SC_NCHAIN * 2) * NWAVES + wave, ((int)gridDim.x - SC_NCHAIN * 2) * NWAVES, wave, lane); return; }
    const int chain = blockIdx.x >> 1, vt = blockIdx.x & 1, dir = chain & 1, h = (chain >> 1) & 7, b = chain >> 4;
    const int n = lane & 31, hh = lane >> 5;
    const unsigned char* CH = OWS + WS_CH + (size_t)chain * SC_NCH * CH_BYTES; bf16* Y = (bf16*)(OWS + WS_Y) + (size_t)dir * MROWS * RW + h * 64 + 32 * vt + 4 * hh;
    constexpr int NPIECE = 19, SLOT = NPIECE * 1024, NSLOT = 6, PD = 4, XCH = NSLOT * SLOT;
    int psrc[3], pdst[3];
#pragma unroll
    for (int j = 0; j < 3; ++j) { int f = wave + 8 * j; if (f >= NPIECE) f -= NPIECE;
        pdst[j] = f;
        psrc[j] = f < 12 ? f * 1024 : f < 16 ? CH_UT + ((((f - 12) >> 1) * 2 + vt) * 2 + ((f - 12) & 1)) * 1024 : f < 18 ? CH_YL + (vt * 2 + (f - 16)) * 1024 : CH_EC; }
    const int lane_off[3] = {pdst[0] == 18 ? (lane * 16) & 255 : lane * 16, pdst[1] == 18 ? (lane * 16) & 255 : lane * 16, pdst[2] == 18 ? (lane * 16) & 255 : lane * 16};
#define SC2_ISSUE(ci_, slot_) do { const unsigned char* im_ = CH + (size_t)(ci_) * CH_BYTES; LAS unsigned char* sl_ = lds + (slot_) * SLOT; \
        _Pragma("unroll") for (int j = 0; j < 3; ++j) __builtin_amdgcn_global_load_lds((const unsigned*)(im_ + psrc[j] + lane_off[j]), (LAS unsigned*)(sl_ + pdst[j] * 1024), 16, 0, 0); } while (0)
#define SC2_LD(slot_, piece_) (*(const LAS v4u*)(lds + (slot_) * SLOT + (piece_) * 1024 + lane * 16))
#define SC2_X(par_, k_) (*(LAS v4u*)(lds + XCH + (par_) * 4096 + (k_) * 1024 + lane * 16))
    f32x16 ST[2] = {zero16(), zero16()};
    SC2_ISSUE(0, 0); SC2_ISSUE(1, 1); SC2_ISSUE(2, 2); SC2_ISSUE(3, 3);
    v4u g0, g1, g2, g3, g4, g5, g6, g7, u0, u1, u2, u3; f32x4 ec[8];
#define SC2_PRELOAD(slot_) do { g0 = SC2_LD(slot_, 0); g1 = SC2_LD(slot_, 1); g2 = SC2_LD(slot_, 2); g3 = SC2_LD(slot_, 3); g4 = SC2_LD(slot_, 4); g5 = SC2_LD(slot_, 5); g6 = SC2_LD(slot_, 6); g7 = SC2_LD(slot_, 7); \
        u0 = SC2_LD(slot_, 12); u1 = SC2_LD(slot_, 13); u2 = SC2_LD(slot_, 14); u3 = SC2_LD(slot_, 15); \
        _Pragma("unroll") for (int kq = 0; kq < 8; ++kq) ec[kq] = *(const LAS f32x4*)(lds + (slot_) * SLOT + 18 * 1024 + (32 * (kq >> 2) + 8 * (kq & 3) + 4 * hh) * 4); } while (0)
    for (int ci = 0; ci <= SC_NCH; ++ci) {
        asm volatile("s_waitcnt vmcnt(6)" ::: "memory");
        __builtin_amdgcn_s_barrier();
        asm volatile("" ::: "memory");
        { const int nx = ci + PD < SC_NCH ? ci + PD : SC_NCH - 1; SC2_ISSUE(nx, (ci + PD) % NSLOT); }
        if (wave == 0 && ci < SC_NCH) {
            if (ci == 0) SC2_PRELOAD(0);
            asm volatile("" : "+v"(g0), "+v"(g1), "+v"(g2), "+v"(g3), "+v"(g4), "+v"(g5), "+v"(g6), "+v"(g7), "+v"(u0), "+v"(u1), "+v"(u2), "+v"(u3));
            asm volatile("" : "+v"(ec[0]), "+v"(ec[1]), "+v"(ec[2]), "+v"(ec[3]), "+v"(ec[4]), "+v"(ec[5]), "+v"(ec[6]), "+v"(ec[7]));
            const v4u s00 = cvtf<0, 0>(ST[0]), s01 = cvtf<1, 0>(ST[0]), s10 = cvtf<0, 0>(ST[1]), s11 = cvtf<1, 0>(ST[1]);
            SC2_X(ci & 1, 0) = s00; SC2_X(ci & 1, 1) = s01; SC2_X(ci & 1, 2) = s10; SC2_X(ci & 1, 3) = s11;
            f32x16 a0, a1;
            a0[0] = bflo(u0.x); a0[1] = bfhi(u0.x); a0[2] = bflo(u0.y); a0[3] = bfhi(u0.y); a0[4] = bflo(u0.z); a0[5] = bfhi(u0.z); a0[6] = bflo(u0.w); a0[7] = bfhi(u0.w);
            a0[8] = bflo(u1.x); a0[9] = bfhi(u1.x); a0[10] = bflo(u1.y); a0[11] = bfhi(u1.y); a0[12] = bflo(u1.z); a0[13] = bfhi(u1.z); a0[14] = bflo(u1.w); a0[15] = bfhi(u1.w);
            a1[0] = bflo(u2.x); a1[1] = bfhi(u2.x); a1[2] = bflo(u2.y); a1[3] = bfhi(u2.y); a1[4] = bflo(u2.z); a1[5] = bfhi(u2.z); a1[6] = bflo(u2.w); a1[7] = bfhi(u2.w);
            a1[8] = bflo(u3.x); a1[9] = bfhi(u3.x); a1[10] = bflo(u3.y); a1[11] = bfhi(u3.y); a1[12] = bflo(u3.z); a1[13] = bfhi(u3.z); a1[14] = bflo(u3.w); a1[15] = bfhi(u3.w);
#pragma unroll
            for (int q = 0; q < 4; ++q)
#pragma unroll
                for (int e = 0; e < 4; ++e) { a0[4 * q + e] += ST[0][4 * q + e] * ec[q][e]; a1[4 * q + e] += ST[1][4 * q + e] * ec[4 + q][e]; }
            a0 = mm(g0, s00, a0); a1 = mm(g4, s00, a1); a0 = mm(g1, s01, a0); a1 = mm(g5, s01, a1);
            a0 = mm(g2, s10, a0); a1 = mm(g6, s10, a1); a0 = mm(g3, s11, a0); a1 = mm(g7, s11, a1);
            if (ci + 1 < SC_NCH) SC2_PRELOAD((ci + 1) % NSLOT);
            ST[0] = a0; ST[1] = a1;
            if (lane == 0 && ci == SC_NCH - 24) __hip_atomic_fetch_add(sdone, 1u, __ATOMIC_RELAXED, __HIP_MEMORY_SCOPE_AGENT);
        } else if (wave == 1 && ci >= 1) {
            const int cj = ci - 1, sj = cj % NSLOT, par = cj & 1;
            v4u ya = SC2_LD(sj, 16), yc = SC2_LD(sj, 17), q0 = SC2_LD(sj, 8), q1 = SC2_LD(sj, 9), q2 = SC2_LD(sj, 10), q3 = SC2_LD(sj, 11), x0 = SC2_X(par, 0), x1 = SC2_X(par, 1), x2 = SC2_X(par, 2), x3 = SC2_X(par, 3);
            asm volatile("" : "+v"(ya), "+v"(yc), "+v"(q0), "+v"(q1), "+v"(q2), "+v"(q3), "+v"(x0), "+v"(x1), "+v"(x2), "+v"(x3));
            f32x16 y, y2 = zero16();
            y[0] = bflo(ya.x); y[1] = bfhi(ya.x); y[2] = bflo(ya.y); y[3] = bfhi(ya.y); y[4] = bflo(ya.z); y[5] = bfhi(ya.z); y[6] = bflo(ya.w); y[7] = bfhi(ya.w);
            y[8] = bflo(yc.x); y[9] = bfhi(yc.x); y[10] = bflo(yc.y); y[11] = bfhi(yc.y); y[12] = bflo(yc.z); y[13] = bfhi(yc.z); y[14] = bflo(yc.w); y[15] = bfhi(yc.w);
            y = mm(x0, q0, y); y2 = mm(x2, q2, y2); y = mm(x1, q1, y); y2 = mm(x3, q3, y2);
            const int row = scan_row(b, dir, SC_C * cj + n); bf16* yo = Y + (size_t)row * RW;
#pragma unroll
            for (int q = 0; q < 4; ++q) *(v2u*)(yo + 8 * q) = (v2u){cvtpk(y[4 * q] + y2[4 * q], y[4 * q + 1] + y2[4 * q + 1]), cvtpk(y[4 * q + 2] + y2[4 * q + 2], y[4 * q + 3] + y2[4 * q + 3])};
        }
        asm volatile("s_waitcnt lgkmcnt(0)" ::: "memory");
    }
    asm volatile("s_waitcnt vmcnt(0)" ::: "memory");
#undef SC2_ISSUE
#undef SC2_LD
#undef SC2_X
#undef SC2_PRELOAD
}

__device__ __forceinline__ float sum8(float v) { v += __shfl_xor(v, 1); v += __shfl_xor(v, 2); v += __shfl_xor(v, 4); return v; }
__device__ __forceinline__ void unpack8(v4u s, float (&v)[8]) { v[0] = bflo(s.x); v[1] = bfhi(s.x); v[2] = bflo(s.y); v[3] = bfhi(s.y); v[4] = bflo(s.z); v[5] = bfhi(s.z); v[6] = bflo(s.w); v[7] = bfhi(s.w); }
__device__ __forceinline__ void ld8f(const float* q, float (&v)[8]) { const f32x4 a = *(const f32x4*)q, b = *(const f32x4*)(q + 4); v[0] = a[0]; v[1] = a[1]; v[2] = a[2]; v[3] = a[3]; v[4] = b[0]; v[5] = b[1]; v[6] = b[2]; v[7] = b[3]; }
__device__ __forceinline__ v4u pack8(const float (&v)[8]) { v4u o; o.x = cvtpk(v[0], v[1]); o.y = cvtpk(v[2], v[3]); o.z = cvtpk(v[4], v[5]); o.w = cvtpk(v[6], v[7]); return o; }

__device__ __forceinline__ void ph_readout2(const KP& p, int l, int gw, int NGW, int lane) {
    const bf16* P = (const bf16*)(OWS + WS_P); const bf16* LO = (const bf16*)(OWS + WS_LO); const bf16* Y = (const bf16*)(OWS + WS_Y);
    bf16* MI = (bf16*)(OWS + WS_MIXIN); constexpr size_t PA = (size_t)MROWS * RW; const int c0 = lane * 8;
    const int nrows = l == DEPTH - 1 ? NLAT : MROWS;
#pragma unroll 2
    for (int row = gw; row < nrows; row += NGW) { const bf16* pr = P + (size_t)row * NP; const bf16* lo = LO + (size_t)row * NLO;
        int t, len; if (row < NLAT) { t = row & 63; len = 64; } else { t = (row - NLAT) & 255; len = 256; }
        const v4u kw = *(const v4u*)(pr + PC_K + c0), rw = *(const v4u*)(pr + PC_R + c0), vw = *(const v4u*)(pr + PC_V + c0);
        const v4u cbw = *(const v4u*)(pr + PC_CB + c0), ccw = *(const v4u*)(pr + PC_CC + c0), chw = *(const v4u*)(pr + PC_CH + c0);
        v4u ccp = (v4u){0u, 0u, 0u, 0u}, chp = ccp, ccn = ccp, chn = ccp;
        if (t > 0) { ccp = *(const v4u*)(pr - NP + PC_CC + c0); chp = *(const v4u*)(pr - NP + PC_CH + c0); }
        if (t < len - 1) { ccn = *(const v4u*)(pr + NP + PC_CC + c0); chn = *(const v4u*)(pr + NP + PC_CH + c0); }
        float yf[8], yb[8], la0[8], la1[8], g[8];
        unpack8(*(const v4u*)(Y + (size_t)row * RW + c0), yf); unpack8(*(const v4u*)(Y + PA + (size_t)row * RW + c0), yb); unpack8(*(const v4u*)(lo + 1024 + c0), la0); unpack8(*(const v4u*)(lo + 1536 + c0), la1); unpack8(*(const v4u*)(lo + 2048 + c0), g);
        float a0[8], a1[8], ka[8], rkp[8], lg[8], lb[8];
        ld8f(PIN(I_A0) + (l * 2 + 0) * RW + c0, a0); ld8f(PIN(I_A0) + (l * 2 + 1) * RW + c0, a1); ld8f(PIN(I_KA) + l * RW + c0, ka); ld8f(PIN(I_RK) + l * RW + c0, rkp);
        ld8f(PIN(I_LNXG) + l * RW + c0, lg); ld8f(PIN(I_LNXB) + l * RW + c0, lb);
        float kv[8], rv[8], vv[8]; unpack8(kw, kv); unpack8(rw, rv); unpack8(vw, vv);
        float y[8], s = 0.f, rk = 0.f;
#pragma unroll
        for (int j = 0; j < 8; ++j) { y[j] = yf[j] + yb[j]; s += y[j]; const float av = sigm(a0[j] + la0[j]) + sigm(a1[j] + la1[j]); rk += rv[j] * kv[j] * (2.f + (av - 2.f) * ka[j]) * rkp[j]; }
        const float mu = sum8(s) * (1.f / 64.f); rk = sum8(rk); float q = 0.f;
#pragma unroll
        for (int j = 0; j < 8; ++j) { y[j] -= mu; q += y[j] * y[j]; }
        const float rstd = 1.f / sqrtf(sum8(q) * (1.f / 64.f) + GN_EPS);
        float o[8];
#pragma unroll
        for (int j = 0; j < 8; ++j) o[j] = (y[j] * rstd * lg[j] + lb[j] + rk * vv[j]) * g[j];
        float orw[8];
#pragma unroll
        for (int j = 0; j < 8; ++j) orw[j] = o[j];
        float cb[8], cc[8], ch[8], pcc[8], pch[8], ncc[8], nch[8], w0[8], w1[8], w2[8];
        unpack8(cbw, cb); unpack8(ccw, cc); unpack8(chw, ch); unpack8(ccp, pcc); unpack8(chp, pch); unpack8(ccn, ncc); unpack8(chn, nch);
        const float* cw = PIN(I_CONVW) + (size_t)l * 3 * RW + c0; ld8f(cw, w0); ld8f(cw + RW, w1); ld8f(cw + 2 * RW, w2);
#pragma unroll
        for (int j = 0; j < 8; ++j) o[j] = cb[j] * (pcc[j] * pch[j] * w0[j] + cc[j] * ch[j] * w1[j] + ncc[j] * nch[j] * w2[j]);
        float am = 0.f;
#pragma unroll
        for (int j = 0; j < 8; ++j) am = fmaxf(am, fmaxf(fabsf(orw[j]), fabsf(o[j])));
#pragma unroll
        for (int sh = 1; sh < 64; sh <<= 1) am = fmaxf(am, __shfl_xor(am, sh));
        am = fmaxf(am, 1e-30f); const float inv = 127.f / am; unsigned char* m8 = (unsigned char*)MI + (size_t)row * D + c0;
        *(v2u*)m8 = (v2u){q8pack(orw[0] * inv, orw[1] * inv, orw[2] * inv, orw[3] * inv), q8pack(orw[4] * inv, orw[5] * inv, orw[6] * inv, orw[7] * inv)};
        *(v2u*)(m8 + RW) = (v2u){q8pack(o[0] * inv, o[1] * inv, o[2] * inv, o[3] * inv), q8pack(o[4] * inv, o[5] * inv, o[6] * inv, o[7] * inv)};
        if (lane == 0) ((float*)(OWS + WS_SAM))[row] = am * (1.f / 127.f);
    }
}


template <int KS> __device__ __forceinline__ void lora_afrag(const v4u (&raw)[KS], int fn, v4u (&af)[KS]) {
#pragma unroll
    for (int s = 0; s < KS; ++s) { float v[8]; unpack8(raw[s], v);
        if (fn == 0) {
#pragma unroll
            for (int j = 0; j < 8; ++j) v[j] = 1.f - 2.f * __builtin_amdgcn_rcpf(1.f + __expf(2.f * v[j])); }
        else if (fn == 2) {
#pragma unroll
            for (int j = 0; j < 8; ++j) v[j] = __builtin_amdgcn_rcpf(1.f + __expf(-v[j])); }
        af[s] = pack8(v); }
}
template <int KS, int NT> __device__ __forceinline__ void lora_task(const bf16* P, int col0, int fn, const bf16* wt, bf16* LOg, int ct0, int rb0, int rb1, int n, int hh) {
    v4u bfr[NT][KS];
#pragma unroll
    for (int t = 0; t < NT; ++t)
#pragma unroll
        for (int s = 0; s < KS; ++s) bfr[t][s] = *(const v4u*)(wt + (size_t)(32 * (ct0 + t) + n) * (16 * KS) + 8 * hh + 16 * s);
    v4u raw[KS];
#pragma unroll
    for (int s = 0; s < KS; ++s) raw[s] = *(const v4u*)(P + (size_t)(rb0 * 32 + n) * NP + col0 + 16 * s + 8 * hh);
    for (int rb = rb0; rb < rb1; ++rb) {
        v4u af[KS]; lora_afrag<KS>(raw, fn, af);
        if (rb + 1 < rb1) {
#pragma unroll
            for (int s = 0; s < KS; ++s) raw[s] = *(const v4u*)(P + (size_t)((rb + 1) * 32 + n) * NP + col0 + 16 * s + 8 * hh); }
        int no = n, ho = hh; asm volatile("" : "+v"(no), "+v"(ho));
        bf16* out = LOg + (size_t)(rb * 32 + 4 * ho) * NLO + 32 * ct0 + no;
#pragma unroll
        for (int t = 0; t < NT; ++t) { f32x16 acc = zero16();
#pragma unroll
            for (int s = 0; s < KS; ++s) acc = mm(af[s], bfr[t][s], acc);
#pragma unroll
            for (int r = 0; r < 16; ++r) out[(size_t)((r & 3) + 8 * (r >> 2)) * NLO + 32 * t] = (bf16)f2bf(acc[r]); }
    }
}
__device__ __forceinline__ void ph_lora(const KP& p, int l, int gw, int NGW, int lane) {
    const bf16* P = (const bf16*)(OWS + WS_P); bf16* LO = (bf16*)(OWS + WS_LO); float* NRM = (float*)(OWS + WS_RKS);
    const bf16* LW = (const bf16*)(OWS + WS_LORA) + (size_t)l * LORAW_PER_LAYER; const int n = lane & 31, hh = lane >> 5;
    constexpr int RCH = 7, NRB = MROWS / 32, NCHK = (NRB + RCH - 1) / RCH;
    for (int task = gw; task < NCHK * 24; task += NGW) { const int ctk = task % 24, chunk = task / 24, rb0 = chunk * RCH, rb1 = rb0 + RCH < NRB ? rb0 + RCH : NRB;
        if (ctk < 16) { const int grp = ctk >> 2; lora_task<4, 4>(P, grp < 2 ? PC_WD + 64 * grp : PC_AD + 64 * (grp - 2), grp < 2 ? 0 : 1, LW + (size_t)grp * 512 * 64, LO + grp * 512, (ctk & 3) * 4, rb0, rb1, n, hh); }
        else lora_task<8, 2>(P, PC_GD, 2, LW + (size_t)4 * 512 * 64, LO + 4 * 512, (ctk - 16) * 2, rb0, rb1, n, hh); }
    float kkc[8]; ld8f(PIN(I_KK) + l * RW + lane * 8, kkc);
    for (int row = gw; row < MROWS; row += NGW) { const v4u kw = *(const v4u*)(P + (size_t)row * NP + PC_K + lane * 8); float kv[8]; unpack8(kw, kv); float ss = 0.f;
#pragma unroll
        for (int j = 0; j < 8; ++j) { const float t = kv[j] * kkc[j]; ss += t * t; }
        ss = sum8(ss); if ((lane & 7) == 0) NRM[row * 8 + (lane >> 3)] = 1.f / fmaxf(sqrtf(ss), 1e-12f); }
}

__device__ __forceinline__ void ph_moe_gather(const KP& p, int l, int gw, int NGW, int lane) {
    const unsigned* gcnt = (const unsigned*)(OWS + WS_CTL) + CW_GCNT + 64 * (l >> 1);
    int cnt[8], pb[9]; pb[0] = 0;
#pragma unroll
    for (int e = 0; e < 8; ++e) { cnt[e] = (int)gcnt[e]; pb[e + 1] = pb[e] + ((cnt[e] + 255) & ~255); }
    const unsigned* rowlist = (const unsigned*)(OWS + WS_ROWLIST); const float* wsel = (const float*)(OWS + WS_WSEL); float* wsort = (float*)(OWS + WS_WSORT);
    const unsigned char* H8 = OWS + WS_H8; unsigned char* HG = OWS + WS_HG; const float* sa = (const float*)(OWS + WS_SA); float* sag = (float*)(OWS + WS_SAG);
    for (int pos = gw; pos < pb[8]; pos += NGW) {
        int e = 0, base = 0, ce = cnt[0];
#pragma unroll
        for (int k = 1; k < 8; ++k) if (pos >= pb[k]) { e = k; base = pb[k]; ce = cnt[k]; }
        const int rank = pos - base; v4u a = (v4u){0u, 0u, 0u, 0u}; float w = 0.f, sc = 0.f;
        if (rank < ce) { const unsigned ent = rowlist[(size_t)e * MROWS + rank]; a = *(const v4u*)(H8 + (size_t)(ent >> 1) * D + lane * 16); w = wsel[ent]; sc = sa[ent >> 1]; }
        *(v4u*)(HG + (size_t)pos * D + lane * 16) = a;
        if (lane == 0) { wsort[pos] = w; sag[pos] = sc; }
    }
}

__device__ __forceinline__ void ph_ln(const KP& p, LAS unsigned char* lds, int l, int which, int tid, int wave, int gw, int NGW, int lane) {
    const float* modv = (const float*)(OWS + WS_MODV); float* X = (float*)(OWS + WS_X); bf16* H = (bf16*)(OWS + WS_H);
    const bf16* BR = (const bf16*)(OWS + (which == 0 ? WS_MIXO : WS_F)); const float* BP = (const float*)(OWS + (which == 0 ? WS_MIXP : WS_FP));
    const float* lg = PIN(which == 0 ? I_LN1G : I_LN2G) + l * D; const float* lb = PIN(which == 0 ? I_LN1B : I_LN2B) + l * D;
    const bool moe = (which == 0) && (l & 1); const bool last = (which == 1) && (l == DEPTH - 1); const bool moe_out = (which == 1) && (l & 1);
    LAS int* lcnt = (LAS int*)lds;
    LAS int* lsel = (LAS int*)(lds + 64);
    int nloc = 0;
    if (moe) { if (tid < 16) lcnt[tid] = 0; __syncthreads(); }
    int pbs[9]; pbs[0] = 0;
    if (moe_out) { const unsigned* gcnt = (const unsigned*)(OWS + WS_CTL) + CW_GCNT + 64 * (l >> 1);
#pragma unroll
        for (int e = 0; e < 8; ++e) pbs[e + 1] = pbs[e] + (int)((gcnt[e] + 255u) & ~255u); }
    f32x4 gt[4], g4[4], b4[4], sh[4], sc[4]; ld_row(lg, lane, g4); ld_row(lb, lane, b4);
#pragma unroll 2
    for (int it = 0; it < 9; ++it) {
        if (it == 8 && (gw >= NCTX || l == DEPTH - 1)) break;
        const int row = it < 8 ? (gw >> 9) * SEQ + (gw & 511) + 512 * it : NLAT + gw;
        const int mr = mod_row(row); const float* mv = modv + (size_t)(l * 5 + mr) * NMOD;
        if (it == 0 || it == 8) { ld_row(mv + (which == 0 ? 2048 : 5120), lane, gt);
            if (!last) { const float* mv2 = which == 0 ? mv + 3072 : modv + (size_t)((l + 1) * 5 + mr) * NMOD; ld_row(mv2, lane, sh); ld_row(mv2 + 1024, lane, sc); } }
        f32x4 x[4], br[4], t[4]; ld_row(l == 0 && which == 0 ? (row < NLAT ? PIN(I_X) + (size_t)row * D : PIN(I_CTX) + (size_t)(row - NLAT) * D) : X + (size_t)row * D, lane, x);
        if (moe_out) { const int* ts = (const int*)(OWS + WS_TOKSEL) + row * 4; const int e0 = ts[0], r0 = ts[1], e1 = ts[2], r1 = ts[3]; int b0 = 0, b1 = 0;
#pragma unroll
            for (int k = 1; k < 8; ++k) { if (e0 >= k) b0 = pbs[k]; if (e1 >= k) b1 = pbs[k]; }
            f32x4 ba[4], bb[4]; const int q0 = b0 + r0, q1 = b1 + r1; constexpr int MM = MOE_MAIN_PANELS * 256;
            if (q0 < MM) ld_row_bf16(BR + (size_t)q0 * D, lane, ba); else ld_row_parts<4>(BP + (size_t)(q0 - MM) * D, (size_t)MOE_TAIL_ROWS * D, lane, ba);
            if (q1 < MM) ld_row_bf16(BR + (size_t)q1 * D, lane, bb); else ld_row_parts<4>(BP + (size_t)(q1 - MM) * D, (size_t)MOE_TAIL_ROWS * D, lane, bb);
#pragma unroll
            for (int j = 0; j < 4; ++j) br[j] = ba[j] + bb[j]; }
        else if (row < NLAT) ld_row_bf16(BR + (size_t)row * D, lane, br);
        else if (which == 0) ld_row_parts<2>(BP + (size_t)(row - NLAT) * D, (size_t)NCTX * D, lane, br);
        else ld_row_parts<7>(BP + (size_t)(row - NLAT) * D, (size_t)NCTX * D, lane, br);
        float s = 0.f;
#pragma unroll
        for (int j = 0; j < 4; ++j) { t[j] = DN_ALPHA * x[j] + gt[j] * br[j]; s += (t[j][0] + t[j][1]) + (t[j][2] + t[j][3]); }
        const float mean = wave_sum(s) * (1.f / D); float s2 = 0.f;
#pragma unroll
        for (int j = 0; j < 4; ++j) { t[j] = t[j] - mean; s2 += (t[j][0] * t[j][0] + t[j][1] * t[j][1]) + (t[j][2] * t[j][2] + t[j][3] * t[j][3]); }
        const float rstd = 1.f / sqrtf(wave_sum(s2) * (1.f / D) + LN_EPS);
#pragma unroll
        for (int j = 0; j < 4; ++j) x[j] = t[j] * rstd * g4[j] + b4[j];
        if (last) {
#if PROBE_DUP & (128 | 256)
            { const unsigned* cw = (const unsigned*)(OWS + WS_CTL); const float cval = 10.f * ((float)cw[20001] / 1024.f) / fmaxf((float)cw[20000], 1.f);
#pragma unroll
              for (int j = 0; j < 4; ++j) x[j] = (f32x4){cval, cval, cval, cval}; }
#endif
            if (row < NLAT) st_row(p.out + (size_t)row * D, lane, x); continue; }
        st_row(X + (size_t)row * D, lane, x);
        f32x4 hh[4];
#pragma unroll
        for (int j = 0; j < 4; ++j) hh[j] = x[j] * (1.f + sc[j]) + sh[j];
        st_row_q8(OWS + WS_H8, (float*)(OWS + WS_SA), row, lane, hh);
        if (moe) {
            const float* rw = PIN(I_RTW) + (size_t)(l >> 1) * D * NE; float lgt[8];
#pragma unroll
            for (int e = 0; e < 8; ++e) lgt[e] = 0.f;
#pragma unroll
            for (int j = 0; j < 4; ++j)
#pragma unroll
                for (int i = 0; i < 4; ++i) { const f32x4* wp = (const f32x4*)(rw + (size_t)(4 * lane + 256 * j + i) * NE); const f32x4 w0 = wp[0], w1 = wp[1]; const float hv = hh[j][i];
                    lgt[0] += hv * w0[0]; lgt[1] += hv * w0[1]; lgt[2] += hv * w0[2]; lgt[3] += hv * w0[3]; lgt[4] += hv * w1[0]; lgt[5] += hv * w1[1]; lgt[6] += hv * w1[2]; lgt[7] += hv * w1[3]; }
#pragma unroll
            for (int e = 0; e < 8; ++e) lgt[e] = wave_sum(lgt[e]) + PIN(I_RTB)[(l >> 1) * NE + e];
            float v0 = lgt[0]; int i0 = 0;
#pragma unroll
            for (int e = 1; e < 8; ++e) if (lgt[e] > v0) { v0 = lgt[e]; i0 = e; }
            float v1 = -3.0e38f; int i1 = -1;
#pragma unroll
            for (int e = 0; e < 8; ++e) if (e != i0 && lgt[e] > v1) { v1 = lgt[e]; i1 = e; }
            const float w0 = 1.f / (1.f + expf(v1 - v0)), w1 = 1.f - w0;
            if (lane == 0) { const int lr0 = __hip_atomic_fetch_add(lcnt + i0, 1, __ATOMIC_RELAXED, __HIP_MEMORY_SCOPE_WORKGROUP), lr1 = __hip_atomic_fetch_add(lcnt + i1, 1, __ATOMIC_RELAXED, __HIP_MEMORY_SCOPE_WORKGROUP); const int li = nloc * NWAVES + wave;
                lsel[li * 8 + 0] = row; lsel[li * 8 + 1] = i0; lsel[li * 8 + 2] = lr0; lsel[li * 8 + 3] = i1; lsel[li * 8 + 4] = lr1;
                ((float*)(OWS + WS_WSEL))[row * 2] = w0; ((float*)(OWS + WS_WSEL))[row * 2 + 1] = w1; }
            ++nloc;
        }
    }
    if (moe) {
        __syncthreads();
        unsigned* gcnt = (unsigned*)(OWS + WS_CTL) + CW_GCNT + 64 * (l >> 1);
        if (tid < 8) lcnt[8 + tid] = (int)__hip_atomic_fetch_add(gcnt + tid, (unsigned)lcnt[tid], __ATOMIC_RELAXED, __HIP_MEMORY_SCOPE_AGENT);
        __syncthreads();
        unsigned* rowlist = (unsigned*)(OWS + WS_ROWLIST); int* toksel = (int*)(OWS + WS_TOKSEL);
        if (tid < 16 * NWAVES) { const int k = tid / NWAVES, w = tid % NWAVES; if (k < 8 || (k == 8 && (int)blockIdx.x * NWAVES + w < NCTX && l != DEPTH - 1)) { const int li = k * NWAVES + w;
            const int row = lsel[li * 8 + 0], e0 = lsel[li * 8 + 1], r0 = lcnt[8 + e0] + lsel[li * 8 + 2], e1 = lsel[li * 8 + 3], r1 = lcnt[8 + e1] + lsel[li * 8 + 4];
            rowlist[(size_t)e0 * MROWS + r0] = (unsigned)row * 2u; rowlist[(size_t)e1 * MROWS + r1] = (unsigned)row * 2u + 1u;
            toksel[row * 4 + 0] = e0; toksel[row * 4 + 1] = r0; toksel[row * 4 + 2] = e1; toksel[row * 4 + 3] = r1; } }
    }
}


#ifndef PROBE_WHICH
#define PROBE_WHICH(x, y) (x)
#endif
#if PROBE_DUP & 128
__device__ __forceinline__ void ph_check_up(const KP& p, int gw, int lane) {
    if (gw >= 64) return;
    const float* X = (const float*)(OWS + WS_X); const float* modv = (const float*)(OWS + WS_MODV); const bf16* ACT = (const bf16*)(OWS + WS_ACT);
    const int row = gw * 257, c = lane * 56 + (gw & 7), mr = mod_row(row); const float* mv = modv + (size_t)(0 * 5 + mr) * NMOD;
    const signed char* H8 = (const signed char*)(OWS + WS_H8); const signed char* W8 = (const signed char*)(OWS + WS_F13); const float* SA = (const float*)(OWS + WS_SA); const unsigned* AM = (const unsigned*)(OWS + WS_AMAX);
    const int j1 = 8 * (c >> 2) + (c & 3), j3 = j1 + 4; int ia = 0, ib = 0;
    for (int k = 0; k < D; ++k) { const int h = H8[(size_t)row * D + k]; ia += h * W8[(size_t)j1 * D + k]; ib += h * W8[(size_t)j3 * D + k]; }
    const float a = (float)ia * SA[row] * __builtin_bit_cast(float, AM[j1]) * (1.f / 127.f), b = (float)ib * SA[row] * __builtin_bit_cast(float, AM[j3]) * (1.f / 127.f);
    (void)X; (void)mv;
    const float ref = a / (1.f + expf(-a)) * b, got = bf2f(ACT[(size_t)row * DFF + c]);
    const float da = ((const float*)(OWS + WS_F))[(size_t)row * DFF + c], db = ((const float*)(OWS + WS_F))[(size_t)4096 * DFF + (size_t)row * DFF + c]; (void)got; (void)db;
    if (row < 4096 && abs(ia) > 1000) { const float ratio = 10.f * fminf(fabsf(PROBE_WHICH(da / a, db / b) - 1.f), 0.4f);
        __hip_atomic_fetch_add((unsigned*)(OWS + WS_CTL) + 20000, 1u, __ATOMIC_RELAXED, __HIP_MEMORY_SCOPE_AGENT); __hip_atomic_fetch_add((unsigned*)(OWS + WS_CTL) + 20001, (unsigned)(ratio * 1024.f), __ATOMIC_RELAXED, __HIP_MEMORY_SCOPE_AGENT); }
}
#endif

#if PROBE_DUP & 256
__device__ __forceinline__ void ph_check_mfma(const KP& p, int lane) {
    typedef int i32x4 __attribute__((ext_vector_type(4)));
    const int r = lane & 15, g = lane >> 4; unsigned aw[4], bw[4];
#pragma unroll
    for (int q = 0; q < 4; ++q) { unsigned a = 0, b = 0;
#pragma unroll
        for (int t = 0; t < 4; ++t) { const int k = 16 * g + 4 * q + t; const int av = ((r * 7 + k * 3) % 5) - 2, bv = ((r * 5 + k * 11) % 7) - 3; a |= (unsigned)(av & 255) << (8 * t); b |= (unsigned)(bv & 255) << (8 * t); }
        aw[q] = a; bw[q] = b; }
    i32x4 c = {0, 0, 0, 0};
    c = __builtin_amdgcn_mfma_i32_16x16x64_i8((i32x4){(int)aw[0], (int)aw[1], (int)aw[2], (int)aw[3]}, (i32x4){(int)bw[0], (int)bw[1], (int)bw[2], (int)bw[3]}, c, 0, 0, 0);
    bool bad = false;
#pragma unroll
    for (int reg = 0; reg < 4; ++reg) { const int i = 4 * g + reg, j = r; int e = 0;
        for (int k = 0; k < 64; ++k) e += (((i * 7 + k * 3) % 5) - 2) * (((j * 5 + k * 11) % 7) - 3);
        if (c[reg] != e) bad = true; }
    if (bad) __hip_atomic_fetch_add((unsigned*)(OWS + WS_CTL) + 20000, 1000u, __ATOMIC_RELAXED, __HIP_MEMORY_SCOPE_AGENT);
}
#endif
__global__ void __launch_bounds__(NWAVES * 64, 2) fwd_kernel(KP p) {
    extern __shared__ __attribute__((aligned(16))) unsigned char lds_raw[];
    LAS unsigned char* lds = (LAS unsigned char*)lds_raw;
    volatile LAS unsigned* MISC = (volatile LAS unsigned*)(lds + MISC_OFF);
    const int G = gridDim.x, NGW = G * NWAVES;
    for (int u = threadIdx.x; u < (LDS_BYTES - LDSCTL_OFF) / 4; u += NWAVES * 64) ((LAS unsigned*)(lds + LDSCTL_OFF))[u] = 0u;
    __syncthreads();
    unsigned* ctl = (unsigned*)(OWS + WS_CTL);
    const bool single = p.ph < 0;
    XcdBarrier bar; bar.bar = ctl + CW_BAR; bar.x = 0; bar.st = nullptr;
    if (single) bar = xcd_barrier_post(ctl + CW_BAR, MISC + 8);
    int phc = 0;
#ifndef PROBE_DUP
#define PROBE_DUP 0
#endif
#define REP(bit) for (int rep_ = 0; rep_ < ((PROBE_DUP & (bit)) ? 2 : 1); ++rep_)
#define RUN() (single || p.ph == phc)
#define FRESH() int tid = threadIdx.x; asm volatile("" : "+v"(tid)); const int lane = tid & 63, wave = __builtin_amdgcn_readfirstlane(tid >> 6), gw = blockIdx.x * NWAVES + wave; (void)lane; (void)gw
#define SEAM() do { if (single) { XcdBarrier b2_ = bar; asm volatile("" : "+s"(b2_.bar)); xcd_barrier(b2_); if (PROBE_DUP & 32) { XcdBarrier b3_ = bar; asm volatile("" : "+s"(b3_.bar)); xcd_barrier(b3_); } } ++phc; } while (0)

    REP(4) if (RUN()) { FRESH(); ph_modvec(p, lds, tid); __syncthreads(); ph_convert(p, lds, gw, NGW, wave, lane); cq_static(p, lds, 3 * CQ_IN + 3 * CQ_OUT + 2 * CQ_UP, CQ_J1, gw, NGW, wave, lane); ph_amax(p, gw, NGW, lane); }
    SEAM();
#if PROBE_DUP & 256
    if (blockIdx.x == 0 && threadIdx.x < 64) ph_check_mfma(p, threadIdx.x);
#endif
    if (RUN()) { FRESH(); ph_init_rows(p, gw, NGW, lane); cq_static(p, lds, -CQ_NEG, 3 * CQ_IN + 3 * CQ_OUT + 2 * CQ_UP, gw, NGW, wave, lane); }
    SEAM();
    for (int ll = 0; ll < DEPTH; ++ll) {
#define l (ll + opaque_zero_i())
         if (RUN()) { pg8::Gemm g{(const bf16*)(OWS + WS_H8), (const bf16*)(OWS + WS_WIN) + (size_t)l * (NP * D / 2), MROWS, NP, D / 2, D / 2}; pg8::StaticOrder S; S.init(MROWS, NP, G, (int)blockIdx.x);
            pg8::EpiBf16S8 E{(bf16*)(OWS + WS_P), NP, (const float*)(OWS + WS_SA), (const float*)(OWS + WS_AMAX) + AM_IN + l * NP}; pg8::gemm_phase<pg8::EpiBf16S8, pg8::StaticOrder, true, true, true>(lds, g, S, E); }
        SEAM();
        REP(8) if (RUN()) { FRESH(); ph_lora(p, l, gw, NGW, lane); }
        SEAM();
        REP(1) if (RUN()) { FRESH(); ph_scan1(p, l, gw, NGW, lane); }
        SEAM();
        REP(2) if (RUN()) { FRESH(); ph_scan2(p, lds, l, wave, lane); }
        SEAM();
        REP(64) if (RUN()) { FRESH(); ph_readout2(p, l, gw, NGW, lane); }
        SEAM();
         if (RUN()) {
            { pg8::Gemm g{(const bf16*)(OWS + WS_MIXIN), (const bf16*)(OWS + WS_WOUT) + (size_t)l * (D * D / 2), NLAT, D, D / 2, D / 2}; pg8::StaticOrder S; S.init(NLAT, D, G, (int)blockIdx.x);
              pg8::EpiBf16S8 E{(bf16*)(OWS + WS_MIXO), D, (const float*)(OWS + WS_SAM), (const float*)(OWS + WS_AMAX) + AM_OUT + l * D}; pg8::gemm_phase<pg8::EpiBf16S8, pg8::StaticOrder, true, true, true>(lds, g, S, E); }
            if (ll < DEPTH - 1) { pg8::Gemm g{(const bf16*)(OWS + WS_MIXIN), (const bf16*)(OWS + WS_WOUT) + (size_t)l * (D * D / 2), NCTX, D, D / 4, D / 2}; pg8::SplitOrder S{NCTX / 256, D / 256, 2, G, (int)blockIdx.x, NLAT / 256, 0, 0, 0, 0, 0, 0, 0, 0};
              pg8::EpiPartS8 E{(float*)(OWS + WS_MIXP), D, (size_t)NCTX * D, NLAT / 256, (const float*)(OWS + WS_SAM), (const float*)(OWS + WS_AMAX) + AM_OUT + l * D}; pg8::gemm_phase<pg8::EpiPartS8, pg8::SplitOrder, true, true, true>(lds, g, S, E); }
        }
        SEAM();
        for (int rep2_ = 0; rep2_ < (((PROBE_DUP & 512) && ll == 0) ? 5 : 1); ++rep2_) if (RUN()) { FRESH(); ph_ln(p, lds, l, 0, tid, wave, gw, NGW, lane); if (ll & 1) { __syncthreads(); cq_static(p, lds, (l == 1 ? CQ_J1 : CQ_END0) + 2 * CQ_SLOT_ITEMS, l == 1 ? CQ_END0 : CQ_END1, gw, NGW, wave, lane); } }
        SEAM();
        if ((l & 1) == 0) {
            const int fi = l >> 1;
             if (RUN()) { pg8::Gemm g{(const bf16*)(OWS + WS_H8), (const bf16*)(OWS + WS_F13) + (size_t)fi * DFF * D, MROWS, 2 * DFF, D / 2, D / 2}; pg8::StaticOrder S; S.init(MROWS, 2 * DFF, G, (int)blockIdx.x);
                constexpr int NOE = 0x7fffffff; pg8::EpiSwiGLU8 E{(bf16*)(OWS + WS_ACT), DFF, nullptr, (const float*)(OWS + WS_SA), (const unsigned*)(OWS + WS_AMAX) + (size_t)fi * 2 * DFF, NOE, NOE, NOE, NOE, NOE, NOE, NOE};
#if PROBE_DUP & 128
                E.dbg = (int*)(OWS + WS_F);
#endif
                pg8::gemm_phase<pg8::EpiSwiGLU8, pg8::StaticOrder, true, true, true>(lds, g, S, E); }
            SEAM();
#if PROBE_DUP & 128
            if (ll == 0) { if (RUN()) { FRESH(); ph_check_up(p, gw, lane); } SEAM(); }
#endif
             if (RUN()) {
                { pg8::Gemm g{(const bf16*)(OWS + WS_ACT), (const bf16*)(OWS + WS_F2) + (size_t)fi * D * DFF, NLAT, D, DFF, DFF}; pg8::StaticOrder S; S.init(NLAT, D, G, (int)blockIdx.x);
                  pg8::EpiBf16<0> E{(bf16*)(OWS + WS_F), D, nullptr, 0, 0, 1.f}; pg8::gemm_phase<pg8::EpiBf16<0>, pg8::StaticOrder, true, true>(lds, g, S, E); }
                { pg8::Gemm g{(const bf16*)(OWS + WS_ACT), (const bf16*)(OWS + WS_F2) + (size_t)fi * D * DFF, NCTX, D, DFF / 7, DFF}; pg8::SplitOrder S{NCTX / 256, D / 256, 7, G, (int)blockIdx.x, NLAT / 256, 0, 0, 0, 0, 0, 0, 0, 0};
                  pg8::EpiPart E{(float*)(OWS + WS_FP), D, (size_t)NCTX * D, NLAT / 256}; pg8::gemm_phase<pg8::EpiPart, pg8::SplitOrder, true, true>(lds, g, S, E); }
            }
            SEAM();
        } else {
            if (RUN()) { FRESH(); ph_moe_gather(p, l, gw, NGW, lane); }
            SEAM();
            {   const unsigned* gcnt = (const unsigned*)(OWS + WS_CTL) + CW_GCNT + 64 * (l >> 1); int pbp[9]; pbp[0] = 0;
#pragma unroll
                for (int e = 0; e < 8; ++e) pbp[e + 1] = pbp[e] + (int)((gcnt[e] + 255u) >> 8);
                const int mrows = pbp[8] * 256;
                 if (RUN()) { pg8::Gemm g{(const bf16*)(OWS + WS_HG), (const bf16*)(OWS + WS_MOEW13), mrows, 2 * DFF, D / 2, D / 2}; pg8::MoeOrder S; S.init(mrows, 2 * DFF, G, (int)blockIdx.x);
                    S.pb1 = pbp[1]; S.pb2 = pbp[2]; S.pb3 = pbp[3]; S.pb4 = pbp[4]; S.pb5 = pbp[5]; S.pb6 = pbp[6]; S.pb7 = pbp[7]; S.estride = (size_t)DFF * D;
                    pg8::EpiSwiGLU8 E{(bf16*)(OWS + WS_ACT), DFF, (const float*)(OWS + WS_WSORT), (const float*)(OWS + WS_SAG), (const unsigned*)(OWS + WS_AMAX) + (size_t)(2 + 8 * (l >> 1)) * 2 * DFF, pbp[1], pbp[2], pbp[3], pbp[4], pbp[5], pbp[6], pbp[7]};
                    pg8::gemm_phase<pg8::EpiSwiGLU8, pg8::MoeOrder, true, true, true>(lds, g, S, E); }
                SEAM();
                 if (RUN()) {
                    { pg8::Gemm g{(const bf16*)(OWS + WS_ACT), (const bf16*)(OWS + WS_MOEW2), MOE_MAIN_PANELS * 256, D, DFF, DFF}; pg8::MoeOrder S; S.init(MOE_MAIN_PANELS * 256, D, G, (int)blockIdx.x);
                      S.pb1 = pbp[1]; S.pb2 = pbp[2]; S.pb3 = pbp[3]; S.pb4 = pbp[4]; S.pb5 = pbp[5]; S.pb6 = pbp[6]; S.pb7 = pbp[7]; S.estride = (size_t)D * DFF;
                      pg8::EpiBf16<0> E{(bf16*)(OWS + WS_F), D, nullptr, 0, 0, 1.f}; pg8::gemm_phase<pg8::EpiBf16<0>, pg8::MoeOrder, true, true>(lds, g, S, E); }
                    { const int nT = pbp[8] - MOE_MAIN_PANELS;
                      pg8::Gemm g{(const bf16*)(OWS + WS_ACT), (const bf16*)(OWS + WS_MOEW2), nT * 256, D, DFF / 4, DFF}; pg8::SplitOrder S{nT, D / 256, 4, G, (int)blockIdx.x, MOE_MAIN_PANELS, pbp[1], pbp[2], pbp[3], pbp[4], pbp[5], pbp[6], pbp[7], (size_t)D * DFF};
                      pg8::EpiPart E{(float*)(OWS + WS_FP), D, (size_t)MOE_TAIL_ROWS * D, MOE_MAIN_PANELS}; pg8::gemm_phase<pg8::EpiPart, pg8::SplitOrder, true, true>(lds, g, S, E); }
                }
                SEAM();
            }
        }
        if (RUN()) { FRESH(); ph_ln(p, lds, l, 1, tid, wave, gw, NGW, lane); }
        SEAM();
    }
#undef l
#undef RUN
#undef SEAM
}

#ifndef MK_PER_PHASE
#define MK_PER_PHASE 0
#endif
extern "C" void kernel_launch(void* const* d_in, const int* in_sizes, int n_in, void* d_out, int out_size, void* d_ws, size_t ws_size, hipStream_t stream) {
    static int grid = 0;
    if (grid == 0) {
        if (n_in != N_IN || in_sizes[0] != NLAT * D || out_size != NLAT * D || ws_size < WS_NEED) { fprintf(stderr, "kernel_launch: unexpected shapes / workspace (%d inputs, ws %zu, need %zu)\n", n_in, ws_size, (size_t)WS_NEED); grid = -1; return; }
        int dev = 0, cus = 0, per_cu = 0;
        if (hipGetDevice(&dev) != hipSuccess || hipDeviceGetAttribute(&cus, hipDeviceAttributeMultiprocessorCount, dev) != hipSuccess) { grid = -1; return; }
        if (hipFuncSetAttribute((const void*)fwd_kernel, hipFuncAttributeMaxDynamicSharedMemorySize, LDS_BYTES) != hipSuccess) { fprintf(stderr, "kernel_launch: hipFuncSetAttribute failed\n"); grid = -1; return; }
        if (hipOccupancyMaxActiveBlocksPerMultiprocessor(&per_cu, (const void*)fwd_kernel, NWAVES * 64, LDS_BYTES) != hipSuccess || per_cu < 1) fprintf(stderr, "kernel_launch: occupancy query says %d\n", per_cu);
        (void)hipGetLastError();
        grid = cus;
        if (grid != 256) { fprintf(stderr, "kernel_launch: built for a 256-CU device, found %d CUs\n", cus); grid = -1; return; }
    }
    if (grid < 0) return;
    if (hipMemsetAsync((char*)d_ws + WS_CTL, 0, CTL_BYTES, stream) != hipSuccess) return;
    KP p{};
    for (int i = 0; i < N_IN; ++i) p.in[i] = (const float*)d_in[i];
    p.out = (float*)d_out; p.ws = (unsigned char*)d_ws; p.pad = 0;
#if MK_PER_PHASE
    const int nph = 2 + 2 * 11 + 2 * 13;
    for (int ph = 0; ph < nph; ++ph) { p.ph = ph; hipLaunchKernelGGL(fwd_kernel, dim3(grid), dim3(NWAVES * 64), LDS_BYTES, stream, p); }
#else
    p.ph = -1;
    hipLaunchKernelGGL(fwd_kernel, dim3(grid), dim3(NWAVES * 64), LDS_BYTES, stream, p);
#endif
}
```

```cpp
#include <hip/hip_runtime.h>
#define PROBE_DUP 0
#define CQ_SLOT_WGS 0
#define CQ_SLOT_ITEMS 3500
#include <cstdio>
#include <cstdint>
namespace pg8 {
#define PG8_LAS __attribute__((address_space(3)))
typedef unsigned short bf16_t;
typedef short bf16x8 __attribute__((ext_vector_type(8)));
typedef float f32x4 __attribute__((ext_vector_type(4)));
typedef unsigned u32x4 __attribute__((ext_vector_type(4)));
constexpr int BM = 256, BK = 64, HALF = 128, HTB = HALF * BK * 2  , STAGE_BYTES = 8 * HTB, NXCD = 8, WGM = 8;

__host__ __device__ __forceinline__ int lds_byte(int r, int c) { const int st = (r >> 4) * 2 + (c >> 5), rr = r & 15, cc = c & 31, ob = rr * 64 + cc * 2; return st * 1024 + (ob ^ (((ob >> 9) & 1) << 5)); }
__host__ __device__ __forceinline__ void stage_rc(int b, int& R, int& C) { const int st = b / 1024, sb = b % 1024, swz = sb ^ (((sb >> 9) & 1) << 5); R = (st >> 1) * 16 + swz / 64; C = (st & 1) * 32 + (swz % 64) / 2; }
__host__ __device__ __forceinline__ int perm32(int rho) { const int n = rho >> 4, i = rho & 15; return 8 * (i >> 2) + 4 * n + (i & 3); }

struct Unit { int pm, pn, ks; };
struct Gemm { const bf16_t* A; const bf16_t* Bt; int M, N, K, ld; };

struct StaticOrder {
    int nM, nN, nwg, G, c;
    __host__ __device__ void init(int M, int N, int G_, int c_) { nM = M / BM; nN = N / BM; nwg = nM * nN; G = G_; c = c_; }
    __host__ __device__ bool next(int i, Unit& u) const {
        const long L = (long)i * G + c; if (L >= nwg) return false;
        int wgid = (int)L; { const int q = nwg / NXCD, r = nwg % NXCD, xcd = wgid % NXCD, off = wgid / NXCD; wgid = (xcd < r ? xcd * (q + 1) : r * (q + 1) + (xcd - r) * q) + off; }
        const int nig = WGM * nN, gid = wgid / nig, fm = gid * WGM, gsz = (nM - fm) < WGM ? (nM - fm) : WGM;
        u.pm = fm + ((wgid % nig) % gsz); u.pn = (wgid % nig) / gsz; u.ks = 0; return true;
    }
    __device__ __forceinline__ const char* abase(const Gemm& g, const Unit& u, size_t tstep) const { return (const char*)g.A + (size_t)u.pm * tstep; }
    __device__ __forceinline__ const char* bbase(const Gemm& g, const Unit& u, size_t tstep) const { return (const char*)g.Bt + (size_t)u.pn * tstep; }
    __device__ __forceinline__ void a_ready(const Unit&) const {}
    __device__ __forceinline__ void done(const Unit&) const {}
};

__device__ __forceinline__ unsigned cvt_pk_bf16(float lo, float hi) { unsigned r; asm volatile("v_cvt_pk_bf16_f32 %0, %1, %2" : "=v"(r) : "v"(lo), "v"(hi)); return r; }
typedef float f32x2 __attribute__((ext_vector_type(2)));
__device__ __forceinline__ f32x2 gelu_pk(f32x2 v) {
    const f32x2 av = __builtin_elementwise_abs(v), d = av * 0.2316418882f + 1.0f;
    f32x2 t; t.x = __builtin_amdgcn_rcpf(d.x); t.y = __builtin_amdgcn_rcpf(d.y);
    f32x2 q = t * 0.5307027145f + (-0.7265760135f); q = q * t + 0.7107068705f; q = q * t + (-0.142248368f); q = q * t + 0.127414796f; q = q * t;
    const f32x2 s = (v * v) * (-0.72134752044f);
    f32x2 e; e.x = __builtin_amdgcn_exp2f(s.x); e.y = __builtin_amdgcn_exp2f(s.y);
    const f32x2 m = v * (q * e), r = v - m;
    f32x2 o; o.x = v.x < 0.f ? m.x : r.x; o.y = v.y < 0.f ? m.y : r.y; return o;
}

template <int ACT  > struct EpiBf16 {
    static constexpr bool PERM = true, AFTER_DRAIN = false; static_assert(ACT == 0 || ACT == 1, "EpiBf16: ACT is 0 (none) or 1 (gelu_pk)");
    bf16_t* O; int ldc; const float* bias; int split_cols; size_t split_stride; float scale0;
    __device__ __forceinline__ void operator()(const f32x4 (&acc)[2][2][4][2], const Unit& u, int wr, int wc, int fr, int fq) const {
        asm volatile("" : "+v"(fr), "+v"(fq));
        const int row0 = u.pm * BM + wr * 64 + fr; int colt = u.pn * BM; bf16_t* base = O;
        float sc = 1.f; if (split_cols) { const int t = colt / split_cols; base += (size_t)t * split_stride; colt -= t * split_cols; if (t == 0) sc = scale0; }
        const int col0 = colt + wc * 32 + 8 * fq, bcol0 = u.pn * BM + wc * 32 + 8 * fq;
        f32x4 bv[2][2];
#pragma unroll
        for (int bj = 0; bj < 2; ++bj)
#pragma unroll
            for (int n = 0; n < 2; ++n) bv[bj][n] = bias ? *(const f32x4*)(bias + bcol0 + bj * HALF + 4 * n) : (f32x4){0.f, 0.f, 0.f, 0.f};
#pragma unroll
        for (int ai = 0; ai < 2; ++ai)
#pragma unroll
            for (int m = 0; m < 4; ++m) { bf16_t* rowp = base + (size_t)(row0 + ai * HALF + m * 16) * ldc + col0;
#pragma unroll
                for (int bj = 0; bj < 2; ++bj) { f32x4 v0 = acc[ai][bj][m][0] + bv[bj][0], v1 = acc[ai][bj][m][1] + bv[bj][1];
                    if (ACT == 1) { f32x2 a = gelu_pk((f32x2){v0[0], v0[1]}), b = gelu_pk((f32x2){v0[2], v0[3]}), c = gelu_pk((f32x2){v1[0], v1[1]}), d = gelu_pk((f32x2){v1[2], v1[3]});
                        v0 = (f32x4){a.x, a.y, b.x, b.y}; v1 = (f32x4){c.x, c.y, d.x, d.y}; }
                    v0 = v0 * sc; v1 = v1 * sc; u32x4 w; w.x = cvt_pk_bf16(v0[0], v0[1]); w.y = cvt_pk_bf16(v0[2], v0[3]); w.z = cvt_pk_bf16(v1[0], v1[1]); w.w = cvt_pk_bf16(v1[2], v1[3]);
                    *(u32x4*)(rowp + bj * HALF) = w; } }
    }
};
typedef int i32x4 __attribute__((ext_vector_type(4)));
template <bool I8> __device__ __forceinline__ f32x4 mma16(bf16x8 b, bf16x8 a, f32x4 c) { return __builtin_amdgcn_mfma_f32_16x16x32_bf16(b, a, c, 0, 0, 0); }
template <bool I8> __device__ __forceinline__ i32x4 mma16(bf16x8 b, bf16x8 a, i32x4 c) { return __builtin_amdgcn_mfma_i32_16x16x64_i8(__builtin_bit_cast(i32x4, b), __builtin_bit_cast(i32x4, a), c, 0, 0, 0); }
struct EpiF32 {
    static constexpr bool PERM = false, AFTER_DRAIN = false;
    float* C; int ldc; int accum;
    __device__ __forceinline__ void operator()(const f32x4 (&acc)[2][2][4][2], const Unit& u, int wr, int wc, int fr, int fq) const {
        asm volatile("" : "+v"(fr), "+v"(fq));
        const int row0 = u.pm * BM + wr * 64 + fr, col0 = u.pn * BM + wc * 32 + 4 * fq;
#pragma unroll
        for (int ai = 0; ai < 2; ++ai)
#pragma unroll
            for (int m = 0; m < 4; ++m) { float* rowp = C + (size_t)(row0 + ai * HALF + m * 16) * ldc + col0;
#pragma unroll
                for (int bj = 0; bj < 2; ++bj)
#pragma unroll
                    for (int n = 0; n < 2; ++n) { f32x4 v = acc[ai][bj][m][n]; if (accum) v += *(const f32x4*)(rowp + bj * HALF + n * 16); *(f32x4*)(rowp + bj * HALF + n * 16) = v; } }
    }
};
struct EpiSwiGLU {
    static constexpr bool PERM = true, AFTER_DRAIN = false;
    bf16_t* O; int ldo; const float* rowscale; int rs_stride;
    __device__ __forceinline__ void operator()(const f32x4 (&acc)[2][2][4][2], const Unit& u, int wr, int wc, int fr, int fq) const {
        asm volatile("" : "+v"(fr), "+v"(fq));
        typedef unsigned u32x2v __attribute__((ext_vector_type(2)));
        const int row0 = u.pm * BM + wr * 64 + fr; const int ch0 = (u.pn * BM + wc * 32 + 8 * fq) >> 1;
#pragma unroll
        for (int ai = 0; ai < 2; ++ai)
#pragma unroll
            for (int m = 0; m < 4; ++m) { const int row = row0 + ai * HALF + m * 16; bf16_t* rowp = O + (size_t)row * ldo + ch0;
                const float rs = rowscale ? rowscale[(size_t)row * rs_stride] : 1.f;
#pragma unroll
                for (int bj = 0; bj < 2; ++bj) { const f32x4 a = acc[ai][bj][m][0], b = acc[ai][bj][m][1]; f32x4 o;
#pragma unroll
                    for (int i = 0; i < 4; ++i) o[i] = a[i] * __builtin_amdgcn_rcpf(1.f + __expf(-a[i])) * b[i] * rs;
                    u32x2v w; w.x = cvt_pk_bf16(o[0], o[1]); w.y = cvt_pk_bf16(o[2], o[3]);
                    *(u32x2v*)(rowp + bj * (HALF / 2)) = w; } }
    }
};

struct MoeOrder : StaticOrder {
    int pb1, pb2, pb3, pb4, pb5, pb6, pb7; size_t estride;
    __device__ __forceinline__ const char* bbase(const Gemm& g, const Unit& u, size_t tstep) const {
        const int e = (u.pm >= pb1) + (u.pm >= pb2) + (u.pm >= pb3) + (u.pm >= pb4) + (u.pm >= pb5) + (u.pm >= pb6) + (u.pm >= pb7);
        return (const char*)(g.Bt + (size_t)e * estride) + (size_t)u.pn * tstep; }
};
struct SplitOrder {
    int nM, nN, S, G, c, pm0; int pb1, pb2, pb3, pb4, pb5, pb6, pb7; size_t estride;
    __device__ __forceinline__ bool next(int i, Unit& u) const { const int L = i * G + c; if (L >= nM * nN * S) return false; u.ks = L % S; const int t = L / S; u.pn = t % nN; u.pm = pm0 + t / nN; return true; }
    __device__ __forceinline__ const char* abase(const Gemm& g, const Unit& u, size_t tstep) const { return (const char*)g.A + (size_t)u.pm * tstep + (size_t)u.ks * g.K * 2; }
    __device__ __forceinline__ const char* bbase(const Gemm& g, const Unit& u, size_t tstep) const {
        const int e = estride ? (u.pm >= pb1) + (u.pm >= pb2) + (u.pm >= pb3) + (u.pm >= pb4) + (u.pm >= pb5) + (u.pm >= pb6) + (u.pm >= pb7) : 0;
        return (const char*)(g.Bt + (size_t)e * estride) + (size_t)u.pn * tstep + (size_t)u.ks * g.K * 2; }
    __device__ __forceinline__ void a_ready(const Unit&) const {}
    __device__ __forceinline__ void done(const Unit&) const {}
};
struct EpiPart {
    static constexpr bool PERM = false, AFTER_DRAIN = false;
    float* C; int ldc; size_t pstride; int pm0;
    __device__ __forceinline__ void operator()(const f32x4 (&acc)[2][2][4][2], const Unit& u, int wr, int wc, int fr, int fq) const {
        asm volatile("" : "+v"(fr), "+v"(fq));
        const int row0 = (u.pm - pm0) * BM + wr * 64 + fr, col0 = u.pn * BM + wc * 32 + 4 * fq; float* base = C + (size_t)u.ks * pstride;
#pragma unroll
        for (int ai = 0; ai < 2; ++ai)
#pragma unroll
            for (int m = 0; m < 4; ++m) { float* rowp = base + (size_t)(row0 + ai * HALF + m * 16) * ldc + col0;
#pragma unroll
                for (int bj = 0; bj < 2; ++bj)
#pragma unroll
                    for (int n = 0; n < 2; ++n) *(f32x4*)(rowp + bj * HALF + n * 16) = acc[ai][bj][m][n]; }
    }
};

struct EpiSwiGLU8 {
    static constexpr bool PERM = true, AFTER_DRAIN = false;
    bf16_t* O; int ldo; const float* rowscale; const float* sa; const unsigned* amax; int pb1, pb2, pb3, pb4, pb5, pb6, pb7;
    __device__ __forceinline__ void operator()(const i32x4 (&acc)[2][2][4][2], const Unit& u, int wr, int wc, int fr, int fq) const {
        typedef unsigned u32x2v __attribute__((ext_vector_type(2))); typedef unsigned u32x4v __attribute__((ext_vector_type(4)));
        asm volatile("" : "+v"(fr), "+v"(fq));
        const int row0 = u.pm * BM + wr * 64 + fr; const int cb0 = u.pn * BM + wc * 32 + 8 * fq; const int ch0 = cb0 >> 1;
        const int e = (u.pm >= pb1) + (u.pm >= pb2) + (u.pm >= pb3) + (u.pm >= pb4) + (u.pm >= pb5) + (u.pm >= pb6) + (u.pm >= pb7);
        const unsigned* am = amax + (size_t)e * 2 * 3584 + cb0;
#pragma unroll
        for (int bj = 0; bj < 2; ++bj) {
            const float* amf = (const float*)am + bj * HALF;
            const f32x4 sb0 = *(const f32x4*)amf * (1.f / 127.f), sb1 = *(const f32x4*)(amf + 4) * (1.f / 127.f);
#pragma unroll
            for (int ai = 0; ai < 2; ++ai)
#pragma unroll
                for (int m = 0; m < 4; ++m) { const int row = row0 + ai * HALF + m * 16; bf16_t* rowp = O + (size_t)row * ldo + ch0 + bj * (HALF / 2);
                    const float sr = sa[row], rs = rowscale ? rowscale[row] : 1.f; f32x4 o;
#pragma unroll
                    for (int i = 0; i < 4; ++i) { const float a = (float)acc[ai][bj][m][0][i] * sr * sb0[i], b = (float)acc[ai][bj][m][1][i] * sr * sb1[i];
                        o[i] = a * __builtin_amdgcn_rcpf(1.f + __expf(-a)) * b * rs; }
                    u32x2v w; w.x = cvt_pk_bf16(o[0], o[1]); w.y = cvt_pk_bf16(o[2], o[3]);
                    *(u32x2v*)rowp = w;
#if PROBE_DUP & 128
                    if (dbg && row < 4096) { f32x4 av, bv;
#pragma unroll
                        for (int i = 0; i < 4; ++i) { av[i] = (float)acc[ai][bj][m][0][i] * sr * sb0[i]; bv[i] = (float)acc[ai][bj][m][1][i] * sr * sb1[i]; }
                        *(f32x4*)((float*)dbg + (size_t)row * ldo + (rowp - (O + (size_t)row * ldo))) = av; *(f32x4*)((float*)dbg + (size_t)4096 * ldo + (size_t)row * ldo + (rowp - (O + (size_t)row * ldo))) = bv; }
#endif
                    } }
    }
#if PROBE_DUP & 128
    int* dbg = nullptr;
#endif
};

struct EpiBf16S8 {
    static constexpr bool PERM = true, AFTER_DRAIN = false;
    bf16_t* O; int ldc; const float* sa; const float* amax;
    __device__ __forceinline__ void operator()(const i32x4 (&acc)[2][2][4][2], const Unit& u, int wr, int wc, int fr, int fq) const {
        asm volatile("" : "+v"(fr), "+v"(fq));
        const int row0 = u.pm * BM + wr * 64 + fr, col0 = u.pn * BM + wc * 32 + 8 * fq;
#pragma unroll
        for (int bj = 0; bj < 2; ++bj) { const f32x4 s0 = *(const f32x4*)(amax + col0 + bj * HALF) * (1.f / 127.f), s1 = *(const f32x4*)(amax + col0 + bj * HALF + 4) * (1.f / 127.f);
#pragma unroll
            for (int ai = 0; ai < 2; ++ai)
#pragma unroll
                for (int m = 0; m < 4; ++m) { const int row = row0 + ai * HALF + m * 16; const float sr = sa[row]; f32x4 v0, v1;
#pragma unroll
                    for (int i = 0; i < 4; ++i) { v0[i] = (float)acc[ai][bj][m][0][i] * sr * s0[i]; v1[i] = (float)acc[ai][bj][m][1][i] * sr * s1[i]; }
                    u32x4 w; w.x = cvt_pk_bf16(v0[0], v0[1]); w.y = cvt_pk_bf16(v0[2], v0[3]); w.z = cvt_pk_bf16(v1[0], v1[1]); w.w = cvt_pk_bf16(v1[2], v1[3]);
                    *(u32x4*)(O + (size_t)row * ldc + col0 + bj * HALF) = w; } }
    }
};
struct EpiPartS8 {
    static constexpr bool PERM = false, AFTER_DRAIN = false;
    float* C; int ldc; size_t pstride; int pm0; const float* sa; const float* amax;
    __device__ __forceinline__ void operator()(const i32x4 (&acc)[2][2][4][2], const Unit& u, int wr, int wc, int fr, int fq) const {
        asm volatile("" : "+v"(fr), "+v"(fq));
        const int row0 = (u.pm - pm0) * BM + wr * 64 + fr, col0 = u.pn * BM + wc * 32 + 4 * fq; float* base = C + (size_t)u.ks * pstride;
#pragma unroll
        for (int bj = 0; bj < 2; ++bj)
#pragma unroll
            for (int n = 0; n < 2; ++n) { const f32x4 sc = *(const f32x4*)(amax + col0 + bj * HALF + n * 16) * (1.f / 127.f);
#pragma unroll
                for (int ai = 0; ai < 2; ++ai)
#pragma unroll
                    for (int m = 0; m < 4; ++m) { const int rl = row0 + ai * HALF + m * 16; const float sr = sa[rl + pm0 * BM]; f32x4 v;
#pragma unroll
                        for (int i = 0; i < 4; ++i) v[i] = (float)acc[ai][bj][m][n][i] * sr * sc[i];
                        *(f32x4*)(base + (size_t)rl * ldc + col0 + bj * HALF + n * 16) = v; } }
    }
};
template <bool I8> struct AccSel { typedef f32x4 type; }; template <> struct AccSel<true> { typedef i32x4 type; };
template <class Epi, class Sched, bool ALIGN_EPI = false, bool SP2 = false, bool I8 = false>
__device__ __forceinline__ void gemm_phase(PG8_LAS unsigned char* lds, const Gemm g, const Sched& S, const Epi& E) {
    int tid_o = threadIdx.x; asm volatile("" : "+v"(tid_o));
    const int tid = tid_o, wid = __builtin_amdgcn_readfirstlane(tid >> 6), lane = tid & 63, wr = wid >> 2, wc = wid & 3, fr = lane & 15, fq = lane >> 4;
    const int K = g.K, nt = K / BK;
    unsigned voffA[2], voffB[2];
#pragma unroll
    for (int i = 0; i < 2; ++i) { int R, C; stage_rc(tid * 16 + i * 8192, R, C); const int Rb = Epi::PERM ? ((R & ~31) + perm32(R & 31)) : R;
        voffA[i] = (unsigned)(R * g.ld + C) * 2u; voffB[i] = (unsigned)(Rb * g.ld + C) * 2u; }
    const size_t kstep = (size_t)(BK * 2);
    const size_t hstep = (size_t)HALF * g.ld * 2;
    const size_t tstep = 2 * hstep;
    const unsigned ldsw = (unsigned)wid * 1024u;
    const int aoff = lds_byte(wr * 64 + fr, fq * 8), boff = lds_byte(wc * 32 + fr, fq * 8);
#define PG8_SA(b, h) (((b) * 2 + (h)) * HTB)
#define PG8_SB(b, h) ((4 + (b) * 2 + (h)) * HTB)
#define PG8_STAGE(bufoff, gbase, voff) do { _Pragma("unroll") for (int _i = 0; _i < 2; ++_i) \
        __builtin_amdgcn_global_load_lds((const unsigned*)((const char*)(gbase) + (voff)[_i]), (PG8_LAS unsigned*)(lds + (bufoff) + ldsw + _i * 8192), 16, 0, 0); } while (0)
#define PG8_LDA(dst, b, h) do { _Pragma("unroll") for (int m = 0; m < 4; ++m) _Pragma("unroll") for (int k = 0; k < 2; ++k) dst[m][k] = *(const PG8_LAS bf16x8*)(lds + PG8_SA(b, h) + aoff + m * 2048 + k * 1024); } while (0)
#define PG8_LDB(dst, b, h) do { _Pragma("unroll") for (int n = 0; n < 2; ++n) _Pragma("unroll") for (int k = 0; k < 2; ++k) dst[n][k] = *(const PG8_LAS bf16x8*)(lds + PG8_SB(b, h) + boff + n * 2048 + k * 1024); } while (0)
#define PG8_MMA(ai, bj, At, Bt) do { __builtin_amdgcn_s_setprio(1); _Pragma("unroll") for (int k = 0; k < 2; ++k) _Pragma("unroll") for (int m = 0; m < 4; ++m) _Pragma("unroll") for (int n = 0; n < 2; ++n) \
        acc[ai][bj][m][n] = mma16<I8>(Bt[n][k], At[m][k], acc[ai][bj][m][n]); __builtin_amdgcn_s_setprio(0); } while (0)
#define PG8_WAIT_V(n) asm volatile("s_waitcnt vmcnt(" #n ")" ::: "memory")
#define PG8_WAIT_L(n) asm volatile("s_waitcnt lgkmcnt(" #n ")" ::: "memory")
#define PG8_BAR __builtin_amdgcn_s_barrier()
#define PG8_SCHED __builtin_amdgcn_sched_barrier(0)
    Unit cur, nxt; int ui = 0;
    if (!S.next(0, cur)) return;
    typedef typename AccSel<I8>::type AccT; AccT acc[2][2][4][2];
#pragma unroll
    for (int a = 0; a < 2; ++a)
#pragma unroll
        for (int b = 0; b < 2; ++b)
#pragma unroll
            for (int m = 0; m < 4; ++m)
#pragma unroll
                for (int n = 0; n < 2; ++n) acc[a][b][m][n] = (AccT)(0);
    bf16x8 At[4][2], B0[2][2], B1[2][2];
    const char* cA = S.abase(g, cur, tstep); const char* cB = S.bbase(g, cur, tstep);
    S.a_ready(cur);
    if constexpr (SP2) {
        PG8_STAGE(PG8_SB(0, 0), cB, voffB); PG8_STAGE(PG8_SB(0, 1), cB + hstep, voffB); PG8_STAGE(PG8_SA(0, 0), cA, voffA); PG8_STAGE(PG8_SA(0, 1), cA + hstep, voffA);
        if (wr == 1) PG8_BAR;
        PG8_WAIT_V(2); PG8_BAR;
        PG8_STAGE(PG8_SB(1, 0), cB + kstep, voffB); PG8_STAGE(PG8_SA(1, 0), cA + kstep, voffA); PG8_STAGE(PG8_SB(1, 1), cB + hstep + kstep, voffB);
        PG8_WAIT_V(6); PG8_BAR;
    } else {
        PG8_STAGE(PG8_SB(0, 0), cB, voffB); PG8_STAGE(PG8_SA(0, 0), cA, voffA); PG8_STAGE(PG8_SB(0, 1), cB + hstep, voffB); PG8_STAGE(PG8_SA(0, 1), cA + hstep, voffA);
        if (wr == 1) PG8_BAR;
        PG8_WAIT_V(4); PG8_BAR;
        PG8_STAGE(PG8_SB(1, 0), cB + kstep, voffB); PG8_STAGE(PG8_SA(1, 0), cA + kstep, voffA); PG8_STAGE(PG8_SB(1, 1), cB + hstep + kstep, voffB);
        PG8_WAIT_V(6); PG8_BAR;
    }
    for (;;) {
        const bool has_next = S.next(ui + 1, nxt);
        const char* nA = has_next ? S.abase(g, nxt, tstep) : cA; const char* nB = has_next ? S.bbase(g, nxt, tstep) : cB;
        for (int t = 0; t < nt; t += 2) {
            const bool last = (t == nt - 2);
            const char* a1 = cA + (size_t)(t + 1) * kstep;
            const char* a2 = last ? nA : cA + (size_t)(t + 2) * kstep; const char* b2 = last ? nB : cB + (size_t)(t + 2) * kstep;
            const char* a3 = a2 + kstep; const char* b3 = b2 + kstep;
            if (last && has_next) S.a_ready(nxt);
            if constexpr (SP2) {
            PG8_LDB(B0, 0, 0); PG8_LDB(B1, 0, 1); PG8_SCHED; PG8_LDA(At, 0, 0); PG8_STAGE(PG8_SA(1, 1), a1 + hstep, voffA);
            PG8_WAIT_V(8); PG8_WAIT_L(0); PG8_BAR; PG8_MMA(0, 0, At, B0); PG8_MMA(0, 1, At, B1); PG8_BAR; PG8_SCHED;
            PG8_LDA(At, 0, 1); PG8_STAGE(PG8_SB(0, 0), b2, voffB); PG8_STAGE(PG8_SB(0, 1), b2 + hstep, voffB); PG8_STAGE(PG8_SA(0, 0), a2, voffA);
            PG8_WAIT_V(8); PG8_WAIT_L(0); PG8_BAR; PG8_MMA(1, 0, At, B0); PG8_MMA(1, 1, At, B1); PG8_BAR; PG8_SCHED;
            PG8_LDB(B0, 1, 0); PG8_LDB(B1, 1, 1); PG8_SCHED; PG8_LDA(At, 1, 0); PG8_STAGE(PG8_SA(0, 1), a2 + hstep, voffA);
            PG8_WAIT_V(8); PG8_WAIT_L(0); PG8_BAR; PG8_MMA(0, 0, At, B0); PG8_MMA(0, 1, At, B1); PG8_BAR; PG8_SCHED;
            PG8_LDA(At, 1, 1); PG8_STAGE(PG8_SB(1, 0), b3, voffB); PG8_STAGE(PG8_SB(1, 1), b3 + hstep, voffB); PG8_STAGE(PG8_SA(1, 0), a3, voffA);
            PG8_WAIT_V(8); PG8_WAIT_L(0); PG8_BAR; PG8_MMA(1, 0, At, B0); PG8_MMA(1, 1, At, B1); PG8_BAR; PG8_SCHED;
            } else {
            PG8_LDB(B0, 0, 0); PG8_SCHED; PG8_LDA(At, 0, 0); PG8_STAGE(PG8_SA(1, 1), a1 + hstep, voffA);
            PG8_WAIT_L(8); PG8_BAR; PG8_WAIT_L(0); PG8_MMA(0, 0, At, B0); PG8_BAR; PG8_SCHED;
            PG8_LDB(B1, 0, 1); PG8_STAGE(PG8_SB(0, 0), b2, voffB);
            PG8_BAR; PG8_WAIT_L(0); PG8_MMA(0, 1, At, B1); PG8_BAR;
            PG8_LDA(At, 0, 1); PG8_STAGE(PG8_SA(0, 0), a2, voffA);
            PG8_BAR; PG8_WAIT_L(0); PG8_MMA(1, 0, At, B0); PG8_BAR; PG8_SCHED;
            PG8_STAGE(PG8_SB(0, 1), b2 + hstep, voffB);
            PG8_WAIT_V(6); PG8_BAR; PG8_MMA(1, 1, At, B1); PG8_BAR;
            PG8_LDB(B0, 1, 0); PG8_SCHED; PG8_LDA(At, 1, 0); PG8_STAGE(PG8_SA(0, 1), a2 + hstep, voffA);
            PG8_WAIT_L(8); PG8_BAR; PG8_WAIT_L(0); PG8_MMA(0, 0, At, B0); PG8_BAR; PG8_SCHED;
            PG8_LDB(B1, 1, 1); PG8_STAGE(PG8_SB(1, 0), b3, voffB);
            PG8_BAR; PG8_WAIT_L(0); PG8_MMA(0, 1, At, B1); PG8_BAR;
            PG8_LDA(At, 1, 1); PG8_STAGE(PG8_SA(1, 0), a3, voffA);
            PG8_BAR; PG8_WAIT_L(0); PG8_MMA(1, 0, At, B0); PG8_BAR; PG8_SCHED;
            PG8_STAGE(PG8_SB(1, 1), b3 + hstep, voffB);
            PG8_WAIT_V(6); PG8_BAR; PG8_MMA(1, 1, At, B1); PG8_BAR;
            }
        }
        if constexpr (ALIGN_EPI) { if (wr == 0) PG8_BAR; }
        if constexpr (!Epi::AFTER_DRAIN) { E(acc, cur, wr, wc, fr, fq); S.done(cur); }
        if (!has_next) break;
#pragma unroll
        for (int a = 0; a < 2; ++a)
#pragma unroll
            for (int b = 0; b < 2; ++b)
#pragma unroll
                for (int m = 0; m < 4; ++m)
#pragma unroll
                    for (int n = 0; n < 2; ++n) acc[a][b][m][n] = (AccT)(0);
        cur = nxt; cA = nA; cB = nB; ++ui;
        if constexpr (ALIGN_EPI) { if (wr == 1) PG8_BAR; }
    }
    PG8_WAIT_V(0);
    if constexpr (!ALIGN_EPI) { if (wr == 0) PG8_BAR; }
    PG8_BAR;
    if constexpr (Epi::AFTER_DRAIN) { E.fused(acc, cur, wr, wc, fr, fq, lds, wid, lane); S.done(cur); }
#undef PG8_SA
#undef PG8_SB
#undef PG8_STAGE
#undef PG8_LDA
#undef PG8_LDB
#undef PG8_MMA
#undef PG8_WAIT_V
#undef PG8_WAIT_L
#undef PG8_BAR
#undef PG8_SCHED
}
}

constexpr int NWAVES = 8;
constexpr int D = 1024, NB = 4, SEQ = 4096, CTXL = 256, NLAT = NB * SEQ, NCTX = NB * CTXL, MROWS = NLAT + NCTX;
constexpr int DEPTH = 4, RW = 512, NH = 8, HS = 64, DFF = 3584, NE = 8, NPROJ = 3456, NP = 3584, NLO = 2560, KLA = 512, NMOD = 6144;
constexpr int PC_R = 0, PC_K = 512, PC_V = 1024, PC_CB = 1536, PC_CC = 2048, PC_CH = 2560, PC_WD = 3072, PC_AD = 3200, PC_GD = 3328;
constexpr float LN_EPS = 1e-5f, GN_EPS = 64e-5f, DN_ALPHA = 1.681792830507429f;
enum { I_X = 0, I_C, I_CTX, I_CCTX, I_WMOD, I_BMOD, I_WIN, I_W0, I_W2, I_A0, I_A2, I_KK, I_KA, I_RK, I_G2, I_LNXG, I_LNXB, I_CONVW, I_WOUT, I_LN1G, I_LN1B, I_LN2G, I_LN2B,
       I_FW1, I_FW3, I_FW2, I_RTW, I_RTB, I_MW1, I_MW3, I_MW2, N_IN };

constexpr size_t MiB = 1u << 20;
constexpr size_t WS_CTL = 0, CTL_BYTES = 3 * MiB;
constexpr size_t WS_MODV = 1 * MiB;
constexpr size_t WS_AMAX = 2 * MiB;
constexpr size_t WS_RKS = 3 * MiB;
constexpr size_t WS_WIN = 4 * MiB;
constexpr size_t WS_WOUT = WS_WIN + 28 * MiB;
constexpr size_t WS_LORA = WS_WOUT + 8 * MiB;
constexpr size_t WS_F13 = WS_LORA + 10 * MiB;
constexpr size_t WS_F2 = WS_F13 + 28 * MiB;
constexpr size_t WS_X = WS_F2 + 14 * MiB;
constexpr size_t WS_H = WS_X + 68 * MiB;
constexpr size_t WS_MOES = WS_H + 34 * MiB;
constexpr size_t WS_ROWLIST = WS_MOES;
constexpr size_t WS_TOKSEL = WS_MOES + 640 * 1024;
constexpr size_t WS_WSEL = WS_TOKSEL + 320 * 1024;
constexpr size_t WS_WSORT = WS_WSEL + 192 * 1024;
constexpr size_t WS_MOEW13 = WS_MOES + 2 * MiB;
constexpr size_t WS_MOEW2 = WS_MOEW13 + 112 * MiB;
constexpr size_t WS_H8 = WS_MOEW13 + 56 * MiB;
constexpr size_t WS_SA = WS_H8 + 17 * MiB;
constexpr size_t WS_SAM = WS_SA + 512 * 1024;
constexpr size_t WS_SAG = WS_SA + 1 * MiB;
constexpr size_t WS_SCR = WS_MOEW2 + 56 * MiB;
constexpr size_t WS_P = WS_SCR;
constexpr size_t WS_LO = WS_P + 119 * MiB;
constexpr size_t WS_PREP = WS_LO + 170 * MiB;
constexpr size_t WS_Y = WS_PREP + 213 * MiB;
constexpr size_t WS_MIXIN = WS_Y + 68 * MiB;
constexpr size_t WS_CH = WS_PREP;
constexpr size_t WS_MIXO = WS_PREP;
constexpr size_t WS_MIXP = WS_PREP + 34 * MiB;
constexpr size_t WS_END_MIXER = WS_MIXIN + 34 * MiB;
constexpr size_t WS_HG = WS_SCR;
constexpr size_t WS_ACT = WS_HG + 72 * MiB;
constexpr size_t WS_F = WS_ACT + 252 * MiB;
constexpr size_t WS_FP = WS_F + 72 * MiB;
constexpr size_t WS_END_FFN = WS_FP + 64 * MiB;
constexpr size_t WS_NEED = WS_END_MIXER > WS_END_FFN ? WS_END_MIXER : WS_END_FFN;
static_assert((size_t)MROWS * NP * 2 <= 119 * MiB && (size_t)MROWS * NLO * 4 <= 170 * MiB && (size_t)8704 * 25600 <= 213 * MiB && (size_t)MROWS * D * 4 <= 68 * MiB && WS_NEED <= 990 * MiB, "ws map");
constexpr int MOE_MAIN_PANELS = 128, MOE_TAIL_ROWS = 4096;
constexpr int MOE_ROWS = 36864;
constexpr int AM_IN = 18 * 2 * DFF, AM_OUT = AM_IN + DEPTH * NP;
constexpr int LORAW_PER_LAYER = 4 * 512 * 64 + 512 * 128;
constexpr int CW_BAR = 4096, CW_GCNT = 8192, CW_CQ = 12288, CW_SDONE = 12544;

constexpr int RING_BYTES = 131072, LDSCTL_OFF = RING_BYTES, MISC_OFF = LDSCTL_OFF + 320, SCX_OFF = 132096  , LDS_BYTES = 163840;

typedef unsigned short bf16;
typedef unsigned v4u __attribute__((ext_vector_type(4)));
typedef unsigned v2u __attribute__((ext_vector_type(2)));
typedef float f32x4 __attribute__((ext_vector_type(4)));
#define LAS __attribute__((address_space(3)))
#define LDS_WAIT() asm volatile("s_waitcnt lgkmcnt(0)" ::: "memory")
__device__ __forceinline__ unsigned f2bf(float f) { unsigned u = __builtin_bit_cast(unsigned, f); return (u + 0x7fffu + ((u >> 16) & 1u)) >> 16; }
__device__ __forceinline__ unsigned pk2(float lo, float hi) { return f2bf(lo) | (f2bf(hi) << 16); }
__device__ __forceinline__ float bf2f(unsigned short b) { return __builtin_bit_cast(float, ((unsigned)b) << 16); }
__device__ __forceinline__ float bflo(unsigned w) { return __builtin_bit_cast(float, w << 16); }
__device__ __forceinline__ float bfhi(unsigned w) { return __builtin_bit_cast(float, w & 0xffff0000u); }
__device__ __forceinline__ float wave_sum(float v) {
#pragma unroll
    for (int o = 1; o < 64; o <<= 1) v += __shfl_xor(v, o);
    return v;
}
__device__ __forceinline__ float sigm(float x) { return 1.f / (1.f + __expf(-x)); }

#define XB_TMO      128
#define XB_XCNT(j)  (256  + 64 * (j))
#define XB_XSUB(j)  (1280 + 64 * (j))
#define XB_XGEN(j)  (2304 + 64 * (j))
#define XB_TOP      3328
#define XB_TOPGEN   3392
#define XCD_BAR_WORDS 3456
#define XB_SPIN_CAP (1u << 18)

__device__ __forceinline__ unsigned xb_ld(unsigned* p)              { return __hip_atomic_load(p, __ATOMIC_RELAXED, __HIP_MEMORY_SCOPE_AGENT); }
__device__ __forceinline__ unsigned xb_add(unsigned* p, unsigned v) { return __hip_atomic_fetch_add(p, v, __ATOMIC_RELAXED, __HIP_MEMORY_SCOPE_AGENT); }
__device__ __forceinline__ unsigned xb_xcc_id() { return (unsigned)__builtin_amdgcn_s_getreg((3 << 11) | 20) & 0xFu; }
#define XB_SPIN(cond, bar) do { unsigned _sp = 0; while (cond) { __builtin_amdgcn_s_sleep(1); \
    if ((++_sp & 255u) == 0u) { if (xb_ld(&(bar)[XB_TMO])) break; if (_sp > XB_SPIN_CAP) { atomicAdd(&(bar)[XB_TMO], 1u); break; } } } } while (0)

struct XcdBarrier {
    unsigned* bar; unsigned x;
    volatile LAS unsigned* st;
};

__device__ __forceinline__ XcdBarrier xcd_barrier_post(unsigned* bar, volatile LAS unsigned* st) {
    XcdBarrier b; b.bar = bar; b.x = xb_xcc_id(); b.st = st;
    if (threadIdx.x == 0) (void)xb_add(&bar[XB_XCNT(b.x)], 1u);
    return b;
}
__device__ __forceinline__ void xcd_barrier_complete(unsigned* bar, unsigned x, unsigned& nloc, unsigned& nx) {
    const unsigned G = gridDim.x * gridDim.y * gridDim.z;
    unsigned sum, cnt, mine, sp = 0u;
    for (;;) {
        sum = 0u; cnt = 0u; mine = 0u;
#pragma unroll
        for (unsigned j = 0; j < 16; ++j) { const unsigned c = xb_ld(&bar[XB_XCNT(j)]); sum += c; cnt += (c > 0u) ? 1u : 0u; mine = (j == x) ? c : mine; }
        if (sum == G) break;
        __builtin_amdgcn_s_sleep(1);
        if ((++sp & 255u) == 0u) { if (xb_ld(&bar[XB_TMO])) break; if (sp > XB_SPIN_CAP) { atomicAdd(&bar[XB_TMO], 1u); break; } }
    }
    nloc = mine > 0u ? mine : 1u; nx = cnt > 0u ? cnt : 1u;
}

__device__ __forceinline__ void xcd_barrier(const XcdBarrier& b) {
    asm volatile("s_waitcnt vmcnt(0)" ::: "memory");
    __syncthreads();
    if (threadIdx.x == 0) {
        unsigned* bar = b.bar;
        __builtin_amdgcn_s_waitcnt(0);
        unsigned nloc = b.st[0], nx = b.st[1];
        if (nloc == 0u) { xcd_barrier_complete(bar, b.x, nloc, nx); b.st[0] = nloc; b.st[1] = nx; }
        const unsigned old = xb_add(&bar[XB_XSUB(b.x)], 1u);
        const unsigned gen = old / nloc;
        if (old + 1u == (gen + 1u) * nloc) {
            __builtin_amdgcn_fence(__ATOMIC_RELEASE, "agent");
            asm volatile("s_waitcnt vmcnt(0)" ::: "memory");
            const unsigned og = xb_add(&bar[XB_TOP], 1u);
            const unsigned tg = og / nx;
            if (og + 1u == (tg + 1u) * nx) xb_add(&bar[XB_TOPGEN], 1u);
            else XB_SPIN(xb_ld(&bar[XB_TOPGEN]) == tg, bar);
            __builtin_amdgcn_fence(__ATOMIC_ACQUIRE, "agent");
            xb_add(&bar[XB_XGEN(b.x)], 1u);
            asm volatile("s_waitcnt vmcnt(0)" ::: "memory");
        } else {
            XB_SPIN(xb_ld(&bar[XB_XGEN(b.x)]) == gen, bar);
            __builtin_amdgcn_fence(__ATOMIC_ACQUIRE, "agent");
            asm volatile("s_waitcnt vmcnt(0)" ::: "memory");
        }
    }
    __syncthreads();
}


__device__ __forceinline__ size_t opaque_zero() { size_t z = 0; asm volatile("" : "+s"(z)); return z; }
#define OWS (p.ws + opaque_zero())
__device__ __forceinline__ int opaque_zero_i() { int z = 0; asm volatile("" : "+s"(z)); return z; }
#define PIN(i) (p.in[(i) + opaque_zero_i()])
struct KP { const float* in[N_IN]; float* out; unsigned char* ws; int ph; int pad; };

template <int MODE> __device__ __forceinline__ int rowmap(int n, int arg) {
    if (MODE == 0) return n + arg;
    if (MODE == 1) { if (n < 1536) return n; if (n < 1664) return n - 1536 + PC_WD; if (n < 1792) return n - 1664 + PC_AD; if (n < 1920) return n - 1792 + PC_GD;
                     if (n < 2432) return n - 1920 + PC_CB; if (n < 2944) return n - 2432 + PC_CC; return n - 2944 + PC_CH; }
    return 8 * (n >> 2) + 4 * arg + (n & 3);
}
template <int MODE> __device__ __forceinline__ void transpose_item(const float* W, int K, int N, bf16* WT, int arg, LAS float* scr, int item, int lane) {
    const int nblk = N / 32, kb = item / nblk, nb = item % nblk, k0 = 64 * kb, n0 = 32 * nb;
#pragma unroll 8
    for (int i = 0; i < 32; ++i) { const int kk = 2 * i + (lane >> 5); scr[kk * 33 + (lane & 31)] = W[(size_t)(k0 + kk) * N + n0 + (lane & 31)]; }
    LDS_WAIT(); asm volatile("" ::: "memory");
    const int c = lane & 7;
#pragma unroll
    for (int j = 0; j < 4; ++j) { const int n = (lane >> 3) + 8 * j; const LAS float* s = scr + (8 * c) * 33 + n;
        v4u o; o.x = pk2(s[0 * 33], s[1 * 33]); o.y = pk2(s[2 * 33], s[3 * 33]); o.z = pk2(s[4 * 33], s[5 * 33]); o.w = pk2(s[6 * 33], s[7 * 33]);
        *(v4u*)(WT + (size_t)rowmap<MODE>(n0 + n, arg) * K + k0 + 8 * c) = o; }
    LDS_WAIT(); asm volatile("" ::: "memory");
}

__device__ __forceinline__ void ph_modvec(const KP& p, LAS unsigned char* lds, int tid) {
    LAS float* sil = (LAS float*)lds;
    LAS float* red = (LAS float*)(lds + 5 * 1024 * 4);
    const float* c = PIN(I_C); const float* cc = PIN(I_CCTX);
    for (int i = tid; i < 5 * 1024; i += 512) { const float v = i < 4096 ? c[i] : cc[i - 4096]; sil[i] = v / (1.f + __expf(-v)); }
    __syncthreads();
    float* modv = (float*)(OWS + WS_MODV);
    const int ks = tid >> 6, col = tid & 63;
    for (int task = blockIdx.x; task < DEPTH * 96; task += gridDim.x) {
        const int l = task / 96, j0 = (task % 96) * 64;
        const float* w = PIN(I_WMOD) + (size_t)l * D * NMOD + (size_t)(ks * 128) * NMOD + j0 + col;
        float a0 = 0.f, a1 = 0.f, a2 = 0.f, a3 = 0.f, a4 = 0.f;
#pragma unroll 8
        for (int k = 0; k < 128; ++k) { const float wv = w[(size_t)k * NMOD]; const int kk = ks * 128 + k;
            a0 += sil[kk] * wv; a1 += sil[1024 + kk] * wv; a2 += sil[2048 + kk] * wv; a3 += sil[3072 + kk] * wv; a4 += sil[4096 + kk] * wv; }
        red[(ks * 5 + 0) * 64 + col] = a0; red[(ks * 5 + 1) * 64 + col] = a1; red[(ks * 5 + 2) * 64 + col] = a2; red[(ks * 5 + 3) * 64 + col] = a3; red[(ks * 5 + 4) * 64 + col] = a4;
        __syncthreads();
        if (tid < 320) { const int r = tid >> 6; float s = 0.f;
#pragma unroll
            for (int q = 0; q < 8; ++q) s += red[(q * 5 + r) * 64 + col];
            modv[(size_t)(l * 5 + r) * NMOD + j0 + col] = s + PIN(I_BMOD)[l * NMOD + j0 + col]; }
        __syncthreads();
    }
}

__device__ __forceinline__ void ph_convert(const KP& p, LAS unsigned char* lds, int gw, int NGW, int wave, int lane) {
    LAS float* scr = (LAS float*)(lds + wave * 16384);
    bf16* win = (bf16*)(OWS + WS_WIN); bf16* f2 = (bf16*)(OWS + WS_F2); bf16* lora = (bf16*)(OWS + WS_LORA);
    constexpr int I_IN = (D / 64) * (NPROJ / 32), I_OUT = (D / 64) * (D / 32), I_UP = (D / 64) * (DFF / 32), I_DN = (DFF / 64) * (D / 32);
    for (int it = gw; it < I_DN; it += NGW) transpose_item<0>(PIN(I_FW2), DFF, D, f2, 0, scr, it, lane);
    { const int gt = gw * 64 + lane, NGT = NGW * 64; constexpr int PER = (NP - NPROJ) * D / 16;
      for (int i = gt; i < DEPTH * PER; i += NGT) { const int l = i / PER, q = i % PER; *(v4u*)((unsigned char*)win + (size_t)l * NP * D + (size_t)NPROJ * D + (size_t)q * 16) = (v4u){0u, 0u, 0u, 0u}; } }
    { const int gt = gw * 64 + lane, NGT = NGW * 64;
      for (int i = gt; i < DEPTH * LORAW_PER_LAYER / 8; i += NGT) { const int l = i / (LORAW_PER_LAYER / 8); int q = (i % (LORAW_PER_LAYER / 8)) * 8; float v[8];
          int grp, c, k0; if (q < 4 * 512 * 64) { grp = q / (512 * 64); q -= grp * 512 * 64; c = q / 64; k0 = q % 64; } else { grp = 4; q -= 4 * 512 * 64; c = q / 128; k0 = q % 128; }
#pragma unroll
          for (int j = 0; j < 8; ++j) { const int k = k0 + j;
              v[j] = grp < 2 ? PIN(I_W2)[((size_t)(l * 2 + grp) * 64 + k) * RW + c] : grp < 4 ? PIN(I_A2)[((size_t)(l * 2 + grp - 2) * 64 + k) * RW + c] : PIN(I_G2)[((size_t)l * 128 + k) * RW + c]; }
          v4u o; o.x = pk2(v[0], v[1]); o.y = pk2(v[2], v[3]); o.z = pk2(v[4], v[5]); o.w = pk2(v[6], v[7]);
          *(v4u*)(lora + (size_t)i * 8) = o; } }
}
__device__ __forceinline__ void ph_amax(const KP& p, int gw, int NGW, int lane) {
    unsigned* AM = (unsigned*)(OWS + WS_AMAX);
    for (int it = gw; it < 18 * 2 * (DFF / 64); it += NGW) { const int kq = 0, strip = it % (DFF / 64), sm = it / (DFF / 64), s1 = sm & 1, cm = sm >> 1;
        const float* W = cm < 2 ? PIN(s1 ? I_FW3 : I_FW1) + (size_t)cm * D * DFF : PIN(s1 ? I_MW3 : I_MW1) + (size_t)(cm - 2) * D * DFF;
        const int n = strip * 64 + lane; const float* src = W + (size_t)(kq * 256) * DFF + n; float m = 0.f;
#pragma unroll 16
        for (int k = 0; k < 256; ++k) { const float w = src[(size_t)k * DFF]; m += w * w; }
        AM[(size_t)cm * 2 * DFF + 8 * (n >> 2) + 4 * s1 + (n & 3)] = __builtin_bit_cast(unsigned, 4.25f * sqrtf(m * (1.f / 256.f))); }
    for (int it = gw; it < DEPTH * (NPROJ / 64 + D / 64); it += NGW) { const int kq = 0; int t = it; const int l = t / (NPROJ / 64 + D / 64); t -= l * (NPROJ / 64 + D / 64);
        const bool isin = t < NPROJ / 64; const int strip = isin ? t : t - NPROJ / 64, N = isin ? NPROJ : D, n = strip * 64 + lane;
        const float* src = (isin ? PIN(I_WIN) + (size_t)l * D * NPROJ : PIN(I_WOUT) + (size_t)l * D * D) + (size_t)(kq * 256) * N + n; float m = 0.f;
#pragma unroll 16
        for (int k = 0; k < 256; ++k) { const float w = src[(size_t)k * N]; m += w * w; }
        AM[isin ? AM_IN + l * NP + rowmap<1>(n, 0) : AM_OUT + l * D + n] = __builtin_bit_cast(unsigned, 4.25f * sqrtf(m * (1.f / 256.f))); }
}
__device__ __forceinline__ unsigned q8pack(float a, float b, float c, float d) {
    const int qa = __float2int_rn(fminf(fmaxf(a, -127.f), 127.f)), qb = __float2int_rn(fminf(fmaxf(b, -127.f), 127.f)), qc = __float2int_rn(fminf(fmaxf(c, -127.f), 127.f)), qd = __float2int_rn(fminf(fmaxf(d, -127.f), 127.f));
    return (unsigned)(qa & 255) | ((unsigned)(qb & 255) << 8) | ((unsigned)(qc & 255) << 16) | ((unsigned)(qd & 255) << 24); }
constexpr int CQ_IN = (D / 64) * (NPROJ / 32), CQ_OUT = (D / 64) * (D / 32), CQ_UP = (D / 64) * (DFF / 32), CQ_DN = (DFF / 64) * (D / 32);
constexpr int CQ_NEG = CQ_IN + CQ_OUT + 2 * CQ_UP;
constexpr int CQ_J1 = 3 * CQ_IN + 3 * CQ_OUT + 2 * CQ_UP + CQ_DN, CQ_MOE = NE * (2 * CQ_UP + CQ_DN), CQ_END0 = CQ_J1 + CQ_MOE, CQ_END1 = CQ_END0 + CQ_MOE;
#ifndef CQ_SLOT_ITEMS
#define CQ_SLOT_ITEMS 12000
#endif
struct CqItem { const float* W; bf16* WT; int K, N, mode, arg, item; const unsigned* am; };
__device__ __forceinline__ CqItem cq_decode(const KP& p, int q) {
    CqItem c; bf16* win = (bf16*)(OWS + WS_WIN); bf16* wout = (bf16*)(OWS + WS_WOUT); bf16* f13 = (bf16*)(OWS + WS_F13); bf16* f2 = (bf16*)(OWS + WS_F2);
    bf16* m13 = (bf16*)(OWS + WS_MOEW13); bf16* m2 = (bf16*)(OWS + WS_MOEW2); const unsigned* AM = (const unsigned*)(OWS + WS_AMAX);
    if (q < 0) { q += CQ_NEG;
        if (q < CQ_IN) { c = CqItem{PIN(I_WIN), win, D, NPROJ, 3, 0, q, AM + AM_IN}; return c; } q -= CQ_IN;
        if (q < CQ_OUT) { c = CqItem{PIN(I_WOUT), wout, D, D, 4, 0, q, AM + AM_OUT}; return c; } q -= CQ_OUT;
        if (q < CQ_UP) { c = CqItem{PIN(I_FW1), f13, D, DFF, 2, 0, q, AM}; return c; } q -= CQ_UP;
        c = CqItem{PIN(I_FW3), f13, D, DFF, 2, 1, q, AM}; return c; }
    if (q < 3 * CQ_IN) { const int l = 1 + q / CQ_IN; c = CqItem{PIN(I_WIN) + (size_t)l * D * NPROJ, win + (size_t)l * (NP * D / 2), D, NPROJ, 3, 0, q % CQ_IN, AM + AM_IN + l * NP}; return c; } q -= 3 * CQ_IN;
    if (q < 3 * CQ_OUT) { const int l = 1 + q / CQ_OUT; c = CqItem{PIN(I_WOUT) + (size_t)l * D * D, wout + (size_t)l * (D * D / 2), D, D, 4, 0, q % CQ_OUT, AM + AM_OUT + l * D}; return c; } q -= 3 * CQ_OUT;
    if (q < CQ_UP) { c = CqItem{PIN(I_FW1) + (size_t)D * DFF, f13 + (size_t)DFF * D, D, DFF, 2, 0, q, AM + 2 * DFF}; return c; } q -= CQ_UP;
    if (q < CQ_UP) { c = CqItem{PIN(I_FW3) + (size_t)D * DFF, f13 + (size_t)DFF * D, D, DFF, 2, 1, q, AM + 2 * DFF}; return c; } q -= CQ_UP;
    if (q < CQ_DN) { c = CqItem{PIN(I_FW2) + (size_t)DFF * D, f2 + (size_t)D * DFF, DFF, D, 0, 0, q, nullptr}; return c; } q -= CQ_DN;
    const int mi = q / CQ_MOE; q -= mi * CQ_MOE;
    if (q < NE * CQ_UP) { const int e = q / CQ_UP; c = CqItem{PIN(I_MW1) + ((size_t)mi * NE + e) * D * DFF, m13 + (size_t)e * DFF * D, D, DFF, 2, 0, q % CQ_UP, AM + (size_t)(2 + 8 * mi + e) * 2 * DFF}; return c; } q -= NE * CQ_UP;
    if (q < NE * CQ_UP) { const int e = q / CQ_UP; c = CqItem{PIN(I_MW3) + ((size_t)mi * NE + e) * D * DFF, m13 + (size_t)e * DFF * D, D, DFF, 2, 1, q % CQ_UP, AM + (size_t)(2 + 8 * mi + e) * 2 * DFF}; return c; } q -= NE * CQ_UP;
    { const int e = q / CQ_DN; c = CqItem{PIN(I_MW2) + ((size_t)mi * NE + e) * DFF * D, m2 + (size_t)e * D * DFF, DFF, D, 0, 0, q % CQ_DN, nullptr}; return c; }
}
__device__ __forceinline__ void cq_load(const CqItem& c, int lane, float (&r)[32]) {
    const int nblk = c.N / 32, kb = c.item / nblk, nb = c.item % nblk; const float* src = c.W + (size_t)(64 * kb + (lane >> 5)) * c.N + 32 * nb + (lane & 31);
#pragma unroll
    for (int i = 0; i < 32; ++i) r[i] = src[(size_t)(2 * i) * c.N];
}
__device__ __forceinline__ void cq_store(const CqItem& c, int lane, const float (&r)[32], LAS float* scr) {
    const int nblk = c.N / 32, kb = c.item / nblk, nb = c.item % nblk, k0 = 64 * kb, n0 = 32 * nb;
#pragma unroll
    for (int i = 0; i < 32; ++i) scr[(2 * i + (lane >> 5)) * 33 + (lane & 31)] = r[i];
    LDS_WAIT(); asm volatile("" ::: "memory");
    if (c.mode >= 2) {
        const int n = lane >> 1, hf = lane & 1, nn = n0 + n, j = c.mode == 2 ? 8 * (nn >> 2) + 4 * c.arg + (nn & 3) : c.mode == 3 ? rowmap<1>(nn, 0) : nn;
        const float inv = 127.f / fmaxf(__builtin_bit_cast(float, c.am[j]), 1e-30f); const LAS float* sp = scr + (32 * hf) * 33 + n; unsigned w[8];
#pragma unroll
        for (int q = 0; q < 8; ++q) w[q] = q8pack(sp[(4 * q + 0) * 33] * inv, sp[(4 * q + 1) * 33] * inv, sp[(4 * q + 2) * 33] * inv, sp[(4 * q + 3) * 33] * inv);
        unsigned char* dst = (unsigned char*)c.WT + (size_t)j * c.K + k0 + 32 * hf;
        *(v4u*)dst = (v4u){w[0], w[1], w[2], w[3]}; *(v4u*)(dst + 16) = (v4u){w[4], w[5], w[6], w[7]};
    } else {
    const int cc = lane & 7;
#pragma unroll
    for (int j = 0; j < 4; ++j) { const int n = (lane >> 3) + 8 * j; const LAS float* sp = scr + (8 * cc) * 33 + n;
        v4u o; o.x = pk2(sp[0 * 33], sp[1 * 33]); o.y = pk2(sp[2 * 33], sp[3 * 33]); o.z = pk2(sp[4 * 33], sp[5 * 33]); o.w = pk2(sp[6 * 33], sp[7 * 33]);
        const int nn = n0 + n;
        *(v4u*)(c.WT + (size_t)nn * c.K + k0 + 8 * cc) = o; }
    }
    LDS_WAIT(); asm volatile("" ::: "memory");
}
constexpr int CQ_B = 4;
__device__ __forceinline__ int cq_grab(unsigned* heads, int nseg, int& cnt, int lane) {
    int q = -1, n = 0;
    if (lane == 0) { for (int sg = 0; sg < nseg && q < 0; ++sg) { const int size = sg == 0 ? CQ_J1 : CQ_MOE, base = sg == 0 ? 0 : sg == 1 ? CQ_J1 : CQ_END0; unsigned* hd = heads + 64 * sg;
            if ((int)__hip_atomic_load(hd, __ATOMIC_RELAXED, __HIP_MEMORY_SCOPE_AGENT) < size) { const int t = (int)__hip_atomic_fetch_add(hd, (unsigned)CQ_B, __ATOMIC_RELAXED, __HIP_MEMORY_SCOPE_AGENT);
                if (t < size) { q = base + t; n = size - t < CQ_B ? size - t : CQ_B; } } } }
    cnt = __builtin_amdgcn_readfirstlane(n); return __builtin_amdgcn_readfirstlane(q);
}
__device__ __forceinline__ void cq_run(const KP& p, LAS unsigned char* lds, int nseg, const unsigned* stop, unsigned stopval, int wave, int lane) {
    unsigned* heads = (unsigned*)(OWS + WS_CTL) + CW_CQ; LAS float* scr = (LAS float*)(lds + wave * 16384);
    for (;;) {
        if (stop) { unsigned sv = 0u; if (lane == 0) sv = __hip_atomic_load(stop, __ATOMIC_RELAXED, __HIP_MEMORY_SCOPE_AGENT); if ((unsigned)__builtin_amdgcn_readfirstlane((int)sv) >= stopval) break; }
        int cnt; const int q0 = cq_grab(heads, nseg, cnt, lane); if (q0 < 0) break;
        CqItem cur = cq_decode(p, q0); float ra[32]; cq_load(cur, lane, ra);
        for (int j = 0; j < cnt; ++j) { CqItem nxt = cur; float rb[32];
            if (j + 1 < cnt) { nxt = cq_decode(p, q0 + j + 1); cq_load(nxt, lane, rb); }
            cq_store(cur, lane, ra, scr);
            if (j + 1 < cnt) { cur = nxt;
#pragma unroll
                for (int i = 0; i < 32; ++i) ra[i] = rb[i]; } }
    }
}

__device__ __forceinline__ void cq_static(const KP& p, LAS unsigned char* lds, int q0, int q1, int gw, int NGW, int wave, int lane) {
    LAS float* scr = (LAS float*)(lds + wave * 16384);
    int q = q0 + gw; if (q >= q1) return;
    CqItem cur = cq_decode(p, q); float ra[32]; cq_load(cur, lane, ra);
    for (;;) { const int qn = q + NGW; CqItem nxt = cur; float rb[32];
        if (qn < q1) { nxt = cq_decode(p, qn); cq_load(nxt, lane, rb); }
        cq_store(cur, lane, ra, scr);
        if (qn >= q1) break;
        cur = nxt; q = qn;
#pragma unroll
        for (int i = 0; i < 32; ++i) ra[i] = rb[i]; }
}

__device__ __forceinline__ void ld_row(const float* r, int lane, f32x4 (&v)[4]) { const f32x4* q = (const f32x4*)r + lane;
#pragma unroll
    for (int j = 0; j < 4; ++j) v[j] = q[64 * j]; }
__device__ __forceinline__ void st_row(float* r, int lane, const f32x4 (&v)[4]) { f32x4* q = (f32x4*)r + lane;
#pragma unroll
    for (int j = 0; j < 4; ++j) q[64 * j] = v[j]; }
__device__ __forceinline__ void st_row_bf16(bf16* r, int lane, const f32x4 (&v)[4]) { v2u* q = (v2u*)r + lane;
#pragma unroll
    for (int j = 0; j < 4; ++j) { v2u w; w.x = pk2(v[j][0], v[j][1]); w.y = pk2(v[j][2], v[j][3]); q[64 * j] = w; } }
__device__ __forceinline__ void ld_row_bf16(const bf16* r, int lane, f32x4 (&v)[4]) { const v2u* q = (const v2u*)r + lane;
#pragma unroll
    for (int j = 0; j < 4; ++j) { const v2u w = q[64 * j]; v[j] = (f32x4){bflo(w.x), bfhi(w.x), bflo(w.y), bfhi(w.y)}; } }
template <int S> __device__ __forceinline__ void ld_row_parts(const float* r, size_t pstride, int lane, f32x4 (&v)[4]) {
    ld_row(r, lane, v);
#pragma unroll
    for (int s = 1; s < S; ++s) { f32x4 t[4]; ld_row(r + (size_t)s * pstride, lane, t);
#pragma unroll
        for (int j = 0; j < 4; ++j) v[j] += t[j]; } }
__device__ __forceinline__ int mod_row(int row) { return row < NLAT ? (row >> 12) : 4; }

__device__ __forceinline__ void st_row_q8(unsigned char* dst8, float* scale, int row, int lane, const f32x4 (&v)[4]) {
    float am = 0.f;
#pragma unroll
    for (int j = 0; j < 4; ++j) am = fmaxf(fmaxf(am, fmaxf(fabsf(v[j][0]), fabsf(v[j][1]))), fmaxf(fabsf(v[j][2]), fabsf(v[j][3])));
#pragma unroll
    for (int o = 1; o < 64; o <<= 1) am = fmaxf(am, __shfl_xor(am, o));
    am = fmaxf(am, 1e-30f); const float inv = 127.f / am; unsigned* h8 = (unsigned*)dst8 + (size_t)row * (D / 4) + lane;
#pragma unroll
    for (int j = 0; j < 4; ++j) h8[64 * j] = q8pack(v[j][0] * inv, v[j][1] * inv, v[j][2] * inv, v[j][3] * inv);
    if (lane == 0) scale[row] = am * (1.f / 127.f);
}
__device__ __forceinline__ void ph_init_rows(const KP& p, int gw, int NGW, int lane) {
    const float* modv = (const float*)(OWS + WS_MODV); float* X = (float*)(OWS + WS_X); bf16* H = (bf16*)(OWS + WS_H);
    for (int row = gw; row < MROWS; row += NGW) {
        const float* src = row < NLAT ? PIN(I_X) + (size_t)row * D : PIN(I_CTX) + (size_t)(row - NLAT) * D;
        const float* mv = modv + (size_t)(0 * 5 + mod_row(row)) * NMOD;
        f32x4 x[4], sh[4], sc[4], h[4]; ld_row(src, lane, x); ld_row(mv, lane, sh); ld_row(mv + 1024, lane, sc);
#pragma unroll
        for (int j = 0; j < 4; ++j) h[j] = x[j] * (1.f + sc[j]) + sh[j];
        st_row_q8(OWS + WS_H8, (float*)(OWS + WS_SA), row, lane, h);
    }
}

__device__ __forceinline__ int scan_row(int b, int dir, int step) { return step < CTXL ? NLAT + b * CTXL + (dir ? CTXL - 1 - step : step) : b * SEQ + (dir ? SEQ - 1 - (step - CTXL) : step - CTXL); }
typedef short sbf16x8 __attribute__((ext_vector_type(8)));
typedef float f32x16 __attribute__((ext_vector_type(16)));
constexpr int SC_C = 32, SC_NCH = (CTXL + SEQ) / SC_C  , SC_NCHAIN = NB * NH * 2  , SC_NTASK = SC_NCH * SC_NCHAIN  ;
constexpr int SC_P1 = 48, SC_P2 = 96;
constexpr int CH_G = 0, CH_Q = 8192, CH_UT = 12288, CH_YL = 20480, CH_EC = 24576, CH_BYTES = 25600, CH_NLOAD = 26;

__device__ __forceinline__ f32x16 mm(v4u a, v4u b, f32x16 c) { return __builtin_amdgcn_mfma_f32_32x32x16_bf16(__builtin_bit_cast(sbf16x8, a), __builtin_bit_cast(sbf16x8, b), c, 0, 0, 0); }
typedef float f32x2c __attribute__((ext_vector_type(2))); typedef __bf16 bf16x2c __attribute__((ext_vector_type(2)));
__device__ __forceinline__ unsigned cvtpk(float lo, float hi) { return __builtin_bit_cast(unsigned, __builtin_convertvector((f32x2c){lo, hi}, bf16x2c)); }
template <int S, int NEG> __device__ __forceinline__ v4u cvtf(const f32x16& x) {
    v4u w; const float sg = NEG ? -1.f : 1.f;
    w.x = cvtpk(sg * x[8 * S + 0], sg * x[8 * S + 1]); w.y = cvtpk(sg * x[8 * S + 2], sg * x[8 * S + 3]); w.z = cvtpk(sg * x[8 * S + 4], sg * x[8 * S + 5]); w.w = cvtpk(sg * x[8 * S + 6], sg * x[8 * S + 7]); return w; }
template <int MODE  > __device__ __forceinline__ f32x16 mask_acc(f32x16 x, int n, int hh) {
#pragma unroll
    for (int r = 0; r < 16; ++r) { const int m = (r & 3) + 8 * (r >> 2) + 4 * hh; const bool keep = MODE == 0 ? (m > n) : MODE == 1 ? (m < n) : (m <= n); x[r] = keep ? x[r] : 0.f; }
    return x; }
__device__ __forceinline__ f32x16 zero16() { f32x16 z;
#pragma unroll
    for (int r = 0; r < 16; ++r) z[r] = 0.f;
    return z; }
__device__ __forceinline__ void cm_build(const unsigned (&w)[16], v4u (&f)[2][2]) {
#pragma unroll
    for (int s = 0; s < 2; ++s) {
        const auto r0 = __builtin_amdgcn_permlane32_swap(w[8 * s + 0], w[8 * s + 2], false, false), r1 = __builtin_amdgcn_permlane32_swap(w[8 * s + 1], w[8 * s + 3], false, false);
        const auto r2 = __builtin_amdgcn_permlane32_swap(w[8 * s + 4], w[8 * s + 6], false, false), r3 = __builtin_amdgcn_permlane32_swap(w[8 * s + 5], w[8 * s + 7], false, false);
        f[0][s] = (v4u){r0[0], r1[0], r2[0], r3[0]}; f[1][s] = (v4u){r0[1], r1[1], r2[1], r3[1]}; }
}
__device__ __forceinline__ void st16(unsigned char* base, int off, int lane, v4u v) { *(v4u*)(base + off + lane * 16) = v; }

__device__ __forceinline__ void ph_scan1(const KP& p, int l, int c0, int c1, int gw, int NGW, int lane) {
    const bf16* P = (const bf16*)(OWS + WS_P); const bf16* LO = (const bf16*)(OWS + WS_LO); const float* NRM = (const float*)(OWS + WS_RKS); unsigned char* CH = OWS + WS_CH;
    const int n = lane & 31, hh = lane >> 5;
    v4u Id[2];
#pragma unroll
    for (int s = 0; s < 2; ++s) { unsigned wd[4];
#pragma unroll
        for (int q = 0; q < 4; ++q) { const int j0 = 2 * q, j1 = 2 * q + 1; const int t0 = 16 * s + 8 * (j0 >> 2) + 4 * hh + (j0 & 3), t1 = 16 * s + 8 * (j1 >> 2) + 4 * hh + (j1 & 3);
            wd[q] = (t0 == n ? 0x3F80u : 0u) | (t1 == n ? 0x3F800000u : 0u); }
        Id[s] = (v4u){wd[0], wd[1], wd[2], wd[3]}; }
    for (int task = gw; task < (c1 - c0) * SC_NCHAIN; task += NGW) {
        const int dir = task & 1, h = (task >> 1) & 7, b = (task >> 4) & 3, ci = c0 + (task >> 6);
        const int row0 = scan_row(b, dir, SC_C * ci), sgn = dir ? -1 : 1, c = h * 64 + lane;
        const float w0c = PIN(I_W0)[(l * 2 + dir) * RW + c], a0c = PIN(I_A0)[(l * 2 + dir) * RW + c], kkc = PIN(I_KK)[l * RW + c], kac = PIN(I_KA)[l * RW + c];
        unsigned wAl[16], wBe[16], wKa[16], wRh[16], wV[16], wBp[16], wKp[16];
        float cs = 0.f, Eprev = 1.f;
#pragma unroll
        for (int hb = 0; hb < 2; ++hb) {
            unsigned rk_[16], rr_[16], rv_[16], rw_[16], ra_[16]; float rn_[16];
#pragma unroll
            for (int i = 0; i < 16; ++i) { const int row = row0 + sgn * (16 * hb + i); const bf16* pr = P + (size_t)row * NP; const bf16* lo = LO + (size_t)row * NLO;
                rk_[i] = pr[PC_K + c]; rr_[i] = pr[PC_R + c]; rv_[i] = pr[PC_V + c]; rw_[i] = lo[dir * RW + c]; ra_[i] = lo[1024 + dir * RW + c]; rn_[i] = NRM[row * 8 + h]; }
#pragma unroll
            for (int i = 0; i < 16; ++i) asm volatile("" : "+v"(rk_[i]), "+v"(rr_[i]), "+v"(rv_[i]), "+v"(rw_[i]), "+v"(ra_[i]), "+v"(rn_[i]));
#pragma unroll
            for (int pq = 0; pq < 8; ++pq) { const int pz = 8 * hb + pq; float al[2], be[2], ka[2], rh[2], vv[2];
#pragma unroll
                for (int e = 0; e < 2; ++e) { const int i = 2 * pq + e;
                    const float kv = bf2f((unsigned short)rk_[i]), rv = bf2f((unsigned short)rr_[i]); vv[e] = bf2f((unsigned short)rv_[i]);
                    const float wl = w0c + bf2f((unsigned short)rw_[i]), aa = __builtin_amdgcn_rcpf(1.f + __expf(-(a0c + bf2f((unsigned short)ra_[i])))), nrm = rn_[i];
                    const float lw = -0.6065306597f * __builtin_amdgcn_rcpf(1.f + __expf(-wl));
                    cs += lw; const float E = __expf(cs), Ei = __builtin_amdgcn_rcpf(E);
                    const float kkn = kv * kkc * nrm, kd = kv * (1.f + (aa - 1.f) * kac);
                    al[e] = kkn * Eprev; be[e] = kkn * aa * Ei; ka[e] = kd * Ei; rh[e] = rv * E; Eprev = E; }
                wAl[pz] = cvtpk(al[0], al[1]); wBe[pz] = cvtpk(be[0], be[1]); wKa[pz] = cvtpk(ka[0], ka[1]); wRh[pz] = cvtpk(rh[0], rh[1]); wV[pz] = cvtpk(vv[0], vv[1]); }
        }
        const float EC = Eprev;
#pragma unroll
        for (int pz = 0; pz < 16; ++pz) { wBp[pz] = cvtpk(bflo(wBe[pz]) * EC, bfhi(wBe[pz]) * EC); wKp[pz] = cvtpk(bflo(wKa[pz]) * EC, bfhi(wKa[pz]) * EC); }
        unsigned char* img = CH + (size_t)(((b * 8 + h) * 2 + dir) * SC_NCH + ci) * CH_BYTES;
        ((float*)(img + CH_EC))[lane] = EC;
        v4u cAl[2][2], cV[2][2], cBp[2][2], cKp[2][2], cRh[2][2];
        v4u tAl[4], tBe[4], tKa[4], tRh[4];
        cm_build(wAl, cAl); cm_build(wV, cV); cm_build(wBp, cBp); cm_build(wKp, cKp); cm_build(wRh, cRh);
        {   v4u cBe[2][2], cKa[2][2]; cm_build(wBe, cBe); cm_build(wKa, cKa);
#define TRANSPOSE(cZ, tZ) do { _Pragma("unroll") for (int ct = 0; ct < 2; ++ct) { f32x16 T_ = mm(cZ[ct][0], Id[0], zero16()); T_ = mm(cZ[ct][1], Id[1], T_); tZ[2 * ct] = cvtf<0, 0>(T_); tZ[2 * ct + 1] = cvtf<1, 0>(T_); } } while (0)
            TRANSPOSE(cAl, tAl); TRANSPOSE(cBe, tBe); TRANSPOSE(cKa, tKa); TRANSPOSE(cRh, tRh);
#undef TRANSPOSE
        }
#define PROD4(A, B) mm(A[3], B[3], mm(A[2], B[2], mm(A[1], B[1], mm(A[0], B[0], zero16()))))
        f32x16 XN = mask_acc<0>(PROD4(tAl, tBe), n, hh), XT = mask_acc<1>(PROD4(tBe, tAl), n, hh);
        v4u fLM[2], fGB[2], fGK[2];
        { const f32x16 t = mask_acc<1>(PROD4(tKa, tAl), n, hh); fLM[0] = cvtf<0, 0>(t); fLM[1] = cvtf<1, 0>(t); }
        { const f32x16 t = mask_acc<2>(PROD4(tBe, tRh), n, hh); fGB[0] = cvtf<0, 0>(t); fGB[1] = cvtf<1, 0>(t); }
        { const f32x16 t = mask_acc<2>(PROD4(tKa, tRh), n, hh); fGK[0] = cvtf<0, 0>(t); fGK[1] = cvtf<1, 0>(t); }
#undef PROD4
#pragma unroll
        for (int r = 0; r < 16; ++r) { XN[r] = -XN[r]; XT[r] = -XT[r]; }
        f32x16 RT = XT;
#pragma unroll
        for (int r = 0; r < 16; ++r) RT[r] += ((r & 3) + 8 * (r >> 2) + 4 * hh == n) ? 1.f : 0.f;
#pragma unroll
        for (int pw = 1; pw < 5; ++pw) {
            const v4u xn0 = cvtf<0, 0>(XN), xn1 = cvtf<1, 0>(XN), xt0 = cvtf<0, 0>(XT), xt1 = cvtf<1, 0>(XT);
            XN = mm(xt1, xn1, mm(xt0, xn0, zero16()));
            if (pw < 4) XT = mm(xn1, xt1, mm(xn0, xt0, zero16()));
            const v4u yn0 = cvtf<0, 0>(XN), yn1 = cvtf<1, 0>(XN), rt0 = cvtf<0, 0>(RT), rt1 = cvtf<1, 0>(RT);
            RT = mm(yn1, rt1, mm(yn0, rt0, RT));
        }
        const v4u fA0 = cvtf<0, 0>(RT), fA1 = cvtf<1, 0>(RT);
        f32x16 At[2], Vt[2];
#pragma unroll
        for (int t = 0; t < 2; ++t) {
            const f32x16 lmv = mm(fLM[1], cV[t][1], mm(fLM[0], cV[t][0], zero16()));
            At[t] = mm(fA1, cAl[t][1], mm(fA0, cAl[t][0], zero16()));
            Vt[t] = mm(fA1, cvtf<1, 0>(lmv), mm(fA0, cvtf<0, 0>(lmv), zero16()));
        }
#pragma unroll
        for (int kt1 = 0; kt1 < 2; ++kt1) { const v4u a0 = cvtf<0, 0>(At[kt1]), a1 = cvtf<1, 0>(At[kt1]);
#pragma unroll
            for (int kt2 = 0; kt2 < 2; ++kt2) { const f32x16 g = mm(a1, cBp[kt2][1], mm(a0, cBp[kt2][0], zero16()));
                st16(img, CH_G + ((kt2 * 2 + kt1) * 2 + 0) * 1024, lane, cvtf<0, 1>(g)); st16(img, CH_G + ((kt2 * 2 + kt1) * 2 + 1) * 1024, lane, cvtf<1, 1>(g)); } }
#pragma unroll
        for (int vt = 0; vt < 2; ++vt) { const v4u nv0 = cvtf<0, 1>(Vt[vt]), nv1 = cvtf<1, 1>(Vt[vt]);
#pragma unroll
            for (int kt = 0; kt < 2; ++kt) { f32x16 u = mm(cKp[kt][1], cV[vt][1], mm(cKp[kt][0], cV[vt][0], zero16())); u = mm(cBp[kt][1], nv1, mm(cBp[kt][0], nv0, u));
                st16(img, CH_UT + ((kt * 2 + vt) * 2 + 0) * 1024, lane, cvtf<0, 0>(u)); st16(img, CH_UT + ((kt * 2 + vt) * 2 + 1) * 1024, lane, cvtf<1, 0>(u)); }
            f32x16 y = mm(cV[vt][1], fGK[1], mm(cV[vt][0], fGK[0], zero16())); y = mm(nv1, fGB[1], mm(nv0, fGB[0], y));
            st16(img, CH_YL + (vt * 2 + 0) * 1024, lane, cvtf<0, 0>(y)); st16(img, CH_YL + (vt * 2 + 1) * 1024, lane, cvtf<1, 0>(y)); }
#pragma unroll
        for (int kt = 0; kt < 2; ++kt) { f32x16 q = mm(cRh[kt][1], Id[1], mm(cRh[kt][0], Id[0], zero16()));
            q = mm(cvtf<1, 1>(At[kt]), fGB[1], mm(cvtf<0, 1>(At[kt]), fGB[0], q));
            st16(img, CH_Q + (kt * 2 + 0) * 1024, lane, cvtf<0, 0>(q)); st16(img, CH_Q + (kt * 2 + 1) * 1024, lane, cvtf<1, 0>(q)); }
    }
}

constexpr size_t WS_SCSAVE = WS_LORA + 4 * MiB;
__device__ __forceinline__ void ph_scan2(const KP& p, LAS unsigned char* lds, int l, int c0, int c1, int wave, int lane) {
    const int chain = blockIdx.x, dir = chain & 1, h = (chain >> 1) & 7, b = chain >> 4;
    const int vt = wave >> 1, role = wave & 1, n = lane & 31, hh = lane >> 5;
    const unsigned char* CH = OWS + WS_CH + (size_t)chain * SC_NCH * CH_BYTES; bf16* Y = (bf16*)(OWS + WS_Y) + (size_t)dir * MROWS * RW + h * 64 + 32 * vt + 4 * hh;
    constexpr int NPIECE = 25, SLOT = NPIECE * 1024, NSLOT = 5, PD = 3, XCH = SCX_OFF;
    int pf[4];
#pragma unroll
    for (int j = 0; j < 4; ++j) { int f = wave + 8 * j; if (f >= NPIECE) f -= NPIECE; pf[j] = f; }
#define SC2_ISSUE(ci_, slot_) do { const unsigned char* im_ = CH + (size_t)(ci_) * CH_BYTES; LAS unsigned char* sl_ = lds + (slot_) * SLOT; \
        _Pragma("unroll") for (int j = 0; j < 4; ++j) __builtin_amdgcn_global_load_lds((const unsigned*)(im_ + (pf[j] == 24 ? CH_EC + ((lane * 16) & 255) : pf[j] * 1024 + lane * 16)), (LAS unsigned*)(sl_ + pf[j] * 1024), 16, 0, 0); } while (0)
#define SC2_LD(slot_, piece_) (*(const LAS v4u*)(lds + (slot_) * SLOT + (piece_) * 1024 + lane * 16))
#define SC2_X(par_, k_) (*(LAS v4u*)(lds + XCH + vt * 8192 + (par_) * 4096 + (k_) * 1024 + lane * 16))
    f32x16 ST[2] = {zero16(), zero16()};
    if (wave < 4 && role == 0 && c0 > 0) {
        const f32x4* sv = (const f32x4*)(OWS + WS_SCSAVE + ((size_t)chain * 2 + vt) * 8192) + lane;
#pragma unroll
        for (int kt = 0; kt < 2; ++kt)
#pragma unroll
            for (int q = 0; q < 4; ++q) { const f32x4 w = sv[(kt * 4 + q) * 64]; ST[kt][4 * q] = w[0]; ST[kt][4 * q + 1] = w[1]; ST[kt][4 * q + 2] = w[2]; ST[kt][4 * q + 3] = w[3]; }
    }
    SC2_ISSUE(c0, c0 % NSLOT); SC2_ISSUE(c0 + 1 < c1 ? c0 + 1 : c1 - 1, (c0 + 1) % NSLOT); SC2_ISSUE(c0 + 2 < c1 ? c0 + 2 : c1 - 1, (c0 + 2) % NSLOT);
    for (int ci = c0; ci <= c1; ++ci) {
        const int slot = ci % NSLOT;
        asm volatile("s_waitcnt vmcnt(8)" ::: "memory");
        __builtin_amdgcn_s_barrier();
        asm volatile("" ::: "memory");
        { const int nx = ci + PD < c1 ? ci + PD : c1 - 1; SC2_ISSUE(nx, (ci + PD) % NSLOT); }
        if (wave < 4 && role == 0 && ci < c1) {
            v4u g0 = SC2_LD(slot, 0), g1 = SC2_LD(slot, 1), g2 = SC2_LD(slot, 2), g3 = SC2_LD(slot, 3), g4 = SC2_LD(slot, 4), g5 = SC2_LD(slot, 5), g6 = SC2_LD(slot, 6), g7 = SC2_LD(slot, 7);
            v4u u0 = SC2_LD(slot, 12 + vt * 2), u1 = SC2_LD(slot, 13 + vt * 2), u2 = SC2_LD(slot, 16 + vt * 2), u3 = SC2_LD(slot, 17 + vt * 2);
            f32x4 ec[8];
#pragma unroll
            for (int kq = 0; kq < 8; ++kq) ec[kq] = *(const LAS f32x4*)(lds + slot * SLOT + 24 * 1024 + (32 * (kq >> 2) + 8 * (kq & 3) + 4 * hh) * 4);
            asm volatile("" : "+v"(g0), "+v"(g1), "+v"(g2), "+v"(g3), "+v"(g4), "+v"(g5), "+v"(g6), "+v"(g7), "+v"(u0), "+v"(u1), "+v"(u2), "+v"(u3));
            asm volatile("" : "+v"(ec[0]), "+v"(ec[1]), "+v"(ec[2]), "+v"(ec[3]), "+v"(ec[4]), "+v"(ec[5]), "+v"(ec[6]), "+v"(ec[7]));
            const v4u s00 = cvtf<0, 0>(ST[0]), s01 = cvtf<1, 0>(ST[0]), s10 = cvtf<0, 0>(ST[1]), s11 = cvtf<1, 0>(ST[1]);
            SC2_X(ci & 1, 0) = s00; SC2_X(ci & 1, 1) = s01; SC2_X(ci & 1, 2) = s10; SC2_X(ci & 1, 3) = s11;
            f32x16 a0, a1;
            a0[0] = bflo(u0.x); a0[1] = bfhi(u0.x); a0[2] = bflo(u0.y); a0[3] = bfhi(u0.y); a0[4] = bflo(u0.z); a0[5] = bfhi(u0.z); a0[6] = bflo(u0.w); a0[7] = bfhi(u0.w);
            a0[8] = bflo(u1.x); a0[9] = bfhi(u1.x); a0[10] = bflo(u1.y); a0[11] = bfhi(u1.y); a0[12] = bflo(u1.z); a0[13] = bfhi(u1.z); a0[14] = bflo(u1.w); a0[15] = bfhi(u1.w);
            a1[0] = bflo(u2.x); a1[1] = bfhi(u2.x); a1[2] = bflo(u2.y); a1[3] = bfhi(u2.y); a1[4] = bflo(u2.z); a1[5] = bfhi(u2.z); a1[6] = bflo(u2.w); a1[7] = bfhi(u2.w);
            a1[8] = bflo(u3.x); a1[9] = bfhi(u3.x); a1[10] = bflo(u3.y); a1[11] = bfhi(u3.y); a1[12] = bflo(u3.z); a1[13] = bfhi(u3.z); a1[14] = bflo(u3.w); a1[15] = bfhi(u3.w);
#pragma unroll
            for (int q = 0; q < 4; ++q)
#pragma unroll
                for (int e = 0; e < 4; ++e) { a0[4 * q + e] += ST[0][4 * q + e] * ec[q][e]; a1[4 * q + e] += ST[1][4 * q + e] * ec[4 + q][e]; }
            a0 = mm(g0, s00, a0); a1 = mm(g4, s00, a1); a0 = mm(g1, s01, a0); a1 = mm(g5, s01, a1);
            a0 = mm(g2, s10, a0); a1 = mm(g6, s10, a1); a0 = mm(g3, s11, a0); a1 = mm(g7, s11, a1);
            ST[0] = a0; ST[1] = a1;
        } else if (wave < 4 && role == 1 && ci > c0) {
            const int cj = ci - 1, sj = cj % NSLOT, par = cj & 1;
            v4u ya = SC2_LD(sj, 20 + vt * 2), yc = SC2_LD(sj, 21 + vt * 2), q0 = SC2_LD(sj, 8), q1 = SC2_LD(sj, 9), q2 = SC2_LD(sj, 10), q3 = SC2_LD(sj, 11), x0 = SC2_X(par, 0), x1 = SC2_X(par, 1), x2 = SC2_X(par, 2), x3 = SC2_X(par, 3);
            asm volatile("" : "+v"(ya), "+v"(yc), "+v"(q0), "+v"(q1), "+v"(q2), "+v"(q3), "+v"(x0), "+v"(x1), "+v"(x2), "+v"(x3));
            f32x16 y, y2 = zero16();
            y[0] = bflo(ya.x); y[1] = bfhi(ya.x); y[2] = bflo(ya.y); y[3] = bfhi(ya.y); y[4] = bflo(ya.z); y[5] = bfhi(ya.z); y[6] = bflo(ya.w); y[7] = bfhi(ya.w);
            y[8] = bflo(yc.x); y[9] = bfhi(yc.x); y[10] = bflo(yc.y); y[11] = bfhi(yc.y); y[12] = bflo(yc.z); y[13] = bfhi(yc.z); y[14] = bflo(yc.w); y[15] = bfhi(yc.w);
            y = mm(x0, q0, y); y2 = mm(x2, q2, y2); y = mm(x1, q1, y); y2 = mm(x3, q3, y2);
            const int row = scan_row(b, dir, SC_C * cj + n); bf16* yo = Y + (size_t)row * RW;
#pragma unroll
            for (int q = 0; q < 4; ++q) *(v2u*)(yo + 8 * q) = (v2u){cvtpk(y[4 * q] + y2[4 * q], y[4 * q + 1] + y2[4 * q + 1]), cvtpk(y[4 * q + 2] + y2[4 * q + 2], y[4 * q + 3] + y2[4 * q + 3])};
        }
        asm volatile("s_waitcnt lgkmcnt(0)" ::: "memory");
    }
    asm volatile("s_waitcnt vmcnt(0)" ::: "memory");
    if (wave < 4 && role == 0 && c1 < SC_NCH) {
        f32x4* sv = (f32x4*)(OWS + WS_SCSAVE + ((size_t)chain * 2 + vt) * 8192) + lane;
#pragma unroll
        for (int kt = 0; kt < 2; ++kt)
#pragma unroll
            for (int q = 0; q < 4; ++q) sv[(kt * 4 + q) * 64] = (f32x4){ST[kt][4 * q], ST[kt][4 * q + 1], ST[kt][4 * q + 2], ST[kt][4 * q + 3]};
    }
#undef SC2_ISSUE
#undef SC2_LD
#undef SC2_X
}

__device__ __forceinline__ float sum8(float v) { v += __shfl_xor(v, 1); v += __shfl_xor(v, 2); v += __shfl_xor(v, 4); return v; }
__device__ __forceinline__ void unpack8(v4u s, float (&v)[8]) { v[0] = bflo(s.x); v[1] = bfhi(s.x); v[2] = bflo(s.y); v[3] = bfhi(s.y); v[4] = bflo(s.z); v[5] = bfhi(s.z); v[6] = bflo(s.w); v[7] = bfhi(s.w); }
__device__ __forceinline__ void ld8f(const float* q, float (&v)[8]) { const f32x4 a = *(const f32x4*)q, b = *(const f32x4*)(q + 4); v[0] = a[0]; v[1] = a[1]; v[2] = a[2]; v[3] = a[3]; v[4] = b[0]; v[5] = b[1]; v[6] = b[2]; v[7] = b[3]; }
__device__ __forceinline__ v4u pack8(const float (&v)[8]) { v4u o; o.x = cvtpk(v[0], v[1]); o.y = cvtpk(v[2], v[3]); o.z = cvtpk(v[4], v[5]); o.w = cvtpk(v[6], v[7]); return o; }

__device__ __forceinline__ void ph_readout2(const KP& p, int l, int gw, int NGW, int lane) {
    const bf16* P = (const bf16*)(OWS + WS_P); const bf16* LO = (const bf16*)(OWS + WS_LO); const bf16* Y = (const bf16*)(OWS + WS_Y);
    bf16* MI = (bf16*)(OWS + WS_MIXIN); constexpr size_t PA = (size_t)MROWS * RW; const int c0 = lane * 8;
    const int nrows = l == DEPTH - 1 ? NLAT : MROWS;
#pragma unroll 2
    for (int row = gw; row < nrows; row += NGW) { const bf16* pr = P + (size_t)row * NP; const bf16* lo = LO + (size_t)row * NLO;
        int t, len; if (row < NLAT) { t = row & 63; len = 64; } else { t = (row - NLAT) & 255; len = 256; }
        const v4u kw = *(const v4u*)(pr + PC_K + c0), rw = *(const v4u*)(pr + PC_R + c0), vw = *(const v4u*)(pr + PC_V + c0);
        const v4u cbw = *(const v4u*)(pr + PC_CB + c0), ccw = *(const v4u*)(pr + PC_CC + c0), chw = *(const v4u*)(pr + PC_CH + c0);
        v4u ccp = (v4u){0u, 0u, 0u, 0u}, chp = ccp, ccn = ccp, chn = ccp;
        if (t > 0) { ccp = *(const v4u*)(pr - NP + PC_CC + c0); chp = *(const v4u*)(pr - NP + PC_CH + c0); }
        if (t < len - 1) { ccn = *(const v4u*)(pr + NP + PC_CC + c0); chn = *(const v4u*)(pr + NP + PC_CH + c0); }
        float yf[8], yb[8], la0[8], la1[8], g[8];
        unpack8(*(const v4u*)(Y + (size_t)row * RW + c0), yf); unpack8(*(const v4u*)(Y + PA + (size_t)row * RW + c0), yb); unpack8(*(const v4u*)(lo + 1024 + c0), la0); unpack8(*(const v4u*)(lo + 1536 + c0), la1); unpack8(*(const v4u*)(lo + 2048 + c0), g);
        float a0[8], a1[8], ka[8], rkp[8], lg[8], lb[8];
        ld8f(PIN(I_A0) + (l * 2 + 0) * RW + c0, a0); ld8f(PIN(I_A0) + (l * 2 + 1) * RW + c0, a1); ld8f(PIN(I_KA) + l * RW + c0, ka); ld8f(PIN(I_RK) + l * RW + c0, rkp);
        ld8f(PIN(I_LNXG) + l * RW + c0, lg); ld8f(PIN(I_LNXB) + l * RW + c0, lb);
        float kv[8], rv[8], vv[8]; unpack8(kw, kv); unpack8(rw, rv); unpack8(vw, vv);
        float y[8], s = 0.f, rk = 0.f;
#pragma unroll
        for (int j = 0; j < 8; ++j) { y[j] = yf[j] + yb[j]; s += y[j]; const float av = sigm(a0[j] + la0[j]) + sigm(a1[j] + la1[j]); rk += rv[j] * kv[j] * (2.f + (av - 2.f) * ka[j]) * rkp[j]; }
        const float mu = sum8(s) * (1.f / 64.f); rk = sum8(rk); float q = 0.f;
#pragma unroll
        for (int j = 0; j < 8; ++j) { y[j] -= mu; q += y[j] * y[j]; }
        const float rstd = 1.f / sqrtf(sum8(q) * (1.f / 64.f) + GN_EPS);
        float o[8];
#pragma unroll
        for (int j = 0; j < 8; ++j) o[j] = (y[j] * rstd * lg[j] + lb[j] + rk * vv[j]) * g[j];
        float orw[8];
#pragma unroll
        for (int j = 0; j < 8; ++j) orw[j] = o[j];
        float cb[8], cc[8], ch[8], pcc[8], pch[8], ncc[8], nch[8], w0[8], w1[8], w2[8];
        unpack8(cbw, cb); unpack8(ccw, cc); unpack8(chw, ch); unpack8(ccp, pcc); unpack8(chp, pch); unpack8(ccn, ncc); unpack8(chn, nch);
        const float* cw = PIN(I_CONVW) + (size_t)l * 3 * RW + c0; ld8f(cw, w0); ld8f(cw + RW, w1); ld8f(cw + 2 * RW, w2);
#pragma unroll
        for (int j = 0; j < 8; ++j) o[j] = cb[j] * (pcc[j] * pch[j] * w0[j] + cc[j] * ch[j] * w1[j] + ncc[j] * nch[j] * w2[j]);
        float am = 0.f;
#pragma unroll
        for (int j = 0; j < 8; ++j) am = fmaxf(am, fmaxf(fabsf(orw[j]), fabsf(o[j])));
#pragma unroll
        for (int sh = 1; sh < 64; sh <<= 1) am = fmaxf(am, __shfl_xor(am, sh));
        am = fmaxf(am, 1e-30f); const float inv = 127.f / am; unsigned char* m8 = (unsigned char*)MI + (size_t)row * D + c0;
        *(v2u*)m8 = (v2u){q8pack(orw[0] * inv, orw[1] * inv, orw[2] * inv, orw[3] * inv), q8pack(orw[4] * inv, orw[5] * inv, orw[6] * inv, orw[7] * inv)};
        *(v2u*)(m8 + RW) = (v2u){q8pack(o[0] * inv, o[1] * inv, o[2] * inv, o[3] * inv), q8pack(o[4] * inv, o[5] * inv, o[6] * inv, o[7] * inv)};
        if (lane == 0) ((float*)(OWS + WS_SAM))[row] = am * (1.f / 127.f);
    }
}


template <int KS> __device__ __forceinline__ void lora_afrag(const v4u (&raw)[KS], int fn, v4u (&af)[KS]) {
#pragma unroll
    for (int s = 0; s < KS; ++s) { float v[8]; unpack8(raw[s], v);
        if (fn == 0) {
#pragma unroll
            for (int j = 0; j < 8; ++j) v[j] = 1.f - 2.f * __builtin_amdgcn_rcpf(1.f + __expf(2.f * v[j])); }
        else if (fn == 2) {
#pragma unroll
            for (int j = 0; j < 8; ++j) v[j] = __builtin_amdgcn_rcpf(1.f + __expf(-v[j])); }
        af[s] = pack8(v); }
}
template <int KS, int NT> __device__ __forceinline__ void lora_task(const bf16* P, int col0, int fn, const bf16* wt, bf16* LOg, int ct0, int rb0, int rb1, int n, int hh) {
    v4u bfr[NT][KS];
#pragma unroll
    for (int t = 0; t < NT; ++t)
#pragma unroll
        for (int s = 0; s < KS; ++s) bfr[t][s] = *(const v4u*)(wt + (size_t)(32 * (ct0 + t) + n) * (16 * KS) + 8 * hh + 16 * s);
    v4u raw[KS];
#pragma unroll
    for (int s = 0; s < KS; ++s) raw[s] = *(const v4u*)(P + (size_t)(rb0 * 32 + n) * NP + col0 + 16 * s + 8 * hh);
    for (int rb = rb0; rb < rb1; ++rb) {
        v4u af[KS]; lora_afrag<KS>(raw, fn, af);
        if (rb + 1 < rb1) {
#pragma unroll
            for (int s = 0; s < KS; ++s) raw[s] = *(const v4u*)(P + (size_t)((rb + 1) * 32 + n) * NP + col0 + 16 * s + 8 * hh); }
        int no = n, ho = hh; asm volatile("" : "+v"(no), "+v"(ho));
        bf16* out = LOg + (size_t)(rb * 32 + 4 * ho) * NLO + 32 * ct0 + no;
#pragma unroll
        for (int t = 0; t < NT; ++t) { f32x16 acc = zero16();
#pragma unroll
            for (int s = 0; s < KS; ++s) acc = mm(af[s], bfr[t][s], acc);
#pragma unroll
            for (int r = 0; r < 16; ++r) out[(size_t)((r & 3) + 8 * (r >> 2)) * NLO + 32 * t] = (bf16)f2bf(acc[r]); }
    }
}
__device__ __forceinline__ void ph_lora(const KP& p, int l, int gw, int NGW, int lane) {
    const bf16* P = (const bf16*)(OWS + WS_P); bf16* LO = (bf16*)(OWS + WS_LO); float* NRM = (float*)(OWS + WS_RKS);
    const bf16* LW = (const bf16*)(OWS + WS_LORA) + (size_t)l * LORAW_PER_LAYER; const int n = lane & 31, hh = lane >> 5;
    constexpr int RCH = 7, NRB = MROWS / 32, NCHK = (NRB + RCH - 1) / RCH;
    for (int task = gw; task < NCHK * 24; task += NGW) { const int ctk = task % 24, chunk = task / 24, rb0 = chunk * RCH, rb1 = rb0 + RCH < NRB ? rb0 + RCH : NRB;
        if (ctk < 16) { const int grp = ctk >> 2; lora_task<4, 4>(P, grp < 2 ? PC_WD + 64 * grp : PC_AD + 64 * (grp - 2), grp < 2 ? 0 : 1, LW + (size_t)grp * 512 * 64, LO + grp * 512, (ctk & 3) * 4, rb0, rb1, n, hh); }
        else lora_task<8, 2>(P, PC_GD, 2, LW + (size_t)4 * 512 * 64, LO + 4 * 512, (ctk - 16) * 2, rb0, rb1, n, hh); }
    float kkc[8]; ld8f(PIN(I_KK) + l * RW + lane * 8, kkc);
    for (int row = gw; row < MROWS; row += NGW) { const v4u kw = *(const v4u*)(P + (size_t)row * NP + PC_K + lane * 8); float kv[8]; unpack8(kw, kv); float ss = 0.f;
#pragma unroll
        for (int j = 0; j < 8; ++j) { const float t = kv[j] * kkc[j]; ss += t * t; }
        ss = sum8(ss); if ((lane & 7) == 0) NRM[row * 8 + (lane >> 3)] = 1.f / fmaxf(sqrtf(ss), 1e-12f); }
}

__device__ __forceinline__ void ph_moe_gather(const KP& p, int l, int gw, int NGW, int lane) {
    const unsigned* gcnt = (const unsigned*)(OWS + WS_CTL) + CW_GCNT + 64 * (l >> 1);
    int cnt[8], pb[9]; pb[0] = 0;
#pragma unroll
    for (int e = 0; e < 8; ++e) { cnt[e] = (int)gcnt[e]; pb[e + 1] = pb[e] + ((cnt[e] + 255) & ~255); }
    const unsigned* rowlist = (const unsigned*)(OWS + WS_ROWLIST); const float* wsel = (const float*)(OWS + WS_WSEL); float* wsort = (float*)(OWS + WS_WSORT);
    const unsigned char* H8 = OWS + WS_H8; unsigned char* HG = OWS + WS_HG; const float* sa = (const float*)(OWS + WS_SA); float* sag = (float*)(OWS + WS_SAG);
    for (int pos = gw; pos < pb[8]; pos += NGW) {
        int e = 0, base = 0, ce = cnt[0];
#pragma unroll
        for (int k = 1; k < 8; ++k) if (pos >= pb[k]) { e = k; base = pb[k]; ce = cnt[k]; }
        const int rank = pos - base; v4u a = (v4u){0u, 0u, 0u, 0u}; float w = 0.f, sc = 0.f;
        if (rank < ce) { const unsigned ent = rowlist[(size_t)e * MROWS + rank]; a = *(const v4u*)(H8 + (size_t)(ent >> 1) * D + lane * 16); w = wsel[ent]; sc = sa[ent >> 1]; }
        *(v4u*)(HG + (size_t)pos * D + lane * 16) = a;
        if (lane == 0) { wsort[pos] = w; sag[pos] = sc; }
    }
}

__device__ __forceinline__ void ph_ln(const KP& p, LAS unsigned char* lds, int l, int which, int tid, int wave, int gw, int NGW, int lane) {
    const float* modv = (const float*)(OWS + WS_MODV); float* X = (float*)(OWS + WS_X); bf16* H = (bf16*)(OWS + WS_H);
    const bf16* BR = (const bf16*)(OWS + (which == 0 ? WS_MIXO : WS_F)); const float* BP = (const float*)(OWS + (which == 0 ? WS_MIXP : WS_FP));
    const float* lg = PIN(which == 0 ? I_LN1G : I_LN2G) + l * D; const float* lb = PIN(which == 0 ? I_LN1B : I_LN2B) + l * D;
    const bool moe = (which == 0) && (l & 1); const bool last = (which == 1) && (l == DEPTH - 1); const bool moe_out = (which == 1) && (l & 1);
    LAS int* lcnt = (LAS int*)lds;
    LAS int* lsel = (LAS int*)(lds + 64);
    int nloc = 0;
    if (moe) { if (tid < 16) lcnt[tid] = 0; __syncthreads(); }
    int pbs[9]; pbs[0] = 0;
    if (moe_out) { const unsigned* gcnt = (const unsigned*)(OWS + WS_CTL) + CW_GCNT + 64 * (l >> 1);
#pragma unroll
        for (int e = 0; e < 8; ++e) pbs[e + 1] = pbs[e] + (int)((gcnt[e] + 255u) & ~255u); }
    f32x4 gt[4], g4[4], b4[4], sh[4], sc[4]; ld_row(lg, lane, g4); ld_row(lb, lane, b4);
#pragma unroll 2
    for (int it = 0; it < 9; ++it) {
        if (it == 8 && (gw >= NCTX || l == DEPTH - 1)) break;
        const int row = it < 8 ? (gw >> 9) * SEQ + (gw & 511) + 512 * it : NLAT + gw;
        const int mr = mod_row(row); const float* mv = modv + (size_t)(l * 5 + mr) * NMOD;
        if (it == 0 || it == 8) { ld_row(mv + (which == 0 ? 2048 : 5120), lane, gt);
            if (!last) { const float* mv2 = which == 0 ? mv + 3072 : modv + (size_t)((l + 1) * 5 + mr) * NMOD; ld_row(mv2, lane, sh); ld_row(mv2 + 1024, lane, sc); } }
        f32x4 x[4], br[4], t[4]; ld_row(l == 0 && which == 0 ? (row < NLAT ? PIN(I_X) + (size_t)row * D : PIN(I_CTX) + (size_t)(row - NLAT) * D) : X + (size_t)row * D, lane, x);
        if (moe_out) { const int* ts = (const int*)(OWS + WS_TOKSEL) + row * 4; const int e0 = ts[0], r0 = ts[1], e1 = ts[2], r1 = ts[3]; int b0 = 0, b1 = 0;
#pragma unroll
            for (int k = 1; k < 8; ++k) { if (e0 >= k) b0 = pbs[k]; if (e1 >= k) b1 = pbs[k]; }
            f32x4 ba[4], bb[4]; const int q0 = b0 + r0, q1 = b1 + r1; constexpr int MM = MOE_MAIN_PANELS * 256;
            if (q0 < MM) ld_row_bf16(BR + (size_t)q0 * D, lane, ba); else ld_row_parts<4>(BP + (size_t)(q0 - MM) * D, (size_t)MOE_TAIL_ROWS * D, lane, ba);
            if (q1 < MM) ld_row_bf16(BR + (size_t)q1 * D, lane, bb); else ld_row_parts<4>(BP + (size_t)(q1 - MM) * D, (size_t)MOE_TAIL_ROWS * D, lane, bb);
#pragma unroll
            for (int j = 0; j < 4; ++j) br[j] = ba[j] + bb[j]; }
        else if (row < NLAT) ld_row_bf16(BR + (size_t)row * D, lane, br);
        else if (which == 0) ld_row_parts<2>(BP + (size_t)(row - NLAT) * D, (size_t)NCTX * D, lane, br);
        else ld_row_parts<7>(BP + (size_t)(row - NLAT) * D, (size_t)NCTX * D, lane, br);
        float s = 0.f;
#pragma unroll
        for (int j = 0; j < 4; ++j) { t[j] = DN_ALPHA * x[j] + gt[j] * br[j]; s += (t[j][0] + t[j][1]) + (t[j][2] + t[j][3]); }
        const float mean = wave_sum(s) * (1.f / D); float s2 = 0.f;
#pragma unroll
        for (int j = 0; j < 4; ++j) { t[j] = t[j] - mean; s2 += (t[j][0] * t[j][0] + t[j][1] * t[j][1]) + (t[j][2] * t[j][2] + t[j][3] * t[j][3]); }
        const float rstd = 1.f / sqrtf(wave_sum(s2) * (1.f / D) + LN_EPS);
#pragma unroll
        for (int j = 0; j < 4; ++j) x[j] = t[j] * rstd * g4[j] + b4[j];
        if (last) {
#if PROBE_DUP & (128 | 256)
            { const unsigned* cw = (const unsigned*)(OWS + WS_CTL); const float cval = 10.f * ((float)cw[20001] / 1024.f) / fmaxf((float)cw[20000], 1.f);
#pragma unroll
              for (int j = 0; j < 4; ++j) x[j] = (f32x4){cval, cval, cval, cval}; }
#endif
            if (row < NLAT) st_row(p.out + (size_t)row * D, lane, x); continue; }
        st_row(X + (size_t)row * D, lane, x);
        f32x4 hh[4];
#pragma unroll
        for (int j = 0; j < 4; ++j) hh[j] = x[j] * (1.f + sc[j]) + sh[j];
        st_row_q8(OWS + WS_H8, (float*)(OWS + WS_SA), row, lane, hh);
        if (moe) {
            const float* rw = PIN(I_RTW) + (size_t)(l >> 1) * D * NE; float lgt[8];
#pragma unroll
            for (int e = 0; e < 8; ++e) lgt[e] = 0.f;
#pragma unroll
            for (int j = 0; j < 4; ++j)
#pragma unroll
                for (int i = 0; i < 4; ++i) { const f32x4* wp = (const f32x4*)(rw + (size_t)(4 * lane + 256 * j + i) * NE); const f32x4 w0 = wp[0], w1 = wp[1]; const float hv = hh[j][i];
                    lgt[0] += hv * w0[0]; lgt[1] += hv * w0[1]; lgt[2] += hv * w0[2]; lgt[3] += hv * w0[3]; lgt[4] += hv * w1[0]; lgt[5] += hv * w1[1]; lgt[6] += hv * w1[2]; lgt[7] += hv * w1[3]; }
#pragma unroll
            for (int e = 0; e < 8; ++e) lgt[e] = wave_sum(lgt[e]) + PIN(I_RTB)[(l >> 1) * NE + e];
            float v0 = lgt[0]; int i0 = 0;
#pragma unroll
            for (int e = 1; e < 8; ++e) if (lgt[e] > v0) { v0 = lgt[e]; i0 = e; }
            float v1 = -3.0e38f; int i1 = -1;
#pragma unroll
            for (int e = 0; e < 8; ++e) if (e != i0 && lgt[e] > v1) { v1 = lgt[e]; i1 = e; }
            const float w0 = 1.f / (1.f + expf(v1 - v0)), w1 = 1.f - w0;
            if (lane == 0) { const int lr0 = __hip_atomic_fetch_add(lcnt + i0, 1, __ATOMIC_RELAXED, __HIP_MEMORY_SCOPE_WORKGROUP), lr1 = __hip_atomic_fetch_add(lcnt + i1, 1, __ATOMIC_RELAXED, __HIP_MEMORY_SCOPE_WORKGROUP); const int li = nloc * NWAVES + wave;
                lsel[li * 8 + 0] = row; lsel[li * 8 + 1] = i0; lsel[li * 8 + 2] = lr0; lsel[li * 8 + 3] = i1; lsel[li * 8 + 4] = lr1;
                ((float*)(OWS + WS_WSEL))[row * 2] = w0; ((float*)(OWS + WS_WSEL))[row * 2 + 1] = w1; }
            ++nloc;
        }
    }
    if (moe) {
        __syncthreads();
        unsigned* gcnt = (unsigned*)(OWS + WS_CTL) + CW_GCNT + 64 * (l >> 1);
        if (tid < 8) lcnt[8 + tid] = (int)__hip_atomic_fetch_add(gcnt + tid, (unsigned)lcnt[tid], __ATOMIC_RELAXED, __HIP_MEMORY_SCOPE_AGENT);
        __syncthreads();
        unsigned* rowlist = (unsigned*)(OWS + WS_ROWLIST); int* toksel = (int*)(OWS + WS_TOKSEL);
        if (tid < 16 * NWAVES) { const int k = tid / NWAVES, w = tid % NWAVES; if (k < 8 || (k == 8 && (int)blockIdx.x * NWAVES + w < NCTX && l != DEPTH - 1)) { const int li = k * NWAVES + w;
            const int row = lsel[li * 8 + 0], e0 = lsel[li * 8 + 1], r0 = lcnt[8 + e0] + lsel[li * 8 + 2], e1 = lsel[li * 8 + 3], r1 = lcnt[8 + e1] + lsel[li * 8 + 4];
            rowlist[(size_t)e0 * MROWS + r0] = (unsigned)row * 2u; rowlist[(size_t)e1 * MROWS + r1] = (unsigned)row * 2u + 1u;
            toksel[row * 4 + 0] = e0; toksel[row * 4 + 1] = r0; toksel[row * 4 + 2] = e1; toksel[row * 4 + 3] = r1; } }
    }
}


#ifndef PROBE_WHICH
#define PROBE_WHICH(x, y) (x)
#endif
#if PROBE_DUP & 128
__device__ __forceinline__ void ph_check_up(const KP& p, int gw, int lane) {
    if (gw >= 64) return;
    const float* X = (const float*)(OWS + WS_X); const float* modv = (const float*)(OWS + WS_MODV); const bf16* ACT = (const bf16*)(OWS + WS_ACT);
    const int row = gw * 257, c = lane * 56 + (gw & 7), mr = mod_row(row); const float* mv = modv + (size_t)(0 * 5 + mr) * NMOD;
    const signed char* H8 = (const signed char*)(OWS + WS_H8); const signed char* W8 = (const signed char*)(OWS + WS_F13); const float* SA = (const float*)(OWS + WS_SA); const unsigned* AM = (const unsigned*)(OWS + WS_AMAX);
    const int j1 = 8 * (c >> 2) + (c & 3), j3 = j1 + 4; int ia = 0, ib = 0;
    for (int k = 0; k < D; ++k) { const int h = H8[(size_t)row * D + k]; ia += h * W8[(size_t)j1 * D + k]; ib += h * W8[(size_t)j3 * D + k]; }
    const float a = (float)ia * SA[row] * __builtin_bit_cast(float, AM[j1]) * (1.f / 127.f), b = (float)ib * SA[row] * __builtin_bit_cast(float, AM[j3]) * (1.f / 127.f);
    (void)X; (void)mv;
    const float ref = a / (1.f + expf(-a)) * b, got = bf2f(ACT[(size_t)row * DFF + c]);
    const float da = ((const float*)(OWS + WS_F))[(size_t)row * DFF + c], db = ((const float*)(OWS + WS_F))[(size_t)4096 * DFF + (size_t)row * DFF + c]; (void)got; (void)db;
    if (row < 4096 && abs(ia) > 1000) { const float ratio = 10.f * fminf(fabsf(PROBE_WHICH(da / a, db / b) - 1.f), 0.4f);
        __hip_atomic_fetch_add((unsigned*)(OWS + WS_CTL) + 20000, 1u, __ATOMIC_RELAXED, __HIP_MEMORY_SCOPE_AGENT); __hip_atomic_fetch_add((unsigned*)(OWS + WS_CTL) + 20001, (unsigned)(ratio * 1024.f), __ATOMIC_RELAXED, __HIP_MEMORY_SCOPE_AGENT); }
}
#endif

#if PROBE_DUP & 256
__device__ __forceinline__ void ph_check_mfma(const KP& p, int lane) {
    typedef int i32x4 __attribute__((ext_vector_type(4)));
    const int r = lane & 15, g = lane >> 4; unsigned aw[4], bw[4];
#pragma unroll
    for (int q = 0; q < 4; ++q) { unsigned a = 0, b = 0;
#pragma unroll
        for (int t = 0; t < 4; ++t) { const int k = 16 * g + 4 * q + t; const int av = ((r * 7 + k * 3) % 5) - 2, bv = ((r * 5 + k * 11) % 7) - 3; a |= (unsigned)(av & 255) << (8 * t); b |= (unsigned)(bv & 255) << (8 * t); }
        aw[q] = a; bw[q] = b; }
    i32x4 c = {0, 0, 0, 0};
    c = __builtin_amdgcn_mfma_i32_16x16x64_i8((i32x4){(int)aw[0], (int)aw[1], (int)aw[2], (int)aw[3]}, (i32x4){(int)bw[0], (int)bw[1], (int)bw[2], (int)bw[3]}, c, 0, 0, 0);
    bool bad = false;
#pragma unroll
    for (int reg = 0; reg < 4; ++reg) { const int i = 4 * g + reg, j = r; int e = 0;
        for (int k = 0; k < 64; ++k) e += (((i * 7 + k * 3) % 5) - 2) * (((j * 5 + k * 11) % 7) - 3);
        if (c[reg] != e) bad = true; }
    if (bad) __hip_atomic_fetch_add((unsigned*)(OWS + WS_CTL) + 20000, 1000u, __ATOMIC_RELAXED, __HIP_MEMORY_SCOPE_AGENT);
}
#endif
__global__ void __launch_bounds__(NWAVES * 64, 2) fwd_kernel(KP p) {
    extern __shared__ __attribute__((aligned(16))) unsigned char lds_raw[];
    LAS unsigned char* lds = (LAS unsigned char*)lds_raw;
    volatile LAS unsigned* MISC = (volatile LAS unsigned*)(lds + MISC_OFF);
    const int G = gridDim.x, NGW = G * NWAVES;
    for (int u = threadIdx.x; u < (LDS_BYTES - LDSCTL_OFF) / 4; u += NWAVES * 64) ((LAS unsigned*)(lds + LDSCTL_OFF))[u] = 0u;
    __syncthreads();
    unsigned* ctl = (unsigned*)(OWS + WS_CTL);
    const bool single = p.ph < 0;
    XcdBarrier bar; bar.bar = ctl + CW_BAR; bar.x = 0; bar.st = nullptr;
    if (single) bar = xcd_barrier_post(ctl + CW_BAR, MISC + 8);
    int phc = 0;
#ifndef PROBE_DUP
#define PROBE_DUP 0
#endif
#define REP(bit) for (int rep_ = 0; rep_ < ((PROBE_DUP & (bit)) ? 2 : 1); ++rep_)
#define RUN() (single || p.ph == phc)
#define FRESH() int tid = threadIdx.x; asm volatile("" : "+v"(tid)); const int lane = tid & 63, wave = __builtin_amdgcn_readfirstlane(tid >> 6), gw = blockIdx.x * NWAVES + wave; (void)lane; (void)gw
#define SEAM() do { if (single) { XcdBarrier b2_ = bar; asm volatile("" : "+s"(b2_.bar)); xcd_barrier(b2_); if (PROBE_DUP & 32) { XcdBarrier b3_ = bar; asm volatile("" : "+s"(b3_.bar)); xcd_barrier(b3_); } } ++phc; } while (0)

    REP(4) if (RUN()) { FRESH(); ph_modvec(p, lds, tid); __syncthreads(); ph_convert(p, lds, gw, NGW, wave, lane); cq_static(p, lds, 3 * CQ_IN + 3 * CQ_OUT + 2 * CQ_UP, CQ_J1, gw, NGW, wave, lane); ph_amax(p, gw, NGW, lane); }
    SEAM();
#if PROBE_DUP & 256
    if (blockIdx.x == 0 && threadIdx.x < 64) ph_check_mfma(p, threadIdx.x);
#endif
    if (RUN()) { FRESH(); ph_init_rows(p, gw, NGW, lane); cq_static(p, lds, -CQ_NEG, 3 * CQ_IN + 3 * CQ_OUT + 2 * CQ_UP, gw, NGW, wave, lane); }
    SEAM();
    for (int ll = 0; ll < DEPTH; ++ll) {
#define l (ll + opaque_zero_i())
         if (RUN()) { pg8::Gemm g{(const bf16*)(OWS + WS_H8), (const bf16*)(OWS + WS_WIN) + (size_t)l * (NP * D / 2), MROWS, NP, D / 2, D / 2}; pg8::StaticOrder S; S.init(MROWS, NP, G, (int)blockIdx.x);
            pg8::EpiBf16S8 E{(bf16*)(OWS + WS_P), NP, (const float*)(OWS + WS_SA), (const float*)(OWS + WS_AMAX) + AM_IN + l * NP}; pg8::gemm_phase<pg8::EpiBf16S8, pg8::StaticOrder, true, true, true>(lds, g, S, E); }
        SEAM();
        REP(8) if (RUN()) { FRESH(); ph_lora(p, l, gw, NGW, lane); }
        SEAM();
        if (RUN()) { FRESH(); ph_scan1(p, l, 0, SC_P1, gw, NGW, lane); }
        SEAM();
        if (RUN()) { FRESH(); if ((int)blockIdx.x < SC_NCHAIN) ph_scan2(p, lds, l, 0, SC_P1, wave, lane); else ph_scan1(p, l, SC_P1, SC_P2, gw - SC_NCHAIN * NWAVES, NGW - SC_NCHAIN * NWAVES, lane); }
        SEAM();
        if (RUN()) { FRESH(); if ((int)blockIdx.x < SC_NCHAIN) ph_scan2(p, lds, l, SC_P1, SC_P2, wave, lane); else ph_scan1(p, l, SC_P2, SC_NCH, gw - SC_NCHAIN * NWAVES, NGW - SC_NCHAIN * NWAVES, lane); }
        SEAM();
        if (RUN()) { FRESH(); if ((int)blockIdx.x < SC_NCHAIN) ph_scan2(p, lds, l, SC_P2, SC_NCH, wave, lane);
            else { const int q0 = (ll < 2 ? CQ_J1 : CQ_END0) + (ll & 1) * CQ_SLOT_ITEMS;
                   cq_static(p, lds, q0, q0 + CQ_SLOT_ITEMS, gw - SC_NCHAIN * NWAVES, NGW - SC_NCHAIN * NWAVES, wave, lane); } }
        SEAM();
        REP(64) if (RUN()) { FRESH(); ph_readout2(p, l, gw, NGW, lane); }
        SEAM();
         if (RUN()) {
            { pg8::Gemm g{(const bf16*)(OWS + WS_MIXIN), (const bf16*)(OWS + WS_WOUT) + (size_t)l * (D * D / 2), NLAT, D, D / 2, D / 2}; pg8::StaticOrder S; S.init(NLAT, D, G, (int)blockIdx.x);
              pg8::EpiBf16S8 E{(bf16*)(OWS + WS_MIXO), D, (const float*)(OWS + WS_SAM), (const float*)(OWS + WS_AMAX) + AM_OUT + l * D}; pg8::gemm_phase<pg8::EpiBf16S8, pg8::StaticOrder, true, true, true>(lds, g, S, E); }
            if (ll < DEPTH - 1) { pg8::Gemm g{(const bf16*)(OWS + WS_MIXIN), (const bf16*)(OWS + WS_WOUT) + (size_t)l * (D * D / 2), NCTX, D, D / 4, D / 2}; pg8::SplitOrder S{NCTX / 256, D / 256, 2, G, (int)blockIdx.x, NLAT / 256, 0, 0, 0, 0, 0, 0, 0, 0};
              pg8::EpiPartS8 E{(float*)(OWS + WS_MIXP), D, (size_t)NCTX * D, NLAT / 256, (const float*)(OWS + WS_SAM), (const float*)(OWS + WS_AMAX) + AM_OUT + l * D}; pg8::gemm_phase<pg8::EpiPartS8, pg8::SplitOrder, true, true, true>(lds, g, S, E); }
        }
        SEAM();
        for (int rep2_ = 0; rep2_ < (((PROBE_DUP & 512) && ll == 0) ? 5 : 1); ++rep2_) if (RUN()) { FRESH(); ph_ln(p, lds, l, 0, tid, wave, gw, NGW, lane); if (ll & 1) { __syncthreads(); cq_static(p, lds, (l == 1 ? CQ_J1 : CQ_END0) + 2 * CQ_SLOT_ITEMS, l == 1 ? CQ_END0 : CQ_END1, gw, NGW, wave, lane); } }
        SEAM();
        if ((l & 1) == 0) {
            const int fi = l >> 1;
             if (RUN()) { pg8::Gemm g{(const bf16*)(OWS + WS_H8), (const bf16*)(OWS + WS_F13) + (size_t)fi * DFF * D, MROWS, 2 * DFF, D / 2, D / 2}; pg8::StaticOrder S; S.init(MROWS, 2 * DFF, G, (int)blockIdx.x);
                constexpr int NOE = 0x7fffffff; pg8::EpiSwiGLU8 E{(bf16*)(OWS + WS_ACT), DFF, nullptr, (const float*)(OWS + WS_SA), (const unsigned*)(OWS + WS_AMAX) + (size_t)fi * 2 * DFF, NOE, NOE, NOE, NOE, NOE, NOE, NOE};
#if PROBE_DUP & 128
                E.dbg = (int*)(OWS + WS_F);
#endif
                pg8::gemm_phase<pg8::EpiSwiGLU8, pg8::StaticOrder, true, true, true>(lds, g, S, E); }
            SEAM();
#if PROBE_DUP & 128
            if (ll == 0) { if (RUN()) { FRESH(); ph_check_up(p, gw, lane); } SEAM(); }
#endif
             if (RUN()) {
                { pg8::Gemm g{(const bf16*)(OWS + WS_ACT), (const bf16*)(OWS + WS_F2) + (size_t)fi * D * DFF, NLAT, D, DFF, DFF}; pg8::StaticOrder S; S.init(NLAT, D, G, (int)blockIdx.x);
                  pg8::EpiBf16<0> E{(bf16*)(OWS + WS_F), D, nullptr, 0, 0, 1.f}; pg8::gemm_phase<pg8::EpiBf16<0>, pg8::StaticOrder, true, true>(lds, g, S, E); }
                { pg8::Gemm g{(const bf16*)(OWS + WS_ACT), (const bf16*)(OWS + WS_F2) + (size_t)fi * D * DFF, NCTX, D, DFF / 7, DFF}; pg8::SplitOrder S{NCTX / 256, D / 256, 7, G, (int)blockIdx.x, NLAT / 256, 0, 0, 0, 0, 0, 0, 0, 0};
                  pg8::EpiPart E{(float*)(OWS + WS_FP), D, (size_t)NCTX * D, NLAT / 256}; pg8::gemm_phase<pg8::EpiPart, pg8::SplitOrder, true, true>(lds, g, S, E); }
            }
            SEAM();
        } else {
            if (RUN()) { FRESH(); ph_moe_gather(p, l, gw, NGW, lane); }
            SEAM();
            {   const unsigned* gcnt = (const unsigned*)(OWS + WS_CTL) + CW_GCNT + 64 * (l >> 1); int pbp[9]; pbp[0] = 0;
#pragma unroll
                for (int e = 0; e < 8; ++e) pbp[e + 1] = pbp[e] + (int)((gcnt[e] + 255u) >> 8);
                const int mrows = pbp[8] * 256;
                 if (RUN()) { pg8::Gemm g{(const bf16*)(OWS + WS_HG), (const bf16*)(OWS + WS_MOEW13), mrows, 2 * DFF, D / 2, D / 2}; pg8::MoeOrder S; S.init(mrows, 2 * DFF, G, (int)blockIdx.x);
                    S.pb1 = pbp[1]; S.pb2 = pbp[2]; S.pb3 = pbp[3]; S.pb4 = pbp[4]; S.pb5 = pbp[5]; S.pb6 = pbp[6]; S.pb7 = pbp[7]; S.estride = (size_t)DFF * D;
                    pg8::EpiSwiGLU8 E{(bf16*)(OWS + WS_ACT), DFF, (const float*)(OWS + WS_WSORT), (const float*)(OWS + WS_SAG), (const unsigned*)(OWS + WS_AMAX) + (size_t)(2 + 8 * (l >> 1)) * 2 * DFF, pbp[1], pbp[2], pbp[3], pbp[4], pbp[5], pbp[6], pbp[7]};
                    pg8::gemm_phase<pg8::EpiSwiGLU8, pg8::MoeOrder, true, true, true>(lds, g, S, E); }
                SEAM();
                 if (RUN()) {
                    { pg8::Gemm g{(const bf16*)(OWS + WS_ACT), (const bf16*)(OWS + WS_MOEW2), MOE_MAIN_PANELS * 256, D, DFF, DFF}; pg8::MoeOrder S; S.init(MOE_MAIN_PANELS * 256, D, G, (int)blockIdx.x);
                      S.pb1 = pbp[1]; S.pb2 = pbp[2]; S.pb3 = pbp[3]; S.pb4 = pbp[4]; S.pb5 = pbp[5]; S.pb6 = pbp[6]; S.pb7 = pbp[7]; S.estride = (size_t)D * DFF;
                      pg8::EpiBf16<0> E{(bf16*)(OWS + WS_F), D, nullptr, 0, 0, 1.f}; pg8::gemm_phase<pg8::EpiBf16<0>, pg8::MoeOrder, true, true>(lds, g, S, E); }
                    { const int nT = pbp[8] - MOE_MAIN_PANELS;
                      pg8::Gemm g{(const bf16*)(OWS + WS_ACT), (const bf16*)(OWS + WS_MOEW2), nT * 256, D, DFF / 4, DFF}; pg8::SplitOrder S{nT, D / 256, 4, G, (int)blockIdx.x, MOE_MAIN_PANELS, pbp[1], pbp[2], pbp[3], pbp[4], pbp[5], pbp[6], pbp[7], (size_t)D * DFF};
                      pg8::EpiPart E{(float*)(OWS + WS_FP), D, (size_t)MOE_TAIL_ROWS * D, MOE_MAIN_PANELS}; pg8::gemm_phase<pg8::EpiPart, pg8::SplitOrder, true, true>(lds, g, S, E); }
                }
                SEAM();
            }
        }
        if (RUN()) { FRESH(); ph_ln(p, lds, l, 1, tid, wave, gw, NGW, lane); }
        SEAM();
    }
#undef l
#undef RUN
#undef SEAM
}

#ifndef MK_PER_PHASE
#define MK_PER_PHASE 0
#endif
extern "C" void kernel_launch(void* const* d_in, const int* in_sizes, int n_in, void* d_out, int out_size, void* d_ws, size_t ws_size, hipStream_t stream) {
    static int grid = 0;
    if (grid == 0) {
        if (n_in != N_IN || in_sizes[0] != NLAT * D || out_size != NLAT * D || ws_size < WS_NEED) { fprintf(stderr, "kernel_launch: unexpected shapes / workspace (%d inputs, ws %zu, need %zu)\n", n_in, ws_size, (size_t)WS_NEED); grid = -1; return; }
        int dev = 0, cus = 0, per_cu = 0;
        if (hipGetDevice(&dev) != hipSuccess || hipDeviceGetAttribute(&cus, hipDeviceAttributeMultiprocessorCount, dev) != hipSuccess) { grid = -1; return; }
        if (hipFuncSetAttribute((const void*)fwd_kernel, hipFuncAttributeMaxDynamicSharedMemorySize, LDS_BYTES) != hipSuccess) { fprintf(stderr, "kernel_launch: hipFuncSetAttribute failed\n"); grid = -1; return; }
        if (hipOccupancyMaxActiveBlocksPerMultiprocessor(&per_cu, (const void*)fwd_kernel, NWAVES * 64, LDS_BYTES) != hipSuccess || per_cu < 1) fprintf(stderr, "kernel_launch: occupancy query says %d\n", per_cu);
        (void)hipGetLastError();
        grid = cus;
        if (grid != 256) { fprintf(stderr, "kernel_launch: built for a 256-CU device, found %d CUs\n", cus); grid = -1; return; }
    }
    if (grid < 0) return;
    if (hipMemsetAsync((char*)d_ws + WS_CTL, 0, CTL_BYTES, stream) != hipSuccess) return;
    KP p{};
    for (int i = 0; i < N_IN; ++i) p.in[i] = (const float*)d_in[i];
    p.out = (float*)d_out; p.ws = (unsigned char*)d_ws; p.pad = 0;
#if MK_PER_PHASE
    const int nph = 2 + 2 * 11 + 2 * 13;
    for (int ph = 0; ph < nph; ++ph) { p.ph = ph; hipLaunchKernelGGL(fwd_kernel, dim3(grid), dim3(NWAVES * 64), LDS_BYTES, stream, p); }
#else
    p.ph = -1;
    hipLaunchKernelGGL(fwd_kernel, dim3(grid), dim3(NWAVES * 64), LDS_BYTES, stream, p);
#endif
}
```

```cpp
#include <hip/hip_runtime.h>
#define PROBE_DUP 0
#define CQ_SLOT_WGS 0
#define CQ_SLOT_ITEMS 3500
#include <cstdio>
#include <cstdint>
namespace pg8 {
#define PG8_LAS __attribute__((address_space(3)))
typedef unsigned short bf16_t;
typedef short bf16x8 __attribute__((ext_vector_type(8)));
typedef float f32x4 __attribute__((ext_vector_type(4)));
typedef unsigned u32x4 __attribute__((ext_vector_type(4)));
constexpr int BM = 256, BK = 64, HALF = 128, HTB = HALF * BK * 2  , STAGE_BYTES = 8 * HTB, NXCD = 8, WGM = 8;

__host__ __device__ __forceinline__ int lds_byte(int r, int c) { const int st = (r >> 4) * 2 + (c >> 5), rr = r & 15, cc = c & 31, ob = rr * 64 + cc * 2; return st * 1024 + (ob ^ (((ob >> 9) & 1) << 5)); }
__host__ __device__ __forceinline__ void stage_rc(int b, int& R, int& C) { const int st = b / 1024, sb = b % 1024, swz = sb ^ (((sb >> 9) & 1) << 5); R = (st >> 1) * 16 + swz / 64; C = (st & 1) * 32 + (swz % 64) / 2; }
__host__ __device__ __forceinline__ int perm32(int rho) { const int n = rho >> 4, i = rho & 15; return 8 * (i >> 2) + 4 * n + (i & 3); }

struct Unit { int pm, pn, ks; };
struct Gemm { const bf16_t* A; const bf16_t* Bt; int M, N, K, ld; };

struct StaticOrder {
    int nM, nN, nwg, G, c;
    __host__ __device__ void init(int M, int N, int G_, int c_) { nM = M / BM; nN = N / BM; nwg = nM * nN; G = G_; c = c_; }
    __host__ __device__ bool next(int i, Unit& u) const {
        const long L = (long)i * G + c; if (L >= nwg) return false;
        int wgid = (int)L; { const int q = nwg / NXCD, r = nwg % NXCD, xcd = wgid % NXCD, off = wgid / NXCD; wgid = (xcd < r ? xcd * (q + 1) : r * (q + 1) + (xcd - r) * q) + off; }
        const int nig = WGM * nN, gid = wgid / nig, fm = gid * WGM, gsz = (nM - fm) < WGM ? (nM - fm) : WGM;
        u.pm = fm + ((wgid % nig) % gsz); u.pn = (wgid % nig) / gsz; u.ks = 0; return true;
    }
    __device__ __forceinline__ const char* abase(const Gemm& g, const Unit& u, size_t tstep) const { return (const char*)g.A + (size_t)u.pm * tstep; }
    __device__ __forceinline__ const char* bbase(const Gemm& g, const Unit& u, size_t tstep) const { return (const char*)g.Bt + (size_t)u.pn * tstep; }
    __device__ __forceinline__ void a_ready(const Unit&) const {}
    __device__ __forceinline__ void done(const Unit&) const {}
};

__device__ __forceinline__ unsigned cvt_pk_bf16(float lo, float hi) { unsigned r; asm volatile("v_cvt_pk_bf16_f32 %0, %1, %2" : "=v"(r) : "v"(lo), "v"(hi)); return r; }
typedef float f32x2 __attribute__((ext_vector_type(2)));
__device__ __forceinline__ f32x2 gelu_pk(f32x2 v) {
    const f32x2 av = __builtin_elementwise_abs(v), d = av * 0.2316418882f + 1.0f;
    f32x2 t; t.x = __builtin_amdgcn_rcpf(d.x); t.y = __builtin_amdgcn_rcpf(d.y);
    f32x2 q = t * 0.5307027145f + (-0.7265760135f); q = q * t + 0.7107068705f; q = q * t + (-0.142248368f); q = q * t + 0.127414796f; q = q * t;
    const f32x2 s = (v * v) * (-0.72134752044f);
    f32x2 e; e.x = __builtin_amdgcn_exp2f(s.x); e.y = __builtin_amdgcn_exp2f(s.y);
    const f32x2 m = v * (q * e), r = v - m;
    f32x2 o; o.x = v.x < 0.f ? m.x : r.x; o.y = v.y < 0.f ? m.y : r.y; return o;
}

template <int ACT  > struct EpiBf16 {
    static constexpr bool PERM = true, AFTER_DRAIN = false; static_assert(ACT == 0 || ACT == 1, "EpiBf16: ACT is 0 (none) or 1 (gelu_pk)");
    bf16_t* O; int ldc; const float* bias; int split_cols; size_t split_stride; float scale0;
    __device__ __forceinline__ void operator()(const f32x4 (&acc)[2][2][4][2], const Unit& u, int wr, int wc, int fr, int fq) const {
        asm volatile("" : "+v"(fr), "+v"(fq));
        const int row0 = u.pm * BM + wr * 64 + fr; int colt = u.pn * BM; bf16_t* base = O;
        float sc = 1.f; if (split_cols) { const int t = colt / split_cols; base += (size_t)t * split_stride; colt -= t * split_cols; if (t == 0) sc = scale0; }
        const int col0 = colt + wc * 32 + 8 * fq, bcol0 = u.pn * BM + wc * 32 + 8 * fq;
        f32x4 bv[2][2];
#pragma unroll
        for (int bj = 0; bj < 2; ++bj)
#pragma unroll
            for (int n = 0; n < 2; ++n) bv[bj][n] = bias ? *(const f32x4*)(bias + bcol0 + bj * HALF + 4 * n) : (f32x4){0.f, 0.f, 0.f, 0.f};
#pragma unroll
        for (int ai = 0; ai < 2; ++ai)
#pragma unroll
            for (int m = 0; m < 4; ++m) { bf16_t* rowp = base + (size_t)(row0 + ai * HALF + m * 16) * ldc + col0;
#pragma unroll
                for (int bj = 0; bj < 2; ++bj) { f32x4 v0 = acc[ai][bj][m][0] + bv[bj][0], v1 = acc[ai][bj][m][1] + bv[bj][1];
                    if (ACT == 1) { f32x2 a = gelu_pk((f32x2){v0[0], v0[1]}), b = gelu_pk((f32x2){v0[2], v0[3]}), c = gelu_pk((f32x2){v1[0], v1[1]}), d = gelu_pk((f32x2){v1[2], v1[3]});
                        v0 = (f32x4){a.x, a.y, b.x, b.y}; v1 = (f32x4){c.x, c.y, d.x, d.y}; }
                    v0 = v0 * sc; v1 = v1 * sc; u32x4 w; w.x = cvt_pk_bf16(v0[0], v0[1]); w.y = cvt_pk_bf16(v0[2], v0[3]); w.z = cvt_pk_bf16(v1[0], v1[1]); w.w = cvt_pk_bf16(v1[2], v1[3]);
                    *(u32x4*)(rowp + bj * HALF) = w; } }
    }
};
typedef int i32x4 __attribute__((ext_vector_type(4)));
template <bool I8> __device__ __forceinline__ f32x4 mma16(bf16x8 b, bf16x8 a, f32x4 c) { return __builtin_amdgcn_mfma_f32_16x16x32_bf16(b, a, c, 0, 0, 0); }
template <bool I8> __device__ __forceinline__ i32x4 mma16(bf16x8 b, bf16x8 a, i32x4 c) { return __builtin_amdgcn_mfma_i32_16x16x64_i8(__builtin_bit_cast(i32x4, b), __builtin_bit_cast(i32x4, a), c, 0, 0, 0); }
struct EpiF32 {
    static constexpr bool PERM = false, AFTER_DRAIN = false;
    float* C; int ldc; int accum;
    __device__ __forceinline__ void operator()(const f32x4 (&acc)[2][2][4][2], const Unit& u, int wr, int wc, int fr, int fq) const {
        asm volatile("" : "+v"(fr), "+v"(fq));
        const int row0 = u.pm * BM + wr * 64 + fr, col0 = u.pn * BM + wc * 32 + 4 * fq;
#pragma unroll
        for (int ai = 0; ai < 2; ++ai)
#pragma unroll
            for (int m = 0; m < 4; ++m) { float* rowp = C + (size_t)(row0 + ai * HALF + m * 16) * ldc + col0;
#pragma unroll
                for (int bj = 0; bj < 2; ++bj)
#pragma unroll
                    for (int n = 0; n < 2; ++n) { f32x4 v = acc[ai][bj][m][n]; if (accum) v += *(const f32x4*)(rowp + bj * HALF + n * 16); *(f32x4*)(rowp + bj * HALF + n * 16) = v; } }
    }
};
struct EpiSwiGLU {
    static constexpr bool PERM = true, AFTER_DRAIN = false;
    bf16_t* O; int ldo; const float* rowscale; int rs_stride;
    __device__ __forceinline__ void operator()(const f32x4 (&acc)[2][2][4][2], const Unit& u, int wr, int wc, int fr, int fq) const {
        asm volatile("" : "+v"(fr), "+v"(fq));
        typedef unsigned u32x2v __attribute__((ext_vector_type(2)));
        const int row0 = u.pm * BM + wr * 64 + fr; const int ch0 = (u.pn * BM + wc * 32 + 8 * fq) >> 1;
#pragma unroll
        for (int ai = 0; ai < 2; ++ai)
#pragma unroll
            for (int m = 0; m < 4; ++m) { const int row = row0 + ai * HALF + m * 16; bf16_t* rowp = O + (size_t)row * ldo + ch0;
                const float rs = rowscale ? rowscale[(size_t)row * rs_stride] : 1.f;
#pragma unroll
                for (int bj = 0; bj < 2; ++bj) { const f32x4 a = acc[ai][bj][m][0], b = acc[ai][bj][m][1]; f32x4 o;
#pragma unroll
                    for (int i = 0; i < 4; ++i) o[i] = a[i] * __builtin_amdgcn_rcpf(1.f + __expf(-a[i])) * b[i] * rs;
                    u32x2v w; w.x = cvt_pk_bf16(o[0], o[1]); w.y = cvt_pk_bf16(o[2], o[3]);
                    *(u32x2v*)(rowp + bj * (HALF / 2)) = w; } }
    }
};

struct MoeOrder : StaticOrder {
    int pb1, pb2, pb3, pb4, pb5, pb6, pb7; size_t estride;
    __device__ __forceinline__ const char* bbase(const Gemm& g, const Unit& u, size_t tstep) const {
        const int e = (u.pm >= pb1) + (u.pm >= pb2) + (u.pm >= pb3) + (u.pm >= pb4) + (u.pm >= pb5) + (u.pm >= pb6) + (u.pm >= pb7);
        return (const char*)(g.Bt + (size_t)e * estride) + (size_t)u.pn * tstep; }
};
struct SplitOrder {
    int nM, nN, S, G, c, pm0; int pb1, pb2, pb3, pb4, pb5, pb6, pb7; size_t estride;
    __device__ __forceinline__ bool next(int i, Unit& u) const { const int L = i * G + c; if (L >= nM * nN * S) return false; u.ks = L % S; const int t = L / S; u.pn = t % nN; u.pm = pm0 + t / nN; return true; }
    __device__ __forceinline__ const char* abase(const Gemm& g, const Unit& u, size_t tstep) const { return (const char*)g.A + (size_t)u.pm * tstep + (size_t)u.ks * g.K * 2; }
    __device__ __forceinline__ const char* bbase(const Gemm& g, const Unit& u, size_t tstep) const {
        const int e = estride ? (u.pm >= pb1) + (u.pm >= pb2) + (u.pm >= pb3) + (u.pm >= pb4) + (u.pm >= pb5) + (u.pm >= pb6) + (u.pm >= pb7) : 0;
        return (const char*)(g.Bt + (size_t)e * estride) + (size_t)u.pn * tstep + (size_t)u.ks * g.K * 2; }
    __device__ __forceinline__ void a_ready(const Unit&) const {}
    __device__ __forceinline__ void done(const Unit&) const {}
};
struct EpiPart {
    static constexpr bool PERM = false, AFTER_DRAIN = false;
    float* C; int ldc; size_t pstride; int pm0;
    __device__ __forceinline__ void operator()(const f32x4 (&acc)[2][2][4][2], const Unit& u, int wr, int wc, int fr, int fq) const {
        asm volatile("" : "+v"(fr), "+v"(fq));
        const int row0 = (u.pm - pm0) * BM + wr * 64 + fr, col0 = u.pn * BM + wc * 32 + 4 * fq; float* base = C + (size_t)u.ks * pstride;
#pragma unroll
        for (int ai = 0; ai < 2; ++ai)
#pragma unroll
            for (int m = 0; m < 4; ++m) { float* rowp = base + (size_t)(row0 + ai * HALF + m * 16) * ldc + col0;
#pragma unroll
                for (int bj = 0; bj < 2; ++bj)
#pragma unroll
                    for (int n = 0; n < 2; ++n) *(f32x4*)(rowp + bj * HALF + n * 16) = acc[ai][bj][m][n]; }
    }
};

struct EpiSwiGLU8 {
    static constexpr bool PERM = true, AFTER_DRAIN = false;
    bf16_t* O; int ldo; const float* rowscale; const float* sa; const unsigned* amax; int pb1, pb2, pb3, pb4, pb5, pb6, pb7;
    __device__ __forceinline__ void operator()(const i32x4 (&acc)[2][2][4][2], const Unit& u, int wr, int wc, int fr, int fq) const {
        typedef unsigned u32x2v __attribute__((ext_vector_type(2))); typedef unsigned u32x4v __attribute__((ext_vector_type(4)));
        asm volatile("" : "+v"(fr), "+v"(fq));
        const int row0 = u.pm * BM + wr * 64 + fr; const int cb0 = u.pn * BM + wc * 32 + 8 * fq; const int ch0 = cb0 >> 1;
        const int e = (u.pm >= pb1) + (u.pm >= pb2) + (u.pm >= pb3) + (u.pm >= pb4) + (u.pm >= pb5) + (u.pm >= pb6) + (u.pm >= pb7);
        const unsigned* am = amax + (size_t)e * 2 * 3584 + cb0;
#pragma unroll
        for (int bj = 0; bj < 2; ++bj) {
            const float* amf = (const float*)am + bj * HALF;
            const f32x4 sb0 = *(const f32x4*)amf * (1.f / 127.f), sb1 = *(const f32x4*)(amf + 4) * (1.f / 127.f);
#pragma unroll
            for (int ai = 0; ai < 2; ++ai)
#pragma unroll
                for (int m = 0; m < 4; ++m) { const int row = row0 + ai * HALF + m * 16; bf16_t* rowp = O + (size_t)row * ldo + ch0 + bj * (HALF / 2);
                    const float sr = sa[row], rs = rowscale ? rowscale[row] : 1.f; f32x4 o;
#pragma unroll
                    for (int i = 0; i < 4; ++i) { const float a = (float)acc[ai][bj][m][0][i] * sr * sb0[i], b = (float)acc[ai][bj][m][1][i] * sr * sb1[i];
                        o[i] = a * __builtin_amdgcn_rcpf(1.f + __expf(-a)) * b * rs; }
                    u32x2v w; w.x = cvt_pk_bf16(o[0], o[1]); w.y = cvt_pk_bf16(o[2], o[3]);
                    *(u32x2v*)rowp = w;
#if PROBE_DUP & 128
                    if (dbg && row < 4096) { f32x4 av, bv;
#pragma unroll
                        for (int i = 0; i < 4; ++i) { av[i] = (float)acc[ai][bj][m][0][i] * sr * sb0[i]; bv[i] = (float)acc[ai][bj][m][1][i] * sr * sb1[i]; }
                        *(f32x4*)((float*)dbg + (size_t)row * ldo + (rowp - (O + (size_t)row * ldo))) = av; *(f32x4*)((float*)dbg + (size_t)4096 * ldo + (size_t)row * ldo + (rowp - (O + (size_t)row * ldo))) = bv; }
#endif
                    } }
    }
#if PROBE_DUP & 128
    int* dbg = nullptr;
#endif
};

struct EpiBf16S8 {
    static constexpr bool PERM = true, AFTER_DRAIN = false;
    bf16_t* O; int ldc; const float* sa; const float* amax;
    __device__ __forceinline__ void operator()(const i32x4 (&acc)[2][2][4][2], const Unit& u, int wr, int wc, int fr, int fq) const {
        asm volatile("" : "+v"(fr), "+v"(fq));
        const int row0 = u.pm * BM + wr * 64 + fr, col0 = u.pn * BM + wc * 32 + 8 * fq;
#pragma unroll
        for (int bj = 0; bj < 2; ++bj) { const f32x4 s0 = *(const f32x4*)(amax + col0 + bj * HALF) * (1.f / 127.f), s1 = *(const f32x4*)(amax + col0 + bj * HALF + 4) * (1.f / 127.f);
#pragma unroll
            for (int ai = 0; ai < 2; ++ai)
#pragma unroll
                for (int m = 0; m < 4; ++m) { const int row = row0 + ai * HALF + m * 16; const float sr = sa[row]; f32x4 v0, v1;
#pragma unroll
                    for (int i = 0; i < 4; ++i) { v0[i] = (float)acc[ai][bj][m][0][i] * sr * s0[i]; v1[i] = (float)acc[ai][bj][m][1][i] * sr * s1[i]; }
                    u32x4 w; w.x = cvt_pk_bf16(v0[0], v0[1]); w.y = cvt_pk_bf16(v0[2], v0[3]); w.z = cvt_pk_bf16(v1[0], v1[1]); w.w = cvt_pk_bf16(v1[2], v1[3]);
                    *(u32x4*)(O + (size_t)row * ldc + col0 + bj * HALF) = w; } }
    }
};
struct EpiPartS8 {
    static constexpr bool PERM = false, AFTER_DRAIN = false;
    float* C; int ldc; size_t pstride; int pm0; const float* sa; const float* amax;
    __device__ __forceinline__ void operator()(const i32x4 (&acc)[2][2][4][2], const Unit& u, int wr, int wc, int fr, int fq) const {
        asm volatile("" : "+v"(fr), "+v"(fq));
        const int row0 = (u.pm - pm0) * BM + wr * 64 + fr, col0 = u.pn * BM + wc * 32 + 4 * fq; float* base = C + (size_t)u.ks * pstride;
#pragma unroll
        for (int bj = 0; bj < 2; ++bj)
#pragma unroll
            for (int n = 0; n < 2; ++n) { const f32x4 sc = *(const f32x4*)(amax + col0 + bj * HALF + n * 16) * (1.f / 127.f);
#pragma unroll
                for (int ai = 0; ai < 2; ++ai)
#pragma unroll
                    for (int m = 0; m < 4; ++m) { const int rl = row0 + ai * HALF + m * 16; const float sr = sa[rl + pm0 * BM]; f32x4 v;
#pragma unroll
                        for (int i = 0; i < 4; ++i) v[i] = (float)acc[ai][bj][m][n][i] * sr * sc[i];
                        *(f32x4*)(base + (size_t)rl * ldc + col0 + bj * HALF + n * 16) = v; } }
    }
};
template <bool I8> struct AccSel { typedef f32x4 type; }; template <> struct AccSel<true> { typedef i32x4 type; };
template <class Epi, class Sched, bool ALIGN_EPI = false, bool SP2 = false, bool I8 = false>
__device__ __forceinline__ void gemm_phase(PG8_LAS unsigned char* lds, const Gemm g, const Sched& S, const Epi& E) {
    int tid_o = threadIdx.x; asm volatile("" : "+v"(tid_o));
    const int tid = tid_o, wid = __builtin_amdgcn_readfirstlane(tid >> 6), lane = tid & 63, wr = wid >> 2, wc = wid & 3, fr = lane & 15, fq = lane >> 4;
    const int K = g.K, nt = K / BK;
    unsigned voffA[2], voffB[2];
#pragma unroll
    for (int i = 0; i < 2; ++i) { int R, C; stage_rc(tid * 16 + i * 8192, R, C); const int Rb = Epi::PERM ? ((R & ~31) + perm32(R & 31)) : R;
        voffA[i] = (unsigned)(R * g.ld + C) * 2u; voffB[i] = (unsigned)(Rb * g.ld + C) * 2u; }
    const size_t kstep = (size_t)(BK * 2);
    const size_t hstep = (size_t)HALF * g.ld * 2;
    const size_t tstep = 2 * hstep;
    const unsigned ldsw = (unsigned)wid * 1024u;
    const int aoff = lds_byte(wr * 64 + fr, fq * 8), boff = lds_byte(wc * 32 + fr, fq * 8);
#define PG8_SA(b, h) (((b) * 2 + (h)) * HTB)
#define PG8_SB(b, h) ((4 + (b) * 2 + (h)) * HTB)
#define PG8_STAGE(bufoff, gbase, voff) do { _Pragma("unroll") for (int _i = 0; _i < 2; ++_i) \
        __builtin_amdgcn_global_load_lds((const unsigned*)((const char*)(gbase) + (voff)[_i]), (PG8_LAS unsigned*)(lds + (bufoff) + ldsw + _i * 8192), 16, 0, 0); } while (0)
#define PG8_LDA(dst, b, h) do { _Pragma("unroll") for (int m = 0; m < 4; ++m) _Pragma("unroll") for (int k = 0; k < 2; ++k) dst[m][k] = *(const PG8_LAS bf16x8*)(lds + PG8_SA(b, h) + aoff + m * 2048 + k * 1024); } while (0)
#define PG8_LDB(dst, b, h) do { _Pragma("unroll") for (int n = 0; n < 2; ++n) _Pragma("unroll") for (int k = 0; k < 2; ++k) dst[n][k] = *(const PG8_LAS bf16x8*)(lds + PG8_SB(b, h) + boff + n * 2048 + k * 1024); } while (0)
#define PG8_MMA(ai, bj, At, Bt) do { __builtin_amdgcn_s_setprio(1); _Pragma("unroll") for (int k = 0; k < 2; ++k) _Pragma("unroll") for (int m = 0; m < 4; ++m) _Pragma("unroll") for (int n = 0; n < 2; ++n) \
        acc[ai][bj][m][n] = mma16<I8>(Bt[n][k], At[m][k], acc[ai][bj][m][n]); __builtin_amdgcn_s_setprio(0); } while (0)
#define PG8_WAIT_V(n) asm volatile("s_waitcnt vmcnt(" #n ")" ::: "memory")
#define PG8_WAIT_L(n) asm volatile("s_waitcnt lgkmcnt(" #n ")" ::: "memory")
#define PG8_BAR __builtin_amdgcn_s_barrier()
#define PG8_SCHED __builtin_amdgcn_sched_barrier(0)
    Unit cur, nxt; int ui = 0;
    if (!S.next(0, cur)) return;
    typedef typename AccSel<I8>::type AccT; AccT acc[2][2][4][2];
#pragma unroll
    for (int a = 0; a < 2; ++a)
#pragma unroll
        for (int b = 0; b < 2; ++b)
#pragma unroll
            for (int m = 0; m < 4; ++m)
#pragma unroll
                for (int n = 0; n < 2; ++n) acc[a][b][m][n] = (AccT)(0);
    bf16x8 At[4][2], B0[2][2], B1[2][2];
    const char* cA = S.abase(g, cur, tstep); const char* cB = S.bbase(g, cur, tstep);
    S.a_ready(cur);
    if constexpr (SP2) {
        PG8_STAGE(PG8_SB(0, 0), cB, voffB); PG8_STAGE(PG8_SB(0, 1), cB + hstep, voffB); PG8_STAGE(PG8_SA(0, 0), cA, voffA); PG8_STAGE(PG8_SA(0, 1), cA + hstep, voffA);
        if (wr == 1) PG8_BAR;
        PG8_WAIT_V(2); PG8_BAR;
        PG8_STAGE(PG8_SB(1, 0), cB + kstep, voffB); PG8_STAGE(PG8_SA(1, 0), cA + kstep, voffA); PG8_STAGE(PG8_SB(1, 1), cB + hstep + kstep, voffB);
        PG8_WAIT_V(6); PG8_BAR;
    } else {
        PG8_STAGE(PG8_SB(0, 0), cB, voffB); PG8_STAGE(PG8_SA(0, 0), cA, voffA); PG8_STAGE(PG8_SB(0, 1), cB + hstep, voffB); PG8_STAGE(PG8_SA(0, 1), cA + hstep, voffA);
        if (wr == 1) PG8_BAR;
        PG8_WAIT_V(4); PG8_BAR;
        PG8_STAGE(PG8_SB(1, 0), cB + kstep, voffB); PG8_STAGE(PG8_SA(1, 0), cA + kstep, voffA); PG8_STAGE(PG8_SB(1, 1), cB + hstep + kstep, voffB);
        PG8_WAIT_V(6); PG8_BAR;
    }
    for (;;) {
        const bool has_next = S.next(ui + 1, nxt);
        const char* nA = has_next ? S.abase(g, nxt, tstep) : cA; const char* nB = has_next ? S.bbase(g, nxt, tstep) : cB;
        for (int t = 0; t < nt; t += 2) {
            const bool last = (t == nt - 2);
            const char* a1 = cA + (size_t)(t + 1) * kstep;
            const char* a2 = last ? nA : cA + (size_t)(t + 2) * kstep; const char* b2 = last ? nB : cB + (size_t)(t + 2) * kstep;
            const char* a3 = a2 + kstep; const char* b3 = b2 + kstep;
            if (last && has_next) S.a_ready(nxt);
            if constexpr (SP2) {
            PG8_LDB(B0, 0, 0); PG8_LDB(B1, 0, 1); PG8_SCHED; PG8_LDA(At, 0, 0); PG8_STAGE(PG8_SA(1, 1), a1 + hstep, voffA);
            PG8_WAIT_V(8); PG8_WAIT_L(0); PG8_BAR; PG8_MMA(0, 0, At, B0); PG8_MMA(0, 1, At, B1); PG8_BAR; PG8_SCHED;
            PG8_LDA(At, 0, 1); PG8_STAGE(PG8_SB(0, 0), b2, voffB); PG8_STAGE(PG8_SB(0, 1), b2 + hstep, voffB); PG8_STAGE(PG8_SA(0, 0), a2, voffA);
            PG8_WAIT_V(8); PG8_WAIT_L(0); PG8_BAR; PG8_MMA(1, 0, At, B0); PG8_MMA(1, 1, At, B1); PG8_BAR; PG8_SCHED;
            PG8_LDB(B0, 1, 0); PG8_LDB(B1, 1, 1); PG8_SCHED; PG8_LDA(At, 1, 0); PG8_STAGE(PG8_SA(0, 1), a2 + hstep, voffA);
            PG8_WAIT_V(8); PG8_WAIT_L(0); PG8_BAR; PG8_MMA(0, 0, At, B0); PG8_MMA(0, 1, At, B1); PG8_BAR; PG8_SCHED;
            PG8_LDA(At, 1, 1); PG8_STAGE(PG8_SB(1, 0), b3, voffB); PG8_STAGE(PG8_SB(1, 1), b3 + hstep, voffB); PG8_STAGE(PG8_SA(1, 0), a3, voffA);
            PG8_WAIT_V(8); PG8_WAIT_L(0); PG8_BAR; PG8_MMA(1, 0, At, B0); PG8_MMA(1, 1, At, B1); PG8_BAR; PG8_SCHED;
            } else {
            PG8_LDB(B0, 0, 0); PG8_SCHED; PG8_LDA(At, 0, 0); PG8_STAGE(PG8_SA(1, 1), a1 + hstep, voffA);
            PG8_WAIT_L(8); PG8_BAR; PG8_WAIT_L(0); PG8_MMA(0, 0, At, B0); PG8_BAR; PG8_SCHED;
            PG8_LDB(B1, 0, 1); PG8_STAGE(PG8_SB(0, 0), b2, voffB);
            PG8_BAR; PG8_WAIT_L(0); PG8_MMA(0, 1, At, B1); PG8_BAR;
            PG8_LDA(At, 0, 1); PG8_STAGE(PG8_SA(0, 0), a2, voffA);
            PG8_BAR; PG8_WAIT_L(0); PG8_MMA(1, 0, At, B0); PG8_BAR; PG8_SCHED;
            PG8_STAGE(PG8_SB(0, 1), b2 + hstep, voffB);
            PG8_WAIT_V(6); PG8_BAR; PG8_MMA(1, 1, At, B1); PG8_BAR;
            PG8_LDB(B0, 1, 0); PG8_SCHED; PG8_LDA(At, 1, 0); PG8_STAGE(PG8_SA(0, 1), a2 + hstep, voffA);
            PG8_WAIT_L(8); PG8_BAR; PG8_WAIT_L(0); PG8_MMA(0, 0, At, B0); PG8_BAR; PG8_SCHED;
            PG8_LDB(B1, 1, 1); PG8_STAGE(PG8_SB(1, 0), b3, voffB);
            PG8_BAR; PG8_WAIT_L(0); PG8_MMA(0, 1, At, B1); PG8_BAR;
            PG8_LDA(At, 1, 1); PG8_STAGE(PG8_SA(1, 0), a3, voffA);
            PG8_BAR; PG8_WAIT_L(0); PG8_MMA(1, 0, At, B0); PG8_BAR; PG8_SCHED;
            PG8_STAGE(PG8_SB(1, 1), b3 + hstep, voffB);
            PG8_WAIT_V(6); PG8_BAR; PG8_MMA(1, 1, At, B1); PG8_BAR;
            }
        }
        if constexpr (ALIGN_EPI) { if (wr == 0) PG8_BAR; }
        if constexpr (!Epi::AFTER_DRAIN) { E(acc, cur, wr, wc, fr, fq); S.done(cur); }
        if (!has_next) break;
#pragma unroll
        for (int a = 0; a < 2; ++a)
#pragma unroll
            for (int b = 0; b < 2; ++b)
#pragma unroll
                for (int m = 0; m < 4; ++m)
#pragma unroll
                    for (int n = 0; n < 2; ++n) acc[a][b][m][n] = (AccT)(0);
        cur = nxt; cA = nA; cB = nB; ++ui;
        if constexpr (ALIGN_EPI) { if (wr == 1) PG8_BAR; }
    }
    PG8_WAIT_V(0);
    if constexpr (!ALIGN_EPI) { if (wr == 0) PG8_BAR; }
    PG8_BAR;
    if constexpr (Epi::AFTER_DRAIN) { E.fused(acc, cur, wr, wc, fr, fq, lds, wid, lane); S.done(cur); }
#undef PG8_SA
#undef PG8_SB
#undef PG8_STAGE
#undef PG8_LDA
#undef PG8_LDB
#undef PG8_MMA
#undef PG8_WAIT_V
#undef PG8_WAIT_L
#undef PG8_BAR
#undef PG8_SCHED
}
}

constexpr int NWAVES = 8;
constexpr int D = 1024, NB = 4, SEQ = 4096, CTXL = 256, NLAT = NB * SEQ, NCTX = NB * CTXL, MROWS = NLAT + NCTX;
constexpr int DEPTH = 4, RW = 512, NH = 8, HS = 64, DFF = 3584, NE = 8, NPROJ = 3456, NP = 3584, NLO = 2560, KLA = 512, NMOD = 6144;
constexpr int PC_R = 0, PC_K = 512, PC_V = 1024, PC_CB = 1536, PC_CC = 2048, PC_CH = 2560, PC_WD = 3072, PC_AD = 3200, PC_GD = 3328;
constexpr float LN_EPS = 1e-5f, GN_EPS = 64e-5f, DN_ALPHA = 1.681792830507429f;
enum { I_X = 0, I_C, I_CTX, I_CCTX, I_WMOD, I_BMOD, I_WIN, I_W0, I_W2, I_A0, I_A2, I_KK, I_KA, I_RK, I_G2, I_LNXG, I_LNXB, I_CONVW, I_WOUT, I_LN1G, I_LN1B, I_LN2G, I_LN2B,
       I_FW1, I_FW3, I_FW2, I_RTW, I_RTB, I_MW1, I_MW3, I_MW2, N_IN };

constexpr size_t MiB = 1u << 20;
constexpr size_t WS_CTL = 0, CTL_BYTES = 3 * MiB;
constexpr size_t WS_MODV = 1 * MiB;
constexpr size_t WS_AMAX = 2 * MiB;
constexpr size_t WS_RKS = 3 * MiB;
constexpr size_t WS_WIN = 4 * MiB;
constexpr size_t WS_WOUT = WS_WIN + 28 * MiB;
constexpr size_t WS_LORA = WS_WOUT + 8 * MiB;
constexpr size_t WS_F13 = WS_LORA + 10 * MiB;
constexpr size_t WS_F2 = WS_F13 + 28 * MiB;
constexpr size_t WS_X = WS_F2 + 14 * MiB;
constexpr size_t WS_H = WS_X + 68 * MiB;
constexpr size_t WS_MOES = WS_H + 34 * MiB;
constexpr size_t WS_ROWLIST = WS_MOES;
constexpr size_t WS_TOKSEL = WS_MOES + 640 * 1024;
constexpr size_t WS_WSEL = WS_TOKSEL + 320 * 1024;
constexpr size_t WS_WSORT = WS_WSEL + 192 * 1024;
constexpr size_t WS_MOEW13 = WS_MOES + 2 * MiB;
constexpr size_t WS_MOEW2 = WS_MOEW13 + 112 * MiB;
constexpr size_t WS_H8 = WS_MOEW13 + 56 * MiB;
constexpr size_t WS_SA = WS_H8 + 17 * MiB;
constexpr size_t WS_SAM = WS_SA + 512 * 1024;
constexpr size_t WS_SAG = WS_SA + 1 * MiB;
constexpr size_t WS_SCR = WS_MOEW2 + 56 * MiB;
constexpr size_t WS_P = WS_SCR;
constexpr size_t WS_LO = WS_P + 119 * MiB;
constexpr size_t WS_PREP = WS_LO + 170 * MiB;
constexpr size_t WS_Y = WS_PREP + 213 * MiB;
constexpr size_t WS_MIXIN = WS_Y + 68 * MiB;
constexpr size_t WS_CH = WS_PREP;
constexpr size_t WS_MIXO = WS_PREP;
constexpr size_t WS_MIXP = WS_PREP + 34 * MiB;
constexpr size_t WS_END_MIXER = WS_MIXIN + 34 * MiB;
constexpr size_t WS_HG = WS_SCR;
constexpr size_t WS_ACT = WS_HG + 72 * MiB;
constexpr size_t WS_F = WS_ACT + 252 * MiB;
constexpr size_t WS_FP = WS_F + 72 * MiB;
constexpr size_t WS_END_FFN = WS_FP + 64 * MiB;
constexpr size_t WS_NEED = WS_END_MIXER > WS_END_FFN ? WS_END_MIXER : WS_END_FFN;
static_assert((size_t)MROWS * NP * 2 <= 119 * MiB && (size_t)MROWS * NLO * 4 <= 170 * MiB && (size_t)8704 * 25600 <= 213 * MiB && (size_t)MROWS * D * 4 <= 68 * MiB && WS_NEED <= 990 * MiB, "ws map");
constexpr int MOE_MAIN_PANELS = 128, MOE_TAIL_ROWS = 4096;
constexpr int MOE_ROWS = 36864;
constexpr int AM_IN = 18 * 2 * DFF, AM_OUT = AM_IN + DEPTH * NP;
constexpr int LORAW_PER_LAYER = 4 * 512 * 64 + 512 * 128;
constexpr int CW_BAR = 4096, CW_GCNT = 8192, CW_CQ = 12288, CW_SDONE = 12544;

constexpr int RING_BYTES = 131072, LDSCTL_OFF = RING_BYTES, MISC_OFF = LDSCTL_OFF + 320, LDS_BYTES = 147456;

typedef unsigned short bf16;
typedef unsigned v4u __attribute__((ext_vector_type(4)));
typedef unsigned v2u __attribute__((ext_vector_type(2)));
typedef float f32x4 __attribute__((ext_vector_type(4)));
#define LAS __attribute__((address_space(3)))
#define LDS_WAIT() asm volatile("s_waitcnt lgkmcnt(0)" ::: "memory")
__device__ __forceinline__ unsigned f2bf(float f) { unsigned u = __builtin_bit_cast(unsigned, f); return (u + 0x7fffu + ((u >> 16) & 1u)) >> 16; }
__device__ __forceinline__ unsigned pk2(float lo, float hi) { return f2bf(lo) | (f2bf(hi) << 16); }
__device__ __forceinline__ float bf2f(unsigned short b) { return __builtin_bit_cast(float, ((unsigned)b) << 16); }
__device__ __forceinline__ float bflo(unsigned w) { return __builtin_bit_cast(float, w << 16); }
__device__ __forceinline__ float bfhi(unsigned w) { return __builtin_bit_cast(float, w & 0xffff0000u); }
__device__ __forceinline__ float wave_sum(float v) {
#pragma unroll
    for (int o = 1; o < 64; o <<= 1) v += __shfl_xor(v, o);
    return v;
}
__device__ __forceinline__ float sigm(float x) { return 1.f / (1.f + __expf(-x)); }

#define XB_TMO      128
#define XB_XCNT(j)  (256  + 64 * (j))
#define XB_XSUB(j)  (1280 + 64 * (j))
#define XB_XGEN(j)  (2304 + 64 * (j))
#define XB_TOP      3328
#define XB_TOPGEN   3392
#define XCD_BAR_WORDS 3456
#define XB_SPIN_CAP (1u << 18)

__device__ __forceinline__ unsigned xb_ld(unsigned* p)              { return __hip_atomic_load(p, __ATOMIC_RELAXED, __HIP_MEMORY_SCOPE_AGENT); }
__device__ __forceinline__ unsigned xb_add(unsigned* p, unsigned v) { return __hip_atomic_fetch_add(p, v, __ATOMIC_RELAXED, __HIP_MEMORY_SCOPE_AGENT); }
__device__ __forceinline__ unsigned xb_xcc_id() { return (unsigned)__builtin_amdgcn_s_getreg((3 << 11) | 20) & 0xFu; }
#define XB_SPIN(cond, bar) do { unsigned _sp = 0; while (cond) { __builtin_amdgcn_s_sleep(1); \
    if ((++_sp & 255u) == 0u) { if (xb_ld(&(bar)[XB_TMO])) break; if (_sp > XB_SPIN_CAP) { atomicAdd(&(bar)[XB_TMO], 1u); break; } } } } while (0)

struct XcdBarrier {
    unsigned* bar; unsigned x;
    volatile LAS unsigned* st;
};

__device__ __forceinline__ XcdBarrier xcd_barrier_post(unsigned* bar, volatile LAS unsigned* st) {
    XcdBarrier b; b.bar = bar; b.x = xb_xcc_id(); b.st = st;
    if (threadIdx.x == 0) (void)xb_add(&bar[XB_XCNT(b.x)], 1u);
    return b;
}
__device__ __forceinline__ void xcd_barrier_complete(unsigned* bar, unsigned x, unsigned& nloc, unsigned& nx) {
    const unsigned G = gridDim.x * gridDim.y * gridDim.z;
    unsigned sum, cnt, mine, sp = 0u;
    for (;;) {
        sum = 0u; cnt = 0u; mine = 0u;
#pragma unroll
        for (unsigned j = 0; j < 16; ++j) { const unsigned c = xb_ld(&bar[XB_XCNT(j)]); sum += c; cnt += (c > 0u) ? 1u : 0u; mine = (j == x) ? c : mine; }
        if (sum == G) break;
        __builtin_amdgcn_s_sleep(1);
        if ((++sp & 255u) == 0u) { if (xb_ld(&bar[XB_TMO])) break; if (sp > XB_SPIN_CAP) { atomicAdd(&bar[XB_TMO], 1u); break; } }
    }
    nloc = mine > 0u ? mine : 1u; nx = cnt > 0u ? cnt : 1u;
}

__device__ __forceinline__ void xcd_barrier(const XcdBarrier& b) {
    asm volatile("s_waitcnt vmcnt(0)" ::: "memory");
    __syncthreads();
    if (threadIdx.x == 0) {
        unsigned* bar = b.bar;
        __builtin_amdgcn_s_waitcnt(0);
        unsigned nloc = b.st[0], nx = b.st[1];
        if (nloc == 0u) { xcd_barrier_complete(bar, b.x, nloc, nx); b.st[0] = nloc; b.st[1] = nx; }
        const unsigned old = xb_add(&bar[XB_XSUB(b.x)], 1u);
        const unsigned gen = old / nloc;
        if (old + 1u == (gen + 1u) * nloc) {
            __builtin_amdgcn_fence(__ATOMIC_RELEASE, "agent");
            asm volatile("s_waitcnt vmcnt(0)" ::: "memory");
            const unsigned og = xb_add(&bar[XB_TOP], 1u);
            const unsigned tg = og / nx;
            if (og + 1u == (tg + 1u) * nx) xb_add(&bar[XB_TOPGEN], 1u);
            else XB_SPIN(xb_ld(&bar[XB_TOPGEN]) == tg, bar);
            __builtin_amdgcn_fence(__ATOMIC_ACQUIRE, "agent");
            xb_add(&bar[XB_XGEN(b.x)], 1u);
            asm volatile("s_waitcnt vmcnt(0)" ::: "memory");
        } else {
            XB_SPIN(xb_ld(&bar[XB_XGEN(b.x)]) == gen, bar);
            __builtin_amdgcn_fence(__ATOMIC_ACQUIRE, "agent");
            asm volatile("s_waitcnt vmcnt(0)" ::: "memory");
        }
    }
    __syncthreads();
}


__device__ __forceinline__ size_t opaque_zero() { size_t z = 0; asm volatile("" : "+s"(z)); return z; }
#define OWS (p.ws + opaque_zero())
__device__ __forceinline__ int opaque_zero_i() { int z = 0; asm volatile("" : "+s"(z)); return z; }
#define PIN(i) (p.in[(i) + opaque_zero_i()])
struct KP { const float* in[N_IN]; float* out; unsigned char* ws; int ph; int pad; };

template <int MODE> __device__ __forceinline__ int rowmap(int n, int arg) {
    if (MODE == 0) return n + arg;
    if (MODE == 1) { if (n < 1536) return n; if (n < 1664) return n - 1536 + PC_WD; if (n < 1792) return n - 1664 + PC_AD; if (n < 1920) return n - 1792 + PC_GD;
                     if (n < 2432) return n - 1920 + PC_CB; if (n < 2944) return n - 2432 + PC_CC; return n - 2944 + PC_CH; }
    return 8 * (n >> 2) + 4 * arg + (n & 3);
}
template <int MODE> __device__ __forceinline__ void transpose_item(const float* W, int K, int N, bf16* WT, int arg, LAS float* scr, int item, int lane) {
    const int nblk = N / 32, kb = item / nblk, nb = item % nblk, k0 = 64 * kb, n0 = 32 * nb;
#pragma unroll 8
    for (int i = 0; i < 32; ++i) { const int kk = 2 * i + (lane >> 5); scr[kk * 33 + (lane & 31)] = W[(size_t)(k0 + kk) * N + n0 + (lane & 31)]; }
    LDS_WAIT(); asm volatile("" ::: "memory");
    const int c = lane & 7;
#pragma unroll
    for (int j = 0; j < 4; ++j) { const int n = (lane >> 3) + 8 * j; const LAS float* s = scr + (8 * c) * 33 + n;
        v4u o; o.x = pk2(s[0 * 33], s[1 * 33]); o.y = pk2(s[2 * 33], s[3 * 33]); o.z = pk2(s[4 * 33], s[5 * 33]); o.w = pk2(s[6 * 33], s[7 * 33]);
        *(v4u*)(WT + (size_t)rowmap<MODE>(n0 + n, arg) * K + k0 + 8 * c) = o; }
    LDS_WAIT(); asm volatile("" ::: "memory");
}

__device__ __forceinline__ void ph_modvec(const KP& p, LAS unsigned char* lds, int tid) {
    LAS float* sil = (LAS float*)lds;
    LAS float* red = (LAS float*)(lds + 5 * 1024 * 4);
    const float* c = PIN(I_C); const float* cc = PIN(I_CCTX);
    for (int i = tid; i < 5 * 1024; i += 512) { const float v = i < 4096 ? c[i] : cc[i - 4096]; sil[i] = v / (1.f + __expf(-v)); }
    __syncthreads();
    float* modv = (float*)(OWS + WS_MODV);
    const int ks = tid >> 6, col = tid & 63;
    for (int task = blockIdx.x; task < DEPTH * 96; task += gridDim.x) {
        const int l = task / 96, j0 = (task % 96) * 64;
        const float* w = PIN(I_WMOD) + (size_t)l * D * NMOD + (size_t)(ks * 128) * NMOD + j0 + col;
        float a0 = 0.f, a1 = 0.f, a2 = 0.f, a3 = 0.f, a4 = 0.f;
#pragma unroll 8
        for (int k = 0; k < 128; ++k) { const float wv = w[(size_t)k * NMOD]; const int kk = ks * 128 + k;
            a0 += sil[kk] * wv; a1 += sil[1024 + kk] * wv; a2 += sil[2048 + kk] * wv; a3 += sil[3072 + kk] * wv; a4 += sil[4096 + kk] * wv; }
        red[(ks * 5 + 0) * 64 + col] = a0; red[(ks * 5 + 1) * 64 + col] = a1; red[(ks * 5 + 2) * 64 + col] = a2; red[(ks * 5 + 3) * 64 + col] = a3; red[(ks * 5 + 4) * 64 + col] = a4;
        __syncthreads();
        if (tid < 320) { const int r = tid >> 6; float s = 0.f;
#pragma unroll
            for (int q = 0; q < 8; ++q) s += red[(q * 5 + r) * 64 + col];
            modv[(size_t)(l * 5 + r) * NMOD + j0 + col] = s + PIN(I_BMOD)[l * NMOD + j0 + col]; }
        __syncthreads();
    }
}

__device__ __forceinline__ void ph_convert(const KP& p, LAS unsigned char* lds, int gw, int NGW, int wave, int lane) {
    LAS float* scr = (LAS float*)(lds + wave * 16384);
    bf16* win = (bf16*)(OWS + WS_WIN); bf16* f2 = (bf16*)(OWS + WS_F2); bf16* lora = (bf16*)(OWS + WS_LORA);
    constexpr int I_IN = (D / 64) * (NPROJ / 32), I_OUT = (D / 64) * (D / 32), I_UP = (D / 64) * (DFF / 32), I_DN = (DFF / 64) * (D / 32);
    for (int it = gw; it < I_DN; it += NGW) transpose_item<0>(PIN(I_FW2), DFF, D, f2, 0, scr, it, lane);
    { const int gt = gw * 64 + lane, NGT = NGW * 64; constexpr int PER = (NP - NPROJ) * D / 16;
      for (int i = gt; i < DEPTH * PER; i += NGT) { const int l = i / PER, q = i % PER; *(v4u*)((unsigned char*)win + (size_t)l * NP * D + (size_t)NPROJ * D + (size_t)q * 16) = (v4u){0u, 0u, 0u, 0u}; } }
    { const int gt = gw * 64 + lane, NGT = NGW * 64;
      for (int i = gt; i < DEPTH * LORAW_PER_LAYER / 8; i += NGT) { const int l = i / (LORAW_PER_LAYER / 8); int q = (i % (LORAW_PER_LAYER / 8)) * 8; float v[8];
          int grp, c, k0; if (q < 4 * 512 * 64) { grp = q / (512 * 64); q -= grp * 512 * 64; c = q / 64; k0 = q % 64; } else { grp = 4; q -= 4 * 512 * 64; c = q / 128; k0 = q % 128; }
#pragma unroll
          for (int j = 0; j < 8; ++j) { const int k = k0 + j;
              v[j] = grp < 2 ? PIN(I_W2)[((size_t)(l * 2 + grp) * 64 + k) * RW + c] : grp < 4 ? PIN(I_A2)[((size_t)(l * 2 + grp - 2) * 64 + k) * RW + c] : PIN(I_G2)[((size_t)l * 128 + k) * RW + c]; }
          v4u o; o.x = pk2(v[0], v[1]); o.y = pk2(v[2], v[3]); o.z = pk2(v[4], v[5]); o.w = pk2(v[6], v[7]);
          *(v4u*)(lora + (size_t)i * 8) = o; } }
}
__device__ __forceinline__ void ph_amax(const KP& p, int gw, int NGW, int lane) {
    unsigned* AM = (unsigned*)(OWS + WS_AMAX);
    for (int it = gw; it < 18 * 2 * (DFF / 64); it += NGW) { const int kq = 0, strip = it % (DFF / 64), sm = it / (DFF / 64), s1 = sm & 1, cm = sm >> 1;
        const float* W = cm < 2 ? PIN(s1 ? I_FW3 : I_FW1) + (size_t)cm * D * DFF : PIN(s1 ? I_MW3 : I_MW1) + (size_t)(cm - 2) * D * DFF;
        const int n = strip * 64 + lane; const float* src = W + (size_t)(kq * 256) * DFF + n; float m = 0.f;
#pragma unroll 16
        for (int k = 0; k < 256; ++k) { const float w = src[(size_t)k * DFF]; m += w * w; }
        AM[(size_t)cm * 2 * DFF + 8 * (n >> 2) + 4 * s1 + (n & 3)] = __builtin_bit_cast(unsigned, 4.25f * sqrtf(m * (1.f / 256.f))); }
    for (int it = gw; it < DEPTH * (NPROJ / 64 + D / 64); it += NGW) { const int kq = 0; int t = it; const int l = t / (NPROJ / 64 + D / 64); t -= l * (NPROJ / 64 + D / 64);
        const bool isin = t < NPROJ / 64; const int strip = isin ? t : t - NPROJ / 64, N = isin ? NPROJ : D, n = strip * 64 + lane;
        const float* src = (isin ? PIN(I_WIN) + (size_t)l * D * NPROJ : PIN(I_WOUT) + (size_t)l * D * D) + (size_t)(kq * 256) * N + n; float m = 0.f;
#pragma unroll 16
        for (int k = 0; k < 256; ++k) { const float w = src[(size_t)k * N]; m += w * w; }
        AM[isin ? AM_IN + l * NP + rowmap<1>(n, 0) : AM_OUT + l * D + n] = __builtin_bit_cast(unsigned, 4.25f * sqrtf(m * (1.f / 256.f))); }
}
__device__ __forceinline__ unsigned q8pack(float a, float b, float c, float d) {
    const int qa = __float2int_rn(fminf(fmaxf(a, -127.f), 127.f)), qb = __float2int_rn(fminf(fmaxf(b, -127.f), 127.f)), qc = __float2int_rn(fminf(fmaxf(c, -127.f), 127.f)), qd = __float2int_rn(fminf(fmaxf(d, -127.f), 127.f));
    return (unsigned)(qa & 255) | ((unsigned)(qb & 255) << 8) | ((unsigned)(qc & 255) << 16) | ((unsigned)(qd & 255) << 24); }
constexpr int CQ_IN = (D / 64) * (NPROJ / 32), CQ_OUT = (D / 64) * (D / 32), CQ_UP = (D / 64) * (DFF / 32), CQ_DN = (DFF / 64) * (D / 32);
constexpr int CQ_NEG = CQ_IN + CQ_OUT + 2 * CQ_UP;
constexpr int CQ_J1 = 3 * CQ_IN + 3 * CQ_OUT + 2 * CQ_UP + CQ_DN, CQ_MOE = NE * (2 * CQ_UP + CQ_DN), CQ_END0 = CQ_J1 + CQ_MOE, CQ_END1 = CQ_END0 + CQ_MOE;
#ifndef CQ_SLOT_ITEMS
#define CQ_SLOT_ITEMS 12000
#endif
struct CqItem { const float* W; bf16* WT; int K, N, mode, arg, item; const unsigned* am; };
__device__ __forceinline__ CqItem cq_decode(const KP& p, int q) {
    CqItem c; bf16* win = (bf16*)(OWS + WS_WIN); bf16* wout = (bf16*)(OWS + WS_WOUT); bf16* f13 = (bf16*)(OWS + WS_F13); bf16* f2 = (bf16*)(OWS + WS_F2);
    bf16* m13 = (bf16*)(OWS + WS_MOEW13); bf16* m2 = (bf16*)(OWS + WS_MOEW2); const unsigned* AM = (const unsigned*)(OWS + WS_AMAX);
    if (q < 0) { q += CQ_NEG;
        if (q < CQ_IN) { c = CqItem{PIN(I_WIN), win, D, NPROJ, 3, 0, q, AM + AM_IN}; return c; } q -= CQ_IN;
        if (q < CQ_OUT) { c = CqItem{PIN(I_WOUT), wout, D, D, 4, 0, q, AM + AM_OUT}; return c; } q -= CQ_OUT;
        if (q < CQ_UP) { c = CqItem{PIN(I_FW1), f13, D, DFF, 2, 0, q, AM}; return c; } q -= CQ_UP;
        c = CqItem{PIN(I_FW3), f13, D, DFF, 2, 1, q, AM}; return c; }
    if (q < 3 * CQ_IN) { const int l = 1 + q / CQ_IN; c = CqItem{PIN(I_WIN) + (size_t)l * D * NPROJ, win + (size_t)l * (NP * D / 2), D, NPROJ, 3, 0, q % CQ_IN, AM + AM_IN + l * NP}; return c; } q -= 3 * CQ_IN;
    if (q < 3 * CQ_OUT) { const int l = 1 + q / CQ_OUT; c = CqItem{PIN(I_WOUT) + (size_t)l * D * D, wout + (size_t)l * (D * D / 2), D, D, 4, 0, q % CQ_OUT, AM + AM_OUT + l * D}; return c; } q -= 3 * CQ_OUT;
    if (q < CQ_UP) { c = CqItem{PIN(I_FW1) + (size_t)D * DFF, f13 + (size_t)DFF * D, D, DFF, 2, 0, q, AM + 2 * DFF}; return c; } q -= CQ_UP;
    if (q < CQ_UP) { c = CqItem{PIN(I_FW3) + (size_t)D * DFF, f13 + (size_t)DFF * D, D, DFF, 2, 1, q, AM + 2 * DFF}; return c; } q -= CQ_UP;
    if (q < CQ_DN) { c = CqItem{PIN(I_FW2) + (size_t)DFF * D, f2 + (size_t)D * DFF, DFF, D, 0, 0, q, nullptr}; return c; } q -= CQ_DN;
    const int mi = q / CQ_MOE; q -= mi * CQ_MOE;
    if (q < NE * CQ_UP) { const int e = q / CQ_UP; c = CqItem{PIN(I_MW1) + ((size_t)mi * NE + e) * D * DFF, m13 + (size_t)e * DFF * D, D, DFF, 2, 0, q % CQ_UP, AM + (size_t)(2 + 8 * mi + e) * 2 * DFF}; return c; } q -= NE * CQ_UP;
    if (q < NE * CQ_UP) { const int e = q / CQ_UP; c = CqItem{PIN(I_MW3) + ((size_t)mi * NE + e) * D * DFF, m13 + (size_t)e * DFF * D, D, DFF, 2, 1, q % CQ_UP, AM + (size_t)(2 + 8 * mi + e) * 2 * DFF}; return c; } q -= NE * CQ_UP;
    { const int e = q / CQ_DN; c = CqItem{PIN(I_MW2) + ((size_t)mi * NE + e) * DFF * D, m2 + (size_t)e * D * DFF, DFF, D, 0, 0, q % CQ_DN, nullptr}; return c; }
}
__device__ __forceinline__ void cq_load(const CqItem& c, int lane, float (&r)[32]) {
    const int nblk = c.N / 32, kb = c.item / nblk, nb = c.item % nblk; const float* src = c.W + (size_t)(64 * kb + (lane >> 5)) * c.N + 32 * nb + (lane & 31);
#pragma unroll
    for (int i = 0; i < 32; ++i) r[i] = src[(size_t)(2 * i) * c.N];
}
__device__ __forceinline__ void cq_store(const CqItem& c, int lane, const float (&r)[32], LAS float* scr) {
    const int nblk = c.N / 32, kb = c.item / nblk, nb = c.item % nblk, k0 = 64 * kb, n0 = 32 * nb;
#pragma unroll
    for (int i = 0; i < 32; ++i) scr[(2 * i + (lane >> 5)) * 33 + (lane & 31)] = r[i];
    LDS_WAIT(); asm volatile("" ::: "memory");
    if (c.mode >= 2) {
        const int n = lane >> 1, hf = lane & 1, nn = n0 + n, j = c.mode == 2 ? 8 * (nn >> 2) + 4 * c.arg + (nn & 3) : c.mode == 3 ? rowmap<1>(nn, 0) : nn;
        const float inv = 127.f / fmaxf(__builtin_bit_cast(float, c.am[j]), 1e-30f); const LAS float* sp = scr + (32 * hf) * 33 + n; unsigned w[8];
#pragma unroll
        for (int q = 0; q < 8; ++q) w[q] = q8pack(sp[(4 * q + 0) * 33] * inv, sp[(4 * q + 1) * 33] * inv, sp[(4 * q + 2) * 33] * inv, sp[(4 * q + 3) * 33] * inv);
        unsigned char* dst = (unsigned char*)c.WT + (size_t)j * c.K + k0 + 32 * hf;
        *(v4u*)dst = (v4u){w[0], w[1], w[2], w[3]}; *(v4u*)(dst + 16) = (v4u){w[4], w[5], w[6], w[7]};
    } else {
    const int cc = lane & 7;
#pragma unroll
    for (int j = 0; j < 4; ++j) { const int n = (lane >> 3) + 8 * j; const LAS float* sp = scr + (8 * cc) * 33 + n;
        v4u o; o.x = pk2(sp[0 * 33], sp[1 * 33]); o.y = pk2(sp[2 * 33], sp[3 * 33]); o.z = pk2(sp[4 * 33], sp[5 * 33]); o.w = pk2(sp[6 * 33], sp[7 * 33]);
        const int nn = n0 + n;
        *(v4u*)(c.WT + (size_t)nn * c.K + k0 + 8 * cc) = o; }
    }
    LDS_WAIT(); asm volatile("" ::: "memory");
}
constexpr int CQ_B = 4;
__device__ __forceinline__ int cq_grab(unsigned* heads, int nseg, int& cnt, int lane) {
    int q = -1, n = 0;
    if (lane == 0) { for (int sg = 0; sg < nseg && q < 0; ++sg) { const int size = sg == 0 ? CQ_J1 : CQ_MOE, base = sg == 0 ? 0 : sg == 1 ? CQ_J1 : CQ_END0; unsigned* hd = heads + 64 * sg;
            if ((int)__hip_atomic_load(hd, __ATOMIC_RELAXED, __HIP_MEMORY_SCOPE_AGENT) < size) { const int t = (int)__hip_atomic_fetch_add(hd, (unsigned)CQ_B, __ATOMIC_RELAXED, __HIP_MEMORY_SCOPE_AGENT);
                if (t < size) { q = base + t; n = size - t < CQ_B ? size - t : CQ_B; } } } }
    cnt = __builtin_amdgcn_readfirstlane(n); return __builtin_amdgcn_readfirstlane(q);
}
__device__ __forceinline__ void cq_run(const KP& p, LAS unsigned char* lds, int nseg, const unsigned* stop, unsigned stopval, int wave, int lane) {
    unsigned* heads = (unsigned*)(OWS + WS_CTL) + CW_CQ; LAS float* scr = (LAS float*)(lds + wave * 16384);
    for (;;) {
        if (stop) { unsigned sv = 0u; if (lane == 0) sv = __hip_atomic_load(stop, __ATOMIC_RELAXED, __HIP_MEMORY_SCOPE_AGENT); if ((unsigned)__builtin_amdgcn_readfirstlane((int)sv) >= stopval) break; }
        int cnt; const int q0 = cq_grab(heads, nseg, cnt, lane); if (q0 < 0) break;
        CqItem cur = cq_decode(p, q0); float ra[32]; cq_load(cur, lane, ra);
        for (int j = 0; j < cnt; ++j) { CqItem nxt = cur; float rb[32];
            if (j + 1 < cnt) { nxt = cq_decode(p, q0 + j + 1); cq_load(nxt, lane, rb); }
            cq_store(cur, lane, ra, scr);
            if (j + 1 < cnt) { cur = nxt;
#pragma unroll
                for (int i = 0; i < 32; ++i) ra[i] = rb[i]; } }
    }
}

__device__ __forceinline__ void cq_static(const KP& p, LAS unsigned char* lds, int q0, int q1, int gw, int NGW, int wave, int lane) {
    LAS float* scr = (LAS float*)(lds + wave * 16384);
    int q = q0 + gw; if (q >= q1) return;
    CqItem cur = cq_decode(p, q); float ra[32]; cq_load(cur, lane, ra);
    for (;;) { const int qn = q + NGW; CqItem nxt = cur; float rb[32];
        if (qn < q1) { nxt = cq_decode(p, qn); cq_load(nxt, lane, rb); }
        cq_store(cur, lane, ra, scr);
        if (qn >= q1) break;
        cur = nxt; q = qn;
#pragma unroll
        for (int i = 0; i < 32; ++i) ra[i] = rb[i]; }
}

__device__ __forceinline__ void ld_row(const float* r, int lane, f32x4 (&v)[4]) { const f32x4* q = (const f32x4*)r + lane;
#pragma unroll
    for (int j = 0; j < 4; ++j) v[j] = q[64 * j]; }
__device__ __forceinline__ void st_row(float* r, int lane, const f32x4 (&v)[4]) { f32x4* q = (f32x4*)r + lane;
#pragma unroll
    for (int j = 0; j < 4; ++j) q[64 * j] = v[j]; }
__device__ __forceinline__ void st_row_bf16(bf16* r, int lane, const f32x4 (&v)[4]) { v2u* q = (v2u*)r + lane;
#pragma unroll
    for (int j = 0; j < 4; ++j) { v2u w; w.x = pk2(v[j][0], v[j][1]); w.y = pk2(v[j][2], v[j][3]); q[64 * j] = w; } }
__device__ __forceinline__ void ld_row_bf16(const bf16* r, int lane, f32x4 (&v)[4]) { const v2u* q = (const v2u*)r + lane;
#pragma unroll
    for (int j = 0; j < 4; ++j) { const v2u w = q[64 * j]; v[j] = (f32x4){bflo(w.x), bfhi(w.x), bflo(w.y), bfhi(w.y)}; } }
template <int S> __device__ __forceinline__ void ld_row_parts(const float* r, size_t pstride, int lane, f32x4 (&v)[4]) {
    ld_row(r, lane, v);
#pragma unroll
    for (int s = 1; s < S; ++s) { f32x4 t[4]; ld_row(r + (size_t)s * pstride, lane, t);
#pragma unroll
        for (int j = 0; j < 4; ++j) v[j] += t[j]; } }
__device__ __forceinline__ int mod_row(int row) { return row < NLAT ? (row >> 12) : 4; }

__device__ __forceinline__ void st_row_q8(unsigned char* dst8, float* scale, int row, int lane, const f32x4 (&v)[4]) {
    float am = 0.f;
#pragma unroll
    for (int j = 0; j < 4; ++j) am = fmaxf(fmaxf(am, fmaxf(fabsf(v[j][0]), fabsf(v[j][1]))), fmaxf(fabsf(v[j][2]), fabsf(v[j][3])));
#pragma unroll
    for (int o = 1; o < 64; o <<= 1) am = fmaxf(am, __shfl_xor(am, o));
    am = fmaxf(am, 1e-30f); const float inv = 127.f / am; unsigned* h8 = (unsigned*)dst8 + (size_t)row * (D / 4) + lane;
#pragma unroll
    for (int j = 0; j < 4; ++j) h8[64 * j] = q8pack(v[j][0] * inv, v[j][1] * inv, v[j][2] * inv, v[j][3] * inv);
    if (lane == 0) scale[row] = am * (1.f / 127.f);
}
__device__ __forceinline__ void ph_init_rows(const KP& p, int gw, int NGW, int lane) {
    const float* modv = (const float*)(OWS + WS_MODV); float* X = (float*)(OWS + WS_X); bf16* H = (bf16*)(OWS + WS_H);
    for (int row = gw; row < MROWS; row += NGW) {
        const float* src = row < NLAT ? PIN(I_X) + (size_t)row * D : PIN(I_CTX) + (size_t)(row - NLAT) * D;
        const float* mv = modv + (size_t)(0 * 5 + mod_row(row)) * NMOD;
        f32x4 x[4], sh[4], sc[4], h[4]; ld_row(src, lane, x); ld_row(mv, lane, sh); ld_row(mv + 1024, lane, sc);
#pragma unroll
        for (int j = 0; j < 4; ++j) h[j] = x[j] * (1.f + sc[j]) + sh[j];
        st_row_q8(OWS + WS_H8, (float*)(OWS + WS_SA), row, lane, h);
    }
}

__device__ __forceinline__ int scan_row(int b, int dir, int step) { return step < CTXL ? NLAT + b * CTXL + (dir ? CTXL - 1 - step : step) : b * SEQ + (dir ? SEQ - 1 - (step - CTXL) : step - CTXL); }
typedef short sbf16x8 __attribute__((ext_vector_type(8)));
typedef float f32x16 __attribute__((ext_vector_type(16)));
constexpr int SC_C = 32, SC_NCH = (CTXL + SEQ) / SC_C  , SC_NCHAIN = NB * NH * 2  , SC_NTASK = SC_NCH * SC_NCHAIN  ;
constexpr int CH_G = 0, CH_Q = 8192, CH_UT = 12288, CH_YL = 20480, CH_EC = 24576, CH_BYTES = 25600, CH_NLOAD = 26;

__device__ __forceinline__ f32x16 mm(v4u a, v4u b, f32x16 c) { return __builtin_amdgcn_mfma_f32_32x32x16_bf16(__builtin_bit_cast(sbf16x8, a), __builtin_bit_cast(sbf16x8, b), c, 0, 0, 0); }
typedef float f32x2c __attribute__((ext_vector_type(2))); typedef __bf16 bf16x2c __attribute__((ext_vector_type(2)));
__device__ __forceinline__ unsigned cvtpk(float lo, float hi) { return __builtin_bit_cast(unsigned, __builtin_convertvector((f32x2c){lo, hi}, bf16x2c)); }
template <int S, int NEG> __device__ __forceinline__ v4u cvtf(const f32x16& x) {
    v4u w; const float sg = NEG ? -1.f : 1.f;
    w.x = cvtpk(sg * x[8 * S + 0], sg * x[8 * S + 1]); w.y = cvtpk(sg * x[8 * S + 2], sg * x[8 * S + 3]); w.z = cvtpk(sg * x[8 * S + 4], sg * x[8 * S + 5]); w.w = cvtpk(sg * x[8 * S + 6], sg * x[8 * S + 7]); return w; }
template <int MODE  > __device__ __forceinline__ f32x16 mask_acc(f32x16 x, int n, int hh) {
#pragma unroll
    for (int r = 0; r < 16; ++r) { const int m = (r & 3) + 8 * (r >> 2) + 4 * hh; const bool keep = MODE == 0 ? (m > n) : MODE == 1 ? (m < n) : (m <= n); x[r] = keep ? x[r] : 0.f; }
    return x; }
__device__ __forceinline__ f32x16 zero16() { f32x16 z;
#pragma unroll
    for (int r = 0; r < 16; ++r) z[r] = 0.f;
    return z; }
__device__ __forceinline__ void cm_build(const unsigned (&w)[16], v4u (&f)[2][2]) {
#pragma unroll
    for (int s = 0; s < 2; ++s) {
        const auto r0 = __builtin_amdgcn_permlane32_swap(w[8 * s + 0], w[8 * s + 2], false, false), r1 = __builtin_amdgcn_permlane32_swap(w[8 * s + 1], w[8 * s + 3], false, false);
        const auto r2 = __builtin_amdgcn_permlane32_swap(w[8 * s + 4], w[8 * s + 6], false, false), r3 = __builtin_amdgcn_permlane32_swap(w[8 * s + 5], w[8 * s + 7], false, false);
        f[0][s] = (v4u){r0[0], r1[0], r2[0], r3[0]}; f[1][s] = (v4u){r0[1], r1[1], r2[1], r3[1]}; }
}
__device__ __forceinline__ void st16(unsigned char* base, int off, int lane, v4u v) { *(v4u*)(base + off + lane * 16) = v; }

__device__ __forceinline__ void ph_scan1(const KP& p, int l, int gw, int NGW, int lane) {
    const bf16* P = (const bf16*)(OWS + WS_P); const bf16* LO = (const bf16*)(OWS + WS_LO); const float* NRM = (const float*)(OWS + WS_RKS); unsigned char* CH = OWS + WS_CH;
    const int n = lane & 31, hh = lane >> 5;
    v4u Id[2];
#pragma unroll
    for (int s = 0; s < 2; ++s) { unsigned wd[4];
#pragma unroll
        for (int q = 0; q < 4; ++q) { const int j0 = 2 * q, j1 = 2 * q + 1; const int t0 = 16 * s + 8 * (j0 >> 2) + 4 * hh + (j0 & 3), t1 = 16 * s + 8 * (j1 >> 2) + 4 * hh + (j1 & 3);
            wd[q] = (t0 == n ? 0x3F80u : 0u) | (t1 == n ? 0x3F800000u : 0u); }
        Id[s] = (v4u){wd[0], wd[1], wd[2], wd[3]}; }
    for (int task = gw; task < SC_NTASK; task += NGW) {
        const int dir = task & 1, h = (task >> 1) & 7, b = (task >> 4) & 3, ci = task >> 6;
        const int row0 = scan_row(b, dir, SC_C * ci), sgn = dir ? -1 : 1, c = h * 64 + lane;
        const float w0c = PIN(I_W0)[(l * 2 + dir) * RW + c], a0c = PIN(I_A0)[(l * 2 + dir) * RW + c], kkc = PIN(I_KK)[l * RW + c], kac = PIN(I_KA)[l * RW + c];
        unsigned wAl[16], wBe[16], wKa[16], wRh[16], wV[16], wBp[16], wKp[16];
        float cs = 0.f, Eprev = 1.f;
#pragma unroll
        for (int hb = 0; hb < 2; ++hb) {
            unsigned rk_[16], rr_[16], rv_[16], rw_[16], ra_[16]; float rn_[16];
#pragma unroll
            for (int i = 0; i < 16; ++i) { const int row = row0 + sgn * (16 * hb + i); const bf16* pr = P + (size_t)row * NP; const bf16* lo = LO + (size_t)row * NLO;
                rk_[i] = pr[PC_K + c]; rr_[i] = pr[PC_R + c]; rv_[i] = pr[PC_V + c]; rw_[i] = lo[dir * RW + c]; ra_[i] = lo[1024 + dir * RW + c]; rn_[i] = NRM[row * 8 + h]; }
#pragma unroll
            for (int i = 0; i < 16; ++i) asm volatile("" : "+v"(rk_[i]), "+v"(rr_[i]), "+v"(rv_[i]), "+v"(rw_[i]), "+v"(ra_[i]), "+v"(rn_[i]));
#pragma unroll
            for (int pq = 0; pq < 8; ++pq) { const int pz = 8 * hb + pq; float al[2], be[2], ka[2], rh[2], vv[2];
#pragma unroll
                for (int e = 0; e < 2; ++e) { const int i = 2 * pq + e;
                    const float kv = bf2f((unsigned short)rk_[i]), rv = bf2f((unsigned short)rr_[i]); vv[e] = bf2f((unsigned short)rv_[i]);
                    const float wl = w0c + bf2f((unsigned short)rw_[i]), aa = __builtin_amdgcn_rcpf(1.f + __expf(-(a0c + bf2f((unsigned short)ra_[i])))), nrm = rn_[i];
                    const float lw = -0.6065306597f * __builtin_amdgcn_rcpf(1.f + __expf(-wl));
                    cs += lw; const float E = __expf(cs), Ei = __builtin_amdgcn_rcpf(E);
                    const float kkn = kv * kkc * nrm, kd = kv * (1.f + (aa - 1.f) * kac);
                    al[e] = kkn * Eprev; be[e] = kkn * aa * Ei; ka[e] = kd * Ei; rh[e] = rv * E; Eprev = E; }
                wAl[pz] = cvtpk(al[0], al[1]); wBe[pz] = cvtpk(be[0], be[1]); wKa[pz] = cvtpk(ka[0], ka[1]); wRh[pz] = cvtpk(rh[0], rh[1]); wV[pz] = cvtpk(vv[0], vv[1]); }
        }
        const float EC = Eprev;
#pragma unroll
        for (int pz = 0; pz < 16; ++pz) { wBp[pz] = cvtpk(bflo(wBe[pz]) * EC, bfhi(wBe[pz]) * EC); wKp[pz] = cvtpk(bflo(wKa[pz]) * EC, bfhi(wKa[pz]) * EC); }
        unsigned char* img = CH + (size_t)(((b * 8 + h) * 2 + dir) * SC_NCH + ci) * CH_BYTES;
        ((float*)(img + CH_EC))[lane] = EC;
        v4u cAl[2][2], cV[2][2], cBp[2][2], cKp[2][2], cRh[2][2];
        v4u tAl[4], tBe[4], tKa[4], tRh[4];
        cm_build(wAl, cAl); cm_build(wV, cV); cm_build(wBp, cBp); cm_build(wKp, cKp); cm_build(wRh, cRh);
        {   v4u cBe[2][2], cKa[2][2]; cm_build(wBe, cBe); cm_build(wKa, cKa);
#define TRANSPOSE(cZ, tZ) do { _Pragma("unroll") for (int ct = 0; ct < 2; ++ct) { f32x16 T_ = mm(cZ[ct][0], Id[0], zero16()); T_ = mm(cZ[ct][1], Id[1], T_); tZ[2 * ct] = cvtf<0, 0>(T_); tZ[2 * ct + 1] = cvtf<1, 0>(T_); } } while (0)
            TRANSPOSE(cAl, tAl); TRANSPOSE(cBe, tBe); TRANSPOSE(cKa, tKa); TRANSPOSE(cRh, tRh);
#undef TRANSPOSE
        }
#define PROD4(A, B) mm(A[3], B[3], mm(A[2], B[2], mm(A[1], B[1], mm(A[0], B[0], zero16()))))
        f32x16 XN = mask_acc<0>(PROD4(tAl, tBe), n, hh), XT = mask_acc<1>(PROD4(tBe, tAl), n, hh);
        v4u fLM[2], fGB[2], fGK[2];
        { const f32x16 t = mask_acc<1>(PROD4(tKa, tAl), n, hh); fLM[0] = cvtf<0, 0>(t); fLM[1] = cvtf<1, 0>(t); }
        { const f32x16 t = mask_acc<2>(PROD4(tBe, tRh), n, hh); fGB[0] = cvtf<0, 0>(t); fGB[1] = cvtf<1, 0>(t); }
        { const f32x16 t = mask_acc<2>(PROD4(tKa, tRh), n, hh); fGK[0] = cvtf<0, 0>(t); fGK[1] = cvtf<1, 0>(t); }
#undef PROD4
#pragma unroll
        for (int r = 0; r < 16; ++r) { XN[r] = -XN[r]; XT[r] = -XT[r]; }
        f32x16 RT = XT;
#pragma unroll
        for (int r = 0; r < 16; ++r) RT[r] += ((r & 3) + 8 * (r >> 2) + 4 * hh == n) ? 1.f : 0.f;
#pragma unroll
        for (int pw = 1; pw < 5; ++pw) {
            const v4u xn0 = cvtf<0, 0>(XN), xn1 = cvtf<1, 0>(XN), xt0 = cvtf<0, 0>(XT), xt1 = cvtf<1, 0>(XT);
            XN = mm(xt1, xn1, mm(xt0, xn0, zero16()));
            if (pw < 4) XT = mm(xn1, xt1, mm(xn0, xt0, zero16()));
            const v4u yn0 = cvtf<0, 0>(XN), yn1 = cvtf<1, 0>(XN), rt0 = cvtf<0, 0>(RT), rt1 = cvtf<1, 0>(RT);
            RT = mm(yn1, rt1, mm(yn0, rt0, RT));
        }
        const v4u fA0 = cvtf<0, 0>(RT), fA1 = cvtf<1, 0>(RT);
        f32x16 At[2], Vt[2];
#pragma unroll
        for (int t = 0; t < 2; ++t) {
            const f32x16 lmv = mm(fLM[1], cV[t][1], mm(fLM[0], cV[t][0], zero16()));
            At[t] = mm(fA1, cAl[t][1], mm(fA0, cAl[t][0], zero16()));
            Vt[t] = mm(fA1, cvtf<1, 0>(lmv), mm(fA0, cvtf<0, 0>(lmv), zero16()));
        }
#pragma unroll
        for (int kt1 = 0; kt1 < 2; ++kt1) { const v4u a0 = cvtf<0, 0>(At[kt1]), a1 = cvtf<1, 0>(At[kt1]);
#pragma unroll
            for (int kt2 = 0; kt2 < 2; ++kt2) { const f32x16 g = mm(a1, cBp[kt2][1], mm(a0, cBp[kt2][0], zero16()));
                st16(img, CH_G + ((kt2 * 2 + kt1) * 2 + 0) * 1024, lane, cvtf<0, 1>(g)); st16(img, CH_G + ((kt2 * 2 + kt1) * 2 + 1) * 1024, lane, cvtf<1, 1>(g)); } }
#pragma unroll
        for (int vt = 0; vt < 2; ++vt) { const v4u nv0 = cvtf<0, 1>(Vt[vt]), nv1 = cvtf<1, 1>(Vt[vt]);
#pragma unroll
            for (int kt = 0; kt < 2; ++kt) { f32x16 u = mm(cKp[kt][1], cV[vt][1], mm(cKp[kt][0], cV[vt][0], zero16())); u = mm(cBp[kt][1], nv1, mm(cBp[kt][0], nv0, u));
                st16(img, CH_UT + ((kt * 2 + vt) * 2 + 0) * 1024, lane, cvtf<0, 0>(u)); st16(img, CH_UT + ((kt * 2 + vt) * 2 + 1) * 1024, lane, cvtf<1, 0>(u)); }
            f32x16 y = mm(cV[vt][1], fGK[1], mm(cV[vt][0], fGK[0], zero16())); y = mm(nv1, fGB[1], mm(nv0, fGB[0], y));
            st16(img, CH_YL + (vt * 2 + 0) * 1024, lane, cvtf<0, 0>(y)); st16(img, CH_YL + (vt * 2 + 1) * 1024, lane, cvtf<1, 0>(y)); }
#pragma unroll
        for (int kt = 0; kt < 2; ++kt) { f32x16 q = mm(cRh[kt][1], Id[1], mm(cRh[kt][0], Id[0], zero16()));
            q = mm(cvtf<1, 1>(At[kt]), fGB[1], mm(cvtf<0, 1>(At[kt]), fGB[0], q));
            st16(img, CH_Q + (kt * 2 + 0) * 1024, lane, cvtf<0, 0>(q)); st16(img, CH_Q + (kt * 2 + 1) * 1024, lane, cvtf<1, 0>(q)); }
    }
}

__device__ __forceinline__ void ph_scan2(const KP& p, LAS unsigned char* lds, int l, int wave, int lane) {
    unsigned* sdone = (unsigned*)(OWS + WS_CTL) + CW_SDONE + 64 * l;
#ifndef CQ_SLOT_WGS
#define CQ_SLOT_WGS 128
#endif
    if (blockIdx.x >= SC_NCHAIN * 2) {
        const int q0 = (l < 2 ? CQ_J1 : CQ_END0) + (l & 1) * CQ_SLOT_ITEMS;
        cq_static(p, lds, q0, q0 + CQ_SLOT_ITEMS, ((int)blockIdx.x - SC_NCHAIN * 2) * NWAVES + wave, ((int)gridDim.x - SC_NCHAIN * 2) * NWAVES, wave, lane); return; }
    const int chain = blockIdx.x >> 1, vt = blockIdx.x & 1, dir = chain & 1, h = (chain >> 1) & 7, b = chain >> 4;
    const int n = lane & 31, hh = lane >> 5;
    const unsigned char* CH = OWS + WS_CH + (size_t)chain * SC_NCH * CH_BYTES; bf16* Y = (bf16*)(OWS + WS_Y) + (size_t)dir * MROWS * RW + h * 64 + 32 * vt + 4 * hh;
    constexpr int NPIECE = 19, SLOT = NPIECE * 1024, NSLOT = 6, PD = 4, XCH = NSLOT * SLOT;
    int psrc[3], pdst[3];
#pragma unroll
    for (int j = 0; j < 3; ++j) { int f = wave + 8 * j; if (f >= NPIECE) f -= NPIECE;
        pdst[j] = f;
        psrc[j] = f < 12 ? f * 1024 : f < 16 ? CH_UT + ((((f - 12) >> 1) * 2 + vt) * 2 + ((f - 12) & 1)) * 1024 : f < 18 ? CH_YL + (vt * 2 + (f - 16)) * 1024 : CH_EC; }
    const int lane_off[3] = {pdst[0] == 18 ? (lane * 16) & 255 : lane * 16, pdst[1] == 18 ? (lane * 16) & 255 : lane * 16, pdst[2] == 18 ? (lane * 16) & 255 : lane * 16};
#define SC2_ISSUE(ci_, slot_) do { const unsigned char* im_ = CH + (size_t)(ci_) * CH_BYTES; LAS unsigned char* sl_ = lds + (slot_) * SLOT; \
        _Pragma("unroll") for (int j = 0; j < 3; ++j) __builtin_amdgcn_global_load_lds((const unsigned*)(im_ + psrc[j] + lane_off[j]), (LAS unsigned*)(sl_ + pdst[j] * 1024), 16, 0, 0); } while (0)
#define SC2_LD(slot_, piece_) (*(const LAS v4u*)(lds + (slot_) * SLOT + (piece_) * 1024 + lane * 16))
#define SC2_X(par_, k_) (*(LAS v4u*)(lds + XCH + (par_) * 4096 + (k_) * 1024 + lane * 16))
    f32x16 ST[2] = {zero16(), zero16()};
    SC2_ISSUE(0, 0); SC2_ISSUE(1, 1); SC2_ISSUE(2, 2); SC2_ISSUE(3, 3);
    v4u g0, g1, g2, g3, g4, g5, g6, g7, u0, u1, u2, u3; f32x4 ec[8];
#define SC2_PRELOAD(slot_) do { g0 = SC2_LD(slot_, 0); g1 = SC2_LD(slot_, 1); g2 = SC2_LD(slot_, 2); g3 = SC2_LD(slot_, 3); g4 = SC2_LD(slot_, 4); g5 = SC2_LD(slot_, 5); g6 = SC2_LD(slot_, 6); g7 = SC2_LD(slot_, 7); \
        u0 = SC2_LD(slot_, 12); u1 = SC2_LD(slot_, 13); u2 = SC2_LD(slot_, 14); u3 = SC2_LD(slot_, 15); \
        _Pragma("unroll") for (int kq = 0; kq < 8; ++kq) ec[kq] = *(const LAS f32x4*)(lds + (slot_) * SLOT + 18 * 1024 + (32 * (kq >> 2) + 8 * (kq & 3) + 4 * hh) * 4); } while (0)
    for (int ci = 0; ci <= SC_NCH; ++ci) {
        asm volatile("s_waitcnt vmcnt(6)" ::: "memory");
        __builtin_amdgcn_s_barrier();
        asm volatile("" ::: "memory");
        { const int nx = ci + PD < SC_NCH ? ci + PD : SC_NCH - 1; SC2_ISSUE(nx, (ci + PD) % NSLOT); }
        if (wave == 0 && ci < SC_NCH) {
            if (ci == 0) SC2_PRELOAD(0);
            asm volatile("" : "+v"(g0), "+v"(g1), "+v"(g2), "+v"(g3), "+v"(g4), "+v"(g5), "+v"(g6), "+v"(g7), "+v"(u0), "+v"(u1), "+v"(u2), "+v"(u3));
            asm volatile("" : "+v"(ec[0]), "+v"(ec[1]), "+v"(ec[2]), "+v"(ec[3]), "+v"(ec[4]), "+v"(ec[5]), "+v"(ec[6]), "+v"(ec[7]));
            const v4u s00 = cvtf<0, 0>(ST[0]), s01 = cvtf<1, 0>(ST[0]), s10 = cvtf<0, 0>(ST[1]), s11 = cvtf<1, 0>(ST[1]);
            SC2_X(ci & 1, 0) = s00; SC2_X(ci & 1, 1) = s01; SC2_X(ci & 1, 2) = s10; SC2_X(ci & 1, 3) = s11;
            f32x16 a0, a1;
            a0[0] = bflo(u0.x); a0[1] = bfhi(u0.x); a0[2] = bflo(u0.y); a0[3] = bfhi(u0.y); a0[4] = bflo(u0.z); a0[5] = bfhi(u0.z); a0[6] = bflo(u0.w); a0[7] = bfhi(u0.w);
            a0[8] = bflo(u1.x); a0[9] = bfhi(u1.x); a0[10] = bflo(u1.y); a0[11] = bfhi(u1.y); a0[12] = bflo(u1.z); a0[13] = bfhi(u1.z); a0[14] = bflo(u1.w); a0[15] = bfhi(u1.w);
            a1[0] = bflo(u2.x); a1[1] = bfhi(u2.x); a1[2] = bflo(u2.y); a1[3] = bfhi(u2.y); a1[4] = bflo(u2.z); a1[5] = bfhi(u2.z); a1[6] = bflo(u2.w); a1[7] = bfhi(u2.w);
            a1[8] = bflo(u3.x); a1[9] = bfhi(u3.x); a1[10] = bflo(u3.y); a1[11] = bfhi(u3.y); a1[12] = bflo(u3.z); a1[13] = bfhi(u3.z); a1[14] = bflo(u3.w); a1[15] = bfhi(u3.w);
#pragma unroll
            for (int q = 0; q < 4; ++q)
#pragma unroll
                for (int e = 0; e < 4; ++e) { a0[4 * q + e] += ST[0][4 * q + e] * ec[q][e]; a1[4 * q + e] += ST[1][4 * q + e] * ec[4 + q][e]; }
            a0 = mm(g0, s00, a0); a1 = mm(g4, s00, a1); a0 = mm(g1, s01, a0); a1 = mm(g5, s01, a1);
            a0 = mm(g2, s10, a0); a1 = mm(g6, s10, a1); a0 = mm(g3, s11, a0); a1 = mm(g7, s11, a1);
            if (ci + 1 < SC_NCH) SC2_PRELOAD((ci + 1) % NSLOT);
            ST[0] = a0; ST[1] = a1;
            if (lane == 0 && ci == SC_NCH - 24) __hip_atomic_fetch_add(sdone, 1u, __ATOMIC_RELAXED, __HIP_MEMORY_SCOPE_AGENT);
        } else if (wave == 1 && ci >= 1) {
            const int cj = ci - 1, sj = cj % NSLOT, par = cj & 1;
            v4u ya = SC2_LD(sj, 16), yc = SC2_LD(sj, 17), q0 = SC2_LD(sj, 8), q1 = SC2_LD(sj, 9), q2 = SC2_LD(sj, 10), q3 = SC2_LD(sj, 11), x0 = SC2_X(par, 0), x1 = SC2_X(par, 1), x2 = SC2_X(par, 2), x3 = SC2_X(par, 3);
            asm volatile("" : "+v"(ya), "+v"(yc), "+v"(q0), "+v"(q1), "+v"(q2), "+v"(q3), "+v"(x0), "+v"(x1), "+v"(x2), "+v"(x3));
            f32x16 y, y2 = zero16();
            y[0] = bflo(ya.x); y[1] = bfhi(ya.x); y[2] = bflo(ya.y); y[3] = bfhi(ya.y); y[4] = bflo(ya.z); y[5] = bfhi(ya.z); y[6] = bflo(ya.w); y[7] = bfhi(ya.w);
            y[8] = bflo(yc.x); y[9] = bfhi(yc.x); y[10] = bflo(yc.y); y[11] = bfhi(yc.y); y[12] = bflo(yc.z); y[13] = bfhi(yc.z); y[14] = bflo(yc.w); y[15] = bfhi(yc.w);
            y = mm(x0, q0, y); y2 = mm(x2, q2, y2); y = mm(x1, q1, y); y2 = mm(x3, q3, y2);
            const int row = scan_row(b, dir, SC_C * cj + n); bf16* yo = Y + (size_t)row * RW;
#pragma unroll
            for (int q = 0; q < 4; ++q) *(v2u*)(yo + 8 * q) = (v2u){cvtpk(y[4 * q] + y2[4 * q], y[4 * q + 1] + y2[4 * q + 1]), cvtpk(y[4 * q + 2] + y2[4 * q + 2], y[4 * q + 3] + y2[4 * q + 3])};
        }
        asm volatile("s_waitcnt lgkmcnt(0)" ::: "memory");
    }
    asm volatile("s_waitcnt vmcnt(0)" ::: "memory");
#undef SC2_ISSUE
#undef SC2_LD
#undef SC2_X
#undef SC2_PRELOAD
}

__device__ __forceinline__ float sum8(float v) { v += __shfl_xor(v, 1); v += __shfl_xor(v, 2); v += __shfl_xor(v, 4); return v; }
__device__ __forceinline__ void unpack8(v4u s, float (&v)[8]) { v[0] = bflo(s.x); v[1] = bfhi(s.x); v[2] = bflo(s.y); v[3] = bfhi(s.y); v[4] = bflo(s.z); v[5] = bfhi(s.z); v[6] = bflo(s.w); v[7] = bfhi(s.w); }
__device__ __forceinline__ void ld8f(const float* q, float (&v)[8]) { const f32x4 a = *(const f32x4*)q, b = *(const f32x4*)(q + 4); v[0] = a[0]; v[1] = a[1]; v[2] = a[2]; v[3] = a[3]; v[4] = b[0]; v[5] = b[1]; v[6] = b[2]; v[7] = b[3]; }
__device__ __forceinline__ v4u pack8(const float (&v)[8]) { v4u o; o.x = cvtpk(v[0], v[1]); o.y = cvtpk(v[2], v[3]); o.z = cvtpk(v[4], v[5]); o.w = cvtpk(v[6], v[7]); return o; }

__device__ __forceinline__ void ph_readout2(const KP& p, int l, int gw, int NGW, int lane) {
    const bf16* P = (const bf16*)(OWS + WS_P); const bf16* LO = (const bf16*)(OWS + WS_LO); const bf16* Y = (const bf16*)(OWS + WS_Y);
    bf16* MI = (bf16*)(OWS + WS_MIXIN); constexpr size_t PA = (size_t)MROWS * RW; const int c0 = lane * 8;
    const int nrows = l == DEPTH - 1 ? NLAT : MROWS;
#pragma unroll 2
    for (int row = gw; row < nrows; row += NGW) { const bf16* pr = P + (size_t)row * NP; const bf16* lo = LO + (size_t)row * NLO;
        int t, len; if (row < NLAT) { t = row & 63; len = 64; } else { t = (row - NLAT) & 255; len = 256; }
        const v4u kw = *(const v4u*)(pr + PC_K + c0), rw = *(const v4u*)(pr + PC_R + c0), vw = *(const v4u*)(pr + PC_V + c0);
        const v4u cbw = *(const v4u*)(pr + PC_CB + c0), ccw = *(const v4u*)(pr + PC_CC + c0), chw = *(const v4u*)(pr + PC_CH + c0);
        v4u ccp = (v4u){0u, 0u, 0u, 0u}, chp = ccp, ccn = ccp, chn = ccp;
        if (t > 0) { ccp = *(const v4u*)(pr - NP + PC_CC + c0); chp = *(const v4u*)(pr - NP + PC_CH + c0); }
        if (t < len - 1) { ccn = *(const v4u*)(pr + NP + PC_CC + c0); chn = *(const v4u*)(pr + NP + PC_CH + c0); }
        float yf[8], yb[8], la0[8], la1[8], g[8];
        unpack8(*(const v4u*)(Y + (size_t)row * RW + c0), yf); unpack8(*(const v4u*)(Y + PA + (size_t)row * RW + c0), yb); unpack8(*(const v4u*)(lo + 1024 + c0), la0); unpack8(*(const v4u*)(lo + 1536 + c0), la1); unpack8(*(const v4u*)(lo + 2048 + c0), g);
        float a0[8], a1[8], ka[8], rkp[8], lg[8], lb[8];
        ld8f(PIN(I_A0) + (l * 2 + 0) * RW + c0, a0); ld8f(PIN(I_A0) + (l * 2 + 1) * RW + c0, a1); ld8f(PIN(I_KA) + l * RW + c0, ka); ld8f(PIN(I_RK) + l * RW + c0, rkp);
        ld8f(PIN(I_LNXG) + l * RW + c0, lg); ld8f(PIN(I_LNXB) + l * RW + c0, lb);
        float kv[8], rv[8], vv[8]; unpack8(kw, kv); unpack8(rw, rv); unpack8(vw, vv);
        float y[8], s = 0.f, rk = 0.f;
#pragma unroll
        for (int j = 0; j < 8; ++j) { y[j] = yf[j] + yb[j]; s += y[j]; const float av = sigm(a0[j] + la0[j]) + sigm(a1[j] + la1[j]); rk += rv[j] * kv[j] * (2.f + (av - 2.f) * ka[j]) * rkp[j]; }
        const float mu = sum8(s) * (1.f / 64.f); rk = sum8(rk); float q = 0.f;
#pragma unroll
        for (int j = 0; j < 8; ++j) { y[j] -= mu; q += y[j] * y[j]; }
        const float rstd = 1.f / sqrtf(sum8(q) * (1.f / 64.f) + GN_EPS);
        float o[8];
#pragma unroll
        for (int j = 0; j < 8; ++j) o[j] = (y[j] * rstd * lg[j] + lb[j] + rk * vv[j]) * g[j];
        float orw[8];
#pragma unroll
        for (int j = 0; j < 8; ++j) orw[j] = o[j];
        float cb[8], cc[8], ch[8], pcc[8], pch[8], ncc[8], nch[8], w0[8], w1[8], w2[8];
        unpack8(cbw, cb); unpack8(ccw, cc); unpack8(chw, ch); unpack8(ccp, pcc); unpack8(chp, pch); unpack8(ccn, ncc); unpack8(chn, nch);
        const float* cw = PIN(I_CONVW) + (size_t)l * 3 * RW + c0; ld8f(cw, w0); ld8f(cw + RW, w1); ld8f(cw + 2 * RW, w2);
#pragma unroll
        for (int j = 0; j < 8; ++j) o[j] = cb[j] * (pcc[j] * pch[j] * w0[j] + cc[j] * ch[j] * w1[j] + ncc[j] * nch[j] * w2[j]);
        float am = 0.f;
#pragma unroll
        for (int j = 0; j < 8; ++j) am = fmaxf(am, fmaxf(fabsf(orw[j]), fabsf(o[j])));
#pragma unroll
        for (int sh = 1; sh < 64; sh <<= 1) am = fmaxf(am, __shfl_xor(am, sh));
        am = fmaxf(am, 1e-30f); const float inv = 127.f / am; unsigned char* m8 = (unsigned char*)MI + (size_t)row * D + c0;
        *(v2u*)m8 = (v2u){q8pack(orw[0] * inv, orw[1] * inv, orw[2] * inv, orw[3] * inv), q8pack(orw[4] * inv, orw[5] * inv, orw[6] * inv, orw[7] * inv)};
        *(v2u*)(m8 + RW) = (v2u){q8pack(o[0] * inv, o[1] * inv, o[2] * inv, o[3] * inv), q8pack(o[4] * inv, o[5] * inv, o[6] * inv, o[7] * inv)};
        if (lane == 0) ((float*)(OWS + WS_SAM))[row] = am * (1.f / 127.f);
    }
}


template <int KS> __device__ __forceinline__ void lora_afrag(const v4u (&raw)[KS], int fn, v4u (&af)[KS]) {
#pragma unroll
    for (int s = 0; s < KS; ++s) { float v[8]; unpack8(raw[s], v);
        if (fn == 0) {
#pragma unroll
            for (int j = 0; j < 8; ++j) v[j] = 1.f - 2.f * __builtin_amdgcn_rcpf(1.f + __expf(2.f * v[j])); }
        else if (fn == 2) {
#pragma unroll
            for (int j = 0; j < 8; ++j) v[j] = __builtin_amdgcn_rcpf(1.f + __expf(-v[j])); }
        af[s] = pack8(v); }
}
template <int KS, int NT> __device__ __forceinline__ void lora_task(const bf16* P, int col0, int fn, const bf16* wt, bf16* LOg, int ct0, int rb0, int rb1, int n, int hh) {
    v4u bfr[NT][KS];
#pragma unroll
    for (int t = 0; t < NT; ++t)
#pragma unroll
        for (int s = 0; s < KS; ++s) bfr[t][s] = *(const v4u*)(wt + (size_t)(32 * (ct0 + t) + n) * (16 * KS) + 8 * hh + 16 * s);
    v4u raw[KS];
#pragma unroll
    for (int s = 0; s < KS; ++s) raw[s] = *(const v4u*)(P + (size_t)(rb0 * 32 + n) * NP + col0 + 16 * s + 8 * hh);
    for (int rb = rb0; rb < rb1; ++rb) {
        v4u af[KS]; lora_afrag<KS>(raw, fn, af);
        if (rb + 1 < rb1) {
#pragma unroll
            for (int s = 0; s < KS; ++s) raw[s] = *(const v4u*)(P + (size_t)((rb + 1) * 32 + n) * NP + col0 + 16 * s + 8 * hh); }
        int no = n, ho = hh; asm volatile("" : "+v"(no), "+v"(ho));
        bf16* out = LOg + (size_t)(rb * 32 + 4 * ho) * NLO + 32 * ct0 + no;
#pragma unroll
        for (int t = 0; t < NT; ++t) { f32x16 acc = zero16();
#pragma unroll
            for (int s = 0; s < KS; ++s) acc = mm(af[s], bfr[t][s], acc);
#pragma unroll
            for (int r = 0; r < 16; ++r) out[(size_t)((r & 3) + 8 * (r >> 2)) * NLO + 32 * t] = (bf16)f2bf(acc[r]); }
    }
}
__device__ __forceinline__ void ph_lora(const KP& p, int l, int gw, int NGW, int lane) {
    const bf16* P = (const bf16*)(OWS + WS_P); bf16* LO = (bf16*)(OWS + WS_LO); float* NRM = (float*)(OWS + WS_RKS);
    const bf16* LW = (const bf16*)(OWS + WS_LORA) + (size_t)l * LORAW_PER_LAYER; const int n = lane & 31, hh = lane >> 5;
    constexpr int RCH = 7, NRB = MROWS / 32, NCHK = (NRB + RCH - 1) / RCH;
    for (int task = gw; task < NCHK * 24; task += NGW) { const int ctk = task % 24, chunk = task / 24, rb0 = chunk * RCH, rb1 = rb0 + RCH < NRB ? rb0 + RCH : NRB;
        if (ctk < 16) { const int grp = ctk >> 2; lora_task<4, 4>(P, grp < 2 ? PC_WD + 64 * grp : PC_AD + 64 * (grp - 2), grp < 2 ? 0 : 1, LW + (size_t)grp * 512 * 64, LO + grp * 512, (ctk & 3) * 4, rb0, rb1, n, hh); }
        else lora_task<8, 2>(P, PC_GD, 2, LW + (size_t)4 * 512 * 64, LO + 4 * 512, (ctk - 16) * 2, rb0, rb1, n, hh); }
    float kkc[8]; ld8f(PIN(I_KK) + l * RW + lane * 8, kkc);
    for (int row = gw; row < MROWS; row += NGW) { const v4u kw = *(const v4u*)(P + (size_t)row * NP + PC_K + lane * 8); float kv[8]; unpack8(kw, kv); float ss = 0.f;
#pragma unroll
        for (int j = 0; j < 8; ++j) { const float t = kv[j] * kkc[j]; ss += t * t; }
        ss = sum8(ss); if ((lane & 7) == 0) NRM[row * 8 + (lane >> 3)] = 1.f / fmaxf(sqrtf(ss), 1e-12f); }
}

__device__ __forceinline__ void ph_moe_gather(const KP& p, int l, int gw, int NGW, int lane) {
    const unsigned* gcnt = (const unsigned*)(OWS + WS_CTL) + CW_GCNT + 64 * (l >> 1);
    int cnt[8], pb[9]; pb[0] = 0;
#pragma unroll
    for (int e = 0; e < 8; ++e) { cnt[e] = (int)gcnt[e]; pb[e + 1] = pb[e] + ((cnt[e] + 255) & ~255); }
    const unsigned* rowlist = (const unsigned*)(OWS + WS_ROWLIST); const float* wsel = (const float*)(OWS + WS_WSEL); float* wsort = (float*)(OWS + WS_WSORT);
    const unsigned char* H8 = OWS + WS_H8; unsigned char* HG = OWS + WS_HG; const float* sa = (const float*)(OWS + WS_SA); float* sag = (float*)(OWS + WS_SAG);
    for (int pos = gw; pos < pb[8]; pos += NGW) {
        int e = 0, base = 0, ce = cnt[0];
#pragma unroll
        for (int k = 1; k < 8; ++k) if (pos >= pb[k]) { e = k; base = pb[k]; ce = cnt[k]; }
        const int rank = pos - base; v4u a = (v4u){0u, 0u, 0u, 0u}; float w = 0.f, sc = 0.f;
        if (rank < ce) { const unsigned ent = rowlist[(size_t)e * MROWS + rank]; a = *(const v4u*)(H8 + (size_t)(ent >> 1) * D + lane * 16); w = wsel[ent]; sc = sa[ent >> 1]; }
        *(v4u*)(HG + (size_t)pos * D + lane * 16) = a;
        if (lane == 0) { wsort[pos] = w; sag[pos] = sc; }
    }
}

__device__ __forceinline__ void ph_ln(const KP& p, LAS unsigned char* lds, int l, int which, int tid, int wave, int gw, int NGW, int lane) {
    const float* modv = (const float*)(OWS + WS_MODV); float* X = (float*)(OWS + WS_X); bf16* H = (bf16*)(OWS + WS_H);
    const bf16* BR = (const bf16*)(OWS + (which == 0 ? WS_MIXO : WS_F)); const float* BP = (const float*)(OWS + (which == 0 ? WS_MIXP : WS_FP));
    const float* lg = PIN(which == 0 ? I_LN1G : I_LN2G) + l * D; const float* lb = PIN(which == 0 ? I_LN1B : I_LN2B) + l * D;
    const bool moe = (which == 0) && (l & 1); const bool last = (which == 1) && (l == DEPTH - 1); const bool moe_out = (which == 1) && (l & 1);
    LAS int* lcnt = (LAS int*)lds;
    LAS int* lsel = (LAS int*)(lds + 64);
    int nloc = 0;
    if (moe) { if (tid < 16) lcnt[tid] = 0; __syncthreads(); }
    int pbs[9]; pbs[0] = 0;
    if (moe_out) { const unsigned* gcnt = (const unsigned*)(OWS + WS_CTL) + CW_GCNT + 64 * (l >> 1);
#pragma unroll
        for (int e = 0; e < 8; ++e) pbs[e + 1] = pbs[e] + (int)((gcnt[e] + 255u) & ~255u); }
    f32x4 gt[4], g4[4], b4[4], sh[4], sc[4]; ld_row(lg, lane, g4); ld_row(lb, lane, b4);
#pragma unroll 2
    for (int it = 0; it < 9; ++it) {
        if (it == 8 && (gw >= NCTX || l == DEPTH - 1)) break;
        const int row = it < 8 ? (gw >> 9) * SEQ + (gw & 511) + 512 * it : NLAT + gw;
        const int mr = mod_row(row); const float* mv = modv + (size_t)(l * 5 + mr) * NMOD;
        if (it == 0 || it == 8) { ld_row(mv + (which == 0 ? 2048 : 5120), lane, gt);
            if (!last) { const float* mv2 = which == 0 ? mv + 3072 : modv + (size_t)((l + 1) * 5 + mr) * NMOD; ld_row(mv2, lane, sh); ld_row(mv2 + 1024, lane, sc); } }
        f32x4 x[4], br[4], t[4]; ld_row(l == 0 && which == 0 ? (row < NLAT ? PIN(I_X) + (size_t)row * D : PIN(I_CTX) + (size_t)(row - NLAT) * D) : X + (size_t)row * D, lane, x);
        if (moe_out) { const int* ts = (const int*)(OWS + WS_TOKSEL) + row * 4; const int e0 = ts[0], r0 = ts[1], e1 = ts[2], r1 = ts[3]; int b0 = 0, b1 = 0;
#pragma unroll
            for (int k = 1; k < 8; ++k) { if (e0 >= k) b0 = pbs[k]; if (e1 >= k) b1 = pbs[k]; }
            f32x4 ba[4], bb[4]; const int q0 = b0 + r0, q1 = b1 + r1; constexpr int MM = MOE_MAIN_PANELS * 256;
            if (q0 < MM) ld_row_bf16(BR + (size_t)q0 * D, lane, ba); else ld_row_parts<4>(BP + (size_t)(q0 - MM) * D, (size_t)MOE_TAIL_ROWS * D, lane, ba);
            if (q1 < MM) ld_row_bf16(BR + (size_t)q1 * D, lane, bb); else ld_row_parts<4>(BP + (size_t)(q1 - MM) * D, (size_t)MOE_TAIL_ROWS * D, lane, bb);
#pragma unroll
            for (int j = 0; j < 4; ++j) br[j] = ba[j] + bb[j]; }
        else if (row < NLAT) ld_row_bf16(BR + (size_t)row * D, lane, br);
        else if (which == 0) ld_row_parts<2>(BP + (size_t)(row - NLAT) * D, (size_t)NCTX * D, lane, br);
        else ld_row_parts<7>(BP + (size_t)(row - NLAT) * D, (size_t)NCTX * D, lane, br);
        float s = 0.f;
#pragma unroll
        for (int j = 0; j < 4; ++j) { t[j] = DN_ALPHA * x[j] + gt[j] * br[j]; s += (t[j][0] + t[j][1]) + (t[j][2] + t[j][3]); }
        const float mean = wave_sum(s) * (1.f / D); float s2 = 0.f;
#pragma unroll
        for (int j = 0; j < 4; ++j) { t[j] = t[j] - mean; s2 += (t[j][0] * t[j][0] + t[j][1] * t[j][1]) + (t[j][2] * t[j][2] + t[j][3] * t[j][3]); }
        const float rstd = 1.f / sqrtf(wave_sum(s2) * (1.f / D) + LN_EPS);
#pragma unroll
        for (int j = 0; j < 4; ++j) x[j] = t[j] * rstd * g4[j] + b4[j];
        if (last) {
#if PROBE_DUP & (128 | 256)
            { const unsigned* cw = (const unsigned*)(OWS + WS_CTL); const float cval = 10.f * ((float)cw[20001] / 1024.f) / fmaxf((float)cw[20000], 1.f);
#pragma unroll
              for (int j = 0; j < 4; ++j) x[j] = (f32x4){cval, cval, cval, cval}; }
#endif
            if (row < NLAT) st_row(p.out + (size_t)row * D, lane, x); continue; }
        st_row(X + (size_t)row * D, lane, x);
        f32x4 hh[4];
#pragma unroll
        for (int j = 0; j < 4; ++j) hh[j] = x[j] * (1.f + sc[j]) + sh[j];
        st_row_q8(OWS + WS_H8, (float*)(OWS + WS_SA), row, lane, hh);
        if (moe) {
            const float* rw = PIN(I_RTW) + (size_t)(l >> 1) * D * NE; float lgt[8];
#pragma unroll
            for (int e = 0; e < 8; ++e) lgt[e] = 0.f;
#pragma unroll
            for (int j = 0; j < 4; ++j)
#pragma unroll
                for (int i = 0; i < 4; ++i) { const f32x4* wp = (const f32x4*)(rw + (size_t)(4 * lane + 256 * j + i) * NE); const f32x4 w0 = wp[0], w1 = wp[1]; const float hv = hh[j][i];
                    lgt[0] += hv * w0[0]; lgt[1] += hv * w0[1]; lgt[2] += hv * w0[2]; lgt[3] += hv * w0[3]; lgt[4] += hv * w1[0]; lgt[5] += hv * w1[1]; lgt[6] += hv * w1[2]; lgt[7] += hv * w1[3]; }
#pragma unroll
            for (int e = 0; e < 8; ++e) lgt[e] = wave_sum(lgt[e]) + PIN(I_RTB)[(l >> 1) * NE + e];
            float v0 = lgt[0]; int i0 = 0;
#pragma unroll
            for (int e = 1; e < 8; ++e) if (lgt[e] > v0) { v0 = lgt[e]; i0 = e; }
            float v1 = -3.0e38f; int i1 = -1;
#pragma unroll
            for (int e = 0; e < 8; ++e) if (e != i0 && lgt[e] > v1) { v1 = lgt[e]; i1 = e; }
            const float w0 = 1.f / (1.f + expf(v1 - v0)), w1 = 1.f - w0;
            if (lane == 0) { const int lr0 = __hip_atomic_fetch_add(lcnt + i0, 1, __ATOMIC_RELAXED, __HIP_MEMORY_SCOPE_WORKGROUP), lr1 = __hip_atomic_fetch_add(lcnt + i1, 1, __ATOMIC_RELAXED, __HIP_MEMORY_SCOPE_WORKGROUP); const int li = nloc * NWAVES + wave;
                lsel[li * 8 + 0] = row; lsel[li * 8 + 1] = i0; lsel[li * 8 + 2] = lr0; lsel[li * 8 + 3] = i1; lsel[li * 8 + 4] = lr1;
                ((float*)(OWS + WS_WSEL))[row * 2] = w0; ((float*)(OWS + WS_WSEL))[row * 2 + 1] = w1; }
            ++nloc;
        }
    }
    if (moe) {
        __syncthreads();
        unsigned* gcnt = (unsigned*)(OWS + WS_CTL) + CW_GCNT + 64 * (l >> 1);
        if (tid < 8) lcnt[8 + tid] = (int)__hip_atomic_fetch_add(gcnt + tid, (unsigned)lcnt[tid], __ATOMIC_RELAXED, __HIP_MEMORY_SCOPE_AGENT);
        __syncthreads();
        unsigned* rowlist = (unsigned*)(OWS + WS_ROWLIST); int* toksel = (int*)(OWS + WS_TOKSEL);
        if (tid < 16 * NWAVES) { const int k = tid / NWAVES, w = tid % NWAVES; if (k < 8 || (k == 8 && (int)blockIdx.x * NWAVES + w < NCTX && l != DEPTH - 1)) { const int li = k * NWAVES + w;
            const int row = lsel[li * 8 + 0], e0 = lsel[li * 8 + 1], r0 = lcnt[8 + e0] + lsel[li * 8 + 2], e1 = lsel[li * 8 + 3], r1 = lcnt[8 + e1] + lsel[li * 8 + 4];
            rowlist[(size_t)e0 * MROWS + r0] = (unsigned)row * 2u; rowlist[(size_t)e1 * MROWS + r1] = (unsigned)row * 2u + 1u;
            toksel[row * 4 + 0] = e0; toksel[row * 4 + 1] = r0; toksel[row * 4 + 2] = e1; toksel[row * 4 + 3] = r1; } }
    }
}


#ifndef PROBE_WHICH
#define PROBE_WHICH(x, y) (x)
#endif
#if PROBE_DUP & 128
__device__ __forceinline__ void ph_check_up(const KP& p, int gw, int lane) {
    if (gw >= 64) return;
    const float* X = (const float*)(OWS + WS_X); const float* modv = (const float*)(OWS + WS_MODV); const bf16* ACT = (const bf16*)(OWS + WS_ACT);
    const int row = gw * 257, c = lane * 56 + (gw & 7), mr = mod_row(row); const float* mv = modv + (size_t)(0 * 5 + mr) * NMOD;
    const signed char* H8 = (const signed char*)(OWS + WS_H8); const signed char* W8 = (const signed char*)(OWS + WS_F13); const float* SA = (const float*)(OWS + WS_SA); const unsigned* AM = (const unsigned*)(OWS + WS_AMAX);
    const int j1 = 8 * (c >> 2) + (c & 3), j3 = j1 + 4; int ia = 0, ib = 0;
    for (int k = 0; k < D; ++k) { const int h = H8[(size_t)row * D + k]; ia += h * W8[(size_t)j1 * D + k]; ib += h * W8[(size_t)j3 * D + k]; }
    const float a = (float)ia * SA[row] * __builtin_bit_cast(float, AM[j1]) * (1.f / 127.f), b = (float)ib * SA[row] * __builtin_bit_cast(float, AM[j3]) * (1.f / 127.f);
    (void)X; (void)mv;
    const float ref = a / (1.f + expf(-a)) * b, got = bf2f(ACT[(size_t)row * DFF + c]);
    const float da = ((const float*)(OWS + WS_F))[(size_t)row * DFF + c], db = ((const float*)(OWS + WS_F))[(size_t)4096 * DFF + (size_t)row * DFF + c]; (void)got; (void)db;
    if (row < 4096 && abs(ia) > 1000) { const float ratio = 10.f * fminf(fabsf(PROBE_WHICH(da / a, db / b) - 1.f), 0.4f);
        __hip_atomic_fetch_add((unsigned*)(OWS + WS_CTL) + 20000, 1u, __ATOMIC_RELAXED, __HIP_MEMORY_SCOPE_AGENT); __hip_atomic_fetch_add((unsigned*)(OWS + WS_CTL) + 20001, (unsigned)(ratio * 1024.f), __ATOMIC_RELAXED, __HIP_MEMORY_SCOPE_AGENT); }
}
#endif

#if PROBE_DUP & 256
__device__ __forceinline__ void ph_check_mfma(const KP& p, int lane) {
    typedef int i32x4 __attribute__((ext_vector_type(4)));
    const int r = lane & 15, g = lane >> 4; unsigned aw[4], bw[4];
#pragma unroll
    for (int q = 0; q < 4; ++q) { unsigned a = 0, b = 0;
#pragma unroll
        for (int t = 0; t < 4; ++t) { const int k = 16 * g + 4 * q + t; const int av = ((r * 7 + k * 3) % 5) - 2, bv = ((r * 5 + k * 11) % 7) - 3; a |= (unsigned)(av & 255) << (8 * t); b |= (unsigned)(bv & 255) << (8 * t); }
        aw[q] = a; bw[q] = b; }
    i32x4 c = {0, 0, 0, 0};
    c = __builtin_amdgcn_mfma_i32_16x16x64_i8((i32x4){(int)aw[0], (int)aw[1], (int)aw[2], (int)aw[3]}, (i32x4){(int)bw[0], (int)bw[1], (int)bw[2], (int)bw[3]}, c, 0, 0, 0);
    bool bad = false;
#pragma unroll
    for (int reg = 0; reg < 4; ++reg) { const int i = 4 * g + reg, j = r; int e = 0;
        for (int k = 0; k < 64; ++k) e += (((i * 7 + k * 3) % 5) - 2) * (((j * 5 + k * 11) % 7) - 3);
        if (c[reg] != e) bad = true; }
    if (bad) __hip_atomic_fetch_add((unsigned*)(OWS + WS_CTL) + 20000, 1000u, __ATOMIC_RELAXED, __HIP_MEMORY_SCOPE_AGENT);
}
#endif
__global__ void __launch_bounds__(NWAVES * 64, 2) fwd_kernel(KP p) {
    extern __shared__ __attribute__((aligned(16))) unsigned char lds_raw[];
    LAS unsigned char* lds = (LAS unsigned char*)lds_raw;
    volatile LAS unsigned* MISC = (volatile LAS unsigned*)(lds + MISC_OFF);
    const int G = gridDim.x, NGW = G * NWAVES;
    for (int u = threadIdx.x; u < (LDS_BYTES - LDSCTL_OFF) / 4; u += NWAVES * 64) ((LAS unsigned*)(lds + LDSCTL_OFF))[u] = 0u;
    __syncthreads();
    unsigned* ctl = (unsigned*)(OWS + WS_CTL);
    const bool single = p.ph < 0;
    XcdBarrier bar; bar.bar = ctl + CW_BAR; bar.x = 0; bar.st = nullptr;
    if (single) bar = xcd_barrier_post(ctl + CW_BAR, MISC + 8);
    int phc = 0;
#ifndef PROBE_DUP
#define PROBE_DUP 0
#endif
#define REP(bit) for (int rep_ = 0; rep_ < ((PROBE_DUP & (bit)) ? 2 : 1); ++rep_)
#define RUN() (single || p.ph == phc)
#define FRESH() int tid = threadIdx.x; asm volatile("" : "+v"(tid)); const int lane = tid & 63, wave = __builtin_amdgcn_readfirstlane(tid >> 6), gw = blockIdx.x * NWAVES + wave; (void)lane; (void)gw
#define SEAM() do { if (single) { XcdBarrier b2_ = bar; asm volatile("" : "+s"(b2_.bar)); xcd_barrier(b2_); if (PROBE_DUP & 32) { XcdBarrier b3_ = bar; asm volatile("" : "+s"(b3_.bar)); xcd_barrier(b3_); } } ++phc; } while (0)

    REP(4) if (RUN()) { FRESH(); ph_modvec(p, lds, tid); __syncthreads(); ph_convert(p, lds, gw, NGW, wave, lane); cq_static(p, lds, 3 * CQ_IN + 3 * CQ_OUT + 2 * CQ_UP, CQ_J1, gw, NGW, wave, lane); ph_amax(p, gw, NGW, lane); }
    SEAM();
#if PROBE_DUP & 256
    if (blockIdx.x == 0 && threadIdx.x < 64) ph_check_mfma(p, threadIdx.x);
#endif
    if (RUN()) { FRESH(); ph_init_rows(p, gw, NGW, lane); cq_static(p, lds, -CQ_NEG, 3 * CQ_IN + 3 * CQ_OUT + 2 * CQ_UP, gw, NGW, wave, lane); }
    SEAM();
    for (int ll = 0; ll < DEPTH; ++ll) {
#define l (ll + opaque_zero_i())
         if (RUN()) { pg8::Gemm g{(const bf16*)(OWS + WS_H8), (const bf16*)(OWS + WS_WIN) + (size_t)l * (NP * D / 2), MROWS, NP, D / 2, D / 2}; pg8::StaticOrder S; S.init(MROWS, NP, G, (int)blockIdx.x);
            pg8::EpiBf16S8 E{(bf16*)(OWS + WS_P), NP, (const float*)(OWS + WS_SA), (const float*)(OWS + WS_AMAX) + AM_IN + l * NP}; pg8::gemm_phase<pg8::EpiBf16S8, pg8::StaticOrder, true, true, true>(lds, g, S, E); }
        SEAM();
        REP(8) if (RUN()) { FRESH(); ph_lora(p, l, gw, NGW, lane); }
        SEAM();
        REP(1) if (RUN()) { FRESH(); ph_scan1(p, l, gw, NGW, lane); }
        SEAM();
        REP(2) if (RUN()) { FRESH(); ph_scan2(p, lds, l, wave, lane); }
        SEAM();
        REP(64) if (RUN()) { FRESH(); ph_readout2(p, l, gw, NGW, lane); }
        SEAM();
         if (RUN()) {
            { pg8::Gemm g{(const bf16*)(OWS + WS_MIXIN), (const bf16*)(OWS + WS_WOUT) + (size_t)l * (D * D / 2), NLAT, D, D / 2, D / 2}; pg8::StaticOrder S; S.init(NLAT, D, G, (int)blockIdx.x);
              pg8::EpiBf16S8 E{(bf16*)(OWS + WS_MIXO), D, (const float*)(OWS + WS_SAM), (const float*)(OWS + WS_AMAX) + AM_OUT + l * D}; pg8::gemm_phase<pg8::EpiBf16S8, pg8::StaticOrder, true, true, true>(lds, g, S, E); }
            if (ll < DEPTH - 1) { pg8::Gemm g{(const bf16*)(OWS + WS_MIXIN), (const bf16*)(OWS + WS_WOUT) + (size_t)l * (D * D / 2), NCTX, D, D / 4, D / 2}; pg8::SplitOrder S{NCTX / 256, D / 256, 2, G, (int)blockIdx.x, NLAT / 256, 0, 0, 0, 0, 0, 0, 0, 0};
              pg8::EpiPartS8 E{(float*)(OWS + WS_MIXP), D, (size_t)NCTX * D, NLAT / 256, (const float*)(OWS + WS_SAM), (const float*)(OWS + WS_AMAX) + AM_OUT + l * D}; pg8::gemm_phase<pg8::EpiPartS8, pg8::SplitOrder, true, true, true>(lds, g, S, E); }
        }
        SEAM();
        for (int rep2_ = 0; rep2_ < (((PROBE_DUP & 512) && ll == 0) ? 5 : 1); ++rep2_) if (RUN()) { FRESH(); ph_ln(p, lds, l, 0, tid, wave, gw, NGW, lane); if (ll & 1) { __syncthreads(); cq_static(p, lds, (l == 1 ? CQ_J1 : CQ_END0) + 2 * CQ_SLOT_ITEMS, l == 1 ? CQ_END0 : CQ_END1, gw, NGW, wave, lane); } }
        SEAM();
        if ((l & 1) == 0) {
            const int fi = l >> 1;
             if (RUN()) { pg8::Gemm g{(const bf16*)(OWS + WS_H8), (const bf16*)(OWS + WS_F13) + (size_t)fi * DFF * D, MROWS, 2 * DFF, D / 2, D / 2}; pg8::StaticOrder S; S.init(MROWS, 2 * DFF, G, (int)blockIdx.x);
                constexpr int NOE = 0x7fffffff; pg8::EpiSwiGLU8 E{(bf16*)(OWS + WS_ACT), DFF, nullptr, (const float*)(OWS + WS_SA), (const unsigned*)(OWS + WS_AMAX) + (size_t)fi * 2 * DFF, NOE, NOE, NOE, NOE, NOE, NOE, NOE};
#if PROBE_DUP & 128
                E.dbg = (int*)(OWS + WS_F);
#endif
                pg8::gemm_phase<pg8::EpiSwiGLU8, pg8::StaticOrder, true, true, true>(lds, g, S, E); }
            SEAM();
#if PROBE_DUP & 128
            if (ll == 0) { if (RUN()) { FRESH(); ph_check_up(p, gw, lane); } SEAM(); }
#endif
             if (RUN()) {
                { pg8::Gemm g{(const bf16*)(OWS + WS_ACT), (const bf16*)(OWS + WS_F2) + (size_t)fi * D * DFF, NLAT, D, DFF, DFF}; pg8::StaticOrder S; S.init(NLAT, D, G, (int)blockIdx.x);
                  pg8::EpiBf16<0> E{(bf16*)(OWS + WS_F), D, nullptr, 0, 0, 1.f}; pg8::gemm_phase<pg8::EpiBf16<0>, pg8::StaticOrder, true, true>(lds, g, S, E); }
                { pg8::Gemm g{(const bf16*)(OWS + WS_ACT), (const bf16*)(OWS + WS_F2) + (size_t)fi * D * DFF, NCTX, D, DFF / 7, DFF}; pg8::SplitOrder S{NCTX / 256, D / 256, 7, G, (int)blockIdx.x, NLAT / 256, 0, 0, 0, 0, 0, 0, 0, 0};
                  pg8::EpiPart E{(float*)(OWS + WS_FP), D, (size_t)NCTX * D, NLAT / 256}; pg8::gemm_phase<pg8::EpiPart, pg8::SplitOrder, true, true>(lds, g, S, E); }
            }
            SEAM();
        } else {
            if (RUN()) { FRESH(); ph_moe_gather(p, l, gw, NGW, lane); }
            SEAM();
            {   const unsigned* gcnt = (const unsigned*)(OWS + WS_CTL) + CW_GCNT + 64 * (l >> 1); int pbp[9]; pbp[0] = 0;
#pragma unroll
                for (int e = 0; e < 8; ++e) pbp[e + 1] = pbp[e] + (int)((gcnt[e] + 255u) >> 8);
                const int mrows = pbp[8] * 256;
                 if (RUN()) { pg8::Gemm g{(const bf16*)(OWS + WS_HG), (const bf16*)(OWS + WS_MOEW13), mrows, 2 * DFF, D / 2, D / 2}; pg8::MoeOrder S; S.init(mrows, 2 * DFF, G, (int)blockIdx.x);
                    S.pb1 = pbp[1]; S.pb2 = pbp[2]; S.pb3 = pbp[3]; S.pb4 = pbp[4]; S.pb5 = pbp[5]; S.pb6 = pbp[6]; S.pb7 = pbp[7]; S.estride = (size_t)DFF * D;
                    pg8::EpiSwiGLU8 E{(bf16*)(OWS + WS_ACT), DFF, (const float*)(OWS + WS_WSORT), (const float*)(OWS + WS_SAG), (const unsigned*)(OWS + WS_AMAX) + (size_t)(2 + 8 * (l >> 1)) * 2 * DFF, pbp[1], pbp[2], pbp[3], pbp[4], pbp[5], pbp[6], pbp[7]};
                    pg8::gemm_phase<pg8::EpiSwiGLU8, pg8::MoeOrder, true, true, true>(lds, g, S, E); }
                SEAM();
                 if (RUN()) {
                    { pg8::Gemm g{(const bf16*)(OWS + WS_ACT), (const bf16*)(OWS + WS_MOEW2), MOE_MAIN_PANELS * 256, D, DFF, DFF}; pg8::MoeOrder S; S.init(MOE_MAIN_PANELS * 256, D, G, (int)blockIdx.x);
                      S.pb1 = pbp[1]; S.pb2 = pbp[2]; S.pb3 = pbp[3]; S.pb4 = pbp[4]; S.pb5 = pbp[5]; S.pb6 = pbp[6]; S.pb7 = pbp[7]; S.estride = (size_t)D * DFF;
                      pg8::EpiBf16<0> E{(bf16*)(OWS + WS_F), D, nullptr, 0, 0, 1.f}; pg8::gemm_phase<pg8::EpiBf16<0>, pg8::MoeOrder, true, true>(lds, g, S, E); }
                    { const int nT = pbp[8] - MOE_MAIN_PANELS;
                      pg8::Gemm g{(const bf16*)(OWS + WS_ACT), (const bf16*)(OWS + WS_MOEW2), nT * 256, D, DFF / 4, DFF}; pg8::SplitOrder S{nT, D / 256, 4, G, (int)blockIdx.x, MOE_MAIN_PANELS, pbp[1], pbp[2], pbp[3], pbp[4], pbp[5], pbp[6], pbp[7], (size_t)D * DFF};
                      pg8::EpiPart E{(float*)(OWS + WS_FP), D, (size_t)MOE_TAIL_ROWS * D, MOE_MAIN_PANELS}; pg8::gemm_phase<pg8::EpiPart, pg8::SplitOrder, true, true>(lds, g, S, E); }
                }
                SEAM();
            }
        }
        if (RUN()) { FRESH(); ph_ln(p, lds, l, 1, tid, wave, gw, NGW, lane); }
        SEAM();
    }
#undef l
#undef RUN
#undef SEAM
}

#ifndef MK_PER_PHASE
#define MK_PER_PHASE 0
#endif
extern "C" void kernel_launch(void* const* d_in, const int* in_sizes, int n_in, void* d_out, int out_size, void* d_ws, size_t ws_size, hipStream_t stream) {
    static int grid = 0;
    if (grid == 0) {
        if (n_in != N_IN || in_sizes[0] != NLAT * D || out_size != NLAT * D || ws_size < WS_NEED) { fprintf(stderr, "kernel_launch: unexpected shapes / workspace (%d inputs, ws %zu, need %zu)\n", n_in, ws_size, (size_t)WS_NEED); grid = -1; return; }
        int dev = 0, cus = 0, per_cu = 0;
        if (hipGetDevice(&dev) != hipSuccess || hipDeviceGetAttribute(&cus, hipDeviceAttributeMultiprocessorCount, dev) != hipSuccess) { grid = -1; return; }
        if (hipFuncSetAttribute((const void*)fwd_kernel, hipFuncAttributeMaxDynamicSharedMemorySize, LDS_BYTES) != hipSuccess) { fprintf(stderr, "kernel_launch: hipFuncSetAttribute failed\n"); grid = -1; return; }
        if (hipOccupancyMaxActiveBlocksPerMultiprocessor(&per_cu, (const void*)fwd_kernel, NWAVES * 64, LDS_BYTES) != hipSuccess || per_cu < 1) fprintf(stderr, "kernel_launch: occupancy query says %d\n", per_cu);
        (void)hipGetLastError();
        grid = cus;
        if (grid != 256) { fprintf(stderr, "kernel_launch: built for a 256-CU device, found %d CUs\n", cus); grid = -1; return; }
    }
    if (grid < 0) return;
    if (hipMemsetAsync((char*)d_ws + WS_CTL, 0, CTL_BYTES, stream) != hipSuccess) return;
    KP p{};
    for (int i = 0; i < N_IN; ++i) p.in[i] = (const float*)d_in[i];
    p.out = (float*)d_out; p.ws = (unsigned char*)d_ws; p.pad = 0;
#if MK_PER_PHASE
    const int nph = 2 + 2 * 11 + 2 * 13;
    for (int ph = 0; ph < nph; ++ph) { p.ph = ph; hipLaunchKernelGGL(fwd_kernel, dim3(grid), dim3(NWAVES * 64), LDS_BYTES, stream, p); }
#else
    p.ph = -1;
    hipLaunchKernelGGL(fwd_kernel, dim3(grid), dim3(NWAVES * 64), LDS_BYTES, stream, p);
#endif
}
```

```cpp
#include <hip/hip_runtime.h>
#define PROBE_DUP 0
#define CQ_SLOT_WGS 0
#define CQ_SLOT_ITEMS 3500
#include <cstdio>
#include <cstdint>
namespace pg8 {
#define PG8_LAS __attribute__((address_space(3)))
typedef unsigned short bf16_t;
typedef short bf16x8 __attribute__((ext_vector_type(8)));
typedef float f32x4 __attribute__((ext_vector_type(4)));
typedef unsigned u32x4 __attribute__((ext_vector_type(4)));
constexpr int BM = 256, BK = 64, HALF = 128, HTB = HALF * BK * 2  , STAGE_BYTES = 8 * HTB, NXCD = 8, WGM = 8;

__host__ __device__ __forceinline__ int lds_byte(int r, int c) { const int st = (r >> 4) * 2 + (c >> 5), rr = r & 15, cc = c & 31, ob = rr * 64 + cc * 2; return st * 1024 + (ob ^ (((ob >> 9) & 1) << 5)); }
__host__ __device__ __forceinline__ void stage_rc(int b, int& R, int& C) { const int st = b / 1024, sb = b % 1024, swz = sb ^ (((sb >> 9) & 1) << 5); R = (st >> 1) * 16 + swz / 64; C = (st & 1) * 32 + (swz % 64) / 2; }
__host__ __device__ __forceinline__ int perm32(int rho) { const int n = rho >> 4, i = rho & 15; return 8 * (i >> 2) + 4 * n + (i & 3); }

struct Unit { int pm, pn, ks; };
struct Gemm { const bf16_t* A; const bf16_t* Bt; int M, N, K, ld; };

struct StaticOrder {
    int nM, nN, nwg, G, c;
    __host__ __device__ void init(int M, int N, int G_, int c_) { nM = M / BM; nN = N / BM; nwg = nM * nN; G = G_; c = c_; }
    __host__ __device__ bool next(int i, Unit& u) const {
        const long L = (long)i * G + c; if (L >= nwg) return false;
        int wgid = (int)L; { const int q = nwg / NXCD, r = nwg % NXCD, xcd = wgid % NXCD, off = wgid / NXCD; wgid = (xcd < r ? xcd * (q + 1) : r * (q + 1) + (xcd - r) * q) + off; }
        const int nig = WGM * nN, gid = wgid / nig, fm = gid * WGM, gsz = (nM - fm) < WGM ? (nM - fm) : WGM;
        u.pm = fm + ((wgid % nig) % gsz); u.pn = (wgid % nig) / gsz; u.ks = 0; return true;
    }
    __device__ __forceinline__ const char* abase(const Gemm& g, const Unit& u, size_t tstep) const { return (const char*)g.A + (size_t)u.pm * tstep; }
    __device__ __forceinline__ const char* bbase(const Gemm& g, const Unit& u, size_t tstep) const { return (const char*)g.Bt + (size_t)u.pn * tstep; }
    __device__ __forceinline__ void a_ready(const Unit&) const {}
    __device__ __forceinline__ void done(const Unit&) const {}
};

__device__ __forceinline__ unsigned cvt_pk_bf16(float lo, float hi) { unsigned r; asm volatile("v_cvt_pk_bf16_f32 %0, %1, %2" : "=v"(r) : "v"(lo), "v"(hi)); return r; }
typedef float f32x2 __attribute__((ext_vector_type(2)));
__device__ __forceinline__ f32x2 gelu_pk(f32x2 v) {
    const f32x2 av = __builtin_elementwise_abs(v), d = av * 0.2316418882f + 1.0f;
    f32x2 t; t.x = __builtin_amdgcn_rcpf(d.x); t.y = __builtin_amdgcn_rcpf(d.y);
    f32x2 q = t * 0.5307027145f + (-0.7265760135f); q = q * t + 0.7107068705f; q = q * t + (-0.142248368f); q = q * t + 0.127414796f; q = q * t;
    const f32x2 s = (v * v) * (-0.72134752044f);
    f32x2 e; e.x = __builtin_amdgcn_exp2f(s.x); e.y = __builtin_amdgcn_exp2f(s.y);
    const f32x2 m = v * (q * e), r = v - m;
    f32x2 o; o.x = v.x < 0.f ? m.x : r.x; o.y = v.y < 0.f ? m.y : r.y; return o;
}

template <int ACT  > struct EpiBf16 {
    static constexpr bool PERM = true, AFTER_DRAIN = false; static_assert(ACT == 0 || ACT == 1, "EpiBf16: ACT is 0 (none) or 1 (gelu_pk)");
    bf16_t* O; int ldc; const float* bias; int split_cols; size_t split_stride; float scale0;
    __device__ __forceinline__ void operator()(const f32x4 (&acc)[2][2][4][2], const Unit& u, int wr, int wc, int fr, int fq) const {
        asm volatile("" : "+v"(fr), "+v"(fq));
        const int row0 = u.pm * BM + wr * 64 + fr; int colt = u.pn * BM; bf16_t* base = O;
        float sc = 1.f; if (split_cols) { const int t = colt / split_cols; base += (size_t)t * split_stride; colt -= t * split_cols; if (t == 0) sc = scale0; }
        const int col0 = colt + wc * 32 + 8 * fq, bcol0 = u.pn * BM + wc * 32 + 8 * fq;
        f32x4 bv[2][2];
#pragma unroll
        for (int bj = 0; bj < 2; ++bj)
#pragma unroll
            for (int n = 0; n < 2; ++n) bv[bj][n] = bias ? *(const f32x4*)(bias + bcol0 + bj * HALF + 4 * n) : (f32x4){0.f, 0.f, 0.f, 0.f};
#pragma unroll
        for (int ai = 0; ai < 2; ++ai)
#pragma unroll
            for (int m = 0; m < 4; ++m) { bf16_t* rowp = base + (size_t)(row0 + ai * HALF + m * 16) * ldc + col0;
#pragma unroll
                for (int bj = 0; bj < 2; ++bj) { f32x4 v0 = acc[ai][bj][m][0] + bv[bj][0], v1 = acc[ai][bj][m][1] + bv[bj][1];
                    if (ACT == 1) { f32x2 a = gelu_pk((f32x2){v0[0], v0[1]}), b = gelu_pk((f32x2){v0[2], v0[3]}), c = gelu_pk((f32x2){v1[0], v1[1]}), d = gelu_pk((f32x2){v1[2], v1[3]});
                        v0 = (f32x4){a.x, a.y, b.x, b.y}; v1 = (f32x4){c.x, c.y, d.x, d.y}; }
                    v0 = v0 * sc; v1 = v1 * sc; u32x4 w; w.x = cvt_pk_bf16(v0[0], v0[1]); w.y = cvt_pk_bf16(v0[2], v0[3]); w.z = cvt_pk_bf16(v1[0], v1[1]); w.w = cvt_pk_bf16(v1[2], v1[3]);
                    *(u32x4*)(rowp + bj * HALF) = w; } }
    }
};
typedef int i32x4 __attribute__((ext_vector_type(4)));
template <bool I8> __device__ __forceinline__ f32x4 mma16(bf16x8 b, bf16x8 a, f32x4 c) { return __builtin_amdgcn_mfma_f32_16x16x32_bf16(b, a, c, 0, 0, 0); }
template <bool I8> __device__ __forceinline__ i32x4 mma16(bf16x8 b, bf16x8 a, i32x4 c) { return __builtin_amdgcn_mfma_i32_16x16x64_i8(__builtin_bit_cast(i32x4, b), __builtin_bit_cast(i32x4, a), c, 0, 0, 0); }
struct EpiF32 {
    static constexpr bool PERM = false, AFTER_DRAIN = false;
    float* C; int ldc; int accum;
    __device__ __forceinline__ void operator()(const f32x4 (&acc)[2][2][4][2], const Unit& u, int wr, int wc, int fr, int fq) const {
        asm volatile("" : "+v"(fr), "+v"(fq));
        const int row0 = u.pm * BM + wr * 64 + fr, col0 = u.pn * BM + wc * 32 + 4 * fq;
#pragma unroll
        for (int ai = 0; ai < 2; ++ai)
#pragma unroll
            for (int m = 0; m < 4; ++m) { float* rowp = C + (size_t)(row0 + ai * HALF + m * 16) * ldc + col0;
#pragma unroll
                for (int bj = 0; bj < 2; ++bj)
#pragma unroll
                    for (int n = 0; n < 2; ++n) { f32x4 v = acc[ai][bj][m][n]; if (accum) v += *(const f32x4*)(rowp + bj * HALF + n * 16); *(f32x4*)(rowp + bj * HALF + n * 16) = v; } }
    }
};
struct EpiSwiGLU {
    static constexpr bool PERM = true, AFTER_DRAIN = false;
    bf16_t* O; int ldo; const float* rowscale; int rs_stride;
    __device__ __forceinline__ void operator()(const f32x4 (&acc)[2][2][4][2], const Unit& u, int wr, int wc, int fr, int fq) const {
        asm volatile("" : "+v"(fr), "+v"(fq));
        typedef unsigned u32x2v __attribute__((ext_vector_type(2)));
        const int row0 = u.pm * BM + wr * 64 + fr; const int ch0 = (u.pn * BM + wc * 32 + 8 * fq) >> 1;
#pragma unroll
        for (int ai = 0; ai < 2; ++ai)
#pragma unroll
            for (int m = 0; m < 4; ++m) { const int row = row0 + ai * HALF + m * 16; bf16_t* rowp = O + (size_t)row * ldo + ch0;
                const float rs = rowscale ? rowscale[(size_t)row * rs_stride] : 1.f;
#pragma unroll
                for (int bj = 0; bj < 2; ++bj) { const f32x4 a = acc[ai][bj][m][0], b = acc[ai][bj][m][1]; f32x4 o;
#pragma unroll
                    for (int i = 0; i < 4; ++i) o[i] = a[i] * __builtin_amdgcn_rcpf(1.f + __expf(-a[i])) * b[i] * rs;
                    u32x2v w; w.x = cvt_pk_bf16(o[0], o[1]); w.y = cvt_pk_bf16(o[2], o[3]);
                    *(u32x2v*)(rowp + bj * (HALF / 2)) = w; } }
    }
};

struct MoeOrder : StaticOrder {
    int pb1, pb2, pb3, pb4, pb5, pb6, pb7; size_t estride;
    __device__ __forceinline__ const char* bbase(const Gemm& g, const Unit& u, size_t tstep) const {
        const int e = (u.pm >= pb1) + (u.pm >= pb2) + (u.pm >= pb3) + (u.pm >= pb4) + (u.pm >= pb5) + (u.pm >= pb6) + (u.pm >= pb7);
        return (const char*)(g.Bt + (size_t)e * estride) + (size_t)u.pn * tstep; }
};
struct SplitOrder {
    int nM, nN, S, G, c, pm0; int pb1, pb2, pb3, pb4, pb5, pb6, pb7; size_t estride;
    __device__ __forceinline__ bool next(int i, Unit& u) const { const int L = i * G + c; if (L >= nM * nN * S) return false; u.ks = L % S; const int t = L / S; u.pn = t % nN; u.pm = pm0 + t / nN; return true; }
    __device__ __forceinline__ const char* abase(const Gemm& g, const Unit& u, size_t tstep) const { return (const char*)g.A + (size_t)u.pm * tstep + (size_t)u.ks * g.K * 2; }
    __device__ __forceinline__ const char* bbase(const Gemm& g, const Unit& u, size_t tstep) const {
        const int e = estride ? (u.pm >= pb1) + (u.pm >= pb2) + (u.pm >= pb3) + (u.pm >= pb4) + (u.pm >= pb5) + (u.pm >= pb6) + (u.pm >= pb7) : 0;
        return (const char*)(g.Bt + (size_t)e * estride) + (size_t)u.pn * tstep + (size_t)u.ks * g.K * 2; }
    __device__ __forceinline__ void a_ready(const Unit&) const {}
    __device__ __forceinline__ void done(const Unit&) const {}
};
struct EpiPart {
    static constexpr bool PERM = false, AFTER_DRAIN = false;
    float* C; int ldc; size_t pstride; int pm0;
    __device__ __forceinline__ void operator()(const f32x4 (&acc)[2][2][4][2], const Unit& u, int wr, int wc, int fr, int fq) const {
        asm volatile("" : "+v"(fr), "+v"(fq));
        const int row0 = (u.pm - pm0) * BM + wr * 64 + fr, col0 = u.pn * BM + wc * 32 + 4 * fq; float* base = C + (size_t)u.ks * pstride;
#pragma unroll
        for (int ai = 0; ai < 2; ++ai)
#pragma unroll
            for (int m = 0; m < 4; ++m) { float* rowp = base + (size_t)(row0 + ai * HALF + m * 16) * ldc + col0;
#pragma unroll
                for (int bj = 0; bj < 2; ++bj)
#pragma unroll
                    for (int n = 0; n < 2; ++n) *(f32x4*)(rowp + bj * HALF + n * 16) = acc[ai][bj][m][n]; }
    }
};

struct EpiSwiGLU8 {
    static constexpr bool PERM = true, AFTER_DRAIN = false;
    bf16_t* O; int ldo; const float* rowscale; const float* sa; const unsigned* amax; int pb1, pb2, pb3, pb4, pb5, pb6, pb7;
    __device__ __forceinline__ void operator()(const i32x4 (&acc)[2][2][4][2], const Unit& u, int wr, int wc, int fr, int fq) const {
        typedef unsigned u32x2v __attribute__((ext_vector_type(2))); typedef unsigned u32x4v __attribute__((ext_vector_type(4)));
        asm volatile("" : "+v"(fr), "+v"(fq));
        const int row0 = u.pm * BM + wr * 64 + fr; const int cb0 = u.pn * BM + wc * 32 + 8 * fq; const int ch0 = cb0 >> 1;
        const int e = (u.pm >= pb1) + (u.pm >= pb2) + (u.pm >= pb3) + (u.pm >= pb4) + (u.pm >= pb5) + (u.pm >= pb6) + (u.pm >= pb7);
        const unsigned* am = amax + (size_t)e * 2 * 3584 + cb0;
#pragma unroll
        for (int bj = 0; bj < 2; ++bj) {
            const float* amf = (const float*)am + bj * HALF;
            const f32x4 sb0 = *(const f32x4*)amf * (1.f / 127.f), sb1 = *(const f32x4*)(amf + 4) * (1.f / 127.f);
#pragma unroll
            for (int ai = 0; ai < 2; ++ai)
#pragma unroll
                for (int m = 0; m < 4; ++m) { const int row = row0 + ai * HALF + m * 16; bf16_t* rowp = O + (size_t)row * ldo + ch0 + bj * (HALF / 2);
                    const float sr = sa[row], rs = rowscale ? rowscale[row] : 1.f; f32x4 o;
#pragma unroll
                    for (int i = 0; i < 4; ++i) { const float a = (float)acc[ai][bj][m][0][i] * sr * sb0[i], b = (float)acc[ai][bj][m][1][i] * sr * sb1[i];
                        o[i] = a * __builtin_amdgcn_rcpf(1.f + __expf(-a)) * b * rs; }
                    u32x2v w; w.x = cvt_pk_bf16(o[0], o[1]); w.y = cvt_pk_bf16(o[2], o[3]);
                    *(u32x2v*)rowp = w;
#if PROBE_DUP & 128
                    if (dbg && row < 4096) { f32x4 av, bv;
#pragma unroll
                        for (int i = 0; i < 4; ++i) { av[i] = (float)acc[ai][bj][m][0][i] * sr * sb0[i]; bv[i] = (float)acc[ai][bj][m][1][i] * sr * sb1[i]; }
                        *(f32x4*)((float*)dbg + (size_t)row * ldo + (rowp - (O + (size_t)row * ldo))) = av; *(f32x4*)((float*)dbg + (size_t)4096 * ldo + (size_t)row * ldo + (rowp - (O + (size_t)row * ldo))) = bv; }
#endif
                    } }
    }
#if PROBE_DUP & 128
    int* dbg = nullptr;
#endif
};

struct EpiBf16S8 {
    static constexpr bool PERM = true, AFTER_DRAIN = false;
    bf16_t* O; int ldc; const float* sa; const float* amax;
    __device__ __forceinline__ void operator()(const i32x4 (&acc)[2][2][4][2], const Unit& u, int wr, int wc, int fr, int fq) const {
        asm volatile("" : "+v"(fr), "+v"(fq));
        const int row0 = u.pm * BM + wr * 64 + fr, col0 = u.pn * BM + wc * 32 + 8 * fq;
#pragma unroll
        for (int bj = 0; bj < 2; ++bj) { const f32x4 s0 = *(const f32x4*)(amax + col0 + bj * HALF) * (1.f / 127.f), s1 = *(const f32x4*)(amax + col0 + bj * HALF + 4) * (1.f / 127.f);
#pragma unroll
            for (int ai = 0; ai < 2; ++ai)
#pragma unroll
                for (int m = 0; m < 4; ++m) { const int row = row0 + ai * HALF + m * 16; const float sr = sa[row]; f32x4 v0, v1;
#pragma unroll
                    for (int i = 0; i < 4; ++i) { v0[i] = (float)acc[ai][bj][m][0][i] * sr * s0[i]; v1[i] = (float)acc[ai][bj][m][1][i] * sr * s1[i]; }
                    u32x4 w; w.x = cvt_pk_bf16(v0[0], v0[1]); w.y = cvt_pk_bf16(v0[2], v0[3]); w.z = cvt_pk_bf16(v1[0], v1[1]); w.w = cvt_pk_bf16(v1[2], v1[3]);
                    *(u32x4*)(O + (size_t)row * ldc + col0 + bj * HALF) = w; } }
    }
};
struct EpiPartS8 {
    static constexpr bool PERM = false, AFTER_DRAIN = false;
    float* C; int ldc; size_t pstride; int pm0; const float* sa; const float* amax;
    __device__ __forceinline__ void operator()(const i32x4 (&acc)[2][2][4][2], const Unit& u, int wr, int wc, int fr, int fq) const {
        asm volatile("" : "+v"(fr), "+v"(fq));
        const int row0 = (u.pm - pm0) * BM + wr * 64 + fr, col0 = u.pn * BM + wc * 32 + 4 * fq; float* base = C + (size_t)u.ks * pstride;
#pragma unroll
        for (int bj = 0; bj < 2; ++bj)
#pragma unroll
            for (int n = 0; n < 2; ++n) { const f32x4 sc = *(const f32x4*)(amax + col0 + bj * HALF + n * 16) * (1.f / 127.f);
#pragma unroll
                for (int ai = 0; ai < 2; ++ai)
#pragma unroll
                    for (int m = 0; m < 4; ++m) { const int rl = row0 + ai * HALF + m * 16; const float sr = sa[rl + pm0 * BM]; f32x4 v;
#pragma unroll
                        for (int i = 0; i < 4; ++i) v[i] = (float)acc[ai][bj][m][n][i] * sr * sc[i];
                        *(f32x4*)(base + (size_t)rl * ldc + col0 + bj * HALF + n * 16) = v; } }
    }
};
template <bool I8> struct AccSel { typedef f32x4 type; }; template <> struct AccSel<true> { typedef i32x4 type; };
template <class Epi, class Sched, bool ALIGN_EPI = false, bool SP2 = false, bool I8 = false>
__device__ __forceinline__ void gemm_phase(PG8_LAS unsigned char* lds, const Gemm g, const Sched& S, const Epi& E) {
    int tid_o = threadIdx.x; asm volatile("" : "+v"(tid_o));
    const int tid = tid_o, wid = __builtin_amdgcn_readfirstlane(tid >> 6), lane = tid & 63, wr = wid >> 2, wc = wid & 3, fr = lane & 15, fq = lane >> 4;
    const int K = g.K, nt = K / BK;
    unsigned voffA[2], voffB[2];
#pragma unroll
    for (int i = 0; i < 2; ++i) { int R, C; stage_rc(tid * 16 + i * 8192, R, C); const int Rb = Epi::PERM ? ((R & ~31) + perm32(R & 31)) : R;
        voffA[i] = (unsigned)(R * g.ld + C) * 2u; voffB[i] = (unsigned)(Rb * g.ld + C) * 2u; }
    const size_t kstep = (size_t)(BK * 2);
    const size_t hstep = (size_t)HALF * g.ld * 2;
    const size_t tstep = 2 * hstep;
    const unsigned ldsw = (unsigned)wid * 1024u;
    const int aoff = lds_byte(wr * 64 + fr, fq * 8), boff = lds_byte(wc * 32 + fr, fq * 8);
#define PG8_SA(b, h) (((b) * 2 + (h)) * HTB)
#define PG8_SB(b, h) ((4 + (b) * 2 + (h)) * HTB)
#define PG8_STAGE(bufoff, gbase, voff) do { _Pragma("unroll") for (int _i = 0; _i < 2; ++_i) \
        __builtin_amdgcn_global_load_lds((const unsigned*)((const char*)(gbase) + (voff)[_i]), (PG8_LAS unsigned*)(lds + (bufoff) + ldsw + _i * 8192), 16, 0, 0); } while (0)
#define PG8_LDA(dst, b, h) do { _Pragma("unroll") for (int m = 0; m < 4; ++m) _Pragma("unroll") for (int k = 0; k < 2; ++k) dst[m][k] = *(const PG8_LAS bf16x8*)(lds + PG8_SA(b, h) + aoff + m * 2048 + k * 1024); } while (0)
#define PG8_LDB(dst, b, h) do { _Pragma("unroll") for (int n = 0; n < 2; ++n) _Pragma("unroll") for (int k = 0; k < 2; ++k) dst[n][k] = *(const PG8_LAS bf16x8*)(lds + PG8_SB(b, h) + boff + n * 2048 + k * 1024); } while (0)
#define PG8_MMA(ai, bj, At, Bt) do { __builtin_amdgcn_s_setprio(1); _Pragma("unroll") for (int k = 0; k < 2; ++k) _Pragma("unroll") for (int m = 0; m < 4; ++m) _Pragma("unroll") for (int n = 0; n < 2; ++n) \
        acc[ai][bj][m][n] = mma16<I8>(Bt[n][k], At[m][k], acc[ai][bj][m][n]); __builtin_amdgcn_s_setprio(0); } while (0)
#define PG8_WAIT_V(n) asm volatile("s_waitcnt vmcnt(" #n ")" ::: "memory")
#define PG8_WAIT_L(n) asm volatile("s_waitcnt lgkmcnt(" #n ")" ::: "memory")
#define PG8_BAR __builtin_amdgcn_s_barrier()
#define PG8_SCHED __builtin_amdgcn_sched_barrier(0)
    Unit cur, nxt; int ui = 0;
    if (!S.next(0, cur)) return;
    typedef typename AccSel<I8>::type AccT; AccT acc[2][2][4][2];
#pragma unroll
    for (int a = 0; a < 2; ++a)
#pragma unroll
        for (int b = 0; b < 2; ++b)
#pragma unroll
            for (int m = 0; m < 4; ++m)
#pragma unroll
                for (int n = 0; n < 2; ++n) acc[a][b][m][n] = (AccT)(0);
    bf16x8 At[4][2], B0[2][2], B1[2][2];
    const char* cA = S.abase(g, cur, tstep); const char* cB = S.bbase(g, cur, tstep);
    S.a_ready(cur);
    if constexpr (SP2) {
        PG8_STAGE(PG8_SB(0, 0), cB, voffB); PG8_STAGE(PG8_SB(0, 1), cB + hstep, voffB); PG8_STAGE(PG8_SA(0, 0), cA, voffA); PG8_STAGE(PG8_SA(0, 1), cA + hstep, voffA);
        if (wr == 1) PG8_BAR;
        PG8_WAIT_V(2); PG8_BAR;
        PG8_STAGE(PG8_SB(1, 0), cB + kstep, voffB); PG8_STAGE(PG8_SA(1, 0), cA + kstep, voffA); PG8_STAGE(PG8_SB(1, 1), cB + hstep + kstep, voffB);
        PG8_WAIT_V(6); PG8_BAR;
    } else {
        PG8_STAGE(PG8_SB(0, 0), cB, voffB); PG8_STAGE(PG8_SA(0, 0), cA, voffA); PG8_STAGE(PG8_SB(0, 1), cB + hstep, voffB); PG8_STAGE(PG8_SA(0, 1), cA + hstep, voffA);
        if (wr == 1) PG8_BAR;
        PG8_WAIT_V(4); PG8_BAR;
        PG8_STAGE(PG8_SB(1, 0), cB + kstep, voffB); PG8_STAGE(PG8_SA(1, 0), cA + kstep, voffA); PG8_STAGE(PG8_SB(1, 1), cB + hstep + kstep, voffB);
        PG8_WAIT_V(6); PG8_BAR;
    }
    for (;;) {
        const bool has_next = S.next(ui + 1, nxt);
        const char* nA = has_next ? S.abase(g, nxt, tstep) : cA; const char* nB = has_next ? S.bbase(g, nxt, tstep) : cB;
        for (int t = 0; t < nt; t += 2) {
            const bool last = (t == nt - 2);
            const char* a1 = cA + (size_t)(t + 1) * kstep;
            const char* a2 = last ? nA : cA + (size_t)(t + 2) * kstep; const char* b2 = last ? nB : cB + (size_t)(t + 2) * kstep;
            const char* a3 = a2 + kstep; const char* b3 = b2 + kstep;
            if (last && has_next) S.a_ready(nxt);
            if constexpr (SP2) {
            PG8_LDB(B0, 0, 0); PG8_LDB(B1, 0, 1); PG8_SCHED; PG8_LDA(At, 0, 0); PG8_STAGE(PG8_SA(1, 1), a1 + hstep, voffA);
            PG8_WAIT_V(8); PG8_WAIT_L(0); PG8_BAR; PG8_MMA(0, 0, At, B0); PG8_MMA(0, 1, At, B1); PG8_BAR; PG8_SCHED;
            PG8_LDA(At, 0, 1); PG8_STAGE(PG8_SB(0, 0), b2, voffB); PG8_STAGE(PG8_SB(0, 1), b2 + hstep, voffB); PG8_STAGE(PG8_SA(0, 0), a2, voffA);
            PG8_WAIT_V(8); PG8_WAIT_L(0); PG8_BAR; PG8_MMA(1, 0, At, B0); PG8_MMA(1, 1, At, B1); PG8_BAR; PG8_SCHED;
            PG8_LDB(B0, 1, 0); PG8_LDB(B1, 1, 1); PG8_SCHED; PG8_LDA(At, 1, 0); PG8_STAGE(PG8_SA(0, 1), a2 + hstep, voffA);
            PG8_WAIT_V(8); PG8_WAIT_L(0); PG8_BAR; PG8_MMA(0, 0, At, B0); PG8_MMA(0, 1, At, B1); PG8_BAR; PG8_SCHED;
            PG8_LDA(At, 1, 1); PG8_STAGE(PG8_SB(1, 0), b3, voffB); PG8_STAGE(PG8_SB(1, 1), b3 + hstep, voffB); PG8_STAGE(PG8_SA(1, 0), a3, voffA);
            PG8_WAIT_V(8); PG8_WAIT_L(0); PG8_BAR; PG8_MMA(1, 0, At, B0); PG8_MMA(1, 1, At, B1); PG8_BAR; PG8_SCHED;
            } else {
            PG8_LDB(B0, 0, 0); PG8_SCHED; PG8_LDA(At, 0, 0); PG8_STAGE(PG8_SA(1, 1), a1 + hstep, voffA);
            PG8_WAIT_L(8); PG8_BAR; PG8_WAIT_L(0); PG8_MMA(0, 0, At, B0); PG8_BAR; PG8_SCHED;
            PG8_LDB(B1, 0, 1); PG8_STAGE(PG8_SB(0, 0), b2, voffB);
            PG8_BAR; PG8_WAIT_L(0); PG8_MMA(0, 1, At, B1); PG8_BAR;
            PG8_LDA(At, 0, 1); PG8_STAGE(PG8_SA(0, 0), a2, voffA);
            PG8_BAR; PG8_WAIT_L(0); PG8_MMA(1, 0, At, B0); PG8_BAR; PG8_SCHED;
            PG8_STAGE(PG8_SB(0, 1), b2 + hstep, voffB);
            PG8_WAIT_V(6); PG8_BAR; PG8_MMA(1, 1, At, B1); PG8_BAR;
            PG8_LDB(B0, 1, 0); PG8_SCHED; PG8_LDA(At, 1, 0); PG8_STAGE(PG8_SA(0, 1), a2 + hstep, voffA);
            PG8_WAIT_L(8); PG8_BAR; PG8_WAIT_L(0); PG8_MMA(0, 0, At, B0); PG8_BAR; PG8_SCHED;
            PG8_LDB(B1, 1, 1); PG8_STAGE(PG8_SB(1, 0), b3, voffB);
            PG8_BAR; PG8_WAIT_L(0); PG8_MMA(0, 1, At, B1); PG8_BAR;
            PG8_LDA(At, 1, 1); PG8_STAGE(PG8_SA(1, 0), a3, voffA);
            PG8_BAR; PG8_WAIT_L(0); PG8_MMA(1, 0, At, B0); PG8_BAR; PG8_SCHED;
            PG8_STAGE(PG8_SB(1, 1), b3 + hstep, voffB);
            PG8_WAIT_V(6); PG8_BAR; PG8_MMA(1, 1, At, B1); PG8_BAR;
            }
        }
        if constexpr (ALIGN_EPI) { if (wr == 0) PG8_BAR; }
        if constexpr (!Epi::AFTER_DRAIN) { E(acc, cur, wr, wc, fr, fq); S.done(cur); }
        if (!has_next) break;
#pragma unroll
        for (int a = 0; a < 2; ++a)
#pragma unroll
            for (int b = 0; b < 2; ++b)
#pragma unroll
                for (int m = 0; m < 4; ++m)
#pragma unroll
                    for (int n = 0; n < 2; ++n) acc[a][b][m][n] = (AccT)(0);
        cur = nxt; cA = nA; cB = nB; ++ui;
        if constexpr (ALIGN_EPI) { if (wr == 1) PG8_BAR; }
    }
    PG8_WAIT_V(0);
    if constexpr (!ALIGN_EPI) { if (wr == 0) PG8_BAR; }
    PG8_BAR;
    if constexpr (Epi::AFTER_DRAIN) { E.fused(acc, cur, wr, wc, fr, fq, lds, wid, lane); S.done(cur); }
#undef PG8_SA
#undef PG8_SB
#undef PG8_STAGE
#undef PG8_LDA
#undef PG8_LDB
#undef PG8_MMA
#undef PG8_WAIT_V
#undef PG8_WAIT_L
#undef PG8_BAR
#undef PG8_SCHED
}
}

constexpr int NWAVES = 8;
constexpr int D = 1024, NB = 4, SEQ = 4096, CTXL = 256, NLAT = NB * SEQ, NCTX = NB * CTXL, MROWS = NLAT + NCTX;
constexpr int DEPTH = 4, RW = 512, NH = 8, HS = 64, DFF = 3584, NE = 8, NPROJ = 3456, NP = 3584, NLO = 2560, KLA = 512, NMOD = 6144;
constexpr int PC_R = 0, PC_K = 512, PC_V = 1024, PC_CB = 1536, PC_CC = 2048, PC_CH = 2560, PC_WD = 3072, PC_AD = 3200, PC_GD = 3328;
constexpr float LN_EPS = 1e-5f, GN_EPS = 64e-5f, DN_ALPHA = 1.681792830507429f;
enum { I_X = 0, I_C, I_CTX, I_CCTX, I_WMOD, I_BMOD, I_WIN, I_W0, I_W2, I_A0, I_A2, I_KK, I_KA, I_RK, I_G2, I_LNXG, I_LNXB, I_CONVW, I_WOUT, I_LN1G, I_LN1B, I_LN2G, I_LN2B,
       I_FW1, I_FW3, I_FW2, I_RTW, I_RTB, I_MW1, I_MW3, I_MW2, N_IN };

constexpr size_t MiB = 1u << 20;
constexpr size_t WS_CTL = 0, CTL_BYTES = 3 * MiB;
constexpr size_t WS_MODV = 1 * MiB;
constexpr size_t WS_AMAX = 2 * MiB;
constexpr size_t WS_RKS = 3 * MiB;
constexpr size_t WS_WIN = 4 * MiB;
constexpr size_t WS_WOUT = WS_WIN + 28 * MiB;
constexpr size_t WS_LORA = WS_WOUT + 8 * MiB;
constexpr size_t WS_F13 = WS_LORA + 10 * MiB;
constexpr size_t WS_F2 = WS_F13 + 28 * MiB;
constexpr size_t WS_X = WS_F2 + 14 * MiB;
constexpr size_t WS_H = WS_X + 68 * MiB;
constexpr size_t WS_MOES = WS_H + 34 * MiB;
constexpr size_t WS_ROWLIST = WS_MOES;
constexpr size_t WS_TOKSEL = WS_MOES + 640 * 1024;
constexpr size_t WS_WSEL = WS_TOKSEL + 320 * 1024;
constexpr size_t WS_WSORT = WS_WSEL + 192 * 1024;
constexpr size_t WS_MOEW13 = WS_MOES + 2 * MiB;
constexpr size_t WS_MOEW2 = WS_MOEW13 + 112 * MiB;
constexpr size_t WS_H8 = WS_MOEW13 + 56 * MiB;
constexpr size_t WS_SA = WS_H8 + 17 * MiB;
constexpr size_t WS_SAM = WS_SA + 512 * 1024;
constexpr size_t WS_SAG = WS_SA + 1 * MiB;
constexpr size_t WS_SCR = WS_MOEW2 + 56 * MiB;
constexpr size_t WS_P = WS_SCR;
constexpr size_t WS_LO = WS_P + 119 * MiB;
constexpr size_t WS_PREP = WS_LO + 170 * MiB;
constexpr size_t WS_Y = WS_PREP + 213 * MiB;
constexpr size_t WS_MIXIN = WS_Y + 68 * MiB;
constexpr size_t WS_CH = WS_PREP;
constexpr size_t WS_MIXO = WS_PREP;
constexpr size_t WS_MIXP = WS_PREP + 34 * MiB;
constexpr size_t WS_END_MIXER = WS_MIXIN + 34 * MiB;
constexpr size_t WS_HG = WS_SCR;
constexpr size_t WS_ACT = WS_HG + 72 * MiB;
constexpr size_t WS_F = WS_ACT + 252 * MiB;
constexpr size_t WS_FP = WS_F + 72 * MiB;
constexpr size_t WS_END_FFN = WS_FP + 64 * MiB;
constexpr size_t WS_NEED = WS_END_MIXER > WS_END_FFN ? WS_END_MIXER : WS_END_FFN;
static_assert((size_t)MROWS * NP * 2 <= 119 * MiB && (size_t)MROWS * NLO * 4 <= 170 * MiB && (size_t)8704 * 25600 <= 213 * MiB && (size_t)MROWS * D * 4 <= 68 * MiB && WS_NEED <= 990 * MiB, "ws map");
constexpr int MOE_MAIN_PANELS = 128, MOE_TAIL_ROWS = 4096;
constexpr int MOE_ROWS = 36864;
constexpr int AM_IN = 18 * 2 * DFF, AM_OUT = AM_IN + DEPTH * NP;
constexpr int LORAW_PER_LAYER = 4 * 512 * 64 + 512 * 128;
constexpr int CW_BAR = 4096, CW_GCNT = 8192, CW_CQ = 12288, CW_SDONE = 12544;

constexpr int RING_BYTES = 131072, LDSCTL_OFF = RING_BYTES, MISC_OFF = LDSCTL_OFF + 320, LDS_BYTES = 147456;

typedef unsigned short bf16;
typedef unsigned v4u __attribute__((ext_vector_type(4)));
typedef unsigned v2u __attribute__((ext_vector_type(2)));
typedef float f32x4 __attribute__((ext_vector_type(4)));
#define LAS __attribute__((address_space(3)))
#define LDS_WAIT() asm volatile("s_waitcnt lgkmcnt(0)" ::: "memory")
__device__ __forceinline__ unsigned f2bf(float f) { unsigned u = __builtin_bit_cast(unsigned, f); return (u + 0x7fffu + ((u >> 16) & 1u)) >> 16; }
__device__ __forceinline__ unsigned pk2(float lo, float hi) { return f2bf(lo) | (f2bf(hi) << 16); }
__device__ __forceinline__ float bf2f(unsigned short b) { return __builtin_bit_cast(float, ((unsigned)b) << 16); }
__device__ __forceinline__ float bflo(unsigned w) { return __builtin_bit_cast(float, w << 16); }
__device__ __forceinline__ float bfhi(unsigned w) { return __builtin_bit_cast(float, w & 0xffff0000u); }
__device__ __forceinline__ float wave_sum(float v) {
#pragma unroll
    for (int o = 1; o < 64; o <<= 1) v += __shfl_xor(v, o);
    return v;
}
__device__ __forceinline__ float sigm(float x) { return 1.f / (1.f + __expf(-x)); }

#define XB_TMO      128
#define XB_XCNT(j)  (256  + 64 * (j))
#define XB_XSUB(j)  (1280 + 64 * (j))
#define XB_XGEN(j)  (2304 + 64 * (j))
#define XB_TOP      3328
#define XB_TOPGEN   3392
#define XCD_BAR_WORDS 3456
#define XB_SPIN_CAP (1u << 18)

__device__ __forceinline__ unsigned xb_ld(unsigned* p)              { return __hip_atomic_load(p, __ATOMIC_RELAXED, __HIP_MEMORY_SCOPE_AGENT); }
__device__ __forceinline__ unsigned xb_add(unsigned* p, unsigned v) { return __hip_atomic_fetch_add(p, v, __ATOMIC_RELAXED, __HIP_MEMORY_SCOPE_AGENT); }
__device__ __forceinline__ unsigned xb_xcc_id() { return (unsigned)__builtin_amdgcn_s_getreg((3 << 11) | 20) & 0xFu; }
#define XB_SPIN(cond, bar) do { unsigned _sp = 0; while (cond) { __builtin_amdgcn_s_sleep(1); \
    if ((++_sp & 255u) == 0u) { if (xb_ld(&(bar)[XB_TMO])) break; if (_sp > XB_SPIN_CAP) { atomicAdd(&(bar)[XB_TMO], 1u); break; } } } } while (0)

struct XcdBarrier {
    unsigned* bar; unsigned x;
    volatile LAS unsigned* st;
};

__device__ __forceinline__ XcdBarrier xcd_barrier_post(unsigned* bar, volatile LAS unsigned* st) {
    XcdBarrier b; b.bar = bar; b.x = xb_xcc_id(); b.st = st;
    if (threadIdx.x == 0) (void)xb_add(&bar[XB_XCNT(b.x)], 1u);
    return b;
}
__device__ __forceinline__ void xcd_barrier_complete(unsigned* bar, unsigned x, unsigned& nloc, unsigned& nx) {
    const unsigned G = gridDim.x * gridDim.y * gridDim.z;
    unsigned sum, cnt, mine, sp = 0u;
    for (;;) {
        sum = 0u; cnt = 0u; mine = 0u;
#pragma unroll
        for (unsigned j = 0; j < 16; ++j) { const unsigned c = xb_ld(&bar[XB_XCNT(j)]); sum += c; cnt += (c > 0u) ? 1u : 0u; mine = (j == x) ? c : mine; }
        if (sum == G) break;
        __builtin_amdgcn_s_sleep(1);
        if ((++sp & 255u) == 0u) { if (xb_ld(&bar[XB_TMO])) break; if (sp > XB_SPIN_CAP) { atomicAdd(&bar[XB_TMO], 1u); break; } }
    }
    nloc = mine > 0u ? mine : 1u; nx = cnt > 0u ? cnt : 1u;
}

__device__ __forceinline__ void xcd_barrier(const XcdBarrier& b) {
    asm volatile("s_waitcnt vmcnt(0)" ::: "memory");
    __syncthreads();
    if (threadIdx.x == 0) {
        unsigned* bar = b.bar;
        __builtin_amdgcn_s_waitcnt(0);
        unsigned nloc = b.st[0], nx = b.st[1];
        if (nloc == 0u) { xcd_barrier_complete(bar, b.x, nloc, nx); b.st[0] = nloc; b.st[1] = nx; }
        const unsigned old = xb_add(&bar[XB_XSUB(b.x)], 1u);
        const unsigned gen = old / nloc;
        if (old + 1u == (gen + 1u) * nloc) {
            __builtin_amdgcn_fence(__ATOMIC_RELEASE, "agent");
            asm volatile("s_waitcnt vmcnt(0)" ::: "memory");
            const unsigned og = xb_add(&bar[XB_TOP], 1u);
            const unsigned tg = og / nx;
            if (og + 1u == (tg + 1u) * nx) xb_add(&bar[XB_TOPGEN], 1u);
            else XB_SPIN(xb_ld(&bar[XB_TOPGEN]) == tg, bar);
            __builtin_amdgcn_fence(__ATOMIC_ACQUIRE, "agent");
            xb_add(&bar[XB_XGEN(b.x)], 1u);
            asm volatile("s_waitcnt vmcnt(0)" ::: "memory");
        } else {
            XB_SPIN(xb_ld(&bar[XB_XGEN(b.x)]) == gen, bar);
            __builtin_amdgcn_fence(__ATOMIC_ACQUIRE, "agent");
            asm volatile("s_waitcnt vmcnt(0)" ::: "memory");
        }
    }
    __syncthreads();
}


__device__ __forceinline__ size_t opaque_zero() { size_t z = 0; asm volatile("" : "+s"(z)); return z; }
#define OWS (p.ws + opaque_zero())
__device__ __forceinline__ int opaque_zero_i() { int z = 0; asm volatile("" : "+s"(z)); return z; }
#define PIN(i) (p.in[(i) + opaque_zero_i()])
struct KP { const float* in[N_IN]; float* out; unsigned char* ws; int ph; int pad; };

template <int MODE> __device__ __forceinline__ int rowmap(int n, int arg) {
    if (MODE == 0) return n + arg;
    if (MODE == 1) { if (n < 1536) return n; if (n < 1664) return n - 1536 + PC_WD; if (n < 1792) return n - 1664 + PC_AD; if (n < 1920) return n - 1792 + PC_GD;
                     if (n < 2432) return n - 1920 + PC_CB; if (n < 2944) return n - 2432 + PC_CC; return n - 2944 + PC_CH; }
    return 8 * (n >> 2) + 4 * arg + (n & 3);
}
template <int MODE> __device__ __forceinline__ void transpose_item(const float* W, int K, int N, bf16* WT, int arg, LAS float* scr, int item, int lane) {
    const int nblk = N / 32, kb = item / nblk, nb = item % nblk, k0 = 64 * kb, n0 = 32 * nb;
#pragma unroll 8
    for (int i = 0; i < 32; ++i) { const int kk = 2 * i + (lane >> 5); scr[kk * 33 + (lane & 31)] = W[(size_t)(k0 + kk) * N + n0 + (lane & 31)]; }
    LDS_WAIT(); asm volatile("" ::: "memory");
    const int c = lane & 7;
#pragma unroll
    for (int j = 0; j < 4; ++j) { const int n = (lane >> 3) + 8 * j; const LAS float* s = scr + (8 * c) * 33 + n;
        v4u o; o.x = pk2(s[0 * 33], s[1 * 33]); o.y = pk2(s[2 * 33], s[3 * 33]); o.z = pk2(s[4 * 33], s[5 * 33]); o.w = pk2(s[6 * 33], s[7 * 33]);
        *(v4u*)(WT + (size_t)rowmap<MODE>(n0 + n, arg) * K + k0 + 8 * c) = o; }
    LDS_WAIT(); asm volatile("" ::: "memory");
}

__device__ __forceinline__ void ph_modvec(const KP& p, LAS unsigned char* lds, int tid) {
    LAS float* sil = (LAS float*)lds;
    LAS float* red = (LAS float*)(lds + 5 * 1024 * 4);
    const float* c = PIN(I_C); const float* cc = PIN(I_CCTX);
    for (int i = tid; i < 5 * 1024; i += 512) { const float v = i < 4096 ? c[i] : cc[i - 4096]; sil[i] = v / (1.f + __expf(-v)); }
    __syncthreads();
    float* modv = (float*)(OWS + WS_MODV);
    const int ks = tid >> 6, col = tid & 63;
    for (int task = blockIdx.x; task < DEPTH * 96; task += gridDim.x) {
        const int l = task / 96, j0 = (task % 96) * 64;
        const float* w = PIN(I_WMOD) + (size_t)l * D * NMOD + (size_t)(ks * 128) * NMOD + j0 + col;
        float a0 = 0.f, a1 = 0.f, a2 = 0.f, a3 = 0.f, a4 = 0.f;
#pragma unroll 8
        for (int k = 0; k < 128; ++k) { const float wv = w[(size_t)k * NMOD]; const int kk = ks * 128 + k;
            a0 += sil[kk] * wv; a1 += sil[1024 + kk] * wv; a2 += sil[2048 + kk] * wv; a3 += sil[3072 + kk] * wv; a4 += sil[4096 + kk] * wv; }
        red[(ks * 5 + 0) * 64 + col] = a0; red[(ks * 5 + 1) * 64 + col] = a1; red[(ks * 5 + 2) * 64 + col] = a2; red[(ks * 5 + 3) * 64 + col] = a3; red[(ks * 5 + 4) * 64 + col] = a4;
        __syncthreads();
        if (tid < 320) { const int r = tid >> 6; float s = 0.f;
#pragma unroll
            for (int q = 0; q < 8; ++q) s += red[(q * 5 + r) * 64 + col];
            modv[(size_t)(l * 5 + r) * NMOD + j0 + col] = s + PIN(I_BMOD)[l * NMOD + j0 + col]; }
        __syncthreads();
    }
}

__device__ __forceinline__ void ph_convert(const KP& p, LAS unsigned char* lds, int gw, int NGW, int wave, int lane) {
    LAS float* scr = (LAS float*)(lds + wave * 16384);
    bf16* win = (bf16*)(OWS + WS_WIN); bf16* f2 = (bf16*)(OWS + WS_F2); bf16* lora = (bf16*)(OWS + WS_LORA);
    constexpr int I_IN = (D / 64) * (NPROJ / 32), I_OUT = (D / 64) * (D / 32), I_UP = (D / 64) * (DFF / 32), I_DN = (DFF / 64) * (D / 32);
    for (int it = gw; it < I_DN; it += NGW) transpose_item<0>(PIN(I_FW2), DFF, D, f2, 0, scr, it, lane);
    { const int gt = gw * 64 + lane, NGT = NGW * 64; constexpr int PER = (NP - NPROJ) * D / 16;
      for (int i = gt; i < DEPTH * PER; i += NGT) { const int l = i / PER, q = i % PER; *(v4u*)((unsigned char*)win + (size_t)l * NP * D + (size_t)NPROJ * D + (size_t)q * 16) = (v4u){0u, 0u, 0u, 0u}; } }
    { const int gt = gw * 64 + lane, NGT = NGW * 64;
      for (int i = gt; i < DEPTH * LORAW_PER_LAYER / 8; i += NGT) { const int l = i / (LORAW_PER_LAYER / 8); int q = (i % (LORAW_PER_LAYER / 8)) * 8; float v[8];
          int grp, c, k0; if (q < 4 * 512 * 64) { grp = q / (512 * 64); q -= grp * 512 * 64; c = q / 64; k0 = q % 64; } else { grp = 4; q -= 4 * 512 * 64; c = q / 128; k0 = q % 128; }
#pragma unroll
          for (int j = 0; j < 8; ++j) { const int k = k0 + j;
              v[j] = grp < 2 ? PIN(I_W2)[((size_t)(l * 2 + grp) * 64 + k) * RW + c] : grp < 4 ? PIN(I_A2)[((size_t)(l * 2 + grp - 2) * 64 + k) * RW + c] : PIN(I_G2)[((size_t)l * 128 + k) * RW + c]; }
          v4u o; o.x = pk2(v[0], v[1]); o.y = pk2(v[2], v[3]); o.z = pk2(v[4], v[5]); o.w = pk2(v[6], v[7]);
          *(v4u*)(lora + (size_t)i * 8) = o; } }
}
__device__ __forceinline__ void ph_amax(const KP& p, int gw, int NGW, int lane) {
    unsigned* AM = (unsigned*)(OWS + WS_AMAX);
    for (int it = gw; it < 18 * 2 * (DFF / 64); it += NGW) { const int kq = 0, strip = it % (DFF / 64), sm = it / (DFF / 64), s1 = sm & 1, cm = sm >> 1;
        const float* W = cm < 2 ? PIN(s1 ? I_FW3 : I_FW1) + (size_t)cm * D * DFF : PIN(s1 ? I_MW3 : I_MW1) + (size_t)(cm - 2) * D * DFF;
        const int n = strip * 64 + lane; const float* src = W + (size_t)(kq * 256) * DFF + n; float m = 0.f;
#pragma unroll 16
        for (int k = 0; k < 256; ++k) { const float w = src[(size_t)k * DFF]; m += w * w; }
        AM[(size_t)cm * 2 * DFF + 8 * (n >> 2) + 4 * s1 + (n & 3)] = __builtin_bit_cast(unsigned, 4.25f * sqrtf(m * (1.f / 256.f))); }
    for (int it = gw; it < DEPTH * (NPROJ / 64 + D / 64); it += NGW) { const int kq = 0; int t = it; const int l = t / (NPROJ / 64 + D / 64); t -= l * (NPROJ / 64 + D / 64);
        const bool isin = t < NPROJ / 64; const int strip = isin ? t : t - NPROJ / 64, N = isin ? NPROJ : D, n = strip * 64 + lane;
        const float* src = (isin ? PIN(I_WIN) + (size_t)l * D * NPROJ : PIN(I_WOUT) + (size_t)l * D * D) + (size_t)(kq * 256) * N + n; float m = 0.f;
#pragma unroll 16
        for (int k = 0; k < 256; ++k) { const float w = src[(size_t)k * N]; m += w * w; }
        AM[isin ? AM_IN + l * NP + rowmap<1>(n, 0) : AM_OUT + l * D + n] = __builtin_bit_cast(unsigned, 4.25f * sqrtf(m * (1.f / 256.f))); }
}
__device__ __forceinline__ unsigned q8pack(float a, float b, float c, float d) {
    const int qa = __float2int_rn(fminf(fmaxf(a, -127.f), 127.f)), qb = __float2int_rn(fminf(fmaxf(b, -127.f), 127.f)), qc = __float2int_rn(fminf(fmaxf(c, -127.f), 127.f)), qd = __float2int_rn(fminf(fmaxf(d, -127.f), 127.f));
    return (unsigned)(qa & 255) | ((unsigned)(qb & 255) << 8) | ((unsigned)(qc & 255) << 16) | ((unsigned)(qd & 255) << 24); }
constexpr int CQ_IN = (D / 64) * (NPROJ / 32), CQ_OUT = (D / 64) * (D / 32), CQ_UP = (D / 64) * (DFF / 32), CQ_DN = (DFF / 64) * (D / 32);
constexpr int CQ_NEG = CQ_IN + CQ_OUT + 2 * CQ_UP;
constexpr int CQ_J1 = 3 * CQ_IN + 3 * CQ_OUT + 2 * CQ_UP + CQ_DN, CQ_MOE = NE * (2 * CQ_UP + CQ_DN), CQ_END0 = CQ_J1 + CQ_MOE, CQ_END1 = CQ_END0 + CQ_MOE;
#ifndef CQ_SLOT_ITEMS
#define CQ_SLOT_ITEMS 12000
#endif
struct CqItem { const float* W; bf16* WT; int K, N, mode, arg, item; const unsigned* am; };
__device__ __forceinline__ CqItem cq_decode(const KP& p, int q) {
    CqItem c; bf16* win = (bf16*)(OWS + WS_WIN); bf16* wout = (bf16*)(OWS + WS_WOUT); bf16* f13 = (bf16*)(OWS + WS_F13); bf16* f2 = (bf16*)(OWS + WS_F2);
    bf16* m13 = (bf16*)(OWS + WS_MOEW13); bf16* m2 = (bf16*)(OWS + WS_MOEW2); const unsigned* AM = (const unsigned*)(OWS + WS_AMAX);
    if (q < 0) { q += CQ_NEG;
        if (q < CQ_IN) { c = CqItem{PIN(I_WIN), win, D, NPROJ, 3, 0, q, AM + AM_IN}; return c; } q -= CQ_IN;
        if (q < CQ_OUT) { c = CqItem{PIN(I_WOUT), wout, D, D, 4, 0, q, AM + AM_OUT}; return c; } q -= CQ_OUT;
        if (q < CQ_UP) { c = CqItem{PIN(I_FW1), f13, D, DFF, 2, 0, q, AM}; return c; } q -= CQ_UP;
        c = CqItem{PIN(I_FW3), f13, D, DFF, 2, 1, q, AM}; return c; }
    if (q < 3 * CQ_IN) { const int l = 1 + q / CQ_IN; c = CqItem{PIN(I_WIN) + (size_t)l * D * NPROJ, win + (size_t)l * (NP * D / 2), D, NPROJ, 3, 0, q % CQ_IN, AM + AM_IN + l * NP}; return c; } q -= 3 * CQ_IN;
    if (q < 3 * CQ_OUT) { const int l = 1 + q / CQ_OUT; c = CqItem{PIN(I_WOUT) + (size_t)l * D * D, wout + (size_t)l * (D * D / 2), D, D, 4, 0, q % CQ_OUT, AM + AM_OUT + l * D}; return c; } q -= 3 * CQ_OUT;
    if (q < CQ_UP) { c = CqItem{PIN(I_FW1) + (size_t)D * DFF, f13 + (size_t)DFF * D, D, DFF, 2, 0, q, AM + 2 * DFF}; return c; } q -= CQ_UP;
    if (q < CQ_UP) { c = CqItem{PIN(I_FW3) + (size_t)D * DFF, f13 + (size_t)DFF * D, D, DFF, 2, 1, q, AM + 2 * DFF}; return c; } q -= CQ_UP;
    if (q < CQ_DN) { c = CqItem{PIN(I_FW2) + (size_t)DFF * D, f2 + (size_t)D * DFF, DFF, D, 0, 0, q, nullptr}; return c; } q -= CQ_DN;
    const int mi = q / CQ_MOE; q -= mi * CQ_MOE;
    if (q < NE * CQ_UP) { const int e = q / CQ_UP; c = CqItem{PIN(I_MW1) + ((size_t)mi * NE + e) * D * DFF, m13 + (size_t)e * DFF * D, D, DFF, 2, 0, q % CQ_UP, AM + (size_t)(2 + 8 * mi + e) * 2 * DFF}; return c; } q -= NE * CQ_UP;
    if (q < NE * CQ_UP) { const int e = q / CQ_UP; c = CqItem{PIN(I_MW3) + ((size_t)mi * NE + e) * D * DFF, m13 + (size_t)e * DFF * D, D, DFF, 2, 1, q % CQ_UP, AM + (size_t)(2 + 8 * mi + e) * 2 * DFF}; return c; } q -= NE * CQ_UP;
    { const int e = q / CQ_DN; c = CqItem{PIN(I_MW2) + ((size_t)mi * NE + e) * DFF * D, m2 + (size_t)e * D * DFF, DFF, D, 0, 0, q % CQ_DN, nullptr}; return c; }
}
__device__ __forceinline__ void cq_load(const CqItem& c, int lane, float (&r)[32]) {
    const int nblk = c.N / 32, kb = c.item / nblk, nb = c.item % nblk; const float* src = c.W + (size_t)(64 * kb + (lane >> 5)) * c.N + 32 * nb + (lane & 31);
#pragma unroll
    for (int i = 0; i < 32; ++i) r[i] = src[(size_t)(2 * i) * c.N];
}
__device__ __forceinline__ void cq_store(const CqItem& c, int lane, const float (&r)[32], LAS float* scr) {
    const int nblk = c.N / 32, kb = c.item / nblk, nb = c.item % nblk, k0 = 64 * kb, n0 = 32 * nb;
#pragma unroll
    for (int i = 0; i < 32; ++i) scr[(2 * i + (lane >> 5)) * 33 + (lane & 31)] = r[i];
    LDS_WAIT(); asm volatile("" ::: "memory");
    if (c.mode >= 2) {
        const int n = lane >> 1, hf = lane & 1, nn = n0 + n, j = c.mode == 2 ? 8 * (nn >> 2) + 4 * c.arg + (nn & 3) : c.mode == 3 ? rowmap<1>(nn, 0) : nn;
        const float inv = 127.f / fmaxf(__builtin_bit_cast(float, c.am[j]), 1e-30f); const LAS float* sp = scr + (32 * hf) * 33 + n; unsigned w[8];
#pragma unroll
        for (int q = 0; q < 8; ++q) w[q] = q8pack(sp[(4 * q + 0) * 33] * inv, sp[(4 * q + 1) * 33] * inv, sp[(4 * q + 2) * 33] * inv, sp[(4 * q + 3) * 33] * inv);
        unsigned char* dst = (unsigned char*)c.WT + (size_t)j * c.K + k0 + 32 * hf;
        *(v4u*)dst = (v4u){w[0], w[1], w[2], w[3]}; *(v4u*)(dst + 16) = (v4u){w[4], w[5], w[6], w[7]};
    } else {
    const int cc = lane & 7;
#pragma unroll
    for (int j = 0; j < 4; ++j) { const int n = (lane >> 3) + 8 * j; const LAS float* sp = scr + (8 * cc) * 33 + n;
        v4u o; o.x = pk2(sp[0 * 33], sp[1 * 33]); o.y = pk2(sp[2 * 33], sp[3 * 33]); o.z = pk2(sp[4 * 33], sp[5 * 33]); o.w = pk2(sp[6 * 33], sp[7 * 33]);
        const int nn = n0 + n;
        *(v4u*)(c.WT + (size_t)nn * c.K + k0 + 8 * cc) = o; }
    }
    LDS_WAIT(); asm volatile("" ::: "memory");
}
constexpr int CQ_B = 4;
__device__ __forceinline__ int cq_grab(unsigned* heads, int nseg, int& cnt, int lane) {
    int q = -1, n = 0;
    if (lane == 0) { for (int sg = 0; sg < nseg && q < 0; ++sg) { const int size = sg == 0 ? CQ_J1 : CQ_MOE, base = sg == 0 ? 0 : sg == 1 ? CQ_J1 : CQ_END0; unsigned* hd = heads + 64 * sg;
            if ((int)__hip_atomic_load(hd, __ATOMIC_RELAXED, __HIP_MEMORY_SCOPE_AGENT) < size) { const int t = (int)__hip_atomic_fetch_add(hd, (unsigned)CQ_B, __ATOMIC_RELAXED, __HIP_MEMORY_SCOPE_AGENT);
                if (t < size) { q = base + t; n = size - t < CQ_B ? size - t : CQ_B; } } } }
    cnt = __builtin_amdgcn_readfirstlane(n); return __builtin_amdgcn_readfirstlane(q);
}
__device__ __forceinline__ void cq_run(const KP& p, LAS unsigned char* lds, int nseg, const unsigned* stop, unsigned stopval, int wave, int lane) {
    unsigned* heads = (unsigned*)(OWS + WS_CTL) + CW_CQ; LAS float* scr = (LAS float*)(lds + wave * 16384);
    for (;;) {
        if (stop) { unsigned sv = 0u; if (lane == 0) sv = __hip_atomic_load(stop, __ATOMIC_RELAXED, __HIP_MEMORY_SCOPE_AGENT); if ((unsigned)__builtin_amdgcn_readfirstlane((int)sv) >= stopval) break; }
        int cnt; const int q0 = cq_grab(heads, nseg, cnt, lane); if (q0 < 0) break;
        CqItem cur = cq_decode(p, q0); float ra[32]; cq_load(cur, lane, ra);
        for (int j = 0; j < cnt; ++j) { CqItem nxt = cur; float rb[32];
            if (j + 1 < cnt) { nxt = cq_decode(p, q0 + j + 1); cq_load(nxt, lane, rb); }
            cq_store(cur, lane, ra, scr);
            if (j + 1 < cnt) { cur = nxt;
#pragma unroll
                for (int i = 0; i < 32; ++i) ra[i] = rb[i]; } }
    }
}

__device__ __forceinline__ void cq_static(const KP& p, LAS unsigned char* lds, int q0, int q1, int gw, int NGW, int wave, int lane) {
    LAS float* scr = (LAS float*)(lds + wave * 16384);
    int q = q0 + gw; if (q >= q1) return;
    CqItem cur = cq_decode(p, q); float ra[32]; cq_load(cur, lane, ra);
    for (;;) { const int qn = q + NGW; CqItem nxt = cur; float rb[32];
        if (qn < q1) { nxt = cq_decode(p, qn); cq_load(nxt, lane, rb); }
        cq_store(cur, lane, ra, scr);
        if (qn >= q1) break;
        cur = nxt; q = qn;
#pragma unroll
        for (int i = 0; i < 32; ++i) ra[i] = rb[i]; }
}

__device__ __forceinline__ void ld_row(const float* r, int lane, f32x4 (&v)[4]) { const f32x4* q = (const f32x4*)r + lane;
#pragma unroll
    for (int j = 0; j < 4; ++j) v[j] = q[64 * j]; }
__device__ __forceinline__ void st_row(float* r, int lane, const f32x4 (&v)[4]) { f32x4* q = (f32x4*)r + lane;
#pragma unroll
    for (int j = 0; j < 4; ++j) q[64 * j] = v[j]; }
__device__ __forceinline__ void st_row_bf16(bf16* r, int lane, const f32x4 (&v)[4]) { v2u* q = (v2u*)r + lane;
#pragma unroll
    for (int j = 0; j < 4; ++j) { v2u w; w.x = pk2(v[j][0], v[j][1]); w.y = pk2(v[j][2], v[j][3]); q[64 * j] = w; } }
__device__ __forceinline__ void ld_row_bf16(const bf16* r, int lane, f32x4 (&v)[4]) { const v2u* q = (const v2u*)r + lane;
#pragma unroll
    for (int j = 0; j < 4; ++j) { const v2u w = q[64 * j]; v[j] = (f32x4){bflo(w.x), bfhi(w.x), bflo(w.y), bfhi(w.y)}; } }
typedef _Float16 h16x4 __attribute__((ext_vector_type(4)));
__device__ __forceinline__ void st_row_h16(_Float16* r, int lane, const f32x4 (&v)[4]) { h16x4* q = (h16x4*)r + lane;
#pragma unroll
    for (int j = 0; j < 4; ++j) { h16x4 w; w[0] = (_Float16)v[j][0]; w[1] = (_Float16)v[j][1]; w[2] = (_Float16)v[j][2]; w[3] = (_Float16)v[j][3]; q[64 * j] = w; } }
__device__ __forceinline__ void ld_row_h16(const _Float16* r, int lane, f32x4 (&v)[4]) { const h16x4* q = (const h16x4*)r + lane;
#pragma unroll
    for (int j = 0; j < 4; ++j) { const h16x4 w = q[64 * j]; v[j] = (f32x4){(float)w[0], (float)w[1], (float)w[2], (float)w[3]}; } }
template <int S> __device__ __forceinline__ void ld_row_parts(const float* r, size_t pstride, int lane, f32x4 (&v)[4]) {
    ld_row(r, lane, v);
#pragma unroll
    for (int s = 1; s < S; ++s) { f32x4 t[4]; ld_row(r + (size_t)s * pstride, lane, t);
#pragma unroll
        for (int j = 0; j < 4; ++j) v[j] += t[j]; } }
__device__ __forceinline__ int mod_row(int row) { return row < NLAT ? (row >> 12) : 4; }

__device__ __forceinline__ void st_row_q8(unsigned char* dst8, float* scale, int row, int lane, const f32x4 (&v)[4]) {
    float am = 0.f;
#pragma unroll
    for (int j = 0; j < 4; ++j) am = fmaxf(fmaxf(am, fmaxf(fabsf(v[j][0]), fabsf(v[j][1]))), fmaxf(fabsf(v[j][2]), fabsf(v[j][3])));
#pragma unroll
    for (int o = 1; o < 64; o <<= 1) am = fmaxf(am, __shfl_xor(am, o));
    am = fmaxf(am, 1e-30f); const float inv = 127.f / am; unsigned* h8 = (unsigned*)dst8 + (size_t)row * (D / 4) + lane;
#pragma unroll
    for (int j = 0; j < 4; ++j) h8[64 * j] = q8pack(v[j][0] * inv, v[j][1] * inv, v[j][2] * inv, v[j][3] * inv);
    if (lane == 0) scale[row] = am * (1.f / 127.f);
}
__device__ __forceinline__ void ph_init_rows(const KP& p, int gw, int NGW, int lane) {
    const float* modv = (const float*)(OWS + WS_MODV); float* X = (float*)(OWS + WS_X); bf16* H = (bf16*)(OWS + WS_H);
    for (int row = gw; row < MROWS; row += NGW) {
        const float* src = row < NLAT ? PIN(I_X) + (size_t)row * D : PIN(I_CTX) + (size_t)(row - NLAT) * D;
        const float* mv = modv + (size_t)(0 * 5 + mod_row(row)) * NMOD;
        f32x4 x[4], sh[4], sc[4], h[4]; ld_row(src, lane, x); ld_row(mv, lane, sh); ld_row(mv + 1024, lane, sc);
#pragma unroll
        for (int j = 0; j < 4; ++j) h[j] = x[j] * (1.f + sc[j]) + sh[j];
        st_row_q8(OWS + WS_H8, (float*)(OWS + WS_SA), row, lane, h);
    }
}

__device__ __forceinline__ int scan_row(int b, int dir, int step) { return step < CTXL ? NLAT + b * CTXL + (dir ? CTXL - 1 - step : step) : b * SEQ + (dir ? SEQ - 1 - (step - CTXL) : step - CTXL); }
typedef short sbf16x8 __attribute__((ext_vector_type(8)));
typedef float f32x16 __attribute__((ext_vector_type(16)));
constexpr int SC_C = 32, SC_NCH = (CTXL + SEQ) / SC_C  , SC_NCHAIN = NB * NH * 2  , SC_NTASK = SC_NCH * SC_NCHAIN  ;
constexpr int CH_G = 0, CH_Q = 8192, CH_UT = 12288, CH_YL = 20480, CH_EC = 24576, CH_BYTES = 25600, CH_NLOAD = 26;

__device__ __forceinline__ f32x16 mm(v4u a, v4u b, f32x16 c) { return __builtin_amdgcn_mfma_f32_32x32x16_bf16(__builtin_bit_cast(sbf16x8, a), __builtin_bit_cast(sbf16x8, b), c, 0, 0, 0); }
typedef float f32x2c __attribute__((ext_vector_type(2))); typedef __bf16 bf16x2c __attribute__((ext_vector_type(2)));
__device__ __forceinline__ unsigned cvtpk(float lo, float hi) { return __builtin_bit_cast(unsigned, __builtin_convertvector((f32x2c){lo, hi}, bf16x2c)); }
template <int S, int NEG> __device__ __forceinline__ v4u cvtf(const f32x16& x) {
    v4u w; const float sg = NEG ? -1.f : 1.f;
    w.x = cvtpk(sg * x[8 * S + 0], sg * x[8 * S + 1]); w.y = cvtpk(sg * x[8 * S + 2], sg * x[8 * S + 3]); w.z = cvtpk(sg * x[8 * S + 4], sg * x[8 * S + 5]); w.w = cvtpk(sg * x[8 * S + 6], sg * x[8 * S + 7]); return w; }
template <int MODE  > __device__ __forceinline__ f32x16 mask_acc(f32x16 x, int n, int hh) {
#pragma unroll
    for (int r = 0; r < 16; ++r) { const int m = (r & 3) + 8 * (r >> 2) + 4 * hh; const bool keep = MODE == 0 ? (m > n) : MODE == 1 ? (m < n) : (m <= n); x[r] = keep ? x[r] : 0.f; }
    return x; }
__device__ __forceinline__ f32x16 zero16() { f32x16 z;
#pragma unroll
    for (int r = 0; r < 16; ++r) z[r] = 0.f;
    return z; }
__device__ __forceinline__ void cm_build(const unsigned (&w)[16], v4u (&f)[2][2]) {
#pragma unroll
    for (int s = 0; s < 2; ++s) {
        const auto r0 = __builtin_amdgcn_permlane32_swap(w[8 * s + 0], w[8 * s + 2], false, false), r1 = __builtin_amdgcn_permlane32_swap(w[8 * s + 1], w[8 * s + 3], false, false);
        const auto r2 = __builtin_amdgcn_permlane32_swap(w[8 * s + 4], w[8 * s + 6], false, false), r3 = __builtin_amdgcn_permlane32_swap(w[8 * s + 5], w[8 * s + 7], false, false);
        f[0][s] = (v4u){r0[0], r1[0], r2[0], r3[0]}; f[1][s] = (v4u){r0[1], r1[1], r2[1], r3[1]}; }
}
__device__ __forceinline__ void st16(unsigned char* base, int off, int lane, v4u v) { *(v4u*)(base + off + lane * 16) = v; }

__device__ __forceinline__ void ph_scan1(const KP& p, int l, int gw, int NGW, int lane) {
    const bf16* P = (const bf16*)(OWS + WS_P); const bf16* LO = (const bf16*)(OWS + WS_LO); const float* NRM = (const float*)(OWS + WS_RKS); unsigned char* CH = OWS + WS_CH;
    const int n = lane & 31, hh = lane >> 5;
    v4u Id[2];
#pragma unroll
    for (int s = 0; s < 2; ++s) { unsigned wd[4];
#pragma unroll
        for (int q = 0; q < 4; ++q) { const int j0 = 2 * q, j1 = 2 * q + 1; const int t0 = 16 * s + 8 * (j0 >> 2) + 4 * hh + (j0 & 3), t1 = 16 * s + 8 * (j1 >> 2) + 4 * hh + (j1 & 3);
            wd[q] = (t0 == n ? 0x3F80u : 0u) | (t1 == n ? 0x3F800000u : 0u); }
        Id[s] = (v4u){wd[0], wd[1], wd[2], wd[3]}; }
    for (int task = gw; task < SC_NTASK; task += NGW) {
        const int dir = task & 1, h = (task >> 1) & 7, b = (task >> 4) & 3, ci = task >> 6;
        const int row0 = scan_row(b, dir, SC_C * ci), sgn = dir ? -1 : 1, c = h * 64 + lane;
        const float w0c = PIN(I_W0)[(l * 2 + dir) * RW + c], a0c = PIN(I_A0)[(l * 2 + dir) * RW + c], kkc = PIN(I_KK)[l * RW + c], kac = PIN(I_KA)[l * RW + c];
        unsigned wAl[16], wBe[16], wKa[16], wRh[16], wV[16], wBp[16], wKp[16];
        float cs = 0.f, Eprev = 1.f;
#pragma unroll
        for (int hb = 0; hb < 2; ++hb) {
            unsigned rk_[16], rr_[16], rv_[16], rw_[16], ra_[16]; float rn_[16];
#pragma unroll
            for (int i = 0; i < 16; ++i) { const int row = row0 + sgn * (16 * hb + i); const bf16* pr = P + (size_t)row * NP; const bf16* lo = LO + (size_t)row * NLO;
                rk_[i] = pr[PC_K + c]; rr_[i] = pr[PC_R + c]; rv_[i] = pr[PC_V + c]; rw_[i] = lo[dir * RW + c]; ra_[i] = lo[1024 + dir * RW + c]; rn_[i] = NRM[row * 8 + h]; }
#pragma unroll
            for (int i = 0; i < 16; ++i) asm volatile("" : "+v"(rk_[i]), "+v"(rr_[i]), "+v"(rv_[i]), "+v"(rw_[i]), "+v"(ra_[i]), "+v"(rn_[i]));
#pragma unroll
            for (int pq = 0; pq < 8; ++pq) { const int pz = 8 * hb + pq; float al[2], be[2], ka[2], rh[2], vv[2];
#pragma unroll
                for (int e = 0; e < 2; ++e) { const int i = 2 * pq + e;
                    const float kv = bf2f((unsigned short)rk_[i]), rv = bf2f((unsigned short)rr_[i]); vv[e] = bf2f((unsigned short)rv_[i]);
                    const float wl = w0c + bf2f((unsigned short)rw_[i]), aa = __builtin_amdgcn_rcpf(1.f + __expf(-(a0c + bf2f((unsigned short)ra_[i])))), nrm = rn_[i];
                    const float lw = -0.6065306597f * __builtin_amdgcn_rcpf(1.f + __expf(-wl));
                    cs += lw; const float E = __expf(cs), Ei = __builtin_amdgcn_rcpf(E);
                    const float kkn = kv * kkc * nrm, kd = kv * (1.f + (aa - 1.f) * kac);
                    al[e] = kkn * Eprev; be[e] = kkn * aa * Ei; ka[e] = kd * Ei; rh[e] = rv * E; Eprev = E; }
                wAl[pz] = cvtpk(al[0], al[1]); wBe[pz] = cvtpk(be[0], be[1]); wKa[pz] = cvtpk(ka[0], ka[1]); wRh[pz] = cvtpk(rh[0], rh[1]); wV[pz] = cvtpk(vv[0], vv[1]); }
        }
        const float EC = Eprev;
#pragma unroll
        for (int pz = 0; pz < 16; ++pz) { wBp[pz] = cvtpk(bflo(wBe[pz]) * EC, bfhi(wBe[pz]) * EC); wKp[pz] = cvtpk(bflo(wKa[pz]) * EC, bfhi(wKa[pz]) * EC); }
        unsigned char* img = CH + (size_t)(((b * 8 + h) * 2 + dir) * SC_NCH + ci) * CH_BYTES;
        ((float*)(img + CH_EC))[lane] = EC;
        v4u cAl[2][2], cV[2][2], cBp[2][2], cKp[2][2], cRh[2][2];
        v4u tAl[4], tBe[4], tKa[4], tRh[4];
        cm_build(wAl, cAl); cm_build(wV, cV); cm_build(wBp, cBp); cm_build(wKp, cKp); cm_build(wRh, cRh);
        {   v4u cBe[2][2], cKa[2][2]; cm_build(wBe, cBe); cm_build(wKa, cKa);
#define TRANSPOSE(cZ, tZ) do { _Pragma("unroll") for (int ct = 0; ct < 2; ++ct) { f32x16 T_ = mm(cZ[ct][0], Id[0], zero16()); T_ = mm(cZ[ct][1], Id[1], T_); tZ[2 * ct] = cvtf<0, 0>(T_); tZ[2 * ct + 1] = cvtf<1, 0>(T_); } } while (0)
            TRANSPOSE(cAl, tAl); TRANSPOSE(cBe, tBe); TRANSPOSE(cKa, tKa); TRANSPOSE(cRh, tRh);
#undef TRANSPOSE
        }
#define PROD4(A, B) mm(A[3], B[3], mm(A[2], B[2], mm(A[1], B[1], mm(A[0], B[0], zero16()))))
        f32x16 XN = mask_acc<0>(PROD4(tAl, tBe), n, hh), XT = mask_acc<1>(PROD4(tBe, tAl), n, hh);
        v4u fLM[2], fGB[2], fGK[2];
        { const f32x16 t = mask_acc<1>(PROD4(tKa, tAl), n, hh); fLM[0] = cvtf<0, 0>(t); fLM[1] = cvtf<1, 0>(t); }
        { const f32x16 t = mask_acc<2>(PROD4(tBe, tRh), n, hh); fGB[0] = cvtf<0, 0>(t); fGB[1] = cvtf<1, 0>(t); }
        { const f32x16 t = mask_acc<2>(PROD4(tKa, tRh), n, hh); fGK[0] = cvtf<0, 0>(t); fGK[1] = cvtf<1, 0>(t); }
#undef PROD4
#pragma unroll
        for (int r = 0; r < 16; ++r) { XN[r] = -XN[r]; XT[r] = -XT[r]; }
        f32x16 RT = XT;
#pragma unroll
        for (int r = 0; r < 16; ++r) RT[r] += ((r & 3) + 8 * (r >> 2) + 4 * hh == n) ? 1.f : 0.f;
#pragma unroll
        for (int pw = 1; pw < 5; ++pw) {
            const v4u xn0 = cvtf<0, 0>(XN), xn1 = cvtf<1, 0>(XN), xt0 = cvtf<0, 0>(XT), xt1 = cvtf<1, 0>(XT);
            XN = mm(xt1, xn1, mm(xt0, xn0, zero16()));
            if (pw < 4) XT = mm(xn1, xt1, mm(xn0, xt0, zero16()));
            const v4u yn0 = cvtf<0, 0>(XN), yn1 = cvtf<1, 0>(XN), rt0 = cvtf<0, 0>(RT), rt1 = cvtf<1, 0>(RT);
            RT = mm(yn1, rt1, mm(yn0, rt0, RT));
        }
        const v4u fA0 = cvtf<0, 0>(RT), fA1 = cvtf<1, 0>(RT);
        f32x16 At[2], Vt[2];
#pragma unroll
        for (int t = 0; t < 2; ++t) {
            const f32x16 lmv = mm(fLM[1], cV[t][1], mm(fLM[0], cV[t][0], zero16()));
            At[t] = mm(fA1, cAl[t][1], mm(fA0, cAl[t][0], zero16()));
            Vt[t] = mm(fA1, cvtf<1, 0>(lmv), mm(fA0, cvtf<0, 0>(lmv), zero16()));
        }
#pragma unroll
        for (int kt1 = 0; kt1 < 2; ++kt1) { const v4u a0 = cvtf<0, 0>(At[kt1]), a1 = cvtf<1, 0>(At[kt1]);
#pragma unroll
            for (int kt2 = 0; kt2 < 2; ++kt2) { const f32x16 g = mm(a1, cBp[kt2][1], mm(a0, cBp[kt2][0], zero16()));
                st16(img, CH_G + ((kt2 * 2 + kt1) * 2 + 0) * 1024, lane, cvtf<0, 1>(g)); st16(img, CH_G + ((kt2 * 2 + kt1) * 2 + 1) * 1024, lane, cvtf<1, 1>(g)); } }
#pragma unroll
        for (int vt = 0; vt < 2; ++vt) { const v4u nv0 = cvtf<0, 1>(Vt[vt]), nv1 = cvtf<1, 1>(Vt[vt]);
#pragma unroll
            for (int kt = 0; kt < 2; ++kt) { f32x16 u = mm(cKp[kt][1], cV[vt][1], mm(cKp[kt][0], cV[vt][0], zero16())); u = mm(cBp[kt][1], nv1, mm(cBp[kt][0], nv0, u));
                st16(img, CH_UT + ((kt * 2 + vt) * 2 + 0) * 1024, lane, cvtf<0, 0>(u)); st16(img, CH_UT + ((kt * 2 + vt) * 2 + 1) * 1024, lane, cvtf<1, 0>(u)); }
            f32x16 y = mm(cV[vt][1], fGK[1], mm(cV[vt][0], fGK[0], zero16())); y = mm(nv1, fGB[1], mm(nv0, fGB[0], y));
            st16(img, CH_YL + (vt * 2 + 0) * 1024, lane, cvtf<0, 0>(y)); st16(img, CH_YL + (vt * 2 + 1) * 1024, lane, cvtf<1, 0>(y)); }
#pragma unroll
        for (int kt = 0; kt < 2; ++kt) { f32x16 q = mm(cRh[kt][1], Id[1], mm(cRh[kt][0], Id[0], zero16()));
            q = mm(cvtf<1, 1>(At[kt]), fGB[1], mm(cvtf<0, 1>(At[kt]), fGB[0], q));
            st16(img, CH_Q + (kt * 2 + 0) * 1024, lane, cvtf<0, 0>(q)); st16(img, CH_Q + (kt * 2 + 1) * 1024, lane, cvtf<1, 0>(q)); }
    }
}

__device__ __forceinline__ void ph_scan2(const KP& p, LAS unsigned char* lds, int l, int wave, int lane) {
    unsigned* sdone = (unsigned*)(OWS + WS_CTL) + CW_SDONE + 64 * l;
#ifndef CQ_SLOT_WGS
#define CQ_SLOT_WGS 128
#endif
    if (blockIdx.x >= SC_NCHAIN * 2) {
        const int q0 = (l < 2 ? CQ_J1 : CQ_END0) + (l & 1) * CQ_SLOT_ITEMS;
        cq_static(p, lds, q0, q0 + CQ_SLOT_ITEMS, ((int)blockIdx.x - SC_NCHAIN * 2) * NWAVES + wave, ((int)gridDim.x - SC_NCHAIN * 2) * NWAVES, wave, lane); return; }
    const int chain = blockIdx.x >> 1, vt = blockIdx.x & 1, dir = chain & 1, h = (chain >> 1) & 7, b = chain >> 4;
    const int n = lane & 31, hh = lane >> 5;
    const unsigned char* CH = OWS + WS_CH + (size_t)chain * SC_NCH * CH_BYTES; bf16* Y = (bf16*)(OWS + WS_Y) + (size_t)dir * MROWS * RW + h * 64 + 32 * vt + 4 * hh;
    constexpr int NPIECE = 19, SLOT = NPIECE * 1024, NSLOT = 6, PD = 4, XCH = NSLOT * SLOT;
    int psrc[3], pdst[3];
#pragma unroll
    for (int j = 0; j < 3; ++j) { int f = wave + 8 * j; if (f >= NPIECE) f -= NPIECE;
        pdst[j] = f;
        psrc[j] = f < 12 ? f * 1024 : f < 16 ? CH_UT + ((((f - 12) >> 1) * 2 + vt) * 2 + ((f - 12) & 1)) * 1024 : f < 18 ? CH_YL + (vt * 2 + (f - 16)) * 1024 : CH_EC; }
    const int lane_off[3] = {pdst[0] == 18 ? (lane * 16) & 255 : lane * 16, pdst[1] == 18 ? (lane * 16) & 255 : lane * 16, pdst[2] == 18 ? (lane * 16) & 255 : lane * 16};
#define SC2_ISSUE(ci_, slot_) do { const unsigned char* im_ = CH + (size_t)(ci_) * CH_BYTES; LAS unsigned char* sl_ = lds + (slot_) * SLOT; \
        _Pragma("unroll") for (int j = 0; j < 3; ++j) __builtin_amdgcn_global_load_lds((const unsigned*)(im_ + psrc[j] + lane_off[j]), (LAS unsigned*)(sl_ + pdst[j] * 1024), 16, 0, 0); } while (0)
#define SC2_LD(slot_, piece_) (*(const LAS v4u*)(lds + (slot_) * SLOT + (piece_) * 1024 + lane * 16))
#define SC2_X(par_, k_) (*(LAS v4u*)(lds + XCH + (par_) * 4096 + (k_) * 1024 + lane * 16))
    f32x16 ST[2] = {zero16(), zero16()};
    SC2_ISSUE(0, 0); SC2_ISSUE(1, 1); SC2_ISSUE(2, 2); SC2_ISSUE(3, 3);
    v4u g0, g1, g2, g3, g4, g5, g6, g7, u0, u1, u2, u3; f32x4 ec[8];
#define SC2_PRELOAD(slot_) do { g0 = SC2_LD(slot_, 0); g1 = SC2_LD(slot_, 1); g2 = SC2_LD(slot_, 2); g3 = SC2_LD(slot_, 3); g4 = SC2_LD(slot_, 4); g5 = SC2_LD(slot_, 5); g6 = SC2_LD(slot_, 6); g7 = SC2_LD(slot_, 7); \
        u0 = SC2_LD(slot_, 12); u1 = SC2_LD(slot_, 13); u2 = SC2_LD(slot_, 14); u3 = SC2_LD(slot_, 15); \
        _Pragma("unroll") for (int kq = 0; kq < 8; ++kq) ec[kq] = *(const LAS f32x4*)(lds + (slot_) * SLOT + 18 * 1024 + (32 * (kq >> 2) + 8 * (kq & 3) + 4 * hh) * 4); } while (0)
    for (int ci = 0; ci <= SC_NCH; ++ci) {
        asm volatile("s_waitcnt vmcnt(6)" ::: "memory");
        __builtin_amdgcn_s_barrier();
        asm volatile("" ::: "memory");
        { const int nx = ci + PD < SC_NCH ? ci + PD : SC_NCH - 1; SC2_ISSUE(nx, (ci + PD) % NSLOT); }
        if (wave == 0 && ci < SC_NCH) {
            if (ci == 0) SC2_PRELOAD(0);
            asm volatile("" : "+v"(g0), "+v"(g1), "+v"(g2), "+v"(g3), "+v"(g4), "+v"(g5), "+v"(g6), "+v"(g7), "+v"(u0), "+v"(u1), "+v"(u2), "+v"(u3));
            asm volatile("" : "+v"(ec[0]), "+v"(ec[1]), "+v"(ec[2]), "+v"(ec[3]), "+v"(ec[4]), "+v"(ec[5]), "+v"(ec[6]), "+v"(ec[7]));
            const v4u s00 = cvtf<0, 0>(ST[0]), s01 = cvtf<1, 0>(ST[0]), s10 = cvtf<0, 0>(ST[1]), s11 = cvtf<1, 0>(ST[1]);
            SC2_X(ci & 1, 0) = s00; SC2_X(ci & 1, 1) = s01; SC2_X(ci & 1, 2) = s10; SC2_X(ci & 1, 3) = s11;
            f32x16 a0, a1;
            a0[0] = bflo(u0.x); a0[1] = bfhi(u0.x); a0[2] = bflo(u0.y); a0[3] = bfhi(u0.y); a0[4] = bflo(u0.z); a0[5] = bfhi(u0.z); a0[6] = bflo(u0.w); a0[7] = bfhi(u0.w);
            a0[8] = bflo(u1.x); a0[9] = bfhi(u1.x); a0[10] = bflo(u1.y); a0[11] = bfhi(u1.y); a0[12] = bflo(u1.z); a0[13] = bfhi(u1.z); a0[14] = bflo(u1.w); a0[15] = bfhi(u1.w);
            a1[0] = bflo(u2.x); a1[1] = bfhi(u2.x); a1[2] = bflo(u2.y); a1[3] = bfhi(u2.y); a1[4] = bflo(u2.z); a1[5] = bfhi(u2.z); a1[6] = bflo(u2.w); a1[7] = bfhi(u2.w);
            a1[8] = bflo(u3.x); a1[9] = bfhi(u3.x); a1[10] = bflo(u3.y); a1[11] = bfhi(u3.y); a1[12] = bflo(u3.z); a1[13] = bfhi(u3.z); a1[14] = bflo(u3.w); a1[15] = bfhi(u3.w);
#pragma unroll
            for (int q = 0; q < 4; ++q)
#pragma unroll
                for (int e = 0; e < 4; ++e) { a0[4 * q + e] += ST[0][4 * q + e] * ec[q][e]; a1[4 * q + e] += ST[1][4 * q + e] * ec[4 + q][e]; }
            a0 = mm(g0, s00, a0); a1 = mm(g4, s00, a1); a0 = mm(g1, s01, a0); a1 = mm(g5, s01, a1);
            a0 = mm(g2, s10, a0); a1 = mm(g6, s10, a1); a0 = mm(g3, s11, a0); a1 = mm(g7, s11, a1);
            if (ci + 1 < SC_NCH) SC2_PRELOAD((ci + 1) % NSLOT);
            ST[0] = a0; ST[1] = a1;
            if (lane == 0 && ci == SC_NCH - 24) __hip_atomic_fetch_add(sdone, 1u, __ATOMIC_RELAXED, __HIP_MEMORY_SCOPE_AGENT);
        } else if (wave == 1 && ci >= 1) {
            const int cj = ci - 1, sj = cj % NSLOT, par = cj & 1;
            v4u ya = SC2_LD(sj, 16), yc = SC2_LD(sj, 17), q0 = SC2_LD(sj, 8), q1 = SC2_LD(sj, 9), q2 = SC2_LD(sj, 10), q3 = SC2_LD(sj, 11), x0 = SC2_X(par, 0), x1 = SC2_X(par, 1), x2 = SC2_X(par, 2), x3 = SC2_X(par, 3);
            asm volatile("" : "+v"(ya), "+v"(yc), "+v"(q0), "+v"(q1), "+v"(q2), "+v"(q3), "+v"(x0), "+v"(x1), "+v"(x2), "+v"(x3));
            f32x16 y, y2 = zero16();
            y[0] = bflo(ya.x); y[1] = bfhi(ya.x); y[2] = bflo(ya.y); y[3] = bfhi(ya.y); y[4] = bflo(ya.z); y[5] = bfhi(ya.z); y[6] = bflo(ya.w); y[7] = bfhi(ya.w);
            y[8] = bflo(yc.x); y[9] = bfhi(yc.x); y[10] = bflo(yc.y); y[11] = bfhi(yc.y); y[12] = bflo(yc.z); y[13] = bfhi(yc.z); y[14] = bflo(yc.w); y[15] = bfhi(yc.w);
            y = mm(x0, q0, y); y2 = mm(x2, q2, y2); y = mm(x1, q1, y); y2 = mm(x3, q3, y2);
            const int row = scan_row(b, dir, SC_C * cj + n); bf16* yo = Y + (size_t)row * RW;
#pragma unroll
            for (int q = 0; q < 4; ++q) *(v2u*)(yo + 8 * q) = (v2u){cvtpk(y[4 * q] + y2[4 * q], y[4 * q + 1] + y2[4 * q + 1]), cvtpk(y[4 * q + 2] + y2[4 * q + 2], y[4 * q + 3] + y2[4 * q + 3])};
        }
        asm volatile("s_waitcnt lgkmcnt(0)" ::: "memory");
    }
    asm volatile("s_waitcnt vmcnt(0)" ::: "memory");
#undef SC2_ISSUE
#undef SC2_LD
#undef SC2_X
#undef SC2_PRELOAD
}

__device__ __forceinline__ float sum8(float v) { v += __shfl_xor(v, 1); v += __shfl_xor(v, 2); v += __shfl_xor(v, 4); return v; }
__device__ __forceinline__ void unpack8(v4u s, float (&v)[8]) { v[0] = bflo(s.x); v[1] = bfhi(s.x); v[2] = bflo(s.y); v[3] = bfhi(s.y); v[4] = bflo(s.z); v[5] = bfhi(s.z); v[6] = bflo(s.w); v[7] = bfhi(s.w); }
__device__ __forceinline__ void ld8f(const float* q, float (&v)[8]) { const f32x4 a = *(const f32x4*)q, b = *(const f32x4*)(q + 4); v[0] = a[0]; v[1] = a[1]; v[2] = a[2]; v[3] = a[3]; v[4] = b[0]; v[5] = b[1]; v[6] = b[2]; v[7] = b[3]; }
__device__ __forceinline__ v4u pack8(const float (&v)[8]) { v4u o; o.x = cvtpk(v[0], v[1]); o.y = cvtpk(v[2], v[3]); o.z = cvtpk(v[4], v[5]); o.w = cvtpk(v[6], v[7]); return o; }

__device__ __forceinline__ void ph_readout2(const KP& p, int l, int gw, int NGW, int lane) {
    const bf16* P = (const bf16*)(OWS + WS_P); const bf16* LO = (const bf16*)(OWS + WS_LO); const bf16* Y = (const bf16*)(OWS + WS_Y);
    bf16* MI = (bf16*)(OWS + WS_MIXIN); constexpr size_t PA = (size_t)MROWS * RW; const int c0 = lane * 8;
    const int nrows = l == DEPTH - 1 ? NLAT : MROWS;
#pragma unroll 2
    for (int row = gw; row < nrows; row += NGW) { const bf16* pr = P + (size_t)row * NP; const bf16* lo = LO + (size_t)row * NLO;
        int t, len; if (row < NLAT) { t = row & 63; len = 64; } else { t = (row - NLAT) & 255; len = 256; }
        const v4u kw = *(const v4u*)(pr + PC_K + c0), rw = *(const v4u*)(pr + PC_R + c0), vw = *(const v4u*)(pr + PC_V + c0);
        const v4u cbw = *(const v4u*)(pr + PC_CB + c0), ccw = *(const v4u*)(pr + PC_CC + c0), chw = *(const v4u*)(pr + PC_CH + c0);
        v4u ccp = (v4u){0u, 0u, 0u, 0u}, chp = ccp, ccn = ccp, chn = ccp;
        if (t > 0) { ccp = *(const v4u*)(pr - NP + PC_CC + c0); chp = *(const v4u*)(pr - NP + PC_CH + c0); }
        if (t < len - 1) { ccn = *(const v4u*)(pr + NP + PC_CC + c0); chn = *(const v4u*)(pr + NP + PC_CH + c0); }
        float yf[8], yb[8], la0[8], la1[8], g[8];
        unpack8(*(const v4u*)(Y + (size_t)row * RW + c0), yf); unpack8(*(const v4u*)(Y + PA + (size_t)row * RW + c0), yb); unpack8(*(const v4u*)(lo + 1024 + c0), la0); unpack8(*(const v4u*)(lo + 1536 + c0), la1); unpack8(*(const v4u*)(lo + 2048 + c0), g);
        float a0[8], a1[8], ka[8], rkp[8], lg[8], lb[8];
        ld8f(PIN(I_A0) + (l * 2 + 0) * RW + c0, a0); ld8f(PIN(I_A0) + (l * 2 + 1) * RW + c0, a1); ld8f(PIN(I_KA) + l * RW + c0, ka); ld8f(PIN(I_RK) + l * RW + c0, rkp);
        ld8f(PIN(I_LNXG) + l * RW + c0, lg); ld8f(PIN(I_LNXB) + l * RW + c0, lb);
        float kv[8], rv[8], vv[8]; unpack8(kw, kv); unpack8(rw, rv); unpack8(vw, vv);
        float y[8], s = 0.f, rk = 0.f;
#pragma unroll
        for (int j = 0; j < 8; ++j) { y[j] = yf[j] + yb[j]; s += y[j]; const float av = sigm(a0[j] + la0[j]) + sigm(a1[j] + la1[j]); rk += rv[j] * kv[j] * (2.f + (av - 2.f) * ka[j]) * rkp[j]; }
        const float mu = sum8(s) * (1.f / 64.f); rk = sum8(rk); float q = 0.f;
#pragma unroll
        for (int j = 0; j < 8; ++j) { y[j] -= mu; q += y[j] * y[j]; }
        const float rstd = 1.f / sqrtf(sum8(q) * (1.f / 64.f) + GN_EPS);
        float o[8];
#pragma unroll
        for (int j = 0; j < 8; ++j) o[j] = (y[j] * rstd * lg[j] + lb[j] + rk * vv[j]) * g[j];
        float orw[8];
#pragma unroll
        for (int j = 0; j < 8; ++j) orw[j] = o[j];
        float cb[8], cc[8], ch[8], pcc[8], pch[8], ncc[8], nch[8], w0[8], w1[8], w2[8];
        unpack8(cbw, cb); unpack8(ccw, cc); unpack8(chw, ch); unpack8(ccp, pcc); unpack8(chp, pch); unpack8(ccn, ncc); unpack8(chn, nch);
        const float* cw = PIN(I_CONVW) + (size_t)l * 3 * RW + c0; ld8f(cw, w0); ld8f(cw + RW, w1); ld8f(cw + 2 * RW, w2);
#pragma unroll
        for (int j = 0; j < 8; ++j) o[j] = cb[j] * (pcc[j] * pch[j] * w0[j] + cc[j] * ch[j] * w1[j] + ncc[j] * nch[j] * w2[j]);
        float am = 0.f;
#pragma unroll
        for (int j = 0; j < 8; ++j) am = fmaxf(am, fmaxf(fabsf(orw[j]), fabsf(o[j])));
#pragma unroll
        for (int sh = 1; sh < 64; sh <<= 1) am = fmaxf(am, __shfl_xor(am, sh));
        am = fmaxf(am, 1e-30f); const float inv = 127.f / am; unsigned char* m8 = (unsigned char*)MI + (size_t)row * D + c0;
        *(v2u*)m8 = (v2u){q8pack(orw[0] * inv, orw[1] * inv, orw[2] * inv, orw[3] * inv), q8pack(orw[4] * inv, orw[5] * inv, orw[6] * inv, orw[7] * inv)};
        *(v2u*)(m8 + RW) = (v2u){q8pack(o[0] * inv, o[1] * inv, o[2] * inv, o[3] * inv), q8pack(o[4] * inv, o[5] * inv, o[6] * inv, o[7] * inv)};
        if (lane == 0) ((float*)(OWS + WS_SAM))[row] = am * (1.f / 127.f);
    }
}


template <int KS> __device__ __forceinline__ void lora_afrag(const v4u (&raw)[KS], int fn, v4u (&af)[KS]) {
#pragma unroll
    for (int s = 0; s < KS; ++s) { float v[8]; unpack8(raw[s], v);
        if (fn == 0) {
#pragma unroll
            for (int j = 0; j < 8; ++j) v[j] = 1.f - 2.f * __builtin_amdgcn_rcpf(1.f + __expf(2.f * v[j])); }
        else if (fn == 2) {
#pragma unroll
            for (int j = 0; j < 8; ++j) v[j] = __builtin_amdgcn_rcpf(1.f + __expf(-v[j])); }
        af[s] = pack8(v); }
}
template <int KS, int NT> __device__ __forceinline__ void lora_task(const bf16* P, int col0, int fn, const bf16* wt, bf16* LOg, int ct0, int rb0, int rb1, int n, int hh) {
    v4u bfr[NT][KS];
#pragma unroll
    for (int t = 0; t < NT; ++t)
#pragma unroll
        for (int s = 0; s < KS; ++s) bfr[t][s] = *(const v4u*)(wt + (size_t)(32 * (ct0 + t) + n) * (16 * KS) + 8 * hh + 16 * s);
    v4u raw[KS];
#pragma unroll
    for (int s = 0; s < KS; ++s) raw[s] = *(const v4u*)(P + (size_t)(rb0 * 32 + n) * NP + col0 + 16 * s + 8 * hh);
    for (int rb = rb0; rb < rb1; ++rb) {
        v4u af[KS]; lora_afrag<KS>(raw, fn, af);
        if (rb + 1 < rb1) {
#pragma unroll
            for (int s = 0; s < KS; ++s) raw[s] = *(const v4u*)(P + (size_t)((rb + 1) * 32 + n) * NP + col0 + 16 * s + 8 * hh); }
        int no = n, ho = hh; asm volatile("" : "+v"(no), "+v"(ho));
        bf16* out = LOg + (size_t)(rb * 32 + 4 * ho) * NLO + 32 * ct0 + no;
#pragma unroll
        for (int t = 0; t < NT; ++t) { f32x16 acc = zero16();
#pragma unroll
            for (int s = 0; s < KS; ++s) acc = mm(af[s], bfr[t][s], acc);
#pragma unroll
            for (int r = 0; r < 16; ++r) out[(size_t)((r & 3) + 8 * (r >> 2)) * NLO + 32 * t] = (bf16)f2bf(acc[r]); }
    }
}
__device__ __forceinline__ void ph_lora(const KP& p, int l, int gw, int NGW, int lane) {
    const bf16* P = (const bf16*)(OWS + WS_P); bf16* LO = (bf16*)(OWS + WS_LO); float* NRM = (float*)(OWS + WS_RKS);
    const bf16* LW = (const bf16*)(OWS + WS_LORA) + (size_t)l * LORAW_PER_LAYER; const int n = lane & 31, hh = lane >> 5;
    constexpr int RCH = 7, NRB = MROWS / 32, NCHK = (NRB + RCH - 1) / RCH;
    for (int task = gw; task < NCHK * 24; task += NGW) { const int ctk = task % 24, chunk = task / 24, rb0 = chunk * RCH, rb1 = rb0 + RCH < NRB ? rb0 + RCH : NRB;
        if (ctk < 16) { const int grp = ctk >> 2; lora_task<4, 4>(P, grp < 2 ? PC_WD + 64 * grp : PC_AD + 64 * (grp - 2), grp < 2 ? 0 : 1, LW + (size_t)grp * 512 * 64, LO + grp * 512, (ctk & 3) * 4, rb0, rb1, n, hh); }
        else lora_task<8, 2>(P, PC_GD, 2, LW + (size_t)4 * 512 * 64, LO + 4 * 512, (ctk - 16) * 2, rb0, rb1, n, hh); }
    float kkc[8]; ld8f(PIN(I_KK) + l * RW + lane * 8, kkc);
    for (int row = gw; row < MROWS; row += NGW) { const v4u kw = *(const v4u*)(P + (size_t)row * NP + PC_K + lane * 8); float kv[8]; unpack8(kw, kv); float ss = 0.f;
#pragma unroll
        for (int j = 0; j < 8; ++j) { const float t = kv[j] * kkc[j]; ss += t * t; }
        ss = sum8(ss); if ((lane & 7) == 0) NRM[row * 8 + (lane >> 3)] = 1.f / fmaxf(sqrtf(ss), 1e-12f); }
}

__device__ __forceinline__ void ph_moe_gather(const KP& p, int l, int gw, int NGW, int lane) {
    const unsigned* gcnt = (const unsigned*)(OWS + WS_CTL) + CW_GCNT + 64 * (l >> 1);
    int cnt[8], pb[9]; pb[0] = 0;
#pragma unroll
    for (int e = 0; e < 8; ++e) { cnt[e] = (int)gcnt[e]; pb[e + 1] = pb[e] + ((cnt[e] + 255) & ~255); }
    const unsigned* rowlist = (const unsigned*)(OWS + WS_ROWLIST); const float* wsel = (const float*)(OWS + WS_WSEL); float* wsort = (float*)(OWS + WS_WSORT);
    const unsigned char* H8 = OWS + WS_H8; unsigned char* HG = OWS + WS_HG; const float* sa = (const float*)(OWS + WS_SA); float* sag = (float*)(OWS + WS_SAG);
    for (int pos = gw; pos < pb[8]; pos += NGW) {
        int e = 0, base = 0, ce = cnt[0];
#pragma unroll
        for (int k = 1; k < 8; ++k) if (pos >= pb[k]) { e = k; base = pb[k]; ce = cnt[k]; }
        const int rank = pos - base; v4u a = (v4u){0u, 0u, 0u, 0u}; float w = 0.f, sc = 0.f;
        if (rank < ce) { const unsigned ent = rowlist[(size_t)e * MROWS + rank]; a = *(const v4u*)(H8 + (size_t)(ent >> 1) * D + lane * 16); w = wsel[ent]; sc = sa[ent >> 1]; }
        *(v4u*)(HG + (size_t)pos * D + lane * 16) = a;
        if (lane == 0) { wsort[pos] = w; sag[pos] = sc; }
    }
}

__device__ __forceinline__ void ph_ln(const KP& p, LAS unsigned char* lds, int l, int which, int tid, int wave, int gw, int NGW, int lane) {
    const float* modv = (const float*)(OWS + WS_MODV); _Float16* X = (_Float16*)(OWS + WS_X);
    const bf16* BR = (const bf16*)(OWS + (which == 0 ? WS_MIXO : WS_F)); const float* BP = (const float*)(OWS + (which == 0 ? WS_MIXP : WS_FP));
    const float* lg = PIN(which == 0 ? I_LN1G : I_LN2G) + l * D; const float* lb = PIN(which == 0 ? I_LN1B : I_LN2B) + l * D;
    const bool moe = (which == 0) && (l & 1); const bool last = (which == 1) && (l == DEPTH - 1); const bool moe_out = (which == 1) && (l & 1);
    LAS int* lcnt = (LAS int*)lds;
    LAS int* lsel = (LAS int*)(lds + 64);
    int nloc = 0;
    if (moe) { if (tid < 16) lcnt[tid] = 0; __syncthreads(); }
    int pbs[9]; pbs[0] = 0;
    if (moe_out) { const unsigned* gcnt = (const unsigned*)(OWS + WS_CTL) + CW_GCNT + 64 * (l >> 1);
#pragma unroll
        for (int e = 0; e < 8; ++e) pbs[e + 1] = pbs[e] + (int)((gcnt[e] + 255u) & ~255u); }
    f32x4 gt[4], g4[4], b4[4], sh[4], sc[4]; ld_row(lg, lane, g4); ld_row(lb, lane, b4);
#pragma unroll 2
    for (int it = 0; it < 9; ++it) {
        if (it == 8 && (gw >= NCTX || l == DEPTH - 1)) break;
        const int row = it < 8 ? (gw >> 9) * SEQ + (gw & 511) + 512 * it : NLAT + gw;
        const int mr = mod_row(row); const float* mv = modv + (size_t)(l * 5 + mr) * NMOD;
        if (it == 0 || it == 8) { ld_row(mv + (which == 0 ? 2048 : 5120), lane, gt);
            if (!last) { const float* mv2 = which == 0 ? mv + 3072 : modv + (size_t)((l + 1) * 5 + mr) * NMOD; ld_row(mv2, lane, sh); ld_row(mv2 + 1024, lane, sc); } }
        f32x4 x[4], br[4], t[4];
        if (l == 0 && which == 0) ld_row(row < NLAT ? PIN(I_X) + (size_t)row * D : PIN(I_CTX) + (size_t)(row - NLAT) * D, lane, x); else ld_row_h16(X + (size_t)row * D, lane, x);
        if (moe_out) { const int* ts = (const int*)(OWS + WS_TOKSEL) + row * 4; const int e0 = ts[0], r0 = ts[1], e1 = ts[2], r1 = ts[3]; int b0 = 0, b1 = 0;
#pragma unroll
            for (int k = 1; k < 8; ++k) { if (e0 >= k) b0 = pbs[k]; if (e1 >= k) b1 = pbs[k]; }
            f32x4 ba[4], bb[4]; const int q0 = b0 + r0, q1 = b1 + r1; constexpr int MM = MOE_MAIN_PANELS * 256;
            if (q0 < MM) ld_row_bf16(BR + (size_t)q0 * D, lane, ba); else ld_row_parts<4>(BP + (size_t)(q0 - MM) * D, (size_t)MOE_TAIL_ROWS * D, lane, ba);
            if (q1 < MM) ld_row_bf16(BR + (size_t)q1 * D, lane, bb); else ld_row_parts<4>(BP + (size_t)(q1 - MM) * D, (size_t)MOE_TAIL_ROWS * D, lane, bb);
#pragma unroll
            for (int j = 0; j < 4; ++j) br[j] = ba[j] + bb[j]; }
        else if (row < NLAT) ld_row_bf16(BR + (size_t)row * D, lane, br);
        else if (which == 0) ld_row_parts<2>(BP + (size_t)(row - NLAT) * D, (size_t)NCTX * D, lane, br);
        else ld_row_parts<7>(BP + (size_t)(row - NLAT) * D, (size_t)NCTX * D, lane, br);
        float s = 0.f;
#pragma unroll
        for (int j = 0; j < 4; ++j) { t[j] = DN_ALPHA * x[j] + gt[j] * br[j]; s += (t[j][0] + t[j][1]) + (t[j][2] + t[j][3]); }
        const float mean = wave_sum(s) * (1.f / D); float s2 = 0.f;
#pragma unroll
        for (int j = 0; j < 4; ++j) { t[j] = t[j] - mean; s2 += (t[j][0] * t[j][0] + t[j][1] * t[j][1]) + (t[j][2] * t[j][2] + t[j][3] * t[j][3]); }
        const float rstd = 1.f / sqrtf(wave_sum(s2) * (1.f / D) + LN_EPS);
#pragma unroll
        for (int j = 0; j < 4; ++j) x[j] = t[j] * rstd * g4[j] + b4[j];
        if (last) {
#if PROBE_DUP & (128 | 256)
            { const unsigned* cw = (const unsigned*)(OWS + WS_CTL); const float cval = 10.f * ((float)cw[20001] / 1024.f) / fmaxf((float)cw[20000], 1.f);
#pragma unroll
              for (int j = 0; j < 4; ++j) x[j] = (f32x4){cval, cval, cval, cval}; }
#endif
            if (row < NLAT) st_row(p.out + (size_t)row * D, lane, x); continue; }
        st_row_h16(X + (size_t)row * D, lane, x);
        f32x4 hh[4];
#pragma unroll
        for (int j = 0; j < 4; ++j) hh[j] = x[j] * (1.f + sc[j]) + sh[j];
        st_row_q8(OWS + WS_H8, (float*)(OWS + WS_SA), row, lane, hh);
        if (moe) {
            const float* rw = PIN(I_RTW) + (size_t)(l >> 1) * D * NE; float lgt[8];
#pragma unroll
            for (int e = 0; e < 8; ++e) lgt[e] = 0.f;
#pragma unroll
            for (int j = 0; j < 4; ++j)
#pragma unroll
                for (int i = 0; i < 4; ++i) { const f32x4* wp = (const f32x4*)(rw + (size_t)(4 * lane + 256 * j + i) * NE); const f32x4 w0 = wp[0], w1 = wp[1]; const float hv = hh[j][i];
                    lgt[0] += hv * w0[0]; lgt[1] += hv * w0[1]; lgt[2] += hv * w0[2]; lgt[3] += hv * w0[3]; lgt[4] += hv * w1[0]; lgt[5] += hv * w1[1]; lgt[6] += hv * w1[2]; lgt[7] += hv * w1[3]; }
#pragma unroll
            for (int e = 0; e < 8; ++e) lgt[e] = wave_sum(lgt[e]) + PIN(I_RTB)[(l >> 1) * NE + e];
            float v0 = lgt[0]; int i0 = 0;
#pragma unroll
            for (int e = 1; e < 8; ++e) if (lgt[e] > v0) { v0 = lgt[e]; i0 = e; }
            float v1 = -3.0e38f; int i1 = -1;
#pragma unroll
            for (int e = 0; e < 8; ++e) if (e != i0 && lgt[e] > v1) { v1 = lgt[e]; i1 = e; }
            const float w0 = 1.f / (1.f + expf(v1 - v0)), w1 = 1.f - w0;
            if (lane == 0) { const int lr0 = __hip_atomic_fetch_add(lcnt + i0, 1, __ATOMIC_RELAXED, __HIP_MEMORY_SCOPE_WORKGROUP), lr1 = __hip_atomic_fetch_add(lcnt + i1, 1, __ATOMIC_RELAXED, __HIP_MEMORY_SCOPE_WORKGROUP); const int li = nloc * NWAVES + wave;
                lsel[li * 8 + 0] = row; lsel[li * 8 + 1] = i0; lsel[li * 8 + 2] = lr0; lsel[li * 8 + 3] = i1; lsel[li * 8 + 4] = lr1;
                ((float*)(OWS + WS_WSEL))[row * 2] = w0; ((float*)(OWS + WS_WSEL))[row * 2 + 1] = w1; }
            ++nloc;
        }
    }
    if (moe) {
        __syncthreads();
        unsigned* gcnt = (unsigned*)(OWS + WS_CTL) + CW_GCNT + 64 * (l >> 1);
        if (tid < 8) lcnt[8 + tid] = (int)__hip_atomic_fetch_add(gcnt + tid, (unsigned)lcnt[tid], __ATOMIC_RELAXED, __HIP_MEMORY_SCOPE_AGENT);
        __syncthreads();
        unsigned* rowlist = (unsigned*)(OWS + WS_ROWLIST); int* toksel = (int*)(OWS + WS_TOKSEL);
        if (tid < 16 * NWAVES) { const int k = tid / NWAVES, w = tid % NWAVES; if (k < 8 || (k == 8 && (int)blockIdx.x * NWAVES + w < NCTX && l != DEPTH - 1)) { const int li = k * NWAVES + w;
            const int row = lsel[li * 8 + 0], e0 = lsel[li * 8 + 1], r0 = lcnt[8 + e0] + lsel[li * 8 + 2], e1 = lsel[li * 8 + 3], r1 = lcnt[8 + e1] + lsel[li * 8 + 4];
            rowlist[(size_t)e0 * MROWS + r0] = (unsigned)row * 2u; rowlist[(size_t)e1 * MROWS + r1] = (unsigned)row * 2u + 1u;
            toksel[row * 4 + 0] = e0; toksel[row * 4 + 1] = r0; toksel[row * 4 + 2] = e1; toksel[row * 4 + 3] = r1; } }
    }
}


#ifndef PROBE_WHICH
#define PROBE_WHICH(x, y) (x)
#endif
#if PROBE_DUP & 128
__device__ __forceinline__ void ph_check_up(const KP& p, int gw, int lane) {
    if (gw >= 64) return;
    const float* X = (const float*)(OWS + WS_X); const float* modv = (const float*)(OWS + WS_MODV); const bf16* ACT = (const bf16*)(OWS + WS_ACT);
    const int row = gw * 257, c = lane * 56 + (gw & 7), mr = mod_row(row); const float* mv = modv + (size_t)(0 * 5 + mr) * NMOD;
    const signed char* H8 = (const signed char*)(OWS + WS_H8); const signed char* W8 = (const signed char*)(OWS + WS_F13); const float* SA = (const float*)(OWS + WS_SA); const unsigned* AM = (const unsigned*)(OWS + WS_AMAX);
    const int j1 = 8 * (c >> 2) + (c & 3), j3 = j1 + 4; int ia = 0, ib = 0;
    for (int k = 0; k < D; ++k) { const int h = H8[(size_t)row * D + k]; ia += h * W8[(size_t)j1 * D + k]; ib += h * W8[(size_t)j3 * D + k]; }
    const float a = (float)ia * SA[row] * __builtin_bit_cast(float, AM[j1]) * (1.f / 127.f), b = (float)ib * SA[row] * __builtin_bit_cast(float, AM[j3]) * (1.f / 127.f);
    (void)X; (void)mv;
    const float ref = a / (1.f + expf(-a)) * b, got = bf2f(ACT[(size_t)row * DFF + c]);
    const float da = ((const float*)(OWS + WS_F))[(size_t)row * DFF + c], db = ((const float*)(OWS + WS_F))[(size_t)4096 * DFF + (size_t)row * DFF + c]; (void)got; (void)db;
    if (row < 4096 && abs(ia) > 1000) { const float ratio = 10.f * fminf(fabsf(PROBE_WHICH(da / a, db / b) - 1.f), 0.4f);
        __hip_atomic_fetch_add((unsigned*)(OWS + WS_CTL) + 20000, 1u, __ATOMIC_RELAXED, __HIP_MEMORY_SCOPE_AGENT); __hip_atomic_fetch_add((unsigned*)(OWS + WS_CTL) + 20001, (unsigned)(ratio * 1024.f), __ATOMIC_RELAXED, __HIP_MEMORY_SCOPE_AGENT); }
}
#endif

#if PROBE_DUP & 256
__device__ __forceinline__ void ph_check_mfma(const KP& p, int lane) {
    typedef int i32x4 __attribute__((ext_vector_type(4)));
    const int r = lane & 15, g = lane >> 4; unsigned aw[4], bw[4];
#pragma unroll
    for (int q = 0; q < 4; ++q) { unsigned a = 0, b = 0;
#pragma unroll
        for (int t = 0; t < 4; ++t) { const int k = 16 * g + 4 * q + t; const int av = ((r * 7 + k * 3) % 5) - 2, bv = ((r * 5 + k * 11) % 7) - 3; a |= (unsigned)(av & 255) << (8 * t); b |= (unsigned)(bv & 255) << (8 * t); }
        aw[q] = a; bw[q] = b; }
    i32x4 c = {0, 0, 0, 0};
    c = __builtin_amdgcn_mfma_i32_16x16x64_i8((i32x4){(int)aw[0], (int)aw[1], (int)aw[2], (int)aw[3]}, (i32x4){(int)bw[0], (int)bw[1], (int)bw[2], (int)bw[3]}, c, 0, 0, 0);
    bool bad = false;
#pragma unroll
    for (int reg = 0; reg < 4; ++reg) { const int i = 4 * g + reg, j = r; int e = 0;
        for (int k = 0; k < 64; ++k) e += (((i * 7 + k * 3) % 5) - 2) * (((j * 5 + k * 11) % 7) - 3);
        if (c[reg] != e) bad = true; }
    if (bad) __hip_atomic_fetch_add((unsigned*)(OWS + WS_CTL) + 20000, 1000u, __ATOMIC_RELAXED, __HIP_MEMORY_SCOPE_AGENT);
}
#endif
__global__ void __launch_bounds__(NWAVES * 64, 2) fwd_kernel(KP p) {
    extern __shared__ __attribute__((aligned(16))) unsigned char lds_raw[];
    LAS unsigned char* lds = (LAS unsigned char*)lds_raw;
    volatile LAS unsigned* MISC = (volatile LAS unsigned*)(lds + MISC_OFF);
    const int G = gridDim.x, NGW = G * NWAVES;
    for (int u = threadIdx.x; u < (LDS_BYTES - LDSCTL_OFF) / 4; u += NWAVES * 64) ((LAS unsigned*)(lds + LDSCTL_OFF))[u] = 0u;
    __syncthreads();
    unsigned* ctl = (unsigned*)(OWS + WS_CTL);
    const bool single = p.ph < 0;
    XcdBarrier bar; bar.bar = ctl + CW_BAR; bar.x = 0; bar.st = nullptr;
    if (single) bar = xcd_barrier_post(ctl + CW_BAR, MISC + 8);
    int phc = 0;
#ifndef PROBE_DUP
#define PROBE_DUP 0
#endif
#define REP(bit) for (int rep_ = 0; rep_ < ((PROBE_DUP & (bit)) ? 2 : 1); ++rep_)
#define RUN() (single || p.ph == phc)
#define FRESH() int tid = threadIdx.x; asm volatile("" : "+v"(tid)); const int lane = tid & 63, wave = __builtin_amdgcn_readfirstlane(tid >> 6), gw = blockIdx.x * NWAVES + wave; (void)lane; (void)gw
#define SEAM() do { if (single) { XcdBarrier b2_ = bar; asm volatile("" : "+s"(b2_.bar)); xcd_barrier(b2_); if (PROBE_DUP & 32) { XcdBarrier b3_ = bar; asm volatile("" : "+s"(b3_.bar)); xcd_barrier(b3_); } } ++phc; } while (0)

    REP(4) if (RUN()) { FRESH(); ph_modvec(p, lds, tid); __syncthreads(); ph_convert(p, lds, gw, NGW, wave, lane); cq_static(p, lds, 3 * CQ_IN + 3 * CQ_OUT + 2 * CQ_UP, CQ_J1, gw, NGW, wave, lane); ph_amax(p, gw, NGW, lane); }
    SEAM();
#if PROBE_DUP & 256
    if (blockIdx.x == 0 && threadIdx.x < 64) ph_check_mfma(p, threadIdx.x);
#endif
    if (RUN()) { FRESH(); ph_init_rows(p, gw, NGW, lane); cq_static(p, lds, -CQ_NEG, 3 * CQ_IN + 3 * CQ_OUT + 2 * CQ_UP, gw, NGW, wave, lane); }
    SEAM();
    for (int ll = 0; ll < DEPTH; ++ll) {
#define l (ll + opaque_zero_i())
         if (RUN()) { pg8::Gemm g{(const bf16*)(OWS + WS_H8), (const bf16*)(OWS + WS_WIN) + (size_t)l * (NP * D / 2), MROWS, NP, D / 2, D / 2}; pg8::StaticOrder S; S.init(MROWS, NP, G, (int)blockIdx.x);
            pg8::EpiBf16S8 E{(bf16*)(OWS + WS_P), NP, (const float*)(OWS + WS_SA), (const float*)(OWS + WS_AMAX) + AM_IN + l * NP}; pg8::gemm_phase<pg8::EpiBf16S8, pg8::StaticOrder, true, true, true>(lds, g, S, E); }
        SEAM();
        REP(8) if (RUN()) { FRESH(); ph_lora(p, l, gw, NGW, lane); }
        SEAM();
        REP(1) if (RUN()) { FRESH(); ph_scan1(p, l, gw, NGW, lane); }
        SEAM();
        REP(2) if (RUN()) { FRESH(); ph_scan2(p, lds, l, wave, lane); }
        SEAM();
        REP(64) if (RUN()) { FRESH(); ph_readout2(p, l, gw, NGW, lane); }
        SEAM();
         if (RUN()) {
            { pg8::Gemm g{(const bf16*)(OWS + WS_MIXIN), (const bf16*)(OWS + WS_WOUT) + (size_t)l * (D * D / 2), NLAT, D, D / 2, D / 2}; pg8::StaticOrder S; S.init(NLAT, D, G, (int)blockIdx.x);
              pg8::EpiBf16S8 E{(bf16*)(OWS + WS_MIXO), D, (const float*)(OWS + WS_SAM), (const float*)(OWS + WS_AMAX) + AM_OUT + l * D}; pg8::gemm_phase<pg8::EpiBf16S8, pg8::StaticOrder, true, true, true>(lds, g, S, E); }
            if (ll < DEPTH - 1) { pg8::Gemm g{(const bf16*)(OWS + WS_MIXIN), (const bf16*)(OWS + WS_WOUT) + (size_t)l * (D * D / 2), NCTX, D, D / 4, D / 2}; pg8::SplitOrder S{NCTX / 256, D / 256, 2, G, (int)blockIdx.x, NLAT / 256, 0, 0, 0, 0, 0, 0, 0, 0};
              pg8::EpiPartS8 E{(float*)(OWS + WS_MIXP), D, (size_t)NCTX * D, NLAT / 256, (const float*)(OWS + WS_SAM), (const float*)(OWS + WS_AMAX) + AM_OUT + l * D}; pg8::gemm_phase<pg8::EpiPartS8, pg8::SplitOrder, true, true, true>(lds, g, S, E); }
        }
        SEAM();
        for (int rep2_ = 0; rep2_ < (((PROBE_DUP & 512) && ll == 0) ? 5 : 1); ++rep2_) if (RUN()) { FRESH(); ph_ln(p, lds, l, 0, tid, wave, gw, NGW, lane); if (ll & 1) { __syncthreads(); cq_static(p, lds, (l == 1 ? CQ_J1 : CQ_END0) + 2 * CQ_SLOT_ITEMS, l == 1 ? CQ_END0 : CQ_END1, gw, NGW, wave, lane); } }
        SEAM();
        if ((l & 1) == 0) {
            const int fi = l >> 1;
             if (RUN()) { pg8::Gemm g{(const bf16*)(OWS + WS_H8), (const bf16*)(OWS + WS_F13) + (size_t)fi * DFF * D, MROWS, 2 * DFF, D / 2, D / 2}; pg8::StaticOrder S; S.init(MROWS, 2 * DFF, G, (int)blockIdx.x);
                constexpr int NOE = 0x7fffffff; pg8::EpiSwiGLU8 E{(bf16*)(OWS + WS_ACT), DFF, nullptr, (const float*)(OWS + WS_SA), (const unsigned*)(OWS + WS_AMAX) + (size_t)fi * 2 * DFF, NOE, NOE, NOE, NOE, NOE, NOE, NOE};
#if PROBE_DUP & 128
                E.dbg = (int*)(OWS + WS_F);
#endif
                pg8::gemm_phase<pg8::EpiSwiGLU8, pg8::StaticOrder, true, true, true>(lds, g, S, E); }
            SEAM();
#if PROBE_DUP & 128
            if (ll == 0) { if (RUN()) { FRESH(); ph_check_up(p, gw, lane); } SEAM(); }
#endif
             if (RUN()) {
                { pg8::Gemm g{(const bf16*)(OWS + WS_ACT), (const bf16*)(OWS + WS_F2) + (size_t)fi * D * DFF, NLAT, D, DFF, DFF}; pg8::StaticOrder S; S.init(NLAT, D, G, (int)blockIdx.x);
                  pg8::EpiBf16<0> E{(bf16*)(OWS + WS_F), D, nullptr, 0, 0, 1.f}; pg8::gemm_phase<pg8::EpiBf16<0>, pg8::StaticOrder, true, true>(lds, g, S, E); }
                { pg8::Gemm g{(const bf16*)(OWS + WS_ACT), (const bf16*)(OWS + WS_F2) + (size_t)fi * D * DFF, NCTX, D, DFF / 7, DFF}; pg8::SplitOrder S{NCTX / 256, D / 256, 7, G, (int)blockIdx.x, NLAT / 256, 0, 0, 0, 0, 0, 0, 0, 0};
                  pg8::EpiPart E{(float*)(OWS + WS_FP), D, (size_t)NCTX * D, NLAT / 256}; pg8::gemm_phase<pg8::EpiPart, pg8::SplitOrder, true, true>(lds, g, S, E); }
            }
            SEAM();
        } else {
            if (RUN()) { FRESH(); ph_moe_gather(p, l, gw, NGW, lane); }
            SEAM();
            {   const unsigned* gcnt = (const unsigned*)(OWS + WS_CTL) + CW_GCNT + 64 * (l >> 1); int pbp[9]; pbp[0] = 0;
#pragma unroll
                for (int e = 0; e < 8; ++e) pbp[e + 1] = pbp[e] + (int)((gcnt[e] + 255u) >> 8);
                const int mrows = pbp[8] * 256;
                 if (RUN()) { pg8::Gemm g{(const bf16*)(OWS + WS_HG), (const bf16*)(OWS + WS_MOEW13), mrows, 2 * DFF, D / 2, D / 2}; pg8::MoeOrder S; S.init(mrows, 2 * DFF, G, (int)blockIdx.x);
                    S.pb1 = pbp[1]; S.pb2 = pbp[2]; S.pb3 = pbp[3]; S.pb4 = pbp[4]; S.pb5 = pbp[5]; S.pb6 = pbp[6]; S.pb7 = pbp[7]; S.estride = (size_t)DFF * D;
                    pg8::EpiSwiGLU8 E{(bf16*)(OWS + WS_ACT), DFF, (const float*)(OWS + WS_WSORT), (const float*)(OWS + WS_SAG), (const unsigned*)(OWS + WS_AMAX) + (size_t)(2 + 8 * (l >> 1)) * 2 * DFF, pbp[1], pbp[2], pbp[3], pbp[4], pbp[5], pbp[6], pbp[7]};
                    pg8::gemm_phase<pg8::EpiSwiGLU8, pg8::MoeOrder, true, true, true>(lds, g, S, E); }
                SEAM();
                 if (RUN()) {
                    { pg8::Gemm g{(const bf16*)(OWS + WS_ACT), (const bf16*)(OWS + WS_MOEW2), MOE_MAIN_PANELS * 256, D, DFF, DFF}; pg8::MoeOrder S; S.init(MOE_MAIN_PANELS * 256, D, G, (int)blockIdx.x);
                      S.pb1 = pbp[1]; S.pb2 = pbp[2]; S.pb3 = pbp[3]; S.pb4 = pbp[4]; S.pb5 = pbp[5]; S.pb6 = pbp[6]; S.pb7 = pbp[7]; S.estride = (size_t)D * DFF;
                      pg8::EpiBf16<0> E{(bf16*)(OWS + WS_F), D, nullptr, 0, 0, 1.f}; pg8::gemm_phase<pg8::EpiBf16<0>, pg8::MoeOrder, true, true>(lds, g, S, E); }
                    { const int nT = pbp[8] - MOE_MAIN_PANELS;
                      pg8::Gemm g{(const bf16*)(OWS + WS_ACT), (const bf16*)(OWS + WS_MOEW2), nT * 256, D, DFF / 4, DFF}; pg8::SplitOrder S{nT, D / 256, 4, G, (int)blockIdx.x, MOE_MAIN_PANELS, pbp[1], pbp[2], pbp[3], pbp[4], pbp[5], pbp[6], pbp[7], (size_t)D * DFF};
                      pg8::EpiPart E{(float*)(OWS + WS_FP), D, (size_t)MOE_TAIL_ROWS * D, MOE_MAIN_PANELS}; pg8::gemm_phase<pg8::EpiPart, pg8::SplitOrder, true, true>(lds, g, S, E); }
                }
                SEAM();
            }
        }
        if (RUN()) { FRESH(); ph_ln(p, lds, l, 1, tid, wave, gw, NGW, lane); }
        SEAM();
    }
#undef l
#undef RUN
#undef SEAM
}

#ifndef MK_PER_PHASE
#define MK_PER_PHASE 0
#endif
extern "C" void kernel_launch(void* const* d_in, const int* in_sizes, int n_in, void* d_out, int out_size, void* d_ws, size_t ws_size, hipStream_t stream) {
    static int grid = 0;
    if (grid == 0) {
        if (n_in != N_IN || in_sizes[0] != NLAT * D || out_size != NLAT * D || ws_size < WS_NEED) { fprintf(stderr, "kernel_launch: unexpected shapes / workspace (%d inputs, ws %zu, need %zu)\n", n_in, ws_size, (size_t)WS_NEED); grid = -1; return; }
        int dev = 0, cus = 0, per_cu = 0;
        if (hipGetDevice(&dev) != hipSuccess || hipDeviceGetAttribute(&cus, hipDeviceAttributeMultiprocessorCount, dev) != hipSuccess) { grid = -1; return; }
        if (hipFuncSetAttribute((const void*)fwd_kernel, hipFuncAttributeMaxDynamicSharedMemorySize, LDS_BYTES) != hipSuccess) { fprintf(stderr, "kernel_launch: hipFuncSetAttribute failed\n"); grid = -1; return; }
        if (hipOccupancyMaxActiveBlocksPerMultiprocessor(&per_cu, (const void*)fwd_kernel, NWAVES * 64, LDS_BYTES) != hipSuccess || per_cu < 1) fprintf(stderr, "kernel_launch: occupancy query says %d\n", per_cu);
        (void)hipGetLastError();
        grid = cus;
        if (grid != 256) { fprintf(stderr, "kernel_launch: built for a 256-CU device, found %d CUs\n", cus); grid = -1; return; }
    }
    if (grid < 0) return;
    if (hipMemsetAsync((char*)d_ws + WS_CTL, 0, CTL_BYTES, stream) != hipSuccess) return;
    KP p{};
    for (int i = 0; i < N_IN; ++i) p.in[i] = (const float*)d_in[i];
    p.out = (float*)d_out; p.ws = (unsigned char*)d_ws; p.pad = 0;
#if MK_PER_PHASE
    const int nph = 2 + 2 * 11 + 2 * 13;
    for (int ph = 0; ph < nph; ++ph) { p.ph = ph; hipLaunchKernelGGL(fwd_kernel, dim3(grid), dim3(NWAVES * 64), LDS_BYTES, stream, p); }
#else
    p.ph = -1;
    hipLaunchKernelGGL(fwd_kernel, dim3(grid), dim3(NWAVES * 64), LDS_BYTES, stream, p);
#endif
}
```

```cpp
#include <hip/hip_runtime.h>
#define PROBE_DUP 0
#define CQ_SLOT_WGS 0
#define CQ_SLOT_ITEMS 3500
#define CQ_Q_IN 48
#define CQ_Q_OT 16
#define CQ_Q_UP 60
#define CQ_Q_DT 54
#include <cstdio>
#include <cstdint>
namespace pg8 {
#define PG8_LAS __attribute__((address_space(3)))
typedef unsigned short bf16_t;
typedef short bf16x8 __attribute__((ext_vector_type(8)));
typedef float f32x4 __attribute__((ext_vector_type(4)));
typedef unsigned u32x4 __attribute__((ext_vector_type(4)));
constexpr int BM = 256, BK = 64, HALF = 128, HTB = HALF * BK * 2  , STAGE_BYTES = 8 * HTB, NXCD = 8, WGM = 8;

__host__ __device__ __forceinline__ int lds_byte(int r, int c) { const int st = (r >> 4) * 2 + (c >> 5), rr = r & 15, cc = c & 31, ob = rr * 64 + cc * 2; return st * 1024 + (ob ^ (((ob >> 9) & 1) << 5)); }
__host__ __device__ __forceinline__ void stage_rc(int b, int& R, int& C) { const int st = b / 1024, sb = b % 1024, swz = sb ^ (((sb >> 9) & 1) << 5); R = (st >> 1) * 16 + swz / 64; C = (st & 1) * 32 + (swz % 64) / 2; }
__host__ __device__ __forceinline__ int perm32(int rho) { const int n = rho >> 4, i = rho & 15; return 8 * (i >> 2) + 4 * n + (i & 3); }

struct Unit { int pm, pn, ks; };
struct Gemm { const bf16_t* A; const bf16_t* Bt; int M, N, K, ld; };

struct StaticOrder {
    int nM, nN, nwg, G, c;
    __host__ __device__ void init(int M, int N, int G_, int c_) { nM = M / BM; nN = N / BM; nwg = nM * nN; G = G_; c = c_; }
    __host__ __device__ bool next(int i, Unit& u) const {
        const long L = (long)i * G + c; if (L >= nwg) return false;
        int wgid = (int)L; { const int q = nwg / NXCD, r = nwg % NXCD, xcd = wgid % NXCD, off = wgid / NXCD; wgid = (xcd < r ? xcd * (q + 1) : r * (q + 1) + (xcd - r) * q) + off; }
        const int nig = WGM * nN, gid = wgid / nig, fm = gid * WGM, gsz = (nM - fm) < WGM ? (nM - fm) : WGM;
        u.pm = fm + ((wgid % nig) % gsz); u.pn = (wgid % nig) / gsz; u.ks = 0; return true;
    }
    __device__ __forceinline__ const char* abase(const Gemm& g, const Unit& u, size_t tstep) const { return (const char*)g.A + (size_t)u.pm * tstep; }
    __device__ __forceinline__ const char* bbase(const Gemm& g, const Unit& u, size_t tstep) const { return (const char*)g.Bt + (size_t)u.pn * tstep; }
    __device__ __forceinline__ void a_ready(const Unit&) const {}
    __device__ __forceinline__ void done(const Unit&) const {}
};

__device__ __forceinline__ unsigned cvt_pk_bf16(float lo, float hi) { unsigned r; asm volatile("v_cvt_pk_bf16_f32 %0, %1, %2" : "=v"(r) : "v"(lo), "v"(hi)); return r; }
typedef float f32x2 __attribute__((ext_vector_type(2)));
__device__ __forceinline__ f32x2 gelu_pk(f32x2 v) {
    const f32x2 av = __builtin_elementwise_abs(v), d = av * 0.2316418882f + 1.0f;
    f32x2 t; t.x = __builtin_amdgcn_rcpf(d.x); t.y = __builtin_amdgcn_rcpf(d.y);
    f32x2 q = t * 0.5307027145f + (-0.7265760135f); q = q * t + 0.7107068705f; q = q * t + (-0.142248368f); q = q * t + 0.127414796f; q = q * t;
    const f32x2 s = (v * v) * (-0.72134752044f);
    f32x2 e; e.x = __builtin_amdgcn_exp2f(s.x); e.y = __builtin_amdgcn_exp2f(s.y);
    const f32x2 m = v * (q * e), r = v - m;
    f32x2 o; o.x = v.x < 0.f ? m.x : r.x; o.y = v.y < 0.f ? m.y : r.y; return o;
}

template <int ACT  > struct EpiBf16 {
    static constexpr bool PERM = true, AFTER_DRAIN = false; static_assert(ACT == 0 || ACT == 1, "EpiBf16: ACT is 0 (none) or 1 (gelu_pk)");
    bf16_t* O; int ldc; const float* bias; int split_cols; size_t split_stride; float scale0;
    __device__ __forceinline__ void operator()(const f32x4 (&acc)[2][2][4][2], const Unit& u, int wr, int wc, int fr, int fq) const {
        asm volatile("" : "+v"(fr), "+v"(fq));
        const int row0 = u.pm * BM + wr * 64 + fr; int colt = u.pn * BM; bf16_t* base = O;
        float sc = 1.f; if (split_cols) { const int t = colt / split_cols; base += (size_t)t * split_stride; colt -= t * split_cols; if (t == 0) sc = scale0; }
        const int col0 = colt + wc * 32 + 8 * fq, bcol0 = u.pn * BM + wc * 32 + 8 * fq;
        f32x4 bv[2][2];
#pragma unroll
        for (int bj = 0; bj < 2; ++bj)
#pragma unroll
            for (int n = 0; n < 2; ++n) bv[bj][n] = bias ? *(const f32x4*)(bias + bcol0 + bj * HALF + 4 * n) : (f32x4){0.f, 0.f, 0.f, 0.f};
#pragma unroll
        for (int ai = 0; ai < 2; ++ai)
#pragma unroll
            for (int m = 0; m < 4; ++m) { bf16_t* rowp = base + (size_t)(row0 + ai * HALF + m * 16) * ldc + col0;
#pragma unroll
                for (int bj = 0; bj < 2; ++bj) { f32x4 v0 = acc[ai][bj][m][0] + bv[bj][0], v1 = acc[ai][bj][m][1] + bv[bj][1];
                    if (ACT == 1) { f32x2 a = gelu_pk((f32x2){v0[0], v0[1]}), b = gelu_pk((f32x2){v0[2], v0[3]}), c = gelu_pk((f32x2){v1[0], v1[1]}), d = gelu_pk((f32x2){v1[2], v1[3]});
                        v0 = (f32x4){a.x, a.y, b.x, b.y}; v1 = (f32x4){c.x, c.y, d.x, d.y}; }
                    v0 = v0 * sc; v1 = v1 * sc; u32x4 w; w.x = cvt_pk_bf16(v0[0], v0[1]); w.y = cvt_pk_bf16(v0[2], v0[3]); w.z = cvt_pk_bf16(v1[0], v1[1]); w.w = cvt_pk_bf16(v1[2], v1[3]);
                    *(u32x4*)(rowp + bj * HALF) = w; } }
    }
};
typedef int i32x4 __attribute__((ext_vector_type(4)));
template <bool I8> __device__ __forceinline__ f32x4 mma16(bf16x8 b, bf16x8 a, f32x4 c) { return __builtin_amdgcn_mfma_f32_16x16x32_bf16(b, a, c, 0, 0, 0); }
template <bool I8> __device__ __forceinline__ i32x4 mma16(bf16x8 b, bf16x8 a, i32x4 c) { return __builtin_amdgcn_mfma_i32_16x16x64_i8(__builtin_bit_cast(i32x4, b), __builtin_bit_cast(i32x4, a), c, 0, 0, 0); }
struct EpiF32 {
    static constexpr bool PERM = false, AFTER_DRAIN = false;
    float* C; int ldc; int accum;
    __device__ __forceinline__ void operator()(const f32x4 (&acc)[2][2][4][2], const Unit& u, int wr, int wc, int fr, int fq) const {
        asm volatile("" : "+v"(fr), "+v"(fq));
        const int row0 = u.pm * BM + wr * 64 + fr, col0 = u.pn * BM + wc * 32 + 4 * fq;
#pragma unroll
        for (int ai = 0; ai < 2; ++ai)
#pragma unroll
            for (int m = 0; m < 4; ++m) { float* rowp = C + (size_t)(row0 + ai * HALF + m * 16) * ldc + col0;
#pragma unroll
                for (int bj = 0; bj < 2; ++bj)
#pragma unroll
                    for (int n = 0; n < 2; ++n) { f32x4 v = acc[ai][bj][m][n]; if (accum) v += *(const f32x4*)(rowp + bj * HALF + n * 16); *(f32x4*)(rowp + bj * HALF + n * 16) = v; } }
    }
};
struct EpiSwiGLU {
    static constexpr bool PERM = true, AFTER_DRAIN = false;
    bf16_t* O; int ldo; const float* rowscale; int rs_stride;
    __device__ __forceinline__ void operator()(const f32x4 (&acc)[2][2][4][2], const Unit& u, int wr, int wc, int fr, int fq) const {
        asm volatile("" : "+v"(fr), "+v"(fq));
        typedef unsigned u32x2v __attribute__((ext_vector_type(2)));
        const int row0 = u.pm * BM + wr * 64 + fr; const int ch0 = (u.pn * BM + wc * 32 + 8 * fq) >> 1;
#pragma unroll
        for (int ai = 0; ai < 2; ++ai)
#pragma unroll
            for (int m = 0; m < 4; ++m) { const int row = row0 + ai * HALF + m * 16; bf16_t* rowp = O + (size_t)row * ldo + ch0;
                const float rs = rowscale ? rowscale[(size_t)row * rs_stride] : 1.f;
#pragma unroll
                for (int bj = 0; bj < 2; ++bj) { const f32x4 a = acc[ai][bj][m][0], b = acc[ai][bj][m][1]; f32x4 o;
#pragma unroll
                    for (int i = 0; i < 4; ++i) o[i] = a[i] * __builtin_amdgcn_rcpf(1.f + __expf(-a[i])) * b[i] * rs;
                    u32x2v w; w.x = cvt_pk_bf16(o[0], o[1]); w.y = cvt_pk_bf16(o[2], o[3]);
                    *(u32x2v*)(rowp + bj * (HALF / 2)) = w; } }
    }
};

struct MoeOrder : StaticOrder {
    int pb1, pb2, pb3, pb4, pb5, pb6, pb7; size_t estride;
    __device__ __forceinline__ const char* bbase(const Gemm& g, const Unit& u, size_t tstep) const {
        const int e = (u.pm >= pb1) + (u.pm >= pb2) + (u.pm >= pb3) + (u.pm >= pb4) + (u.pm >= pb5) + (u.pm >= pb6) + (u.pm >= pb7);
        return (const char*)(g.Bt + (size_t)e * estride) + (size_t)u.pn * tstep; }
};
struct SplitOrder {
    int nM, nN, S, G, c, pm0; int pb1, pb2, pb3, pb4, pb5, pb6, pb7; size_t estride;
    __device__ __forceinline__ bool next(int i, Unit& u) const { const int L = i * G + c; if (L >= nM * nN * S) return false; u.ks = L % S; const int t = L / S; u.pn = t % nN; u.pm = pm0 + t / nN; return true; }
    __device__ __forceinline__ const char* abase(const Gemm& g, const Unit& u, size_t tstep) const { return (const char*)g.A + (size_t)u.pm * tstep + (size_t)u.ks * g.K * 2; }
    __device__ __forceinline__ const char* bbase(const Gemm& g, const Unit& u, size_t tstep) const {
        const int e = estride ? (u.pm >= pb1) + (u.pm >= pb2) + (u.pm >= pb3) + (u.pm >= pb4) + (u.pm >= pb5) + (u.pm >= pb6) + (u.pm >= pb7) : 0;
        return (const char*)(g.Bt + (size_t)e * estride) + (size_t)u.pn * tstep + (size_t)u.ks * g.K * 2; }
    __device__ __forceinline__ void a_ready(const Unit&) const {}
    __device__ __forceinline__ void done(const Unit&) const {}
};
struct EpiPart {
    static constexpr bool PERM = false, AFTER_DRAIN = false;
    float* C; int ldc; size_t pstride; int pm0;
    __device__ __forceinline__ void operator()(const f32x4 (&acc)[2][2][4][2], const Unit& u, int wr, int wc, int fr, int fq) const {
        asm volatile("" : "+v"(fr), "+v"(fq));
        const int row0 = (u.pm - pm0) * BM + wr * 64 + fr, col0 = u.pn * BM + wc * 32 + 4 * fq; float* base = C + (size_t)u.ks * pstride;
#pragma unroll
        for (int ai = 0; ai < 2; ++ai)
#pragma unroll
            for (int m = 0; m < 4; ++m) { float* rowp = base + (size_t)(row0 + ai * HALF + m * 16) * ldc + col0;
#pragma unroll
                for (int bj = 0; bj < 2; ++bj)
#pragma unroll
                    for (int n = 0; n < 2; ++n) *(f32x4*)(rowp + bj * HALF + n * 16) = acc[ai][bj][m][n]; }
    }
};

struct EpiSwiGLU8 {
    static constexpr bool PERM = true, AFTER_DRAIN = false;
    bf16_t* O; int ldo; const float* rowscale; const float* sa; const unsigned* amax; int pb1, pb2, pb3, pb4, pb5, pb6, pb7;
    __device__ __forceinline__ void operator()(const i32x4 (&acc)[2][2][4][2], const Unit& u, int wr, int wc, int fr, int fq) const {
        typedef unsigned u32x2v __attribute__((ext_vector_type(2))); typedef unsigned u32x4v __attribute__((ext_vector_type(4)));
        asm volatile("" : "+v"(fr), "+v"(fq));
        const int row0 = u.pm * BM + wr * 64 + fr; const int cb0 = u.pn * BM + wc * 32 + 8 * fq; const int ch0 = cb0 >> 1;
        const int e = (u.pm >= pb1) + (u.pm >= pb2) + (u.pm >= pb3) + (u.pm >= pb4) + (u.pm >= pb5) + (u.pm >= pb6) + (u.pm >= pb7);
        const unsigned* am = amax + (size_t)e * 2 * 3584 + cb0;
#pragma unroll
        for (int bj = 0; bj < 2; ++bj) {
            const float* amf = (const float*)am + bj * HALF;
            const f32x4 sb0 = *(const f32x4*)amf * (1.f / 127.f), sb1 = *(const f32x4*)(amf + 4) * (1.f / 127.f);
#pragma unroll
            for (int ai = 0; ai < 2; ++ai)
#pragma unroll
                for (int m = 0; m < 4; ++m) { const int row = row0 + ai * HALF + m * 16; bf16_t* rowp = O + (size_t)row * ldo + ch0 + bj * (HALF / 2);
                    const float sr = sa[row], rs = rowscale ? rowscale[row] : 1.f; f32x4 o;
#pragma unroll
                    for (int i = 0; i < 4; ++i) { const float a = (float)acc[ai][bj][m][0][i] * sr * sb0[i], b = (float)acc[ai][bj][m][1][i] * sr * sb1[i];
                        o[i] = a * __builtin_amdgcn_rcpf(1.f + __expf(-a)) * b * rs; }
                    u32x2v w; w.x = cvt_pk_bf16(o[0], o[1]); w.y = cvt_pk_bf16(o[2], o[3]);
                    *(u32x2v*)rowp = w;
#if PROBE_DUP & 128
                    if (dbg && row < 4096) { f32x4 av, bv;
#pragma unroll
                        for (int i = 0; i < 4; ++i) { av[i] = (float)acc[ai][bj][m][0][i] * sr * sb0[i]; bv[i] = (float)acc[ai][bj][m][1][i] * sr * sb1[i]; }
                        *(f32x4*)((float*)dbg + (size_t)row * ldo + (rowp - (O + (size_t)row * ldo))) = av; *(f32x4*)((float*)dbg + (size_t)4096 * ldo + (size_t)row * ldo + (rowp - (O + (size_t)row * ldo))) = bv; }
#endif
                    } }
    }
#if PROBE_DUP & 128
    int* dbg = nullptr;
#endif
};

struct EpiBf16S8 {
    static constexpr bool PERM = true, AFTER_DRAIN = false;
    bf16_t* O; int ldc; const float* sa; const float* amax;
    __device__ __forceinline__ void operator()(const i32x4 (&acc)[2][2][4][2], const Unit& u, int wr, int wc, int fr, int fq) const {
        asm volatile("" : "+v"(fr), "+v"(fq));
        const int row0 = u.pm * BM + wr * 64 + fr, col0 = u.pn * BM + wc * 32 + 8 * fq;
#pragma unroll
        for (int bj = 0; bj < 2; ++bj) { const f32x4 s0 = *(const f32x4*)(amax + col0 + bj * HALF) * (1.f / 127.f), s1 = *(const f32x4*)(amax + col0 + bj * HALF + 4) * (1.f / 127.f);
#pragma unroll
            for (int ai = 0; ai < 2; ++ai)
#pragma unroll
                for (int m = 0; m < 4; ++m) { const int row = row0 + ai * HALF + m * 16; const float sr = sa[row]; f32x4 v0, v1;
#pragma unroll
                    for (int i = 0; i < 4; ++i) { v0[i] = (float)acc[ai][bj][m][0][i] * sr * s0[i]; v1[i] = (float)acc[ai][bj][m][1][i] * sr * s1[i]; }
                    u32x4 w; w.x = cvt_pk_bf16(v0[0], v0[1]); w.y = cvt_pk_bf16(v0[2], v0[3]); w.z = cvt_pk_bf16(v1[0], v1[1]); w.w = cvt_pk_bf16(v1[2], v1[3]);
                    *(u32x4*)(O + (size_t)row * ldc + col0 + bj * HALF) = w; } }
    }
};
struct EpiPartS8 {
    static constexpr bool PERM = false, AFTER_DRAIN = false;
    float* C; int ldc; size_t pstride; int pm0; const float* sa; const float* amax;
    __device__ __forceinline__ void operator()(const i32x4 (&acc)[2][2][4][2], const Unit& u, int wr, int wc, int fr, int fq) const {
        asm volatile("" : "+v"(fr), "+v"(fq));
        const int row0 = (u.pm - pm0) * BM + wr * 64 + fr, col0 = u.pn * BM + wc * 32 + 4 * fq; float* base = C + (size_t)u.ks * pstride;
#pragma unroll
        for (int bj = 0; bj < 2; ++bj)
#pragma unroll
            for (int n = 0; n < 2; ++n) { const f32x4 sc = *(const f32x4*)(amax + col0 + bj * HALF + n * 16) * (1.f / 127.f);
#pragma unroll
                for (int ai = 0; ai < 2; ++ai)
#pragma unroll
                    for (int m = 0; m < 4; ++m) { const int rl = row0 + ai * HALF + m * 16; const float sr = sa[rl + pm0 * BM]; f32x4 v;
#pragma unroll
                        for (int i = 0; i < 4; ++i) v[i] = (float)acc[ai][bj][m][n][i] * sr * sc[i];
                        *(f32x4*)(base + (size_t)rl * ldc + col0 + bj * HALF + n * 16) = v; } }
    }
};
template <bool I8> struct AccSel { typedef f32x4 type; }; template <> struct AccSel<true> { typedef i32x4 type; };
template <class Epi, class Sched, bool ALIGN_EPI = false, bool SP2 = false, bool I8 = false>
__device__ __forceinline__ void gemm_phase(PG8_LAS unsigned char* lds, const Gemm g, const Sched& S, const Epi& E) {
    int tid_o = threadIdx.x; asm volatile("" : "+v"(tid_o));
    const int tid = tid_o, wid = __builtin_amdgcn_readfirstlane(tid >> 6), lane = tid & 63, wr = wid >> 2, wc = wid & 3, fr = lane & 15, fq = lane >> 4;
    const int K = g.K, nt = K / BK;
    unsigned voffA[2], voffB[2];
#pragma unroll
    for (int i = 0; i < 2; ++i) { int R, C; stage_rc(tid * 16 + i * 8192, R, C); const int Rb = Epi::PERM ? ((R & ~31) + perm32(R & 31)) : R;
        voffA[i] = (unsigned)(R * g.ld + C) * 2u; voffB[i] = (unsigned)(Rb * g.ld + C) * 2u; }
    const size_t kstep = (size_t)(BK * 2);
    const size_t hstep = (size_t)HALF * g.ld * 2;
    const size_t tstep = 2 * hstep;
    const unsigned ldsw = (unsigned)wid * 1024u;
    const int aoff = lds_byte(wr * 64 + fr, fq * 8), boff = lds_byte(wc * 32 + fr, fq * 8);
#define PG8_SA(b, h) (((b) * 2 + (h)) * HTB)
#define PG8_SB(b, h) ((4 + (b) * 2 + (h)) * HTB)
#define PG8_STAGE(bufoff, gbase, voff) do { _Pragma("unroll") for (int _i = 0; _i < 2; ++_i) \
        __builtin_amdgcn_global_load_lds((const unsigned*)((const char*)(gbase) + (voff)[_i]), (PG8_LAS unsigned*)(lds + (bufoff) + ldsw + _i * 8192), 16, 0, 0); } while (0)
#define PG8_LDA(dst, b, h) do { _Pragma("unroll") for (int m = 0; m < 4; ++m) _Pragma("unroll") for (int k = 0; k < 2; ++k) dst[m][k] = *(const PG8_LAS bf16x8*)(lds + PG8_SA(b, h) + aoff + m * 2048 + k * 1024); } while (0)
#define PG8_LDB(dst, b, h) do { _Pragma("unroll") for (int n = 0; n < 2; ++n) _Pragma("unroll") for (int k = 0; k < 2; ++k) dst[n][k] = *(const PG8_LAS bf16x8*)(lds + PG8_SB(b, h) + boff + n * 2048 + k * 1024); } while (0)
#define PG8_MMA(ai, bj, At, Bt) do { __builtin_amdgcn_s_setprio(1); _Pragma("unroll") for (int k = 0; k < 2; ++k) _Pragma("unroll") for (int m = 0; m < 4; ++m) _Pragma("unroll") for (int n = 0; n < 2; ++n) \
        acc[ai][bj][m][n] = mma16<I8>(Bt[n][k], At[m][k], acc[ai][bj][m][n]); __builtin_amdgcn_s_setprio(0); } while (0)
#define PG8_WAIT_V(n) asm volatile("s_waitcnt vmcnt(" #n ")" ::: "memory")
#define PG8_WAIT_L(n) asm volatile("s_waitcnt lgkmcnt(" #n ")" ::: "memory")
#define PG8_BAR __builtin_amdgcn_s_barrier()
#define PG8_SCHED __builtin_amdgcn_sched_barrier(0)
    Unit cur, nxt; int ui = 0;
    if (!S.next(0, cur)) return;
    typedef typename AccSel<I8>::type AccT; AccT acc[2][2][4][2];
#pragma unroll
    for (int a = 0; a < 2; ++a)
#pragma unroll
        for (int b = 0; b < 2; ++b)
#pragma unroll
            for (int m = 0; m < 4; ++m)
#pragma unroll
                for (int n = 0; n < 2; ++n) acc[a][b][m][n] = (AccT)(0);
    bf16x8 At[4][2], B0[2][2], B1[2][2];
    const char* cA = S.abase(g, cur, tstep); const char* cB = S.bbase(g, cur, tstep);
    S.a_ready(cur);
    if constexpr (SP2) {
        PG8_STAGE(PG8_SB(0, 0), cB, voffB); PG8_STAGE(PG8_SB(0, 1), cB + hstep, voffB); PG8_STAGE(PG8_SA(0, 0), cA, voffA); PG8_STAGE(PG8_SA(0, 1), cA + hstep, voffA);
        if (wr == 1) PG8_BAR;
        PG8_WAIT_V(2); PG8_BAR;
        PG8_STAGE(PG8_SB(1, 0), cB + kstep, voffB); PG8_STAGE(PG8_SA(1, 0), cA + kstep, voffA); PG8_STAGE(PG8_SB(1, 1), cB + hstep + kstep, voffB);
        PG8_WAIT_V(6); PG8_BAR;
    } else {
        PG8_STAGE(PG8_SB(0, 0), cB, voffB); PG8_STAGE(PG8_SA(0, 0), cA, voffA); PG8_STAGE(PG8_SB(0, 1), cB + hstep, voffB); PG8_STAGE(PG8_SA(0, 1), cA + hstep, voffA);
        if (wr == 1) PG8_BAR;
        PG8_WAIT_V(4); PG8_BAR;
        PG8_STAGE(PG8_SB(1, 0), cB + kstep, voffB); PG8_STAGE(PG8_SA(1, 0), cA + kstep, voffA); PG8_STAGE(PG8_SB(1, 1), cB + hstep + kstep, voffB);
        PG8_WAIT_V(6); PG8_BAR;
    }
    for (;;) {
        const bool has_next = S.next(ui + 1, nxt);
        const char* nA = has_next ? S.abase(g, nxt, tstep) : cA; const char* nB = has_next ? S.bbase(g, nxt, tstep) : cB;
        for (int t = 0; t < nt; t += 2) {
            const bool last = (t == nt - 2);
            const char* a1 = cA + (size_t)(t + 1) * kstep;
            const char* a2 = last ? nA : cA + (size_t)(t + 2) * kstep; const char* b2 = last ? nB : cB + (size_t)(t + 2) * kstep;
            const char* a3 = a2 + kstep; const char* b3 = b2 + kstep;
            if (last && has_next) S.a_ready(nxt);
            if constexpr (SP2) {
            PG8_LDB(B0, 0, 0); PG8_LDB(B1, 0, 1); PG8_SCHED; PG8_LDA(At, 0, 0); PG8_STAGE(PG8_SA(1, 1), a1 + hstep, voffA);
            PG8_WAIT_V(8); PG8_WAIT_L(0); PG8_BAR; PG8_MMA(0, 0, At, B0); PG8_MMA(0, 1, At, B1); PG8_BAR; PG8_SCHED;
            PG8_LDA(At, 0, 1); PG8_STAGE(PG8_SB(0, 0), b2, voffB); PG8_STAGE(PG8_SB(0, 1), b2 + hstep, voffB); PG8_STAGE(PG8_SA(0, 0), a2, voffA);
            PG8_WAIT_V(8); PG8_WAIT_L(0); PG8_BAR; PG8_MMA(1, 0, At, B0); PG8_MMA(1, 1, At, B1); PG8_BAR; PG8_SCHED;
            PG8_LDB(B0, 1, 0); PG8_LDB(B1, 1, 1); PG8_SCHED; PG8_LDA(At, 1, 0); PG8_STAGE(PG8_SA(0, 1), a2 + hstep, voffA);
            PG8_WAIT_V(8); PG8_WAIT_L(0); PG8_BAR; PG8_MMA(0, 0, At, B0); PG8_MMA(0, 1, At, B1); PG8_BAR; PG8_SCHED;
            PG8_LDA(At, 1, 1); PG8_STAGE(PG8_SB(1, 0), b3, voffB); PG8_STAGE(PG8_SB(1, 1), b3 + hstep, voffB); PG8_STAGE(PG8_SA(1, 0), a3, voffA);
            PG8_WAIT_V(8); PG8_WAIT_L(0); PG8_BAR; PG8_MMA(1, 0, At, B0); PG8_MMA(1, 1, At, B1); PG8_BAR; PG8_SCHED;
            } else {
            PG8_LDB(B0, 0, 0); PG8_SCHED; PG8_LDA(At, 0, 0); PG8_STAGE(PG8_SA(1, 1), a1 + hstep, voffA);
            PG8_WAIT_L(8); PG8_BAR; PG8_WAIT_L(0); PG8_MMA(0, 0, At, B0); PG8_BAR; PG8_SCHED;
            PG8_LDB(B1, 0, 1); PG8_STAGE(PG8_SB(0, 0), b2, voffB);
            PG8_BAR; PG8_WAIT_L(0); PG8_MMA(0, 1, At, B1); PG8_BAR;
            PG8_LDA(At, 0, 1); PG8_STAGE(PG8_SA(0, 0), a2, voffA);
            PG8_BAR; PG8_WAIT_L(0); PG8_MMA(1, 0, At, B0); PG8_BAR; PG8_SCHED;
            PG8_STAGE(PG8_SB(0, 1), b2 + hstep, voffB);
            PG8_WAIT_V(6); PG8_BAR; PG8_MMA(1, 1, At, B1); PG8_BAR;
            PG8_LDB(B0, 1, 0); PG8_SCHED; PG8_LDA(At, 1, 0); PG8_STAGE(PG8_SA(0, 1), a2 + hstep, voffA);
            PG8_WAIT_L(8); PG8_BAR; PG8_WAIT_L(0); PG8_MMA(0, 0, At, B0); PG8_BAR; PG8_SCHED;
            PG8_LDB(B1, 1, 1); PG8_STAGE(PG8_SB(1, 0), b3, voffB);
            PG8_BAR; PG8_WAIT_L(0); PG8_MMA(0, 1, At, B1); PG8_BAR;
            PG8_LDA(At, 1, 1); PG8_STAGE(PG8_SA(1, 0), a3, voffA);
            PG8_BAR; PG8_WAIT_L(0); PG8_MMA(1, 0, At, B0); PG8_BAR; PG8_SCHED;
            PG8_STAGE(PG8_SB(1, 1), b3 + hstep, voffB);
            PG8_WAIT_V(6); PG8_BAR; PG8_MMA(1, 1, At, B1); PG8_BAR;
            }
        }
        if constexpr (ALIGN_EPI) { if (wr == 0) PG8_BAR; }
        if constexpr (!Epi::AFTER_DRAIN) { E(acc, cur, wr, wc, fr, fq); S.done(cur); }
        if (!has_next) break;
#pragma unroll
        for (int a = 0; a < 2; ++a)
#pragma unroll
            for (int b = 0; b < 2; ++b)
#pragma unroll
                for (int m = 0; m < 4; ++m)
#pragma unroll
                    for (int n = 0; n < 2; ++n) acc[a][b][m][n] = (AccT)(0);
        cur = nxt; cA = nA; cB = nB; ++ui;
        if constexpr (ALIGN_EPI) { if (wr == 1) PG8_BAR; }
    }
    PG8_WAIT_V(0);
    if constexpr (!ALIGN_EPI) { if (wr == 0) PG8_BAR; }
    PG8_BAR;
    if constexpr (Epi::AFTER_DRAIN) { E.fused(acc, cur, wr, wc, fr, fq, lds, wid, lane); S.done(cur); }
#undef PG8_SA
#undef PG8_SB
#undef PG8_STAGE
#undef PG8_LDA
#undef PG8_LDB
#undef PG8_MMA
#undef PG8_WAIT_V
#undef PG8_WAIT_L
#undef PG8_BAR
#undef PG8_SCHED
}
}

constexpr int NWAVES = 8;
constexpr int D = 1024, NB = 4, SEQ = 4096, CTXL = 256, NLAT = NB * SEQ, NCTX = NB * CTXL, MROWS = NLAT + NCTX;
constexpr int DEPTH = 4, RW = 512, NH = 8, HS = 64, DFF = 3584, NE = 8, NPROJ = 3456, NP = 3584, NLO = 2560, KLA = 512, NMOD = 6144;
constexpr int PC_R = 0, PC_K = 512, PC_V = 1024, PC_CB = 1536, PC_CC = 2048, PC_CH = 2560, PC_WD = 3072, PC_AD = 3200, PC_GD = 3328;
constexpr float LN_EPS = 1e-5f, GN_EPS = 64e-5f, DN_ALPHA = 1.681792830507429f;
enum { I_X = 0, I_C, I_CTX, I_CCTX, I_WMOD, I_BMOD, I_WIN, I_W0, I_W2, I_A0, I_A2, I_KK, I_KA, I_RK, I_G2, I_LNXG, I_LNXB, I_CONVW, I_WOUT, I_LN1G, I_LN1B, I_LN2G, I_LN2B,
       I_FW1, I_FW3, I_FW2, I_RTW, I_RTB, I_MW1, I_MW3, I_MW2, N_IN };

constexpr size_t MiB = 1u << 20;
constexpr size_t WS_CTL = 0, CTL_BYTES = 3 * MiB;
constexpr size_t WS_MODV = 1 * MiB;
constexpr size_t WS_AMAX = 2 * MiB;
constexpr size_t WS_RKS = 3 * MiB;
constexpr size_t WS_WIN = 4 * MiB;
constexpr size_t WS_WOUT = WS_WIN + 28 * MiB;
constexpr size_t WS_LORA = WS_WOUT + 8 * MiB;
constexpr size_t WS_F13 = WS_LORA + 10 * MiB;
constexpr size_t WS_F2 = WS_F13 + 28 * MiB;
constexpr size_t WS_X = WS_F2 + 14 * MiB;
constexpr size_t WS_H = WS_X + 68 * MiB;
constexpr size_t WS_MOES = WS_H + 34 * MiB;
constexpr size_t WS_ROWLIST = WS_MOES;
constexpr size_t WS_TOKSEL = WS_MOES + 640 * 1024;
constexpr size_t WS_WSEL = WS_TOKSEL + 320 * 1024;
constexpr size_t WS_WSORT = WS_WSEL + 192 * 1024;
constexpr size_t WS_MOEW13 = WS_MOES + 2 * MiB;
constexpr size_t WS_MOEW2 = WS_MOEW13 + 112 * MiB;
constexpr size_t WS_H8 = WS_MOEW13 + 56 * MiB;
constexpr size_t WS_SA = WS_H8 + 17 * MiB;
constexpr size_t WS_SAM = WS_SA + 512 * 1024;
constexpr size_t WS_SAG = WS_SA + 1 * MiB;
constexpr size_t WS_SCR = WS_MOEW2 + 56 * MiB;
constexpr size_t WS_P = WS_SCR;
constexpr size_t WS_LO = WS_P + 119 * MiB;
constexpr size_t WS_PREP = WS_LO + 170 * MiB;
constexpr size_t WS_Y = WS_PREP + 213 * MiB;
constexpr size_t WS_MIXIN = WS_Y + 68 * MiB;
constexpr size_t WS_CH = WS_PREP;
constexpr size_t WS_MIXO = WS_PREP;
constexpr size_t WS_MIXP = WS_PREP + 34 * MiB;
constexpr size_t WS_END_MIXER = WS_MIXIN + 34 * MiB;
constexpr size_t WS_HG = WS_SCR;
constexpr size_t WS_ACT = WS_HG + 72 * MiB;
constexpr size_t WS_F = WS_ACT + 252 * MiB;
constexpr size_t WS_FP = WS_F + 72 * MiB;
constexpr size_t WS_END_FFN = WS_FP + 64 * MiB;
constexpr size_t WS_NEED = WS_END_MIXER > WS_END_FFN ? WS_END_MIXER : WS_END_FFN;
static_assert((size_t)MROWS * NP * 2 <= 119 * MiB && (size_t)MROWS * NLO * 4 <= 170 * MiB && (size_t)8704 * 25600 <= 213 * MiB && (size_t)MROWS * D * 4 <= 68 * MiB && WS_NEED <= 990 * MiB, "ws map");
constexpr int MOE_MAIN_PANELS = 128, MOE_TAIL_ROWS = 4096;
constexpr int MOE_ROWS = 36864;
constexpr int AM_IN = 18 * 2 * DFF, AM_OUT = AM_IN + DEPTH * NP;
constexpr int LORAW_PER_LAYER = 4 * 512 * 64 + 512 * 128;
constexpr int CW_BAR = 4096, CW_GCNT = 8192, CW_CQ = 12288, CW_SDONE = 12544;

constexpr int RING_BYTES = 131072, LDSCTL_OFF = RING_BYTES, MISC_OFF = LDSCTL_OFF + 320, LDS_BYTES = 147456;

typedef unsigned short bf16;
typedef unsigned v4u __attribute__((ext_vector_type(4)));
typedef unsigned v2u __attribute__((ext_vector_type(2)));
typedef float f32x4 __attribute__((ext_vector_type(4)));
#define LAS __attribute__((address_space(3)))
#define LDS_WAIT() asm volatile("s_waitcnt lgkmcnt(0)" ::: "memory")
__device__ __forceinline__ unsigned f2bf(float f) { unsigned u = __builtin_bit_cast(unsigned, f); return (u + 0x7fffu + ((u >> 16) & 1u)) >> 16; }
__device__ __forceinline__ unsigned pk2(float lo, float hi) { return f2bf(lo) | (f2bf(hi) << 16); }
__device__ __forceinline__ float bf2f(unsigned short b) { return __builtin_bit_cast(float, ((unsigned)b) << 16); }
__device__ __forceinline__ float bflo(unsigned w) { return __builtin_bit_cast(float, w << 16); }
__device__ __forceinline__ float bfhi(unsigned w) { return __builtin_bit_cast(float, w & 0xffff0000u); }
__device__ __forceinline__ float wave_sum(float v) {
#pragma unroll
    for (int o = 1; o < 64; o <<= 1) v += __shfl_xor(v, o);
    return v;
}
__device__ __forceinline__ float sigm(float x) { return 1.f / (1.f + __expf(-x)); }

#define XB_TMO      128
#define XB_XCNT(j)  (256  + 64 * (j))
#define XB_XSUB(j)  (1280 + 64 * (j))
#define XB_XGEN(j)  (2304 + 64 * (j))
#define XB_TOP      3328
#define XB_TOPGEN   3392
#define XCD_BAR_WORDS 3456
#define XB_SPIN_CAP (1u << 18)

__device__ __forceinline__ unsigned xb_ld(unsigned* p)              { return __hip_atomic_load(p, __ATOMIC_RELAXED, __HIP_MEMORY_SCOPE_AGENT); }
__device__ __forceinline__ unsigned xb_add(unsigned* p, unsigned v) { return __hip_atomic_fetch_add(p, v, __ATOMIC_RELAXED, __HIP_MEMORY_SCOPE_AGENT); }
__device__ __forceinline__ unsigned xb_xcc_id() { return (unsigned)__builtin_amdgcn_s_getreg((3 << 11) | 20) & 0xFu; }
#define XB_SPIN(cond, bar) do { unsigned _sp = 0; while (cond) { __builtin_amdgcn_s_sleep(1); \
    if ((++_sp & 255u) == 0u) { if (xb_ld(&(bar)[XB_TMO])) break; if (_sp > XB_SPIN_CAP) { atomicAdd(&(bar)[XB_TMO], 1u); break; } } } } while (0)

struct XcdBarrier {
    unsigned* bar; unsigned x;
    volatile LAS unsigned* st;
};

__device__ __forceinline__ XcdBarrier xcd_barrier_post(unsigned* bar, volatile LAS unsigned* st) {
    XcdBarrier b; b.bar = bar; b.x = xb_xcc_id(); b.st = st;
    if (threadIdx.x == 0) (void)xb_add(&bar[XB_XCNT(b.x)], 1u);
    return b;
}
__device__ __forceinline__ void xcd_barrier_complete(unsigned* bar, unsigned x, unsigned& nloc, unsigned& nx) {
    const unsigned G = gridDim.x * gridDim.y * gridDim.z;
    unsigned sum, cnt, mine, sp = 0u;
    for (;;) {
        sum = 0u; cnt = 0u; mine = 0u;
#pragma unroll
        for (unsigned j = 0; j < 16; ++j) { const unsigned c = xb_ld(&bar[XB_XCNT(j)]); sum += c; cnt += (c > 0u) ? 1u : 0u; mine = (j == x) ? c : mine; }
        if (sum == G) break;
        __builtin_amdgcn_s_sleep(1);
        if ((++sp & 255u) == 0u) { if (xb_ld(&bar[XB_TMO])) break; if (sp > XB_SPIN_CAP) { atomicAdd(&bar[XB_TMO], 1u); break; } }
    }
    nloc = mine > 0u ? mine : 1u; nx = cnt > 0u ? cnt : 1u;
}

__device__ __forceinline__ void xcd_barrier(const XcdBarrier& b) {
    asm volatile("s_waitcnt vmcnt(0)" ::: "memory");
    __syncthreads();
    if (threadIdx.x == 0) {
        unsigned* bar = b.bar;
        __builtin_amdgcn_s_waitcnt(0);
        unsigned nloc = b.st[0], nx = b.st[1];
        if (nloc == 0u) { xcd_barrier_complete(bar, b.x, nloc, nx); b.st[0] = nloc; b.st[1] = nx; }
        const unsigned old = xb_add(&bar[XB_XSUB(b.x)], 1u);
        const unsigned gen = old / nloc;
        if (old + 1u == (gen + 1u) * nloc) {
            __builtin_amdgcn_fence(__ATOMIC_RELEASE, "agent");
            asm volatile("s_waitcnt vmcnt(0)" ::: "memory");
            const unsigned og = xb_add(&bar[XB_TOP], 1u);
            const unsigned tg = og / nx;
            if (og + 1u == (tg + 1u) * nx) xb_add(&bar[XB_TOPGEN], 1u);
            else XB_SPIN(xb_ld(&bar[XB_TOPGEN]) == tg, bar);
            __builtin_amdgcn_fence(__ATOMIC_ACQUIRE, "agent");
            xb_add(&bar[XB_XGEN(b.x)], 1u);
            asm volatile("s_waitcnt vmcnt(0)" ::: "memory");
        } else {
            XB_SPIN(xb_ld(&bar[XB_XGEN(b.x)]) == gen, bar);
            __builtin_amdgcn_fence(__ATOMIC_ACQUIRE, "agent");
            asm volatile("s_waitcnt vmcnt(0)" ::: "memory");
        }
    }
    __syncthreads();
}


__device__ __forceinline__ size_t opaque_zero() { size_t z = 0; asm volatile("" : "+s"(z)); return z; }
#define OWS (p.ws + opaque_zero())
__device__ __forceinline__ int opaque_zero_i() { int z = 0; asm volatile("" : "+s"(z)); return z; }
#define PIN(i) (p.in[(i) + opaque_zero_i()])
struct KP { const float* in[N_IN]; float* out; unsigned char* ws; int ph; int pad; };

template <int MODE> __device__ __forceinline__ int rowmap(int n, int arg) {
    if (MODE == 0) return n + arg;
    if (MODE == 1) { if (n < 1536) return n; if (n < 1664) return n - 1536 + PC_WD; if (n < 1792) return n - 1664 + PC_AD; if (n < 1920) return n - 1792 + PC_GD;
                     if (n < 2432) return n - 1920 + PC_CB; if (n < 2944) return n - 2432 + PC_CC; return n - 2944 + PC_CH; }
    return 8 * (n >> 2) + 4 * arg + (n & 3);
}
template <int MODE> __device__ __forceinline__ void transpose_item(const float* W, int K, int N, bf16* WT, int arg, LAS float* scr, int item, int lane) {
    const int nblk = N / 32, kb = item / nblk, nb = item % nblk, k0 = 64 * kb, n0 = 32 * nb;
#pragma unroll 8
    for (int i = 0; i < 32; ++i) { const int kk = 2 * i + (lane >> 5); scr[kk * 33 + (lane & 31)] = W[(size_t)(k0 + kk) * N + n0 + (lane & 31)]; }
    LDS_WAIT(); asm volatile("" ::: "memory");
    const int c = lane & 7;
#pragma unroll
    for (int j = 0; j < 4; ++j) { const int n = (lane >> 3) + 8 * j; const LAS float* s = scr + (8 * c) * 33 + n;
        v4u o; o.x = pk2(s[0 * 33], s[1 * 33]); o.y = pk2(s[2 * 33], s[3 * 33]); o.z = pk2(s[4 * 33], s[5 * 33]); o.w = pk2(s[6 * 33], s[7 * 33]);
        *(v4u*)(WT + (size_t)rowmap<MODE>(n0 + n, arg) * K + k0 + 8 * c) = o; }
    LDS_WAIT(); asm volatile("" ::: "memory");
}

__device__ __forceinline__ void ph_modvec(const KP& p, LAS unsigned char* lds, int tid) {
    LAS float* sil = (LAS float*)lds;
    LAS float* red = (LAS float*)(lds + 5 * 1024 * 4);
    const float* c = PIN(I_C); const float* cc = PIN(I_CCTX);
    for (int i = tid; i < 5 * 1024; i += 512) { const float v = i < 4096 ? c[i] : cc[i - 4096]; sil[i] = v / (1.f + __expf(-v)); }
    __syncthreads();
    float* modv = (float*)(OWS + WS_MODV);
    const int ks = tid >> 6, col = tid & 63;
    for (int task = blockIdx.x; task < DEPTH * 96; task += gridDim.x) {
        const int l = task / 96, j0 = (task % 96) * 64;
        const float* w = PIN(I_WMOD) + (size_t)l * D * NMOD + (size_t)(ks * 128) * NMOD + j0 + col;
        float a0 = 0.f, a1 = 0.f, a2 = 0.f, a3 = 0.f, a4 = 0.f;
#pragma unroll 8
        for (int k = 0; k < 128; ++k) { const float wv = w[(size_t)k * NMOD]; const int kk = ks * 128 + k;
            a0 += sil[kk] * wv; a1 += sil[1024 + kk] * wv; a2 += sil[2048 + kk] * wv; a3 += sil[3072 + kk] * wv; a4 += sil[4096 + kk] * wv; }
        red[(ks * 5 + 0) * 64 + col] = a0; red[(ks * 5 + 1) * 64 + col] = a1; red[(ks * 5 + 2) * 64 + col] = a2; red[(ks * 5 + 3) * 64 + col] = a3; red[(ks * 5 + 4) * 64 + col] = a4;
        __syncthreads();
        if (tid < 320) { const int r = tid >> 6; float s = 0.f;
#pragma unroll
            for (int q = 0; q < 8; ++q) s += red[(q * 5 + r) * 64 + col];
            modv[(size_t)(l * 5 + r) * NMOD + j0 + col] = s + PIN(I_BMOD)[l * NMOD + j0 + col]; }
        __syncthreads();
    }
}

__device__ __forceinline__ void ph_convert(const KP& p, LAS unsigned char* lds, int gw, int NGW, int wave, int lane) {
    LAS float* scr = (LAS float*)(lds + wave * 16384);
    bf16* win = (bf16*)(OWS + WS_WIN); bf16* f2 = (bf16*)(OWS + WS_F2); bf16* lora = (bf16*)(OWS + WS_LORA);
    constexpr int I_IN = (D / 64) * (NPROJ / 32), I_OUT = (D / 64) * (D / 32), I_UP = (D / 64) * (DFF / 32), I_DN = (DFF / 64) * (D / 32);
    for (int it = gw; it < I_DN; it += NGW) transpose_item<0>(PIN(I_FW2), DFF, D, f2, 0, scr, it, lane);
    { const int gt = gw * 64 + lane, NGT = NGW * 64; constexpr int PER = (NP - NPROJ) * D / 16;
      for (int i = gt; i < DEPTH * PER; i += NGT) { const int l = i / PER, q = i % PER; *(v4u*)((unsigned char*)win + (size_t)l * NP * D + (size_t)NPROJ * D + (size_t)q * 16) = (v4u){0u, 0u, 0u, 0u}; } }
    { const int gt = gw * 64 + lane, NGT = NGW * 64;
      for (int i = gt; i < DEPTH * LORAW_PER_LAYER / 8; i += NGT) { const int l = i / (LORAW_PER_LAYER / 8); int q = (i % (LORAW_PER_LAYER / 8)) * 8; float v[8];
          int grp, c, k0; if (q < 4 * 512 * 64) { grp = q / (512 * 64); q -= grp * 512 * 64; c = q / 64; k0 = q % 64; } else { grp = 4; q -= 4 * 512 * 64; c = q / 128; k0 = q % 128; }
#pragma unroll
          for (int j = 0; j < 8; ++j) { const int k = k0 + j;
              v[j] = grp < 2 ? PIN(I_W2)[((size_t)(l * 2 + grp) * 64 + k) * RW + c] : grp < 4 ? PIN(I_A2)[((size_t)(l * 2 + grp - 2) * 64 + k) * RW + c] : PIN(I_G2)[((size_t)l * 128 + k) * RW + c]; }
          v4u o; o.x = pk2(v[0], v[1]); o.y = pk2(v[2], v[3]); o.z = pk2(v[4], v[5]); o.w = pk2(v[6], v[7]);
          *(v4u*)(lora + (size_t)i * 8) = o; } }
}
__device__ __forceinline__ void ph_amax(const KP& p, int gw, int NGW, int lane) {
    unsigned* AM = (unsigned*)(OWS + WS_AMAX);
    for (int it = gw; it < 18 * 2 * (DFF / 64); it += NGW) { const int kq = 0, strip = it % (DFF / 64), sm = it / (DFF / 64), s1 = sm & 1, cm = sm >> 1;
        const float* W = cm < 2 ? PIN(s1 ? I_FW3 : I_FW1) + (size_t)cm * D * DFF : PIN(s1 ? I_MW3 : I_MW1) + (size_t)(cm - 2) * D * DFF;
        const int n = strip * 64 + lane; const float* src = W + (size_t)(kq * 256) * DFF + n; float m = 0.f;
#pragma unroll 16
        for (int k = 0; k < 256; ++k) { const float w = src[(size_t)k * DFF]; m += w * w; }
        AM[(size_t)cm * 2 * DFF + 8 * (n >> 2) + 4 * s1 + (n & 3)] = __builtin_bit_cast(unsigned, 4.25f * sqrtf(m * (1.f / 256.f))); }
    for (int it = gw; it < DEPTH * (NPROJ / 64 + D / 64); it += NGW) { const int kq = 0; int t = it; const int l = t / (NPROJ / 64 + D / 64); t -= l * (NPROJ / 64 + D / 64);
        const bool isin = t < NPROJ / 64; const int strip = isin ? t : t - NPROJ / 64, N = isin ? NPROJ : D, n = strip * 64 + lane;
        const float* src = (isin ? PIN(I_WIN) + (size_t)l * D * NPROJ : PIN(I_WOUT) + (size_t)l * D * D) + (size_t)(kq * 256) * N + n; float m = 0.f;
#pragma unroll 16
        for (int k = 0; k < 256; ++k) { const float w = src[(size_t)k * N]; m += w * w; }
        AM[isin ? AM_IN + l * NP + rowmap<1>(n, 0) : AM_OUT + l * D + n] = __builtin_bit_cast(unsigned, 4.25f * sqrtf(m * (1.f / 256.f))); }
}
__device__ __forceinline__ unsigned q8pack(float a, float b, float c, float d) {
    const int qa = __float2int_rn(fminf(fmaxf(a, -127.f), 127.f)), qb = __float2int_rn(fminf(fmaxf(b, -127.f), 127.f)), qc = __float2int_rn(fminf(fmaxf(c, -127.f), 127.f)), qd = __float2int_rn(fminf(fmaxf(d, -127.f), 127.f));
    return (unsigned)(qa & 255) | ((unsigned)(qb & 255) << 8) | ((unsigned)(qc & 255) << 16) | ((unsigned)(qd & 255) << 24); }
constexpr int CQ_IN = (D / 64) * (NPROJ / 32), CQ_OUT = (D / 64) * (D / 32), CQ_UP = (D / 64) * (DFF / 32), CQ_DN = (DFF / 64) * (D / 32);
constexpr int CQ_NEG = CQ_IN + CQ_OUT + 2 * CQ_UP;
constexpr int CQ_J1 = 3 * CQ_IN + 3 * CQ_OUT + 2 * CQ_UP + CQ_DN, CQ_MOE = NE * (2 * CQ_UP + CQ_DN), CQ_END0 = CQ_J1 + CQ_MOE, CQ_END1 = CQ_END0 + CQ_MOE;
#ifndef CQ_SLOT_ITEMS
#define CQ_SLOT_ITEMS 12000
#endif
struct CqItem { const float* W; bf16* WT; int K, N, mode, arg, item; const unsigned* am; };
__device__ __forceinline__ CqItem cq_decode(const KP& p, int q) {
    CqItem c; bf16* win = (bf16*)(OWS + WS_WIN); bf16* wout = (bf16*)(OWS + WS_WOUT); bf16* f13 = (bf16*)(OWS + WS_F13); bf16* f2 = (bf16*)(OWS + WS_F2);
    bf16* m13 = (bf16*)(OWS + WS_MOEW13); bf16* m2 = (bf16*)(OWS + WS_MOEW2); const unsigned* AM = (const unsigned*)(OWS + WS_AMAX);
    if (q < 0) { q += CQ_NEG;
        if (q < CQ_IN) { c = CqItem{PIN(I_WIN), win, D, NPROJ, 3, 0, q, AM + AM_IN}; return c; } q -= CQ_IN;
        if (q < CQ_OUT) { c = CqItem{PIN(I_WOUT), wout, D, D, 4, 0, q, AM + AM_OUT}; return c; } q -= CQ_OUT;
        if (q < CQ_UP) { c = CqItem{PIN(I_FW1), f13, D, DFF, 2, 0, q, AM}; return c; } q -= CQ_UP;
        c = CqItem{PIN(I_FW3), f13, D, DFF, 2, 1, q, AM}; return c; }
    if (q < 3 * CQ_IN) { const int l = 1 + q / CQ_IN; c = CqItem{PIN(I_WIN) + (size_t)l * D * NPROJ, win + (size_t)l * (NP * D / 2), D, NPROJ, 3, 0, q % CQ_IN, AM + AM_IN + l * NP}; return c; } q -= 3 * CQ_IN;
    if (q < 3 * CQ_OUT) { const int l = 1 + q / CQ_OUT; c = CqItem{PIN(I_WOUT) + (size_t)l * D * D, wout + (size_t)l * (D * D / 2), D, D, 4, 0, q % CQ_OUT, AM + AM_OUT + l * D}; return c; } q -= 3 * CQ_OUT;
    if (q < CQ_UP) { c = CqItem{PIN(I_FW1) + (size_t)D * DFF, f13 + (size_t)DFF * D, D, DFF, 2, 0, q, AM + 2 * DFF}; return c; } q -= CQ_UP;
    if (q < CQ_UP) { c = CqItem{PIN(I_FW3) + (size_t)D * DFF, f13 + (size_t)DFF * D, D, DFF, 2, 1, q, AM + 2 * DFF}; return c; } q -= CQ_UP;
    if (q < CQ_DN) { c = CqItem{PIN(I_FW2) + (size_t)DFF * D, f2 + (size_t)D * DFF, DFF, D, 0, 0, q, nullptr}; return c; } q -= CQ_DN;
    const int mi = q / CQ_MOE; q -= mi * CQ_MOE;
    if (q < NE * CQ_UP) { const int e = q / CQ_UP; c = CqItem{PIN(I_MW1) + ((size_t)mi * NE + e) * D * DFF, m13 + (size_t)e * DFF * D, D, DFF, 2, 0, q % CQ_UP, AM + (size_t)(2 + 8 * mi + e) * 2 * DFF}; return c; } q -= NE * CQ_UP;
    if (q < NE * CQ_UP) { const int e = q / CQ_UP; c = CqItem{PIN(I_MW3) + ((size_t)mi * NE + e) * D * DFF, m13 + (size_t)e * DFF * D, D, DFF, 2, 1, q % CQ_UP, AM + (size_t)(2 + 8 * mi + e) * 2 * DFF}; return c; } q -= NE * CQ_UP;
    { const int e = q / CQ_DN; c = CqItem{PIN(I_MW2) + ((size_t)mi * NE + e) * DFF * D, m2 + (size_t)e * D * DFF, DFF, D, 0, 0, q % CQ_DN, nullptr}; return c; }
}
__device__ __forceinline__ void cq_load(const CqItem& c, int lane, float (&r)[32]) {
    const int nblk = c.N / 32, kb = c.item / nblk, nb = c.item % nblk; const float* src = c.W + (size_t)(64 * kb + (lane >> 5)) * c.N + 32 * nb + (lane & 31);
#pragma unroll
    for (int i = 0; i < 32; ++i) r[i] = src[(size_t)(2 * i) * c.N];
}
__device__ __forceinline__ void cq_store(const CqItem& c, int lane, const float (&r)[32], LAS float* scr) {
    const int nblk = c.N / 32, kb = c.item / nblk, nb = c.item % nblk, k0 = 64 * kb, n0 = 32 * nb;
#pragma unroll
    for (int i = 0; i < 32; ++i) scr[(2 * i + (lane >> 5)) * 33 + (lane & 31)] = r[i];
    LDS_WAIT(); asm volatile("" ::: "memory");
    if (c.mode >= 2) {
        const int n = lane >> 1, hf = lane & 1, nn = n0 + n, j = c.mode == 2 ? 8 * (nn >> 2) + 4 * c.arg + (nn & 3) : c.mode == 3 ? rowmap<1>(nn, 0) : nn;
        const float inv = 127.f / fmaxf(__builtin_bit_cast(float, c.am[j]), 1e-30f); const LAS float* sp = scr + (32 * hf) * 33 + n; unsigned w[8];
#pragma unroll
        for (int q = 0; q < 8; ++q) w[q] = q8pack(sp[(4 * q + 0) * 33] * inv, sp[(4 * q + 1) * 33] * inv, sp[(4 * q + 2) * 33] * inv, sp[(4 * q + 3) * 33] * inv);
        unsigned char* dst = (unsigned char*)c.WT + (size_t)j * c.K + k0 + 32 * hf;
        *(v4u*)dst = (v4u){w[0], w[1], w[2], w[3]}; *(v4u*)(dst + 16) = (v4u){w[4], w[5], w[6], w[7]};
    } else {
    const int cc = lane & 7;
#pragma unroll
    for (int j = 0; j < 4; ++j) { const int n = (lane >> 3) + 8 * j; const LAS float* sp = scr + (8 * cc) * 33 + n;
        v4u o; o.x = pk2(sp[0 * 33], sp[1 * 33]); o.y = pk2(sp[2 * 33], sp[3 * 33]); o.z = pk2(sp[4 * 33], sp[5 * 33]); o.w = pk2(sp[6 * 33], sp[7 * 33]);
        const int nn = n0 + n;
        *(v4u*)(c.WT + (size_t)nn * c.K + k0 + 8 * cc) = o; }
    }
    LDS_WAIT(); asm volatile("" ::: "memory");
}
constexpr int CQ_B = 4;
__device__ __forceinline__ int cq_grab(unsigned* heads, int nseg, int& cnt, int lane) {
    int q = -1, n = 0;
    if (lane == 0) { for (int sg = 0; sg < nseg && q < 0; ++sg) { const int size = sg == 0 ? CQ_J1 : CQ_MOE, base = sg == 0 ? 0 : sg == 1 ? CQ_J1 : CQ_END0; unsigned* hd = heads + 64 * sg;
            if ((int)__hip_atomic_load(hd, __ATOMIC_RELAXED, __HIP_MEMORY_SCOPE_AGENT) < size) { const int t = (int)__hip_atomic_fetch_add(hd, (unsigned)CQ_B, __ATOMIC_RELAXED, __HIP_MEMORY_SCOPE_AGENT);
                if (t < size) { q = base + t; n = size - t < CQ_B ? size - t : CQ_B; } } } }
    cnt = __builtin_amdgcn_readfirstlane(n); return __builtin_amdgcn_readfirstlane(q);
}
__device__ __forceinline__ void cq_run(const KP& p, LAS unsigned char* lds, int nseg, const unsigned* stop, unsigned stopval, int wave, int lane) {
    unsigned* heads = (unsigned*)(OWS + WS_CTL) + CW_CQ; LAS float* scr = (LAS float*)(lds + wave * 16384);
    for (;;) {
        if (stop) { unsigned sv = 0u; if (lane == 0) sv = __hip_atomic_load(stop, __ATOMIC_RELAXED, __HIP_MEMORY_SCOPE_AGENT); if ((unsigned)__builtin_amdgcn_readfirstlane((int)sv) >= stopval) break; }
        int cnt; const int q0 = cq_grab(heads, nseg, cnt, lane); if (q0 < 0) break;
        CqItem cur = cq_decode(p, q0); float ra[32]; cq_load(cur, lane, ra);
        for (int j = 0; j < cnt; ++j) { CqItem nxt = cur; float rb[32];
            if (j + 1 < cnt) { nxt = cq_decode(p, q0 + j + 1); cq_load(nxt, lane, rb); }
            cq_store(cur, lane, ra, scr);
            if (j + 1 < cnt) { cur = nxt;
#pragma unroll
                for (int i = 0; i < 32; ++i) ra[i] = rb[i]; } }
    }
}

__device__ __forceinline__ void cq_static(const KP& p, LAS unsigned char* lds, int q0, int q1, int gw, int NGW, int wave, int lane) {
    LAS float* scr = (LAS float*)(lds + wave * 16384);
    int q = q0 + gw; if (q >= q1) return;
    CqItem cur = cq_decode(p, q); float ra[32]; cq_load(cur, lane, ra);
    for (;;) { const int qn = q + NGW; CqItem nxt = cur; float rb[32];
        if (qn < q1) { nxt = cq_decode(p, qn); cq_load(nxt, lane, rb); }
        cq_store(cur, lane, ra, scr);
        if (qn >= q1) break;
        cur = nxt; q = qn;
#pragma unroll
        for (int i = 0; i < 32; ++i) ra[i] = rb[i]; }
}

constexpr int CW_ICUR = 13312, CW_IDONE = 13440;
constexpr int IDLE_IN0 = ((MROWS / 256) * (NP / 256)) % 256, IDLE_OT0 = (NCTX / 256) * (D / 256) * 2, IDLE_UP0 = ((MROWS / 256) * (2 * DFF / 256)) % 256, IDLE_DT0 = (NCTX / 256) * (D / 256) * 7;
constexpr int CQO_DYN = 2 * CQ_SLOT_ITEMS, CQ_DYN_LIM = CQ_MOE - CQO_DYN;
static_assert(CQ_DYN_LIM > 0, "carry-phase slots exceed the MoE conversion segment");
__device__ __forceinline__ void cq_idle(const KP& p, LAS unsigned char* lds, int segbase, int mi, int slot, int first_idle, int tid, int wave, int lane) {
    unsigned* ctl = (unsigned*)(OWS + WS_CTL);
    if ((int)blockIdx.x < first_idle) { if (tid == 0) __hip_atomic_fetch_add(ctl + CW_IDONE + 64 * slot, 1u, __ATOMIC_RELAXED, __HIP_MEMORY_SCOPE_AGENT); }
    else {
        asm volatile("s_waitcnt vmcnt(0)" ::: "memory"); __syncthreads();
        LAS int* tk = (LAS int*)(lds + LDSCTL_OFF + 2048); LAS float* scr = (LAS float*)(lds + wave * 16384);
        for (int r = 0;; ++r) {
            if (tid == 0) { int t = -1;
                if ((int)__hip_atomic_load(ctl + CW_IDONE + 64 * slot, __ATOMIC_RELAXED, __HIP_MEMORY_SCOPE_AGENT) < first_idle) {
                    t = (int)__hip_atomic_fetch_add(ctl + CW_ICUR + 64 * mi, (unsigned)NWAVES, __ATOMIC_RELAXED, __HIP_MEMORY_SCOPE_AGENT); if (t >= CQ_DYN_LIM) t = -1; }
                tk[r & 1] = t; }
            __syncthreads();
            const int t = __builtin_amdgcn_readfirstlane(tk[r & 1]); if (t < 0) break;
            const int q = segbase + CQO_DYN + t + wave;
            if (q < segbase + CQ_MOE) { CqItem c = cq_decode(p, q); float ra[32]; cq_load(c, lane, ra); cq_store(c, lane, ra, scr); }
        }
    }
}

__device__ __forceinline__ void ld_row(const float* r, int lane, f32x4 (&v)[4]) { const f32x4* q = (const f32x4*)r + lane;
#pragma unroll
    for (int j = 0; j < 4; ++j) v[j] = q[64 * j]; }
__device__ __forceinline__ void st_row(float* r, int lane, const f32x4 (&v)[4]) { f32x4* q = (f32x4*)r + lane;
#pragma unroll
    for (int j = 0; j < 4; ++j) q[64 * j] = v[j]; }
__device__ __forceinline__ void st_row_bf16(bf16* r, int lane, const f32x4 (&v)[4]) { v2u* q = (v2u*)r + lane;
#pragma unroll
    for (int j = 0; j < 4; ++j) { v2u w; w.x = pk2(v[j][0], v[j][1]); w.y = pk2(v[j][2], v[j][3]); q[64 * j] = w; } }
__device__ __forceinline__ void ld_row_bf16(const bf16* r, int lane, f32x4 (&v)[4]) { const v2u* q = (const v2u*)r + lane;
#pragma unroll
    for (int j = 0; j < 4; ++j) { const v2u w = q[64 * j]; v[j] = (f32x4){bflo(w.x), bfhi(w.x), bflo(w.y), bfhi(w.y)}; } }
typedef _Float16 h16x4 __attribute__((ext_vector_type(4)));
__device__ __forceinline__ void st_row_h16(_Float16* r, int lane, const f32x4 (&v)[4]) { h16x4* q = (h16x4*)r + lane;
#pragma unroll
    for (int j = 0; j < 4; ++j) { h16x4 w; w[0] = (_Float16)v[j][0]; w[1] = (_Float16)v[j][1]; w[2] = (_Float16)v[j][2]; w[3] = (_Float16)v[j][3]; q[64 * j] = w; } }
__device__ __forceinline__ void ld_row_h16(const _Float16* r, int lane, f32x4 (&v)[4]) { const h16x4* q = (const h16x4*)r + lane;
#pragma unroll
    for (int j = 0; j < 4; ++j) { const h16x4 w = q[64 * j]; v[j] = (f32x4){(float)w[0], (float)w[1], (float)w[2], (float)w[3]}; } }
template <int S> __device__ __forceinline__ void ld_row_parts(const float* r, size_t pstride, int lane, f32x4 (&v)[4]) {
    ld_row(r, lane, v);
#pragma unroll
    for (int s = 1; s < S; ++s) { f32x4 t[4]; ld_row(r + (size_t)s * pstride, lane, t);
#pragma unroll
        for (int j = 0; j < 4; ++j) v[j] += t[j]; } }
__device__ __forceinline__ int mod_row(int row) { return row < NLAT ? (row >> 12) : 4; }

__device__ __forceinline__ void st_row_q8(unsigned char* dst8, float* scale, int row, int lane, const f32x4 (&v)[4]) {
    float am = 0.f;
#pragma unroll
    for (int j = 0; j < 4; ++j) am = fmaxf(fmaxf(am, fmaxf(fabsf(v[j][0]), fabsf(v[j][1]))), fmaxf(fabsf(v[j][2]), fabsf(v[j][3])));
#pragma unroll
    for (int o = 1; o < 64; o <<= 1) am = fmaxf(am, __shfl_xor(am, o));
    am = fmaxf(am, 1e-30f); const float inv = 127.f / am; unsigned* h8 = (unsigned*)dst8 + (size_t)row * (D / 4) + lane;
#pragma unroll
    for (int j = 0; j < 4; ++j) h8[64 * j] = q8pack(v[j][0] * inv, v[j][1] * inv, v[j][2] * inv, v[j][3] * inv);
    if (lane == 0) scale[row] = am * (1.f / 127.f);
}
__device__ __forceinline__ void ph_init_rows(const KP& p, int gw, int NGW, int lane) {
    const float* modv = (const float*)(OWS + WS_MODV); float* X = (float*)(OWS + WS_X); bf16* H = (bf16*)(OWS + WS_H);
    for (int row = gw; row < MROWS; row += NGW) {
        const float* src = row < NLAT ? PIN(I_X) + (size_t)row * D : PIN(I_CTX) + (size_t)(row - NLAT) * D;
        const float* mv = modv + (size_t)(0 * 5 + mod_row(row)) * NMOD;
        f32x4 x[4], sh[4], sc[4], h[4]; ld_row(src, lane, x); ld_row(mv, lane, sh); ld_row(mv + 1024, lane, sc);
#pragma unroll
        for (int j = 0; j < 4; ++j) h[j] = x[j] * (1.f + sc[j]) + sh[j];
        st_row_q8(OWS + WS_H8, (float*)(OWS + WS_SA), row, lane, h);
    }
}

__device__ __forceinline__ int scan_row(int b, int dir, int step) { return step < CTXL ? NLAT + b * CTXL + (dir ? CTXL - 1 - step : step) : b * SEQ + (dir ? SEQ - 1 - (step - CTXL) : step - CTXL); }
typedef short sbf16x8 __attribute__((ext_vector_type(8)));
typedef float f32x16 __attribute__((ext_vector_type(16)));
constexpr int SC_C = 32, SC_NCH = (CTXL + SEQ) / SC_C  , SC_NCHAIN = NB * NH * 2  , SC_NTASK = SC_NCH * SC_NCHAIN  ;
constexpr int CH_G = 0, CH_Q = 8192, CH_UT = 12288, CH_YL = 20480, CH_EC = 24576, CH_BYTES = 25600, CH_NLOAD = 26;

__device__ __forceinline__ f32x16 mm(v4u a, v4u b, f32x16 c) { return __builtin_amdgcn_mfma_f32_32x32x16_bf16(__builtin_bit_cast(sbf16x8, a), __builtin_bit_cast(sbf16x8, b), c, 0, 0, 0); }
typedef float f32x2c __attribute__((ext_vector_type(2))); typedef __bf16 bf16x2c __attribute__((ext_vector_type(2)));
__device__ __forceinline__ unsigned cvtpk(float lo, float hi) { return __builtin_bit_cast(unsigned, __builtin_convertvector((f32x2c){lo, hi}, bf16x2c)); }
template <int S, int NEG> __device__ __forceinline__ v4u cvtf(const f32x16& x) {
    v4u w; const float sg = NEG ? -1.f : 1.f;
    w.x = cvtpk(sg * x[8 * S + 0], sg * x[8 * S + 1]); w.y = cvtpk(sg * x[8 * S + 2], sg * x[8 * S + 3]); w.z = cvtpk(sg * x[8 * S + 4], sg * x[8 * S + 5]); w.w = cvtpk(sg * x[8 * S + 6], sg * x[8 * S + 7]); return w; }
template <int MODE  > __device__ __forceinline__ f32x16 mask_acc(f32x16 x, int n, int hh) {
#pragma unroll
    for (int r = 0; r < 16; ++r) { const int m = (r & 3) + 8 * (r >> 2) + 4 * hh; const bool keep = MODE == 0 ? (m > n) : MODE == 1 ? (m < n) : (m <= n); x[r] = keep ? x[r] : 0.f; }
    return x; }
__device__ __forceinline__ f32x16 zero16() { f32x16 z;
#pragma unroll
    for (int r = 0; r < 16; ++r) z[r] = 0.f;
    return z; }
__device__ __forceinline__ void cm_build(const unsigned (&w)[16], v4u (&f)[2][2]) {
#pragma unroll
    for (int s = 0; s < 2; ++s) {
        const auto r0 = __builtin_amdgcn_permlane32_swap(w[8 * s + 0], w[8 * s + 2], false, false), r1 = __builtin_amdgcn_permlane32_swap(w[8 * s + 1], w[8 * s + 3], false, false);
        const auto r2 = __builtin_amdgcn_permlane32_swap(w[8 * s + 4], w[8 * s + 6], false, false), r3 = __builtin_amdgcn_permlane32_swap(w[8 * s + 5], w[8 * s + 7], false, false);
        f[0][s] = (v4u){r0[0], r1[0], r2[0], r3[0]}; f[1][s] = (v4u){r0[1], r1[1], r2[1], r3[1]}; }
}
__device__ __forceinline__ void st16(unsigned char* base, int off, int lane, v4u v) { *(v4u*)(base + off + lane * 16) = v; }

__device__ __forceinline__ void ph_scan1(const KP& p, int l, int gw, int NGW, int lane) {
    const bf16* P = (const bf16*)(OWS + WS_P); const bf16* LO = (const bf16*)(OWS + WS_LO); const float* NRM = (const float*)(OWS + WS_RKS); unsigned char* CH = OWS + WS_CH;
    const int n = lane & 31, hh = lane >> 5;
    v4u Id[2];
#pragma unroll
    for (int s = 0; s < 2; ++s) { unsigned wd[4];
#pragma unroll
        for (int q = 0; q < 4; ++q) { const int j0 = 2 * q, j1 = 2 * q + 1; const int t0 = 16 * s + 8 * (j0 >> 2) + 4 * hh + (j0 & 3), t1 = 16 * s + 8 * (j1 >> 2) + 4 * hh + (j1 & 3);
            wd[q] = (t0 == n ? 0x3F80u : 0u) | (t1 == n ? 0x3F800000u : 0u); }
        Id[s] = (v4u){wd[0], wd[1], wd[2], wd[3]}; }
    for (int task = gw; task < SC_NTASK; task += NGW) {
        const int dir = task & 1, h = (task >> 1) & 7, b = (task >> 4) & 3, ci = task >> 6;
        const int row0 = scan_row(b, dir, SC_C * ci), sgn = dir ? -1 : 1, c = h * 64 + lane;
        const float w0c = PIN(I_W0)[(l * 2 + dir) * RW + c], a0c = PIN(I_A0)[(l * 2 + dir) * RW + c], kkc = PIN(I_KK)[l * RW + c], kac = PIN(I_KA)[l * RW + c];
        unsigned wAl[16], wBe[16], wKa[16], wRh[16], wV[16], wBp[16], wKp[16];
        float cs = 0.f, Eprev = 1.f;
#pragma unroll
        for (int hb = 0; hb < 2; ++hb) {
            unsigned rk_[16], rr_[16], rv_[16], rw_[16], ra_[16]; float rn_[16];
#pragma unroll
            for (int i = 0; i < 16; ++i) { const int row = row0 + sgn * (16 * hb + i); const bf16* pr = P + (size_t)row * NP; const bf16* lo = LO + (size_t)row * NLO;
                rk_[i] = pr[PC_K + c]; rr_[i] = pr[PC_R + c]; rv_[i] = pr[PC_V + c]; rw_[i] = lo[dir * RW + c]; ra_[i] = lo[1024 + dir * RW + c]; rn_[i] = NRM[row * 8 + h]; }
#pragma unroll
            for (int i = 0; i < 16; ++i) asm volatile("" : "+v"(rk_[i]), "+v"(rr_[i]), "+v"(rv_[i]), "+v"(rw_[i]), "+v"(ra_[i]), "+v"(rn_[i]));
#pragma unroll
            for (int pq = 0; pq < 8; ++pq) { const int pz = 8 * hb + pq; float al[2], be[2], ka[2], rh[2], vv[2];
#pragma unroll
                for (int e = 0; e < 2; ++e) { const int i = 2 * pq + e;
                    const float kv = bf2f((unsigned short)rk_[i]), rv = bf2f((unsigned short)rr_[i]); vv[e] = bf2f((unsigned short)rv_[i]);
                    const float wl = w0c + bf2f((unsigned short)rw_[i]), aa = __builtin_amdgcn_rcpf(1.f + __expf(-(a0c + bf2f((unsigned short)ra_[i])))), nrm = rn_[i];
                    const float lw = -0.6065306597f * __builtin_amdgcn_rcpf(1.f + __expf(-wl));
                    cs += lw; const float E = __expf(cs), Ei = __builtin_amdgcn_rcpf(E);
                    const float kkn = kv * kkc * nrm, kd = kv * (1.f + (aa - 1.f) * kac);
                    al[e] = kkn * Eprev; be[e] = kkn * aa * Ei; ka[e] = kd * Ei; rh[e] = rv * E; Eprev = E; }
                wAl[pz] = cvtpk(al[0], al[1]); wBe[pz] = cvtpk(be[0], be[1]); wKa[pz] = cvtpk(ka[0], ka[1]); wRh[pz] = cvtpk(rh[0], rh[1]); wV[pz] = cvtpk(vv[0], vv[1]); }
        }
        const float EC = Eprev;
#pragma unroll
        for (int pz = 0; pz < 16; ++pz) { wBp[pz] = cvtpk(bflo(wBe[pz]) * EC, bfhi(wBe[pz]) * EC); wKp[pz] = cvtpk(bflo(wKa[pz]) * EC, bfhi(wKa[pz]) * EC); }
        unsigned char* img = CH + (size_t)(((b * 8 + h) * 2 + dir) * SC_NCH + ci) * CH_BYTES;
        ((float*)(img + CH_EC))[lane] = EC;
        v4u cAl[2][2], cV[2][2], cBp[2][2], cKp[2][2], cRh[2][2];
        v4u tAl[4], tBe[4], tKa[4], tRh[4];
        cm_build(wAl, cAl); cm_build(wV, cV); cm_build(wBp, cBp); cm_build(wKp, cKp); cm_build(wRh, cRh);
        {   v4u cBe[2][2], cKa[2][2]; cm_build(wBe, cBe); cm_build(wKa, cKa);
#define TRANSPOSE(cZ, tZ) do { _Pragma("unroll") for (int ct = 0; ct < 2; ++ct) { f32x16 T_ = mm(cZ[ct][0], Id[0], zero16()); T_ = mm(cZ[ct][1], Id[1], T_); tZ[2 * ct] = cvtf<0, 0>(T_); tZ[2 * ct + 1] = cvtf<1, 0>(T_); } } while (0)
            TRANSPOSE(cAl, tAl); TRANSPOSE(cBe, tBe); TRANSPOSE(cKa, tKa); TRANSPOSE(cRh, tRh);
#undef TRANSPOSE
        }
#define PROD4(A, B) mm(A[3], B[3], mm(A[2], B[2], mm(A[1], B[1], mm(A[0], B[0], zero16()))))
        f32x16 XN = mask_acc<0>(PROD4(tAl, tBe), n, hh), XT = mask_acc<1>(PROD4(tBe, tAl), n, hh);
        v4u fLM[2], fGB[2], fGK[2];
        { const f32x16 t = mask_acc<1>(PROD4(tKa, tAl), n, hh); fLM[0] = cvtf<0, 0>(t); fLM[1] = cvtf<1, 0>(t); }
        { const f32x16 t = mask_acc<2>(PROD4(tBe, tRh), n, hh); fGB[0] = cvtf<0, 0>(t); fGB[1] = cvtf<1, 0>(t); }
        { const f32x16 t = mask_acc<2>(PROD4(tKa, tRh), n, hh); fGK[0] = cvtf<0, 0>(t); fGK[1] = cvtf<1, 0>(t); }
#undef PROD4
#pragma unroll
        for (int r = 0; r < 16; ++r) { XN[r] = -XN[r]; XT[r] = -XT[r]; }
        f32x16 RT = XT;
#pragma unroll
        for (int r = 0; r < 16; ++r) RT[r] += ((r & 3) + 8 * (r >> 2) + 4 * hh == n) ? 1.f : 0.f;
#pragma unroll
        for (int pw = 1; pw < 5; ++pw) {
            const v4u xn0 = cvtf<0, 0>(XN), xn1 = cvtf<1, 0>(XN), xt0 = cvtf<0, 0>(XT), xt1 = cvtf<1, 0>(XT);
            XN = mm(xt1, xn1, mm(xt0, xn0, zero16()));
            if (pw < 4) XT = mm(xn1, xt1, mm(xn0, xt0, zero16()));
            const v4u yn0 = cvtf<0, 0>(XN), yn1 = cvtf<1, 0>(XN), rt0 = cvtf<0, 0>(RT), rt1 = cvtf<1, 0>(RT);
            RT = mm(yn1, rt1, mm(yn0, rt0, RT));
        }
        const v4u fA0 = cvtf<0, 0>(RT), fA1 = cvtf<1, 0>(RT);
        f32x16 At[2], Vt[2];
#pragma unroll
        for (int t = 0; t < 2; ++t) {
            const f32x16 lmv = mm(fLM[1], cV[t][1], mm(fLM[0], cV[t][0], zero16()));
            At[t] = mm(fA1, cAl[t][1], mm(fA0, cAl[t][0], zero16()));
            Vt[t] = mm(fA1, cvtf<1, 0>(lmv), mm(fA0, cvtf<0, 0>(lmv), zero16()));
        }
#pragma unroll
        for (int kt1 = 0; kt1 < 2; ++kt1) { const v4u a0 = cvtf<0, 0>(At[kt1]), a1 = cvtf<1, 0>(At[kt1]);
#pragma unroll
            for (int kt2 = 0; kt2 < 2; ++kt2) { const f32x16 g = mm(a1, cBp[kt2][1], mm(a0, cBp[kt2][0], zero16()));
                st16(img, CH_G + ((kt2 * 2 + kt1) * 2 + 0) * 1024, lane, cvtf<0, 1>(g)); st16(img, CH_G + ((kt2 * 2 + kt1) * 2 + 1) * 1024, lane, cvtf<1, 1>(g)); } }
#pragma unroll
        for (int vt = 0; vt < 2; ++vt) { const v4u nv0 = cvtf<0, 1>(Vt[vt]), nv1 = cvtf<1, 1>(Vt[vt]);
#pragma unroll
            for (int kt = 0; kt < 2; ++kt) { f32x16 u = mm(cKp[kt][1], cV[vt][1], mm(cKp[kt][0], cV[vt][0], zero16())); u = mm(cBp[kt][1], nv1, mm(cBp[kt][0], nv0, u));
                st16(img, CH_UT + ((kt * 2 + vt) * 2 + 0) * 1024, lane, cvtf<0, 0>(u)); st16(img, CH_UT + ((kt * 2 + vt) * 2 + 1) * 1024, lane, cvtf<1, 0>(u)); }
            f32x16 y = mm(cV[vt][1], fGK[1], mm(cV[vt][0], fGK[0], zero16())); y = mm(nv1, fGB[1], mm(nv0, fGB[0], y));
            st16(img, CH_YL + (vt * 2 + 0) * 1024, lane, cvtf<0, 0>(y)); st16(img, CH_YL + (vt * 2 + 1) * 1024, lane, cvtf<1, 0>(y)); }
#pragma unroll
        for (int kt = 0; kt < 2; ++kt) { f32x16 q = mm(cRh[kt][1], Id[1], mm(cRh[kt][0], Id[0], zero16()));
            q = mm(cvtf<1, 1>(At[kt]), fGB[1], mm(cvtf<0, 1>(At[kt]), fGB[0], q));
            st16(img, CH_Q + (kt * 2 + 0) * 1024, lane, cvtf<0, 0>(q)); st16(img, CH_Q + (kt * 2 + 1) * 1024, lane, cvtf<1, 0>(q)); }
    }
}

__device__ __forceinline__ void ph_scan2(const KP& p, LAS unsigned char* lds, int l, int wave, int lane) {
    unsigned* sdone = (unsigned*)(OWS + WS_CTL) + CW_SDONE + 64 * l;
#ifndef CQ_SLOT_WGS
#define CQ_SLOT_WGS 128
#endif
    if (blockIdx.x >= SC_NCHAIN * 2) {
        const int q0 = (l < 2 ? CQ_J1 : CQ_END0) + (l & 1) * CQ_SLOT_ITEMS;
        cq_static(p, lds, q0, q0 + CQ_SLOT_ITEMS, ((int)blockIdx.x - SC_NCHAIN * 2) * NWAVES + wave, ((int)gridDim.x - SC_NCHAIN * 2) * NWAVES, wave, lane); return; }
    const int chain = blockIdx.x >> 1, vt = blockIdx.x & 1, dir = chain & 1, h = (chain >> 1) & 7, b = chain >> 4;
    const int n = lane & 31, hh = lane >> 5;
    const unsigned char* CH = OWS + WS_CH + (size_t)chain * SC_NCH * CH_BYTES; bf16* Y = (bf16*)(OWS + WS_Y) + (size_t)dir * MROWS * RW + h * 64 + 32 * vt + 4 * hh;
    constexpr int NPIECE = 19, SLOT = NPIECE * 1024, NSLOT = 6, PD = 4, XCH = NSLOT * SLOT;
    int psrc[3], pdst[3];
#pragma unroll
    for (int j = 0; j < 3; ++j) { int f = wave + 8 * j; if (f >= NPIECE) f -= NPIECE;
        pdst[j] = f;
        psrc[j] = f < 12 ? f * 1024 : f < 16 ? CH_UT + ((((f - 12) >> 1) * 2 + vt) * 2 + ((f - 12) & 1)) * 1024 : f < 18 ? CH_YL + (vt * 2 + (f - 16)) * 1024 : CH_EC; }
    const int lane_off[3] = {pdst[0] == 18 ? (lane * 16) & 255 : lane * 16, pdst[1] == 18 ? (lane * 16) & 255 : lane * 16, pdst[2] == 18 ? (lane * 16) & 255 : lane * 16};
#define SC2_ISSUE(ci_, slot_) do { const unsigned char* im_ = CH + (size_t)(ci_) * CH_BYTES; LAS unsigned char* sl_ = lds + (slot_) * SLOT; \
        _Pragma("unroll") for (int j = 0; j < 3; ++j) __builtin_amdgcn_global_load_lds((const unsigned*)(im_ + psrc[j] + lane_off[j]), (LAS unsigned*)(sl_ + pdst[j] * 1024), 16, 0, 0); } while (0)
#define SC2_LD(slot_, piece_) (*(const LAS v4u*)(lds + (slot_) * SLOT + (piece_) * 1024 + lane * 16))
#define SC2_X(par_, k_) (*(LAS v4u*)(lds + XCH + (par_) * 4096 + (k_) * 1024 + lane * 16))
    f32x16 ST[2] = {zero16(), zero16()};
    SC2_ISSUE(0, 0); SC2_ISSUE(1, 1); SC2_ISSUE(2, 2); SC2_ISSUE(3, 3);
    v4u g0, g1, g2, g3, g4, g5, g6, g7, u0, u1, u2, u3; f32x4 ec[8];
#define SC2_PRELOAD(slot_) do { g0 = SC2_LD(slot_, 0); g1 = SC2_LD(slot_, 1); g2 = SC2_LD(slot_, 2); g3 = SC2_LD(slot_, 3); g4 = SC2_LD(slot_, 4); g5 = SC2_LD(slot_, 5); g6 = SC2_LD(slot_, 6); g7 = SC2_LD(slot_, 7); \
        u0 = SC2_LD(slot_, 12); u1 = SC2_LD(slot_, 13); u2 = SC2_LD(slot_, 14); u3 = SC2_LD(slot_, 15); \
        _Pragma("unroll") for (int kq = 0; kq < 8; ++kq) ec[kq] = *(const LAS f32x4*)(lds + (slot_) * SLOT + 18 * 1024 + (32 * (kq >> 2) + 8 * (kq & 3) + 4 * hh) * 4); } while (0)
    for (int ci = 0; ci <= SC_NCH; ++ci) {
        asm volatile("s_waitcnt vmcnt(6)" ::: "memory");
        __builtin_amdgcn_s_barrier();
        asm volatile("" ::: "memory");
        { const int nx = ci + PD < SC_NCH ? ci + PD : SC_NCH - 1; SC2_ISSUE(nx, (ci + PD) % NSLOT); }
        if (wave == 0 && ci < SC_NCH) {
            if (ci == 0) SC2_PRELOAD(0);
            asm volatile("" : "+v"(g0), "+v"(g1), "+v"(g2), "+v"(g3), "+v"(g4), "+v"(g5), "+v"(g6), "+v"(g7), "+v"(u0), "+v"(u1), "+v"(u2), "+v"(u3));
            asm volatile("" : "+v"(ec[0]), "+v"(ec[1]), "+v"(ec[2]), "+v"(ec[3]), "+v"(ec[4]), "+v"(ec[5]), "+v"(ec[6]), "+v"(ec[7]));
            const v4u s00 = cvtf<0, 0>(ST[0]), s01 = cvtf<1, 0>(ST[0]), s10 = cvtf<0, 0>(ST[1]), s11 = cvtf<1, 0>(ST[1]);
            SC2_X(ci & 1, 0) = s00; SC2_X(ci & 1, 1) = s01; SC2_X(ci & 1, 2) = s10; SC2_X(ci & 1, 3) = s11;
            f32x16 a0, a1;
            a0[0] = bflo(u0.x); a0[1] = bfhi(u0.x); a0[2] = bflo(u0.y); a0[3] = bfhi(u0.y); a0[4] = bflo(u0.z); a0[5] = bfhi(u0.z); a0[6] = bflo(u0.w); a0[7] = bfhi(u0.w);
            a0[8] = bflo(u1.x); a0[9] = bfhi(u1.x); a0[10] = bflo(u1.y); a0[11] = bfhi(u1.y); a0[12] = bflo(u1.z); a0[13] = bfhi(u1.z); a0[14] = bflo(u1.w); a0[15] = bfhi(u1.w);
            a1[0] = bflo(u2.x); a1[1] = bfhi(u2.x); a1[2] = bflo(u2.y); a1[3] = bfhi(u2.y); a1[4] = bflo(u2.z); a1[5] = bfhi(u2.z); a1[6] = bflo(u2.w); a1[7] = bfhi(u2.w);
            a1[8] = bflo(u3.x); a1[9] = bfhi(u3.x); a1[10] = bflo(u3.y); a1[11] = bfhi(u3.y); a1[12] = bflo(u3.z); a1[13] = bfhi(u3.z); a1[14] = bflo(u3.w); a1[15] = bfhi(u3.w);
#pragma unroll
            for (int q = 0; q < 4; ++q)
#pragma unroll
                for (int e = 0; e < 4; ++e) { a0[4 * q + e] += ST[0][4 * q + e] * ec[q][e]; a1[4 * q + e] += ST[1][4 * q + e] * ec[4 + q][e]; }
            a0 = mm(g0, s00, a0); a1 = mm(g4, s00, a1); a0 = mm(g1, s01, a0); a1 = mm(g5, s01, a1);
            a0 = mm(g2, s10, a0); a1 = mm(g6, s10, a1); a0 = mm(g3, s11, a0); a1 = mm(g7, s11, a1);
            if (ci + 1 < SC_NCH) SC2_PRELOAD((ci + 1) % NSLOT);
            ST[0] = a0; ST[1] = a1;
            if (lane == 0 && ci == SC_NCH - 24) __hip_atomic_fetch_add(sdone, 1u, __ATOMIC_RELAXED, __HIP_MEMORY_SCOPE_AGENT);
        } else if (wave == 1 && ci >= 1) {
            const int cj = ci - 1, sj = cj % NSLOT, par = cj & 1;
            v4u ya = SC2_LD(sj, 16), yc = SC2_LD(sj, 17), q0 = SC2_LD(sj, 8), q1 = SC2_LD(sj, 9), q2 = SC2_LD(sj, 10), q3 = SC2_LD(sj, 11), x0 = SC2_X(par, 0), x1 = SC2_X(par, 1), x2 = SC2_X(par, 2), x3 = SC2_X(par, 3);
            asm volatile("" : "+v"(ya), "+v"(yc), "+v"(q0), "+v"(q1), "+v"(q2), "+v"(q3), "+v"(x0), "+v"(x1), "+v"(x2), "+v"(x3));
            f32x16 y, y2 = zero16();
            y[0] = bflo(ya.x); y[1] = bfhi(ya.x); y[2] = bflo(ya.y); y[3] = bfhi(ya.y); y[4] = bflo(ya.z); y[5] = bfhi(ya.z); y[6] = bflo(ya.w); y[7] = bfhi(ya.w);
            y[8] = bflo(yc.x); y[9] = bfhi(yc.x); y[10] = bflo(yc.y); y[11] = bfhi(yc.y); y[12] = bflo(yc.z); y[13] = bfhi(yc.z); y[14] = bflo(yc.w); y[15] = bfhi(yc.w);
            y = mm(x0, q0, y); y2 = mm(x2, q2, y2); y = mm(x1, q1, y); y2 = mm(x3, q3, y2);
            const int row = scan_row(b, dir, SC_C * cj + n); bf16* yo = Y + (size_t)row * RW;
#pragma unroll
            for (int q = 0; q < 4; ++q) *(v2u*)(yo + 8 * q) = (v2u){cvtpk(y[4 * q] + y2[4 * q], y[4 * q + 1] + y2[4 * q + 1]), cvtpk(y[4 * q + 2] + y2[4 * q + 2], y[4 * q + 3] + y2[4 * q + 3])};
        }
        asm volatile("s_waitcnt lgkmcnt(0)" ::: "memory");
    }
    asm volatile("s_waitcnt vmcnt(0)" ::: "memory");
#undef SC2_ISSUE
#undef SC2_LD
#undef SC2_X
#undef SC2_PRELOAD
}

__device__ __forceinline__ float sum8(float v) { v += __shfl_xor(v, 1); v += __shfl_xor(v, 2); v += __shfl_xor(v, 4); return v; }
__device__ __forceinline__ void unpack8(v4u s, float (&v)[8]) { v[0] = bflo(s.x); v[1] = bfhi(s.x); v[2] = bflo(s.y); v[3] = bfhi(s.y); v[4] = bflo(s.z); v[5] = bfhi(s.z); v[6] = bflo(s.w); v[7] = bfhi(s.w); }
__device__ __forceinline__ void ld8f(const float* q, float (&v)[8]) { const f32x4 a = *(const f32x4*)q, b = *(const f32x4*)(q + 4); v[0] = a[0]; v[1] = a[1]; v[2] = a[2]; v[3] = a[3]; v[4] = b[0]; v[5] = b[1]; v[6] = b[2]; v[7] = b[3]; }
__device__ __forceinline__ v4u pack8(const float (&v)[8]) { v4u o; o.x = cvtpk(v[0], v[1]); o.y = cvtpk(v[2], v[3]); o.z = cvtpk(v[4], v[5]); o.w = cvtpk(v[6], v[7]); return o; }

__device__ __forceinline__ void ph_readout2(const KP& p, int l, int gw, int NGW, int lane) {
    const bf16* P = (const bf16*)(OWS + WS_P); const bf16* LO = (const bf16*)(OWS + WS_LO); const bf16* Y = (const bf16*)(OWS + WS_Y);
    bf16* MI = (bf16*)(OWS + WS_MIXIN); constexpr size_t PA = (size_t)MROWS * RW; const int c0 = lane * 8;
    const int nrows = l == DEPTH - 1 ? NLAT : MROWS;
#pragma unroll 2
    for (int row = gw; row < nrows; row += NGW) { const bf16* pr = P + (size_t)row * NP; const bf16* lo = LO + (size_t)row * NLO;
        int t, len; if (row < NLAT) { t = row & 63; len = 64; } else { t = (row - NLAT) & 255; len = 256; }
        const v4u kw = *(const v4u*)(pr + PC_K + c0), rw = *(const v4u*)(pr + PC_R + c0), vw = *(const v4u*)(pr + PC_V + c0);
        const v4u cbw = *(const v4u*)(pr + PC_CB + c0), ccw = *(const v4u*)(pr + PC_CC + c0), chw = *(const v4u*)(pr + PC_CH + c0);
        v4u ccp = (v4u){0u, 0u, 0u, 0u}, chp = ccp, ccn = ccp, chn = ccp;
        if (t > 0) { ccp = *(const v4u*)(pr - NP + PC_CC + c0); chp = *(const v4u*)(pr - NP + PC_CH + c0); }
        if (t < len - 1) { ccn = *(const v4u*)(pr + NP + PC_CC + c0); chn = *(const v4u*)(pr + NP + PC_CH + c0); }
        float yf[8], yb[8], la0[8], la1[8], g[8];
        unpack8(*(const v4u*)(Y + (size_t)row * RW + c0), yf); unpack8(*(const v4u*)(Y + PA + (size_t)row * RW + c0), yb); unpack8(*(const v4u*)(lo + 1024 + c0), la0); unpack8(*(const v4u*)(lo + 1536 + c0), la1); unpack8(*(const v4u*)(lo + 2048 + c0), g);
        float a0[8], a1[8], ka[8], rkp[8], lg[8], lb[8];
        ld8f(PIN(I_A0) + (l * 2 + 0) * RW + c0, a0); ld8f(PIN(I_A0) + (l * 2 + 1) * RW + c0, a1); ld8f(PIN(I_KA) + l * RW + c0, ka); ld8f(PIN(I_RK) + l * RW + c0, rkp);
        ld8f(PIN(I_LNXG) + l * RW + c0, lg); ld8f(PIN(I_LNXB) + l * RW + c0, lb);
        float kv[8], rv[8], vv[8]; unpack8(kw, kv); unpack8(rw, rv); unpack8(vw, vv);
        float y[8], s = 0.f, rk = 0.f;
#pragma unroll
        for (int j = 0; j < 8; ++j) { y[j] = yf[j] + yb[j]; s += y[j]; const float av = sigm(a0[j] + la0[j]) + sigm(a1[j] + la1[j]); rk += rv[j] * kv[j] * (2.f + (av - 2.f) * ka[j]) * rkp[j]; }
        const float mu = sum8(s) * (1.f / 64.f); rk = sum8(rk); float q = 0.f;
#pragma unroll
        for (int j = 0; j < 8; ++j) { y[j] -= mu; q += y[j] * y[j]; }
        const float rstd = 1.f / sqrtf(sum8(q) * (1.f / 64.f) + GN_EPS);
        float o[8];
#pragma unroll
        for (int j = 0; j < 8; ++j) o[j] = (y[j] * rstd * lg[j] + lb[j] + rk * vv[j]) * g[j];
        float orw[8];
#pragma unroll
        for (int j = 0; j < 8; ++j) orw[j] = o[j];
        float cb[8], cc[8], ch[8], pcc[8], pch[8], ncc[8], nch[8], w0[8], w1[8], w2[8];
        unpack8(cbw, cb); unpack8(ccw, cc); unpack8(chw, ch); unpack8(ccp, pcc); unpack8(chp, pch); unpack8(ccn, ncc); unpack8(chn, nch);
        const float* cw = PIN(I_CONVW) + (size_t)l * 3 * RW + c0; ld8f(cw, w0); ld8f(cw + RW, w1); ld8f(cw + 2 * RW, w2);
#pragma unroll
        for (int j = 0; j < 8; ++j) o[j] = cb[j] * (pcc[j] * pch[j] * w0[j] + cc[j] * ch[j] * w1[j] + ncc[j] * nch[j] * w2[j]);
        float am = 0.f;
#pragma unroll
        for (int j = 0; j < 8; ++j) am = fmaxf(am, fmaxf(fabsf(orw[j]), fabsf(o[j])));
#pragma unroll
        for (int sh = 1; sh < 64; sh <<= 1) am = fmaxf(am, __shfl_xor(am, sh));
        am = fmaxf(am, 1e-30f); const float inv = 127.f / am; unsigned char* m8 = (unsigned char*)MI + (size_t)row * D + c0;
        *(v2u*)m8 = (v2u){q8pack(orw[0] * inv, orw[1] * inv, orw[2] * inv, orw[3] * inv), q8pack(orw[4] * inv, orw[5] * inv, orw[6] * inv, orw[7] * inv)};
        *(v2u*)(m8 + RW) = (v2u){q8pack(o[0] * inv, o[1] * inv, o[2] * inv, o[3] * inv), q8pack(o[4] * inv, o[5] * inv, o[6] * inv, o[7] * inv)};
        if (lane == 0) ((float*)(OWS + WS_SAM))[row] = am * (1.f / 127.f);
    }
}


template <int KS> __device__ __forceinline__ void lora_afrag(const v4u (&raw)[KS], int fn, v4u (&af)[KS]) {
#pragma unroll
    for (int s = 0; s < KS; ++s) { float v[8]; unpack8(raw[s], v);
        if (fn == 0) {
#pragma unroll
            for (int j = 0; j < 8; ++j) v[j] = 1.f - 2.f * __builtin_amdgcn_rcpf(1.f + __expf(2.f * v[j])); }
        else if (fn == 2) {
#pragma unroll
            for (int j = 0; j < 8; ++j) v[j] = __builtin_amdgcn_rcpf(1.f + __expf(-v[j])); }
        af[s] = pack8(v); }
}
template <int KS, int NT> __device__ __forceinline__ void lora_task(const bf16* P, int col0, int fn, const bf16* wt, bf16* LOg, int ct0, int rb0, int rb1, int n, int hh) {
    v4u bfr[NT][KS];
#pragma unroll
    for (int t = 0; t < NT; ++t)
#pragma unroll
        for (int s = 0; s < KS; ++s) bfr[t][s] = *(const v4u*)(wt + (size_t)(32 * (ct0 + t) + n) * (16 * KS) + 8 * hh + 16 * s);
    v4u raw[KS];
#pragma unroll
    for (int s = 0; s < KS; ++s) raw[s] = *(const v4u*)(P + (size_t)(rb0 * 32 + n) * NP + col0 + 16 * s + 8 * hh);
    for (int rb = rb0; rb < rb1; ++rb) {
        v4u af[KS]; lora_afrag<KS>(raw, fn, af);
        if (rb + 1 < rb1) {
#pragma unroll
            for (int s = 0; s < KS; ++s) raw[s] = *(const v4u*)(P + (size_t)((rb + 1) * 32 + n) * NP + col0 + 16 * s + 8 * hh); }
        int no = n, ho = hh; asm volatile("" : "+v"(no), "+v"(ho));
        bf16* out = LOg + (size_t)(rb * 32 + 4 * ho) * NLO + 32 * ct0 + no;
#pragma unroll
        for (int t = 0; t < NT; ++t) { f32x16 acc = zero16();
#pragma unroll
            for (int s = 0; s < KS; ++s) acc = mm(af[s], bfr[t][s], acc);
#pragma unroll
            for (int r = 0; r < 16; ++r) out[(size_t)((r & 3) + 8 * (r >> 2)) * NLO + 32 * t] = (bf16)f2bf(acc[r]); }
    }
}
__device__ __forceinline__ void ph_lora(const KP& p, int l, int gw, int NGW, int lane) {
    const bf16* P = (const bf16*)(OWS + WS_P); bf16* LO = (bf16*)(OWS + WS_LO); float* NRM = (float*)(OWS + WS_RKS);
    const bf16* LW = (const bf16*)(OWS + WS_LORA) + (size_t)l * LORAW_PER_LAYER; const int n = lane & 31, hh = lane >> 5;
    constexpr int RCH = 7, NRB = MROWS / 32, NCHK = (NRB + RCH - 1) / RCH;
    for (int task = gw; task < NCHK * 24; task += NGW) { const int ctk = task % 24, chunk = task / 24, rb0 = chunk * RCH, rb1 = rb0 + RCH < NRB ? rb0 + RCH : NRB;
        if (ctk < 16) { const int grp = ctk >> 2; lora_task<4, 4>(P, grp < 2 ? PC_WD + 64 * grp : PC_AD + 64 * (grp - 2), grp < 2 ? 0 : 1, LW + (size_t)grp * 512 * 64, LO + grp * 512, (ctk & 3) * 4, rb0, rb1, n, hh); }
        else lora_task<8, 2>(P, PC_GD, 2, LW + (size_t)4 * 512 * 64, LO + 4 * 512, (ctk - 16) * 2, rb0, rb1, n, hh); }
    float kkc[8]; ld8f(PIN(I_KK) + l * RW + lane * 8, kkc);
    for (int row = gw; row < MROWS; row += NGW) { const v4u kw = *(const v4u*)(P + (size_t)row * NP + PC_K + lane * 8); float kv[8]; unpack8(kw, kv); float ss = 0.f;
#pragma unroll
        for (int j = 0; j < 8; ++j) { const float t = kv[j] * kkc[j]; ss += t * t; }
        ss = sum8(ss); if ((lane & 7) == 0) NRM[row * 8 + (lane >> 3)] = 1.f / fmaxf(sqrtf(ss), 1e-12f); }
}

__device__ __forceinline__ void ph_moe_gather(const KP& p, int l, int gw, int NGW, int lane) {
    const unsigned* gcnt = (const unsigned*)(OWS + WS_CTL) + CW_GCNT + 64 * (l >> 1);
    int cnt[8], pb[9]; pb[0] = 0;
#pragma unroll
    for (int e = 0; e < 8; ++e) { cnt[e] = (int)gcnt[e]; pb[e + 1] = pb[e] + ((cnt[e] + 255) & ~255); }
    const unsigned* rowlist = (const unsigned*)(OWS + WS_ROWLIST); const float* wsel = (const float*)(OWS + WS_WSEL); float* wsort = (float*)(OWS + WS_WSORT);
    const unsigned char* H8 = OWS + WS_H8; unsigned char* HG = OWS + WS_HG; const float* sa = (const float*)(OWS + WS_SA); float* sag = (float*)(OWS + WS_SAG);
    for (int pos = gw; pos < pb[8]; pos += NGW) {
        int e = 0, base = 0, ce = cnt[0];
#pragma unroll
        for (int k = 1; k < 8; ++k) if (pos >= pb[k]) { e = k; base = pb[k]; ce = cnt[k]; }
        const int rank = pos - base; v4u a = (v4u){0u, 0u, 0u, 0u}; float w = 0.f, sc = 0.f;
        if (rank < ce) { const unsigned ent = rowlist[(size_t)e * MROWS + rank]; a = *(const v4u*)(H8 + (size_t)(ent >> 1) * D + lane * 16); w = wsel[ent]; sc = sa[ent >> 1]; }
        *(v4u*)(HG + (size_t)pos * D + lane * 16) = a;
        if (lane == 0) { wsort[pos] = w; sag[pos] = sc; }
    }
}

__device__ __forceinline__ void ph_ln(const KP& p, LAS unsigned char* lds, int l, int which, int tid, int wave, int gw, int NGW, int lane) {
    const float* modv = (const float*)(OWS + WS_MODV); _Float16* X = (_Float16*)(OWS + WS_X);
    const bf16* BR = (const bf16*)(OWS + (which == 0 ? WS_MIXO : WS_F)); const float* BP = (const float*)(OWS + (which == 0 ? WS_MIXP : WS_FP));
    const float* lg = PIN(which == 0 ? I_LN1G : I_LN2G) + l * D; const float* lb = PIN(which == 0 ? I_LN1B : I_LN2B) + l * D;
    const bool moe = (which == 0) && (l & 1); const bool last = (which == 1) && (l == DEPTH - 1); const bool moe_out = (which == 1) && (l & 1);
    LAS int* lcnt = (LAS int*)lds;
    LAS int* lsel = (LAS int*)(lds + 64);
    int nloc = 0;
    if (moe) { if (tid < 16) lcnt[tid] = 0; __syncthreads(); }
    int pbs[9]; pbs[0] = 0;
    if (moe_out) { const unsigned* gcnt = (const unsigned*)(OWS + WS_CTL) + CW_GCNT + 64 * (l >> 1);
#pragma unroll
        for (int e = 0; e < 8; ++e) pbs[e + 1] = pbs[e] + (int)((gcnt[e] + 255u) & ~255u); }
    f32x4 gt[4], g4[4], b4[4], sh[4], sc[4]; ld_row(lg, lane, g4); ld_row(lb, lane, b4);
#pragma unroll 2
    for (int it = 0; it < 9; ++it) {
        if (it == 8 && (gw >= NCTX || l == DEPTH - 1)) break;
        const int row = it < 8 ? (gw >> 9) * SEQ + (gw & 511) + 512 * it : NLAT + gw;
        const int mr = mod_row(row); const float* mv = modv + (size_t)(l * 5 + mr) * NMOD;
        if (it == 0 || it == 8) { ld_row(mv + (which == 0 ? 2048 : 5120), lane, gt);
            if (!last) { const float* mv2 = which == 0 ? mv + 3072 : modv + (size_t)((l + 1) * 5 + mr) * NMOD; ld_row(mv2, lane, sh); ld_row(mv2 + 1024, lane, sc); } }
        f32x4 x[4], br[4], t[4];
        if (l == 0 && which == 0) ld_row(row < NLAT ? PIN(I_X) + (size_t)row * D : PIN(I_CTX) + (size_t)(row - NLAT) * D, lane, x); else ld_row_h16(X + (size_t)row * D, lane, x);
        if (moe_out) { const int* ts = (const int*)(OWS + WS_TOKSEL) + row * 4; const int e0 = ts[0], r0 = ts[1], e1 = ts[2], r1 = ts[3]; int b0 = 0, b1 = 0;
#pragma unroll
            for (int k = 1; k < 8; ++k) { if (e0 >= k) b0 = pbs[k]; if (e1 >= k) b1 = pbs[k]; }
            f32x4 ba[4], bb[4]; const int q0 = b0 + r0, q1 = b1 + r1; constexpr int MM = MOE_MAIN_PANELS * 256;
            if (q0 < MM) ld_row_bf16(BR + (size_t)q0 * D, lane, ba); else ld_row_parts<4>(BP + (size_t)(q0 - MM) * D, (size_t)MOE_TAIL_ROWS * D, lane, ba);
            if (q1 < MM) ld_row_bf16(BR + (size_t)q1 * D, lane, bb); else ld_row_parts<4>(BP + (size_t)(q1 - MM) * D, (size_t)MOE_TAIL_ROWS * D, lane, bb);
#pragma unroll
            for (int j = 0; j < 4; ++j) br[j] = ba[j] + bb[j]; }
        else if (row < NLAT) ld_row_bf16(BR + (size_t)row * D, lane, br);
        else if (which == 0) ld_row_parts<2>(BP + (size_t)(row - NLAT) * D, (size_t)NCTX * D, lane, br);
        else ld_row_parts<7>(BP + (size_t)(row - NLAT) * D, (size_t)NCTX * D, lane, br);
        float s = 0.f;
#pragma unroll
        for (int j = 0; j < 4; ++j) { t[j] = DN_ALPHA * x[j] + gt[j] * br[j]; s += (t[j][0] + t[j][1]) + (t[j][2] + t[j][3]); }
        const float mean = wave_sum(s) * (1.f / D); float s2 = 0.f;
#pragma unroll
        for (int j = 0; j < 4; ++j) { t[j] = t[j] - mean; s2 += (t[j][0] * t[j][0] + t[j][1] * t[j][1]) + (t[j][2] * t[j][2] + t[j][3] * t[j][3]); }
        const float rstd = 1.f / sqrtf(wave_sum(s2) * (1.f / D) + LN_EPS);
#pragma unroll
        for (int j = 0; j < 4; ++j) x[j] = t[j] * rstd * g4[j] + b4[j];
        if (last) {
#if PROBE_DUP & (128 | 256)
            { const unsigned* cw = (const unsigned*)(OWS + WS_CTL); const float cval = 10.f * ((float)cw[20001] / 1024.f) / fmaxf((float)cw[20000], 1.f);
#pragma unroll
              for (int j = 0; j < 4; ++j) x[j] = (f32x4){cval, cval, cval, cval}; }
#endif
            if (row < NLAT) st_row(p.out + (size_t)row * D, lane, x); continue; }
        st_row_h16(X + (size_t)row * D, lane, x);
        f32x4 hh[4];
#pragma unroll
        for (int j = 0; j < 4; ++j) hh[j] = x[j] * (1.f + sc[j]) + sh[j];
        st_row_q8(OWS + WS_H8, (float*)(OWS + WS_SA), row, lane, hh);
        if (moe) {
            const float* rw = PIN(I_RTW) + (size_t)(l >> 1) * D * NE; float lgt[8];
#pragma unroll
            for (int e = 0; e < 8; ++e) lgt[e] = 0.f;
#pragma unroll
            for (int j = 0; j < 4; ++j)
#pragma unroll
                for (int i = 0; i < 4; ++i) { const f32x4* wp = (const f32x4*)(rw + (size_t)(4 * lane + 256 * j + i) * NE); const f32x4 w0 = wp[0], w1 = wp[1]; const float hv = hh[j][i];
                    lgt[0] += hv * w0[0]; lgt[1] += hv * w0[1]; lgt[2] += hv * w0[2]; lgt[3] += hv * w0[3]; lgt[4] += hv * w1[0]; lgt[5] += hv * w1[1]; lgt[6] += hv * w1[2]; lgt[7] += hv * w1[3]; }
#pragma unroll
            for (int e = 0; e < 8; ++e) lgt[e] = wave_sum(lgt[e]) + PIN(I_RTB)[(l >> 1) * NE + e];
            float v0 = lgt[0]; int i0 = 0;
#pragma unroll
            for (int e = 1; e < 8; ++e) if (lgt[e] > v0) { v0 = lgt[e]; i0 = e; }
            float v1 = -3.0e38f; int i1 = -1;
#pragma unroll
            for (int e = 0; e < 8; ++e) if (e != i0 && lgt[e] > v1) { v1 = lgt[e]; i1 = e; }
            const float w0 = 1.f / (1.f + expf(v1 - v0)), w1 = 1.f - w0;
            if (lane == 0) { const int lr0 = __hip_atomic_fetch_add(lcnt + i0, 1, __ATOMIC_RELAXED, __HIP_MEMORY_SCOPE_WORKGROUP), lr1 = __hip_atomic_fetch_add(lcnt + i1, 1, __ATOMIC_RELAXED, __HIP_MEMORY_SCOPE_WORKGROUP); const int li = nloc * NWAVES + wave;
                lsel[li * 8 + 0] = row; lsel[li * 8 + 1] = i0; lsel[li * 8 + 2] = lr0; lsel[li * 8 + 3] = i1; lsel[li * 8 + 4] = lr1;
                ((float*)(OWS + WS_WSEL))[row * 2] = w0; ((float*)(OWS + WS_WSEL))[row * 2 + 1] = w1; }
            ++nloc;
        }
    }
    if (moe) {
        __syncthreads();
        unsigned* gcnt = (unsigned*)(OWS + WS_CTL) + CW_GCNT + 64 * (l >> 1);
        if (tid < 8) lcnt[8 + tid] = (int)__hip_atomic_fetch_add(gcnt + tid, (unsigned)lcnt[tid], __ATOMIC_RELAXED, __HIP_MEMORY_SCOPE_AGENT);
        __syncthreads();
        unsigned* rowlist = (unsigned*)(OWS + WS_ROWLIST); int* toksel = (int*)(OWS + WS_TOKSEL);
        if (tid < 16 * NWAVES) { const int k = tid / NWAVES, w = tid % NWAVES; if (k < 8 || (k == 8 && (int)blockIdx.x * NWAVES + w < NCTX && l != DEPTH - 1)) { const int li = k * NWAVES + w;
            const int row = lsel[li * 8 + 0], e0 = lsel[li * 8 + 1], r0 = lcnt[8 + e0] + lsel[li * 8 + 2], e1 = lsel[li * 8 + 3], r1 = lcnt[8 + e1] + lsel[li * 8 + 4];
            rowlist[(size_t)e0 * MROWS + r0] = (unsigned)row * 2u; rowlist[(size_t)e1 * MROWS + r1] = (unsigned)row * 2u + 1u;
            toksel[row * 4 + 0] = e0; toksel[row * 4 + 1] = r0; toksel[row * 4 + 2] = e1; toksel[row * 4 + 3] = r1; } }
    }
}


#ifndef PROBE_WHICH
#define PROBE_WHICH(x, y) (x)
#endif
#if PROBE_DUP & 128
__device__ __forceinline__ void ph_check_up(const KP& p, int gw, int lane) {
    if (gw >= 64) return;
    const float* X = (const float*)(OWS + WS_X); const float* modv = (const float*)(OWS + WS_MODV); const bf16* ACT = (const bf16*)(OWS + WS_ACT);
    const int row = gw * 257, c = lane * 56 + (gw & 7), mr = mod_row(row); const float* mv = modv + (size_t)(0 * 5 + mr) * NMOD;
    const signed char* H8 = (const signed char*)(OWS + WS_H8); const signed char* W8 = (const signed char*)(OWS + WS_F13); const float* SA = (const float*)(OWS + WS_SA); const unsigned* AM = (const unsigned*)(OWS + WS_AMAX);
    const int j1 = 8 * (c >> 2) + (c & 3), j3 = j1 + 4; int ia = 0, ib = 0;
    for (int k = 0; k < D; ++k) { const int h = H8[(size_t)row * D + k]; ia += h * W8[(size_t)j1 * D + k]; ib += h * W8[(size_t)j3 * D + k]; }
    const float a = (float)ia * SA[row] * __builtin_bit_cast(float, AM[j1]) * (1.f / 127.f), b = (float)ib * SA[row] * __builtin_bit_cast(float, AM[j3]) * (1.f / 127.f);
    (void)X; (void)mv;
    const float ref = a / (1.f + expf(-a)) * b, got = bf2f(ACT[(size_t)row * DFF + c]);
    const float da = ((const float*)(OWS + WS_F))[(size_t)row * DFF + c], db = ((const float*)(OWS + WS_F))[(size_t)4096 * DFF + (size_t)row * DFF + c]; (void)got; (void)db;
    if (row < 4096 && abs(ia) > 1000) { const float ratio = 10.f * fminf(fabsf(PROBE_WHICH(da / a, db / b) - 1.f), 0.4f);
        __hip_atomic_fetch_add((unsigned*)(OWS + WS_CTL) + 20000, 1u, __ATOMIC_RELAXED, __HIP_MEMORY_SCOPE_AGENT); __hip_atomic_fetch_add((unsigned*)(OWS + WS_CTL) + 20001, (unsigned)(ratio * 1024.f), __ATOMIC_RELAXED, __HIP_MEMORY_SCOPE_AGENT); }
}
#endif

#if PROBE_DUP & 256
__device__ __forceinline__ void ph_check_mfma(const KP& p, int lane) {
    typedef int i32x4 __attribute__((ext_vector_type(4)));
    const int r = lane & 15, g = lane >> 4; unsigned aw[4], bw[4];
#pragma unroll
    for (int q = 0; q < 4; ++q) { unsigned a = 0, b = 0;
#pragma unroll
        for (int t = 0; t < 4; ++t) { const int k = 16 * g + 4 * q + t; const int av = ((r * 7 + k * 3) % 5) - 2, bv = ((r * 5 + k * 11) % 7) - 3; a |= (unsigned)(av & 255) << (8 * t); b |= (unsigned)(bv & 255) << (8 * t); }
        aw[q] = a; bw[q] = b; }
    i32x4 c = {0, 0, 0, 0};
    c = __builtin_amdgcn_mfma_i32_16x16x64_i8((i32x4){(int)aw[0], (int)aw[1], (int)aw[2], (int)aw[3]}, (i32x4){(int)bw[0], (int)bw[1], (int)bw[2], (int)bw[3]}, c, 0, 0, 0);
    bool bad = false;
#pragma unroll
    for (int reg = 0; reg < 4; ++reg) { const int i = 4 * g + reg, j = r; int e = 0;
        for (int k = 0; k < 64; ++k) e += (((i * 7 + k * 3) % 5) - 2) * (((j * 5 + k * 11) % 7) - 3);
        if (c[reg] != e) bad = true; }
    if (bad) __hip_atomic_fetch_add((unsigned*)(OWS + WS_CTL) + 20000, 1000u, __ATOMIC_RELAXED, __HIP_MEMORY_SCOPE_AGENT);
}
#endif
__global__ void __launch_bounds__(NWAVES * 64, 2) fwd_kernel(KP p_arg) {
    const KP& p = *(const KP*)__builtin_amdgcn_kernarg_segment_ptr(); (void)p_arg;
    extern __shared__ __attribute__((aligned(16))) unsigned char lds_raw[];
    LAS unsigned char* lds = (LAS unsigned char*)lds_raw;
    volatile LAS unsigned* MISC = (volatile LAS unsigned*)(lds + MISC_OFF);
    const int G = gridDim.x, NGW = G * NWAVES;
    for (int u = threadIdx.x; u < (LDS_BYTES - LDSCTL_OFF) / 4; u += NWAVES * 64) ((LAS unsigned*)(lds + LDSCTL_OFF))[u] = 0u;
    __syncthreads();
    unsigned* ctl = (unsigned*)(OWS + WS_CTL);
    const bool single = p.ph < 0;
    XcdBarrier bar; bar.bar = ctl + CW_BAR; bar.x = 0; bar.st = nullptr;
    if (single) bar = xcd_barrier_post(ctl + CW_BAR, MISC + 8);
    int phc = 0;
#ifndef PROBE_DUP
#define PROBE_DUP 0
#endif
#define REP(bit) for (int rep_ = 0; rep_ < ((PROBE_DUP & (bit)) ? 2 : 1); ++rep_)
#define RUN() (single || p.ph == phc)
#define FRESH() int tid = threadIdx.x; asm volatile("" : "+v"(tid)); const int lane = tid & 63, wave = __builtin_amdgcn_readfirstlane(tid >> 6), gw = blockIdx.x * NWAVES + wave; (void)lane; (void)gw
#define SEAM() do { if (single) { XcdBarrier b2_ = bar; b2_.bar = (unsigned*)(OWS + WS_CTL) + CW_BAR; xcd_barrier(b2_); if (PROBE_DUP & 32) { XcdBarrier b3_ = bar; b3_.bar = (unsigned*)(OWS + WS_CTL) + CW_BAR; xcd_barrier(b3_); } } ++phc; } while (0)

    REP(4) if (RUN()) { FRESH(); ph_modvec(p, lds, tid); __syncthreads(); ph_convert(p, lds, gw, NGW, wave, lane); cq_static(p, lds, 3 * CQ_IN + 3 * CQ_OUT + 2 * CQ_UP, CQ_J1, gw, NGW, wave, lane); ph_amax(p, gw, NGW, lane); }
    SEAM();
#if PROBE_DUP & 256
    if (blockIdx.x == 0 && threadIdx.x < 64) ph_check_mfma(p, threadIdx.x);
#endif
    if (RUN()) { FRESH(); ph_init_rows(p, gw, NGW, lane); cq_static(p, lds, -CQ_NEG, 3 * CQ_IN + 3 * CQ_OUT + 2 * CQ_UP, gw, NGW, wave, lane); }
    SEAM();
    for (int ll = 0; ll < DEPTH; ++ll) {
#define l (ll + opaque_zero_i())
         if (RUN()) { pg8::Gemm g{(const bf16*)(OWS + WS_H8), (const bf16*)(OWS + WS_WIN) + (size_t)l * (NP * D / 2), MROWS, NP, D / 2, D / 2}; pg8::StaticOrder S; S.init(MROWS, NP, G, (int)blockIdx.x);
            pg8::EpiBf16S8 E{(bf16*)(OWS + WS_P), NP, (const float*)(OWS + WS_SA), (const float*)(OWS + WS_AMAX) + AM_IN + l * NP}; pg8::gemm_phase<pg8::EpiBf16S8, pg8::StaticOrder, true, true, true>(lds, g, S, E); }
        if (RUN()) { FRESH(); const int segb = ll < 2 ? CQ_J1 : CQ_END0; cq_idle(p, lds, segb, ll >> 1, ll * 4 + 0, IDLE_IN0, tid, wave, lane); }
        SEAM();
        REP(8) if (RUN()) { FRESH(); ph_lora(p, l, gw, NGW, lane); }
        SEAM();
        REP(1) if (RUN()) { FRESH(); ph_scan1(p, l, gw, NGW, lane); }
        SEAM();
        REP(2) if (RUN()) { FRESH(); ph_scan2(p, lds, l, wave, lane); }
        SEAM();
        REP(64) if (RUN()) { FRESH(); ph_readout2(p, l, gw, NGW, lane); }
        SEAM();
         if (RUN()) {
            { pg8::Gemm g{(const bf16*)(OWS + WS_MIXIN), (const bf16*)(OWS + WS_WOUT) + (size_t)l * (D * D / 2), NLAT, D, D / 2, D / 2}; pg8::StaticOrder S; S.init(NLAT, D, G, (int)blockIdx.x);
              pg8::EpiBf16S8 E{(bf16*)(OWS + WS_MIXO), D, (const float*)(OWS + WS_SAM), (const float*)(OWS + WS_AMAX) + AM_OUT + l * D}; pg8::gemm_phase<pg8::EpiBf16S8, pg8::StaticOrder, true, true, true>(lds, g, S, E); }
            if (ll < DEPTH - 1) { pg8::Gemm g{(const bf16*)(OWS + WS_MIXIN), (const bf16*)(OWS + WS_WOUT) + (size_t)l * (D * D / 2), NCTX, D, D / 4, D / 2}; pg8::SplitOrder S{NCTX / 256, D / 256, 2, G, (int)blockIdx.x, NLAT / 256, 0, 0, 0, 0, 0, 0, 0, 0};
              pg8::EpiPartS8 E{(float*)(OWS + WS_MIXP), D, (size_t)NCTX * D, NLAT / 256, (const float*)(OWS + WS_SAM), (const float*)(OWS + WS_AMAX) + AM_OUT + l * D}; pg8::gemm_phase<pg8::EpiPartS8, pg8::SplitOrder, true, true, true>(lds, g, S, E); }
        }
        if (RUN() && ll < DEPTH - 1) { FRESH(); const int segb = ll < 2 ? CQ_J1 : CQ_END0; cq_idle(p, lds, segb, ll >> 1, ll * 4 + 1, IDLE_OT0, tid, wave, lane); }
        SEAM();
        for (int rep2_ = 0; rep2_ < (((PROBE_DUP & 512) && ll == 0) ? 5 : 1); ++rep2_) if (RUN()) { FRESH(); ph_ln(p, lds, l, 0, tid, wave, gw, NGW, lane); if (ll & 1) { __syncthreads(); const int cur_ = (int)__hip_atomic_load((const unsigned*)(OWS + WS_CTL) + CW_ICUR + 64 * (ll >> 1), __ATOMIC_RELAXED, __HIP_MEMORY_SCOPE_AGENT); cq_static(p, lds, (l == 1 ? CQ_J1 : CQ_END0) + CQO_DYN + (cur_ < CQ_DYN_LIM ? cur_ : CQ_DYN_LIM), l == 1 ? CQ_END0 : CQ_END1, gw, NGW, wave, lane); } }
        SEAM();
        if ((l & 1) == 0) {
            const int fi = l >> 1;
             if (RUN()) { pg8::Gemm g{(const bf16*)(OWS + WS_H8), (const bf16*)(OWS + WS_F13) + (size_t)fi * DFF * D, MROWS, 2 * DFF, D / 2, D / 2}; pg8::StaticOrder S; S.init(MROWS, 2 * DFF, G, (int)blockIdx.x);
                constexpr int NOE = 0x7fffffff; pg8::EpiSwiGLU8 E{(bf16*)(OWS + WS_ACT), DFF, nullptr, (const float*)(OWS + WS_SA), (const unsigned*)(OWS + WS_AMAX) + (size_t)fi * 2 * DFF, NOE, NOE, NOE, NOE, NOE, NOE, NOE};
#if PROBE_DUP & 128
                E.dbg = (int*)(OWS + WS_F);
#endif
                pg8::gemm_phase<pg8::EpiSwiGLU8, pg8::StaticOrder, true, true, true>(lds, g, S, E); }
            if (RUN()) { FRESH(); const int segb = ll < 2 ? CQ_J1 : CQ_END0; cq_idle(p, lds, segb, ll >> 1, ll * 4 + 2, IDLE_UP0, tid, wave, lane); }
            SEAM();
#if PROBE_DUP & 128
            if (ll == 0) { if (RUN()) { FRESH(); ph_check_up(p, gw, lane); } SEAM(); }
#endif
             if (RUN()) {
                { pg8::Gemm g{(const bf16*)(OWS + WS_ACT), (const bf16*)(OWS + WS_F2) + (size_t)fi * D * DFF, NLAT, D, DFF, DFF}; pg8::StaticOrder S; S.init(NLAT, D, G, (int)blockIdx.x);
                  pg8::EpiBf16<0> E{(bf16*)(OWS + WS_F), D, nullptr, 0, 0, 1.f}; pg8::gemm_phase<pg8::EpiBf16<0>, pg8::StaticOrder, true, true>(lds, g, S, E); }
                { pg8::Gemm g{(const bf16*)(OWS + WS_ACT), (const bf16*)(OWS + WS_F2) + (size_t)fi * D * DFF, NCTX, D, DFF / 7, DFF}; pg8::SplitOrder S{NCTX / 256, D / 256, 7, G, (int)blockIdx.x, NLAT / 256, 0, 0, 0, 0, 0, 0, 0, 0};
                  pg8::EpiPart E{(float*)(OWS + WS_FP), D, (size_t)NCTX * D, NLAT / 256}; pg8::gemm_phase<pg8::EpiPart, pg8::SplitOrder, true, true>(lds, g, S, E); }
            }
            if (RUN()) { FRESH(); const int segb = ll < 2 ? CQ_J1 : CQ_END0; cq_idle(p, lds, segb, ll >> 1, ll * 4 + 3, IDLE_DT0, tid, wave, lane); }
            SEAM();
        } else {
            if (RUN()) { FRESH(); ph_moe_gather(p, l, gw, NGW, lane); }
            SEAM();
            {   const unsigned* gcnt = (const unsigned*)(OWS + WS_CTL) + CW_GCNT + 64 * (l >> 1); int pbp[9]; pbp[0] = 0;
#pragma unroll
                for (int e = 0; e < 8; ++e) pbp[e + 1] = pbp[e] + (int)((gcnt[e] + 255u) >> 8);
                const int mrows = pbp[8] * 256;
                 if (RUN()) { pg8::Gemm g{(const bf16*)(OWS + WS_HG), (const bf16*)(OWS + WS_MOEW13), mrows, 2 * DFF, D / 2, D / 2}; pg8::MoeOrder S; S.init(mrows, 2 * DFF, G, (int)blockIdx.x);
                    S.pb1 = pbp[1]; S.pb2 = pbp[2]; S.pb3 = pbp[3]; S.pb4 = pbp[4]; S.pb5 = pbp[5]; S.pb6 = pbp[6]; S.pb7 = pbp[7]; S.estride = (size_t)DFF * D;
                    pg8::EpiSwiGLU8 E{(bf16*)(OWS + WS_ACT), DFF, (const float*)(OWS + WS_WSORT), (const float*)(OWS + WS_SAG), (const unsigned*)(OWS + WS_AMAX) + (size_t)(2 + 8 * (l >> 1)) * 2 * DFF, pbp[1], pbp[2], pbp[3], pbp[4], pbp[5], pbp[6], pbp[7]};
                    pg8::gemm_phase<pg8::EpiSwiGLU8, pg8::MoeOrder, true, true, true>(lds, g, S, E); }
                SEAM();
                 if (RUN()) {
                    { pg8::Gemm g{(const bf16*)(OWS + WS_ACT), (const bf16*)(OWS + WS_MOEW2), MOE_MAIN_PANELS * 256, D, DFF, DFF}; pg8::MoeOrder S; S.init(MOE_MAIN_PANELS * 256, D, G, (int)blockIdx.x);
                      S.pb1 = pbp[1]; S.pb2 = pbp[2]; S.pb3 = pbp[3]; S.pb4 = pbp[4]; S.pb5 = pbp[5]; S.pb6 = pbp[6]; S.pb7 = pbp[7]; S.estride = (size_t)D * DFF;
                      pg8::EpiBf16<0> E{(bf16*)(OWS + WS_F), D, nullptr, 0, 0, 1.f}; pg8::gemm_phase<pg8::EpiBf16<0>, pg8::MoeOrder, true, true>(lds, g, S, E); }
                    { const int nT = pbp[8] - MOE_MAIN_PANELS;
                      pg8::Gemm g{(const bf16*)(OWS + WS_ACT), (const bf16*)(OWS + WS_MOEW2), nT * 256, D, DFF / 4, DFF}; pg8::SplitOrder S{nT, D / 256, 4, G, (int)blockIdx.x, MOE_MAIN_PANELS, pbp[1], pbp[2], pbp[3], pbp[4], pbp[5], pbp[6], pbp[7], (size_t)D * DFF};
                      pg8::EpiPart E{(float*)(OWS + WS_FP), D, (size_t)MOE_TAIL_ROWS * D, MOE_MAIN_PANELS}; pg8::gemm_phase<pg8::EpiPart, pg8::SplitOrder, true, true>(lds, g, S, E); }
                }
                SEAM();
            }
        }
        if (RUN()) { FRESH(); ph_ln(p, lds, l, 1, tid, wave, gw, NGW, lane); }
        SEAM();
    }
#undef l
#undef RUN
#undef SEAM
}

#ifndef MK_PER_PHASE
#define MK_PER_PHASE 0
#endif
extern "C" void kernel_launch(void* const* d_in, const int* in_sizes, int n_in, void* d_out, int out_size, void* d_ws, size_t ws_size, hipStream_t stream) {
    static int grid = 0;
    if (grid == 0) {
        if (n_in != N_IN || in_sizes[0] != NLAT * D || out_size != NLAT * D || ws_size < WS_NEED) { fprintf(stderr, "kernel_launch: unexpected shapes / workspace (%d inputs, ws %zu, need %zu)\n", n_in, ws_size, (size_t)WS_NEED); grid = -1; return; }
        int dev = 0, cus = 0, per_cu = 0;
        if (hipGetDevice(&dev) != hipSuccess || hipDeviceGetAttribute(&cus, hipDeviceAttributeMultiprocessorCount, dev) != hipSuccess) { grid = -1; return; }
        if (hipFuncSetAttribute((const void*)fwd_kernel, hipFuncAttributeMaxDynamicSharedMemorySize, LDS_BYTES) != hipSuccess) { fprintf(stderr, "kernel_launch: hipFuncSetAttribute failed\n"); grid = -1; return; }
        if (hipOccupancyMaxActiveBlocksPerMultiprocessor(&per_cu, (const void*)fwd_kernel, NWAVES * 64, LDS_BYTES) != hipSuccess || per_cu < 1) fprintf(stderr, "kernel_launch: occupancy query says %d\n", per_cu);
        (void)hipGetLastError();
        grid = cus;
        if (grid != 256) { fprintf(stderr, "kernel_launch: built for a 256-CU device, found %d CUs\n", cus); grid = -1; return; }
    }
    if (grid < 0) return;
    if (hipMemsetAsync((char*)d_ws + WS_CTL, 0, CTL_BYTES, stream) != hipSuccess) return;
    KP p{};
    for (int i = 0; i < N_IN; ++i) p.in[i] = (const float*)d_in[i];
    p.out = (float*)d_out; p.ws = (unsigned char*)d_ws; p.pad = 0;
#if MK_PER_PHASE
    const int nph = 2 + 2 * 11 + 2 * 13;
    for (int ph = 0; ph < nph; ++ph) { p.ph = ph; hipLaunchKernelGGL(fwd_kernel, dim3(grid), dim3(NWAVES * 64), LDS_BYTES, stream, p); }
#else
    p.ph = -1;
    hipLaunchKernelGGL(fwd_kernel, dim3(grid), dim3(NWAVES * 64), LDS_BYTES, stream, p);
#endif
}
```

```cpp
#include <hip/hip_runtime.h>
#define PROBE_DUP 0
#define CQ_SLOT_WGS 0
#define CQ_SLOT_ITEMS 8000
#define CQ_Q_IN 48
#define CQ_Q_OT 16
#define CQ_Q_UP 60
#define CQ_Q_DT 54
#include <cstdio>
#include <cstdint>
namespace pg8 {
#define PG8_LAS __attribute__((address_space(3)))
typedef unsigned short bf16_t;
typedef short bf16x8 __attribute__((ext_vector_type(8)));
typedef float f32x4 __attribute__((ext_vector_type(4)));
typedef unsigned u32x4 __attribute__((ext_vector_type(4)));
constexpr int BM = 256, BK = 64, HALF = 128, HTB = HALF * BK * 2  , STAGE_BYTES = 8 * HTB, NXCD = 8, WGM = 8;

__host__ __device__ __forceinline__ int lds_byte(int r, int c) { const int st = (r >> 4) * 2 + (c >> 5), rr = r & 15, cc = c & 31, ob = rr * 64 + cc * 2; return st * 1024 + (ob ^ (((ob >> 9) & 1) << 5)); }
__host__ __device__ __forceinline__ void stage_rc(int b, int& R, int& C) { const int st = b / 1024, sb = b % 1024, swz = sb ^ (((sb >> 9) & 1) << 5); R = (st >> 1) * 16 + swz / 64; C = (st & 1) * 32 + (swz % 64) / 2; }
__host__ __device__ __forceinline__ int perm32(int rho) { const int n = rho >> 4, i = rho & 15; return 8 * (i >> 2) + 4 * n + (i & 3); }

struct Unit { int pm, pn, ks; };
struct Gemm { const bf16_t* A; const bf16_t* Bt; int M, N, K, ld; };

struct StaticOrder {
    int nM, nN, nwg, G, c;
    __host__ __device__ void init(int M, int N, int G_, int c_) { nM = M / BM; nN = N / BM; nwg = nM * nN; G = G_; c = c_; }
    __host__ __device__ bool next(int i, Unit& u) const {
        const long L = (long)i * G + c; if (L >= nwg) return false;
        int wgid = (int)L; { const int q = nwg / NXCD, r = nwg % NXCD, xcd = wgid % NXCD, off = wgid / NXCD; wgid = (xcd < r ? xcd * (q + 1) : r * (q + 1) + (xcd - r) * q) + off; }
        const int nig = WGM * nN, gid = wgid / nig, fm = gid * WGM, gsz = (nM - fm) < WGM ? (nM - fm) : WGM;
        u.pm = fm + ((wgid % nig) % gsz); u.pn = (wgid % nig) / gsz; u.ks = 0; return true;
    }
    __device__ __forceinline__ const char* abase(const Gemm& g, const Unit& u, size_t tstep) const { return (const char*)g.A + (size_t)u.pm * tstep; }
    __device__ __forceinline__ const char* bbase(const Gemm& g, const Unit& u, size_t tstep) const { return (const char*)g.Bt + (size_t)u.pn * tstep; }
    __device__ __forceinline__ void a_ready(const Unit&) const {}
    __device__ __forceinline__ void done(const Unit&) const {}
};

__device__ __forceinline__ unsigned cvt_pk_bf16(float lo, float hi) { unsigned r; asm volatile("v_cvt_pk_bf16_f32 %0, %1, %2" : "=v"(r) : "v"(lo), "v"(hi)); return r; }
typedef float f32x2 __attribute__((ext_vector_type(2)));
__device__ __forceinline__ f32x2 gelu_pk(f32x2 v) {
    const f32x2 av = __builtin_elementwise_abs(v), d = av * 0.2316418882f + 1.0f;
    f32x2 t; t.x = __builtin_amdgcn_rcpf(d.x); t.y = __builtin_amdgcn_rcpf(d.y);
    f32x2 q = t * 0.5307027145f + (-0.7265760135f); q = q * t + 0.7107068705f; q = q * t + (-0.142248368f); q = q * t + 0.127414796f; q = q * t;
    const f32x2 s = (v * v) * (-0.72134752044f);
    f32x2 e; e.x = __builtin_amdgcn_exp2f(s.x); e.y = __builtin_amdgcn_exp2f(s.y);
    const f32x2 m = v * (q * e), r = v - m;
    f32x2 o; o.x = v.x < 0.f ? m.x : r.x; o.y = v.y < 0.f ? m.y : r.y; return o;
}

template <int ACT  > struct EpiBf16 {
    static constexpr bool PERM = true, AFTER_DRAIN = false; static_assert(ACT == 0 || ACT == 1, "EpiBf16: ACT is 0 (none) or 1 (gelu_pk)"); static constexpr int NST = 16;
    bf16_t* O; int ldc; const float* bias; int split_cols; size_t split_stride; float scale0;
    __device__ __forceinline__ void operator()(const f32x4 (&acc)[2][2][4][2], const Unit& u, int wr, int wc, int fr, int fq) const {
        asm volatile("" : "+v"(fr), "+v"(fq));
        const int row0 = u.pm * BM + wr * 64 + fr; int colt = u.pn * BM; bf16_t* base = O;
        float sc = 1.f; if (split_cols) { const int t = colt / split_cols; base += (size_t)t * split_stride; colt -= t * split_cols; if (t == 0) sc = scale0; }
        const int col0 = colt + wc * 32 + 8 * fq, bcol0 = u.pn * BM + wc * 32 + 8 * fq;
        f32x4 bv[2][2];
#pragma unroll
        for (int bj = 0; bj < 2; ++bj)
#pragma unroll
            for (int n = 0; n < 2; ++n) bv[bj][n] = bias ? *(const f32x4*)(bias + bcol0 + bj * HALF + 4 * n) : (f32x4){0.f, 0.f, 0.f, 0.f};
#pragma unroll
        for (int ai = 0; ai < 2; ++ai)
#pragma unroll
            for (int m = 0; m < 4; ++m) { bf16_t* rowp = base + (size_t)(row0 + ai * HALF + m * 16) * ldc + col0;
#pragma unroll
                for (int bj = 0; bj < 2; ++bj) { f32x4 v0 = acc[ai][bj][m][0] + bv[bj][0], v1 = acc[ai][bj][m][1] + bv[bj][1];
                    if (ACT == 1) { f32x2 a = gelu_pk((f32x2){v0[0], v0[1]}), b = gelu_pk((f32x2){v0[2], v0[3]}), c = gelu_pk((f32x2){v1[0], v1[1]}), d = gelu_pk((f32x2){v1[2], v1[3]});
                        v0 = (f32x4){a.x, a.y, b.x, b.y}; v1 = (f32x4){c.x, c.y, d.x, d.y}; }
                    v0 = v0 * sc; v1 = v1 * sc; u32x4 w; w.x = cvt_pk_bf16(v0[0], v0[1]); w.y = cvt_pk_bf16(v0[2], v0[3]); w.z = cvt_pk_bf16(v1[0], v1[1]); w.w = cvt_pk_bf16(v1[2], v1[3]);
                    *(u32x4*)(rowp + bj * HALF) = w; } }
    }
};
typedef int i32x4 __attribute__((ext_vector_type(4)));
template <bool I8> __device__ __forceinline__ f32x4 mma16(bf16x8 b, bf16x8 a, f32x4 c) { return __builtin_amdgcn_mfma_f32_16x16x32_bf16(b, a, c, 0, 0, 0); }
template <bool I8> __device__ __forceinline__ i32x4 mma16(bf16x8 b, bf16x8 a, i32x4 c) { return __builtin_amdgcn_mfma_i32_16x16x64_i8(__builtin_bit_cast(i32x4, b), __builtin_bit_cast(i32x4, a), c, 0, 0, 0); }
struct EpiF32 {
    static constexpr bool PERM = false, AFTER_DRAIN = false; static constexpr int NST = 0;
    float* C; int ldc; int accum;
    __device__ __forceinline__ void operator()(const f32x4 (&acc)[2][2][4][2], const Unit& u, int wr, int wc, int fr, int fq) const {
        asm volatile("" : "+v"(fr), "+v"(fq));
        const int row0 = u.pm * BM + wr * 64 + fr, col0 = u.pn * BM + wc * 32 + 4 * fq;
#pragma unroll
        for (int ai = 0; ai < 2; ++ai)
#pragma unroll
            for (int m = 0; m < 4; ++m) { float* rowp = C + (size_t)(row0 + ai * HALF + m * 16) * ldc + col0;
#pragma unroll
                for (int bj = 0; bj < 2; ++bj)
#pragma unroll
                    for (int n = 0; n < 2; ++n) { f32x4 v = acc[ai][bj][m][n]; if (accum) v += *(const f32x4*)(rowp + bj * HALF + n * 16); *(f32x4*)(rowp + bj * HALF + n * 16) = v; } }
    }
};
struct EpiSwiGLU {
    static constexpr bool PERM = true, AFTER_DRAIN = false; static constexpr int NST = 0;
    bf16_t* O; int ldo; const float* rowscale; int rs_stride;
    __device__ __forceinline__ void operator()(const f32x4 (&acc)[2][2][4][2], const Unit& u, int wr, int wc, int fr, int fq) const {
        asm volatile("" : "+v"(fr), "+v"(fq));
        typedef unsigned u32x2v __attribute__((ext_vector_type(2)));
        const int row0 = u.pm * BM + wr * 64 + fr; const int ch0 = (u.pn * BM + wc * 32 + 8 * fq) >> 1;
#pragma unroll
        for (int ai = 0; ai < 2; ++ai)
#pragma unroll
            for (int m = 0; m < 4; ++m) { const int row = row0 + ai * HALF + m * 16; bf16_t* rowp = O + (size_t)row * ldo + ch0;
                const float rs = rowscale ? rowscale[(size_t)row * rs_stride] : 1.f;
#pragma unroll
                for (int bj = 0; bj < 2; ++bj) { const f32x4 a = acc[ai][bj][m][0], b = acc[ai][bj][m][1]; f32x4 o;
#pragma unroll
                    for (int i = 0; i < 4; ++i) o[i] = a[i] * __builtin_amdgcn_rcpf(1.f + __expf(-a[i])) * b[i] * rs;
                    u32x2v w; w.x = cvt_pk_bf16(o[0], o[1]); w.y = cvt_pk_bf16(o[2], o[3]);
                    *(u32x2v*)(rowp + bj * (HALF / 2)) = w; } }
    }
};

struct MoeOrder : StaticOrder {
    int pb1, pb2, pb3, pb4, pb5, pb6, pb7; size_t estride;
    __device__ __forceinline__ const char* bbase(const Gemm& g, const Unit& u, size_t tstep) const {
        const int e = (u.pm >= pb1) + (u.pm >= pb2) + (u.pm >= pb3) + (u.pm >= pb4) + (u.pm >= pb5) + (u.pm >= pb6) + (u.pm >= pb7);
        return (const char*)(g.Bt + (size_t)e * estride) + (size_t)u.pn * tstep; }
};
struct SplitOrder {
    int nM, nN, S, G, c, pm0; int pb1, pb2, pb3, pb4, pb5, pb6, pb7; size_t estride;
    __device__ __forceinline__ bool next(int i, Unit& u) const { const int L = i * G + c; if (L >= nM * nN * S) return false; u.ks = L % S; const int t = L / S; u.pn = t % nN; u.pm = pm0 + t / nN; return true; }
    __device__ __forceinline__ const char* abase(const Gemm& g, const Unit& u, size_t tstep) const { return (const char*)g.A + (size_t)u.pm * tstep + (size_t)u.ks * g.K * 2; }
    __device__ __forceinline__ const char* bbase(const Gemm& g, const Unit& u, size_t tstep) const {
        const int e = estride ? (u.pm >= pb1) + (u.pm >= pb2) + (u.pm >= pb3) + (u.pm >= pb4) + (u.pm >= pb5) + (u.pm >= pb6) + (u.pm >= pb7) : 0;
        return (const char*)(g.Bt + (size_t)e * estride) + (size_t)u.pn * tstep + (size_t)u.ks * g.K * 2; }
    __device__ __forceinline__ void a_ready(const Unit&) const {}
    __device__ __forceinline__ void done(const Unit&) const {}
};
struct EpiPart {
    static constexpr bool PERM = false, AFTER_DRAIN = false; static constexpr int NST = 32;
    float* C; int ldc; size_t pstride; int pm0;
    __device__ __forceinline__ void operator()(const f32x4 (&acc)[2][2][4][2], const Unit& u, int wr, int wc, int fr, int fq) const {
        asm volatile("" : "+v"(fr), "+v"(fq));
        const int row0 = (u.pm - pm0) * BM + wr * 64 + fr, col0 = u.pn * BM + wc * 32 + 4 * fq; float* base = C + (size_t)u.ks * pstride;
#pragma unroll
        for (int ai = 0; ai < 2; ++ai)
#pragma unroll
            for (int m = 0; m < 4; ++m) { float* rowp = base + (size_t)(row0 + ai * HALF + m * 16) * ldc + col0;
#pragma unroll
                for (int bj = 0; bj < 2; ++bj)
#pragma unroll
                    for (int n = 0; n < 2; ++n) *(f32x4*)(rowp + bj * HALF + n * 16) = acc[ai][bj][m][n]; }
    }
};

struct EpiSwiGLU8 {
    static constexpr bool PERM = true, AFTER_DRAIN = false; static constexpr int NST = 16;
    bf16_t* O; int ldo; const float* rowscale; const float* sa; const unsigned* amax; int pb1, pb2, pb3, pb4, pb5, pb6, pb7;
    __device__ __forceinline__ void operator()(const i32x4 (&acc)[2][2][4][2], const Unit& u, int wr, int wc, int fr, int fq) const {
        typedef unsigned u32x2v __attribute__((ext_vector_type(2))); typedef unsigned u32x4v __attribute__((ext_vector_type(4)));
        asm volatile("" : "+v"(fr), "+v"(fq));
        const int row0 = u.pm * BM + wr * 64 + fr; const int cb0 = u.pn * BM + wc * 32 + 8 * fq; const int ch0 = cb0 >> 1;
        const int e = (u.pm >= pb1) + (u.pm >= pb2) + (u.pm >= pb3) + (u.pm >= pb4) + (u.pm >= pb5) + (u.pm >= pb6) + (u.pm >= pb7);
        const unsigned* am = amax + (size_t)e * 2 * 3584 + cb0;
#pragma unroll
        for (int bj = 0; bj < 2; ++bj) {
            const float* amf = (const float*)am + bj * HALF;
            const f32x4 sb0 = *(const f32x4*)amf * (1.f / 127.f), sb1 = *(const f32x4*)(amf + 4) * (1.f / 127.f);
#pragma unroll
            for (int ai = 0; ai < 2; ++ai)
#pragma unroll
                for (int m = 0; m < 4; ++m) { const int row = row0 + ai * HALF + m * 16; bf16_t* rowp = O + (size_t)row * ldo + ch0 + bj * (HALF / 2);
                    const float sr = sa[row], rs = rowscale ? rowscale[row] : 1.f; f32x4 o;
#pragma unroll
                    for (int i = 0; i < 4; ++i) { const float a = (float)acc[ai][bj][m][0][i] * sr * sb0[i], b = (float)acc[ai][bj][m][1][i] * sr * sb1[i];
                        o[i] = a * __builtin_amdgcn_rcpf(1.f + __expf(-a)) * b * rs; }
                    u32x2v w; w.x = cvt_pk_bf16(o[0], o[1]); w.y = cvt_pk_bf16(o[2], o[3]);
                    *(u32x2v*)rowp = w;
#if PROBE_DUP & 128
                    if (dbg && row < 4096) { f32x4 av, bv;
#pragma unroll
                        for (int i = 0; i < 4; ++i) { av[i] = (float)acc[ai][bj][m][0][i] * sr * sb0[i]; bv[i] = (float)acc[ai][bj][m][1][i] * sr * sb1[i]; }
                        *(f32x4*)((float*)dbg + (size_t)row * ldo + (rowp - (O + (size_t)row * ldo))) = av; *(f32x4*)((float*)dbg + (size_t)4096 * ldo + (size_t)row * ldo + (rowp - (O + (size_t)row * ldo))) = bv; }
#endif
                    } }
    }
#if PROBE_DUP & 128
    int* dbg = nullptr;
#endif
};

struct EpiBf16S8 {
    static constexpr bool PERM = true, AFTER_DRAIN = false; static constexpr int NST = 16;
    bf16_t* O; int ldc; const float* sa; const float* amax;
    __device__ __forceinline__ void operator()(const i32x4 (&acc)[2][2][4][2], const Unit& u, int wr, int wc, int fr, int fq) const {
        asm volatile("" : "+v"(fr), "+v"(fq));
        const int row0 = u.pm * BM + wr * 64 + fr, col0 = u.pn * BM + wc * 32 + 8 * fq;
#pragma unroll
        for (int bj = 0; bj < 2; ++bj) { const f32x4 s0 = *(const f32x4*)(amax + col0 + bj * HALF) * (1.f / 127.f), s1 = *(const f32x4*)(amax + col0 + bj * HALF + 4) * (1.f / 127.f);
#pragma unroll
            for (int ai = 0; ai < 2; ++ai)
#pragma unroll
                for (int m = 0; m < 4; ++m) { const int row = row0 + ai * HALF + m * 16; const float sr = sa[row]; f32x4 v0, v1;
#pragma unroll
                    for (int i = 0; i < 4; ++i) { v0[i] = (float)acc[ai][bj][m][0][i] * sr * s0[i]; v1[i] = (float)acc[ai][bj][m][1][i] * sr * s1[i]; }
                    u32x4 w; w.x = cvt_pk_bf16(v0[0], v0[1]); w.y = cvt_pk_bf16(v0[2], v0[3]); w.z = cvt_pk_bf16(v1[0], v1[1]); w.w = cvt_pk_bf16(v1[2], v1[3]);
                    *(u32x4*)(O + (size_t)row * ldc + col0 + bj * HALF) = w; } }
    }
};
struct EpiPartS8 {
    static constexpr bool PERM = false, AFTER_DRAIN = false; static constexpr int NST = 32;
    float* C; int ldc; size_t pstride; int pm0; const float* sa; const float* amax;
    __device__ __forceinline__ void operator()(const i32x4 (&acc)[2][2][4][2], const Unit& u, int wr, int wc, int fr, int fq) const {
        asm volatile("" : "+v"(fr), "+v"(fq));
        const int row0 = (u.pm - pm0) * BM + wr * 64 + fr, col0 = u.pn * BM + wc * 32 + 4 * fq; float* base = C + (size_t)u.ks * pstride;
#pragma unroll
        for (int bj = 0; bj < 2; ++bj)
#pragma unroll
            for (int n = 0; n < 2; ++n) { const f32x4 sc = *(const f32x4*)(amax + col0 + bj * HALF + n * 16) * (1.f / 127.f);
#pragma unroll
                for (int ai = 0; ai < 2; ++ai)
#pragma unroll
                    for (int m = 0; m < 4; ++m) { const int rl = row0 + ai * HALF + m * 16; const float sr = sa[rl + pm0 * BM]; f32x4 v;
#pragma unroll
                        for (int i = 0; i < 4; ++i) v[i] = (float)acc[ai][bj][m][n][i] * sr * sc[i];
                        *(f32x4*)(base + (size_t)rl * ldc + col0 + bj * HALF + n * 16) = v; } }
    }
};
template <bool I8> struct AccSel { typedef f32x4 type; }; template <> struct AccSel<true> { typedef i32x4 type; };
template <class Epi, class Sched, bool ALIGN_EPI = false, bool SP2 = false, bool I8 = false>
__device__ __forceinline__ void gemm_phase(PG8_LAS unsigned char* lds, const Gemm g, const Sched& S, const Epi& E) {
    int tid_o = threadIdx.x; asm volatile("" : "+v"(tid_o));
    const int tid = tid_o, wid = __builtin_amdgcn_readfirstlane(tid >> 6), lane = tid & 63, wr = wid >> 2, wc = wid & 3, fr = lane & 15, fq = lane >> 4;
    const int K = g.K, nt = K / BK;
    unsigned voffA[2], voffB[2];
#pragma unroll
    for (int i = 0; i < 2; ++i) { int R, C; stage_rc(tid * 16 + i * 8192, R, C); const int Rb = Epi::PERM ? ((R & ~31) + perm32(R & 31)) : R;
        voffA[i] = (unsigned)(R * g.ld + C) * 2u; voffB[i] = (unsigned)(Rb * g.ld + C) * 2u; }
    const size_t kstep = (size_t)(BK * 2);
    const size_t hstep = (size_t)HALF * g.ld * 2;
    const size_t tstep = 2 * hstep;
    const unsigned ldsw = (unsigned)wid * 1024u;
    const int aoff = lds_byte(wr * 64 + fr, fq * 8), boff = lds_byte(wc * 32 + fr, fq * 8);
#define PG8_SA(b, h) (((b) * 2 + (h)) * HTB)
#define PG8_SB(b, h) ((4 + (b) * 2 + (h)) * HTB)
#define PG8_STAGE(bufoff, gbase, voff) do { _Pragma("unroll") for (int _i = 0; _i < 2; ++_i) \
        __builtin_amdgcn_global_load_lds((const unsigned*)((const char*)(gbase) + (voff)[_i]), (PG8_LAS unsigned*)(lds + (bufoff) + ldsw + _i * 8192), 16, 0, 0); } while (0)
#define PG8_LDA(dst, b, h) do { _Pragma("unroll") for (int m = 0; m < 4; ++m) _Pragma("unroll") for (int k = 0; k < 2; ++k) dst[m][k] = *(const PG8_LAS bf16x8*)(lds + PG8_SA(b, h) + aoff + m * 2048 + k * 1024); } while (0)
#define PG8_LDB(dst, b, h) do { _Pragma("unroll") for (int n = 0; n < 2; ++n) _Pragma("unroll") for (int k = 0; k < 2; ++k) dst[n][k] = *(const PG8_LAS bf16x8*)(lds + PG8_SB(b, h) + boff + n * 2048 + k * 1024); } while (0)
#define PG8_MMA(ai, bj, At, Bt) do { __builtin_amdgcn_s_setprio(1); _Pragma("unroll") for (int k = 0; k < 2; ++k) _Pragma("unroll") for (int m = 0; m < 4; ++m) _Pragma("unroll") for (int n = 0; n < 2; ++n) \
        acc[ai][bj][m][n] = mma16<I8>(Bt[n][k], At[m][k], acc[ai][bj][m][n]); __builtin_amdgcn_s_setprio(0); } while (0)
#define PG8_WAIT_V(n) asm volatile("s_waitcnt vmcnt(" #n ")" ::: "memory")
#define PG8_WAIT_V8R(flag) do { if constexpr (Epi::NST >= 32) asm volatile("s_cmp_eq_u32 %0, 0\n\ts_cbranch_scc1 .Lw8a_%=\n\ts_waitcnt vmcnt(40)\n\ts_branch .Lw8b_%=\n.Lw8a_%=:\n\ts_waitcnt vmcnt(8)\n.Lw8b_%=:" :: "s"(flag) : "scc", "memory"); \
    else if constexpr (Epi::NST >= 16) asm volatile("s_cmp_eq_u32 %0, 0\n\ts_cbranch_scc1 .Lw8a_%=\n\ts_waitcnt vmcnt(24)\n\ts_branch .Lw8b_%=\n.Lw8a_%=:\n\ts_waitcnt vmcnt(8)\n.Lw8b_%=:" :: "s"(flag) : "scc", "memory"); \
    else asm volatile("s_waitcnt vmcnt(8)" ::: "memory"); } while (0)
#define PG8_WAIT_L(n) asm volatile("s_waitcnt lgkmcnt(" #n ")" ::: "memory")
#define PG8_BAR __builtin_amdgcn_s_barrier()
#define PG8_SCHED __builtin_amdgcn_sched_barrier(0)
    Unit cur, nxt; int ui = 0;
    if (!S.next(0, cur)) return;
    typedef typename AccSel<I8>::type AccT; AccT acc[2][2][4][2];
#pragma unroll
    for (int a = 0; a < 2; ++a)
#pragma unroll
        for (int b = 0; b < 2; ++b)
#pragma unroll
            for (int m = 0; m < 4; ++m)
#pragma unroll
                for (int n = 0; n < 2; ++n) acc[a][b][m][n] = (AccT)(0);
    bf16x8 At[4][2], B0[2][2], B1[2][2];
    const char* cA = S.abase(g, cur, tstep); const char* cB = S.bbase(g, cur, tstep);
    S.a_ready(cur);
    if constexpr (SP2) {
        PG8_STAGE(PG8_SB(0, 0), cB, voffB); PG8_STAGE(PG8_SB(0, 1), cB + hstep, voffB); PG8_STAGE(PG8_SA(0, 0), cA, voffA); PG8_STAGE(PG8_SA(0, 1), cA + hstep, voffA);
        if (wr == 1) PG8_BAR;
        PG8_WAIT_V(2); PG8_BAR;
        PG8_STAGE(PG8_SB(1, 0), cB + kstep, voffB); PG8_STAGE(PG8_SA(1, 0), cA + kstep, voffA); PG8_STAGE(PG8_SB(1, 1), cB + hstep + kstep, voffB);
        PG8_WAIT_V(6); PG8_BAR;
    } else {
        PG8_STAGE(PG8_SB(0, 0), cB, voffB); PG8_STAGE(PG8_SA(0, 0), cA, voffA); PG8_STAGE(PG8_SB(0, 1), cB + hstep, voffB); PG8_STAGE(PG8_SA(0, 1), cA + hstep, voffA);
        if (wr == 1) PG8_BAR;
        PG8_WAIT_V(4); PG8_BAR;
        PG8_STAGE(PG8_SB(1, 0), cB + kstep, voffB); PG8_STAGE(PG8_SA(1, 0), cA + kstep, voffA); PG8_STAGE(PG8_SB(1, 1), cB + hstep + kstep, voffB);
        PG8_WAIT_V(6); PG8_BAR;
    }
    for (;;) {
        const bool has_next = S.next(ui + 1, nxt);
        const char* nA = has_next ? S.abase(g, nxt, tstep) : cA; const char* nB = has_next ? S.bbase(g, nxt, tstep) : cB;
        for (int t = 0; t < nt; t += 2) {
            const bool last = (t == nt - 2);
            const char* a1 = cA + (size_t)(t + 1) * kstep;
            const char* a2 = last ? nA : cA + (size_t)(t + 2) * kstep; const char* b2 = last ? nB : cB + (size_t)(t + 2) * kstep;
            const char* a3 = a2 + kstep; const char* b3 = b2 + kstep;
            if (last && has_next) S.a_ready(nxt);
            if constexpr (SP2) {
            const int rx_ = __builtin_amdgcn_readfirstlane((Epi::NST > 0 && t == 0 && ui > 0) ? 1 : 0);
            PG8_LDB(B0, 0, 0); PG8_LDB(B1, 0, 1); PG8_SCHED; PG8_LDA(At, 0, 0); PG8_STAGE(PG8_SA(1, 1), a1 + hstep, voffA);
            PG8_WAIT_V8R(rx_);
            PG8_WAIT_L(0); PG8_BAR; PG8_MMA(0, 0, At, B0); PG8_MMA(0, 1, At, B1); PG8_BAR; PG8_SCHED;
            PG8_LDA(At, 0, 1); PG8_STAGE(PG8_SB(0, 0), b2, voffB); PG8_STAGE(PG8_SB(0, 1), b2 + hstep, voffB); PG8_STAGE(PG8_SA(0, 0), a2, voffA);
            PG8_WAIT_V8R(rx_);
            PG8_WAIT_L(0); PG8_BAR; PG8_MMA(1, 0, At, B0); PG8_MMA(1, 1, At, B1); PG8_BAR; PG8_SCHED;
            PG8_LDB(B0, 1, 0); PG8_LDB(B1, 1, 1); PG8_SCHED; PG8_LDA(At, 1, 0); PG8_STAGE(PG8_SA(0, 1), a2 + hstep, voffA);
            PG8_WAIT_V(8); PG8_WAIT_L(0); PG8_BAR; PG8_MMA(0, 0, At, B0); PG8_MMA(0, 1, At, B1); PG8_BAR; PG8_SCHED;
            PG8_LDA(At, 1, 1); PG8_STAGE(PG8_SB(1, 0), b3, voffB); PG8_STAGE(PG8_SB(1, 1), b3 + hstep, voffB); PG8_STAGE(PG8_SA(1, 0), a3, voffA);
            PG8_WAIT_V(8); PG8_WAIT_L(0); PG8_BAR; PG8_MMA(1, 0, At, B0); PG8_MMA(1, 1, At, B1); PG8_BAR; PG8_SCHED;
            } else {
            PG8_LDB(B0, 0, 0); PG8_SCHED; PG8_LDA(At, 0, 0); PG8_STAGE(PG8_SA(1, 1), a1 + hstep, voffA);
            PG8_WAIT_L(8); PG8_BAR; PG8_WAIT_L(0); PG8_MMA(0, 0, At, B0); PG8_BAR; PG8_SCHED;
            PG8_LDB(B1, 0, 1); PG8_STAGE(PG8_SB(0, 0), b2, voffB);
            PG8_BAR; PG8_WAIT_L(0); PG8_MMA(0, 1, At, B1); PG8_BAR;
            PG8_LDA(At, 0, 1); PG8_STAGE(PG8_SA(0, 0), a2, voffA);
            PG8_BAR; PG8_WAIT_L(0); PG8_MMA(1, 0, At, B0); PG8_BAR; PG8_SCHED;
            PG8_STAGE(PG8_SB(0, 1), b2 + hstep, voffB);
            PG8_WAIT_V(6); PG8_BAR; PG8_MMA(1, 1, At, B1); PG8_BAR;
            PG8_LDB(B0, 1, 0); PG8_SCHED; PG8_LDA(At, 1, 0); PG8_STAGE(PG8_SA(0, 1), a2 + hstep, voffA);
            PG8_WAIT_L(8); PG8_BAR; PG8_WAIT_L(0); PG8_MMA(0, 0, At, B0); PG8_BAR; PG8_SCHED;
            PG8_LDB(B1, 1, 1); PG8_STAGE(PG8_SB(1, 0), b3, voffB);
            PG8_BAR; PG8_WAIT_L(0); PG8_MMA(0, 1, At, B1); PG8_BAR;
            PG8_LDA(At, 1, 1); PG8_STAGE(PG8_SA(1, 0), a3, voffA);
            PG8_BAR; PG8_WAIT_L(0); PG8_MMA(1, 0, At, B0); PG8_BAR; PG8_SCHED;
            PG8_STAGE(PG8_SB(1, 1), b3 + hstep, voffB);
            PG8_WAIT_V(6); PG8_BAR; PG8_MMA(1, 1, At, B1); PG8_BAR;
            }
        }
        if constexpr (ALIGN_EPI) { if (wr == 0) PG8_BAR; }
        if constexpr (!Epi::AFTER_DRAIN) { E(acc, cur, wr, wc, fr, fq); S.done(cur); }
        if (!has_next) break;
#pragma unroll
        for (int a = 0; a < 2; ++a)
#pragma unroll
            for (int b = 0; b < 2; ++b)
#pragma unroll
                for (int m = 0; m < 4; ++m)
#pragma unroll
                    for (int n = 0; n < 2; ++n) acc[a][b][m][n] = (AccT)(0);
        cur = nxt; cA = nA; cB = nB; ++ui;
        if constexpr (ALIGN_EPI) { if (wr == 1) PG8_BAR; }
    }
    PG8_WAIT_V(0);
    if constexpr (!ALIGN_EPI) { if (wr == 0) PG8_BAR; }
    PG8_BAR;
    if constexpr (Epi::AFTER_DRAIN) { E.fused(acc, cur, wr, wc, fr, fq, lds, wid, lane); S.done(cur); }
#undef PG8_SA
#undef PG8_SB
#undef PG8_STAGE
#undef PG8_LDA
#undef PG8_LDB
#undef PG8_MMA
#undef PG8_WAIT_V
#undef PG8_WAIT_L
#undef PG8_BAR
#undef PG8_SCHED
}
}

constexpr int NWAVES = 8;
constexpr int D = 1024, NB = 4, SEQ = 4096, CTXL = 256, NLAT = NB * SEQ, NCTX = NB * CTXL, MROWS = NLAT + NCTX;
constexpr int DEPTH = 4, RW = 512, NH = 8, HS = 64, DFF = 3584, NE = 8, NPROJ = 3456, NP = 3584, NLO = 2560, KLA = 512, NMOD = 6144;
constexpr int PC_R = 0, PC_K = 512, PC_V = 1024, PC_CB = 1536, PC_CC = 2048, PC_CH = 2560, PC_WD = 3072, PC_AD = 3200, PC_GD = 3328;
constexpr float LN_EPS = 1e-5f, GN_EPS = 64e-5f, DN_ALPHA = 1.681792830507429f;
enum { I_X = 0, I_C, I_CTX, I_CCTX, I_WMOD, I_BMOD, I_WIN, I_W0, I_W2, I_A0, I_A2, I_KK, I_KA, I_RK, I_G2, I_LNXG, I_LNXB, I_CONVW, I_WOUT, I_LN1G, I_LN1B, I_LN2G, I_LN2B,
       I_FW1, I_FW3, I_FW2, I_RTW, I_RTB, I_MW1, I_MW3, I_MW2, N_IN };

constexpr size_t MiB = 1u << 20;
constexpr size_t WS_CTL = 0, CTL_BYTES = 3 * MiB;
constexpr size_t WS_MODV = 1 * MiB;
constexpr size_t WS_AMAX = 2 * MiB;
constexpr size_t WS_RKS = 3 * MiB;
constexpr size_t WS_WIN = 4 * MiB;
constexpr size_t WS_WOUT = WS_WIN + 28 * MiB;
constexpr size_t WS_LORA = WS_WOUT + 8 * MiB;
constexpr size_t WS_F13 = WS_LORA + 10 * MiB;
constexpr size_t WS_F2 = WS_F13 + 28 * MiB;
constexpr size_t WS_X = WS_F2 + 14 * MiB;
constexpr size_t WS_H = WS_X + 68 * MiB;
constexpr size_t WS_MOES = WS_H + 34 * MiB;
constexpr size_t WS_ROWLIST = WS_MOES;
constexpr size_t WS_TOKSEL = WS_MOES + 640 * 1024;
constexpr size_t WS_WSEL = WS_TOKSEL + 320 * 1024;
constexpr size_t WS_WSORT = WS_WSEL + 192 * 1024;
constexpr size_t WS_MOEW13 = WS_MOES + 2 * MiB;
constexpr size_t WS_MOEW2 = WS_MOEW13 + 112 * MiB;
constexpr size_t WS_H8 = WS_MOEW13 + 56 * MiB;
constexpr size_t WS_SA = WS_H8 + 17 * MiB;
constexpr size_t WS_SAM = WS_SA + 512 * 1024;
constexpr size_t WS_SAG = WS_SA + 1 * MiB;
constexpr size_t WS_SCR = WS_MOEW2 + 56 * MiB;
constexpr size_t WS_P = WS_SCR;
constexpr size_t WS_LO = WS_P + 119 * MiB;
constexpr size_t WS_PREP = WS_LO + 170 * MiB;
constexpr size_t WS_Y = WS_PREP + 213 * MiB;
constexpr size_t WS_MIXIN = WS_Y + 68 * MiB;
constexpr size_t WS_CH = WS_PREP;
constexpr size_t WS_MIXO = WS_PREP;
constexpr size_t WS_MIXP = WS_PREP + 34 * MiB;
constexpr size_t WS_END_MIXER = WS_MIXIN + 34 * MiB;
constexpr size_t WS_HG = WS_SCR;
constexpr size_t WS_ACT = WS_HG + 72 * MiB;
constexpr size_t WS_F = WS_ACT + 252 * MiB;
constexpr size_t WS_FP = WS_F + 72 * MiB;
constexpr size_t WS_END_FFN = WS_FP + 64 * MiB;
constexpr size_t WS_NEED = WS_END_MIXER > WS_END_FFN ? WS_END_MIXER : WS_END_FFN;
static_assert((size_t)MROWS * NP * 2 <= 119 * MiB && (size_t)MROWS * NLO * 4 <= 170 * MiB && (size_t)8704 * 25600 <= 213 * MiB && (size_t)MROWS * D * 4 <= 68 * MiB && WS_NEED <= 990 * MiB, "ws map");
constexpr int MOE_MAIN_PANELS = 128, MOE_TAIL_ROWS = 4096;
constexpr int MOE_ROWS = 36864;
constexpr int AM_IN = 18 * 2 * DFF, AM_OUT = AM_IN + DEPTH * NP;
constexpr int LORAW_PER_LAYER = 4 * 512 * 64 + 512 * 128;
constexpr int CW_BAR = 4096, CW_GCNT = 8192, CW_CQ = 12288, CW_SDONE = 12544;

constexpr int RING_BYTES = 131072, LDSCTL_OFF = RING_BYTES, MISC_OFF = LDSCTL_OFF + 320, LDS_BYTES = 147456;

typedef unsigned short bf16;
typedef unsigned v4u __attribute__((ext_vector_type(4)));
typedef unsigned v2u __attribute__((ext_vector_type(2)));
typedef float f32x4 __attribute__((ext_vector_type(4)));
#define LAS __attribute__((address_space(3)))
#define LDS_WAIT() asm volatile("s_waitcnt lgkmcnt(0)" ::: "memory")
__device__ __forceinline__ unsigned f2bf(float f) { unsigned u = __builtin_bit_cast(unsigned, f); return (u + 0x7fffu + ((u >> 16) & 1u)) >> 16; }
__device__ __forceinline__ unsigned pk2(float lo, float hi) { return f2bf(lo) | (f2bf(hi) << 16); }
__device__ __forceinline__ float bf2f(unsigned short b) { return __builtin_bit_cast(float, ((unsigned)b) << 16); }
__device__ __forceinline__ float bflo(unsigned w) { return __builtin_bit_cast(float, w << 16); }
__device__ __forceinline__ float bfhi(unsigned w) { return __builtin_bit_cast(float, w & 0xffff0000u); }
__device__ __forceinline__ float wave_sum(float v) {
#pragma unroll
    for (int o = 1; o < 64; o <<= 1) v += __shfl_xor(v, o);
    return v;
}
__device__ __forceinline__ float sigm(float x) { return 1.f / (1.f + __expf(-x)); }

#define XB_TMO      128
#define XB_XCNT(j)  (256  + 64 * (j))
#define XB_XSUB(j)  (1280 + 64 * (j))
#define XB_XGEN(j)  (2304 + 64 * (j))
#define XB_TOP      3328
#define XB_TOPGEN   3392
#define XCD_BAR_WORDS 3456
#define XB_SPIN_CAP (1u << 18)

__device__ __forceinline__ unsigned xb_ld(unsigned* p)              { return __hip_atomic_load(p, __ATOMIC_RELAXED, __HIP_MEMORY_SCOPE_AGENT); }
__device__ __forceinline__ unsigned xb_add(unsigned* p, unsigned v) { return __hip_atomic_fetch_add(p, v, __ATOMIC_RELAXED, __HIP_MEMORY_SCOPE_AGENT); }
__device__ __forceinline__ unsigned xb_xcc_id() { return (unsigned)__builtin_amdgcn_s_getreg((3 << 11) | 20) & 0xFu; }
#define XB_SPIN(cond, bar) do { unsigned _sp = 0; while (cond) { __builtin_amdgcn_s_sleep(1); \
    if ((++_sp & 255u) == 0u) { if (xb_ld(&(bar)[XB_TMO])) break; if (_sp > XB_SPIN_CAP) { atomicAdd(&(bar)[XB_TMO], 1u); break; } } } } while (0)

struct XcdBarrier {
    unsigned* bar; unsigned x;
    volatile LAS unsigned* st;
};

__device__ __forceinline__ XcdBarrier xcd_barrier_post(unsigned* bar, volatile LAS unsigned* st) {
    XcdBarrier b; b.bar = bar; b.x = xb_xcc_id(); b.st = st;
    if (threadIdx.x == 0) (void)xb_add(&bar[XB_XCNT(b.x)], 1u);
    return b;
}
__device__ __forceinline__ void xcd_barrier_complete(unsigned* bar, unsigned x, unsigned& nloc, unsigned& nx) {
    const unsigned G = gridDim.x * gridDim.y * gridDim.z;
    unsigned sum, cnt, mine, sp = 0u;
    for (;;) {
        sum = 0u; cnt = 0u; mine = 0u;
#pragma unroll
        for (unsigned j = 0; j < 16; ++j) { const unsigned c = xb_ld(&bar[XB_XCNT(j)]); sum += c; cnt += (c > 0u) ? 1u : 0u; mine = (j == x) ? c : mine; }
        if (sum == G) break;
        __builtin_amdgcn_s_sleep(1);
        if ((++sp & 255u) == 0u) { if (xb_ld(&bar[XB_TMO])) break; if (sp > XB_SPIN_CAP) { atomicAdd(&bar[XB_TMO], 1u); break; } }
    }
    nloc = mine > 0u ? mine : 1u; nx = cnt > 0u ? cnt : 1u;
}

__device__ __forceinline__ void xcd_barrier(const XcdBarrier& b) {
    asm volatile("s_waitcnt vmcnt(0)" ::: "memory");
    __syncthreads();
    if (threadIdx.x == 0) {
        unsigned* bar = b.bar;
        __builtin_amdgcn_s_waitcnt(0);
        unsigned nloc = b.st[0], nx = b.st[1];
        if (nloc == 0u) { xcd_barrier_complete(bar, b.x, nloc, nx); b.st[0] = nloc; b.st[1] = nx; }
        const unsigned old = xb_add(&bar[XB_XSUB(b.x)], 1u);
        const unsigned gen = old / nloc;
        if (old + 1u == (gen + 1u) * nloc) {
            __builtin_amdgcn_fence(__ATOMIC_RELEASE, "agent");
            asm volatile("s_waitcnt vmcnt(0)" ::: "memory");
            const unsigned og = xb_add(&bar[XB_TOP], 1u);
            const unsigned tg = og / nx;
            if (og + 1u == (tg + 1u) * nx) xb_add(&bar[XB_TOPGEN], 1u);
            else XB_SPIN(xb_ld(&bar[XB_TOPGEN]) == tg, bar);
            __builtin_amdgcn_fence(__ATOMIC_ACQUIRE, "agent");
            xb_add(&bar[XB_XGEN(b.x)], 1u);
            asm volatile("s_waitcnt vmcnt(0)" ::: "memory");
        } else {
            XB_SPIN(xb_ld(&bar[XB_XGEN(b.x)]) == gen, bar);
            __builtin_amdgcn_fence(__ATOMIC_ACQUIRE, "agent");
            asm volatile("s_waitcnt vmcnt(0)" ::: "memory");
        }
    }
    __syncthreads();
}


__device__ __forceinline__ size_t opaque_zero() { size_t z = 0; asm volatile("" : "+s"(z)); return z; }
#define OWS (p.ws + opaque_zero())
__device__ __forceinline__ int opaque_zero_i() { int z = 0; asm volatile("" : "+s"(z)); return z; }
#define PIN(i) (p.in[(i) + opaque_zero_i()])
struct KP { const float* in[N_IN]; float* out; unsigned char* ws; int ph; int pad; };

template <int MODE> __device__ __forceinline__ int rowmap(int n, int arg) {
    if (MODE == 0) return n + arg;
    if (MODE == 1) { if (n < 1536) return n; if (n < 1664) return n - 1536 + PC_WD; if (n < 1792) return n - 1664 + PC_AD; if (n < 1920) return n - 1792 + PC_GD;
                     if (n < 2432) return n - 1920 + PC_CB; if (n < 2944) return n - 2432 + PC_CC; return n - 2944 + PC_CH; }
    return 8 * (n >> 2) + 4 * arg + (n & 3);
}
template <int MODE> __device__ __forceinline__ void transpose_item(const float* W, int K, int N, bf16* WT, int arg, LAS float* scr, int item, int lane) {
    const int nblk = N / 32, kb = item / nblk, nb = item % nblk, k0 = 64 * kb, n0 = 32 * nb;
#pragma unroll 8
    for (int i = 0; i < 32; ++i) { const int kk = 2 * i + (lane >> 5); scr[kk * 33 + (lane & 31)] = W[(size_t)(k0 + kk) * N + n0 + (lane & 31)]; }
    LDS_WAIT(); asm volatile("" ::: "memory");
    const int c = lane & 7;
#pragma unroll
    for (int j = 0; j < 4; ++j) { const int n = (lane >> 3) + 8 * j; const LAS float* s = scr + (8 * c) * 33 + n;
        v4u o; o.x = pk2(s[0 * 33], s[1 * 33]); o.y = pk2(s[2 * 33], s[3 * 33]); o.z = pk2(s[4 * 33], s[5 * 33]); o.w = pk2(s[6 * 33], s[7 * 33]);
        *(v4u*)(WT + (size_t)rowmap<MODE>(n0 + n, arg) * K + k0 + 8 * c) = o; }
    LDS_WAIT(); asm volatile("" ::: "memory");
}

__device__ __forceinline__ void ph_modvec(const KP& p, LAS unsigned char* lds, int tid) {
    LAS float* sil = (LAS float*)lds;
    LAS float* red = (LAS float*)(lds + 5 * 1024 * 4);
    const float* c = PIN(I_C); const float* cc = PIN(I_CCTX);
    for (int i = tid; i < 5 * 1024; i += 512) { const float v = i < 4096 ? c[i] : cc[i - 4096]; sil[i] = v / (1.f + __expf(-v)); }
    __syncthreads();
    float* modv = (float*)(OWS + WS_MODV);
    const int l = (int)blockIdx.x >> 6, j0 = ((int)blockIdx.x & 63) * 96;
    if (tid < 384) { const int ks = tid / 24, cq = tid % 24;
        const float* w = PIN(I_WMOD) + (size_t)l * D * NMOD + (size_t)(ks * 64) * NMOD + j0 + 4 * cq;
        f32x4 a0 = {0.f, 0.f, 0.f, 0.f}, a1 = a0, a2 = a0, a3 = a0, a4 = a0;
#pragma unroll 8
        for (int k = 0; k < 64; ++k) { const f32x4 wv = *(const f32x4*)(w + (size_t)k * NMOD); const int kk = ks * 64 + k;
            a0 += sil[kk] * wv; a1 += sil[1024 + kk] * wv; a2 += sil[2048 + kk] * wv; a3 += sil[3072 + kk] * wv; a4 += sil[4096 + kk] * wv; }
        *(LAS f32x4*)(red + (ks * 5 + 0) * 96 + 4 * cq) = a0; *(LAS f32x4*)(red + (ks * 5 + 1) * 96 + 4 * cq) = a1; *(LAS f32x4*)(red + (ks * 5 + 2) * 96 + 4 * cq) = a2;
        *(LAS f32x4*)(red + (ks * 5 + 3) * 96 + 4 * cq) = a3; *(LAS f32x4*)(red + (ks * 5 + 4) * 96 + 4 * cq) = a4; }
    __syncthreads();
    if (tid < 480) { const int r = tid / 96, col = tid % 96; float sacc = 0.f;
#pragma unroll
        for (int q = 0; q < 16; ++q) sacc += red[(q * 5 + r) * 96 + col];
        modv[(size_t)(l * 5 + r) * NMOD + j0 + col] = sacc + PIN(I_BMOD)[l * NMOD + j0 + col]; }
    __syncthreads();
}

__device__ __forceinline__ void ph_convert(const KP& p, LAS unsigned char* lds, int gw, int NGW, int wave, int lane) {
    LAS float* scr = (LAS float*)(lds + wave * 16384);
    bf16* win = (bf16*)(OWS + WS_WIN); bf16* f2 = (bf16*)(OWS + WS_F2); bf16* lora = (bf16*)(OWS + WS_LORA);
    constexpr int I_IN = (D / 64) * (NPROJ / 32), I_OUT = (D / 64) * (D / 32), I_UP = (D / 64) * (DFF / 32), I_DN = (DFF / 64) * (D / 32);
    for (int it = gw; it < I_DN; it += NGW) transpose_item<0>(PIN(I_FW2), DFF, D, f2, 0, scr, it, lane);
    { const int gt = gw * 64 + lane, NGT = NGW * 64; constexpr int PER = (NP - NPROJ) * D / 16;
      for (int i = gt; i < DEPTH * PER; i += NGT) { const int l = i / PER, q = i % PER; *(v4u*)((unsigned char*)win + (size_t)l * NP * D + (size_t)NPROJ * D + (size_t)q * 16) = (v4u){0u, 0u, 0u, 0u}; } }
    { const int gt = gw * 64 + lane, NGT = NGW * 64;
      for (int i = gt; i < DEPTH * LORAW_PER_LAYER / 8; i += NGT) { const int l = i / (LORAW_PER_LAYER / 8); int q = (i % (LORAW_PER_LAYER / 8)) * 8; float v[8];
          int grp, c, k0; if (q < 4 * 512 * 64) { grp = q / (512 * 64); q -= grp * 512 * 64; c = q / 64; k0 = q % 64; } else { grp = 4; q -= 4 * 512 * 64; c = q / 128; k0 = q % 128; }
#pragma unroll
          for (int j = 0; j < 8; ++j) { const int k = k0 + j;
              v[j] = grp < 2 ? PIN(I_W2)[((size_t)(l * 2 + grp) * 64 + k) * RW + c] : grp < 4 ? PIN(I_A2)[((size_t)(l * 2 + grp - 2) * 64 + k) * RW + c] : PIN(I_G2)[((size_t)l * 128 + k) * RW + c]; }
          v4u o; o.x = pk2(v[0], v[1]); o.y = pk2(v[2], v[3]); o.z = pk2(v[4], v[5]); o.w = pk2(v[6], v[7]);
          *(v4u*)(lora + (size_t)i * 8) = o; } }
}
#ifndef AMAX_ROWS
#define AMAX_ROWS 128
#endif
__device__ __forceinline__ void ph_amax(const KP& p, int gw, int NGW, int lane) {
    unsigned* AM = (unsigned*)(OWS + WS_AMAX);
    const int kp = lane >> 4, cq = lane & 15;
    for (int it = gw; it < 18 * 2 * (DFF / 64); it += NGW) { const int strip = it % (DFF / 64), sm = it / (DFF / 64), s1 = sm & 1, cm = sm >> 1;
        const float* W = cm < 2 ? PIN(s1 ? I_FW3 : I_FW1) + (size_t)cm * D * DFF : PIN(s1 ? I_MW3 : I_MW1) + (size_t)(cm - 2) * D * DFF;
        const int n = strip * 64 + 4 * cq; const float* src = W + (size_t)kp * DFF + n; f32x4 m = {0.f, 0.f, 0.f, 0.f};
#pragma unroll 16
        for (int k = 0; k < AMAX_ROWS / 4; ++k) { const f32x4 w = *(const f32x4*)(src + (size_t)(4 * k) * DFF); m += w * w; }
#pragma unroll
        for (int j = 0; j < 4; ++j) { m[j] += __shfl_xor(m[j], 16); m[j] += __shfl_xor(m[j], 32); }
        if (kp == 0) { f32x4 o;
#pragma unroll
            for (int j = 0; j < 4; ++j) o[j] = 4.25f * sqrtf(m[j] * (1.f / AMAX_ROWS));
            *(f32x4*)((float*)AM + (size_t)cm * 2 * DFF + 8 * (n >> 2) + 4 * s1) = o; } }
    for (int it = gw; it < DEPTH * (NPROJ / 64 + D / 64); it += NGW) { int t = it; const int l = t / (NPROJ / 64 + D / 64); t -= l * (NPROJ / 64 + D / 64);
        const bool isin = t < NPROJ / 64; const int strip = isin ? t : t - NPROJ / 64, N = isin ? NPROJ : D, n = strip * 64 + 4 * cq;
        const float* src = (isin ? PIN(I_WIN) + (size_t)l * D * NPROJ : PIN(I_WOUT) + (size_t)l * D * D) + (size_t)kp * N + n; f32x4 m = {0.f, 0.f, 0.f, 0.f};
#pragma unroll 16
        for (int k = 0; k < AMAX_ROWS / 4; ++k) { const f32x4 w = *(const f32x4*)(src + (size_t)(4 * k) * N); m += w * w; }
#pragma unroll
        for (int j = 0; j < 4; ++j) { m[j] += __shfl_xor(m[j], 16); m[j] += __shfl_xor(m[j], 32); }
        if (kp == 0) {
#pragma unroll
            for (int j = 0; j < 4; ++j) AM[isin ? AM_IN + l * NP + rowmap<1>(n + j, 0) : AM_OUT + l * D + n + j] = __builtin_bit_cast(unsigned, 4.25f * sqrtf(m[j] * (1.f / AMAX_ROWS))); } }
}
__device__ __forceinline__ unsigned q8pack(float a, float b, float c, float d) {
    const int qa = __float2int_rn(fminf(fmaxf(a, -127.f), 127.f)), qb = __float2int_rn(fminf(fmaxf(b, -127.f), 127.f)), qc = __float2int_rn(fminf(fmaxf(c, -127.f), 127.f)), qd = __float2int_rn(fminf(fmaxf(d, -127.f), 127.f));
    return (unsigned)(qa & 255) | ((unsigned)(qb & 255) << 8) | ((unsigned)(qc & 255) << 16) | ((unsigned)(qd & 255) << 24); }
constexpr int CQ_IN = (D / 64) * (NPROJ / 32), CQ_OUT = (D / 64) * (D / 32), CQ_UP = (D / 64) * (DFF / 32), CQ_DN = (DFF / 64) * (D / 32);
constexpr int CQ_NEG = CQ_IN + CQ_OUT + 2 * CQ_UP;
constexpr int CQ_J1 = 3 * CQ_IN + 3 * CQ_OUT + 2 * CQ_UP + CQ_DN, CQ_MOE = NE * (2 * CQ_UP + CQ_DN), CQ_END0 = CQ_J1 + CQ_MOE, CQ_END1 = CQ_END0 + CQ_MOE;
#ifndef CQ_SLOT_ITEMS
#define CQ_SLOT_ITEMS 12000
#endif
struct CqItem { const float* W; bf16* WT; int K, N, mode, arg, item; const unsigned* am; };
__device__ __forceinline__ CqItem cq_decode(const KP& p, int q) {
    CqItem c; bf16* win = (bf16*)(OWS + WS_WIN); bf16* wout = (bf16*)(OWS + WS_WOUT); bf16* f13 = (bf16*)(OWS + WS_F13); bf16* f2 = (bf16*)(OWS + WS_F2);
    bf16* m13 = (bf16*)(OWS + WS_MOEW13); bf16* m2 = (bf16*)(OWS + WS_MOEW2); const unsigned* AM = (const unsigned*)(OWS + WS_AMAX);
    if (q < 0) { q += CQ_NEG;
        if (q < CQ_IN) { c = CqItem{PIN(I_WIN), win, D, NPROJ, 3, 0, q, AM + AM_IN}; return c; } q -= CQ_IN;
        if (q < CQ_OUT) { c = CqItem{PIN(I_WOUT), wout, D, D, 4, 0, q, AM + AM_OUT}; return c; } q -= CQ_OUT;
        if (q < CQ_UP) { c = CqItem{PIN(I_FW1), f13, D, DFF, 2, 0, q, AM}; return c; } q -= CQ_UP;
        c = CqItem{PIN(I_FW3), f13, D, DFF, 2, 1, q, AM}; return c; }
    if (q < 3 * CQ_IN) { const int l = 1 + q / CQ_IN; c = CqItem{PIN(I_WIN) + (size_t)l * D * NPROJ, win + (size_t)l * (NP * D / 2), D, NPROJ, 3, 0, q % CQ_IN, AM + AM_IN + l * NP}; return c; } q -= 3 * CQ_IN;
    if (q < 3 * CQ_OUT) { const int l = 1 + q / CQ_OUT; c = CqItem{PIN(I_WOUT) + (size_t)l * D * D, wout + (size_t)l * (D * D / 2), D, D, 4, 0, q % CQ_OUT, AM + AM_OUT + l * D}; return c; } q -= 3 * CQ_OUT;
    if (q < CQ_UP) { c = CqItem{PIN(I_FW1) + (size_t)D * DFF, f13 + (size_t)DFF * D, D, DFF, 2, 0, q, AM + 2 * DFF}; return c; } q -= CQ_UP;
    if (q < CQ_UP) { c = CqItem{PIN(I_FW3) + (size_t)D * DFF, f13 + (size_t)DFF * D, D, DFF, 2, 1, q, AM + 2 * DFF}; return c; } q -= CQ_UP;
    if (q < CQ_DN) { c = CqItem{PIN(I_FW2) + (size_t)DFF * D, f2 + (size_t)D * DFF, DFF, D, 0, 0, q, nullptr}; return c; } q -= CQ_DN;
    const int mi = q / CQ_MOE; q -= mi * CQ_MOE;
    if (q < NE * CQ_UP) { const int e = q / CQ_UP; c = CqItem{PIN(I_MW1) + ((size_t)mi * NE + e) * D * DFF, m13 + (size_t)e * DFF * D, D, DFF, 2, 0, q % CQ_UP, AM + (size_t)(2 + 8 * mi + e) * 2 * DFF}; return c; } q -= NE * CQ_UP;
    if (q < NE * CQ_UP) { const int e = q / CQ_UP; c = CqItem{PIN(I_MW3) + ((size_t)mi * NE + e) * D * DFF, m13 + (size_t)e * DFF * D, D, DFF, 2, 1, q % CQ_UP, AM + (size_t)(2 + 8 * mi + e) * 2 * DFF}; return c; } q -= NE * CQ_UP;
    { const int e = q / CQ_DN; c = CqItem{PIN(I_MW2) + ((size_t)mi * NE + e) * DFF * D, m2 + (size_t)e * D * DFF, DFF, D, 0, 0, q % CQ_DN, nullptr}; return c; }
}
__device__ __forceinline__ void cq_load(const CqItem& c, int lane, float (&r)[32]) {
    const int nblk = c.N / 32, kb = c.item / nblk, nb = c.item % nblk; const float* src = c.W + (size_t)(64 * kb + (lane >> 5)) * c.N + 32 * nb + (lane & 31);
#pragma unroll
    for (int i = 0; i < 32; ++i) r[i] = src[(size_t)(2 * i) * c.N];
}
__device__ __forceinline__ void cq_store(const CqItem& c, int lane, const float (&r)[32], LAS float* scr) {
    const int nblk = c.N / 32, kb = c.item / nblk, nb = c.item % nblk, k0 = 64 * kb, n0 = 32 * nb;
#pragma unroll
    for (int i = 0; i < 32; ++i) scr[(2 * i + (lane >> 5)) * 33 + (lane & 31)] = r[i];
    LDS_WAIT(); asm volatile("" ::: "memory");
    if (c.mode >= 2) {
        const int n = lane >> 1, hf = lane & 1, nn = n0 + n, j = c.mode == 2 ? 8 * (nn >> 2) + 4 * c.arg + (nn & 3) : c.mode == 3 ? rowmap<1>(nn, 0) : nn;
        const float inv = 127.f / fmaxf(__builtin_bit_cast(float, c.am[j]), 1e-30f); const LAS float* sp = scr + (32 * hf) * 33 + n; unsigned w[8];
#pragma unroll
        for (int q = 0; q < 8; ++q) w[q] = q8pack(sp[(4 * q + 0) * 33] * inv, sp[(4 * q + 1) * 33] * inv, sp[(4 * q + 2) * 33] * inv, sp[(4 * q + 3) * 33] * inv);
        unsigned char* dst = (unsigned char*)c.WT + (size_t)j * c.K + k0 + 32 * hf;
        *(v4u*)dst = (v4u){w[0], w[1], w[2], w[3]}; *(v4u*)(dst + 16) = (v4u){w[4], w[5], w[6], w[7]};
    } else {
    const int cc = lane & 7;
#pragma unroll
    for (int j = 0; j < 4; ++j) { const int n = (lane >> 3) + 8 * j; const LAS float* sp = scr + (8 * cc) * 33 + n;
        v4u o; o.x = pk2(sp[0 * 33], sp[1 * 33]); o.y = pk2(sp[2 * 33], sp[3 * 33]); o.z = pk2(sp[4 * 33], sp[5 * 33]); o.w = pk2(sp[6 * 33], sp[7 * 33]);
        const int nn = n0 + n;
        *(v4u*)(c.WT + (size_t)nn * c.K + k0 + 8 * cc) = o; }
    }
    LDS_WAIT(); asm volatile("" ::: "memory");
}
constexpr int CQ_B = 4;
__device__ __forceinline__ int cq_grab(unsigned* heads, int nseg, int& cnt, int lane) {
    int q = -1, n = 0;
    if (lane == 0) { for (int sg = 0; sg < nseg && q < 0; ++sg) { const int size = sg == 0 ? CQ_J1 : CQ_MOE, base = sg == 0 ? 0 : sg == 1 ? CQ_J1 : CQ_END0; unsigned* hd = heads + 64 * sg;
            if ((int)__hip_atomic_load(hd, __ATOMIC_RELAXED, __HIP_MEMORY_SCOPE_AGENT) < size) { const int t = (int)__hip_atomic_fetch_add(hd, (unsigned)CQ_B, __ATOMIC_RELAXED, __HIP_MEMORY_SCOPE_AGENT);
                if (t < size) { q = base + t; n = size - t < CQ_B ? size - t : CQ_B; } } } }
    cnt = __builtin_amdgcn_readfirstlane(n); return __builtin_amdgcn_readfirstlane(q);
}
__device__ __forceinline__ void cq_run(const KP& p, LAS unsigned char* lds, int nseg, const unsigned* stop, unsigned stopval, int wave, int lane) {
    unsigned* heads = (unsigned*)(OWS + WS_CTL) + CW_CQ; LAS float* scr = (LAS float*)(lds + wave * 16384);
    for (;;) {
        if (stop) { unsigned sv = 0u; if (lane == 0) sv = __hip_atomic_load(stop, __ATOMIC_RELAXED, __HIP_MEMORY_SCOPE_AGENT); if ((unsigned)__builtin_amdgcn_readfirstlane((int)sv) >= stopval) break; }
        int cnt; const int q0 = cq_grab(heads, nseg, cnt, lane); if (q0 < 0) break;
        CqItem cur = cq_decode(p, q0); float ra[32]; cq_load(cur, lane, ra);
        for (int j = 0; j < cnt; ++j) { CqItem nxt = cur; float rb[32];
            if (j + 1 < cnt) { nxt = cq_decode(p, q0 + j + 1); cq_load(nxt, lane, rb); }
            cq_store(cur, lane, ra, scr);
            if (j + 1 < cnt) { cur = nxt;
#pragma unroll
                for (int i = 0; i < 32; ++i) ra[i] = rb[i]; } }
    }
}

__device__ __forceinline__ void cq_static(const KP& p, LAS unsigned char* lds, int q0, int q1, int gw, int NGW, int wave, int lane) {
    LAS float* scr = (LAS float*)(lds + wave * 16384);
    int q = q0 + gw; if (q >= q1) return;
    CqItem cur = cq_decode(p, q); float ra[32]; cq_load(cur, lane, ra);
    for (;;) { const int qn = q + NGW; CqItem nxt = cur; float rb[32];
        if (qn < q1) { nxt = cq_decode(p, qn); cq_load(nxt, lane, rb); }
        cq_store(cur, lane, ra, scr);
        if (qn >= q1) break;
        cur = nxt; q = qn;
#pragma unroll
        for (int i = 0; i < 32; ++i) ra[i] = rb[i]; }
}

constexpr int CW_ICUR = 13312, CW_IDONE = 13440;
#ifndef PROBE_MI
#define PROBE_MI 0
#endif
#ifndef IDLE_STOP
#define IDLE_STOP 1
#endif
constexpr int IDLE_IN0 = ((MROWS / 256) * (NP / 256)) % 256, IDLE_OT0 = (NCTX / 256) * (D / 256) * 2, IDLE_UP0 = ((MROWS / 256) * (2 * DFF / 256)) % 256, IDLE_DT0 = (NCTX / 256) * (D / 256) * 7;
constexpr int CQO_DYN = 2 * CQ_SLOT_ITEMS, CQ_DYN_LIM = CQ_MOE - CQO_DYN;
static_assert(CQ_DYN_LIM > 0, "carry-phase slots exceed the MoE conversion segment");
__device__ __forceinline__ void cq_idle(const KP& p, LAS unsigned char* lds, int segbase, int mi, int slot, int first_idle, int tid, int wave, int lane) {
#ifdef IDLE_OFF
    return;
#endif
    unsigned* ctl = (unsigned*)(OWS + WS_CTL);
    if ((int)blockIdx.x < first_idle) { if (tid == 0) __hip_atomic_fetch_add(ctl + CW_IDONE + 64 * slot, 1u, __ATOMIC_RELAXED, __HIP_MEMORY_SCOPE_AGENT); }
    else {
        asm volatile("s_waitcnt vmcnt(0)" ::: "memory"); __syncthreads();
        LAS int* tk = (LAS int*)(lds + LDSCTL_OFF + 2048); LAS float* scr = (LAS float*)(lds + wave * 16384);
        for (int r = 0;; ++r) {
            if (tid == 0) { int t = -1;
                if ((int)__hip_atomic_load(ctl + CW_IDONE + 64 * slot, __ATOMIC_RELAXED, __HIP_MEMORY_SCOPE_AGENT) < IDLE_STOP) {
                    t = (int)__hip_atomic_fetch_add(ctl + CW_ICUR + 64 * mi, (unsigned)NWAVES, __ATOMIC_RELAXED, __HIP_MEMORY_SCOPE_AGENT); if (t >= CQ_DYN_LIM) t = -1; }
                tk[r & 1] = t; }
            __syncthreads();
            const int t = __builtin_amdgcn_readfirstlane(tk[r & 1]); if (t < 0) break;
            const int q = segbase + CQO_DYN + t + wave;
            if (q < segbase + CQ_MOE) { CqItem c = cq_decode(p, q); float ra[32]; cq_load(c, lane, ra); cq_store(c, lane, ra, scr); }
        }
    }
}

__device__ __forceinline__ void ld_row(const float* r, int lane, f32x4 (&v)[4]) { const f32x4* q = (const f32x4*)r + lane;
#pragma unroll
    for (int j = 0; j < 4; ++j) v[j] = q[64 * j]; }
__device__ __forceinline__ void st_row(float* r, int lane, const f32x4 (&v)[4]) { f32x4* q = (f32x4*)r + lane;
#pragma unroll
    for (int j = 0; j < 4; ++j) q[64 * j] = v[j]; }
__device__ __forceinline__ void st_row_bf16(bf16* r, int lane, const f32x4 (&v)[4]) { v2u* q = (v2u*)r + lane;
#pragma unroll
    for (int j = 0; j < 4; ++j) { v2u w; w.x = pk2(v[j][0], v[j][1]); w.y = pk2(v[j][2], v[j][3]); q[64 * j] = w; } }
__device__ __forceinline__ void ld_row_bf16(const bf16* r, int lane, f32x4 (&v)[4]) { const v2u* q = (const v2u*)r + lane;
#pragma unroll
    for (int j = 0; j < 4; ++j) { const v2u w = q[64 * j]; v[j] = (f32x4){bflo(w.x), bfhi(w.x), bflo(w.y), bfhi(w.y)}; } }
typedef _Float16 h16x4 __attribute__((ext_vector_type(4)));
__device__ __forceinline__ void st_row_h16(_Float16* r, int lane, const f32x4 (&v)[4]) { h16x4* q = (h16x4*)r + lane;
#pragma unroll
    for (int j = 0; j < 4; ++j) { h16x4 w; w[0] = (_Float16)v[j][0]; w[1] = (_Float16)v[j][1]; w[2] = (_Float16)v[j][2]; w[3] = (_Float16)v[j][3]; q[64 * j] = w; } }
__device__ __forceinline__ void ld_row_h16(const _Float16* r, int lane, f32x4 (&v)[4]) { const h16x4* q = (const h16x4*)r + lane;
#pragma unroll
    for (int j = 0; j < 4; ++j) { const h16x4 w = q[64 * j]; v[j] = (f32x4){(float)w[0], (float)w[1], (float)w[2], (float)w[3]}; } }
template <int S> __device__ __forceinline__ void ld_row_parts(const float* r, size_t pstride, int lane, f32x4 (&v)[4]) {
    ld_row(r, lane, v);
#pragma unroll
    for (int s = 1; s < S; ++s) { f32x4 t[4]; ld_row(r + (size_t)s * pstride, lane, t);
#pragma unroll
        for (int j = 0; j < 4; ++j) v[j] += t[j]; } }
__device__ __forceinline__ int mod_row(int row) { return row < NLAT ? (row >> 12) : 4; }

__device__ __forceinline__ void st_row_q8(unsigned char* dst8, float* scale, int row, int lane, const f32x4 (&v)[4]) {
    float am = 0.f;
#pragma unroll
    for (int j = 0; j < 4; ++j) am = fmaxf(fmaxf(am, fmaxf(fabsf(v[j][0]), fabsf(v[j][1]))), fmaxf(fabsf(v[j][2]), fabsf(v[j][3])));
#pragma unroll
    for (int o = 1; o < 64; o <<= 1) am = fmaxf(am, __shfl_xor(am, o));
    am = fmaxf(am, 1e-30f); const float inv = 127.f / am; unsigned* h8 = (unsigned*)dst8 + (size_t)row * (D / 4) + lane;
#pragma unroll
    for (int j = 0; j < 4; ++j) h8[64 * j] = q8pack(v[j][0] * inv, v[j][1] * inv, v[j][2] * inv, v[j][3] * inv);
    if (lane == 0) scale[row] = am * (1.f / 127.f);
}
__device__ __forceinline__ void ph_init_rows(const KP& p, int gw, int NGW, int lane) {
    const float* modv = (const float*)(OWS + WS_MODV); float* X = (float*)(OWS + WS_X); bf16* H = (bf16*)(OWS + WS_H);
    for (int row = gw; row < MROWS; row += NGW) {
        const float* src = row < NLAT ? PIN(I_X) + (size_t)row * D : PIN(I_CTX) + (size_t)(row - NLAT) * D;
        const float* mv = modv + (size_t)(0 * 5 + mod_row(row)) * NMOD;
        f32x4 x[4], sh[4], sc[4], h[4]; ld_row(src, lane, x); ld_row(mv, lane, sh); ld_row(mv + 1024, lane, sc);
#pragma unroll
        for (int j = 0; j < 4; ++j) h[j] = x[j] * (1.f + sc[j]) + sh[j];
        st_row_q8(OWS + WS_H8, (float*)(OWS + WS_SA), row, lane, h);
    }
}

__device__ __forceinline__ int scan_row(int b, int dir, int step) { return step < CTXL ? NLAT + b * CTXL + (dir ? CTXL - 1 - step : step) : b * SEQ + (dir ? SEQ - 1 - (step - CTXL) : step - CTXL); }
typedef short sbf16x8 __attribute__((ext_vector_type(8)));
typedef float f32x16 __attribute__((ext_vector_type(16)));
constexpr int SC_C = 32, SC_NCH = (CTXL + SEQ) / SC_C  , SC_NCHAIN = NB * NH * 2  , SC_NTASK = SC_NCH * SC_NCHAIN  ;
constexpr int CH_G = 0, CH_Q = 8192, CH_UT = 12288, CH_YL = 20480, CH_EC = 24576, CH_BYTES = 25600, CH_NLOAD = 26;

__device__ __forceinline__ f32x16 mm(v4u a, v4u b, f32x16 c) { return __builtin_amdgcn_mfma_f32_32x32x16_bf16(__builtin_bit_cast(sbf16x8, a), __builtin_bit_cast(sbf16x8, b), c, 0, 0, 0); }
typedef float f32x2c __attribute__((ext_vector_type(2))); typedef __bf16 bf16x2c __attribute__((ext_vector_type(2)));
__device__ __forceinline__ unsigned cvtpk(float lo, float hi) { return __builtin_bit_cast(unsigned, __builtin_convertvector((f32x2c){lo, hi}, bf16x2c)); }
template <int S, int NEG> __device__ __forceinline__ v4u cvtf(const f32x16& x) {
    v4u w; const float sg = NEG ? -1.f : 1.f;
    w.x = cvtpk(sg * x[8 * S + 0], sg * x[8 * S + 1]); w.y = cvtpk(sg * x[8 * S + 2], sg * x[8 * S + 3]); w.z = cvtpk(sg * x[8 * S + 4], sg * x[8 * S + 5]); w.w = cvtpk(sg * x[8 * S + 6], sg * x[8 * S + 7]); return w; }
template <int MODE  > __device__ __forceinline__ f32x16 mask_acc(f32x16 x, int n, int hh) {
#pragma unroll
    for (int r = 0; r < 16; ++r) { const int m = (r & 3) + 8 * (r >> 2) + 4 * hh; const bool keep = MODE == 0 ? (m > n) : MODE == 1 ? (m < n) : (m <= n); x[r] = keep ? x[r] : 0.f; }
    return x; }
__device__ __forceinline__ f32x16 zero16() { f32x16 z;
#pragma unroll
    for (int r = 0; r < 16; ++r) z[r] = 0.f;
    return z; }
__device__ __forceinline__ void cm_build(const unsigned (&w)[16], v4u (&f)[2][2]) {
#pragma unroll
    for (int s = 0; s < 2; ++s) {
        const auto r0 = __builtin_amdgcn_permlane32_swap(w[8 * s + 0], w[8 * s + 2], false, false), r1 = __builtin_amdgcn_permlane32_swap(w[8 * s + 1], w[8 * s + 3], false, false);
        const auto r2 = __builtin_amdgcn_permlane32_swap(w[8 * s + 4], w[8 * s + 6], false, false), r3 = __builtin_amdgcn_permlane32_swap(w[8 * s + 5], w[8 * s + 7], false, false);
        f[0][s] = (v4u){r0[0], r1[0], r2[0], r3[0]}; f[1][s] = (v4u){r0[1], r1[1], r2[1], r3[1]}; }
}
__device__ __forceinline__ void st16(unsigned char* base, int off, int lane, v4u v) { *(v4u*)(base + off + lane * 16) = v; }

__device__ __forceinline__ void ph_scan1(const KP& p, int l, int gw, int NGW, int lane) {
    const bf16* P = (const bf16*)(OWS + WS_P); const bf16* LO = (const bf16*)(OWS + WS_LO); const float* NRM = (const float*)(OWS + WS_RKS); unsigned char* CH = OWS + WS_CH;
    const int n = lane & 31, hh = lane >> 5;
    v4u Id[2];
#pragma unroll
    for (int s = 0; s < 2; ++s) { unsigned wd[4];
#pragma unroll
        for (int q = 0; q < 4; ++q) { const int j0 = 2 * q, j1 = 2 * q + 1; const int t0 = 16 * s + 8 * (j0 >> 2) + 4 * hh + (j0 & 3), t1 = 16 * s + 8 * (j1 >> 2) + 4 * hh + (j1 & 3);
            wd[q] = (t0 == n ? 0x3F80u : 0u) | (t1 == n ? 0x3F800000u : 0u); }
        Id[s] = (v4u){wd[0], wd[1], wd[2], wd[3]}; }
    for (int task = gw; task < SC_NTASK; task += NGW) {
        const int dir = task & 1, h = (task >> 1) & 7, b = (task >> 4) & 3, ci = task >> 6;
        const int row0 = scan_row(b, dir, SC_C * ci), sgn = dir ? -1 : 1, c = h * 64 + lane;
        const float w0c = PIN(I_W0)[(l * 2 + dir) * RW + c], a0c = PIN(I_A0)[(l * 2 + dir) * RW + c], kkc = PIN(I_KK)[l * RW + c], kac = PIN(I_KA)[l * RW + c];
        unsigned wAl[16], wBe[16], wKa[16], wRh[16], wV[16], wBp[16], wKp[16];
        float cs = 0.f, Eprev = 1.f;
#pragma unroll
        for (int hb = 0; hb < 2; ++hb) {
            unsigned rk_[16], rr_[16], rv_[16], rw_[16], ra_[16]; float rn_[16];
#pragma unroll
            for (int i = 0; i < 16; ++i) { const int row = row0 + sgn * (16 * hb + i); const bf16* pr = P + (size_t)row * NP; const bf16* lo = LO + (size_t)row * NLO;
                rk_[i] = pr[PC_K + c]; rr_[i] = pr[PC_R + c]; rv_[i] = pr[PC_V + c]; rw_[i] = lo[dir * RW + c]; ra_[i] = lo[1024 + dir * RW + c]; rn_[i] = NRM[row * 8 + h]; }
#pragma unroll
            for (int i = 0; i < 16; ++i) asm volatile("" : "+v"(rk_[i]), "+v"(rr_[i]), "+v"(rv_[i]), "+v"(rw_[i]), "+v"(ra_[i]), "+v"(rn_[i]));
#pragma unroll
            for (int pq = 0; pq < 8; ++pq) { const int pz = 8 * hb + pq; float al[2], be[2], ka[2], rh[2], vv[2];
#pragma unroll
                for (int e = 0; e < 2; ++e) { const int i = 2 * pq + e;
                    const float kv = bf2f((unsigned short)rk_[i]), rv = bf2f((unsigned short)rr_[i]); vv[e] = bf2f((unsigned short)rv_[i]);
                    const float wl = w0c + bf2f((unsigned short)rw_[i]), aa = __builtin_amdgcn_rcpf(1.f + __expf(-(a0c + bf2f((unsigned short)ra_[i])))), nrm = rn_[i];
                    const float lw = -0.6065306597f * __builtin_amdgcn_rcpf(1.f + __expf(-wl));
                    cs += lw; const float E = __expf(cs), Ei = __builtin_amdgcn_rcpf(E);
                    const float kkn = kv * kkc * nrm, kd = kv * (1.f + (aa - 1.f) * kac);
                    al[e] = kkn * Eprev; be[e] = kkn * aa * Ei; ka[e] = kd * Ei; rh[e] = rv * E; Eprev = E; }
                wAl[pz] = cvtpk(al[0], al[1]); wBe[pz] = cvtpk(be[0], be[1]); wKa[pz] = cvtpk(ka[0], ka[1]); wRh[pz] = cvtpk(rh[0], rh[1]); wV[pz] = cvtpk(vv[0], vv[1]); }
        }
        const float EC = Eprev;
#pragma unroll
        for (int pz = 0; pz < 16; ++pz) { wBp[pz] = cvtpk(bflo(wBe[pz]) * EC, bfhi(wBe[pz]) * EC); wKp[pz] = cvtpk(bflo(wKa[pz]) * EC, bfhi(wKa[pz]) * EC); }
        unsigned char* img = CH + (size_t)(((b * 8 + h) * 2 + dir) * SC_NCH + ci) * CH_BYTES;
        ((float*)(img + CH_EC))[lane] = EC;
        v4u cAl[2][2], cV[2][2], cBp[2][2], cKp[2][2], cRh[2][2];
        v4u tAl[4], tBe[4], tKa[4], tRh[4];
        cm_build(wAl, cAl); cm_build(wV, cV); cm_build(wBp, cBp); cm_build(wKp, cKp); cm_build(wRh, cRh);
        {   v4u cBe[2][2], cKa[2][2]; cm_build(wBe, cBe); cm_build(wKa, cKa);
#define TRANSPOSE(cZ, tZ) do { _Pragma("unroll") for (int ct = 0; ct < 2; ++ct) { f32x16 T_ = mm(cZ[ct][0], Id[0], zero16()); T_ = mm(cZ[ct][1], Id[1], T_); tZ[2 * ct] = cvtf<0, 0>(T_); tZ[2 * ct + 1] = cvtf<1, 0>(T_); } } while (0)
            TRANSPOSE(cAl, tAl); TRANSPOSE(cBe, tBe); TRANSPOSE(cKa, tKa); TRANSPOSE(cRh, tRh);
#undef TRANSPOSE
        }
#define PROD4(A, B) mm(A[3], B[3], mm(A[2], B[2], mm(A[1], B[1], mm(A[0], B[0], zero16()))))
        f32x16 XN = mask_acc<0>(PROD4(tAl, tBe), n, hh), XT = mask_acc<1>(PROD4(tBe, tAl), n, hh);
        v4u fLM[2], fGB[2], fGK[2];
        { const f32x16 t = mask_acc<1>(PROD4(tKa, tAl), n, hh); fLM[0] = cvtf<0, 0>(t); fLM[1] = cvtf<1, 0>(t); }
        { const f32x16 t = mask_acc<2>(PROD4(tBe, tRh), n, hh); fGB[0] = cvtf<0, 0>(t); fGB[1] = cvtf<1, 0>(t); }
        { const f32x16 t = mask_acc<2>(PROD4(tKa, tRh), n, hh); fGK[0] = cvtf<0, 0>(t); fGK[1] = cvtf<1, 0>(t); }
#undef PROD4
#pragma unroll
        for (int r = 0; r < 16; ++r) { XN[r] = -XN[r]; XT[r] = -XT[r]; }
        f32x16 RT = XT;
#pragma unroll
        for (int r = 0; r < 16; ++r) RT[r] += ((r & 3) + 8 * (r >> 2) + 4 * hh == n) ? 1.f : 0.f;
#pragma unroll
        for (int pw = 1; pw < 5; ++pw) {
            const v4u xn0 = cvtf<0, 0>(XN), xn1 = cvtf<1, 0>(XN), xt0 = cvtf<0, 0>(XT), xt1 = cvtf<1, 0>(XT);
            XN = mm(xt1, xn1, mm(xt0, xn0, zero16()));
            if (pw < 4) XT = mm(xn1, xt1, mm(xn0, xt0, zero16()));
            const v4u yn0 = cvtf<0, 0>(XN), yn1 = cvtf<1, 0>(XN), rt0 = cvtf<0, 0>(RT), rt1 = cvtf<1, 0>(RT);
            RT = mm(yn1, rt1, mm(yn0, rt0, RT));
        }
        const v4u fA0 = cvtf<0, 0>(RT), fA1 = cvtf<1, 0>(RT);
        f32x16 At[2], Vt[2];
#pragma unroll
        for (int t = 0; t < 2; ++t) {
            const f32x16 lmv = mm(fLM[1], cV[t][1], mm(fLM[0], cV[t][0], zero16()));
            At[t] = mm(fA1, cAl[t][1], mm(fA0, cAl[t][0], zero16()));
            Vt[t] = mm(fA1, cvtf<1, 0>(lmv), mm(fA0, cvtf<0, 0>(lmv), zero16()));
        }
#pragma unroll
        for (int kt1 = 0; kt1 < 2; ++kt1) { const v4u a0 = cvtf<0, 0>(At[kt1]), a1 = cvtf<1, 0>(At[kt1]);
#pragma unroll
            for (int kt2 = 0; kt2 < 2; ++kt2) { const f32x16 g = mm(a1, cBp[kt2][1], mm(a0, cBp[kt2][0], zero16()));
                st16(img, CH_G + ((kt2 * 2 + kt1) * 2 + 0) * 1024, lane, cvtf<0, 1>(g)); st16(img, CH_G + ((kt2 * 2 + kt1) * 2 + 1) * 1024, lane, cvtf<1, 1>(g)); } }
#pragma unroll
        for (int vt = 0; vt < 2; ++vt) { const v4u nv0 = cvtf<0, 1>(Vt[vt]), nv1 = cvtf<1, 1>(Vt[vt]);
#pragma unroll
            for (int kt = 0; kt < 2; ++kt) { f32x16 u = mm(cKp[kt][1], cV[vt][1], mm(cKp[kt][0], cV[vt][0], zero16())); u = mm(cBp[kt][1], nv1, mm(cBp[kt][0], nv0, u));
                st16(img, CH_UT + ((kt * 2 + vt) * 2 + 0) * 1024, lane, cvtf<0, 0>(u)); st16(img, CH_UT + ((kt * 2 + vt) * 2 + 1) * 1024, lane, cvtf<1, 0>(u)); }
            f32x16 y = mm(cV[vt][1], fGK[1], mm(cV[vt][0], fGK[0], zero16())); y = mm(nv1, fGB[1], mm(nv0, fGB[0], y));
            st16(img, CH_YL + (vt * 2 + 0) * 1024, lane, cvtf<0, 0>(y)); st16(img, CH_YL + (vt * 2 + 1) * 1024, lane, cvtf<1, 0>(y)); }
#pragma unroll
        for (int kt = 0; kt < 2; ++kt) { f32x16 q = mm(cRh[kt][1], Id[1], mm(cRh[kt][0], Id[0], zero16()));
            q = mm(cvtf<1, 1>(At[kt]), fGB[1], mm(cvtf<0, 1>(At[kt]), fGB[0], q));
            st16(img, CH_Q + (kt * 2 + 0) * 1024, lane, cvtf<0, 0>(q)); st16(img, CH_Q + (kt * 2 + 1) * 1024, lane, cvtf<1, 0>(q)); }
    }
}

__device__ __forceinline__ void ph_scan2(const KP& p, LAS unsigned char* lds, int l, int wave, int lane) {
    unsigned* sdone = (unsigned*)(OWS + WS_CTL) + CW_SDONE + 64 * l;
#ifndef CQ_SLOT_WGS
#define CQ_SLOT_WGS 128
#endif
    if (blockIdx.x >= SC_NCHAIN * 2) {
        const int q0 = (l < 2 ? CQ_J1 : CQ_END0) + (l & 1) * CQ_SLOT_ITEMS;
        cq_static(p, lds, q0, q0 + CQ_SLOT_ITEMS, ((int)blockIdx.x - SC_NCHAIN * 2) * NWAVES + wave, ((int)gridDim.x - SC_NCHAIN * 2) * NWAVES, wave, lane); return; }
    const int chain = blockIdx.x >> 1, vt = blockIdx.x & 1, dir = chain & 1, h = (chain >> 1) & 7, b = chain >> 4;
    const int n = lane & 31, hh = lane >> 5;
    const unsigned char* CH = OWS + WS_CH + (size_t)chain * SC_NCH * CH_BYTES; bf16* Y = (bf16*)(OWS + WS_Y) + (size_t)dir * MROWS * RW + h * 64 + 32 * vt + 4 * hh;
    constexpr int NPIECE = 19, SLOT = NPIECE * 1024, NSLOT = 6, PD = 4, XCH = NSLOT * SLOT;
    int psrc[3], pdst[3];
#pragma unroll
    for (int j = 0; j < 3; ++j) { int f = wave + 8 * j; if (f >= NPIECE) f -= NPIECE;
        pdst[j] = f;
        psrc[j] = f < 12 ? f * 1024 : f < 16 ? CH_UT + ((((f - 12) >> 1) * 2 + vt) * 2 + ((f - 12) & 1)) * 1024 : f < 18 ? CH_YL + (vt * 2 + (f - 16)) * 1024 : CH_EC; }
    const int lane_off[3] = {pdst[0] == 18 ? (lane * 16) & 255 : lane * 16, pdst[1] == 18 ? (lane * 16) & 255 : lane * 16, pdst[2] == 18 ? (lane * 16) & 255 : lane * 16};
#define SC2_ISSUE(ci_, slot_) do { const unsigned char* im_ = CH + (size_t)(ci_) * CH_BYTES; LAS unsigned char* sl_ = lds + (slot_) * SLOT; \
        _Pragma("unroll") for (int j = 0; j < 3; ++j) __builtin_amdgcn_global_load_lds((const unsigned*)(im_ + psrc[j] + lane_off[j]), (LAS unsigned*)(sl_ + pdst[j] * 1024), 16, 0, 0); } while (0)
#define SC2_LD(slot_, piece_) (*(const LAS v4u*)(lds + (slot_) * SLOT + (piece_) * 1024 + lane * 16))
#define SC2_X(par_, k_) (*(LAS v4u*)(lds + XCH + (par_) * 4096 + (k_) * 1024 + lane * 16))
    f32x16 ST[2] = {zero16(), zero16()};
    SC2_ISSUE(0, 0); SC2_ISSUE(1, 1); SC2_ISSUE(2, 2); SC2_ISSUE(3, 3);
    v4u g0, g1, g2, g3, g4, g5, g6, g7, u0, u1, u2, u3; f32x4 ec[8];
#define SC2_PRELOAD(slot_) do { g0 = SC2_LD(slot_, 0); g1 = SC2_LD(slot_, 1); g2 = SC2_LD(slot_, 2); g3 = SC2_LD(slot_, 3); g4 = SC2_LD(slot_, 4); g5 = SC2_LD(slot_, 5); g6 = SC2_LD(slot_, 6); g7 = SC2_LD(slot_, 7); \
        u0 = SC2_LD(slot_, 12); u1 = SC2_LD(slot_, 13); u2 = SC2_LD(slot_, 14); u3 = SC2_LD(slot_, 15); \
        _Pragma("unroll") for (int kq = 0; kq < 8; ++kq) ec[kq] = *(const LAS f32x4*)(lds + (slot_) * SLOT + 18 * 1024 + (32 * (kq >> 2) + 8 * (kq & 3) + 4 * hh) * 4); } while (0)
#ifdef PROBE_S2SEG
    unsigned long long psacc_ = 0, pst_ = 0;
#ifndef PROBE_S2END
#define PROBE_S2END (PROBE_S2SEG + 1)
#endif
#ifndef PROBE_S2WV
#define PROBE_S2WV 0
#endif
#define S2T(id_) do { if ((id_) == PROBE_S2SEG) pst_ = __builtin_readcyclecounter(); if ((id_) == PROBE_S2END) psacc_ += __builtin_readcyclecounter() - pst_; } while (0)
#else
#define S2T(id_) do {} while (0)
#endif
    for (int ci = 0; ci <= SC_NCH; ++ci) {
        S2T(1);
        asm volatile("s_waitcnt vmcnt(6)" ::: "memory");
        __builtin_amdgcn_s_barrier();
        asm volatile("" ::: "memory");
        { const int nx = ci + PD < SC_NCH ? ci + PD : SC_NCH - 1; SC2_ISSUE(nx, (ci + PD) % NSLOT); }
        S2T(2);
        if (wave == 0 && ci < SC_NCH) {
            if (ci == 0) SC2_PRELOAD(0);
            asm volatile("" : "+v"(g0), "+v"(g1), "+v"(g2), "+v"(g3), "+v"(g4), "+v"(g5), "+v"(g6), "+v"(g7), "+v"(u0), "+v"(u1), "+v"(u2), "+v"(u3));
            asm volatile("" : "+v"(ec[0]), "+v"(ec[1]), "+v"(ec[2]), "+v"(ec[3]), "+v"(ec[4]), "+v"(ec[5]), "+v"(ec[6]), "+v"(ec[7]));
            const v4u s00 = cvtf<0, 0>(ST[0]), s01 = cvtf<1, 0>(ST[0]), s10 = cvtf<0, 0>(ST[1]), s11 = cvtf<1, 0>(ST[1]);
            SC2_X(ci & 1, 0) = s00; SC2_X(ci & 1, 1) = s01; SC2_X(ci & 1, 2) = s10; SC2_X(ci & 1, 3) = s11;
            f32x16 a0, a1;
            a0[0] = bflo(u0.x); a0[1] = bfhi(u0.x); a0[2] = bflo(u0.y); a0[3] = bfhi(u0.y); a0[4] = bflo(u0.z); a0[5] = bfhi(u0.z); a0[6] = bflo(u0.w); a0[7] = bfhi(u0.w);
            a0[8] = bflo(u1.x); a0[9] = bfhi(u1.x); a0[10] = bflo(u1.y); a0[11] = bfhi(u1.y); a0[12] = bflo(u1.z); a0[13] = bfhi(u1.z); a0[14] = bflo(u1.w); a0[15] = bfhi(u1.w);
            a1[0] = bflo(u2.x); a1[1] = bfhi(u2.x); a1[2] = bflo(u2.y); a1[3] = bfhi(u2.y); a1[4] = bflo(u2.z); a1[5] = bfhi(u2.z); a1[6] = bflo(u2.w); a1[7] = bfhi(u2.w);
            a1[8] = bflo(u3.x); a1[9] = bfhi(u3.x); a1[10] = bflo(u3.y); a1[11] = bfhi(u3.y); a1[12] = bflo(u3.z); a1[13] = bfhi(u3.z); a1[14] = bflo(u3.w); a1[15] = bfhi(u3.w);
#pragma unroll
            for (int q = 0; q < 4; ++q)
#pragma unroll
                for (int e = 0; e < 4; ++e) { a0[4 * q + e] += ST[0][4 * q + e] * ec[q][e]; a1[4 * q + e] += ST[1][4 * q + e] * ec[4 + q][e]; }
            a0 = mm(g0, s00, a0); a1 = mm(g4, s00, a1); a0 = mm(g1, s01, a0); a1 = mm(g5, s01, a1);
            a0 = mm(g2, s10, a0); a1 = mm(g6, s10, a1); a0 = mm(g3, s11, a0); a1 = mm(g7, s11, a1);
            S2T(3);
            if (ci + 1 < SC_NCH) SC2_PRELOAD((ci + 1) % NSLOT);
            ST[0] = a0; ST[1] = a1;
            if (lane == 0 && ci == SC_NCH - 24) __hip_atomic_fetch_add(sdone, 1u, __ATOMIC_RELAXED, __HIP_MEMORY_SCOPE_AGENT);
        } else if (wave == 1 && ci >= 1) {
            const int cj = ci - 1, sj = cj % NSLOT, par = cj & 1;
            v4u ya = SC2_LD(sj, 16), yc = SC2_LD(sj, 17), q0 = SC2_LD(sj, 8), q1 = SC2_LD(sj, 9), q2 = SC2_LD(sj, 10), q3 = SC2_LD(sj, 11), x0 = SC2_X(par, 0), x1 = SC2_X(par, 1), x2 = SC2_X(par, 2), x3 = SC2_X(par, 3);
            asm volatile("" : "+v"(ya), "+v"(yc), "+v"(q0), "+v"(q1), "+v"(q2), "+v"(q3), "+v"(x0), "+v"(x1), "+v"(x2), "+v"(x3));
            f32x16 y, y2 = zero16();
            y[0] = bflo(ya.x); y[1] = bfhi(ya.x); y[2] = bflo(ya.y); y[3] = bfhi(ya.y); y[4] = bflo(ya.z); y[5] = bfhi(ya.z); y[6] = bflo(ya.w); y[7] = bfhi(ya.w);
            y[8] = bflo(yc.x); y[9] = bfhi(yc.x); y[10] = bflo(yc.y); y[11] = bfhi(yc.y); y[12] = bflo(yc.z); y[13] = bfhi(yc.z); y[14] = bflo(yc.w); y[15] = bfhi(yc.w);
            y = mm(x0, q0, y); y2 = mm(x2, q2, y2); y = mm(x1, q1, y); y2 = mm(x3, q3, y2);
            const int row = scan_row(b, dir, SC_C * cj + n); bf16* yo = Y + (size_t)row * RW;
#pragma unroll
            for (int q = 0; q < 4; ++q) *(v2u*)(yo + 8 * q) = (v2u){cvtpk(y[4 * q] + y2[4 * q], y[4 * q + 1] + y2[4 * q + 1]), cvtpk(y[4 * q + 2] + y2[4 * q + 2], y[4 * q + 3] + y2[4 * q + 3])};
        }
        asm volatile("s_waitcnt lgkmcnt(0)" ::: "memory");
        S2T(4);
    }
    asm volatile("s_waitcnt vmcnt(0)" ::: "memory");
#ifdef PROBE_S2SEG
    if (blockIdx.x == 0 && wave == PROBE_S2WV) { const unsigned long long t1_ = __builtin_readcyclecounter(), dt_ = psacc_ * PROBE_S2K; while (__builtin_readcyclecounter() - t1_ < dt_) __builtin_amdgcn_s_sleep(32); }
#endif
#undef SC2_ISSUE
#undef SC2_LD
#undef SC2_X
#undef SC2_PRELOAD
}

__device__ __forceinline__ float sum8(float v) { v += __shfl_xor(v, 1); v += __shfl_xor(v, 2); v += __shfl_xor(v, 4); return v; }
__device__ __forceinline__ void unpack8(v4u s, float (&v)[8]) { v[0] = bflo(s.x); v[1] = bfhi(s.x); v[2] = bflo(s.y); v[3] = bfhi(s.y); v[4] = bflo(s.z); v[5] = bfhi(s.z); v[6] = bflo(s.w); v[7] = bfhi(s.w); }
__device__ __forceinline__ void ld8f(const float* q, float (&v)[8]) { const f32x4 a = *(const f32x4*)q, b = *(const f32x4*)(q + 4); v[0] = a[0]; v[1] = a[1]; v[2] = a[2]; v[3] = a[3]; v[4] = b[0]; v[5] = b[1]; v[6] = b[2]; v[7] = b[3]; }
__device__ __forceinline__ v4u pack8(const float (&v)[8]) { v4u o; o.x = cvtpk(v[0], v[1]); o.y = cvtpk(v[2], v[3]); o.z = cvtpk(v[4], v[5]); o.w = cvtpk(v[6], v[7]); return o; }

__device__ __forceinline__ void ph_readout2(const KP& p, int l, int gw, int NGW, int lane) {
    const bf16* P = (const bf16*)(OWS + WS_P); const bf16* LO = (const bf16*)(OWS + WS_LO); const bf16* Y = (const bf16*)(OWS + WS_Y);
    bf16* MI = (bf16*)(OWS + WS_MIXIN); constexpr size_t PA = (size_t)MROWS * RW; const int c0 = lane * 8;
    const int nrows = l == DEPTH - 1 ? NLAT : MROWS;
    float a0[8], a1[8], ka[8], rkp[8], lg[8], lb[8], w0[8], w1[8], w2[8];
    ld8f(PIN(I_A0) + (l * 2 + 0) * RW + c0, a0); ld8f(PIN(I_A0) + (l * 2 + 1) * RW + c0, a1); ld8f(PIN(I_KA) + l * RW + c0, ka); ld8f(PIN(I_RK) + l * RW + c0, rkp);
    ld8f(PIN(I_LNXG) + l * RW + c0, lg); ld8f(PIN(I_LNXB) + l * RW + c0, lb);
    { const float* cw = PIN(I_CONVW) + (size_t)l * 3 * RW + c0; ld8f(cw, w0); ld8f(cw + RW, w1); ld8f(cw + 2 * RW, w2); }
#pragma unroll 2
    for (int row = gw; row < nrows; row += NGW) { const bf16* pr = P + (size_t)row * NP; const bf16* lo = LO + (size_t)row * NLO;
        int t, len; if (row < NLAT) { t = row & 63; len = 64; } else { t = (row - NLAT) & 255; len = 256; }
        const v4u kw = *(const v4u*)(pr + PC_K + c0), rw = *(const v4u*)(pr + PC_R + c0), vw = *(const v4u*)(pr + PC_V + c0);
        const v4u cbw = *(const v4u*)(pr + PC_CB + c0), ccw = *(const v4u*)(pr + PC_CC + c0), chw = *(const v4u*)(pr + PC_CH + c0);
        v4u ccp = (v4u){0u, 0u, 0u, 0u}, chp = ccp, ccn = ccp, chn = ccp;
        if (t > 0) { ccp = *(const v4u*)(pr - NP + PC_CC + c0); chp = *(const v4u*)(pr - NP + PC_CH + c0); }
        if (t < len - 1) { ccn = *(const v4u*)(pr + NP + PC_CC + c0); chn = *(const v4u*)(pr + NP + PC_CH + c0); }
        float yf[8], yb[8], la0[8], la1[8], g[8];
        unpack8(*(const v4u*)(Y + (size_t)row * RW + c0), yf); unpack8(*(const v4u*)(Y + PA + (size_t)row * RW + c0), yb); unpack8(*(const v4u*)(lo + 1024 + c0), la0); unpack8(*(const v4u*)(lo + 1536 + c0), la1); unpack8(*(const v4u*)(lo + 2048 + c0), g);
        float kv[8], rv[8], vv[8]; unpack8(kw, kv); unpack8(rw, rv); unpack8(vw, vv);
        float y[8], s = 0.f, rk = 0.f;
#pragma unroll
        for (int j = 0; j < 8; ++j) { y[j] = yf[j] + yb[j]; s += y[j]; const float av = sigm(a0[j] + la0[j]) + sigm(a1[j] + la1[j]); rk += rv[j] * kv[j] * (2.f + (av - 2.f) * ka[j]) * rkp[j]; }
        const float mu = sum8(s) * (1.f / 64.f); rk = sum8(rk); float q = 0.f;
#pragma unroll
        for (int j = 0; j < 8; ++j) { y[j] -= mu; q += y[j] * y[j]; }
        const float rstd = 1.f / sqrtf(sum8(q) * (1.f / 64.f) + GN_EPS);
        float o[8];
#pragma unroll
        for (int j = 0; j < 8; ++j) o[j] = (y[j] * rstd * lg[j] + lb[j] + rk * vv[j]) * g[j];
        float orw[8];
#pragma unroll
        for (int j = 0; j < 8; ++j) orw[j] = o[j];
        float cb[8], cc[8], ch[8], pcc[8], pch[8], ncc[8], nch[8];
        unpack8(cbw, cb); unpack8(ccw, cc); unpack8(chw, ch); unpack8(ccp, pcc); unpack8(chp, pch); unpack8(ccn, ncc); unpack8(chn, nch);
#pragma unroll
        for (int j = 0; j < 8; ++j) o[j] = cb[j] * (pcc[j] * pch[j] * w0[j] + cc[j] * ch[j] * w1[j] + ncc[j] * nch[j] * w2[j]);
        float am = 0.f;
#pragma unroll
        for (int j = 0; j < 8; ++j) am = fmaxf(am, fmaxf(fabsf(orw[j]), fabsf(o[j])));
#pragma unroll
        for (int sh = 1; sh < 64; sh <<= 1) am = fmaxf(am, __shfl_xor(am, sh));
        am = fmaxf(am, 1e-30f); const float inv = 127.f / am; unsigned char* m8 = (unsigned char*)MI + (size_t)row * D + c0;
        *(v2u*)m8 = (v2u){q8pack(orw[0] * inv, orw[1] * inv, orw[2] * inv, orw[3] * inv), q8pack(orw[4] * inv, orw[5] * inv, orw[6] * inv, orw[7] * inv)};
        *(v2u*)(m8 + RW) = (v2u){q8pack(o[0] * inv, o[1] * inv, o[2] * inv, o[3] * inv), q8pack(o[4] * inv, o[5] * inv, o[6] * inv, o[7] * inv)};
        if (lane == 0) ((float*)(OWS + WS_SAM))[row] = am * (1.f / 127.f);
    }
}


template <int KS> __device__ __forceinline__ void lora_afrag(const v4u (&raw)[KS], int fn, v4u (&af)[KS]) {
#pragma unroll
    for (int s = 0; s < KS; ++s) { float v[8]; unpack8(raw[s], v);
        if (fn == 0) {
#pragma unroll
            for (int j = 0; j < 8; ++j) v[j] = 1.f - 2.f * __builtin_amdgcn_rcpf(1.f + __expf(2.f * v[j])); }
        else if (fn == 2) {
#pragma unroll
            for (int j = 0; j < 8; ++j) v[j] = __builtin_amdgcn_rcpf(1.f + __expf(-v[j])); }
        af[s] = pack8(v); }
}
template <int KS, int NT> __device__ __forceinline__ void lora_task(const bf16* P, int col0, int fn, const bf16* wt, bf16* LOg, int ct0, int rb0, int rb1, int n, int hh) {
    v4u bfr[NT][KS];
#pragma unroll
    for (int t = 0; t < NT; ++t)
#pragma unroll
        for (int s = 0; s < KS; ++s) bfr[t][s] = *(const v4u*)(wt + (size_t)(32 * (ct0 + t) + n) * (16 * KS) + 8 * hh + 16 * s);
    v4u raw[KS];
#pragma unroll
    for (int s = 0; s < KS; ++s) raw[s] = *(const v4u*)(P + (size_t)(rb0 * 32 + n) * NP + col0 + 16 * s + 8 * hh);
    for (int rb = rb0; rb < rb1; ++rb) {
        v4u af[KS]; lora_afrag<KS>(raw, fn, af);
        if (rb + 1 < rb1) {
#pragma unroll
            for (int s = 0; s < KS; ++s) raw[s] = *(const v4u*)(P + (size_t)((rb + 1) * 32 + n) * NP + col0 + 16 * s + 8 * hh); }
        int no = n, ho = hh; asm volatile("" : "+v"(no), "+v"(ho));
        bf16* out = LOg + (size_t)(rb * 32 + 4 * ho) * NLO + 32 * ct0 + no;
#pragma unroll
        for (int t = 0; t < NT; ++t) { f32x16 acc = zero16();
#pragma unroll
            for (int s = 0; s < KS; ++s) acc = mm(af[s], bfr[t][s], acc);
#pragma unroll
            for (int r = 0; r < 16; ++r) out[(size_t)((r & 3) + 8 * (r >> 2)) * NLO + 32 * t] = (bf16)f2bf(acc[r]); }
    }
}
__device__ __forceinline__ void ph_lora(const KP& p, int l, int gw, int NGW, int lane) {
    const bf16* P = (const bf16*)(OWS + WS_P); bf16* LO = (bf16*)(OWS + WS_LO); float* NRM = (float*)(OWS + WS_RKS);
    const bf16* LW = (const bf16*)(OWS + WS_LORA) + (size_t)l * LORAW_PER_LAYER; const int n = lane & 31, hh = lane >> 5;
    constexpr int RCH = 7, NRB = MROWS / 32, NCHK = (NRB + RCH - 1) / RCH;
    for (int task = gw; task < NCHK * 24; task += NGW) { const int ctk = task % 24, chunk = task / 24, rb0 = chunk * RCH, rb1 = rb0 + RCH < NRB ? rb0 + RCH : NRB;
        if (ctk < 16) { const int grp = ctk >> 2; lora_task<4, 4>(P, grp < 2 ? PC_WD + 64 * grp : PC_AD + 64 * (grp - 2), grp < 2 ? 0 : 1, LW + (size_t)grp * 512 * 64, LO + grp * 512, (ctk & 3) * 4, rb0, rb1, n, hh); }
        else lora_task<8, 2>(P, PC_GD, 2, LW + (size_t)4 * 512 * 64, LO + 4 * 512, (ctk - 16) * 2, rb0, rb1, n, hh); }
    float kkc[8]; ld8f(PIN(I_KK) + l * RW + lane * 8, kkc);
    for (int row0 = gw; row0 < MROWS; row0 += 4 * NGW) {
        v4u kw[4];
#pragma unroll
        for (int u = 0; u < 4; ++u) { const int row = row0 + u * NGW; kw[u] = row < MROWS ? *(const v4u*)(P + (size_t)row * NP + PC_K + lane * 8) : (v4u){0u, 0u, 0u, 0u}; }
#pragma unroll
        for (int u = 0; u < 4; ++u) asm volatile("" : "+v"(kw[u]));
#pragma unroll
        for (int u = 0; u < 4; ++u) { const int row = row0 + u * NGW; float kv[8]; unpack8(kw[u], kv); float ss = 0.f;
#pragma unroll
            for (int j = 0; j < 8; ++j) { const float t = kv[j] * kkc[j]; ss += t * t; }
            ss = sum8(ss); if ((lane & 7) == 0 && row < MROWS) NRM[row * 8 + (lane >> 3)] = 1.f / fmaxf(sqrtf(ss), 1e-12f); } }
}

__device__ __forceinline__ void ph_moe_gather(const KP& p, int l, int gw, int NGW, int lane) {
    const unsigned* gcnt = (const unsigned*)(OWS + WS_CTL) + CW_GCNT + 64 * (l >> 1);
    int cnt[8], pb[9]; pb[0] = 0;
#pragma unroll
    for (int e = 0; e < 8; ++e) { cnt[e] = (int)gcnt[e]; pb[e + 1] = pb[e] + ((cnt[e] + 255) & ~255); }
    const unsigned* rowlist = (const unsigned*)(OWS + WS_ROWLIST); const float* wsel = (const float*)(OWS + WS_WSEL); float* wsort = (float*)(OWS + WS_WSORT);
    const unsigned char* H8 = OWS + WS_H8; unsigned char* HG = OWS + WS_HG; const float* sa = (const float*)(OWS + WS_SA); float* sag = (float*)(OWS + WS_SAG);
    for (int pos = gw; pos < pb[8]; pos += NGW) {
        int e = 0, base = 0, ce = cnt[0];
#pragma unroll
        for (int k = 1; k < 8; ++k) if (pos >= pb[k]) { e = k; base = pb[k]; ce = cnt[k]; }
        const int rank = pos - base; v4u a = (v4u){0u, 0u, 0u, 0u}; float w = 0.f, sc = 0.f;
        if (rank < ce) { const unsigned ent = rowlist[(size_t)e * MROWS + rank]; a = *(const v4u*)(H8 + (size_t)(ent >> 1) * D + lane * 16); w = wsel[ent]; sc = sa[ent >> 1]; }
        *(v4u*)(HG + (size_t)pos * D + lane * 16) = a;
        if (lane == 0) { wsort[pos] = w; sag[pos] = sc; }
    }
}

__device__ __forceinline__ void ph_ln(const KP& p, LAS unsigned char* lds, int l, int which, int tid, int wave, int gw, int NGW, int lane) {
    const float* modv = (const float*)(OWS + WS_MODV); _Float16* X = (_Float16*)(OWS + WS_X);
    const bf16* BR = (const bf16*)(OWS + (which == 0 ? WS_MIXO : WS_F)); const float* BP = (const float*)(OWS + (which == 0 ? WS_MIXP : WS_FP));
    const float* lg = PIN(which == 0 ? I_LN1G : I_LN2G) + l * D; const float* lb = PIN(which == 0 ? I_LN1B : I_LN2B) + l * D;
    const bool moe = (which == 0) && (l & 1); const bool last = (which == 1) && (l == DEPTH - 1); const bool moe_out = (which == 1) && (l & 1);
    LAS int* lcnt = (LAS int*)lds;
    LAS int* lsel = (LAS int*)(lds + 64);
    int nloc = 0;
    LAS f32x4* rtab = (LAS f32x4*)(lds + 8192);
    if (moe) { if (tid < 16) lcnt[tid] = 0;
        const f32x4* rw4 = (const f32x4*)(PIN(I_RTW) + (size_t)(l >> 1) * D * NE);
#pragma unroll
        for (int k = 0; k < 4; ++k) { const int c = tid + 512 * k, col = c >> 1, hf = c & 1, j = col >> 8, ln = (col & 255) >> 2, i = col & 3; rtab[((j * 4 + i) * 2 + hf) * 64 + ln] = rw4[c]; }
        __syncthreads(); }
    int pbs[9]; pbs[0] = 0;
    if (moe_out) { const unsigned* gcnt = (const unsigned*)(OWS + WS_CTL) + CW_GCNT + 64 * (l >> 1);
#pragma unroll
        for (int e = 0; e < 8; ++e) pbs[e + 1] = pbs[e] + (int)((gcnt[e] + 255u) & ~255u); }
    f32x4 gt[4], g4[4], b4[4], sh[4], sc[4]; ld_row(lg, lane, g4); ld_row(lb, lane, b4);
#pragma unroll 2
    for (int it = 0; it < 9; ++it) {
        if (it == 8 && (gw >= NCTX || l == DEPTH - 1)) break;
        const int row = it < 8 ? (gw >> 9) * SEQ + (gw & 511) + 512 * it : NLAT + gw;
        const int mr = mod_row(row); const float* mv = modv + (size_t)(l * 5 + mr) * NMOD;
        if (it == 0 || it == 8) { ld_row(mv + (which == 0 ? 2048 : 5120), lane, gt);
            if (!last) { const float* mv2 = which == 0 ? mv + 3072 : modv + (size_t)((l + 1) * 5 + mr) * NMOD; ld_row(mv2, lane, sh); ld_row(mv2 + 1024, lane, sc); } }
        f32x4 x[4], br[4], t[4];
        if (l == 0 && which == 0) ld_row(row < NLAT ? PIN(I_X) + (size_t)row * D : PIN(I_CTX) + (size_t)(row - NLAT) * D, lane, x); else ld_row_h16(X + (size_t)row * D, lane, x);
        if (moe_out) { const int* ts = (const int*)(OWS + WS_TOKSEL) + row * 4; const int e0 = ts[0], r0 = ts[1], e1 = ts[2], r1 = ts[3]; int b0 = 0, b1 = 0;
#pragma unroll
            for (int k = 1; k < 8; ++k) { if (e0 >= k) b0 = pbs[k]; if (e1 >= k) b1 = pbs[k]; }
            f32x4 ba[4], bb[4]; const int q0 = b0 + r0, q1 = b1 + r1; constexpr int MM = MOE_MAIN_PANELS * 256;
            if (q0 < MM) ld_row_bf16(BR + (size_t)q0 * D, lane, ba); else ld_row_parts<4>(BP + (size_t)(q0 - MM) * D, (size_t)MOE_TAIL_ROWS * D, lane, ba);
            if (q1 < MM) ld_row_bf16(BR + (size_t)q1 * D, lane, bb); else ld_row_parts<4>(BP + (size_t)(q1 - MM) * D, (size_t)MOE_TAIL_ROWS * D, lane, bb);
#pragma unroll
            for (int j = 0; j < 4; ++j) br[j] = ba[j] + bb[j]; }
        else if (row < NLAT) ld_row_bf16(BR + (size_t)row * D, lane, br);
        else if (which == 0) ld_row_parts<2>(BP + (size_t)(row - NLAT) * D, (size_t)NCTX * D, lane, br);
        else ld_row_parts<7>(BP + (size_t)(row - NLAT) * D, (size_t)NCTX * D, lane, br);
        float s = 0.f;
#pragma unroll
        for (int j = 0; j < 4; ++j) { t[j] = DN_ALPHA * x[j] + gt[j] * br[j]; s += (t[j][0] + t[j][1]) + (t[j][2] + t[j][3]); }
        const float mean = wave_sum(s) * (1.f / D); float s2 = 0.f;
#pragma unroll
        for (int j = 0; j < 4; ++j) { t[j] = t[j] - mean; s2 += (t[j][0] * t[j][0] + t[j][1] * t[j][1]) + (t[j][2] * t[j][2] + t[j][3] * t[j][3]); }
        const float rstd = 1.f / sqrtf(wave_sum(s2) * (1.f / D) + LN_EPS);
#pragma unroll
        for (int j = 0; j < 4; ++j) x[j] = t[j] * rstd * g4[j] + b4[j];
        if (last) {
#if PROBE_DUP & (128 | 256)
            { const unsigned* cw = (const unsigned*)(OWS + WS_CTL); const float cval = 10.f * ((float)cw[20001] / 1024.f) / fmaxf((float)cw[20000], 1.f);
#pragma unroll
              for (int j = 0; j < 4; ++j) x[j] = (f32x4){cval, cval, cval, cval}; }
#endif
#if PROBE_DUP & 1024
            { const unsigned* cw = (const unsigned*)(OWS + WS_CTL); const int cu = (int)cw[CW_ICUR + 64 * PROBE_MI]; const float cval = 10.f * floorf(8.f * (float)(cu < CQ_DYN_LIM ? cu : CQ_DYN_LIM) / (float)CQ_DYN_LIM) * 0.125f;
#pragma unroll
              for (int j = 0; j < 4; ++j) x[j] = (f32x4){cval, cval, cval, cval}; }
#endif
            if (row < NLAT) st_row(p.out + (size_t)row * D, lane, x); continue; }
        st_row_h16(X + (size_t)row * D, lane, x);
        f32x4 hh[4];
#pragma unroll
        for (int j = 0; j < 4; ++j) hh[j] = x[j] * (1.f + sc[j]) + sh[j];
        st_row_q8(OWS + WS_H8, (float*)(OWS + WS_SA), row, lane, hh);
        if (moe) {
            float lgt[8];
#pragma unroll
            for (int e = 0; e < 8; ++e) lgt[e] = 0.f;
#pragma unroll
            for (int j = 0; j < 4; ++j)
#pragma unroll
                for (int i = 0; i < 4; ++i) { const f32x4 w0 = rtab[((j * 4 + i) * 2 + 0) * 64 + lane], w1 = rtab[((j * 4 + i) * 2 + 1) * 64 + lane]; const float hv = hh[j][i];
                    lgt[0] += hv * w0[0]; lgt[1] += hv * w0[1]; lgt[2] += hv * w0[2]; lgt[3] += hv * w0[3]; lgt[4] += hv * w1[0]; lgt[5] += hv * w1[1]; lgt[6] += hv * w1[2]; lgt[7] += hv * w1[3]; }
#pragma unroll
            for (int e = 0; e < 8; ++e) lgt[e] = wave_sum(lgt[e]) + PIN(I_RTB)[(l >> 1) * NE + e];
            float v0 = lgt[0]; int i0 = 0;
#pragma unroll
            for (int e = 1; e < 8; ++e) if (lgt[e] > v0) { v0 = lgt[e]; i0 = e; }
            float v1 = -3.0e38f; int i1 = -1;
#pragma unroll
            for (int e = 0; e < 8; ++e) if (e != i0 && lgt[e] > v1) { v1 = lgt[e]; i1 = e; }
            const float w0 = 1.f / (1.f + expf(v1 - v0)), w1 = 1.f - w0;
            if (lane == 0) { const int lr0 = __hip_atomic_fetch_add(lcnt + i0, 1, __ATOMIC_RELAXED, __HIP_MEMORY_SCOPE_WORKGROUP), lr1 = __hip_atomic_fetch_add(lcnt + i1, 1, __ATOMIC_RELAXED, __HIP_MEMORY_SCOPE_WORKGROUP); const int li = nloc * NWAVES + wave;
                lsel[li * 8 + 0] = row; lsel[li * 8 + 1] = i0; lsel[li * 8 + 2] = lr0; lsel[li * 8 + 3] = i1; lsel[li * 8 + 4] = lr1;
                ((float*)(OWS + WS_WSEL))[row * 2] = w0; ((float*)(OWS + WS_WSEL))[row * 2 + 1] = w1; }
            ++nloc;
        }
    }
    if (moe) {
        __syncthreads();
        unsigned* gcnt = (unsigned*)(OWS + WS_CTL) + CW_GCNT + 64 * (l >> 1);
        if (tid < 8) lcnt[8 + tid] = (int)__hip_atomic_fetch_add(gcnt + tid, (unsigned)lcnt[tid], __ATOMIC_RELAXED, __HIP_MEMORY_SCOPE_AGENT);
        __syncthreads();
        unsigned* rowlist = (unsigned*)(OWS + WS_ROWLIST); int* toksel = (int*)(OWS + WS_TOKSEL);
        if (tid < 16 * NWAVES) { const int k = tid / NWAVES, w = tid % NWAVES; if (k < 8 || (k == 8 && (int)blockIdx.x * NWAVES + w < NCTX && l != DEPTH - 1)) { const int li = k * NWAVES + w;
            const int row = lsel[li * 8 + 0], e0 = lsel[li * 8 + 1], r0 = lcnt[8 + e0] + lsel[li * 8 + 2], e1 = lsel[li * 8 + 3], r1 = lcnt[8 + e1] + lsel[li * 8 + 4];
            rowlist[(size_t)e0 * MROWS + r0] = (unsigned)row * 2u; rowlist[(size_t)e1 * MROWS + r1] = (unsigned)row * 2u + 1u;
            toksel[row * 4 + 0] = e0; toksel[row * 4 + 1] = r0; toksel[row * 4 + 2] = e1; toksel[row * 4 + 3] = r1; } }
    }
}


#ifndef PROBE_WHICH
#define PROBE_WHICH(x, y) (x)
#endif
#if PROBE_DUP & 128
__device__ __forceinline__ void ph_check_up(const KP& p, int gw, int lane) {
    if (gw >= 64) return;
    const float* X = (const float*)(OWS + WS_X); const float* modv = (const float*)(OWS + WS_MODV); const bf16* ACT = (const bf16*)(OWS + WS_ACT);
    const int row = gw * 257, c = lane * 56 + (gw & 7), mr = mod_row(row); const float* mv = modv + (size_t)(0 * 5 + mr) * NMOD;
    const signed char* H8 = (const signed char*)(OWS + WS_H8); const signed char* W8 = (const signed char*)(OWS + WS_F13); const float* SA = (const float*)(OWS + WS_SA); const unsigned* AM = (const unsigned*)(OWS + WS_AMAX);
    const int j1 = 8 * (c >> 2) + (c & 3), j3 = j1 + 4; int ia = 0, ib = 0;
    for (int k = 0; k < D; ++k) { const int h = H8[(size_t)row * D + k]; ia += h * W8[(size_t)j1 * D + k]; ib += h * W8[(size_t)j3 * D + k]; }
    const float a = (float)ia * SA[row] * __builtin_bit_cast(float, AM[j1]) * (1.f / 127.f), b = (float)ib * SA[row] * __builtin_bit_cast(float, AM[j3]) * (1.f / 127.f);
    (void)X; (void)mv;
    const float ref = a / (1.f + expf(-a)) * b, got = bf2f(ACT[(size_t)row * DFF + c]);
    const float da = ((const float*)(OWS + WS_F))[(size_t)row * DFF + c], db = ((const float*)(OWS + WS_F))[(size_t)4096 * DFF + (size_t)row * DFF + c]; (void)got; (void)db;
    if (row < 4096 && abs(ia) > 1000) { const float ratio = 10.f * fminf(fabsf(PROBE_WHICH(da / a, db / b) - 1.f), 0.4f);
        __hip_atomic_fetch_add((unsigned*)(OWS + WS_CTL) + 20000, 1u, __ATOMIC_RELAXED, __HIP_MEMORY_SCOPE_AGENT); __hip_atomic_fetch_add((unsigned*)(OWS + WS_CTL) + 20001, (unsigned)(ratio * 1024.f), __ATOMIC_RELAXED, __HIP_MEMORY_SCOPE_AGENT); }
}
#endif

#if PROBE_DUP & 256
__device__ __forceinline__ void ph_check_mfma(const KP& p, int lane) {
    typedef int i32x4 __attribute__((ext_vector_type(4)));
    const int r = lane & 15, g = lane >> 4; unsigned aw[4], bw[4];
#pragma unroll
    for (int q = 0; q < 4; ++q) { unsigned a = 0, b = 0;
#pragma unroll
        for (int t = 0; t < 4; ++t) { const int k = 16 * g + 4 * q + t; const int av = ((r * 7 + k * 3) % 5) - 2, bv = ((r * 5 + k * 11) % 7) - 3; a |= (unsigned)(av & 255) << (8 * t); b |= (unsigned)(bv & 255) << (8 * t); }
        aw[q] = a; bw[q] = b; }
    i32x4 c = {0, 0, 0, 0};
    c = __builtin_amdgcn_mfma_i32_16x16x64_i8((i32x4){(int)aw[0], (int)aw[1], (int)aw[2], (int)aw[3]}, (i32x4){(int)bw[0], (int)bw[1], (int)bw[2], (int)bw[3]}, c, 0, 0, 0);
    bool bad = false;
#pragma unroll
    for (int reg = 0; reg < 4; ++reg) { const int i = 4 * g + reg, j = r; int e = 0;
        for (int k = 0; k < 64; ++k) e += (((i * 7 + k * 3) % 5) - 2) * (((j * 5 + k * 11) % 7) - 3);
        if (c[reg] != e) bad = true; }
    if (bad) __hip_atomic_fetch_add((unsigned*)(OWS + WS_CTL) + 20000, 1000u, __ATOMIC_RELAXED, __HIP_MEMORY_SCOPE_AGENT);
}
#endif
__global__ void __launch_bounds__(NWAVES * 64, 2) fwd_kernel(KP p_arg) {
    const KP& p = *(const KP*)__builtin_amdgcn_kernarg_segment_ptr(); (void)p_arg;
    extern __shared__ __attribute__((aligned(16))) unsigned char lds_raw[];
    LAS unsigned char* lds = (LAS unsigned char*)lds_raw;
    volatile LAS unsigned* MISC = (volatile LAS unsigned*)(lds + MISC_OFF);
    const int G = gridDim.x, NGW = G * NWAVES;
    for (int u = threadIdx.x; u < (LDS_BYTES - LDSCTL_OFF) / 4; u += NWAVES * 64) ((LAS unsigned*)(lds + LDSCTL_OFF))[u] = 0u;
    __syncthreads();
    unsigned* ctl = (unsigned*)(OWS + WS_CTL);
    const bool single = p.ph < 0;
    XcdBarrier bar; bar.bar = ctl + CW_BAR; bar.x = 0; bar.st = nullptr;
    if (single) bar = xcd_barrier_post(ctl + CW_BAR, MISC + 8);
    int phc = 0;
#ifndef PROBE_DUP
#define PROBE_DUP 0
#endif
#define REP(bit) for (int rep_ = 0; rep_ < ((PROBE_DUP & (bit)) ? 2 : 1); ++rep_)
#define RUN() (single || p.ph == phc)
#define FRESH() int tid = threadIdx.x; asm volatile("" : "+v"(tid)); const int lane = tid & 63, wave = __builtin_amdgcn_readfirstlane(tid >> 6), gw = blockIdx.x * NWAVES + wave; (void)lane; (void)gw
#ifndef PROBE_TK
#define PROBE_TK 0
#endif
#if PROBE_TK > 0
    unsigned long long tp0_ = wall_clock64();
#define SEAM_PROBE() do { if (phc == PROBE_TA - 1) tp0_ = wall_clock64(); if (phc == PROBE_TB) { const unsigned long long t1_ = wall_clock64(), dt_ = (t1_ - tp0_) * PROBE_TK; if (blockIdx.x == 0) while (wall_clock64() - t1_ < dt_) __builtin_amdgcn_s_sleep(32); } } while (0)
#else
#define SEAM_PROBE() do {} while (0)
#ifdef PROBE_P0
    const unsigned long long tp0_ = wall_clock64();
#endif
#endif
#define SEAM() do { if (single) { XcdBarrier b2_ = bar; b2_.bar = (unsigned*)(OWS + WS_CTL) + CW_BAR; xcd_barrier(b2_); if (PROBE_DUP & 32) { XcdBarrier b3_ = bar; b3_.bar = (unsigned*)(OWS + WS_CTL) + CW_BAR; xcd_barrier(b3_); } } SEAM_PROBE(); ++phc; } while (0)

#ifdef PROBE_P0
#define P0_MARK(id) do { if (PROBE_P0 == (id) && blockIdx.x == 0) { __syncthreads(); const unsigned long long t1_ = wall_clock64(), dt_ = (t1_ - tp0_) * PROBE_P0K; while (wall_clock64() - t1_ < dt_) __builtin_amdgcn_s_sleep(32); } } while (0)
#else
#define P0_MARK(id) do {} while (0)
#endif
    REP(4) if (RUN()) { FRESH(); ph_modvec(p, lds, tid); __syncthreads(); P0_MARK(1); ph_convert(p, lds, gw, NGW, wave, lane); P0_MARK(2); cq_static(p, lds, 3 * CQ_IN + 3 * CQ_OUT + 2 * CQ_UP, CQ_J1, gw, NGW, wave, lane); P0_MARK(3); ph_amax(p, gw, NGW, lane); P0_MARK(4); }
    SEAM();
#if PROBE_DUP & 256
    if (blockIdx.x == 0 && threadIdx.x < 64) ph_check_mfma(p, threadIdx.x);
#endif
    if (RUN()) { FRESH(); ph_init_rows(p, gw, NGW, lane); cq_static(p, lds, -CQ_NEG, 3 * CQ_IN + 3 * CQ_OUT + 2 * CQ_UP, gw, NGW, wave, lane); }
    SEAM();
    for (int ll = 0; ll < DEPTH; ++ll) {
#define l (ll + opaque_zero_i())
         if (RUN()) { pg8::Gemm g{(const bf16*)(OWS + WS_H8), (const bf16*)(OWS + WS_WIN) + (size_t)l * (NP * D / 2), MROWS, NP, D / 2, D / 2}; pg8::StaticOrder S; S.init(MROWS, NP, G, (int)blockIdx.x);
            pg8::EpiBf16S8 E{(bf16*)(OWS + WS_P), NP, (const float*)(OWS + WS_SA), (const float*)(OWS + WS_AMAX) + AM_IN + l * NP}; pg8::gemm_phase<pg8::EpiBf16S8, pg8::StaticOrder, true, true, true>(lds, g, S, E); }
        if (RUN()) { FRESH(); const int segb = ll < 2 ? CQ_J1 : CQ_END0; cq_idle(p, lds, segb, ll >> 1, ll * 4 + 0, IDLE_IN0, tid, wave, lane); }
        SEAM();
        REP(8) if (RUN()) { FRESH(); ph_lora(p, l, gw, NGW, lane); }
        SEAM();
        REP(1) if (RUN()) { FRESH(); ph_scan1(p, l, gw, NGW, lane); }
        SEAM();
        REP(2) if (RUN()) { FRESH(); ph_scan2(p, lds, l, wave, lane); }
        SEAM();
        REP(64) if (RUN()) { FRESH(); ph_readout2(p, l, gw, NGW, lane); }
        SEAM();
         if (RUN()) {
            { pg8::Gemm g{(const bf16*)(OWS + WS_MIXIN), (const bf16*)(OWS + WS_WOUT) + (size_t)l * (D * D / 2), NLAT, D, D / 2, D / 2}; pg8::StaticOrder S; S.init(NLAT, D, G, (int)blockIdx.x);
              pg8::EpiBf16S8 E{(bf16*)(OWS + WS_MIXO), D, (const float*)(OWS + WS_SAM), (const float*)(OWS + WS_AMAX) + AM_OUT + l * D}; pg8::gemm_phase<pg8::EpiBf16S8, pg8::StaticOrder, true, true, true>(lds, g, S, E); }
            if (ll < DEPTH - 1) { pg8::Gemm g{(const bf16*)(OWS + WS_MIXIN), (const bf16*)(OWS + WS_WOUT) + (size_t)l * (D * D / 2), NCTX, D, D / 4, D / 2}; pg8::SplitOrder S{NCTX / 256, D / 256, 2, G, (int)blockIdx.x, NLAT / 256, 0, 0, 0, 0, 0, 0, 0, 0};
              pg8::EpiPartS8 E{(float*)(OWS + WS_MIXP), D, (size_t)NCTX * D, NLAT / 256, (const float*)(OWS + WS_SAM), (const float*)(OWS + WS_AMAX) + AM_OUT + l * D}; pg8::gemm_phase<pg8::EpiPartS8, pg8::SplitOrder, true, true, true>(lds, g, S, E); }
        }
        if (RUN() && ll < DEPTH - 1) { FRESH(); const int segb = ll < 2 ? CQ_J1 : CQ_END0; cq_idle(p, lds, segb, ll >> 1, ll * 4 + 1, IDLE_OT0, tid, wave, lane); }
        SEAM();
        for (int rep2_ = 0; rep2_ < (((PROBE_DUP & 512) && ll == 0) ? 5 : 1); ++rep2_) if (RUN()) { FRESH(); ph_ln(p, lds, l, 0, tid, wave, gw, NGW, lane); if (ll & 1) { __syncthreads(); const int cur_ = (int)__hip_atomic_load((const unsigned*)(OWS + WS_CTL) + CW_ICUR + 64 * (ll >> 1), __ATOMIC_RELAXED, __HIP_MEMORY_SCOPE_AGENT); cq_static(p, lds, (l == 1 ? CQ_J1 : CQ_END0) + CQO_DYN + (cur_ < CQ_DYN_LIM ? cur_ : CQ_DYN_LIM), l == 1 ? CQ_END0 : CQ_END1, gw, NGW, wave, lane); } }
        SEAM();
        if ((l & 1) == 0) {
            const int fi = l >> 1;
             if (RUN()) { pg8::Gemm g{(const bf16*)(OWS + WS_H8), (const bf16*)(OWS + WS_F13) + (size_t)fi * DFF * D, MROWS, 2 * DFF, D / 2, D / 2}; pg8::StaticOrder S; S.init(MROWS, 2 * DFF, G, (int)blockIdx.x);
                constexpr int NOE = 0x7fffffff; pg8::EpiSwiGLU8 E{(bf16*)(OWS + WS_ACT), DFF, nullptr, (const float*)(OWS + WS_SA), (const unsigned*)(OWS + WS_AMAX) + (size_t)fi * 2 * DFF, NOE, NOE, NOE, NOE, NOE, NOE, NOE};
#if PROBE_DUP & 128
                E.dbg = (int*)(OWS + WS_F);
#endif
                pg8::gemm_phase<pg8::EpiSwiGLU8, pg8::StaticOrder, true, true, true>(lds, g, S, E); }
            if (RUN()) { FRESH(); const int segb = ll < 2 ? CQ_J1 : CQ_END0; cq_idle(p, lds, segb, ll >> 1, ll * 4 + 2, IDLE_UP0, tid, wave, lane); }
            SEAM();
#if PROBE_DUP & 128
            if (ll == 0) { if (RUN()) { FRESH(); ph_check_up(p, gw, lane); } SEAM(); }
#endif
             if (RUN()) {
                { pg8::Gemm g{(const bf16*)(OWS + WS_ACT), (const bf16*)(OWS + WS_F2) + (size_t)fi * D * DFF, NLAT, D, DFF, DFF}; pg8::StaticOrder S; S.init(NLAT, D, G, (int)blockIdx.x);
                  pg8::EpiBf16<0> E{(bf16*)(OWS + WS_F), D, nullptr, 0, 0, 1.f}; pg8::gemm_phase<pg8::EpiBf16<0>, pg8::StaticOrder, true, true>(lds, g, S, E); }
                { pg8::Gemm g{(const bf16*)(OWS + WS_ACT), (const bf16*)(OWS + WS_F2) + (size_t)fi * D * DFF, NCTX, D, DFF / 7, DFF}; pg8::SplitOrder S{NCTX / 256, D / 256, 7, G, (int)blockIdx.x, NLAT / 256, 0, 0, 0, 0, 0, 0, 0, 0};
                  pg8::EpiPart E{(float*)(OWS + WS_FP), D, (size_t)NCTX * D, NLAT / 256}; pg8::gemm_phase<pg8::EpiPart, pg8::SplitOrder, true, true>(lds, g, S, E); }
            }
            if (RUN()) { FRESH(); const int segb = ll < 2 ? CQ_J1 : CQ_END0; cq_idle(p, lds, segb, ll >> 1, ll * 4 + 3, IDLE_DT0, tid, wave, lane); }
            SEAM();
        } else {
            if (RUN()) { FRESH(); ph_moe_gather(p, l, gw, NGW, lane); }
            SEAM();
            {   const unsigned* gcnt = (const unsigned*)(OWS + WS_CTL) + CW_GCNT + 64 * (l >> 1); int pbp[9]; pbp[0] = 0;
#pragma unroll
                for (int e = 0; e < 8; ++e) pbp[e + 1] = pbp[e] + (int)((gcnt[e] + 255u) >> 8);
                const int mrows = pbp[8] * 256;
                 if (RUN()) { pg8::Gemm g{(const bf16*)(OWS + WS_HG), (const bf16*)(OWS + WS_MOEW13), mrows, 2 * DFF, D / 2, D / 2}; pg8::MoeOrder S; S.init(mrows, 2 * DFF, G, (int)blockIdx.x);
                    S.pb1 = pbp[1]; S.pb2 = pbp[2]; S.pb3 = pbp[3]; S.pb4 = pbp[4]; S.pb5 = pbp[5]; S.pb6 = pbp[6]; S.pb7 = pbp[7]; S.estride = (size_t)DFF * D;
                    pg8::EpiSwiGLU8 E{(bf16*)(OWS + WS_ACT), DFF, (const float*)(OWS + WS_WSORT), (const float*)(OWS + WS_SAG), (const unsigned*)(OWS + WS_AMAX) + (size_t)(2 + 8 * (l >> 1)) * 2 * DFF, pbp[1], pbp[2], pbp[3], pbp[4], pbp[5], pbp[6], pbp[7]};
                    pg8::gemm_phase<pg8::EpiSwiGLU8, pg8::MoeOrder, true, true, true>(lds, g, S, E); }
                SEAM();
                 if (RUN()) {
                    { pg8::Gemm g{(const bf16*)(OWS + WS_ACT), (const bf16*)(OWS + WS_MOEW2), MOE_MAIN_PANELS * 256, D, DFF, DFF}; pg8::MoeOrder S; S.init(MOE_MAIN_PANELS * 256, D, G, (int)blockIdx.x);
                      S.pb1 = pbp[1]; S.pb2 = pbp[2]; S.pb3 = pbp[3]; S.pb4 = pbp[4]; S.pb5 = pbp[5]; S.pb6 = pbp[6]; S.pb7 = pbp[7]; S.estride = (size_t)D * DFF;
                      pg8::EpiBf16<0> E{(bf16*)(OWS + WS_F), D, nullptr, 0, 0, 1.f}; pg8::gemm_phase<pg8::EpiBf16<0>, pg8::MoeOrder, true, true>(lds, g, S, E); }
                    { const int nT = pbp[8] - MOE_MAIN_PANELS;
                      pg8::Gemm g{(const bf16*)(OWS + WS_ACT), (const bf16*)(OWS + WS_MOEW2), nT * 256, D, DFF / 4, DFF}; pg8::SplitOrder S{nT, D / 256, 4, G, (int)blockIdx.x, MOE_MAIN_PANELS, pbp[1], pbp[2], pbp[3], pbp[4], pbp[5], pbp[6], pbp[7], (size_t)D * DFF};
                      pg8::EpiPart E{(float*)(OWS + WS_FP), D, (size_t)MOE_TAIL_ROWS * D, MOE_MAIN_PANELS}; pg8::gemm_phase<pg8::EpiPart, pg8::SplitOrder, true, true>(lds, g, S, E); }
                }
                SEAM();
            }
        }
        if (RUN()) { FRESH(); ph_ln(p, lds, l, 1, tid, wave, gw, NGW, lane); }
        SEAM();
    }
#undef l
#undef RUN
#undef SEAM
}

#ifndef MK_PER_PHASE
#define MK_PER_PHASE 0
#endif
extern "C" void kernel_launch(void* const* d_in, const int* in_sizes, int n_in, void* d_out, int out_size, void* d_ws, size_t ws_size, hipStream_t stream) {
    static int grid = 0;
    if (grid == 0) {
        if (n_in != N_IN || in_sizes[0] != NLAT * D || out_size != NLAT * D || ws_size < WS_NEED) { fprintf(stderr, "kernel_launch: unexpected shapes / workspace (%d inputs, ws %zu, need %zu)\n", n_in, ws_size, (size_t)WS_NEED); grid = -1; return; }
        int dev = 0, cus = 0, per_cu = 0;
        if (hipGetDevice(&dev) != hipSuccess || hipDeviceGetAttribute(&cus, hipDeviceAttributeMultiprocessorCount, dev) != hipSuccess) { grid = -1; return; }
        if (hipFuncSetAttribute((const void*)fwd_kernel, hipFuncAttributeMaxDynamicSharedMemorySize, LDS_BYTES) != hipSuccess) { fprintf(stderr, "kernel_launch: hipFuncSetAttribute failed\n"); grid = -1; return; }
        if (hipOccupancyMaxActiveBlocksPerMultiprocessor(&per_cu, (const void*)fwd_kernel, NWAVES * 64, LDS_BYTES) != hipSuccess || per_cu < 1) fprintf(stderr, "kernel_launch: occupancy query says %d\n", per_cu);
        (void)hipGetLastError();
        grid = cus;
        if (grid != 256) { fprintf(stderr, "kernel_launch: built for a 256-CU device, found %d CUs\n", cus); grid = -1; return; }
    }
    if (grid < 0) return;
    if (hipMemsetAsync((char*)d_ws + WS_CTL, 0, CTL_BYTES, stream) != hipSuccess) return;
    KP p{};
    for (int i = 0; i < N_IN; ++i) p.in[i] = (const float*)d_in[i];
    p.out = (float*)d_out; p.ws = (unsigned char*)d_ws; p.pad = 0;
#if MK_PER_PHASE
    const int nph = 2 + 2 * 11 + 2 * 13;
    for (int ph = 0; ph < nph; ++ph) { p.ph = ph; hipLaunchKernelGGL(fwd_kernel, dim3(grid), dim3(NWAVES * 64), LDS_BYTES, stream, p); }
#else
    p.ph = -1;
    hipLaunchKernelGGL(fwd_kernel, dim3(grid), dim3(NWAVES * 64), LDS_BYTES, stream, p);
#endif
}
```

```cpp
#include <hip/hip_runtime.h>
#define PROBE_DUP 0
#define CQ_SLOT_WGS 0
#define CQ_SLOT_ITEMS 12000
#define CQ_Q_IN 48
#define CQ_Q_OT 16
#define CQ_Q_UP 60
#define CQ_Q_DT 54
#include <cstdio>
#include <cstdint>
namespace pg8 {
#define PG8_LAS __attribute__((address_space(3)))
typedef unsigned short bf16_t;
typedef short bf16x8 __attribute__((ext_vector_type(8)));
typedef float f32x4 __attribute__((ext_vector_type(4)));
typedef unsigned u32x4 __attribute__((ext_vector_type(4)));
constexpr int BM = 256, BK = 64, HALF = 128, HTB = HALF * BK * 2  , STAGE_BYTES = 8 * HTB, NXCD = 8, WGM = 8;

__host__ __device__ __forceinline__ int lds_byte(int r, int c) { const int st = (r >> 4) * 2 + (c >> 5), rr = r & 15, cc = c & 31, ob = rr * 64 + cc * 2; return st * 1024 + (ob ^ (((ob >> 9) & 1) << 5)); }
__host__ __device__ __forceinline__ void stage_rc(int b, int& R, int& C) { const int st = b / 1024, sb = b % 1024, swz = sb ^ (((sb >> 9) & 1) << 5); R = (st >> 1) * 16 + swz / 64; C = (st & 1) * 32 + (swz % 64) / 2; }
__host__ __device__ __forceinline__ int perm32(int rho) { const int n = rho >> 4, i = rho & 15; return 8 * (i >> 2) + 4 * n + (i & 3); }

struct Unit { int pm, pn, ks; };
struct Gemm { const bf16_t* A; const bf16_t* Bt; int M, N, K, ld; };

struct StaticOrder {
    int nM, nN, nwg, G, c;
    __host__ __device__ void init(int M, int N, int G_, int c_) { nM = M / BM; nN = N / BM; nwg = nM * nN; G = G_; c = c_; }
    __host__ __device__ bool next(int i, Unit& u) const {
        const long L = (long)i * G + c; if (L >= nwg) return false;
        int wgid = (int)L; { const int q = nwg / NXCD, r = nwg % NXCD, xcd = wgid % NXCD, off = wgid / NXCD; wgid = (xcd < r ? xcd * (q + 1) : r * (q + 1) + (xcd - r) * q) + off; }
        const int nig = WGM * nN, gid = wgid / nig, fm = gid * WGM, gsz = (nM - fm) < WGM ? (nM - fm) : WGM;
        u.pm = fm + ((wgid % nig) % gsz); u.pn = (wgid % nig) / gsz; u.ks = 0; return true;
    }
    __device__ __forceinline__ const char* abase(const Gemm& g, const Unit& u, size_t tstep) const { return (const char*)g.A + (size_t)u.pm * tstep; }
    __device__ __forceinline__ const char* bbase(const Gemm& g, const Unit& u, size_t tstep) const { return (const char*)g.Bt + (size_t)u.pn * tstep; }
    __device__ __forceinline__ void a_ready(const Unit&) const {}
    __device__ __forceinline__ void done(const Unit&) const {}
};

__device__ __forceinline__ unsigned cvt_pk_bf16(float lo, float hi) { unsigned r; asm volatile("v_cvt_pk_bf16_f32 %0, %1, %2" : "=v"(r) : "v"(lo), "v"(hi)); return r; }
typedef float f32x2 __attribute__((ext_vector_type(2)));
__device__ __forceinline__ f32x2 gelu_pk(f32x2 v) {
    const f32x2 av = __builtin_elementwise_abs(v), d = av * 0.2316418882f + 1.0f;
    f32x2 t; t.x = __builtin_amdgcn_rcpf(d.x); t.y = __builtin_amdgcn_rcpf(d.y);
    f32x2 q = t * 0.5307027145f + (-0.7265760135f); q = q * t + 0.7107068705f; q = q * t + (-0.142248368f); q = q * t + 0.127414796f; q = q * t;
    const f32x2 s = (v * v) * (-0.72134752044f);
    f32x2 e; e.x = __builtin_amdgcn_exp2f(s.x); e.y = __builtin_amdgcn_exp2f(s.y);
    const f32x2 m = v * (q * e), r = v - m;
    f32x2 o; o.x = v.x < 0.f ? m.x : r.x; o.y = v.y < 0.f ? m.y : r.y; return o;
}

template <int ACT  > struct EpiBf16 {
    static constexpr bool PERM = true, AFTER_DRAIN = false; static_assert(ACT == 0 || ACT == 1, "EpiBf16: ACT is 0 (none) or 1 (gelu_pk)");
    bf16_t* O; int ldc; const float* bias; int split_cols; size_t split_stride; float scale0;
    __device__ __forceinline__ void operator()(const f32x4 (&acc)[2][2][4][2], const Unit& u, int wr, int wc, int fr, int fq) const {
        asm volatile("" : "+v"(fr), "+v"(fq));
        const int row0 = u.pm * BM + wr * 64 + fr; int colt = u.pn * BM; bf16_t* base = O;
        float sc = 1.f; if (split_cols) { const int t = colt / split_cols; base += (size_t)t * split_stride; colt -= t * split_cols; if (t == 0) sc = scale0; }
        const int col0 = colt + wc * 32 + 8 * fq, bcol0 = u.pn * BM + wc * 32 + 8 * fq;
        f32x4 bv[2][2];
#pragma unroll
        for (int bj = 0; bj < 2; ++bj)
#pragma unroll
            for (int n = 0; n < 2; ++n) bv[bj][n] = bias ? *(const f32x4*)(bias + bcol0 + bj * HALF + 4 * n) : (f32x4){0.f, 0.f, 0.f, 0.f};
#pragma unroll
        for (int ai = 0; ai < 2; ++ai)
#pragma unroll
            for (int m = 0; m < 4; ++m) { bf16_t* rowp = base + (size_t)(row0 + ai * HALF + m * 16) * ldc + col0;
#pragma unroll
                for (int bj = 0; bj < 2; ++bj) { f32x4 v0 = acc[ai][bj][m][0] + bv[bj][0], v1 = acc[ai][bj][m][1] + bv[bj][1];
                    if (ACT == 1) { f32x2 a = gelu_pk((f32x2){v0[0], v0[1]}), b = gelu_pk((f32x2){v0[2], v0[3]}), c = gelu_pk((f32x2){v1[0], v1[1]}), d = gelu_pk((f32x2){v1[2], v1[3]});
                        v0 = (f32x4){a.x, a.y, b.x, b.y}; v1 = (f32x4){c.x, c.y, d.x, d.y}; }
                    v0 = v0 * sc; v1 = v1 * sc; u32x4 w; w.x = cvt_pk_bf16(v0[0], v0[1]); w.y = cvt_pk_bf16(v0[2], v0[3]); w.z = cvt_pk_bf16(v1[0], v1[1]); w.w = cvt_pk_bf16(v1[2], v1[3]);
                    *(u32x4*)(rowp + bj * HALF) = w; } }
    }
};
typedef int i32x4 __attribute__((ext_vector_type(4)));
template <bool I8> __device__ __forceinline__ f32x4 mma16(bf16x8 b, bf16x8 a, f32x4 c) { return __builtin_amdgcn_mfma_f32_16x16x32_bf16(b, a, c, 0, 0, 0); }
template <bool I8> __device__ __forceinline__ i32x4 mma16(bf16x8 b, bf16x8 a, i32x4 c) { return __builtin_amdgcn_mfma_i32_16x16x64_i8(__builtin_bit_cast(i32x4, b), __builtin_bit_cast(i32x4, a), c, 0, 0, 0); }
struct EpiF32 {
    static constexpr bool PERM = false, AFTER_DRAIN = false;
    float* C; int ldc; int accum;
    __device__ __forceinline__ void operator()(const f32x4 (&acc)[2][2][4][2], const Unit& u, int wr, int wc, int fr, int fq) const {
        asm volatile("" : "+v"(fr), "+v"(fq));
        const int row0 = u.pm * BM + wr * 64 + fr, col0 = u.pn * BM + wc * 32 + 4 * fq;
#pragma unroll
        for (int ai = 0; ai < 2; ++ai)
#pragma unroll
            for (int m = 0; m < 4; ++m) { float* rowp = C + (size_t)(row0 + ai * HALF + m * 16) * ldc + col0;
#pragma unroll
                for (int bj = 0; bj < 2; ++bj)
#pragma unroll
                    for (int n = 0; n < 2; ++n) { f32x4 v = acc[ai][bj][m][n]; if (accum) v += *(const f32x4*)(rowp + bj * HALF + n * 16); *(f32x4*)(rowp + bj * HALF + n * 16) = v; } }
    }
};
struct EpiSwiGLU {
    static constexpr bool PERM = true, AFTER_DRAIN = false;
    bf16_t* O; int ldo; const float* rowscale; int rs_stride;
    __device__ __forceinline__ void operator()(const f32x4 (&acc)[2][2][4][2], const Unit& u, int wr, int wc, int fr, int fq) const {
        asm volatile("" : "+v"(fr), "+v"(fq));
        typedef unsigned u32x2v __attribute__((ext_vector_type(2)));
        const int row0 = u.pm * BM + wr * 64 + fr; const int ch0 = (u.pn * BM + wc * 32 + 8 * fq) >> 1;
#pragma unroll
        for (int ai = 0; ai < 2; ++ai)
#pragma unroll
            for (int m = 0; m < 4; ++m) { const int row = row0 + ai * HALF + m * 16; bf16_t* rowp = O + (size_t)row * ldo + ch0;
                const float rs = rowscale ? rowscale[(size_t)row * rs_stride] : 1.f;
#pragma unroll
                for (int bj = 0; bj < 2; ++bj) { const f32x4 a = acc[ai][bj][m][0], b = acc[ai][bj][m][1]; f32x4 o;
#pragma unroll
                    for (int i = 0; i < 4; ++i) o[i] = a[i] * __builtin_amdgcn_rcpf(1.f + __expf(-a[i])) * b[i] * rs;
                    u32x2v w; w.x = cvt_pk_bf16(o[0], o[1]); w.y = cvt_pk_bf16(o[2], o[3]);
                    *(u32x2v*)(rowp + bj * (HALF / 2)) = w; } }
    }
};

struct MoeOrder : StaticOrder {
    int pb1, pb2, pb3, pb4, pb5, pb6, pb7; size_t estride;
    __device__ __forceinline__ const char* bbase(const Gemm& g, const Unit& u, size_t tstep) const {
        const int e = (u.pm >= pb1) + (u.pm >= pb2) + (u.pm >= pb3) + (u.pm >= pb4) + (u.pm >= pb5) + (u.pm >= pb6) + (u.pm >= pb7);
        return (const char*)(g.Bt + (size_t)e * estride) + (size_t)u.pn * tstep; }
};
struct SplitOrder {
    int nM, nN, S, G, c, pm0; int pb1, pb2, pb3, pb4, pb5, pb6, pb7; size_t estride;
    __device__ __forceinline__ bool next(int i, Unit& u) const { const int L = i * G + c; if (L >= nM * nN * S) return false; u.ks = L % S; const int t = L / S; u.pn = t % nN; u.pm = pm0 + t / nN; return true; }
    __device__ __forceinline__ const char* abase(const Gemm& g, const Unit& u, size_t tstep) const { return (const char*)g.A + (size_t)u.pm * tstep + (size_t)u.ks * g.K * 2; }
    __device__ __forceinline__ const char* bbase(const Gemm& g, const Unit& u, size_t tstep) const {
        const int e = estride ? (u.pm >= pb1) + (u.pm >= pb2) + (u.pm >= pb3) + (u.pm >= pb4) + (u.pm >= pb5) + (u.pm >= pb6) + (u.pm >= pb7) : 0;
        return (const char*)(g.Bt + (size_t)e * estride) + (size_t)u.pn * tstep + (size_t)u.ks * g.K * 2; }
    __device__ __forceinline__ void a_ready(const Unit&) const {}
    __device__ __forceinline__ void done(const Unit&) const {}
};
struct EpiPart {
    static constexpr bool PERM = false, AFTER_DRAIN = false;
    float* C; int ldc; size_t pstride; int pm0;
    __device__ __forceinline__ void operator()(const f32x4 (&acc)[2][2][4][2], const Unit& u, int wr, int wc, int fr, int fq) const {
        asm volatile("" : "+v"(fr), "+v"(fq));
        const int row0 = (u.pm - pm0) * BM + wr * 64 + fr, col0 = u.pn * BM + wc * 32 + 4 * fq; float* base = C + (size_t)u.ks * pstride;
#pragma unroll
        for (int ai = 0; ai < 2; ++ai)
#pragma unroll
            for (int m = 0; m < 4; ++m) { float* rowp = base + (size_t)(row0 + ai * HALF + m * 16) * ldc + col0;
#pragma unroll
                for (int bj = 0; bj < 2; ++bj)
#pragma unroll
                    for (int n = 0; n < 2; ++n) *(f32x4*)(rowp + bj * HALF + n * 16) = acc[ai][bj][m][n]; }
    }
};

struct EpiSwiGLU8 {
    static constexpr bool PERM = true, AFTER_DRAIN = false;
    bf16_t* O; int ldo; const float* rowscale; const float* sa; const unsigned* amax; int pb1, pb2, pb3, pb4, pb5, pb6, pb7;
    __device__ __forceinline__ void operator()(const i32x4 (&acc)[2][2][4][2], const Unit& u, int wr, int wc, int fr, int fq) const {
        typedef unsigned u32x2v __attribute__((ext_vector_type(2))); typedef unsigned u32x4v __attribute__((ext_vector_type(4)));
        asm volatile("" : "+v"(fr), "+v"(fq));
        const int row0 = u.pm * BM + wr * 64 + fr; const int cb0 = u.pn * BM + wc * 32 + 8 * fq; const int ch0 = cb0 >> 1;
        const int e = (u.pm >= pb1) + (u.pm >= pb2) + (u.pm >= pb3) + (u.pm >= pb4) + (u.pm >= pb5) + (u.pm >= pb6) + (u.pm >= pb7);
        const unsigned* am = amax + (size_t)e * 2 * 3584 + cb0;
#pragma unroll
        for (int bj = 0; bj < 2; ++bj) {
            const float* amf = (const float*)am + bj * HALF;
            const f32x4 sb0 = *(const f32x4*)amf * (1.f / 127.f), sb1 = *(const f32x4*)(amf + 4) * (1.f / 127.f);
#pragma unroll
            for (int ai = 0; ai < 2; ++ai)
#pragma unroll
                for (int m = 0; m < 4; ++m) { const int row = row0 + ai * HALF + m * 16; bf16_t* rowp = O + (size_t)row * ldo + ch0 + bj * (HALF / 2);
                    const float sr = sa[row], rs = rowscale ? rowscale[row] : 1.f; f32x4 o;
#pragma unroll
                    for (int i = 0; i < 4; ++i) { const float a = (float)acc[ai][bj][m][0][i] * sr * sb0[i], b = (float)acc[ai][bj][m][1][i] * sr * sb1[i];
                        o[i] = a * __builtin_amdgcn_rcpf(1.f + __expf(-a)) * b * rs; }
                    u32x2v w; w.x = cvt_pk_bf16(o[0], o[1]); w.y = cvt_pk_bf16(o[2], o[3]);
                    *(u32x2v*)rowp = w;
#if PROBE_DUP & 128
                    if (dbg && row < 4096) { f32x4 av, bv;
#pragma unroll
                        for (int i = 0; i < 4; ++i) { av[i] = (float)acc[ai][bj][m][0][i] * sr * sb0[i]; bv[i] = (float)acc[ai][bj][m][1][i] * sr * sb1[i]; }
                        *(f32x4*)((float*)dbg + (size_t)row * ldo + (rowp - (O + (size_t)row * ldo))) = av; *(f32x4*)((float*)dbg + (size_t)4096 * ldo + (size_t)row * ldo + (rowp - (O + (size_t)row * ldo))) = bv; }
#endif
                    } }
    }
#if PROBE_DUP & 128
    int* dbg = nullptr;
#endif
};

struct EpiBf16S8 {
    static constexpr bool PERM = true, AFTER_DRAIN = false;
    bf16_t* O; int ldc; const float* sa; const float* amax;
    __device__ __forceinline__ void operator()(const i32x4 (&acc)[2][2][4][2], const Unit& u, int wr, int wc, int fr, int fq) const {
        asm volatile("" : "+v"(fr), "+v"(fq));
        const int row0 = u.pm * BM + wr * 64 + fr, col0 = u.pn * BM + wc * 32 + 8 * fq;
#pragma unroll
        for (int bj = 0; bj < 2; ++bj) { const f32x4 s0 = *(const f32x4*)(amax + col0 + bj * HALF) * (1.f / 127.f), s1 = *(const f32x4*)(amax + col0 + bj * HALF + 4) * (1.f / 127.f);
#pragma unroll
            for (int ai = 0; ai < 2; ++ai)
#pragma unroll
                for (int m = 0; m < 4; ++m) { const int row = row0 + ai * HALF + m * 16; const float sr = sa[row]; f32x4 v0, v1;
#pragma unroll
                    for (int i = 0; i < 4; ++i) { v0[i] = (float)acc[ai][bj][m][0][i] * sr * s0[i]; v1[i] = (float)acc[ai][bj][m][1][i] * sr * s1[i]; }
                    u32x4 w; w.x = cvt_pk_bf16(v0[0], v0[1]); w.y = cvt_pk_bf16(v0[2], v0[3]); w.z = cvt_pk_bf16(v1[0], v1[1]); w.w = cvt_pk_bf16(v1[2], v1[3]);
                    *(u32x4*)(O + (size_t)row * ldc + col0 + bj * HALF) = w; } }
    }
};
struct EpiPartS8 {
    static constexpr bool PERM = false, AFTER_DRAIN = false;
    float* C; int ldc; size_t pstride; int pm0; const float* sa; const float* amax;
    __device__ __forceinline__ void operator()(const i32x4 (&acc)[2][2][4][2], const Unit& u, int wr, int wc, int fr, int fq) const {
        asm volatile("" : "+v"(fr), "+v"(fq));
        const int row0 = (u.pm - pm0) * BM + wr * 64 + fr, col0 = u.pn * BM + wc * 32 + 4 * fq; float* base = C + (size_t)u.ks * pstride;
#pragma unroll
        for (int bj = 0; bj < 2; ++bj)
#pragma unroll
            for (int n = 0; n < 2; ++n) { const f32x4 sc = *(const f32x4*)(amax + col0 + bj * HALF + n * 16) * (1.f / 127.f);
#pragma unroll
                for (int ai = 0; ai < 2; ++ai)
#pragma unroll
                    for (int m = 0; m < 4; ++m) { const int rl = row0 + ai * HALF + m * 16; const float sr = sa[rl + pm0 * BM]; f32x4 v;
#pragma unroll
                        for (int i = 0; i < 4; ++i) v[i] = (float)acc[ai][bj][m][n][i] * sr * sc[i];
                        *(f32x4*)(base + (size_t)rl * ldc + col0 + bj * HALF + n * 16) = v; } }
    }
};
template <bool I8> struct AccSel { typedef f32x4 type; }; template <> struct AccSel<true> { typedef i32x4 type; };
template <class Epi, class Sched, bool ALIGN_EPI = false, bool SP2 = false, bool I8 = false>
__device__ __forceinline__ void gemm_phase(PG8_LAS unsigned char* lds, const Gemm g, const Sched& S, const Epi& E) {
    int tid_o = threadIdx.x; asm volatile("" : "+v"(tid_o));
    const int tid = tid_o, wid = __builtin_amdgcn_readfirstlane(tid >> 6), lane = tid & 63, wr = wid >> 2, wc = wid & 3, fr = lane & 15, fq = lane >> 4;
    const int K = g.K, nt = K / BK;
    unsigned voffA[2], voffB[2];
#pragma unroll
    for (int i = 0; i < 2; ++i) { int R, C; stage_rc(tid * 16 + i * 8192, R, C); const int Rb = Epi::PERM ? ((R & ~31) + perm32(R & 31)) : R;
        voffA[i] = (unsigned)(R * g.ld + C) * 2u; voffB[i] = (unsigned)(Rb * g.ld + C) * 2u; }
    const size_t kstep = (size_t)(BK * 2);
    const size_t hstep = (size_t)HALF * g.ld * 2;
    const size_t tstep = 2 * hstep;
    const unsigned ldsw = (unsigned)wid * 1024u;
    const int aoff = lds_byte(wr * 64 + fr, fq * 8), boff = lds_byte(wc * 32 + fr, fq * 8);
#define PG8_SA(b, h) (((b) * 2 + (h)) * HTB)
#define PG8_SB(b, h) ((4 + (b) * 2 + (h)) * HTB)
#define PG8_STAGE(bufoff, gbase, voff) do { _Pragma("unroll") for (int _i = 0; _i < 2; ++_i) \
        __builtin_amdgcn_global_load_lds((const unsigned*)((const char*)(gbase) + (voff)[_i]), (PG8_LAS unsigned*)(lds + (bufoff) + ldsw + _i * 8192), 16, 0, 0); } while (0)
#define PG8_LDA(dst, b, h) do { _Pragma("unroll") for (int m = 0; m < 4; ++m) _Pragma("unroll") for (int k = 0; k < 2; ++k) dst[m][k] = *(const PG8_LAS bf16x8*)(lds + PG8_SA(b, h) + aoff + m * 2048 + k * 1024); } while (0)
#define PG8_LDB(dst, b, h) do { _Pragma("unroll") for (int n = 0; n < 2; ++n) _Pragma("unroll") for (int k = 0; k < 2; ++k) dst[n][k] = *(const PG8_LAS bf16x8*)(lds + PG8_SB(b, h) + boff + n * 2048 + k * 1024); } while (0)
#define PG8_MMA(ai, bj, At, Bt) do { __builtin_amdgcn_s_setprio(1); _Pragma("unroll") for (int k = 0; k < 2; ++k) _Pragma("unroll") for (int m = 0; m < 4; ++m) _Pragma("unroll") for (int n = 0; n < 2; ++n) \
        acc[ai][bj][m][n] = mma16<I8>(Bt[n][k], At[m][k], acc[ai][bj][m][n]); __builtin_amdgcn_s_setprio(0); } while (0)
#define PG8_WAIT_V(n) asm volatile("s_waitcnt vmcnt(" #n ")" ::: "memory")
#define PG8_WAIT_L(n) asm volatile("s_waitcnt lgkmcnt(" #n ")" ::: "memory")
#define PG8_BAR __builtin_amdgcn_s_barrier()
#define PG8_SCHED __builtin_amdgcn_sched_barrier(0)
    Unit cur, nxt; int ui = 0;
    if (!S.next(0, cur)) return;
    typedef typename AccSel<I8>::type AccT; AccT acc[2][2][4][2];
#pragma unroll
    for (int a = 0; a < 2; ++a)
#pragma unroll
        for (int b = 0; b < 2; ++b)
#pragma unroll
            for (int m = 0; m < 4; ++m)
#pragma unroll
                for (int n = 0; n < 2; ++n) acc[a][b][m][n] = (AccT)(0);
    bf16x8 At[4][2], B0[2][2], B1[2][2];
    const char* cA = S.abase(g, cur, tstep); const char* cB = S.bbase(g, cur, tstep);
    S.a_ready(cur);
    if constexpr (SP2) {
        PG8_STAGE(PG8_SB(0, 0), cB, voffB); PG8_STAGE(PG8_SB(0, 1), cB + hstep, voffB); PG8_STAGE(PG8_SA(0, 0), cA, voffA); PG8_STAGE(PG8_SA(0, 1), cA + hstep, voffA);
        if (wr == 1) PG8_BAR;
        PG8_WAIT_V(2); PG8_BAR;
        PG8_STAGE(PG8_SB(1, 0), cB + kstep, voffB); PG8_STAGE(PG8_SA(1, 0), cA + kstep, voffA); PG8_STAGE(PG8_SB(1, 1), cB + hstep + kstep, voffB);
        PG8_WAIT_V(6); PG8_BAR;
    } else {
        PG8_STAGE(PG8_SB(0, 0), cB, voffB); PG8_STAGE(PG8_SA(0, 0), cA, voffA); PG8_STAGE(PG8_SB(0, 1), cB + hstep, voffB); PG8_STAGE(PG8_SA(0, 1), cA + hstep, voffA);
        if (wr == 1) PG8_BAR;
        PG8_WAIT_V(4); PG8_BAR;
        PG8_STAGE(PG8_SB(1, 0), cB + kstep, voffB); PG8_STAGE(PG8_SA(1, 0), cA + kstep, voffA); PG8_STAGE(PG8_SB(1, 1), cB + hstep + kstep, voffB);
        PG8_WAIT_V(6); PG8_BAR;
    }
    for (;;) {
        const bool has_next = S.next(ui + 1, nxt);
        const char* nA = has_next ? S.abase(g, nxt, tstep) : cA; const char* nB = has_next ? S.bbase(g, nxt, tstep) : cB;
        for (int t = 0; t < nt; t += 2) {
            const bool last = (t == nt - 2);
            const char* a1 = cA + (size_t)(t + 1) * kstep;
            const char* a2 = last ? nA : cA + (size_t)(t + 2) * kstep; const char* b2 = last ? nB : cB + (size_t)(t + 2) * kstep;
            const char* a3 = a2 + kstep; const char* b3 = b2 + kstep;
            if (last && has_next) S.a_ready(nxt);
            if constexpr (SP2) {
            PG8_LDB(B0, 0, 0); PG8_LDB(B1, 0, 1); PG8_SCHED; PG8_LDA(At, 0, 0); PG8_STAGE(PG8_SA(1, 1), a1 + hstep, voffA);
            PG8_WAIT_V(8); PG8_WAIT_L(0); PG8_BAR; PG8_MMA(0, 0, At, B0); PG8_MMA(0, 1, At, B1); PG8_BAR; PG8_SCHED;
            PG8_LDA(At, 0, 1); PG8_STAGE(PG8_SB(0, 0), b2, voffB); PG8_STAGE(PG8_SB(0, 1), b2 + hstep, voffB); PG8_STAGE(PG8_SA(0, 0), a2, voffA);
            PG8_WAIT_V(8); PG8_WAIT_L(0); PG8_BAR; PG8_MMA(1, 0, At, B0); PG8_MMA(1, 1, At, B1); PG8_BAR; PG8_SCHED;
            PG8_LDB(B0, 1, 0); PG8_LDB(B1, 1, 1); PG8_SCHED; PG8_LDA(At, 1, 0); PG8_STAGE(PG8_SA(0, 1), a2 + hstep, voffA);
            PG8_WAIT_V(8); PG8_WAIT_L(0); PG8_BAR; PG8_MMA(0, 0, At, B0); PG8_MMA(0, 1, At, B1); PG8_BAR; PG8_SCHED;
            PG8_LDA(At, 1, 1); PG8_STAGE(PG8_SB(1, 0), b3, voffB); PG8_STAGE(PG8_SB(1, 1), b3 + hstep, voffB); PG8_STAGE(PG8_SA(1, 0), a3, voffA);
            PG8_WAIT_V(8); PG8_WAIT_L(0); PG8_BAR; PG8_MMA(1, 0, At, B0); PG8_MMA(1, 1, At, B1); PG8_BAR; PG8_SCHED;
            } else {
            PG8_LDB(B0, 0, 0); PG8_SCHED; PG8_LDA(At, 0, 0); PG8_STAGE(PG8_SA(1, 1), a1 + hstep, voffA);
            PG8_WAIT_L(8); PG8_BAR; PG8_WAIT_L(0); PG8_MMA(0, 0, At, B0); PG8_BAR; PG8_SCHED;
            PG8_LDB(B1, 0, 1); PG8_STAGE(PG8_SB(0, 0), b2, voffB);
            PG8_BAR; PG8_WAIT_L(0); PG8_MMA(0, 1, At, B1); PG8_BAR;
            PG8_LDA(At, 0, 1); PG8_STAGE(PG8_SA(0, 0), a2, voffA);
            PG8_BAR; PG8_WAIT_L(0); PG8_MMA(1, 0, At, B0); PG8_BAR; PG8_SCHED;
            PG8_STAGE(PG8_SB(0, 1), b2 + hstep, voffB);
            PG8_WAIT_V(6); PG8_BAR; PG8_MMA(1, 1, At, B1); PG8_BAR;
            PG8_LDB(B0, 1, 0); PG8_SCHED; PG8_LDA(At, 1, 0); PG8_STAGE(PG8_SA(0, 1), a2 + hstep, voffA);
            PG8_WAIT_L(8); PG8_BAR; PG8_WAIT_L(0); PG8_MMA(0, 0, At, B0); PG8_BAR; PG8_SCHED;
            PG8_LDB(B1, 1, 1); PG8_STAGE(PG8_SB(1, 0), b3, voffB);
            PG8_BAR; PG8_WAIT_L(0); PG8_MMA(0, 1, At, B1); PG8_BAR;
            PG8_LDA(At, 1, 1); PG8_STAGE(PG8_SA(1, 0), a3, voffA);
            PG8_BAR; PG8_WAIT_L(0); PG8_MMA(1, 0, At, B0); PG8_BAR; PG8_SCHED;
            PG8_STAGE(PG8_SB(1, 1), b3 + hstep, voffB);
            PG8_WAIT_V(6); PG8_BAR; PG8_MMA(1, 1, At, B1); PG8_BAR;
            }
        }
        if constexpr (ALIGN_EPI) { if (wr == 0) PG8_BAR; }
        if constexpr (!Epi::AFTER_DRAIN) { E(acc, cur, wr, wc, fr, fq); S.done(cur); }
        if (!has_next) break;
#pragma unroll
        for (int a = 0; a < 2; ++a)
#pragma unroll
            for (int b = 0; b < 2; ++b)
#pragma unroll
                for (int m = 0; m < 4; ++m)
#pragma unroll
                    for (int n = 0; n < 2; ++n) acc[a][b][m][n] = (AccT)(0);
        cur = nxt; cA = nA; cB = nB; ++ui;
        if constexpr (ALIGN_EPI) { if (wr == 1) PG8_BAR; }
    }
    PG8_WAIT_V(0);
    if constexpr (!ALIGN_EPI) { if (wr == 0) PG8_BAR; }
    PG8_BAR;
    if constexpr (Epi::AFTER_DRAIN) { E.fused(acc, cur, wr, wc, fr, fq, lds, wid, lane); S.done(cur); }
#undef PG8_SA
#undef PG8_SB
#undef PG8_STAGE
#undef PG8_LDA
#undef PG8_LDB
#undef PG8_MMA
#undef PG8_WAIT_V
#undef PG8_WAIT_L
#undef PG8_BAR
#undef PG8_SCHED
}
}

constexpr int NWAVES = 8;
constexpr int D = 1024, NB = 4, SEQ = 4096, CTXL = 256, NLAT = NB * SEQ, NCTX = NB * CTXL, MROWS = NLAT + NCTX;
constexpr int DEPTH = 4, RW = 512, NH = 8, HS = 64, DFF = 3584, NE = 8, NPROJ = 3456, NP = 3584, NLO = 2560, KLA = 512, NMOD = 6144;
constexpr int PC_R = 0, PC_K = 512, PC_V = 1024, PC_CB = 1536, PC_CC = 2048, PC_CH = 2560, PC_WD = 3072, PC_AD = 3200, PC_GD = 3328;
constexpr float LN_EPS = 1e-5f, GN_EPS = 64e-5f, DN_ALPHA = 1.681792830507429f;
enum { I_X = 0, I_C, I_CTX, I_CCTX, I_WMOD, I_BMOD, I_WIN, I_W0, I_W2, I_A0, I_A2, I_KK, I_KA, I_RK, I_G2, I_LNXG, I_LNXB, I_CONVW, I_WOUT, I_LN1G, I_LN1B, I_LN2G, I_LN2B,
       I_FW1, I_FW3, I_FW2, I_RTW, I_RTB, I_MW1, I_MW3, I_MW2, N_IN };

constexpr size_t MiB = 1u << 20;
constexpr size_t WS_CTL = 0, CTL_BYTES = 3 * MiB;
constexpr size_t WS_MODV = 1 * MiB;
constexpr size_t WS_AMAX = 2 * MiB;
constexpr size_t WS_RKS = 3 * MiB;
constexpr size_t WS_WIN = 4 * MiB;
constexpr size_t WS_WOUT = WS_WIN + 28 * MiB;
constexpr size_t WS_LORA = WS_WOUT + 8 * MiB;
constexpr size_t WS_F13 = WS_LORA + 10 * MiB;
constexpr size_t WS_F2 = WS_F13 + 28 * MiB;
constexpr size_t WS_X = WS_F2 + 14 * MiB;
constexpr size_t WS_H = WS_X + 68 * MiB;
constexpr size_t WS_MOES = WS_H + 34 * MiB;
constexpr size_t WS_ROWLIST = WS_MOES;
constexpr size_t WS_TOKSEL = WS_MOES + 640 * 1024;
constexpr size_t WS_WSEL = WS_TOKSEL + 320 * 1024;
constexpr size_t WS_WSORT = WS_WSEL + 192 * 1024;
constexpr size_t WS_MOEW13 = WS_MOES + 2 * MiB;
constexpr size_t WS_MOEW2 = WS_MOEW13 + 112 * MiB;
constexpr size_t WS_H8 = WS_MOEW13 + 56 * MiB;
constexpr size_t WS_SA = WS_H8 + 17 * MiB;
constexpr size_t WS_SAM = WS_SA + 512 * 1024;
constexpr size_t WS_SAG = WS_SA + 1 * MiB;
constexpr size_t WS_SCR = WS_MOEW2 + 56 * MiB;
constexpr size_t WS_P = WS_SCR;
constexpr size_t WS_LO = WS_P + 119 * MiB;
constexpr size_t WS_PREP = WS_LO + 170 * MiB;
constexpr size_t WS_Y = WS_PREP + 213 * MiB;
constexpr size_t WS_MIXIN = WS_Y + 68 * MiB;
constexpr size_t WS_CH = WS_PREP;
constexpr size_t WS_MIXO = WS_PREP;
constexpr size_t WS_MIXP = WS_PREP + 34 * MiB;
constexpr size_t WS_END_MIXER = WS_MIXIN + 34 * MiB;
constexpr size_t WS_HG = WS_SCR;
constexpr size_t WS_ACT = WS_HG + 72 * MiB;
constexpr size_t WS_F = WS_ACT + 252 * MiB;
constexpr size_t WS_FP = WS_F + 72 * MiB;
constexpr size_t WS_END_FFN = WS_FP + 64 * MiB;
constexpr size_t WS_NEED = WS_END_MIXER > WS_END_FFN ? WS_END_MIXER : WS_END_FFN;
static_assert((size_t)MROWS * NP * 2 <= 119 * MiB && (size_t)MROWS * NLO * 4 <= 170 * MiB && (size_t)8704 * 25600 <= 213 * MiB && (size_t)MROWS * D * 4 <= 68 * MiB && WS_NEED <= 990 * MiB, "ws map");
constexpr int MOE_MAIN_PANELS = 128, MOE_TAIL_ROWS = 4096;
constexpr int MOE_ROWS = 36864;
constexpr int AM_IN = 18 * 2 * DFF, AM_OUT = AM_IN + DEPTH * NP;
constexpr int LORAW_PER_LAYER = 4 * 512 * 64 + 512 * 128;
constexpr int CW_BAR = 4096, CW_GCNT = 8192, CW_CQ = 12288, CW_SDONE = 12544;

constexpr int RING_BYTES = 131072, LDSCTL_OFF = RING_BYTES, MISC_OFF = LDSCTL_OFF + 320, LDS_BYTES = 147456;

typedef unsigned short bf16;
typedef unsigned v4u __attribute__((ext_vector_type(4)));
typedef unsigned v2u __attribute__((ext_vector_type(2)));
typedef float f32x4 __attribute__((ext_vector_type(4)));
#define LAS __attribute__((address_space(3)))
#define LDS_WAIT() asm volatile("s_waitcnt lgkmcnt(0)" ::: "memory")
__device__ __forceinline__ unsigned f2bf(float f) { unsigned u = __builtin_bit_cast(unsigned, f); return (u + 0x7fffu + ((u >> 16) & 1u)) >> 16; }
__device__ __forceinline__ unsigned pk2(float lo, float hi) { return f2bf(lo) | (f2bf(hi) << 16); }
__device__ __forceinline__ float bf2f(unsigned short b) { return __builtin_bit_cast(float, ((unsigned)b) << 16); }
__device__ __forceinline__ float bflo(unsigned w) { return __builtin_bit_cast(float, w << 16); }
__device__ __forceinline__ float bfhi(unsigned w) { return __builtin_bit_cast(float, w & 0xffff0000u); }
__device__ __forceinline__ float wave_sum(float v) {
#pragma unroll
    for (int o = 1; o < 64; o <<= 1) v += __shfl_xor(v, o);
    return v;
}
__device__ __forceinline__ float sigm(float x) { return 1.f / (1.f + __expf(-x)); }

#define XB_TMO      128
#define XB_XCNT(j)  (256  + 64 * (j))
#define XB_XSUB(j)  (1280 + 64 * (j))
#define XB_XGEN(j)  (2304 + 64 * (j))
#define XB_TOP      3328
#define XB_TOPGEN   3392
#define XCD_BAR_WORDS 3456
#define XB_SPIN_CAP (1u << 18)

__device__ __forceinline__ unsigned xb_ld(unsigned* p)              { return __hip_atomic_load(p, __ATOMIC_RELAXED, __HIP_MEMORY_SCOPE_AGENT); }
__device__ __forceinline__ unsigned xb_add(unsigned* p, unsigned v) { return __hip_atomic_fetch_add(p, v, __ATOMIC_RELAXED, __HIP_MEMORY_SCOPE_AGENT); }
__device__ __forceinline__ unsigned xb_xcc_id() { return (unsigned)__builtin_amdgcn_s_getreg((3 << 11) | 20) & 0xFu; }
#define XB_SPIN(cond, bar) do { unsigned _sp = 0; while (cond) { __builtin_amdgcn_s_sleep(1); \
    if ((++_sp & 255u) == 0u) { if (xb_ld(&(bar)[XB_TMO])) break; if (_sp > XB_SPIN_CAP) { atomicAdd(&(bar)[XB_TMO], 1u); break; } } } } while (0)

struct XcdBarrier {
    unsigned* bar; unsigned x;
    volatile LAS unsigned* st;
};

__device__ __forceinline__ XcdBarrier xcd_barrier_post(unsigned* bar, volatile LAS unsigned* st) {
    XcdBarrier b; b.bar = bar; b.x = xb_xcc_id(); b.st = st;
    if (threadIdx.x == 0) (void)xb_add(&bar[XB_XCNT(b.x)], 1u);
    return b;
}
__device__ __forceinline__ void xcd_barrier_complete(unsigned* bar, unsigned x, unsigned& nloc, unsigned& nx) {
    const unsigned G = gridDim.x * gridDim.y * gridDim.z;
    unsigned sum, cnt, mine, sp = 0u;
    for (;;) {
        sum = 0u; cnt = 0u; mine = 0u;
#pragma unroll
        for (unsigned j = 0; j < 16; ++j) { const unsigned c = xb_ld(&bar[XB_XCNT(j)]); sum += c; cnt += (c > 0u) ? 1u : 0u; mine = (j == x) ? c : mine; }
        if (sum == G) break;
        __builtin_amdgcn_s_sleep(1);
        if ((++sp & 255u) == 0u) { if (xb_ld(&bar[XB_TMO])) break; if (sp > XB_SPIN_CAP) { atomicAdd(&bar[XB_TMO], 1u); break; } }
    }
    nloc = mine > 0u ? mine : 1u; nx = cnt > 0u ? cnt : 1u;
}

__device__ __forceinline__ void xcd_barrier(const XcdBarrier& b) {
    asm volatile("s_waitcnt vmcnt(0)" ::: "memory");
    __syncthreads();
    if (threadIdx.x == 0) {
        unsigned* bar = b.bar;
        __builtin_amdgcn_s_waitcnt(0);
        unsigned nloc = b.st[0], nx = b.st[1];
        if (nloc == 0u) { xcd_barrier_complete(bar, b.x, nloc, nx); b.st[0] = nloc; b.st[1] = nx; }
        const unsigned old = xb_add(&bar[XB_XSUB(b.x)], 1u);
        const unsigned gen = old / nloc;
        if (old + 1u == (gen + 1u) * nloc) {
            __builtin_amdgcn_fence(__ATOMIC_RELEASE, "agent");
            asm volatile("s_waitcnt vmcnt(0)" ::: "memory");
            const unsigned og = xb_add(&bar[XB_TOP], 1u);
            const unsigned tg = og / nx;
            if (og + 1u == (tg + 1u) * nx) xb_add(&bar[XB_TOPGEN], 1u);
            else XB_SPIN(xb_ld(&bar[XB_TOPGEN]) == tg, bar);
            __builtin_amdgcn_fence(__ATOMIC_ACQUIRE, "agent");
            xb_add(&bar[XB_XGEN(b.x)], 1u);
            asm volatile("s_waitcnt vmcnt(0)" ::: "memory");
        } else {
            XB_SPIN(xb_ld(&bar[XB_XGEN(b.x)]) == gen, bar);
            __builtin_amdgcn_fence(__ATOMIC_ACQUIRE, "agent");
            asm volatile("s_waitcnt vmcnt(0)" ::: "memory");
        }
    }
    __syncthreads();
}


__device__ __forceinline__ size_t opaque_zero() { size_t z = 0; asm volatile("" : "+s"(z)); return z; }
#define OWS (p.ws + opaque_zero())
__device__ __forceinline__ int opaque_zero_i() { int z = 0; asm volatile("" : "+s"(z)); return z; }
#define PIN(i) (p.in[(i) + opaque_zero_i()])
struct KP { const float* in[N_IN]; float* out; unsigned char* ws; int ph; int pad; };

template <int MODE> __device__ __forceinline__ int rowmap(int n, int arg) {
    if (MODE == 0) return n + arg;
    if (MODE == 1) { if (n < 1536) return n; if (n < 1664) return n - 1536 + PC_WD; if (n < 1792) return n - 1664 + PC_AD; if (n < 1920) return n - 1792 + PC_GD;
                     if (n < 2432) return n - 1920 + PC_CB; if (n < 2944) return n - 2432 + PC_CC; return n - 2944 + PC_CH; }
    return 8 * (n >> 2) + 4 * arg + (n & 3);
}
template <int MODE> __device__ __forceinline__ void transpose_item(const float* W, int K, int N, bf16* WT, int arg, LAS float* scr, int item, int lane) {
    const int nblk = N / 32, kb = item / nblk, nb = item % nblk, k0 = 64 * kb, n0 = 32 * nb;
#pragma unroll 8
    for (int i = 0; i < 32; ++i) { const int kk = 2 * i + (lane >> 5); scr[kk * 33 + (lane & 31)] = __builtin_nontemporal_load(W + (size_t)(k0 + kk) * N + n0 + (lane & 31)); }
    LDS_WAIT(); asm volatile("" ::: "memory");
    const int c = lane & 7;
#pragma unroll
    for (int j = 0; j < 4; ++j) { const int n = (lane >> 3) + 8 * j; const LAS float* s = scr + (8 * c) * 33 + n;
        v4u o; o.x = pk2(s[0 * 33], s[1 * 33]); o.y = pk2(s[2 * 33], s[3 * 33]); o.z = pk2(s[4 * 33], s[5 * 33]); o.w = pk2(s[6 * 33], s[7 * 33]);
        *(v4u*)(WT + (size_t)rowmap<MODE>(n0 + n, arg) * K + k0 + 8 * c) = o; }
    LDS_WAIT(); asm volatile("" ::: "memory");
}

__device__ __forceinline__ void ph_modvec(const KP& p, LAS unsigned char* lds, int tid) {
    LAS float* sil = (LAS float*)lds;
    LAS float* red = (LAS float*)(lds + 5 * 1024 * 4);
    const float* c = PIN(I_C); const float* cc = PIN(I_CCTX);
    for (int i = tid; i < 5 * 1024; i += 512) { const float v = i < 4096 ? c[i] : cc[i - 4096]; sil[i] = v / (1.f + __expf(-v)); }
    __syncthreads();
    float* modv = (float*)(OWS + WS_MODV);
    const int l = (int)blockIdx.x >> 6, j0 = ((int)blockIdx.x & 63) * 96;
    if (tid < 384) { const int ks = tid / 24, cq = tid % 24;
        const float* w = PIN(I_WMOD) + (size_t)l * D * NMOD + (size_t)(ks * 64) * NMOD + j0 + 4 * cq;
        f32x4 a0 = {0.f, 0.f, 0.f, 0.f}, a1 = a0, a2 = a0, a3 = a0, a4 = a0;
#pragma unroll 8
        for (int k = 0; k < 64; ++k) { const f32x4 wv = __builtin_nontemporal_load((const f32x4*)(w + (size_t)k * NMOD)); const int kk = ks * 64 + k;
            a0 += sil[kk] * wv; a1 += sil[1024 + kk] * wv; a2 += sil[2048 + kk] * wv; a3 += sil[3072 + kk] * wv; a4 += sil[4096 + kk] * wv; }
        *(LAS f32x4*)(red + (ks * 5 + 0) * 96 + 4 * cq) = a0; *(LAS f32x4*)(red + (ks * 5 + 1) * 96 + 4 * cq) = a1; *(LAS f32x4*)(red + (ks * 5 + 2) * 96 + 4 * cq) = a2;
        *(LAS f32x4*)(red + (ks * 5 + 3) * 96 + 4 * cq) = a3; *(LAS f32x4*)(red + (ks * 5 + 4) * 96 + 4 * cq) = a4; }
    __syncthreads();
    if (tid < 480) { const int r = tid / 96, col = tid % 96; float sacc = 0.f;
#pragma unroll
        for (int q = 0; q < 16; ++q) sacc += red[(q * 5 + r) * 96 + col];
        modv[(size_t)(l * 5 + r) * NMOD + j0 + col] = sacc + PIN(I_BMOD)[l * NMOD + j0 + col]; }
    __syncthreads();
}

__device__ __forceinline__ void ph_convert(const KP& p, LAS unsigned char* lds, int gw, int NGW, int wave, int lane) {
    LAS float* scr = (LAS float*)(lds + wave * 16384);
    bf16* win = (bf16*)(OWS + WS_WIN); bf16* f2 = (bf16*)(OWS + WS_F2); bf16* lora = (bf16*)(OWS + WS_LORA);
    constexpr int I_IN = (D / 64) * (NPROJ / 32), I_OUT = (D / 64) * (D / 32), I_UP = (D / 64) * (DFF / 32), I_DN = (DFF / 64) * (D / 32);
    for (int it = gw; it < I_DN; it += NGW) transpose_item<0>(PIN(I_FW2), DFF, D, f2, 0, scr, it, lane);
    { const int gt = gw * 64 + lane, NGT = NGW * 64; constexpr int PER = (NP - NPROJ) * D / 16;
      for (int i = gt; i < DEPTH * PER; i += NGT) { const int l = i / PER, q = i % PER; *(v4u*)((unsigned char*)win + (size_t)l * NP * D + (size_t)NPROJ * D + (size_t)q * 16) = (v4u){0u, 0u, 0u, 0u}; } }
    { const int gt = gw * 64 + lane, NGT = NGW * 64;
      for (int i = gt; i < DEPTH * LORAW_PER_LAYER / 8; i += NGT) { const int l = i / (LORAW_PER_LAYER / 8); int q = (i % (LORAW_PER_LAYER / 8)) * 8; float v[8];
          int grp, c, k0; if (q < 4 * 512 * 64) { grp = q / (512 * 64); q -= grp * 512 * 64; c = q / 64; k0 = q % 64; } else { grp = 4; q -= 4 * 512 * 64; c = q / 128; k0 = q % 128; }
#pragma unroll
          for (int j = 0; j < 8; ++j) { const int k = k0 + j;
              v[j] = __builtin_nontemporal_load(grp < 2 ? PIN(I_W2) + ((size_t)(l * 2 + grp) * 64 + k) * RW + c : grp < 4 ? PIN(I_A2) + ((size_t)(l * 2 + grp - 2) * 64 + k) * RW + c : PIN(I_G2) + ((size_t)l * 128 + k) * RW + c); }
          v4u o; o.x = pk2(v[0], v[1]); o.y = pk2(v[2], v[3]); o.z = pk2(v[4], v[5]); o.w = pk2(v[6], v[7]);
          *(v4u*)(lora + (size_t)i * 8) = o; } }
}
#ifndef AMAX_ROWS
#define AMAX_ROWS 64
#endif
__device__ __forceinline__ void ph_amax(const KP& p, int gw, int NGW, int lane) {
    unsigned* AM = (unsigned*)(OWS + WS_AMAX);
    const int kp = lane >> 4, cq = lane & 15;
    for (int it = gw; it < 18 * 2 * (DFF / 64); it += NGW) { const int strip = it % (DFF / 64), sm = it / (DFF / 64), s1 = sm & 1, cm = sm >> 1;
        const float* W = cm < 2 ? PIN(s1 ? I_FW3 : I_FW1) + (size_t)cm * D * DFF : PIN(s1 ? I_MW3 : I_MW1) + (size_t)(cm - 2) * D * DFF;
        const int n = strip * 64 + 4 * cq; const float* src = W + (size_t)kp * DFF + n; f32x4 m = {0.f, 0.f, 0.f, 0.f};
#pragma unroll 16
        for (int k = 0; k < AMAX_ROWS / 4; ++k) { const f32x4 w = __builtin_nontemporal_load((const f32x4*)(src + (size_t)(4 * k) * DFF)); m += w * w; }
#pragma unroll
        for (int j = 0; j < 4; ++j) { m[j] += __shfl_xor(m[j], 16); m[j] += __shfl_xor(m[j], 32); }
        if (kp == 0) { f32x4 o;
#pragma unroll
            for (int j = 0; j < 4; ++j) o[j] = 4.25f * sqrtf(m[j] * (1.f / AMAX_ROWS));
            *(f32x4*)((float*)AM + (size_t)cm * 2 * DFF + 8 * (n >> 2) + 4 * s1) = o; } }
    for (int it = gw; it < DEPTH * (NPROJ / 64 + D / 64); it += NGW) { int t = it; const int l = t / (NPROJ / 64 + D / 64); t -= l * (NPROJ / 64 + D / 64);
        const bool isin = t < NPROJ / 64; const int strip = isin ? t : t - NPROJ / 64, N = isin ? NPROJ : D, n = strip * 64 + 4 * cq;
        const float* src = (isin ? PIN(I_WIN) + (size_t)l * D * NPROJ : PIN(I_WOUT) + (size_t)l * D * D) + (size_t)kp * N + n; f32x4 m = {0.f, 0.f, 0.f, 0.f};
#pragma unroll 16
        for (int k = 0; k < AMAX_ROWS / 4; ++k) { const f32x4 w = __builtin_nontemporal_load((const f32x4*)(src + (size_t)(4 * k) * N)); m += w * w; }
#pragma unroll
        for (int j = 0; j < 4; ++j) { m[j] += __shfl_xor(m[j], 16); m[j] += __shfl_xor(m[j], 32); }
        if (kp == 0) {
#pragma unroll
            for (int j = 0; j < 4; ++j) AM[isin ? AM_IN + l * NP + rowmap<1>(n + j, 0) : AM_OUT + l * D + n + j] = __builtin_bit_cast(unsigned, 4.25f * sqrtf(m[j] * (1.f / AMAX_ROWS))); } }
}
__device__ __forceinline__ unsigned q8pack(float a, float b, float c, float d) {
    const int qa = __float2int_rn(fminf(fmaxf(a, -127.f), 127.f)), qb = __float2int_rn(fminf(fmaxf(b, -127.f), 127.f)), qc = __float2int_rn(fminf(fmaxf(c, -127.f), 127.f)), qd = __float2int_rn(fminf(fmaxf(d, -127.f), 127.f));
    return (unsigned)(qa & 255) | ((unsigned)(qb & 255) << 8) | ((unsigned)(qc & 255) << 16) | ((unsigned)(qd & 255) << 24); }
constexpr int CQ_IN = (D / 64) * (NPROJ / 32), CQ_OUT = (D / 64) * (D / 32), CQ_UP = (D / 64) * (DFF / 32), CQ_DN = (DFF / 64) * (D / 32);
constexpr int CQ_NEG = CQ_IN + CQ_OUT + 2 * CQ_UP;
constexpr int CQ_J1 = 3 * CQ_IN + 3 * CQ_OUT + 2 * CQ_UP + CQ_DN, CQ_MOE = NE * (2 * CQ_UP + CQ_DN), CQ_END0 = CQ_J1 + CQ_MOE, CQ_END1 = CQ_END0 + CQ_MOE;
#ifndef CQ_SLOT_ITEMS
#define CQ_SLOT_ITEMS 12000
#endif
#ifndef CQ_NT
#define CQ_NT 1
#endif
#if CQ_NT
#define CQ_NT_LOAD(p_) __builtin_nontemporal_load(p_)
#else
#define CQ_NT_LOAD(p_) (*(p_))
#endif
struct CqItem { const float* W; bf16* WT; int K, N, mode, arg, item; const unsigned* am; };
__device__ __forceinline__ CqItem cq_decode(const KP& p, int q) {
    CqItem c; bf16* win = (bf16*)(OWS + WS_WIN); bf16* wout = (bf16*)(OWS + WS_WOUT); bf16* f13 = (bf16*)(OWS + WS_F13); bf16* f2 = (bf16*)(OWS + WS_F2);
    bf16* m13 = (bf16*)(OWS + WS_MOEW13); bf16* m2 = (bf16*)(OWS + WS_MOEW2); const unsigned* AM = (const unsigned*)(OWS + WS_AMAX);
    if (q < 0) { q += CQ_NEG;
        if (q < CQ_IN) { c = CqItem{PIN(I_WIN), win, D, NPROJ, 3, 0, q, AM + AM_IN}; return c; } q -= CQ_IN;
        if (q < CQ_OUT) { c = CqItem{PIN(I_WOUT), wout, D, D, 4, 0, q, AM + AM_OUT}; return c; } q -= CQ_OUT;
        if (q < CQ_UP) { c = CqItem{PIN(I_FW1), f13, D, DFF, 2, 0, q, AM}; return c; } q -= CQ_UP;
        c = CqItem{PIN(I_FW3), f13, D, DFF, 2, 1, q, AM}; return c; }
    if (q < 3 * CQ_IN) { const int l = 1 + q / CQ_IN; c = CqItem{PIN(I_WIN) + (size_t)l * D * NPROJ, win + (size_t)l * (NP * D / 2), D, NPROJ, 3, 0, q % CQ_IN, AM + AM_IN + l * NP}; return c; } q -= 3 * CQ_IN;
    if (q < 3 * CQ_OUT) { const int l = 1 + q / CQ_OUT; c = CqItem{PIN(I_WOUT) + (size_t)l * D * D, wout + (size_t)l * (D * D / 2), D, D, 4, 0, q % CQ_OUT, AM + AM_OUT + l * D}; return c; } q -= 3 * CQ_OUT;
    if (q < CQ_UP) { c = CqItem{PIN(I_FW1) + (size_t)D * DFF, f13 + (size_t)DFF * D, D, DFF, 2, 0, q, AM + 2 * DFF}; return c; } q -= CQ_UP;
    if (q < CQ_UP) { c = CqItem{PIN(I_FW3) + (size_t)D * DFF, f13 + (size_t)DFF * D, D, DFF, 2, 1, q, AM + 2 * DFF}; return c; } q -= CQ_UP;
    if (q < CQ_DN) { c = CqItem{PIN(I_FW2) + (size_t)DFF * D, f2 + (size_t)D * DFF, DFF, D, 0, 0, q, nullptr}; return c; } q -= CQ_DN;
    const int mi = q / CQ_MOE; q -= mi * CQ_MOE;
    if (q < NE * CQ_UP) { const int e = q / CQ_UP; c = CqItem{PIN(I_MW1) + ((size_t)mi * NE + e) * D * DFF, m13 + (size_t)e * DFF * D, D, DFF, 2, 0, q % CQ_UP, AM + (size_t)(2 + 8 * mi + e) * 2 * DFF}; return c; } q -= NE * CQ_UP;
    if (q < NE * CQ_UP) { const int e = q / CQ_UP; c = CqItem{PIN(I_MW3) + ((size_t)mi * NE + e) * D * DFF, m13 + (size_t)e * DFF * D, D, DFF, 2, 1, q % CQ_UP, AM + (size_t)(2 + 8 * mi + e) * 2 * DFF}; return c; } q -= NE * CQ_UP;
    { const int e = q / CQ_DN; c = CqItem{PIN(I_MW2) + ((size_t)mi * NE + e) * DFF * D, m2 + (size_t)e * D * DFF, DFF, D, 0, 0, q % CQ_DN, nullptr}; return c; }
}
__device__ __forceinline__ void cq_load(const CqItem& c, int lane, float (&r)[32]) {
    const int nblk = c.N / 32, kb = c.item / nblk, nb = c.item % nblk; const float* src = c.W + (size_t)(64 * kb + (lane >> 5)) * c.N + 32 * nb + (lane & 31);
#pragma unroll
    for (int i = 0; i < 32; ++i) r[i] = CQ_NT_LOAD(src + (size_t)(2 * i) * c.N);
}
__device__ __forceinline__ void cq_store(const CqItem& c, int lane, const float (&r)[32], LAS float* scr) {
    const int nblk = c.N / 32, kb = c.item / nblk, nb = c.item % nblk, k0 = 64 * kb, n0 = 32 * nb;
#pragma unroll
    for (int i = 0; i < 32; ++i) scr[(2 * i + (lane >> 5)) * 33 + (lane & 31)] = r[i];
    LDS_WAIT(); asm volatile("" ::: "memory");
    if (c.mode >= 2) {
        const int n = lane >> 1, hf = lane & 1, nn = n0 + n, j = c.mode == 2 ? 8 * (nn >> 2) + 4 * c.arg + (nn & 3) : c.mode == 3 ? rowmap<1>(nn, 0) : nn;
        const float inv = 127.f / fmaxf(__builtin_bit_cast(float, c.am[j]), 1e-30f); const LAS float* sp = scr + (32 * hf) * 33 + n; unsigned w[8];
#pragma unroll
        for (int q = 0; q < 8; ++q) w[q] = q8pack(sp[(4 * q + 0) * 33] * inv, sp[(4 * q + 1) * 33] * inv, sp[(4 * q + 2) * 33] * inv, sp[(4 * q + 3) * 33] * inv);
        unsigned char* dst = (unsigned char*)c.WT + (size_t)j * c.K + k0 + 32 * hf;
        __builtin_nontemporal_store((v4u){w[0], w[1], w[2], w[3]}, (v4u*)dst); __builtin_nontemporal_store((v4u){w[4], w[5], w[6], w[7]}, (v4u*)(dst + 16));
    } else {
    const int cc = lane & 7;
#pragma unroll
    for (int j = 0; j < 4; ++j) { const int n = (lane >> 3) + 8 * j; const LAS float* sp = scr + (8 * cc) * 33 + n;
        v4u o; o.x = pk2(sp[0 * 33], sp[1 * 33]); o.y = pk2(sp[2 * 33], sp[3 * 33]); o.z = pk2(sp[4 * 33], sp[5 * 33]); o.w = pk2(sp[6 * 33], sp[7 * 33]);
        const int nn = n0 + n;
        __builtin_nontemporal_store(o, (v4u*)(c.WT + (size_t)nn * c.K + k0 + 8 * cc)); }
    }
    LDS_WAIT(); asm volatile("" ::: "memory");
}
constexpr int CQ_B = 4;
__device__ __forceinline__ int cq_grab(unsigned* heads, int nseg, int& cnt, int lane) {
    int q = -1, n = 0;
    if (lane == 0) { for (int sg = 0; sg < nseg && q < 0; ++sg) { const int size = sg == 0 ? CQ_J1 : CQ_MOE, base = sg == 0 ? 0 : sg == 1 ? CQ_J1 : CQ_END0; unsigned* hd = heads + 64 * sg;
            if ((int)__hip_atomic_load(hd, __ATOMIC_RELAXED, __HIP_MEMORY_SCOPE_AGENT) < size) { const int t = (int)__hip_atomic_fetch_add(hd, (unsigned)CQ_B, __ATOMIC_RELAXED, __HIP_MEMORY_SCOPE_AGENT);
                if (t < size) { q = base + t; n = size - t < CQ_B ? size - t : CQ_B; } } } }
    cnt = __builtin_amdgcn_readfirstlane(n); return __builtin_amdgcn_readfirstlane(q);
}
__device__ __forceinline__ void cq_run(const KP& p, LAS unsigned char* lds, int nseg, const unsigned* stop, unsigned stopval, int wave, int lane) {
    unsigned* heads = (unsigned*)(OWS + WS_CTL) + CW_CQ; LAS float* scr = (LAS float*)(lds + wave * 16384);
    for (;;) {
        if (stop) { unsigned sv = 0u; if (lane == 0) sv = __hip_atomic_load(stop, __ATOMIC_RELAXED, __HIP_MEMORY_SCOPE_AGENT); if ((unsigned)__builtin_amdgcn_readfirstlane((int)sv) >= stopval) break; }
        int cnt; const int q0 = cq_grab(heads, nseg, cnt, lane); if (q0 < 0) break;
        CqItem cur = cq_decode(p, q0); float ra[32]; cq_load(cur, lane, ra);
        for (int j = 0; j < cnt; ++j) { CqItem nxt = cur; float rb[32];
            if (j + 1 < cnt) { nxt = cq_decode(p, q0 + j + 1); cq_load(nxt, lane, rb); }
            cq_store(cur, lane, ra, scr);
            if (j + 1 < cnt) { cur = nxt;
#pragma unroll
                for (int i = 0; i < 32; ++i) ra[i] = rb[i]; } }
    }
}

__device__ __forceinline__ void cq_static(const KP& p, LAS unsigned char* lds, int q0, int q1, int gw, int NGW, int wave, int lane) {
    LAS float* scr = (LAS float*)(lds + wave * 16384);
    int q = q0 + gw; if (q >= q1) return;
    CqItem cur = cq_decode(p, q); float ra[32]; cq_load(cur, lane, ra);
    for (;;) { const int qn = q + NGW; CqItem nxt = cur; float rb[32];
        if (qn < q1) { nxt = cq_decode(p, qn); cq_load(nxt, lane, rb); }
        cq_store(cur, lane, ra, scr);
        if (qn >= q1) break;
        cur = nxt; q = qn;
#pragma unroll
        for (int i = 0; i < 32; ++i) ra[i] = rb[i]; }
}

constexpr int CW_ICUR = 13312, CW_IDONE = 13440;
#ifndef PROBE_MI
#define PROBE_MI 0
#endif
#ifndef SC1_XW
#define SC1_XW 2
#endif
#ifndef S2_DMAX
#define S2_DMAX 1
#endif
#ifndef IDLE_STOP
#define IDLE_STOP 1
#endif
constexpr int IDLE_IN0 = ((MROWS / 256) * (NP / 256)) % 256, IDLE_OT0 = (NCTX / 256) * (D / 256) * 2, IDLE_UP0 = ((MROWS / 256) * (2 * DFF / 256)) % 256, IDLE_DT0 = (NCTX / 256) * (D / 256) * 7;
constexpr int CQO_DYN = 2 * CQ_SLOT_ITEMS, CQ_DYN_LIM = CQ_MOE - CQO_DYN;
static_assert(CQ_DYN_LIM > 0, "carry-phase slots exceed the MoE conversion segment");
__device__ __forceinline__ void cq_idle(const KP& p, LAS unsigned char* lds, int segbase, int mi, int slot, int first_idle, int tid, int wave, int lane) {
#ifdef IDLE_OFF
    return;
#endif
    unsigned* ctl = (unsigned*)(OWS + WS_CTL);
    if ((int)blockIdx.x < first_idle) { if (tid == 0) __hip_atomic_fetch_add(ctl + CW_IDONE + 64 * slot, 1u, __ATOMIC_RELAXED, __HIP_MEMORY_SCOPE_AGENT); }
    else {
        asm volatile("s_waitcnt vmcnt(0)" ::: "memory"); __syncthreads();
        LAS int* tk = (LAS int*)(lds + LDSCTL_OFF + 2048); LAS float* scr = (LAS float*)(lds + wave * 16384);
        for (int r = 0;; ++r) {
            if (tid == 0) { int t = -1;
                if ((int)__hip_atomic_load(ctl + CW_IDONE + 64 * slot, __ATOMIC_RELAXED, __HIP_MEMORY_SCOPE_AGENT) < IDLE_STOP) {
                    t = (int)__hip_atomic_fetch_add(ctl + CW_ICUR + 64 * mi, (unsigned)NWAVES, __ATOMIC_RELAXED, __HIP_MEMORY_SCOPE_AGENT); if (t >= CQ_DYN_LIM) t = -1; }
                tk[r & 1] = t; }
            __syncthreads();
            const int t = __builtin_amdgcn_readfirstlane(tk[r & 1]); if (t < 0) break;
            const int q = segbase + CQO_DYN + t + wave;
            if (q < segbase + CQ_MOE) { CqItem c = cq_decode(p, q); float ra[32]; cq_load(c, lane, ra); cq_store(c, lane, ra, scr); }
        }
    }
}

__device__ __forceinline__ void ld_row(const float* r, int lane, f32x4 (&v)[4]) { const f32x4* q = (const f32x4*)r + lane;
#pragma unroll
    for (int j = 0; j < 4; ++j) v[j] = q[64 * j]; }
__device__ __forceinline__ void ld_row_nt(const float* r, int lane, f32x4 (&v)[4]) { const f32x4* q = (const f32x4*)r + lane;
#pragma unroll
    for (int j = 0; j < 4; ++j) v[j] = __builtin_nontemporal_load(q + 64 * j); }
__device__ __forceinline__ void st_row(float* r, int lane, const f32x4 (&v)[4]) { f32x4* q = (f32x4*)r + lane;
#pragma unroll
    for (int j = 0; j < 4; ++j) q[64 * j] = v[j]; }
__device__ __forceinline__ void st_row_bf16(bf16* r, int lane, const f32x4 (&v)[4]) { v2u* q = (v2u*)r + lane;
#pragma unroll
    for (int j = 0; j < 4; ++j) { v2u w; w.x = pk2(v[j][0], v[j][1]); w.y = pk2(v[j][2], v[j][3]); q[64 * j] = w; } }
__device__ __forceinline__ void ld_row_bf16(const bf16* r, int lane, f32x4 (&v)[4]) { const v2u* q = (const v2u*)r + lane;
#pragma unroll
    for (int j = 0; j < 4; ++j) { const v2u w = q[64 * j]; v[j] = (f32x4){bflo(w.x), bfhi(w.x), bflo(w.y), bfhi(w.y)}; } }
typedef _Float16 h16x4 __attribute__((ext_vector_type(4)));
__device__ __forceinline__ void st_row_h16(_Float16* r, int lane, const f32x4 (&v)[4]) { h16x4* q = (h16x4*)r + lane;
#pragma unroll
    for (int j = 0; j < 4; ++j) { h16x4 w; w[0] = (_Float16)v[j][0]; w[1] = (_Float16)v[j][1]; w[2] = (_Float16)v[j][2]; w[3] = (_Float16)v[j][3]; q[64 * j] = w; } }
__device__ __forceinline__ void ld_row_h16(const _Float16* r, int lane, f32x4 (&v)[4]) { const h16x4* q = (const h16x4*)r + lane;
#pragma unroll
    for (int j = 0; j < 4; ++j) { const h16x4 w = __builtin_nontemporal_load(q + 64 * j); v[j] = (f32x4){(float)w[0], (float)w[1], (float)w[2], (float)w[3]}; } }
__device__ __forceinline__ void ld_row_bf16_nt(const bf16* r, int lane, f32x4 (&v)[4]) { const v2u* q = (const v2u*)r + lane;
#pragma unroll
    for (int j = 0; j < 4; ++j) { const v2u w = __builtin_nontemporal_load(q + 64 * j); v[j] = (f32x4){bflo(w.x), bfhi(w.x), bflo(w.y), bfhi(w.y)}; } }
template <int S> __device__ __forceinline__ void ld_row_parts(const float* r, size_t pstride, int lane, f32x4 (&v)[4]) {
    ld_row_nt(r, lane, v);
#pragma unroll
    for (int s = 1; s < S; ++s) { f32x4 t[4]; ld_row_nt(r + (size_t)s * pstride, lane, t);
#pragma unroll
        for (int j = 0; j < 4; ++j) v[j] += t[j]; } }
__device__ __forceinline__ int mod_row(int row) { return row < NLAT ? (row >> 12) : 4; }

__device__ __forceinline__ void st_row_q8(unsigned char* dst8, float* scale, int row, int lane, const f32x4 (&v)[4]) {
    float am = 0.f;
#pragma unroll
    for (int j = 0; j < 4; ++j) am = fmaxf(fmaxf(am, fmaxf(fabsf(v[j][0]), fabsf(v[j][1]))), fmaxf(fabsf(v[j][2]), fabsf(v[j][3])));
#pragma unroll
    for (int o = 1; o < 64; o <<= 1) am = fmaxf(am, __shfl_xor(am, o));
    am = fmaxf(am, 1e-30f); const float inv = 127.f / am; unsigned* h8 = (unsigned*)dst8 + (size_t)row * (D / 4) + lane;
#pragma unroll
    for (int j = 0; j < 4; ++j) h8[64 * j] = q8pack(v[j][0] * inv, v[j][1] * inv, v[j][2] * inv, v[j][3] * inv);
    if (lane == 0) scale[row] = am * (1.f / 127.f);
}
__device__ __forceinline__ void ph_init_rows(const KP& p, int gw, int NGW, int lane) {
    const float* modv = (const float*)(OWS + WS_MODV); float* X = (float*)(OWS + WS_X); bf16* H = (bf16*)(OWS + WS_H);
    for (int row = gw; row < MROWS; row += NGW) {
        const float* src = row < NLAT ? PIN(I_X) + (size_t)row * D : PIN(I_CTX) + (size_t)(row - NLAT) * D;
        const float* mv = modv + (size_t)(0 * 5 + mod_row(row)) * NMOD;
        f32x4 x[4], sh[4], sc[4], h[4]; ld_row_nt(src, lane, x); ld_row(mv, lane, sh); ld_row(mv + 1024, lane, sc);
#pragma unroll
        for (int j = 0; j < 4; ++j) h[j] = x[j] * (1.f + sc[j]) + sh[j];
        st_row_q8(OWS + WS_H8, (float*)(OWS + WS_SA), row, lane, h);
    }
}

__device__ __forceinline__ int scan_row(int b, int dir, int step) { return step < CTXL ? NLAT + b * CTXL + (dir ? CTXL - 1 - step : step) : b * SEQ + (dir ? SEQ - 1 - (step - CTXL) : step - CTXL); }
typedef short sbf16x8 __attribute__((ext_vector_type(8)));
typedef float f32x16 __attribute__((ext_vector_type(16)));
constexpr int SC_C = 32, SC_NCH = (CTXL + SEQ) / SC_C  , SC_NCHAIN = NB * NH * 2  , SC_NTASK = SC_NCH * SC_NCHAIN  ;
constexpr int CH_G = 0, CH_Q = 8192, CH_UT = 12288, CH_YL = 20480, CH_EC = 24576, CH_BYTES = 25600, CH_NLOAD = 26;

__device__ __forceinline__ f32x16 mm(v4u a, v4u b, f32x16 c) { return __builtin_amdgcn_mfma_f32_32x32x16_bf16(__builtin_bit_cast(sbf16x8, a), __builtin_bit_cast(sbf16x8, b), c, 0, 0, 0); }
typedef float f32x2c __attribute__((ext_vector_type(2))); typedef __bf16 bf16x2c __attribute__((ext_vector_type(2)));
__device__ __forceinline__ unsigned cvtpk(float lo, float hi) { return __builtin_bit_cast(unsigned, __builtin_convertvector((f32x2c){lo, hi}, bf16x2c)); }
template <int S, int NEG> __device__ __forceinline__ v4u cvtf(const f32x16& x) {
    v4u w; const float sg = NEG ? -1.f : 1.f;
    w.x = cvtpk(sg * x[8 * S + 0], sg * x[8 * S + 1]); w.y = cvtpk(sg * x[8 * S + 2], sg * x[8 * S + 3]); w.z = cvtpk(sg * x[8 * S + 4], sg * x[8 * S + 5]); w.w = cvtpk(sg * x[8 * S + 6], sg * x[8 * S + 7]); return w; }
template <int MODE  > __device__ __forceinline__ f32x16 mask_acc(f32x16 x, int n, int hh) {
#pragma unroll
    for (int r = 0; r < 16; ++r) { const int m = (r & 3) + 8 * (r >> 2) + 4 * hh; const bool keep = MODE == 0 ? (m > n) : MODE == 1 ? (m < n) : (m <= n); x[r] = keep ? x[r] : 0.f; }
    return x; }
__device__ __forceinline__ f32x16 zero16() { f32x16 z;
#pragma unroll
    for (int r = 0; r < 16; ++r) z[r] = 0.f;
    return z; }
__device__ __forceinline__ void cm_build(const unsigned (&w)[16], v4u (&f)[2][2]) {
#pragma unroll
    for (int s = 0; s < 2; ++s) {
        const auto r0 = __builtin_amdgcn_permlane32_swap(w[8 * s + 0], w[8 * s + 2], false, false), r1 = __builtin_amdgcn_permlane32_swap(w[8 * s + 1], w[8 * s + 3], false, false);
        const auto r2 = __builtin_amdgcn_permlane32_swap(w[8 * s + 4], w[8 * s + 6], false, false), r3 = __builtin_amdgcn_permlane32_swap(w[8 * s + 5], w[8 * s + 7], false, false);
        f[0][s] = (v4u){r0[0], r1[0], r2[0], r3[0]}; f[1][s] = (v4u){r0[1], r1[1], r2[1], r3[1]}; }
}
#ifndef IMG_NT
#define IMG_NT 1
#endif
__device__ __forceinline__ void st16(unsigned char* base, int off, int lane, v4u v) {
#if IMG_NT
    __builtin_nontemporal_store(v, (v4u*)(base + off + lane * 16));
#else
    *(v4u*)(base + off + lane * 16) = v;
#endif
}

__device__ __forceinline__ void ph_scan1(const KP& p, LAS unsigned char* lds, int l, int gw, int NGW, int wave, int lane) {
    const bf16* P = (const bf16*)(OWS + WS_P); const bf16* LO = (const bf16*)(OWS + WS_LO); const float* NRM = (const float*)(OWS + WS_RKS); unsigned char* CH = OWS + WS_CH;
    const int n = lane & 31, hh = lane >> 5;
    v4u Id[2];
#pragma unroll
    for (int s = 0; s < 2; ++s) { unsigned wd[4];
#pragma unroll
        for (int q = 0; q < 4; ++q) { const int j0 = 2 * q, j1 = 2 * q + 1; const int t0 = 16 * s + 8 * (j0 >> 2) + 4 * hh + (j0 & 3), t1 = 16 * s + 8 * (j1 >> 2) + 4 * hh + (j1 & 3);
            wd[q] = (t0 == n ? 0x3F80u : 0u) | (t1 == n ? 0x3F800000u : 0u); }
        Id[s] = (v4u){wd[0], wd[1], wd[2], wd[3]}; }
    static_assert(SC_NTASK == 4 * 2048 + 512, "ph_scan1: task deal assumes 8704 tasks on a 256-workgroup grid");
    for (int rnd = 0; rnd < 5; ++rnd) { int task;
        if (rnd < 4) task = gw + rnd * 2048; else { if ((gw & 7) >= SC1_XW) break; task = 4 * 2048 + (gw >> 3) * 2 + (gw & 7); if (SC1_XW != 2) { if (gw >= 512) break; task = 4 * 2048 + gw; } }
        const int dir = task & 1, h = (task >> 1) & 7, b = (task >> 4) & 3, ci = task >> 6;
        const int row0 = scan_row(b, dir, SC_C * ci), sgn = dir ? -1 : 1, c = h * 64 + lane;
        const float w0c = PIN(I_W0)[(l * 2 + dir) * RW + c], a0c = PIN(I_A0)[(l * 2 + dir) * RW + c], kkc = PIN(I_KK)[l * RW + c], kac = PIN(I_KA)[l * RW + c];
        unsigned wAl[16], wBe[16], wKa[16], wRh[16], wV[16], wBp[16], wKp[16];
        float cs = 0.f, Eprev = 1.f;
#pragma unroll
        for (int hb = 0; hb < 2; ++hb) {
            unsigned rk_[16], rr_[16], rv_[16], rw_[16], ra_[16]; float rn_[16];
            { LAS unsigned char* wl = lds + wave * 10240; const int tk = lane >> 3, cg = lane & 7; v4u raw[2][5];
#pragma unroll
              for (int jj = 0; jj < 2; ++jj) { const int row = row0 + sgn * (16 * hb + 8 * jj + tk); const bf16* pr = P + (size_t)row * NP + h * 64 + 8 * cg; const bf16* lo = LO + (size_t)row * NLO + dir * RW + h * 64 + 8 * cg;
                  raw[jj][0] = *(const v4u*)(pr + PC_K); raw[jj][1] = *(const v4u*)(pr + PC_R); raw[jj][2] = *(const v4u*)(pr + PC_V); raw[jj][3] = *(const v4u*)lo; raw[jj][4] = *(const v4u*)(lo + 1024); }
              float rnv = NRM[(row0 + sgn * (16 * hb + (lane & 15))) * 8 + h];
#pragma unroll
              for (int jj = 0; jj < 2; ++jj)
#pragma unroll
                  for (int q = 0; q < 5; ++q) asm volatile("" : "+v"(raw[jj][q]));
              asm volatile("" : "+v"(rnv));
#pragma unroll
              for (int i = 0; i < 16; ++i) rn_[i] = __builtin_bit_cast(float, __builtin_amdgcn_readlane(__builtin_bit_cast(int, rnv), i));
#pragma unroll
              for (int jj = 0; jj < 2; ++jj)
#pragma unroll
                  for (int q = 0; q < 5; ++q) *(LAS v4u*)(wl + q * 2048 + (8 * jj + tk) * 128 + cg * 16) = raw[jj][q];
#pragma unroll
              for (int i = 0; i < 16; ++i) { const LAS unsigned short* sp = (const LAS unsigned short*)(wl + i * 128) + lane;
                  rk_[i] = sp[0]; rr_[i] = sp[1024]; rv_[i] = sp[2048]; rw_[i] = sp[3072]; ra_[i] = sp[4096]; } }
#pragma unroll
            for (int i = 0; i < 16; ++i) asm volatile("" : "+v"(rk_[i]), "+v"(rr_[i]), "+v"(rv_[i]), "+v"(rw_[i]), "+v"(ra_[i]), "+v"(rn_[i]));
#pragma unroll
            for (int pq = 0; pq < 8; ++pq) { const int pz = 8 * hb + pq; float al[2], be[2], ka[2], rh[2], vv[2];
#pragma unroll
                for (int e = 0; e < 2; ++e) { const int i = 2 * pq + e;
                    const float kv = bf2f((unsigned short)rk_[i]), rv = bf2f((unsigned short)rr_[i]); vv[e] = bf2f((unsigned short)rv_[i]);
                    const float wl = w0c + bf2f((unsigned short)rw_[i]), aa = __builtin_amdgcn_rcpf(1.f + __expf(-(a0c + bf2f((unsigned short)ra_[i])))), nrm = rn_[i];
                    const float lw = -0.6065306597f * __builtin_amdgcn_rcpf(1.f + __expf(-wl));
                    cs += lw; const float E = __expf(cs), Ei = __builtin_amdgcn_rcpf(E);
                    const float kkn = kv * kkc * nrm, kd = kv * (1.f + (aa - 1.f) * kac);
                    al[e] = kkn * Eprev; be[e] = kkn * aa * Ei; ka[e] = kd * Ei; rh[e] = rv * E; Eprev = E; }
                wAl[pz] = cvtpk(al[0], al[1]); wBe[pz] = cvtpk(be[0], be[1]); wKa[pz] = cvtpk(ka[0], ka[1]); wRh[pz] = cvtpk(rh[0], rh[1]); wV[pz] = cvtpk(vv[0], vv[1]); }
        }
        const float EC = Eprev;
#pragma unroll
        for (int pz = 0; pz < 16; ++pz) { wBp[pz] = cvtpk(bflo(wBe[pz]) * EC, bfhi(wBe[pz]) * EC); wKp[pz] = cvtpk(bflo(wKa[pz]) * EC, bfhi(wKa[pz]) * EC); }
        unsigned char* img = CH + (size_t)(((b * 8 + h) * 2 + dir) * SC_NCH + ci) * CH_BYTES;
        ((float*)(img + CH_EC))[lane] = EC;
        v4u cAl[2][2], cV[2][2], cBp[2][2], cKp[2][2], cRh[2][2];
        v4u tAl[4], tBe[4], tKa[4], tRh[4];
        cm_build(wAl, cAl); cm_build(wV, cV); cm_build(wBp, cBp); cm_build(wKp, cKp); cm_build(wRh, cRh);
        {   v4u cBe[2][2], cKa[2][2]; cm_build(wBe, cBe); cm_build(wKa, cKa);
#define TRANSPOSE(cZ, tZ) do { _Pragma("unroll") for (int ct = 0; ct < 2; ++ct) { f32x16 T_ = mm(cZ[ct][0], Id[0], zero16()); T_ = mm(cZ[ct][1], Id[1], T_); tZ[2 * ct] = cvtf<0, 0>(T_); tZ[2 * ct + 1] = cvtf<1, 0>(T_); } } while (0)
            TRANSPOSE(cAl, tAl); TRANSPOSE(cBe, tBe); TRANSPOSE(cKa, tKa); TRANSPOSE(cRh, tRh);
#undef TRANSPOSE
        }
#define PROD4(A, B) mm(A[3], B[3], mm(A[2], B[2], mm(A[1], B[1], mm(A[0], B[0], zero16()))))
        f32x16 XN = mask_acc<0>(PROD4(tAl, tBe), n, hh), XT = mask_acc<1>(PROD4(tBe, tAl), n, hh);
        v4u fLM[2], fGB[2], fGK[2];
        { const f32x16 t = mask_acc<1>(PROD4(tKa, tAl), n, hh); fLM[0] = cvtf<0, 0>(t); fLM[1] = cvtf<1, 0>(t); }
        { const f32x16 t = mask_acc<2>(PROD4(tBe, tRh), n, hh); fGB[0] = cvtf<0, 0>(t); fGB[1] = cvtf<1, 0>(t); }
        { const f32x16 t = mask_acc<2>(PROD4(tKa, tRh), n, hh); fGK[0] = cvtf<0, 0>(t); fGK[1] = cvtf<1, 0>(t); }
#undef PROD4
#pragma unroll
        for (int r = 0; r < 16; ++r) { XN[r] = -XN[r]; XT[r] = -XT[r]; }
        f32x16 RT = XT;
#pragma unroll
        for (int r = 0; r < 16; ++r) RT[r] += ((r & 3) + 8 * (r >> 2) + 4 * hh == n) ? 1.f : 0.f;
#pragma unroll
        for (int pw = 1; pw < 5; ++pw) {
            const v4u xn0 = cvtf<0, 0>(XN), xn1 = cvtf<1, 0>(XN), xt0 = cvtf<0, 0>(XT), xt1 = cvtf<1, 0>(XT);
            XN = mm(xt1, xn1, mm(xt0, xn0, zero16()));
            if (pw < 4) XT = mm(xn1, xt1, mm(xn0, xt0, zero16()));
            const v4u yn0 = cvtf<0, 0>(XN), yn1 = cvtf<1, 0>(XN), rt0 = cvtf<0, 0>(RT), rt1 = cvtf<1, 0>(RT);
            RT = mm(yn1, rt1, mm(yn0, rt0, RT));
        }
        const v4u fA0 = cvtf<0, 0>(RT), fA1 = cvtf<1, 0>(RT);
        f32x16 At[2], Vt[2];
#pragma unroll
        for (int t = 0; t < 2; ++t) {
            const f32x16 lmv = mm(fLM[1], cV[t][1], mm(fLM[0], cV[t][0], zero16()));
            At[t] = mm(fA1, cAl[t][1], mm(fA0, cAl[t][0], zero16()));
            Vt[t] = mm(fA1, cvtf<1, 0>(lmv), mm(fA0, cvtf<0, 0>(lmv), zero16()));
        }
#pragma unroll
        for (int kt1 = 0; kt1 < 2; ++kt1) { const v4u a0 = cvtf<0, 0>(At[kt1]), a1 = cvtf<1, 0>(At[kt1]);
#pragma unroll
            for (int kt2 = 0; kt2 < 2; ++kt2) { const f32x16 g = mm(a1, cBp[kt2][1], mm(a0, cBp[kt2][0], zero16()));
                st16(img, CH_G + ((kt2 * 2 + kt1) * 2 + 0) * 1024, lane, cvtf<0, 1>(g)); st16(img, CH_G + ((kt2 * 2 + kt1) * 2 + 1) * 1024, lane, cvtf<1, 1>(g)); } }
#pragma unroll
        for (int vt = 0; vt < 2; ++vt) { const v4u nv0 = cvtf<0, 1>(Vt[vt]), nv1 = cvtf<1, 1>(Vt[vt]);
#pragma unroll
            for (int kt = 0; kt < 2; ++kt) { f32x16 u = mm(cKp[kt][1], cV[vt][1], mm(cKp[kt][0], cV[vt][0], zero16())); u = mm(cBp[kt][1], nv1, mm(cBp[kt][0], nv0, u));
                st16(img, CH_UT + ((kt * 2 + vt) * 2 + 0) * 1024, lane, cvtf<0, 0>(u)); st16(img, CH_UT + ((kt * 2 + vt) * 2 + 1) * 1024, lane, cvtf<1, 0>(u)); }
            f32x16 y = mm(cV[vt][1], fGK[1], mm(cV[vt][0], fGK[0], zero16())); y = mm(nv1, fGB[1], mm(nv0, fGB[0], y));
            st16(img, CH_YL + (vt * 2 + 0) * 1024, lane, cvtf<0, 0>(y)); st16(img, CH_YL + (vt * 2 + 1) * 1024, lane, cvtf<1, 0>(y)); }
#pragma unroll
        for (int kt = 0; kt < 2; ++kt) { f32x16 q = mm(cRh[kt][1], Id[1], mm(cRh[kt][0], Id[0], zero16()));
            q = mm(cvtf<1, 1>(At[kt]), fGB[1], mm(cvtf<0, 1>(At[kt]), fGB[0], q));
            st16(img, CH_Q + (kt * 2 + 0) * 1024, lane, cvtf<0, 0>(q)); st16(img, CH_Q + (kt * 2 + 1) * 1024, lane, cvtf<1, 0>(q)); }
    }
}

__device__ __forceinline__ void ph_scan2(const KP& p, LAS unsigned char* lds, int l, int wave, int lane) {
    unsigned* sdone = (unsigned*)(OWS + WS_CTL) + CW_SDONE + 64 * l;
#ifndef CQ_SLOT_WGS
#define CQ_SLOT_WGS 128
#endif
    if (blockIdx.x >= SC_NCHAIN * 2) {
        const int q0 = (l < 2 ? CQ_J1 : CQ_END0) + (l & 1) * CQ_SLOT_ITEMS;
        cq_static(p, lds, q0, q0 + CQ_SLOT_ITEMS, ((int)blockIdx.x - SC_NCHAIN * 2) * NWAVES + wave, ((int)gridDim.x - SC_NCHAIN * 2) * NWAVES, wave, lane); return; }
    const int chain = blockIdx.x & (SC_NCHAIN - 1), vt = blockIdx.x >> 6, dir = chain & 1, h = (chain >> 1) & 7, b = chain >> 4;
    const int n = lane & 31, hh = lane >> 5;
    const unsigned char* CH = OWS + WS_CH + (size_t)chain * SC_NCH * CH_BYTES; bf16* Y = (bf16*)(OWS + WS_Y) + (size_t)dir * MROWS * RW + h * 64 + 32 * vt + 4 * hh;
    constexpr int NPIECE = 19, SLOT = NPIECE * 1024, NSLOT = 6, PD = 4, XCH = NSLOT * SLOT;
    int psrc[3], pdst[3];
#pragma unroll
    for (int j = 0; j < 3; ++j) { int f = wave + 8 * j; if (f >= NPIECE) f -= NPIECE;
        pdst[j] = f;
        psrc[j] = f < 12 ? f * 1024 : f < 16 ? CH_UT + ((((f - 12) >> 1) * 2 + vt) * 2 + ((f - 12) & 1)) * 1024 : f < 18 ? CH_YL + (vt * 2 + (f - 16)) * 1024 : CH_EC; }
    const int lane_off[3] = {pdst[0] == 18 ? (lane * 16) & 255 : lane * 16, pdst[1] == 18 ? (lane * 16) & 255 : lane * 16, pdst[2] == 18 ? (lane * 16) & 255 : lane * 16};
#define SC2_ISSUE(ci_, slot_) do { const unsigned char* im_ = CH + (size_t)(ci_) * CH_BYTES; LAS unsigned char* sl_ = lds + (slot_) * SLOT; \
        _Pragma("unroll") for (int j = 0; j < 3 * S2_DMAX; ++j) __builtin_amdgcn_global_load_lds((const unsigned*)(im_ + psrc[j % 3] + lane_off[j % 3]), (LAS unsigned*)(sl_ + pdst[j % 3] * 1024), 16, 0, 0); } while (0)
#define SC2_LD(slot_, piece_) (*(const LAS v4u*)(lds + (slot_) * SLOT + (piece_) * 1024 + lane * 16))
#define SC2_X(par_, k_) (*(LAS v4u*)(lds + XCH + (par_) * 4096 + (k_) * 1024 + lane * 16))
    f32x16 ST[2] = {zero16(), zero16()};
    if (wave == 0) __builtin_amdgcn_s_setprio(3);
    SC2_ISSUE(0, 0); SC2_ISSUE(1, 1); SC2_ISSUE(2, 2); SC2_ISSUE(3, 3);
    v4u g0, g1, g2, g3, g4, g5, g6, g7, u0, u1, u2, u3; f32x4 ec[8];
#define SC2_PRELOAD(slot_) do { g0 = SC2_LD(slot_, 0); g1 = SC2_LD(slot_, 1); g2 = SC2_LD(slot_, 2); g3 = SC2_LD(slot_, 3); g4 = SC2_LD(slot_, 4); g5 = SC2_LD(slot_, 5); g6 = SC2_LD(slot_, 6); g7 = SC2_LD(slot_, 7); \
        u0 = SC2_LD(slot_, 12); u1 = SC2_LD(slot_, 13); u2 = SC2_LD(slot_, 14); u3 = SC2_LD(slot_, 15); \
        _Pragma("unroll") for (int kq = 0; kq < 8; ++kq) ec[kq] = *(const LAS f32x4*)(lds + (slot_) * SLOT + 18 * 1024 + (32 * (kq >> 2) + 8 * (kq & 3) + 4 * hh) * 4); } while (0)
#ifdef PROBE_S2SEG
    unsigned long long psacc_ = 0, pst_ = 0;
#ifndef PROBE_S2END
#define PROBE_S2END (PROBE_S2SEG + 1)
#endif
#ifndef PROBE_S2WV
#define PROBE_S2WV 0
#endif
#define S2T(id_) do { if ((id_) == PROBE_S2SEG) pst_ = __builtin_readcyclecounter(); if ((id_) == PROBE_S2END) psacc_ += __builtin_readcyclecounter() - pst_; } while (0)
#else
#define S2T(id_) do {} while (0)
#endif
    for (int ci = 0; ci <= SC_NCH; ++ci) {
        S2T(1);
#ifdef S2_W1LAX
        if (wave == 1 && ci >= 4) asm volatile("s_waitcnt vmcnt(12)" ::: "memory"); else
#endif
#if S2_DMAX == 2
        asm volatile("s_waitcnt vmcnt(12)" ::: "memory");
#else
        asm volatile("s_waitcnt vmcnt(6)" ::: "memory");
#endif of chunks <= ci+1 have landed (only the two later chunks' six loads may be outstanding; y stores only make the wait stricter)
        S2T(5);
        __builtin_amdgcn_s_barrier();
        asm volatile("" ::: "memory");
        S2T(6);
        { const int nx = ci + PD < SC_NCH ? ci + PD : SC_NCH - 1; SC2_ISSUE(nx, (ci + PD) % NSLOT); }
        S2T(2);
        if (wave == 0 && ci < SC_NCH) {
            if (ci == 0) SC2_PRELOAD(0);
            asm volatile("" : "+v"(g0), "+v"(g1), "+v"(g2), "+v"(g3), "+v"(g4), "+v"(g5), "+v"(g6), "+v"(g7), "+v"(u0), "+v"(u1), "+v"(u2), "+v"(u3));
            asm volatile("" : "+v"(ec[0]), "+v"(ec[1]), "+v"(ec[2]), "+v"(ec[3]), "+v"(ec[4]), "+v"(ec[5]), "+v"(ec[6]), "+v"(ec[7]));
            const v4u s00 = cvtf<0, 0>(ST[0]), s01 = cvtf<1, 0>(ST[0]), s10 = cvtf<0, 0>(ST[1]), s11 = cvtf<1, 0>(ST[1]);
            SC2_X(ci & 1, 0) = s00; SC2_X(ci & 1, 1) = s01; SC2_X(ci & 1, 2) = s10; SC2_X(ci & 1, 3) = s11;
            f32x16 a0, a1;
            a0[0] = bflo(u0.x); a0[1] = bfhi(u0.x); a0[2] = bflo(u0.y); a0[3] = bfhi(u0.y); a0[4] = bflo(u0.z); a0[5] = bfhi(u0.z); a0[6] = bflo(u0.w); a0[7] = bfhi(u0.w);
            a0[8] = bflo(u1.x); a0[9] = bfhi(u1.x); a0[10] = bflo(u1.y); a0[11] = bfhi(u1.y); a0[12] = bflo(u1.z); a0[13] = bfhi(u1.z); a0[14] = bflo(u1.w); a0[15] = bfhi(u1.w);
            a1[0] = bflo(u2.x); a1[1] = bfhi(u2.x); a1[2] = bflo(u2.y); a1[3] = bfhi(u2.y); a1[4] = bflo(u2.z); a1[5] = bfhi(u2.z); a1[6] = bflo(u2.w); a1[7] = bfhi(u2.w);
            a1[8] = bflo(u3.x); a1[9] = bfhi(u3.x); a1[10] = bflo(u3.y); a1[11] = bfhi(u3.y); a1[12] = bflo(u3.z); a1[13] = bfhi(u3.z); a1[14] = bflo(u3.w); a1[15] = bfhi(u3.w);
#pragma unroll
            for (int q = 0; q < 4; ++q)
#pragma unroll
                for (int e = 0; e < 4; ++e) { a0[4 * q + e] += ST[0][4 * q + e] * ec[q][e]; a1[4 * q + e] += ST[1][4 * q + e] * ec[4 + q][e]; }
            a0 = mm(g0, s00, a0); a1 = mm(g4, s00, a1); a0 = mm(g1, s01, a0); a1 = mm(g5, s01, a1);
            a0 = mm(g2, s10, a0); a1 = mm(g6, s10, a1); a0 = mm(g3, s11, a0); a1 = mm(g7, s11, a1);
            S2T(3);
            if (ci + 1 < SC_NCH) SC2_PRELOAD((ci + 1) % NSLOT);
            ST[0] = a0; ST[1] = a1;
            if (lane == 0 && ci == SC_NCH - 24) __hip_atomic_fetch_add(sdone, 1u, __ATOMIC_RELAXED, __HIP_MEMORY_SCOPE_AGENT);
        } else if (wave == 1 && ci >= 1) {
            const int cj = ci - 1, sj = cj % NSLOT, par = cj & 1;
            v4u ya = SC2_LD(sj, 16), yc = SC2_LD(sj, 17), q0 = SC2_LD(sj, 8), q1 = SC2_LD(sj, 9), q2 = SC2_LD(sj, 10), q3 = SC2_LD(sj, 11), x0 = SC2_X(par, 0), x1 = SC2_X(par, 1), x2 = SC2_X(par, 2), x3 = SC2_X(par, 3);
            asm volatile("" : "+v"(ya), "+v"(yc), "+v"(q0), "+v"(q1), "+v"(q2), "+v"(q3), "+v"(x0), "+v"(x1), "+v"(x2), "+v"(x3));
            f32x16 y, y2 = zero16();
            y[0] = bflo(ya.x); y[1] = bfhi(ya.x); y[2] = bflo(ya.y); y[3] = bfhi(ya.y); y[4] = bflo(ya.z); y[5] = bfhi(ya.z); y[6] = bflo(ya.w); y[7] = bfhi(ya.w);
            y[8] = bflo(yc.x); y[9] = bfhi(yc.x); y[10] = bflo(yc.y); y[11] = bfhi(yc.y); y[12] = bflo(yc.z); y[13] = bfhi(yc.z); y[14] = bflo(yc.w); y[15] = bfhi(yc.w);
            y = mm(x0, q0, y); y2 = mm(x2, q2, y2); y = mm(x1, q1, y); y2 = mm(x3, q3, y2);
            { LAS unsigned char* yt = lds + XCH + 8192;
#pragma unroll
              for (int q = 0; q < 4; ++q) *(LAS v2u*)(yt + n * 72 + 16 * q + 8 * hh) = (v2u){cvtpk(y[4 * q] + y2[4 * q], y[4 * q + 1] + y2[4 * q + 1]), cvtpk(y[4 * q + 2] + y2[4 * q + 2], y[4 * q + 3] + y2[4 * q + 3])};
              bf16* Yb = Y - 4 * hh;
#pragma unroll
              for (int k = 0; k < 2; ++k) { const int t = (lane >> 2) + 16 * k, ck = lane & 3; const LAS v2u* sp = (const LAS v2u*)(yt + t * 72 + 16 * ck); const v2u lo = sp[0], hi = sp[1];
                  const int row = scan_row(b, dir, SC_C * cj + t); *(v4u*)(Yb + (size_t)row * RW + 8 * ck) = (v4u){lo.x, lo.y, hi.x, hi.y}; } }
        }
        asm volatile("s_waitcnt lgkmcnt(0)" ::: "memory");
        S2T(4);
    }
    asm volatile("s_waitcnt vmcnt(0)" ::: "memory");
    __builtin_amdgcn_s_setprio(0);
#ifdef PROBE_S2SEG
    if (blockIdx.x == 0 && wave == PROBE_S2WV) { const unsigned long long t1_ = __builtin_readcyclecounter(), dt_ = psacc_ * PROBE_S2K; while (__builtin_readcyclecounter() - t1_ < dt_) __builtin_amdgcn_s_sleep(32); }
#endif
#undef SC2_ISSUE
#undef SC2_LD
#undef SC2_X
#undef SC2_PRELOAD
}

__device__ __forceinline__ float sum8(float v) { v += __shfl_xor(v, 1); v += __shfl_xor(v, 2); v += __shfl_xor(v, 4); return v; }
__device__ __forceinline__ void unpack8(v4u s, float (&v)[8]) { v[0] = bflo(s.x); v[1] = bfhi(s.x); v[2] = bflo(s.y); v[3] = bfhi(s.y); v[4] = bflo(s.z); v[5] = bfhi(s.z); v[6] = bflo(s.w); v[7] = bfhi(s.w); }
__device__ __forceinline__ void ld8f(const float* q, float (&v)[8]) { const f32x4 a = *(const f32x4*)q, b = *(const f32x4*)(q + 4); v[0] = a[0]; v[1] = a[1]; v[2] = a[2]; v[3] = a[3]; v[4] = b[0]; v[5] = b[1]; v[6] = b[2]; v[7] = b[3]; }
__device__ __forceinline__ v4u pack8(const float (&v)[8]) { v4u o; o.x = cvtpk(v[0], v[1]); o.y = cvtpk(v[2], v[3]); o.z = cvtpk(v[4], v[5]); o.w = cvtpk(v[6], v[7]); return o; }

__device__ __forceinline__ void ph_readout2(const KP& p, int l, int gw, int NGW, int lane) {
    const bf16* P = (const bf16*)(OWS + WS_P); const bf16* LO = (const bf16*)(OWS + WS_LO); const bf16* Y = (const bf16*)(OWS + WS_Y);
    bf16* MI = (bf16*)(OWS + WS_MIXIN); constexpr size_t PA = (size_t)MROWS * RW; const int c0 = lane * 8;
    const int nrows = l == DEPTH - 1 ? NLAT : MROWS;
    float a0[8], a1[8], ka[8], rkp[8], lg[8], lb[8], w0[8], w1[8], w2[8];
    ld8f(PIN(I_A0) + (l * 2 + 0) * RW + c0, a0); ld8f(PIN(I_A0) + (l * 2 + 1) * RW + c0, a1); ld8f(PIN(I_KA) + l * RW + c0, ka); ld8f(PIN(I_RK) + l * RW + c0, rkp);
    ld8f(PIN(I_LNXG) + l * RW + c0, lg); ld8f(PIN(I_LNXB) + l * RW + c0, lb);
    { const float* cw = PIN(I_CONVW) + (size_t)l * 3 * RW + c0; ld8f(cw, w0); ld8f(cw + RW, w1); ld8f(cw + 2 * RW, w2); }
#pragma unroll 2
    for (int row = gw; row < nrows; row += NGW) { const bf16* pr = P + (size_t)row * NP; const bf16* lo = LO + (size_t)row * NLO;
        int t, len; if (row < NLAT) { t = row & 63; len = 64; } else { t = (row - NLAT) & 255; len = 256; }
        const v4u kw = __builtin_nontemporal_load((const v4u*)(pr + PC_K + c0)), rw = __builtin_nontemporal_load((const v4u*)(pr + PC_R + c0)), vw = __builtin_nontemporal_load((const v4u*)(pr + PC_V + c0));
        const v4u cbw = __builtin_nontemporal_load((const v4u*)(pr + PC_CB + c0)), ccw = *(const v4u*)(pr + PC_CC + c0), chw = *(const v4u*)(pr + PC_CH + c0);
        v4u ccp = (v4u){0u, 0u, 0u, 0u}, chp = ccp, ccn = ccp, chn = ccp;
        if (t > 0) { ccp = *(const v4u*)(pr - NP + PC_CC + c0); chp = *(const v4u*)(pr - NP + PC_CH + c0); }
        if (t < len - 1) { ccn = *(const v4u*)(pr + NP + PC_CC + c0); chn = *(const v4u*)(pr + NP + PC_CH + c0); }
        float yf[8], yb[8], la0[8], la1[8], g[8];
        unpack8(__builtin_nontemporal_load((const v4u*)(Y + (size_t)row * RW + c0)), yf); unpack8(__builtin_nontemporal_load((const v4u*)(Y + PA + (size_t)row * RW + c0)), yb); unpack8(__builtin_nontemporal_load((const v4u*)(lo + 1024 + c0)), la0); unpack8(__builtin_nontemporal_load((const v4u*)(lo + 1536 + c0)), la1); unpack8(__builtin_nontemporal_load((const v4u*)(lo + 2048 + c0)), g);
        float kv[8], rv[8], vv[8]; unpack8(kw, kv); unpack8(rw, rv); unpack8(vw, vv);
        float y[8], s = 0.f, rk = 0.f;
#pragma unroll
        for (int j = 0; j < 8; ++j) { y[j] = yf[j] + yb[j]; s += y[j]; const float av = sigm(a0[j] + la0[j]) + sigm(a1[j] + la1[j]); rk += rv[j] * kv[j] * (2.f + (av - 2.f) * ka[j]) * rkp[j]; }
        const float mu = sum8(s) * (1.f / 64.f); rk = sum8(rk); float q = 0.f;
#pragma unroll
        for (int j = 0; j < 8; ++j) { y[j] -= mu; q += y[j] * y[j]; }
        const float rstd = 1.f / sqrtf(sum8(q) * (1.f / 64.f) + GN_EPS);
        float o[8];
#pragma unroll
        for (int j = 0; j < 8; ++j) o[j] = (y[j] * rstd * lg[j] + lb[j] + rk * vv[j]) * g[j];
        float orw[8];
#pragma unroll
        for (int j = 0; j < 8; ++j) orw[j] = o[j];
        float cb[8], cc[8], ch[8], pcc[8], pch[8], ncc[8], nch[8];
        unpack8(cbw, cb); unpack8(ccw, cc); unpack8(chw, ch); unpack8(ccp, pcc); unpack8(chp, pch); unpack8(ccn, ncc); unpack8(chn, nch);
#pragma unroll
        for (int j = 0; j < 8; ++j) o[j] = cb[j] * (pcc[j] * pch[j] * w0[j] + cc[j] * ch[j] * w1[j] + ncc[j] * nch[j] * w2[j]);
        float am = 0.f;
#pragma unroll
        for (int j = 0; j < 8; ++j) am = fmaxf(am, fmaxf(fabsf(orw[j]), fabsf(o[j])));
#pragma unroll
        for (int sh = 1; sh < 64; sh <<= 1) am = fmaxf(am, __shfl_xor(am, sh));
        am = fmaxf(am, 1e-30f); const float inv = 127.f / am; unsigned char* m8 = (unsigned char*)MI + (size_t)row * D + c0;
        *(v2u*)m8 = (v2u){q8pack(orw[0] * inv, orw[1] * inv, orw[2] * inv, orw[3] * inv), q8pack(orw[4] * inv, orw[5] * inv, orw[6] * inv, orw[7] * inv)};
        *(v2u*)(m8 + RW) = (v2u){q8pack(o[0] * inv, o[1] * inv, o[2] * inv, o[3] * inv), q8pack(o[4] * inv, o[5] * inv, o[6] * inv, o[7] * inv)};
        if (lane == 0) ((float*)(OWS + WS_SAM))[row] = am * (1.f / 127.f);
    }
}


template <int KS> __device__ __forceinline__ void lora_afrag(const v4u (&raw)[KS], int fn, v4u (&af)[KS]) {
#pragma unroll
    for (int s = 0; s < KS; ++s) { float v[8]; unpack8(raw[s], v);
        if (fn == 0) {
#pragma unroll
            for (int j = 0; j < 8; ++j) v[j] = 1.f - 2.f * __builtin_amdgcn_rcpf(1.f + __expf(2.f * v[j])); }
        else if (fn == 2) {
#pragma unroll
            for (int j = 0; j < 8; ++j) v[j] = __builtin_amdgcn_rcpf(1.f + __expf(-v[j])); }
        af[s] = pack8(v); }
}
template <int KS, int NT> __device__ __forceinline__ void lora_task(const bf16* P, int col0, int fn, const bf16* wt, bf16* LOg, int ct0, int rb0, int rb1, int n, int hh, LAS unsigned char* tile) {
    v4u bfr[NT][KS];
#pragma unroll
    for (int t = 0; t < NT; ++t)
#pragma unroll
        for (int s = 0; s < KS; ++s) bfr[t][s] = *(const v4u*)(wt + (size_t)(32 * (ct0 + t) + n) * (16 * KS) + 8 * hh + 16 * s);
    v4u raw[KS];
#pragma unroll
    for (int s = 0; s < KS; ++s) raw[s] = *(const v4u*)(P + (size_t)(rb0 * 32 + n) * NP + col0 + 16 * s + 8 * hh);
    for (int rb = rb0; rb < rb1; ++rb) {
        v4u af[KS]; lora_afrag<KS>(raw, fn, af);
        if (rb + 1 < rb1) {
#pragma unroll
            for (int s = 0; s < KS; ++s) raw[s] = *(const v4u*)(P + (size_t)((rb + 1) * 32 + n) * NP + col0 + 16 * s + 8 * hh); }
        int no = n, ho = hh; asm volatile("" : "+v"(no), "+v"(ho));
        constexpr int TP = 64 * NT + 4;
        LAS unsigned char* tw = tile + (4 * ho) * TP + 2 * no;
#pragma unroll
        for (int t = 0; t < NT; ++t) { f32x16 acc = zero16();
#pragma unroll
            for (int s = 0; s < KS; ++s) acc = mm(af[s], bfr[t][s], acc);
#pragma unroll
            for (int r = 0; r < 16; ++r) *(LAS unsigned short*)(tw + ((r & 3) + 8 * (r >> 2)) * TP + 64 * t) = (unsigned short)f2bf(acc[r]); }
        constexpr int CPR = 4 * NT  , RPI = 64 / CPR  ;
        const int lane_ = no + 32 * ho, rr0 = lane_ / CPR, ck = lane_ % CPR;
#pragma unroll
        for (int k = 0; k < 32 / RPI; ++k) { const int row = rr0 + RPI * k; const LAS unsigned* sp = (const LAS unsigned*)(tile + row * TP + 16 * ck);
            v4u o; o.x = sp[0]; o.y = sp[1]; o.z = sp[2]; o.w = sp[3];
            *(v4u*)(LOg + (size_t)(rb * 32 + row) * NLO + 32 * ct0 + 8 * ck) = o; }
    }
}
__device__ __forceinline__ void ph_lora(const KP& p, LAS unsigned char* lds, int l, int gw, int NGW, int wave, int lane) {
    const bf16* P = (const bf16*)(OWS + WS_P); bf16* LO = (bf16*)(OWS + WS_LO); float* NRM = (float*)(OWS + WS_RKS);
    const bf16* LW = (const bf16*)(OWS + WS_LORA) + (size_t)l * LORAW_PER_LAYER; const int n = lane & 31, hh = lane >> 5;
    constexpr int RCH = 7, NRB = MROWS / 32, NCHK = (NRB + RCH - 1) / RCH;
    for (int task = gw; task < NCHK * 24; task += NGW) { const int ctk = task % 24, chunk = task / 24, rb0 = chunk * RCH, rb1 = rb0 + RCH < NRB ? rb0 + RCH : NRB;
        if (ctk < 16) { const int grp = ctk >> 2; lora_task<4, 4>(P, grp < 2 ? PC_WD + 64 * grp : PC_AD + 64 * (grp - 2), grp < 2 ? 0 : 1, LW + (size_t)grp * 512 * 64, LO + grp * 512, (ctk & 3) * 4, rb0, rb1, n, hh, lds + wave * 9216); }
        else lora_task<8, 2>(P, PC_GD, 2, LW + (size_t)4 * 512 * 64, LO + 4 * 512, (ctk - 16) * 2, rb0, rb1, n, hh, lds + wave * 9216); }
    float kkc[8]; ld8f(PIN(I_KK) + l * RW + lane * 8, kkc);
    for (int row0 = gw; row0 < MROWS; row0 += 4 * NGW) {
        v4u kw[4];
#pragma unroll
        for (int u = 0; u < 4; ++u) { const int row = row0 + u * NGW; kw[u] = row < MROWS ? *(const v4u*)(P + (size_t)row * NP + PC_K + lane * 8) : (v4u){0u, 0u, 0u, 0u}; }
#pragma unroll
        for (int u = 0; u < 4; ++u) asm volatile("" : "+v"(kw[u]));
#pragma unroll
        for (int u = 0; u < 4; ++u) { const int row = row0 + u * NGW; float kv[8]; unpack8(kw[u], kv); float ss = 0.f;
#pragma unroll
            for (int j = 0; j < 8; ++j) { const float t = kv[j] * kkc[j]; ss += t * t; }
            ss = sum8(ss); if ((lane & 7) == 0 && row < MROWS) NRM[row * 8 + (lane >> 3)] = 1.f / fmaxf(sqrtf(ss), 1e-12f); } }
}

__device__ __forceinline__ void ph_moe_gather(const KP& p, int l, int gw, int NGW, int lane) {
    const unsigned* gcnt = (const unsigned*)(OWS + WS_CTL) + CW_GCNT + 64 * (l >> 1);
    int cnt[8], pb[9]; pb[0] = 0;
#pragma unroll
    for (int e = 0; e < 8; ++e) { cnt[e] = (int)gcnt[e]; pb[e + 1] = pb[e] + ((cnt[e] + 255) & ~255); }
    const unsigned* rowlist = (const unsigned*)(OWS + WS_ROWLIST); const float* wsel = (const float*)(OWS + WS_WSEL); float* wsort = (float*)(OWS + WS_WSORT);
    const unsigned char* H8 = OWS + WS_H8; unsigned char* HG = OWS + WS_HG; const float* sa = (const float*)(OWS + WS_SA); float* sag = (float*)(OWS + WS_SAG);
    for (int pos0 = gw; pos0 < pb[8]; pos0 += 4 * NGW) {
        unsigned ent[4]; bool live[4];
#pragma unroll
        for (int u = 0; u < 4; ++u) { const int pos = pos0 + u * NGW; int e = 0, base = 0, ce = cnt[0];
#pragma unroll
            for (int k = 1; k < 8; ++k) if (pos >= pb[k]) { e = k; base = pb[k]; ce = cnt[k]; }
            const int rank = pos - base; live[u] = pos < pb[8] && rank < ce; ent[u] = live[u] ? rowlist[(size_t)e * MROWS + rank] : 0u; }
        v4u a[4]; float w[4], sc[4];
#pragma unroll
        for (int u = 0; u < 4; ++u) { a[u] = (v4u){0u, 0u, 0u, 0u}; w[u] = 0.f; sc[u] = 0.f;
            if (live[u]) { a[u] = *(const v4u*)(H8 + (size_t)(ent[u] >> 1) * D + lane * 16); w[u] = wsel[ent[u]]; sc[u] = sa[ent[u] >> 1]; } }
#pragma unroll
        for (int u = 0; u < 4; ++u) { const int pos = pos0 + u * NGW;
            if (pos < pb[8]) { *(v4u*)(HG + (size_t)pos * D + lane * 16) = a[u]; if (lane == 0) { wsort[pos] = w[u]; sag[pos] = sc[u]; } } }
    }
}

__device__ __forceinline__ void ph_ln(const KP& p, LAS unsigned char* lds, int l, int which, int tid, int wave, int gw, int NGW, int lane) {
    const float* modv = (const float*)(OWS + WS_MODV); _Float16* X = (_Float16*)(OWS + WS_X);
    const bf16* BR = (const bf16*)(OWS + (which == 0 ? WS_MIXO : WS_F)); const float* BP = (const float*)(OWS + (which == 0 ? WS_MIXP : WS_FP));
    const float* lg = PIN(which == 0 ? I_LN1G : I_LN2G) + l * D; const float* lb = PIN(which == 0 ? I_LN1B : I_LN2B) + l * D;
    const bool moe = (which == 0) && (l & 1); const bool last = (which == 1) && (l == DEPTH - 1); const bool moe_out = (which == 1) && (l & 1);
    LAS int* lcnt = (LAS int*)lds;
    LAS int* lsel = (LAS int*)(lds + 64);
    int nloc = 0;
    LAS f32x4* rtab = (LAS f32x4*)(lds + 8192);
    if (moe) { if (tid < 16) lcnt[tid] = 0;
        const f32x4* rw4 = (const f32x4*)(PIN(I_RTW) + (size_t)(l >> 1) * D * NE);
#pragma unroll
        for (int k = 0; k < 4; ++k) { const int c = tid + 512 * k, col = c >> 1, hf = c & 1, j = col >> 8, ln = (col & 255) >> 2, i = col & 3; rtab[((j * 4 + i) * 2 + hf) * 64 + ln] = rw4[c]; }
        __syncthreads(); }
    int pbs[9]; pbs[0] = 0;
    if (moe_out) { const unsigned* gcnt = (const unsigned*)(OWS + WS_CTL) + CW_GCNT + 64 * (l >> 1);
#pragma unroll
        for (int e = 0; e < 8; ++e) pbs[e + 1] = pbs[e] + (int)((gcnt[e] + 255u) & ~255u); }
    f32x4 gt[4], g4[4], b4[4], sh[4], sc[4]; ld_row(lg, lane, g4); ld_row(lb, lane, b4);
    typedef int i32x4v __attribute__((ext_vector_type(4)));
    i32x4v tsn = {0, 0, 0, 0};
    if (moe_out) tsn = *(const i32x4v*)((const int*)(OWS + WS_TOKSEL) + ((gw >> 9) * SEQ + (gw & 511)) * 4);
#pragma unroll 3
    for (int it = 0; it < 9; ++it) {
        if (it == 8 && (gw >= NCTX || l == DEPTH - 1)) break;
        const int row = it < 8 ? (gw >> 9) * SEQ + (gw & 511) + 512 * it : NLAT + gw;
        const int mr = mod_row(row); const float* mv = modv + (size_t)(l * 5 + mr) * NMOD;
        if (it == 0 || it == 8) { ld_row(mv + (which == 0 ? 2048 : 5120), lane, gt);
            if (!last) { const float* mv2 = which == 0 ? mv + 3072 : modv + (size_t)((l + 1) * 5 + mr) * NMOD; ld_row(mv2, lane, sh); ld_row(mv2 + 1024, lane, sc); } }
        f32x4 x[4], br[4], t[4];
        if (l == 0 && which == 0) ld_row_nt(row < NLAT ? PIN(I_X) + (size_t)row * D : PIN(I_CTX) + (size_t)(row - NLAT) * D, lane, x); else ld_row_h16(X + (size_t)row * D, lane, x);
        if (moe_out) { const i32x4v tsc = tsn; { const int itn = it + 1, rown = itn < 8 ? (gw >> 9) * SEQ + (gw & 511) + 512 * itn : NLAT + (gw < NCTX ? gw : 0); tsn = *(const i32x4v*)((const int*)(OWS + WS_TOKSEL) + rown * 4); }
            const int e0 = tsc[0], r0 = tsc[1], e1 = tsc[2], r1 = tsc[3]; int b0 = 0, b1 = 0;
#pragma unroll
            for (int k = 1; k < 8; ++k) { if (e0 >= k) b0 = pbs[k]; if (e1 >= k) b1 = pbs[k]; }
            f32x4 ba[4], bb[4]; const int q0 = b0 + r0, q1 = b1 + r1; constexpr int MM = MOE_MAIN_PANELS * 256;
            if (q0 < MM) ld_row_bf16_nt(BR + (size_t)q0 * D, lane, ba); else ld_row_parts<4>(BP + (size_t)(q0 - MM) * D, (size_t)MOE_TAIL_ROWS * D, lane, ba);
            if (q1 < MM) ld_row_bf16_nt(BR + (size_t)q1 * D, lane, bb); else ld_row_parts<4>(BP + (size_t)(q1 - MM) * D, (size_t)MOE_TAIL_ROWS * D, lane, bb);
#pragma unroll
            for (int j = 0; j < 4; ++j) br[j] = ba[j] + bb[j]; }
        else if (row < NLAT) ld_row_bf16_nt(BR + (size_t)row * D, lane, br);
        else if (which == 0) ld_row_parts<2>(BP + (size_t)(row - NLAT) * D, (size_t)NCTX * D, lane, br);
        else ld_row_parts<7>(BP + (size_t)(row - NLAT) * D, (size_t)NCTX * D, lane, br);
        float s = 0.f;
#pragma unroll
        for (int j = 0; j < 4; ++j) { t[j] = DN_ALPHA * x[j] + gt[j] * br[j]; s += (t[j][0] + t[j][1]) + (t[j][2] + t[j][3]); }
        const float mean = wave_sum(s) * (1.f / D); float s2 = 0.f;
#pragma unroll
        for (int j = 0; j < 4; ++j) { t[j] = t[j] - mean; s2 += (t[j][0] * t[j][0] + t[j][1] * t[j][1]) + (t[j][2] * t[j][2] + t[j][3] * t[j][3]); }
        const float rstd = 1.f / sqrtf(wave_sum(s2) * (1.f / D) + LN_EPS);
#pragma unroll
        for (int j = 0; j < 4; ++j) x[j] = t[j] * rstd * g4[j] + b4[j];
        if (last) {
#if PROBE_DUP & (128 | 256)
            { const unsigned* cw = (const unsigned*)(OWS + WS_CTL); const float cval = 10.f * ((float)cw[20001] / 1024.f) / fmaxf((float)cw[20000], 1.f);
#pragma unroll
              for (int j = 0; j < 4; ++j) x[j] = (f32x4){cval, cval, cval, cval}; }
#endif
#if PROBE_DUP & 1024
            { const unsigned* cw = (const unsigned*)(OWS + WS_CTL); const int cu = (int)cw[CW_ICUR + 64 * PROBE_MI]; const float cval = 10.f * floorf(8.f * (float)(cu < CQ_DYN_LIM ? cu : CQ_DYN_LIM) / (float)CQ_DYN_LIM) * 0.125f;
#pragma unroll
              for (int j = 0; j < 4; ++j) x[j] = (f32x4){cval, cval, cval, cval}; }
#endif
            if (row < NLAT) { f32x4* q_ = (f32x4*)(p.out + (size_t)row * D) + lane;
#pragma unroll
                for (int j = 0; j < 4; ++j) __builtin_nontemporal_store(x[j], q_ + 64 * j); } continue; }
        st_row_h16(X + (size_t)row * D, lane, x);
        f32x4 hh[4];
#pragma unroll
        for (int j = 0; j < 4; ++j) hh[j] = x[j] * (1.f + sc[j]) + sh[j];
        st_row_q8(OWS + WS_H8, (float*)(OWS + WS_SA), row, lane, hh);
        if (moe) {
            float lgt[8];
#pragma unroll
            for (int e = 0; e < 8; ++e) lgt[e] = 0.f;
#pragma unroll
            for (int j = 0; j < 4; ++j)
#pragma unroll
                for (int i = 0; i < 4; ++i) { const f32x4 w0 = rtab[((j * 4 + i) * 2 + 0) * 64 + lane], w1 = rtab[((j * 4 + i) * 2 + 1) * 64 + lane]; const float hv = hh[j][i];
                    lgt[0] += hv * w0[0]; lgt[1] += hv * w0[1]; lgt[2] += hv * w0[2]; lgt[3] += hv * w0[3]; lgt[4] += hv * w1[0]; lgt[5] += hv * w1[1]; lgt[6] += hv * w1[2]; lgt[7] += hv * w1[3]; }
#pragma unroll
            for (int e = 0; e < 8; ++e) lgt[e] = wave_sum(lgt[e]) + PIN(I_RTB)[(l >> 1) * NE + e];
            float v0 = lgt[0]; int i0 = 0;
#pragma unroll
            for (int e = 1; e < 8; ++e) if (lgt[e] > v0) { v0 = lgt[e]; i0 = e; }
            float v1 = -3.0e38f; int i1 = -1;
#pragma unroll
            for (int e = 0; e < 8; ++e) if (e != i0 && lgt[e] > v1) { v1 = lgt[e]; i1 = e; }
            const float w0 = 1.f / (1.f + expf(v1 - v0)), w1 = 1.f - w0;
            if (lane == 0) { const int lr0 = __hip_atomic_fetch_add(lcnt + i0, 1, __ATOMIC_RELAXED, __HIP_MEMORY_SCOPE_WORKGROUP), lr1 = __hip_atomic_fetch_add(lcnt + i1, 1, __ATOMIC_RELAXED, __HIP_MEMORY_SCOPE_WORKGROUP); const int li = nloc * NWAVES + wave;
                lsel[li * 8 + 0] = row; lsel[li * 8 + 1] = i0; lsel[li * 8 + 2] = lr0; lsel[li * 8 + 3] = i1; lsel[li * 8 + 4] = lr1;
                ((float*)(OWS + WS_WSEL))[row * 2] = w0; ((float*)(OWS + WS_WSEL))[row * 2 + 1] = w1; }
            ++nloc;
        }
    }
    if (moe) {
        __syncthreads();
        unsigned* gcnt = (unsigned*)(OWS + WS_CTL) + CW_GCNT + 64 * (l >> 1);
        if (tid < 8) lcnt[8 + tid] = (int)__hip_atomic_fetch_add(gcnt + tid, (unsigned)lcnt[tid], __ATOMIC_RELAXED, __HIP_MEMORY_SCOPE_AGENT);
        __syncthreads();
        unsigned* rowlist = (unsigned*)(OWS + WS_ROWLIST); int* toksel = (int*)(OWS + WS_TOKSEL);
        if (tid < 16 * NWAVES) { const int k = tid / NWAVES, w = tid % NWAVES; if (k < 8 || (k == 8 && (int)blockIdx.x * NWAVES + w < NCTX && l != DEPTH - 1)) { const int li = k * NWAVES + w;
            const int row = lsel[li * 8 + 0], e0 = lsel[li * 8 + 1], r0 = lcnt[8 + e0] + lsel[li * 8 + 2], e1 = lsel[li * 8 + 3], r1 = lcnt[8 + e1] + lsel[li * 8 + 4];
            rowlist[(size_t)e0 * MROWS + r0] = (unsigned)row * 2u; rowlist[(size_t)e1 * MROWS + r1] = (unsigned)row * 2u + 1u;
            toksel[row * 4 + 0] = e0; toksel[row * 4 + 1] = r0; toksel[row * 4 + 2] = e1; toksel[row * 4 + 3] = r1; } }
    }
}


#ifndef PROBE_WHICH
#define PROBE_WHICH(x, y) (x)
#endif
#if PROBE_DUP & 128
__device__ __forceinline__ void ph_check_up(const KP& p, int gw, int lane) {
    if (gw >= 64) return;
    const float* X = (const float*)(OWS + WS_X); const float* modv = (const float*)(OWS + WS_MODV); const bf16* ACT = (const bf16*)(OWS + WS_ACT);
    const int row = gw * 257, c = lane * 56 + (gw & 7), mr = mod_row(row); const float* mv = modv + (size_t)(0 * 5 + mr) * NMOD;
    const signed char* H8 = (const signed char*)(OWS + WS_H8); const signed char* W8 = (const signed char*)(OWS + WS_F13); const float* SA = (const float*)(OWS + WS_SA); const unsigned* AM = (const unsigned*)(OWS + WS_AMAX);
    const int j1 = 8 * (c >> 2) + (c & 3), j3 = j1 + 4; int ia = 0, ib = 0;
    for (int k = 0; k < D; ++k) { const int h = H8[(size_t)row * D + k]; ia += h * W8[(size_t)j1 * D + k]; ib += h * W8[(size_t)j3 * D + k]; }
    const float a = (float)ia * SA[row] * __builtin_bit_cast(float, AM[j1]) * (1.f / 127.f), b = (float)ib * SA[row] * __builtin_bit_cast(float, AM[j3]) * (1.f / 127.f);
    (void)X; (void)mv;
    const float ref = a / (1.f + expf(-a)) * b, got = bf2f(ACT[(size_t)row * DFF + c]);
    const float da = ((const float*)(OWS + WS_F))[(size_t)row * DFF + c], db = ((const float*)(OWS + WS_F))[(size_t)4096 * DFF + (size_t)row * DFF + c]; (void)got; (void)db;
    if (row < 4096 && abs(ia) > 1000) { const float ratio = 10.f * fminf(fabsf(PROBE_WHICH(da / a, db / b) - 1.f), 0.4f);
        __hip_atomic_fetch_add((unsigned*)(OWS + WS_CTL) + 20000, 1u, __ATOMIC_RELAXED, __HIP_MEMORY_SCOPE_AGENT); __hip_atomic_fetch_add((unsigned*)(OWS + WS_CTL) + 20001, (unsigned)(ratio * 1024.f), __ATOMIC_RELAXED, __HIP_MEMORY_SCOPE_AGENT); }
}
#endif

#if PROBE_DUP & 256
__device__ __forceinline__ void ph_check_mfma(const KP& p, int lane) {
    typedef int i32x4 __attribute__((ext_vector_type(4)));
    const int r = lane & 15, g = lane >> 4; unsigned aw[4], bw[4];
#pragma unroll
    for (int q = 0; q < 4; ++q) { unsigned a = 0, b = 0;
#pragma unroll
        for (int t = 0; t < 4; ++t) { const int k = 16 * g + 4 * q + t; const int av = ((r * 7 + k * 3) % 5) - 2, bv = ((r * 5 + k * 11) % 7) - 3; a |= (unsigned)(av & 255) << (8 * t); b |= (unsigned)(bv & 255) << (8 * t); }
        aw[q] = a; bw[q] = b; }
    i32x4 c = {0, 0, 0, 0};
    c = __builtin_amdgcn_mfma_i32_16x16x64_i8((i32x4){(int)aw[0], (int)aw[1], (int)aw[2], (int)aw[3]}, (i32x4){(int)bw[0], (int)bw[1], (int)bw[2], (int)bw[3]}, c, 0, 0, 0);
    bool bad = false;
#pragma unroll
    for (int reg = 0; reg < 4; ++reg) { const int i = 4 * g + reg, j = r; int e = 0;
        for (int k = 0; k < 64; ++k) e += (((i * 7 + k * 3) % 5) - 2) * (((j * 5 + k * 11) % 7) - 3);
        if (c[reg] != e) bad = true; }
    if (bad) __hip_atomic_fetch_add((unsigned*)(OWS + WS_CTL) + 20000, 1000u, __ATOMIC_RELAXED, __HIP_MEMORY_SCOPE_AGENT);
}
#endif
__global__ void __launch_bounds__(NWAVES * 64, 2) fwd_kernel(KP p_arg) {
    const KP& p = *(const KP*)__builtin_amdgcn_kernarg_segment_ptr(); (void)p_arg;
    extern __shared__ __attribute__((aligned(16))) unsigned char lds_raw[];
    LAS unsigned char* lds = (LAS unsigned char*)lds_raw;
    volatile LAS unsigned* MISC = (volatile LAS unsigned*)(lds + MISC_OFF);
    const int G = gridDim.x, NGW = G * NWAVES;
    for (int u = threadIdx.x; u < (LDS_BYTES - LDSCTL_OFF) / 4; u += NWAVES * 64) ((LAS unsigned*)(lds + LDSCTL_OFF))[u] = 0u;
    __syncthreads();
    unsigned* ctl = (unsigned*)(OWS + WS_CTL);
    const bool single = p.ph < 0;
    XcdBarrier bar; bar.bar = ctl + CW_BAR; bar.x = 0; bar.st = nullptr;
    if (single) bar = xcd_barrier_post(ctl + CW_BAR, MISC + 8);
    int phc = 0;
#ifndef PROBE_DUP
#define PROBE_DUP 0
#endif
#define REP(bit) for (int rep_ = 0; rep_ < ((PROBE_DUP & (bit)) ? 2 : 1); ++rep_)
#define RUN() (single || p.ph == phc)
#define FRESH() int tid = threadIdx.x; asm volatile("" : "+v"(tid)); const int lane = tid & 63, wave = __builtin_amdgcn_readfirstlane(tid >> 6), gw = blockIdx.x * NWAVES + wave; (void)lane; (void)gw
#ifndef PROBE_TK
#define PROBE_TK 0
#endif
#if PROBE_TK > 0
    unsigned long long tp0_ = wall_clock64();
#define SEAM_PROBE() do { if (phc == PROBE_TA - 1) tp0_ = wall_clock64(); if (phc == PROBE_TB) { const unsigned long long t1_ = wall_clock64(), dt_ = (t1_ - tp0_) * PROBE_TK; if (blockIdx.x == 0) while (wall_clock64() - t1_ < dt_) __builtin_amdgcn_s_sleep(32); } } while (0)
#else
#define SEAM_PROBE() do {} while (0)
#ifdef PROBE_P0
    const unsigned long long tp0_ = wall_clock64();
#endif
#endif
#define SEAM() do { if (single) { XcdBarrier b2_ = bar; b2_.bar = (unsigned*)(OWS + WS_CTL) + CW_BAR; xcd_barrier(b2_); if (PROBE_DUP & 32) { XcdBarrier b3_ = bar; b3_.bar = (unsigned*)(OWS + WS_CTL) + CW_BAR; xcd_barrier(b3_); } } SEAM_PROBE(); ++phc; } while (0)

#ifdef PROBE_P0
#define P0_MARK(id) do { if (PROBE_P0 == (id) && blockIdx.x == 0) { __syncthreads(); const unsigned long long t1_ = wall_clock64(), dt_ = (t1_ - tp0_) * PROBE_P0K; while (wall_clock64() - t1_ < dt_) __builtin_amdgcn_s_sleep(32); } } while (0)
#else
#define P0_MARK(id) do {} while (0)
#endif
    REP(4) if (RUN()) { FRESH(); ph_modvec(p, lds, tid); __syncthreads(); P0_MARK(1); ph_convert(p, lds, gw, NGW, wave, lane); P0_MARK(2); cq_static(p, lds, 3 * CQ_IN + 3 * CQ_OUT + 2 * CQ_UP, CQ_J1, gw, NGW, wave, lane); P0_MARK(3); ph_amax(p, gw, NGW, lane); P0_MARK(4); }
    SEAM();
#if PROBE_DUP & 256
    if (blockIdx.x == 0 && threadIdx.x < 64) ph_check_mfma(p, threadIdx.x);
#endif
    if (RUN()) { FRESH(); ph_init_rows(p, gw, NGW, lane); cq_static(p, lds, -CQ_NEG, 3 * CQ_IN + 3 * CQ_OUT + 2 * CQ_UP, gw, NGW, wave, lane); }
    SEAM();
    for (int ll = 0; ll < DEPTH; ++ll) {
#define l (ll + opaque_zero_i())
         if (RUN()) { pg8::Gemm g{(const bf16*)(OWS + WS_H8), (const bf16*)(OWS + WS_WIN) + (size_t)l * (NP * D / 2), MROWS, NP, D / 2, D / 2}; pg8::StaticOrder S; S.init(MROWS, NP, G, (int)blockIdx.x);
            pg8::EpiBf16S8 E{(bf16*)(OWS + WS_P), NP, (const float*)(OWS + WS_SA), (const float*)(OWS + WS_AMAX) + AM_IN + l * NP}; pg8::gemm_phase<pg8::EpiBf16S8, pg8::StaticOrder, true, true, true>(lds, g, S, E); }
        if (RUN()) { FRESH(); const int segb = ll < 2 ? CQ_J1 : CQ_END0; cq_idle(p, lds, segb, ll >> 1, ll * 4 + 0, IDLE_IN0, tid, wave, lane); }
        SEAM();
        REP(8) if (RUN()) { FRESH(); ph_lora(p, lds, l, gw, NGW, wave, lane); }
        SEAM();
        REP(1) if (RUN()) { FRESH(); ph_scan1(p, lds, l, gw, NGW, wave, lane); }
        SEAM();
        REP(2) if (RUN()) { FRESH(); ph_scan2(p, lds, l, wave, lane); }
        SEAM();
        REP(64) if (RUN()) { FRESH(); ph_readout2(p, l, gw, NGW, lane); }
        SEAM();
         if (RUN()) {
            { pg8::Gemm g{(const bf16*)(OWS + WS_MIXIN), (const bf16*)(OWS + WS_WOUT) + (size_t)l * (D * D / 2), NLAT, D, D / 2, D / 2}; pg8::StaticOrder S; S.init(NLAT, D, G, (int)blockIdx.x);
              pg8::EpiBf16S8 E{(bf16*)(OWS + WS_MIXO), D, (const float*)(OWS + WS_SAM), (const float*)(OWS + WS_AMAX) + AM_OUT + l * D}; pg8::gemm_phase<pg8::EpiBf16S8, pg8::StaticOrder, true, true, true>(lds, g, S, E); }
            if (ll < DEPTH - 1) { pg8::Gemm g{(const bf16*)(OWS + WS_MIXIN), (const bf16*)(OWS + WS_WOUT) + (size_t)l * (D * D / 2), NCTX, D, D / 4, D / 2}; pg8::SplitOrder S{NCTX / 256, D / 256, 2, G, (int)blockIdx.x, NLAT / 256, 0, 0, 0, 0, 0, 0, 0, 0};
              pg8::EpiPartS8 E{(float*)(OWS + WS_MIXP), D, (size_t)NCTX * D, NLAT / 256, (const float*)(OWS + WS_SAM), (const float*)(OWS + WS_AMAX) + AM_OUT + l * D}; pg8::gemm_phase<pg8::EpiPartS8, pg8::SplitOrder, true, true, true>(lds, g, S, E); }
        }
        if (RUN() && ll < DEPTH - 1) { FRESH(); const int segb = ll < 2 ? CQ_J1 : CQ_END0; cq_idle(p, lds, segb, ll >> 1, ll * 4 + 1, IDLE_OT0, tid, wave, lane); }
        SEAM();
        for (int rep2_ = 0; rep2_ < (((PROBE_DUP & 512) && ll == 0) ? 5 : 1); ++rep2_) if (RUN()) { FRESH(); ph_ln(p, lds, l, 0, tid, wave, gw, NGW, lane); if (ll & 1) { __syncthreads(); const int cur_ = (int)__hip_atomic_load((const unsigned*)(OWS + WS_CTL) + CW_ICUR + 64 * (ll >> 1), __ATOMIC_RELAXED, __HIP_MEMORY_SCOPE_AGENT); cq_static(p, lds, (l == 1 ? CQ_J1 : CQ_END0) + CQO_DYN + (cur_ < CQ_DYN_LIM ? cur_ : CQ_DYN_LIM), l == 1 ? CQ_END0 : CQ_END1, gw, NGW, wave, lane); } }
        SEAM();
        if ((l & 1) == 0) {
            const int fi = l >> 1;
             if (RUN()) { pg8::Gemm g{(const bf16*)(OWS + WS_H8), (const bf16*)(OWS + WS_F13) + (size_t)fi * DFF * D, MROWS, 2 * DFF, D / 2, D / 2}; pg8::StaticOrder S; S.init(MROWS, 2 * DFF, G, (int)blockIdx.x);
                constexpr int NOE = 0x7fffffff; pg8::EpiSwiGLU8 E{(bf16*)(OWS + WS_ACT), DFF, nullptr, (const float*)(OWS + WS_SA), (const unsigned*)(OWS + WS_AMAX) + (size_t)fi * 2 * DFF, NOE, NOE, NOE, NOE, NOE, NOE, NOE};
#if PROBE_DUP & 128
                E.dbg = (int*)(OWS + WS_F);
#endif
                pg8::gemm_phase<pg8::EpiSwiGLU8, pg8::StaticOrder, true, true, true>(lds, g, S, E); }
            if (RUN()) { FRESH(); const int segb = ll < 2 ? CQ_J1 : CQ_END0; cq_idle(p, lds, segb, ll >> 1, ll * 4 + 2, IDLE_UP0, tid, wave, lane); }
            SEAM();
#if PROBE_DUP & 128
            if (ll == 0) { if (RUN()) { FRESH(); ph_check_up(p, gw, lane); } SEAM(); }
#endif
             if (RUN()) {
                { pg8::Gemm g{(const bf16*)(OWS + WS_ACT), (const bf16*)(OWS + WS_F2) + (size_t)fi * D * DFF, NLAT, D, DFF, DFF}; pg8::StaticOrder S; S.init(NLAT, D, G, (int)blockIdx.x);
                  pg8::EpiBf16<0> E{(bf16*)(OWS + WS_F), D, nullptr, 0, 0, 1.f}; pg8::gemm_phase<pg8::EpiBf16<0>, pg8::StaticOrder, true, true>(lds, g, S, E); }
                { pg8::Gemm g{(const bf16*)(OWS + WS_ACT), (const bf16*)(OWS + WS_F2) + (size_t)fi * D * DFF, NCTX, D, DFF / 7, DFF}; pg8::SplitOrder S{NCTX / 256, D / 256, 7, G, (int)blockIdx.x, NLAT / 256, 0, 0, 0, 0, 0, 0, 0, 0};
                  pg8::EpiPart E{(float*)(OWS + WS_FP), D, (size_t)NCTX * D, NLAT / 256}; pg8::gemm_phase<pg8::EpiPart, pg8::SplitOrder, true, true>(lds, g, S, E); }
            }
            if (RUN()) { FRESH(); const int segb = ll < 2 ? CQ_J1 : CQ_END0; cq_idle(p, lds, segb, ll >> 1, ll * 4 + 3, IDLE_DT0, tid, wave, lane); }
            SEAM();
        } else {
            if (RUN()) { FRESH(); ph_moe_gather(p, l, gw, NGW, lane); }
            SEAM();
            {   const unsigned* gcnt = (const unsigned*)(OWS + WS_CTL) + CW_GCNT + 64 * (l >> 1); int pbp[9]; pbp[0] = 0;
#pragma unroll
                for (int e = 0; e < 8; ++e) pbp[e + 1] = pbp[e] + (int)((gcnt[e] + 255u) >> 8);
                const int mrows = pbp[8] * 256;
                 if (RUN()) { pg8::Gemm g{(const bf16*)(OWS + WS_HG), (const bf16*)(OWS + WS_MOEW13), mrows, 2 * DFF, D / 2, D / 2}; pg8::MoeOrder S; S.init(mrows, 2 * DFF, G, (int)blockIdx.x);
                    S.pb1 = pbp[1]; S.pb2 = pbp[2]; S.pb3 = pbp[3]; S.pb4 = pbp[4]; S.pb5 = pbp[5]; S.pb6 = pbp[6]; S.pb7 = pbp[7]; S.estride = (size_t)DFF * D;
                    pg8::EpiSwiGLU8 E{(bf16*)(OWS + WS_ACT), DFF, (const float*)(OWS + WS_WSORT), (const float*)(OWS + WS_SAG), (const unsigned*)(OWS + WS_AMAX) + (size_t)(2 + 8 * (l >> 1)) * 2 * DFF, pbp[1], pbp[2], pbp[3], pbp[4], pbp[5], pbp[6], pbp[7]};
                    pg8::gemm_phase<pg8::EpiSwiGLU8, pg8::MoeOrder, true, true, true>(lds, g, S, E); }
                SEAM();
                 if (RUN()) {
                    { pg8::Gemm g{(const bf16*)(OWS + WS_ACT), (const bf16*)(OWS + WS_MOEW2), MOE_MAIN_PANELS * 256, D, DFF, DFF}; pg8::MoeOrder S; S.init(MOE_MAIN_PANELS * 256, D, G, (int)blockIdx.x);
                      S.pb1 = pbp[1]; S.pb2 = pbp[2]; S.pb3 = pbp[3]; S.pb4 = pbp[4]; S.pb5 = pbp[5]; S.pb6 = pbp[6]; S.pb7 = pbp[7]; S.estride = (size_t)D * DFF;
                      pg8::EpiBf16<0> E{(bf16*)(OWS + WS_F), D, nullptr, 0, 0, 1.f}; pg8::gemm_phase<pg8::EpiBf16<0>, pg8::MoeOrder, true, true>(lds, g, S, E); }
                    { const int nT = pbp[8] - MOE_MAIN_PANELS;
                      pg8::Gemm g{(const bf16*)(OWS + WS_ACT), (const bf16*)(OWS + WS_MOEW2), nT * 256, D, DFF / 4, DFF}; pg8::SplitOrder S{nT, D / 256, 4, G, (int)blockIdx.x, MOE_MAIN_PANELS, pbp[1], pbp[2], pbp[3], pbp[4], pbp[5], pbp[6], pbp[7], (size_t)D * DFF};
                      pg8::EpiPart E{(float*)(OWS + WS_FP), D, (size_t)MOE_TAIL_ROWS * D, MOE_MAIN_PANELS}; pg8::gemm_phase<pg8::EpiPart, pg8::SplitOrder, true, true>(lds, g, S, E); }
                }
                SEAM();
            }
        }
        if (RUN()) { FRESH(); ph_ln(p, lds, l, 1, tid, wave, gw, NGW, lane); }
        SEAM();
    }
#undef l
#undef RUN
#undef SEAM
}

#ifndef MK_PER_PHASE
#define MK_PER_PHASE 0
#endif
extern "C" void kernel_launch(void* const* d_in, const int* in_sizes, int n_in, void* d_out, int out_size, void* d_ws, size_t ws_size, hipStream_t stream) {
    static int grid = 0;
    if (grid == 0) {
        if (n_in != N_IN || in_sizes[0] != NLAT * D || out_size != NLAT * D || ws_size < WS_NEED) { fprintf(stderr, "kernel_launch: unexpected shapes / workspace (%d inputs, ws %zu, need %zu)\n", n_in, ws_size, (size_t)WS_NEED); grid = -1; return; }
        int dev = 0, cus = 0, per_cu = 0;
        if (hipGetDevice(&dev) != hipSuccess || hipDeviceGetAttribute(&cus, hipDeviceAttributeMultiprocessorCount, dev) != hipSuccess) { grid = -1; return; }
        if (hipFuncSetAttribute((const void*)fwd_kernel, hipFuncAttributeMaxDynamicSharedMemorySize, LDS_BYTES) != hipSuccess) { fprintf(stderr, "kernel_launch: hipFuncSetAttribute failed\n"); grid = -1; return; }
        if (hipOccupancyMaxActiveBlocksPerMultiprocessor(&per_cu, (const void*)fwd_kernel, NWAVES * 64, LDS_BYTES) != hipSuccess || per_cu < 1) fprintf(stderr, "kernel_launch: occupancy query says %d\n", per_cu);
        (void)hipGetLastError();
        grid = cus;
        if (grid != 256) { fprintf(stderr, "kernel_launch: built for a 256-CU device, found %d CUs\n", cus); grid = -1; return; }
    }
    if (grid < 0) return;
    if (hipMemsetAsync((char*)d_ws + WS_CTL, 0, CTL_BYTES, stream) != hipSuccess) return;
    KP p{};
    for (int i = 0; i < N_IN; ++i) p.in[i] = (const float*)d_in[i];
    p.out = (float*)d_out; p.ws = (unsigned char*)d_ws; p.pad = 0;
#if MK_PER_PHASE
    const int nph = 2 + 2 * 11 + 2 * 13;
    for (int ph = 0; ph < nph; ++ph) { p.ph = ph; hipLaunchKernelGGL(fwd_kernel, dim3(grid), dim3(NWAVES * 64), LDS_BYTES, stream, p); }
#else
    p.ph = -1;
    hipLaunchKernelGGL(fwd_kernel, dim3(grid), dim3(NWAVES * 64), LDS_BYTES, stream, p);
#endif
}
```
